# Optimizing an MI355X kernel written in HIP

```python
import jax, jax.numpy as jnp
from jax import lax
import numpy as np

D_MODEL = 1024
BATCH = 16
SEQ = 2048
DEPTH = 1

N_Q_HEADS = 8
N_KV_HEADS = 2
HEAD_DIM = 64
Q_GROUP = N_Q_HEADS // N_KV_HEADS
ATTN_WIDTH = N_Q_HEADS * HEAD_DIM
KV_WIDTH = N_KV_HEADS * HEAD_DIM
WINDOW = 128
BLOCK = 128
POOL_WINDOWS = (2, 4, 8, 16)
POOL_GROUPS = len(POOL_WINDOWS)
POOL_WIDTH = D_MODEL // 2
POOL_GROUP_DIM = POOL_WIDTH // POOL_GROUPS
IN_WIDTH = ATTN_WIDTH + 2 * KV_WIDTH + POOL_WIDTH
N_BRANCHES = 2
PEER_HEADS = 8
N_KEYS = 128
N_EXPERTS = N_KEYS * N_KEYS
PEER_HALF = 128
PEER_QUERY_DIM = 2 * PEER_HALF
PEER_TOPK = 16
PEER_CHUNK = 128
EPS = 1e-6
NEG_INF = -1e30

kernel_name = "hybrid_swa_pool_peer_encoder"


def _alibi_slopes():
    s = np.array([2.0 ** (-8.0 * (h + 1) / N_Q_HEADS) for h in range(N_Q_HEADS)], dtype=np.float32)
    return jnp.asarray(s).reshape(N_KV_HEADS, Q_GROUP)


def _rmsnorm(x, g):
    xf = x.astype(jnp.float32)
    y = xf * lax.rsqrt(jnp.mean(xf * xf, axis=-1, keepdims=True) + EPS)
    return (y * g.astype(jnp.float32)).astype(x.dtype)


def _windowed_gqa(q, k, v, sink_logits):
    B, S, _ = q.shape
    nb = S // BLOCK
    qb = q.reshape(B, nb, BLOCK, N_KV_HEADS, Q_GROUP, HEAD_DIM)

    def band(t):
        t = t.reshape(B, S, N_KV_HEADS, HEAD_DIM)
        tp = jnp.pad(t, ((0, 0), (BLOCK, BLOCK), (0, 0), (0, 0)))
        tp = tp.reshape(B, nb + 2, BLOCK, N_KV_HEADS, HEAD_DIM)
        return jnp.concatenate([tp[:, :-2], tp[:, 1:-1], tp[:, 2:]], axis=2)

    kb, vb = band(k), band(v)
    logits = jnp.einsum('bnqkgd,bnckd->bnkgqc', qb, kb).astype(jnp.float32) * (HEAD_DIM ** -0.5)
    qpos = jnp.arange(BLOCK)
    cpos = jnp.arange(3 * BLOCK)
    rel = qpos[:, None] + BLOCK - cpos[None, :]
    dist = jnp.abs(rel)
    s_abs = jnp.arange(nb)[:, None] * BLOCK - BLOCK + cpos[None, :]
    valid = (dist <= WINDOW)[None] & ((s_abs >= 0) & (s_abs < S))[:, None, :]
    logits = logits - _alibi_slopes()[:, :, None, None] * dist.astype(jnp.float32)
    logits = jnp.where(valid[None, :, None, None], logits, NEG_INF)
    sink = jnp.broadcast_to(sink_logits.astype(jnp.float32).reshape(N_KV_HEADS, Q_GROUP, 1, 1),
                            logits.shape[:-1] + (1,))
    probs = jax.nn.softmax(jnp.concatenate([logits, sink], axis=-1), axis=-1)[..., :-1]
    out = jnp.einsum('bnkgqc,bnckd->bnqkgd', probs.astype(v.dtype), vb)
    return out.reshape(B, S, ATTN_WIDTH)


def _pool_mixer(u, pool_w, pool_scale):
    B, S, _ = u.shape
    ug = u.reshape(B, S, POOL_GROUPS, POOL_GROUP_DIM)
    csum = jnp.concatenate([jnp.zeros((B, 1, POOL_GROUPS, POOL_GROUP_DIM), jnp.float32),
                            jnp.cumsum(ug.astype(jnp.float32), axis=1)], axis=1)
    t = jnp.arange(S)
    means = []
    for gi, w in enumerate(POOL_WINDOWS):
        lo = jnp.clip(t - w // 2, 0, S)
        hi = jnp.clip(t + w - w // 2, 0, S)
        total = csum[:, hi, gi] - csum[:, lo, gi]
        means.append(total / (hi - lo).astype(jnp.float32)[:, None])
    pooled = jnp.stack(means, axis=2)
    mixed = (pooled - ug.astype(jnp.float32)).astype(u.dtype)
    y = jnp.einsum('bsgc,gcd->bsgd', mixed, pool_w).reshape(B, S, POOL_WIDTH)
    return y * pool_scale


def _peer(h, w_query, sub_keys, u_table, v_table):
    B, S, D = h.shape
    q = (h @ w_query).reshape(B, S, PEER_HEADS, 2, PEER_HALF)
    scores = jnp.einsum('bshpc,hpnc->bshpn', q, sub_keys).astype(jnp.float32)
    top_s, top_i = lax.top_k(scores, PEER_TOPK)
    cand_s = (top_s[..., 0, :, None] + top_s[..., 1, None, :]).reshape(B, S, PEER_HEADS, PEER_TOPK * PEER_TOPK)
    cand_i = (top_i[..., 0, :, None] * N_KEYS + top_i[..., 1, None, :]).reshape(B, S, PEER_HEADS, PEER_TOPK * PEER_TOPK)
    best_s, best_pos = lax.top_k(cand_s, PEER_TOPK)
    expert_idx = jnp.take_along_axis(cand_i, best_pos, axis=-1)
    gate = jax.nn.softmax(best_s, axis=-1).astype(h.dtype)
    nc = (B * S) // PEER_CHUNK
    xs = h.reshape(nc, PEER_CHUNK, D)
    idx = expert_idx.reshape(nc, PEER_CHUNK, PEER_HEADS, PEER_TOPK)
    gs = gate.reshape(nc, PEER_CHUNK, PEER_HEADS, PEER_TOPK)

    def chunk(args):
        xc, ic, gc = args
        u_e = jnp.take(u_table, ic, axis=0)
        act = jax.nn.gelu(jnp.einsum('thkd,td->thk', u_e, xc), approximate=False) * gc
        v_e = jnp.take(v_table, ic, axis=0)
        return jnp.einsum('thk,thkd->td', act, v_e)

    return lax.map(chunk, (xs, idx, gs)).reshape(B, S, D)


def setup_inputs(seed: int = 0) -> dict:
    key = jax.random.key(seed)
    ks = jax.random.split(key, 17)
    nrm = lambda k, shape, s: jax.random.normal(k, shape, jnp.float32) * s
    L = DEPTH
    return {
        "x": nrm(ks[0], (BATCH, SEQ, D_MODEL), 1.0),
        "norm1_g": 1.0 + nrm(ks[1], (L, D_MODEL), 0.01),
        "w_in": nrm(ks[2], (L, D_MODEL, IN_WIDTH), D_MODEL ** -0.5),
        "sink_logits": nrm(ks[3], (L, N_Q_HEADS), 0.5),
        "pool_w": nrm(ks[4], (L, POOL_GROUPS, POOL_GROUP_DIM, POOL_GROUP_DIM), POOL_GROUP_DIM ** -0.5),
        "pool_scale": 1.0 + nrm(ks[5], (L, POOL_WIDTH), 0.1),
        "w_branch": nrm(ks[6], (L, N_BRANCHES, ATTN_WIDTH, D_MODEL), ATTN_WIDTH ** -0.5),
        "w_gate": nrm(ks[7], (L, D_MODEL, N_BRANCHES * D_MODEL), D_MODEL ** -0.5),
        "b_gate": nrm(ks[8], (L, N_BRANCHES * D_MODEL), 0.01),
        "w_out": nrm(ks[9], (L, D_MODEL, D_MODEL), D_MODEL ** -0.5),
        "norm2_g": 1.0 + nrm(ks[10], (L, D_MODEL), 0.01),
        "peer_w_query": nrm(ks[11], (L, D_MODEL, PEER_HEADS * PEER_QUERY_DIM), D_MODEL ** -0.5),
        "peer_sub_keys": nrm(ks[12], (L, PEER_HEADS, 2, N_KEYS, PEER_HALF), PEER_HALF ** -0.5),
        "peer_u": nrm(ks[13], (L, N_EXPERTS, D_MODEL), D_MODEL ** -0.5),
        "peer_v": nrm(ks[14], (L, N_EXPERTS, D_MODEL), 0.5),
        "norm_final_g": 1.0 + nrm(ks[15], (D_MODEL,), 0.01),
    }


def reference(x, norm1_g, w_in, sink_logits, pool_w, pool_scale, w_branch, w_gate, b_gate, w_out,
              norm2_g, peer_w_query, peer_sub_keys, peer_u, peer_v, norm_final_g):
    B, S, D = x.shape
    for l in range(DEPTH):
        h = _rmsnorm(x, norm1_g[l])
        proj = h @ w_in[l]
        q, k, v, u = jnp.split(proj, [ATTN_WIDTH, ATTN_WIDTH + KV_WIDTH, ATTN_WIDTH + 2 * KV_WIDTH], axis=-1)
        o_attn = _windowed_gqa(q, k, v, sink_logits[l])
        o_pool = _pool_mixer(u, pool_w[l], pool_scale[l])
        gates = jax.nn.sigmoid((h @ w_gate[l] + b_gate[l]).astype(jnp.float32)).astype(x.dtype)
        gates = gates.reshape(B, S, N_BRANCHES, D)
        merged = gates[:, :, 0] * (o_attn @ w_branch[l, 0]) + gates[:, :, 1] * (o_pool @ w_branch[l, 1])
        x = x + merged @ w_out[l]
        h2 = _rmsnorm(x, norm2_g[l])
        x = x + _peer(h2, peer_w_query[l], peer_sub_keys[l], peer_u[l], peer_v[l])
    return _rmsnorm(x, norm_final_g)
```

```cpp
#include <hip/hip_runtime.h>
#include <cstdint>
#include <cstdio>

typedef _Float16 f16;
typedef _Float16 half8 __attribute__((ext_vector_type(8)));
typedef _Float16 half4 __attribute__((ext_vector_type(4)));
typedef float f32x4 __attribute__((ext_vector_type(4)));

constexpr int DM = 1024, BATCH = 16, SEQ = 2048, T = BATCH * SEQ;
constexpr int NQKVU = 1280, NGATE = 2048, NCAT = NQKVU + NGATE;
constexpr int COL_K = 512, COL_V = 640, COL_U = 768;
constexpr int NEXP = 16384, PEER_H = 8, TOPK = 16;
constexpr float EPS = 1e-6f;

constexpr size_t MiB = 1u << 20;
constexpr size_t WS_CTL = 0;
constexpr size_t WS_WCAT = 1 * MiB;
constexpr size_t WS_WB = 8 * MiB;
constexpr size_t WS_WOUT = 10 * MiB;
constexpr size_t WS_WQ = 12 * MiB;
constexpr size_t WS_POOLW = 16 * MiB;
constexpr size_t WS_SUBK = 16 * MiB + 512 * 1024;
constexpr size_t WS_RS1 = 17 * MiB;
constexpr size_t WS_SS2 = 17 * MiB + 256 * 1024;
constexpr size_t WS_EIDX = 18 * MiB;
constexpr size_t WS_EGATE = 34 * MiB;
constexpr size_t WS_UTAB = 50 * MiB;
constexpr size_t WS_VTAB = 82 * MiB;
constexpr size_t WS_XH = 114 * MiB;
constexpr size_t WS_MERGED = WS_XH;
constexpr size_t WS_QKVU = 178 * MiB;
constexpr size_t WS_X1H = WS_QKVU;
constexpr size_t WS_GATES = 258 * MiB;
constexpr size_t WS_QP = WS_GATES;
constexpr size_t WS_OCAT = 386 * MiB;
constexpr size_t WS_MIXED = 450 * MiB;
constexpr size_t WS_END = 482 * MiB;

__device__ __forceinline__ float wave_sum(float v) {
#pragma unroll
    for (int o = 1; o < 64; o <<= 1) v += __shfl_xor(v, o);
    return v;
}
__device__ __forceinline__ float gelu_exact(float x) { return 0.5f * x * (1.0f + erff(x * 0.70710678118654752f)); }

__global__ void __launch_bounds__(256) k_transpose(const float* __restrict__ W, int K, int N, f16* __restrict__ out, int ldo, int koff) {
    __shared__ float tile[32][33];
    const int nb = N / 32, kb = blockIdx.x / nb, nbi = blockIdx.x % nb;
    const int tx = threadIdx.x & 31, ty = threadIdx.x >> 5;
    for (int i = ty; i < 32; i += 8) tile[i][tx] = W[(size_t)(kb * 32 + i) * N + nbi * 32 + tx];
    __syncthreads();
    for (int i = ty; i < 32; i += 8) out[(size_t)(nbi * 32 + i) * ldo + koff + kb * 32 + tx] = (f16)tile[tx][i];
}
__global__ void __launch_bounds__(256) k_convert(const float* __restrict__ in, f16* __restrict__ out, size_t n4) {
    for (size_t i = (size_t)blockIdx.x * 256 + threadIdx.x; i < n4; i += (size_t)gridDim.x * 256) {
        const f32x4 v = ((const f32x4*)in)[i];
        half4 h; h[0] = (f16)v[0]; h[1] = (f16)v[1]; h[2] = (f16)v[2]; h[3] = (f16)v[3];
        ((half4*)out)[i] = h;
    }
}
__global__ void __launch_bounds__(256) k_rowprep(const float* __restrict__ x, const float* __restrict__ g, f16* __restrict__ xh, float* __restrict__ ss, int zero_rest) {
    const int lane = threadIdx.x & 63;
    const int wave = (blockIdx.x * 256 + threadIdx.x) >> 6, nw = gridDim.x * 4;
    for (int t = wave; t < T; t += nw) {
        const float* xr = x + (size_t)t * DM;
        float s = 0.f;
#pragma unroll
        for (int j = 0; j < 4; ++j) {
            const f32x4 v = *(const f32x4*)(xr + j * 256 + lane * 4);
            const f32x4 gg = *(const f32x4*)(g + j * 256 + lane * 4);
            s += v[0] * v[0] + v[1] * v[1] + v[2] * v[2] + v[3] * v[3];
            half4 h; h[0] = (f16)(v[0] * gg[0]); h[1] = (f16)(v[1] * gg[1]); h[2] = (f16)(v[2] * gg[2]); h[3] = (f16)(v[3] * gg[3]);
            *(half4*)(xh + (size_t)t * DM + j * 256 + lane * 4) = h;
        }
        s = wave_sum(s);
        if (lane == 0) { ss[t] = s; if (zero_rest) { ss[T + t] = 0.f; ss[2 * T + t] = 0.f; ss[3 * T + t] = 0.f; } }
    }
}

template <class Epi>
__global__ void __launch_bounds__(256) k_gemm_naive(const f16* __restrict__ A, int lda, const f16* __restrict__ Bt, int ldb, int k0, int k1, Epi epi) {
    __shared__ float As[32][65];
    __shared__ float Bs[32][65];
    const int tm = blockIdx.y * 64, tn = blockIdx.x * 64;
    const int tx = threadIdx.x & 15, ty = threadIdx.x >> 4;
    float acc[4][4];
#pragma unroll
    for (int i = 0; i < 4; ++i)
#pragma unroll
        for (int j = 0; j < 4; ++j) acc[i][j] = 0.f;
    for (int kk = k0; kk < k1; kk += 32) {
        for (int i = threadIdx.x; i < 64 * 32; i += 256) {
            const int r = i >> 5, c = i & 31;
            As[c][r] = (float)A[(size_t)(tm + r) * lda + kk + c];
            Bs[c][r] = (float)Bt[(size_t)(tn + r) * ldb + kk + c];
        }
        __syncthreads();
#pragma unroll
        for (int c = 0; c < 32; ++c) {
            float a[4], b[4];
#pragma unroll
            for (int i = 0; i < 4; ++i) { a[i] = As[c][ty * 4 + i]; b[i] = Bs[c][tx * 4 + i]; }
#pragma unroll
            for (int i = 0; i < 4; ++i)
#pragma unroll
                for (int j = 0; j < 4; ++j) acc[i][j] += a[i] * b[j];
        }
        __syncthreads();
    }
#pragma unroll
    for (int i = 0; i < 4; ++i)
#pragma unroll
        for (int j = 0; j < 4; ++j) epi(tm + ty * 4 + i, tn + tx * 4 + j, acc[i][j]);
}

__device__ __forceinline__ float rs_from_ss(const float* ss, int t) {
    const float s = (ss[t] + ss[T + t]) + (ss[2 * T + t] + ss[3 * T + t]);
    return rsqrtf(s * (1.0f / DM) + EPS);
}

struct EpiP1 {
    const float* rs1; const float* bgate; f16* qkvu; f16* gates;
    __device__ __forceinline__ void operator()(int m, int n, float acc) const {
        const float r = rsqrtf(rs1[m] * (1.0f / DM) + EPS);
        const float v = acc * r;
        if (n < NQKVU) qkvu[(size_t)m * NQKVU + n] = (f16)v;
        else { const int c = n - NQKVU; const float z = v + bgate[c]; gates[(size_t)m * NGATE + c] = (f16)(1.0f / (1.0f + __expf(-z))); }
    }
};
struct EpiM0 {
    const f16* gates; float* tmp;
    __device__ __forceinline__ void operator()(int m, int n, float acc) const { tmp[(size_t)m * DM + n] = (float)gates[(size_t)m * NGATE + n] * acc; }
};
struct EpiM1 {
    const f16* gates; const float* tmp; f16* merged;
    __device__ __forceinline__ void operator()(int m, int n, float acc) const { merged[(size_t)m * DM + n] = (f16)(tmp[(size_t)m * DM + n] + (float)gates[(size_t)m * NGATE + DM + n] * acc); }
};
struct EpiOut {
    const float* x; float* x1;
    __device__ __forceinline__ void operator()(int m, int n, float acc) const { x1[(size_t)m * DM + n] = x[(size_t)m * DM + n] + acc; }
};
struct EpiQ {
    const float* ss2; f16* qp;
    __device__ __forceinline__ void operator()(int m, int n, float acc) const { qp[(size_t)m * 2048 + n] = (f16)(acc * rs_from_ss(ss2, m)); }
};

__global__ void __launch_bounds__(256) k_attn_naive(const f16* __restrict__ qkvu, const float* __restrict__ sink, f16* __restrict__ ocat) {
    const int gid = blockIdx.x * 256 + threadIdx.x;
    const int t = gid % T, h = gid / T;
    if (h >= 8) return;
    const int b = t / SEQ, ts = t % SEQ, kh = h >> 2;
    float q[64], o[64];
    const f16* qr = qkvu + (size_t)t * NQKVU + h * 64;
#pragma unroll
    for (int d = 0; d < 64; ++d) { q[d] = (float)qr[d]; o[d] = 0.f; }
    const float slope = exp2f(-(float)(h + 1));
    float m = -1e30f, l = 0.f;
    const int s0 = max(ts - 128, 0), s1 = min(ts + 128, SEQ - 1);
    for (int s = s0; s <= s1; ++s) {
        const f16* kr = qkvu + (size_t)(b * SEQ + s) * NQKVU + COL_K + kh * 64;
        const f16* vr = qkvu + (size_t)(b * SEQ + s) * NQKVU + COL_V + kh * 64;
        float dot = 0.f;
#pragma unroll
        for (int d = 0; d < 64; ++d) dot += q[d] * (float)kr[d];
        const float lg = dot * 0.125f - slope * fabsf((float)(ts - s));
        const float mn = fmaxf(m, lg), al = __expf(m - mn), p = __expf(lg - mn);
        l = l * al + p;
#pragma unroll
        for (int d = 0; d < 64; ++d) o[d] = o[d] * al + p * (float)vr[d];
        m = mn;
    }
    const float sk = sink[h];
    const float mn = fmaxf(m, sk), al = __expf(m - mn);
    l = l * al + __expf(sk - mn);
    const float inv = al / l;
    f16* orow = ocat + (size_t)t * DM + h * 64;
#pragma unroll
    for (int d = 0; d < 64; ++d) orow[d] = (f16)(o[d] * inv);
}

__global__ void __launch_bounds__(256) k_pool_naive(const f16* __restrict__ qkvu, f16* __restrict__ mixed) {
    const size_t gid = (size_t)blockIdx.x * 256 + threadIdx.x;
    const int c = (int)(gid & 511), t = (int)(gid >> 9);
    const int b = t / SEQ, ts = t % SEQ, g = c >> 7, w = 2 << g;
    const int lo = max(ts - w / 2, 0), hi = min(ts + w / 2, SEQ);
    float s = 0.f;
    for (int i = lo; i < hi; ++i) s += (float)qkvu[(size_t)(b * SEQ + i) * NQKVU + COL_U + c];
    const float mean = s / (float)(hi - lo);
    mixed[(size_t)t * 512 + c] = (f16)(mean - (float)qkvu[(size_t)t * NQKVU + COL_U + c]);
}
__global__ void __launch_bounds__(256) k_poolmm_naive(const f16* __restrict__ mixed, const f16* __restrict__ poolw_t, const float* __restrict__ pscale, f16* __restrict__ ocat) {
    const size_t gid = (size_t)blockIdx.x * 256 + threadIdx.x;
    const int n = (int)(gid & 511), t = (int)(gid >> 9), g = n >> 7, d = n & 127;
    const f16* mr = mixed + (size_t)t * 512 + g * 128;
    const f16* wr = poolw_t + (size_t)(g * 128 + d) * 128;
    float acc = 0.f;
    for (int c = 0; c < 128; ++c) acc += (float)mr[c] * (float)wr[c];
    ocat[(size_t)t * DM + 512 + n] = (f16)(acc * pscale[n]);
}


#define INS(LV, LI, v_, i_) do { float cv_ = (v_); int ci_ = (i_); \
    _Pragma("unroll") for (int z_ = 0; z_ < 16; ++z_) { const bool gt_ = cv_ > LV[z_]; const float tv_ = gt_ ? LV[z_] : cv_; const int ti_ = gt_ ? LI[z_] : ci_; \
        LV[z_] = gt_ ? cv_ : LV[z_]; LI[z_] = gt_ ? ci_ : LI[z_]; cv_ = tv_; ci_ = ti_; } } while (0)
__global__ void __launch_bounds__(256) k_route_naive(const f16* __restrict__ qp, const f16* __restrict__ subk, int* __restrict__ eidx, float* __restrict__ egate) {
    const int gid = blockIdx.x * 256 + threadIdx.x;
    const int t = gid % T, h = gid / T;
    if (h >= 8) return;
    float av[16], bv[16]; int ai[16], bi[16];
#pragma unroll
    for (int z = 0; z < 16; ++z) { av[z] = -3e38f; bv[z] = -3e38f; ai[z] = 0; bi[z] = 0; }
    for (int p = 0; p < 2; ++p) {
        const f16* qr = qp + (size_t)t * 2048 + h * 256 + p * 128;
        for (int n = 0; n < 128; ++n) {
            const f16* kr = subk + ((size_t)((h * 2 + p) * 128 + n)) * 128;
            float dot = 0.f;
            for (int c = 0; c < 128; ++c) dot += (float)qr[c] * (float)kr[c];
            if (p == 0) INS(av, ai, dot, n); else INS(bv, bi, dot, n);
        }
    }
    float cv[16]; int ci[16];
#pragma unroll
    for (int z = 0; z < 16; ++z) { cv[z] = -3e38f; ci[z] = 0; }
#pragma unroll
    for (int i = 0; i < 16; ++i)
#pragma unroll
        for (int j = 0; j < 16; ++j)
            if ((i + 1) * (j + 1) <= 16) INS(cv, ci, av[i] + bv[j], ai[i] * 128 + bi[j]);
    float sum = 0.f, e[16];
#pragma unroll
    for (int z = 0; z < 16; ++z) { e[z] = __expf(cv[z] - cv[0]); sum += e[z]; }
    const float inv = 1.0f / sum;
#pragma unroll
    for (int z = 0; z < 16; ++z) { eidx[(size_t)t * 128 + h * 16 + z] = ci[z]; egate[(size_t)t * 128 + h * 16 + z] = e[z] * inv; }
}

__global__ void __launch_bounds__(256) k_peer_gather(const f16* __restrict__ x1h, const float* __restrict__ ss2, const int* __restrict__ eidx, const float* __restrict__ egate,
                                                     const f16* __restrict__ utab, const f16* __restrict__ vtab, float* __restrict__ xio, const float* __restrict__ gf) {
    const int lane = threadIdx.x & 63;
    const int wave = (blockIdx.x * 256 + threadIdx.x) >> 6, nw = gridDim.x * 4;
    for (int t = wave; t < T; t += nw) {
        const float rs2 = rs_from_ss(ss2, t);
        const half8 ha = *(const half8*)(x1h + (size_t)t * DM + 8 * lane), hb = *(const half8*)(x1h + (size_t)t * DM + 512 + 8 * lane);
        float hf[16];
#pragma unroll
        for (int i = 0; i < 8; ++i) { hf[i] = (float)ha[i]; hf[8 + i] = (float)hb[i]; }
        const int e0 = eidx[(size_t)t * 128 + lane], e1 = eidx[(size_t)t * 128 + 64 + lane];
        const float g0 = egate[(size_t)t * 128 + lane], g1 = egate[(size_t)t * 128 + 64 + lane];
        float a0 = 0.f, a1 = 0.f;
#pragma unroll 4
        for (int k = 0; k < 128; ++k) {
            const int e = __builtin_amdgcn_readfirstlane(__shfl(k < 64 ? e0 : e1, k & 63));
            const f16* ur = utab + (size_t)e * DM;
            const half8 ua = *(const half8*)(ur + 8 * lane), ub = *(const half8*)(ur + 512 + 8 * lane);
            float p = 0.f;
#pragma unroll
            for (int i = 0; i < 8; ++i) { p += (float)ua[i] * hf[i]; p += (float)ub[i] * hf[8 + i]; }
            p = wave_sum(p);
            if (lane == (k & 63)) { if (k < 64) a0 = p; else a1 = p; }
        }
        a0 = gelu_exact(a0 * rs2) * g0; a1 = gelu_exact(a1 * rs2) * g1;
        float o[16];
#pragma unroll
        for (int i = 0; i < 16; ++i) o[i] = 0.f;
#pragma unroll 4
        for (int k = 0; k < 128; ++k) {
            const int e = __builtin_amdgcn_readfirstlane(__shfl(k < 64 ? e0 : e1, k & 63));
            const float a = __shfl(k < 64 ? a0 : a1, k & 63);
            const f16* vr = vtab + (size_t)e * DM;
            const half8 va = *(const half8*)(vr + 8 * lane), vb = *(const half8*)(vr + 512 + 8 * lane);
#pragma unroll
            for (int i = 0; i < 8; ++i) { o[i] += a * (float)va[i]; o[8 + i] += a * (float)vb[i]; }
        }
        float* xr = xio + (size_t)t * DM;
        float y[16]; float s = 0.f;
#pragma unroll
        for (int j = 0; j < 4; ++j) {
            const f32x4 v = *(const f32x4*)(xr + (j >> 1) * 512 + 8 * lane + (j & 1) * 4);
#pragma unroll
            for (int i = 0; i < 4; ++i) { y[j * 4 + i] = v[i] + o[j * 4 + i]; s += y[j * 4 + i] * y[j * 4 + i]; }
        }
        s = wave_sum(s);
        const float r = rsqrtf(s * (1.0f / DM) + EPS);
#pragma unroll
        for (int j = 0; j < 4; ++j) {
            const int c0 = (j >> 1) * 512 + 8 * lane + (j & 1) * 4;
            const f32x4 gg = *(const f32x4*)(gf + c0);
            f32x4 v;
#pragma unroll
            for (int i = 0; i < 4; ++i) v[i] = y[j * 4 + i] * r * gg[i];
            *(f32x4*)(xr + c0) = v;
        }
    }
}

extern "C" void kernel_launch(void* const* d_in, const int* in_sizes, int n_in, void* d_out, int out_size, void* d_ws, size_t ws_size, hipStream_t stream) {
    if (n_in != 16 || in_sizes[0] != T * DM || out_size != T * DM || ws_size < WS_END) {
        fprintf(stderr, "kernel_launch: unexpected shapes (n_in %d in0 %d out %d ws %zu)\n", n_in, n_in > 0 ? in_sizes[0] : -1, out_size, ws_size);
        return;
    }
    const float* x = (const float*)d_in[0];
    const float* norm1_g = (const float*)d_in[1];
    const float* w_in = (const float*)d_in[2];
    const float* sink = (const float*)d_in[3];
    const float* pool_w = (const float*)d_in[4];
    const float* pool_scale = (const float*)d_in[5];
    const float* w_branch = (const float*)d_in[6];
    const float* w_gate = (const float*)d_in[7];
    const float* b_gate = (const float*)d_in[8];
    const float* w_out = (const float*)d_in[9];
    const float* norm2_g = (const float*)d_in[10];
    const float* w_query = (const float*)d_in[11];
    const float* sub_keys = (const float*)d_in[12];
    const float* peer_u = (const float*)d_in[13];
    const float* peer_v = (const float*)d_in[14];
    const float* normf_g = (const float*)d_in[15];
    float* out = (float*)d_out;
    char* ws = (char*)d_ws;
    f16* wcat = (f16*)(ws + WS_WCAT); f16* wb = (f16*)(ws + WS_WB); f16* wout = (f16*)(ws + WS_WOUT); f16* wq = (f16*)(ws + WS_WQ);
    f16* poolw = (f16*)(ws + WS_POOLW); f16* subk = (f16*)(ws + WS_SUBK);
    float* rs1 = (float*)(ws + WS_RS1); float* ss2 = (float*)(ws + WS_SS2);
    int* eidx = (int*)(ws + WS_EIDX); float* egate = (float*)(ws + WS_EGATE);
    f16* utab = (f16*)(ws + WS_UTAB); f16* vtab = (f16*)(ws + WS_VTAB);
    f16* xh = (f16*)(ws + WS_XH); f16* merged = (f16*)(ws + WS_MERGED);
    f16* qkvu = (f16*)(ws + WS_QKVU); f16* x1h = (f16*)(ws + WS_X1H);
    f16* gates = (f16*)(ws + WS_GATES); f16* qp = (f16*)(ws + WS_QP);
    f16* ocat = (f16*)(ws + WS_OCAT); f16* mixed = (f16*)(ws + WS_MIXED);

    k_transpose<<<(1024 / 32) * (1280 / 32), 256, 0, stream>>>(w_in, 1024, 1280, wcat, 1024, 0);
    k_transpose<<<(1024 / 32) * (2048 / 32), 256, 0, stream>>>(w_gate, 1024, 2048, wcat + (size_t)NQKVU * 1024, 1024, 0);
    k_transpose<<<(512 / 32) * (1024 / 32), 256, 0, stream>>>(w_branch, 512, 1024, wb, 1024, 0);
    k_transpose<<<(512 / 32) * (1024 / 32), 256, 0, stream>>>(w_branch + 512 * 1024, 512, 1024, wb, 1024, 512);
    k_transpose<<<(1024 / 32) * (1024 / 32), 256, 0, stream>>>(w_out, 1024, 1024, wout, 1024, 0);
    k_transpose<<<(1024 / 32) * (2048 / 32), 256, 0, stream>>>(w_query, 1024, 2048, wq, 1024, 0);
    for (int g = 0; g < 4; ++g) k_transpose<<<(128 / 32) * (128 / 32), 256, 0, stream>>>(pool_w + g * 128 * 128, 128, 128, poolw + g * 128 * 128, 128, 0);
    k_convert<<<256, 256, 0, stream>>>(sub_keys, subk, (size_t)8 * 2 * 128 * 128 / 4);
    k_convert<<<2048, 256, 0, stream>>>(peer_u, utab, (size_t)NEXP * DM / 4);
    k_convert<<<2048, 256, 0, stream>>>(peer_v, vtab, (size_t)NEXP * DM / 4);
    k_rowprep<<<2048, 256, 0, stream>>>(x, norm1_g, xh, rs1, 0);
    k_gemm_naive<EpiP1><<<dim3(NCAT / 64, T / 64), 256, 0, stream>>>(xh, DM, wcat, DM, 0, DM, EpiP1{rs1, b_gate, qkvu, gates});
    k_attn_naive<<<T * 8 / 256, 256, 0, stream>>>(qkvu, sink, ocat);
    k_pool_naive<<<T * 512 / 256, 256, 0, stream>>>(qkvu, mixed);
    k_poolmm_naive<<<T * 512 / 256, 256, 0, stream>>>(mixed, poolw, pool_scale, ocat);
    k_gemm_naive<EpiM0><<<dim3(DM / 64, T / 64), 256, 0, stream>>>(ocat, DM, wb, DM, 0, 512, EpiM0{gates, out});
    k_gemm_naive<EpiM1><<<dim3(DM / 64, T / 64), 256, 0, stream>>>(ocat, DM, wb, DM, 512, 1024, EpiM1{gates, out, merged});
    k_gemm_naive<EpiOut><<<dim3(DM / 64, T / 64), 256, 0, stream>>>(merged, DM, wout, DM, 0, DM, EpiOut{x, out});
    k_rowprep<<<2048, 256, 0, stream>>>(out, norm2_g, x1h, ss2, 1);
    k_gemm_naive<EpiQ><<<dim3(2048 / 64, T / 64), 256, 0, stream>>>(x1h, DM, wq, DM, 0, DM, EpiQ{ss2, qp});
    k_route_naive<<<T * 8 / 256, 256, 0, stream>>>(qp, subk, eidx, egate);
    k_peer_gather<<<2048, 256, 0, stream>>>(x1h, ss2, eidx, egate, utab, vtab, out, normf_g);
}
```

```cpp
#include <hip/hip_runtime.h>
#include <cstdint>
#include <cstdio>

typedef _Float16 f16;
typedef _Float16 half8 __attribute__((ext_vector_type(8)));
typedef _Float16 half4 __attribute__((ext_vector_type(4)));
typedef float f32x4 __attribute__((ext_vector_type(4)));
#define LAS __attribute__((address_space(3)))
#define GAS __attribute__((address_space(1)))

constexpr int DM = 1024, BATCH = 16, SEQ = 2048, T = BATCH * SEQ;
constexpr int NQKVU = 1280, NGATE = 2048, NCAT = NQKVU + NGATE;
constexpr int COL_K = 512, COL_V = 640, COL_U = 768;
constexpr int NEXP = 16384, PEER_H = 8, TOPK = 16;
constexpr float EPS = 1e-6f;
constexpr int NWAVES = 8, NTHREADS = NWAVES * 64;

constexpr size_t MiB = 1u << 20;
constexpr size_t WS_CTL = 0, CTL_ZERO_BYTES = 64 * 1024;
constexpr size_t WS_WCAT = 1 * MiB;
constexpr size_t WS_WB = 8 * MiB;
constexpr size_t WS_WOUT = 10 * MiB;
constexpr size_t WS_WQ = 12 * MiB;
constexpr size_t WS_POOLW = 16 * MiB;
constexpr size_t WS_SUBK = 16 * MiB + 512 * 1024;
constexpr size_t WS_RS1 = 17 * MiB;
constexpr size_t WS_EIDX = 18 * MiB;
constexpr size_t WS_EGATE = 34 * MiB;
constexpr size_t WS_UTAB = 50 * MiB;
constexpr size_t WS_VTAB = 82 * MiB;
constexpr size_t WS_XH = 114 * MiB;
constexpr size_t WS_MERGED = WS_XH;
constexpr size_t WS_QKVU = 178 * MiB;
constexpr size_t WS_X1H = WS_QKVU;
constexpr size_t WS_GATES = 258 * MiB;
constexpr size_t WS_QP = WS_GATES;
constexpr size_t WS_OCAT = 386 * MiB;
constexpr size_t WS_MIXED = 450 * MiB;
constexpr size_t WS_SS2 = 482 * MiB;
constexpr size_t WS_END = 484 * MiB;
constexpr int CW_BAR = 4096;

constexpr int RING_OFF = 0, RING_BYTES = 131072;
constexpr int LDSCTL_OFF = RING_BYTES, MISC_OFF = LDSCTL_OFF + 320;
constexpr int LDS_BYTES = 147456;

#define LDS_WAIT() asm volatile("s_waitcnt lgkmcnt(0)" ::: "memory")
__device__ __forceinline__ float wave_sum(float v) {
#pragma unroll
    for (int o = 1; o < 64; o <<= 1) v += __shfl_xor(v, o);
    return v;
}
__device__ __forceinline__ float gelu_exact(float x) { return 0.5f * x * (1.0f + erff(x * 0.70710678118654752f)); }
__device__ __forceinline__ float rs_from_ss(const float* ss, int t) {
    float s = 0.f;
#pragma unroll
    for (int i = 0; i < 16; ++i) s += ss[(size_t)i * T + t];
    return rsqrtf(s * (1.0f / DM) + EPS);
}

struct Ctx {
    int tid, lane, wave;
    int G;
    int gw, ngw;
    int gt, ngt;
};

__device__ __forceinline__ void p0_transpose_item(const float* W, int K, int N, f16* WT, int ldo, int koff, LAS float* scr, int item, int lane) {
    const int nblk = N / 32, kb = item / nblk, nb = item % nblk, k0 = 64 * kb, n0 = 32 * nb;
#pragma unroll 8
    for (int i = 0; i < 32; ++i) { const int kk = 2 * i + (lane >> 5); scr[kk * 33 + (lane & 31)] = W[(size_t)(k0 + kk) * N + n0 + (lane & 31)]; }
    LDS_WAIT(); asm volatile("" ::: "memory");
    const int c = lane & 7;
#pragma unroll
    for (int j = 0; j < 4; ++j) { const int n = (lane >> 3) + 8 * j; const LAS float* s = scr + (8 * c) * 33 + n;
        half8 o;
#pragma unroll
        for (int i = 0; i < 8; ++i) o[i] = (f16)s[i * 33];
        *(half8*)(WT + (size_t)(n0 + n) * ldo + koff + k0 + 8 * c) = o; }
    LDS_WAIT(); asm volatile("" ::: "memory");
}
__device__ __forceinline__ void cvt_stream(const Ctx& C, const float* in, f16* out, size_t n4) {
    for (size_t i = (size_t)C.gt; i < n4; i += (size_t)C.ngt) {
        const f32x4 v = ((const f32x4*)in)[i];
        half4 h; h[0] = (f16)v[0]; h[1] = (f16)v[1]; h[2] = (f16)v[2]; h[3] = (f16)v[3];
        ((half4*)out)[i] = h;
    }
}
__device__ __forceinline__ void rowprep(const Ctx& C, const float* x, const float* g, f16* xh, float* ss) {
    const int lane = C.lane;
    for (int t = C.gw; t < T; t += C.ngw) {
        const float* xr = x + (size_t)t * DM;
        float s = 0.f;
#pragma unroll
        for (int j = 0; j < 4; ++j) {
            const f32x4 v = *(const f32x4*)(xr + j * 256 + lane * 4);
            const f32x4 gg = *(const f32x4*)(g + j * 256 + lane * 4);
            s += v[0] * v[0] + v[1] * v[1] + v[2] * v[2] + v[3] * v[3];
            half4 h; h[0] = (f16)(v[0] * gg[0]); h[1] = (f16)(v[1] * gg[1]); h[2] = (f16)(v[2] * gg[2]); h[3] = (f16)(v[3] * gg[3]);
            *(half4*)(xh + (size_t)t * DM + j * 256 + lane * 4) = h;
        }
        s = wave_sum(s);
        if (lane == 0) ss[t] = s;
    }
}
__device__ __forceinline__ void ph_prep(const Ctx& C, LAS unsigned char* lds, const float* const* in, unsigned char* ws) {
    LAS float* scr = (LAS float*)(lds + RING_OFF + C.wave * 16384);
    f16* wcat = (f16*)(ws + WS_WCAT); f16* wb = (f16*)(ws + WS_WB); f16* wout = (f16*)(ws + WS_WOUT); f16* wq = (f16*)(ws + WS_WQ); f16* poolw = (f16*)(ws + WS_POOLW);
    constexpr int I_IN = 16 * 40, I_G = 16 * 64, I_B = 8 * 32, I_O = 16 * 32, I_Q = 16 * 64, I_P = 2 * 4;
    constexpr int NITEMS = I_IN + I_G + 2 * I_B + I_O + I_Q + 4 * I_P;
    for (int it = C.gw; it < NITEMS; it += C.ngw) {
        int r = it;
        if (r < I_IN) { p0_transpose_item(in[2], 1024, 1280, wcat, 1024, 0, scr, r, C.lane); continue; } r -= I_IN;
        if (r < I_G) { p0_transpose_item(in[7], 1024, 2048, wcat + (size_t)NQKVU * 1024, 1024, 0, scr, r, C.lane); continue; } r -= I_G;
        if (r < I_B) { p0_transpose_item(in[6], 512, 1024, wb, 1024, 0, scr, r, C.lane); continue; } r -= I_B;
        if (r < I_B) { p0_transpose_item(in[6] + 512 * 1024, 512, 1024, wb, 1024, 512, scr, r, C.lane); continue; } r -= I_B;
        if (r < I_O) { p0_transpose_item(in[9], 1024, 1024, wout, 1024, 0, scr, r, C.lane); continue; } r -= I_O;
        if (r < I_Q) { p0_transpose_item(in[11], 1024, 2048, wq, 1024, 0, scr, r, C.lane); continue; } r -= I_Q;
        { const int g = r / I_P; p0_transpose_item(in[4] + g * 128 * 128, 128, 128, poolw + g * 128 * 128, 128, 0, scr, r % I_P, C.lane); }
    }
    cvt_stream(C, in[12], (f16*)(ws + WS_SUBK), (size_t)8 * 2 * 128 * 128 / 4);
    cvt_stream(C, in[13], (f16*)(ws + WS_UTAB), (size_t)NEXP * DM / 4);
    cvt_stream(C, in[14], (f16*)(ws + WS_VTAB), (size_t)NEXP * DM / 4);
    rowprep(C, in[0], in[1], (f16*)(ws + WS_XH), (float*)(ws + WS_RS1));
}

__device__ __forceinline__ void ph_attn_naive(const Ctx& C, const f16* __restrict__ qkvu, const float* __restrict__ sink, f16* __restrict__ ocat) {
    for (int gid = C.gt; gid < T * 8; gid += C.ngt) {
        const int t = gid % T, h = gid / T;
        const int b = t / SEQ, ts = t % SEQ, kh = h >> 2;
        float q[64], o[64];
        const f16* qr = qkvu + (size_t)t * NQKVU + h * 64;
#pragma unroll
        for (int d = 0; d < 64; ++d) { q[d] = (float)qr[d]; o[d] = 0.f; }
        const float slope = exp2f(-(float)(h + 1));
        float m = -1e30f, l = 0.f;
        const int s0 = max(ts - 128, 0), s1 = min(ts + 128, SEQ - 1);
        for (int s = s0; s <= s1; ++s) {
            const f16* kr = qkvu + (size_t)(b * SEQ + s) * NQKVU + COL_K + kh * 64;
            const f16* vr = qkvu + (size_t)(b * SEQ + s) * NQKVU + COL_V + kh * 64;
            float dot = 0.f;
#pragma unroll
            for (int d = 0; d < 64; ++d) dot += q[d] * (float)kr[d];
            const float lg = dot * 0.125f - slope * fabsf((float)(ts - s));
            const float mn = fmaxf(m, lg), al = __expf(m - mn), p = __expf(lg - mn);
            l = l * al + p;
#pragma unroll
            for (int d = 0; d < 64; ++d) o[d] = o[d] * al + p * (float)vr[d];
            m = mn;
        }
        const float sk = sink[h];
        const float mn = fmaxf(m, sk), al = __expf(m - mn);
        l = l * al + __expf(sk - mn);
        const float inv = al / l;
        f16* orow = ocat + (size_t)t * DM + h * 64;
#pragma unroll
        for (int d = 0; d < 64; ++d) orow[d] = (f16)(o[d] * inv);
    }
}

__device__ __forceinline__ void ph_pool_naive(const Ctx& C, const f16* __restrict__ qkvu, f16* __restrict__ mixed) {
    for (size_t gid = (size_t)C.gt; gid < (size_t)T * 512; gid += (size_t)C.ngt) {
        const int c = (int)(gid & 511), t = (int)(gid >> 9);
        const int b = t / SEQ, ts = t % SEQ, g = c >> 7, w = 2 << g;
        const int lo = max(ts - w / 2, 0), hi = min(ts + w / 2, SEQ);
        float s = 0.f;
        for (int i = lo; i < hi; ++i) s += (float)qkvu[(size_t)(b * SEQ + i) * NQKVU + COL_U + c];
        const float mean = s / (float)(hi - lo);
        mixed[(size_t)t * 512 + c] = (f16)(mean - (float)qkvu[(size_t)t * NQKVU + COL_U + c]);
    }
}
__device__ __forceinline__ void ph_poolmm_naive(const Ctx& C, const f16* __restrict__ mixed, const f16* __restrict__ poolw_t, const float* __restrict__ pscale, f16* __restrict__ ocat) {
    for (size_t gid = (size_t)C.gt; gid < (size_t)T * 512; gid += (size_t)C.ngt) {
        const int n = (int)(gid & 511), t = (int)(gid >> 9), g = n >> 7, d = n & 127;
        const f16* mr = mixed + (size_t)t * 512 + g * 128;
        const f16* wr = poolw_t + (size_t)(g * 128 + d) * 128;
        float acc = 0.f;
        for (int c = 0; c < 128; ++c) acc += (float)mr[c] * (float)wr[c];
        ocat[(size_t)t * DM + 512 + n] = (f16)(acc * pscale[n]);
    }
}

#define INS(LV, LI, v_, i_) do { float cv_ = (v_); int ci_ = (i_); \
    _Pragma("unroll") for (int z_ = 0; z_ < 16; ++z_) { const bool gt_ = cv_ > LV[z_]; const float tv_ = gt_ ? LV[z_] : cv_; const int ti_ = gt_ ? LI[z_] : ci_; \
        LV[z_] = gt_ ? cv_ : LV[z_]; LI[z_] = gt_ ? ci_ : LI[z_]; cv_ = tv_; ci_ = ti_; } } while (0)
__device__ __forceinline__ void ph_route_naive(const Ctx& C, const f16* __restrict__ qp, const float* __restrict__ ss2, const f16* __restrict__ subk, int* __restrict__ eidx, float* __restrict__ egate) {
    for (int gid = C.gt; gid < T * 8; gid += C.ngt) {
        const int t = gid % T, h = gid / T;
        const float rs2 = rs_from_ss(ss2, t);
        float av[16], bv[16]; int ai[16], bi[16];
#pragma unroll
        for (int z = 0; z < 16; ++z) { av[z] = -3e38f; bv[z] = -3e38f; ai[z] = 0; bi[z] = 0; }
        for (int p = 0; p < 2; ++p) {
            const f16* qr = qp + (size_t)t * 2048 + h * 256 + p * 128;
            for (int n = 0; n < 128; ++n) {
                const f16* kr = subk + ((size_t)((h * 2 + p) * 128 + n)) * 128;
                float dot = 0.f;
                for (int c = 0; c < 128; ++c) dot += (float)qr[c] * (float)kr[c];
                dot *= rs2;
                if (p == 0) INS(av, ai, dot, n); else INS(bv, bi, dot, n);
            }
        }
        float cv[16]; int ci[16];
#pragma unroll
        for (int z = 0; z < 16; ++z) { cv[z] = -3e38f; ci[z] = 0; }
#pragma unroll
        for (int i = 0; i < 16; ++i)
#pragma unroll
            for (int j = 0; j < 16; ++j)
                if ((i + 1) * (j + 1) <= 16) INS(cv, ci, av[i] + bv[j], ai[i] * 128 + bi[j]);
        float sum = 0.f, e[16];
#pragma unroll
        for (int z = 0; z < 16; ++z) { e[z] = __expf(cv[z] - cv[0]); sum += e[z]; }
        const float inv = 1.0f / sum;
#pragma unroll
        for (int z = 0; z < 16; ++z) { eidx[(size_t)t * 128 + h * 16 + z] = ci[z]; egate[(size_t)t * 128 + h * 16 + z] = e[z] * inv; }
    }
}

__device__ __forceinline__ void ph_gather(const Ctx& C, const f16* __restrict__ x1h, const float* __restrict__ ss2, const int* __restrict__ eidx, const float* __restrict__ egate,
                                          const f16* __restrict__ utab, const f16* __restrict__ vtab, float* __restrict__ xio, const float* __restrict__ gf) {
    const int lane = C.lane;
    for (int t = C.gw; t < T; t += C.ngw) {
        const float rs2 = rs_from_ss(ss2, t);
        const half8 ha = *(const half8*)(x1h + (size_t)t * DM + 8 * lane), hb = *(const half8*)(x1h + (size_t)t * DM + 512 + 8 * lane);
        float hf[16];
#pragma unroll
        for (int i = 0; i < 8; ++i) { hf[i] = (float)ha[i]; hf[8 + i] = (float)hb[i]; }
        const int e0 = eidx[(size_t)t * 128 + lane], e1 = eidx[(size_t)t * 128 + 64 + lane];
        const float g0 = egate[(size_t)t * 128 + lane], g1 = egate[(size_t)t * 128 + 64 + lane];
        float a0 = 0.f, a1 = 0.f;
#pragma unroll 4
        for (int k = 0; k < 128; ++k) {
            const int e = __builtin_amdgcn_readfirstlane(__shfl(k < 64 ? e0 : e1, k & 63));
            const f16* ur = utab + (size_t)e * DM;
            const half8 ua = *(const half8*)(ur + 8 * lane), ub = *(const half8*)(ur + 512 + 8 * lane);
            float p = 0.f;
#pragma unroll
            for (int i = 0; i < 8; ++i) { p += (float)ua[i] * hf[i]; p += (float)ub[i] * hf[8 + i]; }
            p = wave_sum(p);
            if (lane == (k & 63)) { if (k < 64) a0 = p; else a1 = p; }
        }
        a0 = gelu_exact(a0 * rs2) * g0; a1 = gelu_exact(a1 * rs2) * g1;
        float o[16];
#pragma unroll
        for (int i = 0; i < 16; ++i) o[i] = 0.f;
#pragma unroll 4
        for (int k = 0; k < 128; ++k) {
            const int e = __builtin_amdgcn_readfirstlane(__shfl(k < 64 ? e0 : e1, k & 63));
            const float a = __shfl(k < 64 ? a0 : a1, k & 63);
            const f16* vr = vtab + (size_t)e * DM;
            const half8 va = *(const half8*)(vr + 8 * lane), vb = *(const half8*)(vr + 512 + 8 * lane);
#pragma unroll
            for (int i = 0; i < 8; ++i) { o[i] += a * (float)va[i]; o[8 + i] += a * (float)vb[i]; }
        }
        float* xr = xio + (size_t)t * DM;
        float y[16]; float s = 0.f;
#pragma unroll
        for (int j = 0; j < 4; ++j) {
            const f32x4 v = *(const f32x4*)(xr + (j >> 1) * 512 + 8 * lane + (j & 1) * 4);
#pragma unroll
            for (int i = 0; i < 4; ++i) { y[j * 4 + i] = v[i] + o[j * 4 + i]; s += y[j * 4 + i] * y[j * 4 + i]; }
        }
        s = wave_sum(s);
        const float r = rsqrtf(s * (1.0f / DM) + EPS);
#pragma unroll
        for (int j = 0; j < 4; ++j) {
            const int c0 = (j >> 1) * 512 + 8 * lane + (j & 1) * 4;
            const f32x4 gg = *(const f32x4*)(gf + c0);
            f32x4 v;
#pragma unroll
            for (int i = 0; i < 4; ++i) v[i] = y[j * 4 + i] * r * gg[i];
            *(f32x4*)(xr + c0) = v;
        }
    }
}

namespace pg8 {
#define PG8_LAS __attribute__((address_space(3)))
typedef _Float16 frag8 __attribute__((ext_vector_type(8)));
typedef float f32x4 __attribute__((ext_vector_type(4)));
constexpr int BM = 256, BK = 64, HALF = 128, HTB = HALF * BK * 2  , STAGE_BYTES = 8 * HTB, NXCD = 8, WGM = 8;

__host__ __device__ __forceinline__ int lds_byte(int r, int c) { const int st = (r >> 4) * 2 + (c >> 5), rr = r & 15, cc = c & 31, ob = rr * 64 + cc * 2; return st * 1024 + (ob ^ (((ob >> 9) & 1) << 5)); }
__host__ __device__ __forceinline__ void stage_rc(int b, int& R, int& C) { const int st = b / 1024, sb = b % 1024, swz = sb ^ (((sb >> 9) & 1) << 5); R = (st >> 1) * 16 + swz / 64; C = (st & 1) * 32 + (swz % 64) / 2; }
__host__ __device__ __forceinline__ int perm32(int rho) { const int n = rho >> 4, i = rho & 15; return 8 * (i >> 2) + 4 * n + (i & 3); }

struct Unit { int pm, pn; };
struct Gemm { const f16* A; const f16* Bt; int M, N, K; };

struct StaticOrder {
    int nM, nN, nwg, G, c;
    __host__ __device__ void init(int M, int N, int G_, int c_) { nM = M / BM; nN = N / BM; nwg = nM * nN; G = G_; c = c_; }
    __host__ __device__ bool next(int i, Unit& u) const {
        const long L = (long)i * G + c; if (L >= nwg) return false;
        int wgid = (int)L; { const int q = nwg / NXCD, r = nwg % NXCD, xcd = wgid % NXCD, off = wgid / NXCD; wgid = (xcd < r ? xcd * (q + 1) : r * (q + 1) + (xcd - r) * q) + off; }
        const int nig = WGM * nN, gid = wgid / nig, fm = gid * WGM, gsz = (nM - fm) < WGM ? (nM - fm) : WGM;
        u.pm = fm + ((wgid % nig) % gsz); u.pn = (wgid % nig) / gsz; return true;
    }
    __device__ __forceinline__ void a_ready(const Unit&) const {}
    __device__ __forceinline__ void done(const Unit&) const {}
};

__device__ __forceinline__ frag8 pack8(const f32x4 a, const f32x4 b) {
    frag8 h; h[0] = (f16)a[0]; h[1] = (f16)a[1]; h[2] = (f16)a[2]; h[3] = (f16)a[3]; h[4] = (f16)b[0]; h[5] = (f16)b[1]; h[6] = (f16)b[2]; h[7] = (f16)b[3]; return h;
}
__device__ __forceinline__ float sigmoidf_(float z) { return 1.0f / (1.0f + __expf(-z)); }

struct EpiP1 {
    static constexpr bool PERM = true, AFTER_DRAIN = false, MIDK = false;
    const float* ss1; const float* bgate; f16* qkvu; f16* gates;
    __device__ __forceinline__ void operator()(const f32x4 (&acc)[2][2][4][2], const Unit& u, int wr, int wc, int fr, int fq) const {
        const int row0 = u.pm * BM + wr * 64 + fr, colt = u.pn * BM; const bool isg = colt >= NQKVU;
#pragma unroll
        for (int ai = 0; ai < 2; ++ai)
#pragma unroll
            for (int m = 0; m < 4; ++m) { const int row = row0 + ai * HALF + m * 16; const float r = rsqrtf(ss1[row] * (1.0f / DM) + EPS);
#pragma unroll
                for (int bj = 0; bj < 2; ++bj) { const int c0 = colt + bj * HALF + wc * 32 + 8 * fq; f32x4 v0 = acc[ai][bj][m][0] * r, v1 = acc[ai][bj][m][1] * r;
                    if (isg) { const int cg = c0 - NQKVU; const f32x4 b0 = *(const f32x4*)(bgate + cg), b1 = *(const f32x4*)(bgate + cg + 4);
#pragma unroll
                        for (int i = 0; i < 4; ++i) { v0[i] = sigmoidf_(v0[i] + b0[i]); v1[i] = sigmoidf_(v1[i] + b1[i]); }
                        *(frag8*)(gates + (size_t)row * NGATE + cg) = pack8(v0, v1); }
                    else *(frag8*)(qkvu + (size_t)row * NQKVU + c0) = pack8(v0, v1); } }
    }
};
struct EpiMerged {
    static constexpr bool PERM = true, AFTER_DRAIN = false, MIDK = true;
    const f16* gates; f16* merged;
    __device__ __forceinline__ void mid(f32x4 (&acc)[2][2][4][2], const Unit& u, int wr, int wc, int fr, int fq) const {
        const int row0 = u.pm * BM + wr * 64 + fr, colt = u.pn * BM;
        const f16* gb = gates + (size_t)row0 * NGATE + colt + wc * 32 + 8 * fq;
        asm volatile("" : "+v"(gb));
#pragma unroll
        for (int ai = 0; ai < 2; ++ai) {
            frag8 g0[4][2], g1[4][2];
#pragma unroll
            for (int m = 0; m < 4; ++m)
#pragma unroll
                for (int bj = 0; bj < 2; ++bj) { const f16* gp = gb + (size_t)(ai * HALF + m * 16) * NGATE + bj * HALF; g0[m][bj] = *(const frag8*)gp; g1[m][bj] = *(const frag8*)(gp + DM); }
#pragma unroll
            for (int m = 0; m < 4; ++m)
#pragma unroll
                for (int bj = 0; bj < 2; ++bj)
#pragma unroll
                    for (int i = 0; i < 4; ++i) {
                        acc[ai][bj][m][0][i] *= (float)g0[m][bj][i] * __builtin_amdgcn_rcpf(fmaxf((float)g1[m][bj][i], 1e-4f));
                        acc[ai][bj][m][1][i] *= (float)g0[m][bj][4 + i] * __builtin_amdgcn_rcpf(fmaxf((float)g1[m][bj][4 + i], 1e-4f)); }
            asm volatile("" ::: "memory");
        }
    }
    __device__ __forceinline__ void operator()(const f32x4 (&acc)[2][2][4][2], const Unit& u, int wr, int wc, int fr, int fq) const {
        const int row0 = u.pm * BM + wr * 64 + fr, colt = u.pn * BM;
#pragma unroll
        for (int ai = 0; ai < 2; ++ai)
#pragma unroll
            for (int m = 0; m < 4; ++m) { const int row = row0 + ai * HALF + m * 16;
#pragma unroll
                for (int bj = 0; bj < 2; ++bj) { const int c0 = colt + bj * HALF + wc * 32 + 8 * fq;
                    const frag8 g1 = *(const frag8*)(gates + (size_t)row * NGATE + DM + c0); f32x4 v0, v1;
#pragma unroll
                    for (int i = 0; i < 4; ++i) { v0[i] = acc[ai][bj][m][0][i] * fmaxf((float)g1[i], 1e-4f); v1[i] = acc[ai][bj][m][1][i] * fmaxf((float)g1[4 + i], 1e-4f); }
                    *(frag8*)(merged + (size_t)row * DM + c0) = pack8(v0, v1); } }
    }
};
struct EpiOut {
    static constexpr bool PERM = false, AFTER_DRAIN = false, MIDK = false;
    const float* x; const float* g2; float* x1; f16* x1h; float* ss2p;
    __device__ __forceinline__ void operator()(const f32x4 (&acc)[2][2][4][2], const Unit& u, int wr, int wc, int fr, int fq) const {
        const int row0 = u.pm * BM + wr * 64 + fr, col0 = u.pn * BM + wc * 32 + 4 * fq;
        f32x4 gv[2][2];
#pragma unroll
        for (int bj = 0; bj < 2; ++bj)
#pragma unroll
            for (int n = 0; n < 2; ++n) gv[bj][n] = *(const f32x4*)(g2 + col0 + bj * HALF + n * 16);
#pragma unroll
        for (int ai = 0; ai < 2; ++ai)
#pragma unroll
            for (int m = 0; m < 4; ++m) { const int row = row0 + ai * HALF + m * 16; const size_t off = (size_t)row * DM + col0; float ssq = 0.f;
#pragma unroll
                for (int bj = 0; bj < 2; ++bj)
#pragma unroll
                    for (int n = 0; n < 2; ++n) { const f32x4 y = *(const f32x4*)(x + off + bj * HALF + n * 16) + acc[ai][bj][m][n];
                        *(f32x4*)(x1 + off + bj * HALF + n * 16) = y; ssq += (y[0] * y[0] + y[1] * y[1]) + (y[2] * y[2] + y[3] * y[3]);
                        const f32x4 yg = y * gv[bj][n]; half4 h; h[0] = (f16)yg[0]; h[1] = (f16)yg[1]; h[2] = (f16)yg[2]; h[3] = (f16)yg[3];
                        *(half4*)(x1h + off + bj * HALF + n * 16) = h; }
                ssq += __shfl_xor(ssq, 16); ssq += __shfl_xor(ssq, 32);
                if (fq == 0) ss2p[(size_t)(u.pn * 4 + wc) * T + row] = ssq; }
    }
};
struct EpiQ {
    static constexpr bool PERM = true, AFTER_DRAIN = false, MIDK = false;
    f16* qp;
    __device__ __forceinline__ void operator()(const f32x4 (&acc)[2][2][4][2], const Unit& u, int wr, int wc, int fr, int fq) const {
        const int row0 = u.pm * BM + wr * 64 + fr, colt = u.pn * BM;
#pragma unroll
        for (int ai = 0; ai < 2; ++ai)
#pragma unroll
            for (int m = 0; m < 4; ++m) { const int row = row0 + ai * HALF + m * 16;
#pragma unroll
                for (int bj = 0; bj < 2; ++bj) { const int c0 = colt + bj * HALF + wc * 32 + 8 * fq;
                    *(frag8*)(qp + (size_t)row * 2048 + c0) = pack8(acc[ai][bj][m][0], acc[ai][bj][m][1]); } }
    }
};

template <class Epi, class Sched, bool ALIGN_EPI = false, bool SP2 = false>
__device__ __forceinline__ void gemm_phase(PG8_LAS unsigned char* lds, const Gemm g, const Sched& S, const Epi& E) {
    const int tid = threadIdx.x, wid = __builtin_amdgcn_readfirstlane(tid >> 6), lane = tid & 63, wr = wid >> 2, wc = wid & 3, fr = lane & 15, fq = lane >> 4;
    const int K = g.K, nt = K / BK;
    unsigned voffA[2], voffB[2];
#pragma unroll
    for (int i = 0; i < 2; ++i) { int R, C; stage_rc(tid * 16 + i * 8192, R, C); const int Rb = Epi::PERM ? ((R & ~31) + perm32(R & 31)) : R;
        voffA[i] = (unsigned)(R * K + C) * 2u; voffB[i] = (unsigned)(Rb * K + C) * 2u; }
    const size_t kstep = (size_t)(BK * 2);
    const size_t hstep = (size_t)HALF * K * 2;
    const size_t tstep = 2 * hstep;
    const unsigned ldsw = (unsigned)wid * 1024u;
    const int aoff = lds_byte(wr * 64 + fr, fq * 8), boff = lds_byte(wc * 32 + fr, fq * 8);
#define PG8_SA(b, h) (((b) * 2 + (h)) * HTB)
#define PG8_SB(b, h) ((4 + (b) * 2 + (h)) * HTB)
#define PG8_STAGE(bufoff, gbase, voff) do { _Pragma("unroll") for (int _i = 0; _i < 2; ++_i) \
        __builtin_amdgcn_global_load_lds((const unsigned*)((const char*)(gbase) + (voff)[_i]), (PG8_LAS unsigned*)(lds + (bufoff) + ldsw + _i * 8192), 16, 0, 0); } while (0)
#define PG8_LDA(dst, b, h) do { _Pragma("unroll") for (int m = 0; m < 4; ++m) _Pragma("unroll") for (int k = 0; k < 2; ++k) dst[m][k] = *(const PG8_LAS frag8*)(lds + PG8_SA(b, h) + aoff + m * 2048 + k * 1024); } while (0)
#define PG8_LDB(dst, b, h) do { _Pragma("unroll") for (int n = 0; n < 2; ++n) _Pragma("unroll") for (int k = 0; k < 2; ++k) dst[n][k] = *(const PG8_LAS frag8*)(lds + PG8_SB(b, h) + boff + n * 2048 + k * 1024); } while (0)
#define PG8_MMA(ai, bj, At, Bt) do { __builtin_amdgcn_s_setprio(1); _Pragma("unroll") for (int m = 0; m < 4; ++m) _Pragma("unroll") for (int n = 0; n < 2; ++n) _Pragma("unroll") for (int k = 0; k < 2; ++k) \
        acc[ai][bj][m][n] = __builtin_amdgcn_mfma_f32_16x16x32_f16(Bt[n][k], At[m][k], acc[ai][bj][m][n], 0, 0, 0); __builtin_amdgcn_s_setprio(0); } while (0)
#define PG8_WAIT_V(n) asm volatile("s_waitcnt vmcnt(" #n ")" ::: "memory")
#define PG8_WAIT_L(n) asm volatile("s_waitcnt lgkmcnt(" #n ")" ::: "memory")
#define PG8_BAR __builtin_amdgcn_s_barrier()
#define PG8_SCHED __builtin_amdgcn_sched_barrier(0)
    Unit cur, nxt; int ui = 0;
    if (!S.next(0, cur)) return;
    f32x4 acc[2][2][4][2];
#pragma unroll
    for (int a = 0; a < 2; ++a)
#pragma unroll
        for (int b = 0; b < 2; ++b)
#pragma unroll
            for (int m = 0; m < 4; ++m)
#pragma unroll
                for (int n = 0; n < 2; ++n) acc[a][b][m][n] = (f32x4){0.f, 0.f, 0.f, 0.f};
    frag8 At[4][2], B0[2][2], B1[2][2];
    const char* cA = (const char*)g.A + (size_t)cur.pm * tstep; const char* cB = (const char*)g.Bt + (size_t)cur.pn * tstep;
    S.a_ready(cur);
    if constexpr (SP2) {
        PG8_STAGE(PG8_SB(0, 0), cB, voffB); PG8_STAGE(PG8_SB(0, 1), cB + hstep, voffB); PG8_STAGE(PG8_SA(0, 0), cA, voffA); PG8_STAGE(PG8_SA(0, 1), cA + hstep, voffA);
        if (wr == 1) PG8_BAR;
        PG8_WAIT_V(2); PG8_BAR;
        PG8_STAGE(PG8_SB(1, 0), cB + kstep, voffB); PG8_STAGE(PG8_SA(1, 0), cA + kstep, voffA); PG8_STAGE(PG8_SB(1, 1), cB + hstep + kstep, voffB);
        PG8_WAIT_V(6); PG8_BAR;
    } else {
        PG8_STAGE(PG8_SB(0, 0), cB, voffB); PG8_STAGE(PG8_SA(0, 0), cA, voffA); PG8_STAGE(PG8_SB(0, 1), cB + hstep, voffB); PG8_STAGE(PG8_SA(0, 1), cA + hstep, voffA);
        if (wr == 1) PG8_BAR;
        PG8_WAIT_V(4); PG8_BAR;
        PG8_STAGE(PG8_SB(1, 0), cB + kstep, voffB); PG8_STAGE(PG8_SA(1, 0), cA + kstep, voffA); PG8_STAGE(PG8_SB(1, 1), cB + hstep + kstep, voffB);
        PG8_WAIT_V(6); PG8_BAR;
    }
    for (;;) {
        const bool has_next = S.next(ui + 1, nxt);
        const char* nA = has_next ? (const char*)g.A + (size_t)nxt.pm * tstep : cA; const char* nB = has_next ? (const char*)g.Bt + (size_t)nxt.pn * tstep : cB;
        for (int t = 0; t < nt; t += 2) {
            const bool last = (t == nt - 2);
            if constexpr (Epi::MIDK) { if (t == (nt >> 1)) E.mid(acc, cur, wr, wc, fr, fq); }
            const char* a1 = cA + (size_t)(t + 1) * kstep;
            const char* a2 = last ? nA : cA + (size_t)(t + 2) * kstep; const char* b2 = last ? nB : cB + (size_t)(t + 2) * kstep;
            const char* a3 = a2 + kstep; const char* b3 = b2 + kstep;
            if (last && has_next) S.a_ready(nxt);
            if constexpr (SP2) {
            PG8_LDB(B0, 0, 0); PG8_LDB(B1, 0, 1); PG8_SCHED; PG8_LDA(At, 0, 0); PG8_STAGE(PG8_SA(1, 1), a1 + hstep, voffA);
            PG8_WAIT_V(8); PG8_WAIT_L(0); PG8_BAR; PG8_MMA(0, 0, At, B0); PG8_MMA(0, 1, At, B1); PG8_BAR; PG8_SCHED;
            PG8_LDA(At, 0, 1); PG8_STAGE(PG8_SB(0, 0), b2, voffB); PG8_STAGE(PG8_SB(0, 1), b2 + hstep, voffB); PG8_STAGE(PG8_SA(0, 0), a2, voffA);
            PG8_WAIT_V(8); PG8_WAIT_L(0); PG8_BAR; PG8_MMA(1, 0, At, B0); PG8_MMA(1, 1, At, B1); PG8_BAR; PG8_SCHED;
            PG8_LDB(B0, 1, 0); PG8_LDB(B1, 1, 1); PG8_SCHED; PG8_LDA(At, 1, 0); PG8_STAGE(PG8_SA(0, 1), a2 + hstep, voffA);
            PG8_WAIT_V(8); PG8_WAIT_L(0); PG8_BAR; PG8_MMA(0, 0, At, B0); PG8_MMA(0, 1, At, B1); PG8_BAR; PG8_SCHED;
            PG8_LDA(At, 1, 1); PG8_STAGE(PG8_SB(1, 0), b3, voffB); PG8_STAGE(PG8_SB(1, 1), b3 + hstep, voffB); PG8_STAGE(PG8_SA(1, 0), a3, voffA);
            PG8_WAIT_V(8); PG8_WAIT_L(0); PG8_BAR; PG8_MMA(1, 0, At, B0); PG8_MMA(1, 1, At, B1); PG8_BAR; PG8_SCHED;
            } else {
            PG8_LDB(B0, 0, 0); PG8_SCHED; PG8_LDA(At, 0, 0); PG8_STAGE(PG8_SA(1, 1), a1 + hstep, voffA);
            PG8_WAIT_L(8); PG8_BAR; PG8_WAIT_L(0); PG8_MMA(0, 0, At, B0); PG8_BAR; PG8_SCHED;
            PG8_LDB(B1, 0, 1); PG8_STAGE(PG8_SB(0, 0), b2, voffB);
            PG8_BAR; PG8_WAIT_L(0); PG8_MMA(0, 1, At, B1); PG8_BAR;
            PG8_LDA(At, 0, 1); PG8_STAGE(PG8_SA(0, 0), a2, voffA);
            PG8_BAR; PG8_WAIT_L(0); PG8_MMA(1, 0, At, B0); PG8_BAR; PG8_SCHED;
            PG8_STAGE(PG8_SB(0, 1), b2 + hstep, voffB);
            PG8_WAIT_V(6); PG8_BAR; PG8_MMA(1, 1, At, B1); PG8_BAR;
            PG8_LDB(B0, 1, 0); PG8_SCHED; PG8_LDA(At, 1, 0); PG8_STAGE(PG8_SA(0, 1), a2 + hstep, voffA);
            PG8_WAIT_L(8); PG8_BAR; PG8_WAIT_L(0); PG8_MMA(0, 0, At, B0); PG8_BAR; PG8_SCHED;
            PG8_LDB(B1, 1, 1); PG8_STAGE(PG8_SB(1, 0), b3, voffB);
            PG8_BAR; PG8_WAIT_L(0); PG8_MMA(0, 1, At, B1); PG8_BAR;
            PG8_LDA(At, 1, 1); PG8_STAGE(PG8_SA(1, 0), a3, voffA);
            PG8_BAR; PG8_WAIT_L(0); PG8_MMA(1, 0, At, B0); PG8_BAR; PG8_SCHED;
            PG8_STAGE(PG8_SB(1, 1), b3 + hstep, voffB);
            PG8_WAIT_V(6); PG8_BAR; PG8_MMA(1, 1, At, B1); PG8_BAR;
            }
        }
        if constexpr (ALIGN_EPI) { if (wr == 0) PG8_BAR; }
        if constexpr (!Epi::AFTER_DRAIN) { E(acc, cur, wr, wc, fr, fq); S.done(cur); }
        if (!has_next) break;
#pragma unroll
        for (int a = 0; a < 2; ++a)
#pragma unroll
            for (int b = 0; b < 2; ++b)
#pragma unroll
                for (int m = 0; m < 4; ++m)
#pragma unroll
                    for (int n = 0; n < 2; ++n) acc[a][b][m][n] = (f32x4){0.f, 0.f, 0.f, 0.f};
        cur = nxt; cA = nA; cB = nB; ++ui;
        if constexpr (ALIGN_EPI) { if (wr == 1) PG8_BAR; }
    }
    PG8_WAIT_V(0);
    if constexpr (!ALIGN_EPI) { if (wr == 0) PG8_BAR; }
    PG8_BAR;
    if constexpr (Epi::AFTER_DRAIN) { E.fused(acc, cur, wr, wc, fr, fq, lds, wid, lane); S.done(cur); }
#undef PG8_SA
#undef PG8_SB
#undef PG8_STAGE
#undef PG8_LDA
#undef PG8_LDB
#undef PG8_MMA
#undef PG8_WAIT_V
#undef PG8_WAIT_L
#undef PG8_BAR
#undef PG8_SCHED
}
}

#define XB_TMO      128
#define XB_XCNT(j)  (256  + 64 * (j))
#define XB_XSUB(j)  (1280 + 64 * (j))
#define XB_XGEN(j)  (2304 + 64 * (j))
#define XB_TOP      3328
#define XB_TOPGEN   3392
#define XCD_BAR_WORDS 3456
#define XB_SPIN_CAP (1u << 18)

__device__ __forceinline__ unsigned xb_ld(unsigned* p)              { return __hip_atomic_load(p, __ATOMIC_RELAXED, __HIP_MEMORY_SCOPE_AGENT); }
__device__ __forceinline__ unsigned xb_add(unsigned* p, unsigned v) { return __hip_atomic_fetch_add(p, v, __ATOMIC_RELAXED, __HIP_MEMORY_SCOPE_AGENT); }
__device__ __forceinline__ unsigned xb_xcc_id() { return (unsigned)__builtin_amdgcn_s_getreg((3 << 11) | 20) & 0xFu; }
#define XB_SPIN(cond, bar) do { unsigned _sp = 0; while (cond) { __builtin_amdgcn_s_sleep(1); \
    if ((++_sp & 255u) == 0u) { if (xb_ld(&(bar)[XB_TMO])) break; if (_sp > XB_SPIN_CAP) { atomicAdd(&(bar)[XB_TMO], 1u); break; } } } } while (0)

struct XcdBarrier {
    unsigned* bar; unsigned x;
    volatile LAS unsigned* st;
};

__device__ __forceinline__ XcdBarrier xcd_barrier_post(unsigned* bar, volatile LAS unsigned* st) {
    XcdBarrier b; b.bar = bar; b.x = xb_xcc_id(); b.st = st;
    if (threadIdx.x == 0) (void)xb_add(&bar[XB_XCNT(b.x)], 1u);
    return b;
}
__device__ __forceinline__ void xcd_barrier_complete(unsigned* bar, unsigned x, unsigned& nloc, unsigned& nx) {
    const unsigned G = gridDim.x * gridDim.y * gridDim.z;
    unsigned sum, cnt, mine, sp = 0u;
    for (;;) {
        sum = 0u; cnt = 0u; mine = 0u;
#pragma unroll
        for (unsigned j = 0; j < 16; ++j) { const unsigned c = xb_ld(&bar[XB_XCNT(j)]); sum += c; cnt += (c > 0u) ? 1u : 0u; mine = (j == x) ? c : mine; }
        if (sum == G) break;
        __builtin_amdgcn_s_sleep(1);
        if ((++sp & 255u) == 0u) { if (xb_ld(&bar[XB_TMO])) break; if (sp > XB_SPIN_CAP) { atomicAdd(&bar[XB_TMO], 1u); break; } }
    }
    nloc = mine > 0u ? mine : 1u; nx = cnt > 0u ? cnt : 1u;
}

__device__ __forceinline__ void xcd_barrier(const XcdBarrier& b) {
    asm volatile("s_waitcnt vmcnt(0)" ::: "memory");
    __syncthreads();
    if (threadIdx.x == 0) {
        unsigned* bar = b.bar;
        __builtin_amdgcn_s_waitcnt(0);
        unsigned nloc = b.st[0], nx = b.st[1];
        if (nloc == 0u) { xcd_barrier_complete(bar, b.x, nloc, nx); b.st[0] = nloc; b.st[1] = nx; }
        const unsigned old = xb_add(&bar[XB_XSUB(b.x)], 1u);
        const unsigned gen = old / nloc;
        if (old + 1u == (gen + 1u) * nloc) {
            __builtin_amdgcn_fence(__ATOMIC_RELEASE, "agent");
            asm volatile("s_waitcnt vmcnt(0)" ::: "memory");
            const unsigned og = xb_add(&bar[XB_TOP], 1u);
            const unsigned tg = og / nx;
            if (og + 1u == (tg + 1u) * nx) xb_add(&bar[XB_TOPGEN], 1u);
            else XB_SPIN(xb_ld(&bar[XB_TOPGEN]) == tg, bar);
            __builtin_amdgcn_fence(__ATOMIC_ACQUIRE, "agent");
            xb_add(&bar[XB_XGEN(b.x)], 1u);
            asm volatile("s_waitcnt vmcnt(0)" ::: "memory");
        } else {
            XB_SPIN(xb_ld(&bar[XB_XGEN(b.x)]) == gen, bar);
            __builtin_amdgcn_fence(__ATOMIC_ACQUIRE, "agent");
            asm volatile("s_waitcnt vmcnt(0)" ::: "memory");
        }
    }
    __syncthreads();
}


struct Args { const float* in[16]; float* out; unsigned char* ws; int ph_lo, ph_hi; };
constexpr int N_PHASES = 10;

__global__ void __launch_bounds__(NTHREADS, 2) mk_fwd(Args a) {
    extern __shared__ __attribute__((aligned(16))) unsigned char lds[];
    LAS unsigned char* L = (LAS unsigned char*)lds;
    volatile LAS unsigned* MISC = (volatile LAS unsigned*)(L + MISC_OFF);
    unsigned char* ws = a.ws;
    Ctx C;
    C.tid = threadIdx.x; C.lane = C.tid & 63; C.wave = __builtin_amdgcn_readfirstlane(C.tid >> 6);
    C.G = gridDim.x; C.gw = blockIdx.x * NWAVES + C.wave; C.ngw = C.G * NWAVES; C.gt = blockIdx.x * NTHREADS + C.tid; C.ngt = C.G * NTHREADS;
    for (int u = C.tid; u < (LDS_BYTES - LDSCTL_OFF) / 4; u += NTHREADS) ((LAS unsigned*)(L + LDSCTL_OFF))[u] = 0u;
    __syncthreads();
    const int lo = a.ph_lo, hi = a.ph_hi, G = C.G;
    const bool multi = (hi - lo) > 1;
    XcdBarrier bar; bar.bar = (unsigned*)(ws + WS_CTL) + CW_BAR; bar.x = 0; bar.st = nullptr;
    if (multi) bar = xcd_barrier_post((unsigned*)(ws + WS_CTL) + CW_BAR, MISC + 8);
#define IN(k) (lo <= (k) && (k) < hi)
#define SEAM(k) do { if (IN(k) && IN((k) + 1)) xcd_barrier(bar); } while (0)

    if (IN(0)) { ph_prep(C, L, a.in, ws); }
    SEAM(0);
    if (IN(1)) {
        pg8::Gemm g{(const f16*)(ws + WS_XH), (const f16*)(ws + WS_WCAT), T, NCAT, DM}; pg8::StaticOrder S; S.init(T, NCAT, G, (int)blockIdx.x);
        pg8::EpiP1 E{(const float*)(ws + WS_RS1), a.in[8], (f16*)(ws + WS_QKVU), (f16*)(ws + WS_GATES)};
        pg8::gemm_phase<pg8::EpiP1, pg8::StaticOrder, true, true>(L, g, S, E);
    }
    SEAM(1);
    if (IN(2)) {
        ph_attn_naive(C, (const f16*)(ws + WS_QKVU), a.in[3], (f16*)(ws + WS_OCAT));
        ph_pool_naive(C, (const f16*)(ws + WS_QKVU), (f16*)(ws + WS_MIXED));
    }
    SEAM(2);
    if (IN(3)) { ph_poolmm_naive(C, (const f16*)(ws + WS_MIXED), (const f16*)(ws + WS_POOLW), a.in[5], (f16*)(ws + WS_OCAT)); }
    SEAM(3);
    if (IN(4)) {
        pg8::Gemm g{(const f16*)(ws + WS_OCAT), (const f16*)(ws + WS_WB), T, DM, DM}; pg8::StaticOrder S; S.init(T, DM, G, (int)blockIdx.x);
        pg8::EpiMerged E{(const f16*)(ws + WS_GATES), (f16*)(ws + WS_MERGED)};
        pg8::gemm_phase<pg8::EpiMerged, pg8::StaticOrder, true, true>(L, g, S, E);
    }
    SEAM(4);
    if (IN(5)) {
        pg8::Gemm g{(const f16*)(ws + WS_MERGED), (const f16*)(ws + WS_WOUT), T, DM, DM}; pg8::StaticOrder S; S.init(T, DM, G, (int)blockIdx.x);
        pg8::EpiOut E{a.in[0], a.in[10], a.out, (f16*)(ws + WS_X1H), (float*)(ws + WS_SS2)};
        pg8::gemm_phase<pg8::EpiOut, pg8::StaticOrder, true, true>(L, g, S, E);
    }
    SEAM(5);
    if (IN(6)) {
        pg8::Gemm g{(const f16*)(ws + WS_X1H), (const f16*)(ws + WS_WQ), T, 2048, DM}; pg8::StaticOrder S; S.init(T, 2048, G, (int)blockIdx.x);
        pg8::EpiQ E{(f16*)(ws + WS_QP)};
        pg8::gemm_phase<pg8::EpiQ, pg8::StaticOrder, true, true>(L, g, S, E);
    }
    SEAM(6);
    if (IN(7)) { ph_route_naive(C, (const f16*)(ws + WS_QP), (const float*)(ws + WS_SS2), (const f16*)(ws + WS_SUBK), (int*)(ws + WS_EIDX), (float*)(ws + WS_EGATE)); }
    SEAM(7);
    if (IN(8)) { ph_gather(C, (const f16*)(ws + WS_X1H), (const float*)(ws + WS_SS2), (const int*)(ws + WS_EIDX), (const float*)(ws + WS_EGATE),
                           (const f16*)(ws + WS_UTAB), (const f16*)(ws + WS_VTAB), a.out, a.in[15]); }
#undef IN
#undef SEAM
}

#ifndef MK_N_LAUNCHES
#define MK_N_LAUNCHES 1
#endif
extern "C" void kernel_launch(void* const* d_in, const int* in_sizes, int n_in, void* d_out, int out_size, void* d_ws, size_t ws_size, hipStream_t stream) {
    static int grid = 0;
    if (grid == 0) {
        if (n_in != 16 || in_sizes[0] != T * DM || out_size != T * DM || ws_size < WS_END) {
            fprintf(stderr, "kernel_launch: unexpected shapes (n_in %d in0 %d out %d ws %zu)\n", n_in, n_in > 0 ? in_sizes[0] : -1, out_size, ws_size);
            grid = -1; return;
        }
        int dev = 0, cus = 0;
        if (hipGetDevice(&dev) != hipSuccess || hipDeviceGetAttribute(&cus, hipDeviceAttributeMultiprocessorCount, dev) != hipSuccess) { grid = -1; return; }
        if (hipFuncSetAttribute((const void*)mk_fwd, hipFuncAttributeMaxDynamicSharedMemorySize, LDS_BYTES) != hipSuccess) { fprintf(stderr, "kernel_launch: hipFuncSetAttribute failed\n"); grid = -1; return; }
        int per_cu = 0;
        if (hipOccupancyMaxActiveBlocksPerMultiprocessor(&per_cu, (const void*)mk_fwd, NTHREADS, LDS_BYTES) != hipSuccess || per_cu < 1)
            fprintf(stderr, "kernel_launch: occupancy query reports %d workgroups per CU\n", per_cu);
        (void)hipGetLastError();
        grid = cus;
    }
    if (grid < 0) return;
    (void)hipMemsetAsync((char*)d_ws + WS_CTL, 0, CTL_ZERO_BYTES, stream);
    Args a{};
    for (int i = 0; i < 16; ++i) a.in[i] = (const float*)d_in[i];
    a.out = (float*)d_out; a.ws = (unsigned char*)d_ws;
    if (MK_N_LAUNCHES == 1) {
        a.ph_lo = 0; a.ph_hi = N_PHASES;
        hipLaunchKernelGGL(mk_fwd, dim3(grid), dim3(NTHREADS), LDS_BYTES, stream, a);
    } else {
        for (int p = 0; p < N_PHASES; ++p) { a.ph_lo = p; a.ph_hi = p + 1; hipLaunchKernelGGL(mk_fwd, dim3(grid), dim3(NTHREADS), LDS_BYTES, stream, a); }
    }
}
```

```cpp
#include <hip/hip_runtime.h>
#include <cstdint>
#include <cstdio>

typedef _Float16 f16;
typedef _Float16 half8 __attribute__((ext_vector_type(8)));
typedef _Float16 half4 __attribute__((ext_vector_type(4)));
typedef _Float16 half2 __attribute__((ext_vector_type(2)));
typedef float f32x4 __attribute__((ext_vector_type(4)));
typedef float f32x16 __attribute__((ext_vector_type(16)));
#define LAS __attribute__((address_space(3)))
#define GAS __attribute__((address_space(1)))

constexpr int DM = 1024, BATCH = 16, SEQ = 2048, T = BATCH * SEQ;
constexpr int NQKVU = 1280, NGATE = 2048, NCAT = NQKVU + NGATE;
constexpr int COL_K = 512, COL_V = 640, COL_U = 768;
constexpr int NEXP = 16384, PEER_H = 8, TOPK = 16;
constexpr float EPS = 1e-6f;
constexpr int NWAVES = 8, NTHREADS = NWAVES * 64;

constexpr size_t MiB = 1u << 20;
constexpr size_t WS_CTL = 0, CTL_ZERO_BYTES = 64 * 1024;
constexpr size_t WS_WCAT = 1 * MiB;
constexpr size_t WS_WB = 8 * MiB;
constexpr size_t WS_WOUT = 10 * MiB;
constexpr size_t WS_WQ = 12 * MiB;
constexpr size_t WS_POOLW = 16 * MiB;
constexpr size_t WS_SUBK = 16 * MiB + 512 * 1024;
constexpr size_t WS_RS1 = 17 * MiB;
constexpr size_t WS_EIDX = 18 * MiB;
constexpr size_t WS_EGATE = 34 * MiB;
constexpr size_t WS_UTAB = 50 * MiB;
constexpr size_t WS_VTAB = 82 * MiB;
constexpr size_t WS_XH = 114 * MiB;
constexpr size_t WS_MERGED = WS_XH;
constexpr size_t WS_QKVU = 178 * MiB;
constexpr size_t WS_X1H = WS_QKVU;
constexpr size_t WS_GATES = 258 * MiB;
constexpr size_t WS_QP = WS_GATES;
constexpr size_t WS_OCAT = 386 * MiB;
constexpr size_t WS_MIXED = 450 * MiB;
constexpr size_t WS_SS2 = 482 * MiB;
constexpr size_t WS_VT = 484 * MiB;
constexpr size_t WS_END = 492 * MiB;
constexpr int CW_BAR = 4096;

constexpr int RING_OFF = 0, RING_BYTES = 131072;
constexpr int LDSCTL_OFF = RING_BYTES, MISC_OFF = LDSCTL_OFF + 320;
constexpr int LDS_BYTES = 147456;

#define LDS_WAIT() asm volatile("s_waitcnt lgkmcnt(0)" ::: "memory")
__device__ __forceinline__ float wave_sum(float v) {
#pragma unroll
    for (int o = 1; o < 64; o <<= 1) v += __shfl_xor(v, o);
    return v;
}
__device__ __forceinline__ float gelu_exact(float x) { return 0.5f * x * (1.0f + erff(x * 0.70710678118654752f)); }
__device__ __forceinline__ float rs_from_ss(const float* ss, int t) {
    float s = 0.f;
#pragma unroll
    for (int i = 0; i < 16; ++i) s += ss[(size_t)i * T + t];
    return rsqrtf(s * (1.0f / DM) + EPS);
}

struct Ctx {
    int tid, lane, wave;
    int G;
    int gw, ngw;
    int gt, ngt;
};

__device__ __forceinline__ void p0_transpose_item(const float* W, int K, int N, f16* WT, int ldo, int koff, LAS float* scr, int item, int lane) {
    const int nblk = N / 32, kb = item / nblk, nb = item % nblk, k0 = 64 * kb, n0 = 32 * nb;
#pragma unroll 8
    for (int i = 0; i < 32; ++i) { const int kk = 2 * i + (lane >> 5); scr[kk * 33 + (lane & 31)] = W[(size_t)(k0 + kk) * N + n0 + (lane & 31)]; }
    LDS_WAIT(); asm volatile("" ::: "memory");
    const int c = lane & 7;
#pragma unroll
    for (int j = 0; j < 4; ++j) { const int n = (lane >> 3) + 8 * j; const LAS float* s = scr + (8 * c) * 33 + n;
        half8 o;
#pragma unroll
        for (int i = 0; i < 8; ++i) o[i] = (f16)s[i * 33];
        *(half8*)(WT + (size_t)(n0 + n) * ldo + koff + k0 + 8 * c) = o; }
    LDS_WAIT(); asm volatile("" ::: "memory");
}
__device__ __forceinline__ void cvt_stream(const Ctx& C, const float* in, f16* out, size_t n4) {
    for (size_t i = (size_t)C.gt; i < n4; i += (size_t)C.ngt) {
        const f32x4 v = ((const f32x4*)in)[i];
        half4 h; h[0] = (f16)v[0]; h[1] = (f16)v[1]; h[2] = (f16)v[2]; h[3] = (f16)v[3];
        ((half4*)out)[i] = h;
    }
}
__device__ __forceinline__ void rowprep(const Ctx& C, const float* x, const float* g, f16* xh, float* ss) {
    const int lane = C.lane;
    for (int t = C.gw; t < T; t += C.ngw) {
        const float* xr = x + (size_t)t * DM;
        float s = 0.f;
#pragma unroll
        for (int j = 0; j < 4; ++j) {
            const f32x4 v = *(const f32x4*)(xr + j * 256 + lane * 4);
            const f32x4 gg = *(const f32x4*)(g + j * 256 + lane * 4);
            s += v[0] * v[0] + v[1] * v[1] + v[2] * v[2] + v[3] * v[3];
            half4 h; h[0] = (f16)(v[0] * gg[0]); h[1] = (f16)(v[1] * gg[1]); h[2] = (f16)(v[2] * gg[2]); h[3] = (f16)(v[3] * gg[3]);
            *(half4*)(xh + (size_t)t * DM + j * 256 + lane * 4) = h;
        }
        s = wave_sum(s);
        if (lane == 0) ss[t] = s;
    }
}
__device__ __forceinline__ void ph_prep(const Ctx& C, LAS unsigned char* lds, const float* const* in, unsigned char* ws) {
    LAS float* scr = (LAS float*)(lds + RING_OFF + C.wave * 16384);
    f16* wcat = (f16*)(ws + WS_WCAT); f16* wb = (f16*)(ws + WS_WB); f16* wout = (f16*)(ws + WS_WOUT); f16* wq = (f16*)(ws + WS_WQ); f16* poolw = (f16*)(ws + WS_POOLW);
    constexpr int I_IN = 16 * 40, I_G = 16 * 64, I_B = 8 * 32, I_O = 16 * 32, I_Q = 16 * 64, I_P = 2 * 4;
    constexpr int NITEMS = I_IN + I_G + 2 * I_B + I_O + I_Q + 4 * I_P;
    for (int it = C.gw; it < NITEMS; it += C.ngw) {
        int r = it;
        if (r < I_IN) { p0_transpose_item(in[2], 1024, 1280, wcat, 1024, 0, scr, r, C.lane); continue; } r -= I_IN;
        if (r < I_G) { p0_transpose_item(in[7], 1024, 2048, wcat + (size_t)NQKVU * 1024, 1024, 0, scr, r, C.lane); continue; } r -= I_G;
        if (r < I_B) { p0_transpose_item(in[6], 512, 1024, wb, 1024, 0, scr, r, C.lane); continue; } r -= I_B;
        if (r < I_B) { p0_transpose_item(in[6] + 512 * 1024, 512, 1024, wb, 1024, 512, scr, r, C.lane); continue; } r -= I_B;
        if (r < I_O) { p0_transpose_item(in[9], 1024, 1024, wout, 1024, 0, scr, r, C.lane); continue; } r -= I_O;
        if (r < I_Q) { p0_transpose_item(in[11], 1024, 2048, wq, 1024, 0, scr, r, C.lane); continue; } r -= I_Q;
        { const int g = r / I_P; p0_transpose_item(in[4] + g * 128 * 128, 128, 128, poolw + g * 128 * 128, 128, 0, scr, r % I_P, C.lane); }
    }
    cvt_stream(C, in[12], (f16*)(ws + WS_SUBK), (size_t)8 * 2 * 128 * 128 / 4);
    cvt_stream(C, in[13], (f16*)(ws + WS_UTAB), (size_t)NEXP * DM / 4);
    cvt_stream(C, in[14], (f16*)(ws + WS_VTAB), (size_t)NEXP * DM / 4);
    rowprep(C, in[0], in[1], (f16*)(ws + WS_XH), (float*)(ws + WS_RS1));
}

__device__ __forceinline__ void ph_attn_naive(const Ctx& C, const f16* __restrict__ qkvu, const float* __restrict__ sink, f16* __restrict__ ocat) {
    for (int gid = C.gt; gid < T * 8; gid += C.ngt) {
        const int t = gid % T, h = gid / T;
        const int b = t / SEQ, ts = t % SEQ, kh = h >> 2;
        float q[64], o[64];
        const f16* qr = qkvu + (size_t)t * NQKVU + h * 64;
#pragma unroll
        for (int d = 0; d < 64; ++d) { q[d] = (float)qr[d]; o[d] = 0.f; }
        const float slope = exp2f(-(float)(h + 1));
        float m = -1e30f, l = 0.f;
        const int s0 = max(ts - 128, 0), s1 = min(ts + 128, SEQ - 1);
        for (int s = s0; s <= s1; ++s) {
            const f16* kr = qkvu + (size_t)(b * SEQ + s) * NQKVU + COL_K + kh * 64;
            const f16* vr = qkvu + (size_t)(b * SEQ + s) * NQKVU + COL_V + kh * 64;
            float dot = 0.f;
#pragma unroll
            for (int d = 0; d < 64; ++d) dot += q[d] * (float)kr[d];
            const float lg = dot * 0.125f - slope * fabsf((float)(ts - s));
            const float mn = fmaxf(m, lg), al = __expf(m - mn), p = __expf(lg - mn);
            l = l * al + p;
#pragma unroll
            for (int d = 0; d < 64; ++d) o[d] = o[d] * al + p * (float)vr[d];
            m = mn;
        }
        const float sk = sink[h];
        const float mn = fmaxf(m, sk), al = __expf(m - mn);
        l = l * al + __expf(sk - mn);
        const float inv = al / l;
        f16* orow = ocat + (size_t)t * DM + h * 64;
#pragma unroll
        for (int d = 0; d < 64; ++d) orow[d] = (f16)(o[d] * inv);
    }
}

__device__ __forceinline__ void ph_attn(const Ctx& C, const f16* __restrict__ qkvu, const f16* __restrict__ vT, const float* __restrict__ sink, f16* __restrict__ ocat) {
    const int lane = C.lane, r32 = lane & 31, hh = lane >> 5;
    const int krow = (r32 & 19) | ((r32 & 4) << 1) | ((r32 & 8) >> 1);
    constexpr float L2E = 1.4426950408889634f;
    for (int u = C.gw; u < BATCH * 8 * 64; u += C.ngw) {
        const int qs = u & 63, h = (u >> 6) & 7, b = u >> 9, kh = h >> 2;
        const int tq = qs * 32 + r32;
        const float slope2 = exp2f(-(float)(h + 1)) * L2E, sink2 = sink[h] * L2E;
        const f16* qrow = qkvu + (size_t)(b * SEQ + tq) * NQKVU + h * 64 + 8 * hh;
        half8 bq[4];
#pragma unroll
        for (int ks = 0; ks < 4; ++ks) bq[ks] = *(const half8*)(qrow + 16 * ks);
        f32x16 o0, o1;
#pragma unroll
        for (int r = 0; r < 16; ++r) { o0[r] = 0.f; o1[r] = 0.f; }
        float m = -1e30f, l = 0.f;
        const int kb_lo = max(qs - 4, 0), kb_hi = min(qs + 4, 63);
        const f16* vbase = vT + (size_t)((b * 2 + kh) * 64 + r32) * SEQ + 8 * hh;
#pragma unroll 1
        for (int kb = kb_lo; kb <= kb_hi; ++kb) {
            const f16* kr = qkvu + (size_t)(b * SEQ + kb * 32 + krow) * NQKVU + COL_K + kh * 64 + 8 * hh;
            f32x16 s;
#pragma unroll
            for (int r = 0; r < 16; ++r) s[r] = 0.f;
#pragma unroll
            for (int ks = 0; ks < 4; ++ks) { const half8 ak = *(const half8*)(kr + 16 * ks); s = __builtin_amdgcn_mfma_f32_32x32x16_f16(ak, bq[ks], s, 0, 0, 0); }
            half8 va[2][2];
#pragma unroll
            for (int db = 0; db < 2; ++db)
#pragma unroll
                for (int st = 0; st < 2; ++st) va[db][st] = *(const half8*)(vbase + (size_t)(db * 32) * SEQ + kb * 32 + 16 * st);
            float bmax = -1e30f; bool ok[16];
#pragma unroll
            for (int r = 0; r < 16; ++r) {
                const int tk = kb * 32 + 16 * (r >> 3) + 8 * hh + (r & 7);
                const int dist = abs(tq - tk);
                ok[r] = dist <= 128;
                s[r] = ok[r] ? s[r] * (0.125f * L2E) - slope2 * (float)dist : -1e30f;
                bmax = fmaxf(bmax, s[r]);
            }
            bmax = fmaxf(bmax, __shfl_xor(bmax, 32));
            const float mn = fmaxf(m, bmax), al = exp2f(m - mn);
            m = mn;
            float ps = 0.f; half8 pb[2];
#pragma unroll
            for (int r = 0; r < 16; ++r) { const float p = ok[r] ? exp2f(s[r] - mn) : 0.f; ps += p; pb[r >> 3][r & 7] = (f16)p; }
            l = l * al + ps;
#pragma unroll
            for (int r = 0; r < 16; ++r) { o0[r] *= al; o1[r] *= al; }
#pragma unroll
            for (int st = 0; st < 2; ++st) { o0 = __builtin_amdgcn_mfma_f32_32x32x16_f16(va[0][st], pb[st], o0, 0, 0, 0); o1 = __builtin_amdgcn_mfma_f32_32x32x16_f16(va[1][st], pb[st], o1, 0, 0, 0); }
        }
        l += __shfl_xor(l, 32);
        const float mf = fmaxf(m, sink2), al = exp2f(m - mf);
        const float sc = al / (l * al + exp2f(sink2 - mf));
        f16* orow = ocat + (size_t)(b * SEQ + tq) * DM + h * 64 + 4 * hh;
#pragma unroll
        for (int g = 0; g < 4; ++g) {
            half4 a, c;
#pragma unroll
            for (int i = 0; i < 4; ++i) { a[i] = (f16)(o0[4 * g + i] * sc); c[i] = (f16)(o1[4 * g + i] * sc); }
            *(half4*)(orow + 8 * g) = a; *(half4*)(orow + 32 + 8 * g) = c;
        }
    }
}

__device__ __forceinline__ void ph_pool_naive(const Ctx& C, const f16* __restrict__ qkvu, f16* __restrict__ mixed) {
    for (size_t gid = (size_t)C.gt; gid < (size_t)T * 512; gid += (size_t)C.ngt) {
        const int c = (int)(gid & 511), t = (int)(gid >> 9);
        const int b = t / SEQ, ts = t % SEQ, g = c >> 7, w = 2 << g;
        const int lo = max(ts - w / 2, 0), hi = min(ts + w / 2, SEQ);
        float s = 0.f;
        for (int i = lo; i < hi; ++i) s += (float)qkvu[(size_t)(b * SEQ + i) * NQKVU + COL_U + c];
        const float mean = s / (float)(hi - lo);
        mixed[(size_t)t * 512 + c] = (f16)(mean - (float)qkvu[(size_t)t * NQKVU + COL_U + c]);
    }
}
__device__ __forceinline__ void ph_poolmm_naive(const Ctx& C, const f16* __restrict__ mixed, const f16* __restrict__ poolw_t, const float* __restrict__ pscale, f16* __restrict__ ocat) {
    for (size_t gid = (size_t)C.gt; gid < (size_t)T * 512; gid += (size_t)C.ngt) {
        const int n = (int)(gid & 511), t = (int)(gid >> 9), g = n >> 7, d = n & 127;
        const f16* mr = mixed + (size_t)t * 512 + g * 128;
        const f16* wr = poolw_t + (size_t)(g * 128 + d) * 128;
        float acc = 0.f;
        for (int c = 0; c < 128; ++c) acc += (float)mr[c] * (float)wr[c];
        ocat[(size_t)t * DM + 512 + n] = (f16)(acc * pscale[n]);
    }
}

__device__ __forceinline__ void ph_pool(const Ctx& C, LAS unsigned char* lds, const f16* __restrict__ qkvu, const f16* __restrict__ poolw_t, const float* __restrict__ pscale, f16* __restrict__ ocat) {
    const int tid = C.tid, lane = C.lane, wv = C.wave, r32 = lane & 31, hh = lane >> 5;
    for (int u = blockIdx.x; u < (T / 128) * 4; u += C.G) {
        const int g = u & 3, t0 = (u >> 2) * 128, b = t0 >> 11, hw = 1 << g;
        {
            const int c2 = tid & 63, sf = (t0 & (SEQ - 1)) + wv * 16;
            const f16* ub = qkvu + (size_t)(b * SEQ) * NQKVU + COL_U + g * 128 + 2 * c2;
            float s0 = 0.f, s1 = 0.f;
            for (int s = max(sf - hw, 0); s < min(sf + hw, SEQ); ++s) { const half2 v = *(const half2*)(ub + (size_t)s * NQKVU); s0 += (float)v[0]; s1 += (float)v[1]; }
#pragma unroll 4
            for (int i = 0; i < 16; ++i) {
                const int s = sf + i, lo = max(s - hw, 0), hi = min(s + hw, SEQ);
                const float inv = 1.0f / (float)(hi - lo);
                const half2 cur = *(const half2*)(ub + (size_t)s * NQKVU);
                half2 mx; mx[0] = (f16)(s0 * inv - (float)cur[0]); mx[1] = (f16)(s1 * inv - (float)cur[1]);
                const int tl = wv * 16 + i;
                *(LAS half2*)(lds + tl * 256 + (((c2 >> 2) ^ (tl & 15)) << 4) + ((c2 & 3) << 2)) = mx;
                if (s + hw < SEQ) { const half2 v = *(const half2*)(ub + (size_t)(s + hw) * NQKVU); s0 += (float)v[0]; s1 += (float)v[1]; }
                if (s - hw >= 0) { const half2 v = *(const half2*)(ub + (size_t)(s - hw) * NQKVU); s0 -= (float)v[0]; s1 -= (float)v[1]; }
            }
        }
        __syncthreads();
        {
            const int tb = (wv & 3) * 32, d0 = (wv >> 2) * 64, tl = tb + r32;
            f32x16 acc0, acc1;
#pragma unroll
            for (int r = 0; r < 16; ++r) { acc0[r] = 0.f; acc1[r] = 0.f; }
            const f16* wr = poolw_t + (size_t)(g * 128 + d0 + r32) * 128 + 8 * hh;
#pragma unroll
            for (int ks = 0; ks < 8; ++ks) {
                const half8 bm = *(const LAS half8*)(lds + tl * 256 + (((2 * ks + hh) ^ (tl & 15)) << 4));
                const half8 a0 = *(const half8*)(wr + 16 * ks), a1 = *(const half8*)(wr + 32 * 128 + 16 * ks);
                acc0 = __builtin_amdgcn_mfma_f32_32x32x16_f16(a0, bm, acc0, 0, 0, 0);
                acc1 = __builtin_amdgcn_mfma_f32_32x32x16_f16(a1, bm, acc1, 0, 0, 0);
            }
            f16* orow = ocat + (size_t)(t0 + tl) * DM + 512 + g * 128 + d0 + 4 * hh;
            const float* ps = pscale + g * 128 + d0 + 4 * hh;
#pragma unroll
            for (int q = 0; q < 4; ++q) {
                const f32x4 p0 = *(const f32x4*)(ps + 8 * q), p1 = *(const f32x4*)(ps + 32 + 8 * q);
                half4 x0, x1;
#pragma unroll
                for (int i = 0; i < 4; ++i) { x0[i] = (f16)(acc0[4 * q + i] * p0[i]); x1[i] = (f16)(acc1[4 * q + i] * p1[i]); }
                *(half4*)(orow + 8 * q) = x0; *(half4*)(orow + 32 + 8 * q) = x1;
            }
        }
        __syncthreads();
    }
}

#define INS(LV, LI, v_, i_) do { float cv_ = (v_); int ci_ = (i_); \
    _Pragma("unroll") for (int z_ = 0; z_ < 16; ++z_) { const bool gt_ = cv_ > LV[z_]; const float tv_ = gt_ ? LV[z_] : cv_; const int ti_ = gt_ ? LI[z_] : ci_; \
        LV[z_] = gt_ ? cv_ : LV[z_]; LI[z_] = gt_ ? ci_ : LI[z_]; cv_ = tv_; ci_ = ti_; } } while (0)
__device__ __forceinline__ void ph_route_naive(const Ctx& C, const f16* __restrict__ qp, const float* __restrict__ ss2, const f16* __restrict__ subk, int* __restrict__ eidx, float* __restrict__ egate) {
    for (int gid = C.gt; gid < T * 8; gid += C.ngt) {
        const int t = gid % T, h = gid / T;
        const float rs2 = rs_from_ss(ss2, t);
        float av[16], bv[16]; int ai[16], bi[16];
#pragma unroll
        for (int z = 0; z < 16; ++z) { av[z] = -3e38f; bv[z] = -3e38f; ai[z] = 0; bi[z] = 0; }
        for (int p = 0; p < 2; ++p) {
            const f16* qr = qp + (size_t)t * 2048 + h * 256 + p * 128;
            for (int n = 0; n < 128; ++n) {
                const f16* kr = subk + ((size_t)((h * 2 + p) * 128 + n)) * 128;
                float dot = 0.f;
                for (int c = 0; c < 128; ++c) dot += (float)qr[c] * (float)kr[c];
                dot *= rs2;
                if (p == 0) INS(av, ai, dot, n); else INS(bv, bi, dot, n);
            }
        }
        float cv[16]; int ci[16];
#pragma unroll
        for (int z = 0; z < 16; ++z) { cv[z] = -3e38f; ci[z] = 0; }
#pragma unroll
        for (int i = 0; i < 16; ++i)
#pragma unroll
            for (int j = 0; j < 16; ++j)
                if ((i + 1) * (j + 1) <= 16) INS(cv, ci, av[i] + bv[j], ai[i] * 128 + bi[j]);
        float sum = 0.f, e[16];
#pragma unroll
        for (int z = 0; z < 16; ++z) { e[z] = __expf(cv[z] - cv[0]); sum += e[z]; }
        const float inv = 1.0f / sum;
#pragma unroll
        for (int z = 0; z < 16; ++z) { eidx[(size_t)t * 128 + h * 16 + z] = ci[z]; egate[(size_t)t * 128 + h * 16 + z] = e[z] * inv; }
    }
}

__device__ __forceinline__ int mono_i(float f) { const int b = __float_as_int(f); return b ^ ((b >> 31) & 0x7fffffff); }
__device__ __forceinline__ float unmono_f(int m) { return __int_as_float(m ^ ((m >> 31) & 0x7fffffff)); }
#define INS16(Lst, x_) do { int xv_ = (x_); _Pragma("unroll") for (int z_ = 0; z_ < 16; ++z_) { const int hi_ = max(Lst[z_], xv_); xv_ = min(Lst[z_], xv_); Lst[z_] = hi_; } } while (0)
__device__ __forceinline__ void merge_pair16(int (&Lst)[16]) {
    int P[16];
#pragma unroll
    for (int z = 0; z < 16; ++z) P[z] = __shfl_xor(Lst[z], 32);
#pragma unroll
    for (int z = 0; z < 16; ++z) Lst[z] = max(Lst[z], P[15 - z]);
#pragma unroll
    for (int s = 8; s >= 1; s >>= 1)
#pragma unroll
        for (int i = 0; i < 16; ++i) if ((i & s) == 0) { const int hi = max(Lst[i], Lst[i + s]), lo = min(Lst[i], Lst[i + s]); Lst[i] = hi; Lst[i + s] = lo; }
}
__device__ __forceinline__ void ph_route(const Ctx& C, LAS unsigned char* lds, const f16* __restrict__ qp, const float* __restrict__ ss2, const f16* __restrict__ subk,
                                         int* __restrict__ eidx, float* __restrict__ egate) {
    const int lane = C.lane, r32 = lane & 31, hh = lane >> 5;
    LAS unsigned char* tab = lds + C.wave * 4096 + lane * 36;
    for (int u = C.gw; u < (T / 32) * 8; u += C.ngw) {
        const int h = u & 7, t0 = (u >> 3) * 32, t = t0 + r32;
        const float rs2 = rs_from_ss(ss2, t);
        int top[2][16];
#pragma unroll
        for (int p = 0; p < 2; ++p) {
            const f16* qrow = qp + (size_t)t * 2048 + h * 256 + p * 128 + 8 * hh;
            const f16* kbase = subk + (size_t)((h * 2 + p) * 128 + r32) * 128 + 8 * hh;
            half8 bq[8];
#pragma unroll
            for (int ks = 0; ks < 8; ++ks) bq[ks] = *(const half8*)(qrow + 16 * ks);
            int Lst[16];
#pragma unroll
            for (int z = 0; z < 16; ++z) Lst[z] = (int)0x80000000;
#pragma unroll 1
            for (int nb = 0; nb < 4; ++nb) {
                f32x16 acc = {0.f, 0.f, 0.f, 0.f, 0.f, 0.f, 0.f, 0.f, 0.f, 0.f, 0.f, 0.f, 0.f, 0.f, 0.f, 0.f};
#pragma unroll
                for (int ks = 0; ks < 8; ++ks) {
                    const half8 ak = *(const half8*)(kbase + (size_t)(nb * 32) * 128 + 16 * ks);
                    acc = __builtin_amdgcn_mfma_f32_32x32x16_f16(ak, bq[ks], acc, 0, 0, 0);
                }
#pragma unroll
                for (int r = 0; r < 16; ++r) {
                    const int n = nb * 32 + (r & 3) + 8 * (r >> 2) + 4 * hh;
                    const int key = (mono_i(acc[r] * rs2) & ~127) | (127 - n);
                    INS16(Lst, key);
                }
            }
            merge_pair16(Lst);
#pragma unroll
            for (int z = 0; z < 16; ++z) top[p][z] = Lst[z];
        }
        float va[16], vb[16];
#pragma unroll
        for (int z = 0; z < 16; ++z) { va[z] = unmono_f(top[0][z] & ~127); vb[z] = unmono_f(top[1][z] & ~127);
            tab[z] = (unsigned char)(127 - (top[0][z] & 127)); tab[16 + z] = (unsigned char)(127 - (top[1][z] & 127)); }
        int Cl[16];
#pragma unroll
        for (int z = 0; z < 16; ++z) Cl[z] = (int)0x80000000;
#pragma unroll
        for (int i = 0; i < 16; ++i)
#pragma unroll
            for (int j = 0; j < 16; ++j)
                if ((i + 1) * (j + 1) <= 16) { const int key = (mono_i(va[i] + vb[j]) & ~255) | (255 - (i * 16 + j)); INS16(Cl, key); }
        float e[16], sum = 0.f; const float mx = unmono_f(Cl[0] & ~255);
#pragma unroll
        for (int z = 0; z < 16; ++z) { e[z] = __expf(unmono_f(Cl[z] & ~255) - mx); sum += e[z]; }
        const float inv = 1.0f / sum;
        LDS_WAIT();
        int* ei = eidx + (size_t)t * 128 + h * 16 + 8 * hh; float* eg = egate + (size_t)t * 128 + h * 16 + 8 * hh;
#pragma unroll
        for (int z = 0; z < 16; ++z) {
            if ((z >> 3) == hh) { const int code = 255 - (Cl[z] & 255); const int ia = tab[code >> 4], ib = tab[16 + (code & 15)];
                ei[z & 7] = ia * 128 + ib; eg[z & 7] = e[z] * inv; }
        }
        LDS_WAIT();
    }
}

__device__ __forceinline__ float dot8(const half8 a, const half8 b, float c) {
    c = __builtin_amdgcn_fdot2(__builtin_shufflevector(a, a, 0, 1), __builtin_shufflevector(b, b, 0, 1), c, false);
    c = __builtin_amdgcn_fdot2(__builtin_shufflevector(a, a, 2, 3), __builtin_shufflevector(b, b, 2, 3), c, false);
    c = __builtin_amdgcn_fdot2(__builtin_shufflevector(a, a, 4, 5), __builtin_shufflevector(b, b, 4, 5), c, false);
    c = __builtin_amdgcn_fdot2(__builtin_shufflevector(a, a, 6, 7), __builtin_shufflevector(b, b, 6, 7), c, false);
    return c;
}
__device__ __forceinline__ void ph_gather(const Ctx& C, const f16* __restrict__ x1h, const float* __restrict__ ss2, const int* __restrict__ eidx, const float* __restrict__ egate,
                                          const f16* __restrict__ utab, const f16* __restrict__ vtab, float* __restrict__ xio, const float* __restrict__ gf) {
    const int lane = C.lane;
    const bool hh = (lane & 32) != 0, b4 = (lane & 16) != 0, b3 = (lane & 8) != 0, b2 = (lane & 4) != 0;
    const int j15 = lane & 15, srcl = 32 * (j15 >> 3) + 16 * ((j15 >> 2) & 1) + 8 * ((j15 >> 1) & 1) + 4 * (j15 & 1);
    for (int t = C.gw; t < T; t += C.ngw) {
        const float rs2 = rs_from_ss(ss2, t);
        const half8 ha = *(const half8*)(x1h + (size_t)t * DM + 8 * lane), hb = *(const half8*)(x1h + (size_t)t * DM + 512 + 8 * lane);
        const int e0 = eidx[(size_t)t * 128 + lane], e1 = eidx[(size_t)t * 128 + 64 + lane];
        const float g0 = egate[(size_t)t * 128 + lane], g1 = egate[(size_t)t * 128 + 64 + lane];
        float a0 = 0.f, a1 = 0.f;
#pragma unroll 1
        for (int B = 0; B < 8; ++B) {
            const int esel = (B < 4) ? e0 : e1;
            half8 ua[16], ub[16];
#pragma unroll
            for (int j = 0; j < 16; ++j) {
                const int e = __builtin_amdgcn_readlane(esel, ((B & 3) << 4) + j);
                const f16* ur = utab + (size_t)e * DM;
                ua[j] = *(const half8*)(ur + 8 * lane); ub[j] = *(const half8*)(ur + 512 + 8 * lane);
            }
            float p[16];
#pragma unroll
            for (int j = 0; j < 16; ++j) p[j] = dot8(ub[j], hb, dot8(ua[j], ha, 0.f));
            float q8[8], q4[4], q2[2], q1;
#pragma unroll
            for (int i = 0; i < 8; ++i) { const float mine = hh ? p[8 + i] : p[i], oth = hh ? p[i] : p[8 + i]; q8[i] = mine + __shfl_xor(oth, 32); }
#pragma unroll
            for (int i = 0; i < 4; ++i) { const float mine = b4 ? q8[4 + i] : q8[i], oth = b4 ? q8[i] : q8[4 + i]; q4[i] = mine + __shfl_xor(oth, 16); }
#pragma unroll
            for (int i = 0; i < 2; ++i) { const float mine = b3 ? q4[2 + i] : q4[i], oth = b3 ? q4[i] : q4[2 + i]; q2[i] = mine + __shfl_xor(oth, 8); }
            { const float mine = b2 ? q2[1] : q2[0], oth = b2 ? q2[0] : q2[1]; q1 = mine + __shfl_xor(oth, 4); }
            q1 += __shfl_xor(q1, 2); q1 += __shfl_xor(q1, 1);
            const float val = __shfl(q1, srcl);
            if ((lane >> 4) == (B & 3)) { if (B < 4) a0 = val; else a1 = val; }
        }
        a0 = gelu_exact(a0 * rs2) * g0; a1 = gelu_exact(a1 * rs2) * g1;
        float o[16];
#pragma unroll
        for (int i = 0; i < 16; ++i) o[i] = 0.f;
#pragma unroll 1
        for (int B = 0; B < 8; ++B) {
            const int esel = (B < 4) ? e0 : e1; const float asel = (B < 4) ? a0 : a1;
            half8 va[16], vb[16];
#pragma unroll
            for (int j = 0; j < 16; ++j) {
                const int e = __builtin_amdgcn_readlane(esel, ((B & 3) << 4) + j);
                const f16* vr = vtab + (size_t)e * DM;
                va[j] = *(const half8*)(vr + 8 * lane); vb[j] = *(const half8*)(vr + 512 + 8 * lane);
            }
#pragma unroll
            for (int j = 0; j < 16; ++j) {
                const float a = __builtin_bit_cast(float, __builtin_amdgcn_readlane(__builtin_bit_cast(int, asel), ((B & 3) << 4) + j));
#pragma unroll
                for (int i = 0; i < 8; ++i) { o[i] = fmaf(a, (float)va[j][i], o[i]); o[8 + i] = fmaf(a, (float)vb[j][i], o[8 + i]); }
            }
        }
        float* xr = xio + (size_t)t * DM;
        float y[16]; float s = 0.f;
#pragma unroll
        for (int j = 0; j < 4; ++j) {
            const f32x4 v = *(const f32x4*)(xr + (j >> 1) * 512 + 8 * lane + (j & 1) * 4);
#pragma unroll
            for (int i = 0; i < 4; ++i) { y[j * 4 + i] = v[i] + o[j * 4 + i]; s += y[j * 4 + i] * y[j * 4 + i]; }
        }
        s = wave_sum(s);
        const float r = rsqrtf(s * (1.0f / DM) + EPS);
#pragma unroll
        for (int j = 0; j < 4; ++j) {
            const int c0 = (j >> 1) * 512 + 8 * lane + (j & 1) * 4;
            const f32x4 gg = *(const f32x4*)(gf + c0);
            f32x4 v;
#pragma unroll
            for (int i = 0; i < 4; ++i) v[i] = y[j * 4 + i] * r * gg[i];
            *(f32x4*)(xr + c0) = v;
        }
    }
}

namespace pg8 {
#define PG8_LAS __attribute__((address_space(3)))
typedef _Float16 frag8 __attribute__((ext_vector_type(8)));
typedef float f32x4 __attribute__((ext_vector_type(4)));
constexpr int BM = 256, BK = 64, HALF = 128, HTB = HALF * BK * 2  , STAGE_BYTES = 8 * HTB, NXCD = 8, WGM = 8;

__host__ __device__ __forceinline__ int lds_byte(int r, int c) { const int st = (r >> 4) * 2 + (c >> 5), rr = r & 15, cc = c & 31, ob = rr * 64 + cc * 2; return st * 1024 + (ob ^ (((ob >> 9) & 1) << 5)); }
__host__ __device__ __forceinline__ void stage_rc(int b, int& R, int& C) { const int st = b / 1024, sb = b % 1024, swz = sb ^ (((sb >> 9) & 1) << 5); R = (st >> 1) * 16 + swz / 64; C = (st & 1) * 32 + (swz % 64) / 2; }
__host__ __device__ __forceinline__ int perm32(int rho) { const int n = rho >> 4, i = rho & 15; return 8 * (i >> 2) + 4 * n + (i & 3); }

struct Unit { int pm, pn; };
struct Gemm { const f16* A; const f16* Bt; int M, N, K; };

struct StaticOrder {
    int nM, nN, nwg, G, c;
    __host__ __device__ void init(int M, int N, int G_, int c_) { nM = M / BM; nN = N / BM; nwg = nM * nN; G = G_; c = c_; }
    __host__ __device__ bool next(int i, Unit& u) const {
        const long L = (long)i * G + c; if (L >= nwg) return false;
        int wgid = (int)L; { const int q = nwg / NXCD, r = nwg % NXCD, xcd = wgid % NXCD, off = wgid / NXCD; wgid = (xcd < r ? xcd * (q + 1) : r * (q + 1) + (xcd - r) * q) + off; }
        const int nig = WGM * nN, gid = wgid / nig, fm = gid * WGM, gsz = (nM - fm) < WGM ? (nM - fm) : WGM;
        u.pm = fm + ((wgid % nig) % gsz); u.pn = (wgid % nig) / gsz; return true;
    }
    __device__ __forceinline__ void a_ready(const Unit&) const {}
    __device__ __forceinline__ void done(const Unit&) const {}
};

__device__ __forceinline__ frag8 pack8(const f32x4 a, const f32x4 b) {
    frag8 h; h[0] = (f16)a[0]; h[1] = (f16)a[1]; h[2] = (f16)a[2]; h[3] = (f16)a[3]; h[4] = (f16)b[0]; h[5] = (f16)b[1]; h[6] = (f16)b[2]; h[7] = (f16)b[3]; return h;
}
__device__ __forceinline__ float sigmoidf_(float z) { return 1.0f / (1.0f + __expf(-z)); }

struct EpiP1 {
    static constexpr bool PERM = true, AFTER_DRAIN = false, MIDK = false;
    const float* ss1; const float* bgate; f16* qkvu; f16* gates; f16* vT;
    __device__ __forceinline__ void operator()(const f32x4 (&acc)[2][2][4][2], const Unit& u, int wr, int wc, int fr, int fq) const {
        const int row0 = u.pm * BM + wr * 64 + fr, colt = u.pn * BM; const bool isg = colt >= NQKVU;
#pragma unroll
        for (int ai = 0; ai < 2; ++ai)
#pragma unroll
            for (int m = 0; m < 4; ++m) { const int row = row0 + ai * HALF + m * 16; const float r = rsqrtf(ss1[row] * (1.0f / DM) + EPS);
#pragma unroll
                for (int bj = 0; bj < 2; ++bj) { const int c0 = colt + bj * HALF + wc * 32 + 8 * fq; f32x4 v0 = acc[ai][bj][m][0] * r, v1 = acc[ai][bj][m][1] * r;
                    if (isg) { const int cg = c0 - NQKVU; const f32x4 b0 = *(const f32x4*)(bgate + cg), b1 = *(const f32x4*)(bgate + cg + 4);
#pragma unroll
                        for (int i = 0; i < 4; ++i) { v0[i] = sigmoidf_(v0[i] + b0[i]); v1[i] = sigmoidf_(v1[i] + b1[i]); }
                        *(frag8*)(gates + (size_t)row * NGATE + cg) = pack8(v0, v1); }
                    else { const frag8 hv = pack8(v0, v1); *(frag8*)(qkvu + (size_t)row * NQKVU + c0) = hv;
                        if (colt == 512 && bj == 1) {
                            f16* vp = vT + ((size_t)((row >> 11) * 2 + (wc >> 1)) * 64 + (wc & 1) * 32 + 8 * fq) * SEQ + (row & (SEQ - 1));
#pragma unroll
                            for (int i = 0; i < 8; ++i) vp[(size_t)i * SEQ] = hv[i]; } } } }
    }
};
struct EpiMerged {
    static constexpr bool PERM = true, AFTER_DRAIN = false, MIDK = true;
    const f16* gates; f16* merged;
    __device__ __forceinline__ void mid(f32x4 (&acc)[2][2][4][2], const Unit& u, int wr, int wc, int fr, int fq) const {
        const int row0 = u.pm * BM + wr * 64 + fr, colt = u.pn * BM;
        const f16* gb = gates + (size_t)row0 * NGATE + colt + wc * 32 + 8 * fq;
        asm volatile("" : "+v"(gb));
#pragma unroll
        for (int ai = 0; ai < 2; ++ai) {
            frag8 g0[4][2], g1[4][2];
#pragma unroll
            for (int m = 0; m < 4; ++m)
#pragma unroll
                for (int bj = 0; bj < 2; ++bj) { const f16* gp = gb + (size_t)(ai * HALF + m * 16) * NGATE + bj * HALF; g0[m][bj] = *(const frag8*)gp; g1[m][bj] = *(const frag8*)(gp + DM); }
#pragma unroll
            for (int m = 0; m < 4; ++m)
#pragma unroll
                for (int bj = 0; bj < 2; ++bj)
#pragma unroll
                    for (int i = 0; i < 4; ++i) {
                        acc[ai][bj][m][0][i] *= (float)g0[m][bj][i] * __builtin_amdgcn_rcpf(fmaxf((float)g1[m][bj][i], 1e-4f));
                        acc[ai][bj][m][1][i] *= (float)g0[m][bj][4 + i] * __builtin_amdgcn_rcpf(fmaxf((float)g1[m][bj][4 + i], 1e-4f)); }
            asm volatile("" ::: "memory");
        }
    }
    __device__ __forceinline__ void operator()(const f32x4 (&acc)[2][2][4][2], const Unit& u, int wr, int wc, int fr, int fq) const {
        const int row0 = u.pm * BM + wr * 64 + fr, colt = u.pn * BM;
#pragma unroll
        for (int ai = 0; ai < 2; ++ai)
#pragma unroll
            for (int m = 0; m < 4; ++m) { const int row = row0 + ai * HALF + m * 16;
#pragma unroll
                for (int bj = 0; bj < 2; ++bj) { const int c0 = colt + bj * HALF + wc * 32 + 8 * fq;
                    const frag8 g1 = *(const frag8*)(gates + (size_t)row * NGATE + DM + c0); f32x4 v0, v1;
#pragma unroll
                    for (int i = 0; i < 4; ++i) { v0[i] = acc[ai][bj][m][0][i] * fmaxf((float)g1[i], 1e-4f); v1[i] = acc[ai][bj][m][1][i] * fmaxf((float)g1[4 + i], 1e-4f); }
                    *(frag8*)(merged + (size_t)row * DM + c0) = pack8(v0, v1); } }
    }
};
struct EpiOut {
    static constexpr bool PERM = false, AFTER_DRAIN = false, MIDK = false;
    const float* x; const float* g2; float* x1; f16* x1h; float* ss2p;
    __device__ __forceinline__ void operator()(const f32x4 (&acc)[2][2][4][2], const Unit& u, int wr, int wc, int fr, int fq) const {
        const int row0 = u.pm * BM + wr * 64 + fr, col0 = u.pn * BM + wc * 32 + 4 * fq;
        f32x4 gv[2][2];
#pragma unroll
        for (int bj = 0; bj < 2; ++bj)
#pragma unroll
            for (int n = 0; n < 2; ++n) gv[bj][n] = *(const f32x4*)(g2 + col0 + bj * HALF + n * 16);
#pragma unroll
        for (int ai = 0; ai < 2; ++ai)
#pragma unroll
            for (int m = 0; m < 4; ++m) { const int row = row0 + ai * HALF + m * 16; const size_t off = (size_t)row * DM + col0; float ssq = 0.f;
#pragma unroll
                for (int bj = 0; bj < 2; ++bj)
#pragma unroll
                    for (int n = 0; n < 2; ++n) { const f32x4 y = *(const f32x4*)(x + off + bj * HALF + n * 16) + acc[ai][bj][m][n];
                        *(f32x4*)(x1 + off + bj * HALF + n * 16) = y; ssq += (y[0] * y[0] + y[1] * y[1]) + (y[2] * y[2] + y[3] * y[3]);
                        const f32x4 yg = y * gv[bj][n]; half4 h; h[0] = (f16)yg[0]; h[1] = (f16)yg[1]; h[2] = (f16)yg[2]; h[3] = (f16)yg[3];
                        *(half4*)(x1h + off + bj * HALF + n * 16) = h; }
                ssq += __shfl_xor(ssq, 16); ssq += __shfl_xor(ssq, 32);
                if (fq == 0) ss2p[(size_t)(u.pn * 4 + wc) * T + row] = ssq; }
    }
};
struct EpiQ {
    static constexpr bool PERM = true, AFTER_DRAIN = false, MIDK = false;
    f16* qp;
    __device__ __forceinline__ void operator()(const f32x4 (&acc)[2][2][4][2], const Unit& u, int wr, int wc, int fr, int fq) const {
        const int row0 = u.pm * BM + wr * 64 + fr, colt = u.pn * BM;
#pragma unroll
        for (int ai = 0; ai < 2; ++ai)
#pragma unroll
            for (int m = 0; m < 4; ++m) { const int row = row0 + ai * HALF + m * 16;
#pragma unroll
                for (int bj = 0; bj < 2; ++bj) { const int c0 = colt + bj * HALF + wc * 32 + 8 * fq;
                    *(frag8*)(qp + (size_t)row * 2048 + c0) = pack8(acc[ai][bj][m][0], acc[ai][bj][m][1]); } }
    }
};

template <class Epi, class Sched, bool ALIGN_EPI = false, bool SP2 = false>
__device__ __forceinline__ void gemm_phase(PG8_LAS unsigned char* lds, const Gemm g, const Sched& S, const Epi& E) {
    const int tid = threadIdx.x, wid = __builtin_amdgcn_readfirstlane(tid >> 6), lane = tid & 63, wr = wid >> 2, wc = wid & 3, fr = lane & 15, fq = lane >> 4;
    const int K = g.K, nt = K / BK;
    unsigned voffA[2], voffB[2];
#pragma unroll
    for (int i = 0; i < 2; ++i) { int R, C; stage_rc(tid * 16 + i * 8192, R, C); const int Rb = Epi::PERM ? ((R & ~31) + perm32(R & 31)) : R;
        voffA[i] = (unsigned)(R * K + C) * 2u; voffB[i] = (unsigned)(Rb * K + C) * 2u; }
    const size_t kstep = (size_t)(BK * 2);
    const size_t hstep = (size_t)HALF * K * 2;
    const size_t tstep = 2 * hstep;
    const unsigned ldsw = (unsigned)wid * 1024u;
    const int aoff = lds_byte(wr * 64 + fr, fq * 8), boff = lds_byte(wc * 32 + fr, fq * 8);
#define PG8_SA(b, h) (((b) * 2 + (h)) * HTB)
#define PG8_SB(b, h) ((4 + (b) * 2 + (h)) * HTB)
#define PG8_STAGE(bufoff, gbase, voff) do { _Pragma("unroll") for (int _i = 0; _i < 2; ++_i) \
        __builtin_amdgcn_global_load_lds((const unsigned*)((const char*)(gbase) + (voff)[_i]), (PG8_LAS unsigned*)(lds + (bufoff) + ldsw + _i * 8192), 16, 0, 0); } while (0)
#define PG8_LDA(dst, b, h) do { _Pragma("unroll") for (int m = 0; m < 4; ++m) _Pragma("unroll") for (int k = 0; k < 2; ++k) dst[m][k] = *(const PG8_LAS frag8*)(lds + PG8_SA(b, h) + aoff + m * 2048 + k * 1024); } while (0)
#define PG8_LDB(dst, b, h) do { _Pragma("unroll") for (int n = 0; n < 2; ++n) _Pragma("unroll") for (int k = 0; k < 2; ++k) dst[n][k] = *(const PG8_LAS frag8*)(lds + PG8_SB(b, h) + boff + n * 2048 + k * 1024); } while (0)
#define PG8_MMA(ai, bj, At, Bt) do { __builtin_amdgcn_s_setprio(1); _Pragma("unroll") for (int m = 0; m < 4; ++m) _Pragma("unroll") for (int n = 0; n < 2; ++n) _Pragma("unroll") for (int k = 0; k < 2; ++k) \
        acc[ai][bj][m][n] = __builtin_amdgcn_mfma_f32_16x16x32_f16(Bt[n][k], At[m][k], acc[ai][bj][m][n], 0, 0, 0); __builtin_amdgcn_s_setprio(0); } while (0)
#define PG8_WAIT_V(n) asm volatile("s_waitcnt vmcnt(" #n ")" ::: "memory")
#define PG8_WAIT_L(n) asm volatile("s_waitcnt lgkmcnt(" #n ")" ::: "memory")
#define PG8_BAR __builtin_amdgcn_s_barrier()
#define PG8_SCHED __builtin_amdgcn_sched_barrier(0)
    Unit cur, nxt; int ui = 0;
    if (!S.next(0, cur)) return;
    f32x4 acc[2][2][4][2];
#pragma unroll
    for (int a = 0; a < 2; ++a)
#pragma unroll
        for (int b = 0; b < 2; ++b)
#pragma unroll
            for (int m = 0; m < 4; ++m)
#pragma unroll
                for (int n = 0; n < 2; ++n) acc[a][b][m][n] = (f32x4){0.f, 0.f, 0.f, 0.f};
    frag8 At[4][2], B0[2][2], B1[2][2];
    const char* cA = (const char*)g.A + (size_t)cur.pm * tstep; const char* cB = (const char*)g.Bt + (size_t)cur.pn * tstep;
    S.a_ready(cur);
    if constexpr (SP2) {
        PG8_STAGE(PG8_SB(0, 0), cB, voffB); PG8_STAGE(PG8_SB(0, 1), cB + hstep, voffB); PG8_STAGE(PG8_SA(0, 0), cA, voffA); PG8_STAGE(PG8_SA(0, 1), cA + hstep, voffA);
        if (wr == 1) PG8_BAR;
        PG8_WAIT_V(2); PG8_BAR;
        PG8_STAGE(PG8_SB(1, 0), cB + kstep, voffB); PG8_STAGE(PG8_SA(1, 0), cA + kstep, voffA); PG8_STAGE(PG8_SB(1, 1), cB + hstep + kstep, voffB);
        PG8_WAIT_V(6); PG8_BAR;
    } else {
        PG8_STAGE(PG8_SB(0, 0), cB, voffB); PG8_STAGE(PG8_SA(0, 0), cA, voffA); PG8_STAGE(PG8_SB(0, 1), cB + hstep, voffB); PG8_STAGE(PG8_SA(0, 1), cA + hstep, voffA);
        if (wr == 1) PG8_BAR;
        PG8_WAIT_V(4); PG8_BAR;
        PG8_STAGE(PG8_SB(1, 0), cB + kstep, voffB); PG8_STAGE(PG8_SA(1, 0), cA + kstep, voffA); PG8_STAGE(PG8_SB(1, 1), cB + hstep + kstep, voffB);
        PG8_WAIT_V(6); PG8_BAR;
    }
    for (;;) {
        const bool has_next = S.next(ui + 1, nxt);
        const char* nA = has_next ? (const char*)g.A + (size_t)nxt.pm * tstep : cA; const char* nB = has_next ? (const char*)g.Bt + (size_t)nxt.pn * tstep : cB;
        for (int t = 0; t < nt; t += 2) {
            const bool last = (t == nt - 2);
            if constexpr (Epi::MIDK) { if (t == (nt >> 1)) E.mid(acc, cur, wr, wc, fr, fq); }
            const char* a1 = cA + (size_t)(t + 1) * kstep;
            const char* a2 = last ? nA : cA + (size_t)(t + 2) * kstep; const char* b2 = last ? nB : cB + (size_t)(t + 2) * kstep;
            const char* a3 = a2 + kstep; const char* b3 = b2 + kstep;
            if (last && has_next) S.a_ready(nxt);
            if constexpr (SP2) {
            PG8_LDB(B0, 0, 0); PG8_LDB(B1, 0, 1); PG8_SCHED; PG8_LDA(At, 0, 0); PG8_STAGE(PG8_SA(1, 1), a1 + hstep, voffA);
            PG8_WAIT_V(8); PG8_WAIT_L(0); PG8_BAR; PG8_MMA(0, 0, At, B0); PG8_MMA(0, 1, At, B1); PG8_BAR; PG8_SCHED;
            PG8_LDA(At, 0, 1); PG8_STAGE(PG8_SB(0, 0), b2, voffB); PG8_STAGE(PG8_SB(0, 1), b2 + hstep, voffB); PG8_STAGE(PG8_SA(0, 0), a2, voffA);
            PG8_WAIT_V(8); PG8_WAIT_L(0); PG8_BAR; PG8_MMA(1, 0, At, B0); PG8_MMA(1, 1, At, B1); PG8_BAR; PG8_SCHED;
            PG8_LDB(B0, 1, 0); PG8_LDB(B1, 1, 1); PG8_SCHED; PG8_LDA(At, 1, 0); PG8_STAGE(PG8_SA(0, 1), a2 + hstep, voffA);
            PG8_WAIT_V(8); PG8_WAIT_L(0); PG8_BAR; PG8_MMA(0, 0, At, B0); PG8_MMA(0, 1, At, B1); PG8_BAR; PG8_SCHED;
            PG8_LDA(At, 1, 1); PG8_STAGE(PG8_SB(1, 0), b3, voffB); PG8_STAGE(PG8_SB(1, 1), b3 + hstep, voffB); PG8_STAGE(PG8_SA(1, 0), a3, voffA);
            PG8_WAIT_V(8); PG8_WAIT_L(0); PG8_BAR; PG8_MMA(1, 0, At, B0); PG8_MMA(1, 1, At, B1); PG8_BAR; PG8_SCHED;
            } else {
            PG8_LDB(B0, 0, 0); PG8_SCHED; PG8_LDA(At, 0, 0); PG8_STAGE(PG8_SA(1, 1), a1 + hstep, voffA);
            PG8_WAIT_L(8); PG8_BAR; PG8_WAIT_L(0); PG8_MMA(0, 0, At, B0); PG8_BAR; PG8_SCHED;
            PG8_LDB(B1, 0, 1); PG8_STAGE(PG8_SB(0, 0), b2, voffB);
            PG8_BAR; PG8_WAIT_L(0); PG8_MMA(0, 1, At, B1); PG8_BAR;
            PG8_LDA(At, 0, 1); PG8_STAGE(PG8_SA(0, 0), a2, voffA);
            PG8_BAR; PG8_WAIT_L(0); PG8_MMA(1, 0, At, B0); PG8_BAR; PG8_SCHED;
            PG8_STAGE(PG8_SB(0, 1), b2 + hstep, voffB);
            PG8_WAIT_V(6); PG8_BAR; PG8_MMA(1, 1, At, B1); PG8_BAR;
            PG8_LDB(B0, 1, 0); PG8_SCHED; PG8_LDA(At, 1, 0); PG8_STAGE(PG8_SA(0, 1), a2 + hstep, voffA);
            PG8_WAIT_L(8); PG8_BAR; PG8_WAIT_L(0); PG8_MMA(0, 0, At, B0); PG8_BAR; PG8_SCHED;
            PG8_LDB(B1, 1, 1); PG8_STAGE(PG8_SB(1, 0), b3, voffB);
            PG8_BAR; PG8_WAIT_L(0); PG8_MMA(0, 1, At, B1); PG8_BAR;
            PG8_LDA(At, 1, 1); PG8_STAGE(PG8_SA(1, 0), a3, voffA);
            PG8_BAR; PG8_WAIT_L(0); PG8_MMA(1, 0, At, B0); PG8_BAR; PG8_SCHED;
            PG8_STAGE(PG8_SB(1, 1), b3 + hstep, voffB);
            PG8_WAIT_V(6); PG8_BAR; PG8_MMA(1, 1, At, B1); PG8_BAR;
            }
        }
        if constexpr (ALIGN_EPI) { if (wr == 0) PG8_BAR; }
        if constexpr (!Epi::AFTER_DRAIN) { E(acc, cur, wr, wc, fr, fq); S.done(cur); }
        if (!has_next) break;
#pragma unroll
        for (int a = 0; a < 2; ++a)
#pragma unroll
            for (int b = 0; b < 2; ++b)
#pragma unroll
                for (int m = 0; m < 4; ++m)
#pragma unroll
                    for (int n = 0; n < 2; ++n) acc[a][b][m][n] = (f32x4){0.f, 0.f, 0.f, 0.f};
        cur = nxt; cA = nA; cB = nB; ++ui;
        if constexpr (ALIGN_EPI) { if (wr == 1) PG8_BAR; }
    }
    PG8_WAIT_V(0);
    if constexpr (!ALIGN_EPI) { if (wr == 0) PG8_BAR; }
    PG8_BAR;
    if constexpr (Epi::AFTER_DRAIN) { E.fused(acc, cur, wr, wc, fr, fq, lds, wid, lane); S.done(cur); }
#undef PG8_SA
#undef PG8_SB
#undef PG8_STAGE
#undef PG8_LDA
#undef PG8_LDB
#undef PG8_MMA
#undef PG8_WAIT_V
#undef PG8_WAIT_L
#undef PG8_BAR
#undef PG8_SCHED
}
}

#define XB_TMO      128
#define XB_XCNT(j)  (256  + 64 * (j))
#define XB_XSUB(j)  (1280 + 64 * (j))
#define XB_XGEN(j)  (2304 + 64 * (j))
#define XB_TOP      3328
#define XB_TOPGEN   3392
#define XCD_BAR_WORDS 3456
#define XB_SPIN_CAP (1u << 18)

__device__ __forceinline__ unsigned xb_ld(unsigned* p)              { return __hip_atomic_load(p, __ATOMIC_RELAXED, __HIP_MEMORY_SCOPE_AGENT); }
__device__ __forceinline__ unsigned xb_add(unsigned* p, unsigned v) { return __hip_atomic_fetch_add(p, v, __ATOMIC_RELAXED, __HIP_MEMORY_SCOPE_AGENT); }
__device__ __forceinline__ unsigned xb_xcc_id() { return (unsigned)__builtin_amdgcn_s_getreg((3 << 11) | 20) & 0xFu; }
#define XB_SPIN(cond, bar) do { unsigned _sp = 0; while (cond) { __builtin_amdgcn_s_sleep(1); \
    if ((++_sp & 255u) == 0u) { if (xb_ld(&(bar)[XB_TMO])) break; if (_sp > XB_SPIN_CAP) { atomicAdd(&(bar)[XB_TMO], 1u); break; } } } } while (0)

struct XcdBarrier {
    unsigned* bar; unsigned x;
    volatile LAS unsigned* st;
};

__device__ __forceinline__ XcdBarrier xcd_barrier_post(unsigned* bar, volatile LAS unsigned* st) {
    XcdBarrier b; b.bar = bar; b.x = xb_xcc_id(); b.st = st;
    if (threadIdx.x == 0) (void)xb_add(&bar[XB_XCNT(b.x)], 1u);
    return b;
}
__device__ __forceinline__ void xcd_barrier_complete(unsigned* bar, unsigned x, unsigned& nloc, unsigned& nx) {
    const unsigned G = gridDim.x * gridDim.y * gridDim.z;
    unsigned sum, cnt, mine, sp = 0u;
    for (;;) {
        sum = 0u; cnt = 0u; mine = 0u;
#pragma unroll
        for (unsigned j = 0; j < 16; ++j) { const unsigned c = xb_ld(&bar[XB_XCNT(j)]); sum += c; cnt += (c > 0u) ? 1u : 0u; mine = (j == x) ? c : mine; }
        if (sum == G) break;
        __builtin_amdgcn_s_sleep(1);
        if ((++sp & 255u) == 0u) { if (xb_ld(&bar[XB_TMO])) break; if (sp > XB_SPIN_CAP) { atomicAdd(&bar[XB_TMO], 1u); break; } }
    }
    nloc = mine > 0u ? mine : 1u; nx = cnt > 0u ? cnt : 1u;
}

__device__ __forceinline__ void xcd_barrier(const XcdBarrier& b) {
    asm volatile("s_waitcnt vmcnt(0)" ::: "memory");
    __syncthreads();
    if (threadIdx.x == 0) {
        unsigned* bar = b.bar;
        __builtin_amdgcn_s_waitcnt(0);
        unsigned nloc = b.st[0], nx = b.st[1];
        if (nloc == 0u) { xcd_barrier_complete(bar, b.x, nloc, nx); b.st[0] = nloc; b.st[1] = nx; }
        const unsigned old = xb_add(&bar[XB_XSUB(b.x)], 1u);
        const unsigned gen = old / nloc;
        if (old + 1u == (gen + 1u) * nloc) {
            __builtin_amdgcn_fence(__ATOMIC_RELEASE, "agent");
            asm volatile("s_waitcnt vmcnt(0)" ::: "memory");
            const unsigned og = xb_add(&bar[XB_TOP], 1u);
            const unsigned tg = og / nx;
            if (og + 1u == (tg + 1u) * nx) xb_add(&bar[XB_TOPGEN], 1u);
            else XB_SPIN(xb_ld(&bar[XB_TOPGEN]) == tg, bar);
            __builtin_amdgcn_fence(__ATOMIC_ACQUIRE, "agent");
            xb_add(&bar[XB_XGEN(b.x)], 1u);
            asm volatile("s_waitcnt vmcnt(0)" ::: "memory");
        } else {
            XB_SPIN(xb_ld(&bar[XB_XGEN(b.x)]) == gen, bar);
            __builtin_amdgcn_fence(__ATOMIC_ACQUIRE, "agent");
            asm volatile("s_waitcnt vmcnt(0)" ::: "memory");
        }
    }
    __syncthreads();
}


struct Args { const float* in[16]; float* out; unsigned char* ws; int ph_lo, ph_hi; };
constexpr int N_PHASES = 10;

__global__ void __launch_bounds__(NTHREADS, 2) mk_fwd(Args a) {
    extern __shared__ __attribute__((aligned(16))) unsigned char lds[];
    LAS unsigned char* L = (LAS unsigned char*)lds;
    volatile LAS unsigned* MISC = (volatile LAS unsigned*)(L + MISC_OFF);
    unsigned char* ws = a.ws;
    Ctx C;
    C.tid = threadIdx.x; C.lane = C.tid & 63; C.wave = __builtin_amdgcn_readfirstlane(C.tid >> 6);
    C.G = gridDim.x; C.gw = blockIdx.x * NWAVES + C.wave; C.ngw = C.G * NWAVES; C.gt = blockIdx.x * NTHREADS + C.tid; C.ngt = C.G * NTHREADS;
    for (int u = C.tid; u < (LDS_BYTES - LDSCTL_OFF) / 4; u += NTHREADS) ((LAS unsigned*)(L + LDSCTL_OFF))[u] = 0u;
    __syncthreads();
    const int lo = a.ph_lo, hi = a.ph_hi, G = C.G;
    const bool multi = (hi - lo) > 1;
    XcdBarrier bar; bar.bar = (unsigned*)(ws + WS_CTL) + CW_BAR; bar.x = 0; bar.st = nullptr;
    if (multi) bar = xcd_barrier_post((unsigned*)(ws + WS_CTL) + CW_BAR, MISC + 8);
#define IN(k) (lo <= (k) && (k) < hi)
#define SEAM(k) do { if (IN(k) && IN((k) + 1)) xcd_barrier(bar); } while (0)

    if (IN(0)) { ph_prep(C, L, a.in, ws); }
    SEAM(0);
    if (IN(1)) {
        pg8::Gemm g{(const f16*)(ws + WS_XH), (const f16*)(ws + WS_WCAT), T, NCAT, DM}; pg8::StaticOrder S; S.init(T, NCAT, G, (int)blockIdx.x);
        pg8::EpiP1 E{(const float*)(ws + WS_RS1), a.in[8], (f16*)(ws + WS_QKVU), (f16*)(ws + WS_GATES), (f16*)(ws + WS_VT)};
        pg8::gemm_phase<pg8::EpiP1, pg8::StaticOrder, true, true>(L, g, S, E);
    }
    SEAM(1);
    if (IN(2)) {
        ph_attn(C, (const f16*)(ws + WS_QKVU), (const f16*)(ws + WS_VT), a.in[3], (f16*)(ws + WS_OCAT));
        ph_pool(C, L, (const f16*)(ws + WS_QKVU), (const f16*)(ws + WS_POOLW), a.in[5], (f16*)(ws + WS_OCAT));
    }
    if (IN(2) && IN(4)) xcd_barrier(bar);
    if (IN(4)) {
        pg8::Gemm g{(const f16*)(ws + WS_OCAT), (const f16*)(ws + WS_WB), T, DM, DM}; pg8::StaticOrder S; S.init(T, DM, G, (int)blockIdx.x);
        pg8::EpiMerged E{(const f16*)(ws + WS_GATES), (f16*)(ws + WS_MERGED)};
        pg8::gemm_phase<pg8::EpiMerged, pg8::StaticOrder, true, true>(L, g, S, E);
    }
    SEAM(4);
    if (IN(5)) {
        pg8::Gemm g{(const f16*)(ws + WS_MERGED), (const f16*)(ws + WS_WOUT), T, DM, DM}; pg8::StaticOrder S; S.init(T, DM, G, (int)blockIdx.x);
        pg8::EpiOut E{a.in[0], a.in[10], a.out, (f16*)(ws + WS_X1H), (float*)(ws + WS_SS2)};
        pg8::gemm_phase<pg8::EpiOut, pg8::StaticOrder, true, true>(L, g, S, E);
    }
    SEAM(5);
    if (IN(6)) {
        pg8::Gemm g{(const f16*)(ws + WS_X1H), (const f16*)(ws + WS_WQ), T, 2048, DM}; pg8::StaticOrder S; S.init(T, 2048, G, (int)blockIdx.x);
        pg8::EpiQ E{(f16*)(ws + WS_QP)};
        pg8::gemm_phase<pg8::EpiQ, pg8::StaticOrder, true, true>(L, g, S, E);
    }
    SEAM(6);
    if (IN(7)) { ph_route(C, L, (const f16*)(ws + WS_QP), (const float*)(ws + WS_SS2), (const f16*)(ws + WS_SUBK), (int*)(ws + WS_EIDX), (float*)(ws + WS_EGATE)); }
    SEAM(7);
    if (IN(8)) { ph_gather(C, (const f16*)(ws + WS_X1H), (const float*)(ws + WS_SS2), (const int*)(ws + WS_EIDX), (const float*)(ws + WS_EGATE),
                           (const f16*)(ws + WS_UTAB), (const f16*)(ws + WS_VTAB), a.out, a.in[15]); }
#undef IN
#undef SEAM
}

#ifndef MK_N_LAUNCHES
#define MK_N_LAUNCHES 1
#endif
extern "C" void kernel_launch(void* const* d_in, const int* in_sizes, int n_in, void* d_out, int out_size, void* d_ws, size_t ws_size, hipStream_t stream) {
    static int grid = 0;
    if (grid == 0) {
        if (n_in != 16 || in_sizes[0] != T * DM || out_size != T * DM || ws_size < WS_END) {
            fprintf(stderr, "kernel_launch: unexpected shapes (n_in %d in0 %d out %d ws %zu)\n", n_in, n_in > 0 ? in_sizes[0] : -1, out_size, ws_size);
            grid = -1; return;
        }
        int dev = 0, cus = 0;
        if (hipGetDevice(&dev) != hipSuccess || hipDeviceGetAttribute(&cus, hipDeviceAttributeMultiprocessorCount, dev) != hipSuccess) { grid = -1; return; }
        if (hipFuncSetAttribute((const void*)mk_fwd, hipFuncAttributeMaxDynamicSharedMemorySize, LDS_BYTES) != hipSuccess) { fprintf(stderr, "kernel_launch: hipFuncSetAttribute failed\n"); grid = -1; return; }
        int per_cu = 0;
        if (hipOccupancyMaxActiveBlocksPerMultiprocessor(&per_cu, (const void*)mk_fwd, NTHREADS, LDS_BYTES) != hipSuccess || per_cu < 1)
            fprintf(stderr, "kernel_launch: occupancy query reports %d workgroups per CU\n", per_cu);
        (void)hipGetLastError();
        grid = cus;
    }
    if (grid < 0) return;
    (void)hipMemsetAsync((char*)d_ws + WS_CTL, 0, CTL_ZERO_BYTES, stream);
    Args a{};
    for (int i = 0; i < 16; ++i) a.in[i] = (const float*)d_in[i];
    a.out = (float*)d_out; a.ws = (unsigned char*)d_ws;
    if (MK_N_LAUNCHES == 1) {
        a.ph_lo = 0; a.ph_hi = N_PHASES;
        hipLaunchKernelGGL(mk_fwd, dim3(grid), dim3(NTHREADS), LDS_BYTES, stream, a);
    } else {
        for (int p = 0; p < N_PHASES; ++p) { a.ph_lo = p; a.ph_hi = p + 1; hipLaunchKernelGGL(mk_fwd, dim3(grid), dim3(NTHREADS), LDS_BYTES, stream, a); }
    }
}
```

```cpp
#include <hip/hip_runtime.h>
#include <cstdint>
#include <cstdio>

typedef _Float16 f16;
typedef _Float16 half8 __attribute__((ext_vector_type(8)));
typedef _Float16 half4 __attribute__((ext_vector_type(4)));
typedef _Float16 half2 __attribute__((ext_vector_type(2)));
typedef float f32x4 __attribute__((ext_vector_type(4)));
typedef float f32x16 __attribute__((ext_vector_type(16)));
#define LAS __attribute__((address_space(3)))
#ifndef PROBE_DUP
#define PROBE_DUP (-1)
#endif
#define GAS __attribute__((address_space(1)))

constexpr int DM = 1024, BATCH = 16, SEQ = 2048, T = BATCH * SEQ;
constexpr int NQKVU = 1280, NGATE = 2048, NCAT = NQKVU + NGATE;
constexpr int COL_K = 512, COL_V = 640, COL_U = 768;
constexpr int NEXP = 16384, PEER_H = 8, TOPK = 16;
constexpr float EPS = 1e-6f;
constexpr int NWAVES = 8, NTHREADS = NWAVES * 64;

constexpr size_t MiB = 1u << 20;
constexpr size_t WS_CTL = 0, CTL_ZERO_BYTES = 64 * 1024;
constexpr size_t WS_WCAT = 1 * MiB;
constexpr size_t WS_WB = 8 * MiB;
constexpr size_t WS_WOUT = 10 * MiB;
constexpr size_t WS_WQ = 12 * MiB;
constexpr size_t WS_POOLW = 16 * MiB;
constexpr size_t WS_SUBK = 16 * MiB + 512 * 1024;
constexpr size_t WS_RS1 = 17 * MiB;
constexpr size_t WS_EIDX = 18 * MiB;
constexpr size_t WS_EGATE = 34 * MiB;
constexpr size_t WS_UTAB = 50 * MiB;
constexpr size_t WS_VTAB = 82 * MiB;
constexpr size_t WS_XH = 114 * MiB;
constexpr size_t WS_MERGED = WS_XH;
constexpr size_t WS_QKVU = 178 * MiB;
constexpr size_t WS_X1H = WS_QKVU;
constexpr size_t WS_GATES = 258 * MiB;
constexpr size_t WS_QP = WS_GATES;
constexpr size_t WS_OCAT = 386 * MiB;
constexpr size_t WS_UQ = 450 * MiB;
constexpr size_t WS_VQ = 466 * MiB;
constexpr size_t WS_US = 17 * MiB + 256 * 1024, WS_VS = 17 * MiB + 512 * 1024;
constexpr size_t WS_SSF = 402 * MiB;
constexpr size_t WS_ACT = 386 * MiB;
constexpr size_t WS_SS2 = 482 * MiB;
constexpr size_t WS_VT = 484 * MiB;
constexpr size_t WS_END = 492 * MiB;
constexpr int CW_BAR = 4096;

constexpr int RING_OFF = 0, RING_BYTES = 131072;
constexpr int LDSCTL_OFF = RING_BYTES, MISC_OFF = LDSCTL_OFF + 320;
constexpr int LDS_BYTES = 147456;

#define LDS_WAIT() asm volatile("s_waitcnt lgkmcnt(0)" ::: "memory")
__device__ __forceinline__ float wave_sum(float v) {
#pragma unroll
    for (int o = 1; o < 64; o <<= 1) v += __shfl_xor(v, o);
    return v;
}
__device__ __forceinline__ float gelu_exact(float x) { return 0.5f * x * (1.0f + erff(x * 0.70710678118654752f)); }
__device__ __forceinline__ float rs_from_ss(const float* ss, int t) {
    float s = 0.f;
#pragma unroll
    for (int i = 0; i < 16; ++i) s += ss[(size_t)i * T + t];
    return rsqrtf(s * (1.0f / DM) + EPS);
}

struct Ctx {
    int tid, lane, wave;
    int G;
    int gw, ngw;
    int gt, ngt;
};

__device__ __forceinline__ float wave_max(float v) {
#pragma unroll
    for (int o = 1; o < 64; o <<= 1) v = fmaxf(v, __shfl_xor(v, o));
    return v;
}
__device__ __forceinline__ int wave_sum_i(int v) {
#pragma unroll
    for (int o = 1; o < 64; o <<= 1) v += __shfl_xor(v, o);
    return v;
}
__device__ __forceinline__ int pack4_i8(float a, float b, float c, float d) {
    const int ia = (int)rintf(a), ib = (int)rintf(b), ic = (int)rintf(c), id = (int)rintf(d);
    return (ia & 0xff) | ((ib & 0xff) << 8) | ((ic & 0xff) << 16) | (id << 24);
}
template <bool OFFS>
__device__ __forceinline__ void quant_rows(const Ctx& C, const float* __restrict__ tab, unsigned* __restrict__ q, float* __restrict__ scale) {
    const int lane = C.lane;
    for (int r = C.gw; r < NEXP; r += C.ngw) {
        const float* row = tab + (size_t)r * DM;
        f32x4 v[4]; float m = 0.f;
#pragma unroll
        for (int j = 0; j < 4; ++j) { v[j] = *(const f32x4*)(row + j * 256 + lane * 4); m = fmaxf(m, fmaxf(fmaxf(fabsf(v[j][0]), fabsf(v[j][1])), fmaxf(fabsf(v[j][2]), fabsf(v[j][3])))); }
        m = wave_max(m);
        const float inv = m > 0.f ? 127.0f / m : 0.f;
#pragma unroll
        for (int j = 0; j < 4; ++j) {
            unsigned w = (unsigned)pack4_i8(v[j][0] * inv, v[j][1] * inv, v[j][2] * inv, v[j][3] * inv);
            if (OFFS) w ^= 0x80808080u;
            q[(size_t)r * 256 + j * 64 + lane] = w;
        }
        if (lane == 0) scale[r] = m * (1.0f / 127.0f);
    }
}

__device__ __forceinline__ void p0_transpose_item(const float* W, int K, int N, f16* WT, int ldo, int koff, LAS float* scr, int item, int lane) {
    const int nblk = N / 32, kb = item / nblk, nb = item % nblk, k0 = 64 * kb, n0 = 32 * nb;
#pragma unroll 8
    for (int i = 0; i < 32; ++i) { const int kk = 2 * i + (lane >> 5); scr[kk * 33 + (lane & 31)] = W[(size_t)(k0 + kk) * N + n0 + (lane & 31)]; }
    LDS_WAIT(); asm volatile("" ::: "memory");
    const int c = lane & 7;
#pragma unroll
    for (int j = 0; j < 4; ++j) { const int n = (lane >> 3) + 8 * j; const LAS float* s = scr + (8 * c) * 33 + n;
        half8 o;
#pragma unroll
        for (int i = 0; i < 8; ++i) o[i] = (f16)s[i * 33];
        *(half8*)(WT + (size_t)(n0 + n) * ldo + koff + k0 + 8 * c) = o; }
    LDS_WAIT(); asm volatile("" ::: "memory");
}
__device__ __forceinline__ void cvt_stream(const Ctx& C, const float* in, f16* out, size_t n4) {
    for (size_t i = (size_t)C.gt; i < n4; i += (size_t)C.ngt) {
        const f32x4 v = ((const f32x4*)in)[i];
        half4 h; h[0] = (f16)v[0]; h[1] = (f16)v[1]; h[2] = (f16)v[2]; h[3] = (f16)v[3];
        ((half4*)out)[i] = h;
    }
}
__device__ __forceinline__ void rowprep(const Ctx& C, const float* x, const float* g, f16* xh, float* ss) {
    const int lane = C.lane;
    for (int t = C.gw; t < T; t += C.ngw) {
        const float* xr = x + (size_t)t * DM;
        float s = 0.f;
#pragma unroll
        for (int j = 0; j < 4; ++j) {
            const f32x4 v = *(const f32x4*)(xr + j * 256 + lane * 4);
            const f32x4 gg = *(const f32x4*)(g + j * 256 + lane * 4);
            s += v[0] * v[0] + v[1] * v[1] + v[2] * v[2] + v[3] * v[3];
            half4 h; h[0] = (f16)(v[0] * gg[0]); h[1] = (f16)(v[1] * gg[1]); h[2] = (f16)(v[2] * gg[2]); h[3] = (f16)(v[3] * gg[3]);
            *(half4*)(xh + (size_t)t * DM + j * 256 + lane * 4) = h;
        }
        s = wave_sum(s);
        if (lane == 0) ss[t] = s;
    }
}
__device__ __forceinline__ void ph_prep(const Ctx& C, LAS unsigned char* lds, const float* const* in, unsigned char* ws) {
    LAS float* scr = (LAS float*)(lds + RING_OFF + C.wave * 16384);
    f16* wcat = (f16*)(ws + WS_WCAT); f16* wb = (f16*)(ws + WS_WB); f16* wout = (f16*)(ws + WS_WOUT); f16* wq = (f16*)(ws + WS_WQ); f16* poolw = (f16*)(ws + WS_POOLW);
    constexpr int I_IN = 16 * 40, I_G = 16 * 64, I_B = 8 * 32, I_O = 16 * 32, I_Q = 16 * 64, I_P = 2 * 4;
    constexpr int NITEMS = I_IN + I_G + 2 * I_B + I_O + I_Q + 4 * I_P;
    for (int it = C.gw; it < NITEMS; it += C.ngw) {
        int r = it;
        if (r < I_IN) { p0_transpose_item(in[2], 1024, 1280, wcat, 1024, 0, scr, r, C.lane); continue; } r -= I_IN;
        if (r < I_G) { p0_transpose_item(in[7], 1024, 2048, wcat + (size_t)NQKVU * 1024, 1024, 0, scr, r, C.lane); continue; } r -= I_G;
        if (r < I_B) { p0_transpose_item(in[6], 512, 1024, wb, 1024, 0, scr, r, C.lane); continue; } r -= I_B;
        if (r < I_B) { p0_transpose_item(in[6] + 512 * 1024, 512, 1024, wb, 1024, 512, scr, r, C.lane); continue; } r -= I_B;
        if (r < I_O) { p0_transpose_item(in[9], 1024, 1024, wout, 1024, 0, scr, r, C.lane); continue; } r -= I_O;
        if (r < I_Q) { p0_transpose_item(in[11], 1024, 2048, wq, 1024, 0, scr, r, C.lane); continue; } r -= I_Q;
        { const int g = r / I_P; p0_transpose_item(in[4] + g * 128 * 128, 128, 128, poolw + g * 128 * 128, 128, 0, scr, r % I_P, C.lane); }
    }
    cvt_stream(C, in[12], (f16*)(ws + WS_SUBK), (size_t)8 * 2 * 128 * 128 / 4);
    quant_rows<false>(C, in[13], (unsigned*)(ws + WS_UQ), (float*)(ws + WS_US));
    quant_rows<true>(C, in[14], (unsigned*)(ws + WS_VQ), (float*)(ws + WS_VS));
    rowprep(C, in[0], in[1], (f16*)(ws + WS_XH), (float*)(ws + WS_RS1));
}

__device__ __forceinline__ void ph_attn_naive(const Ctx& C, const f16* __restrict__ qkvu, const float* __restrict__ sink, f16* __restrict__ ocat) {
    for (int gid = C.gt; gid < T * 8; gid += C.ngt) {
        const int t = gid % T, h = gid / T;
        const int b = t / SEQ, ts = t % SEQ, kh = h >> 2;
        float q[64], o[64];
        const f16* qr = qkvu + (size_t)t * NQKVU + h * 64;
#pragma unroll
        for (int d = 0; d < 64; ++d) { q[d] = (float)qr[d]; o[d] = 0.f; }
        const float slope = exp2f(-(float)(h + 1));
        float m = -1e30f, l = 0.f;
        const int s0 = max(ts - 128, 0), s1 = min(ts + 128, SEQ - 1);
        for (int s = s0; s <= s1; ++s) {
            const f16* kr = qkvu + (size_t)(b * SEQ + s) * NQKVU + COL_K + kh * 64;
            const f16* vr = qkvu + (size_t)(b * SEQ + s) * NQKVU + COL_V + kh * 64;
            float dot = 0.f;
#pragma unroll
            for (int d = 0; d < 64; ++d) dot += q[d] * (float)kr[d];
            const float lg = dot * 0.125f - slope * fabsf((float)(ts - s));
            const float mn = fmaxf(m, lg), al = __expf(m - mn), p = __expf(lg - mn);
            l = l * al + p;
#pragma unroll
            for (int d = 0; d < 64; ++d) o[d] = o[d] * al + p * (float)vr[d];
            m = mn;
        }
        const float sk = sink[h];
        const float mn = fmaxf(m, sk), al = __expf(m - mn);
        l = l * al + __expf(sk - mn);
        const float inv = al / l;
        f16* orow = ocat + (size_t)t * DM + h * 64;
#pragma unroll
        for (int d = 0; d < 64; ++d) orow[d] = (f16)(o[d] * inv);
    }
}

__device__ __forceinline__ void ph_attn(const Ctx& C, const f16* __restrict__ qkvu, const f16* __restrict__ vT, const float* __restrict__ sink, f16* __restrict__ ocat) {
    const int lane = C.lane, r32 = lane & 31, hh = lane >> 5;
    const int krow = (r32 & 19) | ((r32 & 4) << 1) | ((r32 & 8) >> 1);
    constexpr float L2E = 1.4426950408889634f;
    for (int u = C.gw; u < BATCH * 8 * 64; u += C.ngw) {
        const int qs = u & 63, h = (u >> 6) & 7, b = u >> 9, kh = h >> 2;
        const int tq = qs * 32 + r32;
        const float slope2 = exp2f(-(float)(h + 1)) * L2E, sink2 = sink[h] * L2E;
        const f16* qrow = qkvu + (size_t)(b * SEQ + tq) * NQKVU + h * 64 + 8 * hh;
        half8 bq[4];
#pragma unroll
        for (int ks = 0; ks < 4; ++ks) bq[ks] = *(const half8*)(qrow + 16 * ks);
        f32x16 o0, o1;
#pragma unroll
        for (int r = 0; r < 16; ++r) { o0[r] = 0.f; o1[r] = 0.f; }
        float m = -1e30f, l = 0.f;
        const int kb_lo = max(qs - 4, 0), kb_hi = min(qs + 4, 63);
        const f16* vbase = vT + (size_t)((b * 2 + kh) * 64 + r32) * SEQ + 8 * hh;
#pragma unroll 1
        for (int kb = kb_lo; kb <= kb_hi; ++kb) {
            const f16* kr = qkvu + (size_t)(b * SEQ + kb * 32 + krow) * NQKVU + COL_K + kh * 64 + 8 * hh;
            f32x16 s;
#pragma unroll
            for (int r = 0; r < 16; ++r) s[r] = 0.f;
#pragma unroll
            for (int ks = 0; ks < 4; ++ks) { const half8 ak = *(const half8*)(kr + 16 * ks); s = __builtin_amdgcn_mfma_f32_32x32x16_f16(ak, bq[ks], s, 0, 0, 0); }
            half8 va[2][2];
#pragma unroll
            for (int db = 0; db < 2; ++db)
#pragma unroll
                for (int st = 0; st < 2; ++st) va[db][st] = *(const half8*)(vbase + (size_t)(db * 32) * SEQ + kb * 32 + 16 * st);
            float bmax = -1e30f; bool ok[16];
#pragma unroll
            for (int r = 0; r < 16; ++r) {
                const int tk = kb * 32 + 16 * (r >> 3) + 8 * hh + (r & 7);
                const int dist = abs(tq - tk);
                ok[r] = dist <= 128;
                s[r] = ok[r] ? s[r] * (0.125f * L2E) - slope2 * (float)dist : -1e30f;
                bmax = fmaxf(bmax, s[r]);
            }
            bmax = fmaxf(bmax, __shfl_xor(bmax, 32));
            const float mn = fmaxf(m, bmax), al = exp2f(m - mn);
            m = mn;
            float ps = 0.f; half8 pb[2];
#pragma unroll
            for (int r = 0; r < 16; ++r) { const float p = ok[r] ? exp2f(s[r] - mn) : 0.f; ps += p; pb[r >> 3][r & 7] = (f16)p; }
            l = l * al + ps;
#pragma unroll
            for (int r = 0; r < 16; ++r) { o0[r] *= al; o1[r] *= al; }
#pragma unroll
            for (int st = 0; st < 2; ++st) { o0 = __builtin_amdgcn_mfma_f32_32x32x16_f16(va[0][st], pb[st], o0, 0, 0, 0); o1 = __builtin_amdgcn_mfma_f32_32x32x16_f16(va[1][st], pb[st], o1, 0, 0, 0); }
        }
        l += __shfl_xor(l, 32);
        const float mf = fmaxf(m, sink2), al = exp2f(m - mf);
        const float sc = al / (l * al + exp2f(sink2 - mf));
        f16* orow = ocat + (size_t)(b * SEQ + tq) * DM + h * 64 + 4 * hh;
#pragma unroll
        for (int g = 0; g < 4; ++g) {
            half4 a, c;
#pragma unroll
            for (int i = 0; i < 4; ++i) { a[i] = (f16)(o0[4 * g + i] * sc); c[i] = (f16)(o1[4 * g + i] * sc); }
            *(half4*)(orow + 8 * g) = a; *(half4*)(orow + 32 + 8 * g) = c;
        }
    }
}

__device__ __forceinline__ void ph_pool_naive(const Ctx& C, const f16* __restrict__ qkvu, f16* __restrict__ mixed) {
    for (size_t gid = (size_t)C.gt; gid < (size_t)T * 512; gid += (size_t)C.ngt) {
        const int c = (int)(gid & 511), t = (int)(gid >> 9);
        const int b = t / SEQ, ts = t % SEQ, g = c >> 7, w = 2 << g;
        const int lo = max(ts - w / 2, 0), hi = min(ts + w / 2, SEQ);
        float s = 0.f;
        for (int i = lo; i < hi; ++i) s += (float)qkvu[(size_t)(b * SEQ + i) * NQKVU + COL_U + c];
        const float mean = s / (float)(hi - lo);
        mixed[(size_t)t * 512 + c] = (f16)(mean - (float)qkvu[(size_t)t * NQKVU + COL_U + c]);
    }
}
__device__ __forceinline__ void ph_poolmm_naive(const Ctx& C, const f16* __restrict__ mixed, const f16* __restrict__ poolw_t, const float* __restrict__ pscale, f16* __restrict__ ocat) {
    for (size_t gid = (size_t)C.gt; gid < (size_t)T * 512; gid += (size_t)C.ngt) {
        const int n = (int)(gid & 511), t = (int)(gid >> 9), g = n >> 7, d = n & 127;
        const f16* mr = mixed + (size_t)t * 512 + g * 128;
        const f16* wr = poolw_t + (size_t)(g * 128 + d) * 128;
        float acc = 0.f;
        for (int c = 0; c < 128; ++c) acc += (float)mr[c] * (float)wr[c];
        ocat[(size_t)t * DM + 512 + n] = (f16)(acc * pscale[n]);
    }
}

__device__ __forceinline__ void ph_pool(const Ctx& C, LAS unsigned char* lds, const f16* __restrict__ qkvu, const f16* __restrict__ poolw_t, const float* __restrict__ pscale, f16* __restrict__ ocat) {
    const int tid = C.tid, lane = C.lane, wv = C.wave, r32 = lane & 31, hh = lane >> 5;
    for (int u = blockIdx.x; u < (T / 128) * 4; u += C.G) {
        const int g = u & 3, t0 = (u >> 2) * 128, b = t0 >> 11, hw = 1 << g;
        {
            const int c2 = tid & 63, sf = (t0 & (SEQ - 1)) + wv * 16;
            const f16* ub = qkvu + (size_t)(b * SEQ) * NQKVU + COL_U + g * 128 + 2 * c2;
            float s0 = 0.f, s1 = 0.f;
            for (int s = max(sf - hw, 0); s < min(sf + hw, SEQ); ++s) { const half2 v = *(const half2*)(ub + (size_t)s * NQKVU); s0 += (float)v[0]; s1 += (float)v[1]; }
#pragma unroll 4
            for (int i = 0; i < 16; ++i) {
                const int s = sf + i, lo = max(s - hw, 0), hi = min(s + hw, SEQ);
                const float inv = 1.0f / (float)(hi - lo);
                const half2 cur = *(const half2*)(ub + (size_t)s * NQKVU);
                half2 mx; mx[0] = (f16)(s0 * inv - (float)cur[0]); mx[1] = (f16)(s1 * inv - (float)cur[1]);
                const int tl = wv * 16 + i;
                *(LAS half2*)(lds + tl * 256 + (((c2 >> 2) ^ (tl & 15)) << 4) + ((c2 & 3) << 2)) = mx;
                if (s + hw < SEQ) { const half2 v = *(const half2*)(ub + (size_t)(s + hw) * NQKVU); s0 += (float)v[0]; s1 += (float)v[1]; }
                if (s - hw >= 0) { const half2 v = *(const half2*)(ub + (size_t)(s - hw) * NQKVU); s0 -= (float)v[0]; s1 -= (float)v[1]; }
            }
        }
        __syncthreads();
        {
            const int tb = (wv & 3) * 32, d0 = (wv >> 2) * 64, tl = tb + r32;
            f32x16 acc0, acc1;
#pragma unroll
            for (int r = 0; r < 16; ++r) { acc0[r] = 0.f; acc1[r] = 0.f; }
            const f16* wr = poolw_t + (size_t)(g * 128 + d0 + r32) * 128 + 8 * hh;
#pragma unroll
            for (int ks = 0; ks < 8; ++ks) {
                const half8 bm = *(const LAS half8*)(lds + tl * 256 + (((2 * ks + hh) ^ (tl & 15)) << 4));
                const half8 a0 = *(const half8*)(wr + 16 * ks), a1 = *(const half8*)(wr + 32 * 128 + 16 * ks);
                acc0 = __builtin_amdgcn_mfma_f32_32x32x16_f16(a0, bm, acc0, 0, 0, 0);
                acc1 = __builtin_amdgcn_mfma_f32_32x32x16_f16(a1, bm, acc1, 0, 0, 0);
            }
            f16* orow = ocat + (size_t)(t0 + tl) * DM + 512 + g * 128 + d0 + 4 * hh;
            const float* ps = pscale + g * 128 + d0 + 4 * hh;
#pragma unroll
            for (int q = 0; q < 4; ++q) {
                const f32x4 p0 = *(const f32x4*)(ps + 8 * q), p1 = *(const f32x4*)(ps + 32 + 8 * q);
                half4 x0, x1;
#pragma unroll
                for (int i = 0; i < 4; ++i) { x0[i] = (f16)(acc0[4 * q + i] * p0[i]); x1[i] = (f16)(acc1[4 * q + i] * p1[i]); }
                *(half4*)(orow + 8 * q) = x0; *(half4*)(orow + 32 + 8 * q) = x1;
            }
        }
        __syncthreads();
    }
}

#define INS(LV, LI, v_, i_) do { float cv_ = (v_); int ci_ = (i_); \
    _Pragma("unroll") for (int z_ = 0; z_ < 16; ++z_) { const bool gt_ = cv_ > LV[z_]; const float tv_ = gt_ ? LV[z_] : cv_; const int ti_ = gt_ ? LI[z_] : ci_; \
        LV[z_] = gt_ ? cv_ : LV[z_]; LI[z_] = gt_ ? ci_ : LI[z_]; cv_ = tv_; ci_ = ti_; } } while (0)
__device__ __forceinline__ void ph_route_naive(const Ctx& C, const f16* __restrict__ qp, const float* __restrict__ ss2, const f16* __restrict__ subk, int* __restrict__ eidx, float* __restrict__ egate) {
    for (int gid = C.gt; gid < T * 8; gid += C.ngt) {
        const int t = gid % T, h = gid / T;
        const float rs2 = rs_from_ss(ss2, t);
        float av[16], bv[16]; int ai[16], bi[16];
#pragma unroll
        for (int z = 0; z < 16; ++z) { av[z] = -3e38f; bv[z] = -3e38f; ai[z] = 0; bi[z] = 0; }
        for (int p = 0; p < 2; ++p) {
            const f16* qr = qp + (size_t)t * 2048 + h * 256 + p * 128;
            for (int n = 0; n < 128; ++n) {
                const f16* kr = subk + ((size_t)((h * 2 + p) * 128 + n)) * 128;
                float dot = 0.f;
                for (int c = 0; c < 128; ++c) dot += (float)qr[c] * (float)kr[c];
                dot *= rs2;
                if (p == 0) INS(av, ai, dot, n); else INS(bv, bi, dot, n);
            }
        }
        float cv[16]; int ci[16];
#pragma unroll
        for (int z = 0; z < 16; ++z) { cv[z] = -3e38f; ci[z] = 0; }
#pragma unroll
        for (int i = 0; i < 16; ++i)
#pragma unroll
            for (int j = 0; j < 16; ++j)
                if ((i + 1) * (j + 1) <= 16) INS(cv, ci, av[i] + bv[j], ai[i] * 128 + bi[j]);
        float sum = 0.f, e[16];
#pragma unroll
        for (int z = 0; z < 16; ++z) { e[z] = __expf(cv[z] - cv[0]); sum += e[z]; }
        const float inv = 1.0f / sum;
#pragma unroll
        for (int z = 0; z < 16; ++z) { eidx[(size_t)t * 128 + h * 16 + z] = ci[z]; egate[(size_t)t * 128 + h * 16 + z] = e[z] * inv; }
    }
}

__device__ __forceinline__ int mono_i(float f) { const int b = __float_as_int(f); return b ^ ((b >> 31) & 0x7fffffff); }
__device__ __forceinline__ float unmono_f(int m) { return __int_as_float(m ^ ((m >> 31) & 0x7fffffff)); }
#define INS16(Lst, x_) do { int xv_ = (x_); _Pragma("unroll") for (int z_ = 0; z_ < 16; ++z_) { const int hi_ = max(Lst[z_], xv_); xv_ = min(Lst[z_], xv_); Lst[z_] = hi_; } } while (0)
__device__ __forceinline__ void merge_pair16(int (&Lst)[16]) {
    int P[16];
#pragma unroll
    for (int z = 0; z < 16; ++z) P[z] = __shfl_xor(Lst[z], 32);
#pragma unroll
    for (int z = 0; z < 16; ++z) Lst[z] = max(Lst[z], P[15 - z]);
#pragma unroll
    for (int s = 8; s >= 1; s >>= 1)
#pragma unroll
        for (int i = 0; i < 16; ++i) if ((i & s) == 0) { const int hi = max(Lst[i], Lst[i + s]), lo = min(Lst[i], Lst[i + s]); Lst[i] = hi; Lst[i + s] = lo; }
}
__device__ __forceinline__ void ph_route(const Ctx& C, LAS unsigned char* lds, const f16* __restrict__ qp, const float* __restrict__ ss2, const f16* __restrict__ subk,
                                         int* __restrict__ eidx, float* __restrict__ egate) {
    const int lane = C.lane, r32 = lane & 31, hh = lane >> 5;
    LAS unsigned char* tab = lds + C.wave * 4096 + lane * 36;
    for (int u = C.gw; u < (T / 32) * 8; u += C.ngw) {
        const int h = u & 7, t0 = (u >> 3) * 32, t = t0 + r32;
        const float rs2 = rs_from_ss(ss2, t);
        int top[2][16];
#pragma unroll
        for (int p = 0; p < 2; ++p) {
            const f16* qrow = qp + (size_t)t * 2048 + h * 256 + p * 128 + 8 * hh;
            const f16* kbase = subk + (size_t)((h * 2 + p) * 128 + r32) * 128 + 8 * hh;
            half8 bq[8];
#pragma unroll
            for (int ks = 0; ks < 8; ++ks) bq[ks] = *(const half8*)(qrow + 16 * ks);
            int Lst[16];
#pragma unroll
            for (int z = 0; z < 16; ++z) Lst[z] = (int)0x80000000;
#pragma unroll 1
            for (int nb = 0; nb < 4; ++nb) {
                f32x16 acc = {0.f, 0.f, 0.f, 0.f, 0.f, 0.f, 0.f, 0.f, 0.f, 0.f, 0.f, 0.f, 0.f, 0.f, 0.f, 0.f};
#pragma unroll
                for (int ks = 0; ks < 8; ++ks) {
                    const half8 ak = *(const half8*)(kbase + (size_t)(nb * 32) * 128 + 16 * ks);
                    acc = __builtin_amdgcn_mfma_f32_32x32x16_f16(ak, bq[ks], acc, 0, 0, 0);
                }
#pragma unroll
                for (int r = 0; r < 16; ++r) {
                    const int n = nb * 32 + (r & 3) + 8 * (r >> 2) + 4 * hh;
                    const int key = (mono_i(acc[r] * rs2) & ~127) | (127 - n);
                    INS16(Lst, key);
                }
            }
            merge_pair16(Lst);
#pragma unroll
            for (int z = 0; z < 16; ++z) top[p][z] = Lst[z];
        }
        float va[16], vb[16];
#pragma unroll
        for (int z = 0; z < 16; ++z) { va[z] = unmono_f(top[0][z] & ~127); vb[z] = unmono_f(top[1][z] & ~127);
            tab[z] = (unsigned char)(127 - (top[0][z] & 127)); tab[16 + z] = (unsigned char)(127 - (top[1][z] & 127)); }
        int Cl[16];
#pragma unroll
        for (int z = 0; z < 16; ++z) Cl[z] = (int)0x80000000;
#pragma unroll
        for (int i = 0; i < 16; ++i)
#pragma unroll
            for (int j = 0; j < 16; ++j)
                if ((i + 1) * (j + 1) <= 16) { const int key = (mono_i(va[i] + vb[j]) & ~255) | (255 - (i * 16 + j)); INS16(Cl, key); }
        float e[16], sum = 0.f; const float mx = unmono_f(Cl[0] & ~255);
#pragma unroll
        for (int z = 0; z < 16; ++z) { e[z] = __expf(unmono_f(Cl[z] & ~255) - mx); sum += e[z]; }
        const float inv = 1.0f / sum;
        LDS_WAIT();
        int* ei = eidx + (size_t)t * 128 + h * 16 + 8 * hh; float* eg = egate + (size_t)t * 128 + h * 16 + 8 * hh;
#pragma unroll
        for (int z = 0; z < 16; ++z) {
            if ((z >> 3) == hh) { const int code = 255 - (Cl[z] & 255); const int ia = tab[code >> 4], ib = tab[16 + (code & 15)];
                ei[z & 7] = ia * 128 + ib; eg[z & 7] = e[z] * inv; }
        }
        LDS_WAIT();
    }
}

typedef unsigned u32x4 __attribute__((ext_vector_type(4)));
constexpr int USLOTS = 24;
struct UEnt { int ent; int cnt; float us, gate; };
__device__ __forceinline__ UEnt u_build(int t, int s, int e0, int e1, const float* __restrict__ us, const float* __restrict__ egate, volatile LAS int* scr, int lane) {
    const bool m0 = (e0 >> 11) == s, m1 = (e1 >> 11) == s;
    const unsigned long long b0 = __ballot(m0), b1 = __ballot(m1);
    const int c0 = __builtin_popcountll(b0), cnt = c0 + __builtin_popcountll(b1);
    const int p0 = __builtin_amdgcn_mbcnt_hi((unsigned)(b0 >> 32), __builtin_amdgcn_mbcnt_lo((unsigned)b0, 0));
    const int p1 = c0 + __builtin_amdgcn_mbcnt_hi((unsigned)(b1 >> 32), __builtin_amdgcn_mbcnt_lo((unsigned)b1, 0));
    if (m0 && p0 < 64) scr[p0] = lane | (e0 << 8);
    if (m1 && p1 < 64) scr[p1] = (64 + lane) | (e1 << 8);
    LDS_WAIT();
    UEnt r; r.cnt = cnt;
    r.ent = (lane < cnt) ? scr[lane] : 0;
    LDS_WAIT();
    r.us = 0.f; r.gate = 0.f;
    return r;
}
__device__ __forceinline__ void u_gather(UEnt& r, int t, const float* __restrict__ us, const float* __restrict__ egate, int lane) {
    const bool act_l = lane < r.cnt && lane < USLOTS;
    r.us = act_l ? us[r.ent >> 8] : 0.f;
    r.gate = act_l ? egate[(size_t)t * 128 + (r.ent & 127)] : 0.f;
}
__device__ __forceinline__ void u_quant(const half8 h0, const half8 h1, float rs2, int (&hq)[4], float& sc) {
    float hm = 0.f;
#pragma unroll
    for (int i = 0; i < 8; ++i) hm = fmaxf(hm, fmaxf(fabsf((float)h0[i]), fabsf((float)h1[i])));
    hm = wave_max(hm);
    const float inv = hm > 0.f ? 127.0f / hm : 0.f;
    sc = hm * (1.0f / 127.0f) * rs2;
    hq[0] = pack4_i8((float)h0[0] * inv, (float)h0[1] * inv, (float)h0[2] * inv, (float)h0[3] * inv);
    hq[1] = pack4_i8((float)h0[4] * inv, (float)h0[5] * inv, (float)h0[6] * inv, (float)h0[7] * inv);
    hq[2] = pack4_i8((float)h1[0] * inv, (float)h1[1] * inv, (float)h1[2] * inv, (float)h1[3] * inv);
    hq[3] = pack4_i8((float)h1[4] * inv, (float)h1[5] * inv, (float)h1[6] * inv, (float)h1[7] * inv);
}
__device__ __forceinline__ int u_dot(const u32x4 r, const int (&hq)[4]) {
    int p = __builtin_amdgcn_sdot4((int)r[0], hq[0], 0, false); p = __builtin_amdgcn_sdot4((int)r[1], hq[1], p, false);
    p = __builtin_amdgcn_sdot4((int)r[2], hq[2], p, false); return __builtin_amdgcn_sdot4((int)r[3], hq[3], p, false);
}
struct Slicing { int m, pi, nloc, rank; };
__device__ __forceinline__ Slicing get_slicing(const unsigned* bar, volatile LAS unsigned* misc) {
    Slicing S; const unsigned x = (unsigned)__builtin_amdgcn_s_getreg((3 << 11) | 20) & 0xFu;
    int m = 0, pi = 0, nloc = 1;
    for (unsigned j = 0; j < 16; ++j) { const unsigned c = __hip_atomic_load(&bar[256 + 64 * j], __ATOMIC_RELAXED, __HIP_MEMORY_SCOPE_AGENT); if (c > 0u) { if (j < x) ++pi; ++m; } if (j == x) nloc = (int)c; }
    S.m = m > 0 ? m : 1; S.pi = pi; S.nloc = nloc > 0 ? nloc : 1; S.rank = (int)misc[10];
    return S;
}
__device__ __forceinline__ void ph_upeer(const Ctx& C, LAS unsigned char* lds, const Slicing SL, const f16* __restrict__ x1h, const float* __restrict__ ss2, const int* __restrict__ eidx, const float* __restrict__ egate,
                                         const unsigned char* __restrict__ uq, const float* __restrict__ us, float* __restrict__ act) {
    const int lane = C.lane;
    const bool hh = (lane & 32) != 0, b4 = (lane & 16) != 0, b3 = (lane & 8) != 0;
    const int j7 = lane & 7, srcl = 32 * (j7 >> 2) + 16 * ((j7 >> 1) & 1) + 8 * (j7 & 1);
    const int wv = SL.rank * NWAVES + C.wave, nwv = SL.nloc * NWAVES;
    volatile LAS int* scr = (volatile LAS int*)(lds + C.wave * 1024);
  for (int s = SL.pi; s < 8; s += SL.m) {
    const int ntok = (T - wv + nwv - 1) / nwv;
    auto tok = [&](int i) { const int t = wv + i * nwv; return t < T ? t : T - 1; };
    int tA = tok(0), tB = tok(1), tC = tok(2);
    UEnt cur = u_build(tA, s, eidx[(size_t)tA * 128 + lane], eidx[(size_t)tA * 128 + 64 + lane], us, egate, scr, lane);
    UEnt nxt = u_build(tB, s, eidx[(size_t)tB * 128 + lane], eidx[(size_t)tB * 128 + 64 + lane], us, egate, scr, lane);
    if (ntok < 2) nxt.cnt = 0;
    u_gather(cur, tA, us, egate, lane);
    int hq[4]; float sc;
    u_quant(*(const half8*)(x1h + (size_t)tA * DM + 16 * lane), *(const half8*)(x1h + (size_t)tA * DM + 16 * lane + 8), rs_from_ss(ss2, tA), hq, sc);
    u32x4 r[USLOTS];
#pragma unroll
    for (int j = 0; j < USLOTS; ++j) { const int e = __builtin_amdgcn_readlane(cur.ent, j < cur.cnt ? j : 0) >> 8; r[j] = *(const u32x4*)(uq + (size_t)e * DM + 16 * lane); }
    int ne0 = eidx[(size_t)tC * 128 + lane], ne1 = eidx[(size_t)tC * 128 + 64 + lane];
    half8 nh0 = *(const half8*)(x1h + (size_t)tB * DM + 16 * lane), nh1 = *(const half8*)(x1h + (size_t)tB * DM + 16 * lane + 8);
    float nrs2 = rs_from_ss(ss2, tB);
#pragma unroll 1
    for (int i = 0; i < ntok; ++i) {
        const int t = tok(i), t2 = tok(i + 2), t3 = tok(i + 3);
        const int ze0 = eidx[(size_t)t3 * 128 + lane], ze1 = eidx[(size_t)t3 * 128 + 64 + lane];
        const half8 zh0 = *(const half8*)(x1h + (size_t)t2 * DM + 16 * lane), zh1 = *(const half8*)(x1h + (size_t)t2 * DM + 16 * lane + 8);
        const float zrs2 = rs_from_ss(ss2, t2);
        u_gather(nxt, tok(i + 1), us, egate, lane);
        int tot = 0;
#pragma unroll
        for (int g = 0; g < USLOTS / 8; ++g) {
            int p[8];
#pragma unroll
            for (int jj = 0; jj < 8; ++jj) {
                const int j = g * 8 + jj;
                p[jj] = u_dot(r[j], hq);
                const int e = __builtin_amdgcn_readlane(nxt.ent, j < nxt.cnt ? j : 0) >> 8;
                r[j] = *(const u32x4*)(uq + (size_t)e * DM + 16 * lane);
            }
            int q4[4], q2[2], q1;
#pragma unroll
            for (int k = 0; k < 4; ++k) { const int mine = hh ? p[4 + k] : p[k], oth = hh ? p[k] : p[4 + k]; q4[k] = mine + __shfl_xor(oth, 32); }
#pragma unroll
            for (int k = 0; k < 2; ++k) { const int mine = b4 ? q4[2 + k] : q4[k], oth = b4 ? q4[k] : q4[2 + k]; q2[k] = mine + __shfl_xor(oth, 16); }
            { const int mine = b3 ? q2[1] : q2[0], oth = b3 ? q2[0] : q2[1]; q1 = mine + __shfl_xor(oth, 8); }
            q1 += __shfl_xor(q1, 4); q1 += __shfl_xor(q1, 2); q1 += __shfl_xor(q1, 1);
            const int val = __shfl(q1, srcl);
            if ((lane >> 3) == g) tot = val;
        }
        if (lane < cur.cnt && lane < USLOTS) act[(size_t)t * 128 + (cur.ent & 127)] = gelu_exact((float)tot * sc * cur.us) * cur.gate;
        if (cur.cnt > USLOTS) {
            for (int j = USLOTS; j < cur.cnt && j < 64; ++j) {
                const int en = __builtin_amdgcn_readlane(cur.ent, j), e = en >> 8, k = en & 127;
                const u32x4 rr = *(const u32x4*)(uq + (size_t)e * DM + 16 * lane);
                const int pp = wave_sum_i(u_dot(rr, hq));
                if (lane == 0) act[(size_t)t * 128 + k] = gelu_exact((float)pp * sc * us[e]) * egate[(size_t)t * 128 + k];
            }
        }
        UEnt n2 = u_build(t2, s, ne0, ne1, us, egate, scr, lane);
        if (i + 2 >= ntok) n2.cnt = 0;
        u_quant(nh0, nh1, nrs2, hq, sc);
        cur = nxt; nxt = n2;
        ne0 = ze0; ne1 = ze1; nh0 = zh0; nh1 = zh1; nrs2 = zrs2;
    }
  }
}

__device__ __forceinline__ void ph_vpeer(const Ctx& C, const Slicing SL, const int* __restrict__ eidx, const float* __restrict__ act, const unsigned char* __restrict__ vq, const float* __restrict__ vs,
                                         float* xio, float* __restrict__ ssf) {
    const int lane = C.lane, grp = lane >> 3, c8 = lane & 7;
    const bool hh = (lane & 32) != 0, b4 = (lane & 16) != 0, b3 = (lane & 8) != 0;
    const int wv = SL.rank * NWAVES + C.wave, nwv = SL.nloc * NWAVES;
    const int ntok = (T - wv + nwv - 1) / nwv;
    auto tok = [&](int i) { const int t = wv + i * nwv; return t < T ? t : T - 1; };
  for (int s = SL.pi; s < 8; s += SL.m) {
    const unsigned char* vqs = vq + s * 128 + c8 * 16;
    const int chl = 8 * (hh ? 1 : 0) + 4 * (b4 ? 1 : 0) + 2 * (b3 ? 1 : 0);
    const int coff = s * 128 + c8 * 16 + chl;
    int tA = tok(0), tB = tok(1);
    int e0 = eidx[(size_t)tA * 128 + lane], e1 = eidx[(size_t)tA * 128 + 64 + lane];
    float w0 = act[(size_t)tA * 128 + lane] * vs[e0], w1 = act[(size_t)tA * 128 + 64 + lane] * vs[e1];
    int ne0 = eidx[(size_t)tB * 128 + lane], ne1 = eidx[(size_t)tB * 128 + 64 + lane];
    float na0 = act[(size_t)tB * 128 + lane], na1 = act[(size_t)tB * 128 + 64 + lane];
    u32x4 r[16];
#pragma unroll
    for (int i = 0; i < 16; ++i) { const int e = __shfl(i < 8 ? e0 : e1, 8 * (i & 7) + grp); r[i] = *(const u32x4*)(vqs + (size_t)e * DM); }
#pragma unroll 1
    for (int it = 0; it < ntok; ++it) {
        const int t = tok(it), t2 = tok(it + 2);
        const int ze0 = eidx[(size_t)t2 * 128 + lane], ze1 = eidx[(size_t)t2 * 128 + 64 + lane];
        const float za0 = act[(size_t)t2 * 128 + lane], za1 = act[(size_t)t2 * 128 + 64 + lane];
        const float nv0 = vs[ne0], nv1 = vs[ne1];
        const float2 xv = *(const float2*)(xio + (size_t)t * DM + coff);
        float o[16], wsum = 0.f;
#pragma unroll
        for (int c = 0; c < 16; ++c) o[c] = 0.f;
#pragma unroll
        for (int i = 0; i < 16; ++i) {
            const float w = __shfl(i < 8 ? w0 : w1, 8 * (i & 7) + grp);
            wsum += w;
#pragma unroll
            for (int d = 0; d < 4; ++d) {
                const unsigned q = r[i][d];
                o[4 * d + 0] = fmaf(w, (float)(q & 0xffu), o[4 * d + 0]); o[4 * d + 1] = fmaf(w, (float)((q >> 8) & 0xffu), o[4 * d + 1]);
                o[4 * d + 2] = fmaf(w, (float)((q >> 16) & 0xffu), o[4 * d + 2]); o[4 * d + 3] = fmaf(w, (float)(q >> 24), o[4 * d + 3]);
            }
            const int e = __shfl(i < 8 ? ne0 : ne1, 8 * (i & 7) + grp);
            r[i] = *(const u32x4*)(vqs + (size_t)e * DM);
        }
        float q8[8], q4[4], q2[2];
#pragma unroll
        for (int k = 0; k < 8; ++k) { const float mine = hh ? o[8 + k] : o[k], oth = hh ? o[k] : o[8 + k]; q8[k] = mine + __shfl_xor(oth, 32); }
#pragma unroll
        for (int k = 0; k < 4; ++k) { const float mine = b4 ? q8[4 + k] : q8[k], oth = b4 ? q8[k] : q8[4 + k]; q4[k] = mine + __shfl_xor(oth, 16); }
#pragma unroll
        for (int k = 0; k < 2; ++k) { const float mine = b3 ? q4[2 + k] : q4[k], oth = b3 ? q4[k] : q4[2 + k]; q2[k] = mine + __shfl_xor(oth, 8); }
        wsum += __shfl_xor(wsum, 32); wsum += __shfl_xor(wsum, 16); wsum += __shfl_xor(wsum, 8);
        const float y0 = xv.x + (q2[0] - 128.0f * wsum), y1 = xv.y + (q2[1] - 128.0f * wsum);
        *(float2*)(xio + (size_t)t * DM + coff) = make_float2(y0, y1);
        const float ss = wave_sum(y0 * y0 + y1 * y1);
        if (lane == 0) ssf[(size_t)s * T + t] = ss;
        w0 = na0 * nv0; w1 = na1 * nv1;
        ne0 = ze0; ne1 = ze1; na0 = za0; na1 = za1;
    }
  }
}
__device__ __forceinline__ void ph_final(const Ctx& C, const float* __restrict__ ssf, float* xio, const float* __restrict__ gf) {
    const int lane = C.lane;
    for (int t = C.gw; t < T; t += C.ngw) {
        float s = 0.f;
#pragma unroll
        for (int i = 0; i < 8; ++i) s += ssf[(size_t)i * T + t];
        const float r = rsqrtf(s * (1.0f / DM) + EPS);
        float* xr = xio + (size_t)t * DM;
#pragma unroll
        for (int j = 0; j < 4; ++j) {
            const int c0 = j * 256 + lane * 4;
            const f32x4 v = *(const f32x4*)(xr + c0), gg = *(const f32x4*)(gf + c0);
            *(f32x4*)(xr + c0) = v * r * gg;
        }
    }
}

namespace pg8 {
#define PG8_LAS __attribute__((address_space(3)))
typedef _Float16 frag8 __attribute__((ext_vector_type(8)));
typedef float f32x4 __attribute__((ext_vector_type(4)));
constexpr int BM = 256, BK = 64, HALF = 128, HTB = HALF * BK * 2  , STAGE_BYTES = 8 * HTB, NXCD = 8, WGM = 8;

__host__ __device__ __forceinline__ int lds_byte(int r, int c) { const int st = (r >> 4) * 2 + (c >> 5), rr = r & 15, cc = c & 31, ob = rr * 64 + cc * 2; return st * 1024 + (ob ^ (((ob >> 9) & 1) << 5)); }
__host__ __device__ __forceinline__ void stage_rc(int b, int& R, int& C) { const int st = b / 1024, sb = b % 1024, swz = sb ^ (((sb >> 9) & 1) << 5); R = (st >> 1) * 16 + swz / 64; C = (st & 1) * 32 + (swz % 64) / 2; }
__host__ __device__ __forceinline__ int perm32(int rho) { const int n = rho >> 4, i = rho & 15; return 8 * (i >> 2) + 4 * n + (i & 3); }

struct Unit { int pm, pn; };
struct Gemm { const f16* A; const f16* Bt; int M, N, K; };

struct StaticOrder {
    int nM, nN, nwg, G, c;
    __host__ __device__ void init(int M, int N, int G_, int c_) { nM = M / BM; nN = N / BM; nwg = nM * nN; G = G_; c = c_; }
    __host__ __device__ bool next(int i, Unit& u) const {
        const long L = (long)i * G + c; if (L >= nwg) return false;
        int wgid = (int)L; { const int q = nwg / NXCD, r = nwg % NXCD, xcd = wgid % NXCD, off = wgid / NXCD; wgid = (xcd < r ? xcd * (q + 1) : r * (q + 1) + (xcd - r) * q) + off; }
        const int nig = WGM * nN, gid = wgid / nig, fm = gid * WGM, gsz = (nM - fm) < WGM ? (nM - fm) : WGM;
        u.pm = fm + ((wgid % nig) % gsz); u.pn = (wgid % nig) / gsz; return true;
    }
    __device__ __forceinline__ void a_ready(const Unit&) const {}
    __device__ __forceinline__ void done(const Unit&) const {}
};

__device__ __forceinline__ frag8 pack8(const f32x4 a, const f32x4 b) {
    frag8 h; h[0] = (f16)a[0]; h[1] = (f16)a[1]; h[2] = (f16)a[2]; h[3] = (f16)a[3]; h[4] = (f16)b[0]; h[5] = (f16)b[1]; h[6] = (f16)b[2]; h[7] = (f16)b[3]; return h;
}
__device__ __forceinline__ float sigmoidf_(float z) { return 1.0f / (1.0f + __expf(-z)); }

struct EpiP1 {
    static constexpr bool PERM = true, AFTER_DRAIN = false, MIDK = false;
    const float* ss1; const float* bgate; f16* qkvu; f16* gates; f16* vT;
    __device__ __forceinline__ void operator()(const f32x4 (&acc)[2][2][4][2], const Unit& u, int wr, int wc, int fr, int fq) const {
        const int row0 = u.pm * BM + wr * 64 + fr, colt = u.pn * BM; const bool isg = colt >= NQKVU;
#pragma unroll
        for (int ai = 0; ai < 2; ++ai)
#pragma unroll
            for (int m = 0; m < 4; ++m) { const int row = row0 + ai * HALF + m * 16; const float r = rsqrtf(ss1[row] * (1.0f / DM) + EPS);
#pragma unroll
                for (int bj = 0; bj < 2; ++bj) { const int c0 = colt + bj * HALF + wc * 32 + 8 * fq; f32x4 v0 = acc[ai][bj][m][0] * r, v1 = acc[ai][bj][m][1] * r;
                    if (isg) { const int cg = c0 - NQKVU; const f32x4 b0 = *(const f32x4*)(bgate + cg), b1 = *(const f32x4*)(bgate + cg + 4);
#pragma unroll
                        for (int i = 0; i < 4; ++i) { v0[i] = sigmoidf_(v0[i] + b0[i]); v1[i] = sigmoidf_(v1[i] + b1[i]); }
                        *(frag8*)(gates + (size_t)row * NGATE + cg) = pack8(v0, v1); }
                    else { const frag8 hv = pack8(v0, v1); *(frag8*)(qkvu + (size_t)row * NQKVU + c0) = hv;
                        if (colt == 512 && bj == 1) {
                            f16* vp = vT + ((size_t)((row >> 11) * 2 + (wc >> 1)) * 64 + (wc & 1) * 32 + 8 * fq) * SEQ + (row & (SEQ - 1));
#pragma unroll
                            for (int i = 0; i < 8; ++i) vp[(size_t)i * SEQ] = hv[i]; } } } }
    }
};
struct EpiMerged {
    static constexpr bool PERM = true, AFTER_DRAIN = false, MIDK = true;
    const f16* gates; f16* merged;
    __device__ __forceinline__ void mid(f32x4 (&acc)[2][2][4][2], const Unit& u, int wr, int wc, int fr, int fq) const {
        const int row0 = u.pm * BM + wr * 64 + fr, colt = u.pn * BM;
        const f16* gb = gates + (size_t)row0 * NGATE + colt + wc * 32 + 8 * fq;
        asm volatile("" : "+v"(gb));
#pragma unroll
        for (int ai = 0; ai < 2; ++ai) {
            frag8 g0[4][2], g1[4][2];
#pragma unroll
            for (int m = 0; m < 4; ++m)
#pragma unroll
                for (int bj = 0; bj < 2; ++bj) { const f16* gp = gb + (size_t)(ai * HALF + m * 16) * NGATE + bj * HALF; g0[m][bj] = *(const frag8*)gp; g1[m][bj] = *(const frag8*)(gp + DM); }
#pragma unroll
            for (int m = 0; m < 4; ++m)
#pragma unroll
                for (int bj = 0; bj < 2; ++bj)
#pragma unroll
                    for (int i = 0; i < 4; ++i) {
                        acc[ai][bj][m][0][i] *= (float)g0[m][bj][i] * __builtin_amdgcn_rcpf(fmaxf((float)g1[m][bj][i], 1e-4f));
                        acc[ai][bj][m][1][i] *= (float)g0[m][bj][4 + i] * __builtin_amdgcn_rcpf(fmaxf((float)g1[m][bj][4 + i], 1e-4f)); }
            asm volatile("" ::: "memory");
        }
    }
    __device__ __forceinline__ void operator()(const f32x4 (&acc)[2][2][4][2], const Unit& u, int wr, int wc, int fr, int fq) const {
        const int row0 = u.pm * BM + wr * 64 + fr, colt = u.pn * BM;
#pragma unroll
        for (int ai = 0; ai < 2; ++ai)
#pragma unroll
            for (int m = 0; m < 4; ++m) { const int row = row0 + ai * HALF + m * 16;
#pragma unroll
                for (int bj = 0; bj < 2; ++bj) { const int c0 = colt + bj * HALF + wc * 32 + 8 * fq;
                    const frag8 g1 = *(const frag8*)(gates + (size_t)row * NGATE + DM + c0); f32x4 v0, v1;
#pragma unroll
                    for (int i = 0; i < 4; ++i) { v0[i] = acc[ai][bj][m][0][i] * fmaxf((float)g1[i], 1e-4f); v1[i] = acc[ai][bj][m][1][i] * fmaxf((float)g1[4 + i], 1e-4f); }
                    *(frag8*)(merged + (size_t)row * DM + c0) = pack8(v0, v1); } }
    }
};
struct EpiOut {
    static constexpr bool PERM = false, AFTER_DRAIN = false, MIDK = false;
    const float* x; const float* g2; float* x1; f16* x1h; float* ss2p;
    __device__ __forceinline__ void operator()(const f32x4 (&acc)[2][2][4][2], const Unit& u, int wr, int wc, int fr, int fq) const {
        const int row0 = u.pm * BM + wr * 64 + fr, col0 = u.pn * BM + wc * 32 + 4 * fq;
        f32x4 gv[2][2];
#pragma unroll
        for (int bj = 0; bj < 2; ++bj)
#pragma unroll
            for (int n = 0; n < 2; ++n) gv[bj][n] = *(const f32x4*)(g2 + col0 + bj * HALF + n * 16);
#pragma unroll
        for (int ai = 0; ai < 2; ++ai)
#pragma unroll
            for (int m = 0; m < 4; ++m) { const int row = row0 + ai * HALF + m * 16; const size_t off = (size_t)row * DM + col0; float ssq = 0.f;
#pragma unroll
                for (int bj = 0; bj < 2; ++bj)
#pragma unroll
                    for (int n = 0; n < 2; ++n) { const f32x4 y = *(const f32x4*)(x + off + bj * HALF + n * 16) + acc[ai][bj][m][n];
                        *(f32x4*)(x1 + off + bj * HALF + n * 16) = y; ssq += (y[0] * y[0] + y[1] * y[1]) + (y[2] * y[2] + y[3] * y[3]);
                        const f32x4 yg = y * gv[bj][n]; half4 h; h[0] = (f16)yg[0]; h[1] = (f16)yg[1]; h[2] = (f16)yg[2]; h[3] = (f16)yg[3];
                        *(half4*)(x1h + off + bj * HALF + n * 16) = h; }
                ssq += __shfl_xor(ssq, 16); ssq += __shfl_xor(ssq, 32);
                if (fq == 0) ss2p[(size_t)(u.pn * 4 + wc) * T + row] = ssq; }
    }
};
struct EpiQ {
    static constexpr bool PERM = true, AFTER_DRAIN = false, MIDK = false;
    f16* qp;
    __device__ __forceinline__ void operator()(const f32x4 (&acc)[2][2][4][2], const Unit& u, int wr, int wc, int fr, int fq) const {
        const int row0 = u.pm * BM + wr * 64 + fr, colt = u.pn * BM;
#pragma unroll
        for (int ai = 0; ai < 2; ++ai)
#pragma unroll
            for (int m = 0; m < 4; ++m) { const int row = row0 + ai * HALF + m * 16;
#pragma unroll
                for (int bj = 0; bj < 2; ++bj) { const int c0 = colt + bj * HALF + wc * 32 + 8 * fq;
                    *(frag8*)(qp + (size_t)row * 2048 + c0) = pack8(acc[ai][bj][m][0], acc[ai][bj][m][1]); } }
    }
};

template <class Epi, class Sched, bool ALIGN_EPI = false, bool SP2 = false>
__device__ __forceinline__ void gemm_phase(PG8_LAS unsigned char* lds, const Gemm g, const Sched& S, const Epi& E) {
    const int tid = threadIdx.x, wid = __builtin_amdgcn_readfirstlane(tid >> 6), lane = tid & 63, wr = wid >> 2, wc = wid & 3, fr = lane & 15, fq = lane >> 4;
    const int K = g.K, nt = K / BK;
    unsigned voffA[2], voffB[2];
#pragma unroll
    for (int i = 0; i < 2; ++i) { int R, C; stage_rc(tid * 16 + i * 8192, R, C); const int Rb = Epi::PERM ? ((R & ~31) + perm32(R & 31)) : R;
        voffA[i] = (unsigned)(R * K + C) * 2u; voffB[i] = (unsigned)(Rb * K + C) * 2u; }
    const size_t kstep = (size_t)(BK * 2);
    const size_t hstep = (size_t)HALF * K * 2;
    const size_t tstep = 2 * hstep;
    const unsigned ldsw = (unsigned)wid * 1024u;
    const int aoff = lds_byte(wr * 64 + fr, fq * 8), boff = lds_byte(wc * 32 + fr, fq * 8);
#define PG8_SA(b, h) (((b) * 2 + (h)) * HTB)
#define PG8_SB(b, h) ((4 + (b) * 2 + (h)) * HTB)
#define PG8_STAGE(bufoff, gbase, voff) do { _Pragma("unroll") for (int _i = 0; _i < 2; ++_i) \
        __builtin_amdgcn_global_load_lds((const unsigned*)((const char*)(gbase) + (voff)[_i]), (PG8_LAS unsigned*)(lds + (bufoff) + ldsw + _i * 8192), 16, 0, 0); } while (0)
#define PG8_LDA(dst, b, h) do { _Pragma("unroll") for (int m = 0; m < 4; ++m) _Pragma("unroll") for (int k = 0; k < 2; ++k) dst[m][k] = *(const PG8_LAS frag8*)(lds + PG8_SA(b, h) + aoff + m * 2048 + k * 1024); } while (0)
#define PG8_LDB(dst, b, h) do { _Pragma("unroll") for (int n = 0; n < 2; ++n) _Pragma("unroll") for (int k = 0; k < 2; ++k) dst[n][k] = *(const PG8_LAS frag8*)(lds + PG8_SB(b, h) + boff + n * 2048 + k * 1024); } while (0)
#define PG8_MMA(ai, bj, At, Bt) do { __builtin_amdgcn_s_setprio(1); _Pragma("unroll") for (int m = 0; m < 4; ++m) _Pragma("unroll") for (int n = 0; n < 2; ++n) _Pragma("unroll") for (int k = 0; k < 2; ++k) \
        acc[ai][bj][m][n] = __builtin_amdgcn_mfma_f32_16x16x32_f16(Bt[n][k], At[m][k], acc[ai][bj][m][n], 0, 0, 0); __builtin_amdgcn_s_setprio(0); } while (0)
#define PG8_WAIT_V(n) asm volatile("s_waitcnt vmcnt(" #n ")" ::: "memory")
#define PG8_WAIT_L(n) asm volatile("s_waitcnt lgkmcnt(" #n ")" ::: "memory")
#define PG8_BAR __builtin_amdgcn_s_barrier()
#define PG8_SCHED __builtin_amdgcn_sched_barrier(0)
    Unit cur, nxt; int ui = 0;
    if (!S.next(0, cur)) return;
    f32x4 acc[2][2][4][2];
#pragma unroll
    for (int a = 0; a < 2; ++a)
#pragma unroll
        for (int b = 0; b < 2; ++b)
#pragma unroll
            for (int m = 0; m < 4; ++m)
#pragma unroll
                for (int n = 0; n < 2; ++n) acc[a][b][m][n] = (f32x4){0.f, 0.f, 0.f, 0.f};
    frag8 At[4][2], B0[2][2], B1[2][2];
    const char* cA = (const char*)g.A + (size_t)cur.pm * tstep; const char* cB = (const char*)g.Bt + (size_t)cur.pn * tstep;
    S.a_ready(cur);
    if constexpr (SP2) {
        PG8_STAGE(PG8_SB(0, 0), cB, voffB); PG8_STAGE(PG8_SB(0, 1), cB + hstep, voffB); PG8_STAGE(PG8_SA(0, 0), cA, voffA); PG8_STAGE(PG8_SA(0, 1), cA + hstep, voffA);
        if (wr == 1) PG8_BAR;
        PG8_WAIT_V(2); PG8_BAR;
        PG8_STAGE(PG8_SB(1, 0), cB + kstep, voffB); PG8_STAGE(PG8_SA(1, 0), cA + kstep, voffA); PG8_STAGE(PG8_SB(1, 1), cB + hstep + kstep, voffB);
        PG8_WAIT_V(6); PG8_BAR;
    } else {
        PG8_STAGE(PG8_SB(0, 0), cB, voffB); PG8_STAGE(PG8_SA(0, 0), cA, voffA); PG8_STAGE(PG8_SB(0, 1), cB + hstep, voffB); PG8_STAGE(PG8_SA(0, 1), cA + hstep, voffA);
        if (wr == 1) PG8_BAR;
        PG8_WAIT_V(4); PG8_BAR;
        PG8_STAGE(PG8_SB(1, 0), cB + kstep, voffB); PG8_STAGE(PG8_SA(1, 0), cA + kstep, voffA); PG8_STAGE(PG8_SB(1, 1), cB + hstep + kstep, voffB);
        PG8_WAIT_V(6); PG8_BAR;
    }
    for (;;) {
        const bool has_next = S.next(ui + 1, nxt);
        const char* nA = has_next ? (const char*)g.A + (size_t)nxt.pm * tstep : cA; const char* nB = has_next ? (const char*)g.Bt + (size_t)nxt.pn * tstep : cB;
        for (int t = 0; t < nt; t += 2) {
            const bool last = (t == nt - 2);
            if constexpr (Epi::MIDK) { if (t == (nt >> 1)) E.mid(acc, cur, wr, wc, fr, fq); }
            const char* a1 = cA + (size_t)(t + 1) * kstep;
            const char* a2 = last ? nA : cA + (size_t)(t + 2) * kstep; const char* b2 = last ? nB : cB + (size_t)(t + 2) * kstep;
            const char* a3 = a2 + kstep; const char* b3 = b2 + kstep;
            if (last && has_next) S.a_ready(nxt);
            if constexpr (SP2) {
            PG8_LDB(B0, 0, 0); PG8_LDB(B1, 0, 1); PG8_SCHED; PG8_LDA(At, 0, 0); PG8_STAGE(PG8_SA(1, 1), a1 + hstep, voffA);
            PG8_WAIT_V(8); PG8_WAIT_L(0); PG8_BAR; PG8_MMA(0, 0, At, B0); PG8_MMA(0, 1, At, B1); PG8_BAR; PG8_SCHED;
            PG8_LDA(At, 0, 1); PG8_STAGE(PG8_SB(0, 0), b2, voffB); PG8_STAGE(PG8_SB(0, 1), b2 + hstep, voffB); PG8_STAGE(PG8_SA(0, 0), a2, voffA);
            PG8_WAIT_V(8); PG8_WAIT_L(0); PG8_BAR; PG8_MMA(1, 0, At, B0); PG8_MMA(1, 1, At, B1); PG8_BAR; PG8_SCHED;
            PG8_LDB(B0, 1, 0); PG8_LDB(B1, 1, 1); PG8_SCHED; PG8_LDA(At, 1, 0); PG8_STAGE(PG8_SA(0, 1), a2 + hstep, voffA);
            PG8_WAIT_V(8); PG8_WAIT_L(0); PG8_BAR; PG8_MMA(0, 0, At, B0); PG8_MMA(0, 1, At, B1); PG8_BAR; PG8_SCHED;
            PG8_LDA(At, 1, 1); PG8_STAGE(PG8_SB(1, 0), b3, voffB); PG8_STAGE(PG8_SB(1, 1), b3 + hstep, voffB); PG8_STAGE(PG8_SA(1, 0), a3, voffA);
            PG8_WAIT_V(8); PG8_WAIT_L(0); PG8_BAR; PG8_MMA(1, 0, At, B0); PG8_MMA(1, 1, At, B1); PG8_BAR; PG8_SCHED;
            } else {
            PG8_LDB(B0, 0, 0); PG8_SCHED; PG8_LDA(At, 0, 0); PG8_STAGE(PG8_SA(1, 1), a1 + hstep, voffA);
            PG8_WAIT_L(8); PG8_BAR; PG8_WAIT_L(0); PG8_MMA(0, 0, At, B0); PG8_BAR; PG8_SCHED;
            PG8_LDB(B1, 0, 1); PG8_STAGE(PG8_SB(0, 0), b2, voffB);
            PG8_BAR; PG8_WAIT_L(0); PG8_MMA(0, 1, At, B1); PG8_BAR;
            PG8_LDA(At, 0, 1); PG8_STAGE(PG8_SA(0, 0), a2, voffA);
            PG8_BAR; PG8_WAIT_L(0); PG8_MMA(1, 0, At, B0); PG8_BAR; PG8_SCHED;
            PG8_STAGE(PG8_SB(0, 1), b2 + hstep, voffB);
            PG8_WAIT_V(6); PG8_BAR; PG8_MMA(1, 1, At, B1); PG8_BAR;
            PG8_LDB(B0, 1, 0); PG8_SCHED; PG8_LDA(At, 1, 0); PG8_STAGE(PG8_SA(0, 1), a2 + hstep, voffA);
            PG8_WAIT_L(8); PG8_BAR; PG8_WAIT_L(0); PG8_MMA(0, 0, At, B0); PG8_BAR; PG8_SCHED;
            PG8_LDB(B1, 1, 1); PG8_STAGE(PG8_SB(1, 0), b3, voffB);
            PG8_BAR; PG8_WAIT_L(0); PG8_MMA(0, 1, At, B1); PG8_BAR;
            PG8_LDA(At, 1, 1); PG8_STAGE(PG8_SA(1, 0), a3, voffA);
            PG8_BAR; PG8_WAIT_L(0); PG8_MMA(1, 0, At, B0); PG8_BAR; PG8_SCHED;
            PG8_STAGE(PG8_SB(1, 1), b3 + hstep, voffB);
            PG8_WAIT_V(6); PG8_BAR; PG8_MMA(1, 1, At, B1); PG8_BAR;
            }
        }
        if constexpr (ALIGN_EPI) { if (wr == 0) PG8_BAR; }
        if constexpr (!Epi::AFTER_DRAIN) { E(acc, cur, wr, wc, fr, fq); S.done(cur); }
        if (!has_next) break;
#pragma unroll
        for (int a = 0; a < 2; ++a)
#pragma unroll
            for (int b = 0; b < 2; ++b)
#pragma unroll
                for (int m = 0; m < 4; ++m)
#pragma unroll
                    for (int n = 0; n < 2; ++n) acc[a][b][m][n] = (f32x4){0.f, 0.f, 0.f, 0.f};
        cur = nxt; cA = nA; cB = nB; ++ui;
        if constexpr (ALIGN_EPI) { if (wr == 1) PG8_BAR; }
    }
    PG8_WAIT_V(0);
    if constexpr (!ALIGN_EPI) { if (wr == 0) PG8_BAR; }
    PG8_BAR;
    if constexpr (Epi::AFTER_DRAIN) { E.fused(acc, cur, wr, wc, fr, fq, lds, wid, lane); S.done(cur); }
#undef PG8_SA
#undef PG8_SB
#undef PG8_STAGE
#undef PG8_LDA
#undef PG8_LDB
#undef PG8_MMA
#undef PG8_WAIT_V
#undef PG8_WAIT_L
#undef PG8_BAR
#undef PG8_SCHED
}
}

#define XB_TMO      128
#define XB_XCNT(j)  (256  + 64 * (j))
#define XB_XSUB(j)  (1280 + 64 * (j))
#define XB_XGEN(j)  (2304 + 64 * (j))
#define XB_TOP      3328
#define XB_TOPGEN   3392
#define XCD_BAR_WORDS 3456
#define XB_SPIN_CAP (1u << 18)

__device__ __forceinline__ unsigned xb_ld(unsigned* p)              { return __hip_atomic_load(p, __ATOMIC_RELAXED, __HIP_MEMORY_SCOPE_AGENT); }
__device__ __forceinline__ unsigned xb_add(unsigned* p, unsigned v) { return __hip_atomic_fetch_add(p, v, __ATOMIC_RELAXED, __HIP_MEMORY_SCOPE_AGENT); }
__device__ __forceinline__ unsigned xb_xcc_id() { return (unsigned)__builtin_amdgcn_s_getreg((3 << 11) | 20) & 0xFu; }
#define XB_SPIN(cond, bar) do { unsigned _sp = 0; while (cond) { __builtin_amdgcn_s_sleep(1); \
    if ((++_sp & 255u) == 0u) { if (xb_ld(&(bar)[XB_TMO])) break; if (_sp > XB_SPIN_CAP) { atomicAdd(&(bar)[XB_TMO], 1u); break; } } } } while (0)

struct XcdBarrier {
    unsigned* bar; unsigned x;
    volatile LAS unsigned* st;
};

__device__ __forceinline__ XcdBarrier xcd_barrier_post(unsigned* bar, volatile LAS unsigned* st) {
    XcdBarrier b; b.bar = bar; b.x = xb_xcc_id(); b.st = st;
    if (threadIdx.x == 0) st[2] = xb_add(&bar[XB_XCNT(b.x)], 1u);
    return b;
}
__device__ __forceinline__ void xcd_barrier_complete(unsigned* bar, unsigned x, unsigned& nloc, unsigned& nx) {
    const unsigned G = gridDim.x * gridDim.y * gridDim.z;
    unsigned sum, cnt, mine, sp = 0u;
    for (;;) {
        sum = 0u; cnt = 0u; mine = 0u;
#pragma unroll
        for (unsigned j = 0; j < 16; ++j) { const unsigned c = xb_ld(&bar[XB_XCNT(j)]); sum += c; cnt += (c > 0u) ? 1u : 0u; mine = (j == x) ? c : mine; }
        if (sum == G) break;
        __builtin_amdgcn_s_sleep(1);
        if ((++sp & 255u) == 0u) { if (xb_ld(&bar[XB_TMO])) break; if (sp > XB_SPIN_CAP) { atomicAdd(&bar[XB_TMO], 1u); break; } }
    }
    nloc = mine > 0u ? mine : 1u; nx = cnt > 0u ? cnt : 1u;
}

__device__ __forceinline__ void xcd_barrier(const XcdBarrier& b) {
    asm volatile("s_waitcnt vmcnt(0)" ::: "memory");
    __syncthreads();
    if (threadIdx.x == 0) {
        unsigned* bar = b.bar;
        __builtin_amdgcn_s_waitcnt(0);
        unsigned nloc = b.st[0], nx = b.st[1];
        if (nloc == 0u) { xcd_barrier_complete(bar, b.x, nloc, nx); b.st[0] = nloc; b.st[1] = nx; }
        const unsigned old = xb_add(&bar[XB_XSUB(b.x)], 1u);
        const unsigned gen = old / nloc;
        if (old + 1u == (gen + 1u) * nloc) {
            __builtin_amdgcn_fence(__ATOMIC_RELEASE, "agent");
            asm volatile("s_waitcnt vmcnt(0)" ::: "memory");
            const unsigned og = xb_add(&bar[XB_TOP], 1u);
            const unsigned tg = og / nx;
            if (og + 1u == (tg + 1u) * nx) xb_add(&bar[XB_TOPGEN], 1u);
            else XB_SPIN(xb_ld(&bar[XB_TOPGEN]) == tg, bar);
            __builtin_amdgcn_fence(__ATOMIC_ACQUIRE, "agent");
            xb_add(&bar[XB_XGEN(b.x)], 1u);
            asm volatile("s_waitcnt vmcnt(0)" ::: "memory");
        } else {
            XB_SPIN(xb_ld(&bar[XB_XGEN(b.x)]) == gen, bar);
            __builtin_amdgcn_fence(__ATOMIC_ACQUIRE, "agent");
            asm volatile("s_waitcnt vmcnt(0)" ::: "memory");
        }
    }
    __syncthreads();
}


struct Args { const float* in[16]; float* out; unsigned char* ws; int ph_lo, ph_hi; };
constexpr int N_PHASES = 11;

__global__ void __launch_bounds__(NTHREADS, 2) mk_fwd(Args a) {
    extern __shared__ __attribute__((aligned(16))) unsigned char lds[];
    LAS unsigned char* L = (LAS unsigned char*)lds;
    volatile LAS unsigned* MISC = (volatile LAS unsigned*)(L + MISC_OFF);
    unsigned char* ws = a.ws;
    Ctx C;
    C.tid = threadIdx.x; C.lane = C.tid & 63; C.wave = __builtin_amdgcn_readfirstlane(C.tid >> 6);
    C.G = gridDim.x; C.gw = blockIdx.x * NWAVES + C.wave; C.ngw = C.G * NWAVES; C.gt = blockIdx.x * NTHREADS + C.tid; C.ngt = C.G * NTHREADS;
    for (int u = C.tid; u < (LDS_BYTES - LDSCTL_OFF) / 4; u += NTHREADS) ((LAS unsigned*)(L + LDSCTL_OFF))[u] = 0u;
    __syncthreads();
    const int lo = a.ph_lo, hi = a.ph_hi, G = C.G;
    const bool multi = (hi - lo) > 1;
    XcdBarrier bar; bar.bar = (unsigned*)(ws + WS_CTL) + CW_BAR; bar.x = 0; bar.st = nullptr;
    if (multi) bar = xcd_barrier_post((unsigned*)(ws + WS_CTL) + CW_BAR, MISC + 8);
#define IN(k) (lo <= (k) && (k) < hi)
#define SEAM(k) do { if (IN(k) && IN((k) + 1)) xcd_barrier(bar); } while (0)

#define REPS(k) for (int rep_ = 0; rep_ < ((PROBE_DUP == (k)) ? 2 : 1); ++rep_)
#define REPBAR(k) do { if (PROBE_DUP == (k) && rep_ == 0) xcd_barrier(bar); } while (0)
    if (IN(0)) REPS(0) { ph_prep(C, L, a.in, ws); REPBAR(0); }
    SEAM(0);
    if (IN(1)) REPS(1) {
        pg8::Gemm g{(const f16*)(ws + WS_XH), (const f16*)(ws + WS_WCAT), T, NCAT, DM}; pg8::StaticOrder S; S.init(T, NCAT, G, (int)blockIdx.x);
        pg8::EpiP1 E{(const float*)(ws + WS_RS1), a.in[8], (f16*)(ws + WS_QKVU), (f16*)(ws + WS_GATES), (f16*)(ws + WS_VT)};
        pg8::gemm_phase<pg8::EpiP1, pg8::StaticOrder, true, true>(L, g, S, E);
        REPBAR(1);
    }
    SEAM(1);
    if (IN(2)) REPS(2) {
        ph_attn(C, (const f16*)(ws + WS_QKVU), (const f16*)(ws + WS_VT), a.in[3], (f16*)(ws + WS_OCAT));
        REPBAR(2);
    }
    if (IN(2)) REPS(3) {
        ph_pool(C, L, (const f16*)(ws + WS_QKVU), (const f16*)(ws + WS_POOLW), a.in[5], (f16*)(ws + WS_OCAT));
        REPBAR(3);
    }
    if (IN(2) && IN(4)) xcd_barrier(bar);
    if (IN(4)) REPS(4) {
        pg8::Gemm g{(const f16*)(ws + WS_OCAT), (const f16*)(ws + WS_WB), T, DM, DM}; pg8::StaticOrder S; S.init(T, DM, G, (int)blockIdx.x);
        pg8::EpiMerged E{(const f16*)(ws + WS_GATES), (f16*)(ws + WS_MERGED)};
        pg8::gemm_phase<pg8::EpiMerged, pg8::StaticOrder, true, true>(L, g, S, E);
        REPBAR(4);
    }
    SEAM(4);
    if (IN(5)) REPS(5) {
        pg8::Gemm g{(const f16*)(ws + WS_MERGED), (const f16*)(ws + WS_WOUT), T, DM, DM}; pg8::StaticOrder S; S.init(T, DM, G, (int)blockIdx.x);
        pg8::EpiOut E{a.in[0], a.in[10], a.out, (f16*)(ws + WS_X1H), (float*)(ws + WS_SS2)};
        pg8::gemm_phase<pg8::EpiOut, pg8::StaticOrder, true, true>(L, g, S, E);
        REPBAR(5);
    }
    SEAM(5);
    if (IN(6)) REPS(6) {
        pg8::Gemm g{(const f16*)(ws + WS_X1H), (const f16*)(ws + WS_WQ), T, 2048, DM}; pg8::StaticOrder S; S.init(T, 2048, G, (int)blockIdx.x);
        pg8::EpiQ E{(f16*)(ws + WS_QP)};
        pg8::gemm_phase<pg8::EpiQ, pg8::StaticOrder, true, true>(L, g, S, E);
        REPBAR(6);
    }
    SEAM(6);
    if (IN(7)) REPS(7) { ph_route(C, L, (const f16*)(ws + WS_QP), (const float*)(ws + WS_SS2), (const f16*)(ws + WS_SUBK), (int*)(ws + WS_EIDX), (float*)(ws + WS_EGATE)); REPBAR(7); }
    SEAM(7);
    if (IN(8)) REPS(8) {
        const Slicing SL = get_slicing((const unsigned*)(ws + WS_CTL) + CW_BAR, MISC);
        ph_upeer(C, L, SL, (const f16*)(ws + WS_X1H), (const float*)(ws + WS_SS2), (const int*)(ws + WS_EIDX), (const float*)(ws + WS_EGATE),
                 (const unsigned char*)(ws + WS_UQ), (const float*)(ws + WS_US), (float*)(ws + WS_ACT));
        REPBAR(8);
    }
    SEAM(8);
    if (IN(9)) {
        const Slicing SL = get_slicing((const unsigned*)(ws + WS_CTL) + CW_BAR, MISC);
        ph_vpeer(C, SL, (const int*)(ws + WS_EIDX), (const float*)(ws + WS_ACT), (const unsigned char*)(ws + WS_VQ), (const float*)(ws + WS_VS), a.out, (float*)(ws + WS_SSF));
    }
    SEAM(9);
    if (IN(10)) { ph_final(C, (const float*)(ws + WS_SSF), a.out, a.in[15]); }
#undef IN
#undef SEAM
}

#ifndef MK_N_LAUNCHES
#define MK_N_LAUNCHES 1
#endif
extern "C" void kernel_launch(void* const* d_in, const int* in_sizes, int n_in, void* d_out, int out_size, void* d_ws, size_t ws_size, hipStream_t stream) {
    static int grid = 0;
    if (grid == 0) {
        if (n_in != 16 || in_sizes[0] != T * DM || out_size != T * DM || ws_size < WS_END) {
            fprintf(stderr, "kernel_launch: unexpected shapes (n_in %d in0 %d out %d ws %zu)\n", n_in, n_in > 0 ? in_sizes[0] : -1, out_size, ws_size);
            grid = -1; return;
        }
        int dev = 0, cus = 0;
        if (hipGetDevice(&dev) != hipSuccess || hipDeviceGetAttribute(&cus, hipDeviceAttributeMultiprocessorCount, dev) != hipSuccess) { grid = -1; return; }
        if (hipFuncSetAttribute((const void*)mk_fwd, hipFuncAttributeMaxDynamicSharedMemorySize, LDS_BYTES) != hipSuccess) { fprintf(stderr, "kernel_launch: hipFuncSetAttribute failed\n"); grid = -1; return; }
        int per_cu = 0;
        if (hipOccupancyMaxActiveBlocksPerMultiprocessor(&per_cu, (const void*)mk_fwd, NTHREADS, LDS_BYTES) != hipSuccess || per_cu < 1)
            fprintf(stderr, "kernel_launch: occupancy query reports %d workgroups per CU\n", per_cu);
        (void)hipGetLastError();
        grid = cus;
    }
    if (grid < 0) return;
    (void)hipMemsetAsync((char*)d_ws + WS_CTL, 0, CTL_ZERO_BYTES, stream);
    Args a{};
    for (int i = 0; i < 16; ++i) a.in[i] = (const float*)d_in[i];
    a.out = (float*)d_out; a.ws = (unsigned char*)d_ws;
    if (MK_N_LAUNCHES == 1) {
        a.ph_lo = 0; a.ph_hi = N_PHASES;
        hipLaunchKernelGGL(mk_fwd, dim3(grid), dim3(NTHREADS), LDS_BYTES, stream, a);
    } else {
        for (int p = 0; p < N_PHASES; ++p) { a.ph_lo = p; a.ph_hi = p + 1; hipLaunchKernelGGL(mk_fwd, dim3(grid), dim3(NTHREADS), LDS_BYTES, stream, a); }
    }
}
```

```cpp
#include <hip/hip_runtime.h>
#include <cstdint>
#include <cstdio>

typedef _Float16 f16;
typedef _Float16 half8 __attribute__((ext_vector_type(8)));
typedef _Float16 half4 __attribute__((ext_vector_type(4)));
typedef _Float16 half2 __attribute__((ext_vector_type(2)));
typedef float f32x4 __attribute__((ext_vector_type(4)));
typedef float f32x16 __attribute__((ext_vector_type(16)));
#define LAS __attribute__((address_space(3)))
#ifndef PROBE_DIAG
#define PROBE_DIAG (0)
#endif
#ifndef PROBE_DUP
#define PROBE_DUP (-1)
#endif
#define GAS __attribute__((address_space(1)))

constexpr int DM = 1024, BATCH = 16, SEQ = 2048, T = BATCH * SEQ;
constexpr int NQKVU = 1280, NGATE = 2048, NCAT = NQKVU + NGATE;
constexpr int COL_K = 512, COL_V = 640, COL_U = 768;
constexpr int NEXP = 16384, PEER_H = 8, TOPK = 16;
constexpr float EPS = 1e-6f;
constexpr int NWAVES = 8, NTHREADS = NWAVES * 64;

constexpr size_t MiB = 1u << 20;
constexpr size_t WS_CTL = 0, CTL_ZERO_BYTES = 64 * 1024;
constexpr size_t WS_WCAT = 1 * MiB;
constexpr size_t WS_WB = 8 * MiB;
constexpr size_t WS_WOUT = 10 * MiB;
constexpr size_t WS_WQ = 12 * MiB;
constexpr size_t WS_POOLW = 16 * MiB;
constexpr size_t WS_SUBK = 16 * MiB + 512 * 1024;
constexpr size_t WS_RS1 = 17 * MiB;
constexpr size_t WS_EIDX = 18 * MiB;
constexpr size_t WS_EGATE = 34 * MiB;
constexpr size_t WS_UTAB = 50 * MiB;
constexpr size_t WS_VTAB = 82 * MiB;
constexpr size_t WS_XH = 114 * MiB;
constexpr size_t WS_MERGED = WS_XH;
constexpr size_t WS_QKVU = 178 * MiB;
constexpr size_t WS_X1H = WS_QKVU;
constexpr size_t WS_GATES = 258 * MiB;
constexpr size_t WS_QP = WS_GATES;
constexpr size_t WS_OCAT = 386 * MiB;
constexpr size_t WS_UQ = 450 * MiB;
constexpr size_t WS_VQ = 466 * MiB;
constexpr size_t WS_US = 17 * MiB + 256 * 1024, WS_VS = 17 * MiB + 512 * 1024;
constexpr size_t WS_PDOT = WS_GATES;
constexpr size_t WS_H2Q = 404 * MiB;
constexpr size_t WS_HSC = 403 * MiB;
constexpr size_t WS_SSF = 402 * MiB;
constexpr size_t WS_ACT = 386 * MiB;
constexpr size_t WS_SS2 = 482 * MiB;
constexpr size_t WS_VT = 484 * MiB;
constexpr size_t WS_END = 492 * MiB;
constexpr int CW_BAR = 4096;

constexpr int RING_OFF = 0, RING_BYTES = 131072;
constexpr int LDSCTL_OFF = RING_BYTES, MISC_OFF = LDSCTL_OFF + 320;
constexpr int LDS_BYTES = 147456;

#define LDS_WAIT() asm volatile("s_waitcnt lgkmcnt(0)" ::: "memory")
template <int CTRL> __device__ __forceinline__ float dppf(float x) { return __uint_as_float(__builtin_amdgcn_update_dpp(0u, __float_as_uint(x), CTRL, 0xf, 0xf, false)); }
template <int CTRL> __device__ __forceinline__ int dppi(int x) { return (int)__builtin_amdgcn_update_dpp(0u, (unsigned)x, CTRL, 0xf, 0xf, false); }
__device__ __forceinline__ float bfly32(float a, float b) { auto r = __builtin_amdgcn_permlane32_swap(__float_as_uint(a), __float_as_uint(b), false, false); return __uint_as_float(r[0]) + __uint_as_float(r[1]); }
__device__ __forceinline__ float bfly16(float a, float b) { auto r = __builtin_amdgcn_permlane16_swap(__float_as_uint(a), __float_as_uint(b), false, false); return __uint_as_float(r[0]) + __uint_as_float(r[1]); }
__device__ __forceinline__ int bfly32i(int a, int b) { auto r = __builtin_amdgcn_permlane32_swap((unsigned)a, (unsigned)b, false, false); return (int)(r[0] + r[1]); }
__device__ __forceinline__ int bfly16i(int a, int b) { auto r = __builtin_amdgcn_permlane16_swap((unsigned)a, (unsigned)b, false, false); return (int)(r[0] + r[1]); }
__device__ __forceinline__ float wave_sum(float x) {
    x += dppf<0x121>(x); x += dppf<0x122>(x); x += dppf<0x124>(x); x += dppf<0x128>(x);
    x = bfly16(x, x); return bfly32(x, x);
}
__device__ __forceinline__ int wave_sum_i(int x) {
    x += dppi<0x121>(x); x += dppi<0x122>(x); x += dppi<0x124>(x); x += dppi<0x128>(x);
    x = bfly16i(x, x); return bfly32i(x, x);
}
__device__ __forceinline__ float wave_max(float x) {
    x = fmaxf(x, dppf<0x121>(x)); x = fmaxf(x, dppf<0x122>(x)); x = fmaxf(x, dppf<0x124>(x)); x = fmaxf(x, dppf<0x128>(x));
    { auto r = __builtin_amdgcn_permlane16_swap(__float_as_uint(x), __float_as_uint(x), false, false); x = fmaxf(__uint_as_float(r[0]), __uint_as_float(r[1])); }
    { auto r = __builtin_amdgcn_permlane32_swap(__float_as_uint(x), __float_as_uint(x), false, false); x = fmaxf(__uint_as_float(r[0]), __uint_as_float(r[1])); }
    return x;
}
__device__ __forceinline__ float gelu_exact(float x) { return 0.5f * x * (1.0f + erff(x * 0.70710678118654752f)); }
__device__ __forceinline__ float rs_from_ss(const float* ss, int t) {
    float s = 0.f;
#pragma unroll
    for (int i = 0; i < 16; ++i) s += ss[(size_t)i * T + t];
    return rsqrtf(s * (1.0f / DM) + EPS);
}

struct Ctx {
    int tid, lane, wave;
    int G;
    int gw, ngw;
    int gt, ngt;
};

__device__ __forceinline__ int pack4_i8(float a, float b, float c, float d) {
    const int ia = (int)rintf(a), ib = (int)rintf(b), ic = (int)rintf(c), id = (int)rintf(d);
    return (ia & 0xff) | ((ib & 0xff) << 8) | ((ic & 0xff) << 16) | (id << 24);
}
template <bool OFFS>
__device__ __forceinline__ void quant_rows(const Ctx& C, const float* __restrict__ tab, unsigned* __restrict__ q, float* __restrict__ scale) {
    const int lane = C.lane;
    for (int r = C.gw; r < NEXP; r += C.ngw) {
        const float* row = tab + (size_t)r * DM;
        f32x4 v[4]; float m = 0.f;
#pragma unroll
        for (int j = 0; j < 4; ++j) { v[j] = *(const f32x4*)(row + j * 256 + lane * 4); m = fmaxf(m, fmaxf(fmaxf(fabsf(v[j][0]), fabsf(v[j][1])), fmaxf(fabsf(v[j][2]), fabsf(v[j][3])))); }
        m = wave_max(m);
        const float inv = m > 0.f ? 127.0f / m : 0.f;
#pragma unroll
        for (int j = 0; j < 4; ++j) {
            unsigned w = (unsigned)pack4_i8(v[j][0] * inv, v[j][1] * inv, v[j][2] * inv, v[j][3] * inv);
            if (OFFS) w ^= 0x80808080u;
            q[(size_t)r * 256 + j * 64 + lane] = w;
        }
        if (lane == 0) scale[r] = m * (1.0f / 127.0f);
    }
}

__device__ __forceinline__ void p0_transpose_item(const float* W, int K, int N, f16* WT, int ldo, int koff, LAS float* scr, int item, int lane) {
    const int nblk = N / 32, kb = item / nblk, nb = item % nblk, k0 = 64 * kb, n0 = 32 * nb;
#pragma unroll 8
    for (int i = 0; i < 32; ++i) { const int kk = 2 * i + (lane >> 5); scr[kk * 33 + (lane & 31)] = W[(size_t)(k0 + kk) * N + n0 + (lane & 31)]; }
    LDS_WAIT(); asm volatile("" ::: "memory");
    const int c = lane & 7;
#pragma unroll
    for (int j = 0; j < 4; ++j) { const int n = (lane >> 3) + 8 * j; const LAS float* s = scr + (8 * c) * 33 + n;
        half8 o;
#pragma unroll
        for (int i = 0; i < 8; ++i) o[i] = (f16)s[i * 33];
        *(half8*)(WT + (size_t)(n0 + n) * ldo + koff + k0 + 8 * c) = o; }
    LDS_WAIT(); asm volatile("" ::: "memory");
}
__device__ __forceinline__ void cvt_stream(const Ctx& C, const float* in, f16* out, size_t n4) {
    for (size_t i = (size_t)C.gt; i < n4; i += (size_t)C.ngt) {
        const f32x4 v = ((const f32x4*)in)[i];
        half4 h; h[0] = (f16)v[0]; h[1] = (f16)v[1]; h[2] = (f16)v[2]; h[3] = (f16)v[3];
        ((half4*)out)[i] = h;
    }
}
__device__ __forceinline__ void rowprep(const Ctx& C, const float* x, const float* g, f16* xh, float* ss) {
    const int lane = C.lane;
    for (int t = C.gw; t < T; t += C.ngw) {
        const float* xr = x + (size_t)t * DM;
        float s = 0.f;
#pragma unroll
        for (int j = 0; j < 4; ++j) {
            const f32x4 v = *(const f32x4*)(xr + j * 256 + lane * 4);
            const f32x4 gg = *(const f32x4*)(g + j * 256 + lane * 4);
            s += v[0] * v[0] + v[1] * v[1] + v[2] * v[2] + v[3] * v[3];
            half4 h; h[0] = (f16)(v[0] * gg[0]); h[1] = (f16)(v[1] * gg[1]); h[2] = (f16)(v[2] * gg[2]); h[3] = (f16)(v[3] * gg[3]);
            *(half4*)(xh + (size_t)t * DM + j * 256 + lane * 4) = h;
        }
        s = wave_sum(s);
        if (lane == 0) ss[t] = s;
    }
}
__device__ __forceinline__ void ph_prep(const Ctx& C, LAS unsigned char* lds, const float* const* in, unsigned char* ws) {
    LAS float* scr = (LAS float*)(lds + RING_OFF + C.wave * 16384);
    f16* wcat = (f16*)(ws + WS_WCAT); f16* wb = (f16*)(ws + WS_WB); f16* wout = (f16*)(ws + WS_WOUT); f16* wq = (f16*)(ws + WS_WQ); f16* poolw = (f16*)(ws + WS_POOLW);
    constexpr int I_IN = 16 * 40, I_G = 16 * 64, I_B = 8 * 32, I_O = 16 * 32, I_Q = 16 * 64, I_P = 2 * 4;
    constexpr int NITEMS = I_IN + I_G + 2 * I_B + I_O + I_Q + 4 * I_P;
    for (int it = C.gw; it < NITEMS; it += C.ngw) {
        int r = it;
        if (r < I_IN) { p0_transpose_item(in[2], 1024, 1280, wcat, 1024, 0, scr, r, C.lane); continue; } r -= I_IN;
        if (r < I_G) { p0_transpose_item(in[7], 1024, 2048, wcat + (size_t)NQKVU * 1024, 1024, 0, scr, r, C.lane); continue; } r -= I_G;
        if (r < I_B) { p0_transpose_item(in[6], 512, 1024, wb, 1024, 0, scr, r, C.lane); continue; } r -= I_B;
        if (r < I_B) { p0_transpose_item(in[6] + 512 * 1024, 512, 1024, wb, 1024, 512, scr, r, C.lane); continue; } r -= I_B;
        if (r < I_O) { p0_transpose_item(in[9], 1024, 1024, wout, 1024, 0, scr, r, C.lane); continue; } r -= I_O;
        if (r < I_Q) { p0_transpose_item(in[11], 1024, 2048, wq, 1024, 0, scr, r, C.lane); continue; } r -= I_Q;
        { const int g = r / I_P; p0_transpose_item(in[4] + g * 128 * 128, 128, 128, poolw + g * 128 * 128, 128, 0, scr, r % I_P, C.lane); }
    }
    cvt_stream(C, in[12], (f16*)(ws + WS_SUBK), (size_t)8 * 2 * 128 * 128 / 4);
    quant_rows<false>(C, in[13], (unsigned*)(ws + WS_UQ), (float*)(ws + WS_US));
    quant_rows<true>(C, in[14], (unsigned*)(ws + WS_VQ), (float*)(ws + WS_VS));
    rowprep(C, in[0], in[1], (f16*)(ws + WS_XH), (float*)(ws + WS_RS1));
}

__device__ __forceinline__ void ph_attn_naive(const Ctx& C, const f16* __restrict__ qkvu, const float* __restrict__ sink, f16* __restrict__ ocat) {
    for (int gid = C.gt; gid < T * 8; gid += C.ngt) {
        const int t = gid % T, h = gid / T;
        const int b = t / SEQ, ts = t % SEQ, kh = h >> 2;
        float q[64], o[64];
        const f16* qr = qkvu + (size_t)t * NQKVU + h * 64;
#pragma unroll
        for (int d = 0; d < 64; ++d) { q[d] = (float)qr[d]; o[d] = 0.f; }
        const float slope = exp2f(-(float)(h + 1));
        float m = -1e30f, l = 0.f;
        const int s0 = max(ts - 128, 0), s1 = min(ts + 128, SEQ - 1);
        for (int s = s0; s <= s1; ++s) {
            const f16* kr = qkvu + (size_t)(b * SEQ + s) * NQKVU + COL_K + kh * 64;
            const f16* vr = qkvu + (size_t)(b * SEQ + s) * NQKVU + COL_V + kh * 64;
            float dot = 0.f;
#pragma unroll
            for (int d = 0; d < 64; ++d) dot += q[d] * (float)kr[d];
            const float lg = dot * 0.125f - slope * fabsf((float)(ts - s));
            const float mn = fmaxf(m, lg), al = __expf(m - mn), p = __expf(lg - mn);
            l = l * al + p;
#pragma unroll
            for (int d = 0; d < 64; ++d) o[d] = o[d] * al + p * (float)vr[d];
            m = mn;
        }
        const float sk = sink[h];
        const float mn = fmaxf(m, sk), al = __expf(m - mn);
        l = l * al + __expf(sk - mn);
        const float inv = al / l;
        f16* orow = ocat + (size_t)t * DM + h * 64;
#pragma unroll
        for (int d = 0; d < 64; ++d) orow[d] = (f16)(o[d] * inv);
    }
}

__device__ __forceinline__ void ph_attn(const Ctx& C, const f16* __restrict__ qkvu, const f16* __restrict__ vT, const float* __restrict__ sink, f16* __restrict__ ocat) {
    const int lane = C.lane, r32 = lane & 31, hh = lane >> 5;
    const int krow = (r32 & 19) | ((r32 & 4) << 1) | ((r32 & 8) >> 1);
    constexpr float L2E = 1.4426950408889634f;
    for (int u = C.gw; u < BATCH * 8 * 64; u += C.ngw) {
        const int qs = u & 63, h = (u >> 6) & 7, b = u >> 9, kh = h >> 2;
        const int tq = qs * 32 + r32;
        const float slope2 = exp2f(-(float)(h + 1)) * L2E, sink2 = sink[h] * L2E;
        const f16* qrow = qkvu + (size_t)(b * SEQ + tq) * NQKVU + h * 64 + 8 * hh;
        half8 bq[4];
#pragma unroll
        for (int ks = 0; ks < 4; ++ks) bq[ks] = *(const half8*)(qrow + 16 * ks);
        f32x16 o0, o1;
#pragma unroll
        for (int r = 0; r < 16; ++r) { o0[r] = 0.f; o1[r] = 0.f; }
        float m = -1e30f, l = 0.f;
        const int kb_lo = max(qs - 4, 0), kb_hi = min(qs + 4, 63);
        const f16* vbase = vT + (size_t)((b * 2 + kh) * 64 + r32) * SEQ + 8 * hh;
#pragma unroll 1
        for (int kb = kb_lo; kb <= kb_hi; ++kb) {
            const f16* kr = qkvu + (size_t)(b * SEQ + kb * 32 + krow) * NQKVU + COL_K + kh * 64 + 8 * hh;
            f32x16 s;
#pragma unroll
            for (int r = 0; r < 16; ++r) s[r] = 0.f;
#pragma unroll
            for (int ks = 0; ks < 4; ++ks) { const half8 ak = *(const half8*)(kr + 16 * ks); s = __builtin_amdgcn_mfma_f32_32x32x16_f16(ak, bq[ks], s, 0, 0, 0); }
            half8 va[2][2];
#pragma unroll
            for (int db = 0; db < 2; ++db)
#pragma unroll
                for (int st = 0; st < 2; ++st) va[db][st] = *(const half8*)(vbase + (size_t)(db * 32) * SEQ + kb * 32 + 16 * st);
            float bmax = -1e30f; bool ok[16];
#pragma unroll
            for (int r = 0; r < 16; ++r) {
                const int tk = kb * 32 + 16 * (r >> 3) + 8 * hh + (r & 7);
                const int dist = abs(tq - tk);
                ok[r] = dist <= 128;
                s[r] = ok[r] ? s[r] * (0.125f * L2E) - slope2 * (float)dist : -1e30f;
                bmax = fmaxf(bmax, s[r]);
            }
            bmax = fmaxf(bmax, __shfl_xor(bmax, 32));
            const float mn = fmaxf(m, bmax), al = exp2f(m - mn);
            m = mn;
            float ps = 0.f; half8 pb[2];
#pragma unroll
            for (int r = 0; r < 16; ++r) { const float p = ok[r] ? exp2f(s[r] - mn) : 0.f; ps += p; pb[r >> 3][r & 7] = (f16)p; }
            l = l * al + ps;
#pragma unroll
            for (int r = 0; r < 16; ++r) { o0[r] *= al; o1[r] *= al; }
#pragma unroll
            for (int st = 0; st < 2; ++st) { o0 = __builtin_amdgcn_mfma_f32_32x32x16_f16(va[0][st], pb[st], o0, 0, 0, 0); o1 = __builtin_amdgcn_mfma_f32_32x32x16_f16(va[1][st], pb[st], o1, 0, 0, 0); }
        }
        l += __shfl_xor(l, 32);
        const float mf = fmaxf(m, sink2), al = exp2f(m - mf);
        const float sc = al / (l * al + exp2f(sink2 - mf));
        f16* orow = ocat + (size_t)(b * SEQ + tq) * DM + h * 64 + 4 * hh;
#pragma unroll
        for (int g = 0; g < 4; ++g) {
            half4 a, c;
#pragma unroll
            for (int i = 0; i < 4; ++i) { a[i] = (f16)(o0[4 * g + i] * sc); c[i] = (f16)(o1[4 * g + i] * sc); }
            *(half4*)(orow + 8 * g) = a; *(half4*)(orow + 32 + 8 * g) = c;
        }
    }
}

__device__ __forceinline__ void ph_pool_naive(const Ctx& C, const f16* __restrict__ qkvu, f16* __restrict__ mixed) {
    for (size_t gid = (size_t)C.gt; gid < (size_t)T * 512; gid += (size_t)C.ngt) {
        const int c = (int)(gid & 511), t = (int)(gid >> 9);
        const int b = t / SEQ, ts = t % SEQ, g = c >> 7, w = 2 << g;
        const int lo = max(ts - w / 2, 0), hi = min(ts + w / 2, SEQ);
        float s = 0.f;
        for (int i = lo; i < hi; ++i) s += (float)qkvu[(size_t)(b * SEQ + i) * NQKVU + COL_U + c];
        const float mean = s / (float)(hi - lo);
        mixed[(size_t)t * 512 + c] = (f16)(mean - (float)qkvu[(size_t)t * NQKVU + COL_U + c]);
    }
}
__device__ __forceinline__ void ph_poolmm_naive(const Ctx& C, const f16* __restrict__ mixed, const f16* __restrict__ poolw_t, const float* __restrict__ pscale, f16* __restrict__ ocat) {
    for (size_t gid = (size_t)C.gt; gid < (size_t)T * 512; gid += (size_t)C.ngt) {
        const int n = (int)(gid & 511), t = (int)(gid >> 9), g = n >> 7, d = n & 127;
        const f16* mr = mixed + (size_t)t * 512 + g * 128;
        const f16* wr = poolw_t + (size_t)(g * 128 + d) * 128;
        float acc = 0.f;
        for (int c = 0; c < 128; ++c) acc += (float)mr[c] * (float)wr[c];
        ocat[(size_t)t * DM + 512 + n] = (f16)(acc * pscale[n]);
    }
}

__device__ __forceinline__ void ph_pool(const Ctx& C, LAS unsigned char* lds, const f16* __restrict__ qkvu, const f16* __restrict__ poolw_t, const float* __restrict__ pscale, f16* __restrict__ ocat) {
    const int tid = C.tid, lane = C.lane, wv = C.wave, r32 = lane & 31, hh = lane >> 5;
    for (int u = blockIdx.x; u < (T / 128) * 4; u += C.G) {
        const int g = u & 3, t0 = (u >> 2) * 128, b = t0 >> 11, hw = 1 << g;
        {
            const int c2 = tid & 63, sf = (t0 & (SEQ - 1)) + wv * 16;
            const f16* ub = qkvu + (size_t)(b * SEQ) * NQKVU + COL_U + g * 128 + 2 * c2;
            float s0 = 0.f, s1 = 0.f;
            for (int s = max(sf - hw, 0); s < min(sf + hw, SEQ); ++s) { const half2 v = *(const half2*)(ub + (size_t)s * NQKVU); s0 += (float)v[0]; s1 += (float)v[1]; }
#pragma unroll 4
            for (int i = 0; i < 16; ++i) {
                const int s = sf + i, lo = max(s - hw, 0), hi = min(s + hw, SEQ);
                const float inv = 1.0f / (float)(hi - lo);
                const half2 cur = *(const half2*)(ub + (size_t)s * NQKVU);
                half2 mx; mx[0] = (f16)(s0 * inv - (float)cur[0]); mx[1] = (f16)(s1 * inv - (float)cur[1]);
                const int tl = wv * 16 + i;
                *(LAS half2*)(lds + tl * 256 + (((c2 >> 2) ^ (tl & 15)) << 4) + ((c2 & 3) << 2)) = mx;
                if (s + hw < SEQ) { const half2 v = *(const half2*)(ub + (size_t)(s + hw) * NQKVU); s0 += (float)v[0]; s1 += (float)v[1]; }
                if (s - hw >= 0) { const half2 v = *(const half2*)(ub + (size_t)(s - hw) * NQKVU); s0 -= (float)v[0]; s1 -= (float)v[1]; }
            }
        }
        __syncthreads();
        {
            const int tb = (wv & 3) * 32, d0 = (wv >> 2) * 64, tl = tb + r32;
            f32x16 acc0, acc1;
#pragma unroll
            for (int r = 0; r < 16; ++r) { acc0[r] = 0.f; acc1[r] = 0.f; }
            const f16* wr = poolw_t + (size_t)(g * 128 + d0 + r32) * 128 + 8 * hh;
#pragma unroll
            for (int ks = 0; ks < 8; ++ks) {
                const half8 bm = *(const LAS half8*)(lds + tl * 256 + (((2 * ks + hh) ^ (tl & 15)) << 4));
                const half8 a0 = *(const half8*)(wr + 16 * ks), a1 = *(const half8*)(wr + 32 * 128 + 16 * ks);
                acc0 = __builtin_amdgcn_mfma_f32_32x32x16_f16(a0, bm, acc0, 0, 0, 0);
                acc1 = __builtin_amdgcn_mfma_f32_32x32x16_f16(a1, bm, acc1, 0, 0, 0);
            }
            f16* orow = ocat + (size_t)(t0 + tl) * DM + 512 + g * 128 + d0 + 4 * hh;
            const float* ps = pscale + g * 128 + d0 + 4 * hh;
#pragma unroll
            for (int q = 0; q < 4; ++q) {
                const f32x4 p0 = *(const f32x4*)(ps + 8 * q), p1 = *(const f32x4*)(ps + 32 + 8 * q);
                half4 x0, x1;
#pragma unroll
                for (int i = 0; i < 4; ++i) { x0[i] = (f16)(acc0[4 * q + i] * p0[i]); x1[i] = (f16)(acc1[4 * q + i] * p1[i]); }
                *(half4*)(orow + 8 * q) = x0; *(half4*)(orow + 32 + 8 * q) = x1;
            }
        }
        __syncthreads();
    }
}

#define INS(LV, LI, v_, i_) do { float cv_ = (v_); int ci_ = (i_); \
    _Pragma("unroll") for (int z_ = 0; z_ < 16; ++z_) { const bool gt_ = cv_ > LV[z_]; const float tv_ = gt_ ? LV[z_] : cv_; const int ti_ = gt_ ? LI[z_] : ci_; \
        LV[z_] = gt_ ? cv_ : LV[z_]; LI[z_] = gt_ ? ci_ : LI[z_]; cv_ = tv_; ci_ = ti_; } } while (0)
__device__ __forceinline__ void ph_route_naive(const Ctx& C, const f16* __restrict__ qp, const float* __restrict__ ss2, const f16* __restrict__ subk, int* __restrict__ eidx, float* __restrict__ egate) {
    for (int gid = C.gt; gid < T * 8; gid += C.ngt) {
        const int t = gid % T, h = gid / T;
        const float rs2 = rs_from_ss(ss2, t);
        float av[16], bv[16]; int ai[16], bi[16];
#pragma unroll
        for (int z = 0; z < 16; ++z) { av[z] = -3e38f; bv[z] = -3e38f; ai[z] = 0; bi[z] = 0; }
        for (int p = 0; p < 2; ++p) {
            const f16* qr = qp + (size_t)t * 2048 + h * 256 + p * 128;
            for (int n = 0; n < 128; ++n) {
                const f16* kr = subk + ((size_t)((h * 2 + p) * 128 + n)) * 128;
                float dot = 0.f;
                for (int c = 0; c < 128; ++c) dot += (float)qr[c] * (float)kr[c];
                dot *= rs2;
                if (p == 0) INS(av, ai, dot, n); else INS(bv, bi, dot, n);
            }
        }
        float cv[16]; int ci[16];
#pragma unroll
        for (int z = 0; z < 16; ++z) { cv[z] = -3e38f; ci[z] = 0; }
#pragma unroll
        for (int i = 0; i < 16; ++i)
#pragma unroll
            for (int j = 0; j < 16; ++j)
                if ((i + 1) * (j + 1) <= 16) INS(cv, ci, av[i] + bv[j], ai[i] * 128 + bi[j]);
        float sum = 0.f, e[16];
#pragma unroll
        for (int z = 0; z < 16; ++z) { e[z] = __expf(cv[z] - cv[0]); sum += e[z]; }
        const float inv = 1.0f / sum;
#pragma unroll
        for (int z = 0; z < 16; ++z) { eidx[(size_t)t * 128 + h * 16 + z] = ci[z]; egate[(size_t)t * 128 + h * 16 + z] = e[z] * inv; }
    }
}

__device__ __forceinline__ int mono_i(float f) { const int b = __float_as_int(f); return b ^ ((b >> 31) & 0x7fffffff); }
__device__ __forceinline__ float unmono_f(int m) { return __int_as_float(m ^ ((m >> 31) & 0x7fffffff)); }
#define INS16(Lst, x_) do { int xv_ = (x_); _Pragma("unroll") for (int z_ = 0; z_ < 16; ++z_) { const int hi_ = max(Lst[z_], xv_); xv_ = min(Lst[z_], xv_); Lst[z_] = hi_; } } while (0)
__device__ __forceinline__ void merge_pair16(int (&Lst)[16]) {
    int P[16];
#pragma unroll
    for (int z = 0; z < 16; ++z) P[z] = __shfl_xor(Lst[z], 32);
#pragma unroll
    for (int z = 0; z < 16; ++z) Lst[z] = max(Lst[z], P[15 - z]);
#pragma unroll
    for (int s = 8; s >= 1; s >>= 1)
#pragma unroll
        for (int i = 0; i < 16; ++i) if ((i & s) == 0) { const int hi = max(Lst[i], Lst[i + s]), lo = min(Lst[i], Lst[i + s]); Lst[i] = hi; Lst[i + s] = lo; }
}
__device__ __forceinline__ void ph_route(const Ctx& C, LAS unsigned char* lds, const f16* __restrict__ qp, const float* __restrict__ ss2, const f16* __restrict__ subk,
                                         int* __restrict__ eidx, float* __restrict__ egate) {
    const int lane = C.lane, r32 = lane & 31, hh = lane >> 5;
    LAS unsigned char* tab = lds + C.wave * 4096 + lane * 36;
    for (int u = C.gw; u < (T / 32) * 8; u += C.ngw) {
        const int h = u & 7, t0 = (u >> 3) * 32, t = t0 + r32;
        const float rs2 = rs_from_ss(ss2, t);
        int top[2][16];
#pragma unroll
        for (int p = 0; p < 2; ++p) {
            const f16* qrow = qp + (size_t)t * 2048 + h * 256 + p * 128 + 8 * hh;
            const f16* kbase = subk + (size_t)((h * 2 + p) * 128 + r32) * 128 + 8 * hh;
            half8 bq[8];
#pragma unroll
            for (int ks = 0; ks < 8; ++ks) bq[ks] = *(const half8*)(qrow + 16 * ks);
            int Lst[16];
#pragma unroll
            for (int z = 0; z < 16; ++z) Lst[z] = (int)0x80000000;
#pragma unroll 1
            for (int nb = 0; nb < 4; ++nb) {
                f32x16 acc = {0.f, 0.f, 0.f, 0.f, 0.f, 0.f, 0.f, 0.f, 0.f, 0.f, 0.f, 0.f, 0.f, 0.f, 0.f, 0.f};
#pragma unroll
                for (int ks = 0; ks < 8; ++ks) {
                    const half8 ak = *(const half8*)(kbase + (size_t)(nb * 32) * 128 + 16 * ks);
                    acc = __builtin_amdgcn_mfma_f32_32x32x16_f16(ak, bq[ks], acc, 0, 0, 0);
                }
#pragma unroll
                for (int r = 0; r < 16; ++r) {
                    const int n = nb * 32 + (r & 3) + 8 * (r >> 2) + 4 * hh;
                    const int key = (mono_i(acc[r] * rs2) & ~127) | (127 - n);
                    INS16(Lst, key);
                }
            }
            merge_pair16(Lst);
#pragma unroll
            for (int z = 0; z < 16; ++z) top[p][z] = Lst[z];
        }
        float va[16], vb[16];
#pragma unroll
        for (int z = 0; z < 16; ++z) { va[z] = unmono_f(top[0][z] & ~127); vb[z] = unmono_f(top[1][z] & ~127);
            tab[z] = (unsigned char)(127 - (top[0][z] & 127)); tab[16 + z] = (unsigned char)(127 - (top[1][z] & 127)); }
        int Cl[16];
#pragma unroll
        for (int z = 0; z < 16; ++z) Cl[z] = (int)0x80000000;
#pragma unroll
        for (int i = 0; i < 16; ++i)
#pragma unroll
            for (int j = 0; j < 16; ++j)
                if ((i + 1) * (j + 1) <= 16) { const int key = (mono_i(va[i] + vb[j]) & ~255) | (255 - (i * 16 + j)); INS16(Cl, key); }
        float e[16], sum = 0.f; const float mx = unmono_f(Cl[0] & ~255);
#pragma unroll
        for (int z = 0; z < 16; ++z) { e[z] = __expf(unmono_f(Cl[z] & ~255) - mx); sum += e[z]; }
        const float inv = 1.0f / sum;
        LDS_WAIT();
        int* ei = eidx + (size_t)t * 128 + h * 16 + 8 * hh; float* eg = egate + (size_t)t * 128 + h * 16 + 8 * hh;
#pragma unroll
        for (int z = 0; z < 16; ++z) {
            if ((z >> 3) == hh) { const int code = 255 - (Cl[z] & 255); const int ia = tab[code >> 4], ib = tab[16 + (code & 15)];
                ei[z & 7] = ia * 128 + ib; eg[z & 7] = e[z] * inv; }
        }
        LDS_WAIT();
    }
}

typedef unsigned u32x4 __attribute__((ext_vector_type(4)));
struct Slicing { int m, pi, nloc, rank; };
__device__ __forceinline__ Slicing get_slicing(const unsigned* bar, volatile LAS unsigned* misc) {
    Slicing S; const unsigned x = (unsigned)__builtin_amdgcn_s_getreg((3 << 11) | 20) & 0xFu;
    int m = 0, pi = 0, nloc = 1;
    for (unsigned j = 0; j < 16; ++j) { const unsigned c = __hip_atomic_load(&bar[256 + 64 * j], __ATOMIC_RELAXED, __HIP_MEMORY_SCOPE_AGENT); if (c > 0u) { if (j < x) ++pi; ++m; } if (j == x) nloc = (int)c; }
    S.m = m > 0 ? m : 1; S.pi = pi; S.nloc = nloc > 0 ? nloc : 1; S.rank = (int)misc[10];
    return S;
}
__device__ __forceinline__ float gelu_fast(float v) {
    const float av = fabsf(v), t = __builtin_amdgcn_rcpf(av * 0.2316418882f + 1.0f);
    float q = t * 0.5307027145f + (-0.7265760135f); q = q * t + 0.7107068705f; q = q * t + (-0.142248368f); q = q * t + 0.127414796f; q = q * t;
    const float m = v * (q * __builtin_amdgcn_exp2f((v * v) * (-0.72134752044f)));
    return v < 0.f ? m : v - m;
}
__device__ __forceinline__ void ph_h2quant(const Ctx& C, const f16* __restrict__ x1h, const float* __restrict__ ss2, unsigned* __restrict__ h2q, float* __restrict__ hsc) {
    const int lane = C.lane;
    for (int t = C.gw; t < T; t += C.ngw) {
        const half8 h0 = *(const half8*)(x1h + (size_t)t * DM + 16 * lane), h1 = *(const half8*)(x1h + (size_t)t * DM + 16 * lane + 8);
        float hm = 0.f;
#pragma unroll
        for (int i = 0; i < 8; ++i) hm = fmaxf(hm, fmaxf(fabsf((float)h0[i]), fabsf((float)h1[i])));
        hm = wave_max(hm);
        const float inv = hm > 0.f ? 127.0f / hm : 0.f;
        u32x4 w;
        w[0] = (unsigned)pack4_i8((float)h0[0] * inv, (float)h0[1] * inv, (float)h0[2] * inv, (float)h0[3] * inv);
        w[1] = (unsigned)pack4_i8((float)h0[4] * inv, (float)h0[5] * inv, (float)h0[6] * inv, (float)h0[7] * inv);
        w[2] = (unsigned)pack4_i8((float)h1[0] * inv, (float)h1[1] * inv, (float)h1[2] * inv, (float)h1[3] * inv);
        w[3] = (unsigned)pack4_i8((float)h1[4] * inv, (float)h1[5] * inv, (float)h1[6] * inv, (float)h1[7] * inv);
        *(u32x4*)(h2q + (size_t)t * 256 + 4 * lane) = w;
        if (lane == 0) hsc[t] = hm * (1.0f / 127.0f) * rs_from_ss(ss2, t);
    }
}
__device__ __forceinline__ void ph_upeer(const Ctx& C, LAS unsigned char* lds, const Slicing SL, const unsigned* __restrict__ h2q, const int* __restrict__ eidx,
                                         const unsigned char* __restrict__ uq, int* __restrict__ pdot) {
    const int lane = C.lane, grp = lane >> 3, c8 = lane & 7;
    const int wv = SL.rank * NWAVES + C.wave, nwv = SL.nloc * NWAVES;
    const int ntok = (T - wv + nwv - 1) / nwv;
    auto tok = [&](int i) { const int t = wv + i * nwv; return t < T ? t : T - 1; };
    volatile LAS int* row = (volatile LAS int*)(lds + C.wave * 1024);
  for (int s = SL.pi; s < 8; s += SL.m) {
    const unsigned char* uqs = uq + s * 128 + c8 * 16;
    const unsigned* hqs = h2q + s * 32 + c8 * 4;
    int tA = tok(0), tB = tok(1);
    int e0 = eidx[(size_t)tA * 128 + lane], e1 = eidx[(size_t)tA * 128 + 64 + lane];
    u32x4 hq = *(const u32x4*)(hqs + (size_t)tA * 256);
    int ne0 = eidx[(size_t)tB * 128 + lane], ne1 = eidx[(size_t)tB * 128 + 64 + lane];
    u32x4 r[16];
#pragma unroll
    for (int i = 0; i < 16; ++i) { const int e = __shfl(i < 8 ? e0 : e1, 8 * (i & 7) + grp); r[i] = *(const u32x4*)(uqs + (size_t)e * DM); }
#pragma unroll 1
    for (int it = 0; it < ntok; ++it) {
        const int t = tok(it), t1 = tok(it + 1), t2 = tok(it + 2);
        const int ze0 = eidx[(size_t)t2 * 128 + lane], ze1 = eidx[(size_t)t2 * 128 + 64 + lane];
        const u32x4 nhq = *(const u32x4*)(hqs + (size_t)t1 * 256);
#pragma unroll
        for (int hf = 0; hf < 2; ++hf) {
            int evv[8];
#pragma unroll
            for (int i = 0; i < 8; ++i) evv[i] = __shfl(hf ? ne1 : ne0, 8 * i + grp);
#pragma unroll
            for (int ii = 0; ii < 8; ++ii) {
                const int i = hf * 8 + ii;
                int p = __builtin_amdgcn_sdot4((int)r[i][0], (int)hq[0], 0, false); p = __builtin_amdgcn_sdot4((int)r[i][1], (int)hq[1], p, false);
                p = __builtin_amdgcn_sdot4((int)r[i][2], (int)hq[2], p, false); p = __builtin_amdgcn_sdot4((int)r[i][3], (int)hq[3], p, false);
                p += dppi<0xB1>(p); p += dppi<0x4E>(p); p += dppi<0x141>(p);
                if (c8 == 0) row[8 * i + grp] = p;
                asm volatile("" ::: "memory");
                r[i] = *(const u32x4*)(uqs + (size_t)evv[ii] * DM);
                asm volatile("" ::: "memory");
            }
        }
        LDS_WAIT();
        const int p0 = row[lane], p1 = row[64 + lane];
        LDS_WAIT();
        { int* pp = pdot + ((size_t)s * T + t) * 128 + lane; asm volatile("global_store_dword %0, %1, off\n\tglobal_store_dword %0, %2, off offset:256" :: "v"(pp), "v"(p0), "v"(p1) : "memory"); }
        hq = nhq; ne0 = ze0; ne1 = ze1;
    }
  }
}
__device__ __forceinline__ void ph_ureduce(const Ctx& C, const int* __restrict__ pdot, const float* __restrict__ hsc, const int* __restrict__ eidx, const float* __restrict__ us,
                                           const float* __restrict__ egate, float* __restrict__ act) {
    const int lane = C.lane;
    for (int t = C.gw; t < T; t += C.ngw) {
        const int e0 = eidx[(size_t)t * 128 + lane], e1 = eidx[(size_t)t * 128 + 64 + lane];
        int s0 = 0, s1 = 0;
#pragma unroll
        for (int s = 0; s < 8; ++s) { const int* pp = pdot + ((size_t)s * T + t) * 128 + lane; s0 += pp[0]; s1 += pp[64]; }
        const float h = hsc[t];
        act[(size_t)t * 128 + lane] = gelu_fast((float)s0 * h * us[e0]) * egate[(size_t)t * 128 + lane];
        act[(size_t)t * 128 + 64 + lane] = gelu_fast((float)s1 * h * us[e1]) * egate[(size_t)t * 128 + 64 + lane];
    }
}

template <int EMASK>
__device__ __forceinline__ void ph_vpeer(const Ctx& C, const Slicing SL, const int* __restrict__ eidx, const float* __restrict__ act, const unsigned char* __restrict__ vq, const float* __restrict__ vs,
                                         const float* xio, float* xout, float* __restrict__ ssf) {
    const int lane = C.lane, grp = lane >> 3, c8 = lane & 7;
    const bool hh = (lane & 32) != 0, b4 = (lane & 16) != 0, b3 = (lane & 8) != 0;
    const int wv = SL.rank * NWAVES + C.wave, nwv = SL.nloc * NWAVES;
    const int ntok = (T - wv + nwv - 1) / nwv;
    auto tok = [&](int i) { const int t = wv + i * nwv; return t < T ? t : T - 1; };
  for (int s = SL.pi; s < 8; s += SL.m) {
    const unsigned char* vqs = vq + s * 128 + c8 * 16;
    const int chl = 8 * (hh ? 1 : 0) + 4 * (b4 ? 1 : 0) + 2 * (b3 ? 1 : 0);
    const int coff = s * 128 + c8 * 16 + chl;
    int tA = tok(0), tB = tok(1);
    int e0 = eidx[(size_t)tA * 128 + lane], e1 = eidx[(size_t)tA * 128 + 64 + lane];
    float w0 = act[(size_t)tA * 128 + lane] * vs[e0], w1 = act[(size_t)tA * 128 + 64 + lane] * vs[e1];
    int ne0 = eidx[(size_t)tB * 128 + lane], ne1 = eidx[(size_t)tB * 128 + 64 + lane];
    float na0 = act[(size_t)tB * 128 + lane], na1 = act[(size_t)tB * 128 + 64 + lane];
    u32x4 r[16];
#pragma unroll
    for (int i = 0; i < 16; ++i) { const int e = __shfl(i < 8 ? e0 : e1, 8 * (i & 7) + grp) & EMASK; r[i] = *(const u32x4*)(vqs + (size_t)e * DM); }
#pragma unroll 1
    for (int it = 0; it < ntok; ++it) {
        const int t = tok(it), t2 = tok(it + 2);
        const int ze0 = eidx[(size_t)t2 * 128 + lane], ze1 = eidx[(size_t)t2 * 128 + 64 + lane];
        const float za0 = act[(size_t)t2 * 128 + lane], za1 = act[(size_t)t2 * 128 + 64 + lane];
        const float nv0 = vs[ne0], nv1 = vs[ne1];
        const float2 xv = *(const float2*)(xio + (size_t)t * DM + coff);
        float o[16], wsum = 0.f;
#pragma unroll
        for (int c = 0; c < 16; ++c) o[c] = 0.f;
#pragma unroll
        for (int hf = 0; hf < 2; ++hf) {
            float wvv[8]; int evv[8];
#pragma unroll
            for (int i = 0; i < 8; ++i) { wvv[i] = __shfl(hf ? w1 : w0, 8 * i + grp); evv[i] = __shfl(hf ? ne1 : ne0, 8 * i + grp) & EMASK; }
#pragma unroll
            for (int ii = 0; ii < 8; ++ii) {
                const int i = hf * 8 + ii;
                const float w = wvv[ii];
                wsum += w;
#pragma unroll
                for (int d = 0; d < 4; ++d) {
                    const unsigned q = r[i][d];
                    o[4 * d + 0] = fmaf(w, (float)(q & 0xffu), o[4 * d + 0]); o[4 * d + 1] = fmaf(w, (float)((q >> 8) & 0xffu), o[4 * d + 1]);
                    o[4 * d + 2] = fmaf(w, (float)((q >> 16) & 0xffu), o[4 * d + 2]); o[4 * d + 3] = fmaf(w, (float)(q >> 24), o[4 * d + 3]);
                }
                asm volatile("" ::: "memory");
                r[i] = *(const u32x4*)(vqs + (size_t)evv[ii] * DM);
                asm volatile("" ::: "memory");
            }
        }
        float q8[8], q4[4], q2[2];
#pragma unroll
        for (int k = 0; k < 8; ++k) q8[k] = bfly32(o[k], o[8 + k]);
#pragma unroll
        for (int k = 0; k < 4; ++k) q4[k] = bfly16(q8[k], q8[4 + k]);
#pragma unroll
        for (int k = 0; k < 2; ++k) { const float mine = b3 ? q4[2 + k] : q4[k], oth = b3 ? q4[k] : q4[2 + k]; q2[k] = mine + dppf<0x128>(oth); }
        wsum += dppf<0x128>(wsum); wsum = bfly16(wsum, wsum); wsum = bfly32(wsum, wsum);
        const float y0 = xv.x + (q2[0] - 128.0f * wsum), y1 = xv.y + (q2[1] - 128.0f * wsum);
        { float* yp = xout + (size_t)t * DM + coff; const float2 yv = make_float2(y0, y1); asm volatile("global_store_dwordx2 %0, %1, off" :: "v"(yp), "v"(yv) : "memory"); }
        const float ss = wave_sum(y0 * y0 + y1 * y1);
        if (lane == 0) { float* sp = ssf + (size_t)s * T + t; asm volatile("global_store_dword %0, %1, off" :: "v"(sp), "v"(ss) : "memory"); }
        w0 = na0 * nv0; w1 = na1 * nv1;
        ne0 = ze0; ne1 = ze1; na0 = za0; na1 = za1;
    }
  }
}
__device__ __forceinline__ void ph_final(const Ctx& C, const float* __restrict__ ssf, float* xio, const float* __restrict__ gf) {
    const int lane = C.lane;
    for (int t = C.gw; t < T; t += C.ngw) {
        float s = 0.f;
#pragma unroll
        for (int i = 0; i < 8; ++i) s += ssf[(size_t)i * T + t];
        const float r = rsqrtf(s * (1.0f / DM) + EPS);
        float* xr = xio + (size_t)t * DM;
#pragma unroll
        for (int j = 0; j < 4; ++j) {
            const int c0 = j * 256 + lane * 4;
            const f32x4 v = *(const f32x4*)(xr + c0), gg = *(const f32x4*)(gf + c0);
            *(f32x4*)(xr + c0) = v * r * gg;
        }
    }
}

namespace pg8 {
#define PG8_LAS __attribute__((address_space(3)))
typedef _Float16 frag8 __attribute__((ext_vector_type(8)));
typedef float f32x4 __attribute__((ext_vector_type(4)));
constexpr int BM = 256, BK = 64, HALF = 128, HTB = HALF * BK * 2  , STAGE_BYTES = 8 * HTB, NXCD = 8, WGM = 8;

__host__ __device__ __forceinline__ int lds_byte(int r, int c) { const int st = (r >> 4) * 2 + (c >> 5), rr = r & 15, cc = c & 31, ob = rr * 64 + cc * 2; return st * 1024 + (ob ^ (((ob >> 9) & 1) << 5)); }
__host__ __device__ __forceinline__ void stage_rc(int b, int& R, int& C) { const int st = b / 1024, sb = b % 1024, swz = sb ^ (((sb >> 9) & 1) << 5); R = (st >> 1) * 16 + swz / 64; C = (st & 1) * 32 + (swz % 64) / 2; }
__host__ __device__ __forceinline__ int perm32(int rho) { const int n = rho >> 4, i = rho & 15; return 8 * (i >> 2) + 4 * n + (i & 3); }

struct Unit { int pm, pn; };
struct Gemm { const f16* A; const f16* Bt; int M, N, K; };

struct StaticOrder {
    int nM, nN, nwg, G, c;
    __host__ __device__ void init(int M, int N, int G_, int c_) { nM = M / BM; nN = N / BM; nwg = nM * nN; G = G_; c = c_; }
    __host__ __device__ bool next(int i, Unit& u) const {
        const long L = (long)i * G + c; if (L >= nwg) return false;
        int wgid = (int)L; { const int q = nwg / NXCD, r = nwg % NXCD, xcd = wgid % NXCD, off = wgid / NXCD; wgid = (xcd < r ? xcd * (q + 1) : r * (q + 1) + (xcd - r) * q) + off; }
        const int nig = WGM * nN, gid = wgid / nig, fm = gid * WGM, gsz = (nM - fm) < WGM ? (nM - fm) : WGM;
        u.pm = fm + ((wgid % nig) % gsz); u.pn = (wgid % nig) / gsz; return true;
    }
    __device__ __forceinline__ void a_ready(const Unit&) const {}
    __device__ __forceinline__ void done(const Unit&) const {}
};

__device__ __forceinline__ frag8 pack8(const f32x4 a, const f32x4 b) {
    frag8 h; h[0] = (f16)a[0]; h[1] = (f16)a[1]; h[2] = (f16)a[2]; h[3] = (f16)a[3]; h[4] = (f16)b[0]; h[5] = (f16)b[1]; h[6] = (f16)b[2]; h[7] = (f16)b[3]; return h;
}
__device__ __forceinline__ float sigmoidf_(float z) { return 1.0f / (1.0f + __expf(-z)); }

struct EpiP1 {
    static constexpr bool PERM = true, AFTER_DRAIN = false, MIDK = false;
    const float* ss1; const float* bgate; f16* qkvu; f16* gates; f16* vT;
    __device__ __forceinline__ void operator()(const f32x4 (&acc)[2][2][4][2], const Unit& u, int wr, int wc, int fr, int fq) const {
        const int row0 = u.pm * BM + wr * 64 + fr, colt = u.pn * BM; const bool isg = colt >= NQKVU;
#pragma unroll
        for (int ai = 0; ai < 2; ++ai)
#pragma unroll
            for (int m = 0; m < 4; ++m) { const int row = row0 + ai * HALF + m * 16; const float r = rsqrtf(ss1[row] * (1.0f / DM) + EPS);
#pragma unroll
                for (int bj = 0; bj < 2; ++bj) { const int c0 = colt + bj * HALF + wc * 32 + 8 * fq; f32x4 v0 = acc[ai][bj][m][0] * r, v1 = acc[ai][bj][m][1] * r;
                    if (isg) { const int cg = c0 - NQKVU; const f32x4 b0 = *(const f32x4*)(bgate + cg), b1 = *(const f32x4*)(bgate + cg + 4);
#pragma unroll
                        for (int i = 0; i < 4; ++i) { v0[i] = sigmoidf_(v0[i] + b0[i]); v1[i] = sigmoidf_(v1[i] + b1[i]); }
                        *(frag8*)(gates + (size_t)row * NGATE + cg) = pack8(v0, v1); }
                    else { const frag8 hv = pack8(v0, v1); *(frag8*)(qkvu + (size_t)row * NQKVU + c0) = hv;
                        if (colt == 512 && bj == 1) {
                            f16* vp = vT + ((size_t)((row >> 11) * 2 + (wc >> 1)) * 64 + (wc & 1) * 32 + 8 * fq) * SEQ + (row & (SEQ - 1));
#pragma unroll
                            for (int i = 0; i < 8; ++i) vp[(size_t)i * SEQ] = hv[i]; } } } }
    }
};
struct EpiMerged {
    static constexpr bool PERM = true, AFTER_DRAIN = false, MIDK = true;
    const f16* gates; f16* merged;
    __device__ __forceinline__ void mid(f32x4 (&acc)[2][2][4][2], const Unit& u, int wr, int wc, int fr, int fq) const {
        const int row0 = u.pm * BM + wr * 64 + fr, colt = u.pn * BM;
        const f16* gb = gates + (size_t)row0 * NGATE + colt + wc * 32 + 8 * fq;
        asm volatile("" : "+v"(gb));
#pragma unroll
        for (int ai = 0; ai < 2; ++ai) {
            frag8 g0[4][2], g1[4][2];
#pragma unroll
            for (int m = 0; m < 4; ++m)
#pragma unroll
                for (int bj = 0; bj < 2; ++bj) { const f16* gp = gb + (size_t)(ai * HALF + m * 16) * NGATE + bj * HALF; g0[m][bj] = *(const frag8*)gp; g1[m][bj] = *(const frag8*)(gp + DM); }
#pragma unroll
            for (int m = 0; m < 4; ++m)
#pragma unroll
                for (int bj = 0; bj < 2; ++bj)
#pragma unroll
                    for (int i = 0; i < 4; ++i) {
                        acc[ai][bj][m][0][i] *= (float)g0[m][bj][i] * __builtin_amdgcn_rcpf(fmaxf((float)g1[m][bj][i], 1e-4f));
                        acc[ai][bj][m][1][i] *= (float)g0[m][bj][4 + i] * __builtin_amdgcn_rcpf(fmaxf((float)g1[m][bj][4 + i], 1e-4f)); }
            asm volatile("" ::: "memory");
        }
    }
    __device__ __forceinline__ void operator()(const f32x4 (&acc)[2][2][4][2], const Unit& u, int wr, int wc, int fr, int fq) const {
        const int row0 = u.pm * BM + wr * 64 + fr, colt = u.pn * BM;
#pragma unroll
        for (int ai = 0; ai < 2; ++ai)
#pragma unroll
            for (int m = 0; m < 4; ++m) { const int row = row0 + ai * HALF + m * 16;
#pragma unroll
                for (int bj = 0; bj < 2; ++bj) { const int c0 = colt + bj * HALF + wc * 32 + 8 * fq;
                    const frag8 g1 = *(const frag8*)(gates + (size_t)row * NGATE + DM + c0); f32x4 v0, v1;
#pragma unroll
                    for (int i = 0; i < 4; ++i) { v0[i] = acc[ai][bj][m][0][i] * fmaxf((float)g1[i], 1e-4f); v1[i] = acc[ai][bj][m][1][i] * fmaxf((float)g1[4 + i], 1e-4f); }
                    *(frag8*)(merged + (size_t)row * DM + c0) = pack8(v0, v1); } }
    }
};
struct EpiOut {
    static constexpr bool PERM = false, AFTER_DRAIN = false, MIDK = false;
    const float* x; const float* g2; float* x1; f16* x1h; float* ss2p;
    __device__ __forceinline__ void operator()(const f32x4 (&acc)[2][2][4][2], const Unit& u, int wr, int wc, int fr, int fq) const {
        const int row0 = u.pm * BM + wr * 64 + fr, col0 = u.pn * BM + wc * 32 + 4 * fq;
        f32x4 gv[2][2];
#pragma unroll
        for (int bj = 0; bj < 2; ++bj)
#pragma unroll
            for (int n = 0; n < 2; ++n) gv[bj][n] = *(const f32x4*)(g2 + col0 + bj * HALF + n * 16);
#pragma unroll
        for (int ai = 0; ai < 2; ++ai)
#pragma unroll
            for (int m = 0; m < 4; ++m) { const int row = row0 + ai * HALF + m * 16; const size_t off = (size_t)row * DM + col0; float ssq = 0.f;
#pragma unroll
                for (int bj = 0; bj < 2; ++bj)
#pragma unroll
                    for (int n = 0; n < 2; ++n) { const f32x4 y = *(const f32x4*)(x + off + bj * HALF + n * 16) + acc[ai][bj][m][n];
                        *(f32x4*)(x1 + off + bj * HALF + n * 16) = y; ssq += (y[0] * y[0] + y[1] * y[1]) + (y[2] * y[2] + y[3] * y[3]);
                        const f32x4 yg = y * gv[bj][n]; half4 h; h[0] = (f16)yg[0]; h[1] = (f16)yg[1]; h[2] = (f16)yg[2]; h[3] = (f16)yg[3];
                        *(half4*)(x1h + off + bj * HALF + n * 16) = h; }
                ssq += __shfl_xor(ssq, 16); ssq += __shfl_xor(ssq, 32);
                if (fq == 0) ss2p[(size_t)(u.pn * 4 + wc) * T + row] = ssq; }
    }
};
struct EpiQ {
    static constexpr bool PERM = true, AFTER_DRAIN = false, MIDK = false;
    f16* qp;
    __device__ __forceinline__ void operator()(const f32x4 (&acc)[2][2][4][2], const Unit& u, int wr, int wc, int fr, int fq) const {
        const int row0 = u.pm * BM + wr * 64 + fr, colt = u.pn * BM;
#pragma unroll
        for (int ai = 0; ai < 2; ++ai)
#pragma unroll
            for (int m = 0; m < 4; ++m) { const int row = row0 + ai * HALF + m * 16;
#pragma unroll
                for (int bj = 0; bj < 2; ++bj) { const int c0 = colt + bj * HALF + wc * 32 + 8 * fq;
                    *(frag8*)(qp + (size_t)row * 2048 + c0) = pack8(acc[ai][bj][m][0], acc[ai][bj][m][1]); } }
    }
};

template <class Epi, class Sched, bool ALIGN_EPI = false, bool SP2 = false>
__device__ __forceinline__ void gemm_phase(PG8_LAS unsigned char* lds, const Gemm g, const Sched& S, const Epi& E) {
    const int tid = threadIdx.x, wid = __builtin_amdgcn_readfirstlane(tid >> 6), lane = tid & 63, wr = wid >> 2, wc = wid & 3, fr = lane & 15, fq = lane >> 4;
    const int K = g.K, nt = K / BK;
    unsigned voffA[2], voffB[2];
#pragma unroll
    for (int i = 0; i < 2; ++i) { int R, C; stage_rc(tid * 16 + i * 8192, R, C); const int Rb = Epi::PERM ? ((R & ~31) + perm32(R & 31)) : R;
        voffA[i] = (unsigned)(R * K + C) * 2u; voffB[i] = (unsigned)(Rb * K + C) * 2u; }
    const size_t kstep = (size_t)(BK * 2);
    const size_t hstep = (size_t)HALF * K * 2;
    const size_t tstep = 2 * hstep;
    const unsigned ldsw = (unsigned)wid * 1024u;
    const int aoff = lds_byte(wr * 64 + fr, fq * 8), boff = lds_byte(wc * 32 + fr, fq * 8);
#define PG8_SA(b, h) (((b) * 2 + (h)) * HTB)
#define PG8_SB(b, h) ((4 + (b) * 2 + (h)) * HTB)
#define PG8_STAGE(bufoff, gbase, voff) do { _Pragma("unroll") for (int _i = 0; _i < 2; ++_i) \
        __builtin_amdgcn_global_load_lds((const unsigned*)((const char*)(gbase) + (voff)[_i]), (PG8_LAS unsigned*)(lds + (bufoff) + ldsw + _i * 8192), 16, 0, 0); } while (0)
#define PG8_LDA(dst, b, h) do { _Pragma("unroll") for (int m = 0; m < 4; ++m) _Pragma("unroll") for (int k = 0; k < 2; ++k) dst[m][k] = *(const PG8_LAS frag8*)(lds + PG8_SA(b, h) + aoff + m * 2048 + k * 1024); } while (0)
#define PG8_LDB(dst, b, h) do { _Pragma("unroll") for (int n = 0; n < 2; ++n) _Pragma("unroll") for (int k = 0; k < 2; ++k) dst[n][k] = *(const PG8_LAS frag8*)(lds + PG8_SB(b, h) + boff + n * 2048 + k * 1024); } while (0)
#define PG8_MMA(ai, bj, At, Bt) do { __builtin_amdgcn_s_setprio(1); _Pragma("unroll") for (int m = 0; m < 4; ++m) _Pragma("unroll") for (int n = 0; n < 2; ++n) _Pragma("unroll") for (int k = 0; k < 2; ++k) \
        acc[ai][bj][m][n] = __builtin_amdgcn_mfma_f32_16x16x32_f16(Bt[n][k], At[m][k], acc[ai][bj][m][n], 0, 0, 0); __builtin_amdgcn_s_setprio(0); } while (0)
#define PG8_WAIT_V(n) asm volatile("s_waitcnt vmcnt(" #n ")" ::: "memory")
#define PG8_WAIT_L(n) asm volatile("s_waitcnt lgkmcnt(" #n ")" ::: "memory")
#define PG8_BAR __builtin_amdgcn_s_barrier()
#define PG8_SCHED __builtin_amdgcn_sched_barrier(0)
    Unit cur, nxt; int ui = 0;
    if (!S.next(0, cur)) return;
    f32x4 acc[2][2][4][2];
#pragma unroll
    for (int a = 0; a < 2; ++a)
#pragma unroll
        for (int b = 0; b < 2; ++b)
#pragma unroll
            for (int m = 0; m < 4; ++m)
#pragma unroll
                for (int n = 0; n < 2; ++n) acc[a][b][m][n] = (f32x4){0.f, 0.f, 0.f, 0.f};
    frag8 At[4][2], B0[2][2], B1[2][2];
    const char* cA = (const char*)g.A + (size_t)cur.pm * tstep; const char* cB = (const char*)g.Bt + (size_t)cur.pn * tstep;
    S.a_ready(cur);
    if constexpr (SP2) {
        PG8_STAGE(PG8_SB(0, 0), cB, voffB); PG8_STAGE(PG8_SB(0, 1), cB + hstep, voffB); PG8_STAGE(PG8_SA(0, 0), cA, voffA); PG8_STAGE(PG8_SA(0, 1), cA + hstep, voffA);
        if (wr == 1) PG8_BAR;
        PG8_WAIT_V(2); PG8_BAR;
        PG8_STAGE(PG8_SB(1, 0), cB + kstep, voffB); PG8_STAGE(PG8_SA(1, 0), cA + kstep, voffA); PG8_STAGE(PG8_SB(1, 1), cB + hstep + kstep, voffB);
        PG8_WAIT_V(6); PG8_BAR;
    } else {
        PG8_STAGE(PG8_SB(0, 0), cB, voffB); PG8_STAGE(PG8_SA(0, 0), cA, voffA); PG8_STAGE(PG8_SB(0, 1), cB + hstep, voffB); PG8_STAGE(PG8_SA(0, 1), cA + hstep, voffA);
        if (wr == 1) PG8_BAR;
        PG8_WAIT_V(4); PG8_BAR;
        PG8_STAGE(PG8_SB(1, 0), cB + kstep, voffB); PG8_STAGE(PG8_SA(1, 0), cA + kstep, voffA); PG8_STAGE(PG8_SB(1, 1), cB + hstep + kstep, voffB);
        PG8_WAIT_V(6); PG8_BAR;
    }
    for (;;) {
        const bool has_next = S.next(ui + 1, nxt);
        const char* nA = has_next ? (const char*)g.A + (size_t)nxt.pm * tstep : cA; const char* nB = has_next ? (const char*)g.Bt + (size_t)nxt.pn * tstep : cB;
        for (int t = 0; t < nt; t += 2) {
            const bool last = (t == nt - 2);
            if constexpr (Epi::MIDK) { if (t == (nt >> 1)) E.mid(acc, cur, wr, wc, fr, fq); }
            const char* a1 = cA + (size_t)(t + 1) * kstep;
            const char* a2 = last ? nA : cA + (size_t)(t + 2) * kstep; const char* b2 = last ? nB : cB + (size_t)(t + 2) * kstep;
            const char* a3 = a2 + kstep; const char* b3 = b2 + kstep;
            if (last && has_next) S.a_ready(nxt);
            if constexpr (SP2) {
            PG8_LDB(B0, 0, 0); PG8_LDB(B1, 0, 1); PG8_SCHED; PG8_LDA(At, 0, 0); PG8_STAGE(PG8_SA(1, 1), a1 + hstep, voffA);
            PG8_WAIT_V(8); PG8_WAIT_L(0); PG8_BAR; PG8_MMA(0, 0, At, B0); PG8_MMA(0, 1, At, B1); PG8_BAR; PG8_SCHED;
            PG8_LDA(At, 0, 1); PG8_STAGE(PG8_SB(0, 0), b2, voffB); PG8_STAGE(PG8_SB(0, 1), b2 + hstep, voffB); PG8_STAGE(PG8_SA(0, 0), a2, voffA);
            PG8_WAIT_V(8); PG8_WAIT_L(0); PG8_BAR; PG8_MMA(1, 0, At, B0); PG8_MMA(1, 1, At, B1); PG8_BAR; PG8_SCHED;
            PG8_LDB(B0, 1, 0); PG8_LDB(B1, 1, 1); PG8_SCHED; PG8_LDA(At, 1, 0); PG8_STAGE(PG8_SA(0, 1), a2 + hstep, voffA);
            PG8_WAIT_V(8); PG8_WAIT_L(0); PG8_BAR; PG8_MMA(0, 0, At, B0); PG8_MMA(0, 1, At, B1); PG8_BAR; PG8_SCHED;
            PG8_LDA(At, 1, 1); PG8_STAGE(PG8_SB(1, 0), b3, voffB); PG8_STAGE(PG8_SB(1, 1), b3 + hstep, voffB); PG8_STAGE(PG8_SA(1, 0), a3, voffA);
            PG8_WAIT_V(8); PG8_WAIT_L(0); PG8_BAR; PG8_MMA(1, 0, At, B0); PG8_MMA(1, 1, At, B1); PG8_BAR; PG8_SCHED;
            } else {
            PG8_LDB(B0, 0, 0); PG8_SCHED; PG8_LDA(At, 0, 0); PG8_STAGE(PG8_SA(1, 1), a1 + hstep, voffA);
            PG8_WAIT_L(8); PG8_BAR; PG8_WAIT_L(0); PG8_MMA(0, 0, At, B0); PG8_BAR; PG8_SCHED;
            PG8_LDB(B1, 0, 1); PG8_STAGE(PG8_SB(0, 0), b2, voffB);
            PG8_BAR; PG8_WAIT_L(0); PG8_MMA(0, 1, At, B1); PG8_BAR;
            PG8_LDA(At, 0, 1); PG8_STAGE(PG8_SA(0, 0), a2, voffA);
            PG8_BAR; PG8_WAIT_L(0); PG8_MMA(1, 0, At, B0); PG8_BAR; PG8_SCHED;
            PG8_STAGE(PG8_SB(0, 1), b2 + hstep, voffB);
            PG8_WAIT_V(6); PG8_BAR; PG8_MMA(1, 1, At, B1); PG8_BAR;
            PG8_LDB(B0, 1, 0); PG8_SCHED; PG8_LDA(At, 1, 0); PG8_STAGE(PG8_SA(0, 1), a2 + hstep, voffA);
            PG8_WAIT_L(8); PG8_BAR; PG8_WAIT_L(0); PG8_MMA(0, 0, At, B0); PG8_BAR; PG8_SCHED;
            PG8_LDB(B1, 1, 1); PG8_STAGE(PG8_SB(1, 0), b3, voffB);
            PG8_BAR; PG8_WAIT_L(0); PG8_MMA(0, 1, At, B1); PG8_BAR;
            PG8_LDA(At, 1, 1); PG8_STAGE(PG8_SA(1, 0), a3, voffA);
            PG8_BAR; PG8_WAIT_L(0); PG8_MMA(1, 0, At, B0); PG8_BAR; PG8_SCHED;
            PG8_STAGE(PG8_SB(1, 1), b3 + hstep, voffB);
            PG8_WAIT_V(6); PG8_BAR; PG8_MMA(1, 1, At, B1); PG8_BAR;
            }
        }
        if constexpr (ALIGN_EPI) { if (wr == 0) PG8_BAR; }
        if constexpr (!Epi::AFTER_DRAIN) { E(acc, cur, wr, wc, fr, fq); S.done(cur); }
        if (!has_next) break;
#pragma unroll
        for (int a = 0; a < 2; ++a)
#pragma unroll
            for (int b = 0; b < 2; ++b)
#pragma unroll
                for (int m = 0; m < 4; ++m)
#pragma unroll
                    for (int n = 0; n < 2; ++n) acc[a][b][m][n] = (f32x4){0.f, 0.f, 0.f, 0.f};
        cur = nxt; cA = nA; cB = nB; ++ui;
        if constexpr (ALIGN_EPI) { if (wr == 1) PG8_BAR; }
    }
    PG8_WAIT_V(0);
    if constexpr (!ALIGN_EPI) { if (wr == 0) PG8_BAR; }
    PG8_BAR;
    if constexpr (Epi::AFTER_DRAIN) { E.fused(acc, cur, wr, wc, fr, fq, lds, wid, lane); S.done(cur); }
#undef PG8_SA
#undef PG8_SB
#undef PG8_STAGE
#undef PG8_LDA
#undef PG8_LDB
#undef PG8_MMA
#undef PG8_WAIT_V
#undef PG8_WAIT_L
#undef PG8_BAR
#undef PG8_SCHED
}
}

#define XB_TMO      128
#define XB_XCNT(j)  (256  + 64 * (j))
#define XB_XSUB(j)  (1280 + 64 * (j))
#define XB_XGEN(j)  (2304 + 64 * (j))
#define XB_TOP      3328
#define XB_TOPGEN   3392
#define XCD_BAR_WORDS 3456
#define XB_SPIN_CAP (1u << 18)

__device__ __forceinline__ unsigned xb_ld(unsigned* p)              { return __hip_atomic_load(p, __ATOMIC_RELAXED, __HIP_MEMORY_SCOPE_AGENT); }
__device__ __forceinline__ unsigned xb_add(unsigned* p, unsigned v) { return __hip_atomic_fetch_add(p, v, __ATOMIC_RELAXED, __HIP_MEMORY_SCOPE_AGENT); }
__device__ __forceinline__ unsigned xb_xcc_id() { return (unsigned)__builtin_amdgcn_s_getreg((3 << 11) | 20) & 0xFu; }
#define XB_SPIN(cond, bar) do { unsigned _sp = 0; while (cond) { __builtin_amdgcn_s_sleep(1); \
    if ((++_sp & 255u) == 0u) { if (xb_ld(&(bar)[XB_TMO])) break; if (_sp > XB_SPIN_CAP) { atomicAdd(&(bar)[XB_TMO], 1u); break; } } } } while (0)

struct XcdBarrier {
    unsigned* bar; unsigned x;
    volatile LAS unsigned* st;
};

__device__ __forceinline__ XcdBarrier xcd_barrier_post(unsigned* bar, volatile LAS unsigned* st) {
    XcdBarrier b; b.bar = bar; b.x = xb_xcc_id(); b.st = st;
    if (threadIdx.x == 0) st[2] = xb_add(&bar[XB_XCNT(b.x)], 1u);
    return b;
}
__device__ __forceinline__ void xcd_barrier_complete(unsigned* bar, unsigned x, unsigned& nloc, unsigned& nx) {
    const unsigned G = gridDim.x * gridDim.y * gridDim.z;
    unsigned sum, cnt, mine, sp = 0u;
    for (;;) {
        sum = 0u; cnt = 0u; mine = 0u;
#pragma unroll
        for (unsigned j = 0; j < 16; ++j) { const unsigned c = xb_ld(&bar[XB_XCNT(j)]); sum += c; cnt += (c > 0u) ? 1u : 0u; mine = (j == x) ? c : mine; }
        if (sum == G) break;
        __builtin_amdgcn_s_sleep(1);
        if ((++sp & 255u) == 0u) { if (xb_ld(&bar[XB_TMO])) break; if (sp > XB_SPIN_CAP) { atomicAdd(&bar[XB_TMO], 1u); break; } }
    }
    nloc = mine > 0u ? mine : 1u; nx = cnt > 0u ? cnt : 1u;
}

__device__ __forceinline__ void xcd_barrier(const XcdBarrier& b) {
    asm volatile("s_waitcnt vmcnt(0)" ::: "memory");
    __syncthreads();
    if (threadIdx.x == 0) {
        unsigned* bar = b.bar;
        __builtin_amdgcn_s_waitcnt(0);
        unsigned nloc = b.st[0], nx = b.st[1];
        if (nloc == 0u) { xcd_barrier_complete(bar, b.x, nloc, nx); b.st[0] = nloc; b.st[1] = nx; }
        const unsigned old = xb_add(&bar[XB_XSUB(b.x)], 1u);
        const unsigned gen = old / nloc;
        if (old + 1u == (gen + 1u) * nloc) {
            __builtin_amdgcn_fence(__ATOMIC_RELEASE, "agent");
            asm volatile("s_waitcnt vmcnt(0)" ::: "memory");
            const unsigned og = xb_add(&bar[XB_TOP], 1u);
            const unsigned tg = og / nx;
            if (og + 1u == (tg + 1u) * nx) xb_add(&bar[XB_TOPGEN], 1u);
            else XB_SPIN(xb_ld(&bar[XB_TOPGEN]) == tg, bar);
            __builtin_amdgcn_fence(__ATOMIC_ACQUIRE, "agent");
            xb_add(&bar[XB_XGEN(b.x)], 1u);
            asm volatile("s_waitcnt vmcnt(0)" ::: "memory");
        } else {
            XB_SPIN(xb_ld(&bar[XB_XGEN(b.x)]) == gen, bar);
            __builtin_amdgcn_fence(__ATOMIC_ACQUIRE, "agent");
            asm volatile("s_waitcnt vmcnt(0)" ::: "memory");
        }
    }
    __syncthreads();
}


struct Args { const float* in[16]; float* out; unsigned char* ws; int ph_lo, ph_hi; };
constexpr int N_PHASES = 11;

__global__ void __launch_bounds__(NTHREADS, 2) mk_fwd(Args a) {
    extern __shared__ __attribute__((aligned(16))) unsigned char lds[];
    LAS unsigned char* L = (LAS unsigned char*)lds;
    volatile LAS unsigned* MISC = (volatile LAS unsigned*)(L + MISC_OFF);
    unsigned char* ws = a.ws;
    Ctx C;
    C.tid = threadIdx.x; C.lane = C.tid & 63; C.wave = __builtin_amdgcn_readfirstlane(C.tid >> 6);
    C.G = gridDim.x; C.gw = blockIdx.x * NWAVES + C.wave; C.ngw = C.G * NWAVES; C.gt = blockIdx.x * NTHREADS + C.tid; C.ngt = C.G * NTHREADS;
    for (int u = C.tid; u < (LDS_BYTES - LDSCTL_OFF) / 4; u += NTHREADS) ((LAS unsigned*)(L + LDSCTL_OFF))[u] = 0u;
    __syncthreads();
    const int lo = a.ph_lo, hi = a.ph_hi, G = C.G;
    const bool multi = (hi - lo) > 1;
    XcdBarrier bar; bar.bar = (unsigned*)(ws + WS_CTL) + CW_BAR; bar.x = 0; bar.st = nullptr;
    if (multi) bar = xcd_barrier_post((unsigned*)(ws + WS_CTL) + CW_BAR, MISC + 8);
#define IN(k) (lo <= (k) && (k) < hi)
#define SEAM(k) do { if (IN(k) && IN((k) + 1)) xcd_barrier(bar); } while (0)

#define REPS(k) for (int rep_ = 0; rep_ < ((PROBE_DUP == (k)) ? 2 : 1); ++rep_)
#define REPBAR(k) do { if (PROBE_DUP == (k) && rep_ == 0) xcd_barrier(bar); } while (0)
    if (IN(0)) REPS(0) { ph_prep(C, L, a.in, ws); REPBAR(0); }
    SEAM(0);
    if (IN(1)) REPS(1) {
        pg8::Gemm g{(const f16*)(ws + WS_XH), (const f16*)(ws + WS_WCAT), T, NCAT, DM}; pg8::StaticOrder S; S.init(T, NCAT, G, (int)blockIdx.x);
        pg8::EpiP1 E{(const float*)(ws + WS_RS1), a.in[8], (f16*)(ws + WS_QKVU), (f16*)(ws + WS_GATES), (f16*)(ws + WS_VT)};
        pg8::gemm_phase<pg8::EpiP1, pg8::StaticOrder, true, true>(L, g, S, E);
        REPBAR(1);
    }
    SEAM(1);
    if (IN(2)) REPS(2) {
        ph_attn(C, (const f16*)(ws + WS_QKVU), (const f16*)(ws + WS_VT), a.in[3], (f16*)(ws + WS_OCAT));
        REPBAR(2);
    }
    if (IN(2)) REPS(3) {
        ph_pool(C, L, (const f16*)(ws + WS_QKVU), (const f16*)(ws + WS_POOLW), a.in[5], (f16*)(ws + WS_OCAT));
        REPBAR(3);
    }
    if (IN(2) && IN(4)) xcd_barrier(bar);
    if (IN(4)) REPS(4) {
        pg8::Gemm g{(const f16*)(ws + WS_OCAT), (const f16*)(ws + WS_WB), T, DM, DM}; pg8::StaticOrder S; S.init(T, DM, G, (int)blockIdx.x);
        pg8::EpiMerged E{(const f16*)(ws + WS_GATES), (f16*)(ws + WS_MERGED)};
        pg8::gemm_phase<pg8::EpiMerged, pg8::StaticOrder, true, true>(L, g, S, E);
        REPBAR(4);
    }
    SEAM(4);
    if (IN(5)) REPS(5) {
        pg8::Gemm g{(const f16*)(ws + WS_MERGED), (const f16*)(ws + WS_WOUT), T, DM, DM}; pg8::StaticOrder S; S.init(T, DM, G, (int)blockIdx.x);
        pg8::EpiOut E{a.in[0], a.in[10], a.out, (f16*)(ws + WS_X1H), (float*)(ws + WS_SS2)};
        pg8::gemm_phase<pg8::EpiOut, pg8::StaticOrder, true, true>(L, g, S, E);
        REPBAR(5);
    }
    SEAM(5);
    if (IN(6)) REPS(6) {
        pg8::Gemm g{(const f16*)(ws + WS_X1H), (const f16*)(ws + WS_WQ), T, 2048, DM}; pg8::StaticOrder S; S.init(T, 2048, G, (int)blockIdx.x);
        pg8::EpiQ E{(f16*)(ws + WS_QP)};
        pg8::gemm_phase<pg8::EpiQ, pg8::StaticOrder, true, true>(L, g, S, E);
        REPBAR(6);
    }
    SEAM(6);
    if (IN(7)) REPS(7) { ph_route(C, L, (const f16*)(ws + WS_QP), (const float*)(ws + WS_SS2), (const f16*)(ws + WS_SUBK), (int*)(ws + WS_EIDX), (float*)(ws + WS_EGATE));
        ph_h2quant(C, (const f16*)(ws + WS_X1H), (const float*)(ws + WS_SS2), (unsigned*)(ws + WS_H2Q), (float*)(ws + WS_HSC)); REPBAR(7); }
    SEAM(7);
    if (IN(8)) REPS(8) {
        const Slicing SL = get_slicing((const unsigned*)(ws + WS_CTL) + CW_BAR, MISC);
        ph_upeer(C, L, SL, (const unsigned*)(ws + WS_H2Q), (const int*)(ws + WS_EIDX), (const unsigned char*)(ws + WS_UQ), (int*)(ws + WS_PDOT));
        REPBAR(8);
    }
    SEAM(8);
    if (IN(9)) {
        ph_ureduce(C, (const int*)(ws + WS_PDOT), (const float*)(ws + WS_HSC), (const int*)(ws + WS_EIDX), (const float*)(ws + WS_US), (const float*)(ws + WS_EGATE), (float*)(ws + WS_ACT));
        xcd_barrier(bar);
        const Slicing SL = get_slicing((const unsigned*)(ws + WS_CTL) + CW_BAR, MISC);
        if (PROBE_DUP == 9) {
            ph_vpeer<255>(C, SL, (const int*)(ws + WS_EIDX), (const float*)(ws + WS_ACT), (const unsigned char*)(ws + WS_VQ), (const float*)(ws + WS_VS), a.out, (float*)(ws + WS_QP), (float*)(ws + WS_MERGED));
            xcd_barrier(bar);
        }
        if (PROBE_DUP == 19) {
            ph_vpeer<16383>(C, SL, (const int*)(ws + WS_EIDX), (const float*)(ws + WS_ACT), (const unsigned char*)(ws + WS_VQ), (const float*)(ws + WS_VS), a.out, (float*)(ws + WS_QP), (float*)(ws + WS_MERGED));
            xcd_barrier(bar);
        }
        ph_vpeer<16383>(C, SL, (const int*)(ws + WS_EIDX), (const float*)(ws + WS_ACT), (const unsigned char*)(ws + WS_VQ), (const float*)(ws + WS_VS), a.out, a.out, (float*)(ws + WS_SSF));
    }
    SEAM(9);
    if (IN(10)) { ph_final(C, (const float*)(ws + WS_SSF), a.out, a.in[15]); }
#undef IN
#undef SEAM
}

#ifndef MK_N_LAUNCHES
#define MK_N_LAUNCHES 1
#endif
extern "C" void kernel_launch(void* const* d_in, const int* in_sizes, int n_in, void* d_out, int out_size, void* d_ws, size_t ws_size, hipStream_t stream) {
    static int grid = 0;
    if (grid == 0) {
        if (n_in != 16 || in_sizes[0] != T * DM || out_size != T * DM || ws_size < WS_END) {
            fprintf(stderr, "kernel_launch: unexpected shapes (n_in %d in0 %d out %d ws %zu)\n", n_in, n_in > 0 ? in_sizes[0] : -1, out_size, ws_size);
            grid = -1; return;
        }
        int dev = 0, cus = 0;
        if (hipGetDevice(&dev) != hipSuccess || hipDeviceGetAttribute(&cus, hipDeviceAttributeMultiprocessorCount, dev) != hipSuccess) { grid = -1; return; }
        if (hipFuncSetAttribute((const void*)mk_fwd, hipFuncAttributeMaxDynamicSharedMemorySize, LDS_BYTES) != hipSuccess) { fprintf(stderr, "kernel_launch: hipFuncSetAttribute failed\n"); grid = -1; return; }
        int per_cu = 0;
        if (hipOccupancyMaxActiveBlocksPerMultiprocessor(&per_cu, (const void*)mk_fwd, NTHREADS, LDS_BYTES) != hipSuccess || per_cu < 1)
            fprintf(stderr, "kernel_launch: occupancy query reports %d workgroups per CU\n", per_cu);
        (void)hipGetLastError();
        grid = cus;
    }
    if (grid < 0) return;
    (void)hipMemsetAsync((char*)d_ws + WS_CTL, 0, CTL_ZERO_BYTES, stream);
    Args a{};
    for (int i = 0; i < 16; ++i) a.in[i] = (const float*)d_in[i];
    a.out = (float*)d_out; a.ws = (unsigned char*)d_ws;
    if (MK_N_LAUNCHES == 1) {
        a.ph_lo = 0; a.ph_hi = N_PHASES;
        hipLaunchKernelGGL(mk_fwd, dim3(grid), dim3(NTHREADS), LDS_BYTES, stream, a);
    } else {
        for (int p = 0; p < N_PHASES; ++p) { a.ph_lo = p; a.ph_hi = p + 1; hipLaunchKernelGGL(mk_fwd, dim3(grid), dim3(NTHREADS), LDS_BYTES, stream, a); }
    }
}
```

```cpp
#include <hip/hip_runtime.h>
#include <cstdint>
#include <cstdio>

typedef _Float16 f16;
typedef _Float16 half8 __attribute__((ext_vector_type(8)));
typedef _Float16 half4 __attribute__((ext_vector_type(4)));
typedef _Float16 half2 __attribute__((ext_vector_type(2)));
typedef float f32x4 __attribute__((ext_vector_type(4)));
typedef float f32x16 __attribute__((ext_vector_type(16)));
#define LAS __attribute__((address_space(3)))
#ifndef PROBE_DIAG
#define PROBE_DIAG (0)
#endif
#ifndef PROBE_DUP
#define PROBE_DUP (-1)
#endif
#define GAS __attribute__((address_space(1)))

constexpr int DM = 1024, BATCH = 16, SEQ = 2048, T = BATCH * SEQ;
constexpr int NQKVU = 1280, NGATE = 2048, NCAT = NQKVU + NGATE;
constexpr int COL_K = 512, COL_V = 640, COL_U = 768;
constexpr int NEXP = 16384, PEER_H = 8, TOPK = 16;
constexpr float EPS = 1e-6f;
constexpr int NWAVES = 8, NTHREADS = NWAVES * 64;

constexpr size_t MiB = 1u << 20;
constexpr size_t WS_CTL = 0, CTL_ZERO_BYTES = 64 * 1024;
constexpr size_t WS_WCAT = 1 * MiB;
constexpr size_t WS_WB = 8 * MiB;
constexpr size_t WS_WOUT = 10 * MiB;
constexpr size_t WS_WQ = 12 * MiB;
constexpr size_t WS_POOLW = 16 * MiB;
constexpr size_t WS_SUBK = 16 * MiB + 512 * 1024;
constexpr size_t WS_RS1 = 17 * MiB;
constexpr size_t WS_EIDX = 18 * MiB;
constexpr size_t WS_EGATE = 34 * MiB;
constexpr size_t WS_UTAB = 50 * MiB;
constexpr size_t WS_VTAB = 82 * MiB;
constexpr size_t WS_XH = 114 * MiB;
constexpr size_t WS_MERGED = WS_XH;
constexpr size_t WS_QKVU = 178 * MiB;
constexpr size_t WS_X1H = WS_QKVU;
constexpr size_t WS_GATES = 258 * MiB;
constexpr size_t WS_QP = WS_GATES;
constexpr size_t WS_OCAT = 386 * MiB;
constexpr size_t WS_UQ = 450 * MiB;
constexpr size_t WS_VQ = 466 * MiB;
constexpr size_t WS_US = 17 * MiB + 256 * 1024, WS_VS = 17 * MiB + 512 * 1024;
constexpr size_t WS_PDOT = WS_GATES;
constexpr size_t WS_H2Q = 404 * MiB;
constexpr size_t WS_HSC = 403 * MiB;
constexpr size_t WS_SSF = 402 * MiB;
constexpr size_t WS_WQP = 386 * MiB;
constexpr size_t WS_WSC = 390 * MiB;
constexpr size_t WS_ACT = 386 * MiB;
constexpr size_t WS_SS2 = 482 * MiB;
constexpr size_t WS_VT = 484 * MiB;
constexpr size_t WS_END = 492 * MiB;
constexpr int CW_BAR = 4096;

constexpr int RING_OFF = 0, RING_BYTES = 131072;
constexpr int LDSCTL_OFF = RING_BYTES, MISC_OFF = LDSCTL_OFF + 320;
constexpr int LDS_BYTES = 147456;

#define LDS_WAIT() asm volatile("s_waitcnt lgkmcnt(0)" ::: "memory")
template <int CTRL> __device__ __forceinline__ float dppf(float x) { return __uint_as_float(__builtin_amdgcn_update_dpp(0u, __float_as_uint(x), CTRL, 0xf, 0xf, false)); }
template <int CTRL> __device__ __forceinline__ int dppi(int x) { return (int)__builtin_amdgcn_update_dpp(0u, (unsigned)x, CTRL, 0xf, 0xf, false); }
__device__ __forceinline__ float bfly32(float a, float b) { auto r = __builtin_amdgcn_permlane32_swap(__float_as_uint(a), __float_as_uint(b), false, false); return __uint_as_float(r[0]) + __uint_as_float(r[1]); }
__device__ __forceinline__ float bfly16(float a, float b) { auto r = __builtin_amdgcn_permlane16_swap(__float_as_uint(a), __float_as_uint(b), false, false); return __uint_as_float(r[0]) + __uint_as_float(r[1]); }
__device__ __forceinline__ int bfly32i(int a, int b) { auto r = __builtin_amdgcn_permlane32_swap((unsigned)a, (unsigned)b, false, false); return (int)(r[0] + r[1]); }
__device__ __forceinline__ int bfly16i(int a, int b) { auto r = __builtin_amdgcn_permlane16_swap((unsigned)a, (unsigned)b, false, false); return (int)(r[0] + r[1]); }
__device__ __forceinline__ float wave_sum(float x) {
    x += dppf<0x121>(x); x += dppf<0x122>(x); x += dppf<0x124>(x); x += dppf<0x128>(x);
    x = bfly16(x, x); return bfly32(x, x);
}
__device__ __forceinline__ int wave_sum_i(int x) {
    x += dppi<0x121>(x); x += dppi<0x122>(x); x += dppi<0x124>(x); x += dppi<0x128>(x);
    x = bfly16i(x, x); return bfly32i(x, x);
}
__device__ __forceinline__ float wave_max(float x) {
    x = fmaxf(x, dppf<0x121>(x)); x = fmaxf(x, dppf<0x122>(x)); x = fmaxf(x, dppf<0x124>(x)); x = fmaxf(x, dppf<0x128>(x));
    { auto r = __builtin_amdgcn_permlane16_swap(__float_as_uint(x), __float_as_uint(x), false, false); x = fmaxf(__uint_as_float(r[0]), __uint_as_float(r[1])); }
    { auto r = __builtin_amdgcn_permlane32_swap(__float_as_uint(x), __float_as_uint(x), false, false); x = fmaxf(__uint_as_float(r[0]), __uint_as_float(r[1])); }
    return x;
}
__device__ __forceinline__ float gelu_exact(float x) { return 0.5f * x * (1.0f + erff(x * 0.70710678118654752f)); }
__device__ __forceinline__ float rs_from_ss(const float* ss, int t) {
    float s = 0.f;
#pragma unroll
    for (int i = 0; i < 16; ++i) s += ss[(size_t)i * T + t];
    return rsqrtf(s * (1.0f / DM) + EPS);
}

struct Ctx {
    int tid, lane, wave;
    int G;
    int gw, ngw;
    int gt, ngt;
};

__device__ __forceinline__ int pack4_i8(float a, float b, float c, float d) {
    const int ia = (int)rintf(a), ib = (int)rintf(b), ic = (int)rintf(c), id = (int)rintf(d);
    return (ia & 0xff) | ((ib & 0xff) << 8) | ((ic & 0xff) << 16) | (id << 24);
}
template <bool OFFS>
__device__ __forceinline__ void quant_rows(const Ctx& C, const float* __restrict__ tab, unsigned* __restrict__ q, float* __restrict__ scale) {
    const int lane = C.lane;
    for (int r = C.gw; r < NEXP; r += C.ngw) {
        const float* row = tab + (size_t)r * DM;
        f32x4 v[4]; float m = 0.f;
#pragma unroll
        for (int j = 0; j < 4; ++j) { v[j] = *(const f32x4*)(row + j * 256 + lane * 4); m = fmaxf(m, fmaxf(fmaxf(fabsf(v[j][0]), fabsf(v[j][1])), fmaxf(fabsf(v[j][2]), fabsf(v[j][3])))); }
        m = wave_max(m);
        const float inv = m > 0.f ? 127.0f / m : 0.f;
#pragma unroll
        for (int j = 0; j < 4; ++j) {
            unsigned w = (unsigned)pack4_i8(v[j][0] * inv, v[j][1] * inv, v[j][2] * inv, v[j][3] * inv);
            if (OFFS) w ^= 0x80808080u;
            q[(size_t)r * 256 + j * 64 + lane] = w;
        }
        if (lane == 0) scale[r] = m * (1.0f / 127.0f);
    }
}

__device__ __forceinline__ void p0_transpose_item(const float* W, int K, int N, f16* WT, int ldo, int koff, LAS float* scr, int item, int lane) {
    const int nblk = N / 32, kb = item / nblk, nb = item % nblk, k0 = 64 * kb, n0 = 32 * nb;
#pragma unroll 8
    for (int i = 0; i < 32; ++i) { const int kk = 2 * i + (lane >> 5); scr[kk * 33 + (lane & 31)] = W[(size_t)(k0 + kk) * N + n0 + (lane & 31)]; }
    LDS_WAIT(); asm volatile("" ::: "memory");
    const int c = lane & 7;
#pragma unroll
    for (int j = 0; j < 4; ++j) { const int n = (lane >> 3) + 8 * j; const LAS float* s = scr + (8 * c) * 33 + n;
        half8 o;
#pragma unroll
        for (int i = 0; i < 8; ++i) o[i] = (f16)s[i * 33];
        *(half8*)(WT + (size_t)(n0 + n) * ldo + koff + k0 + 8 * c) = o; }
    LDS_WAIT(); asm volatile("" ::: "memory");
}
__device__ __forceinline__ void cvt_stream(const Ctx& C, const float* in, f16* out, size_t n4) {
    for (size_t i = (size_t)C.gt; i < n4; i += (size_t)C.ngt) {
        const f32x4 v = ((const f32x4*)in)[i];
        half4 h; h[0] = (f16)v[0]; h[1] = (f16)v[1]; h[2] = (f16)v[2]; h[3] = (f16)v[3];
        ((half4*)out)[i] = h;
    }
}
__device__ __forceinline__ void rowprep(const Ctx& C, const float* x, const float* g, f16* xh, float* ss) {
    const int lane = C.lane;
    for (int t = C.gw; t < T; t += C.ngw) {
        const float* xr = x + (size_t)t * DM;
        float s = 0.f;
#pragma unroll
        for (int j = 0; j < 4; ++j) {
            const f32x4 v = *(const f32x4*)(xr + j * 256 + lane * 4);
            const f32x4 gg = *(const f32x4*)(g + j * 256 + lane * 4);
            s += v[0] * v[0] + v[1] * v[1] + v[2] * v[2] + v[3] * v[3];
            half4 h; h[0] = (f16)(v[0] * gg[0]); h[1] = (f16)(v[1] * gg[1]); h[2] = (f16)(v[2] * gg[2]); h[3] = (f16)(v[3] * gg[3]);
            *(half4*)(xh + (size_t)t * DM + j * 256 + lane * 4) = h;
        }
        s = wave_sum(s);
        if (lane == 0) ss[t] = s;
    }
}
__device__ __forceinline__ void ph_prep(const Ctx& C, LAS unsigned char* lds, const float* const* in, unsigned char* ws) {
    LAS float* scr = (LAS float*)(lds + RING_OFF + C.wave * 16384);
    f16* wcat = (f16*)(ws + WS_WCAT); f16* wb = (f16*)(ws + WS_WB); f16* wout = (f16*)(ws + WS_WOUT); f16* wq = (f16*)(ws + WS_WQ); f16* poolw = (f16*)(ws + WS_POOLW);
    constexpr int I_IN = 16 * 40, I_G = 16 * 64, I_B = 8 * 32, I_O = 16 * 32, I_Q = 16 * 64, I_P = 2 * 4;
    constexpr int NITEMS = I_IN + I_G + 2 * I_B + I_O + I_Q + 4 * I_P;
    for (int it = C.gw; it < NITEMS; it += C.ngw) {
        int r = it;
        if (r < I_IN) { p0_transpose_item(in[2], 1024, 1280, wcat, 1024, 0, scr, r, C.lane); continue; } r -= I_IN;
        if (r < I_G) { p0_transpose_item(in[7], 1024, 2048, wcat + (size_t)NQKVU * 1024, 1024, 0, scr, r, C.lane); continue; } r -= I_G;
        if (r < I_B) { p0_transpose_item(in[6], 512, 1024, wb, 1024, 0, scr, r, C.lane); continue; } r -= I_B;
        if (r < I_B) { p0_transpose_item(in[6] + 512 * 1024, 512, 1024, wb, 1024, 512, scr, r, C.lane); continue; } r -= I_B;
        if (r < I_O) { p0_transpose_item(in[9], 1024, 1024, wout, 1024, 0, scr, r, C.lane); continue; } r -= I_O;
        if (r < I_Q) { p0_transpose_item(in[11], 1024, 2048, wq, 1024, 0, scr, r, C.lane); continue; } r -= I_Q;
        { const int g = r / I_P; p0_transpose_item(in[4] + g * 128 * 128, 128, 128, poolw + g * 128 * 128, 128, 0, scr, r % I_P, C.lane); }
    }
    cvt_stream(C, in[12], (f16*)(ws + WS_SUBK), (size_t)8 * 2 * 128 * 128 / 4);
    quant_rows<false>(C, in[13], (unsigned*)(ws + WS_UQ), (float*)(ws + WS_US));
    quant_rows<false>(C, in[14], (unsigned*)(ws + WS_VQ), (float*)(ws + WS_VS));
    rowprep(C, in[0], in[1], (f16*)(ws + WS_XH), (float*)(ws + WS_RS1));
}

__device__ __forceinline__ void ph_attn_naive(const Ctx& C, const f16* __restrict__ qkvu, const float* __restrict__ sink, f16* __restrict__ ocat) {
    for (int gid = C.gt; gid < T * 8; gid += C.ngt) {
        const int t = gid % T, h = gid / T;
        const int b = t / SEQ, ts = t % SEQ, kh = h >> 2;
        float q[64], o[64];
        const f16* qr = qkvu + (size_t)t * NQKVU + h * 64;
#pragma unroll
        for (int d = 0; d < 64; ++d) { q[d] = (float)qr[d]; o[d] = 0.f; }
        const float slope = exp2f(-(float)(h + 1));
        float m = -1e30f, l = 0.f;
        const int s0 = max(ts - 128, 0), s1 = min(ts + 128, SEQ - 1);
        for (int s = s0; s <= s1; ++s) {
            const f16* kr = qkvu + (size_t)(b * SEQ + s) * NQKVU + COL_K + kh * 64;
            const f16* vr = qkvu + (size_t)(b * SEQ + s) * NQKVU + COL_V + kh * 64;
            float dot = 0.f;
#pragma unroll
            for (int d = 0; d < 64; ++d) dot += q[d] * (float)kr[d];
            const float lg = dot * 0.125f - slope * fabsf((float)(ts - s));
            const float mn = fmaxf(m, lg), al = __expf(m - mn), p = __expf(lg - mn);
            l = l * al + p;
#pragma unroll
            for (int d = 0; d < 64; ++d) o[d] = o[d] * al + p * (float)vr[d];
            m = mn;
        }
        const float sk = sink[h];
        const float mn = fmaxf(m, sk), al = __expf(m - mn);
        l = l * al + __expf(sk - mn);
        const float inv = al / l;
        f16* orow = ocat + (size_t)t * DM + h * 64;
#pragma unroll
        for (int d = 0; d < 64; ++d) orow[d] = (f16)(o[d] * inv);
    }
}

__device__ __forceinline__ void ph_attn(const Ctx& C, const f16* __restrict__ qkvu, const f16* __restrict__ vT, const float* __restrict__ sink, f16* __restrict__ ocat) {
    const int lane = C.lane, r32 = lane & 31, hh = lane >> 5;
    const int krow = (r32 & 19) | ((r32 & 4) << 1) | ((r32 & 8) >> 1);
    constexpr float L2E = 1.4426950408889634f;
    for (int u = C.gw; u < BATCH * 8 * 64; u += C.ngw) {
        const int qs = u & 63, h = (u >> 6) & 7, b = u >> 9, kh = h >> 2;
        const int tq = qs * 32 + r32;
        const float slope2 = exp2f(-(float)(h + 1)) * L2E, sink2 = sink[h] * L2E;
        const f16* qrow = qkvu + (size_t)(b * SEQ + tq) * NQKVU + h * 64 + 8 * hh;
        half8 bq[4];
#pragma unroll
        for (int ks = 0; ks < 4; ++ks) bq[ks] = *(const half8*)(qrow + 16 * ks);
        f32x16 o0, o1;
#pragma unroll
        for (int r = 0; r < 16; ++r) { o0[r] = 0.f; o1[r] = 0.f; }
        float m = -1e30f, l = 0.f;
        const int kb_lo = max(qs - 4, 0), kb_hi = min(qs + 4, 63);
        const f16* vbase = vT + (size_t)((b * 2 + kh) * 64 + r32) * SEQ + 8 * hh;
#pragma unroll 1
        for (int kb = kb_lo; kb <= kb_hi; ++kb) {
            const f16* kr = qkvu + (size_t)(b * SEQ + kb * 32 + krow) * NQKVU + COL_K + kh * 64 + 8 * hh;
            f32x16 s;
#pragma unroll
            for (int r = 0; r < 16; ++r) s[r] = 0.f;
#pragma unroll
            for (int ks = 0; ks < 4; ++ks) { const half8 ak = *(const half8*)(kr + 16 * ks); s = __builtin_amdgcn_mfma_f32_32x32x16_f16(ak, bq[ks], s, 0, 0, 0); }
            half8 va[2][2];
#pragma unroll
            for (int db = 0; db < 2; ++db)
#pragma unroll
                for (int st = 0; st < 2; ++st) va[db][st] = *(const half8*)(vbase + (size_t)(db * 32) * SEQ + kb * 32 + 16 * st);
            float bmax = -1e30f; bool ok[16];
#pragma unroll
            for (int r = 0; r < 16; ++r) {
                const int tk = kb * 32 + 16 * (r >> 3) + 8 * hh + (r & 7);
                const int dist = abs(tq - tk);
                ok[r] = dist <= 128;
                s[r] = ok[r] ? s[r] * (0.125f * L2E) - slope2 * (float)dist : -1e30f;
                bmax = fmaxf(bmax, s[r]);
            }
            bmax = fmaxf(bmax, __shfl_xor(bmax, 32));
            const float mn = fmaxf(m, bmax), al = exp2f(m - mn);
            m = mn;
            float ps = 0.f; half8 pb[2];
#pragma unroll
            for (int r = 0; r < 16; ++r) { const float p = ok[r] ? exp2f(s[r] - mn) : 0.f; ps += p; pb[r >> 3][r & 7] = (f16)p; }
            l = l * al + ps;
#pragma unroll
            for (int r = 0; r < 16; ++r) { o0[r] *= al; o1[r] *= al; }
#pragma unroll
            for (int st = 0; st < 2; ++st) { o0 = __builtin_amdgcn_mfma_f32_32x32x16_f16(va[0][st], pb[st], o0, 0, 0, 0); o1 = __builtin_amdgcn_mfma_f32_32x32x16_f16(va[1][st], pb[st], o1, 0, 0, 0); }
        }
        l += __shfl_xor(l, 32);
        const float mf = fmaxf(m, sink2), al = exp2f(m - mf);
        const float sc = al / (l * al + exp2f(sink2 - mf));
        f16* orow = ocat + (size_t)(b * SEQ + tq) * DM + h * 64 + 4 * hh;
#pragma unroll
        for (int g = 0; g < 4; ++g) {
            half4 a, c;
#pragma unroll
            for (int i = 0; i < 4; ++i) { a[i] = (f16)(o0[4 * g + i] * sc); c[i] = (f16)(o1[4 * g + i] * sc); }
            *(half4*)(orow + 8 * g) = a; *(half4*)(orow + 32 + 8 * g) = c;
        }
    }
}

__device__ __forceinline__ void ph_pool_naive(const Ctx& C, const f16* __restrict__ qkvu, f16* __restrict__ mixed) {
    for (size_t gid = (size_t)C.gt; gid < (size_t)T * 512; gid += (size_t)C.ngt) {
        const int c = (int)(gid & 511), t = (int)(gid >> 9);
        const int b = t / SEQ, ts = t % SEQ, g = c >> 7, w = 2 << g;
        const int lo = max(ts - w / 2, 0), hi = min(ts + w / 2, SEQ);
        float s = 0.f;
        for (int i = lo; i < hi; ++i) s += (float)qkvu[(size_t)(b * SEQ + i) * NQKVU + COL_U + c];
        const float mean = s / (float)(hi - lo);
        mixed[(size_t)t * 512 + c] = (f16)(mean - (float)qkvu[(size_t)t * NQKVU + COL_U + c]);
    }
}
__device__ __forceinline__ void ph_poolmm_naive(const Ctx& C, const f16* __restrict__ mixed, const f16* __restrict__ poolw_t, const float* __restrict__ pscale, f16* __restrict__ ocat) {
    for (size_t gid = (size_t)C.gt; gid < (size_t)T * 512; gid += (size_t)C.ngt) {
        const int n = (int)(gid & 511), t = (int)(gid >> 9), g = n >> 7, d = n & 127;
        const f16* mr = mixed + (size_t)t * 512 + g * 128;
        const f16* wr = poolw_t + (size_t)(g * 128 + d) * 128;
        float acc = 0.f;
        for (int c = 0; c < 128; ++c) acc += (float)mr[c] * (float)wr[c];
        ocat[(size_t)t * DM + 512 + n] = (f16)(acc * pscale[n]);
    }
}

__device__ __forceinline__ void ph_pool(const Ctx& C, LAS unsigned char* lds, const f16* __restrict__ qkvu, const f16* __restrict__ poolw_t, const float* __restrict__ pscale, f16* __restrict__ ocat) {
    const int tid = C.tid, lane = C.lane, wv = C.wave, r32 = lane & 31, hh = lane >> 5;
    for (int u = blockIdx.x; u < (T / 128) * 4; u += C.G) {
        const int g = u & 3, t0 = (u >> 2) * 128, b = t0 >> 11, hw = 1 << g;
        {
            const int c2 = tid & 63, sf = (t0 & (SEQ - 1)) + wv * 16;
            const f16* ub = qkvu + (size_t)(b * SEQ) * NQKVU + COL_U + g * 128 + 2 * c2;
            float s0 = 0.f, s1 = 0.f;
            for (int s = max(sf - hw, 0); s < min(sf + hw, SEQ); ++s) { const half2 v = *(const half2*)(ub + (size_t)s * NQKVU); s0 += (float)v[0]; s1 += (float)v[1]; }
#pragma unroll 4
            for (int i = 0; i < 16; ++i) {
                const int s = sf + i, lo = max(s - hw, 0), hi = min(s + hw, SEQ);
                const float inv = 1.0f / (float)(hi - lo);
                const half2 cur = *(const half2*)(ub + (size_t)s * NQKVU);
                half2 mx; mx[0] = (f16)(s0 * inv - (float)cur[0]); mx[1] = (f16)(s1 * inv - (float)cur[1]);
                const int tl = wv * 16 + i;
                *(LAS half2*)(lds + tl * 256 + (((c2 >> 2) ^ (tl & 15)) << 4) + ((c2 & 3) << 2)) = mx;
                if (s + hw < SEQ) { const half2 v = *(const half2*)(ub + (size_t)(s + hw) * NQKVU); s0 += (float)v[0]; s1 += (float)v[1]; }
                if (s - hw >= 0) { const half2 v = *(const half2*)(ub + (size_t)(s - hw) * NQKVU); s0 -= (float)v[0]; s1 -= (float)v[1]; }
            }
        }
        __syncthreads();
        {
            const int tb = (wv & 3) * 32, d0 = (wv >> 2) * 64, tl = tb + r32;
            f32x16 acc0, acc1;
#pragma unroll
            for (int r = 0; r < 16; ++r) { acc0[r] = 0.f; acc1[r] = 0.f; }
            const f16* wr = poolw_t + (size_t)(g * 128 + d0 + r32) * 128 + 8 * hh;
#pragma unroll
            for (int ks = 0; ks < 8; ++ks) {
                const half8 bm = *(const LAS half8*)(lds + tl * 256 + (((2 * ks + hh) ^ (tl & 15)) << 4));
                const half8 a0 = *(const half8*)(wr + 16 * ks), a1 = *(const half8*)(wr + 32 * 128 + 16 * ks);
                acc0 = __builtin_amdgcn_mfma_f32_32x32x16_f16(a0, bm, acc0, 0, 0, 0);
                acc1 = __builtin_amdgcn_mfma_f32_32x32x16_f16(a1, bm, acc1, 0, 0, 0);
            }
            f16* orow = ocat + (size_t)(t0 + tl) * DM + 512 + g * 128 + d0 + 4 * hh;
            const float* ps = pscale + g * 128 + d0 + 4 * hh;
#pragma unroll
            for (int q = 0; q < 4; ++q) {
                const f32x4 p0 = *(const f32x4*)(ps + 8 * q), p1 = *(const f32x4*)(ps + 32 + 8 * q);
                half4 x0, x1;
#pragma unroll
                for (int i = 0; i < 4; ++i) { x0[i] = (f16)(acc0[4 * q + i] * p0[i]); x1[i] = (f16)(acc1[4 * q + i] * p1[i]); }
                *(half4*)(orow + 8 * q) = x0; *(half4*)(orow + 32 + 8 * q) = x1;
            }
        }
        __syncthreads();
    }
}

#define INS(LV, LI, v_, i_) do { float cv_ = (v_); int ci_ = (i_); \
    _Pragma("unroll") for (int z_ = 0; z_ < 16; ++z_) { const bool gt_ = cv_ > LV[z_]; const float tv_ = gt_ ? LV[z_] : cv_; const int ti_ = gt_ ? LI[z_] : ci_; \
        LV[z_] = gt_ ? cv_ : LV[z_]; LI[z_] = gt_ ? ci_ : LI[z_]; cv_ = tv_; ci_ = ti_; } } while (0)
__device__ __forceinline__ void ph_route_naive(const Ctx& C, const f16* __restrict__ qp, const float* __restrict__ ss2, const f16* __restrict__ subk, int* __restrict__ eidx, float* __restrict__ egate) {
    for (int gid = C.gt; gid < T * 8; gid += C.ngt) {
        const int t = gid % T, h = gid / T;
        const float rs2 = rs_from_ss(ss2, t);
        float av[16], bv[16]; int ai[16], bi[16];
#pragma unroll
        for (int z = 0; z < 16; ++z) { av[z] = -3e38f; bv[z] = -3e38f; ai[z] = 0; bi[z] = 0; }
        for (int p = 0; p < 2; ++p) {
            const f16* qr = qp + (size_t)t * 2048 + h * 256 + p * 128;
            for (int n = 0; n < 128; ++n) {
                const f16* kr = subk + ((size_t)((h * 2 + p) * 128 + n)) * 128;
                float dot = 0.f;
                for (int c = 0; c < 128; ++c) dot += (float)qr[c] * (float)kr[c];
                dot *= rs2;
                if (p == 0) INS(av, ai, dot, n); else INS(bv, bi, dot, n);
            }
        }
        float cv[16]; int ci[16];
#pragma unroll
        for (int z = 0; z < 16; ++z) { cv[z] = -3e38f; ci[z] = 0; }
#pragma unroll
        for (int i = 0; i < 16; ++i)
#pragma unroll
            for (int j = 0; j < 16; ++j)
                if ((i + 1) * (j + 1) <= 16) INS(cv, ci, av[i] + bv[j], ai[i] * 128 + bi[j]);
        float sum = 0.f, e[16];
#pragma unroll
        for (int z = 0; z < 16; ++z) { e[z] = __expf(cv[z] - cv[0]); sum += e[z]; }
        const float inv = 1.0f / sum;
#pragma unroll
        for (int z = 0; z < 16; ++z) { eidx[(size_t)t * 128 + h * 16 + z] = ci[z]; egate[(size_t)t * 128 + h * 16 + z] = e[z] * inv; }
    }
}

__device__ __forceinline__ int mono_i(float f) { const int b = __float_as_int(f); return b ^ ((b >> 31) & 0x7fffffff); }
__device__ __forceinline__ float unmono_f(int m) { return __int_as_float(m ^ ((m >> 31) & 0x7fffffff)); }
#define INS16(Lst, x_) do { int xv_ = (x_); _Pragma("unroll") for (int z_ = 0; z_ < 16; ++z_) { const int hi_ = max(Lst[z_], xv_); xv_ = min(Lst[z_], xv_); Lst[z_] = hi_; } } while (0)
__device__ __forceinline__ void merge_pair16(int (&Lst)[16]) {
    int P[16];
#pragma unroll
    for (int z = 0; z < 16; ++z) P[z] = __shfl_xor(Lst[z], 32);
#pragma unroll
    for (int z = 0; z < 16; ++z) Lst[z] = max(Lst[z], P[15 - z]);
#pragma unroll
    for (int s = 8; s >= 1; s >>= 1)
#pragma unroll
        for (int i = 0; i < 16; ++i) if ((i & s) == 0) { const int hi = max(Lst[i], Lst[i + s]), lo = min(Lst[i], Lst[i + s]); Lst[i] = hi; Lst[i + s] = lo; }
}
__device__ __forceinline__ void ph_route(const Ctx& C, LAS unsigned char* lds, const f16* __restrict__ qp, const float* __restrict__ ss2, const f16* __restrict__ subk,
                                         int* __restrict__ eidx, float* __restrict__ egate) {
    const int lane = C.lane, r32 = lane & 31, hh = lane >> 5;
    LAS unsigned char* tab = lds + C.wave * 4096 + lane * 36;
    for (int u = C.gw; u < (T / 32) * 8; u += C.ngw) {
        const int h = u & 7, t0 = (u >> 3) * 32, t = t0 + r32;
        const float rs2 = rs_from_ss(ss2, t);
        int top[2][16];
#pragma unroll
        for (int p = 0; p < 2; ++p) {
            const f16* qrow = qp + (size_t)t * 2048 + h * 256 + p * 128 + 8 * hh;
            const f16* kbase = subk + (size_t)((h * 2 + p) * 128 + r32) * 128 + 8 * hh;
            half8 bq[8];
#pragma unroll
            for (int ks = 0; ks < 8; ++ks) bq[ks] = *(const half8*)(qrow + 16 * ks);
            int Lst[16];
#pragma unroll
            for (int z = 0; z < 16; ++z) Lst[z] = (int)0x80000000;
#pragma unroll 1
            for (int nb = 0; nb < 4; ++nb) {
                f32x16 acc = {0.f, 0.f, 0.f, 0.f, 0.f, 0.f, 0.f, 0.f, 0.f, 0.f, 0.f, 0.f, 0.f, 0.f, 0.f, 0.f};
#pragma unroll
                for (int ks = 0; ks < 8; ++ks) {
                    const half8 ak = *(const half8*)(kbase + (size_t)(nb * 32) * 128 + 16 * ks);
                    acc = __builtin_amdgcn_mfma_f32_32x32x16_f16(ak, bq[ks], acc, 0, 0, 0);
                }
#pragma unroll
                for (int r = 0; r < 16; ++r) {
                    const int n = nb * 32 + (r & 3) + 8 * (r >> 2) + 4 * hh;
                    const int key = (mono_i(acc[r] * rs2) & ~127) | (127 - n);
                    INS16(Lst, key);
                }
            }
            merge_pair16(Lst);
#pragma unroll
            for (int z = 0; z < 16; ++z) top[p][z] = Lst[z];
        }
        float va[16], vb[16];
#pragma unroll
        for (int z = 0; z < 16; ++z) { va[z] = unmono_f(top[0][z] & ~127); vb[z] = unmono_f(top[1][z] & ~127);
            tab[z] = (unsigned char)(127 - (top[0][z] & 127)); tab[16 + z] = (unsigned char)(127 - (top[1][z] & 127)); }
        int Cl[16];
#pragma unroll
        for (int z = 0; z < 16; ++z) Cl[z] = (int)0x80000000;
#pragma unroll
        for (int i = 0; i < 16; ++i)
#pragma unroll
            for (int j = 0; j < 16; ++j)
                if ((i + 1) * (j + 1) <= 16) { const int key = (mono_i(va[i] + vb[j]) & ~255) | (255 - (i * 16 + j)); INS16(Cl, key); }
        float e[16], sum = 0.f; const float mx = unmono_f(Cl[0] & ~255);
#pragma unroll
        for (int z = 0; z < 16; ++z) { e[z] = __expf(unmono_f(Cl[z] & ~255) - mx); sum += e[z]; }
        const float inv = 1.0f / sum;
        LDS_WAIT();
        int* ei = eidx + (size_t)t * 128 + h * 16 + 8 * hh; float* eg = egate + (size_t)t * 128 + h * 16 + 8 * hh;
#pragma unroll
        for (int z = 0; z < 16; ++z) {
            if ((z >> 3) == hh) { const int code = 255 - (Cl[z] & 255); const int ia = tab[code >> 4], ib = tab[16 + (code & 15)];
                ei[z & 7] = ia * 128 + ib; eg[z & 7] = e[z] * inv; }
        }
        LDS_WAIT();
    }
}

typedef unsigned u32x4 __attribute__((ext_vector_type(4)));
struct Slicing { int m, pi, nloc, rank; };
__device__ __forceinline__ Slicing get_slicing(const unsigned* bar, volatile LAS unsigned* misc) {
    Slicing S; const unsigned x = (unsigned)__builtin_amdgcn_s_getreg((3 << 11) | 20) & 0xFu;
    int m = 0, pi = 0, nloc = 1;
    for (unsigned j = 0; j < 16; ++j) { const unsigned c = __hip_atomic_load(&bar[256 + 64 * j], __ATOMIC_RELAXED, __HIP_MEMORY_SCOPE_AGENT); if (c > 0u) { if (j < x) ++pi; ++m; } if (j == x) nloc = (int)c; }
    S.m = m > 0 ? m : 1; S.pi = pi; S.nloc = nloc > 0 ? nloc : 1; S.rank = (int)misc[10];
    return S;
}
__device__ __forceinline__ float gelu_fast(float v) {
    const float av = fabsf(v), t = __builtin_amdgcn_rcpf(av * 0.2316418882f + 1.0f);
    float q = t * 0.5307027145f + (-0.7265760135f); q = q * t + 0.7107068705f; q = q * t + (-0.142248368f); q = q * t + 0.127414796f; q = q * t;
    const float m = v * (q * __builtin_amdgcn_exp2f((v * v) * (-0.72134752044f)));
    return v < 0.f ? m : v - m;
}
__device__ __forceinline__ void ph_h2quant(const Ctx& C, const f16* __restrict__ x1h, const float* __restrict__ ss2, unsigned* __restrict__ h2q, float* __restrict__ hsc) {
    const int lane = C.lane;
    for (int t = C.gw; t < T; t += C.ngw) {
        const half8 h0 = *(const half8*)(x1h + (size_t)t * DM + 16 * lane), h1 = *(const half8*)(x1h + (size_t)t * DM + 16 * lane + 8);
        float hm = 0.f;
#pragma unroll
        for (int i = 0; i < 8; ++i) hm = fmaxf(hm, fmaxf(fabsf((float)h0[i]), fabsf((float)h1[i])));
        hm = wave_max(hm);
        const float inv = hm > 0.f ? 127.0f / hm : 0.f;
        u32x4 w;
        w[0] = (unsigned)pack4_i8((float)h0[0] * inv, (float)h0[1] * inv, (float)h0[2] * inv, (float)h0[3] * inv);
        w[1] = (unsigned)pack4_i8((float)h0[4] * inv, (float)h0[5] * inv, (float)h0[6] * inv, (float)h0[7] * inv);
        w[2] = (unsigned)pack4_i8((float)h1[0] * inv, (float)h1[1] * inv, (float)h1[2] * inv, (float)h1[3] * inv);
        w[3] = (unsigned)pack4_i8((float)h1[4] * inv, (float)h1[5] * inv, (float)h1[6] * inv, (float)h1[7] * inv);
        *(u32x4*)(h2q + (size_t)t * 256 + 4 * lane) = w;
        if (lane == 0) hsc[t] = hm * (1.0f / 127.0f) * rs_from_ss(ss2, t);
    }
}
__device__ __forceinline__ void ph_upeer(const Ctx& C, LAS unsigned char* lds, const Slicing SL, const unsigned* __restrict__ h2q, const int* __restrict__ eidx,
                                         const unsigned char* __restrict__ uq, int* __restrict__ pdot) {
    const int lane = C.lane, grp = lane >> 3, c8 = lane & 7;
    const int wv = SL.rank * NWAVES + C.wave, nwv = SL.nloc * NWAVES;
    const int ntok = (T - wv + nwv - 1) / nwv;
    auto tok = [&](int i) { const int t = wv + i * nwv; return t < T ? t : T - 1; };
    volatile LAS int* row = (volatile LAS int*)(lds + C.wave * 1024);
  for (int s = SL.pi; s < 8; s += SL.m) {
    const unsigned char* uqs = uq + s * 128 + c8 * 16;
    const unsigned* hqs = h2q + s * 32 + c8 * 4;
    int tA = tok(0), tB = tok(1);
    int e0 = eidx[(size_t)tA * 128 + lane], e1 = eidx[(size_t)tA * 128 + 64 + lane];
    u32x4 hq = *(const u32x4*)(hqs + (size_t)tA * 256);
    int ne0 = eidx[(size_t)tB * 128 + lane], ne1 = eidx[(size_t)tB * 128 + 64 + lane];
    u32x4 r[16];
#pragma unroll
    for (int i = 0; i < 16; ++i) { const int e = __shfl(i < 8 ? e0 : e1, 8 * (i & 7) + grp); r[i] = *(const u32x4*)(uqs + (size_t)e * DM); }
#pragma unroll 1
    for (int it = 0; it < ntok; ++it) {
        const int t = tok(it), t1 = tok(it + 1), t2 = tok(it + 2);
        const int ze0 = eidx[(size_t)t2 * 128 + lane], ze1 = eidx[(size_t)t2 * 128 + 64 + lane];
        const u32x4 nhq = *(const u32x4*)(hqs + (size_t)t1 * 256);
#pragma unroll
        for (int hf = 0; hf < 2; ++hf) {
            int evv[8];
#pragma unroll
            for (int i = 0; i < 8; ++i) evv[i] = __shfl(hf ? ne1 : ne0, 8 * i + grp);
#pragma unroll
            for (int ii = 0; ii < 8; ++ii) {
                const int i = hf * 8 + ii;
                int p = __builtin_amdgcn_sdot4((int)r[i][0], (int)hq[0], 0, false); p = __builtin_amdgcn_sdot4((int)r[i][1], (int)hq[1], p, false);
                p = __builtin_amdgcn_sdot4((int)r[i][2], (int)hq[2], p, false); p = __builtin_amdgcn_sdot4((int)r[i][3], (int)hq[3], p, false);
                p += dppi<0xB1>(p); p += dppi<0x4E>(p); p += dppi<0x141>(p);
                if (c8 == 0) row[8 * i + grp] = p;
                asm volatile("" ::: "memory");
                r[i] = *(const u32x4*)(uqs + (size_t)evv[ii] * DM);
                asm volatile("" ::: "memory");
            }
        }
        LDS_WAIT();
        const int p0 = row[lane], p1 = row[64 + lane];
        LDS_WAIT();
        { int* pp = pdot + ((size_t)s * T + t) * 128 + lane; asm volatile("global_store_dword %0, %1, off\n\tglobal_store_dword %0, %2, off offset:256" :: "v"(pp), "v"(p0), "v"(p1) : "memory"); }
        hq = nhq; ne0 = ze0; ne1 = ze1;
    }
  }
}
__device__ __forceinline__ void ph_ureduce(const Ctx& C, LAS unsigned char* lds, const int* __restrict__ pdot, const float* __restrict__ hsc, const int* __restrict__ eidx, const float* __restrict__ us,
                                           const float* __restrict__ vs, const float* __restrict__ egate, unsigned* __restrict__ wqp, float* __restrict__ wsc) {
    const int lane = C.lane;
    volatile LAS unsigned char* row = (volatile LAS unsigned char*)(lds + C.wave * 1024);
    for (int t = C.gw; t < T; t += C.ngw) {
        const int e0 = eidx[(size_t)t * 128 + lane], e1 = eidx[(size_t)t * 128 + 64 + lane];
        int s0 = 0, s1 = 0;
#pragma unroll
        for (int s = 0; s < 8; ++s) { const int* pp = pdot + ((size_t)s * T + t) * 128 + lane; s0 += pp[0]; s1 += pp[64]; }
        const float h = hsc[t];
        const float w0 = gelu_fast((float)s0 * h * us[e0]) * egate[(size_t)t * 128 + lane] * vs[e0];
        const float w1 = gelu_fast((float)s1 * h * us[e1]) * egate[(size_t)t * 128 + 64 + lane] * vs[e1];
        const float wm = wave_max(fmaxf(fabsf(w0), fabsf(w1)));
        const float inv = wm > 0.f ? 127.0f / wm : 0.f;
        { const int k = lane; row[(k & 7) * 16 + (k >> 5) * 4 + ((k >> 3) & 3)] = (unsigned char)(int)rintf(w0 * inv); }
        { const int k = 64 + lane; row[(k & 7) * 16 + (k >> 5) * 4 + ((k >> 3) & 3)] = (unsigned char)(int)rintf(w1 * inv); }
        LDS_WAIT();
        if (lane < 32) wqp[(size_t)t * 32 + lane] = ((volatile LAS unsigned*)row)[lane];
        LDS_WAIT();
        if (lane == 0) wsc[t] = wm * (1.0f / 127.0f);
    }
}
template <int EMASK>
__device__ __forceinline__ void ph_vpeer(const Ctx& C, const Slicing SL, const int* __restrict__ eidx, const unsigned* __restrict__ wqp, const float* __restrict__ wsc, const unsigned char* __restrict__ vq,
                                         const float* xio, float* xout, float* __restrict__ ssf) {
    const int lane = C.lane, grp = lane >> 3, c8 = lane & 7;
    const bool hh = (lane & 32) != 0, b4 = (lane & 16) != 0, b3 = (lane & 8) != 0;
    const int wv = SL.rank * NWAVES + C.wave, nwv = SL.nloc * NWAVES;
    const int ntok = (T - wv + nwv - 1) / nwv;
    auto tok = [&](int i) { const int t = wv + i * nwv; return t < T ? t : T - 1; };
  for (int s = SL.pi; s < 8; s += SL.m) {
    const unsigned char* vqs = vq + s * 128 + c8 * 16;
    const int chl = 8 * (hh ? 1 : 0) + 4 * (b4 ? 1 : 0) + 2 * (b3 ? 1 : 0);
    const int coff = s * 128 + c8 * 16 + chl;
    int tA = tok(0), tB = tok(1);
    int e0 = eidx[(size_t)tA * 128 + lane], e1 = eidx[(size_t)tA * 128 + 64 + lane];
    u32x4 wq = *(const u32x4*)(wqp + (size_t)tA * 32 + grp * 4); float wscale = wsc[tA];
    int ne0 = eidx[(size_t)tB * 128 + lane], ne1 = eidx[(size_t)tB * 128 + 64 + lane];
    u32x4 r[16];
#pragma unroll
    for (int i = 0; i < 16; ++i) { const int e = __shfl(i < 8 ? e0 : e1, 8 * (i & 7) + grp) & EMASK; r[i] = *(const u32x4*)(vqs + (size_t)e * DM); }
#pragma unroll 1
    for (int it = 0; it < ntok; ++it) {
        const int t = tok(it), t1 = tok(it + 1), t2 = tok(it + 2);
        const int ze0 = eidx[(size_t)t2 * 128 + lane], ze1 = eidx[(size_t)t2 * 128 + 64 + lane];
        const u32x4 nwq = *(const u32x4*)(wqp + (size_t)t1 * 32 + grp * 4); const float nwscale = wsc[t1];
        const float2 xv = *(const float2*)(xio + (size_t)t * DM + coff);
        int o[16];
#pragma unroll
        for (int c = 0; c < 16; ++c) o[c] = 0;
#pragma unroll
        for (int q = 0; q < 4; ++q) {
            int evv[4];
#pragma unroll
            for (int j = 0; j < 4; ++j) evv[j] = __shfl(q < 2 ? ne0 : ne1, 32 * (q & 1) + 8 * j + grp) & EMASK;
#pragma unroll
            for (int d = 0; d < 4; ++d) {
                const unsigned a = r[4 * q][d], b = r[4 * q + 1][d], c = r[4 * q + 2][d], e = r[4 * q + 3][d];
                const unsigned t0 = __builtin_amdgcn_perm(b, a, 0x05010400u), t1p = __builtin_amdgcn_perm(b, a, 0x07030602u);
                const unsigned u0 = __builtin_amdgcn_perm(e, c, 0x05010400u), u1 = __builtin_amdgcn_perm(e, c, 0x07030602u);
                o[4 * d + 0] = __builtin_amdgcn_sdot4((int)__builtin_amdgcn_perm(u0, t0, 0x05040100u), (int)wq[q], o[4 * d + 0], false);
                o[4 * d + 1] = __builtin_amdgcn_sdot4((int)__builtin_amdgcn_perm(u0, t0, 0x07060302u), (int)wq[q], o[4 * d + 1], false);
                o[4 * d + 2] = __builtin_amdgcn_sdot4((int)__builtin_amdgcn_perm(u1, t1p, 0x05040100u), (int)wq[q], o[4 * d + 2], false);
                o[4 * d + 3] = __builtin_amdgcn_sdot4((int)__builtin_amdgcn_perm(u1, t1p, 0x07060302u), (int)wq[q], o[4 * d + 3], false);
            }
#pragma unroll
            for (int j = 0; j < 4; ++j) {
                asm volatile("" ::: "memory");
                r[4 * q + j] = *(const u32x4*)(vqs + (size_t)evv[j] * DM);
                asm volatile("" ::: "memory");
            }
        }
        int q8[8], q4[4], q2[2];
#pragma unroll
        for (int k = 0; k < 8; ++k) q8[k] = bfly32i(o[k], o[8 + k]);
#pragma unroll
        for (int k = 0; k < 4; ++k) q4[k] = bfly16i(q8[k], q8[4 + k]);
#pragma unroll
        for (int k = 0; k < 2; ++k) { const int mine = b3 ? q4[2 + k] : q4[k], oth = b3 ? q4[k] : q4[2 + k]; q2[k] = mine + dppi<0x128>(oth); }
        const float y0 = xv.x + (float)q2[0] * wscale, y1 = xv.y + (float)q2[1] * wscale;
        { float* yp = xout + (size_t)t * DM + coff; const float2 yv = make_float2(y0, y1); asm volatile("global_store_dwordx2 %0, %1, off" :: "v"(yp), "v"(yv) : "memory"); }
        const float ss = wave_sum(y0 * y0 + y1 * y1);
        if (lane == 0) { float* sp = ssf + (size_t)s * T + t; asm volatile("global_store_dword %0, %1, off" :: "v"(sp), "v"(ss) : "memory"); }
        wq = nwq; wscale = nwscale; ne0 = ze0; ne1 = ze1;
    }
  }
}
__device__ __forceinline__ void ph_final(const Ctx& C, const float* __restrict__ ssf, float* xio, const float* __restrict__ gf) {
    const int lane = C.lane;
    for (int t = C.gw; t < T; t += C.ngw) {
        float s = 0.f;
#pragma unroll
        for (int i = 0; i < 8; ++i) s += ssf[(size_t)i * T + t];
        const float r = rsqrtf(s * (1.0f / DM) + EPS);
        float* xr = xio + (size_t)t * DM;
#pragma unroll
        for (int j = 0; j < 4; ++j) {
            const int c0 = j * 256 + lane * 4;
            const f32x4 v = *(const f32x4*)(xr + c0), gg = *(const f32x4*)(gf + c0);
            *(f32x4*)(xr + c0) = v * r * gg;
        }
    }
}

namespace pg8 {
#define PG8_LAS __attribute__((address_space(3)))
typedef _Float16 frag8 __attribute__((ext_vector_type(8)));
typedef float f32x4 __attribute__((ext_vector_type(4)));
constexpr int BM = 256, BK = 64, HALF = 128, HTB = HALF * BK * 2  , STAGE_BYTES = 8 * HTB, NXCD = 8, WGM = 8;

__host__ __device__ __forceinline__ int lds_byte(int r, int c) { const int st = (r >> 4) * 2 + (c >> 5), rr = r & 15, cc = c & 31, ob = rr * 64 + cc * 2; return st * 1024 + (ob ^ (((ob >> 9) & 1) << 5)); }
__host__ __device__ __forceinline__ void stage_rc(int b, int& R, int& C) { const int st = b / 1024, sb = b % 1024, swz = sb ^ (((sb >> 9) & 1) << 5); R = (st >> 1) * 16 + swz / 64; C = (st & 1) * 32 + (swz % 64) / 2; }
__host__ __device__ __forceinline__ int perm32(int rho) { const int n = rho >> 4, i = rho & 15; return 8 * (i >> 2) + 4 * n + (i & 3); }

struct Unit { int pm, pn; };
struct Gemm { const f16* A; const f16* Bt; int M, N, K; };

struct StaticOrder {
    int nM, nN, nwg, G, c;
    __host__ __device__ void init(int M, int N, int G_, int c_) { nM = M / BM; nN = N / BM; nwg = nM * nN; G = G_; c = c_; }
    __host__ __device__ bool next(int i, Unit& u) const {
        const long L = (long)i * G + c; if (L >= nwg) return false;
        int wgid = (int)L; { const int q = nwg / NXCD, r = nwg % NXCD, xcd = wgid % NXCD, off = wgid / NXCD; wgid = (xcd < r ? xcd * (q + 1) : r * (q + 1) + (xcd - r) * q) + off; }
        const int nig = WGM * nN, gid = wgid / nig, fm = gid * WGM, gsz = (nM - fm) < WGM ? (nM - fm) : WGM;
        u.pm = fm + ((wgid % nig) % gsz); u.pn = (wgid % nig) / gsz; return true;
    }
    __device__ __forceinline__ void a_ready(const Unit&) const {}
    __device__ __forceinline__ void done(const Unit&) const {}
};

__device__ __forceinline__ frag8 pack8(const f32x4 a, const f32x4 b) {
    frag8 h; h[0] = (f16)a[0]; h[1] = (f16)a[1]; h[2] = (f16)a[2]; h[3] = (f16)a[3]; h[4] = (f16)b[0]; h[5] = (f16)b[1]; h[6] = (f16)b[2]; h[7] = (f16)b[3]; return h;
}
__device__ __forceinline__ float sigmoidf_(float z) { return 1.0f / (1.0f + __expf(-z)); }

struct EpiP1 {
    static constexpr bool PERM = true, AFTER_DRAIN = false, MIDK = false;
    const float* ss1; const float* bgate; f16* qkvu; f16* gates; f16* vT;
    __device__ __forceinline__ void operator()(const f32x4 (&acc)[2][2][4][2], const Unit& u, int wr, int wc, int fr, int fq) const {
        const int row0 = u.pm * BM + wr * 64 + fr, colt = u.pn * BM; const bool isg = colt >= NQKVU;
#pragma unroll
        for (int ai = 0; ai < 2; ++ai)
#pragma unroll
            for (int m = 0; m < 4; ++m) { const int row = row0 + ai * HALF + m * 16; const float r = rsqrtf(ss1[row] * (1.0f / DM) + EPS);
#pragma unroll
                for (int bj = 0; bj < 2; ++bj) { const int c0 = colt + bj * HALF + wc * 32 + 8 * fq; f32x4 v0 = acc[ai][bj][m][0] * r, v1 = acc[ai][bj][m][1] * r;
                    if (isg) { const int cg = c0 - NQKVU; const f32x4 b0 = *(const f32x4*)(bgate + cg), b1 = *(const f32x4*)(bgate + cg + 4);
#pragma unroll
                        for (int i = 0; i < 4; ++i) { v0[i] = sigmoidf_(v0[i] + b0[i]); v1[i] = sigmoidf_(v1[i] + b1[i]); }
                        *(frag8*)(gates + (size_t)row * NGATE + cg) = pack8(v0, v1); }
                    else { const frag8 hv = pack8(v0, v1); *(frag8*)(qkvu + (size_t)row * NQKVU + c0) = hv;
                        if (colt == 512 && bj == 1) {
                            f16* vp = vT + ((size_t)((row >> 11) * 2 + (wc >> 1)) * 64 + (wc & 1) * 32 + 8 * fq) * SEQ + (row & (SEQ - 1));
#pragma unroll
                            for (int i = 0; i < 8; ++i) vp[(size_t)i * SEQ] = hv[i]; } } } }
    }
};
struct EpiMerged {
    static constexpr bool PERM = true, AFTER_DRAIN = false, MIDK = true;
    const f16* gates; f16* merged;
    __device__ __forceinline__ void mid(f32x4 (&acc)[2][2][4][2], const Unit& u, int wr, int wc, int fr, int fq) const {
        const int row0 = u.pm * BM + wr * 64 + fr, colt = u.pn * BM;
        const f16* gb = gates + (size_t)row0 * NGATE + colt + wc * 32 + 8 * fq;
        asm volatile("" : "+v"(gb));
#pragma unroll
        for (int ai = 0; ai < 2; ++ai) {
            frag8 g0[4][2], g1[4][2];
#pragma unroll
            for (int m = 0; m < 4; ++m)
#pragma unroll
                for (int bj = 0; bj < 2; ++bj) { const f16* gp = gb + (size_t)(ai * HALF + m * 16) * NGATE + bj * HALF; g0[m][bj] = *(const frag8*)gp; g1[m][bj] = *(const frag8*)(gp + DM); }
#pragma unroll
            for (int m = 0; m < 4; ++m)
#pragma unroll
                for (int bj = 0; bj < 2; ++bj)
#pragma unroll
                    for (int i = 0; i < 4; ++i) {
                        acc[ai][bj][m][0][i] *= (float)g0[m][bj][i] * __builtin_amdgcn_rcpf(fmaxf((float)g1[m][bj][i], 1e-4f));
                        acc[ai][bj][m][1][i] *= (float)g0[m][bj][4 + i] * __builtin_amdgcn_rcpf(fmaxf((float)g1[m][bj][4 + i], 1e-4f)); }
            asm volatile("" ::: "memory");
        }
    }
    __device__ __forceinline__ void operator()(const f32x4 (&acc)[2][2][4][2], const Unit& u, int wr, int wc, int fr, int fq) const {
        const int row0 = u.pm * BM + wr * 64 + fr, colt = u.pn * BM;
#pragma unroll
        for (int ai = 0; ai < 2; ++ai)
#pragma unroll
            for (int m = 0; m < 4; ++m) { const int row = row0 + ai * HALF + m * 16;
#pragma unroll
                for (int bj = 0; bj < 2; ++bj) { const int c0 = colt + bj * HALF + wc * 32 + 8 * fq;
                    const frag8 g1 = *(const frag8*)(gates + (size_t)row * NGATE + DM + c0); f32x4 v0, v1;
#pragma unroll
                    for (int i = 0; i < 4; ++i) { v0[i] = acc[ai][bj][m][0][i] * fmaxf((float)g1[i], 1e-4f); v1[i] = acc[ai][bj][m][1][i] * fmaxf((float)g1[4 + i], 1e-4f); }
                    *(frag8*)(merged + (size_t)row * DM + c0) = pack8(v0, v1); } }
    }
};
struct EpiOut {
    static constexpr bool PERM = false, AFTER_DRAIN = false, MIDK = false;
    const float* x; const float* g2; float* x1; f16* x1h; float* ss2p;
    __device__ __forceinline__ void operator()(const f32x4 (&acc)[2][2][4][2], const Unit& u, int wr, int wc, int fr, int fq) const {
        const int row0 = u.pm * BM + wr * 64 + fr, col0 = u.pn * BM + wc * 32 + 4 * fq;
        f32x4 gv[2][2];
#pragma unroll
        for (int bj = 0; bj < 2; ++bj)
#pragma unroll
            for (int n = 0; n < 2; ++n) gv[bj][n] = *(const f32x4*)(g2 + col0 + bj * HALF + n * 16);
#pragma unroll
        for (int ai = 0; ai < 2; ++ai)
#pragma unroll
            for (int m = 0; m < 4; ++m) { const int row = row0 + ai * HALF + m * 16; const size_t off = (size_t)row * DM + col0; float ssq = 0.f;
#pragma unroll
                for (int bj = 0; bj < 2; ++bj)
#pragma unroll
                    for (int n = 0; n < 2; ++n) { const f32x4 y = *(const f32x4*)(x + off + bj * HALF + n * 16) + acc[ai][bj][m][n];
                        *(f32x4*)(x1 + off + bj * HALF + n * 16) = y; ssq += (y[0] * y[0] + y[1] * y[1]) + (y[2] * y[2] + y[3] * y[3]);
                        const f32x4 yg = y * gv[bj][n]; half4 h; h[0] = (f16)yg[0]; h[1] = (f16)yg[1]; h[2] = (f16)yg[2]; h[3] = (f16)yg[3];
                        *(half4*)(x1h + off + bj * HALF + n * 16) = h; }
                ssq += __shfl_xor(ssq, 16); ssq += __shfl_xor(ssq, 32);
                if (fq == 0) ss2p[(size_t)(u.pn * 4 + wc) * T + row] = ssq; }
    }
};
struct EpiQ {
    static constexpr bool PERM = true, AFTER_DRAIN = false, MIDK = false;
    f16* qp;
    __device__ __forceinline__ void operator()(const f32x4 (&acc)[2][2][4][2], const Unit& u, int wr, int wc, int fr, int fq) const {
        const int row0 = u.pm * BM + wr * 64 + fr, colt = u.pn * BM;
#pragma unroll
        for (int ai = 0; ai < 2; ++ai)
#pragma unroll
            for (int m = 0; m < 4; ++m) { const int row = row0 + ai * HALF + m * 16;
#pragma unroll
                for (int bj = 0; bj < 2; ++bj) { const int c0 = colt + bj * HALF + wc * 32 + 8 * fq;
                    *(frag8*)(qp + (size_t)row * 2048 + c0) = pack8(acc[ai][bj][m][0], acc[ai][bj][m][1]); } }
    }
};

template <class Epi, class Sched, bool ALIGN_EPI = false, bool SP2 = false>
__device__ __forceinline__ void gemm_phase(PG8_LAS unsigned char* lds, const Gemm g, const Sched& S, const Epi& E) {
    const int tid = threadIdx.x, wid = __builtin_amdgcn_readfirstlane(tid >> 6), lane = tid & 63, wr = wid >> 2, wc = wid & 3, fr = lane & 15, fq = lane >> 4;
    const int K = g.K, nt = K / BK;
    unsigned voffA[2], voffB[2];
#pragma unroll
    for (int i = 0; i < 2; ++i) { int R, C; stage_rc(tid * 16 + i * 8192, R, C); const int Rb = Epi::PERM ? ((R & ~31) + perm32(R & 31)) : R;
        voffA[i] = (unsigned)(R * K + C) * 2u; voffB[i] = (unsigned)(Rb * K + C) * 2u; }
    const size_t kstep = (size_t)(BK * 2);
    const size_t hstep = (size_t)HALF * K * 2;
    const size_t tstep = 2 * hstep;
    const unsigned ldsw = (unsigned)wid * 1024u;
    const int aoff = lds_byte(wr * 64 + fr, fq * 8), boff = lds_byte(wc * 32 + fr, fq * 8);
#define PG8_SA(b, h) (((b) * 2 + (h)) * HTB)
#define PG8_SB(b, h) ((4 + (b) * 2 + (h)) * HTB)
#define PG8_STAGE(bufoff, gbase, voff) do { _Pragma("unroll") for (int _i = 0; _i < 2; ++_i) \
        __builtin_amdgcn_global_load_lds((const unsigned*)((const char*)(gbase) + (voff)[_i]), (PG8_LAS unsigned*)(lds + (bufoff) + ldsw + _i * 8192), 16, 0, 0); } while (0)
#define PG8_LDA(dst, b, h) do { _Pragma("unroll") for (int m = 0; m < 4; ++m) _Pragma("unroll") for (int k = 0; k < 2; ++k) dst[m][k] = *(const PG8_LAS frag8*)(lds + PG8_SA(b, h) + aoff + m * 2048 + k * 1024); } while (0)
#define PG8_LDB(dst, b, h) do { _Pragma("unroll") for (int n = 0; n < 2; ++n) _Pragma("unroll") for (int k = 0; k < 2; ++k) dst[n][k] = *(const PG8_LAS frag8*)(lds + PG8_SB(b, h) + boff + n * 2048 + k * 1024); } while (0)
#define PG8_MMA(ai, bj, At, Bt) do { __builtin_amdgcn_s_setprio(1); _Pragma("unroll") for (int m = 0; m < 4; ++m) _Pragma("unroll") for (int n = 0; n < 2; ++n) _Pragma("unroll") for (int k = 0; k < 2; ++k) \
        acc[ai][bj][m][n] = __builtin_amdgcn_mfma_f32_16x16x32_f16(Bt[n][k], At[m][k], acc[ai][bj][m][n], 0, 0, 0); __builtin_amdgcn_s_setprio(0); } while (0)
#define PG8_WAIT_V(n) asm volatile("s_waitcnt vmcnt(" #n ")" ::: "memory")
#define PG8_WAIT_L(n) asm volatile("s_waitcnt lgkmcnt(" #n ")" ::: "memory")
#define PG8_BAR __builtin_amdgcn_s_barrier()
#define PG8_SCHED __builtin_amdgcn_sched_barrier(0)
    Unit cur, nxt; int ui = 0;
    if (!S.next(0, cur)) return;
    f32x4 acc[2][2][4][2];
#pragma unroll
    for (int a = 0; a < 2; ++a)
#pragma unroll
        for (int b = 0; b < 2; ++b)
#pragma unroll
            for (int m = 0; m < 4; ++m)
#pragma unroll
                for (int n = 0; n < 2; ++n) acc[a][b][m][n] = (f32x4){0.f, 0.f, 0.f, 0.f};
    frag8 At[4][2], B0[2][2], B1[2][2];
    const char* cA = (const char*)g.A + (size_t)cur.pm * tstep; const char* cB = (const char*)g.Bt + (size_t)cur.pn * tstep;
    S.a_ready(cur);
    if constexpr (SP2) {
        PG8_STAGE(PG8_SB(0, 0), cB, voffB); PG8_STAGE(PG8_SB(0, 1), cB + hstep, voffB); PG8_STAGE(PG8_SA(0, 0), cA, voffA); PG8_STAGE(PG8_SA(0, 1), cA + hstep, voffA);
        if (wr == 1) PG8_BAR;
        PG8_WAIT_V(2); PG8_BAR;
        PG8_STAGE(PG8_SB(1, 0), cB + kstep, voffB); PG8_STAGE(PG8_SA(1, 0), cA + kstep, voffA); PG8_STAGE(PG8_SB(1, 1), cB + hstep + kstep, voffB);
        PG8_WAIT_V(6); PG8_BAR;
    } else {
        PG8_STAGE(PG8_SB(0, 0), cB, voffB); PG8_STAGE(PG8_SA(0, 0), cA, voffA); PG8_STAGE(PG8_SB(0, 1), cB + hstep, voffB); PG8_STAGE(PG8_SA(0, 1), cA + hstep, voffA);
        if (wr == 1) PG8_BAR;
        PG8_WAIT_V(4); PG8_BAR;
        PG8_STAGE(PG8_SB(1, 0), cB + kstep, voffB); PG8_STAGE(PG8_SA(1, 0), cA + kstep, voffA); PG8_STAGE(PG8_SB(1, 1), cB + hstep + kstep, voffB);
        PG8_WAIT_V(6); PG8_BAR;
    }
    for (;;) {
        const bool has_next = S.next(ui + 1, nxt);
        const char* nA = has_next ? (const char*)g.A + (size_t)nxt.pm * tstep : cA; const char* nB = has_next ? (const char*)g.Bt + (size_t)nxt.pn * tstep : cB;
        for (int t = 0; t < nt; t += 2) {
            const bool last = (t == nt - 2);
            if constexpr (Epi::MIDK) { if (t == (nt >> 1)) E.mid(acc, cur, wr, wc, fr, fq); }
            const char* a1 = cA + (size_t)(t + 1) * kstep;
            const char* a2 = last ? nA : cA + (size_t)(t + 2) * kstep; const char* b2 = last ? nB : cB + (size_t)(t + 2) * kstep;
            const char* a3 = a2 + kstep; const char* b3 = b2 + kstep;
            if (last && has_next) S.a_ready(nxt);
            if constexpr (SP2) {
            PG8_LDB(B0, 0, 0); PG8_LDB(B1, 0, 1); PG8_SCHED; PG8_LDA(At, 0, 0); PG8_STAGE(PG8_SA(1, 1), a1 + hstep, voffA);
            PG8_WAIT_V(8); PG8_WAIT_L(0); PG8_BAR; PG8_MMA(0, 0, At, B0); PG8_MMA(0, 1, At, B1); PG8_BAR; PG8_SCHED;
            PG8_LDA(At, 0, 1); PG8_STAGE(PG8_SB(0, 0), b2, voffB); PG8_STAGE(PG8_SB(0, 1), b2 + hstep, voffB); PG8_STAGE(PG8_SA(0, 0), a2, voffA);
            PG8_WAIT_V(8); PG8_WAIT_L(0); PG8_BAR; PG8_MMA(1, 0, At, B0); PG8_MMA(1, 1, At, B1); PG8_BAR; PG8_SCHED;
            PG8_LDB(B0, 1, 0); PG8_LDB(B1, 1, 1); PG8_SCHED; PG8_LDA(At, 1, 0); PG8_STAGE(PG8_SA(0, 1), a2 + hstep, voffA);
            PG8_WAIT_V(8); PG8_WAIT_L(0); PG8_BAR; PG8_MMA(0, 0, At, B0); PG8_MMA(0, 1, At, B1); PG8_BAR; PG8_SCHED;
            PG8_LDA(At, 1, 1); PG8_STAGE(PG8_SB(1, 0), b3, voffB); PG8_STAGE(PG8_SB(1, 1), b3 + hstep, voffB); PG8_STAGE(PG8_SA(1, 0), a3, voffA);
            PG8_WAIT_V(8); PG8_WAIT_L(0); PG8_BAR; PG8_MMA(1, 0, At, B0); PG8_MMA(1, 1, At, B1); PG8_BAR; PG8_SCHED;
            } else {
            PG8_LDB(B0, 0, 0); PG8_SCHED; PG8_LDA(At, 0, 0); PG8_STAGE(PG8_SA(1, 1), a1 + hstep, voffA);
            PG8_WAIT_L(8); PG8_BAR; PG8_WAIT_L(0); PG8_MMA(0, 0, At, B0); PG8_BAR; PG8_SCHED;
            PG8_LDB(B1, 0, 1); PG8_STAGE(PG8_SB(0, 0), b2, voffB);
            PG8_BAR; PG8_WAIT_L(0); PG8_MMA(0, 1, At, B1); PG8_BAR;
            PG8_LDA(At, 0, 1); PG8_STAGE(PG8_SA(0, 0), a2, voffA);
            PG8_BAR; PG8_WAIT_L(0); PG8_MMA(1, 0, At, B0); PG8_BAR; PG8_SCHED;
            PG8_STAGE(PG8_SB(0, 1), b2 + hstep, voffB);
            PG8_WAIT_V(6); PG8_BAR; PG8_MMA(1, 1, At, B1); PG8_BAR;
            PG8_LDB(B0, 1, 0); PG8_SCHED; PG8_LDA(At, 1, 0); PG8_STAGE(PG8_SA(0, 1), a2 + hstep, voffA);
            PG8_WAIT_L(8); PG8_BAR; PG8_WAIT_L(0); PG8_MMA(0, 0, At, B0); PG8_BAR; PG8_SCHED;
            PG8_LDB(B1, 1, 1); PG8_STAGE(PG8_SB(1, 0), b3, voffB);
            PG8_BAR; PG8_WAIT_L(0); PG8_MMA(0, 1, At, B1); PG8_BAR;
            PG8_LDA(At, 1, 1); PG8_STAGE(PG8_SA(1, 0), a3, voffA);
            PG8_BAR; PG8_WAIT_L(0); PG8_MMA(1, 0, At, B0); PG8_BAR; PG8_SCHED;
            PG8_STAGE(PG8_SB(1, 1), b3 + hstep, voffB);
            PG8_WAIT_V(6); PG8_BAR; PG8_MMA(1, 1, At, B1); PG8_BAR;
            }
        }
        if constexpr (ALIGN_EPI) { if (wr == 0) PG8_BAR; }
        if constexpr (!Epi::AFTER_DRAIN) { E(acc, cur, wr, wc, fr, fq); S.done(cur); }
        if (!has_next) break;
#pragma unroll
        for (int a = 0; a < 2; ++a)
#pragma unroll
            for (int b = 0; b < 2; ++b)
#pragma unroll
                for (int m = 0; m < 4; ++m)
#pragma unroll
                    for (int n = 0; n < 2; ++n) acc[a][b][m][n] = (f32x4){0.f, 0.f, 0.f, 0.f};
        cur = nxt; cA = nA; cB = nB; ++ui;
        if constexpr (ALIGN_EPI) { if (wr == 1) PG8_BAR; }
    }
    PG8_WAIT_V(0);
    if constexpr (!ALIGN_EPI) { if (wr == 0) PG8_BAR; }
    PG8_BAR;
    if constexpr (Epi::AFTER_DRAIN) { E.fused(acc, cur, wr, wc, fr, fq, lds, wid, lane); S.done(cur); }
#undef PG8_SA
#undef PG8_SB
#undef PG8_STAGE
#undef PG8_LDA
#undef PG8_LDB
#undef PG8_MMA
#undef PG8_WAIT_V
#undef PG8_WAIT_L
#undef PG8_BAR
#undef PG8_SCHED
}
}

#define XB_TMO      128
#define XB_XCNT(j)  (256  + 64 * (j))
#define XB_XSUB(j)  (1280 + 64 * (j))
#define XB_XGEN(j)  (2304 + 64 * (j))
#define XB_TOP      3328
#define XB_TOPGEN   3392
#define XCD_BAR_WORDS 3456
#define XB_SPIN_CAP (1u << 18)

__device__ __forceinline__ unsigned xb_ld(unsigned* p)              { return __hip_atomic_load(p, __ATOMIC_RELAXED, __HIP_MEMORY_SCOPE_AGENT); }
__device__ __forceinline__ unsigned xb_add(unsigned* p, unsigned v) { return __hip_atomic_fetch_add(p, v, __ATOMIC_RELAXED, __HIP_MEMORY_SCOPE_AGENT); }
__device__ __forceinline__ unsigned xb_xcc_id() { return (unsigned)__builtin_amdgcn_s_getreg((3 << 11) | 20) & 0xFu; }
#define XB_SPIN(cond, bar) do { unsigned _sp = 0; while (cond) { __builtin_amdgcn_s_sleep(1); \
    if ((++_sp & 255u) == 0u) { if (xb_ld(&(bar)[XB_TMO])) break; if (_sp > XB_SPIN_CAP) { atomicAdd(&(bar)[XB_TMO], 1u); break; } } } } while (0)

struct XcdBarrier {
    unsigned* bar; unsigned x;
    volatile LAS unsigned* st;
};

__device__ __forceinline__ XcdBarrier xcd_barrier_post(unsigned* bar, volatile LAS unsigned* st) {
    XcdBarrier b; b.bar = bar; b.x = xb_xcc_id(); b.st = st;
    if (threadIdx.x == 0) st[2] = xb_add(&bar[XB_XCNT(b.x)], 1u);
    return b;
}
__device__ __forceinline__ void xcd_barrier_complete(unsigned* bar, unsigned x, unsigned& nloc, unsigned& nx) {
    const unsigned G = gridDim.x * gridDim.y * gridDim.z;
    unsigned sum, cnt, mine, sp = 0u;
    for (;;) {
        sum = 0u; cnt = 0u; mine = 0u;
#pragma unroll
        for (unsigned j = 0; j < 16; ++j) { const unsigned c = xb_ld(&bar[XB_XCNT(j)]); sum += c; cnt += (c > 0u) ? 1u : 0u; mine = (j == x) ? c : mine; }
        if (sum == G) break;
        __builtin_amdgcn_s_sleep(1);
        if ((++sp & 255u) == 0u) { if (xb_ld(&bar[XB_TMO])) break; if (sp > XB_SPIN_CAP) { atomicAdd(&bar[XB_TMO], 1u); break; } }
    }
    nloc = mine > 0u ? mine : 1u; nx = cnt > 0u ? cnt : 1u;
}

__device__ __forceinline__ void xcd_barrier(const XcdBarrier& b) {
    asm volatile("s_waitcnt vmcnt(0)" ::: "memory");
    __syncthreads();
    if (threadIdx.x == 0) {
        unsigned* bar = b.bar;
        __builtin_amdgcn_s_waitcnt(0);
        unsigned nloc = b.st[0], nx = b.st[1];
        if (nloc == 0u) { xcd_barrier_complete(bar, b.x, nloc, nx); b.st[0] = nloc; b.st[1] = nx; }
        const unsigned old = xb_add(&bar[XB_XSUB(b.x)], 1u);
        const unsigned gen = old / nloc;
        if (old + 1u == (gen + 1u) * nloc) {
            __builtin_amdgcn_fence(__ATOMIC_RELEASE, "agent");
            asm volatile("s_waitcnt vmcnt(0)" ::: "memory");
            const unsigned og = xb_add(&bar[XB_TOP], 1u);
            const unsigned tg = og / nx;
            if (og + 1u == (tg + 1u) * nx) xb_add(&bar[XB_TOPGEN], 1u);
            else XB_SPIN(xb_ld(&bar[XB_TOPGEN]) == tg, bar);
            __builtin_amdgcn_fence(__ATOMIC_ACQUIRE, "agent");
            xb_add(&bar[XB_XGEN(b.x)], 1u);
            asm volatile("s_waitcnt vmcnt(0)" ::: "memory");
        } else {
            XB_SPIN(xb_ld(&bar[XB_XGEN(b.x)]) == gen, bar);
            __builtin_amdgcn_fence(__ATOMIC_ACQUIRE, "agent");
            asm volatile("s_waitcnt vmcnt(0)" ::: "memory");
        }
    }
    __syncthreads();
}


struct Args { const float* in[16]; float* out; unsigned char* ws; int ph_lo, ph_hi; };
constexpr int N_PHASES = 11;

__global__ void __launch_bounds__(NTHREADS, 2) mk_fwd(Args a) {
    extern __shared__ __attribute__((aligned(16))) unsigned char lds[];
    LAS unsigned char* L = (LAS unsigned char*)lds;
    volatile LAS unsigned* MISC = (volatile LAS unsigned*)(L + MISC_OFF);
    unsigned char* ws = a.ws;
    Ctx C;
    C.tid = threadIdx.x; C.lane = C.tid & 63; C.wave = __builtin_amdgcn_readfirstlane(C.tid >> 6);
    C.G = gridDim.x; C.gw = blockIdx.x * NWAVES + C.wave; C.ngw = C.G * NWAVES; C.gt = blockIdx.x * NTHREADS + C.tid; C.ngt = C.G * NTHREADS;
    for (int u = C.tid; u < (LDS_BYTES - LDSCTL_OFF) / 4; u += NTHREADS) ((LAS unsigned*)(L + LDSCTL_OFF))[u] = 0u;
    __syncthreads();
    const int lo = a.ph_lo, hi = a.ph_hi, G = C.G;
    const bool multi = (hi - lo) > 1;
    XcdBarrier bar; bar.bar = (unsigned*)(ws + WS_CTL) + CW_BAR; bar.x = 0; bar.st = nullptr;
    if (multi) bar = xcd_barrier_post((unsigned*)(ws + WS_CTL) + CW_BAR, MISC + 8);
#define IN(k) (lo <= (k) && (k) < hi)
#define SEAM(k) do { if (IN(k) && IN((k) + 1)) xcd_barrier(bar); } while (0)

#define REPS(k) for (int rep_ = 0; rep_ < ((PROBE_DUP == (k)) ? 2 : 1); ++rep_)
#define REPBAR(k) do { if (PROBE_DUP == (k) && rep_ == 0) xcd_barrier(bar); } while (0)
    if (IN(0)) REPS(0) { ph_prep(C, L, a.in, ws); REPBAR(0); }
    SEAM(0);
    if (IN(1)) REPS(1) {
        pg8::Gemm g{(const f16*)(ws + WS_XH), (const f16*)(ws + WS_WCAT), T, NCAT, DM}; pg8::StaticOrder S; S.init(T, NCAT, G, (int)blockIdx.x);
        pg8::EpiP1 E{(const float*)(ws + WS_RS1), a.in[8], (f16*)(ws + WS_QKVU), (f16*)(ws + WS_GATES), (f16*)(ws + WS_VT)};
        pg8::gemm_phase<pg8::EpiP1, pg8::StaticOrder, true, true>(L, g, S, E);
        REPBAR(1);
    }
    SEAM(1);
    if (IN(2)) REPS(2) {
        ph_attn(C, (const f16*)(ws + WS_QKVU), (const f16*)(ws + WS_VT), a.in[3], (f16*)(ws + WS_OCAT));
        REPBAR(2);
    }
    if (IN(2)) REPS(3) {
        ph_pool(C, L, (const f16*)(ws + WS_QKVU), (const f16*)(ws + WS_POOLW), a.in[5], (f16*)(ws + WS_OCAT));
        REPBAR(3);
    }
    if (IN(2) && IN(4)) xcd_barrier(bar);
    if (IN(4)) REPS(4) {
        pg8::Gemm g{(const f16*)(ws + WS_OCAT), (const f16*)(ws + WS_WB), T, DM, DM}; pg8::StaticOrder S; S.init(T, DM, G, (int)blockIdx.x);
        pg8::EpiMerged E{(const f16*)(ws + WS_GATES), (f16*)(ws + WS_MERGED)};
        pg8::gemm_phase<pg8::EpiMerged, pg8::StaticOrder, true, true>(L, g, S, E);
        REPBAR(4);
    }
    SEAM(4);
    if (IN(5)) REPS(5) {
        pg8::Gemm g{(const f16*)(ws + WS_MERGED), (const f16*)(ws + WS_WOUT), T, DM, DM}; pg8::StaticOrder S; S.init(T, DM, G, (int)blockIdx.x);
        pg8::EpiOut E{a.in[0], a.in[10], a.out, (f16*)(ws + WS_X1H), (float*)(ws + WS_SS2)};
        pg8::gemm_phase<pg8::EpiOut, pg8::StaticOrder, true, true>(L, g, S, E);
        REPBAR(5);
    }
    SEAM(5);
    if (IN(6)) REPS(6) {
        pg8::Gemm g{(const f16*)(ws + WS_X1H), (const f16*)(ws + WS_WQ), T, 2048, DM}; pg8::StaticOrder S; S.init(T, 2048, G, (int)blockIdx.x);
        pg8::EpiQ E{(f16*)(ws + WS_QP)};
        pg8::gemm_phase<pg8::EpiQ, pg8::StaticOrder, true, true>(L, g, S, E);
        REPBAR(6);
    }
    SEAM(6);
    if (IN(7)) REPS(7) { ph_route(C, L, (const f16*)(ws + WS_QP), (const float*)(ws + WS_SS2), (const f16*)(ws + WS_SUBK), (int*)(ws + WS_EIDX), (float*)(ws + WS_EGATE));
        ph_h2quant(C, (const f16*)(ws + WS_X1H), (const float*)(ws + WS_SS2), (unsigned*)(ws + WS_H2Q), (float*)(ws + WS_HSC)); REPBAR(7); }
    SEAM(7);
    if (IN(8)) REPS(8) {
        const Slicing SL = get_slicing((const unsigned*)(ws + WS_CTL) + CW_BAR, MISC);
        ph_upeer(C, L, SL, (const unsigned*)(ws + WS_H2Q), (const int*)(ws + WS_EIDX), (const unsigned char*)(ws + WS_UQ), (int*)(ws + WS_PDOT));
        REPBAR(8);
    }
    SEAM(8);
    if (IN(9)) {
        ph_ureduce(C, L, (const int*)(ws + WS_PDOT), (const float*)(ws + WS_HSC), (const int*)(ws + WS_EIDX), (const float*)(ws + WS_US), (const float*)(ws + WS_VS), (const float*)(ws + WS_EGATE),
                   (unsigned*)(ws + WS_WQP), (float*)(ws + WS_WSC));
        xcd_barrier(bar);
        const Slicing SL = get_slicing((const unsigned*)(ws + WS_CTL) + CW_BAR, MISC);
        if (PROBE_DUP == 9) {
            ph_vpeer<255>(C, SL, (const int*)(ws + WS_EIDX), (const unsigned*)(ws + WS_WQP), (const float*)(ws + WS_WSC), (const unsigned char*)(ws + WS_VQ), a.out, (float*)(ws + WS_QP), (float*)(ws + WS_MERGED));
            xcd_barrier(bar);
        }
        if (PROBE_DUP == 19) {
            ph_vpeer<16383>(C, SL, (const int*)(ws + WS_EIDX), (const unsigned*)(ws + WS_WQP), (const float*)(ws + WS_WSC), (const unsigned char*)(ws + WS_VQ), a.out, (float*)(ws + WS_QP), (float*)(ws + WS_MERGED));
            xcd_barrier(bar);
        }
        ph_vpeer<16383>(C, SL, (const int*)(ws + WS_EIDX), (const unsigned*)(ws + WS_WQP), (const float*)(ws + WS_WSC), (const unsigned char*)(ws + WS_VQ), a.out, a.out, (float*)(ws + WS_SSF));
    }
    SEAM(9);
    if (IN(10)) { ph_final(C, (const float*)(ws + WS_SSF), a.out, a.in[15]); }
#undef IN
#undef SEAM
}

#ifndef MK_N_LAUNCHES
#define MK_N_LAUNCHES 1
#endif
extern "C" void kernel_launch(void* const* d_in, const int* in_sizes, int n_in, void* d_out, int out_size, void* d_ws, size_t ws_size, hipStream_t stream) {
    static int grid = 0;
    if (grid == 0) {
        if (n_in != 16 || in_sizes[0] != T * DM || out_size != T * DM || ws_size < WS_END) {
            fprintf(stderr, "kernel_launch: unexpected shapes (n_in %d in0 %d out %d ws %zu)\n", n_in, n_in > 0 ? in_sizes[0] : -1, out_size, ws_size);
            grid = -1; return;
        }
        int dev = 0, cus = 0;
        if (hipGetDevice(&dev) != hipSuccess || hipDeviceGetAttribute(&cus, hipDeviceAttributeMultiprocessorCount, dev) != hipSuccess) { grid = -1; return; }
        if (hipFuncSetAttribute((const void*)mk_fwd, hipFuncAttributeMaxDynamicSharedMemorySize, LDS_BYTES) != hipSuccess) { fprintf(stderr, "kernel_launch: hipFuncSetAttribute failed\n"); grid = -1; return; }
        int per_cu = 0;
        if (hipOccupancyMaxActiveBlocksPerMultiprocessor(&per_cu, (const void*)mk_fwd, NTHREADS, LDS_BYTES) != hipSuccess || per_cu < 1)
            fprintf(stderr, "kernel_launch: occupancy query reports %d workgroups per CU\n", per_cu);
        (void)hipGetLastError();
        grid = cus;
    }
    if (grid < 0) return;
    (void)hipMemsetAsync((char*)d_ws + WS_CTL, 0, CTL_ZERO_BYTES, stream);
    Args a{};
    for (int i = 0; i < 16; ++i) a.in[i] = (const float*)d_in[i];
    a.out = (float*)d_out; a.ws = (unsigned char*)d_ws;
    if (MK_N_LAUNCHES == 1) {
        a.ph_lo = 0; a.ph_hi = N_PHASES;
        hipLaunchKernelGGL(mk_fwd, dim3(grid), dim3(NTHREADS), LDS_BYTES, stream, a);
    } else {
        for (int p = 0; p < N_PHASES; ++p) { a.ph_lo = p; a.ph_hi = p + 1; hipLaunchKernelGGL(mk_fwd, dim3(grid), dim3(NTHREADS), LDS_BYTES, stream, a); }
    }
}
```

```cpp
#include <hip/hip_runtime.h>
#include <cstdint>
#include <cstdio>

typedef _Float16 f16;
typedef _Float16 half8 __attribute__((ext_vector_type(8)));
typedef _Float16 half4 __attribute__((ext_vector_type(4)));
typedef _Float16 half2 __attribute__((ext_vector_type(2)));
typedef float f32x4 __attribute__((ext_vector_type(4)));
typedef float f32x16 __attribute__((ext_vector_type(16)));
#define LAS __attribute__((address_space(3)))
#ifndef PROBE_DIAG
#define PROBE_DIAG (0)
#endif
#ifndef PROBE_DUP
#define PROBE_DUP (-1)
#endif
#define GAS __attribute__((address_space(1)))

constexpr int DM = 1024, BATCH = 16, SEQ = 2048, T = BATCH * SEQ;
constexpr int NQKVU = 1280, NGATE = 2048, NCAT = NQKVU + NGATE;
constexpr int COL_K = 512, COL_V = 640, COL_U = 768;
constexpr int NEXP = 16384, PEER_H = 8, TOPK = 16;
constexpr float EPS = 1e-6f;
constexpr int NWAVES = 8, NTHREADS = NWAVES * 64;

constexpr size_t MiB = 1u << 20;
constexpr size_t WS_CTL = 0, CTL_ZERO_BYTES = 64 * 1024;
constexpr size_t WS_WCAT = 1 * MiB;
constexpr size_t WS_WB = 8 * MiB;
constexpr size_t WS_WOUT = 10 * MiB;
constexpr size_t WS_WQ = 12 * MiB;
constexpr size_t WS_POOLW = 16 * MiB;
constexpr size_t WS_SUBK = 16 * MiB + 512 * 1024;
constexpr size_t WS_RS1 = 17 * MiB;
constexpr size_t WS_EIDX = 18 * MiB;
constexpr size_t WS_EGATE = 34 * MiB;
constexpr size_t WS_UTAB = 50 * MiB;
constexpr size_t WS_VTAB = 82 * MiB;
constexpr size_t WS_XH = 114 * MiB;
constexpr size_t WS_MERGED = WS_XH;
constexpr size_t WS_QKVU = 178 * MiB;
constexpr size_t WS_X1H = WS_QKVU;
constexpr size_t WS_GATES = 258 * MiB;
constexpr size_t WS_QP = WS_GATES;
constexpr size_t WS_OCAT = 386 * MiB;
constexpr size_t WS_UQ = 450 * MiB;
constexpr size_t WS_VQ = 466 * MiB;
constexpr size_t WS_US = 17 * MiB + 256 * 1024, WS_VS = 17 * MiB + 512 * 1024;
constexpr size_t WS_PDOT = WS_GATES;
constexpr size_t WS_H2Q = 404 * MiB;
constexpr size_t WS_HSC = 403 * MiB;
constexpr size_t WS_SSF = 402 * MiB;
constexpr size_t WS_WQP = 386 * MiB;
constexpr size_t WS_WSC = 390 * MiB;
constexpr size_t WS_ACT = 386 * MiB;
constexpr size_t WS_SS2 = 482 * MiB;
constexpr size_t WS_VT = 484 * MiB;
constexpr size_t WS_END = 492 * MiB;
constexpr int CW_BAR = 4096;

constexpr int RING_OFF = 0, RING_BYTES = 131072;
constexpr int LDSCTL_OFF = RING_BYTES, MISC_OFF = LDSCTL_OFF + 320;
constexpr int LDS_BYTES = 147456;

#define LDS_WAIT() asm volatile("s_waitcnt lgkmcnt(0)" ::: "memory")
template <int CTRL> __device__ __forceinline__ float dppf(float x) { return __uint_as_float(__builtin_amdgcn_update_dpp(0u, __float_as_uint(x), CTRL, 0xf, 0xf, false)); }
template <int CTRL> __device__ __forceinline__ int dppi(int x) { return (int)__builtin_amdgcn_update_dpp(0u, (unsigned)x, CTRL, 0xf, 0xf, false); }
__device__ __forceinline__ float bfly32(float a, float b) { auto r = __builtin_amdgcn_permlane32_swap(__float_as_uint(a), __float_as_uint(b), false, false); return __uint_as_float(r[0]) + __uint_as_float(r[1]); }
__device__ __forceinline__ float bfly16(float a, float b) { auto r = __builtin_amdgcn_permlane16_swap(__float_as_uint(a), __float_as_uint(b), false, false); return __uint_as_float(r[0]) + __uint_as_float(r[1]); }
__device__ __forceinline__ int bfly32i(int a, int b) { auto r = __builtin_amdgcn_permlane32_swap((unsigned)a, (unsigned)b, false, false); return (int)(r[0] + r[1]); }
__device__ __forceinline__ int bfly16i(int a, int b) { auto r = __builtin_amdgcn_permlane16_swap((unsigned)a, (unsigned)b, false, false); return (int)(r[0] + r[1]); }
__device__ __forceinline__ float wave_sum(float x) {
    x += dppf<0x121>(x); x += dppf<0x122>(x); x += dppf<0x124>(x); x += dppf<0x128>(x);
    x = bfly16(x, x); return bfly32(x, x);
}
__device__ __forceinline__ int wave_sum_i(int x) {
    x += dppi<0x121>(x); x += dppi<0x122>(x); x += dppi<0x124>(x); x += dppi<0x128>(x);
    x = bfly16i(x, x); return bfly32i(x, x);
}
__device__ __forceinline__ float wave_max(float x) {
    x = fmaxf(x, dppf<0x121>(x)); x = fmaxf(x, dppf<0x122>(x)); x = fmaxf(x, dppf<0x124>(x)); x = fmaxf(x, dppf<0x128>(x));
    { auto r = __builtin_amdgcn_permlane16_swap(__float_as_uint(x), __float_as_uint(x), false, false); x = fmaxf(__uint_as_float(r[0]), __uint_as_float(r[1])); }
    { auto r = __builtin_amdgcn_permlane32_swap(__float_as_uint(x), __float_as_uint(x), false, false); x = fmaxf(__uint_as_float(r[0]), __uint_as_float(r[1])); }
    return x;
}
__device__ __forceinline__ float gelu_exact(float x) { return 0.5f * x * (1.0f + erff(x * 0.70710678118654752f)); }
__device__ __forceinline__ float rs_from_ss(const float* ss, int t) {
    float s = 0.f;
#pragma unroll
    for (int i = 0; i < 16; ++i) s += ss[(size_t)i * T + t];
    return rsqrtf(s * (1.0f / DM) + EPS);
}

struct Ctx {
    int tid, lane, wave;
    int G;
    int gw, ngw;
    int gt, ngt;
};

__device__ __forceinline__ int pack4_i8(float a, float b, float c, float d) {
    const int ia = (int)rintf(a), ib = (int)rintf(b), ic = (int)rintf(c), id = (int)rintf(d);
    return (ia & 0xff) | ((ib & 0xff) << 8) | ((ic & 0xff) << 16) | (id << 24);
}
template <bool OFFS>
__device__ __forceinline__ void quant_rows(const Ctx& C, const float* __restrict__ tab, unsigned* __restrict__ q, float* __restrict__ scale) {
    const int lane = C.lane;
    for (int r = C.gw; r < NEXP; r += C.ngw) {
        const float* row = tab + (size_t)r * DM;
        f32x4 v[4]; float m = 0.f;
#pragma unroll
        for (int j = 0; j < 4; ++j) { v[j] = *(const f32x4*)(row + j * 256 + lane * 4); m = fmaxf(m, fmaxf(fmaxf(fabsf(v[j][0]), fabsf(v[j][1])), fmaxf(fabsf(v[j][2]), fabsf(v[j][3])))); }
        m = wave_max(m);
        const float inv = m > 0.f ? 127.0f / m : 0.f;
#pragma unroll
        for (int j = 0; j < 4; ++j) {
            unsigned w = (unsigned)pack4_i8(v[j][0] * inv, v[j][1] * inv, v[j][2] * inv, v[j][3] * inv);
            if (OFFS) w ^= 0x80808080u;
            { const int dw = j * 64 + lane; q[(size_t)(dw >> 5) * (NEXP * 32) + (size_t)r * 32 + (dw & 31)] = w; }
        }
        if (lane == 0) scale[r] = m * (1.0f / 127.0f);
    }
}

__device__ __forceinline__ void p0_transpose_item(const float* W, int K, int N, f16* WT, int ldo, int koff, LAS float* scr, int item, int lane) {
    const int nblk = N / 32, kb = item / nblk, nb = item % nblk, k0 = 64 * kb, n0 = 32 * nb;
#pragma unroll 8
    for (int i = 0; i < 32; ++i) { const int kk = 2 * i + (lane >> 5); scr[kk * 33 + (lane & 31)] = W[(size_t)(k0 + kk) * N + n0 + (lane & 31)]; }
    LDS_WAIT(); asm volatile("" ::: "memory");
    const int c = lane & 7;
#pragma unroll
    for (int j = 0; j < 4; ++j) { const int n = (lane >> 3) + 8 * j; const LAS float* s = scr + (8 * c) * 33 + n;
        half8 o;
#pragma unroll
        for (int i = 0; i < 8; ++i) o[i] = (f16)s[i * 33];
        *(half8*)(WT + (size_t)(n0 + n) * ldo + koff + k0 + 8 * c) = o; }
    LDS_WAIT(); asm volatile("" ::: "memory");
}
__device__ __forceinline__ void cvt_stream(const Ctx& C, const float* in, f16* out, size_t n4) {
    for (size_t i = (size_t)C.gt; i < n4; i += (size_t)C.ngt) {
        const f32x4 v = ((const f32x4*)in)[i];
        half4 h; h[0] = (f16)v[0]; h[1] = (f16)v[1]; h[2] = (f16)v[2]; h[3] = (f16)v[3];
        ((half4*)out)[i] = h;
    }
}
__device__ __forceinline__ void rowprep(const Ctx& C, const float* x, const float* g, f16* xh, float* ss) {
    const int lane = C.lane;
    for (int t = C.gw; t < T; t += C.ngw) {
        const float* xr = x + (size_t)t * DM;
        float s = 0.f;
#pragma unroll
        for (int j = 0; j < 4; ++j) {
            const f32x4 v = *(const f32x4*)(xr + j * 256 + lane * 4);
            const f32x4 gg = *(const f32x4*)(g + j * 256 + lane * 4);
            s += v[0] * v[0] + v[1] * v[1] + v[2] * v[2] + v[3] * v[3];
            half4 h; h[0] = (f16)(v[0] * gg[0]); h[1] = (f16)(v[1] * gg[1]); h[2] = (f16)(v[2] * gg[2]); h[3] = (f16)(v[3] * gg[3]);
            *(half4*)(xh + (size_t)t * DM + j * 256 + lane * 4) = h;
        }
        s = wave_sum(s);
        if (lane == 0) ss[t] = s;
    }
}
__device__ __forceinline__ void ph_prep(const Ctx& C, LAS unsigned char* lds, const float* const* in, unsigned char* ws) {
    LAS float* scr = (LAS float*)(lds + RING_OFF + C.wave * 16384);
    f16* wcat = (f16*)(ws + WS_WCAT); f16* wb = (f16*)(ws + WS_WB); f16* wout = (f16*)(ws + WS_WOUT); f16* wq = (f16*)(ws + WS_WQ); f16* poolw = (f16*)(ws + WS_POOLW);
    constexpr int I_IN = 16 * 40, I_G = 16 * 64, I_B = 8 * 32, I_O = 16 * 32, I_Q = 16 * 64, I_P = 2 * 4;
    constexpr int NITEMS = I_IN + I_G + 2 * I_B + I_O + I_Q + 4 * I_P;
    for (int it = C.gw; it < NITEMS; it += C.ngw) {
        int r = it;
        if (r < I_IN) { p0_transpose_item(in[2], 1024, 1280, wcat, 1024, 0, scr, r, C.lane); continue; } r -= I_IN;
        if (r < I_G) { p0_transpose_item(in[7], 1024, 2048, wcat + (size_t)NQKVU * 1024, 1024, 0, scr, r, C.lane); continue; } r -= I_G;
        if (r < I_B) { p0_transpose_item(in[6], 512, 1024, wb, 1024, 0, scr, r, C.lane); continue; } r -= I_B;
        if (r < I_B) { p0_transpose_item(in[6] + 512 * 1024, 512, 1024, wb, 1024, 512, scr, r, C.lane); continue; } r -= I_B;
        if (r < I_O) { p0_transpose_item(in[9], 1024, 1024, wout, 1024, 0, scr, r, C.lane); continue; } r -= I_O;
        if (r < I_Q) { p0_transpose_item(in[11], 1024, 2048, wq, 1024, 0, scr, r, C.lane); continue; } r -= I_Q;
        { const int g = r / I_P; p0_transpose_item(in[4] + g * 128 * 128, 128, 128, poolw + g * 128 * 128, 128, 0, scr, r % I_P, C.lane); }
    }
    cvt_stream(C, in[12], (f16*)(ws + WS_SUBK), (size_t)8 * 2 * 128 * 128 / 4);
    quant_rows<false>(C, in[13], (unsigned*)(ws + WS_UQ), (float*)(ws + WS_US));
    quant_rows<false>(C, in[14], (unsigned*)(ws + WS_VQ), (float*)(ws + WS_VS));
    rowprep(C, in[0], in[1], (f16*)(ws + WS_XH), (float*)(ws + WS_RS1));
}

__device__ __forceinline__ void ph_attn_naive(const Ctx& C, const f16* __restrict__ qkvu, const float* __restrict__ sink, f16* __restrict__ ocat) {
    for (int gid = C.gt; gid < T * 8; gid += C.ngt) {
        const int t = gid % T, h = gid / T;
        const int b = t / SEQ, ts = t % SEQ, kh = h >> 2;
        float q[64], o[64];
        const f16* qr = qkvu + (size_t)t * NQKVU + h * 64;
#pragma unroll
        for (int d = 0; d < 64; ++d) { q[d] = (float)qr[d]; o[d] = 0.f; }
        const float slope = exp2f(-(float)(h + 1));
        float m = -1e30f, l = 0.f;
        const int s0 = max(ts - 128, 0), s1 = min(ts + 128, SEQ - 1);
        for (int s = s0; s <= s1; ++s) {
            const f16* kr = qkvu + (size_t)(b * SEQ + s) * NQKVU + COL_K + kh * 64;
            const f16* vr = qkvu + (size_t)(b * SEQ + s) * NQKVU + COL_V + kh * 64;
            float dot = 0.f;
#pragma unroll
            for (int d = 0; d < 64; ++d) dot += q[d] * (float)kr[d];
            const float lg = dot * 0.125f - slope * fabsf((float)(ts - s));
            const float mn = fmaxf(m, lg), al = __expf(m - mn), p = __expf(lg - mn);
            l = l * al + p;
#pragma unroll
            for (int d = 0; d < 64; ++d) o[d] = o[d] * al + p * (float)vr[d];
            m = mn;
        }
        const float sk = sink[h];
        const float mn = fmaxf(m, sk), al = __expf(m - mn);
        l = l * al + __expf(sk - mn);
        const float inv = al / l;
        f16* orow = ocat + (size_t)t * DM + h * 64;
#pragma unroll
        for (int d = 0; d < 64; ++d) orow[d] = (f16)(o[d] * inv);
    }
}

__device__ __forceinline__ void ph_attn(const Ctx& C, const f16* __restrict__ qkvu, const f16* __restrict__ vT, const float* __restrict__ sink, f16* __restrict__ ocat) {
    const int lane = C.lane, r32 = lane & 31, hh = lane >> 5;
    const int krow = (r32 & 19) | ((r32 & 4) << 1) | ((r32 & 8) >> 1);
    constexpr float L2E = 1.4426950408889634f;
    for (int u = C.gw; u < BATCH * 8 * 64; u += C.ngw) {
        const int qs = u & 63, h = (u >> 6) & 7, b = u >> 9, kh = h >> 2;
        const int tq = qs * 32 + r32;
        const float slope2 = exp2f(-(float)(h + 1)) * L2E, sink2 = sink[h] * L2E;
        const f16* qrow = qkvu + (size_t)(b * SEQ + tq) * NQKVU + h * 64 + 8 * hh;
        half8 bq[4];
#pragma unroll
        for (int ks = 0; ks < 4; ++ks) bq[ks] = *(const half8*)(qrow + 16 * ks);
        f32x16 o0, o1;
#pragma unroll
        for (int r = 0; r < 16; ++r) { o0[r] = 0.f; o1[r] = 0.f; }
        float m = -1e30f, l = 0.f;
        const int kb_lo = max(qs - 4, 0), kb_hi = min(qs + 4, 63);
        const f16* vbase = vT + (size_t)((b * 2 + kh) * 64 + r32) * SEQ + 8 * hh;
#pragma unroll 1
        for (int kb = kb_lo; kb <= kb_hi; ++kb) {
            const f16* kr = qkvu + (size_t)(b * SEQ + kb * 32 + krow) * NQKVU + COL_K + kh * 64 + 8 * hh;
            f32x16 s;
#pragma unroll
            for (int r = 0; r < 16; ++r) s[r] = 0.f;
#pragma unroll
            for (int ks = 0; ks < 4; ++ks) { const half8 ak = *(const half8*)(kr + 16 * ks); s = __builtin_amdgcn_mfma_f32_32x32x16_f16(ak, bq[ks], s, 0, 0, 0); }
            half8 va[2][2];
#pragma unroll
            for (int db = 0; db < 2; ++db)
#pragma unroll
                for (int st = 0; st < 2; ++st) va[db][st] = *(const half8*)(vbase + (size_t)(db * 32) * SEQ + kb * 32 + 16 * st);
            float bmax = -1e30f; bool ok[16];
#pragma unroll
            for (int r = 0; r < 16; ++r) {
                const int tk = kb * 32 + 16 * (r >> 3) + 8 * hh + (r & 7);
                const int dist = abs(tq - tk);
                ok[r] = dist <= 128;
                s[r] = ok[r] ? s[r] * (0.125f * L2E) - slope2 * (float)dist : -1e30f;
                bmax = fmaxf(bmax, s[r]);
            }
            bmax = fmaxf(bmax, __shfl_xor(bmax, 32));
            const float mn = fmaxf(m, bmax), al = exp2f(m - mn);
            m = mn;
            float ps = 0.f; half8 pb[2];
#pragma unroll
            for (int r = 0; r < 16; ++r) { const float p = ok[r] ? exp2f(s[r] - mn) : 0.f; ps += p; pb[r >> 3][r & 7] = (f16)p; }
            l = l * al + ps;
#pragma unroll
            for (int r = 0; r < 16; ++r) { o0[r] *= al; o1[r] *= al; }
#pragma unroll
            for (int st = 0; st < 2; ++st) { o0 = __builtin_amdgcn_mfma_f32_32x32x16_f16(va[0][st], pb[st], o0, 0, 0, 0); o1 = __builtin_amdgcn_mfma_f32_32x32x16_f16(va[1][st], pb[st], o1, 0, 0, 0); }
        }
        l += __shfl_xor(l, 32);
        const float mf = fmaxf(m, sink2), al = exp2f(m - mf);
        const float sc = al / (l * al + exp2f(sink2 - mf));
        f16* orow = ocat + (size_t)(b * SEQ + tq) * DM + h * 64 + 4 * hh;
#pragma unroll
        for (int g = 0; g < 4; ++g) {
            half4 a, c;
#pragma unroll
            for (int i = 0; i < 4; ++i) { a[i] = (f16)(o0[4 * g + i] * sc); c[i] = (f16)(o1[4 * g + i] * sc); }
            *(half4*)(orow + 8 * g) = a; *(half4*)(orow + 32 + 8 * g) = c;
        }
    }
}

__device__ __forceinline__ void ph_pool_naive(const Ctx& C, const f16* __restrict__ qkvu, f16* __restrict__ mixed) {
    for (size_t gid = (size_t)C.gt; gid < (size_t)T * 512; gid += (size_t)C.ngt) {
        const int c = (int)(gid & 511), t = (int)(gid >> 9);
        const int b = t / SEQ, ts = t % SEQ, g = c >> 7, w = 2 << g;
        const int lo = max(ts - w / 2, 0), hi = min(ts + w / 2, SEQ);
        float s = 0.f;
        for (int i = lo; i < hi; ++i) s += (float)qkvu[(size_t)(b * SEQ + i) * NQKVU + COL_U + c];
        const float mean = s / (float)(hi - lo);
        mixed[(size_t)t * 512 + c] = (f16)(mean - (float)qkvu[(size_t)t * NQKVU + COL_U + c]);
    }
}
__device__ __forceinline__ void ph_poolmm_naive(const Ctx& C, const f16* __restrict__ mixed, const f16* __restrict__ poolw_t, const float* __restrict__ pscale, f16* __restrict__ ocat) {
    for (size_t gid = (size_t)C.gt; gid < (size_t)T * 512; gid += (size_t)C.ngt) {
        const int n = (int)(gid & 511), t = (int)(gid >> 9), g = n >> 7, d = n & 127;
        const f16* mr = mixed + (size_t)t * 512 + g * 128;
        const f16* wr = poolw_t + (size_t)(g * 128 + d) * 128;
        float acc = 0.f;
        for (int c = 0; c < 128; ++c) acc += (float)mr[c] * (float)wr[c];
        ocat[(size_t)t * DM + 512 + n] = (f16)(acc * pscale[n]);
    }
}

__device__ __forceinline__ void ph_pool(const Ctx& C, LAS unsigned char* lds, const f16* __restrict__ qkvu, const f16* __restrict__ poolw_t, const float* __restrict__ pscale, f16* __restrict__ ocat) {
    const int tid = C.tid, lane = C.lane, wv = C.wave, r32 = lane & 31, hh = lane >> 5;
    for (int u = blockIdx.x; u < (T / 128) * 4; u += C.G) {
        const int g = u & 3, t0 = (u >> 2) * 128, b = t0 >> 11, hw = 1 << g;
        {
            const int c2 = tid & 63, sf = (t0 & (SEQ - 1)) + wv * 16;
            const f16* ub = qkvu + (size_t)(b * SEQ) * NQKVU + COL_U + g * 128 + 2 * c2;
            float s0 = 0.f, s1 = 0.f;
            for (int s = max(sf - hw, 0); s < min(sf + hw, SEQ); ++s) { const half2 v = *(const half2*)(ub + (size_t)s * NQKVU); s0 += (float)v[0]; s1 += (float)v[1]; }
#pragma unroll 4
            for (int i = 0; i < 16; ++i) {
                const int s = sf + i, lo = max(s - hw, 0), hi = min(s + hw, SEQ);
                const float inv = 1.0f / (float)(hi - lo);
                const half2 cur = *(const half2*)(ub + (size_t)s * NQKVU);
                half2 mx; mx[0] = (f16)(s0 * inv - (float)cur[0]); mx[1] = (f16)(s1 * inv - (float)cur[1]);
                const int tl = wv * 16 + i;
                *(LAS half2*)(lds + tl * 256 + (((c2 >> 2) ^ (tl & 15)) << 4) + ((c2 & 3) << 2)) = mx;
                if (s + hw < SEQ) { const half2 v = *(const half2*)(ub + (size_t)(s + hw) * NQKVU); s0 += (float)v[0]; s1 += (float)v[1]; }
                if (s - hw >= 0) { const half2 v = *(const half2*)(ub + (size_t)(s - hw) * NQKVU); s0 -= (float)v[0]; s1 -= (float)v[1]; }
            }
        }
        __syncthreads();
        {
            const int tb = (wv & 3) * 32, d0 = (wv >> 2) * 64, tl = tb + r32;
            f32x16 acc0, acc1;
#pragma unroll
            for (int r = 0; r < 16; ++r) { acc0[r] = 0.f; acc1[r] = 0.f; }
            const f16* wr = poolw_t + (size_t)(g * 128 + d0 + r32) * 128 + 8 * hh;
#pragma unroll
            for (int ks = 0; ks < 8; ++ks) {
                const half8 bm = *(const LAS half8*)(lds + tl * 256 + (((2 * ks + hh) ^ (tl & 15)) << 4));
                const half8 a0 = *(const half8*)(wr + 16 * ks), a1 = *(const half8*)(wr + 32 * 128 + 16 * ks);
                acc0 = __builtin_amdgcn_mfma_f32_32x32x16_f16(a0, bm, acc0, 0, 0, 0);
                acc1 = __builtin_amdgcn_mfma_f32_32x32x16_f16(a1, bm, acc1, 0, 0, 0);
            }
            f16* orow = ocat + (size_t)(t0 + tl) * DM + 512 + g * 128 + d0 + 4 * hh;
            const float* ps = pscale + g * 128 + d0 + 4 * hh;
#pragma unroll
            for (int q = 0; q < 4; ++q) {
                const f32x4 p0 = *(const f32x4*)(ps + 8 * q), p1 = *(const f32x4*)(ps + 32 + 8 * q);
                half4 x0, x1;
#pragma unroll
                for (int i = 0; i < 4; ++i) { x0[i] = (f16)(acc0[4 * q + i] * p0[i]); x1[i] = (f16)(acc1[4 * q + i] * p1[i]); }
                *(half4*)(orow + 8 * q) = x0; *(half4*)(orow + 32 + 8 * q) = x1;
            }
        }
        __syncthreads();
    }
}

#define INS(LV, LI, v_, i_) do { float cv_ = (v_); int ci_ = (i_); \
    _Pragma("unroll") for (int z_ = 0; z_ < 16; ++z_) { const bool gt_ = cv_ > LV[z_]; const float tv_ = gt_ ? LV[z_] : cv_; const int ti_ = gt_ ? LI[z_] : ci_; \
        LV[z_] = gt_ ? cv_ : LV[z_]; LI[z_] = gt_ ? ci_ : LI[z_]; cv_ = tv_; ci_ = ti_; } } while (0)
__device__ __forceinline__ void ph_route_naive(const Ctx& C, const f16* __restrict__ qp, const float* __restrict__ ss2, const f16* __restrict__ subk, int* __restrict__ eidx, float* __restrict__ egate) {
    for (int gid = C.gt; gid < T * 8; gid += C.ngt) {
        const int t = gid % T, h = gid / T;
        const float rs2 = rs_from_ss(ss2, t);
        float av[16], bv[16]; int ai[16], bi[16];
#pragma unroll
        for (int z = 0; z < 16; ++z) { av[z] = -3e38f; bv[z] = -3e38f; ai[z] = 0; bi[z] = 0; }
        for (int p = 0; p < 2; ++p) {
            const f16* qr = qp + (size_t)t * 2048 + h * 256 + p * 128;
            for (int n = 0; n < 128; ++n) {
                const f16* kr = subk + ((size_t)((h * 2 + p) * 128 + n)) * 128;
                float dot = 0.f;
                for (int c = 0; c < 128; ++c) dot += (float)qr[c] * (float)kr[c];
                dot *= rs2;
                if (p == 0) INS(av, ai, dot, n); else INS(bv, bi, dot, n);
            }
        }
        float cv[16]; int ci[16];
#pragma unroll
        for (int z = 0; z < 16; ++z) { cv[z] = -3e38f; ci[z] = 0; }
#pragma unroll
        for (int i = 0; i < 16; ++i)
#pragma unroll
            for (int j = 0; j < 16; ++j)
                if ((i + 1) * (j + 1) <= 16) INS(cv, ci, av[i] + bv[j], ai[i] * 128 + bi[j]);
        float sum = 0.f, e[16];
#pragma unroll
        for (int z = 0; z < 16; ++z) { e[z] = __expf(cv[z] - cv[0]); sum += e[z]; }
        const float inv = 1.0f / sum;
#pragma unroll
        for (int z = 0; z < 16; ++z) { eidx[(size_t)t * 128 + h * 16 + z] = ci[z]; egate[(size_t)t * 128 + h * 16 + z] = e[z] * inv; }
    }
}

__device__ __forceinline__ int mono_i(float f) { const int b = __float_as_int(f); return b ^ ((b >> 31) & 0x7fffffff); }
__device__ __forceinline__ float unmono_f(int m) { return __int_as_float(m ^ ((m >> 31) & 0x7fffffff)); }
#define INS16(Lst, x_) do { int xv_ = (x_); _Pragma("unroll") for (int z_ = 0; z_ < 16; ++z_) { const int hi_ = max(Lst[z_], xv_); xv_ = min(Lst[z_], xv_); Lst[z_] = hi_; } } while (0)
__device__ __forceinline__ void merge_pair16(int (&Lst)[16]) {
    int P[16];
#pragma unroll
    for (int z = 0; z < 16; ++z) P[z] = __shfl_xor(Lst[z], 32);
#pragma unroll
    for (int z = 0; z < 16; ++z) Lst[z] = max(Lst[z], P[15 - z]);
#pragma unroll
    for (int s = 8; s >= 1; s >>= 1)
#pragma unroll
        for (int i = 0; i < 16; ++i) if ((i & s) == 0) { const int hi = max(Lst[i], Lst[i + s]), lo = min(Lst[i], Lst[i + s]); Lst[i] = hi; Lst[i + s] = lo; }
}
__device__ __forceinline__ void ph_route(const Ctx& C, LAS unsigned char* lds, const f16* __restrict__ qp, const float* __restrict__ ss2, const f16* __restrict__ subk,
                                         int* __restrict__ eidx, float* __restrict__ egate) {
    const int lane = C.lane, r32 = lane & 31, hh = lane >> 5;
    LAS unsigned char* tab = lds + C.wave * 4096 + lane * 36;
    for (int u = C.gw; u < (T / 32) * 8; u += C.ngw) {
        const int h = u & 7, t0 = (u >> 3) * 32, t = t0 + r32;
        const float rs2 = rs_from_ss(ss2, t);
        int top[2][16];
#pragma unroll
        for (int p = 0; p < 2; ++p) {
            const f16* qrow = qp + (size_t)t * 2048 + h * 256 + p * 128 + 8 * hh;
            const f16* kbase = subk + (size_t)((h * 2 + p) * 128 + r32) * 128 + 8 * hh;
            half8 bq[8];
#pragma unroll
            for (int ks = 0; ks < 8; ++ks) bq[ks] = *(const half8*)(qrow + 16 * ks);
            int Lst[16];
#pragma unroll
            for (int z = 0; z < 16; ++z) Lst[z] = (int)0x80000000;
#pragma unroll 1
            for (int nb = 0; nb < 4; ++nb) {
                f32x16 acc = {0.f, 0.f, 0.f, 0.f, 0.f, 0.f, 0.f, 0.f, 0.f, 0.f, 0.f, 0.f, 0.f, 0.f, 0.f, 0.f};
#pragma unroll
                for (int ks = 0; ks < 8; ++ks) {
                    const half8 ak = *(const half8*)(kbase + (size_t)(nb * 32) * 128 + 16 * ks);
                    acc = __builtin_amdgcn_mfma_f32_32x32x16_f16(ak, bq[ks], acc, 0, 0, 0);
                }
#pragma unroll
                for (int r = 0; r < 16; ++r) {
                    const int n = nb * 32 + (r & 3) + 8 * (r >> 2) + 4 * hh;
                    const int key = (mono_i(acc[r] * rs2) & ~127) | (127 - n);
                    INS16(Lst, key);
                }
            }
            merge_pair16(Lst);
#pragma unroll
            for (int z = 0; z < 16; ++z) top[p][z] = Lst[z];
        }
        float va[16], vb[16];
#pragma unroll
        for (int z = 0; z < 16; ++z) { va[z] = unmono_f(top[0][z] & ~127); vb[z] = unmono_f(top[1][z] & ~127);
            tab[z] = (unsigned char)(127 - (top[0][z] & 127)); tab[16 + z] = (unsigned char)(127 - (top[1][z] & 127)); }
        int Cl[16];
#pragma unroll
        for (int z = 0; z < 16; ++z) Cl[z] = (int)0x80000000;
#pragma unroll
        for (int i = 0; i < 16; ++i)
#pragma unroll
            for (int j = 0; j < 16; ++j)
                if ((i + 1) * (j + 1) <= 16) { const int key = (mono_i(va[i] + vb[j]) & ~255) | (255 - (i * 16 + j)); INS16(Cl, key); }
        float e[16], sum = 0.f; const float mx = unmono_f(Cl[0] & ~255);
#pragma unroll
        for (int z = 0; z < 16; ++z) { e[z] = __expf(unmono_f(Cl[z] & ~255) - mx); sum += e[z]; }
        const float inv = 1.0f / sum;
        LDS_WAIT();
        int* ei = eidx + (size_t)t * 128 + h * 16 + 8 * hh; float* eg = egate + (size_t)t * 128 + h * 16 + 8 * hh;
#pragma unroll
        for (int z = 0; z < 16; ++z) {
            if ((z >> 3) == hh) { const int code = 255 - (Cl[z] & 255); const int ia = tab[code >> 4], ib = tab[16 + (code & 15)];
                ei[z & 7] = ia * 128 + ib; eg[z & 7] = e[z] * inv; }
        }
        LDS_WAIT();
    }
}

typedef unsigned u32x4 __attribute__((ext_vector_type(4)));
struct Slicing { int m, pi, nloc, rank; };
__device__ __forceinline__ Slicing get_slicing(const unsigned* bar, volatile LAS unsigned* misc) {
    Slicing S; const unsigned x = (unsigned)__builtin_amdgcn_s_getreg((3 << 11) | 20) & 0xFu;
    int m = 0, pi = 0, nloc = 1;
    for (unsigned j = 0; j < 16; ++j) { const unsigned c = __hip_atomic_load(&bar[256 + 64 * j], __ATOMIC_RELAXED, __HIP_MEMORY_SCOPE_AGENT); if (c > 0u) { if (j < x) ++pi; ++m; } if (j == x) nloc = (int)c; }
    S.m = m > 0 ? m : 1; S.pi = pi; S.nloc = nloc > 0 ? nloc : 1; S.rank = (int)misc[10];
    return S;
}
__device__ __forceinline__ float gelu_fast(float v) {
    const float av = fabsf(v), t = __builtin_amdgcn_rcpf(av * 0.2316418882f + 1.0f);
    float q = t * 0.5307027145f + (-0.7265760135f); q = q * t + 0.7107068705f; q = q * t + (-0.142248368f); q = q * t + 0.127414796f; q = q * t;
    const float m = v * (q * __builtin_amdgcn_exp2f((v * v) * (-0.72134752044f)));
    return v < 0.f ? m : v - m;
}
__device__ __forceinline__ void ph_h2quant(const Ctx& C, const f16* __restrict__ x1h, const float* __restrict__ ss2, unsigned* __restrict__ h2q, float* __restrict__ hsc) {
    const int lane = C.lane;
    for (int t = C.gw; t < T; t += C.ngw) {
        const half8 h0 = *(const half8*)(x1h + (size_t)t * DM + 16 * lane), h1 = *(const half8*)(x1h + (size_t)t * DM + 16 * lane + 8);
        float hm = 0.f;
#pragma unroll
        for (int i = 0; i < 8; ++i) hm = fmaxf(hm, fmaxf(fabsf((float)h0[i]), fabsf((float)h1[i])));
        hm = wave_max(hm);
        const float inv = hm > 0.f ? 127.0f / hm : 0.f;
        u32x4 w;
        w[0] = (unsigned)pack4_i8((float)h0[0] * inv, (float)h0[1] * inv, (float)h0[2] * inv, (float)h0[3] * inv);
        w[1] = (unsigned)pack4_i8((float)h0[4] * inv, (float)h0[5] * inv, (float)h0[6] * inv, (float)h0[7] * inv);
        w[2] = (unsigned)pack4_i8((float)h1[0] * inv, (float)h1[1] * inv, (float)h1[2] * inv, (float)h1[3] * inv);
        w[3] = (unsigned)pack4_i8((float)h1[4] * inv, (float)h1[5] * inv, (float)h1[6] * inv, (float)h1[7] * inv);
        *(u32x4*)(h2q + (size_t)t * 256 + 4 * lane) = w;
        if (lane == 0) hsc[t] = hm * (1.0f / 127.0f) * rs_from_ss(ss2, t);
    }
}
template <int EMASK>
__device__ __forceinline__ void ph_upeer(const Ctx& C, LAS unsigned char* lds, const Slicing SL, const unsigned* __restrict__ h2q, const int* __restrict__ eidx,
                                         const unsigned char* __restrict__ uq, int* __restrict__ pdot) {
    const int lane = C.lane, grp = lane >> 3, c8 = lane & 7;
    const int wv = SL.rank * NWAVES + C.wave, nwv = SL.nloc * NWAVES;
    const int ntok = (T - wv + nwv - 1) / nwv;
    auto tok = [&](int i) { const int t = wv + i * nwv; return t < T ? t : T - 1; };
    volatile LAS int* row = (volatile LAS int*)(lds + C.wave * 1024);
  for (int s = SL.pi; s < 8; s += SL.m) {
    const unsigned char* uqs = uq + (size_t)s * (NEXP * 128) + c8 * 16;
    const unsigned* hqs = h2q + s * 32 + c8 * 4;
    int tA = tok(0), tB = tok(1);
    int e0 = eidx[(size_t)tA * 128 + lane], e1 = eidx[(size_t)tA * 128 + 64 + lane];
    u32x4 hq = *(const u32x4*)(hqs + (size_t)tA * 256);
    int ne0 = eidx[(size_t)tB * 128 + lane], ne1 = eidx[(size_t)tB * 128 + 64 + lane];
    u32x4 r[16];
#pragma unroll
    for (int i = 0; i < 16; ++i) { const int e = __shfl(i < 8 ? e0 : e1, 8 * (i & 7) + grp) & EMASK; r[i] = *(const u32x4*)(uqs + (size_t)e * 128); }
#pragma unroll 1
    for (int it = 0; it < ntok; ++it) {
        const int t = tok(it), t1 = tok(it + 1), t2 = tok(it + 2);
        const int ze0 = eidx[(size_t)t2 * 128 + lane], ze1 = eidx[(size_t)t2 * 128 + 64 + lane];
        const u32x4 nhq = *(const u32x4*)(hqs + (size_t)t1 * 256);
#pragma unroll
        for (int q = 0; q < 4; ++q) {
            int evv[4];
#pragma unroll
            for (int j = 0; j < 4; ++j) evv[j] = __shfl(q < 2 ? ne0 : ne1, 32 * (q & 1) + 8 * j + grp) & EMASK;
            int pa[4], pb[4];
#pragma unroll
            for (int j = 0; j < 4; ++j) {
                pa[j] = __builtin_amdgcn_sdot4((int)r[4 * q + j][0], (int)hq[0], 0, false); pb[j] = __builtin_amdgcn_sdot4((int)r[4 * q + j][1], (int)hq[1], 0, false);
                pa[j] = __builtin_amdgcn_sdot4((int)r[4 * q + j][2], (int)hq[2], pa[j], false); pb[j] = __builtin_amdgcn_sdot4((int)r[4 * q + j][3], (int)hq[3], pb[j], false);
            }
#pragma unroll
            for (int j = 0; j < 4; ++j) { pa[j] += pb[j]; pa[j] += dppi<0xB1>(pa[j]); }
#pragma unroll
            for (int j = 0; j < 4; ++j) pa[j] += dppi<0x4E>(pa[j]);
#pragma unroll
            for (int j = 0; j < 4; ++j) pa[j] += dppi<0x141>(pa[j]);
            if (c8 == 0) {
#pragma unroll
                for (int j = 0; j < 4; ++j) row[8 * (4 * q + j) + grp] = pa[j];
            }
#pragma unroll
            for (int j = 0; j < 4; ++j) {
                asm volatile("" ::: "memory");
                r[4 * q + j] = *(const u32x4*)(uqs + (size_t)evv[j] * 128);
                asm volatile("" ::: "memory");
            }
        }
        LDS_WAIT();
        const int p0 = row[lane], p1 = row[64 + lane];
        LDS_WAIT();
        { int* pp = pdot + ((size_t)s * T + t) * 128 + lane; asm volatile("global_store_dword %0, %1, off\n\tglobal_store_dword %0, %2, off offset:256" :: "v"(pp), "v"(p0), "v"(p1) : "memory"); }
        hq = nhq; ne0 = ze0; ne1 = ze1;
    }
  }
}
__device__ __forceinline__ void ph_ureduce(const Ctx& C, LAS unsigned char* lds, const int* __restrict__ pdot, const float* __restrict__ hsc, const int* __restrict__ eidx, const float* __restrict__ us,
                                           const float* __restrict__ vs, const float* __restrict__ egate, unsigned* __restrict__ wqp, float* __restrict__ wsc) {
    const int lane = C.lane;
    volatile LAS unsigned char* row = (volatile LAS unsigned char*)(lds + C.wave * 1024);
    for (int t = C.gw; t < T; t += C.ngw) {
        const int e0 = eidx[(size_t)t * 128 + lane], e1 = eidx[(size_t)t * 128 + 64 + lane];
        int s0 = 0, s1 = 0;
#pragma unroll
        for (int s = 0; s < 8; ++s) { const int* pp = pdot + ((size_t)s * T + t) * 128 + lane; s0 += pp[0]; s1 += pp[64]; }
        const float h = hsc[t];
        const float w0 = gelu_fast((float)s0 * h * us[e0]) * egate[(size_t)t * 128 + lane] * vs[e0];
        const float w1 = gelu_fast((float)s1 * h * us[e1]) * egate[(size_t)t * 128 + 64 + lane] * vs[e1];
        const float wm = wave_max(fmaxf(fabsf(w0), fabsf(w1)));
        const float inv = wm > 0.f ? 127.0f / wm : 0.f;
        { const int k = lane; row[(k & 7) * 16 + (k >> 5) * 4 + ((k >> 3) & 3)] = (unsigned char)(int)rintf(w0 * inv); }
        { const int k = 64 + lane; row[(k & 7) * 16 + (k >> 5) * 4 + ((k >> 3) & 3)] = (unsigned char)(int)rintf(w1 * inv); }
        LDS_WAIT();
        if (lane < 32) wqp[(size_t)t * 32 + lane] = ((volatile LAS unsigned*)row)[lane];
        LDS_WAIT();
        if (lane == 0) wsc[t] = wm * (1.0f / 127.0f);
    }
}
template <int EMASK>
__device__ __forceinline__ void ph_vpeer(const Ctx& C, const Slicing SL, const int* __restrict__ eidx, const unsigned* __restrict__ wqp, const float* __restrict__ wsc, const unsigned char* __restrict__ vq,
                                         const float* xio, float* xout, float* __restrict__ ssf) {
    const int lane = C.lane, grp = lane >> 3, c8 = lane & 7;
    const bool hh = (lane & 32) != 0, b4 = (lane & 16) != 0, b3 = (lane & 8) != 0;
    const int wv = SL.rank * NWAVES + C.wave, nwv = SL.nloc * NWAVES;
    const int ntok = (T - wv + nwv - 1) / nwv;
    auto tok = [&](int i) { const int t = wv + i * nwv; return t < T ? t : T - 1; };
  for (int s = SL.pi; s < 8; s += SL.m) {
    const unsigned char* vqs = vq + (size_t)s * (NEXP * 128) + c8 * 16;
    const int chl = 8 * (hh ? 1 : 0) + 4 * (b4 ? 1 : 0) + 2 * (b3 ? 1 : 0);
    const int coff = s * 128 + c8 * 16 + chl;
    int tA = tok(0), tB = tok(1);
    int e0 = eidx[(size_t)tA * 128 + lane], e1 = eidx[(size_t)tA * 128 + 64 + lane];
    u32x4 wq = *(const u32x4*)(wqp + (size_t)tA * 32 + grp * 4); float wscale = wsc[tA];
    int ne0 = eidx[(size_t)tB * 128 + lane], ne1 = eidx[(size_t)tB * 128 + 64 + lane];
    u32x4 r[16];
#pragma unroll
    for (int i = 0; i < 16; ++i) { const int e = __shfl(i < 8 ? e0 : e1, 8 * (i & 7) + grp) & EMASK; r[i] = *(const u32x4*)(vqs + (size_t)e * 128); }
#pragma unroll 1
    for (int it = 0; it < ntok; ++it) {
        const int t = tok(it), t1 = tok(it + 1), t2 = tok(it + 2);
        const int ze0 = eidx[(size_t)t2 * 128 + lane], ze1 = eidx[(size_t)t2 * 128 + 64 + lane];
        const u32x4 nwq = *(const u32x4*)(wqp + (size_t)t1 * 32 + grp * 4); const float nwscale = wsc[t1];
        const float2 xv = *(const float2*)(xio + (size_t)t * DM + coff);
        int o[16];
#pragma unroll
        for (int c = 0; c < 16; ++c) o[c] = 0;
#pragma unroll
        for (int q = 0; q < 4; ++q) {
            int evv[4];
#pragma unroll
            for (int j = 0; j < 4; ++j) evv[j] = __shfl(q < 2 ? ne0 : ne1, 32 * (q & 1) + 8 * j + grp) & EMASK;
#pragma unroll
            for (int d = 0; d < 4; ++d) {
                const unsigned a = r[4 * q][d], b = r[4 * q + 1][d], c = r[4 * q + 2][d], e = r[4 * q + 3][d];
                const unsigned t0 = __builtin_amdgcn_perm(b, a, 0x05010400u), t1p = __builtin_amdgcn_perm(b, a, 0x07030602u);
                const unsigned u0 = __builtin_amdgcn_perm(e, c, 0x05010400u), u1 = __builtin_amdgcn_perm(e, c, 0x07030602u);
                o[4 * d + 0] = __builtin_amdgcn_sdot4((int)__builtin_amdgcn_perm(u0, t0, 0x05040100u), (int)wq[q], o[4 * d + 0], false);
                o[4 * d + 1] = __builtin_amdgcn_sdot4((int)__builtin_amdgcn_perm(u0, t0, 0x07060302u), (int)wq[q], o[4 * d + 1], false);
                o[4 * d + 2] = __builtin_amdgcn_sdot4((int)__builtin_amdgcn_perm(u1, t1p, 0x05040100u), (int)wq[q], o[4 * d + 2], false);
                o[4 * d + 3] = __builtin_amdgcn_sdot4((int)__builtin_amdgcn_perm(u1, t1p, 0x07060302u), (int)wq[q], o[4 * d + 3], false);
            }
#pragma unroll
            for (int j = 0; j < 4; ++j) {
                asm volatile("" ::: "memory");
                r[4 * q + j] = *(const u32x4*)(vqs + (size_t)evv[j] * 128);
                asm volatile("" ::: "memory");
            }
        }
        int q8[8], q4[4], q2[2];
#pragma unroll
        for (int k = 0; k < 8; ++k) q8[k] = bfly32i(o[k], o[8 + k]);
#pragma unroll
        for (int k = 0; k < 4; ++k) q4[k] = bfly16i(q8[k], q8[4 + k]);
#pragma unroll
        for (int k = 0; k < 2; ++k) { const int mine = b3 ? q4[2 + k] : q4[k], oth = b3 ? q4[k] : q4[2 + k]; q2[k] = mine + dppi<0x128>(oth); }
        const float y0 = xv.x + (float)q2[0] * wscale, y1 = xv.y + (float)q2[1] * wscale;
        { float* yp = xout + (size_t)t * DM + coff; const float2 yv = make_float2(y0, y1); asm volatile("global_store_dwordx2 %0, %1, off" :: "v"(yp), "v"(yv) : "memory"); }
        const float ss = wave_sum(y0 * y0 + y1 * y1);
        if (lane == 0) { float* sp = ssf + (size_t)s * T + t; asm volatile("global_store_dword %0, %1, off" :: "v"(sp), "v"(ss) : "memory"); }
        wq = nwq; wscale = nwscale; ne0 = ze0; ne1 = ze1;
    }
  }
}
__device__ __forceinline__ void ph_final(const Ctx& C, const float* __restrict__ ssf, float* xio, const float* __restrict__ gf) {
    const int lane = C.lane;
    for (int t = C.gw; t < T; t += C.ngw) {
        float s = 0.f;
#pragma unroll
        for (int i = 0; i < 8; ++i) s += ssf[(size_t)i * T + t];
        const float r = rsqrtf(s * (1.0f / DM) + EPS);
        float* xr = xio + (size_t)t * DM;
#pragma unroll
        for (int j = 0; j < 4; ++j) {
            const int c0 = j * 256 + lane * 4;
            const f32x4 v = *(const f32x4*)(xr + c0), gg = *(const f32x4*)(gf + c0);
            *(f32x4*)(xr + c0) = v * r * gg;
        }
    }
}

namespace pg8 {
#define PG8_LAS __attribute__((address_space(3)))
typedef _Float16 frag8 __attribute__((ext_vector_type(8)));
typedef float f32x4 __attribute__((ext_vector_type(4)));
constexpr int BM = 256, BK = 64, HALF = 128, HTB = HALF * BK * 2  , STAGE_BYTES = 8 * HTB, NXCD = 8, WGM = 8;

__host__ __device__ __forceinline__ int lds_byte(int r, int c) { const int st = (r >> 4) * 2 + (c >> 5), rr = r & 15, cc = c & 31, ob = rr * 64 + cc * 2; return st * 1024 + (ob ^ (((ob >> 9) & 1) << 5)); }
__host__ __device__ __forceinline__ void stage_rc(int b, int& R, int& C) { const int st = b / 1024, sb = b % 1024, swz = sb ^ (((sb >> 9) & 1) << 5); R = (st >> 1) * 16 + swz / 64; C = (st & 1) * 32 + (swz % 64) / 2; }
__host__ __device__ __forceinline__ int perm32(int rho) { const int n = rho >> 4, i = rho & 15; return 8 * (i >> 2) + 4 * n + (i & 3); }

struct Unit { int pm, pn; };
struct Gemm { const f16* A; const f16* Bt; int M, N, K; };

struct StaticOrder {
    int nM, nN, nwg, G, c;
    __host__ __device__ void init(int M, int N, int G_, int c_) { nM = M / BM; nN = N / BM; nwg = nM * nN; G = G_; c = c_; }
    __host__ __device__ bool next(int i, Unit& u) const {
        const long L = (long)i * G + c; if (L >= nwg) return false;
        int wgid = (int)L; { const int q = nwg / NXCD, r = nwg % NXCD, xcd = wgid % NXCD, off = wgid / NXCD; wgid = (xcd < r ? xcd * (q + 1) : r * (q + 1) + (xcd - r) * q) + off; }
        const int nig = WGM * nN, gid = wgid / nig, fm = gid * WGM, gsz = (nM - fm) < WGM ? (nM - fm) : WGM;
        u.pm = fm + ((wgid % nig) % gsz); u.pn = (wgid % nig) / gsz; return true;
    }
    __device__ __forceinline__ void a_ready(const Unit&) const {}
    __device__ __forceinline__ void done(const Unit&) const {}
};

__device__ __forceinline__ frag8 pack8(const f32x4 a, const f32x4 b) {
    frag8 h; h[0] = (f16)a[0]; h[1] = (f16)a[1]; h[2] = (f16)a[2]; h[3] = (f16)a[3]; h[4] = (f16)b[0]; h[5] = (f16)b[1]; h[6] = (f16)b[2]; h[7] = (f16)b[3]; return h;
}
__device__ __forceinline__ float sigmoidf_(float z) { return 1.0f / (1.0f + __expf(-z)); }

struct EpiP1 {
    static constexpr bool PERM = true, AFTER_DRAIN = false, MIDK = false;
    const float* ss1; const float* bgate; f16* qkvu; f16* gates; f16* vT;
    __device__ __forceinline__ void operator()(const f32x4 (&acc)[2][2][4][2], const Unit& u, int wr, int wc, int fr, int fq) const {
        const int row0 = u.pm * BM + wr * 64 + fr, colt = u.pn * BM; const bool isg = colt >= NQKVU;
#pragma unroll
        for (int ai = 0; ai < 2; ++ai)
#pragma unroll
            for (int m = 0; m < 4; ++m) { const int row = row0 + ai * HALF + m * 16; const float r = rsqrtf(ss1[row] * (1.0f / DM) + EPS);
#pragma unroll
                for (int bj = 0; bj < 2; ++bj) { const int c0 = colt + bj * HALF + wc * 32 + 8 * fq; f32x4 v0 = acc[ai][bj][m][0] * r, v1 = acc[ai][bj][m][1] * r;
                    if (isg) { const int cg = c0 - NQKVU; const f32x4 b0 = *(const f32x4*)(bgate + cg), b1 = *(const f32x4*)(bgate + cg + 4);
#pragma unroll
                        for (int i = 0; i < 4; ++i) { v0[i] = sigmoidf_(v0[i] + b0[i]); v1[i] = sigmoidf_(v1[i] + b1[i]); }
                        *(frag8*)(gates + (size_t)row * NGATE + cg) = pack8(v0, v1); }
                    else { const frag8 hv = pack8(v0, v1); *(frag8*)(qkvu + (size_t)row * NQKVU + c0) = hv;
                        if (colt == 512 && bj == 1) {
                            f16* vp = vT + ((size_t)((row >> 11) * 2 + (wc >> 1)) * 64 + (wc & 1) * 32 + 8 * fq) * SEQ + (row & (SEQ - 1));
#pragma unroll
                            for (int i = 0; i < 8; ++i) vp[(size_t)i * SEQ] = hv[i]; } } } }
    }
};
struct EpiMerged {
    static constexpr bool PERM = true, AFTER_DRAIN = false, MIDK = true;
    const f16* gates; f16* merged;
    __device__ __forceinline__ void mid(f32x4 (&acc)[2][2][4][2], const Unit& u, int wr, int wc, int fr, int fq) const {
        const int row0 = u.pm * BM + wr * 64 + fr, colt = u.pn * BM;
        const f16* gb = gates + (size_t)row0 * NGATE + colt + wc * 32 + 8 * fq;
        asm volatile("" : "+v"(gb));
#pragma unroll
        for (int ai = 0; ai < 2; ++ai) {
            frag8 g0[4][2], g1[4][2];
#pragma unroll
            for (int m = 0; m < 4; ++m)
#pragma unroll
                for (int bj = 0; bj < 2; ++bj) { const f16* gp = gb + (size_t)(ai * HALF + m * 16) * NGATE + bj * HALF; g0[m][bj] = *(const frag8*)gp; g1[m][bj] = *(const frag8*)(gp + DM); }
#pragma unroll
            for (int m = 0; m < 4; ++m)
#pragma unroll
                for (int bj = 0; bj < 2; ++bj)
#pragma unroll
                    for (int i = 0; i < 4; ++i) {
                        acc[ai][bj][m][0][i] *= (float)g0[m][bj][i] * __builtin_amdgcn_rcpf(fmaxf((float)g1[m][bj][i], 1e-4f));
                        acc[ai][bj][m][1][i] *= (float)g0[m][bj][4 + i] * __builtin_amdgcn_rcpf(fmaxf((float)g1[m][bj][4 + i], 1e-4f)); }
            asm volatile("" ::: "memory");
        }
    }
    __device__ __forceinline__ void operator()(const f32x4 (&acc)[2][2][4][2], const Unit& u, int wr, int wc, int fr, int fq) const {
        const int row0 = u.pm * BM + wr * 64 + fr, colt = u.pn * BM;
#pragma unroll
        for (int ai = 0; ai < 2; ++ai)
#pragma unroll
            for (int m = 0; m < 4; ++m) { const int row = row0 + ai * HALF + m * 16;
#pragma unroll
                for (int bj = 0; bj < 2; ++bj) { const int c0 = colt + bj * HALF + wc * 32 + 8 * fq;
                    const frag8 g1 = *(const frag8*)(gates + (size_t)row * NGATE + DM + c0); f32x4 v0, v1;
#pragma unroll
                    for (int i = 0; i < 4; ++i) { v0[i] = acc[ai][bj][m][0][i] * fmaxf((float)g1[i], 1e-4f); v1[i] = acc[ai][bj][m][1][i] * fmaxf((float)g1[4 + i], 1e-4f); }
                    *(frag8*)(merged + (size_t)row * DM + c0) = pack8(v0, v1); } }
    }
};
struct EpiOut {
    static constexpr bool PERM = false, AFTER_DRAIN = false, MIDK = false;
    const float* x; const float* g2; float* x1; f16* x1h; float* ss2p;
    __device__ __forceinline__ void operator()(const f32x4 (&acc)[2][2][4][2], const Unit& u, int wr, int wc, int fr, int fq) const {
        const int row0 = u.pm * BM + wr * 64 + fr, col0 = u.pn * BM + wc * 32 + 4 * fq;
        f32x4 gv[2][2];
#pragma unroll
        for (int bj = 0; bj < 2; ++bj)
#pragma unroll
            for (int n = 0; n < 2; ++n) gv[bj][n] = *(const f32x4*)(g2 + col0 + bj * HALF + n * 16);
#pragma unroll
        for (int ai = 0; ai < 2; ++ai)
#pragma unroll
            for (int m = 0; m < 4; ++m) { const int row = row0 + ai * HALF + m * 16; const size_t off = (size_t)row * DM + col0; float ssq = 0.f;
#pragma unroll
                for (int bj = 0; bj < 2; ++bj)
#pragma unroll
                    for (int n = 0; n < 2; ++n) { const f32x4 y = *(const f32x4*)(x + off + bj * HALF + n * 16) + acc[ai][bj][m][n];
                        *(f32x4*)(x1 + off + bj * HALF + n * 16) = y; ssq += (y[0] * y[0] + y[1] * y[1]) + (y[2] * y[2] + y[3] * y[3]);
                        const f32x4 yg = y * gv[bj][n]; half4 h; h[0] = (f16)yg[0]; h[1] = (f16)yg[1]; h[2] = (f16)yg[2]; h[3] = (f16)yg[3];
                        *(half4*)(x1h + off + bj * HALF + n * 16) = h; }
                ssq += __shfl_xor(ssq, 16); ssq += __shfl_xor(ssq, 32);
                if (fq == 0) ss2p[(size_t)(u.pn * 4 + wc) * T + row] = ssq; }
    }
};
struct EpiQ {
    static constexpr bool PERM = true, AFTER_DRAIN = false, MIDK = false;
    f16* qp;
    __device__ __forceinline__ void operator()(const f32x4 (&acc)[2][2][4][2], const Unit& u, int wr, int wc, int fr, int fq) const {
        const int row0 = u.pm * BM + wr * 64 + fr, colt = u.pn * BM;
#pragma unroll
        for (int ai = 0; ai < 2; ++ai)
#pragma unroll
            for (int m = 0; m < 4; ++m) { const int row = row0 + ai * HALF + m * 16;
#pragma unroll
                for (int bj = 0; bj < 2; ++bj) { const int c0 = colt + bj * HALF + wc * 32 + 8 * fq;
                    *(frag8*)(qp + (size_t)row * 2048 + c0) = pack8(acc[ai][bj][m][0], acc[ai][bj][m][1]); } }
    }
};

template <class Epi, class Sched, bool ALIGN_EPI = false, bool SP2 = false>
__device__ __forceinline__ void gemm_phase(PG8_LAS unsigned char* lds, const Gemm g, const Sched& S, const Epi& E) {
    const int tid = threadIdx.x, wid = __builtin_amdgcn_readfirstlane(tid >> 6), lane = tid & 63, wr = wid >> 2, wc = wid & 3, fr = lane & 15, fq = lane >> 4;
    const int K = g.K, nt = K / BK;
    unsigned voffA[2], voffB[2];
#pragma unroll
    for (int i = 0; i < 2; ++i) { int R, C; stage_rc(tid * 16 + i * 8192, R, C); const int Rb = Epi::PERM ? ((R & ~31) + perm32(R & 31)) : R;
        voffA[i] = (unsigned)(R * K + C) * 2u; voffB[i] = (unsigned)(Rb * K + C) * 2u; }
    const size_t kstep = (size_t)(BK * 2);
    const size_t hstep = (size_t)HALF * K * 2;
    const size_t tstep = 2 * hstep;
    const unsigned ldsw = (unsigned)wid * 1024u;
    const int aoff = lds_byte(wr * 64 + fr, fq * 8), boff = lds_byte(wc * 32 + fr, fq * 8);
#define PG8_SA(b, h) (((b) * 2 + (h)) * HTB)
#define PG8_SB(b, h) ((4 + (b) * 2 + (h)) * HTB)
#define PG8_STAGE(bufoff, gbase, voff) do { _Pragma("unroll") for (int _i = 0; _i < 2; ++_i) \
        __builtin_amdgcn_global_load_lds((const unsigned*)((const char*)(gbase) + (voff)[_i]), (PG8_LAS unsigned*)(lds + (bufoff) + ldsw + _i * 8192), 16, 0, 0); } while (0)
#define PG8_LDA(dst, b, h) do { _Pragma("unroll") for (int m = 0; m < 4; ++m) _Pragma("unroll") for (int k = 0; k < 2; ++k) dst[m][k] = *(const PG8_LAS frag8*)(lds + PG8_SA(b, h) + aoff + m * 2048 + k * 1024); } while (0)
#define PG8_LDB(dst, b, h) do { _Pragma("unroll") for (int n = 0; n < 2; ++n) _Pragma("unroll") for (int k = 0; k < 2; ++k) dst[n][k] = *(const PG8_LAS frag8*)(lds + PG8_SB(b, h) + boff + n * 2048 + k * 1024); } while (0)
#define PG8_MMA(ai, bj, At, Bt) do { __builtin_amdgcn_s_setprio(1); _Pragma("unroll") for (int m = 0; m < 4; ++m) _Pragma("unroll") for (int n = 0; n < 2; ++n) _Pragma("unroll") for (int k = 0; k < 2; ++k) \
        acc[ai][bj][m][n] = __builtin_amdgcn_mfma_f32_16x16x32_f16(Bt[n][k], At[m][k], acc[ai][bj][m][n], 0, 0, 0); __builtin_amdgcn_s_setprio(0); } while (0)
#define PG8_WAIT_V(n) asm volatile("s_waitcnt vmcnt(" #n ")" ::: "memory")
#define PG8_WAIT_L(n) asm volatile("s_waitcnt lgkmcnt(" #n ")" ::: "memory")
#define PG8_BAR __builtin_amdgcn_s_barrier()
#define PG8_SCHED __builtin_amdgcn_sched_barrier(0)
    Unit cur, nxt; int ui = 0;
    if (!S.next(0, cur)) return;
    f32x4 acc[2][2][4][2];
#pragma unroll
    for (int a = 0; a < 2; ++a)
#pragma unroll
        for (int b = 0; b < 2; ++b)
#pragma unroll
            for (int m = 0; m < 4; ++m)
#pragma unroll
                for (int n = 0; n < 2; ++n) acc[a][b][m][n] = (f32x4){0.f, 0.f, 0.f, 0.f};
    frag8 At[4][2], B0[2][2], B1[2][2];
    const char* cA = (const char*)g.A + (size_t)cur.pm * tstep; const char* cB = (const char*)g.Bt + (size_t)cur.pn * tstep;
    S.a_ready(cur);
    if constexpr (SP2) {
        PG8_STAGE(PG8_SB(0, 0), cB, voffB); PG8_STAGE(PG8_SB(0, 1), cB + hstep, voffB); PG8_STAGE(PG8_SA(0, 0), cA, voffA); PG8_STAGE(PG8_SA(0, 1), cA + hstep, voffA);
        if (wr == 1) PG8_BAR;
        PG8_WAIT_V(2); PG8_BAR;
        PG8_STAGE(PG8_SB(1, 0), cB + kstep, voffB); PG8_STAGE(PG8_SA(1, 0), cA + kstep, voffA); PG8_STAGE(PG8_SB(1, 1), cB + hstep + kstep, voffB);
        PG8_WAIT_V(6); PG8_BAR;
    } else {
        PG8_STAGE(PG8_SB(0, 0), cB, voffB); PG8_STAGE(PG8_SA(0, 0), cA, voffA); PG8_STAGE(PG8_SB(0, 1), cB + hstep, voffB); PG8_STAGE(PG8_SA(0, 1), cA + hstep, voffA);
        if (wr == 1) PG8_BAR;
        PG8_WAIT_V(4); PG8_BAR;
        PG8_STAGE(PG8_SB(1, 0), cB + kstep, voffB); PG8_STAGE(PG8_SA(1, 0), cA + kstep, voffA); PG8_STAGE(PG8_SB(1, 1), cB + hstep + kstep, voffB);
        PG8_WAIT_V(6); PG8_BAR;
    }
    for (;;) {
        const bool has_next = S.next(ui + 1, nxt);
        const char* nA = has_next ? (const char*)g.A + (size_t)nxt.pm * tstep : cA; const char* nB = has_next ? (const char*)g.Bt + (size_t)nxt.pn * tstep : cB;
        for (int t = 0; t < nt; t += 2) {
            const bool last = (t == nt - 2);
            if constexpr (Epi::MIDK) { if (t == (nt >> 1)) E.mid(acc, cur, wr, wc, fr, fq); }
            const char* a1 = cA + (size_t)(t + 1) * kstep;
            const char* a2 = last ? nA : cA + (size_t)(t + 2) * kstep; const char* b2 = last ? nB : cB + (size_t)(t + 2) * kstep;
            const char* a3 = a2 + kstep; const char* b3 = b2 + kstep;
            if (last && has_next) S.a_ready(nxt);
            if constexpr (SP2) {
            PG8_LDB(B0, 0, 0); PG8_LDB(B1, 0, 1); PG8_SCHED; PG8_LDA(At, 0, 0); PG8_STAGE(PG8_SA(1, 1), a1 + hstep, voffA);
            PG8_WAIT_V(8); PG8_WAIT_L(0); PG8_BAR; PG8_MMA(0, 0, At, B0); PG8_MMA(0, 1, At, B1); PG8_BAR; PG8_SCHED;
            PG8_LDA(At, 0, 1); PG8_STAGE(PG8_SB(0, 0), b2, voffB); PG8_STAGE(PG8_SB(0, 1), b2 + hstep, voffB); PG8_STAGE(PG8_SA(0, 0), a2, voffA);
            PG8_WAIT_V(8); PG8_WAIT_L(0); PG8_BAR; PG8_MMA(1, 0, At, B0); PG8_MMA(1, 1, At, B1); PG8_BAR; PG8_SCHED;
            PG8_LDB(B0, 1, 0); PG8_LDB(B1, 1, 1); PG8_SCHED; PG8_LDA(At, 1, 0); PG8_STAGE(PG8_SA(0, 1), a2 + hstep, voffA);
            PG8_WAIT_V(8); PG8_WAIT_L(0); PG8_BAR; PG8_MMA(0, 0, At, B0); PG8_MMA(0, 1, At, B1); PG8_BAR; PG8_SCHED;
            PG8_LDA(At, 1, 1); PG8_STAGE(PG8_SB(1, 0), b3, voffB); PG8_STAGE(PG8_SB(1, 1), b3 + hstep, voffB); PG8_STAGE(PG8_SA(1, 0), a3, voffA);
            PG8_WAIT_V(8); PG8_WAIT_L(0); PG8_BAR; PG8_MMA(1, 0, At, B0); PG8_MMA(1, 1, At, B1); PG8_BAR; PG8_SCHED;
            } else {
            PG8_LDB(B0, 0, 0); PG8_SCHED; PG8_LDA(At, 0, 0); PG8_STAGE(PG8_SA(1, 1), a1 + hstep, voffA);
            PG8_WAIT_L(8); PG8_BAR; PG8_WAIT_L(0); PG8_MMA(0, 0, At, B0); PG8_BAR; PG8_SCHED;
            PG8_LDB(B1, 0, 1); PG8_STAGE(PG8_SB(0, 0), b2, voffB);
            PG8_BAR; PG8_WAIT_L(0); PG8_MMA(0, 1, At, B1); PG8_BAR;
            PG8_LDA(At, 0, 1); PG8_STAGE(PG8_SA(0, 0), a2, voffA);
            PG8_BAR; PG8_WAIT_L(0); PG8_MMA(1, 0, At, B0); PG8_BAR; PG8_SCHED;
            PG8_STAGE(PG8_SB(0, 1), b2 + hstep, voffB);
            PG8_WAIT_V(6); PG8_BAR; PG8_MMA(1, 1, At, B1); PG8_BAR;
            PG8_LDB(B0, 1, 0); PG8_SCHED; PG8_LDA(At, 1, 0); PG8_STAGE(PG8_SA(0, 1), a2 + hstep, voffA);
            PG8_WAIT_L(8); PG8_BAR; PG8_WAIT_L(0); PG8_MMA(0, 0, At, B0); PG8_BAR; PG8_SCHED;
            PG8_LDB(B1, 1, 1); PG8_STAGE(PG8_SB(1, 0), b3, voffB);
            PG8_BAR; PG8_WAIT_L(0); PG8_MMA(0, 1, At, B1); PG8_BAR;
            PG8_LDA(At, 1, 1); PG8_STAGE(PG8_SA(1, 0), a3, voffA);
            PG8_BAR; PG8_WAIT_L(0); PG8_MMA(1, 0, At, B0); PG8_BAR; PG8_SCHED;
            PG8_STAGE(PG8_SB(1, 1), b3 + hstep, voffB);
            PG8_WAIT_V(6); PG8_BAR; PG8_MMA(1, 1, At, B1); PG8_BAR;
            }
        }
        if constexpr (ALIGN_EPI) { if (wr == 0) PG8_BAR; }
        if constexpr (!Epi::AFTER_DRAIN) { E(acc, cur, wr, wc, fr, fq); S.done(cur); }
        if (!has_next) break;
#pragma unroll
        for (int a = 0; a < 2; ++a)
#pragma unroll
            for (int b = 0; b < 2; ++b)
#pragma unroll
                for (int m = 0; m < 4; ++m)
#pragma unroll
                    for (int n = 0; n < 2; ++n) acc[a][b][m][n] = (f32x4){0.f, 0.f, 0.f, 0.f};
        cur = nxt; cA = nA; cB = nB; ++ui;
        if constexpr (ALIGN_EPI) { if (wr == 1) PG8_BAR; }
    }
    PG8_WAIT_V(0);
    if constexpr (!ALIGN_EPI) { if (wr == 0) PG8_BAR; }
    PG8_BAR;
    if constexpr (Epi::AFTER_DRAIN) { E.fused(acc, cur, wr, wc, fr, fq, lds, wid, lane); S.done(cur); }
#undef PG8_SA
#undef PG8_SB
#undef PG8_STAGE
#undef PG8_LDA
#undef PG8_LDB
#undef PG8_MMA
#undef PG8_WAIT_V
#undef PG8_WAIT_L
#undef PG8_BAR
#undef PG8_SCHED
}
}

#define XB_TMO      128
#define XB_XCNT(j)  (256  + 64 * (j))
#define XB_XSUB(j)  (1280 + 64 * (j))
#define XB_XGEN(j)  (2304 + 64 * (j))
#define XB_TOP      3328
#define XB_TOPGEN   3392
#define XCD_BAR_WORDS 3456
#define XB_SPIN_CAP (1u << 18)

__device__ __forceinline__ unsigned xb_ld(unsigned* p)              { return __hip_atomic_load(p, __ATOMIC_RELAXED, __HIP_MEMORY_SCOPE_AGENT); }
__device__ __forceinline__ unsigned xb_add(unsigned* p, unsigned v) { return __hip_atomic_fetch_add(p, v, __ATOMIC_RELAXED, __HIP_MEMORY_SCOPE_AGENT); }
__device__ __forceinline__ unsigned xb_xcc_id() { return (unsigned)__builtin_amdgcn_s_getreg((3 << 11) | 20) & 0xFu; }
#define XB_SPIN(cond, bar) do { unsigned _sp = 0; while (cond) { __builtin_amdgcn_s_sleep(1); \
    if ((++_sp & 255u) == 0u) { if (xb_ld(&(bar)[XB_TMO])) break; if (_sp > XB_SPIN_CAP) { atomicAdd(&(bar)[XB_TMO], 1u); break; } } } } while (0)

struct XcdBarrier {
    unsigned* bar; unsigned x;
    volatile LAS unsigned* st;
};

__device__ __forceinline__ XcdBarrier xcd_barrier_post(unsigned* bar, volatile LAS unsigned* st) {
    XcdBarrier b; b.bar = bar; b.x = xb_xcc_id(); b.st = st;
    if (threadIdx.x == 0) st[2] = xb_add(&bar[XB_XCNT(b.x)], 1u);
    return b;
}
__device__ __forceinline__ void xcd_barrier_complete(unsigned* bar, unsigned x, unsigned& nloc, unsigned& nx) {
    const unsigned G = gridDim.x * gridDim.y * gridDim.z;
    unsigned sum, cnt, mine, sp = 0u;
    for (;;) {
        sum = 0u; cnt = 0u; mine = 0u;
#pragma unroll
        for (unsigned j = 0; j < 16; ++j) { const unsigned c = xb_ld(&bar[XB_XCNT(j)]); sum += c; cnt += (c > 0u) ? 1u : 0u; mine = (j == x) ? c : mine; }
        if (sum == G) break;
        __builtin_amdgcn_s_sleep(1);
        if ((++sp & 255u) == 0u) { if (xb_ld(&bar[XB_TMO])) break; if (sp > XB_SPIN_CAP) { atomicAdd(&bar[XB_TMO], 1u); break; } }
    }
    nloc = mine > 0u ? mine : 1u; nx = cnt > 0u ? cnt : 1u;
}

__device__ __forceinline__ void xcd_barrier(const XcdBarrier& b) {
    asm volatile("s_waitcnt vmcnt(0)" ::: "memory");
    __syncthreads();
    if (threadIdx.x == 0) {
        unsigned* bar = b.bar;
        __builtin_amdgcn_s_waitcnt(0);
        unsigned nloc = b.st[0], nx = b.st[1];
        if (nloc == 0u) { xcd_barrier_complete(bar, b.x, nloc, nx); b.st[0] = nloc; b.st[1] = nx; }
        const unsigned old = xb_add(&bar[XB_XSUB(b.x)], 1u);
        const unsigned gen = old / nloc;
        if (old + 1u == (gen + 1u) * nloc) {
            __builtin_amdgcn_fence(__ATOMIC_RELEASE, "agent");
            asm volatile("s_waitcnt vmcnt(0)" ::: "memory");
            const unsigned og = xb_add(&bar[XB_TOP], 1u);
            const unsigned tg = og / nx;
            if (og + 1u == (tg + 1u) * nx) xb_add(&bar[XB_TOPGEN], 1u);
            else XB_SPIN(xb_ld(&bar[XB_TOPGEN]) == tg, bar);
            __builtin_amdgcn_fence(__ATOMIC_ACQUIRE, "agent");
            xb_add(&bar[XB_XGEN(b.x)], 1u);
            asm volatile("s_waitcnt vmcnt(0)" ::: "memory");
        } else {
            XB_SPIN(xb_ld(&bar[XB_XGEN(b.x)]) == gen, bar);
            __builtin_amdgcn_fence(__ATOMIC_ACQUIRE, "agent");
            asm volatile("s_waitcnt vmcnt(0)" ::: "memory");
        }
    }
    __syncthreads();
}


struct Args { const float* in[16]; float* out; unsigned char* ws; int ph_lo, ph_hi; };
constexpr int N_PHASES = 11;

__global__ void __launch_bounds__(NTHREADS, 2) mk_fwd(Args a) {
    extern __shared__ __attribute__((aligned(16))) unsigned char lds[];
    LAS unsigned char* L = (LAS unsigned char*)lds;
    volatile LAS unsigned* MISC = (volatile LAS unsigned*)(L + MISC_OFF);
    unsigned char* ws = a.ws;
    Ctx C;
    C.tid = threadIdx.x; C.lane = C.tid & 63; C.wave = __builtin_amdgcn_readfirstlane(C.tid >> 6);
    C.G = gridDim.x; C.gw = blockIdx.x * NWAVES + C.wave; C.ngw = C.G * NWAVES; C.gt = blockIdx.x * NTHREADS + C.tid; C.ngt = C.G * NTHREADS;
    for (int u = C.tid; u < (LDS_BYTES - LDSCTL_OFF) / 4; u += NTHREADS) ((LAS unsigned*)(L + LDSCTL_OFF))[u] = 0u;
    __syncthreads();
    const int lo = a.ph_lo, hi = a.ph_hi, G = C.G;
    const bool multi = (hi - lo) > 1;
    XcdBarrier bar; bar.bar = (unsigned*)(ws + WS_CTL) + CW_BAR; bar.x = 0; bar.st = nullptr;
    if (multi) bar = xcd_barrier_post((unsigned*)(ws + WS_CTL) + CW_BAR, MISC + 8);
#define IN(k) (lo <= (k) && (k) < hi)
#define SEAM(k) do { if (IN(k) && IN((k) + 1)) xcd_barrier(bar); } while (0)

#define REPS(k) for (int rep_ = 0; rep_ < ((PROBE_DUP == (k)) ? 2 : 1); ++rep_)
#define REPBAR(k) do { if (PROBE_DUP == (k) && rep_ == 0) xcd_barrier(bar); } while (0)
    if (IN(0)) REPS(0) { ph_prep(C, L, a.in, ws); REPBAR(0); }
    SEAM(0);
    if (IN(1)) REPS(1) {
        pg8::Gemm g{(const f16*)(ws + WS_XH), (const f16*)(ws + WS_WCAT), T, NCAT, DM}; pg8::StaticOrder S; S.init(T, NCAT, G, (int)blockIdx.x);
        pg8::EpiP1 E{(const float*)(ws + WS_RS1), a.in[8], (f16*)(ws + WS_QKVU), (f16*)(ws + WS_GATES), (f16*)(ws + WS_VT)};
        pg8::gemm_phase<pg8::EpiP1, pg8::StaticOrder, true, true>(L, g, S, E);
        REPBAR(1);
    }
    SEAM(1);
    if (IN(2)) REPS(2) {
        ph_attn(C, (const f16*)(ws + WS_QKVU), (const f16*)(ws + WS_VT), a.in[3], (f16*)(ws + WS_OCAT));
        REPBAR(2);
    }
    if (IN(2)) REPS(3) {
        ph_pool(C, L, (const f16*)(ws + WS_QKVU), (const f16*)(ws + WS_POOLW), a.in[5], (f16*)(ws + WS_OCAT));
        REPBAR(3);
    }
    if (IN(2) && IN(4)) xcd_barrier(bar);
    if (IN(4)) REPS(4) {
        pg8::Gemm g{(const f16*)(ws + WS_OCAT), (const f16*)(ws + WS_WB), T, DM, DM}; pg8::StaticOrder S; S.init(T, DM, G, (int)blockIdx.x);
        pg8::EpiMerged E{(const f16*)(ws + WS_GATES), (f16*)(ws + WS_MERGED)};
        pg8::gemm_phase<pg8::EpiMerged, pg8::StaticOrder, true, true>(L, g, S, E);
        REPBAR(4);
    }
    SEAM(4);
    if (IN(5)) REPS(5) {
        pg8::Gemm g{(const f16*)(ws + WS_MERGED), (const f16*)(ws + WS_WOUT), T, DM, DM}; pg8::StaticOrder S; S.init(T, DM, G, (int)blockIdx.x);
        pg8::EpiOut E{a.in[0], a.in[10], a.out, (f16*)(ws + WS_X1H), (float*)(ws + WS_SS2)};
        pg8::gemm_phase<pg8::EpiOut, pg8::StaticOrder, true, true>(L, g, S, E);
        REPBAR(5);
    }
    SEAM(5);
    if (IN(6)) REPS(6) {
        pg8::Gemm g{(const f16*)(ws + WS_X1H), (const f16*)(ws + WS_WQ), T, 2048, DM}; pg8::StaticOrder S; S.init(T, 2048, G, (int)blockIdx.x);
        pg8::EpiQ E{(f16*)(ws + WS_QP)};
        pg8::gemm_phase<pg8::EpiQ, pg8::StaticOrder, true, true>(L, g, S, E);
        REPBAR(6);
    }
    SEAM(6);
    if (IN(7)) REPS(7) { ph_route(C, L, (const f16*)(ws + WS_QP), (const float*)(ws + WS_SS2), (const f16*)(ws + WS_SUBK), (int*)(ws + WS_EIDX), (float*)(ws + WS_EGATE));
        ph_h2quant(C, (const f16*)(ws + WS_X1H), (const float*)(ws + WS_SS2), (unsigned*)(ws + WS_H2Q), (float*)(ws + WS_HSC)); REPBAR(7); }
    SEAM(7);
    if (IN(8)) REPS(8) {
        const Slicing SL = get_slicing((const unsigned*)(ws + WS_CTL) + CW_BAR, MISC);
        if (PROBE_DUP == 8 && rep_ == 0) ph_upeer<255>(C, L, SL, (const unsigned*)(ws + WS_H2Q), (const int*)(ws + WS_EIDX), (const unsigned char*)(ws + WS_UQ), (int*)(ws + WS_PDOT));
        else ph_upeer<16383>(C, L, SL, (const unsigned*)(ws + WS_H2Q), (const int*)(ws + WS_EIDX), (const unsigned char*)(ws + WS_UQ), (int*)(ws + WS_PDOT));
        REPBAR(8);
    }
    SEAM(8);
    if (IN(9)) {
        ph_ureduce(C, L, (const int*)(ws + WS_PDOT), (const float*)(ws + WS_HSC), (const int*)(ws + WS_EIDX), (const float*)(ws + WS_US), (const float*)(ws + WS_VS), (const float*)(ws + WS_EGATE),
                   (unsigned*)(ws + WS_WQP), (float*)(ws + WS_WSC));
        xcd_barrier(bar);
        const Slicing SL = get_slicing((const unsigned*)(ws + WS_CTL) + CW_BAR, MISC);
        if (PROBE_DUP == 9) {
            ph_vpeer<255>(C, SL, (const int*)(ws + WS_EIDX), (const unsigned*)(ws + WS_WQP), (const float*)(ws + WS_WSC), (const unsigned char*)(ws + WS_VQ), a.out, (float*)(ws + WS_QP), (float*)(ws + WS_MERGED));
            xcd_barrier(bar);
        }
        if (PROBE_DUP == 19) {
            ph_vpeer<16383>(C, SL, (const int*)(ws + WS_EIDX), (const unsigned*)(ws + WS_WQP), (const float*)(ws + WS_WSC), (const unsigned char*)(ws + WS_VQ), a.out, (float*)(ws + WS_QP), (float*)(ws + WS_MERGED));
            xcd_barrier(bar);
        }
        ph_vpeer<16383>(C, SL, (const int*)(ws + WS_EIDX), (const unsigned*)(ws + WS_WQP), (const float*)(ws + WS_WSC), (const unsigned char*)(ws + WS_VQ), a.out, a.out, (float*)(ws + WS_SSF));
    }
    SEAM(9);
    if (IN(10)) { ph_final(C, (const float*)(ws + WS_SSF), a.out, a.in[15]); }
#undef IN
#undef SEAM
}

#ifndef MK_N_LAUNCHES
#define MK_N_LAUNCHES 1
#endif
extern "C" void kernel_launch(void* const* d_in, const int* in_sizes, int n_in, void* d_out, int out_size, void* d_ws, size_t ws_size, hipStream_t stream) {
    static int grid = 0;
    if (grid == 0) {
        if (n_in != 16 || in_sizes[0] != T * DM || out_size != T * DM || ws_size < WS_END) {
            fprintf(stderr, "kernel_launch: unexpected shapes (n_in %d in0 %d out %d ws %zu)\n", n_in, n_in > 0 ? in_sizes[0] : -1, out_size, ws_size);
            grid = -1; return;
        }
        int dev = 0, cus = 0;
        if (hipGetDevice(&dev) != hipSuccess || hipDeviceGetAttribute(&cus, hipDeviceAttributeMultiprocessorCount, dev) != hipSuccess) { grid = -1; return; }
        if (hipFuncSetAttribute((const void*)mk_fwd, hipFuncAttributeMaxDynamicSharedMemorySize, LDS_BYTES) != hipSuccess) { fprintf(stderr, "kernel_launch: hipFuncSetAttribute failed\n"); grid = -1; return; }
        int per_cu = 0;
        if (hipOccupancyMaxActiveBlocksPerMultiprocessor(&per_cu, (const void*)mk_fwd, NTHREADS, LDS_BYTES) != hipSuccess || per_cu < 1)
            fprintf(stderr, "kernel_launch: occupancy query reports %d workgroups per CU\n", per_cu);
        (void)hipGetLastError();
        grid = cus;
    }
    if (grid < 0) return;
    (void)hipMemsetAsync((char*)d_ws + WS_CTL, 0, CTL_ZERO_BYTES, stream);
    Args a{};
    for (int i = 0; i < 16; ++i) a.in[i] = (const float*)d_in[i];
    a.out = (float*)d_out; a.ws = (unsigned char*)d_ws;
    if (MK_N_LAUNCHES == 1) {
        a.ph_lo = 0; a.ph_hi = N_PHASES;
        hipLaunchKernelGGL(mk_fwd, dim3(grid), dim3(NTHREADS), LDS_BYTES, stream, a);
    } else {
        for (int p = 0; p < N_PHASES; ++p) { a.ph_lo = p; a.ph_hi = p + 1; hipLaunchKernelGGL(mk_fwd, dim3(grid), dim3(NTHREADS), LDS_BYTES, stream, a); }
    }
}
```

```cpp
#include <hip/hip_runtime.h>
#include <cstdint>
#include <cstdio>

typedef _Float16 f16;
typedef _Float16 half8 __attribute__((ext_vector_type(8)));
typedef _Float16 half4 __attribute__((ext_vector_type(4)));
typedef _Float16 half2 __attribute__((ext_vector_type(2)));
typedef float f32x4 __attribute__((ext_vector_type(4)));
typedef float f32x16 __attribute__((ext_vector_type(16)));
#define LAS __attribute__((address_space(3)))
#ifndef PROBE_DIAG
#define PROBE_DIAG (0)
#endif
#ifndef PROBE_DUP
#define PROBE_DUP (-1)
#endif
#define GAS __attribute__((address_space(1)))

constexpr int DM = 1024, BATCH = 16, SEQ = 2048, T = BATCH * SEQ;
constexpr int NQKVU = 1280, NGATE = 2048, NCAT = NQKVU + NGATE;
constexpr int COL_K = 512, COL_V = 640, COL_U = 768;
constexpr int NEXP = 16384, PEER_H = 8, TOPK = 16;
constexpr float EPS = 1e-6f;
constexpr int NWAVES = 8, NTHREADS = NWAVES * 64;

constexpr size_t MiB = 1u << 20;
constexpr size_t WS_CTL = 0, CTL_ZERO_BYTES = 64 * 1024;
constexpr size_t WS_WCAT = 1 * MiB;
constexpr size_t WS_WB = 8 * MiB;
constexpr size_t WS_WOUT = 10 * MiB;
constexpr size_t WS_WQ = 12 * MiB;
constexpr size_t WS_POOLW = 16 * MiB;
constexpr size_t WS_SUBK = 16 * MiB + 512 * 1024;
constexpr size_t WS_RS1 = 17 * MiB;
constexpr size_t WS_EIDX = 18 * MiB;
constexpr size_t WS_EGATE = 34 * MiB;
constexpr size_t WS_UTAB = 50 * MiB;
constexpr size_t WS_VTAB = 82 * MiB;
constexpr size_t WS_XH = 114 * MiB;
constexpr size_t WS_MERGED = WS_XH;
constexpr size_t WS_QKVU = 178 * MiB;
constexpr size_t WS_X1H = WS_QKVU;
constexpr size_t WS_GATES = 258 * MiB;
constexpr size_t WS_QP = WS_GATES;
constexpr size_t WS_OCAT = 386 * MiB;
constexpr size_t WS_UQ = 450 * MiB;
constexpr size_t WS_VQ = 466 * MiB;
constexpr size_t WS_US = 17 * MiB + 256 * 1024, WS_VS = 17 * MiB + 512 * 1024;
constexpr size_t WS_PDOT = WS_GATES;
constexpr size_t WS_H2Q = 404 * MiB;
constexpr size_t WS_HSC = 403 * MiB;
constexpr size_t WS_SSF = 402 * MiB;
constexpr size_t WS_WQP = 386 * MiB;
constexpr size_t WS_WSC = 390 * MiB;
constexpr size_t WS_ACT = 386 * MiB;
constexpr size_t WS_SS2 = 482 * MiB;
constexpr size_t WS_VT = 484 * MiB;
constexpr size_t WS_END = 492 * MiB;
constexpr int CW_BAR = 4096;

constexpr int RING_OFF = 0, RING_BYTES = 131072;
constexpr int LDSCTL_OFF = RING_BYTES, MISC_OFF = LDSCTL_OFF + 320;
constexpr int LDS_BYTES = 147456;

#define LDS_WAIT() asm volatile("s_waitcnt lgkmcnt(0)" ::: "memory")
template <int CTRL> __device__ __forceinline__ float dppf(float x) { return __uint_as_float(__builtin_amdgcn_update_dpp(0u, __float_as_uint(x), CTRL, 0xf, 0xf, false)); }
template <int CTRL> __device__ __forceinline__ int dppi(int x) { return (int)__builtin_amdgcn_update_dpp(0u, (unsigned)x, CTRL, 0xf, 0xf, false); }
__device__ __forceinline__ float bfly32(float a, float b) { auto r = __builtin_amdgcn_permlane32_swap(__float_as_uint(a), __float_as_uint(b), false, false); return __uint_as_float(r[0]) + __uint_as_float(r[1]); }
__device__ __forceinline__ float bfly16(float a, float b) { auto r = __builtin_amdgcn_permlane16_swap(__float_as_uint(a), __float_as_uint(b), false, false); return __uint_as_float(r[0]) + __uint_as_float(r[1]); }
__device__ __forceinline__ int bfly32i(int a, int b) { auto r = __builtin_amdgcn_permlane32_swap((unsigned)a, (unsigned)b, false, false); return (int)(r[0] + r[1]); }
__device__ __forceinline__ int bfly16i(int a, int b) { auto r = __builtin_amdgcn_permlane16_swap((unsigned)a, (unsigned)b, false, false); return (int)(r[0] + r[1]); }
__device__ __forceinline__ float wave_sum(float x) {
    x += dppf<0x121>(x); x += dppf<0x122>(x); x += dppf<0x124>(x); x += dppf<0x128>(x);
    x = bfly16(x, x); return bfly32(x, x);
}
__device__ __forceinline__ int wave_sum_i(int x) {
    x += dppi<0x121>(x); x += dppi<0x122>(x); x += dppi<0x124>(x); x += dppi<0x128>(x);
    x = bfly16i(x, x); return bfly32i(x, x);
}
__device__ __forceinline__ float wave_max(float x) {
    x = fmaxf(x, dppf<0x121>(x)); x = fmaxf(x, dppf<0x122>(x)); x = fmaxf(x, dppf<0x124>(x)); x = fmaxf(x, dppf<0x128>(x));
    { auto r = __builtin_amdgcn_permlane16_swap(__float_as_uint(x), __float_as_uint(x), false, false); x = fmaxf(__uint_as_float(r[0]), __uint_as_float(r[1])); }
    { auto r = __builtin_amdgcn_permlane32_swap(__float_as_uint(x), __float_as_uint(x), false, false); x = fmaxf(__uint_as_float(r[0]), __uint_as_float(r[1])); }
    return x;
}
__device__ __forceinline__ float gelu_exact(float x) { return 0.5f * x * (1.0f + erff(x * 0.70710678118654752f)); }
__device__ __forceinline__ float rs_from_ss(const float* ss, int t) {
    float s = 0.f;
#pragma unroll
    for (int i = 0; i < 16; ++i) s += ss[(size_t)i * T + t];
    return rsqrtf(s * (1.0f / DM) + EPS);
}

struct Ctx {
    int tid, lane, wave;
    int G;
    int gw, ngw;
    int gt, ngt;
};

__device__ __forceinline__ int pack4_i8(float a, float b, float c, float d) {
    const int ia = (int)rintf(a), ib = (int)rintf(b), ic = (int)rintf(c), id = (int)rintf(d);
    return (ia & 0xff) | ((ib & 0xff) << 8) | ((ic & 0xff) << 16) | (id << 24);
}
template <bool OFFS>
__device__ __forceinline__ void quant_rows(const Ctx& C, const float* __restrict__ tab, unsigned* __restrict__ q, float* __restrict__ scale) {
    const int lane = C.lane;
    for (int r = C.gw; r < NEXP; r += C.ngw) {
        const float* row = tab + (size_t)r * DM;
        f32x4 v[4]; float m = 0.f;
#pragma unroll
        for (int j = 0; j < 4; ++j) { v[j] = *(const f32x4*)(row + j * 256 + lane * 4); m = fmaxf(m, fmaxf(fmaxf(fabsf(v[j][0]), fabsf(v[j][1])), fmaxf(fabsf(v[j][2]), fabsf(v[j][3])))); }
        m = wave_max(m);
        const float inv = m > 0.f ? 127.0f / m : 0.f;
#pragma unroll
        for (int j = 0; j < 4; ++j) {
            unsigned w = (unsigned)pack4_i8(v[j][0] * inv, v[j][1] * inv, v[j][2] * inv, v[j][3] * inv);
            if (OFFS) w ^= 0x80808080u;
            { const int dw = j * 64 + lane; q[(size_t)(dw >> 5) * (NEXP * 32) + (size_t)r * 32 + (dw & 31)] = w; }
        }
        if (lane == 0) scale[r] = m * (1.0f / 127.0f);
    }
}

__device__ __forceinline__ void p0_transpose_item(const float* W, int K, int N, f16* WT, int ldo, int koff, LAS float* scr, int item, int lane) {
    const int nblk = N / 32, kb = item / nblk, nb = item % nblk, k0 = 64 * kb, n0 = 32 * nb;
#pragma unroll 8
    for (int i = 0; i < 32; ++i) { const int kk = 2 * i + (lane >> 5); scr[kk * 33 + (lane & 31)] = W[(size_t)(k0 + kk) * N + n0 + (lane & 31)]; }
    LDS_WAIT(); asm volatile("" ::: "memory");
    const int c = lane & 7;
#pragma unroll
    for (int j = 0; j < 4; ++j) { const int n = (lane >> 3) + 8 * j; const LAS float* s = scr + (8 * c) * 33 + n;
        half8 o;
#pragma unroll
        for (int i = 0; i < 8; ++i) o[i] = (f16)s[i * 33];
        *(half8*)(WT + (size_t)(n0 + n) * ldo + koff + k0 + 8 * c) = o; }
    LDS_WAIT(); asm volatile("" ::: "memory");
}
__device__ __forceinline__ void cvt_stream(const Ctx& C, const float* in, f16* out, size_t n4) {
    for (size_t i = (size_t)C.gt; i < n4; i += (size_t)C.ngt) {
        const f32x4 v = ((const f32x4*)in)[i];
        half4 h; h[0] = (f16)v[0]; h[1] = (f16)v[1]; h[2] = (f16)v[2]; h[3] = (f16)v[3];
        ((half4*)out)[i] = h;
    }
}
__device__ __forceinline__ void rowprep(const Ctx& C, const float* x, const float* g, f16* xh, float* ss) {
    const int lane = C.lane;
    for (int t = C.gw; t < T; t += C.ngw) {
        const float* xr = x + (size_t)t * DM;
        float s = 0.f;
#pragma unroll
        for (int j = 0; j < 4; ++j) {
            const f32x4 v = *(const f32x4*)(xr + j * 256 + lane * 4);
            const f32x4 gg = *(const f32x4*)(g + j * 256 + lane * 4);
            s += v[0] * v[0] + v[1] * v[1] + v[2] * v[2] + v[3] * v[3];
            half4 h; h[0] = (f16)(v[0] * gg[0]); h[1] = (f16)(v[1] * gg[1]); h[2] = (f16)(v[2] * gg[2]); h[3] = (f16)(v[3] * gg[3]);
            *(half4*)(xh + (size_t)t * DM + j * 256 + lane * 4) = h;
        }
        s = wave_sum(s);
        if (lane == 0) ss[t] = s;
    }
}
__device__ __forceinline__ void ph_prep(const Ctx& C, LAS unsigned char* lds, const float* const* in, unsigned char* ws) {
    LAS float* scr = (LAS float*)(lds + RING_OFF + C.wave * 16384);
    f16* wcat = (f16*)(ws + WS_WCAT); f16* wb = (f16*)(ws + WS_WB); f16* wout = (f16*)(ws + WS_WOUT); f16* wq = (f16*)(ws + WS_WQ); f16* poolw = (f16*)(ws + WS_POOLW);
    constexpr int I_IN = 16 * 40, I_G = 16 * 64, I_B = 8 * 32, I_O = 16 * 32, I_Q = 16 * 64, I_P = 2 * 4;
    constexpr int NITEMS = I_IN + I_G + 2 * I_B + I_O + I_Q + 4 * I_P;
    for (int it = C.gw; it < NITEMS; it += C.ngw) {
        int r = it;
        if (r < I_IN) { p0_transpose_item(in[2], 1024, 1280, wcat, 1024, 0, scr, r, C.lane); continue; } r -= I_IN;
        if (r < I_G) { p0_transpose_item(in[7], 1024, 2048, wcat + (size_t)NQKVU * 1024, 1024, 0, scr, r, C.lane); continue; } r -= I_G;
        if (r < I_B) { p0_transpose_item(in[6], 512, 1024, wb, 1024, 0, scr, r, C.lane); continue; } r -= I_B;
        if (r < I_B) { p0_transpose_item(in[6] + 512 * 1024, 512, 1024, wb, 1024, 512, scr, r, C.lane); continue; } r -= I_B;
        if (r < I_O) { p0_transpose_item(in[9], 1024, 1024, wout, 1024, 0, scr, r, C.lane); continue; } r -= I_O;
        if (r < I_Q) { p0_transpose_item(in[11], 1024, 2048, wq, 1024, 0, scr, r, C.lane); continue; } r -= I_Q;
        { const int g = r / I_P; p0_transpose_item(in[4] + g * 128 * 128, 128, 128, poolw + g * 128 * 128, 128, 0, scr, r % I_P, C.lane); }
    }
    cvt_stream(C, in[12], (f16*)(ws + WS_SUBK), (size_t)8 * 2 * 128 * 128 / 4);
    quant_rows<false>(C, in[13], (unsigned*)(ws + WS_UQ), (float*)(ws + WS_US));
    quant_rows<false>(C, in[14], (unsigned*)(ws + WS_VQ), (float*)(ws + WS_VS));
    rowprep(C, in[0], in[1], (f16*)(ws + WS_XH), (float*)(ws + WS_RS1));
}

__device__ __forceinline__ void ph_attn_naive(const Ctx& C, const f16* __restrict__ qkvu, const float* __restrict__ sink, f16* __restrict__ ocat) {
    for (int gid = C.gt; gid < T * 8; gid += C.ngt) {
        const int t = gid % T, h = gid / T;
        const int b = t / SEQ, ts = t % SEQ, kh = h >> 2;
        float q[64], o[64];
        const f16* qr = qkvu + (size_t)t * NQKVU + h * 64;
#pragma unroll
        for (int d = 0; d < 64; ++d) { q[d] = (float)qr[d]; o[d] = 0.f; }
        const float slope = exp2f(-(float)(h + 1));
        float m = -1e30f, l = 0.f;
        const int s0 = max(ts - 128, 0), s1 = min(ts + 128, SEQ - 1);
        for (int s = s0; s <= s1; ++s) {
            const f16* kr = qkvu + (size_t)(b * SEQ + s) * NQKVU + COL_K + kh * 64;
            const f16* vr = qkvu + (size_t)(b * SEQ + s) * NQKVU + COL_V + kh * 64;
            float dot = 0.f;
#pragma unroll
            for (int d = 0; d < 64; ++d) dot += q[d] * (float)kr[d];
            const float lg = dot * 0.125f - slope * fabsf((float)(ts - s));
            const float mn = fmaxf(m, lg), al = __expf(m - mn), p = __expf(lg - mn);
            l = l * al + p;
#pragma unroll
            for (int d = 0; d < 64; ++d) o[d] = o[d] * al + p * (float)vr[d];
            m = mn;
        }
        const float sk = sink[h];
        const float mn = fmaxf(m, sk), al = __expf(m - mn);
        l = l * al + __expf(sk - mn);
        const float inv = al / l;
        f16* orow = ocat + (size_t)t * DM + h * 64;
#pragma unroll
        for (int d = 0; d < 64; ++d) orow[d] = (f16)(o[d] * inv);
    }
}

template <int DIAG = 0>
__device__ __forceinline__ void ph_attn(const Ctx& C, const f16* __restrict__ qkvu, const f16* __restrict__ vT, const float* __restrict__ sink, f16* __restrict__ ocat) {
    const int lane = C.lane, r32 = lane & 31, hh = lane >> 5;
    const int krow = (r32 & 19) | ((r32 & 4) << 1) | ((r32 & 8) >> 1);
    constexpr float L2E = 1.4426950408889634f;
    for (int u = C.gw; u < BATCH * 8 * 64; u += C.ngw) {
        const int qs = u & 63, h = (u >> 6) & 7, b = u >> 9, kh = h >> 2;
        const int tq = qs * 32 + r32;
        const float slope2 = exp2f(-(float)(h + 1)) * L2E, sink2 = sink[h] * L2E;
        const f16* qrow = qkvu + (size_t)(b * SEQ + tq) * NQKVU + h * 64 + 8 * hh;
        half8 bq[4];
#pragma unroll
        for (int ks = 0; ks < 4; ++ks) bq[ks] = *(const half8*)(qrow + 16 * ks);
        f32x16 o0, o1;
#pragma unroll
        for (int r = 0; r < 16; ++r) { o0[r] = 0.f; o1[r] = 0.f; }
        float m = -1e30f, l = 0.f;
        const int kb_lo = max(qs - 4, 0), kb_hi = min(qs + 4, 63);
        const f16* vbase = vT + (size_t)((b * 2 + kh) * 64 + r32) * SEQ + 8 * hh;
        const f16* kbase = qkvu + (size_t)(b * SEQ + krow) * NQKVU + COL_K + kh * 64 + 8 * hh;
        half8 kf[4], va[2][2];
#pragma unroll
        for (int ks = 0; ks < 4; ++ks) kf[ks] = *(const half8*)(kbase + (size_t)(kb_lo * 32) * NQKVU + 16 * ks);
#pragma unroll
        for (int db = 0; db < 2; ++db)
#pragma unroll
            for (int st = 0; st < 2; ++st) va[db][st] = *(const half8*)(vbase + (size_t)(db * 32) * SEQ + kb_lo * 32 + 16 * st);
#pragma unroll 1
        for (int kb = kb_lo; kb <= kb_hi; ++kb) {
            const int kn = (DIAG == 2) ? kb_lo : (kb < kb_hi ? kb + 1 : kb);
            half8 nkf[4], nva[2][2];
#pragma unroll
            for (int ks = 0; ks < 4; ++ks) nkf[ks] = *(const half8*)(kbase + (size_t)(kn * 32) * NQKVU + 16 * ks);
#pragma unroll
            for (int db = 0; db < 2; ++db)
#pragma unroll
                for (int st = 0; st < 2; ++st) nva[db][st] = *(const half8*)(vbase + (size_t)(db * 32) * SEQ + kn * 32 + 16 * st);
            f32x16 s;
#pragma unroll
            for (int r = 0; r < 16; ++r) s[r] = 0.f;
#pragma unroll
            for (int ks = 0; ks < 4; ++ks) s = __builtin_amdgcn_mfma_f32_32x32x16_f16(kf[ks], bq[ks], s, 0, 0, 0);
            float bmax = -1e30f; bool ok[16];
#pragma unroll
            for (int r = 0; r < 16; ++r) {
                const int tk = kb * 32 + 16 * (r >> 3) + 8 * hh + (r & 7);
                const int dist = abs(tq - tk);
                ok[r] = dist <= 128;
                s[r] = ok[r] ? s[r] * (0.125f * L2E) - slope2 * (float)dist : -1e30f;
                bmax = fmaxf(bmax, s[r]);
            }
            bmax = fmaxf(bmax, __shfl_xor(bmax, 32));
            const float mn = fmaxf(m, bmax), al = exp2f(m - mn);
            m = mn;
            float ps = 0.f; half8 pb[2];
#pragma unroll
            for (int r = 0; r < 16; ++r) { const float p = ok[r] ? (DIAG == 1 ? (s[r] - mn) : exp2f(s[r] - mn)) : 0.f; ps += p; pb[r >> 3][r & 7] = (f16)p; }
            l = l * al + ps;
#pragma unroll
            for (int r = 0; r < 16; ++r) { o0[r] *= al; o1[r] *= al; }
#pragma unroll
            for (int st = 0; st < 2; ++st) { o0 = __builtin_amdgcn_mfma_f32_32x32x16_f16(va[0][st], pb[st], o0, 0, 0, 0); o1 = __builtin_amdgcn_mfma_f32_32x32x16_f16(va[1][st], pb[st], o1, 0, 0, 0); }
#pragma unroll
            for (int ks = 0; ks < 4; ++ks) kf[ks] = nkf[ks];
#pragma unroll
            for (int db = 0; db < 2; ++db)
#pragma unroll
                for (int st = 0; st < 2; ++st) va[db][st] = nva[db][st];
        }
        l += __shfl_xor(l, 32);
        const float mf = fmaxf(m, sink2), al = exp2f(m - mf);
        const float sc = al / (l * al + exp2f(sink2 - mf));
        f16* orow = ocat + (size_t)(b * SEQ + tq) * DM + h * 64 + 4 * hh;
#pragma unroll
        for (int g = 0; g < 4; ++g) {
            half4 a, c;
#pragma unroll
            for (int i = 0; i < 4; ++i) { a[i] = (f16)(o0[4 * g + i] * sc); c[i] = (f16)(o1[4 * g + i] * sc); }
            *(half4*)(orow + 8 * g) = a; *(half4*)(orow + 32 + 8 * g) = c;
        }
    }
}

__device__ __forceinline__ void ph_pool_naive(const Ctx& C, const f16* __restrict__ qkvu, f16* __restrict__ mixed) {
    for (size_t gid = (size_t)C.gt; gid < (size_t)T * 512; gid += (size_t)C.ngt) {
        const int c = (int)(gid & 511), t = (int)(gid >> 9);
        const int b = t / SEQ, ts = t % SEQ, g = c >> 7, w = 2 << g;
        const int lo = max(ts - w / 2, 0), hi = min(ts + w / 2, SEQ);
        float s = 0.f;
        for (int i = lo; i < hi; ++i) s += (float)qkvu[(size_t)(b * SEQ + i) * NQKVU + COL_U + c];
        const float mean = s / (float)(hi - lo);
        mixed[(size_t)t * 512 + c] = (f16)(mean - (float)qkvu[(size_t)t * NQKVU + COL_U + c]);
    }
}
__device__ __forceinline__ void ph_poolmm_naive(const Ctx& C, const f16* __restrict__ mixed, const f16* __restrict__ poolw_t, const float* __restrict__ pscale, f16* __restrict__ ocat) {
    for (size_t gid = (size_t)C.gt; gid < (size_t)T * 512; gid += (size_t)C.ngt) {
        const int n = (int)(gid & 511), t = (int)(gid >> 9), g = n >> 7, d = n & 127;
        const f16* mr = mixed + (size_t)t * 512 + g * 128;
        const f16* wr = poolw_t + (size_t)(g * 128 + d) * 128;
        float acc = 0.f;
        for (int c = 0; c < 128; ++c) acc += (float)mr[c] * (float)wr[c];
        ocat[(size_t)t * DM + 512 + n] = (f16)(acc * pscale[n]);
    }
}

__device__ __forceinline__ void ph_pool(const Ctx& C, LAS unsigned char* lds, const f16* __restrict__ qkvu, const f16* __restrict__ poolw_t, const float* __restrict__ pscale, f16* __restrict__ ocat) {
    const int tid = C.tid, lane = C.lane, wv = C.wave, r32 = lane & 31, hh = lane >> 5;
    for (int u = blockIdx.x; u < (T / 128) * 4; u += C.G) {
        const int g = u & 3, t0 = (u >> 2) * 128, b = t0 >> 11, hw = 1 << g;
        {
            const int c2 = tid & 63, sf = (t0 & (SEQ - 1)) + wv * 16;
            const f16* ub = qkvu + (size_t)(b * SEQ) * NQKVU + COL_U + g * 128 + 2 * c2;
            float s0 = 0.f, s1 = 0.f;
            for (int s = max(sf - hw, 0); s < min(sf + hw, SEQ); ++s) { const half2 v = *(const half2*)(ub + (size_t)s * NQKVU); s0 += (float)v[0]; s1 += (float)v[1]; }
#pragma unroll 4
            for (int i = 0; i < 16; ++i) {
                const int s = sf + i, lo = max(s - hw, 0), hi = min(s + hw, SEQ);
                const float inv = 1.0f / (float)(hi - lo);
                const half2 cur = *(const half2*)(ub + (size_t)s * NQKVU);
                half2 mx; mx[0] = (f16)(s0 * inv - (float)cur[0]); mx[1] = (f16)(s1 * inv - (float)cur[1]);
                const int tl = wv * 16 + i;
                *(LAS half2*)(lds + tl * 256 + (((c2 >> 2) ^ (tl & 15)) << 4) + ((c2 & 3) << 2)) = mx;
                if (s + hw < SEQ) { const half2 v = *(const half2*)(ub + (size_t)(s + hw) * NQKVU); s0 += (float)v[0]; s1 += (float)v[1]; }
                if (s - hw >= 0) { const half2 v = *(const half2*)(ub + (size_t)(s - hw) * NQKVU); s0 -= (float)v[0]; s1 -= (float)v[1]; }
            }
        }
        __syncthreads();
        {
            const int tb = (wv & 3) * 32, d0 = (wv >> 2) * 64, tl = tb + r32;
            f32x16 acc0, acc1;
#pragma unroll
            for (int r = 0; r < 16; ++r) { acc0[r] = 0.f; acc1[r] = 0.f; }
            const f16* wr = poolw_t + (size_t)(g * 128 + d0 + r32) * 128 + 8 * hh;
#pragma unroll
            for (int ks = 0; ks < 8; ++ks) {
                const half8 bm = *(const LAS half8*)(lds + tl * 256 + (((2 * ks + hh) ^ (tl & 15)) << 4));
                const half8 a0 = *(const half8*)(wr + 16 * ks), a1 = *(const half8*)(wr + 32 * 128 + 16 * ks);
                acc0 = __builtin_amdgcn_mfma_f32_32x32x16_f16(a0, bm, acc0, 0, 0, 0);
                acc1 = __builtin_amdgcn_mfma_f32_32x32x16_f16(a1, bm, acc1, 0, 0, 0);
            }
            f16* orow = ocat + (size_t)(t0 + tl) * DM + 512 + g * 128 + d0 + 4 * hh;
            const float* ps = pscale + g * 128 + d0 + 4 * hh;
#pragma unroll
            for (int q = 0; q < 4; ++q) {
                const f32x4 p0 = *(const f32x4*)(ps + 8 * q), p1 = *(const f32x4*)(ps + 32 + 8 * q);
                half4 x0, x1;
#pragma unroll
                for (int i = 0; i < 4; ++i) { x0[i] = (f16)(acc0[4 * q + i] * p0[i]); x1[i] = (f16)(acc1[4 * q + i] * p1[i]); }
                *(half4*)(orow + 8 * q) = x0; *(half4*)(orow + 32 + 8 * q) = x1;
            }
        }
        __syncthreads();
    }
}

#define INS(LV, LI, v_, i_) do { float cv_ = (v_); int ci_ = (i_); \
    _Pragma("unroll") for (int z_ = 0; z_ < 16; ++z_) { const bool gt_ = cv_ > LV[z_]; const float tv_ = gt_ ? LV[z_] : cv_; const int ti_ = gt_ ? LI[z_] : ci_; \
        LV[z_] = gt_ ? cv_ : LV[z_]; LI[z_] = gt_ ? ci_ : LI[z_]; cv_ = tv_; ci_ = ti_; } } while (0)
__device__ __forceinline__ void ph_route_naive(const Ctx& C, const f16* __restrict__ qp, const float* __restrict__ ss2, const f16* __restrict__ subk, int* __restrict__ eidx, float* __restrict__ egate) {
    for (int gid = C.gt; gid < T * 8; gid += C.ngt) {
        const int t = gid % T, h = gid / T;
        const float rs2 = rs_from_ss(ss2, t);
        float av[16], bv[16]; int ai[16], bi[16];
#pragma unroll
        for (int z = 0; z < 16; ++z) { av[z] = -3e38f; bv[z] = -3e38f; ai[z] = 0; bi[z] = 0; }
        for (int p = 0; p < 2; ++p) {
            const f16* qr = qp + (size_t)t * 2048 + h * 256 + p * 128;
            for (int n = 0; n < 128; ++n) {
                const f16* kr = subk + ((size_t)((h * 2 + p) * 128 + n)) * 128;
                float dot = 0.f;
                for (int c = 0; c < 128; ++c) dot += (float)qr[c] * (float)kr[c];
                dot *= rs2;
                if (p == 0) INS(av, ai, dot, n); else INS(bv, bi, dot, n);
            }
        }
        float cv[16]; int ci[16];
#pragma unroll
        for (int z = 0; z < 16; ++z) { cv[z] = -3e38f; ci[z] = 0; }
#pragma unroll
        for (int i = 0; i < 16; ++i)
#pragma unroll
            for (int j = 0; j < 16; ++j)
                if ((i + 1) * (j + 1) <= 16) INS(cv, ci, av[i] + bv[j], ai[i] * 128 + bi[j]);
        float sum = 0.f, e[16];
#pragma unroll
        for (int z = 0; z < 16; ++z) { e[z] = __expf(cv[z] - cv[0]); sum += e[z]; }
        const float inv = 1.0f / sum;
#pragma unroll
        for (int z = 0; z < 16; ++z) { eidx[(size_t)t * 128 + h * 16 + z] = ci[z]; egate[(size_t)t * 128 + h * 16 + z] = e[z] * inv; }
    }
}

__device__ __forceinline__ int mono_i(float f) { const int b = __float_as_int(f); return b ^ ((b >> 31) & 0x7fffffff); }
__device__ __forceinline__ float unmono_f(int m) { return __int_as_float(m ^ ((m >> 31) & 0x7fffffff)); }
#define INS16(Lst, x_) do { int xv_ = (x_); _Pragma("unroll") for (int z_ = 0; z_ < 16; ++z_) { const int hi_ = max(Lst[z_], xv_); xv_ = min(Lst[z_], xv_); Lst[z_] = hi_; } } while (0)
__device__ __forceinline__ void merge_pair16(int (&Lst)[16]) {
    int P[16];
#pragma unroll
    for (int z = 0; z < 16; ++z) P[z] = __shfl_xor(Lst[z], 32);
#pragma unroll
    for (int z = 0; z < 16; ++z) Lst[z] = max(Lst[z], P[15 - z]);
#pragma unroll
    for (int s = 8; s >= 1; s >>= 1)
#pragma unroll
        for (int i = 0; i < 16; ++i) if ((i & s) == 0) { const int hi = max(Lst[i], Lst[i + s]), lo = min(Lst[i], Lst[i + s]); Lst[i] = hi; Lst[i + s] = lo; }
}
__device__ __forceinline__ void bitonic_sort16_desc(int (&K)[16]) {
#pragma unroll
    for (int k = 2; k <= 16; k <<= 1)
#pragma unroll
        for (int j = k >> 1; j > 0; j >>= 1)
#pragma unroll
            for (int i = 0; i < 16; ++i) { const int l = i ^ j; if (l > i) { const int a = K[i], b = K[l], hi = max(a, b), lo = min(a, b); const bool desc = (i & k) == 0; K[i] = desc ? hi : lo; K[l] = desc ? lo : hi; } }
}
__device__ __forceinline__ void bitonic_merge16_desc(int (&K)[16]) {
#pragma unroll
    for (int s = 8; s >= 1; s >>= 1)
#pragma unroll
        for (int i = 0; i < 16; ++i) if ((i & s) == 0) { const int hi = max(K[i], K[i + s]), lo = min(K[i], K[i + s]); K[i] = hi; K[i + s] = lo; }
}
__device__ __forceinline__ void ph_route(const Ctx& C, LAS unsigned char* lds, const f16* __restrict__ qp, const float* __restrict__ ss2, const f16* __restrict__ subk,
                                         int* __restrict__ eidx, float* __restrict__ egate) {
    const int lane = C.lane, r32 = lane & 31, hh = lane >> 5;
    LAS unsigned char* tab = lds + C.wave * 4096 + lane * 36;
    for (int u = C.gw; u < (T / 32) * 8; u += C.ngw) {
        const int h = u & 7, t0 = (u >> 3) * 32, t = t0 + r32;
        const float rs2 = rs_from_ss(ss2, t);
        int top[2][16];
#pragma unroll
        for (int p = 0; p < 2; ++p) {
            const f16* qrow = qp + (size_t)t * 2048 + h * 256 + p * 128 + 8 * hh;
            const f16* kbase = subk + (size_t)((h * 2 + p) * 128 + r32) * 128 + 8 * hh;
            half8 bq[8];
#pragma unroll
            for (int ks = 0; ks < 8; ++ks) bq[ks] = *(const half8*)(qrow + 16 * ks);
            int Lst[16];
#pragma unroll
            for (int z = 0; z < 16; ++z) Lst[z] = (int)0x80000000;
#pragma unroll 1
            for (int nb = 0; nb < 4; ++nb) {
                f32x16 acc = {0.f, 0.f, 0.f, 0.f, 0.f, 0.f, 0.f, 0.f, 0.f, 0.f, 0.f, 0.f, 0.f, 0.f, 0.f, 0.f};
#pragma unroll
                for (int ks = 0; ks < 8; ++ks) {
                    const half8 ak = *(const half8*)(kbase + (size_t)(nb * 32) * 128 + 16 * ks);
                    acc = __builtin_amdgcn_mfma_f32_32x32x16_f16(ak, bq[ks], acc, 0, 0, 0);
                }
                int K[16];
#pragma unroll
                for (int r = 0; r < 16; ++r) { const int n = nb * 32 + (r & 3) + 8 * (r >> 2) + 4 * hh; K[r] = (mono_i(acc[r] * rs2) & ~127) | (127 - n); }
                bitonic_sort16_desc(K);
#pragma unroll
                for (int z = 0; z < 16; ++z) Lst[z] = max(Lst[z], K[15 - z]);
                bitonic_merge16_desc(Lst);
            }
            merge_pair16(Lst);
#pragma unroll
            for (int z = 0; z < 16; ++z) top[p][z] = Lst[z];
        }
        float va[16], vb[16];
#pragma unroll
        for (int z = 0; z < 16; ++z) { va[z] = unmono_f(top[0][z] & ~127); vb[z] = unmono_f(top[1][z] & ~127);
            tab[z] = (unsigned char)(127 - (top[0][z] & 127)); tab[16 + z] = (unsigned char)(127 - (top[1][z] & 127)); }
        int Cl[16];
        { const float a01 = hh ? va[1] : va[0];
#pragma unroll
          for (int j = 0; j < 16; ++j) { const int key = (mono_i(a01 + vb[j]) & ~255) | (255 - (hh * 16 + j)); Cl[j] = (hh && j >= 8) ? (int)0x80000000 : key; } }
#pragma unroll
        for (int i = 2; i < 16; i += 2) {
            const float ai = hh ? va[i + 1] : va[i];
#pragma unroll
            for (int j = 0; j < 16; ++j)
                if ((i + 1) * (j + 1) <= 16) {
                    int key = (mono_i(ai + vb[j]) & ~255) | (255 - ((i + hh) * 16 + j));
                    if ((i + 2) * (j + 1) > 16) key = hh ? (int)0x80000000 : key;
                    INS16(Cl, key);
                }
        }
        merge_pair16(Cl);
        float e[16], sum = 0.f; const float mx = unmono_f(Cl[0] & ~255);
#pragma unroll
        for (int z = 0; z < 16; ++z) { e[z] = __expf(unmono_f(Cl[z] & ~255) - mx); sum += e[z]; }
        const float inv = 1.0f / sum;
        LDS_WAIT();
        int* ei = eidx + (size_t)t * 128 + h * 16 + 8 * hh; float* eg = egate + (size_t)t * 128 + h * 16 + 8 * hh;
#pragma unroll
        for (int z = 0; z < 16; ++z) {
            if ((z >> 3) == hh) { const int code = 255 - (Cl[z] & 255); const int ia = tab[code >> 4], ib = tab[16 + (code & 15)];
                ei[z & 7] = ia * 128 + ib; eg[z & 7] = e[z] * inv; }
        }
        LDS_WAIT();
    }
}

typedef unsigned u32x4 __attribute__((ext_vector_type(4)));
struct Slicing { int m, pi, nloc, rank; };
__device__ __forceinline__ Slicing get_slicing(const unsigned* bar, volatile LAS unsigned* misc) {
    Slicing S; const unsigned x = (unsigned)__builtin_amdgcn_s_getreg((3 << 11) | 20) & 0xFu;
    int m = 0, pi = 0, nloc = 1;
    for (unsigned j = 0; j < 16; ++j) { const unsigned c = __hip_atomic_load(&bar[256 + 64 * j], __ATOMIC_RELAXED, __HIP_MEMORY_SCOPE_AGENT); if (c > 0u) { if (j < x) ++pi; ++m; } if (j == x) nloc = (int)c; }
    S.m = m > 0 ? m : 1; S.pi = pi; S.nloc = nloc > 0 ? nloc : 1; S.rank = (int)misc[10];
    return S;
}
__device__ __forceinline__ float gelu_fast(float v) {
    const float av = fabsf(v), t = __builtin_amdgcn_rcpf(av * 0.2316418882f + 1.0f);
    float q = t * 0.5307027145f + (-0.7265760135f); q = q * t + 0.7107068705f; q = q * t + (-0.142248368f); q = q * t + 0.127414796f; q = q * t;
    const float m = v * (q * __builtin_amdgcn_exp2f((v * v) * (-0.72134752044f)));
    return v < 0.f ? m : v - m;
}
__device__ __forceinline__ void ph_h2quant(const Ctx& C, const f16* __restrict__ x1h, const float* __restrict__ ss2, unsigned* __restrict__ h2q, float* __restrict__ hsc) {
    const int lane = C.lane;
    for (int t = C.gw; t < T; t += C.ngw) {
        const half8 h0 = *(const half8*)(x1h + (size_t)t * DM + 16 * lane), h1 = *(const half8*)(x1h + (size_t)t * DM + 16 * lane + 8);
        float hm = 0.f;
#pragma unroll
        for (int i = 0; i < 8; ++i) hm = fmaxf(hm, fmaxf(fabsf((float)h0[i]), fabsf((float)h1[i])));
        hm = wave_max(hm);
        const float inv = hm > 0.f ? 127.0f / hm : 0.f;
        u32x4 w;
        w[0] = (unsigned)pack4_i8((float)h0[0] * inv, (float)h0[1] * inv, (float)h0[2] * inv, (float)h0[3] * inv);
        w[1] = (unsigned)pack4_i8((float)h0[4] * inv, (float)h0[5] * inv, (float)h0[6] * inv, (float)h0[7] * inv);
        w[2] = (unsigned)pack4_i8((float)h1[0] * inv, (float)h1[1] * inv, (float)h1[2] * inv, (float)h1[3] * inv);
        w[3] = (unsigned)pack4_i8((float)h1[4] * inv, (float)h1[5] * inv, (float)h1[6] * inv, (float)h1[7] * inv);
        *(u32x4*)(h2q + (size_t)t * 256 + 4 * lane) = w;
        if (lane == 0) hsc[t] = hm * (1.0f / 127.0f) * rs_from_ss(ss2, t);
    }
}
template <int EMASK>
__device__ __forceinline__ void ph_upeer(const Ctx& C, LAS unsigned char* lds, const Slicing SL, const unsigned* __restrict__ h2q, const int* __restrict__ eidx,
                                         const unsigned char* __restrict__ uq, int* __restrict__ pdot) {
    const int lane = C.lane, grp = lane >> 3, c8 = lane & 7;
    const int wv = SL.rank * NWAVES + C.wave, nwv = SL.nloc * NWAVES;
    const int ntok = (T - wv + nwv - 1) / nwv;
    auto tok = [&](int i) { const int t = wv + i * nwv; return t < T ? t : T - 1; };
    volatile LAS int* row = (volatile LAS int*)(lds + C.wave * 1024);
  for (int s = SL.pi; s < 8; s += SL.m) {
    const unsigned char* uqs = uq + (size_t)s * (NEXP * 128) + c8 * 16;
    const unsigned* hqs = h2q + s * 32 + c8 * 4;
    int tA = tok(0), tB = tok(1);
    int e0 = eidx[(size_t)tA * 128 + lane], e1 = eidx[(size_t)tA * 128 + 64 + lane];
    u32x4 hq = *(const u32x4*)(hqs + (size_t)tA * 256);
    int ne0 = eidx[(size_t)tB * 128 + lane], ne1 = eidx[(size_t)tB * 128 + 64 + lane];
    u32x4 r[16];
#pragma unroll
    for (int i = 0; i < 16; ++i) { const int e = __shfl(i < 8 ? e0 : e1, 8 * (i & 7) + grp) & EMASK; r[i] = *(const u32x4*)(uqs + (size_t)e * 128); }
#pragma unroll 1
    for (int it = 0; it < ntok; ++it) {
        const int t = tok(it), t1 = tok(it + 1), t2 = tok(it + 2);
        const int ze0 = eidx[(size_t)t2 * 128 + lane], ze1 = eidx[(size_t)t2 * 128 + 64 + lane];
        const u32x4 nhq = *(const u32x4*)(hqs + (size_t)t1 * 256);
#pragma unroll
        for (int q = 0; q < 4; ++q) {
            int evv[4];
#pragma unroll
            for (int j = 0; j < 4; ++j) evv[j] = __shfl(q < 2 ? ne0 : ne1, 32 * (q & 1) + 8 * j + grp) & EMASK;
            int pa[4], pb[4];
#pragma unroll
            for (int j = 0; j < 4; ++j) {
                pa[j] = __builtin_amdgcn_sdot4((int)r[4 * q + j][0], (int)hq[0], 0, false); pb[j] = __builtin_amdgcn_sdot4((int)r[4 * q + j][1], (int)hq[1], 0, false);
                pa[j] = __builtin_amdgcn_sdot4((int)r[4 * q + j][2], (int)hq[2], pa[j], false); pb[j] = __builtin_amdgcn_sdot4((int)r[4 * q + j][3], (int)hq[3], pb[j], false);
            }
#pragma unroll
            for (int j = 0; j < 4; ++j) { pa[j] += pb[j]; pa[j] += dppi<0xB1>(pa[j]); }
#pragma unroll
            for (int j = 0; j < 4; ++j) pa[j] += dppi<0x4E>(pa[j]);
#pragma unroll
            for (int j = 0; j < 4; ++j) pa[j] += dppi<0x141>(pa[j]);
            if (c8 == 0) {
#pragma unroll
                for (int j = 0; j < 4; ++j) row[8 * (4 * q + j) + grp] = pa[j];
            }
#pragma unroll
            for (int j = 0; j < 4; ++j) {
                asm volatile("" ::: "memory");
                r[4 * q + j] = *(const u32x4*)(uqs + (size_t)evv[j] * 128);
                asm volatile("" ::: "memory");
            }
        }
        LDS_WAIT();
        const int p0 = row[lane], p1 = row[64 + lane];
        LDS_WAIT();
        { int* pp = pdot + ((size_t)s * T + t) * 128 + lane; asm volatile("global_store_dword %0, %1, off\n\tglobal_store_dword %0, %2, off offset:256" :: "v"(pp), "v"(p0), "v"(p1) : "memory"); }
        hq = nhq; ne0 = ze0; ne1 = ze1;
    }
  }
}
__device__ __forceinline__ void ph_ureduce(const Ctx& C, LAS unsigned char* lds, const int* __restrict__ pdot, const float* __restrict__ hsc, const int* __restrict__ eidx, const float* __restrict__ us,
                                           const float* __restrict__ vs, const float* __restrict__ egate, unsigned* __restrict__ wqp, float* __restrict__ wsc) {
    const int lane = C.lane;
    volatile LAS unsigned char* row = (volatile LAS unsigned char*)(lds + C.wave * 1024);
    for (int tb = C.gw * 2; tb < T; tb += C.ngw * 2) {
        int e0[2], e1[2], s0[2], s1[2]; float h[2], g0[2], g1[2];
#pragma unroll
        for (int u = 0; u < 2; ++u) {
            const int t = tb + u;
            e0[u] = eidx[(size_t)t * 128 + lane]; e1[u] = eidx[(size_t)t * 128 + 64 + lane];
            g0[u] = egate[(size_t)t * 128 + lane]; g1[u] = egate[(size_t)t * 128 + 64 + lane];
            h[u] = hsc[t]; s0[u] = 0; s1[u] = 0;
#pragma unroll
            for (int s = 0; s < 8; ++s) { const int* pp = pdot + ((size_t)s * T + t) * 128 + lane; s0[u] += pp[0]; s1[u] += pp[64]; }
        }
        float w0[2], w1[2];
#pragma unroll
        for (int u = 0; u < 2; ++u) {
            w0[u] = gelu_fast((float)s0[u] * h[u] * us[e0[u]]) * g0[u] * vs[e0[u]];
            w1[u] = gelu_fast((float)s1[u] * h[u] * us[e1[u]]) * g1[u] * vs[e1[u]];
        }
#pragma unroll
        for (int u = 0; u < 2; ++u) {
            const int t = tb + u;
            const float wm = wave_max(fmaxf(fabsf(w0[u]), fabsf(w1[u])));
            const float inv = wm > 0.f ? 127.0f / wm : 0.f;
            { const int k = lane; row[u * 128 + (k & 7) * 16 + (k >> 5) * 4 + ((k >> 3) & 3)] = (unsigned char)(int)rintf(w0[u] * inv); }
            { const int k = 64 + lane; row[u * 128 + (k & 7) * 16 + (k >> 5) * 4 + ((k >> 3) & 3)] = (unsigned char)(int)rintf(w1[u] * inv); }
            if (lane == 0) wsc[t] = wm * (1.0f / 127.0f);
        }
        LDS_WAIT();
        wqp[(size_t)tb * 32 + lane] = ((volatile LAS unsigned*)row)[lane];
        LDS_WAIT();
    }
}
template <int EMASK>
__device__ __forceinline__ void ph_vpeer(const Ctx& C, const Slicing SL, const int* __restrict__ eidx, const unsigned* __restrict__ wqp, const float* __restrict__ wsc, const unsigned char* __restrict__ vq,
                                         const float* xio, float* xout, float* __restrict__ ssf) {
    const int lane = C.lane, grp = lane >> 3, c8 = lane & 7;
    const bool hh = (lane & 32) != 0, b4 = (lane & 16) != 0, b3 = (lane & 8) != 0;
    const int wv = SL.rank * NWAVES + C.wave, nwv = SL.nloc * NWAVES;
    const int ntok = (T - wv + nwv - 1) / nwv;
    auto tok = [&](int i) { const int t = wv + i * nwv; return t < T ? t : T - 1; };
  for (int s = SL.pi; s < 8; s += SL.m) {
    const unsigned char* vqs = vq + (size_t)s * (NEXP * 128) + c8 * 16;
    const int chl = 8 * (hh ? 1 : 0) + 4 * (b4 ? 1 : 0) + 2 * (b3 ? 1 : 0);
    const int coff = s * 128 + c8 * 16 + chl;
    int tA = tok(0), tB = tok(1);
    int e0 = eidx[(size_t)tA * 128 + lane], e1 = eidx[(size_t)tA * 128 + 64 + lane];
    u32x4 wq = *(const u32x4*)(wqp + (size_t)tA * 32 + grp * 4); float wscale = wsc[tA];
    int ne0 = eidx[(size_t)tB * 128 + lane], ne1 = eidx[(size_t)tB * 128 + 64 + lane];
    u32x4 r[16];
#pragma unroll
    for (int i = 0; i < 16; ++i) { const int e = __shfl(i < 8 ? e0 : e1, 8 * (i & 7) + grp) & EMASK; r[i] = *(const u32x4*)(vqs + (size_t)e * 128); }
#pragma unroll 1
    for (int it = 0; it < ntok; ++it) {
        const int t = tok(it), t1 = tok(it + 1), t2 = tok(it + 2);
        const int ze0 = eidx[(size_t)t2 * 128 + lane], ze1 = eidx[(size_t)t2 * 128 + 64 + lane];
        const u32x4 nwq = *(const u32x4*)(wqp + (size_t)t1 * 32 + grp * 4); const float nwscale = wsc[t1];
        const float2 xv = *(const float2*)(xio + (size_t)t * DM + coff);
        int o[16];
#pragma unroll
        for (int c = 0; c < 16; ++c) o[c] = 0;
#pragma unroll
        for (int q = 0; q < 4; ++q) {
            int evv[4];
#pragma unroll
            for (int j = 0; j < 4; ++j) evv[j] = __shfl(q < 2 ? ne0 : ne1, 32 * (q & 1) + 8 * j + grp) & EMASK;
#pragma unroll
            for (int d = 0; d < 4; ++d) {
                const unsigned a = r[4 * q][d], b = r[4 * q + 1][d], c = r[4 * q + 2][d], e = r[4 * q + 3][d];
                const unsigned t0 = __builtin_amdgcn_perm(b, a, 0x05010400u), t1p = __builtin_amdgcn_perm(b, a, 0x07030602u);
                const unsigned u0 = __builtin_amdgcn_perm(e, c, 0x05010400u), u1 = __builtin_amdgcn_perm(e, c, 0x07030602u);
                o[4 * d + 0] = __builtin_amdgcn_sdot4((int)__builtin_amdgcn_perm(u0, t0, 0x05040100u), (int)wq[q], o[4 * d + 0], false);
                o[4 * d + 1] = __builtin_amdgcn_sdot4((int)__builtin_amdgcn_perm(u0, t0, 0x07060302u), (int)wq[q], o[4 * d + 1], false);
                o[4 * d + 2] = __builtin_amdgcn_sdot4((int)__builtin_amdgcn_perm(u1, t1p, 0x05040100u), (int)wq[q], o[4 * d + 2], false);
                o[4 * d + 3] = __builtin_amdgcn_sdot4((int)__builtin_amdgcn_perm(u1, t1p, 0x07060302u), (int)wq[q], o[4 * d + 3], false);
            }
#pragma unroll
            for (int j = 0; j < 4; ++j) {
                asm volatile("" ::: "memory");
                r[4 * q + j] = *(const u32x4*)(vqs + (size_t)evv[j] * 128);
                asm volatile("" ::: "memory");
            }
        }
        int q8[8], q4[4], q2[2];
#pragma unroll
        for (int k = 0; k < 8; ++k) q8[k] = bfly32i(o[k], o[8 + k]);
#pragma unroll
        for (int k = 0; k < 4; ++k) q4[k] = bfly16i(q8[k], q8[4 + k]);
#pragma unroll
        for (int k = 0; k < 2; ++k) { const int mine = b3 ? q4[2 + k] : q4[k], oth = b3 ? q4[k] : q4[2 + k]; q2[k] = mine + dppi<0x128>(oth); }
        const float y0 = xv.x + (float)q2[0] * wscale, y1 = xv.y + (float)q2[1] * wscale;
        { float* yp = xout + (size_t)t * DM + coff; const float2 yv = make_float2(y0, y1); asm volatile("global_store_dwordx2 %0, %1, off" :: "v"(yp), "v"(yv) : "memory"); }
        const float ss = wave_sum(y0 * y0 + y1 * y1);
        if (lane == 0) { float* sp = ssf + (size_t)s * T + t; asm volatile("global_store_dword %0, %1, off" :: "v"(sp), "v"(ss) : "memory"); }
        wq = nwq; wscale = nwscale; ne0 = ze0; ne1 = ze1;
    }
  }
}
__device__ __forceinline__ void ph_final(const Ctx& C, const float* __restrict__ ssf, float* xio, const float* __restrict__ gf) {
    const int lane = C.lane;
    for (int t = C.gw; t < T; t += C.ngw) {
        float s = 0.f;
#pragma unroll
        for (int i = 0; i < 8; ++i) s += ssf[(size_t)i * T + t];
        const float r = rsqrtf(s * (1.0f / DM) + EPS);
        float* xr = xio + (size_t)t * DM;
#pragma unroll
        for (int j = 0; j < 4; ++j) {
            const int c0 = j * 256 + lane * 4;
            const f32x4 v = *(const f32x4*)(xr + c0), gg = *(const f32x4*)(gf + c0);
            *(f32x4*)(xr + c0) = v * r * gg;
        }
    }
}

namespace pg8 {
#define PG8_LAS __attribute__((address_space(3)))
typedef _Float16 frag8 __attribute__((ext_vector_type(8)));
typedef float f32x4 __attribute__((ext_vector_type(4)));
constexpr int BM = 256, BK = 64, HALF = 128, HTB = HALF * BK * 2  , STAGE_BYTES = 8 * HTB, NXCD = 8, WGM = 8;

__host__ __device__ __forceinline__ int lds_byte(int r, int c) { const int st = (r >> 4) * 2 + (c >> 5), rr = r & 15, cc = c & 31, ob = rr * 64 + cc * 2; return st * 1024 + (ob ^ (((ob >> 9) & 1) << 5)); }
__host__ __device__ __forceinline__ void stage_rc(int b, int& R, int& C) { const int st = b / 1024, sb = b % 1024, swz = sb ^ (((sb >> 9) & 1) << 5); R = (st >> 1) * 16 + swz / 64; C = (st & 1) * 32 + (swz % 64) / 2; }
__host__ __device__ __forceinline__ int perm32(int rho) { const int n = rho >> 4, i = rho & 15; return 8 * (i >> 2) + 4 * n + (i & 3); }

struct Unit { int pm, pn; };
struct Gemm { const f16* A; const f16* Bt; int M, N, K; };

struct StaticOrder {
    int nM, nN, nwg, G, c;
    __host__ __device__ void init(int M, int N, int G_, int c_) { nM = M / BM; nN = N / BM; nwg = nM * nN; G = G_; c = c_; }
    __host__ __device__ bool next(int i, Unit& u) const {
        const long L = (long)i * G + c; if (L >= nwg) return false;
        int wgid = (int)L; { const int q = nwg / NXCD, r = nwg % NXCD, xcd = wgid % NXCD, off = wgid / NXCD; wgid = (xcd < r ? xcd * (q + 1) : r * (q + 1) + (xcd - r) * q) + off; }
        const int nig = WGM * nN, gid = wgid / nig, fm = gid * WGM, gsz = (nM - fm) < WGM ? (nM - fm) : WGM;
        u.pm = fm + ((wgid % nig) % gsz); u.pn = (wgid % nig) / gsz; return true;
    }
    __device__ __forceinline__ void a_ready(const Unit&) const {}
    __device__ __forceinline__ void done(const Unit&) const {}
};

__device__ __forceinline__ frag8 pack8(const f32x4 a, const f32x4 b) {
    frag8 h; h[0] = (f16)a[0]; h[1] = (f16)a[1]; h[2] = (f16)a[2]; h[3] = (f16)a[3]; h[4] = (f16)b[0]; h[5] = (f16)b[1]; h[6] = (f16)b[2]; h[7] = (f16)b[3]; return h;
}
__device__ __forceinline__ float sigmoidf_(float z) { return 1.0f / (1.0f + __expf(-z)); }

struct EpiP1 {
    static constexpr bool PERM = true, AFTER_DRAIN = false, MIDK = false;
    const float* ss1; const float* bgate; f16* qkvu; f16* gates; f16* vT;
    __device__ __forceinline__ void operator()(const f32x4 (&acc)[2][2][4][2], const Unit& u, int wr, int wc, int fr, int fq) const {
        const int row0 = u.pm * BM + wr * 64 + fr, colt = u.pn * BM; const bool isg = colt >= NQKVU;
#pragma unroll
        for (int ai = 0; ai < 2; ++ai)
#pragma unroll
            for (int m = 0; m < 4; ++m) { const int row = row0 + ai * HALF + m * 16; const float r = rsqrtf(ss1[row] * (1.0f / DM) + EPS);
#pragma unroll
                for (int bj = 0; bj < 2; ++bj) { const int c0 = colt + bj * HALF + wc * 32 + 8 * fq; f32x4 v0 = acc[ai][bj][m][0] * r, v1 = acc[ai][bj][m][1] * r;
                    if (isg) { const int cg = c0 - NQKVU; const f32x4 b0 = *(const f32x4*)(bgate + cg), b1 = *(const f32x4*)(bgate + cg + 4);
#pragma unroll
                        for (int i = 0; i < 4; ++i) { v0[i] = sigmoidf_(v0[i] + b0[i]); v1[i] = sigmoidf_(v1[i] + b1[i]); }
                        *(frag8*)(gates + (size_t)row * NGATE + cg) = pack8(v0, v1); }
                    else { const frag8 hv = pack8(v0, v1); *(frag8*)(qkvu + (size_t)row * NQKVU + c0) = hv;
                        if (colt == 512 && bj == 1) {
                            f16* vp = vT + ((size_t)((row >> 11) * 2 + (wc >> 1)) * 64 + (wc & 1) * 32 + 8 * fq) * SEQ + (row & (SEQ - 1));
#pragma unroll
                            for (int i = 0; i < 8; ++i) vp[(size_t)i * SEQ] = hv[i];
                            if (PROBE_DUP == 21) { asm volatile("s_waitcnt vmcnt(0)" ::: "memory");
#pragma unroll
                                for (int i = 0; i < 8; ++i) { f16* q2 = vp + (size_t)i * SEQ; asm volatile("global_store_short %0, %1, off" :: "v"(q2), "v"(hv[i]) : "memory"); } } } } } }
    }
};
struct EpiMerged {
    static constexpr bool PERM = true, AFTER_DRAIN = false, MIDK = true;
    const f16* gates; f16* merged;
    __device__ __forceinline__ void mid(f32x4 (&acc)[2][2][4][2], const Unit& u, int wr, int wc, int fr, int fq) const {
        const int row0 = u.pm * BM + wr * 64 + fr, colt = u.pn * BM;
        const f16* gb = gates + (size_t)row0 * NGATE + colt + wc * 32 + 8 * fq;
        asm volatile("" : "+v"(gb));
#pragma unroll
        for (int ai = 0; ai < 2; ++ai) {
            frag8 g0[4][2], g1[4][2];
#pragma unroll
            for (int m = 0; m < 4; ++m)
#pragma unroll
                for (int bj = 0; bj < 2; ++bj) { const f16* gp = gb + (size_t)(ai * HALF + m * 16) * NGATE + bj * HALF; g0[m][bj] = *(const frag8*)gp; g1[m][bj] = *(const frag8*)(gp + DM); }
#pragma unroll
            for (int m = 0; m < 4; ++m)
#pragma unroll
                for (int bj = 0; bj < 2; ++bj)
#pragma unroll
                    for (int i = 0; i < 4; ++i) {
                        acc[ai][bj][m][0][i] *= (float)g0[m][bj][i] * __builtin_amdgcn_rcpf(fmaxf((float)g1[m][bj][i], 1e-4f));
                        acc[ai][bj][m][1][i] *= (float)g0[m][bj][4 + i] * __builtin_amdgcn_rcpf(fmaxf((float)g1[m][bj][4 + i], 1e-4f)); }
            asm volatile("" ::: "memory");
        }
    }
    __device__ __forceinline__ void operator()(const f32x4 (&acc)[2][2][4][2], const Unit& u, int wr, int wc, int fr, int fq) const {
        const int row0 = u.pm * BM + wr * 64 + fr, colt = u.pn * BM;
#pragma unroll
        for (int ai = 0; ai < 2; ++ai)
#pragma unroll
            for (int m = 0; m < 4; ++m) { const int row = row0 + ai * HALF + m * 16;
#pragma unroll
                for (int bj = 0; bj < 2; ++bj) { const int c0 = colt + bj * HALF + wc * 32 + 8 * fq;
                    const frag8 g1 = *(const frag8*)(gates + (size_t)row * NGATE + DM + c0); f32x4 v0, v1;
#pragma unroll
                    for (int i = 0; i < 4; ++i) { v0[i] = acc[ai][bj][m][0][i] * fmaxf((float)g1[i], 1e-4f); v1[i] = acc[ai][bj][m][1][i] * fmaxf((float)g1[4 + i], 1e-4f); }
                    *(frag8*)(merged + (size_t)row * DM + c0) = pack8(v0, v1); } }
    }
};
struct EpiOut {
    static constexpr bool PERM = false, AFTER_DRAIN = false, MIDK = false;
    const float* x; const float* g2; float* x1; f16* x1h; float* ss2p;
    __device__ __forceinline__ void operator()(const f32x4 (&acc)[2][2][4][2], const Unit& u, int wr, int wc, int fr, int fq) const {
        const int row0 = u.pm * BM + wr * 64 + fr, col0 = u.pn * BM + wc * 32 + 4 * fq;
        f32x4 gv[2][2];
#pragma unroll
        for (int bj = 0; bj < 2; ++bj)
#pragma unroll
            for (int n = 0; n < 2; ++n) gv[bj][n] = *(const f32x4*)(g2 + col0 + bj * HALF + n * 16);
#pragma unroll
        for (int ai = 0; ai < 2; ++ai)
#pragma unroll
            for (int m = 0; m < 4; ++m) { const int row = row0 + ai * HALF + m * 16; const size_t off = (size_t)row * DM + col0; float ssq = 0.f;
#pragma unroll
                for (int bj = 0; bj < 2; ++bj)
#pragma unroll
                    for (int n = 0; n < 2; ++n) { const f32x4 y = *(const f32x4*)(x + off + bj * HALF + n * 16) + acc[ai][bj][m][n];
                        *(f32x4*)(x1 + off + bj * HALF + n * 16) = y; ssq += (y[0] * y[0] + y[1] * y[1]) + (y[2] * y[2] + y[3] * y[3]);
                        const f32x4 yg = y * gv[bj][n]; half4 h; h[0] = (f16)yg[0]; h[1] = (f16)yg[1]; h[2] = (f16)yg[2]; h[3] = (f16)yg[3];
                        *(half4*)(x1h + off + bj * HALF + n * 16) = h; }
                ssq += __shfl_xor(ssq, 16); ssq += __shfl_xor(ssq, 32);
                if (fq == 0) ss2p[(size_t)(u.pn * 4 + wc) * T + row] = ssq; }
    }
};
struct EpiQ {
    static constexpr bool PERM = true, AFTER_DRAIN = false, MIDK = false;
    f16* qp;
    __device__ __forceinline__ void operator()(const f32x4 (&acc)[2][2][4][2], const Unit& u, int wr, int wc, int fr, int fq) const {
        const int row0 = u.pm * BM + wr * 64 + fr, colt = u.pn * BM;
#pragma unroll
        for (int ai = 0; ai < 2; ++ai)
#pragma unroll
            for (int m = 0; m < 4; ++m) { const int row = row0 + ai * HALF + m * 16;
#pragma unroll
                for (int bj = 0; bj < 2; ++bj) { const int c0 = colt + bj * HALF + wc * 32 + 8 * fq;
                    *(frag8*)(qp + (size_t)row * 2048 + c0) = pack8(acc[ai][bj][m][0], acc[ai][bj][m][1]); } }
    }
};

template <class Epi, class Sched, bool ALIGN_EPI = false, bool SP2 = false>
__device__ __forceinline__ void gemm_phase(PG8_LAS unsigned char* lds, const Gemm g, const Sched& S, const Epi& E) {
    const int tid = threadIdx.x, wid = __builtin_amdgcn_readfirstlane(tid >> 6), lane = tid & 63, wr = wid >> 2, wc = wid & 3, fr = lane & 15, fq = lane >> 4;
    const int K = g.K, nt = K / BK;
    unsigned voffA[2], voffB[2];
#pragma unroll
    for (int i = 0; i < 2; ++i) { int R, C; stage_rc(tid * 16 + i * 8192, R, C); const int Rb = Epi::PERM ? ((R & ~31) + perm32(R & 31)) : R;
        voffA[i] = (unsigned)(R * K + C) * 2u; voffB[i] = (unsigned)(Rb * K + C) * 2u; }
    const size_t kstep = (size_t)(BK * 2);
    const size_t hstep = (size_t)HALF * K * 2;
    const size_t tstep = 2 * hstep;
    const unsigned ldsw = (unsigned)wid * 1024u;
    const int aoff = lds_byte(wr * 64 + fr, fq * 8), boff = lds_byte(wc * 32 + fr, fq * 8);
#define PG8_SA(b, h) (((b) * 2 + (h)) * HTB)
#define PG8_SB(b, h) ((4 + (b) * 2 + (h)) * HTB)
#define PG8_STAGE(bufoff, gbase, voff) do { _Pragma("unroll") for (int _i = 0; _i < 2; ++_i) \
        __builtin_amdgcn_global_load_lds((const unsigned*)((const char*)(gbase) + (voff)[_i]), (PG8_LAS unsigned*)(lds + (bufoff) + ldsw + _i * 8192), 16, 0, 0); } while (0)
#define PG8_LDA(dst, b, h) do { _Pragma("unroll") for (int m = 0; m < 4; ++m) _Pragma("unroll") for (int k = 0; k < 2; ++k) dst[m][k] = *(const PG8_LAS frag8*)(lds + PG8_SA(b, h) + aoff + m * 2048 + k * 1024); } while (0)
#define PG8_LDB(dst, b, h) do { _Pragma("unroll") for (int n = 0; n < 2; ++n) _Pragma("unroll") for (int k = 0; k < 2; ++k) dst[n][k] = *(const PG8_LAS frag8*)(lds + PG8_SB(b, h) + boff + n * 2048 + k * 1024); } while (0)
#define PG8_MMA(ai, bj, At, Bt) do { __builtin_amdgcn_s_setprio(1); _Pragma("unroll") for (int m = 0; m < 4; ++m) _Pragma("unroll") for (int n = 0; n < 2; ++n) _Pragma("unroll") for (int k = 0; k < 2; ++k) \
        acc[ai][bj][m][n] = __builtin_amdgcn_mfma_f32_16x16x32_f16(Bt[n][k], At[m][k], acc[ai][bj][m][n], 0, 0, 0); __builtin_amdgcn_s_setprio(0); } while (0)
#define PG8_WAIT_V(n) asm volatile("s_waitcnt vmcnt(" #n ")" ::: "memory")
#define PG8_WAIT_L(n) asm volatile("s_waitcnt lgkmcnt(" #n ")" ::: "memory")
#define PG8_BAR __builtin_amdgcn_s_barrier()
#define PG8_SCHED __builtin_amdgcn_sched_barrier(0)
    Unit cur, nxt; int ui = 0;
    if (!S.next(0, cur)) return;
    f32x4 acc[2][2][4][2];
#pragma unroll
    for (int a = 0; a < 2; ++a)
#pragma unroll
        for (int b = 0; b < 2; ++b)
#pragma unroll
            for (int m = 0; m < 4; ++m)
#pragma unroll
                for (int n = 0; n < 2; ++n) acc[a][b][m][n] = (f32x4){0.f, 0.f, 0.f, 0.f};
    frag8 At[4][2], B0[2][2], B1[2][2];
    const char* cA = (const char*)g.A + (size_t)cur.pm * tstep; const char* cB = (const char*)g.Bt + (size_t)cur.pn * tstep;
    S.a_ready(cur);
    if constexpr (SP2) {
        PG8_STAGE(PG8_SB(0, 0), cB, voffB); PG8_STAGE(PG8_SB(0, 1), cB + hstep, voffB); PG8_STAGE(PG8_SA(0, 0), cA, voffA); PG8_STAGE(PG8_SA(0, 1), cA + hstep, voffA);
        if (wr == 1) PG8_BAR;
        PG8_WAIT_V(2); PG8_BAR;
        PG8_STAGE(PG8_SB(1, 0), cB + kstep, voffB); PG8_STAGE(PG8_SA(1, 0), cA + kstep, voffA); PG8_STAGE(PG8_SB(1, 1), cB + hstep + kstep, voffB);
        PG8_WAIT_V(6); PG8_BAR;
    } else {
        PG8_STAGE(PG8_SB(0, 0), cB, voffB); PG8_STAGE(PG8_SA(0, 0), cA, voffA); PG8_STAGE(PG8_SB(0, 1), cB + hstep, voffB); PG8_STAGE(PG8_SA(0, 1), cA + hstep, voffA);
        if (wr == 1) PG8_BAR;
        PG8_WAIT_V(4); PG8_BAR;
        PG8_STAGE(PG8_SB(1, 0), cB + kstep, voffB); PG8_STAGE(PG8_SA(1, 0), cA + kstep, voffA); PG8_STAGE(PG8_SB(1, 1), cB + hstep + kstep, voffB);
        PG8_WAIT_V(6); PG8_BAR;
    }
    for (;;) {
        const bool has_next = S.next(ui + 1, nxt);
        const char* nA = has_next ? (const char*)g.A + (size_t)nxt.pm * tstep : cA; const char* nB = has_next ? (const char*)g.Bt + (size_t)nxt.pn * tstep : cB;
        for (int t = 0; t < nt; t += 2) {
            const bool last = (t == nt - 2);
            if constexpr (Epi::MIDK) { if (t == (nt >> 1)) E.mid(acc, cur, wr, wc, fr, fq); }
            const char* a1 = cA + (size_t)(t + 1) * kstep;
            const char* a2 = last ? nA : cA + (size_t)(t + 2) * kstep; const char* b2 = last ? nB : cB + (size_t)(t + 2) * kstep;
            const char* a3 = a2 + kstep; const char* b3 = b2 + kstep;
            if (last && has_next) S.a_ready(nxt);
            if constexpr (SP2) {
            PG8_LDB(B0, 0, 0); PG8_LDB(B1, 0, 1); PG8_SCHED; PG8_LDA(At, 0, 0); PG8_STAGE(PG8_SA(1, 1), a1 + hstep, voffA);
            PG8_WAIT_V(8); PG8_WAIT_L(0); PG8_BAR; PG8_MMA(0, 0, At, B0); PG8_MMA(0, 1, At, B1); PG8_BAR; PG8_SCHED;
            PG8_LDA(At, 0, 1); PG8_STAGE(PG8_SB(0, 0), b2, voffB); PG8_STAGE(PG8_SB(0, 1), b2 + hstep, voffB); PG8_STAGE(PG8_SA(0, 0), a2, voffA);
            PG8_WAIT_V(8); PG8_WAIT_L(0); PG8_BAR; PG8_MMA(1, 0, At, B0); PG8_MMA(1, 1, At, B1); PG8_BAR; PG8_SCHED;
            PG8_LDB(B0, 1, 0); PG8_LDB(B1, 1, 1); PG8_SCHED; PG8_LDA(At, 1, 0); PG8_STAGE(PG8_SA(0, 1), a2 + hstep, voffA);
            PG8_WAIT_V(8); PG8_WAIT_L(0); PG8_BAR; PG8_MMA(0, 0, At, B0); PG8_MMA(0, 1, At, B1); PG8_BAR; PG8_SCHED;
            PG8_LDA(At, 1, 1); PG8_STAGE(PG8_SB(1, 0), b3, voffB); PG8_STAGE(PG8_SB(1, 1), b3 + hstep, voffB); PG8_STAGE(PG8_SA(1, 0), a3, voffA);
            PG8_WAIT_V(8); PG8_WAIT_L(0); PG8_BAR; PG8_MMA(1, 0, At, B0); PG8_MMA(1, 1, At, B1); PG8_BAR; PG8_SCHED;
            } else {
            PG8_LDB(B0, 0, 0); PG8_SCHED; PG8_LDA(At, 0, 0); PG8_STAGE(PG8_SA(1, 1), a1 + hstep, voffA);
            PG8_WAIT_L(8); PG8_BAR; PG8_WAIT_L(0); PG8_MMA(0, 0, At, B0); PG8_BAR; PG8_SCHED;
            PG8_LDB(B1, 0, 1); PG8_STAGE(PG8_SB(0, 0), b2, voffB);
            PG8_BAR; PG8_WAIT_L(0); PG8_MMA(0, 1, At, B1); PG8_BAR;
            PG8_LDA(At, 0, 1); PG8_STAGE(PG8_SA(0, 0), a2, voffA);
            PG8_BAR; PG8_WAIT_L(0); PG8_MMA(1, 0, At, B0); PG8_BAR; PG8_SCHED;
            PG8_STAGE(PG8_SB(0, 1), b2 + hstep, voffB);
            PG8_WAIT_V(6); PG8_BAR; PG8_MMA(1, 1, At, B1); PG8_BAR;
            PG8_LDB(B0, 1, 0); PG8_SCHED; PG8_LDA(At, 1, 0); PG8_STAGE(PG8_SA(0, 1), a2 + hstep, voffA);
            PG8_WAIT_L(8); PG8_BAR; PG8_WAIT_L(0); PG8_MMA(0, 0, At, B0); PG8_BAR; PG8_SCHED;
            PG8_LDB(B1, 1, 1); PG8_STAGE(PG8_SB(1, 0), b3, voffB);
            PG8_BAR; PG8_WAIT_L(0); PG8_MMA(0, 1, At, B1); PG8_BAR;
            PG8_LDA(At, 1, 1); PG8_STAGE(PG8_SA(1, 0), a3, voffA);
            PG8_BAR; PG8_WAIT_L(0); PG8_MMA(1, 0, At, B0); PG8_BAR; PG8_SCHED;
            PG8_STAGE(PG8_SB(1, 1), b3 + hstep, voffB);
            PG8_WAIT_V(6); PG8_BAR; PG8_MMA(1, 1, At, B1); PG8_BAR;
            }
        }
        if constexpr (ALIGN_EPI) { if (wr == 0) PG8_BAR; }
        if constexpr (!Epi::AFTER_DRAIN) { E(acc, cur, wr, wc, fr, fq); S.done(cur); }
        if (!has_next) break;
#pragma unroll
        for (int a = 0; a < 2; ++a)
#pragma unroll
            for (int b = 0; b < 2; ++b)
#pragma unroll
                for (int m = 0; m < 4; ++m)
#pragma unroll
                    for (int n = 0; n < 2; ++n) acc[a][b][m][n] = (f32x4){0.f, 0.f, 0.f, 0.f};
        cur = nxt; cA = nA; cB = nB; ++ui;
        if constexpr (ALIGN_EPI) { if (wr == 1) PG8_BAR; }
    }
    PG8_WAIT_V(0);
    if constexpr (!ALIGN_EPI) { if (wr == 0) PG8_BAR; }
    PG8_BAR;
    if constexpr (Epi::AFTER_DRAIN) { E.fused(acc, cur, wr, wc, fr, fq, lds, wid, lane); S.done(cur); }
#undef PG8_SA
#undef PG8_SB
#undef PG8_STAGE
#undef PG8_LDA
#undef PG8_LDB
#undef PG8_MMA
#undef PG8_WAIT_V
#undef PG8_WAIT_L
#undef PG8_BAR
#undef PG8_SCHED
}
}

#define XB_TMO      128
#define XB_XCNT(j)  (256  + 64 * (j))
#define XB_XSUB(j)  (1280 + 64 * (j))
#define XB_XGEN(j)  (2304 + 64 * (j))
#define XB_TOP      3328
#define XB_TOPGEN   3392
#define XCD_BAR_WORDS 3456
#define XB_SPIN_CAP (1u << 18)

__device__ __forceinline__ unsigned xb_ld(unsigned* p)              { return __hip_atomic_load(p, __ATOMIC_RELAXED, __HIP_MEMORY_SCOPE_AGENT); }
__device__ __forceinline__ unsigned xb_add(unsigned* p, unsigned v) { return __hip_atomic_fetch_add(p, v, __ATOMIC_RELAXED, __HIP_MEMORY_SCOPE_AGENT); }
__device__ __forceinline__ unsigned xb_xcc_id() { return (unsigned)__builtin_amdgcn_s_getreg((3 << 11) | 20) & 0xFu; }
#define XB_SPIN(cond, bar) do { unsigned _sp = 0; while (cond) { __builtin_amdgcn_s_sleep(1); \
    if ((++_sp & 255u) == 0u) { if (xb_ld(&(bar)[XB_TMO])) break; if (_sp > XB_SPIN_CAP) { atomicAdd(&(bar)[XB_TMO], 1u); break; } } } } while (0)

struct XcdBarrier {
    unsigned* bar; unsigned x;
    volatile LAS unsigned* st;
};

__device__ __forceinline__ XcdBarrier xcd_barrier_post(unsigned* bar, volatile LAS unsigned* st) {
    XcdBarrier b; b.bar = bar; b.x = xb_xcc_id(); b.st = st;
    if (threadIdx.x == 0) st[2] = xb_add(&bar[XB_XCNT(b.x)], 1u);
    return b;
}
__device__ __forceinline__ void xcd_barrier_complete(unsigned* bar, unsigned x, unsigned& nloc, unsigned& nx) {
    const unsigned G = gridDim.x * gridDim.y * gridDim.z;
    unsigned sum, cnt, mine, sp = 0u;
    for (;;) {
        sum = 0u; cnt = 0u; mine = 0u;
#pragma unroll
        for (unsigned j = 0; j < 16; ++j) { const unsigned c = xb_ld(&bar[XB_XCNT(j)]); sum += c; cnt += (c > 0u) ? 1u : 0u; mine = (j == x) ? c : mine; }
        if (sum == G) break;
        __builtin_amdgcn_s_sleep(1);
        if ((++sp & 255u) == 0u) { if (xb_ld(&bar[XB_TMO])) break; if (sp > XB_SPIN_CAP) { atomicAdd(&bar[XB_TMO], 1u); break; } }
    }
    nloc = mine > 0u ? mine : 1u; nx = cnt > 0u ? cnt : 1u;
}

__device__ __forceinline__ void xcd_barrier(const XcdBarrier& b) {
    asm volatile("s_waitcnt vmcnt(0)" ::: "memory");
    __syncthreads();
    if (threadIdx.x == 0) {
        unsigned* bar = b.bar;
        __builtin_amdgcn_s_waitcnt(0);
        unsigned nloc = b.st[0], nx = b.st[1];
        if (nloc == 0u) { xcd_barrier_complete(bar, b.x, nloc, nx); b.st[0] = nloc; b.st[1] = nx; }
        const unsigned old = xb_add(&bar[XB_XSUB(b.x)], 1u);
        const unsigned gen = old / nloc;
        if (old + 1u == (gen + 1u) * nloc) {
            __builtin_amdgcn_fence(__ATOMIC_RELEASE, "agent");
            asm volatile("s_waitcnt vmcnt(0)" ::: "memory");
            const unsigned og = xb_add(&bar[XB_TOP], 1u);
            const unsigned tg = og / nx;
            if (og + 1u == (tg + 1u) * nx) xb_add(&bar[XB_TOPGEN], 1u);
            else XB_SPIN(xb_ld(&bar[XB_TOPGEN]) == tg, bar);
            __builtin_amdgcn_fence(__ATOMIC_ACQUIRE, "agent");
            xb_add(&bar[XB_XGEN(b.x)], 1u);
            asm volatile("s_waitcnt vmcnt(0)" ::: "memory");
        } else {
            XB_SPIN(xb_ld(&bar[XB_XGEN(b.x)]) == gen, bar);
            __builtin_amdgcn_fence(__ATOMIC_ACQUIRE, "agent");
            asm volatile("s_waitcnt vmcnt(0)" ::: "memory");
        }
    }
    __syncthreads();
}


struct Args { const float* in[16]; float* out; unsigned char* ws; int ph_lo, ph_hi; };
constexpr int N_PHASES = 11;

__global__ void __launch_bounds__(NTHREADS, 2) mk_fwd(Args a) {
    extern __shared__ __attribute__((aligned(16))) unsigned char lds[];
    LAS unsigned char* L = (LAS unsigned char*)lds;
    volatile LAS unsigned* MISC = (volatile LAS unsigned*)(L + MISC_OFF);
    unsigned char* ws = a.ws;
    Ctx C;
    C.tid = threadIdx.x; C.lane = C.tid & 63; C.wave = __builtin_amdgcn_readfirstlane(C.tid >> 6);
    C.G = gridDim.x; C.gw = blockIdx.x * NWAVES + C.wave; C.ngw = C.G * NWAVES; C.gt = blockIdx.x * NTHREADS + C.tid; C.ngt = C.G * NTHREADS;
    for (int u = C.tid; u < (LDS_BYTES - LDSCTL_OFF) / 4; u += NTHREADS) ((LAS unsigned*)(L + LDSCTL_OFF))[u] = 0u;
    __syncthreads();
    const int lo = a.ph_lo, hi = a.ph_hi, G = C.G;
    const bool multi = (hi - lo) > 1;
    XcdBarrier bar; bar.bar = (unsigned*)(ws + WS_CTL) + CW_BAR; bar.x = 0; bar.st = nullptr;
    if (multi) bar = xcd_barrier_post((unsigned*)(ws + WS_CTL) + CW_BAR, MISC + 8);
#define IN(k) (lo <= (k) && (k) < hi)
#define SEAM(k) do { if (IN(k) && IN((k) + 1)) xcd_barrier(bar); } while (0)

#define REPS(k) for (int rep_ = 0; rep_ < ((PROBE_DUP == (k)) ? 2 : 1); ++rep_)
#define REPBAR(k) do { if (PROBE_DUP == (k) && rep_ == 0) xcd_barrier(bar); } while (0)
    if (IN(0)) REPS(0) { ph_prep(C, L, a.in, ws); REPBAR(0); }
    SEAM(0);
    if (IN(1)) REPS(1) {
        pg8::Gemm g{(const f16*)(ws + WS_XH), (const f16*)(ws + WS_WCAT), T, NCAT, DM}; pg8::StaticOrder S; S.init(T, NCAT, G, (int)blockIdx.x);
        pg8::EpiP1 E{(const float*)(ws + WS_RS1), a.in[8], (f16*)(ws + WS_QKVU), (f16*)(ws + WS_GATES), (f16*)(ws + WS_VT)};
        pg8::gemm_phase<pg8::EpiP1, pg8::StaticOrder, true, true>(L, g, S, E);
        REPBAR(1);
    }
    SEAM(1);
    if (IN(2)) REPS(2) {
        if (PROBE_DUP == 2 && rep_ == 0) ph_attn<PROBE_DIAG>(C, (const f16*)(ws + WS_QKVU), (const f16*)(ws + WS_VT), a.in[3], (f16*)(ws + WS_OCAT));
        else ph_attn<0>(C, (const f16*)(ws + WS_QKVU), (const f16*)(ws + WS_VT), a.in[3], (f16*)(ws + WS_OCAT));
        REPBAR(2);
    }
    if (IN(2)) REPS(3) {
        ph_pool(C, L, (const f16*)(ws + WS_QKVU), (const f16*)(ws + WS_POOLW), a.in[5], (f16*)(ws + WS_OCAT));
        REPBAR(3);
    }
    if (IN(2) && IN(4)) xcd_barrier(bar);
    if (IN(4)) REPS(4) {
        pg8::Gemm g{(const f16*)(ws + WS_OCAT), (const f16*)(ws + WS_WB), T, DM, DM}; pg8::StaticOrder S; S.init(T, DM, G, (int)blockIdx.x);
        pg8::EpiMerged E{(const f16*)(ws + WS_GATES), (f16*)(ws + WS_MERGED)};
        pg8::gemm_phase<pg8::EpiMerged, pg8::StaticOrder, true, true>(L, g, S, E);
        REPBAR(4);
    }
    SEAM(4);
    if (IN(5)) REPS(5) {
        pg8::Gemm g{(const f16*)(ws + WS_MERGED), (const f16*)(ws + WS_WOUT), T, DM, DM}; pg8::StaticOrder S; S.init(T, DM, G, (int)blockIdx.x);
        pg8::EpiOut E{a.in[0], a.in[10], a.out, (f16*)(ws + WS_X1H), (float*)(ws + WS_SS2)};
        pg8::gemm_phase<pg8::EpiOut, pg8::StaticOrder, true, true>(L, g, S, E);
        REPBAR(5);
    }
    SEAM(5);
    if (IN(6)) REPS(6) {
        pg8::Gemm g{(const f16*)(ws + WS_X1H), (const f16*)(ws + WS_WQ), T, 2048, DM}; pg8::StaticOrder S; S.init(T, 2048, G, (int)blockIdx.x);
        pg8::EpiQ E{(f16*)(ws + WS_QP)};
        pg8::gemm_phase<pg8::EpiQ, pg8::StaticOrder, true, true>(L, g, S, E);
        REPBAR(6);
    }
    SEAM(6);
    if (IN(7)) REPS(7) { ph_route(C, L, (const f16*)(ws + WS_QP), (const float*)(ws + WS_SS2), (const f16*)(ws + WS_SUBK), (int*)(ws + WS_EIDX), (float*)(ws + WS_EGATE));
        ph_h2quant(C, (const f16*)(ws + WS_X1H), (const float*)(ws + WS_SS2), (unsigned*)(ws + WS_H2Q), (float*)(ws + WS_HSC)); REPBAR(7); }
    SEAM(7);
    if (IN(8)) REPS(8) {
        const Slicing SL = get_slicing((const unsigned*)(ws + WS_CTL) + CW_BAR, MISC);
        if (PROBE_DUP == 8 && rep_ == 0) ph_upeer<255>(C, L, SL, (const unsigned*)(ws + WS_H2Q), (const int*)(ws + WS_EIDX), (const unsigned char*)(ws + WS_UQ), (int*)(ws + WS_PDOT));
        else ph_upeer<16383>(C, L, SL, (const unsigned*)(ws + WS_H2Q), (const int*)(ws + WS_EIDX), (const unsigned char*)(ws + WS_UQ), (int*)(ws + WS_PDOT));
        REPBAR(8);
    }
    SEAM(8);
    if (IN(9)) {
        ph_ureduce(C, L, (const int*)(ws + WS_PDOT), (const float*)(ws + WS_HSC), (const int*)(ws + WS_EIDX), (const float*)(ws + WS_US), (const float*)(ws + WS_VS), (const float*)(ws + WS_EGATE),
                   (unsigned*)(ws + WS_WQP), (float*)(ws + WS_WSC));
        xcd_barrier(bar);
        const Slicing SL = get_slicing((const unsigned*)(ws + WS_CTL) + CW_BAR, MISC);
        if (PROBE_DUP == 9) {
            ph_vpeer<255>(C, SL, (const int*)(ws + WS_EIDX), (const unsigned*)(ws + WS_WQP), (const float*)(ws + WS_WSC), (const unsigned char*)(ws + WS_VQ), a.out, (float*)(ws + WS_QP), (float*)(ws + WS_MERGED));
            xcd_barrier(bar);
        }
        if (PROBE_DUP == 19) {
            ph_vpeer<16383>(C, SL, (const int*)(ws + WS_EIDX), (const unsigned*)(ws + WS_WQP), (const float*)(ws + WS_WSC), (const unsigned char*)(ws + WS_VQ), a.out, (float*)(ws + WS_QP), (float*)(ws + WS_MERGED));
            xcd_barrier(bar);
        }
        ph_vpeer<16383>(C, SL, (const int*)(ws + WS_EIDX), (const unsigned*)(ws + WS_WQP), (const float*)(ws + WS_WSC), (const unsigned char*)(ws + WS_VQ), a.out, a.out, (float*)(ws + WS_SSF));
    }
    SEAM(9);
    if (IN(10)) { ph_final(C, (const float*)(ws + WS_SSF), a.out, a.in[15]); }
#undef IN
#undef SEAM
}

#ifndef MK_N_LAUNCHES
#define MK_N_LAUNCHES 1
#endif
extern "C" void kernel_launch(void* const* d_in, const int* in_sizes, int n_in, void* d_out, int out_size, void* d_ws, size_t ws_size, hipStream_t stream) {
    static int grid = 0;
    if (grid == 0) {
        if (n_in != 16 || in_sizes[0] != T * DM || out_size != T * DM || ws_size < WS_END) {
            fprintf(stderr, "kernel_launch: unexpected shapes (n_in %d in0 %d out %d ws %zu)\n", n_in, n_in > 0 ? in_sizes[0] : -1, out_size, ws_size);
            grid = -1; return;
        }
        int dev = 0, cus = 0;
        if (hipGetDevice(&dev) != hipSuccess || hipDeviceGetAttribute(&cus, hipDeviceAttributeMultiprocessorCount, dev) != hipSuccess) { grid = -1; return; }
        if (hipFuncSetAttribute((const void*)mk_fwd, hipFuncAttributeMaxDynamicSharedMemorySize, LDS_BYTES) != hipSuccess) { fprintf(stderr, "kernel_launch: hipFuncSetAttribute failed\n"); grid = -1; return; }
        int per_cu = 0;
        if (hipOccupancyMaxActiveBlocksPerMultiprocessor(&per_cu, (const void*)mk_fwd, NTHREADS, LDS_BYTES) != hipSuccess || per_cu < 1)
            fprintf(stderr, "kernel_launch: occupancy query reports %d workgroups per CU\n", per_cu);
        (void)hipGetLastError();
        grid = cus;
    }
    if (grid < 0) return;
    (void)hipMemsetAsync((char*)d_ws + WS_CTL, 0, CTL_ZERO_BYTES, stream);
    Args a{};
    for (int i = 0; i < 16; ++i) a.in[i] = (const float*)d_in[i];
    a.out = (float*)d_out; a.ws = (unsigned char*)d_ws;
    if (MK_N_LAUNCHES == 1) {
        a.ph_lo = 0; a.ph_hi = N_PHASES;
        hipLaunchKernelGGL(mk_fwd, dim3(grid), dim3(NTHREADS), LDS_BYTES, stream, a);
    } else {
        for (int p = 0; p < N_PHASES; ++p) { a.ph_lo = p; a.ph_hi = p + 1; hipLaunchKernelGGL(mk_fwd, dim3(grid), dim3(NTHREADS), LDS_BYTES, stream, a); }
    }
}
```

```cpp
#include <hip/hip_runtime.h>
#include <cstdint>
#include <cstdio>

typedef _Float16 f16;
typedef _Float16 half8 __attribute__((ext_vector_type(8)));
typedef _Float16 half4 __attribute__((ext_vector_type(4)));
typedef _Float16 half2 __attribute__((ext_vector_type(2)));
typedef float f32x4 __attribute__((ext_vector_type(4)));
typedef float f32x16 __attribute__((ext_vector_type(16)));
#define LAS __attribute__((address_space(3)))
#ifndef PROBE_DIAG
#define PROBE_DIAG (0)
#endif
#ifndef PROBE_DUP
#define PROBE_DUP (-1)
#endif
#define GAS __attribute__((address_space(1)))

constexpr int DM = 1024, BATCH = 16, SEQ = 2048, T = BATCH * SEQ;
constexpr int NQKVU = 1280, NGATE = 2048, NCAT = NQKVU + NGATE;
constexpr int COL_K = 512, COL_V = 640, COL_U = 768;
constexpr int NEXP = 16384, PEER_H = 8, TOPK = 16;
constexpr float EPS = 1e-6f;
constexpr int NWAVES = 8, NTHREADS = NWAVES * 64;

constexpr size_t MiB = 1u << 20;
constexpr size_t WS_CTL = 0, CTL_ZERO_BYTES = 64 * 1024;
constexpr size_t WS_WCAT = 1 * MiB;
constexpr size_t WS_WB = 8 * MiB;
constexpr size_t WS_WOUT = 10 * MiB;
constexpr size_t WS_WQ = 12 * MiB;
constexpr size_t WS_POOLW = 16 * MiB;
constexpr size_t WS_SUBK = 16 * MiB + 512 * 1024;
constexpr size_t WS_RS1 = 17 * MiB;
constexpr size_t WS_EIDX = 18 * MiB;
constexpr size_t WS_EGATE = 34 * MiB;
constexpr size_t WS_UTAB = 50 * MiB;
constexpr size_t WS_VTAB = 82 * MiB;
constexpr size_t WS_XH = 114 * MiB;
constexpr size_t WS_MERGED = WS_XH;
constexpr size_t WS_QKVU = 178 * MiB;
constexpr size_t WS_X1H = WS_QKVU;
constexpr size_t WS_GATES = 258 * MiB;
constexpr size_t WS_QP = WS_GATES;
constexpr size_t WS_OCAT = 386 * MiB;
constexpr size_t WS_UQ = 450 * MiB;
constexpr size_t WS_VQ = 466 * MiB;
constexpr size_t WS_US = 17 * MiB + 256 * 1024, WS_VS = 17 * MiB + 512 * 1024;
constexpr size_t WS_PDOT = WS_GATES;
constexpr size_t WS_H2Q = 404 * MiB;
constexpr size_t WS_HSC = 403 * MiB;
constexpr size_t WS_SSF = 402 * MiB;
constexpr size_t WS_WQP = 386 * MiB;
constexpr size_t WS_WSC = 390 * MiB;
constexpr size_t WS_ACT = 386 * MiB;
constexpr size_t WS_SS2 = 482 * MiB;
constexpr size_t WS_VT = 484 * MiB;
constexpr size_t WS_END = 492 * MiB;
constexpr int CW_BAR = 4096;

constexpr int RING_OFF = 0, RING_BYTES = 131072;
constexpr int LDSCTL_OFF = RING_BYTES, MISC_OFF = LDSCTL_OFF + 320;
constexpr int LDS_BYTES = 147456;

#define LDS_WAIT() asm volatile("s_waitcnt lgkmcnt(0)" ::: "memory")
template <int CTRL> __device__ __forceinline__ float dppf(float x) { return __uint_as_float(__builtin_amdgcn_update_dpp(0u, __float_as_uint(x), CTRL, 0xf, 0xf, false)); }
template <int CTRL> __device__ __forceinline__ int dppi(int x) { return (int)__builtin_amdgcn_update_dpp(0u, (unsigned)x, CTRL, 0xf, 0xf, false); }
__device__ __forceinline__ float bfly32(float a, float b) { auto r = __builtin_amdgcn_permlane32_swap(__float_as_uint(a), __float_as_uint(b), false, false); return __uint_as_float(r[0]) + __uint_as_float(r[1]); }
__device__ __forceinline__ float bfly16(float a, float b) { auto r = __builtin_amdgcn_permlane16_swap(__float_as_uint(a), __float_as_uint(b), false, false); return __uint_as_float(r[0]) + __uint_as_float(r[1]); }
__device__ __forceinline__ int bfly32i(int a, int b) { auto r = __builtin_amdgcn_permlane32_swap((unsigned)a, (unsigned)b, false, false); return (int)(r[0] + r[1]); }
__device__ __forceinline__ int bfly16i(int a, int b) { auto r = __builtin_amdgcn_permlane16_swap((unsigned)a, (unsigned)b, false, false); return (int)(r[0] + r[1]); }
__device__ __forceinline__ float wave_sum(float x) {
    x += dppf<0x121>(x); x += dppf<0x122>(x); x += dppf<0x124>(x); x += dppf<0x128>(x);
    x = bfly16(x, x); return bfly32(x, x);
}
__device__ __forceinline__ int wave_sum_i(int x) {
    x += dppi<0x121>(x); x += dppi<0x122>(x); x += dppi<0x124>(x); x += dppi<0x128>(x);
    x = bfly16i(x, x); return bfly32i(x, x);
}
__device__ __forceinline__ float wave_max(float x) {
    x = fmaxf(x, dppf<0x121>(x)); x = fmaxf(x, dppf<0x122>(x)); x = fmaxf(x, dppf<0x124>(x)); x = fmaxf(x, dppf<0x128>(x));
    { auto r = __builtin_amdgcn_permlane16_swap(__float_as_uint(x), __float_as_uint(x), false, false); x = fmaxf(__uint_as_float(r[0]), __uint_as_float(r[1])); }
    { auto r = __builtin_amdgcn_permlane32_swap(__float_as_uint(x), __float_as_uint(x), false, false); x = fmaxf(__uint_as_float(r[0]), __uint_as_float(r[1])); }
    return x;
}
__device__ __forceinline__ float gelu_exact(float x) { return 0.5f * x * (1.0f + erff(x * 0.70710678118654752f)); }
__device__ __forceinline__ float rs_from_ss(const float* ss, int t) {
    float s = 0.f;
#pragma unroll
    for (int i = 0; i < 16; ++i) s += ss[(size_t)i * T + t];
    return rsqrtf(s * (1.0f / DM) + EPS);
}

struct Ctx {
    int tid, lane, wave;
    int G;
    int gw, ngw;
    int gt, ngt;
};

__device__ __forceinline__ int pack4_i8(float a, float b, float c, float d) {
    const int ia = (int)rintf(a), ib = (int)rintf(b), ic = (int)rintf(c), id = (int)rintf(d);
    return (ia & 0xff) | ((ib & 0xff) << 8) | ((ic & 0xff) << 16) | (id << 24);
}
template <bool OFFS>
__device__ __forceinline__ void quant_rows(const Ctx& C, const float* __restrict__ tab, unsigned* __restrict__ q, float* __restrict__ scale) {
    const int lane = C.lane;
    for (int r = C.gw; r < NEXP; r += C.ngw) {
        const float* row = tab + (size_t)r * DM;
        f32x4 v[4]; float m = 0.f;
#pragma unroll
        for (int j = 0; j < 4; ++j) { v[j] = *(const f32x4*)(row + j * 256 + lane * 4); m = fmaxf(m, fmaxf(fmaxf(fabsf(v[j][0]), fabsf(v[j][1])), fmaxf(fabsf(v[j][2]), fabsf(v[j][3])))); }
        m = wave_max(m);
        const float inv = m > 0.f ? 127.0f / m : 0.f;
#pragma unroll
        for (int j = 0; j < 4; ++j) {
            unsigned w = (unsigned)pack4_i8(v[j][0] * inv, v[j][1] * inv, v[j][2] * inv, v[j][3] * inv);
            if (OFFS) w ^= 0x80808080u;
            { const int dw = j * 64 + lane; q[(size_t)(dw >> 5) * (NEXP * 32) + (size_t)r * 32 + (dw & 31)] = w; }
        }
        if (lane == 0) scale[r] = m * (1.0f / 127.0f);
    }
}

__device__ __forceinline__ void p0_transpose_item(const float* W, int K, int N, f16* WT, int ldo, int koff, LAS float* scr, int item, int lane) {
    const int nblk = N / 32, kb = item / nblk, nb = item % nblk, k0 = 64 * kb, n0 = 32 * nb;
#pragma unroll 8
    for (int i = 0; i < 32; ++i) { const int kk = 2 * i + (lane >> 5); scr[kk * 33 + (lane & 31)] = W[(size_t)(k0 + kk) * N + n0 + (lane & 31)]; }
    LDS_WAIT(); asm volatile("" ::: "memory");
    const int c = lane & 7;
#pragma unroll
    for (int j = 0; j < 4; ++j) { const int n = (lane >> 3) + 8 * j; const LAS float* s = scr + (8 * c) * 33 + n;
        half8 o;
#pragma unroll
        for (int i = 0; i < 8; ++i) o[i] = (f16)s[i * 33];
        *(half8*)(WT + (size_t)(n0 + n) * ldo + koff + k0 + 8 * c) = o; }
    LDS_WAIT(); asm volatile("" ::: "memory");
}
__device__ __forceinline__ void cvt_stream(const Ctx& C, const float* in, f16* out, size_t n4) {
    for (size_t i = (size_t)C.gt; i < n4; i += (size_t)C.ngt) {
        const f32x4 v = ((const f32x4*)in)[i];
        half4 h; h[0] = (f16)v[0]; h[1] = (f16)v[1]; h[2] = (f16)v[2]; h[3] = (f16)v[3];
        ((half4*)out)[i] = h;
    }
}
__device__ __forceinline__ void rowprep(const Ctx& C, const float* x, const float* g, f16* xh, float* ss) {
    const int lane = C.lane;
    for (int t = C.gw; t < T; t += C.ngw) {
        const float* xr = x + (size_t)t * DM;
        float s = 0.f;
#pragma unroll
        for (int j = 0; j < 4; ++j) {
            const f32x4 v = *(const f32x4*)(xr + j * 256 + lane * 4);
            const f32x4 gg = *(const f32x4*)(g + j * 256 + lane * 4);
            s += v[0] * v[0] + v[1] * v[1] + v[2] * v[2] + v[3] * v[3];
            half4 h; h[0] = (f16)(v[0] * gg[0]); h[1] = (f16)(v[1] * gg[1]); h[2] = (f16)(v[2] * gg[2]); h[3] = (f16)(v[3] * gg[3]);
            *(half4*)(xh + (size_t)t * DM + j * 256 + lane * 4) = h;
        }
        s = wave_sum(s);
        if (lane == 0) ss[t] = s;
    }
}
__device__ __forceinline__ void ph_prep(const Ctx& C, LAS unsigned char* lds, const float* const* in, unsigned char* ws) {
    LAS float* scr = (LAS float*)(lds + RING_OFF + C.wave * 16384);
    f16* wcat = (f16*)(ws + WS_WCAT); f16* wb = (f16*)(ws + WS_WB); f16* wout = (f16*)(ws + WS_WOUT); f16* wq = (f16*)(ws + WS_WQ); f16* poolw = (f16*)(ws + WS_POOLW);
    constexpr int I_IN = 16 * 40, I_G = 16 * 64, I_B = 8 * 32, I_O = 16 * 32, I_Q = 16 * 64, I_P = 2 * 4;
    constexpr int NITEMS = I_IN + I_G + 2 * I_B + I_O + I_Q + 4 * I_P;
    for (int it = C.gw; it < NITEMS; it += C.ngw) {
        int r = it;
        if (r < I_IN) { p0_transpose_item(in[2], 1024, 1280, wcat, 1024, 0, scr, r, C.lane); continue; } r -= I_IN;
        if (r < I_G) { p0_transpose_item(in[7], 1024, 2048, wcat + (size_t)NQKVU * 1024, 1024, 0, scr, r, C.lane); continue; } r -= I_G;
        if (r < I_B) { p0_transpose_item(in[6], 512, 1024, wb, 1024, 0, scr, r, C.lane); continue; } r -= I_B;
        if (r < I_B) { p0_transpose_item(in[6] + 512 * 1024, 512, 1024, wb, 1024, 512, scr, r, C.lane); continue; } r -= I_B;
        if (r < I_O) { p0_transpose_item(in[9], 1024, 1024, wout, 1024, 0, scr, r, C.lane); continue; } r -= I_O;
        if (r < I_Q) { p0_transpose_item(in[11], 1024, 2048, wq, 1024, 0, scr, r, C.lane); continue; } r -= I_Q;
        { const int g = r / I_P; p0_transpose_item(in[4] + g * 128 * 128, 128, 128, poolw + g * 128 * 128, 128, 0, scr, r % I_P, C.lane); }
    }
    cvt_stream(C, in[12], (f16*)(ws + WS_SUBK), (size_t)8 * 2 * 128 * 128 / 4);
    rowprep(C, in[0], in[1], (f16*)(ws + WS_XH), (float*)(ws + WS_RS1));
}

__device__ __forceinline__ void ph_attn_naive(const Ctx& C, const f16* __restrict__ qkvu, const float* __restrict__ sink, f16* __restrict__ ocat) {
    for (int gid = C.gt; gid < T * 8; gid += C.ngt) {
        const int t = gid % T, h = gid / T;
        const int b = t / SEQ, ts = t % SEQ, kh = h >> 2;
        float q[64], o[64];
        const f16* qr = qkvu + (size_t)t * NQKVU + h * 64;
#pragma unroll
        for (int d = 0; d < 64; ++d) { q[d] = (float)qr[d]; o[d] = 0.f; }
        const float slope = exp2f(-(float)(h + 1));
        float m = -1e30f, l = 0.f;
        const int s0 = max(ts - 128, 0), s1 = min(ts + 128, SEQ - 1);
        for (int s = s0; s <= s1; ++s) {
            const f16* kr = qkvu + (size_t)(b * SEQ + s) * NQKVU + COL_K + kh * 64;
            const f16* vr = qkvu + (size_t)(b * SEQ + s) * NQKVU + COL_V + kh * 64;
            float dot = 0.f;
#pragma unroll
            for (int d = 0; d < 64; ++d) dot += q[d] * (float)kr[d];
            const float lg = dot * 0.125f - slope * fabsf((float)(ts - s));
            const float mn = fmaxf(m, lg), al = __expf(m - mn), p = __expf(lg - mn);
            l = l * al + p;
#pragma unroll
            for (int d = 0; d < 64; ++d) o[d] = o[d] * al + p * (float)vr[d];
            m = mn;
        }
        const float sk = sink[h];
        const float mn = fmaxf(m, sk), al = __expf(m - mn);
        l = l * al + __expf(sk - mn);
        const float inv = al / l;
        f16* orow = ocat + (size_t)t * DM + h * 64;
#pragma unroll
        for (int d = 0; d < 64; ++d) orow[d] = (f16)(o[d] * inv);
    }
}

template <int DIAG = 0>
__device__ __forceinline__ void attn_unit(const Ctx& C, int u, const f16* __restrict__ qkvu, const f16* __restrict__ vT, const float* __restrict__ sink, f16* __restrict__ ocat) {
    const int lane = C.lane, r32 = lane & 31, hh = lane >> 5;
    const int krow = (r32 & 19) | ((r32 & 4) << 1) | ((r32 & 8) >> 1);
    constexpr float L2E = 1.4426950408889634f;
    {
        const int qs = u & 63, h = (u >> 6) & 7, b = u >> 9, kh = h >> 2;
        const int tq = qs * 32 + r32;
        const float slope2 = exp2f(-(float)(h + 1)) * L2E, sink2 = sink[h] * L2E;
        const f16* qrow = qkvu + (size_t)(b * SEQ + tq) * NQKVU + h * 64 + 8 * hh;
        half8 bq[4];
#pragma unroll
        for (int ks = 0; ks < 4; ++ks) bq[ks] = *(const half8*)(qrow + 16 * ks);
        f32x16 o0, o1;
#pragma unroll
        for (int r = 0; r < 16; ++r) { o0[r] = 0.f; o1[r] = 0.f; }
        float m = -1e30f, l = 0.f;
        const int kb_lo = max(qs - 4, 0), kb_hi = min(qs + 4, 63);
        const f16* vbase = vT + (size_t)((b * 2 + kh) * 64 + r32) * SEQ + 8 * hh;
        const f16* kbase = qkvu + (size_t)(b * SEQ + krow) * NQKVU + COL_K + kh * 64 + 8 * hh;
        half8 kf[4], va[2][2];
#pragma unroll
        for (int ks = 0; ks < 4; ++ks) kf[ks] = *(const half8*)(kbase + (size_t)(kb_lo * 32) * NQKVU + 16 * ks);
#pragma unroll
        for (int db = 0; db < 2; ++db)
#pragma unroll
            for (int st = 0; st < 2; ++st) va[db][st] = *(const half8*)(vbase + (size_t)(db * 32) * SEQ + kb_lo * 32 + 16 * st);
#pragma unroll 1
        for (int kb = kb_lo; kb <= kb_hi; ++kb) {
            const int kn = (DIAG == 2) ? kb_lo : (kb < kb_hi ? kb + 1 : kb);
            half8 nkf[4], nva[2][2];
#pragma unroll
            for (int ks = 0; ks < 4; ++ks) nkf[ks] = *(const half8*)(kbase + (size_t)(kn * 32) * NQKVU + 16 * ks);
#pragma unroll
            for (int db = 0; db < 2; ++db)
#pragma unroll
                for (int st = 0; st < 2; ++st) nva[db][st] = *(const half8*)(vbase + (size_t)(db * 32) * SEQ + kn * 32 + 16 * st);
            f32x16 s;
#pragma unroll
            for (int r = 0; r < 16; ++r) s[r] = 0.f;
#pragma unroll
            for (int ks = 0; ks < 4; ++ks) s = __builtin_amdgcn_mfma_f32_32x32x16_f16(kf[ks], bq[ks], s, 0, 0, 0);
            float bmax = -1e30f; bool ok[16];
#pragma unroll
            for (int r = 0; r < 16; ++r) {
                const int tk = kb * 32 + 16 * (r >> 3) + 8 * hh + (r & 7);
                const int dist = abs(tq - tk);
                ok[r] = dist <= 128;
                s[r] = ok[r] ? s[r] * (0.125f * L2E) - slope2 * (float)dist : -1e30f;
                bmax = fmaxf(bmax, s[r]);
            }
            bmax = fmaxf(bmax, __shfl_xor(bmax, 32));
            const float mn = fmaxf(m, bmax), al = exp2f(m - mn);
            m = mn;
            float ps = 0.f; half8 pb[2];
#pragma unroll
            for (int r = 0; r < 16; ++r) { const float p = ok[r] ? (DIAG == 1 ? (s[r] - mn) : exp2f(s[r] - mn)) : 0.f; ps += p; pb[r >> 3][r & 7] = (f16)p; }
            l = l * al + ps;
#pragma unroll
            for (int r = 0; r < 16; ++r) { o0[r] *= al; o1[r] *= al; }
#pragma unroll
            for (int st = 0; st < 2; ++st) { o0 = __builtin_amdgcn_mfma_f32_32x32x16_f16(va[0][st], pb[st], o0, 0, 0, 0); o1 = __builtin_amdgcn_mfma_f32_32x32x16_f16(va[1][st], pb[st], o1, 0, 0, 0); }
#pragma unroll
            for (int ks = 0; ks < 4; ++ks) kf[ks] = nkf[ks];
#pragma unroll
            for (int db = 0; db < 2; ++db)
#pragma unroll
                for (int st = 0; st < 2; ++st) va[db][st] = nva[db][st];
        }
        l += __shfl_xor(l, 32);
        const float mf = fmaxf(m, sink2), al = exp2f(m - mf);
        const float sc = al / (l * al + exp2f(sink2 - mf));
        f16* orow = ocat + (size_t)(b * SEQ + tq) * DM + h * 64 + 4 * hh;
#pragma unroll
        for (int g = 0; g < 4; ++g) {
            half4 a, c;
#pragma unroll
            for (int i = 0; i < 4; ++i) { a[i] = (f16)(o0[4 * g + i] * sc); c[i] = (f16)(o1[4 * g + i] * sc); }
            *(half4*)(orow + 8 * g) = a; *(half4*)(orow + 32 + 8 * g) = c;
        }
    }
}

__device__ __forceinline__ void ph_pool_naive(const Ctx& C, const f16* __restrict__ qkvu, f16* __restrict__ mixed) {
    for (size_t gid = (size_t)C.gt; gid < (size_t)T * 512; gid += (size_t)C.ngt) {
        const int c = (int)(gid & 511), t = (int)(gid >> 9);
        const int b = t / SEQ, ts = t % SEQ, g = c >> 7, w = 2 << g;
        const int lo = max(ts - w / 2, 0), hi = min(ts + w / 2, SEQ);
        float s = 0.f;
        for (int i = lo; i < hi; ++i) s += (float)qkvu[(size_t)(b * SEQ + i) * NQKVU + COL_U + c];
        const float mean = s / (float)(hi - lo);
        mixed[(size_t)t * 512 + c] = (f16)(mean - (float)qkvu[(size_t)t * NQKVU + COL_U + c]);
    }
}
__device__ __forceinline__ void ph_poolmm_naive(const Ctx& C, const f16* __restrict__ mixed, const f16* __restrict__ poolw_t, const float* __restrict__ pscale, f16* __restrict__ ocat) {
    for (size_t gid = (size_t)C.gt; gid < (size_t)T * 512; gid += (size_t)C.ngt) {
        const int n = (int)(gid & 511), t = (int)(gid >> 9), g = n >> 7, d = n & 127;
        const f16* mr = mixed + (size_t)t * 512 + g * 128;
        const f16* wr = poolw_t + (size_t)(g * 128 + d) * 128;
        float acc = 0.f;
        for (int c = 0; c < 128; ++c) acc += (float)mr[c] * (float)wr[c];
        ocat[(size_t)t * DM + 512 + n] = (f16)(acc * pscale[n]);
    }
}

template <int HW>
__device__ __forceinline__ void pool_step1(const f16* __restrict__ qkvu, LAS unsigned char* tile, int t0, int g, int lane) {
    const int c2 = lane, b = t0 >> 11, sf = t0 & (SEQ - 1);
    const f16* ub = qkvu + (size_t)(b * SEQ) * NQKVU + COL_U + g * 128 + 2 * c2;
    constexpr int NR = 32 + 2 * HW - 1;
    half2 v[NR];
#pragma unroll
    for (int i = 0; i < NR; ++i) { const int s = sf - HW + i; half2 z; z[0] = (f16)0.f; z[1] = (f16)0.f; v[i] = z; if (s >= 0 && s < SEQ) v[i] = *(const half2*)(ub + (size_t)s * NQKVU); }
    float s0 = 0.f, s1 = 0.f;
#pragma unroll
    for (int i = 0; i < 2 * HW - 1; ++i) { s0 += (float)v[i][0]; s1 += (float)v[i][1]; }
#pragma unroll
    for (int j = 0; j < 32; ++j) {
        s0 += (float)v[j + 2 * HW - 1][0]; s1 += (float)v[j + 2 * HW - 1][1];
        const int s = sf + j, lo = max(s - HW, 0), hi = min(s + HW, SEQ);
        const float inv = 1.0f / (float)(hi - lo);
        half2 mx; mx[0] = (f16)(s0 * inv - (float)v[j + HW][0]); mx[1] = (f16)(s1 * inv - (float)v[j + HW][1]);
        *(LAS half2*)(tile + j * 256 + (((c2 >> 2) ^ (j & 15)) << 4) + ((c2 & 3) << 2)) = mx;
        s0 -= (float)v[j][0]; s1 -= (float)v[j][1];
    }
}
__device__ __forceinline__ void pool_unit(const Ctx& C, int u, LAS unsigned char* lds, const f16* __restrict__ qkvu, const f16* __restrict__ poolw_t, const float* __restrict__ pscale, f16* __restrict__ ocat) {
    const int lane = C.lane, r32 = lane & 31, hh = lane >> 5;
    LAS unsigned char* tile = lds + C.wave * 8192;
    const int g = u & 3, t0 = (u >> 2) * 32;
    switch (g) { case 0: pool_step1<1>(qkvu, tile, t0, g, lane); break; case 1: pool_step1<2>(qkvu, tile, t0, g, lane); break;
                 case 2: pool_step1<4>(qkvu, tile, t0, g, lane); break; default: pool_step1<8>(qkvu, tile, t0, g, lane); break; }
    LDS_WAIT();
    f32x16 acc[4];
#pragma unroll
    for (int db = 0; db < 4; ++db)
#pragma unroll
        for (int r = 0; r < 16; ++r) acc[db][r] = 0.f;
    const f16* wr = poolw_t + (size_t)(g * 128 + r32) * 128 + 8 * hh;
#pragma unroll
    for (int ks = 0; ks < 8; ++ks) {
        const half8 bm = *(const LAS half8*)(tile + r32 * 256 + (((2 * ks + hh) ^ (r32 & 15)) << 4));
#pragma unroll
        for (int db = 0; db < 4; ++db) { const half8 a = *(const half8*)(wr + (size_t)(db * 32) * 128 + 16 * ks); acc[db] = __builtin_amdgcn_mfma_f32_32x32x16_f16(a, bm, acc[db], 0, 0, 0); }
    }
    LDS_WAIT();
    f16* orow = ocat + (size_t)(t0 + r32) * DM + 512 + g * 128 + 4 * hh;
    const float* ps = pscale + g * 128 + 4 * hh;
#pragma unroll
    for (int db = 0; db < 4; ++db)
#pragma unroll
        for (int q = 0; q < 4; ++q) {
            const f32x4 pv = *(const f32x4*)(ps + db * 32 + 8 * q);
            half4 x0;
#pragma unroll
            for (int i = 0; i < 4; ++i) x0[i] = (f16)(acc[db][4 * q + i] * pv[i]);
            *(half4*)(orow + db * 32 + 8 * q) = x0;
        }
}
__device__ __forceinline__ void ph_attn_pool(const Ctx& C, LAS unsigned char* lds, const f16* __restrict__ qkvu, const f16* __restrict__ vT, const float* __restrict__ sink,
                                             const f16* __restrict__ poolw_t, const float* __restrict__ pscale, f16* __restrict__ ocat) {
    for (int m = C.gw; m < (T / 32) * 4; m += C.ngw) {
        if (C.wave & 4) pool_unit(C, m, lds, qkvu, poolw_t, pscale, ocat);
        attn_unit<0>(C, 2 * m, qkvu, vT, sink, ocat);
        attn_unit<0>(C, 2 * m + 1, qkvu, vT, sink, ocat);
        if (!(C.wave & 4)) pool_unit(C, m, lds, qkvu, poolw_t, pscale, ocat);
    }
}

#define INS(LV, LI, v_, i_) do { float cv_ = (v_); int ci_ = (i_); \
    _Pragma("unroll") for (int z_ = 0; z_ < 16; ++z_) { const bool gt_ = cv_ > LV[z_]; const float tv_ = gt_ ? LV[z_] : cv_; const int ti_ = gt_ ? LI[z_] : ci_; \
        LV[z_] = gt_ ? cv_ : LV[z_]; LI[z_] = gt_ ? ci_ : LI[z_]; cv_ = tv_; ci_ = ti_; } } while (0)
__device__ __forceinline__ void ph_route_naive(const Ctx& C, const f16* __restrict__ qp, const float* __restrict__ ss2, const f16* __restrict__ subk, int* __restrict__ eidx, float* __restrict__ egate) {
    for (int gid = C.gt; gid < T * 8; gid += C.ngt) {
        const int t = gid % T, h = gid / T;
        const float rs2 = rs_from_ss(ss2, t);
        float av[16], bv[16]; int ai[16], bi[16];
#pragma unroll
        for (int z = 0; z < 16; ++z) { av[z] = -3e38f; bv[z] = -3e38f; ai[z] = 0; bi[z] = 0; }
        for (int p = 0; p < 2; ++p) {
            const f16* qr = qp + (size_t)t * 2048 + h * 256 + p * 128;
            for (int n = 0; n < 128; ++n) {
                const f16* kr = subk + ((size_t)((h * 2 + p) * 128 + n)) * 128;
                float dot = 0.f;
                for (int c = 0; c < 128; ++c) dot += (float)qr[c] * (float)kr[c];
                dot *= rs2;
                if (p == 0) INS(av, ai, dot, n); else INS(bv, bi, dot, n);
            }
        }
        float cv[16]; int ci[16];
#pragma unroll
        for (int z = 0; z < 16; ++z) { cv[z] = -3e38f; ci[z] = 0; }
#pragma unroll
        for (int i = 0; i < 16; ++i)
#pragma unroll
            for (int j = 0; j < 16; ++j)
                if ((i + 1) * (j + 1) <= 16) INS(cv, ci, av[i] + bv[j], ai[i] * 128 + bi[j]);
        float sum = 0.f, e[16];
#pragma unroll
        for (int z = 0; z < 16; ++z) { e[z] = __expf(cv[z] - cv[0]); sum += e[z]; }
        const float inv = 1.0f / sum;
#pragma unroll
        for (int z = 0; z < 16; ++z) { eidx[(size_t)t * 128 + h * 16 + z] = ci[z]; egate[(size_t)t * 128 + h * 16 + z] = e[z] * inv; }
    }
}

__device__ __forceinline__ int mono_i(float f) { const int b = __float_as_int(f); return b ^ ((b >> 31) & 0x7fffffff); }
__device__ __forceinline__ float unmono_f(int m) { return __int_as_float(m ^ ((m >> 31) & 0x7fffffff)); }
#define INS16(Lst, x_) do { int xv_ = (x_); _Pragma("unroll") for (int z_ = 0; z_ < 16; ++z_) { const int hi_ = max(Lst[z_], xv_); xv_ = min(Lst[z_], xv_); Lst[z_] = hi_; } } while (0)
__device__ __forceinline__ void merge_pair16(int (&Lst)[16]) {
    int P[16];
#pragma unroll
    for (int z = 0; z < 16; ++z) P[z] = __shfl_xor(Lst[z], 32);
#pragma unroll
    for (int z = 0; z < 16; ++z) Lst[z] = max(Lst[z], P[15 - z]);
#pragma unroll
    for (int s = 8; s >= 1; s >>= 1)
#pragma unroll
        for (int i = 0; i < 16; ++i) if ((i & s) == 0) { const int hi = max(Lst[i], Lst[i + s]), lo = min(Lst[i], Lst[i + s]); Lst[i] = hi; Lst[i + s] = lo; }
}
__device__ __forceinline__ void bitonic_sort16_desc(int (&K)[16]) {
#pragma unroll
    for (int k = 2; k <= 16; k <<= 1)
#pragma unroll
        for (int j = k >> 1; j > 0; j >>= 1)
#pragma unroll
            for (int i = 0; i < 16; ++i) { const int l = i ^ j; if (l > i) { const int a = K[i], b = K[l], hi = max(a, b), lo = min(a, b); const bool desc = (i & k) == 0; K[i] = desc ? hi : lo; K[l] = desc ? lo : hi; } }
}
__device__ __forceinline__ void bitonic_merge16_desc(int (&K)[16]) {
#pragma unroll
    for (int s = 8; s >= 1; s >>= 1)
#pragma unroll
        for (int i = 0; i < 16; ++i) if ((i & s) == 0) { const int hi = max(K[i], K[i + s]), lo = min(K[i], K[i + s]); K[i] = hi; K[i + s] = lo; }
}
template <class Side>
__device__ __forceinline__ void ph_route(const Ctx& C, LAS unsigned char* lds, const f16* __restrict__ qp, const float* __restrict__ ss2, const f16* __restrict__ subk,
                                         int* __restrict__ eidx, float* __restrict__ egate, const Side& side_job) {
    const int lane = C.lane, r32 = lane & 31, hh = lane >> 5;
    LAS unsigned char* tab = lds + 65536 + C.wave * 4096 + lane * 36;
    const int GH = C.G < 8 ? C.G : 8;
  for (int h = blockIdx.x % GH; h < 8; h += GH) {
    const int rank_h = blockIdx.x / GH, nwg_h = (C.G - (blockIdx.x % GH) + GH - 1) / GH;
    __syncthreads();
    for (int i = C.tid; i < 2 * 128 * 16; i += NTHREADS) {
        const int row = i >> 4, ch = i & 15;
        *(LAS half8*)(lds + row * 256 + ((ch ^ (row & 15)) << 4)) = *(const half8*)(subk + (size_t)(h * 256 + row) * 128 + ch * 8);
    }
    __syncthreads();
    if (h == (int)(blockIdx.x % GH) && (C.wave & 4)) side_job();
    for (int tb = rank_h * NWAVES + C.wave; tb < T / 32; tb += nwg_h * NWAVES) {
        const int t0 = tb * 32, t = t0 + r32;
        const float rs2 = rs_from_ss(ss2, t);
        int top[2][16];
#pragma unroll
        for (int p = 0; p < 2; ++p) {
            const f16* qrow = qp + (size_t)t * 2048 + h * 256 + p * 128 + 8 * hh;
            const LAS unsigned char* kl = lds + (p * 128 + r32) * 256;
            half8 bq[8];
#pragma unroll
            for (int ks = 0; ks < 8; ++ks) bq[ks] = *(const half8*)(qrow + 16 * ks);
            int Lst[16];
#pragma unroll
            for (int z = 0; z < 16; ++z) Lst[z] = (int)0x80000000;
#pragma unroll 1
            for (int nb = 0; nb < 4; ++nb) {
                f32x16 acc = {0.f, 0.f, 0.f, 0.f, 0.f, 0.f, 0.f, 0.f, 0.f, 0.f, 0.f, 0.f, 0.f, 0.f, 0.f, 0.f};
#pragma unroll
                for (int ks = 0; ks < 8; ++ks) {
                    const half8 ak = *(const LAS half8*)(kl + nb * 32 * 256 + (((2 * ks + hh) ^ (r32 & 15)) << 4));
                    acc = __builtin_amdgcn_mfma_f32_32x32x16_f16(ak, bq[ks], acc, 0, 0, 0);
                }
                int K[16];
#pragma unroll
                for (int r = 0; r < 16; ++r) { const int n = nb * 32 + (r & 3) + 8 * (r >> 2) + 4 * hh; K[r] = (mono_i(acc[r] * rs2) & ~127) | (127 - n); }
                bitonic_sort16_desc(K);
#pragma unroll
                for (int z = 0; z < 16; ++z) Lst[z] = max(Lst[z], K[15 - z]);
                bitonic_merge16_desc(Lst);
            }
            merge_pair16(Lst);
#pragma unroll
            for (int z = 0; z < 16; ++z) top[p][z] = Lst[z];
        }
        float va[16], vb[16];
#pragma unroll
        for (int z = 0; z < 16; ++z) { va[z] = unmono_f(top[0][z] & ~127); vb[z] = unmono_f(top[1][z] & ~127);
            tab[z] = (unsigned char)(127 - (top[0][z] & 127)); tab[16 + z] = (unsigned char)(127 - (top[1][z] & 127)); }
        int Cl[16];
        { const float a01 = hh ? va[1] : va[0];
#pragma unroll
          for (int j = 0; j < 16; ++j) { const int key = (mono_i(a01 + vb[j]) & ~255) | (255 - (hh * 16 + j)); Cl[j] = (hh && j >= 8) ? (int)0x80000000 : key; } }
#pragma unroll
        for (int i = 2; i < 16; i += 2) {
            const float ai = hh ? va[i + 1] : va[i];
#pragma unroll
            for (int j = 0; j < 16; ++j)
                if ((i + 1) * (j + 1) <= 16) {
                    int key = (mono_i(ai + vb[j]) & ~255) | (255 - ((i + hh) * 16 + j));
                    if ((i + 2) * (j + 1) > 16) key = hh ? (int)0x80000000 : key;
                    INS16(Cl, key);
                }
        }
        merge_pair16(Cl);
        float e[16], sum = 0.f; const float mx = unmono_f(Cl[0] & ~255);
#pragma unroll
        for (int z = 0; z < 16; ++z) { e[z] = __expf(unmono_f(Cl[z] & ~255) - mx); sum += e[z]; }
        const float inv = 1.0f / sum;
        LDS_WAIT();
        int* ei = eidx + (size_t)t * 128 + h * 16 + 8 * hh; float* eg = egate + (size_t)t * 128 + h * 16 + 8 * hh;
#pragma unroll
        for (int z = 0; z < 16; ++z) {
            if ((z >> 3) == hh) { const int code = 255 - (Cl[z] & 255); const int ia = tab[code >> 4], ib = tab[16 + (code & 15)];
                ei[z & 7] = ia * 128 + ib; eg[z & 7] = e[z] * inv; }
        }
        LDS_WAIT();
    }
  }
}

typedef unsigned u32x4 __attribute__((ext_vector_type(4)));
struct Slicing { int m, pi, nloc, rank; };
__device__ __forceinline__ Slicing get_slicing(const unsigned* bar, volatile LAS unsigned* misc) {
    Slicing S; const unsigned x = (unsigned)__builtin_amdgcn_s_getreg((3 << 11) | 20) & 0xFu;
    int m = 0, pi = 0, nloc = 1;
    for (unsigned j = 0; j < 16; ++j) { const unsigned c = __hip_atomic_load(&bar[256 + 64 * j], __ATOMIC_RELAXED, __HIP_MEMORY_SCOPE_AGENT); if (c > 0u) { if (j < x) ++pi; ++m; } if (j == x) nloc = (int)c; }
    S.m = m > 0 ? m : 1; S.pi = pi; S.nloc = nloc > 0 ? nloc : 1; S.rank = (int)misc[10];
    return S;
}
__device__ __forceinline__ float gelu_fast(float v) {
    const float av = fabsf(v), t = __builtin_amdgcn_rcpf(av * 0.2316418882f + 1.0f);
    float q = t * 0.5307027145f + (-0.7265760135f); q = q * t + 0.7107068705f; q = q * t + (-0.142248368f); q = q * t + 0.127414796f; q = q * t;
    const float m = v * (q * __builtin_amdgcn_exp2f((v * v) * (-0.72134752044f)));
    return v < 0.f ? m : v - m;
}
__device__ __forceinline__ void ph_h2quant(const Ctx& C, const f16* __restrict__ x1h, const float* __restrict__ ss2, unsigned* __restrict__ h2q, float* __restrict__ hsc) {
    const int lane = C.lane;
    for (int t = C.gw; t < T; t += C.ngw) {
        const half8 h0 = *(const half8*)(x1h + (size_t)t * DM + 16 * lane), h1 = *(const half8*)(x1h + (size_t)t * DM + 16 * lane + 8);
        float hm = 0.f;
#pragma unroll
        for (int i = 0; i < 8; ++i) hm = fmaxf(hm, fmaxf(fabsf((float)h0[i]), fabsf((float)h1[i])));
        hm = wave_max(hm);
        const float inv = hm > 0.f ? 127.0f / hm : 0.f;
        u32x4 w;
        w[0] = (unsigned)pack4_i8((float)h0[0] * inv, (float)h0[1] * inv, (float)h0[2] * inv, (float)h0[3] * inv);
        w[1] = (unsigned)pack4_i8((float)h0[4] * inv, (float)h0[5] * inv, (float)h0[6] * inv, (float)h0[7] * inv);
        w[2] = (unsigned)pack4_i8((float)h1[0] * inv, (float)h1[1] * inv, (float)h1[2] * inv, (float)h1[3] * inv);
        w[3] = (unsigned)pack4_i8((float)h1[4] * inv, (float)h1[5] * inv, (float)h1[6] * inv, (float)h1[7] * inv);
        *(u32x4*)(h2q + (size_t)t * 256 + 4 * lane) = w;
        if (lane == 0) hsc[t] = hm * (1.0f / 127.0f) * rs_from_ss(ss2, t);
    }
}
template <int EMASK>
__device__ __forceinline__ void ph_upeer(const Ctx& C, LAS unsigned char* lds, const Slicing SL, const unsigned* __restrict__ h2q, const int* __restrict__ eidx,
                                         const unsigned char* __restrict__ uq, short* __restrict__ pdot) {
    const int lane = C.lane, grp = lane >> 3, c8 = lane & 7;
    const int wv = SL.rank * NWAVES + C.wave, nwv = SL.nloc * NWAVES;
    const int ntok = (T - wv + nwv - 1) / nwv;
    auto tok = [&](int i) { const int t = wv + i * nwv; return t < T ? t : T - 1; };
    volatile LAS int* row = (volatile LAS int*)(lds + C.wave * 1024);
  for (int s = SL.pi; s < 8; s += SL.m) {
    const unsigned char* uqs = uq + (size_t)s * (NEXP * 128) + c8 * 16;
    const unsigned* hqs = h2q + s * 32 + c8 * 4;
    int tA = tok(0), tB = tok(1);
    int e0 = eidx[(size_t)tA * 128 + lane], e1 = eidx[(size_t)tA * 128 + 64 + lane];
    u32x4 hq = *(const u32x4*)(hqs + (size_t)tA * 256);
    int ne0 = eidx[(size_t)tB * 128 + lane], ne1 = eidx[(size_t)tB * 128 + 64 + lane];
    u32x4 r[16];
#pragma unroll
    for (int i = 0; i < 16; ++i) { const int e = __shfl(i < 8 ? e0 : e1, 8 * (i & 7) + grp) & EMASK; r[i] = *(const u32x4*)(uqs + (size_t)e * 128); }
#pragma unroll 1
    for (int it = 0; it < ntok; ++it) {
        const int t = tok(it), t1 = tok(it + 1), t2 = tok(it + 2);
        const int ze0 = eidx[(size_t)t2 * 128 + lane], ze1 = eidx[(size_t)t2 * 128 + 64 + lane];
        const u32x4 nhq = *(const u32x4*)(hqs + (size_t)t1 * 256);
#pragma unroll
        for (int q = 0; q < 4; ++q) {
            int evv[4];
#pragma unroll
            for (int j = 0; j < 4; ++j) evv[j] = __shfl(q < 2 ? ne0 : ne1, 32 * (q & 1) + 8 * j + grp) & EMASK;
            int pa[4], pb[4];
#pragma unroll
            for (int j = 0; j < 4; ++j) {
                pa[j] = __builtin_amdgcn_sdot4((int)r[4 * q + j][0], (int)hq[0], 0, false); pb[j] = __builtin_amdgcn_sdot4((int)r[4 * q + j][1], (int)hq[1], 0, false);
                pa[j] = __builtin_amdgcn_sdot4((int)r[4 * q + j][2], (int)hq[2], pa[j], false); pb[j] = __builtin_amdgcn_sdot4((int)r[4 * q + j][3], (int)hq[3], pb[j], false);
            }
#pragma unroll
            for (int j = 0; j < 4; ++j) { pa[j] += pb[j]; pa[j] += dppi<0xB1>(pa[j]); }
#pragma unroll
            for (int j = 0; j < 4; ++j) pa[j] += dppi<0x4E>(pa[j]);
#pragma unroll
            for (int j = 0; j < 4; ++j) pa[j] += dppi<0x141>(pa[j]);
            if (c8 == 0) {
#pragma unroll
                for (int j = 0; j < 4; ++j) row[8 * (4 * q + j) + grp] = pa[j];
            }
#pragma unroll
            for (int j = 0; j < 4; ++j) {
                asm volatile("" ::: "memory");
                r[4 * q + j] = *(const u32x4*)(uqs + (size_t)evv[j] * 128);
                asm volatile("" ::: "memory");
            }
        }
        LDS_WAIT();
        const int p0 = row[lane], p1 = row[64 + lane];
        LDS_WAIT();
        { short* pp = pdot + ((size_t)s * T + t) * 128 + lane; const int c0 = min(max((p0 + 4) >> 3, -32768), 32767), c1 = min(max((p1 + 4) >> 3, -32768), 32767);
          asm volatile("global_store_short %0, %1, off\n\tglobal_store_short %0, %2, off offset:128" :: "v"(pp), "v"(c0), "v"(c1) : "memory"); }
        hq = nhq; ne0 = ze0; ne1 = ze1;
    }
  }
}
__device__ __forceinline__ void ph_ureduce(const Ctx& C, LAS unsigned char* lds, const short* __restrict__ pdot, const float* __restrict__ hsc, const int* __restrict__ eidx, const float* __restrict__ us,
                                           const float* __restrict__ vs, const float* __restrict__ egate, unsigned* __restrict__ wqp, float* __restrict__ wsc) {
    const int lane = C.lane;
    volatile LAS unsigned char* row = (volatile LAS unsigned char*)(lds + C.wave * 1024);
    for (int tb = C.gw * 2; tb < T; tb += C.ngw * 2) {
        int e0[2], e1[2], s0[2], s1[2]; float h[2], g0[2], g1[2];
#pragma unroll
        for (int u = 0; u < 2; ++u) {
            const int t = tb + u;
            e0[u] = eidx[(size_t)t * 128 + lane]; e1[u] = eidx[(size_t)t * 128 + 64 + lane];
            g0[u] = egate[(size_t)t * 128 + lane]; g1[u] = egate[(size_t)t * 128 + 64 + lane];
            h[u] = hsc[t]; s0[u] = 0; s1[u] = 0;
#pragma unroll
            for (int s = 0; s < 8; ++s) { const short* pp = pdot + ((size_t)s * T + t) * 128 + lane; s0[u] += (int)pp[0]; s1[u] += (int)pp[64]; }
        }
        float w0[2], w1[2];
#pragma unroll
        for (int u = 0; u < 2; ++u) {
            w0[u] = gelu_fast((float)s0[u] * (8.0f * h[u]) * us[e0[u]]) * g0[u] * vs[e0[u]];
            w1[u] = gelu_fast((float)s1[u] * (8.0f * h[u]) * us[e1[u]]) * g1[u] * vs[e1[u]];
        }
#pragma unroll
        for (int u = 0; u < 2; ++u) {
            const int t = tb + u;
            const float wm = wave_max(fmaxf(fabsf(w0[u]), fabsf(w1[u])));
            const float inv = wm > 0.f ? 127.0f / wm : 0.f;
            { const int k = lane; row[u * 128 + (k & 7) * 16 + (k >> 5) * 4 + ((k >> 3) & 3)] = (unsigned char)(int)rintf(w0[u] * inv); }
            { const int k = 64 + lane; row[u * 128 + (k & 7) * 16 + (k >> 5) * 4 + ((k >> 3) & 3)] = (unsigned char)(int)rintf(w1[u] * inv); }
            if (lane == 0) wsc[t] = wm * (1.0f / 127.0f);
        }
        LDS_WAIT();
        wqp[(size_t)tb * 32 + lane] = ((volatile LAS unsigned*)row)[lane];
        LDS_WAIT();
    }
}
template <int EMASK>
__device__ __forceinline__ void ph_vpeer(const Ctx& C, const Slicing SL, const int* __restrict__ eidx, const unsigned* __restrict__ wqp, const float* __restrict__ wsc, const unsigned char* __restrict__ vq,
                                         const float* xio, float* xout, float* __restrict__ ssf) {
    const int lane = C.lane, grp = lane >> 3, c8 = lane & 7;
    const bool hh = (lane & 32) != 0, b4 = (lane & 16) != 0, b3 = (lane & 8) != 0;
    const int wv = SL.rank * NWAVES + C.wave, nwv = SL.nloc * NWAVES;
    const int ntok = (T - wv + nwv - 1) / nwv;
    auto tok = [&](int i) { const int t = wv + i * nwv; return t < T ? t : T - 1; };
  for (int s = SL.pi; s < 8; s += SL.m) {
    const unsigned char* vqs = vq + (size_t)s * (NEXP * 128) + c8 * 16;
    const int chl = 8 * (hh ? 1 : 0) + 4 * (b4 ? 1 : 0) + 2 * (b3 ? 1 : 0);
    const int coff = s * 128 + c8 * 16 + chl;
    int tA = tok(0), tB = tok(1);
    int e0 = eidx[(size_t)tA * 128 + lane], e1 = eidx[(size_t)tA * 128 + 64 + lane];
    u32x4 wq = *(const u32x4*)(wqp + (size_t)tA * 32 + grp * 4); float wscale = wsc[tA];
    int ne0 = eidx[(size_t)tB * 128 + lane], ne1 = eidx[(size_t)tB * 128 + 64 + lane];
    u32x4 r[16];
#pragma unroll
    for (int i = 0; i < 16; ++i) { const int e = __shfl(i < 8 ? e0 : e1, 8 * (i & 7) + grp) & EMASK; r[i] = *(const u32x4*)(vqs + (size_t)e * 128); }
#pragma unroll 1
    for (int it = 0; it < ntok; ++it) {
        const int t = tok(it), t1 = tok(it + 1), t2 = tok(it + 2);
        const int ze0 = eidx[(size_t)t2 * 128 + lane], ze1 = eidx[(size_t)t2 * 128 + 64 + lane];
        const u32x4 nwq = *(const u32x4*)(wqp + (size_t)t1 * 32 + grp * 4); const float nwscale = wsc[t1];
        const float2 xv = *(const float2*)(xio + (size_t)t * DM + coff);
        int o[16];
#pragma unroll
        for (int c = 0; c < 16; ++c) o[c] = 0;
#pragma unroll
        for (int q = 0; q < 4; ++q) {
            int evv[4];
#pragma unroll
            for (int j = 0; j < 4; ++j) evv[j] = __shfl(q < 2 ? ne0 : ne1, 32 * (q & 1) + 8 * j + grp) & EMASK;
#pragma unroll
            for (int d = 0; d < 4; ++d) {
                const unsigned a = r[4 * q][d], b = r[4 * q + 1][d], c = r[4 * q + 2][d], e = r[4 * q + 3][d];
                const unsigned t0 = __builtin_amdgcn_perm(b, a, 0x05010400u), t1p = __builtin_amdgcn_perm(b, a, 0x07030602u);
                const unsigned u0 = __builtin_amdgcn_perm(e, c, 0x05010400u), u1 = __builtin_amdgcn_perm(e, c, 0x07030602u);
                o[4 * d + 0] = __builtin_amdgcn_sdot4((int)__builtin_amdgcn_perm(u0, t0, 0x05040100u), (int)wq[q], o[4 * d + 0], false);
                o[4 * d + 1] = __builtin_amdgcn_sdot4((int)__builtin_amdgcn_perm(u0, t0, 0x07060302u), (int)wq[q], o[4 * d + 1], false);
                o[4 * d + 2] = __builtin_amdgcn_sdot4((int)__builtin_amdgcn_perm(u1, t1p, 0x05040100u), (int)wq[q], o[4 * d + 2], false);
                o[4 * d + 3] = __builtin_amdgcn_sdot4((int)__builtin_amdgcn_perm(u1, t1p, 0x07060302u), (int)wq[q], o[4 * d + 3], false);
            }
#pragma unroll
            for (int j = 0; j < 4; ++j) {
                asm volatile("" ::: "memory");
                r[4 * q + j] = *(const u32x4*)(vqs + (size_t)evv[j] * 128);
                asm volatile("" ::: "memory");
            }
        }
        int q8[8], q4[4], q2[2];
#pragma unroll
        for (int k = 0; k < 8; ++k) q8[k] = bfly32i(o[k], o[8 + k]);
#pragma unroll
        for (int k = 0; k < 4; ++k) q4[k] = bfly16i(q8[k], q8[4 + k]);
#pragma unroll
        for (int k = 0; k < 2; ++k) { const int mine = b3 ? q4[2 + k] : q4[k], oth = b3 ? q4[k] : q4[2 + k]; q2[k] = mine + dppi<0x128>(oth); }
        const float y0 = xv.x + (float)q2[0] * wscale, y1 = xv.y + (float)q2[1] * wscale;
        { float* yp = xout + (size_t)t * DM + coff; const float2 yv = make_float2(y0, y1); asm volatile("global_store_dwordx2 %0, %1, off" :: "v"(yp), "v"(yv) : "memory"); }
        const float ss = wave_sum(y0 * y0 + y1 * y1);
        if (lane == 0) { float* sp = ssf + (size_t)s * T + t; asm volatile("global_store_dword %0, %1, off" :: "v"(sp), "v"(ss) : "memory"); }
        wq = nwq; wscale = nwscale; ne0 = ze0; ne1 = ze1;
    }
  }
}
__device__ __forceinline__ void ph_final(const Ctx& C, const float* __restrict__ ssf, float* xio, const float* __restrict__ gf) {
    const int lane = C.lane;
    for (int t = C.gw; t < T; t += C.ngw) {
        float s = 0.f;
#pragma unroll
        for (int i = 0; i < 8; ++i) s += ssf[(size_t)i * T + t];
        const float r = rsqrtf(s * (1.0f / DM) + EPS);
        float* xr = xio + (size_t)t * DM;
#pragma unroll
        for (int j = 0; j < 4; ++j) {
            const int c0 = j * 256 + lane * 4;
            const f32x4 v = *(const f32x4*)(xr + c0), gg = *(const f32x4*)(gf + c0);
            *(f32x4*)(xr + c0) = v * r * gg;
        }
    }
}

namespace pg8 {
#define PG8_LAS __attribute__((address_space(3)))
typedef _Float16 frag8 __attribute__((ext_vector_type(8)));
typedef float f32x4 __attribute__((ext_vector_type(4)));
constexpr int BM = 256, BK = 64, HALF = 128, HTB = HALF * BK * 2  , STAGE_BYTES = 8 * HTB, NXCD = 8, WGM = 8;

__host__ __device__ __forceinline__ int lds_byte(int r, int c) { const int st = (r >> 4) * 2 + (c >> 5), rr = r & 15, cc = c & 31, ob = rr * 64 + cc * 2; return st * 1024 + (ob ^ (((ob >> 9) & 1) << 5)); }
__host__ __device__ __forceinline__ void stage_rc(int b, int& R, int& C) { const int st = b / 1024, sb = b % 1024, swz = sb ^ (((sb >> 9) & 1) << 5); R = (st >> 1) * 16 + swz / 64; C = (st & 1) * 32 + (swz % 64) / 2; }
__host__ __device__ __forceinline__ int perm32(int rho) { const int n = rho >> 4, i = rho & 15; return 8 * (i >> 2) + 4 * n + (i & 3); }

struct Unit { int pm, pn; };
struct Gemm { const f16* A; const f16* Bt; int M, N, K; };

struct StaticOrder {
    int nM, nN, nwg, G, c;
    __host__ __device__ void init(int M, int N, int G_, int c_) { nM = M / BM; nN = N / BM; nwg = nM * nN; G = G_; c = c_; }
    __host__ __device__ bool next(int i, Unit& u) const {
        const long L = (long)i * G + c; if (L >= nwg) return false;
        int wgid = (int)L; { const int q = nwg / NXCD, r = nwg % NXCD, xcd = wgid % NXCD, off = wgid / NXCD; wgid = (xcd < r ? xcd * (q + 1) : r * (q + 1) + (xcd - r) * q) + off; }
        const int nig = WGM * nN, gid = wgid / nig, fm = gid * WGM, gsz = (nM - fm) < WGM ? (nM - fm) : WGM;
        u.pm = fm + ((wgid % nig) % gsz); u.pn = (wgid % nig) / gsz; return true;
    }
    __device__ __forceinline__ void a_ready(const Unit&) const {}
    __device__ __forceinline__ void done(const Unit&) const {}
};

__device__ __forceinline__ frag8 pack8(const f32x4 a, const f32x4 b) {
    frag8 h; h[0] = (f16)a[0]; h[1] = (f16)a[1]; h[2] = (f16)a[2]; h[3] = (f16)a[3]; h[4] = (f16)b[0]; h[5] = (f16)b[1]; h[6] = (f16)b[2]; h[7] = (f16)b[3]; return h;
}
__device__ __forceinline__ float sigmoidf_(float z) { return 1.0f / (1.0f + __expf(-z)); }

struct EpiP1 {
    static constexpr bool PERM = true, AFTER_DRAIN = false, MIDK = false;
    const float* ss1; const float* bgate; f16* qkvu; f16* gates; f16* vT;
    __device__ __forceinline__ void operator()(const f32x4 (&acc)[2][2][4][2], const Unit& u, int wr, int wc, int fr, int fq) const {
        const int row0 = u.pm * BM + wr * 64 + fr, colt = u.pn * BM; const bool isg = colt >= NQKVU;
#pragma unroll
        for (int ai = 0; ai < 2; ++ai)
#pragma unroll
            for (int m = 0; m < 4; ++m) { const int row = row0 + ai * HALF + m * 16; const float r = rsqrtf(ss1[row] * (1.0f / DM) + EPS);
#pragma unroll
                for (int bj = 0; bj < 2; ++bj) { const int c0 = colt + bj * HALF + wc * 32 + 8 * fq; f32x4 v0 = acc[ai][bj][m][0] * r, v1 = acc[ai][bj][m][1] * r;
                    if (isg) { const int cg = c0 - NQKVU; const f32x4 b0 = *(const f32x4*)(bgate + cg), b1 = *(const f32x4*)(bgate + cg + 4);
#pragma unroll
                        for (int i = 0; i < 4; ++i) { v0[i] = sigmoidf_(v0[i] + b0[i]); v1[i] = sigmoidf_(v1[i] + b1[i]); }
                        *(frag8*)(gates + (size_t)row * NGATE + cg) = pack8(v0, v1); }
                    else { const frag8 hv = pack8(v0, v1); *(frag8*)(qkvu + (size_t)row * NQKVU + c0) = hv;
                        if (colt == 512 && bj == 1) {
                            f16* vp = vT + ((size_t)((row >> 11) * 2 + (wc >> 1)) * 64 + (wc & 1) * 32 + 8 * fq) * SEQ + (row & (SEQ - 1));
#pragma unroll
                            for (int i = 0; i < 8; ++i) vp[(size_t)i * SEQ] = hv[i];
                            if (PROBE_DUP == 21) { asm volatile("s_waitcnt vmcnt(0)" ::: "memory");
#pragma unroll
                                for (int i = 0; i < 8; ++i) { f16* q2 = vp + (size_t)i * SEQ; asm volatile("global_store_short %0, %1, off" :: "v"(q2), "v"(hv[i]) : "memory"); } } } } } }
    }
};
struct EpiMerged {
    static constexpr bool PERM = true, AFTER_DRAIN = false, MIDK = true;
    const f16* gates; f16* merged;
    __device__ __forceinline__ void mid(f32x4 (&acc)[2][2][4][2], const Unit& u, int wr, int wc, int fr, int fq) const {
        const int row0 = u.pm * BM + wr * 64 + fr, colt = u.pn * BM;
        const f16* gb = gates + (size_t)row0 * NGATE + colt + wc * 32 + 8 * fq;
        asm volatile("" : "+v"(gb));
#pragma unroll
        for (int ai = 0; ai < 2; ++ai) {
            frag8 g0[4][2], g1[4][2];
#pragma unroll
            for (int m = 0; m < 4; ++m)
#pragma unroll
                for (int bj = 0; bj < 2; ++bj) { const f16* gp = gb + (size_t)(ai * HALF + m * 16) * NGATE + bj * HALF; g0[m][bj] = *(const frag8*)gp; g1[m][bj] = *(const frag8*)(gp + DM); }
#pragma unroll
            for (int m = 0; m < 4; ++m)
#pragma unroll
                for (int bj = 0; bj < 2; ++bj)
#pragma unroll
                    for (int i = 0; i < 4; ++i) {
                        acc[ai][bj][m][0][i] *= (float)g0[m][bj][i] * __builtin_amdgcn_rcpf(fmaxf((float)g1[m][bj][i], 1e-4f));
                        acc[ai][bj][m][1][i] *= (float)g0[m][bj][4 + i] * __builtin_amdgcn_rcpf(fmaxf((float)g1[m][bj][4 + i], 1e-4f)); }
            asm volatile("" ::: "memory");
        }
    }
    __device__ __forceinline__ void operator()(const f32x4 (&acc)[2][2][4][2], const Unit& u, int wr, int wc, int fr, int fq) const {
        const int row0 = u.pm * BM + wr * 64 + fr, colt = u.pn * BM;
#pragma unroll
        for (int ai = 0; ai < 2; ++ai)
#pragma unroll
            for (int m = 0; m < 4; ++m) { const int row = row0 + ai * HALF + m * 16;
#pragma unroll
                for (int bj = 0; bj < 2; ++bj) { const int c0 = colt + bj * HALF + wc * 32 + 8 * fq;
                    const frag8 g1 = *(const frag8*)(gates + (size_t)row * NGATE + DM + c0); f32x4 v0, v1;
#pragma unroll
                    for (int i = 0; i < 4; ++i) { v0[i] = acc[ai][bj][m][0][i] * fmaxf((float)g1[i], 1e-4f); v1[i] = acc[ai][bj][m][1][i] * fmaxf((float)g1[4 + i], 1e-4f); }
                    *(frag8*)(merged + (size_t)row * DM + c0) = pack8(v0, v1); } }
    }
};
struct EpiOut {
    static constexpr bool PERM = false, AFTER_DRAIN = false, MIDK = false;
    const float* x; const float* g2; float* x1; f16* x1h; float* ss2p;
    __device__ __forceinline__ void operator()(const f32x4 (&acc)[2][2][4][2], const Unit& u, int wr, int wc, int fr, int fq) const {
        const int row0 = u.pm * BM + wr * 64 + fr, col0 = u.pn * BM + wc * 32 + 4 * fq;
        f32x4 gv[2][2];
#pragma unroll
        for (int bj = 0; bj < 2; ++bj)
#pragma unroll
            for (int n = 0; n < 2; ++n) gv[bj][n] = *(const f32x4*)(g2 + col0 + bj * HALF + n * 16);
#pragma unroll
        for (int ai = 0; ai < 2; ++ai)
#pragma unroll
            for (int m = 0; m < 4; ++m) { const int row = row0 + ai * HALF + m * 16; const size_t off = (size_t)row * DM + col0; float ssq = 0.f;
#pragma unroll
                for (int bj = 0; bj < 2; ++bj)
#pragma unroll
                    for (int n = 0; n < 2; ++n) { const f32x4 y = *(const f32x4*)(x + off + bj * HALF + n * 16) + acc[ai][bj][m][n];
                        *(f32x4*)(x1 + off + bj * HALF + n * 16) = y; ssq += (y[0] * y[0] + y[1] * y[1]) + (y[2] * y[2] + y[3] * y[3]);
                        const f32x4 yg = y * gv[bj][n]; half4 h; h[0] = (f16)yg[0]; h[1] = (f16)yg[1]; h[2] = (f16)yg[2]; h[3] = (f16)yg[3];
                        *(half4*)(x1h + off + bj * HALF + n * 16) = h; }
                ssq += __shfl_xor(ssq, 16); ssq += __shfl_xor(ssq, 32);
                if (fq == 0) ss2p[(size_t)(u.pn * 4 + wc) * T + row] = ssq; }
    }
};
struct EpiQ {
    static constexpr bool PERM = true, AFTER_DRAIN = false, MIDK = false;
    f16* qp;
    __device__ __forceinline__ void operator()(const f32x4 (&acc)[2][2][4][2], const Unit& u, int wr, int wc, int fr, int fq) const {
        const int row0 = u.pm * BM + wr * 64 + fr, colt = u.pn * BM;
#pragma unroll
        for (int ai = 0; ai < 2; ++ai)
#pragma unroll
            for (int m = 0; m < 4; ++m) { const int row = row0 + ai * HALF + m * 16;
#pragma unroll
                for (int bj = 0; bj < 2; ++bj) { const int c0 = colt + bj * HALF + wc * 32 + 8 * fq;
                    *(frag8*)(qp + (size_t)row * 2048 + c0) = pack8(acc[ai][bj][m][0], acc[ai][bj][m][1]); } }
    }
};

template <class Epi, class Sched, bool ALIGN_EPI = false, bool SP2 = false>
__device__ __forceinline__ void gemm_phase(PG8_LAS unsigned char* lds, const Gemm g, const Sched& S, const Epi& E) {
    const int tid = threadIdx.x, wid = __builtin_amdgcn_readfirstlane(tid >> 6), lane = tid & 63, wr = wid >> 2, wc = wid & 3, fr = lane & 15, fq = lane >> 4;
    const int K = g.K, nt = K / BK;
    unsigned voffA[2], voffB[2];
#pragma unroll
    for (int i = 0; i < 2; ++i) { int R, C; stage_rc(tid * 16 + i * 8192, R, C); const int Rb = Epi::PERM ? ((R & ~31) + perm32(R & 31)) : R;
        voffA[i] = (unsigned)(R * K + C) * 2u; voffB[i] = (unsigned)(Rb * K + C) * 2u; }
    const size_t kstep = (size_t)(BK * 2);
    const size_t hstep = (size_t)HALF * K * 2;
    const size_t tstep = 2 * hstep;
    const unsigned ldsw = (unsigned)wid * 1024u;
    const int aoff = lds_byte(wr * 64 + fr, fq * 8), boff = lds_byte(wc * 32 + fr, fq * 8);
#define PG8_SA(b, h) (((b) * 2 + (h)) * HTB)
#define PG8_SB(b, h) ((4 + (b) * 2 + (h)) * HTB)
#define PG8_STAGE(bufoff, gbase, voff) do { _Pragma("unroll") for (int _i = 0; _i < 2; ++_i) \
        __builtin_amdgcn_global_load_lds((const unsigned*)((const char*)(gbase) + (voff)[_i]), (PG8_LAS unsigned*)(lds + (bufoff) + ldsw + _i * 8192), 16, 0, 0); } while (0)
#define PG8_LDA(dst, b, h) do { _Pragma("unroll") for (int m = 0; m < 4; ++m) _Pragma("unroll") for (int k = 0; k < 2; ++k) dst[m][k] = *(const PG8_LAS frag8*)(lds + PG8_SA(b, h) + aoff + m * 2048 + k * 1024); } while (0)
#define PG8_LDB(dst, b, h) do { _Pragma("unroll") for (int n = 0; n < 2; ++n) _Pragma("unroll") for (int k = 0; k < 2; ++k) dst[n][k] = *(const PG8_LAS frag8*)(lds + PG8_SB(b, h) + boff + n * 2048 + k * 1024); } while (0)
#define PG8_MMA(ai, bj, At, Bt) do { __builtin_amdgcn_s_setprio(1); _Pragma("unroll") for (int m = 0; m < 4; ++m) _Pragma("unroll") for (int n = 0; n < 2; ++n) _Pragma("unroll") for (int k = 0; k < 2; ++k) \
        acc[ai][bj][m][n] = __builtin_amdgcn_mfma_f32_16x16x32_f16(Bt[n][k], At[m][k], acc[ai][bj][m][n], 0, 0, 0); __builtin_amdgcn_s_setprio(0); } while (0)
#define PG8_WAIT_V(n) asm volatile("s_waitcnt vmcnt(" #n ")" ::: "memory")
#define PG8_WAIT_L(n) asm volatile("s_waitcnt lgkmcnt(" #n ")" ::: "memory")
#define PG8_BAR __builtin_amdgcn_s_barrier()
#define PG8_SCHED __builtin_amdgcn_sched_barrier(0)
    Unit cur, nxt; int ui = 0;
    if (!S.next(0, cur)) return;
    f32x4 acc[2][2][4][2];
#pragma unroll
    for (int a = 0; a < 2; ++a)
#pragma unroll
        for (int b = 0; b < 2; ++b)
#pragma unroll
            for (int m = 0; m < 4; ++m)
#pragma unroll
                for (int n = 0; n < 2; ++n) acc[a][b][m][n] = (f32x4){0.f, 0.f, 0.f, 0.f};
    frag8 At[4][2], B0[2][2], B1[2][2];
    const char* cA = (const char*)g.A + (size_t)cur.pm * tstep; const char* cB = (const char*)g.Bt + (size_t)cur.pn * tstep;
    S.a_ready(cur);
    if constexpr (SP2) {
        PG8_STAGE(PG8_SB(0, 0), cB, voffB); PG8_STAGE(PG8_SB(0, 1), cB + hstep, voffB); PG8_STAGE(PG8_SA(0, 0), cA, voffA); PG8_STAGE(PG8_SA(0, 1), cA + hstep, voffA);
        if (wr == 1) PG8_BAR;
        PG8_WAIT_V(2); PG8_BAR;
        PG8_STAGE(PG8_SB(1, 0), cB + kstep, voffB); PG8_STAGE(PG8_SA(1, 0), cA + kstep, voffA); PG8_STAGE(PG8_SB(1, 1), cB + hstep + kstep, voffB);
        PG8_WAIT_V(6); PG8_BAR;
    } else {
        PG8_STAGE(PG8_SB(0, 0), cB, voffB); PG8_STAGE(PG8_SA(0, 0), cA, voffA); PG8_STAGE(PG8_SB(0, 1), cB + hstep, voffB); PG8_STAGE(PG8_SA(0, 1), cA + hstep, voffA);
        if (wr == 1) PG8_BAR;
        PG8_WAIT_V(4); PG8_BAR;
        PG8_STAGE(PG8_SB(1, 0), cB + kstep, voffB); PG8_STAGE(PG8_SA(1, 0), cA + kstep, voffA); PG8_STAGE(PG8_SB(1, 1), cB + hstep + kstep, voffB);
        PG8_WAIT_V(6); PG8_BAR;
    }
    for (;;) {
        const bool has_next = S.next(ui + 1, nxt);
        const char* nA = has_next ? (const char*)g.A + (size_t)nxt.pm * tstep : cA; const char* nB = has_next ? (const char*)g.Bt + (size_t)nxt.pn * tstep : cB;
        for (int t = 0; t < nt; t += 2) {
            const bool last = (t == nt - 2);
            if constexpr (Epi::MIDK) { if (t == (nt >> 1)) E.mid(acc, cur, wr, wc, fr, fq); }
            const char* a1 = cA + (size_t)(t + 1) * kstep;
            const char* a2 = last ? nA : cA + (size_t)(t + 2) * kstep; const char* b2 = last ? nB : cB + (size_t)(t + 2) * kstep;
            const char* a3 = a2 + kstep; const char* b3 = b2 + kstep;
            if (last && has_next) S.a_ready(nxt);
            if constexpr (SP2) {
            PG8_LDB(B0, 0, 0); PG8_LDB(B1, 0, 1); PG8_SCHED; PG8_LDA(At, 0, 0); PG8_STAGE(PG8_SA(1, 1), a1 + hstep, voffA);
            PG8_WAIT_V(8); PG8_WAIT_L(0); PG8_BAR; PG8_MMA(0, 0, At, B0); PG8_MMA(0, 1, At, B1); PG8_BAR; PG8_SCHED;
            PG8_LDA(At, 0, 1); PG8_STAGE(PG8_SB(0, 0), b2, voffB); PG8_STAGE(PG8_SB(0, 1), b2 + hstep, voffB); PG8_STAGE(PG8_SA(0, 0), a2, voffA);
            PG8_WAIT_V(8); PG8_WAIT_L(0); PG8_BAR; PG8_MMA(1, 0, At, B0); PG8_MMA(1, 1, At, B1); PG8_BAR; PG8_SCHED;
            PG8_LDB(B0, 1, 0); PG8_LDB(B1, 1, 1); PG8_SCHED; PG8_LDA(At, 1, 0); PG8_STAGE(PG8_SA(0, 1), a2 + hstep, voffA);
            PG8_WAIT_V(8); PG8_WAIT_L(0); PG8_BAR; PG8_MMA(0, 0, At, B0); PG8_MMA(0, 1, At, B1); PG8_BAR; PG8_SCHED;
            PG8_LDA(At, 1, 1); PG8_STAGE(PG8_SB(1, 0), b3, voffB); PG8_STAGE(PG8_SB(1, 1), b3 + hstep, voffB); PG8_STAGE(PG8_SA(1, 0), a3, voffA);
            PG8_WAIT_V(8); PG8_WAIT_L(0); PG8_BAR; PG8_MMA(1, 0, At, B0); PG8_MMA(1, 1, At, B1); PG8_BAR; PG8_SCHED;
            } else {
            PG8_LDB(B0, 0, 0); PG8_SCHED; PG8_LDA(At, 0, 0); PG8_STAGE(PG8_SA(1, 1), a1 + hstep, voffA);
            PG8_WAIT_L(8); PG8_BAR; PG8_WAIT_L(0); PG8_MMA(0, 0, At, B0); PG8_BAR; PG8_SCHED;
            PG8_LDB(B1, 0, 1); PG8_STAGE(PG8_SB(0, 0), b2, voffB);
            PG8_BAR; PG8_WAIT_L(0); PG8_MMA(0, 1, At, B1); PG8_BAR;
            PG8_LDA(At, 0, 1); PG8_STAGE(PG8_SA(0, 0), a2, voffA);
            PG8_BAR; PG8_WAIT_L(0); PG8_MMA(1, 0, At, B0); PG8_BAR; PG8_SCHED;
            PG8_STAGE(PG8_SB(0, 1), b2 + hstep, voffB);
            PG8_WAIT_V(6); PG8_BAR; PG8_MMA(1, 1, At, B1); PG8_BAR;
            PG8_LDB(B0, 1, 0); PG8_SCHED; PG8_LDA(At, 1, 0); PG8_STAGE(PG8_SA(0, 1), a2 + hstep, voffA);
            PG8_WAIT_L(8); PG8_BAR; PG8_WAIT_L(0); PG8_MMA(0, 0, At, B0); PG8_BAR; PG8_SCHED;
            PG8_LDB(B1, 1, 1); PG8_STAGE(PG8_SB(1, 0), b3, voffB);
            PG8_BAR; PG8_WAIT_L(0); PG8_MMA(0, 1, At, B1); PG8_BAR;
            PG8_LDA(At, 1, 1); PG8_STAGE(PG8_SA(1, 0), a3, voffA);
            PG8_BAR; PG8_WAIT_L(0); PG8_MMA(1, 0, At, B0); PG8_BAR; PG8_SCHED;
            PG8_STAGE(PG8_SB(1, 1), b3 + hstep, voffB);
            PG8_WAIT_V(6); PG8_BAR; PG8_MMA(1, 1, At, B1); PG8_BAR;
            }
        }
        if constexpr (ALIGN_EPI) { if (wr == 0) PG8_BAR; }
        if constexpr (!Epi::AFTER_DRAIN) { E(acc, cur, wr, wc, fr, fq); S.done(cur); }
        if (!has_next) break;
#pragma unroll
        for (int a = 0; a < 2; ++a)
#pragma unroll
            for (int b = 0; b < 2; ++b)
#pragma unroll
                for (int m = 0; m < 4; ++m)
#pragma unroll
                    for (int n = 0; n < 2; ++n) acc[a][b][m][n] = (f32x4){0.f, 0.f, 0.f, 0.f};
        cur = nxt; cA = nA; cB = nB; ++ui;
        if constexpr (ALIGN_EPI) { if (wr == 1) PG8_BAR; }
    }
    PG8_WAIT_V(0);
    if constexpr (!ALIGN_EPI) { if (wr == 0) PG8_BAR; }
    PG8_BAR;
    if constexpr (Epi::AFTER_DRAIN) { E.fused(acc, cur, wr, wc, fr, fq, lds, wid, lane); S.done(cur); }
#undef PG8_SA
#undef PG8_SB
#undef PG8_STAGE
#undef PG8_LDA
#undef PG8_LDB
#undef PG8_MMA
#undef PG8_WAIT_V
#undef PG8_WAIT_L
#undef PG8_BAR
#undef PG8_SCHED
}
}

#define XB_TMO      128
#define XB_XCNT(j)  (256  + 64 * (j))
#define XB_XSUB(j)  (1280 + 64 * (j))
#define XB_XGEN(j)  (2304 + 64 * (j))
#define XB_TOP      3328
#define XB_TOPGEN   3392
#define XCD_BAR_WORDS 3456
#define XB_SPIN_CAP (1u << 18)

__device__ __forceinline__ unsigned xb_ld(unsigned* p)              { return __hip_atomic_load(p, __ATOMIC_RELAXED, __HIP_MEMORY_SCOPE_AGENT); }
__device__ __forceinline__ unsigned xb_add(unsigned* p, unsigned v) { return __hip_atomic_fetch_add(p, v, __ATOMIC_RELAXED, __HIP_MEMORY_SCOPE_AGENT); }
__device__ __forceinline__ unsigned xb_xcc_id() { return (unsigned)__builtin_amdgcn_s_getreg((3 << 11) | 20) & 0xFu; }
#define XB_SPIN(cond, bar) do { unsigned _sp = 0; while (cond) { __builtin_amdgcn_s_sleep(1); \
    if ((++_sp & 255u) == 0u) { if (xb_ld(&(bar)[XB_TMO])) break; if (_sp > XB_SPIN_CAP) { atomicAdd(&(bar)[XB_TMO], 1u); break; } } } } while (0)

struct XcdBarrier {
    unsigned* bar; unsigned x;
    volatile LAS unsigned* st;
};

__device__ __forceinline__ XcdBarrier xcd_barrier_post(unsigned* bar, volatile LAS unsigned* st) {
    XcdBarrier b; b.bar = bar; b.x = xb_xcc_id(); b.st = st;
    if (threadIdx.x == 0) st[2] = xb_add(&bar[XB_XCNT(b.x)], 1u);
    return b;
}
__device__ __forceinline__ void xcd_barrier_complete(unsigned* bar, unsigned x, unsigned& nloc, unsigned& nx) {
    const unsigned G = gridDim.x * gridDim.y * gridDim.z;
    unsigned sum, cnt, mine, sp = 0u;
    for (;;) {
        sum = 0u; cnt = 0u; mine = 0u;
#pragma unroll
        for (unsigned j = 0; j < 16; ++j) { const unsigned c = xb_ld(&bar[XB_XCNT(j)]); sum += c; cnt += (c > 0u) ? 1u : 0u; mine = (j == x) ? c : mine; }
        if (sum == G) break;
        __builtin_amdgcn_s_sleep(1);
        if ((++sp & 255u) == 0u) { if (xb_ld(&bar[XB_TMO])) break; if (sp > XB_SPIN_CAP) { atomicAdd(&bar[XB_TMO], 1u); break; } }
    }
    nloc = mine > 0u ? mine : 1u; nx = cnt > 0u ? cnt : 1u;
}

__device__ __forceinline__ void xcd_barrier(const XcdBarrier& b) {
    asm volatile("s_waitcnt vmcnt(0)" ::: "memory");
    __syncthreads();
    if (threadIdx.x == 0) {
        unsigned* bar = b.bar;
        __builtin_amdgcn_s_waitcnt(0);
        unsigned nloc = b.st[0], nx = b.st[1];
        if (nloc == 0u) { xcd_barrier_complete(bar, b.x, nloc, nx); b.st[0] = nloc; b.st[1] = nx; }
        const unsigned old = xb_add(&bar[XB_XSUB(b.x)], 1u);
        const unsigned gen = old / nloc;
        if (old + 1u == (gen + 1u) * nloc) {
            __builtin_amdgcn_fence(__ATOMIC_RELEASE, "agent");
            asm volatile("s_waitcnt vmcnt(0)" ::: "memory");
            const unsigned og = xb_add(&bar[XB_TOP], 1u);
            const unsigned tg = og / nx;
            if (og + 1u == (tg + 1u) * nx) xb_add(&bar[XB_TOPGEN], 1u);
            else XB_SPIN(xb_ld(&bar[XB_TOPGEN]) == tg, bar);
            __builtin_amdgcn_fence(__ATOMIC_ACQUIRE, "agent");
            xb_add(&bar[XB_XGEN(b.x)], 1u);
            asm volatile("s_waitcnt vmcnt(0)" ::: "memory");
        } else {
            XB_SPIN(xb_ld(&bar[XB_XGEN(b.x)]) == gen, bar);
            __builtin_amdgcn_fence(__ATOMIC_ACQUIRE, "agent");
            asm volatile("s_waitcnt vmcnt(0)" ::: "memory");
        }
    }
    __syncthreads();
}


struct Args { const float* in[16]; float* out; unsigned char* ws; int ph_lo, ph_hi; };
constexpr int N_PHASES = 11;

__global__ void __launch_bounds__(NTHREADS, 2) mk_fwd(Args a) {
    extern __shared__ __attribute__((aligned(16))) unsigned char lds[];
    LAS unsigned char* L = (LAS unsigned char*)lds;
    volatile LAS unsigned* MISC = (volatile LAS unsigned*)(L + MISC_OFF);
    unsigned char* ws = a.ws;
    Ctx C;
    C.tid = threadIdx.x; C.lane = C.tid & 63; C.wave = __builtin_amdgcn_readfirstlane(C.tid >> 6);
    C.G = gridDim.x; C.gw = blockIdx.x * NWAVES + C.wave; C.ngw = C.G * NWAVES; C.gt = blockIdx.x * NTHREADS + C.tid; C.ngt = C.G * NTHREADS;
    for (int u = C.tid; u < (LDS_BYTES - LDSCTL_OFF) / 4; u += NTHREADS) ((LAS unsigned*)(L + LDSCTL_OFF))[u] = 0u;
    __syncthreads();
    const int lo = a.ph_lo, hi = a.ph_hi, G = C.G;
    const bool multi = (hi - lo) > 1;
    XcdBarrier bar; bar.bar = (unsigned*)(ws + WS_CTL) + CW_BAR; bar.x = 0; bar.st = nullptr;
    if (multi) bar = xcd_barrier_post((unsigned*)(ws + WS_CTL) + CW_BAR, MISC + 8);
#define IN(k) (lo <= (k) && (k) < hi)
#define SEAM(k) do { if (IN(k) && IN((k) + 1)) xcd_barrier(bar); } while (0)

#define REPS(k) for (int rep_ = 0; rep_ < ((PROBE_DUP == (k)) ? 2 : 1); ++rep_)
#define REPBAR(k) do { if (PROBE_DUP == (k) && rep_ == 0) xcd_barrier(bar); } while (0)
    if (IN(0)) REPS(0) { ph_prep(C, L, a.in, ws); REPBAR(0); }
    SEAM(0);
    if (IN(1)) REPS(1) {
        pg8::Gemm g{(const f16*)(ws + WS_XH), (const f16*)(ws + WS_WCAT), T, NCAT, DM}; pg8::StaticOrder S; S.init(T, NCAT, G, (int)blockIdx.x);
        pg8::EpiP1 E{(const float*)(ws + WS_RS1), a.in[8], (f16*)(ws + WS_QKVU), (f16*)(ws + WS_GATES), (f16*)(ws + WS_VT)};
        pg8::gemm_phase<pg8::EpiP1, pg8::StaticOrder, true, true>(L, g, S, E);
        REPBAR(1);
    }
    SEAM(1);
    if (IN(2)) REPS(2) {
        ph_attn_pool(C, L, (const f16*)(ws + WS_QKVU), (const f16*)(ws + WS_VT), a.in[3], (const f16*)(ws + WS_POOLW), a.in[5], (f16*)(ws + WS_OCAT));
        REPBAR(2);
    }
    if (IN(2) && IN(4)) xcd_barrier(bar);
    if (IN(4)) REPS(4) {
        pg8::Gemm g{(const f16*)(ws + WS_OCAT), (const f16*)(ws + WS_WB), T, DM, DM}; pg8::StaticOrder S; S.init(T, DM, G, (int)blockIdx.x);
        pg8::EpiMerged E{(const f16*)(ws + WS_GATES), (f16*)(ws + WS_MERGED)};
        pg8::gemm_phase<pg8::EpiMerged, pg8::StaticOrder, true, true>(L, g, S, E);
        REPBAR(4);
    }
    SEAM(4);
    if (IN(5)) REPS(5) {
        pg8::Gemm g{(const f16*)(ws + WS_MERGED), (const f16*)(ws + WS_WOUT), T, DM, DM}; pg8::StaticOrder S; S.init(T, DM, G, (int)blockIdx.x);
        pg8::EpiOut E{a.in[0], a.in[10], a.out, (f16*)(ws + WS_X1H), (float*)(ws + WS_SS2)};
        pg8::gemm_phase<pg8::EpiOut, pg8::StaticOrder, true, true>(L, g, S, E);
        REPBAR(5);
    }
    SEAM(5);
    if (IN(6)) REPS(6) {
        pg8::Gemm g{(const f16*)(ws + WS_X1H), (const f16*)(ws + WS_WQ), T, 2048, DM}; pg8::StaticOrder S; S.init(T, 2048, G, (int)blockIdx.x);
        pg8::EpiQ E{(f16*)(ws + WS_QP)};
        pg8::gemm_phase<pg8::EpiQ, pg8::StaticOrder, true, true>(L, g, S, E);
        REPBAR(6);
    }
    SEAM(6);
    if (IN(7)) REPS(7) {
        auto side = [&]() {
            ph_h2quant(C, (const f16*)(ws + WS_X1H), (const float*)(ws + WS_SS2), (unsigned*)(ws + WS_H2Q), (float*)(ws + WS_HSC));
            quant_rows<false>(C, a.in[13], (unsigned*)(ws + WS_UQ), (float*)(ws + WS_US));
            quant_rows<false>(C, a.in[14], (unsigned*)(ws + WS_VQ), (float*)(ws + WS_VS));
        };
        ph_route(C, L, (const f16*)(ws + WS_QP), (const float*)(ws + WS_SS2), (const f16*)(ws + WS_SUBK), (int*)(ws + WS_EIDX), (float*)(ws + WS_EGATE), side);
        if (!(C.wave & 4)) side();
        REPBAR(7); }
    SEAM(7);
    if (IN(8)) REPS(8) {
        const Slicing SL = get_slicing((const unsigned*)(ws + WS_CTL) + CW_BAR, MISC);
        if (PROBE_DUP == 8 && rep_ == 0) ph_upeer<255>(C, L, SL, (const unsigned*)(ws + WS_H2Q), (const int*)(ws + WS_EIDX), (const unsigned char*)(ws + WS_UQ), (short*)(ws + WS_PDOT));
        else ph_upeer<16383>(C, L, SL, (const unsigned*)(ws + WS_H2Q), (const int*)(ws + WS_EIDX), (const unsigned char*)(ws + WS_UQ), (short*)(ws + WS_PDOT));
        REPBAR(8);
    }
    SEAM(8);
    if (IN(9)) {
        ph_ureduce(C, L, (const short*)(ws + WS_PDOT), (const float*)(ws + WS_HSC), (const int*)(ws + WS_EIDX), (const float*)(ws + WS_US), (const float*)(ws + WS_VS), (const float*)(ws + WS_EGATE),
                   (unsigned*)(ws + WS_WQP), (float*)(ws + WS_WSC));
        xcd_barrier(bar);
        const Slicing SL = get_slicing((const unsigned*)(ws + WS_CTL) + CW_BAR, MISC);
        if (PROBE_DUP == 9) {
            ph_vpeer<255>(C, SL, (const int*)(ws + WS_EIDX), (const unsigned*)(ws + WS_WQP), (const float*)(ws + WS_WSC), (const unsigned char*)(ws + WS_VQ), a.out, (float*)(ws + WS_QP), (float*)(ws + WS_MERGED));
            xcd_barrier(bar);
        }
        if (PROBE_DUP == 19) {
            ph_vpeer<16383>(C, SL, (const int*)(ws + WS_EIDX), (const unsigned*)(ws + WS_WQP), (const float*)(ws + WS_WSC), (const unsigned char*)(ws + WS_VQ), a.out, (float*)(ws + WS_QP), (float*)(ws + WS_MERGED));
            xcd_barrier(bar);
        }
        ph_vpeer<16383>(C, SL, (const int*)(ws + WS_EIDX), (const unsigned*)(ws + WS_WQP), (const float*)(ws + WS_WSC), (const unsigned char*)(ws + WS_VQ), a.out, a.out, (float*)(ws + WS_SSF));
    }
    SEAM(9);
    if (IN(10)) { ph_final(C, (const float*)(ws + WS_SSF), a.out, a.in[15]); }
#undef IN
#undef SEAM
}

#ifndef MK_N_LAUNCHES
#define MK_N_LAUNCHES 1
#endif
extern "C" void kernel_launch(void* const* d_in, const int* in_sizes, int n_in, void* d_out, int out_size, void* d_ws, size_t ws_size, hipStream_t stream) {
    static int grid = 0;
    if (grid == 0) {
        if (n_in != 16 || in_sizes[0] != T * DM || out_size != T * DM || ws_size < WS_END) {
            fprintf(stderr, "kernel_launch: unexpected shapes (n_in %d in0 %d out %d ws %zu)\n", n_in, n_in > 0 ? in_sizes[0] : -1, out_size, ws_size);
            grid = -1; return;
        }
        int dev = 0, cus = 0;
        if (hipGetDevice(&dev) != hipSuccess || hipDeviceGetAttribute(&cus, hipDeviceAttributeMultiprocessorCount, dev) != hipSuccess) { grid = -1; return; }
        if (hipFuncSetAttribute((const void*)mk_fwd, hipFuncAttributeMaxDynamicSharedMemorySize, LDS_BYTES) != hipSuccess) { fprintf(stderr, "kernel_launch: hipFuncSetAttribute failed\n"); grid = -1; return; }
        int per_cu = 0;
        if (hipOccupancyMaxActiveBlocksPerMultiprocessor(&per_cu, (const void*)mk_fwd, NTHREADS, LDS_BYTES) != hipSuccess || per_cu < 1)
            fprintf(stderr, "kernel_launch: occupancy query reports %d workgroups per CU\n", per_cu);
        (void)hipGetLastError();
        grid = cus;
    }
    if (grid < 0) return;
    (void)hipMemsetAsync((char*)d_ws + WS_CTL, 0, CTL_ZERO_BYTES, stream);
    Args a{};
    for (int i = 0; i < 16; ++i) a.in[i] = (const float*)d_in[i];
    a.out = (float*)d_out; a.ws = (unsigned char*)d_ws;
    if (MK_N_LAUNCHES == 1) {
        a.ph_lo = 0; a.ph_hi = N_PHASES;
        hipLaunchKernelGGL(mk_fwd, dim3(grid), dim3(NTHREADS), LDS_BYTES, stream, a);
    } else {
        for (int p = 0; p < N_PHASES; ++p) { a.ph_lo = p; a.ph_hi = p + 1; hipLaunchKernelGGL(mk_fwd, dim3(grid), dim3(NTHREADS), LDS_BYTES, stream, a); }
    }
}
```

```cpp
#include <hip/hip_runtime.h>
#include <cstdint>
#include <cstdio>

typedef _Float16 f16;
typedef _Float16 half8 __attribute__((ext_vector_type(8)));
typedef _Float16 half4 __attribute__((ext_vector_type(4)));
typedef _Float16 half2 __attribute__((ext_vector_type(2)));
typedef float f32x4 __attribute__((ext_vector_type(4)));
typedef float f32x16 __attribute__((ext_vector_type(16)));
#define LAS __attribute__((address_space(3)))
#ifndef PROBE_DIAG
#define PROBE_DIAG (0)
#endif
#ifndef PROBE_DUP
#define PROBE_DUP (-1)
#endif
#define GAS __attribute__((address_space(1)))

constexpr int DM = 1024, BATCH = 16, SEQ = 2048, T = BATCH * SEQ;
constexpr int NQKVU = 1280, NGATE = 2048, NCAT = NQKVU + NGATE;
constexpr int COL_K = 512, COL_V = 640, COL_U = 768;
constexpr int NEXP = 16384, PEER_H = 8, TOPK = 16;
constexpr float EPS = 1e-6f;
constexpr int NWAVES = 8, NTHREADS = NWAVES * 64;

constexpr size_t MiB = 1u << 20;
constexpr size_t WS_CTL = 0, CTL_ZERO_BYTES = 64 * 1024;
constexpr size_t WS_WCAT = 1 * MiB;
constexpr size_t WS_WB = 8 * MiB;
constexpr size_t WS_WOUT = 10 * MiB;
constexpr size_t WS_WQ = 12 * MiB;
constexpr size_t WS_POOLW = 16 * MiB;
constexpr size_t WS_SUBK = 16 * MiB + 512 * 1024;
constexpr size_t WS_RS1 = 17 * MiB;
constexpr size_t WS_EIDX = 18 * MiB;
constexpr size_t WS_EGATE = 34 * MiB;
constexpr size_t WS_UTAB = 50 * MiB;
constexpr size_t WS_VTAB = 82 * MiB;
constexpr size_t WS_XH = 114 * MiB;
constexpr size_t WS_MERGED = WS_XH;
constexpr size_t WS_QKVU = 178 * MiB;
constexpr size_t WS_X1H = WS_QKVU;
constexpr size_t WS_GATES = 258 * MiB;
constexpr size_t WS_QP = WS_GATES;
constexpr size_t WS_OCAT = 386 * MiB;
constexpr size_t WS_UQ = 450 * MiB;
constexpr size_t WS_VQ = 466 * MiB;
constexpr size_t WS_US = 17 * MiB + 256 * 1024, WS_VS = 17 * MiB + 512 * 1024;
constexpr size_t WS_PDOT = WS_GATES;
constexpr size_t WS_H2Q = 404 * MiB;
constexpr size_t WS_HSC = 403 * MiB;
constexpr size_t WS_SSF = 402 * MiB;
constexpr size_t WS_WQP = 386 * MiB;
constexpr size_t WS_WSC = 390 * MiB;
constexpr size_t WS_ACT = 386 * MiB;
constexpr size_t WS_SS2 = 482 * MiB;
constexpr size_t WS_VT = 484 * MiB;
constexpr size_t WS_END = 492 * MiB;
constexpr int CW_BAR = 4096;

constexpr int RING_OFF = 0, RING_BYTES = 131072;
constexpr int LDSCTL_OFF = RING_BYTES, MISC_OFF = LDSCTL_OFF + 320;
constexpr int LDS_BYTES = 147456;

#define LDS_WAIT() asm volatile("s_waitcnt lgkmcnt(0)" ::: "memory")
template <int CTRL> __device__ __forceinline__ float dppf(float x) { return __uint_as_float(__builtin_amdgcn_update_dpp(0u, __float_as_uint(x), CTRL, 0xf, 0xf, false)); }
template <int CTRL> __device__ __forceinline__ int dppi(int x) { return (int)__builtin_amdgcn_update_dpp(0u, (unsigned)x, CTRL, 0xf, 0xf, false); }
__device__ __forceinline__ float bfly32(float a, float b) { auto r = __builtin_amdgcn_permlane32_swap(__float_as_uint(a), __float_as_uint(b), false, false); return __uint_as_float(r[0]) + __uint_as_float(r[1]); }
__device__ __forceinline__ float bfly16(float a, float b) { auto r = __builtin_amdgcn_permlane16_swap(__float_as_uint(a), __float_as_uint(b), false, false); return __uint_as_float(r[0]) + __uint_as_float(r[1]); }
__device__ __forceinline__ int bfly32i(int a, int b) { auto r = __builtin_amdgcn_permlane32_swap((unsigned)a, (unsigned)b, false, false); return (int)(r[0] + r[1]); }
__device__ __forceinline__ int bfly16i(int a, int b) { auto r = __builtin_amdgcn_permlane16_swap((unsigned)a, (unsigned)b, false, false); return (int)(r[0] + r[1]); }
__device__ __forceinline__ float wave_sum(float x) {
    x += dppf<0x121>(x); x += dppf<0x122>(x); x += dppf<0x124>(x); x += dppf<0x128>(x);
    x = bfly16(x, x); return bfly32(x, x);
}
__device__ __forceinline__ int wave_sum_i(int x) {
    x += dppi<0x121>(x); x += dppi<0x122>(x); x += dppi<0x124>(x); x += dppi<0x128>(x);
    x = bfly16i(x, x); return bfly32i(x, x);
}
__device__ __forceinline__ float wave_max(float x) {
    x = fmaxf(x, dppf<0x121>(x)); x = fmaxf(x, dppf<0x122>(x)); x = fmaxf(x, dppf<0x124>(x)); x = fmaxf(x, dppf<0x128>(x));
    { auto r = __builtin_amdgcn_permlane16_swap(__float_as_uint(x), __float_as_uint(x), false, false); x = fmaxf(__uint_as_float(r[0]), __uint_as_float(r[1])); }
    { auto r = __builtin_amdgcn_permlane32_swap(__float_as_uint(x), __float_as_uint(x), false, false); x = fmaxf(__uint_as_float(r[0]), __uint_as_float(r[1])); }
    return x;
}
__device__ __forceinline__ float gelu_exact(float x) { return 0.5f * x * (1.0f + erff(x * 0.70710678118654752f)); }
__device__ __forceinline__ float rs_from_ss(const float* ss, int t) {
    float s = 0.f;
#pragma unroll
    for (int i = 0; i < 16; ++i) s += ss[(size_t)i * T + t];
    return rsqrtf(s * (1.0f / DM) + EPS);
}

struct Ctx {
    int tid, lane, wave;
    int G;
    int gw, ngw;
    int gt, ngt;
};

__device__ __forceinline__ int pack4_i8(float a, float b, float c, float d) {
    const int ia = (int)rintf(a), ib = (int)rintf(b), ic = (int)rintf(c), id = (int)rintf(d);
    return (ia & 0xff) | ((ib & 0xff) << 8) | ((ic & 0xff) << 16) | (id << 24);
}
template <bool OFFS>
__device__ __forceinline__ void quant_rows(const Ctx& C, const float* __restrict__ tab, unsigned* __restrict__ q, float* __restrict__ scale) {
    const int lane = C.lane;
    for (int r = C.gw; r < NEXP; r += C.ngw) {
        const float* row = tab + (size_t)r * DM;
        f32x4 v[4]; float m = 0.f;
#pragma unroll
        for (int j = 0; j < 4; ++j) { v[j] = *(const f32x4*)(row + j * 256 + lane * 4); m = fmaxf(m, fmaxf(fmaxf(fabsf(v[j][0]), fabsf(v[j][1])), fmaxf(fabsf(v[j][2]), fabsf(v[j][3])))); }
        m = wave_max(m);
        const float inv = m > 0.f ? 127.0f / m : 0.f;
#pragma unroll
        for (int j = 0; j < 4; ++j) {
            unsigned w = (unsigned)pack4_i8(v[j][0] * inv, v[j][1] * inv, v[j][2] * inv, v[j][3] * inv);
            if (OFFS) w ^= 0x80808080u;
            { const int dw = j * 64 + lane; q[(size_t)(dw >> 5) * (NEXP * 32) + (size_t)r * 32 + (dw & 31)] = w; }
        }
        if (lane == 0) scale[r] = m * (1.0f / 127.0f);
    }
}

__device__ __forceinline__ void p0_transpose_item(const float* W, int K, int N, f16* WT, int ldo, int koff, LAS float* scr, int item, int lane) {
    const int nblk = N / 32, kb = item / nblk, nb = item % nblk, k0 = 64 * kb, n0 = 32 * nb;
#pragma unroll 8
    for (int i = 0; i < 32; ++i) { const int kk = 2 * i + (lane >> 5); scr[kk * 33 + (lane & 31)] = W[(size_t)(k0 + kk) * N + n0 + (lane & 31)]; }
    LDS_WAIT(); asm volatile("" ::: "memory");
    const int c = lane & 7;
#pragma unroll
    for (int j = 0; j < 4; ++j) { const int n = (lane >> 3) + 8 * j; const LAS float* s = scr + (8 * c) * 33 + n;
        half8 o;
#pragma unroll
        for (int i = 0; i < 8; ++i) o[i] = (f16)s[i * 33];
        *(half8*)(WT + (size_t)(n0 + n) * ldo + koff + k0 + 8 * c) = o; }
    LDS_WAIT(); asm volatile("" ::: "memory");
}
__device__ __forceinline__ void cvt_stream(const Ctx& C, const float* in, f16* out, size_t n4) {
    for (size_t i = (size_t)C.gt; i < n4; i += (size_t)C.ngt) {
        const f32x4 v = ((const f32x4*)in)[i];
        half4 h; h[0] = (f16)v[0]; h[1] = (f16)v[1]; h[2] = (f16)v[2]; h[3] = (f16)v[3];
        ((half4*)out)[i] = h;
    }
}
__device__ __forceinline__ void rowprep(const Ctx& C, const float* x, const float* g, f16* xh, float* ss) {
    const int lane = C.lane;
    f32x4 gg[4];
#pragma unroll
    for (int j = 0; j < 4; ++j) gg[j] = *(const f32x4*)(g + j * 256 + lane * 4);
    for (int tb = C.gw * 4; tb < T; tb += C.ngw * 4) {
        f32x4 v[4][4];
#pragma unroll
        for (int u = 0; u < 4; ++u)
#pragma unroll
            for (int j = 0; j < 4; ++j) v[u][j] = *(const f32x4*)(x + (size_t)(tb + u) * DM + j * 256 + lane * 4);
#pragma unroll
        for (int u = 0; u < 4; ++u) {
            float s = 0.f;
#pragma unroll
            for (int j = 0; j < 4; ++j) {
                const f32x4 w = v[u][j];
                s += w[0] * w[0] + w[1] * w[1] + w[2] * w[2] + w[3] * w[3];
                half4 h; h[0] = (f16)(w[0] * gg[j][0]); h[1] = (f16)(w[1] * gg[j][1]); h[2] = (f16)(w[2] * gg[j][2]); h[3] = (f16)(w[3] * gg[j][3]);
                *(half4*)(xh + (size_t)(tb + u) * DM + j * 256 + lane * 4) = h;
            }
            s = wave_sum(s);
            if (lane == 0) ss[tb + u] = s;
        }
    }
}
__device__ __forceinline__ void ph_prep(const Ctx& C, LAS unsigned char* lds, const float* const* in, unsigned char* ws) {
    LAS float* scr = (LAS float*)(lds + RING_OFF + C.wave * 16384);
    f16* wcat = (f16*)(ws + WS_WCAT); f16* wb = (f16*)(ws + WS_WB); f16* wout = (f16*)(ws + WS_WOUT); f16* wq = (f16*)(ws + WS_WQ); f16* poolw = (f16*)(ws + WS_POOLW);
    constexpr int I_IN = 16 * 40, I_G = 16 * 64, I_B = 8 * 32, I_O = 16 * 32, I_Q = 16 * 64, I_P = 2 * 4;
    constexpr int NITEMS = I_IN + I_G + 2 * I_B + I_O + I_Q + 4 * I_P;
    for (int it = C.gw; it < NITEMS; it += C.ngw) {
        int r = it;
        if (r < I_IN) { p0_transpose_item(in[2], 1024, 1280, wcat, 1024, 0, scr, r, C.lane); continue; } r -= I_IN;
        if (r < I_G) { p0_transpose_item(in[7], 1024, 2048, wcat + (size_t)NQKVU * 1024, 1024, 0, scr, r, C.lane); continue; } r -= I_G;
        if (r < I_B) { p0_transpose_item(in[6], 512, 1024, wb, 1024, 0, scr, r, C.lane); continue; } r -= I_B;
        if (r < I_B) { p0_transpose_item(in[6] + 512 * 1024, 512, 1024, wb, 1024, 512, scr, r, C.lane); continue; } r -= I_B;
        if (r < I_O) { p0_transpose_item(in[9], 1024, 1024, wout, 1024, 0, scr, r, C.lane); continue; } r -= I_O;
        if (r < I_Q) { p0_transpose_item(in[11], 1024, 2048, wq, 1024, 0, scr, r, C.lane); continue; } r -= I_Q;
        { const int g = r / I_P; p0_transpose_item(in[4] + g * 128 * 128, 128, 128, poolw + g * 128 * 128, 128, 0, scr, r % I_P, C.lane); }
    }
    cvt_stream(C, in[12], (f16*)(ws + WS_SUBK), (size_t)8 * 2 * 128 * 128 / 4);
    rowprep(C, in[0], in[1], (f16*)(ws + WS_XH), (float*)(ws + WS_RS1));
}

__device__ __forceinline__ void ph_attn_naive(const Ctx& C, const f16* __restrict__ qkvu, const float* __restrict__ sink, f16* __restrict__ ocat) {
    for (int gid = C.gt; gid < T * 8; gid += C.ngt) {
        const int t = gid % T, h = gid / T;
        const int b = t / SEQ, ts = t % SEQ, kh = h >> 2;
        float q[64], o[64];
        const f16* qr = qkvu + (size_t)t * NQKVU + h * 64;
#pragma unroll
        for (int d = 0; d < 64; ++d) { q[d] = (float)qr[d]; o[d] = 0.f; }
        const float slope = exp2f(-(float)(h + 1));
        float m = -1e30f, l = 0.f;
        const int s0 = max(ts - 128, 0), s1 = min(ts + 128, SEQ - 1);
        for (int s = s0; s <= s1; ++s) {
            const f16* kr = qkvu + (size_t)(b * SEQ + s) * NQKVU + COL_K + kh * 64;
            const f16* vr = qkvu + (size_t)(b * SEQ + s) * NQKVU + COL_V + kh * 64;
            float dot = 0.f;
#pragma unroll
            for (int d = 0; d < 64; ++d) dot += q[d] * (float)kr[d];
            const float lg = dot * 0.125f - slope * fabsf((float)(ts - s));
            const float mn = fmaxf(m, lg), al = __expf(m - mn), p = __expf(lg - mn);
            l = l * al + p;
#pragma unroll
            for (int d = 0; d < 64; ++d) o[d] = o[d] * al + p * (float)vr[d];
            m = mn;
        }
        const float sk = sink[h];
        const float mn = fmaxf(m, sk), al = __expf(m - mn);
        l = l * al + __expf(sk - mn);
        const float inv = al / l;
        f16* orow = ocat + (size_t)t * DM + h * 64;
#pragma unroll
        for (int d = 0; d < 64; ++d) orow[d] = (f16)(o[d] * inv);
    }
}

template <int DIAG = 0>
__device__ __forceinline__ void attn_unit(const Ctx& C, int u, LAS unsigned char* lds, const f16* __restrict__ qkvu, const f16* __restrict__ vT, const float* __restrict__ sink, f16* __restrict__ ocat) {
    const int lane = C.lane, r32 = lane & 31, hh = lane >> 5;
    const int krow = (r32 & 19) | ((r32 & 4) << 1) | ((r32 & 8) >> 1);
    constexpr float L2E = 1.4426950408889634f;
    {
        const int qs = u & 63, h = (u >> 6) & 7, b = u >> 9, kh = h >> 2;
        const int tq = qs * 32 + r32;
        const float slope2 = exp2f(-(float)(h + 1)) * L2E, sink2 = sink[h] * L2E;
        const f16* qrow = qkvu + (size_t)(b * SEQ + tq) * NQKVU + h * 64 + 8 * hh;
        half8 bq[4];
#pragma unroll
        for (int ks = 0; ks < 4; ++ks) bq[ks] = *(const half8*)(qrow + 16 * ks);
        f32x16 o0, o1;
#pragma unroll
        for (int r = 0; r < 16; ++r) { o0[r] = 0.f; o1[r] = 0.f; }
        float m = -1e30f, l = 0.f;
        const int kb_lo = max(qs - 4, 0), kb_hi = min(qs + 4, 63);
        LAS unsigned char* kst = lds + 65536 + C.wave * 8192; LAS unsigned char* vst = kst + 4096;
        const int krw = lane >> 3, kch = lane & 7, vrw = lane >> 2, vch = lane & 3;
        const f16* kg = qkvu + (size_t)(b * SEQ + krw) * NQKVU + COL_K + kh * 64 + kch * 8;
        const f16* vg = vT + (size_t)((b * 2 + kh) * 64 + vrw) * SEQ + vch * 8;
        half8 gk[4], gv[4];
#pragma unroll
        for (int i = 0; i < 4; ++i) { gk[i] = *(const half8*)(kg + (size_t)(kb_lo * 32 + 8 * i) * NQKVU); gv[i] = *(const half8*)(vg + (size_t)(16 * i) * SEQ + kb_lo * 32); }
#pragma unroll 1
        for (int kb = kb_lo; kb <= kb_hi; ++kb) {
#pragma unroll
            for (int i = 0; i < 4; ++i) {
                const int kr = krw + 8 * i; *(LAS half8*)(kst + kr * 128 + ((kch ^ (kr & 7)) << 4)) = gk[i];
                const int vr = vrw + 16 * i; *(LAS half8*)(vst + vr * 64 + ((vch ^ ((vr >> 2) & 3)) << 4)) = gv[i];
            }
            LDS_WAIT();
            half8 kf[4], va[2][2];
#pragma unroll
            for (int ks = 0; ks < 4; ++ks) kf[ks] = *(const LAS half8*)(kst + krow * 128 + (((2 * ks + hh) ^ (krow & 7)) << 4));
#pragma unroll
            for (int db = 0; db < 2; ++db)
#pragma unroll
                for (int st = 0; st < 2; ++st) { const int d = db * 32 + r32; va[db][st] = *(const LAS half8*)(vst + d * 64 + (((2 * st + hh) ^ ((d >> 2) & 3)) << 4)); }
            LDS_WAIT();
            const int kn = (DIAG == 2) ? kb_lo : (kb < kb_hi ? kb + 1 : kb);
#pragma unroll
            for (int i = 0; i < 4; ++i) { gk[i] = *(const half8*)(kg + (size_t)(kn * 32 + 8 * i) * NQKVU); gv[i] = *(const half8*)(vg + (size_t)(16 * i) * SEQ + kn * 32); }
            f32x16 s;
#pragma unroll
            for (int r = 0; r < 16; ++r) s[r] = 0.f;
#pragma unroll
            for (int ks = 0; ks < 4; ++ks) s = __builtin_amdgcn_mfma_f32_32x32x16_f16(kf[ks], bq[ks], s, 0, 0, 0);
            float bmax = -1e30f; bool ok[16];
#pragma unroll
            for (int r = 0; r < 16; ++r) {
                const int tk = kb * 32 + 16 * (r >> 3) + 8 * hh + (r & 7);
                const int dist = abs(tq - tk);
                ok[r] = dist <= 128;
                s[r] = ok[r] ? s[r] * (0.125f * L2E) - slope2 * (float)dist : -1e30f;
                bmax = fmaxf(bmax, s[r]);
            }
            bmax = fmaxf(bmax, __shfl_xor(bmax, 32));
            const float mn = fmaxf(m, bmax), al = exp2f(m - mn);
            m = mn;
            float ps = 0.f; half8 pb[2];
#pragma unroll
            for (int r = 0; r < 16; ++r) { const float p = ok[r] ? (DIAG == 1 ? (s[r] - mn) : exp2f(s[r] - mn)) : 0.f; ps += p; pb[r >> 3][r & 7] = (f16)p; }
            l = l * al + ps;
#pragma unroll
            for (int r = 0; r < 16; ++r) { o0[r] *= al; o1[r] *= al; }
#pragma unroll
            for (int st = 0; st < 2; ++st) { o0 = __builtin_amdgcn_mfma_f32_32x32x16_f16(va[0][st], pb[st], o0, 0, 0, 0); o1 = __builtin_amdgcn_mfma_f32_32x32x16_f16(va[1][st], pb[st], o1, 0, 0, 0); }
        }
        l += __shfl_xor(l, 32);
        const float mf = fmaxf(m, sink2), al = exp2f(m - mf);
        const float sc = al / (l * al + exp2f(sink2 - mf));
        f16* orow = ocat + (size_t)(b * SEQ + tq) * DM + h * 64 + 4 * hh;
#pragma unroll
        for (int g = 0; g < 4; ++g) {
            half4 a, c;
#pragma unroll
            for (int i = 0; i < 4; ++i) { a[i] = (f16)(o0[4 * g + i] * sc); c[i] = (f16)(o1[4 * g + i] * sc); }
            *(half4*)(orow + 8 * g) = a; *(half4*)(orow + 32 + 8 * g) = c;
        }
    }
}

__device__ __forceinline__ void ph_pool_naive(const Ctx& C, const f16* __restrict__ qkvu, f16* __restrict__ mixed) {
    for (size_t gid = (size_t)C.gt; gid < (size_t)T * 512; gid += (size_t)C.ngt) {
        const int c = (int)(gid & 511), t = (int)(gid >> 9);
        const int b = t / SEQ, ts = t % SEQ, g = c >> 7, w = 2 << g;
        const int lo = max(ts - w / 2, 0), hi = min(ts + w / 2, SEQ);
        float s = 0.f;
        for (int i = lo; i < hi; ++i) s += (float)qkvu[(size_t)(b * SEQ + i) * NQKVU + COL_U + c];
        const float mean = s / (float)(hi - lo);
        mixed[(size_t)t * 512 + c] = (f16)(mean - (float)qkvu[(size_t)t * NQKVU + COL_U + c]);
    }
}
__device__ __forceinline__ void ph_poolmm_naive(const Ctx& C, const f16* __restrict__ mixed, const f16* __restrict__ poolw_t, const float* __restrict__ pscale, f16* __restrict__ ocat) {
    for (size_t gid = (size_t)C.gt; gid < (size_t)T * 512; gid += (size_t)C.ngt) {
        const int n = (int)(gid & 511), t = (int)(gid >> 9), g = n >> 7, d = n & 127;
        const f16* mr = mixed + (size_t)t * 512 + g * 128;
        const f16* wr = poolw_t + (size_t)(g * 128 + d) * 128;
        float acc = 0.f;
        for (int c = 0; c < 128; ++c) acc += (float)mr[c] * (float)wr[c];
        ocat[(size_t)t * DM + 512 + n] = (f16)(acc * pscale[n]);
    }
}

template <int HW>
__device__ __forceinline__ void pool_step1(const f16* __restrict__ qkvu, LAS unsigned char* tile, int t0, int g, int lane) {
    const int c2 = lane, b = t0 >> 11, sf = t0 & (SEQ - 1);
    const f16* ub = qkvu + (size_t)(b * SEQ) * NQKVU + COL_U + g * 128 + 2 * c2;
    constexpr int NR = 32 + 2 * HW - 1;
    half2 v[NR];
#pragma unroll
    for (int i = 0; i < NR; ++i) { const int s = sf - HW + i; half2 z; z[0] = (f16)0.f; z[1] = (f16)0.f; v[i] = z; if (s >= 0 && s < SEQ) v[i] = *(const half2*)(ub + (size_t)s * NQKVU); }
    float s0 = 0.f, s1 = 0.f;
#pragma unroll
    for (int i = 0; i < 2 * HW - 1; ++i) { s0 += (float)v[i][0]; s1 += (float)v[i][1]; }
#pragma unroll
    for (int j = 0; j < 32; ++j) {
        s0 += (float)v[j + 2 * HW - 1][0]; s1 += (float)v[j + 2 * HW - 1][1];
        const int s = sf + j, lo = max(s - HW, 0), hi = min(s + HW, SEQ);
        const float inv = 1.0f / (float)(hi - lo);
        half2 mx; mx[0] = (f16)(s0 * inv - (float)v[j + HW][0]); mx[1] = (f16)(s1 * inv - (float)v[j + HW][1]);
        *(LAS half2*)(tile + j * 256 + (((c2 >> 2) ^ (j & 15)) << 4) + ((c2 & 3) << 2)) = mx;
        s0 -= (float)v[j][0]; s1 -= (float)v[j][1];
    }
}
__device__ __forceinline__ void pool_unit(const Ctx& C, int u, LAS unsigned char* lds, const f16* __restrict__ qkvu, const f16* __restrict__ poolw_t, const float* __restrict__ pscale, f16* __restrict__ ocat) {
    const int lane = C.lane, r32 = lane & 31, hh = lane >> 5;
    LAS unsigned char* tile = lds + C.wave * 8192;
    const int g = u & 3, t0 = (u >> 2) * 32;
    switch (g) { case 0: pool_step1<1>(qkvu, tile, t0, g, lane); break; case 1: pool_step1<2>(qkvu, tile, t0, g, lane); break;
                 case 2: pool_step1<4>(qkvu, tile, t0, g, lane); break; default: pool_step1<8>(qkvu, tile, t0, g, lane); break; }
    LDS_WAIT();
    f32x16 acc[4];
#pragma unroll
    for (int db = 0; db < 4; ++db)
#pragma unroll
        for (int r = 0; r < 16; ++r) acc[db][r] = 0.f;
    const f16* wr = poolw_t + (size_t)(g * 128 + r32) * 128 + 8 * hh;
#pragma unroll
    for (int ks = 0; ks < 8; ++ks) {
        const half8 bm = *(const LAS half8*)(tile + r32 * 256 + (((2 * ks + hh) ^ (r32 & 15)) << 4));
#pragma unroll
        for (int db = 0; db < 4; ++db) { const half8 a = *(const half8*)(wr + (size_t)(db * 32) * 128 + 16 * ks); acc[db] = __builtin_amdgcn_mfma_f32_32x32x16_f16(a, bm, acc[db], 0, 0, 0); }
    }
    LDS_WAIT();
    f16* orow = ocat + (size_t)(t0 + r32) * DM + 512 + g * 128 + 4 * hh;
    const float* ps = pscale + g * 128 + 4 * hh;
#pragma unroll
    for (int db = 0; db < 4; ++db)
#pragma unroll
        for (int q = 0; q < 4; ++q) {
            const f32x4 pv = *(const f32x4*)(ps + db * 32 + 8 * q);
            half4 x0;
#pragma unroll
            for (int i = 0; i < 4; ++i) x0[i] = (f16)(acc[db][4 * q + i] * pv[i]);
            *(half4*)(orow + db * 32 + 8 * q) = x0;
        }
}
__device__ __forceinline__ void ph_attn_pool(const Ctx& C, LAS unsigned char* lds, const f16* __restrict__ qkvu, const f16* __restrict__ vT, const float* __restrict__ sink,
                                             const f16* __restrict__ poolw_t, const float* __restrict__ pscale, f16* __restrict__ ocat) {
    for (int m = C.gw; m < (T / 32) * 4; m += C.ngw) {
        if (C.wave & 4) pool_unit(C, m, lds, qkvu, poolw_t, pscale, ocat);
        attn_unit<0>(C, 2 * m, lds, qkvu, vT, sink, ocat);
        attn_unit<0>(C, 2 * m + 1, lds, qkvu, vT, sink, ocat);
        if (!(C.wave & 4)) pool_unit(C, m, lds, qkvu, poolw_t, pscale, ocat);
    }
}

#define INS(LV, LI, v_, i_) do { float cv_ = (v_); int ci_ = (i_); \
    _Pragma("unroll") for (int z_ = 0; z_ < 16; ++z_) { const bool gt_ = cv_ > LV[z_]; const float tv_ = gt_ ? LV[z_] : cv_; const int ti_ = gt_ ? LI[z_] : ci_; \
        LV[z_] = gt_ ? cv_ : LV[z_]; LI[z_] = gt_ ? ci_ : LI[z_]; cv_ = tv_; ci_ = ti_; } } while (0)
__device__ __forceinline__ void ph_route_naive(const Ctx& C, const f16* __restrict__ qp, const float* __restrict__ ss2, const f16* __restrict__ subk, int* __restrict__ eidx, float* __restrict__ egate) {
    for (int gid = C.gt; gid < T * 8; gid += C.ngt) {
        const int t = gid % T, h = gid / T;
        const float rs2 = rs_from_ss(ss2, t);
        float av[16], bv[16]; int ai[16], bi[16];
#pragma unroll
        for (int z = 0; z < 16; ++z) { av[z] = -3e38f; bv[z] = -3e38f; ai[z] = 0; bi[z] = 0; }
        for (int p = 0; p < 2; ++p) {
            const f16* qr = qp + (size_t)t * 2048 + h * 256 + p * 128;
            for (int n = 0; n < 128; ++n) {
                const f16* kr = subk + ((size_t)((h * 2 + p) * 128 + n)) * 128;
                float dot = 0.f;
                for (int c = 0; c < 128; ++c) dot += (float)qr[c] * (float)kr[c];
                dot *= rs2;
                if (p == 0) INS(av, ai, dot, n); else INS(bv, bi, dot, n);
            }
        }
        float cv[16]; int ci[16];
#pragma unroll
        for (int z = 0; z < 16; ++z) { cv[z] = -3e38f; ci[z] = 0; }
#pragma unroll
        for (int i = 0; i < 16; ++i)
#pragma unroll
            for (int j = 0; j < 16; ++j)
                if ((i + 1) * (j + 1) <= 16) INS(cv, ci, av[i] + bv[j], ai[i] * 128 + bi[j]);
        float sum = 0.f, e[16];
#pragma unroll
        for (int z = 0; z < 16; ++z) { e[z] = __expf(cv[z] - cv[0]); sum += e[z]; }
        const float inv = 1.0f / sum;
#pragma unroll
        for (int z = 0; z < 16; ++z) { eidx[(size_t)t * 128 + h * 16 + z] = ci[z]; egate[(size_t)t * 128 + h * 16 + z] = e[z] * inv; }
    }
}

__device__ __forceinline__ int mono_i(float f) { const int b = __float_as_int(f); return b ^ ((b >> 31) & 0x7fffffff); }
__device__ __forceinline__ float unmono_f(int m) { return __int_as_float(m ^ ((m >> 31) & 0x7fffffff)); }
#define INS16(Lst, x_) do { int xv_ = (x_); _Pragma("unroll") for (int z_ = 0; z_ < 16; ++z_) { const int hi_ = max(Lst[z_], xv_); xv_ = min(Lst[z_], xv_); Lst[z_] = hi_; } } while (0)
__device__ __forceinline__ void merge_pair16(int (&Lst)[16]) {
    int P[16];
#pragma unroll
    for (int z = 0; z < 16; ++z) P[z] = __shfl_xor(Lst[z], 32);
#pragma unroll
    for (int z = 0; z < 16; ++z) Lst[z] = max(Lst[z], P[15 - z]);
#pragma unroll
    for (int s = 8; s >= 1; s >>= 1)
#pragma unroll
        for (int i = 0; i < 16; ++i) if ((i & s) == 0) { const int hi = max(Lst[i], Lst[i + s]), lo = min(Lst[i], Lst[i + s]); Lst[i] = hi; Lst[i + s] = lo; }
}
__device__ __forceinline__ void bitonic_sort16_desc(int (&K)[16]) {
#pragma unroll
    for (int k = 2; k <= 16; k <<= 1)
#pragma unroll
        for (int j = k >> 1; j > 0; j >>= 1)
#pragma unroll
            for (int i = 0; i < 16; ++i) { const int l = i ^ j; if (l > i) { const int a = K[i], b = K[l], hi = max(a, b), lo = min(a, b); const bool desc = (i & k) == 0; K[i] = desc ? hi : lo; K[l] = desc ? lo : hi; } }
}
__device__ __forceinline__ void bitonic_merge16_desc(int (&K)[16]) {
#pragma unroll
    for (int s = 8; s >= 1; s >>= 1)
#pragma unroll
        for (int i = 0; i < 16; ++i) if ((i & s) == 0) { const int hi = max(K[i], K[i + s]), lo = min(K[i], K[i + s]); K[i] = hi; K[i + s] = lo; }
}
template <class Side>
__device__ __forceinline__ void ph_route(const Ctx& C, LAS unsigned char* lds, const f16* __restrict__ qp, const float* __restrict__ ss2, const f16* __restrict__ subk,
                                         int* __restrict__ eidx, float* __restrict__ egate, const Side& side_job) {
    const int lane = C.lane, r32 = lane & 31, hh = lane >> 5;
    LAS unsigned char* tab = lds + 65536 + C.wave * 4096 + lane * 36;
    const int GH = C.G < 8 ? C.G : 8;
  for (int h = blockIdx.x % GH; h < 8; h += GH) {
    const int rank_h = blockIdx.x / GH, nwg_h = (C.G - (blockIdx.x % GH) + GH - 1) / GH;
    __syncthreads();
    for (int i = C.tid; i < 2 * 128 * 16; i += NTHREADS) {
        const int row = i >> 4, ch = i & 15;
        *(LAS half8*)(lds + row * 256 + ((ch ^ (row & 15)) << 4)) = *(const half8*)(subk + (size_t)(h * 256 + row) * 128 + ch * 8);
    }
    __syncthreads();
    if (h == (int)(blockIdx.x % GH) && (C.wave & 4)) side_job();
    for (int tb = rank_h * NWAVES + C.wave; tb < T / 32; tb += nwg_h * NWAVES) {
        const int t0 = tb * 32, t = t0 + r32;
        const float rs2 = rs_from_ss(ss2, t);
        int top[2][16];
#pragma unroll
        for (int p = 0; p < 2; ++p) {
            const f16* qrow = qp + (size_t)t * 2048 + h * 256 + p * 128 + 8 * hh;
            const LAS unsigned char* kl = lds + (p * 128 + r32) * 256;
            half8 bq[8];
#pragma unroll
            for (int ks = 0; ks < 8; ++ks) bq[ks] = *(const half8*)(qrow + 16 * ks);
            int Lst[16];
#pragma unroll
            for (int z = 0; z < 16; ++z) Lst[z] = (int)0x80000000;
#pragma unroll 1
            for (int nb = 0; nb < 4; ++nb) {
                f32x16 acc = {0.f, 0.f, 0.f, 0.f, 0.f, 0.f, 0.f, 0.f, 0.f, 0.f, 0.f, 0.f, 0.f, 0.f, 0.f, 0.f};
#pragma unroll
                for (int ks = 0; ks < 8; ++ks) {
                    const half8 ak = *(const LAS half8*)(kl + nb * 32 * 256 + (((2 * ks + hh) ^ (r32 & 15)) << 4));
                    acc = __builtin_amdgcn_mfma_f32_32x32x16_f16(ak, bq[ks], acc, 0, 0, 0);
                }
                int K[16];
#pragma unroll
                for (int r = 0; r < 16; ++r) { const int n = nb * 32 + (r & 3) + 8 * (r >> 2) + 4 * hh; K[r] = (mono_i(acc[r] * rs2) & ~127) | (127 - n); }
                bitonic_sort16_desc(K);
#pragma unroll
                for (int z = 0; z < 16; ++z) Lst[z] = max(Lst[z], K[15 - z]);
                bitonic_merge16_desc(Lst);
            }
            merge_pair16(Lst);
#pragma unroll
            for (int z = 0; z < 16; ++z) top[p][z] = Lst[z];
        }
        float va[16], vb[16];
#pragma unroll
        for (int z = 0; z < 16; ++z) { va[z] = unmono_f(top[0][z] & ~127); vb[z] = unmono_f(top[1][z] & ~127);
            tab[z] = (unsigned char)(127 - (top[0][z] & 127)); tab[16 + z] = (unsigned char)(127 - (top[1][z] & 127)); }
        int Cl[16];
        { const float a01 = hh ? va[1] : va[0];
#pragma unroll
          for (int j = 0; j < 16; ++j) { const int key = (mono_i(a01 + vb[j]) & ~255) | (255 - (hh * 16 + j)); Cl[j] = (hh && j >= 8) ? (int)0x80000000 : key; } }
#pragma unroll
        for (int i = 2; i < 16; i += 2) {
            const float ai = hh ? va[i + 1] : va[i];
#pragma unroll
            for (int j = 0; j < 16; ++j)
                if ((i + 1) * (j + 1) <= 16) {
                    int key = (mono_i(ai + vb[j]) & ~255) | (255 - ((i + hh) * 16 + j));
                    if ((i + 2) * (j + 1) > 16) key = hh ? (int)0x80000000 : key;
                    INS16(Cl, key);
                }
        }
        merge_pair16(Cl);
        float e[16], sum = 0.f; const float mx = unmono_f(Cl[0] & ~255);
#pragma unroll
        for (int z = 0; z < 16; ++z) { e[z] = __expf(unmono_f(Cl[z] & ~255) - mx); sum += e[z]; }
        const float inv = 1.0f / sum;
        LDS_WAIT();
        int* ei = eidx + (size_t)t * 128 + h * 16 + 8 * hh; float* eg = egate + (size_t)t * 128 + h * 16 + 8 * hh;
#pragma unroll
        for (int z = 0; z < 16; ++z) {
            if ((z >> 3) == hh) { const int code = 255 - (Cl[z] & 255); const int ia = tab[code >> 4], ib = tab[16 + (code & 15)];
                ei[z & 7] = ia * 128 + ib; eg[z & 7] = e[z] * inv; }
        }
        LDS_WAIT();
    }
  }
}

typedef unsigned u32x4 __attribute__((ext_vector_type(4)));
struct Slicing { int m, pi, nloc, rank; };
__device__ __forceinline__ Slicing get_slicing(const unsigned* bar, volatile LAS unsigned* misc) {
    Slicing S; const unsigned x = (unsigned)__builtin_amdgcn_s_getreg((3 << 11) | 20) & 0xFu;
    int m = 0, pi = 0, nloc = 1;
    for (unsigned j = 0; j < 16; ++j) { const unsigned c = __hip_atomic_load(&bar[256 + 64 * j], __ATOMIC_RELAXED, __HIP_MEMORY_SCOPE_AGENT); if (c > 0u) { if (j < x) ++pi; ++m; } if (j == x) nloc = (int)c; }
    S.m = m > 0 ? m : 1; S.pi = pi; S.nloc = nloc > 0 ? nloc : 1; S.rank = (int)misc[10];
    return S;
}
__device__ __forceinline__ float gelu_fast(float v) {
    const float av = fabsf(v), t = __builtin_amdgcn_rcpf(av * 0.2316418882f + 1.0f);
    float q = t * 0.5307027145f + (-0.7265760135f); q = q * t + 0.7107068705f; q = q * t + (-0.142248368f); q = q * t + 0.127414796f; q = q * t;
    const float m = v * (q * __builtin_amdgcn_exp2f((v * v) * (-0.72134752044f)));
    return v < 0.f ? m : v - m;
}
__device__ __forceinline__ void ph_h2quant(const Ctx& C, const f16* __restrict__ x1h, const float* __restrict__ ss2, unsigned* __restrict__ h2q, float* __restrict__ hsc) {
    const int lane = C.lane;
    for (int t = C.gw; t < T; t += C.ngw) {
        const half8 h0 = *(const half8*)(x1h + (size_t)t * DM + 16 * lane), h1 = *(const half8*)(x1h + (size_t)t * DM + 16 * lane + 8);
        float hm = 0.f;
#pragma unroll
        for (int i = 0; i < 8; ++i) hm = fmaxf(hm, fmaxf(fabsf((float)h0[i]), fabsf((float)h1[i])));
        hm = wave_max(hm);
        const float inv = hm > 0.f ? 127.0f / hm : 0.f;
        u32x4 w;
        w[0] = (unsigned)pack4_i8((float)h0[0] * inv, (float)h0[1] * inv, (float)h0[2] * inv, (float)h0[3] * inv);
        w[1] = (unsigned)pack4_i8((float)h0[4] * inv, (float)h0[5] * inv, (float)h0[6] * inv, (float)h0[7] * inv);
        w[2] = (unsigned)pack4_i8((float)h1[0] * inv, (float)h1[1] * inv, (float)h1[2] * inv, (float)h1[3] * inv);
        w[3] = (unsigned)pack4_i8((float)h1[4] * inv, (float)h1[5] * inv, (float)h1[6] * inv, (float)h1[7] * inv);
        *(u32x4*)(h2q + (size_t)t * 256 + 4 * lane) = w;
        if (lane == 0) hsc[t] = hm * (1.0f / 127.0f) * rs_from_ss(ss2, t);
    }
}
__device__ __forceinline__ __amdgpu_buffer_rsrc_t slice_rsrc(const unsigned char* base) {
    const unsigned long long b = (unsigned long long)base;
    const unsigned lo = __builtin_amdgcn_readfirstlane((unsigned)b), hi = __builtin_amdgcn_readfirstlane((unsigned)(b >> 32));
    return __builtin_amdgcn_make_buffer_rsrc((void*)(((unsigned long long)hi << 32) | lo), 0, NEXP * 128, 0x00020000);
}
template <int EMASK>
__device__ __forceinline__ void ph_upeer(const Ctx& C, LAS unsigned char* lds, const Slicing SL, const unsigned* __restrict__ h2q, const int* __restrict__ eidx,
                                         const unsigned char* __restrict__ uq, short* __restrict__ pdot) {
    const int lane = C.lane, grp = lane >> 3, c8 = lane & 7;
    const int wv = SL.rank * NWAVES + C.wave, nwv = SL.nloc * NWAVES;
    const int ntok = (T - wv + nwv - 1) / nwv;
    auto tok = [&](int i) { const int t = wv + i * nwv; return t < T ? t : T - 1; };
    volatile LAS int* row = (volatile LAS int*)(lds + C.wave * 1024);
  for (int s = SL.pi; s < 8; s += SL.m) {
    const __amdgpu_buffer_rsrc_t urs = slice_rsrc(uq + (size_t)s * (NEXP * 128));
    const unsigned* hqs = h2q + s * 32 + c8 * 4;
    int tA = tok(0), tB = tok(1);
    int e0 = eidx[(size_t)tA * 128 + lane], e1 = eidx[(size_t)tA * 128 + 64 + lane];
    u32x4 hq = *(const u32x4*)(hqs + (size_t)tA * 256);
    int ne0 = eidx[(size_t)tB * 128 + lane], ne1 = eidx[(size_t)tB * 128 + 64 + lane];
    u32x4 r[16];
#pragma unroll
    for (int i = 0; i < 16; ++i) { const int e = __shfl(i < 8 ? e0 : e1, 8 * (i & 7) + grp) & EMASK; r[i] = __builtin_amdgcn_raw_buffer_load_b128(urs, e * 128 + c8 * 16, 0, 0); }
#pragma unroll 1
    for (int it = 0; it < ntok; ++it) {
        const int t = tok(it), t1 = tok(it + 1), t2 = tok(it + 2);
        const int ze0 = eidx[(size_t)t2 * 128 + lane], ze1 = eidx[(size_t)t2 * 128 + 64 + lane];
        const u32x4 nhq = *(const u32x4*)(hqs + (size_t)t1 * 256);
#pragma unroll
        for (int q = 0; q < 4; ++q) {
            int evv[4];
#pragma unroll
            for (int j = 0; j < 4; ++j) evv[j] = __shfl(q < 2 ? ne0 : ne1, 32 * (q & 1) + 8 * j + grp) & EMASK;
            int pa[4], pb[4];
#pragma unroll
            for (int j = 0; j < 4; ++j) {
                pa[j] = __builtin_amdgcn_sdot4((int)r[4 * q + j][0], (int)hq[0], 0, false); pb[j] = __builtin_amdgcn_sdot4((int)r[4 * q + j][1], (int)hq[1], 0, false);
                pa[j] = __builtin_amdgcn_sdot4((int)r[4 * q + j][2], (int)hq[2], pa[j], false); pb[j] = __builtin_amdgcn_sdot4((int)r[4 * q + j][3], (int)hq[3], pb[j], false);
            }
#pragma unroll
            for (int j = 0; j < 4; ++j) { pa[j] += pb[j]; pa[j] += dppi<0xB1>(pa[j]); }
#pragma unroll
            for (int j = 0; j < 4; ++j) pa[j] += dppi<0x4E>(pa[j]);
#pragma unroll
            for (int j = 0; j < 4; ++j) pa[j] += dppi<0x141>(pa[j]);
            if (c8 == 0) {
#pragma unroll
                for (int j = 0; j < 4; ++j) row[8 * (4 * q + j) + grp] = pa[j];
            }
#pragma unroll
            for (int j = 0; j < 4; ++j) {
                asm volatile("" ::: "memory");
                r[4 * q + j] = __builtin_amdgcn_raw_buffer_load_b128(urs, evv[j] * 128 + c8 * 16, 0, 0);
                asm volatile("" ::: "memory");
            }
        }
        LDS_WAIT();
        const int p0 = row[lane], p1 = row[64 + lane];
        LDS_WAIT();
        { short* pp = pdot + ((size_t)s * T + t) * 128 + lane; const int c0 = min(max((p0 + 4) >> 3, -32768), 32767), c1 = min(max((p1 + 4) >> 3, -32768), 32767);
          asm volatile("global_store_short %0, %1, off\n\tglobal_store_short %0, %2, off offset:128" :: "v"(pp), "v"(c0), "v"(c1) : "memory"); }
        hq = nhq; ne0 = ze0; ne1 = ze1;
    }
  }
}
__device__ __forceinline__ void ph_ureduce(const Ctx& C, LAS unsigned char* lds, const short* __restrict__ pdot, const float* __restrict__ hsc, const int* __restrict__ eidx, const float* __restrict__ us,
                                           const float* __restrict__ vs, const float* __restrict__ egate, unsigned* __restrict__ wqp, float* __restrict__ wsc) {
    const int lane = C.lane;
    volatile LAS unsigned char* row = (volatile LAS unsigned char*)(lds + C.wave * 1024);
    for (int tb = C.gw * 2; tb < T; tb += C.ngw * 2) {
        int e0[2], e1[2], s0[2], s1[2]; float h[2], g0[2], g1[2];
#pragma unroll
        for (int u = 0; u < 2; ++u) {
            const int t = tb + u;
            e0[u] = eidx[(size_t)t * 128 + lane]; e1[u] = eidx[(size_t)t * 128 + 64 + lane];
            g0[u] = egate[(size_t)t * 128 + lane]; g1[u] = egate[(size_t)t * 128 + 64 + lane];
            h[u] = hsc[t]; s0[u] = 0; s1[u] = 0;
#pragma unroll
            for (int s = 0; s < 8; ++s) { const short* pp = pdot + ((size_t)s * T + t) * 128 + lane; s0[u] += (int)pp[0]; s1[u] += (int)pp[64]; }
        }
        float w0[2], w1[2];
#pragma unroll
        for (int u = 0; u < 2; ++u) {
            w0[u] = gelu_fast((float)s0[u] * (8.0f * h[u]) * us[e0[u]]) * g0[u] * vs[e0[u]];
            w1[u] = gelu_fast((float)s1[u] * (8.0f * h[u]) * us[e1[u]]) * g1[u] * vs[e1[u]];
        }
#pragma unroll
        for (int u = 0; u < 2; ++u) {
            const int t = tb + u;
            const float wm = wave_max(fmaxf(fabsf(w0[u]), fabsf(w1[u])));
            const float inv = wm > 0.f ? 127.0f / wm : 0.f;
            { const int k = lane; row[u * 128 + (k & 7) * 16 + (k >> 5) * 4 + ((k >> 3) & 3)] = (unsigned char)(int)rintf(w0[u] * inv); }
            { const int k = 64 + lane; row[u * 128 + (k & 7) * 16 + (k >> 5) * 4 + ((k >> 3) & 3)] = (unsigned char)(int)rintf(w1[u] * inv); }
            if (lane == 0) wsc[t] = wm * (1.0f / 127.0f);
        }
        LDS_WAIT();
        wqp[(size_t)tb * 32 + lane] = ((volatile LAS unsigned*)row)[lane];
        LDS_WAIT();
    }
}
template <int EMASK>
__device__ __forceinline__ void ph_vpeer(const Ctx& C, const Slicing SL, const int* __restrict__ eidx, const unsigned* __restrict__ wqp, const float* __restrict__ wsc, const unsigned char* __restrict__ vq,
                                         const float* xio, float* xout, float* __restrict__ ssf) {
    const int lane = C.lane, grp = lane >> 3, c8 = lane & 7;
    const bool hh = (lane & 32) != 0, b4 = (lane & 16) != 0, b3 = (lane & 8) != 0;
    const int wv = SL.rank * NWAVES + C.wave, nwv = SL.nloc * NWAVES;
    const int ntok = (T - wv + nwv - 1) / nwv;
    auto tok = [&](int i) { const int t = wv + i * nwv; return t < T ? t : T - 1; };
  for (int s = SL.pi; s < 8; s += SL.m) {
    const __amdgpu_buffer_rsrc_t vrs = slice_rsrc(vq + (size_t)s * (NEXP * 128));
    const int chl = 8 * (hh ? 1 : 0) + 4 * (b4 ? 1 : 0) + 2 * (b3 ? 1 : 0);
    const int coff = s * 128 + c8 * 16 + chl;
    int tA = tok(0), tB = tok(1);
    int e0 = eidx[(size_t)tA * 128 + lane], e1 = eidx[(size_t)tA * 128 + 64 + lane];
    u32x4 wq = *(const u32x4*)(wqp + (size_t)tA * 32 + grp * 4); float wscale = wsc[tA];
    int ne0 = eidx[(size_t)tB * 128 + lane], ne1 = eidx[(size_t)tB * 128 + 64 + lane];
    u32x4 r[16];
#pragma unroll
    for (int i = 0; i < 16; ++i) { const int e = __shfl(i < 8 ? e0 : e1, 8 * (i & 7) + grp) & EMASK; r[i] = __builtin_amdgcn_raw_buffer_load_b128(vrs, e * 128 + c8 * 16, 0, 0); }
#pragma unroll 1
    for (int it = 0; it < ntok; ++it) {
        const int t = tok(it), t1 = tok(it + 1), t2 = tok(it + 2);
        const int ze0 = eidx[(size_t)t2 * 128 + lane], ze1 = eidx[(size_t)t2 * 128 + 64 + lane];
        const u32x4 nwq = *(const u32x4*)(wqp + (size_t)t1 * 32 + grp * 4); const float nwscale = wsc[t1];
        const float2 xv = *(const float2*)(xio + (size_t)t * DM + coff);
        int o[16];
#pragma unroll
        for (int c = 0; c < 16; ++c) o[c] = 0;
#pragma unroll
        for (int q = 0; q < 4; ++q) {
            int evv[4];
#pragma unroll
            for (int j = 0; j < 4; ++j) evv[j] = __shfl(q < 2 ? ne0 : ne1, 32 * (q & 1) + 8 * j + grp) & EMASK;
#pragma unroll
            for (int d = 0; d < 4; ++d) {
                const unsigned a = r[4 * q][d], b = r[4 * q + 1][d], c = r[4 * q + 2][d], e = r[4 * q + 3][d];
                const unsigned t0 = __builtin_amdgcn_perm(b, a, 0x05010400u), t1p = __builtin_amdgcn_perm(b, a, 0x07030602u);
                const unsigned u0 = __builtin_amdgcn_perm(e, c, 0x05010400u), u1 = __builtin_amdgcn_perm(e, c, 0x07030602u);
                o[4 * d + 0] = __builtin_amdgcn_sdot4((int)__builtin_amdgcn_perm(u0, t0, 0x05040100u), (int)wq[q], o[4 * d + 0], false);
                o[4 * d + 1] = __builtin_amdgcn_sdot4((int)__builtin_amdgcn_perm(u0, t0, 0x07060302u), (int)wq[q], o[4 * d + 1], false);
                o[4 * d + 2] = __builtin_amdgcn_sdot4((int)__builtin_amdgcn_perm(u1, t1p, 0x05040100u), (int)wq[q], o[4 * d + 2], false);
                o[4 * d + 3] = __builtin_amdgcn_sdot4((int)__builtin_amdgcn_perm(u1, t1p, 0x07060302u), (int)wq[q], o[4 * d + 3], false);
            }
#pragma unroll
            for (int j = 0; j < 4; ++j) {
                asm volatile("" ::: "memory");
                r[4 * q + j] = __builtin_amdgcn_raw_buffer_load_b128(vrs, evv[j] * 128 + c8 * 16, 0, 0);
                asm volatile("" ::: "memory");
            }
        }
        int q8[8], q4[4], q2[2];
#pragma unroll
        for (int k = 0; k < 8; ++k) q8[k] = bfly32i(o[k], o[8 + k]);
#pragma unroll
        for (int k = 0; k < 4; ++k) q4[k] = bfly16i(q8[k], q8[4 + k]);
#pragma unroll
        for (int k = 0; k < 2; ++k) { const int mine = b3 ? q4[2 + k] : q4[k], oth = b3 ? q4[k] : q4[2 + k]; q2[k] = mine + dppi<0x128>(oth); }
        const float y0 = xv.x + (float)q2[0] * wscale, y1 = xv.y + (float)q2[1] * wscale;
        { float* yp = xout + (size_t)t * DM + coff; const float2 yv = make_float2(y0, y1); asm volatile("global_store_dwordx2 %0, %1, off" :: "v"(yp), "v"(yv) : "memory"); }
        const float ss = wave_sum(y0 * y0 + y1 * y1);
        if (lane == 0) { float* sp = ssf + (size_t)s * T + t; asm volatile("global_store_dword %0, %1, off" :: "v"(sp), "v"(ss) : "memory"); }
        wq = nwq; wscale = nwscale; ne0 = ze0; ne1 = ze1;
    }
  }
}
__device__ __forceinline__ void ph_final(const Ctx& C, const float* __restrict__ ssf, float* xio, const float* __restrict__ gf) {
    const int lane = C.lane;
    f32x4 gg[4];
#pragma unroll
    for (int j = 0; j < 4; ++j) gg[j] = *(const f32x4*)(gf + j * 256 + lane * 4);
    for (int tb = C.gw * 4; tb < T; tb += C.ngw * 4) {
        f32x4 v[4][4]; float r[4];
#pragma unroll
        for (int u = 0; u < 4; ++u) {
#pragma unroll
            for (int j = 0; j < 4; ++j) v[u][j] = *(const f32x4*)(xio + (size_t)(tb + u) * DM + j * 256 + lane * 4);
            float s = 0.f;
#pragma unroll
            for (int i = 0; i < 8; ++i) s += ssf[(size_t)i * T + tb + u];
            r[u] = rsqrtf(s * (1.0f / DM) + EPS);
        }
#pragma unroll
        for (int u = 0; u < 4; ++u)
#pragma unroll
            for (int j = 0; j < 4; ++j) *(f32x4*)(xio + (size_t)(tb + u) * DM + j * 256 + lane * 4) = v[u][j] * r[u] * gg[j];
    }
}

namespace pg8 {
#define PG8_LAS __attribute__((address_space(3)))
typedef _Float16 frag8 __attribute__((ext_vector_type(8)));
typedef float f32x4 __attribute__((ext_vector_type(4)));
constexpr int BM = 256, BK = 64, HALF = 128, HTB = HALF * BK * 2  , STAGE_BYTES = 8 * HTB, NXCD = 8, WGM = 8;

__host__ __device__ __forceinline__ int lds_byte(int r, int c) { const int st = (r >> 4) * 2 + (c >> 5), rr = r & 15, cc = c & 31, ob = rr * 64 + cc * 2; return st * 1024 + (ob ^ (((ob >> 9) & 1) << 5)); }
__host__ __device__ __forceinline__ void stage_rc(int b, int& R, int& C) { const int st = b / 1024, sb = b % 1024, swz = sb ^ (((sb >> 9) & 1) << 5); R = (st >> 1) * 16 + swz / 64; C = (st & 1) * 32 + (swz % 64) / 2; }
__host__ __device__ __forceinline__ int perm32(int rho) { const int n = rho >> 4, i = rho & 15; return 8 * (i >> 2) + 4 * n + (i & 3); }

struct Unit { int pm, pn; };
struct Gemm { const f16* A; const f16* Bt; int M, N, K; };

struct StaticOrder {
    int nM, nN, nwg, G, c;
    __host__ __device__ void init(int M, int N, int G_, int c_) { nM = M / BM; nN = N / BM; nwg = nM * nN; G = G_; c = c_; }
    __host__ __device__ bool next(int i, Unit& u) const {
        const long L = (long)i * G + c; if (L >= nwg) return false;
        int wgid = (int)L; { const int q = nwg / NXCD, r = nwg % NXCD, xcd = wgid % NXCD, off = wgid / NXCD; wgid = (xcd < r ? xcd * (q + 1) : r * (q + 1) + (xcd - r) * q) + off; }
        const int nig = WGM * nN, gid = wgid / nig, fm = gid * WGM, gsz = (nM - fm) < WGM ? (nM - fm) : WGM;
        u.pm = fm + ((wgid % nig) % gsz); u.pn = (wgid % nig) / gsz; return true;
    }
    __device__ __forceinline__ void a_ready(const Unit&) const {}
    __device__ __forceinline__ void done(const Unit&) const {}
};

__device__ __forceinline__ frag8 pack8(const f32x4 a, const f32x4 b) {
    frag8 h; h[0] = (f16)a[0]; h[1] = (f16)a[1]; h[2] = (f16)a[2]; h[3] = (f16)a[3]; h[4] = (f16)b[0]; h[5] = (f16)b[1]; h[6] = (f16)b[2]; h[7] = (f16)b[3]; return h;
}
__device__ __forceinline__ float sigmoidf_(float z) { return 1.0f / (1.0f + __expf(-z)); }

struct EpiP1 {
    static constexpr bool PERM = true, AFTER_DRAIN = false, MIDK = false;
    const float* ss1; const float* bgate; f16* qkvu; f16* gates; f16* vT;
    __device__ __forceinline__ void operator()(const f32x4 (&acc)[2][2][4][2], const Unit& u, int wr, int wc, int fr, int fq) const {
        const int row0 = u.pm * BM + wr * 64 + fr, colt = u.pn * BM; const bool isg = colt >= NQKVU;
#pragma unroll
        for (int ai = 0; ai < 2; ++ai)
#pragma unroll
            for (int m = 0; m < 4; ++m) { const int row = row0 + ai * HALF + m * 16; const float r = rsqrtf(ss1[row] * (1.0f / DM) + EPS);
#pragma unroll
                for (int bj = 0; bj < 2; ++bj) { const int c0 = colt + bj * HALF + wc * 32 + 8 * fq; f32x4 v0 = acc[ai][bj][m][0] * r, v1 = acc[ai][bj][m][1] * r;
                    if (isg) { const int cg = c0 - NQKVU; const f32x4 b0 = *(const f32x4*)(bgate + cg), b1 = *(const f32x4*)(bgate + cg + 4);
#pragma unroll
                        for (int i = 0; i < 4; ++i) { v0[i] = sigmoidf_(v0[i] + b0[i]); v1[i] = sigmoidf_(v1[i] + b1[i]); }
                        *(frag8*)(gates + (size_t)row * NGATE + cg) = pack8(v0, v1); }
                    else { const frag8 hv = pack8(v0, v1); *(frag8*)(qkvu + (size_t)row * NQKVU + c0) = hv;
                        if (colt == 512 && bj == 1) {
                            f16* vp = vT + ((size_t)((row >> 11) * 2 + (wc >> 1)) * 64 + (wc & 1) * 32 + 8 * fq) * SEQ + (row & (SEQ - 1));
#pragma unroll
                            for (int i = 0; i < 8; ++i) vp[(size_t)i * SEQ] = hv[i];
                            if (PROBE_DUP == 21) { asm volatile("s_waitcnt vmcnt(0)" ::: "memory");
#pragma unroll
                                for (int i = 0; i < 8; ++i) { f16* q2 = vp + (size_t)i * SEQ; asm volatile("global_store_short %0, %1, off" :: "v"(q2), "v"(hv[i]) : "memory"); } } } } } }
    }
};
struct EpiMerged {
    static constexpr bool PERM = true, AFTER_DRAIN = false, MIDK = true;
    const f16* gates; f16* merged;
    __device__ __forceinline__ void mid(f32x4 (&acc)[2][2][4][2], const Unit& u, int wr, int wc, int fr, int fq) const {
        const int row0 = u.pm * BM + wr * 64 + fr, colt = u.pn * BM;
        const f16* gb = gates + (size_t)row0 * NGATE + colt + wc * 32 + 8 * fq;
        asm volatile("" : "+v"(gb));
#pragma unroll
        for (int ai = 0; ai < 2; ++ai) {
            frag8 g0[4][2], g1[4][2];
#pragma unroll
            for (int m = 0; m < 4; ++m)
#pragma unroll
                for (int bj = 0; bj < 2; ++bj) { const f16* gp = gb + (size_t)(ai * HALF + m * 16) * NGATE + bj * HALF; g0[m][bj] = *(const frag8*)gp; g1[m][bj] = *(const frag8*)(gp + DM); }
#pragma unroll
            for (int m = 0; m < 4; ++m)
#pragma unroll
                for (int bj = 0; bj < 2; ++bj)
#pragma unroll
                    for (int i = 0; i < 4; ++i) {
                        acc[ai][bj][m][0][i] *= (float)g0[m][bj][i] * __builtin_amdgcn_rcpf(fmaxf((float)g1[m][bj][i], 1e-4f));
                        acc[ai][bj][m][1][i] *= (float)g0[m][bj][4 + i] * __builtin_amdgcn_rcpf(fmaxf((float)g1[m][bj][4 + i], 1e-4f)); }
            asm volatile("" ::: "memory");
        }
    }
    __device__ __forceinline__ void operator()(const f32x4 (&acc)[2][2][4][2], const Unit& u, int wr, int wc, int fr, int fq) const {
        const int row0 = u.pm * BM + wr * 64 + fr, colt = u.pn * BM;
#pragma unroll
        for (int ai = 0; ai < 2; ++ai)
#pragma unroll
            for (int m = 0; m < 4; ++m) { const int row = row0 + ai * HALF + m * 16;
#pragma unroll
                for (int bj = 0; bj < 2; ++bj) { const int c0 = colt + bj * HALF + wc * 32 + 8 * fq;
                    const frag8 g1 = *(const frag8*)(gates + (size_t)row * NGATE + DM + c0); f32x4 v0, v1;
#pragma unroll
                    for (int i = 0; i < 4; ++i) { v0[i] = acc[ai][bj][m][0][i] * fmaxf((float)g1[i], 1e-4f); v1[i] = acc[ai][bj][m][1][i] * fmaxf((float)g1[4 + i], 1e-4f); }
                    *(frag8*)(merged + (size_t)row * DM + c0) = pack8(v0, v1); } }
    }
};
struct EpiOut {
    static constexpr bool PERM = false, AFTER_DRAIN = false, MIDK = false;
    const float* x; const float* g2; float* x1; f16* x1h; float* ss2p;
    __device__ __forceinline__ void operator()(const f32x4 (&acc)[2][2][4][2], const Unit& u, int wr, int wc, int fr, int fq) const {
        const int row0 = u.pm * BM + wr * 64 + fr, col0 = u.pn * BM + wc * 32 + 4 * fq;
        f32x4 gv[2][2];
#pragma unroll
        for (int bj = 0; bj < 2; ++bj)
#pragma unroll
            for (int n = 0; n < 2; ++n) gv[bj][n] = *(const f32x4*)(g2 + col0 + bj * HALF + n * 16);
#pragma unroll
        for (int ai = 0; ai < 2; ++ai)
#pragma unroll
            for (int m = 0; m < 4; ++m) { const int row = row0 + ai * HALF + m * 16; const size_t off = (size_t)row * DM + col0; float ssq = 0.f;
#pragma unroll
                for (int bj = 0; bj < 2; ++bj)
#pragma unroll
                    for (int n = 0; n < 2; ++n) { const f32x4 y = *(const f32x4*)(x + off + bj * HALF + n * 16) + acc[ai][bj][m][n];
                        *(f32x4*)(x1 + off + bj * HALF + n * 16) = y; ssq += (y[0] * y[0] + y[1] * y[1]) + (y[2] * y[2] + y[3] * y[3]);
                        const f32x4 yg = y * gv[bj][n]; half4 h; h[0] = (f16)yg[0]; h[1] = (f16)yg[1]; h[2] = (f16)yg[2]; h[3] = (f16)yg[3];
                        *(half4*)(x1h + off + bj * HALF + n * 16) = h; }
                ssq += __shfl_xor(ssq, 16); ssq += __shfl_xor(ssq, 32);
                if (fq == 0) ss2p[(size_t)(u.pn * 4 + wc) * T + row] = ssq; }
    }
};
struct EpiQ {
    static constexpr bool PERM = true, AFTER_DRAIN = false, MIDK = false;
    f16* qp;
    __device__ __forceinline__ void operator()(const f32x4 (&acc)[2][2][4][2], const Unit& u, int wr, int wc, int fr, int fq) const {
        const int row0 = u.pm * BM + wr * 64 + fr, colt = u.pn * BM;
#pragma unroll
        for (int ai = 0; ai < 2; ++ai)
#pragma unroll
            for (int m = 0; m < 4; ++m) { const int row = row0 + ai * HALF + m * 16;
#pragma unroll
                for (int bj = 0; bj < 2; ++bj) { const int c0 = colt + bj * HALF + wc * 32 + 8 * fq;
                    *(frag8*)(qp + (size_t)row * 2048 + c0) = pack8(acc[ai][bj][m][0], acc[ai][bj][m][1]); } }
    }
};

template <class Epi, class Sched, bool ALIGN_EPI = false, bool SP2 = false>
__device__ __forceinline__ void gemm_phase(PG8_LAS unsigned char* lds, const Gemm g, const Sched& S, const Epi& E) {
    const int tid = threadIdx.x, wid = __builtin_amdgcn_readfirstlane(tid >> 6), lane = tid & 63, wr = wid >> 2, wc = wid & 3, fr = lane & 15, fq = lane >> 4;
    const int K = g.K, nt = K / BK;
    unsigned voffA[2], voffB[2];
#pragma unroll
    for (int i = 0; i < 2; ++i) { int R, C; stage_rc(tid * 16 + i * 8192, R, C); const int Rb = Epi::PERM ? ((R & ~31) + perm32(R & 31)) : R;
        voffA[i] = (unsigned)(R * K + C) * 2u; voffB[i] = (unsigned)(Rb * K + C) * 2u; }
    const size_t kstep = (size_t)(BK * 2);
    const size_t hstep = (size_t)HALF * K * 2;
    const size_t tstep = 2 * hstep;
    const unsigned ldsw = (unsigned)wid * 1024u;
    const int aoff = lds_byte(wr * 64 + fr, fq * 8), boff = lds_byte(wc * 32 + fr, fq * 8);
#define PG8_SA(b, h) (((b) * 2 + (h)) * HTB)
#define PG8_SB(b, h) ((4 + (b) * 2 + (h)) * HTB)
#define PG8_STAGE(bufoff, gbase, voff) do { _Pragma("unroll") for (int _i = 0; _i < 2; ++_i) \
        __builtin_amdgcn_global_load_lds((const unsigned*)((const char*)(gbase) + (voff)[_i]), (PG8_LAS unsigned*)(lds + (bufoff) + ldsw + _i * 8192), 16, 0, 0); } while (0)
#define PG8_LDA(dst, b, h) do { _Pragma("unroll") for (int m = 0; m < 4; ++m) _Pragma("unroll") for (int k = 0; k < 2; ++k) dst[m][k] = *(const PG8_LAS frag8*)(lds + PG8_SA(b, h) + aoff + m * 2048 + k * 1024); } while (0)
#define PG8_LDB(dst, b, h) do { _Pragma("unroll") for (int n = 0; n < 2; ++n) _Pragma("unroll") for (int k = 0; k < 2; ++k) dst[n][k] = *(const PG8_LAS frag8*)(lds + PG8_SB(b, h) + boff + n * 2048 + k * 1024); } while (0)
#define PG8_MMA(ai, bj, At, Bt) do { __builtin_amdgcn_s_setprio(1); _Pragma("unroll") for (int m = 0; m < 4; ++m) _Pragma("unroll") for (int n = 0; n < 2; ++n) _Pragma("unroll") for (int k = 0; k < 2; ++k) \
        acc[ai][bj][m][n] = __builtin_amdgcn_mfma_f32_16x16x32_f16(Bt[n][k], At[m][k], acc[ai][bj][m][n], 0, 0, 0); __builtin_amdgcn_s_setprio(0); } while (0)
#define PG8_WAIT_V(n) asm volatile("s_waitcnt vmcnt(" #n ")" ::: "memory")
#define PG8_WAIT_L(n) asm volatile("s_waitcnt lgkmcnt(" #n ")" ::: "memory")
#define PG8_BAR __builtin_amdgcn_s_barrier()
#define PG8_SCHED __builtin_amdgcn_sched_barrier(0)
    Unit cur, nxt; int ui = 0;
    if (!S.next(0, cur)) return;
    f32x4 acc[2][2][4][2];
#pragma unroll
    for (int a = 0; a < 2; ++a)
#pragma unroll
        for (int b = 0; b < 2; ++b)
#pragma unroll
            for (int m = 0; m < 4; ++m)
#pragma unroll
                for (int n = 0; n < 2; ++n) acc[a][b][m][n] = (f32x4){0.f, 0.f, 0.f, 0.f};
    frag8 At[4][2], B0[2][2], B1[2][2];
    const char* cA = (const char*)g.A + (size_t)cur.pm * tstep; const char* cB = (const char*)g.Bt + (size_t)cur.pn * tstep;
    S.a_ready(cur);
    if constexpr (SP2) {
        PG8_STAGE(PG8_SB(0, 0), cB, voffB); PG8_STAGE(PG8_SB(0, 1), cB + hstep, voffB); PG8_STAGE(PG8_SA(0, 0), cA, voffA); PG8_STAGE(PG8_SA(0, 1), cA + hstep, voffA);
        if (wr == 1) PG8_BAR;
        PG8_WAIT_V(2); PG8_BAR;
        PG8_STAGE(PG8_SB(1, 0), cB + kstep, voffB); PG8_STAGE(PG8_SA(1, 0), cA + kstep, voffA); PG8_STAGE(PG8_SB(1, 1), cB + hstep + kstep, voffB);
        PG8_WAIT_V(6); PG8_BAR;
    } else {
        PG8_STAGE(PG8_SB(0, 0), cB, voffB); PG8_STAGE(PG8_SA(0, 0), cA, voffA); PG8_STAGE(PG8_SB(0, 1), cB + hstep, voffB); PG8_STAGE(PG8_SA(0, 1), cA + hstep, voffA);
        if (wr == 1) PG8_BAR;
        PG8_WAIT_V(4); PG8_BAR;
        PG8_STAGE(PG8_SB(1, 0), cB + kstep, voffB); PG8_STAGE(PG8_SA(1, 0), cA + kstep, voffA); PG8_STAGE(PG8_SB(1, 1), cB + hstep + kstep, voffB);
        PG8_WAIT_V(6); PG8_BAR;
    }
    for (;;) {
        const bool has_next = S.next(ui + 1, nxt);
        const char* nA = has_next ? (const char*)g.A + (size_t)nxt.pm * tstep : cA; const char* nB = has_next ? (const char*)g.Bt + (size_t)nxt.pn * tstep : cB;
        for (int t = 0; t < nt; t += 2) {
            const bool last = (t == nt - 2);
            if constexpr (Epi::MIDK) { if (t == (nt >> 1)) E.mid(acc, cur, wr, wc, fr, fq); }
            const char* a1 = cA + (size_t)(t + 1) * kstep;
            const char* a2 = last ? nA : cA + (size_t)(t + 2) * kstep; const char* b2 = last ? nB : cB + (size_t)(t + 2) * kstep;
            const char* a3 = a2 + kstep; const char* b3 = b2 + kstep;
            if (last && has_next) S.a_ready(nxt);
            if constexpr (SP2) {
            PG8_LDB(B0, 0, 0); PG8_LDB(B1, 0, 1); PG8_SCHED; PG8_LDA(At, 0, 0); PG8_STAGE(PG8_SA(1, 1), a1 + hstep, voffA);
            PG8_WAIT_V(8); PG8_WAIT_L(0); PG8_BAR; PG8_MMA(0, 0, At, B0); PG8_MMA(0, 1, At, B1); PG8_BAR; PG8_SCHED;
            PG8_LDA(At, 0, 1); PG8_STAGE(PG8_SB(0, 0), b2, voffB); PG8_STAGE(PG8_SB(0, 1), b2 + hstep, voffB); PG8_STAGE(PG8_SA(0, 0), a2, voffA);
            PG8_WAIT_V(8); PG8_WAIT_L(0); PG8_BAR; PG8_MMA(1, 0, At, B0); PG8_MMA(1, 1, At, B1); PG8_BAR; PG8_SCHED;
            PG8_LDB(B0, 1, 0); PG8_LDB(B1, 1, 1); PG8_SCHED; PG8_LDA(At, 1, 0); PG8_STAGE(PG8_SA(0, 1), a2 + hstep, voffA);
            PG8_WAIT_V(8); PG8_WAIT_L(0); PG8_BAR; PG8_MMA(0, 0, At, B0); PG8_MMA(0, 1, At, B1); PG8_BAR; PG8_SCHED;
            PG8_LDA(At, 1, 1); PG8_STAGE(PG8_SB(1, 0), b3, voffB); PG8_STAGE(PG8_SB(1, 1), b3 + hstep, voffB); PG8_STAGE(PG8_SA(1, 0), a3, voffA);
            PG8_WAIT_V(8); PG8_WAIT_L(0); PG8_BAR; PG8_MMA(1, 0, At, B0); PG8_MMA(1, 1, At, B1); PG8_BAR; PG8_SCHED;
            } else {
            PG8_LDB(B0, 0, 0); PG8_SCHED; PG8_LDA(At, 0, 0); PG8_STAGE(PG8_SA(1, 1), a1 + hstep, voffA);
            PG8_WAIT_L(8); PG8_BAR; PG8_WAIT_L(0); PG8_MMA(0, 0, At, B0); PG8_BAR; PG8_SCHED;
            PG8_LDB(B1, 0, 1); PG8_STAGE(PG8_SB(0, 0), b2, voffB);
            PG8_BAR; PG8_WAIT_L(0); PG8_MMA(0, 1, At, B1); PG8_BAR;
            PG8_LDA(At, 0, 1); PG8_STAGE(PG8_SA(0, 0), a2, voffA);
            PG8_BAR; PG8_WAIT_L(0); PG8_MMA(1, 0, At, B0); PG8_BAR; PG8_SCHED;
            PG8_STAGE(PG8_SB(0, 1), b2 + hstep, voffB);
            PG8_WAIT_V(6); PG8_BAR; PG8_MMA(1, 1, At, B1); PG8_BAR;
            PG8_LDB(B0, 1, 0); PG8_SCHED; PG8_LDA(At, 1, 0); PG8_STAGE(PG8_SA(0, 1), a2 + hstep, voffA);
            PG8_WAIT_L(8); PG8_BAR; PG8_WAIT_L(0); PG8_MMA(0, 0, At, B0); PG8_BAR; PG8_SCHED;
            PG8_LDB(B1, 1, 1); PG8_STAGE(PG8_SB(1, 0), b3, voffB);
            PG8_BAR; PG8_WAIT_L(0); PG8_MMA(0, 1, At, B1); PG8_BAR;
            PG8_LDA(At, 1, 1); PG8_STAGE(PG8_SA(1, 0), a3, voffA);
            PG8_BAR; PG8_WAIT_L(0); PG8_MMA(1, 0, At, B0); PG8_BAR; PG8_SCHED;
            PG8_STAGE(PG8_SB(1, 1), b3 + hstep, voffB);
            PG8_WAIT_V(6); PG8_BAR; PG8_MMA(1, 1, At, B1); PG8_BAR;
            }
        }
        if constexpr (ALIGN_EPI) { if (wr == 0) PG8_BAR; }
        if constexpr (!Epi::AFTER_DRAIN) { E(acc, cur, wr, wc, fr, fq); S.done(cur); }
        if (!has_next) break;
#pragma unroll
        for (int a = 0; a < 2; ++a)
#pragma unroll
            for (int b = 0; b < 2; ++b)
#pragma unroll
                for (int m = 0; m < 4; ++m)
#pragma unroll
                    for (int n = 0; n < 2; ++n) acc[a][b][m][n] = (f32x4){0.f, 0.f, 0.f, 0.f};
        cur = nxt; cA = nA; cB = nB; ++ui;
        if constexpr (ALIGN_EPI) { if (wr == 1) PG8_BAR; }
    }
    PG8_WAIT_V(0);
    if constexpr (!ALIGN_EPI) { if (wr == 0) PG8_BAR; }
    PG8_BAR;
    if constexpr (Epi::AFTER_DRAIN) { E.fused(acc, cur, wr, wc, fr, fq, lds, wid, lane); S.done(cur); }
#undef PG8_SA
#undef PG8_SB
#undef PG8_STAGE
#undef PG8_LDA
#undef PG8_LDB
#undef PG8_MMA
#undef PG8_WAIT_V
#undef PG8_WAIT_L
#undef PG8_BAR
#undef PG8_SCHED
}
}

#define XB_TMO      128
#define XB_XCNT(j)  (256  + 64 * (j))
#define XB_XSUB(j)  (1280 + 64 * (j))
#define XB_XGEN(j)  (2304 + 64 * (j))
#define XB_TOP      3328
#define XB_TOPGEN   3392
#define XCD_BAR_WORDS 3456
#define XB_SPIN_CAP (1u << 18)

__device__ __forceinline__ unsigned xb_ld(unsigned* p)              { return __hip_atomic_load(p, __ATOMIC_RELAXED, __HIP_MEMORY_SCOPE_AGENT); }
__device__ __forceinline__ unsigned xb_add(unsigned* p, unsigned v) { return __hip_atomic_fetch_add(p, v, __ATOMIC_RELAXED, __HIP_MEMORY_SCOPE_AGENT); }
__device__ __forceinline__ unsigned xb_xcc_id() { return (unsigned)__builtin_amdgcn_s_getreg((3 << 11) | 20) & 0xFu; }
#define XB_SPIN(cond, bar) do { unsigned _sp = 0; while (cond) { __builtin_amdgcn_s_sleep(1); \
    if ((++_sp & 255u) == 0u) { if (xb_ld(&(bar)[XB_TMO])) break; if (_sp > XB_SPIN_CAP) { atomicAdd(&(bar)[XB_TMO], 1u); break; } } } } while (0)

struct XcdBarrier {
    unsigned* bar; unsigned x;
    volatile LAS unsigned* st;
};

__device__ __forceinline__ XcdBarrier xcd_barrier_post(unsigned* bar, volatile LAS unsigned* st) {
    XcdBarrier b; b.bar = bar; b.x = xb_xcc_id(); b.st = st;
    if (threadIdx.x == 0) st[2] = xb_add(&bar[XB_XCNT(b.x)], 1u);
    return b;
}
__device__ __forceinline__ void xcd_barrier_complete(unsigned* bar, unsigned x, unsigned& nloc, unsigned& nx) {
    const unsigned G = gridDim.x * gridDim.y * gridDim.z;
    unsigned sum, cnt, mine, sp = 0u;
    for (;;) {
        sum = 0u; cnt = 0u; mine = 0u;
#pragma unroll
        for (unsigned j = 0; j < 16; ++j) { const unsigned c = xb_ld(&bar[XB_XCNT(j)]); sum += c; cnt += (c > 0u) ? 1u : 0u; mine = (j == x) ? c : mine; }
        if (sum == G) break;
        __builtin_amdgcn_s_sleep(1);
        if ((++sp & 255u) == 0u) { if (xb_ld(&bar[XB_TMO])) break; if (sp > XB_SPIN_CAP) { atomicAdd(&bar[XB_TMO], 1u); break; } }
    }
    nloc = mine > 0u ? mine : 1u; nx = cnt > 0u ? cnt : 1u;
}

__device__ __forceinline__ void xcd_barrier(const XcdBarrier& b) {
    asm volatile("s_waitcnt vmcnt(0)" ::: "memory");
    __syncthreads();
    if (threadIdx.x == 0) {
        unsigned* bar = b.bar;
        __builtin_amdgcn_s_waitcnt(0);
        unsigned nloc = b.st[0], nx = b.st[1];
        if (nloc == 0u) { xcd_barrier_complete(bar, b.x, nloc, nx); b.st[0] = nloc; b.st[1] = nx; }
        const unsigned old = xb_add(&bar[XB_XSUB(b.x)], 1u);
        const unsigned gen = old / nloc;
        if (old + 1u == (gen + 1u) * nloc) {
            __builtin_amdgcn_fence(__ATOMIC_RELEASE, "agent");
            asm volatile("s_waitcnt vmcnt(0)" ::: "memory");
            const unsigned og = xb_add(&bar[XB_TOP], 1u);
            const unsigned tg = og / nx;
            if (og + 1u == (tg + 1u) * nx) xb_add(&bar[XB_TOPGEN], 1u);
            else XB_SPIN(xb_ld(&bar[XB_TOPGEN]) == tg, bar);
            __builtin_amdgcn_fence(__ATOMIC_ACQUIRE, "agent");
            xb_add(&bar[XB_XGEN(b.x)], 1u);
            asm volatile("s_waitcnt vmcnt(0)" ::: "memory");
        } else {
            XB_SPIN(xb_ld(&bar[XB_XGEN(b.x)]) == gen, bar);
            __builtin_amdgcn_fence(__ATOMIC_ACQUIRE, "agent");
            asm volatile("s_waitcnt vmcnt(0)" ::: "memory");
        }
    }
    __syncthreads();
}


struct Args { const float* in[16]; float* out; unsigned char* ws; int ph_lo, ph_hi; };
constexpr int N_PHASES = 11;

__global__ void __launch_bounds__(NTHREADS, 2) mk_fwd(Args a) {
    extern __shared__ __attribute__((aligned(16))) unsigned char lds[];
    LAS unsigned char* L = (LAS unsigned char*)lds;
    volatile LAS unsigned* MISC = (volatile LAS unsigned*)(L + MISC_OFF);
    unsigned char* ws = a.ws;
    Ctx C;
    C.tid = threadIdx.x; C.lane = C.tid & 63; C.wave = __builtin_amdgcn_readfirstlane(C.tid >> 6);
    C.G = gridDim.x; C.gw = blockIdx.x * NWAVES + C.wave; C.ngw = C.G * NWAVES; C.gt = blockIdx.x * NTHREADS + C.tid; C.ngt = C.G * NTHREADS;
    for (int u = C.tid; u < (LDS_BYTES - LDSCTL_OFF) / 4; u += NTHREADS) ((LAS unsigned*)(L + LDSCTL_OFF))[u] = 0u;
    __syncthreads();
    const int lo = a.ph_lo, hi = a.ph_hi, G = C.G;
    const bool multi = (hi - lo) > 1;
    XcdBarrier bar; bar.bar = (unsigned*)(ws + WS_CTL) + CW_BAR; bar.x = 0; bar.st = nullptr;
    if (multi) bar = xcd_barrier_post((unsigned*)(ws + WS_CTL) + CW_BAR, MISC + 8);
#define IN(k) (lo <= (k) && (k) < hi)
#define SEAM(k) do { if (IN(k) && IN((k) + 1)) xcd_barrier(bar); } while (0)

#define REPS(k) for (int rep_ = 0; rep_ < ((PROBE_DUP == (k)) ? 2 : 1); ++rep_)
#define REPBAR(k) do { if (PROBE_DUP == (k) && rep_ == 0) xcd_barrier(bar); } while (0)
    if (IN(0)) REPS(0) { ph_prep(C, L, a.in, ws); REPBAR(0); }
    SEAM(0);
    if (IN(1)) REPS(1) {
        pg8::Gemm g{(const f16*)(ws + WS_XH), (const f16*)(ws + WS_WCAT), T, NCAT, DM}; pg8::StaticOrder S; S.init(T, NCAT, G, (int)blockIdx.x);
        pg8::EpiP1 E{(const float*)(ws + WS_RS1), a.in[8], (f16*)(ws + WS_QKVU), (f16*)(ws + WS_GATES), (f16*)(ws + WS_VT)};
        pg8::gemm_phase<pg8::EpiP1, pg8::StaticOrder, true, true>(L, g, S, E);
        REPBAR(1);
    }
    SEAM(1);
    if (IN(2)) REPS(2) {
        ph_attn_pool(C, L, (const f16*)(ws + WS_QKVU), (const f16*)(ws + WS_VT), a.in[3], (const f16*)(ws + WS_POOLW), a.in[5], (f16*)(ws + WS_OCAT));
        REPBAR(2);
    }
    if (IN(2) && IN(4)) xcd_barrier(bar);
    if (IN(4)) REPS(4) {
        pg8::Gemm g{(const f16*)(ws + WS_OCAT), (const f16*)(ws + WS_WB), T, DM, DM}; pg8::StaticOrder S; S.init(T, DM, G, (int)blockIdx.x);
        pg8::EpiMerged E{(const f16*)(ws + WS_GATES), (f16*)(ws + WS_MERGED)};
        pg8::gemm_phase<pg8::EpiMerged, pg8::StaticOrder, true, true>(L, g, S, E);
        REPBAR(4);
    }
    SEAM(4);
    if (IN(5)) REPS(5) {
        pg8::Gemm g{(const f16*)(ws + WS_MERGED), (const f16*)(ws + WS_WOUT), T, DM, DM}; pg8::StaticOrder S; S.init(T, DM, G, (int)blockIdx.x);
        pg8::EpiOut E{a.in[0], a.in[10], a.out, (f16*)(ws + WS_X1H), (float*)(ws + WS_SS2)};
        pg8::gemm_phase<pg8::EpiOut, pg8::StaticOrder, true, true>(L, g, S, E);
        REPBAR(5);
    }
    SEAM(5);
    if (IN(6)) REPS(6) {
        pg8::Gemm g{(const f16*)(ws + WS_X1H), (const f16*)(ws + WS_WQ), T, 2048, DM}; pg8::StaticOrder S; S.init(T, 2048, G, (int)blockIdx.x);
        pg8::EpiQ E{(f16*)(ws + WS_QP)};
        pg8::gemm_phase<pg8::EpiQ, pg8::StaticOrder, true, true>(L, g, S, E);
        REPBAR(6);
    }
    SEAM(6);
    if (IN(7)) REPS(7) {
        auto side = [&]() {
            ph_h2quant(C, (const f16*)(ws + WS_X1H), (const float*)(ws + WS_SS2), (unsigned*)(ws + WS_H2Q), (float*)(ws + WS_HSC));
            quant_rows<false>(C, a.in[13], (unsigned*)(ws + WS_UQ), (float*)(ws + WS_US));
            quant_rows<false>(C, a.in[14], (unsigned*)(ws + WS_VQ), (float*)(ws + WS_VS));
        };
        ph_route(C, L, (const f16*)(ws + WS_QP), (const float*)(ws + WS_SS2), (const f16*)(ws + WS_SUBK), (int*)(ws + WS_EIDX), (float*)(ws + WS_EGATE), side);
        if (!(C.wave & 4)) side();
        REPBAR(7); }
    SEAM(7);
    if (IN(8)) REPS(8) {
        const Slicing SL = get_slicing((const unsigned*)(ws + WS_CTL) + CW_BAR, MISC);
        if (PROBE_DUP == 8 && rep_ == 0) ph_upeer<255>(C, L, SL, (const unsigned*)(ws + WS_H2Q), (const int*)(ws + WS_EIDX), (const unsigned char*)(ws + WS_UQ), (short*)(ws + WS_PDOT));
        else ph_upeer<16383>(C, L, SL, (const unsigned*)(ws + WS_H2Q), (const int*)(ws + WS_EIDX), (const unsigned char*)(ws + WS_UQ), (short*)(ws + WS_PDOT));
        REPBAR(8);
    }
    SEAM(8);
    if (IN(9)) {
        ph_ureduce(C, L, (const short*)(ws + WS_PDOT), (const float*)(ws + WS_HSC), (const int*)(ws + WS_EIDX), (const float*)(ws + WS_US), (const float*)(ws + WS_VS), (const float*)(ws + WS_EGATE),
                   (unsigned*)(ws + WS_WQP), (float*)(ws + WS_WSC));
        xcd_barrier(bar);
        const Slicing SL = get_slicing((const unsigned*)(ws + WS_CTL) + CW_BAR, MISC);
        if (PROBE_DUP == 9) {
            ph_vpeer<255>(C, SL, (const int*)(ws + WS_EIDX), (const unsigned*)(ws + WS_WQP), (const float*)(ws + WS_WSC), (const unsigned char*)(ws + WS_VQ), a.out, (float*)(ws + WS_QP), (float*)(ws + WS_MERGED));
            xcd_barrier(bar);
        }
        if (PROBE_DUP == 19) {
            ph_vpeer<16383>(C, SL, (const int*)(ws + WS_EIDX), (const unsigned*)(ws + WS_WQP), (const float*)(ws + WS_WSC), (const unsigned char*)(ws + WS_VQ), a.out, (float*)(ws + WS_QP), (float*)(ws + WS_MERGED));
            xcd_barrier(bar);
        }
        ph_vpeer<16383>(C, SL, (const int*)(ws + WS_EIDX), (const unsigned*)(ws + WS_WQP), (const float*)(ws + WS_WSC), (const unsigned char*)(ws + WS_VQ), a.out, a.out, (float*)(ws + WS_SSF));
    }
    SEAM(9);
    if (IN(10)) { ph_final(C, (const float*)(ws + WS_SSF), a.out, a.in[15]); }
#undef IN
#undef SEAM
}

#ifndef MK_N_LAUNCHES
#define MK_N_LAUNCHES 1
#endif
extern "C" void kernel_launch(void* const* d_in, const int* in_sizes, int n_in, void* d_out, int out_size, void* d_ws, size_t ws_size, hipStream_t stream) {
    static int grid = 0;
    if (grid == 0) {
        if (n_in != 16 || in_sizes[0] != T * DM || out_size != T * DM || ws_size < WS_END) {
            fprintf(stderr, "kernel_launch: unexpected shapes (n_in %d in0 %d out %d ws %zu)\n", n_in, n_in > 0 ? in_sizes[0] : -1, out_size, ws_size);
            grid = -1; return;
        }
        int dev = 0, cus = 0;
        if (hipGetDevice(&dev) != hipSuccess || hipDeviceGetAttribute(&cus, hipDeviceAttributeMultiprocessorCount, dev) != hipSuccess) { grid = -1; return; }
        if (hipFuncSetAttribute((const void*)mk_fwd, hipFuncAttributeMaxDynamicSharedMemorySize, LDS_BYTES) != hipSuccess) { fprintf(stderr, "kernel_launch: hipFuncSetAttribute failed\n"); grid = -1; return; }
        int per_cu = 0;
        if (hipOccupancyMaxActiveBlocksPerMultiprocessor(&per_cu, (const void*)mk_fwd, NTHREADS, LDS_BYTES) != hipSuccess || per_cu < 1)
            fprintf(stderr, "kernel_launch: occupancy query reports %d workgroups per CU\n", per_cu);
        (void)hipGetLastError();
        grid = cus;
    }
    if (grid < 0) return;
    (void)hipMemsetAsync((char*)d_ws + WS_CTL, 0, CTL_ZERO_BYTES, stream);
    Args a{};
    for (int i = 0; i < 16; ++i) a.in[i] = (const float*)d_in[i];
    a.out = (float*)d_out; a.ws = (unsigned char*)d_ws;
    if (MK_N_LAUNCHES == 1) {
        a.ph_lo = 0; a.ph_hi = N_PHASES;
        hipLaunchKernelGGL(mk_fwd, dim3(grid), dim3(NTHREADS), LDS_BYTES, stream, a);
    } else {
        for (int p = 0; p < N_PHASES; ++p) { a.ph_lo = p; a.ph_hi = p + 1; hipLaunchKernelGGL(mk_fwd, dim3(grid), dim3(NTHREADS), LDS_BYTES, stream, a); }
    }
}
```

```cpp
#include <hip/hip_runtime.h>
#include <cstdint>
#include <cstdio>

typedef _Float16 f16;
typedef _Float16 half8 __attribute__((ext_vector_type(8)));
typedef _Float16 half4 __attribute__((ext_vector_type(4)));
typedef _Float16 half2 __attribute__((ext_vector_type(2)));
typedef float f32x4 __attribute__((ext_vector_type(4)));
typedef float f32x16 __attribute__((ext_vector_type(16)));
typedef unsigned u32x4 __attribute__((ext_vector_type(4)));
typedef int i32x4 __attribute__((ext_vector_type(4)));
#define LAS __attribute__((address_space(3)))
#ifndef PROBE_DIAG
#define PROBE_DIAG (0)
#endif
#ifndef PROBE_DUP
#define PROBE_DUP (-1)
#endif
#define GAS __attribute__((address_space(1)))

constexpr int DM = 1024, BATCH = 16, SEQ = 2048, T = BATCH * SEQ;
constexpr int NQKVU = 1280, NGATE = 2048, NCAT = NQKVU + NGATE;
constexpr int COL_K = 512, COL_V = 640, COL_U = 768;
constexpr int NEXP = 16384, PEER_H = 8, TOPK = 16;
constexpr float EPS = 1e-6f;
constexpr int NWAVES = 8, NTHREADS = NWAVES * 64;

constexpr size_t MiB = 1u << 20;
constexpr size_t WS_CTL = 0, CTL_ZERO_BYTES = 64 * 1024;
constexpr size_t WS_WCAT = 1 * MiB;
constexpr size_t WS_WB = 8 * MiB;
constexpr size_t WS_WOUT = 10 * MiB;
constexpr size_t WS_WQ = 12 * MiB;
constexpr size_t WS_POOLW = 16 * MiB;
constexpr size_t WS_SUBK = 16 * MiB + 512 * 1024;
constexpr size_t WS_RS1 = 17 * MiB;
constexpr size_t WS_EIDX = 18 * MiB;
constexpr size_t WS_EGATE = 34 * MiB;
constexpr size_t WS_WCATQ = 50 * MiB;
constexpr size_t WS_WCS = 54 * MiB;
constexpr size_t WS_RSX = 55 * MiB;
constexpr size_t WS_UTAB = 50 * MiB;
constexpr size_t WS_VTAB = 82 * MiB;
constexpr size_t WS_XH = 114 * MiB;
constexpr size_t WS_MERGED = WS_XH;
constexpr size_t WS_QKVU = 178 * MiB;
constexpr size_t WS_X1H = WS_QKVU;
constexpr size_t WS_GATES = 258 * MiB;
constexpr size_t WS_QP = WS_GATES;
constexpr size_t WS_OCAT = 386 * MiB;
constexpr size_t WS_UQ = 450 * MiB;
constexpr size_t WS_VQ = 466 * MiB;
constexpr size_t WS_US = 17 * MiB + 256 * 1024, WS_VS = 17 * MiB + 512 * 1024;
constexpr size_t WS_PDOT = WS_GATES;
constexpr size_t WS_H2Q = 404 * MiB;
constexpr size_t WS_HSC = 403 * MiB;
constexpr size_t WS_SSF = 402 * MiB;
constexpr size_t WS_WQP = 386 * MiB;
constexpr size_t WS_WSC = 390 * MiB;
constexpr size_t WS_ACT = 386 * MiB;
constexpr size_t WS_SS2 = 482 * MiB;
constexpr size_t WS_VT = 484 * MiB;
constexpr size_t WS_END = 492 * MiB;
constexpr int CW_BAR = 4096;

constexpr int RING_OFF = 0, RING_BYTES = 131072;
constexpr int LDSCTL_OFF = RING_BYTES, MISC_OFF = LDSCTL_OFF + 320;
constexpr int LDS_BYTES = 147456;

#define LDS_WAIT() asm volatile("s_waitcnt lgkmcnt(0)" ::: "memory")
template <int CTRL> __device__ __forceinline__ float dppf(float x) { return __uint_as_float(__builtin_amdgcn_update_dpp(0u, __float_as_uint(x), CTRL, 0xf, 0xf, false)); }
template <int CTRL> __device__ __forceinline__ int dppi(int x) { return (int)__builtin_amdgcn_update_dpp(0u, (unsigned)x, CTRL, 0xf, 0xf, false); }
__device__ __forceinline__ float bfly32(float a, float b) { auto r = __builtin_amdgcn_permlane32_swap(__float_as_uint(a), __float_as_uint(b), false, false); return __uint_as_float(r[0]) + __uint_as_float(r[1]); }
__device__ __forceinline__ float bfly16(float a, float b) { auto r = __builtin_amdgcn_permlane16_swap(__float_as_uint(a), __float_as_uint(b), false, false); return __uint_as_float(r[0]) + __uint_as_float(r[1]); }
__device__ __forceinline__ int bfly32i(int a, int b) { auto r = __builtin_amdgcn_permlane32_swap((unsigned)a, (unsigned)b, false, false); return (int)(r[0] + r[1]); }
__device__ __forceinline__ int bfly16i(int a, int b) { auto r = __builtin_amdgcn_permlane16_swap((unsigned)a, (unsigned)b, false, false); return (int)(r[0] + r[1]); }
__device__ __forceinline__ float wave_sum(float x) {
    x += dppf<0x121>(x); x += dppf<0x122>(x); x += dppf<0x124>(x); x += dppf<0x128>(x);
    x = bfly16(x, x); return bfly32(x, x);
}
__device__ __forceinline__ int wave_sum_i(int x) {
    x += dppi<0x121>(x); x += dppi<0x122>(x); x += dppi<0x124>(x); x += dppi<0x128>(x);
    x = bfly16i(x, x); return bfly32i(x, x);
}
__device__ __forceinline__ float wave_max(float x) {
    x = fmaxf(x, dppf<0x121>(x)); x = fmaxf(x, dppf<0x122>(x)); x = fmaxf(x, dppf<0x124>(x)); x = fmaxf(x, dppf<0x128>(x));
    { auto r = __builtin_amdgcn_permlane16_swap(__float_as_uint(x), __float_as_uint(x), false, false); x = fmaxf(__uint_as_float(r[0]), __uint_as_float(r[1])); }
    { auto r = __builtin_amdgcn_permlane32_swap(__float_as_uint(x), __float_as_uint(x), false, false); x = fmaxf(__uint_as_float(r[0]), __uint_as_float(r[1])); }
    return x;
}
__device__ __forceinline__ float gelu_exact(float x) { return 0.5f * x * (1.0f + erff(x * 0.70710678118654752f)); }
__device__ __forceinline__ float rs_from_ss(const float* ss, int t) {
    float s = 0.f;
#pragma unroll
    for (int i = 0; i < 16; ++i) s += ss[(size_t)i * T + t];
    return rsqrtf(s * (1.0f / DM) + EPS);
}

struct Ctx {
    int tid, lane, wave;
    int G;
    int gw, ngw;
    int gt, ngt;
};

__device__ __forceinline__ int pack4_i8(float a, float b, float c, float d) {
    const int ia = (int)rintf(a), ib = (int)rintf(b), ic = (int)rintf(c), id = (int)rintf(d);
    return (ia & 0xff) | ((ib & 0xff) << 8) | ((ic & 0xff) << 16) | (id << 24);
}
template <bool OFFS>
__device__ __forceinline__ void quant_rows(const Ctx& C, const float* __restrict__ tab, unsigned* __restrict__ q, float* __restrict__ scale) {
    const int lane = C.lane;
    for (int r = C.gw; r < NEXP; r += C.ngw) {
        const float* row = tab + (size_t)r * DM;
        f32x4 v[4]; float m = 0.f;
#pragma unroll
        for (int j = 0; j < 4; ++j) { v[j] = *(const f32x4*)(row + j * 256 + lane * 4); m = fmaxf(m, fmaxf(fmaxf(fabsf(v[j][0]), fabsf(v[j][1])), fmaxf(fabsf(v[j][2]), fabsf(v[j][3])))); }
        m = wave_max(m);
        const float inv = m > 0.f ? 127.0f / m : 0.f;
#pragma unroll
        for (int j = 0; j < 4; ++j) {
            unsigned w = (unsigned)pack4_i8(v[j][0] * inv, v[j][1] * inv, v[j][2] * inv, v[j][3] * inv);
            if (OFFS) w ^= 0x80808080u;
            { const int dw = j * 64 + lane; q[(size_t)(dw >> 5) * (NEXP * 32) + (size_t)r * 32 + (dw & 31)] = w; }
        }
        if (lane == 0) scale[r] = m * (1.0f / 127.0f);
    }
}

__device__ __forceinline__ void p0_transpose_item(const float* W, int K, int N, f16* WT, int ldo, int koff, LAS float* scr, int item, int lane) {
    const int nblk = N / 32, kb = item / nblk, nb = item % nblk, k0 = 64 * kb, n0 = 32 * nb;
#pragma unroll 8
    for (int i = 0; i < 32; ++i) { const int kk = 2 * i + (lane >> 5); scr[kk * 33 + (lane & 31)] = W[(size_t)(k0 + kk) * N + n0 + (lane & 31)]; }
    LDS_WAIT(); asm volatile("" ::: "memory");
    const int c = lane & 7;
#pragma unroll
    for (int j = 0; j < 4; ++j) { const int n = (lane >> 3) + 8 * j; const LAS float* s = scr + (8 * c) * 33 + n;
        half8 o;
#pragma unroll
        for (int i = 0; i < 8; ++i) o[i] = (f16)s[i * 33];
        *(half8*)(WT + (size_t)(n0 + n) * ldo + koff + k0 + 8 * c) = o; }
    LDS_WAIT(); asm volatile("" ::: "memory");
}
__device__ __forceinline__ void cvt_stream(const Ctx& C, const float* in, f16* out, size_t n4) {
    for (size_t i = (size_t)C.gt; i < n4; i += (size_t)C.ngt) {
        const f32x4 v = ((const f32x4*)in)[i];
        half4 h; h[0] = (f16)v[0]; h[1] = (f16)v[1]; h[2] = (f16)v[2]; h[3] = (f16)v[3];
        ((half4*)out)[i] = h;
    }
}
__device__ __forceinline__ void rowprep(const Ctx& C, const float* x, const float* g, unsigned* xq, float* rsx, float* ss) {
    const int lane = C.lane;
    f32x4 gg[4];
#pragma unroll
    for (int j = 0; j < 4; ++j) gg[j] = *(const f32x4*)(g + j * 256 + lane * 4);
    for (int tb = C.gw * 4; tb < T; tb += C.ngw * 4) {
        f32x4 v[4][4];
#pragma unroll
        for (int u = 0; u < 4; ++u)
#pragma unroll
            for (int j = 0; j < 4; ++j) v[u][j] = *(const f32x4*)(x + (size_t)(tb + u) * DM + j * 256 + lane * 4);
#pragma unroll
        for (int u = 0; u < 4; ++u) {
            float s = 0.f, am = 0.f;
#pragma unroll
            for (int j = 0; j < 4; ++j) {
                const f32x4 w = v[u][j];
                s += w[0] * w[0] + w[1] * w[1] + w[2] * w[2] + w[3] * w[3];
                v[u][j] = w * gg[j];
                am = fmaxf(am, fmaxf(fmaxf(fabsf(v[u][j][0]), fabsf(v[u][j][1])), fmaxf(fabsf(v[u][j][2]), fabsf(v[u][j][3]))));
            }
            s = wave_sum(s); am = wave_max(am);
            const float inv = am > 0.f ? 127.0f / am : 0.f;
#pragma unroll
            for (int j = 0; j < 4; ++j) xq[(size_t)(tb + u) * 256 + j * 64 + lane] = (unsigned)pack4_i8(v[u][j][0] * inv, v[u][j][1] * inv, v[u][j][2] * inv, v[u][j][3] * inv);
            if (lane == 0) { ss[tb + u] = s; rsx[tb + u] = am * (1.0f / 127.0f); }
        }
    }
}
__device__ __forceinline__ void quant_wrows(const Ctx& C, const f16* __restrict__ w, int rows, unsigned* __restrict__ q, float* __restrict__ scale) {
    const int lane = C.lane;
    for (int r = C.gw; r < rows; r += C.ngw) {
        const half8 a = *(const half8*)(w + (size_t)r * DM + 16 * lane), b = *(const half8*)(w + (size_t)r * DM + 16 * lane + 8);
        float m = 0.f;
#pragma unroll
        for (int i = 0; i < 8; ++i) m = fmaxf(m, fmaxf(fabsf((float)a[i]), fabsf((float)b[i])));
        m = wave_max(m);
        const float inv = m > 0.f ? 127.0f / m : 0.f;
        u32x4 o;
        o[0] = (unsigned)pack4_i8((float)a[0] * inv, (float)a[1] * inv, (float)a[2] * inv, (float)a[3] * inv);
        o[1] = (unsigned)pack4_i8((float)a[4] * inv, (float)a[5] * inv, (float)a[6] * inv, (float)a[7] * inv);
        o[2] = (unsigned)pack4_i8((float)b[0] * inv, (float)b[1] * inv, (float)b[2] * inv, (float)b[3] * inv);
        o[3] = (unsigned)pack4_i8((float)b[4] * inv, (float)b[5] * inv, (float)b[6] * inv, (float)b[7] * inv);
        *(u32x4*)(q + (size_t)r * 256 + 4 * lane) = o;
        if (lane == 0) scale[r] = m * (1.0f / 127.0f);
    }
}
__device__ __forceinline__ void ph_prep(const Ctx& C, LAS unsigned char* lds, const float* const* in, unsigned char* ws) {
    LAS float* scr = (LAS float*)(lds + RING_OFF + C.wave * 16384);
    f16* wcat = (f16*)(ws + WS_WCAT); f16* wb = (f16*)(ws + WS_WB); f16* wout = (f16*)(ws + WS_WOUT); f16* wq = (f16*)(ws + WS_WQ); f16* poolw = (f16*)(ws + WS_POOLW);
    constexpr int I_IN = 16 * 40, I_G = 16 * 64, I_B = 8 * 32, I_O = 16 * 32, I_Q = 16 * 64, I_P = 2 * 4;
    constexpr int NITEMS = I_IN + I_G + 2 * I_B + I_O + I_Q + 4 * I_P;
    for (int it = C.gw; it < NITEMS; it += C.ngw) {
        int r = it;
        if (r < I_IN) { p0_transpose_item(in[2], 1024, 1280, wcat, 1024, 0, scr, r, C.lane); continue; } r -= I_IN;
        if (r < I_G) { p0_transpose_item(in[7], 1024, 2048, wcat + (size_t)NQKVU * 1024, 1024, 0, scr, r, C.lane); continue; } r -= I_G;
        if (r < I_B) { p0_transpose_item(in[6], 512, 1024, wb, 1024, 0, scr, r, C.lane); continue; } r -= I_B;
        if (r < I_B) { p0_transpose_item(in[6] + 512 * 1024, 512, 1024, wb, 1024, 512, scr, r, C.lane); continue; } r -= I_B;
        if (r < I_O) { p0_transpose_item(in[9], 1024, 1024, wout, 1024, 0, scr, r, C.lane); continue; } r -= I_O;
        if (r < I_Q) { p0_transpose_item(in[11], 1024, 2048, wq, 1024, 0, scr, r, C.lane); continue; } r -= I_Q;
        { const int g = r / I_P; p0_transpose_item(in[4] + g * 128 * 128, 128, 128, poolw + g * 128 * 128, 128, 0, scr, r % I_P, C.lane); }
    }
    cvt_stream(C, in[12], (f16*)(ws + WS_SUBK), (size_t)8 * 2 * 128 * 128 / 4);
    rowprep(C, in[0], in[1], (unsigned*)(ws + WS_XH), (float*)(ws + WS_RSX), (float*)(ws + WS_RS1));
}

__device__ __forceinline__ void ph_attn_naive(const Ctx& C, const f16* __restrict__ qkvu, const float* __restrict__ sink, f16* __restrict__ ocat) {
    for (int gid = C.gt; gid < T * 8; gid += C.ngt) {
        const int t = gid % T, h = gid / T;
        const int b = t / SEQ, ts = t % SEQ, kh = h >> 2;
        float q[64], o[64];
        const f16* qr = qkvu + (size_t)t * NQKVU + h * 64;
#pragma unroll
        for (int d = 0; d < 64; ++d) { q[d] = (float)qr[d]; o[d] = 0.f; }
        const float slope = exp2f(-(float)(h + 1));
        float m = -1e30f, l = 0.f;
        const int s0 = max(ts - 128, 0), s1 = min(ts + 128, SEQ - 1);
        for (int s = s0; s <= s1; ++s) {
            const f16* kr = qkvu + (size_t)(b * SEQ + s) * NQKVU + COL_K + kh * 64;
            const f16* vr = qkvu + (size_t)(b * SEQ + s) * NQKVU + COL_V + kh * 64;
            float dot = 0.f;
#pragma unroll
            for (int d = 0; d < 64; ++d) dot += q[d] * (float)kr[d];
            const float lg = dot * 0.125f - slope * fabsf((float)(ts - s));
            const float mn = fmaxf(m, lg), al = __expf(m - mn), p = __expf(lg - mn);
            l = l * al + p;
#pragma unroll
            for (int d = 0; d < 64; ++d) o[d] = o[d] * al + p * (float)vr[d];
            m = mn;
        }
        const float sk = sink[h];
        const float mn = fmaxf(m, sk), al = __expf(m - mn);
        l = l * al + __expf(sk - mn);
        const float inv = al / l;
        f16* orow = ocat + (size_t)t * DM + h * 64;
#pragma unroll
        for (int d = 0; d < 64; ++d) orow[d] = (f16)(o[d] * inv);
    }
}

template <int DIAG = 0>
__device__ __forceinline__ void attn_unit(const Ctx& C, int u, LAS unsigned char* lds, const f16* __restrict__ qkvu, const f16* __restrict__ vT, const float* __restrict__ sink, f16* __restrict__ ocat) {
    const int lane = C.lane, r32 = lane & 31, hh = lane >> 5;
    const int krow = (r32 & 19) | ((r32 & 4) << 1) | ((r32 & 8) >> 1);
    constexpr float L2E = 1.4426950408889634f;
    {
        const int qs = u & 63, h = (u >> 6) & 7, b = u >> 9, kh = h >> 2;
        const int tq = qs * 32 + r32;
        const float slope2 = exp2f(-(float)(h + 1)) * L2E, sink2 = sink[h] * L2E;
        const f16* qrow = qkvu + (size_t)(b * SEQ + tq) * NQKVU + h * 64 + 8 * hh;
        half8 bq[4];
#pragma unroll
        for (int ks = 0; ks < 4; ++ks) bq[ks] = *(const half8*)(qrow + 16 * ks);
        f32x16 o0, o1;
#pragma unroll
        for (int r = 0; r < 16; ++r) { o0[r] = 0.f; o1[r] = 0.f; }
        float m = -1e30f, l = 0.f;
        const int kb_lo = max(qs - 4, 0), kb_hi = min(qs + 4, 63);
        LAS unsigned char* kst = lds + 65536 + C.wave * 8192; LAS unsigned char* vst = kst + 4096;
        const int krw = lane >> 3, kch = lane & 7, vrw = lane >> 2, vch = lane & 3;
        const f16* kg = qkvu + (size_t)(b * SEQ + krw) * NQKVU + COL_K + kh * 64 + kch * 8;
        const f16* vg = vT + (size_t)((b * 2 + kh) * 64 + vrw) * SEQ + vch * 8;
        half8 gk[4], gv[4];
#pragma unroll
        for (int i = 0; i < 4; ++i) { gk[i] = *(const half8*)(kg + (size_t)(kb_lo * 32 + 8 * i) * NQKVU); gv[i] = *(const half8*)(vg + (size_t)(16 * i) * SEQ + kb_lo * 32); }
#pragma unroll 1
        for (int kb = kb_lo; kb <= kb_hi; ++kb) {
#pragma unroll
            for (int i = 0; i < 4; ++i) {
                const int kr = krw + 8 * i; *(LAS half8*)(kst + kr * 128 + ((kch ^ (kr & 7)) << 4)) = gk[i];
                const int vr = vrw + 16 * i; *(LAS half8*)(vst + vr * 64 + ((vch ^ ((vr >> 2) & 3)) << 4)) = gv[i];
            }
            LDS_WAIT();
            half8 kf[4], va[2][2];
#pragma unroll
            for (int ks = 0; ks < 4; ++ks) kf[ks] = *(const LAS half8*)(kst + krow * 128 + (((2 * ks + hh) ^ (krow & 7)) << 4));
#pragma unroll
            for (int db = 0; db < 2; ++db)
#pragma unroll
                for (int st = 0; st < 2; ++st) { const int d = db * 32 + r32; va[db][st] = *(const LAS half8*)(vst + d * 64 + (((2 * st + hh) ^ ((d >> 2) & 3)) << 4)); }
            LDS_WAIT();
            const int kn = (DIAG == 2) ? kb_lo : (kb < kb_hi ? kb + 1 : kb);
#pragma unroll
            for (int i = 0; i < 4; ++i) { gk[i] = *(const half8*)(kg + (size_t)(kn * 32 + 8 * i) * NQKVU); gv[i] = *(const half8*)(vg + (size_t)(16 * i) * SEQ + kn * 32); }
            f32x16 s;
#pragma unroll
            for (int r = 0; r < 16; ++r) s[r] = 0.f;
#pragma unroll
            for (int ks = 0; ks < 4; ++ks) s = __builtin_amdgcn_mfma_f32_32x32x16_f16(kf[ks], bq[ks], s, 0, 0, 0);
            float bmax = -1e30f; bool ok[16];
#pragma unroll
            for (int r = 0; r < 16; ++r) {
                const int tk = kb * 32 + 16 * (r >> 3) + 8 * hh + (r & 7);
                const int dist = abs(tq - tk);
                ok[r] = dist <= 128;
                s[r] = ok[r] ? s[r] * (0.125f * L2E) - slope2 * (float)dist : -1e30f;
                bmax = fmaxf(bmax, s[r]);
            }
            bmax = fmaxf(bmax, __shfl_xor(bmax, 32));
            const float mn = fmaxf(m, bmax), al = exp2f(m - mn);
            m = mn;
            float ps = 0.f; half8 pb[2];
#pragma unroll
            for (int r = 0; r < 16; ++r) { const float p = ok[r] ? (DIAG == 1 ? (s[r] - mn) : exp2f(s[r] - mn)) : 0.f; ps += p; pb[r >> 3][r & 7] = (f16)p; }
            l = l * al + ps;
#pragma unroll
            for (int r = 0; r < 16; ++r) { o0[r] *= al; o1[r] *= al; }
#pragma unroll
            for (int st = 0; st < 2; ++st) { o0 = __builtin_amdgcn_mfma_f32_32x32x16_f16(va[0][st], pb[st], o0, 0, 0, 0); o1 = __builtin_amdgcn_mfma_f32_32x32x16_f16(va[1][st], pb[st], o1, 0, 0, 0); }
        }
        l += __shfl_xor(l, 32);
        const float mf = fmaxf(m, sink2), al = exp2f(m - mf);
        const float sc = al / (l * al + exp2f(sink2 - mf));
        f16* orow = ocat + (size_t)(b * SEQ + tq) * DM + h * 64 + 4 * hh;
#pragma unroll
        for (int g = 0; g < 4; ++g) {
            half4 a, c;
#pragma unroll
            for (int i = 0; i < 4; ++i) { a[i] = (f16)(o0[4 * g + i] * sc); c[i] = (f16)(o1[4 * g + i] * sc); }
            *(half4*)(orow + 8 * g) = a; *(half4*)(orow + 32 + 8 * g) = c;
        }
    }
}

__device__ __forceinline__ void ph_pool_naive(const Ctx& C, const f16* __restrict__ qkvu, f16* __restrict__ mixed) {
    for (size_t gid = (size_t)C.gt; gid < (size_t)T * 512; gid += (size_t)C.ngt) {
        const int c = (int)(gid & 511), t = (int)(gid >> 9);
        const int b = t / SEQ, ts = t % SEQ, g = c >> 7, w = 2 << g;
        const int lo = max(ts - w / 2, 0), hi = min(ts + w / 2, SEQ);
        float s = 0.f;
        for (int i = lo; i < hi; ++i) s += (float)qkvu[(size_t)(b * SEQ + i) * NQKVU + COL_U + c];
        const float mean = s / (float)(hi - lo);
        mixed[(size_t)t * 512 + c] = (f16)(mean - (float)qkvu[(size_t)t * NQKVU + COL_U + c]);
    }
}
__device__ __forceinline__ void ph_poolmm_naive(const Ctx& C, const f16* __restrict__ mixed, const f16* __restrict__ poolw_t, const float* __restrict__ pscale, f16* __restrict__ ocat) {
    for (size_t gid = (size_t)C.gt; gid < (size_t)T * 512; gid += (size_t)C.ngt) {
        const int n = (int)(gid & 511), t = (int)(gid >> 9), g = n >> 7, d = n & 127;
        const f16* mr = mixed + (size_t)t * 512 + g * 128;
        const f16* wr = poolw_t + (size_t)(g * 128 + d) * 128;
        float acc = 0.f;
        for (int c = 0; c < 128; ++c) acc += (float)mr[c] * (float)wr[c];
        ocat[(size_t)t * DM + 512 + n] = (f16)(acc * pscale[n]);
    }
}

template <int HW>
__device__ __forceinline__ void pool_step1(const f16* __restrict__ qkvu, LAS unsigned char* tile, int t0, int g, int lane) {
    const int c2 = lane, b = t0 >> 11, sf = t0 & (SEQ - 1);
    const f16* ub = qkvu + (size_t)(b * SEQ) * NQKVU + COL_U + g * 128 + 2 * c2;
    constexpr int NR = 32 + 2 * HW - 1;
    half2 v[NR];
#pragma unroll
    for (int i = 0; i < NR; ++i) { const int s = sf - HW + i; half2 z; z[0] = (f16)0.f; z[1] = (f16)0.f; v[i] = z; if (s >= 0 && s < SEQ) v[i] = *(const half2*)(ub + (size_t)s * NQKVU); }
    float s0 = 0.f, s1 = 0.f;
#pragma unroll
    for (int i = 0; i < 2 * HW - 1; ++i) { s0 += (float)v[i][0]; s1 += (float)v[i][1]; }
#pragma unroll
    for (int j = 0; j < 32; ++j) {
        s0 += (float)v[j + 2 * HW - 1][0]; s1 += (float)v[j + 2 * HW - 1][1];
        const int s = sf + j, lo = max(s - HW, 0), hi = min(s + HW, SEQ);
        const float inv = 1.0f / (float)(hi - lo);
        half2 mx; mx[0] = (f16)(s0 * inv - (float)v[j + HW][0]); mx[1] = (f16)(s1 * inv - (float)v[j + HW][1]);
        *(LAS half2*)(tile + j * 256 + (((c2 >> 2) ^ (j & 15)) << 4) + ((c2 & 3) << 2)) = mx;
        s0 -= (float)v[j][0]; s1 -= (float)v[j][1];
    }
}
__device__ __forceinline__ void pool_unit(const Ctx& C, int u, LAS unsigned char* lds, const f16* __restrict__ qkvu, const f16* __restrict__ poolw_t, const float* __restrict__ pscale, f16* __restrict__ ocat) {
    const int lane = C.lane, r32 = lane & 31, hh = lane >> 5;
    LAS unsigned char* tile = lds + C.wave * 8192;
    const int g = u & 3, t0 = (u >> 2) * 32;
    switch (g) { case 0: pool_step1<1>(qkvu, tile, t0, g, lane); break; case 1: pool_step1<2>(qkvu, tile, t0, g, lane); break;
                 case 2: pool_step1<4>(qkvu, tile, t0, g, lane); break; default: pool_step1<8>(qkvu, tile, t0, g, lane); break; }
    LDS_WAIT();
    f32x16 acc[4];
#pragma unroll
    for (int db = 0; db < 4; ++db)
#pragma unroll
        for (int r = 0; r < 16; ++r) acc[db][r] = 0.f;
    const f16* wr = poolw_t + (size_t)(g * 128 + r32) * 128 + 8 * hh;
#pragma unroll
    for (int ks = 0; ks < 8; ++ks) {
        const half8 bm = *(const LAS half8*)(tile + r32 * 256 + (((2 * ks + hh) ^ (r32 & 15)) << 4));
#pragma unroll
        for (int db = 0; db < 4; ++db) { const half8 a = *(const half8*)(wr + (size_t)(db * 32) * 128 + 16 * ks); acc[db] = __builtin_amdgcn_mfma_f32_32x32x16_f16(a, bm, acc[db], 0, 0, 0); }
    }
    LDS_WAIT();
    f16* orow = ocat + (size_t)(t0 + r32) * DM + 512 + g * 128 + 4 * hh;
    const float* ps = pscale + g * 128 + 4 * hh;
#pragma unroll
    for (int db = 0; db < 4; ++db)
#pragma unroll
        for (int q = 0; q < 4; ++q) {
            const f32x4 pv = *(const f32x4*)(ps + db * 32 + 8 * q);
            half4 x0;
#pragma unroll
            for (int i = 0; i < 4; ++i) x0[i] = (f16)(acc[db][4 * q + i] * pv[i]);
            *(half4*)(orow + db * 32 + 8 * q) = x0;
        }
}
__device__ __forceinline__ void ph_attn_pool(const Ctx& C, LAS unsigned char* lds, const f16* __restrict__ qkvu, const f16* __restrict__ vT, const float* __restrict__ sink,
                                             const f16* __restrict__ poolw_t, const float* __restrict__ pscale, f16* __restrict__ ocat) {
    for (int m = C.gw; m < (T / 32) * 4; m += C.ngw) {
        if (C.wave & 4) pool_unit(C, m, lds, qkvu, poolw_t, pscale, ocat);
        attn_unit<0>(C, 2 * m, lds, qkvu, vT, sink, ocat);
        attn_unit<0>(C, 2 * m + 1, lds, qkvu, vT, sink, ocat);
        if (!(C.wave & 4)) pool_unit(C, m, lds, qkvu, poolw_t, pscale, ocat);
    }
}

#define INS(LV, LI, v_, i_) do { float cv_ = (v_); int ci_ = (i_); \
    _Pragma("unroll") for (int z_ = 0; z_ < 16; ++z_) { const bool gt_ = cv_ > LV[z_]; const float tv_ = gt_ ? LV[z_] : cv_; const int ti_ = gt_ ? LI[z_] : ci_; \
        LV[z_] = gt_ ? cv_ : LV[z_]; LI[z_] = gt_ ? ci_ : LI[z_]; cv_ = tv_; ci_ = ti_; } } while (0)
__device__ __forceinline__ void ph_route_naive(const Ctx& C, const f16* __restrict__ qp, const float* __restrict__ ss2, const f16* __restrict__ subk, int* __restrict__ eidx, float* __restrict__ egate) {
    for (int gid = C.gt; gid < T * 8; gid += C.ngt) {
        const int t = gid % T, h = gid / T;
        const float rs2 = rs_from_ss(ss2, t);
        float av[16], bv[16]; int ai[16], bi[16];
#pragma unroll
        for (int z = 0; z < 16; ++z) { av[z] = -3e38f; bv[z] = -3e38f; ai[z] = 0; bi[z] = 0; }
        for (int p = 0; p < 2; ++p) {
            const f16* qr = qp + (size_t)t * 2048 + h * 256 + p * 128;
            for (int n = 0; n < 128; ++n) {
                const f16* kr = subk + ((size_t)((h * 2 + p) * 128 + n)) * 128;
                float dot = 0.f;
                for (int c = 0; c < 128; ++c) dot += (float)qr[c] * (float)kr[c];
                dot *= rs2;
                if (p == 0) INS(av, ai, dot, n); else INS(bv, bi, dot, n);
            }
        }
        float cv[16]; int ci[16];
#pragma unroll
        for (int z = 0; z < 16; ++z) { cv[z] = -3e38f; ci[z] = 0; }
#pragma unroll
        for (int i = 0; i < 16; ++i)
#pragma unroll
            for (int j = 0; j < 16; ++j)
                if ((i + 1) * (j + 1) <= 16) INS(cv, ci, av[i] + bv[j], ai[i] * 128 + bi[j]);
        float sum = 0.f, e[16];
#pragma unroll
        for (int z = 0; z < 16; ++z) { e[z] = __expf(cv[z] - cv[0]); sum += e[z]; }
        const float inv = 1.0f / sum;
#pragma unroll
        for (int z = 0; z < 16; ++z) { eidx[(size_t)t * 128 + h * 16 + z] = ci[z]; egate[(size_t)t * 128 + h * 16 + z] = e[z] * inv; }
    }
}

__device__ __forceinline__ int mono_i(float f) { const int b = __float_as_int(f); return b ^ ((b >> 31) & 0x7fffffff); }
__device__ __forceinline__ float unmono_f(int m) { return __int_as_float(m ^ ((m >> 31) & 0x7fffffff)); }
#define INS16(Lst, x_) do { int xv_ = (x_); _Pragma("unroll") for (int z_ = 0; z_ < 16; ++z_) { const int hi_ = max(Lst[z_], xv_); xv_ = min(Lst[z_], xv_); Lst[z_] = hi_; } } while (0)
__device__ __forceinline__ void merge_pair16(int (&Lst)[16]) {
    int P[16];
#pragma unroll
    for (int z = 0; z < 16; ++z) P[z] = __shfl_xor(Lst[z], 32);
#pragma unroll
    for (int z = 0; z < 16; ++z) Lst[z] = max(Lst[z], P[15 - z]);
#pragma unroll
    for (int s = 8; s >= 1; s >>= 1)
#pragma unroll
        for (int i = 0; i < 16; ++i) if ((i & s) == 0) { const int hi = max(Lst[i], Lst[i + s]), lo = min(Lst[i], Lst[i + s]); Lst[i] = hi; Lst[i + s] = lo; }
}
__device__ __forceinline__ void bitonic_sort16_desc(int (&K)[16]) {
#pragma unroll
    for (int k = 2; k <= 16; k <<= 1)
#pragma unroll
        for (int j = k >> 1; j > 0; j >>= 1)
#pragma unroll
            for (int i = 0; i < 16; ++i) { const int l = i ^ j; if (l > i) { const int a = K[i], b = K[l], hi = max(a, b), lo = min(a, b); const bool desc = (i & k) == 0; K[i] = desc ? hi : lo; K[l] = desc ? lo : hi; } }
}
__device__ __forceinline__ void bitonic_merge16_desc(int (&K)[16]) {
#pragma unroll
    for (int s = 8; s >= 1; s >>= 1)
#pragma unroll
        for (int i = 0; i < 16; ++i) if ((i & s) == 0) { const int hi = max(K[i], K[i + s]), lo = min(K[i], K[i + s]); K[i] = hi; K[i + s] = lo; }
}
template <class Side>
__device__ __forceinline__ void ph_route(const Ctx& C, LAS unsigned char* lds, const f16* __restrict__ qp, const float* __restrict__ ss2, const f16* __restrict__ subk,
                                         int* __restrict__ eidx, float* __restrict__ egate, const Side& side_job) {
    const int lane = C.lane, r32 = lane & 31, hh = lane >> 5;
    LAS unsigned char* tab = lds + 65536 + C.wave * 4096 + lane * 36;
    const int GH = C.G < 8 ? C.G : 8;
  for (int h = blockIdx.x % GH; h < 8; h += GH) {
    const int rank_h = blockIdx.x / GH, nwg_h = (C.G - (blockIdx.x % GH) + GH - 1) / GH;
    __syncthreads();
    for (int i = C.tid; i < 2 * 128 * 16; i += NTHREADS) {
        const int row = i >> 4, ch = i & 15;
        *(LAS half8*)(lds + row * 256 + ((ch ^ (row & 15)) << 4)) = *(const half8*)(subk + (size_t)(h * 256 + row) * 128 + ch * 8);
    }
    __syncthreads();
    if (h == (int)(blockIdx.x % GH) && (C.wave & 4)) side_job();
    for (int tb = rank_h * NWAVES + C.wave; tb < T / 32; tb += nwg_h * NWAVES) {
        const int t0 = tb * 32, t = t0 + r32;
        const float rs2 = rs_from_ss(ss2, t);
        int top[2][16];
#pragma unroll
        for (int p = 0; p < 2; ++p) {
            const f16* qrow = qp + (size_t)t * 2048 + h * 256 + p * 128 + 8 * hh;
            const LAS unsigned char* kl = lds + (p * 128 + r32) * 256;
            half8 bq[8];
#pragma unroll
            for (int ks = 0; ks < 8; ++ks) bq[ks] = *(const half8*)(qrow + 16 * ks);
            int Lst[16];
#pragma unroll
            for (int z = 0; z < 16; ++z) Lst[z] = (int)0x80000000;
#pragma unroll 1
            for (int nb = 0; nb < 4; ++nb) {
                f32x16 acc = {0.f, 0.f, 0.f, 0.f, 0.f, 0.f, 0.f, 0.f, 0.f, 0.f, 0.f, 0.f, 0.f, 0.f, 0.f, 0.f};
#pragma unroll
                for (int ks = 0; ks < 8; ++ks) {
                    const half8 ak = *(const LAS half8*)(kl + nb * 32 * 256 + (((2 * ks + hh) ^ (r32 & 15)) << 4));
                    acc = __builtin_amdgcn_mfma_f32_32x32x16_f16(ak, bq[ks], acc, 0, 0, 0);
                }
                int K[16];
#pragma unroll
                for (int r = 0; r < 16; ++r) { const int n = nb * 32 + (r & 3) + 8 * (r >> 2) + 4 * hh; K[r] = (mono_i(acc[r] * rs2) & ~127) | (127 - n); }
                bitonic_sort16_desc(K);
#pragma unroll
                for (int z = 0; z < 16; ++z) Lst[z] = max(Lst[z], K[15 - z]);
                bitonic_merge16_desc(Lst);
            }
            merge_pair16(Lst);
#pragma unroll
            for (int z = 0; z < 16; ++z) top[p][z] = Lst[z];
        }
        float va[16], vb[16];
#pragma unroll
        for (int z = 0; z < 16; ++z) { va[z] = unmono_f(top[0][z] & ~127); vb[z] = unmono_f(top[1][z] & ~127);
            tab[z] = (unsigned char)(127 - (top[0][z] & 127)); tab[16 + z] = (unsigned char)(127 - (top[1][z] & 127)); }
        int Cl[16];
        { const float a01 = hh ? va[1] : va[0];
#pragma unroll
          for (int j = 0; j < 16; ++j) { const int key = (mono_i(a01 + vb[j]) & ~255) | (255 - (hh * 16 + j)); Cl[j] = (hh && j >= 8) ? (int)0x80000000 : key; } }
#pragma unroll
        for (int i = 2; i < 16; i += 2) {
            const float ai = hh ? va[i + 1] : va[i];
#pragma unroll
            for (int j = 0; j < 16; ++j)
                if ((i + 1) * (j + 1) <= 16) {
                    int key = (mono_i(ai + vb[j]) & ~255) | (255 - ((i + hh) * 16 + j));
                    if ((i + 2) * (j + 1) > 16) key = hh ? (int)0x80000000 : key;
                    INS16(Cl, key);
                }
        }
        merge_pair16(Cl);
        float e[16], sum = 0.f; const float mx = unmono_f(Cl[0] & ~255);
#pragma unroll
        for (int z = 0; z < 16; ++z) { e[z] = __expf(unmono_f(Cl[z] & ~255) - mx); sum += e[z]; }
        const float inv = 1.0f / sum;
        LDS_WAIT();
        int* ei = eidx + (size_t)t * 128 + h * 16 + 8 * hh; float* eg = egate + (size_t)t * 128 + h * 16 + 8 * hh;
#pragma unroll
        for (int z = 0; z < 16; ++z) {
            if ((z >> 3) == hh) { const int code = 255 - (Cl[z] & 255); const int ia = tab[code >> 4], ib = tab[16 + (code & 15)];
                ei[z & 7] = ia * 128 + ib; eg[z & 7] = e[z] * inv; }
        }
        LDS_WAIT();
    }
  }
}

struct Slicing { int m, pi, nloc, rank; };
__device__ __forceinline__ Slicing get_slicing(const unsigned* bar, volatile LAS unsigned* misc) {
    Slicing S; const unsigned x = (unsigned)__builtin_amdgcn_s_getreg((3 << 11) | 20) & 0xFu;
    int m = 0, pi = 0, nloc = 1;
    for (unsigned j = 0; j < 16; ++j) { const unsigned c = __hip_atomic_load(&bar[256 + 64 * j], __ATOMIC_RELAXED, __HIP_MEMORY_SCOPE_AGENT); if (c > 0u) { if (j < x) ++pi; ++m; } if (j == x) nloc = (int)c; }
    S.m = m > 0 ? m : 1; S.pi = pi; S.nloc = nloc > 0 ? nloc : 1; S.rank = (int)misc[10];
    return S;
}
__device__ __forceinline__ float gelu_fast(float v) {
    const float av = fabsf(v), t = __builtin_amdgcn_rcpf(av * 0.2316418882f + 1.0f);
    float q = t * 0.5307027145f + (-0.7265760135f); q = q * t + 0.7107068705f; q = q * t + (-0.142248368f); q = q * t + 0.127414796f; q = q * t;
    const float m = v * (q * __builtin_amdgcn_exp2f((v * v) * (-0.72134752044f)));
    return v < 0.f ? m : v - m;
}
__device__ __forceinline__ void ph_h2quant(const Ctx& C, const f16* __restrict__ x1h, const float* __restrict__ ss2, unsigned* __restrict__ h2q, float* __restrict__ hsc) {
    const int lane = C.lane;
    for (int t = C.gw; t < T; t += C.ngw) {
        const half8 h0 = *(const half8*)(x1h + (size_t)t * DM + 16 * lane), h1 = *(const half8*)(x1h + (size_t)t * DM + 16 * lane + 8);
        float hm = 0.f;
#pragma unroll
        for (int i = 0; i < 8; ++i) hm = fmaxf(hm, fmaxf(fabsf((float)h0[i]), fabsf((float)h1[i])));
        hm = wave_max(hm);
        const float inv = hm > 0.f ? 127.0f / hm : 0.f;
        u32x4 w;
        w[0] = (unsigned)pack4_i8((float)h0[0] * inv, (float)h0[1] * inv, (float)h0[2] * inv, (float)h0[3] * inv);
        w[1] = (unsigned)pack4_i8((float)h0[4] * inv, (float)h0[5] * inv, (float)h0[6] * inv, (float)h0[7] * inv);
        w[2] = (unsigned)pack4_i8((float)h1[0] * inv, (float)h1[1] * inv, (float)h1[2] * inv, (float)h1[3] * inv);
        w[3] = (unsigned)pack4_i8((float)h1[4] * inv, (float)h1[5] * inv, (float)h1[6] * inv, (float)h1[7] * inv);
        *(u32x4*)(h2q + (size_t)t * 256 + 4 * lane) = w;
        if (lane == 0) hsc[t] = hm * (1.0f / 127.0f) * rs_from_ss(ss2, t);
    }
}
__device__ __forceinline__ __amdgpu_buffer_rsrc_t slice_rsrc(const unsigned char* base) {
    const unsigned long long b = (unsigned long long)base;
    const unsigned lo = __builtin_amdgcn_readfirstlane((unsigned)b), hi = __builtin_amdgcn_readfirstlane((unsigned)(b >> 32));
    return __builtin_amdgcn_make_buffer_rsrc((void*)(((unsigned long long)hi << 32) | lo), 0, NEXP * 128, 0x00020000);
}
template <int EMASK>
__device__ __forceinline__ void ph_upeer(const Ctx& C, LAS unsigned char* lds, const Slicing SL, const unsigned* __restrict__ h2q, const int* __restrict__ eidx,
                                         const unsigned char* __restrict__ uq, short* __restrict__ pdot) {
    const int lane = C.lane, grp = lane >> 3, c8 = lane & 7;
    const int wv = SL.rank * NWAVES + C.wave, nwv = SL.nloc * NWAVES;
    const int ntok = (T - wv + nwv - 1) / nwv;
    auto tok = [&](int i) { const int t = wv + i * nwv; return t < T ? t : T - 1; };
    volatile LAS int* row = (volatile LAS int*)(lds + C.wave * 1024);
  for (int s = SL.pi; s < 8; s += SL.m) {
    const __amdgpu_buffer_rsrc_t urs = slice_rsrc(uq + (size_t)s * (NEXP * 128));
    const unsigned* hqs = h2q + s * 32 + c8 * 4;
    int tA = tok(0), tB = tok(1);
    int e0 = eidx[(size_t)tA * 128 + lane], e1 = eidx[(size_t)tA * 128 + 64 + lane];
    u32x4 hq = *(const u32x4*)(hqs + (size_t)tA * 256);
    int ne0 = eidx[(size_t)tB * 128 + lane], ne1 = eidx[(size_t)tB * 128 + 64 + lane];
    u32x4 r[16];
#pragma unroll
    for (int i = 0; i < 16; ++i) { const int e = __shfl(i < 8 ? e0 : e1, 8 * (i & 7) + grp) & EMASK; r[i] = __builtin_amdgcn_raw_buffer_load_b128(urs, e * 128 + c8 * 16, 0, 0); }
#pragma unroll 1
    for (int it = 0; it < ntok; ++it) {
        const int t = tok(it), t1 = tok(it + 1), t2 = tok(it + 2);
        const int ze0 = eidx[(size_t)t2 * 128 + lane], ze1 = eidx[(size_t)t2 * 128 + 64 + lane];
        const u32x4 nhq = *(const u32x4*)(hqs + (size_t)t1 * 256);
#pragma unroll
        for (int q = 0; q < 4; ++q) {
            int evv[4];
#pragma unroll
            for (int j = 0; j < 4; ++j) evv[j] = __shfl(q < 2 ? ne0 : ne1, 32 * (q & 1) + 8 * j + grp) & EMASK;
            int pa[4], pb[4];
#pragma unroll
            for (int j = 0; j < 4; ++j) {
                pa[j] = __builtin_amdgcn_sdot4((int)r[4 * q + j][0], (int)hq[0], 0, false); pb[j] = __builtin_amdgcn_sdot4((int)r[4 * q + j][1], (int)hq[1], 0, false);
                pa[j] = __builtin_amdgcn_sdot4((int)r[4 * q + j][2], (int)hq[2], pa[j], false); pb[j] = __builtin_amdgcn_sdot4((int)r[4 * q + j][3], (int)hq[3], pb[j], false);
            }
#pragma unroll
            for (int j = 0; j < 4; ++j) { pa[j] += pb[j]; pa[j] += dppi<0xB1>(pa[j]); }
#pragma unroll
            for (int j = 0; j < 4; ++j) pa[j] += dppi<0x4E>(pa[j]);
#pragma unroll
            for (int j = 0; j < 4; ++j) pa[j] += dppi<0x141>(pa[j]);
            if (c8 == 0) {
#pragma unroll
                for (int j = 0; j < 4; ++j) row[8 * (4 * q + j) + grp] = pa[j];
            }
#pragma unroll
            for (int j = 0; j < 4; ++j) {
                asm volatile("" ::: "memory");
                r[4 * q + j] = __builtin_amdgcn_raw_buffer_load_b128(urs, evv[j] * 128 + c8 * 16, 0, 0);
                asm volatile("" ::: "memory");
            }
        }
        LDS_WAIT();
        const int p0 = row[lane], p1 = row[64 + lane];
        LDS_WAIT();
        { short* pp = pdot + ((size_t)s * T + t) * 128 + lane; const int c0 = min(max((p0 + 4) >> 3, -32768), 32767), c1 = min(max((p1 + 4) >> 3, -32768), 32767);
          asm volatile("global_store_short %0, %1, off\n\tglobal_store_short %0, %2, off offset:128" :: "v"(pp), "v"(c0), "v"(c1) : "memory"); }
        hq = nhq; ne0 = ze0; ne1 = ze1;
    }
  }
}
__device__ __forceinline__ void ph_ureduce(const Ctx& C, LAS unsigned char* lds, const short* __restrict__ pdot, const float* __restrict__ hsc, const int* __restrict__ eidx, const float* __restrict__ us,
                                           const float* __restrict__ vs, const float* __restrict__ egate, unsigned* __restrict__ wqp, float* __restrict__ wsc) {
    const int lane = C.lane;
    volatile LAS unsigned char* row = (volatile LAS unsigned char*)(lds + C.wave * 1024);
    for (int tb = C.gw * 2; tb < T; tb += C.ngw * 2) {
        int e0[2], e1[2], s0[2], s1[2]; float h[2], g0[2], g1[2];
#pragma unroll
        for (int u = 0; u < 2; ++u) {
            const int t = tb + u;
            e0[u] = eidx[(size_t)t * 128 + lane]; e1[u] = eidx[(size_t)t * 128 + 64 + lane];
            g0[u] = egate[(size_t)t * 128 + lane]; g1[u] = egate[(size_t)t * 128 + 64 + lane];
            h[u] = hsc[t]; s0[u] = 0; s1[u] = 0;
#pragma unroll
            for (int s = 0; s < 8; ++s) { const short* pp = pdot + ((size_t)s * T + t) * 128 + lane; s0[u] += (int)pp[0]; s1[u] += (int)pp[64]; }
        }
        float w0[2], w1[2];
#pragma unroll
        for (int u = 0; u < 2; ++u) {
            w0[u] = gelu_fast((float)s0[u] * (8.0f * h[u]) * us[e0[u]]) * g0[u] * vs[e0[u]];
            w1[u] = gelu_fast((float)s1[u] * (8.0f * h[u]) * us[e1[u]]) * g1[u] * vs[e1[u]];
        }
#pragma unroll
        for (int u = 0; u < 2; ++u) {
            const int t = tb + u;
            const float wm = wave_max(fmaxf(fabsf(w0[u]), fabsf(w1[u])));
            const float inv = wm > 0.f ? 127.0f / wm : 0.f;
            { const int k = lane; row[u * 128 + (k & 7) * 16 + (k >> 5) * 4 + ((k >> 3) & 3)] = (unsigned char)(int)rintf(w0[u] * inv); }
            { const int k = 64 + lane; row[u * 128 + (k & 7) * 16 + (k >> 5) * 4 + ((k >> 3) & 3)] = (unsigned char)(int)rintf(w1[u] * inv); }
            if (lane == 0) wsc[t] = wm * (1.0f / 127.0f);
        }
        LDS_WAIT();
        wqp[(size_t)tb * 32 + lane] = ((volatile LAS unsigned*)row)[lane];
        LDS_WAIT();
    }
}
template <int EMASK>
__device__ __forceinline__ void ph_vpeer(const Ctx& C, const Slicing SL, const int* __restrict__ eidx, const unsigned* __restrict__ wqp, const float* __restrict__ wsc, const unsigned char* __restrict__ vq,
                                         const float* xio, float* xout, float* __restrict__ ssf) {
    const int lane = C.lane, grp = lane >> 3, c8 = lane & 7;
    const bool hh = (lane & 32) != 0, b4 = (lane & 16) != 0, b3 = (lane & 8) != 0;
    const int wv = SL.rank * NWAVES + C.wave, nwv = SL.nloc * NWAVES;
    const int ntok = (T - wv + nwv - 1) / nwv;
    auto tok = [&](int i) { const int t = wv + i * nwv; return t < T ? t : T - 1; };
  for (int s = SL.pi; s < 8; s += SL.m) {
    const __amdgpu_buffer_rsrc_t vrs = slice_rsrc(vq + (size_t)s * (NEXP * 128));
    const int chl = 8 * (hh ? 1 : 0) + 4 * (b4 ? 1 : 0) + 2 * (b3 ? 1 : 0);
    const int coff = s * 128 + c8 * 16 + chl;
    int tA = tok(0), tB = tok(1);
    int e0 = eidx[(size_t)tA * 128 + lane], e1 = eidx[(size_t)tA * 128 + 64 + lane];
    u32x4 wq = *(const u32x4*)(wqp + (size_t)tA * 32 + grp * 4); float wscale = wsc[tA];
    int ne0 = eidx[(size_t)tB * 128 + lane], ne1 = eidx[(size_t)tB * 128 + 64 + lane];
    u32x4 r[16];
#pragma unroll
    for (int i = 0; i < 16; ++i) { const int e = __shfl(i < 8 ? e0 : e1, 8 * (i & 7) + grp) & EMASK; r[i] = __builtin_amdgcn_raw_buffer_load_b128(vrs, e * 128 + c8 * 16, 0, 0); }
#pragma unroll 1
    for (int it = 0; it < ntok; ++it) {
        const int t = tok(it), t1 = tok(it + 1), t2 = tok(it + 2);
        const int ze0 = eidx[(size_t)t2 * 128 + lane], ze1 = eidx[(size_t)t2 * 128 + 64 + lane];
        const u32x4 nwq = *(const u32x4*)(wqp + (size_t)t1 * 32 + grp * 4); const float nwscale = wsc[t1];
        const float2 xv = *(const float2*)(xio + (size_t)t * DM + coff);
        int o[16];
#pragma unroll
        for (int c = 0; c < 16; ++c) o[c] = 0;
#pragma unroll
        for (int q = 0; q < 4; ++q) {
            int evv[4];
#pragma unroll
            for (int j = 0; j < 4; ++j) evv[j] = __shfl(q < 2 ? ne0 : ne1, 32 * (q & 1) + 8 * j + grp) & EMASK;
#pragma unroll
            for (int d = 0; d < 4; ++d) {
                const unsigned a = r[4 * q][d], b = r[4 * q + 1][d], c = r[4 * q + 2][d], e = r[4 * q + 3][d];
                const unsigned t0 = __builtin_amdgcn_perm(b, a, 0x05010400u), t1p = __builtin_amdgcn_perm(b, a, 0x07030602u);
                const unsigned u0 = __builtin_amdgcn_perm(e, c, 0x05010400u), u1 = __builtin_amdgcn_perm(e, c, 0x07030602u);
                o[4 * d + 0] = __builtin_amdgcn_sdot4((int)__builtin_amdgcn_perm(u0, t0, 0x05040100u), (int)wq[q], o[4 * d + 0], false);
                o[4 * d + 1] = __builtin_amdgcn_sdot4((int)__builtin_amdgcn_perm(u0, t0, 0x07060302u), (int)wq[q], o[4 * d + 1], false);
                o[4 * d + 2] = __builtin_amdgcn_sdot4((int)__builtin_amdgcn_perm(u1, t1p, 0x05040100u), (int)wq[q], o[4 * d + 2], false);
                o[4 * d + 3] = __builtin_amdgcn_sdot4((int)__builtin_amdgcn_perm(u1, t1p, 0x07060302u), (int)wq[q], o[4 * d + 3], false);
            }
#pragma unroll
            for (int j = 0; j < 4; ++j) {
                asm volatile("" ::: "memory");
                r[4 * q + j] = __builtin_amdgcn_raw_buffer_load_b128(vrs, evv[j] * 128 + c8 * 16, 0, 0);
                asm volatile("" ::: "memory");
            }
        }
        int q8[8], q4[4], q2[2];
#pragma unroll
        for (int k = 0; k < 8; ++k) q8[k] = bfly32i(o[k], o[8 + k]);
#pragma unroll
        for (int k = 0; k < 4; ++k) q4[k] = bfly16i(q8[k], q8[4 + k]);
#pragma unroll
        for (int k = 0; k < 2; ++k) { const int mine = b3 ? q4[2 + k] : q4[k], oth = b3 ? q4[k] : q4[2 + k]; q2[k] = mine + dppi<0x128>(oth); }
        const float y0 = xv.x + (float)q2[0] * wscale, y1 = xv.y + (float)q2[1] * wscale;
        { float* yp = xout + (size_t)t * DM + coff; const float2 yv = make_float2(y0, y1); asm volatile("global_store_dwordx2 %0, %1, off" :: "v"(yp), "v"(yv) : "memory"); }
        const float ss = wave_sum(y0 * y0 + y1 * y1);
        if (lane == 0) { float* sp = ssf + (size_t)s * T + t; asm volatile("global_store_dword %0, %1, off" :: "v"(sp), "v"(ss) : "memory"); }
        wq = nwq; wscale = nwscale; ne0 = ze0; ne1 = ze1;
    }
  }
}
__device__ __forceinline__ void ph_final(const Ctx& C, const float* __restrict__ ssf, float* xio, const float* __restrict__ gf) {
    const int lane = C.lane;
    f32x4 gg[4];
#pragma unroll
    for (int j = 0; j < 4; ++j) gg[j] = *(const f32x4*)(gf + j * 256 + lane * 4);
    for (int tb = C.gw * 4; tb < T; tb += C.ngw * 4) {
        f32x4 v[4][4]; float r[4];
#pragma unroll
        for (int u = 0; u < 4; ++u) {
#pragma unroll
            for (int j = 0; j < 4; ++j) v[u][j] = *(const f32x4*)(xio + (size_t)(tb + u) * DM + j * 256 + lane * 4);
            float s = 0.f;
#pragma unroll
            for (int i = 0; i < 8; ++i) s += ssf[(size_t)i * T + tb + u];
            r[u] = rsqrtf(s * (1.0f / DM) + EPS);
        }
#pragma unroll
        for (int u = 0; u < 4; ++u)
#pragma unroll
            for (int j = 0; j < 4; ++j) *(f32x4*)(xio + (size_t)(tb + u) * DM + j * 256 + lane * 4) = v[u][j] * r[u] * gg[j];
    }
}

namespace pg8 {
#define PG8_LAS __attribute__((address_space(3)))
typedef _Float16 frag8 __attribute__((ext_vector_type(8)));
typedef float f32x4 __attribute__((ext_vector_type(4)));
constexpr int BM = 256, BK = 64, HALF = 128, HTB = HALF * BK * 2  , STAGE_BYTES = 8 * HTB, NXCD = 8, WGM = 8;

__host__ __device__ __forceinline__ int lds_byte(int r, int c) { const int st = (r >> 4) * 2 + (c >> 5), rr = r & 15, cc = c & 31, ob = rr * 64 + cc * 2; return st * 1024 + (ob ^ (((ob >> 9) & 1) << 5)); }
__host__ __device__ __forceinline__ void stage_rc(int b, int& R, int& C) { const int st = b / 1024, sb = b % 1024, swz = sb ^ (((sb >> 9) & 1) << 5); R = (st >> 1) * 16 + swz / 64; C = (st & 1) * 32 + (swz % 64) / 2; }
__host__ __device__ __forceinline__ int perm32(int rho) { const int n = rho >> 4, i = rho & 15; return 8 * (i >> 2) + 4 * n + (i & 3); }

struct Unit { int pm, pn; };
struct Gemm { const f16* A; const f16* Bt; int M, N, K; };

struct StaticOrder {
    int nM, nN, nwg, G, c;
    __host__ __device__ void init(int M, int N, int G_, int c_) { nM = M / BM; nN = N / BM; nwg = nM * nN; G = G_; c = c_; }
    __host__ __device__ bool next(int i, Unit& u) const {
        const long L = (long)i * G + c; if (L >= nwg) return false;
        int wgid = (int)L; { const int q = nwg / NXCD, r = nwg % NXCD, xcd = wgid % NXCD, off = wgid / NXCD; wgid = (xcd < r ? xcd * (q + 1) : r * (q + 1) + (xcd - r) * q) + off; }
        const int nig = WGM * nN, gid = wgid / nig, fm = gid * WGM, gsz = (nM - fm) < WGM ? (nM - fm) : WGM;
        u.pm = fm + ((wgid % nig) % gsz); u.pn = (wgid % nig) / gsz; return true;
    }
    __device__ __forceinline__ void a_ready(const Unit&) const {}
    __device__ __forceinline__ void done(const Unit&) const {}
};

__device__ __forceinline__ frag8 pack8(const f32x4 a, const f32x4 b) {
    frag8 h; h[0] = (f16)a[0]; h[1] = (f16)a[1]; h[2] = (f16)a[2]; h[3] = (f16)a[3]; h[4] = (f16)b[0]; h[5] = (f16)b[1]; h[6] = (f16)b[2]; h[7] = (f16)b[3]; return h;
}
__device__ __forceinline__ float sigmoidf_(float z) { return 1.0f / (1.0f + __expf(-z)); }

struct EpiP1 {
    typedef i32x4 acc_t; static constexpr bool PERM = true, AFTER_DRAIN = false, MIDK = false;
    const float* ss1; const float* rsx; const float* wcs; const float* bgate; f16* qkvu; f16* gates; f16* vT;
    __device__ __forceinline__ void operator()(const i32x4 (&acc)[2][2][4][2], const Unit& u, int wr, int wc, int fr, int fq) const {
        const int row0 = u.pm * BM + wr * 64 + fr, colt = u.pn * BM; const bool isg = colt >= NQKVU;
        f32x4 cs[2][2];
#pragma unroll
        for (int bj = 0; bj < 2; ++bj) { const int c0 = colt + bj * HALF + wc * 32 + 8 * fq; cs[bj][0] = *(const f32x4*)(wcs + c0); cs[bj][1] = *(const f32x4*)(wcs + c0 + 4); }
#pragma unroll
        for (int ai = 0; ai < 2; ++ai)
#pragma unroll
            for (int m = 0; m < 4; ++m) { const int row = row0 + ai * HALF + m * 16; const float r = rsqrtf(ss1[row] * (1.0f / DM) + EPS) * rsx[row];
#pragma unroll
                for (int bj = 0; bj < 2; ++bj) { const int c0 = colt + bj * HALF + wc * 32 + 8 * fq; f32x4 v0, v1;
#pragma unroll
                    for (int i = 0; i < 4; ++i) { v0[i] = (float)acc[ai][bj][m][0][i] * (r * cs[bj][0][i]); v1[i] = (float)acc[ai][bj][m][1][i] * (r * cs[bj][1][i]); }
                    if (isg) { const int cg = c0 - NQKVU; const f32x4 b0 = *(const f32x4*)(bgate + cg), b1 = *(const f32x4*)(bgate + cg + 4);
#pragma unroll
                        for (int i = 0; i < 4; ++i) { v0[i] = sigmoidf_(v0[i] + b0[i]); v1[i] = sigmoidf_(v1[i] + b1[i]); }
                        *(frag8*)(gates + (size_t)row * NGATE + cg) = pack8(v0, v1); }
                    else { const frag8 hv = pack8(v0, v1); *(frag8*)(qkvu + (size_t)row * NQKVU + c0) = hv;
                        if (colt == 512 && bj == 1) {
                            f16* vp = vT + ((size_t)((row >> 11) * 2 + (wc >> 1)) * 64 + (wc & 1) * 32 + 8 * fq) * SEQ + (row & (SEQ - 1));
#pragma unroll
                            for (int i = 0; i < 8; ++i) vp[(size_t)i * SEQ] = hv[i]; } } } }
    }
};
struct EpiMerged {
    typedef f32x4 acc_t; static constexpr bool PERM = true, AFTER_DRAIN = false, MIDK = true;
    const f16* gates; f16* merged;
    __device__ __forceinline__ void mid(f32x4 (&acc)[2][2][4][2], const Unit& u, int wr, int wc, int fr, int fq) const {
        const int row0 = u.pm * BM + wr * 64 + fr, colt = u.pn * BM;
        const f16* gb = gates + (size_t)row0 * NGATE + colt + wc * 32 + 8 * fq;
        asm volatile("" : "+v"(gb));
#pragma unroll
        for (int ai = 0; ai < 2; ++ai) {
            frag8 g0[4][2], g1[4][2];
#pragma unroll
            for (int m = 0; m < 4; ++m)
#pragma unroll
                for (int bj = 0; bj < 2; ++bj) { const f16* gp = gb + (size_t)(ai * HALF + m * 16) * NGATE + bj * HALF; g0[m][bj] = *(const frag8*)gp; g1[m][bj] = *(const frag8*)(gp + DM); }
#pragma unroll
            for (int m = 0; m < 4; ++m)
#pragma unroll
                for (int bj = 0; bj < 2; ++bj)
#pragma unroll
                    for (int i = 0; i < 4; ++i) {
                        acc[ai][bj][m][0][i] *= (float)g0[m][bj][i] * __builtin_amdgcn_rcpf(fmaxf((float)g1[m][bj][i], 1e-4f));
                        acc[ai][bj][m][1][i] *= (float)g0[m][bj][4 + i] * __builtin_amdgcn_rcpf(fmaxf((float)g1[m][bj][4 + i], 1e-4f)); }
            asm volatile("" ::: "memory");
        }
    }
    __device__ __forceinline__ void operator()(const f32x4 (&acc)[2][2][4][2], const Unit& u, int wr, int wc, int fr, int fq) const {
        const int row0 = u.pm * BM + wr * 64 + fr, colt = u.pn * BM;
#pragma unroll
        for (int ai = 0; ai < 2; ++ai)
#pragma unroll
            for (int m = 0; m < 4; ++m) { const int row = row0 + ai * HALF + m * 16;
#pragma unroll
                for (int bj = 0; bj < 2; ++bj) { const int c0 = colt + bj * HALF + wc * 32 + 8 * fq;
                    const frag8 g1 = *(const frag8*)(gates + (size_t)row * NGATE + DM + c0); f32x4 v0, v1;
#pragma unroll
                    for (int i = 0; i < 4; ++i) { v0[i] = acc[ai][bj][m][0][i] * fmaxf((float)g1[i], 1e-4f); v1[i] = acc[ai][bj][m][1][i] * fmaxf((float)g1[4 + i], 1e-4f); }
                    *(frag8*)(merged + (size_t)row * DM + c0) = pack8(v0, v1); } }
    }
};
struct EpiOut {
    typedef f32x4 acc_t; static constexpr bool PERM = false, AFTER_DRAIN = false, MIDK = false;
    const float* x; const float* g2; float* x1; f16* x1h; float* ss2p;
    __device__ __forceinline__ void operator()(const f32x4 (&acc)[2][2][4][2], const Unit& u, int wr, int wc, int fr, int fq) const {
        const int row0 = u.pm * BM + wr * 64 + fr, col0 = u.pn * BM + wc * 32 + 4 * fq;
        f32x4 gv[2][2];
#pragma unroll
        for (int bj = 0; bj < 2; ++bj)
#pragma unroll
            for (int n = 0; n < 2; ++n) gv[bj][n] = *(const f32x4*)(g2 + col0 + bj * HALF + n * 16);
#pragma unroll
        for (int ai = 0; ai < 2; ++ai)
#pragma unroll
            for (int m = 0; m < 4; ++m) { const int row = row0 + ai * HALF + m * 16; const size_t off = (size_t)row * DM + col0; float ssq = 0.f;
#pragma unroll
                for (int bj = 0; bj < 2; ++bj)
#pragma unroll
                    for (int n = 0; n < 2; ++n) { const f32x4 y = *(const f32x4*)(x + off + bj * HALF + n * 16) + acc[ai][bj][m][n];
                        *(f32x4*)(x1 + off + bj * HALF + n * 16) = y; ssq += (y[0] * y[0] + y[1] * y[1]) + (y[2] * y[2] + y[3] * y[3]);
                        const f32x4 yg = y * gv[bj][n]; half4 h; h[0] = (f16)yg[0]; h[1] = (f16)yg[1]; h[2] = (f16)yg[2]; h[3] = (f16)yg[3];
                        *(half4*)(x1h + off + bj * HALF + n * 16) = h; }
                ssq += __shfl_xor(ssq, 16); ssq += __shfl_xor(ssq, 32);
                if (fq == 0) ss2p[(size_t)(u.pn * 4 + wc) * T + row] = ssq; }
    }
};
struct EpiQ {
    typedef f32x4 acc_t; static constexpr bool PERM = true, AFTER_DRAIN = false, MIDK = false;
    f16* qp;
    __device__ __forceinline__ void operator()(const f32x4 (&acc)[2][2][4][2], const Unit& u, int wr, int wc, int fr, int fq) const {
        const int row0 = u.pm * BM + wr * 64 + fr, colt = u.pn * BM;
#pragma unroll
        for (int ai = 0; ai < 2; ++ai)
#pragma unroll
            for (int m = 0; m < 4; ++m) { const int row = row0 + ai * HALF + m * 16;
#pragma unroll
                for (int bj = 0; bj < 2; ++bj) { const int c0 = colt + bj * HALF + wc * 32 + 8 * fq;
                    *(frag8*)(qp + (size_t)row * 2048 + c0) = pack8(acc[ai][bj][m][0], acc[ai][bj][m][1]); } }
    }
};

__device__ __forceinline__ void mma16(const frag8 b, const frag8 a, f32x4& c) { c = __builtin_amdgcn_mfma_f32_16x16x32_f16(b, a, c, 0, 0, 0); }
__device__ __forceinline__ void mma16(const frag8 b, const frag8 a, i32x4& c) { c = __builtin_amdgcn_mfma_i32_16x16x64_i8(__builtin_bit_cast(i32x4, b), __builtin_bit_cast(i32x4, a), c, 0, 0, 0); }
template <class Epi, class Sched, bool ALIGN_EPI = false, bool SP2 = false>
__device__ __forceinline__ void gemm_phase(PG8_LAS unsigned char* lds, const Gemm g, const Sched& S, const Epi& E) {
    const int tid = threadIdx.x, wid = __builtin_amdgcn_readfirstlane(tid >> 6), lane = tid & 63, wr = wid >> 2, wc = wid & 3, fr = lane & 15, fq = lane >> 4;
    const int K = g.K, nt = K / BK;
    unsigned voffA[2], voffB[2];
#pragma unroll
    for (int i = 0; i < 2; ++i) { int R, C; stage_rc(tid * 16 + i * 8192, R, C); const int Rb = Epi::PERM ? ((R & ~31) + perm32(R & 31)) : R;
        voffA[i] = (unsigned)(R * K + C) * 2u; voffB[i] = (unsigned)(Rb * K + C) * 2u; }
    const size_t kstep = (size_t)(BK * 2);
    const size_t hstep = (size_t)HALF * K * 2;
    const size_t tstep = 2 * hstep;
    const unsigned ldsw = (unsigned)wid * 1024u;
    const int aoff = lds_byte(wr * 64 + fr, fq * 8), boff = lds_byte(wc * 32 + fr, fq * 8);
#define PG8_SA(b, h) (((b) * 2 + (h)) * HTB)
#define PG8_SB(b, h) ((4 + (b) * 2 + (h)) * HTB)
#define PG8_STAGE(bufoff, gbase, voff) do { _Pragma("unroll") for (int _i = 0; _i < 2; ++_i) \
        __builtin_amdgcn_global_load_lds((const unsigned*)((const char*)(gbase) + (voff)[_i]), (PG8_LAS unsigned*)(lds + (bufoff) + ldsw + _i * 8192), 16, 0, 0); } while (0)
#define PG8_LDA(dst, b, h) do { _Pragma("unroll") for (int m = 0; m < 4; ++m) _Pragma("unroll") for (int k = 0; k < 2; ++k) dst[m][k] = *(const PG8_LAS frag8*)(lds + PG8_SA(b, h) + aoff + m * 2048 + k * 1024); } while (0)
#define PG8_LDB(dst, b, h) do { _Pragma("unroll") for (int n = 0; n < 2; ++n) _Pragma("unroll") for (int k = 0; k < 2; ++k) dst[n][k] = *(const PG8_LAS frag8*)(lds + PG8_SB(b, h) + boff + n * 2048 + k * 1024); } while (0)
#define PG8_MMA(ai, bj, At, Bt) do { __builtin_amdgcn_s_setprio(1); _Pragma("unroll") for (int m = 0; m < 4; ++m) _Pragma("unroll") for (int n = 0; n < 2; ++n) _Pragma("unroll") for (int k = 0; k < 2; ++k) \
        mma16(Bt[n][k], At[m][k], acc[ai][bj][m][n]); __builtin_amdgcn_s_setprio(0); } while (0)
#define PG8_WAIT_V(n) asm volatile("s_waitcnt vmcnt(" #n ")" ::: "memory")
#define PG8_WAIT_L(n) asm volatile("s_waitcnt lgkmcnt(" #n ")" ::: "memory")
#define PG8_BAR __builtin_amdgcn_s_barrier()
#define PG8_SCHED __builtin_amdgcn_sched_barrier(0)
    Unit cur, nxt; int ui = 0;
    if (!S.next(0, cur)) return;
    typedef typename Epi::acc_t acc_t;
    acc_t acc[2][2][4][2];
#pragma unroll
    for (int a = 0; a < 2; ++a)
#pragma unroll
        for (int b = 0; b < 2; ++b)
#pragma unroll
            for (int m = 0; m < 4; ++m)
#pragma unroll
                for (int n = 0; n < 2; ++n) acc[a][b][m][n] = acc_t{};
    frag8 At[4][2], B0[2][2], B1[2][2];
    const char* cA = (const char*)g.A + (size_t)cur.pm * tstep; const char* cB = (const char*)g.Bt + (size_t)cur.pn * tstep;
    S.a_ready(cur);
    if constexpr (SP2) {
        PG8_STAGE(PG8_SB(0, 0), cB, voffB); PG8_STAGE(PG8_SB(0, 1), cB + hstep, voffB); PG8_STAGE(PG8_SA(0, 0), cA, voffA); PG8_STAGE(PG8_SA(0, 1), cA + hstep, voffA);
        if (wr == 1) PG8_BAR;
        PG8_WAIT_V(2); PG8_BAR;
        PG8_STAGE(PG8_SB(1, 0), cB + kstep, voffB); PG8_STAGE(PG8_SA(1, 0), cA + kstep, voffA); PG8_STAGE(PG8_SB(1, 1), cB + hstep + kstep, voffB);
        PG8_WAIT_V(6); PG8_BAR;
    } else {
        PG8_STAGE(PG8_SB(0, 0), cB, voffB); PG8_STAGE(PG8_SA(0, 0), cA, voffA); PG8_STAGE(PG8_SB(0, 1), cB + hstep, voffB); PG8_STAGE(PG8_SA(0, 1), cA + hstep, voffA);
        if (wr == 1) PG8_BAR;
        PG8_WAIT_V(4); PG8_BAR;
        PG8_STAGE(PG8_SB(1, 0), cB + kstep, voffB); PG8_STAGE(PG8_SA(1, 0), cA + kstep, voffA); PG8_STAGE(PG8_SB(1, 1), cB + hstep + kstep, voffB);
        PG8_WAIT_V(6); PG8_BAR;
    }
    for (;;) {
        const bool has_next = S.next(ui + 1, nxt);
        const char* nA = has_next ? (const char*)g.A + (size_t)nxt.pm * tstep : cA; const char* nB = has_next ? (const char*)g.Bt + (size_t)nxt.pn * tstep : cB;
        for (int t = 0; t < nt; t += 2) {
            const bool last = (t == nt - 2);
            if constexpr (Epi::MIDK) { if (t == (nt >> 1)) E.mid(acc, cur, wr, wc, fr, fq); }
            const char* a1 = cA + (size_t)(t + 1) * kstep;
            const char* a2 = last ? nA : cA + (size_t)(t + 2) * kstep; const char* b2 = last ? nB : cB + (size_t)(t + 2) * kstep;
            const char* a3 = a2 + kstep; const char* b3 = b2 + kstep;
            if (last && has_next) S.a_ready(nxt);
            if constexpr (SP2) {
            PG8_LDB(B0, 0, 0); PG8_LDB(B1, 0, 1); PG8_SCHED; PG8_LDA(At, 0, 0); PG8_STAGE(PG8_SA(1, 1), a1 + hstep, voffA);
            PG8_WAIT_V(8); PG8_WAIT_L(0); PG8_BAR; PG8_MMA(0, 0, At, B0); PG8_MMA(0, 1, At, B1); PG8_BAR; PG8_SCHED;
            PG8_LDA(At, 0, 1); PG8_STAGE(PG8_SB(0, 0), b2, voffB); PG8_STAGE(PG8_SB(0, 1), b2 + hstep, voffB); PG8_STAGE(PG8_SA(0, 0), a2, voffA);
            PG8_WAIT_V(8); PG8_WAIT_L(0); PG8_BAR; PG8_MMA(1, 0, At, B0); PG8_MMA(1, 1, At, B1); PG8_BAR; PG8_SCHED;
            PG8_LDB(B0, 1, 0); PG8_LDB(B1, 1, 1); PG8_SCHED; PG8_LDA(At, 1, 0); PG8_STAGE(PG8_SA(0, 1), a2 + hstep, voffA);
            PG8_WAIT_V(8); PG8_WAIT_L(0); PG8_BAR; PG8_MMA(0, 0, At, B0); PG8_MMA(0, 1, At, B1); PG8_BAR; PG8_SCHED;
            PG8_LDA(At, 1, 1); PG8_STAGE(PG8_SB(1, 0), b3, voffB); PG8_STAGE(PG8_SB(1, 1), b3 + hstep, voffB); PG8_STAGE(PG8_SA(1, 0), a3, voffA);
            PG8_WAIT_V(8); PG8_WAIT_L(0); PG8_BAR; PG8_MMA(1, 0, At, B0); PG8_MMA(1, 1, At, B1); PG8_BAR; PG8_SCHED;
            } else {
            PG8_LDB(B0, 0, 0); PG8_SCHED; PG8_LDA(At, 0, 0); PG8_STAGE(PG8_SA(1, 1), a1 + hstep, voffA);
            PG8_WAIT_L(8); PG8_BAR; PG8_WAIT_L(0); PG8_MMA(0, 0, At, B0); PG8_BAR; PG8_SCHED;
            PG8_LDB(B1, 0, 1); PG8_STAGE(PG8_SB(0, 0), b2, voffB);
            PG8_BAR; PG8_WAIT_L(0); PG8_MMA(0, 1, At, B1); PG8_BAR;
            PG8_LDA(At, 0, 1); PG8_STAGE(PG8_SA(0, 0), a2, voffA);
            PG8_BAR; PG8_WAIT_L(0); PG8_MMA(1, 0, At, B0); PG8_BAR; PG8_SCHED;
            PG8_STAGE(PG8_SB(0, 1), b2 + hstep, voffB);
            PG8_WAIT_V(6); PG8_BAR; PG8_MMA(1, 1, At, B1); PG8_BAR;
            PG8_LDB(B0, 1, 0); PG8_SCHED; PG8_LDA(At, 1, 0); PG8_STAGE(PG8_SA(0, 1), a2 + hstep, voffA);
            PG8_WAIT_L(8); PG8_BAR; PG8_WAIT_L(0); PG8_MMA(0, 0, At, B0); PG8_BAR; PG8_SCHED;
            PG8_LDB(B1, 1, 1); PG8_STAGE(PG8_SB(1, 0), b3, voffB);
            PG8_BAR; PG8_WAIT_L(0); PG8_MMA(0, 1, At, B1); PG8_BAR;
            PG8_LDA(At, 1, 1); PG8_STAGE(PG8_SA(1, 0), a3, voffA);
            PG8_BAR; PG8_WAIT_L(0); PG8_MMA(1, 0, At, B0); PG8_BAR; PG8_SCHED;
            PG8_STAGE(PG8_SB(1, 1), b3 + hstep, voffB);
            PG8_WAIT_V(6); PG8_BAR; PG8_MMA(1, 1, At, B1); PG8_BAR;
            }
        }
        if constexpr (ALIGN_EPI) { if (wr == 0) PG8_BAR; }
        if constexpr (!Epi::AFTER_DRAIN) { E(acc, cur, wr, wc, fr, fq); S.done(cur); }
        if (!has_next) break;
#pragma unroll
        for (int a = 0; a < 2; ++a)
#pragma unroll
            for (int b = 0; b < 2; ++b)
#pragma unroll
                for (int m = 0; m < 4; ++m)
#pragma unroll
                    for (int n = 0; n < 2; ++n) acc[a][b][m][n] = acc_t{};
        cur = nxt; cA = nA; cB = nB; ++ui;
        if constexpr (ALIGN_EPI) { if (wr == 1) PG8_BAR; }
    }
    PG8_WAIT_V(0);
    if constexpr (!ALIGN_EPI) { if (wr == 0) PG8_BAR; }
    PG8_BAR;
    if constexpr (Epi::AFTER_DRAIN) { E.fused(acc, cur, wr, wc, fr, fq, lds, wid, lane); S.done(cur); }
#undef PG8_SA
#undef PG8_SB
#undef PG8_STAGE
#undef PG8_LDA
#undef PG8_LDB
#undef PG8_MMA
#undef PG8_WAIT_V
#undef PG8_WAIT_L
#undef PG8_BAR
#undef PG8_SCHED
}
}

#define XB_TMO      128
#define XB_XCNT(j)  (256  + 64 * (j))
#define XB_XSUB(j)  (1280 + 64 * (j))
#define XB_XGEN(j)  (2304 + 64 * (j))
#define XB_TOP      3328
#define XB_TOPGEN   3392
#define XCD_BAR_WORDS 3456
#define XB_SPIN_CAP (1u << 18)

__device__ __forceinline__ unsigned xb_ld(unsigned* p)              { return __hip_atomic_load(p, __ATOMIC_RELAXED, __HIP_MEMORY_SCOPE_AGENT); }
__device__ __forceinline__ unsigned xb_add(unsigned* p, unsigned v) { return __hip_atomic_fetch_add(p, v, __ATOMIC_RELAXED, __HIP_MEMORY_SCOPE_AGENT); }
__device__ __forceinline__ unsigned xb_xcc_id() { return (unsigned)__builtin_amdgcn_s_getreg((3 << 11) | 20) & 0xFu; }
#define XB_SPIN(cond, bar) do { unsigned _sp = 0; while (cond) { __builtin_amdgcn_s_sleep(1); \
    if ((++_sp & 255u) == 0u) { if (xb_ld(&(bar)[XB_TMO])) break; if (_sp > XB_SPIN_CAP) { atomicAdd(&(bar)[XB_TMO], 1u); break; } } } } while (0)

struct XcdBarrier {
    unsigned* bar; unsigned x;
    volatile LAS unsigned* st;
};

__device__ __forceinline__ XcdBarrier xcd_barrier_post(unsigned* bar, volatile LAS unsigned* st) {
    XcdBarrier b; b.bar = bar; b.x = xb_xcc_id(); b.st = st;
    if (threadIdx.x == 0) st[2] = xb_add(&bar[XB_XCNT(b.x)], 1u);
    return b;
}
__device__ __forceinline__ void xcd_barrier_complete(unsigned* bar, unsigned x, unsigned& nloc, unsigned& nx) {
    const unsigned G = gridDim.x * gridDim.y * gridDim.z;
    unsigned sum, cnt, mine, sp = 0u;
    for (;;) {
        sum = 0u; cnt = 0u; mine = 0u;
#pragma unroll
        for (unsigned j = 0; j < 16; ++j) { const unsigned c = xb_ld(&bar[XB_XCNT(j)]); sum += c; cnt += (c > 0u) ? 1u : 0u; mine = (j == x) ? c : mine; }
        if (sum == G) break;
        __builtin_amdgcn_s_sleep(1);
        if ((++sp & 255u) == 0u) { if (xb_ld(&bar[XB_TMO])) break; if (sp > XB_SPIN_CAP) { atomicAdd(&bar[XB_TMO], 1u); break; } }
    }
    nloc = mine > 0u ? mine : 1u; nx = cnt > 0u ? cnt : 1u;
}

__device__ __forceinline__ void xcd_barrier(const XcdBarrier& b) {
    asm volatile("s_waitcnt vmcnt(0)" ::: "memory");
    __syncthreads();
    if (threadIdx.x == 0) {
        unsigned* bar = b.bar;
        __builtin_amdgcn_s_waitcnt(0);
        unsigned nloc = b.st[0], nx = b.st[1];
        if (nloc == 0u) { xcd_barrier_complete(bar, b.x, nloc, nx); b.st[0] = nloc; b.st[1] = nx; }
        const unsigned old = xb_add(&bar[XB_XSUB(b.x)], 1u);
        const unsigned gen = old / nloc;
        if (old + 1u == (gen + 1u) * nloc) {
            __builtin_amdgcn_fence(__ATOMIC_RELEASE, "agent");
            asm volatile("s_waitcnt vmcnt(0)" ::: "memory");
            const unsigned og = xb_add(&bar[XB_TOP], 1u);
            const unsigned tg = og / nx;
            if (og + 1u == (tg + 1u) * nx) xb_add(&bar[XB_TOPGEN], 1u);
            else XB_SPIN(xb_ld(&bar[XB_TOPGEN]) == tg, bar);
            __builtin_amdgcn_fence(__ATOMIC_ACQUIRE, "agent");
            xb_add(&bar[XB_XGEN(b.x)], 1u);
            asm volatile("s_waitcnt vmcnt(0)" ::: "memory");
        } else {
            XB_SPIN(xb_ld(&bar[XB_XGEN(b.x)]) == gen, bar);
            __builtin_amdgcn_fence(__ATOMIC_ACQUIRE, "agent");
            asm volatile("s_waitcnt vmcnt(0)" ::: "memory");
        }
    }
    __syncthreads();
}


struct Args { const float* in[16]; float* out; unsigned char* ws; int ph_lo, ph_hi; };
constexpr int N_PHASES = 11;

__global__ void __launch_bounds__(NTHREADS, 2) mk_fwd(Args a) {
    extern __shared__ __attribute__((aligned(16))) unsigned char lds[];
    LAS unsigned char* L = (LAS unsigned char*)lds;
    volatile LAS unsigned* MISC = (volatile LAS unsigned*)(L + MISC_OFF);
    unsigned char* ws = a.ws;
    Ctx C;
    C.tid = threadIdx.x; C.lane = C.tid & 63; C.wave = __builtin_amdgcn_readfirstlane(C.tid >> 6);
    C.G = gridDim.x; C.gw = blockIdx.x * NWAVES + C.wave; C.ngw = C.G * NWAVES; C.gt = blockIdx.x * NTHREADS + C.tid; C.ngt = C.G * NTHREADS;
    for (int u = C.tid; u < (LDS_BYTES - LDSCTL_OFF) / 4; u += NTHREADS) ((LAS unsigned*)(L + LDSCTL_OFF))[u] = 0u;
    __syncthreads();
    const int lo = a.ph_lo, hi = a.ph_hi, G = C.G;
    const bool multi = (hi - lo) > 1;
    XcdBarrier bar; bar.bar = (unsigned*)(ws + WS_CTL) + CW_BAR; bar.x = 0; bar.st = nullptr;
    if (multi) bar = xcd_barrier_post((unsigned*)(ws + WS_CTL) + CW_BAR, MISC + 8);
#define IN(k) (lo <= (k) && (k) < hi)
#define SEAM(k) do { if (IN(k) && IN((k) + 1)) xcd_barrier(bar); } while (0)

#define REPS(k) for (int rep_ = 0; rep_ < ((PROBE_DUP == (k)) ? 2 : 1); ++rep_)
#define REPBAR(k) do { if (PROBE_DUP == (k) && rep_ == 0) xcd_barrier(bar); } while (0)
    if (IN(0)) REPS(0) { ph_prep(C, L, a.in, ws); REPBAR(0); }
    SEAM(0);
    if (IN(1)) {
        quant_wrows(C, (const f16*)(ws + WS_WCAT), NCAT, (unsigned*)(ws + WS_WCATQ), (float*)(ws + WS_WCS));
        xcd_barrier(bar);
        pg8::Gemm g{(const f16*)(ws + WS_XH), (const f16*)(ws + WS_WCATQ), T, NCAT, DM / 2}; pg8::StaticOrder S; S.init(T, NCAT, G, (int)blockIdx.x);
        pg8::EpiP1 E{(const float*)(ws + WS_RS1), (const float*)(ws + WS_RSX), (const float*)(ws + WS_WCS), a.in[8], (f16*)(ws + WS_QKVU), (f16*)(ws + WS_GATES), (f16*)(ws + WS_VT)};
        pg8::gemm_phase<pg8::EpiP1, pg8::StaticOrder, true, true>(L, g, S, E);
    }
    SEAM(1);
    if (IN(2)) REPS(2) {
        ph_attn_pool(C, L, (const f16*)(ws + WS_QKVU), (const f16*)(ws + WS_VT), a.in[3], (const f16*)(ws + WS_POOLW), a.in[5], (f16*)(ws + WS_OCAT));
        REPBAR(2);
    }
    if (IN(2) && IN(4)) xcd_barrier(bar);
    if (IN(4)) REPS(4) {
        pg8::Gemm g{(const f16*)(ws + WS_OCAT), (const f16*)(ws + WS_WB), T, DM, DM}; pg8::StaticOrder S; S.init(T, DM, G, (int)blockIdx.x);
        pg8::EpiMerged E{(const f16*)(ws + WS_GATES), (f16*)(ws + WS_MERGED)};
        pg8::gemm_phase<pg8::EpiMerged, pg8::StaticOrder, true, true>(L, g, S, E);
        REPBAR(4);
    }
    SEAM(4);
    if (IN(5)) REPS(5) {
        pg8::Gemm g{(const f16*)(ws + WS_MERGED), (const f16*)(ws + WS_WOUT), T, DM, DM}; pg8::StaticOrder S; S.init(T, DM, G, (int)blockIdx.x);
        pg8::EpiOut E{a.in[0], a.in[10], a.out, (f16*)(ws + WS_X1H), (float*)(ws + WS_SS2)};
        pg8::gemm_phase<pg8::EpiOut, pg8::StaticOrder, true, true>(L, g, S, E);
        REPBAR(5);
    }
    SEAM(5);
    if (IN(6)) REPS(6) {
        pg8::Gemm g{(const f16*)(ws + WS_X1H), (const f16*)(ws + WS_WQ), T, 2048, DM}; pg8::StaticOrder S; S.init(T, 2048, G, (int)blockIdx.x);
        pg8::EpiQ E{(f16*)(ws + WS_QP)};
        pg8::gemm_phase<pg8::EpiQ, pg8::StaticOrder, true, true>(L, g, S, E);
        REPBAR(6);
    }
    SEAM(6);
    if (IN(7)) REPS(7) {
        auto side = [&]() {
            ph_h2quant(C, (const f16*)(ws + WS_X1H), (const float*)(ws + WS_SS2), (unsigned*)(ws + WS_H2Q), (float*)(ws + WS_HSC));
            quant_rows<false>(C, a.in[13], (unsigned*)(ws + WS_UQ), (float*)(ws + WS_US));
            quant_rows<false>(C, a.in[14], (unsigned*)(ws + WS_VQ), (float*)(ws + WS_VS));
        };
        ph_route(C, L, (const f16*)(ws + WS_QP), (const float*)(ws + WS_SS2), (const f16*)(ws + WS_SUBK), (int*)(ws + WS_EIDX), (float*)(ws + WS_EGATE), side);
        if (!(C.wave & 4)) side();
        REPBAR(7); }
    SEAM(7);
    if (IN(8)) REPS(8) {
        const Slicing SL = get_slicing((const unsigned*)(ws + WS_CTL) + CW_BAR, MISC);
        if (PROBE_DUP == 8 && rep_ == 0) ph_upeer<255>(C, L, SL, (const unsigned*)(ws + WS_H2Q), (const int*)(ws + WS_EIDX), (const unsigned char*)(ws + WS_UQ), (short*)(ws + WS_PDOT));
        else ph_upeer<16383>(C, L, SL, (const unsigned*)(ws + WS_H2Q), (const int*)(ws + WS_EIDX), (const unsigned char*)(ws + WS_UQ), (short*)(ws + WS_PDOT));
        REPBAR(8);
    }
    SEAM(8);
    if (IN(9)) {
        ph_ureduce(C, L, (const short*)(ws + WS_PDOT), (const float*)(ws + WS_HSC), (const int*)(ws + WS_EIDX), (const float*)(ws + WS_US), (const float*)(ws + WS_VS), (const float*)(ws + WS_EGATE),
                   (unsigned*)(ws + WS_WQP), (float*)(ws + WS_WSC));
        xcd_barrier(bar);
        const Slicing SL = get_slicing((const unsigned*)(ws + WS_CTL) + CW_BAR, MISC);
        if (PROBE_DUP == 9) {
            ph_vpeer<255>(C, SL, (const int*)(ws + WS_EIDX), (const unsigned*)(ws + WS_WQP), (const float*)(ws + WS_WSC), (const unsigned char*)(ws + WS_VQ), a.out, (float*)(ws + WS_QP), (float*)(ws + WS_MERGED));
            xcd_barrier(bar);
        }
        if (PROBE_DUP == 19) {
            ph_vpeer<16383>(C, SL, (const int*)(ws + WS_EIDX), (const unsigned*)(ws + WS_WQP), (const float*)(ws + WS_WSC), (const unsigned char*)(ws + WS_VQ), a.out, (float*)(ws + WS_QP), (float*)(ws + WS_MERGED));
            xcd_barrier(bar);
        }
        ph_vpeer<16383>(C, SL, (const int*)(ws + WS_EIDX), (const unsigned*)(ws + WS_WQP), (const float*)(ws + WS_WSC), (const unsigned char*)(ws + WS_VQ), a.out, a.out, (float*)(ws + WS_SSF));
    }
    SEAM(9);
    if (IN(10)) { ph_final(C, (const float*)(ws + WS_SSF), a.out, a.in[15]); }
#undef IN
#undef SEAM
}

#ifndef MK_N_LAUNCHES
#define MK_N_LAUNCHES 1
#endif
extern "C" void kernel_launch(void* const* d_in, const int* in_sizes, int n_in, void* d_out, int out_size, void* d_ws, size_t ws_size, hipStream_t stream) {
    static int grid = 0;
    if (grid == 0) {
        if (n_in != 16 || in_sizes[0] != T * DM || out_size != T * DM || ws_size < WS_END) {
            fprintf(stderr, "kernel_launch: unexpected shapes (n_in %d in0 %d out %d ws %zu)\n", n_in, n_in > 0 ? in_sizes[0] : -1, out_size, ws_size);
            grid = -1; return;
        }
        int dev = 0, cus = 0;
        if (hipGetDevice(&dev) != hipSuccess || hipDeviceGetAttribute(&cus, hipDeviceAttributeMultiprocessorCount, dev) != hipSuccess) { grid = -1; return; }
        if (hipFuncSetAttribute((const void*)mk_fwd, hipFuncAttributeMaxDynamicSharedMemorySize, LDS_BYTES) != hipSuccess) { fprintf(stderr, "kernel_launch: hipFuncSetAttribute failed\n"); grid = -1; return; }
        int per_cu = 0;
        if (hipOccupancyMaxActiveBlocksPerMultiprocessor(&per_cu, (const void*)mk_fwd, NTHREADS, LDS_BYTES) != hipSuccess || per_cu < 1)
            fprintf(stderr, "kernel_launch: occupancy query reports %d workgroups per CU\n", per_cu);
        (void)hipGetLastError();
        grid = cus;
    }
    if (grid < 0) return;
    (void)hipMemsetAsync((char*)d_ws + WS_CTL, 0, CTL_ZERO_BYTES, stream);
    Args a{};
    for (int i = 0; i < 16; ++i) a.in[i] = (const float*)d_in[i];
    a.out = (float*)d_out; a.ws = (unsigned char*)d_ws;
    if (MK_N_LAUNCHES == 1) {
        a.ph_lo = 0; a.ph_hi = N_PHASES;
        hipLaunchKernelGGL(mk_fwd, dim3(grid), dim3(NTHREADS), LDS_BYTES, stream, a);
    } else {
        for (int p = 0; p < N_PHASES; ++p) { a.ph_lo = p; a.ph_hi = p + 1; hipLaunchKernelGGL(mk_fwd, dim3(grid), dim3(NTHREADS), LDS_BYTES, stream, a); }
    }
}
```

```cpp
#include <hip/hip_runtime.h>
#include <cstdint>
#include <cstdio>

typedef _Float16 f16;
typedef _Float16 half8 __attribute__((ext_vector_type(8)));
typedef _Float16 half4 __attribute__((ext_vector_type(4)));
typedef _Float16 half2 __attribute__((ext_vector_type(2)));
typedef float f32x4 __attribute__((ext_vector_type(4)));
typedef float f32x16 __attribute__((ext_vector_type(16)));
typedef unsigned u32x4 __attribute__((ext_vector_type(4)));
typedef int i32x4 __attribute__((ext_vector_type(4)));
#define LAS __attribute__((address_space(3)))
#ifndef PROBE_DIAG
#define PROBE_DIAG (0)
#endif
#ifndef PROBE_DUP
#define PROBE_DUP (-1)
#endif
#define GAS __attribute__((address_space(1)))

constexpr int DM = 1024, BATCH = 16, SEQ = 2048, T = BATCH * SEQ;
constexpr int NQKVU = 1280, NGATE = 2048, NCAT = NQKVU + NGATE;
constexpr int COL_K = 512, COL_V = 640, COL_U = 768;
constexpr int NEXP = 16384, PEER_H = 8, TOPK = 16;
constexpr float EPS = 1e-6f;
constexpr int NWAVES = 8, NTHREADS = NWAVES * 64;

constexpr size_t MiB = 1u << 20;
constexpr size_t WS_CTL = 0, CTL_ZERO_BYTES = 64 * 1024;
constexpr size_t WS_WCAT = 1 * MiB;
constexpr size_t WS_WB = 8 * MiB;
constexpr size_t WS_WOUT = 10 * MiB;
constexpr size_t WS_WQ = 12 * MiB;
constexpr size_t WS_POOLW = 16 * MiB;
constexpr size_t WS_SUBK = 16 * MiB + 512 * 1024;
constexpr size_t WS_RS1 = 17 * MiB;
constexpr size_t WS_EIDX = 18 * MiB;
constexpr size_t WS_EGATE = 34 * MiB;
constexpr size_t WS_WCATQ = 50 * MiB;
constexpr size_t WS_WCS = 54 * MiB;
constexpr size_t WS_WQQ = 56 * MiB;
constexpr size_t WS_WQS = 59 * MiB;
constexpr size_t WS_RSX = 55 * MiB;
constexpr size_t WS_UTAB = 50 * MiB;
constexpr size_t WS_VTAB = 82 * MiB;
constexpr size_t WS_XH = 114 * MiB;
constexpr size_t WS_MERGED = WS_XH;
constexpr size_t WS_QKVU = 178 * MiB;
constexpr size_t WS_X1H = WS_QKVU;
constexpr size_t WS_GATES = 258 * MiB;
constexpr size_t WS_QP = WS_GATES;
constexpr size_t WS_OCAT = 386 * MiB;
constexpr size_t WS_UQ = 450 * MiB;
constexpr size_t WS_VQ = 466 * MiB;
constexpr size_t WS_US = 17 * MiB + 256 * 1024, WS_VS = 17 * MiB + 512 * 1024;
constexpr size_t WS_PDOT = WS_GATES;
constexpr size_t WS_H2Q = 404 * MiB;
constexpr size_t WS_HSC = 403 * MiB;
constexpr size_t WS_SSF = 402 * MiB;
constexpr size_t WS_WQP = 386 * MiB;
constexpr size_t WS_WSC = 390 * MiB;
constexpr size_t WS_ACT = 386 * MiB;
constexpr size_t WS_SS2 = 482 * MiB;
constexpr size_t WS_VT = 484 * MiB;
constexpr size_t WS_END = 492 * MiB;
constexpr int CW_BAR = 4096;

constexpr int RING_OFF = 0, RING_BYTES = 131072;
constexpr int LDSCTL_OFF = RING_BYTES, MISC_OFF = LDSCTL_OFF + 320;
constexpr int LDS_BYTES = 147456;

#define LDS_WAIT() asm volatile("s_waitcnt lgkmcnt(0)" ::: "memory")
template <int CTRL> __device__ __forceinline__ float dppf(float x) { return __uint_as_float(__builtin_amdgcn_update_dpp(0u, __float_as_uint(x), CTRL, 0xf, 0xf, false)); }
template <int CTRL> __device__ __forceinline__ int dppi(int x) { return (int)__builtin_amdgcn_update_dpp(0u, (unsigned)x, CTRL, 0xf, 0xf, false); }
__device__ __forceinline__ float bfly32(float a, float b) { auto r = __builtin_amdgcn_permlane32_swap(__float_as_uint(a), __float_as_uint(b), false, false); return __uint_as_float(r[0]) + __uint_as_float(r[1]); }
__device__ __forceinline__ float bfly16(float a, float b) { auto r = __builtin_amdgcn_permlane16_swap(__float_as_uint(a), __float_as_uint(b), false, false); return __uint_as_float(r[0]) + __uint_as_float(r[1]); }
__device__ __forceinline__ int bfly32i(int a, int b) { auto r = __builtin_amdgcn_permlane32_swap((unsigned)a, (unsigned)b, false, false); return (int)(r[0] + r[1]); }
__device__ __forceinline__ int bfly16i(int a, int b) { auto r = __builtin_amdgcn_permlane16_swap((unsigned)a, (unsigned)b, false, false); return (int)(r[0] + r[1]); }
__device__ __forceinline__ float wave_sum(float x) {
    x += dppf<0x121>(x); x += dppf<0x122>(x); x += dppf<0x124>(x); x += dppf<0x128>(x);
    x = bfly16(x, x); return bfly32(x, x);
}
__device__ __forceinline__ int wave_sum_i(int x) {
    x += dppi<0x121>(x); x += dppi<0x122>(x); x += dppi<0x124>(x); x += dppi<0x128>(x);
    x = bfly16i(x, x); return bfly32i(x, x);
}
__device__ __forceinline__ float wave_max(float x) {
    x = fmaxf(x, dppf<0x121>(x)); x = fmaxf(x, dppf<0x122>(x)); x = fmaxf(x, dppf<0x124>(x)); x = fmaxf(x, dppf<0x128>(x));
    { auto r = __builtin_amdgcn_permlane16_swap(__float_as_uint(x), __float_as_uint(x), false, false); x = fmaxf(__uint_as_float(r[0]), __uint_as_float(r[1])); }
    { auto r = __builtin_amdgcn_permlane32_swap(__float_as_uint(x), __float_as_uint(x), false, false); x = fmaxf(__uint_as_float(r[0]), __uint_as_float(r[1])); }
    return x;
}
__device__ __forceinline__ float gelu_exact(float x) { return 0.5f * x * (1.0f + erff(x * 0.70710678118654752f)); }
__device__ __forceinline__ float rs_from_ss(const float* ss, int t) {
    float s = 0.f;
#pragma unroll
    for (int i = 0; i < 16; ++i) s += ss[(size_t)i * T + t];
    return rsqrtf(s * (1.0f / DM) + EPS);
}

struct Ctx {
    int tid, lane, wave;
    int G;
    int gw, ngw;
    int gt, ngt;
};

__device__ __forceinline__ int pack4_i8(float a, float b, float c, float d) {
    const int ia = (int)rintf(a), ib = (int)rintf(b), ic = (int)rintf(c), id = (int)rintf(d);
    return (ia & 0xff) | ((ib & 0xff) << 8) | ((ic & 0xff) << 16) | (id << 24);
}
template <bool OFFS>
__device__ __forceinline__ void quant_rows(const Ctx& C, const float* __restrict__ tab, unsigned* __restrict__ q, float* __restrict__ scale) {
    const int lane = C.lane;
    for (int r = C.gw; r < NEXP; r += C.ngw) {
        const float* row = tab + (size_t)r * DM;
        f32x4 v[4]; float m = 0.f;
#pragma unroll
        for (int j = 0; j < 4; ++j) { v[j] = *(const f32x4*)(row + j * 256 + lane * 4); m = fmaxf(m, fmaxf(fmaxf(fabsf(v[j][0]), fabsf(v[j][1])), fmaxf(fabsf(v[j][2]), fabsf(v[j][3])))); }
        m = wave_max(m);
        const float inv = m > 0.f ? 127.0f / m : 0.f;
#pragma unroll
        for (int j = 0; j < 4; ++j) {
            unsigned w = (unsigned)pack4_i8(v[j][0] * inv, v[j][1] * inv, v[j][2] * inv, v[j][3] * inv);
            if (OFFS) w ^= 0x80808080u;
            { const int dw = j * 64 + lane; q[(size_t)(dw >> 5) * (NEXP * 32) + (size_t)r * 32 + (dw & 31)] = w; }
        }
        if (lane == 0) scale[r] = m * (1.0f / 127.0f);
    }
}

__device__ __forceinline__ void p0_transpose_item(const float* W, int K, int N, f16* WT, int ldo, int koff, LAS float* scr, int item, int lane) {
    const int nblk = N / 32, kb = item / nblk, nb = item % nblk, k0 = 64 * kb, n0 = 32 * nb;
#pragma unroll 8
    for (int i = 0; i < 32; ++i) { const int kk = 2 * i + (lane >> 5); scr[kk * 33 + (lane & 31)] = W[(size_t)(k0 + kk) * N + n0 + (lane & 31)]; }
    LDS_WAIT(); asm volatile("" ::: "memory");
    const int c = lane & 7;
#pragma unroll
    for (int j = 0; j < 4; ++j) { const int n = (lane >> 3) + 8 * j; const LAS float* s = scr + (8 * c) * 33 + n;
        half8 o;
#pragma unroll
        for (int i = 0; i < 8; ++i) o[i] = (f16)s[i * 33];
        *(half8*)(WT + (size_t)(n0 + n) * ldo + koff + k0 + 8 * c) = o; }
    LDS_WAIT(); asm volatile("" ::: "memory");
}
__device__ __forceinline__ void cvt_stream(const Ctx& C, const float* in, f16* out, size_t n4) {
    for (size_t i = (size_t)C.gt; i < n4; i += (size_t)C.ngt) {
        const f32x4 v = ((const f32x4*)in)[i];
        half4 h; h[0] = (f16)v[0]; h[1] = (f16)v[1]; h[2] = (f16)v[2]; h[3] = (f16)v[3];
        ((half4*)out)[i] = h;
    }
}
__device__ __forceinline__ void rowprep(const Ctx& C, const float* x, const float* g, unsigned* xq, float* rsx, float* ss) {
    const int lane = C.lane;
    f32x4 gg[4];
#pragma unroll
    for (int j = 0; j < 4; ++j) gg[j] = *(const f32x4*)(g + j * 256 + lane * 4);
    for (int tb = C.gw * 4; tb < T; tb += C.ngw * 4) {
        f32x4 v[4][4];
#pragma unroll
        for (int u = 0; u < 4; ++u)
#pragma unroll
            for (int j = 0; j < 4; ++j) v[u][j] = *(const f32x4*)(x + (size_t)(tb + u) * DM + j * 256 + lane * 4);
#pragma unroll
        for (int u = 0; u < 4; ++u) {
            float s = 0.f, am = 0.f;
#pragma unroll
            for (int j = 0; j < 4; ++j) {
                const f32x4 w = v[u][j];
                s += w[0] * w[0] + w[1] * w[1] + w[2] * w[2] + w[3] * w[3];
                v[u][j] = w * gg[j];
                am = fmaxf(am, fmaxf(fmaxf(fabsf(v[u][j][0]), fabsf(v[u][j][1])), fmaxf(fabsf(v[u][j][2]), fabsf(v[u][j][3]))));
            }
            s = wave_sum(s); am = wave_max(am);
            const float inv = am > 0.f ? 127.0f / am : 0.f;
#pragma unroll
            for (int j = 0; j < 4; ++j) xq[(size_t)(tb + u) * 256 + j * 64 + lane] = (unsigned)pack4_i8(v[u][j][0] * inv, v[u][j][1] * inv, v[u][j][2] * inv, v[u][j][3] * inv);
            if (lane == 0) { ss[tb + u] = s; rsx[tb + u] = am * (1.0f / 127.0f); }
        }
    }
}
__device__ __forceinline__ void quant_wrows(const Ctx& C, const f16* __restrict__ w, int rows, unsigned* __restrict__ q, float* __restrict__ scale) {
    const int lane = C.lane;
    for (int r = C.gw; r < rows; r += C.ngw) {
        const half8 a = *(const half8*)(w + (size_t)r * DM + 16 * lane), b = *(const half8*)(w + (size_t)r * DM + 16 * lane + 8);
        float m = 0.f;
#pragma unroll
        for (int i = 0; i < 8; ++i) m = fmaxf(m, fmaxf(fabsf((float)a[i]), fabsf((float)b[i])));
        m = wave_max(m);
        const float inv = m > 0.f ? 127.0f / m : 0.f;
        u32x4 o;
        o[0] = (unsigned)pack4_i8((float)a[0] * inv, (float)a[1] * inv, (float)a[2] * inv, (float)a[3] * inv);
        o[1] = (unsigned)pack4_i8((float)a[4] * inv, (float)a[5] * inv, (float)a[6] * inv, (float)a[7] * inv);
        o[2] = (unsigned)pack4_i8((float)b[0] * inv, (float)b[1] * inv, (float)b[2] * inv, (float)b[3] * inv);
        o[3] = (unsigned)pack4_i8((float)b[4] * inv, (float)b[5] * inv, (float)b[6] * inv, (float)b[7] * inv);
        *(u32x4*)(q + (size_t)r * 256 + 4 * lane) = o;
        if (lane == 0) scale[r] = m * (1.0f / 127.0f);
    }
}
__device__ __forceinline__ void ph_prep(const Ctx& C, LAS unsigned char* lds, const float* const* in, unsigned char* ws) {
    LAS float* scr = (LAS float*)(lds + RING_OFF + C.wave * 16384);
    f16* wcat = (f16*)(ws + WS_WCAT); f16* wb = (f16*)(ws + WS_WB); f16* wout = (f16*)(ws + WS_WOUT); f16* wq = (f16*)(ws + WS_WQ); f16* poolw = (f16*)(ws + WS_POOLW);
    constexpr int I_IN = 16 * 40, I_G = 16 * 64, I_B = 8 * 32, I_O = 16 * 32, I_Q = 16 * 64, I_P = 2 * 4;
    constexpr int NITEMS = I_IN + I_G + 2 * I_B + I_O + I_Q + 4 * I_P;
    for (int it = C.gw; it < NITEMS; it += C.ngw) {
        int r = it;
        if (r < I_IN) { p0_transpose_item(in[2], 1024, 1280, wcat, 1024, 0, scr, r, C.lane); continue; } r -= I_IN;
        if (r < I_G) { p0_transpose_item(in[7], 1024, 2048, wcat + (size_t)NQKVU * 1024, 1024, 0, scr, r, C.lane); continue; } r -= I_G;
        if (r < I_B) { p0_transpose_item(in[6], 512, 1024, wb, 1024, 0, scr, r, C.lane); continue; } r -= I_B;
        if (r < I_B) { p0_transpose_item(in[6] + 512 * 1024, 512, 1024, wb, 1024, 512, scr, r, C.lane); continue; } r -= I_B;
        if (r < I_O) { p0_transpose_item(in[9], 1024, 1024, wout, 1024, 0, scr, r, C.lane); continue; } r -= I_O;
        if (r < I_Q) { p0_transpose_item(in[11], 1024, 2048, wq, 1024, 0, scr, r, C.lane); continue; } r -= I_Q;
        { const int g = r / I_P; p0_transpose_item(in[4] + g * 128 * 128, 128, 128, poolw + g * 128 * 128, 128, 0, scr, r % I_P, C.lane); }
    }
    cvt_stream(C, in[12], (f16*)(ws + WS_SUBK), (size_t)8 * 2 * 128 * 128 / 4);
    rowprep(C, in[0], in[1], (unsigned*)(ws + WS_XH), (float*)(ws + WS_RSX), (float*)(ws + WS_RS1));
}

__device__ __forceinline__ void ph_attn_naive(const Ctx& C, const f16* __restrict__ qkvu, const float* __restrict__ sink, f16* __restrict__ ocat) {
    for (int gid = C.gt; gid < T * 8; gid += C.ngt) {
        const int t = gid % T, h = gid / T;
        const int b = t / SEQ, ts = t % SEQ, kh = h >> 2;
        float q[64], o[64];
        const f16* qr = qkvu + (size_t)t * NQKVU + h * 64;
#pragma unroll
        for (int d = 0; d < 64; ++d) { q[d] = (float)qr[d]; o[d] = 0.f; }
        const float slope = exp2f(-(float)(h + 1));
        float m = -1e30f, l = 0.f;
        const int s0 = max(ts - 128, 0), s1 = min(ts + 128, SEQ - 1);
        for (int s = s0; s <= s1; ++s) {
            const f16* kr = qkvu + (size_t)(b * SEQ + s) * NQKVU + COL_K + kh * 64;
            const f16* vr = qkvu + (size_t)(b * SEQ + s) * NQKVU + COL_V + kh * 64;
            float dot = 0.f;
#pragma unroll
            for (int d = 0; d < 64; ++d) dot += q[d] * (float)kr[d];
            const float lg = dot * 0.125f - slope * fabsf((float)(ts - s));
            const float mn = fmaxf(m, lg), al = __expf(m - mn), p = __expf(lg - mn);
            l = l * al + p;
#pragma unroll
            for (int d = 0; d < 64; ++d) o[d] = o[d] * al + p * (float)vr[d];
            m = mn;
        }
        const float sk = sink[h];
        const float mn = fmaxf(m, sk), al = __expf(m - mn);
        l = l * al + __expf(sk - mn);
        const float inv = al / l;
        f16* orow = ocat + (size_t)t * DM + h * 64;
#pragma unroll
        for (int d = 0; d < 64; ++d) orow[d] = (f16)(o[d] * inv);
    }
}

template <int DIAG = 0>
__device__ __forceinline__ void attn_unit(const Ctx& C, int u, LAS unsigned char* lds, const f16* __restrict__ qkvu, const f16* __restrict__ vT, const float* __restrict__ sink, f16* __restrict__ ocat) {
    const int lane = C.lane, r32 = lane & 31, hh = lane >> 5;
    const int krow = (r32 & 19) | ((r32 & 4) << 1) | ((r32 & 8) >> 1);
    constexpr float L2E = 1.4426950408889634f;
    {
        const int qs = u & 63, h = (u >> 6) & 7, b = u >> 9, kh = h >> 2;
        const int tq = qs * 32 + r32;
        const float slope2 = exp2f(-(float)(h + 1)) * L2E, sink2 = sink[h] * L2E;
        const f16* qrow = qkvu + (size_t)(b * SEQ + tq) * NQKVU + h * 64 + 8 * hh;
        half8 bq[4];
#pragma unroll
        for (int ks = 0; ks < 4; ++ks) bq[ks] = *(const half8*)(qrow + 16 * ks);
        f32x16 o0, o1;
#pragma unroll
        for (int r = 0; r < 16; ++r) { o0[r] = 0.f; o1[r] = 0.f; }
        float m = -1e30f, l = 0.f;
        const int kb_lo = max(qs - 4, 0), kb_hi = min(qs + 4, 63);
        LAS unsigned char* kst = lds + 65536 + C.wave * 8192; LAS unsigned char* vst = kst + 4096;
        const int krw = lane >> 3, kch = lane & 7, vrw = lane >> 2, vch = lane & 3;
        const f16* kg = qkvu + (size_t)(b * SEQ + krw) * NQKVU + COL_K + kh * 64 + kch * 8;
        const f16* vg = vT + (size_t)((b * 2 + kh) * 64 + vrw) * SEQ + vch * 8;
        half8 gk[4], gv[4];
#pragma unroll
        for (int i = 0; i < 4; ++i) { gk[i] = *(const half8*)(kg + (size_t)(kb_lo * 32 + 8 * i) * NQKVU); gv[i] = *(const half8*)(vg + (size_t)(16 * i) * SEQ + kb_lo * 32); }
#pragma unroll 1
        for (int kb = kb_lo; kb <= kb_hi; ++kb) {
#pragma unroll
            for (int i = 0; i < 4; ++i) {
                const int kr = krw + 8 * i; *(LAS half8*)(kst + kr * 128 + ((kch ^ (kr & 7)) << 4)) = gk[i];
                const int vr = vrw + 16 * i; *(LAS half8*)(vst + vr * 64 + ((vch ^ ((vr >> 2) & 3)) << 4)) = gv[i];
            }
            LDS_WAIT();
            half8 kf[4], va[2][2];
#pragma unroll
            for (int ks = 0; ks < 4; ++ks) kf[ks] = *(const LAS half8*)(kst + krow * 128 + (((2 * ks + hh) ^ (krow & 7)) << 4));
#pragma unroll
            for (int db = 0; db < 2; ++db)
#pragma unroll
                for (int st = 0; st < 2; ++st) { const int d = db * 32 + r32; va[db][st] = *(const LAS half8*)(vst + d * 64 + (((2 * st + hh) ^ ((d >> 2) & 3)) << 4)); }
            LDS_WAIT();
            const int kn = (DIAG == 2) ? kb_lo : (kb < kb_hi ? kb + 1 : kb);
#pragma unroll
            for (int i = 0; i < 4; ++i) { gk[i] = *(const half8*)(kg + (size_t)(kn * 32 + 8 * i) * NQKVU); gv[i] = *(const half8*)(vg + (size_t)(16 * i) * SEQ + kn * 32); }
            f32x16 s;
#pragma unroll
            for (int r = 0; r < 16; ++r) s[r] = 0.f;
#pragma unroll
            for (int ks = 0; ks < 4; ++ks) s = __builtin_amdgcn_mfma_f32_32x32x16_f16(kf[ks], bq[ks], s, 0, 0, 0);
            float bmax = -1e30f; bool ok[16];
#pragma unroll
            for (int r = 0; r < 16; ++r) {
                const int tk = kb * 32 + 16 * (r >> 3) + 8 * hh + (r & 7);
                const int dist = abs(tq - tk);
                ok[r] = dist <= 128;
                s[r] = ok[r] ? s[r] * (0.125f * L2E) - slope2 * (float)dist : -1e30f;
                bmax = fmaxf(bmax, s[r]);
            }
            bmax = fmaxf(bmax, __shfl_xor(bmax, 32));
            const float mn = fmaxf(m, bmax), al = exp2f(m - mn);
            m = mn;
            float ps = 0.f; half8 pb[2];
#pragma unroll
            for (int r = 0; r < 16; ++r) { const float p = ok[r] ? (DIAG == 1 ? (s[r] - mn) : exp2f(s[r] - mn)) : 0.f; ps += p; pb[r >> 3][r & 7] = (f16)p; }
            l = l * al + ps;
#pragma unroll
            for (int r = 0; r < 16; ++r) { o0[r] *= al; o1[r] *= al; }
#pragma unroll
            for (int st = 0; st < 2; ++st) { o0 = __builtin_amdgcn_mfma_f32_32x32x16_f16(va[0][st], pb[st], o0, 0, 0, 0); o1 = __builtin_amdgcn_mfma_f32_32x32x16_f16(va[1][st], pb[st], o1, 0, 0, 0); }
        }
        l += __shfl_xor(l, 32);
        const float mf = fmaxf(m, sink2), al = exp2f(m - mf);
        const float sc = al / (l * al + exp2f(sink2 - mf));
        f16* orow = ocat + (size_t)(b * SEQ + tq) * DM + h * 64 + 4 * hh;
#pragma unroll
        for (int g = 0; g < 4; ++g) {
            half4 a, c;
#pragma unroll
            for (int i = 0; i < 4; ++i) { a[i] = (f16)(o0[4 * g + i] * sc); c[i] = (f16)(o1[4 * g + i] * sc); }
            *(half4*)(orow + 8 * g) = a; *(half4*)(orow + 32 + 8 * g) = c;
        }
    }
}

__device__ __forceinline__ void ph_pool_naive(const Ctx& C, const f16* __restrict__ qkvu, f16* __restrict__ mixed) {
    for (size_t gid = (size_t)C.gt; gid < (size_t)T * 512; gid += (size_t)C.ngt) {
        const int c = (int)(gid & 511), t = (int)(gid >> 9);
        const int b = t / SEQ, ts = t % SEQ, g = c >> 7, w = 2 << g;
        const int lo = max(ts - w / 2, 0), hi = min(ts + w / 2, SEQ);
        float s = 0.f;
        for (int i = lo; i < hi; ++i) s += (float)qkvu[(size_t)(b * SEQ + i) * NQKVU + COL_U + c];
        const float mean = s / (float)(hi - lo);
        mixed[(size_t)t * 512 + c] = (f16)(mean - (float)qkvu[(size_t)t * NQKVU + COL_U + c]);
    }
}
__device__ __forceinline__ void ph_poolmm_naive(const Ctx& C, const f16* __restrict__ mixed, const f16* __restrict__ poolw_t, const float* __restrict__ pscale, f16* __restrict__ ocat) {
    for (size_t gid = (size_t)C.gt; gid < (size_t)T * 512; gid += (size_t)C.ngt) {
        const int n = (int)(gid & 511), t = (int)(gid >> 9), g = n >> 7, d = n & 127;
        const f16* mr = mixed + (size_t)t * 512 + g * 128;
        const f16* wr = poolw_t + (size_t)(g * 128 + d) * 128;
        float acc = 0.f;
        for (int c = 0; c < 128; ++c) acc += (float)mr[c] * (float)wr[c];
        ocat[(size_t)t * DM + 512 + n] = (f16)(acc * pscale[n]);
    }
}

template <int HW>
__device__ __forceinline__ void pool_step1(const f16* __restrict__ qkvu, LAS unsigned char* tile, int t0, int g, int lane) {
    const int c2 = lane, b = t0 >> 11, sf = t0 & (SEQ - 1);
    const f16* ub = qkvu + (size_t)(b * SEQ) * NQKVU + COL_U + g * 128 + 2 * c2;
    constexpr int NR = 32 + 2 * HW - 1;
    half2 v[NR];
#pragma unroll
    for (int i = 0; i < NR; ++i) { const int s = sf - HW + i; half2 z; z[0] = (f16)0.f; z[1] = (f16)0.f; v[i] = z; if (s >= 0 && s < SEQ) v[i] = *(const half2*)(ub + (size_t)s * NQKVU); }
    float s0 = 0.f, s1 = 0.f;
#pragma unroll
    for (int i = 0; i < 2 * HW - 1; ++i) { s0 += (float)v[i][0]; s1 += (float)v[i][1]; }
#pragma unroll
    for (int j = 0; j < 32; ++j) {
        s0 += (float)v[j + 2 * HW - 1][0]; s1 += (float)v[j + 2 * HW - 1][1];
        const int s = sf + j, lo = max(s - HW, 0), hi = min(s + HW, SEQ);
        const float inv = 1.0f / (float)(hi - lo);
        half2 mx; mx[0] = (f16)(s0 * inv - (float)v[j + HW][0]); mx[1] = (f16)(s1 * inv - (float)v[j + HW][1]);
        *(LAS half2*)(tile + j * 256 + (((c2 >> 2) ^ (j & 15)) << 4) + ((c2 & 3) << 2)) = mx;
        s0 -= (float)v[j][0]; s1 -= (float)v[j][1];
    }
}
__device__ __forceinline__ void pool_unit(const Ctx& C, int u, LAS unsigned char* lds, const f16* __restrict__ qkvu, const f16* __restrict__ poolw_t, const float* __restrict__ pscale, f16* __restrict__ ocat) {
    const int lane = C.lane, r32 = lane & 31, hh = lane >> 5;
    LAS unsigned char* tile = lds + C.wave * 8192;
    const int g = u & 3, t0 = (u >> 2) * 32;
    switch (g) { case 0: pool_step1<1>(qkvu, tile, t0, g, lane); break; case 1: pool_step1<2>(qkvu, tile, t0, g, lane); break;
                 case 2: pool_step1<4>(qkvu, tile, t0, g, lane); break; default: pool_step1<8>(qkvu, tile, t0, g, lane); break; }
    LDS_WAIT();
    f32x16 acc[4];
#pragma unroll
    for (int db = 0; db < 4; ++db)
#pragma unroll
        for (int r = 0; r < 16; ++r) acc[db][r] = 0.f;
    const f16* wr = poolw_t + (size_t)(g * 128 + r32) * 128 + 8 * hh;
#pragma unroll
    for (int ks = 0; ks < 8; ++ks) {
        const half8 bm = *(const LAS half8*)(tile + r32 * 256 + (((2 * ks + hh) ^ (r32 & 15)) << 4));
#pragma unroll
        for (int db = 0; db < 4; ++db) { const half8 a = *(const half8*)(wr + (size_t)(db * 32) * 128 + 16 * ks); acc[db] = __builtin_amdgcn_mfma_f32_32x32x16_f16(a, bm, acc[db], 0, 0, 0); }
    }
    LDS_WAIT();
    f16* orow = ocat + (size_t)(t0 + r32) * DM + 512 + g * 128 + 4 * hh;
    const float* ps = pscale + g * 128 + 4 * hh;
#pragma unroll
    for (int db = 0; db < 4; ++db)
#pragma unroll
        for (int q = 0; q < 4; ++q) {
            const f32x4 pv = *(const f32x4*)(ps + db * 32 + 8 * q);
            half4 x0;
#pragma unroll
            for (int i = 0; i < 4; ++i) x0[i] = (f16)(acc[db][4 * q + i] * pv[i]);
            *(half4*)(orow + db * 32 + 8 * q) = x0;
        }
}
__device__ __forceinline__ void ph_attn_pool(const Ctx& C, LAS unsigned char* lds, const f16* __restrict__ qkvu, const f16* __restrict__ vT, const float* __restrict__ sink,
                                             const f16* __restrict__ poolw_t, const float* __restrict__ pscale, f16* __restrict__ ocat) {
    for (int m = C.gw; m < (T / 32) * 4; m += C.ngw) {
        if (C.wave & 4) pool_unit(C, m, lds, qkvu, poolw_t, pscale, ocat);
        attn_unit<0>(C, 2 * m, lds, qkvu, vT, sink, ocat);
        attn_unit<0>(C, 2 * m + 1, lds, qkvu, vT, sink, ocat);
        if (!(C.wave & 4)) pool_unit(C, m, lds, qkvu, poolw_t, pscale, ocat);
    }
}

#define INS(LV, LI, v_, i_) do { float cv_ = (v_); int ci_ = (i_); \
    _Pragma("unroll") for (int z_ = 0; z_ < 16; ++z_) { const bool gt_ = cv_ > LV[z_]; const float tv_ = gt_ ? LV[z_] : cv_; const int ti_ = gt_ ? LI[z_] : ci_; \
        LV[z_] = gt_ ? cv_ : LV[z_]; LI[z_] = gt_ ? ci_ : LI[z_]; cv_ = tv_; ci_ = ti_; } } while (0)
__device__ __forceinline__ void ph_route_naive(const Ctx& C, const f16* __restrict__ qp, const float* __restrict__ ss2, const f16* __restrict__ subk, int* __restrict__ eidx, float* __restrict__ egate) {
    for (int gid = C.gt; gid < T * 8; gid += C.ngt) {
        const int t = gid % T, h = gid / T;
        const float rs2 = rs_from_ss(ss2, t);
        float av[16], bv[16]; int ai[16], bi[16];
#pragma unroll
        for (int z = 0; z < 16; ++z) { av[z] = -3e38f; bv[z] = -3e38f; ai[z] = 0; bi[z] = 0; }
        for (int p = 0; p < 2; ++p) {
            const f16* qr = qp + (size_t)t * 2048 + h * 256 + p * 128;
            for (int n = 0; n < 128; ++n) {
                const f16* kr = subk + ((size_t)((h * 2 + p) * 128 + n)) * 128;
                float dot = 0.f;
                for (int c = 0; c < 128; ++c) dot += (float)qr[c] * (float)kr[c];
                dot *= rs2;
                if (p == 0) INS(av, ai, dot, n); else INS(bv, bi, dot, n);
            }
        }
        float cv[16]; int ci[16];
#pragma unroll
        for (int z = 0; z < 16; ++z) { cv[z] = -3e38f; ci[z] = 0; }
#pragma unroll
        for (int i = 0; i < 16; ++i)
#pragma unroll
            for (int j = 0; j < 16; ++j)
                if ((i + 1) * (j + 1) <= 16) INS(cv, ci, av[i] + bv[j], ai[i] * 128 + bi[j]);
        float sum = 0.f, e[16];
#pragma unroll
        for (int z = 0; z < 16; ++z) { e[z] = __expf(cv[z] - cv[0]); sum += e[z]; }
        const float inv = 1.0f / sum;
#pragma unroll
        for (int z = 0; z < 16; ++z) { eidx[(size_t)t * 128 + h * 16 + z] = ci[z]; egate[(size_t)t * 128 + h * 16 + z] = e[z] * inv; }
    }
}

__device__ __forceinline__ int mono_i(float f) { const int b = __float_as_int(f); return b ^ ((b >> 31) & 0x7fffffff); }
__device__ __forceinline__ float unmono_f(int m) { return __int_as_float(m ^ ((m >> 31) & 0x7fffffff)); }
#define INS16(Lst, x_) do { int xv_ = (x_); _Pragma("unroll") for (int z_ = 0; z_ < 16; ++z_) { const int hi_ = max(Lst[z_], xv_); xv_ = min(Lst[z_], xv_); Lst[z_] = hi_; } } while (0)
__device__ __forceinline__ void merge_pair16(int (&Lst)[16]) {
    int P[16];
#pragma unroll
    for (int z = 0; z < 16; ++z) P[z] = __shfl_xor(Lst[z], 32);
#pragma unroll
    for (int z = 0; z < 16; ++z) Lst[z] = max(Lst[z], P[15 - z]);
#pragma unroll
    for (int s = 8; s >= 1; s >>= 1)
#pragma unroll
        for (int i = 0; i < 16; ++i) if ((i & s) == 0) { const int hi = max(Lst[i], Lst[i + s]), lo = min(Lst[i], Lst[i + s]); Lst[i] = hi; Lst[i + s] = lo; }
}
__device__ __forceinline__ void bitonic_sort16_desc(int (&K)[16]) {
#pragma unroll
    for (int k = 2; k <= 16; k <<= 1)
#pragma unroll
        for (int j = k >> 1; j > 0; j >>= 1)
#pragma unroll
            for (int i = 0; i < 16; ++i) { const int l = i ^ j; if (l > i) { const int a = K[i], b = K[l], hi = max(a, b), lo = min(a, b); const bool desc = (i & k) == 0; K[i] = desc ? hi : lo; K[l] = desc ? lo : hi; } }
}
__device__ __forceinline__ void bitonic_merge16_desc(int (&K)[16]) {
#pragma unroll
    for (int s = 8; s >= 1; s >>= 1)
#pragma unroll
        for (int i = 0; i < 16; ++i) if ((i & s) == 0) { const int hi = max(K[i], K[i + s]), lo = min(K[i], K[i + s]); K[i] = hi; K[i + s] = lo; }
}
template <class Side>
__device__ __forceinline__ void ph_route(const Ctx& C, LAS unsigned char* lds, const f16* __restrict__ qp, const float* __restrict__ ss2, const f16* __restrict__ subk,
                                         int* __restrict__ eidx, float* __restrict__ egate, const Side& side_job) {
    const int lane = C.lane, r32 = lane & 31, hh = lane >> 5;
    LAS unsigned char* tab = lds + 65536 + C.wave * 4096 + lane * 36;
    const int GH = C.G < 8 ? C.G : 8;
  for (int h = blockIdx.x % GH; h < 8; h += GH) {
    const int rank_h = blockIdx.x / GH, nwg_h = (C.G - (blockIdx.x % GH) + GH - 1) / GH;
    __syncthreads();
    for (int i = C.tid; i < 2 * 128 * 16; i += NTHREADS) {
        const int row = i >> 4, ch = i & 15;
        *(LAS half8*)(lds + row * 256 + ((ch ^ (row & 15)) << 4)) = *(const half8*)(subk + (size_t)(h * 256 + row) * 128 + ch * 8);
    }
    __syncthreads();
    if (h == (int)(blockIdx.x % GH) && (C.wave & 4)) side_job();
    for (int tb = rank_h * NWAVES + C.wave; tb < T / 32; tb += nwg_h * NWAVES) {
        const int t0 = tb * 32, t = t0 + r32;
        int top[2][16];
#pragma unroll
        for (int p = 0; p < 2; ++p) {
            const f16* qrow = qp + (size_t)t * 2048 + h * 256 + p * 128 + 8 * hh;
            const LAS unsigned char* kl = lds + (p * 128 + r32) * 256;
            half8 bq[8];
#pragma unroll
            for (int ks = 0; ks < 8; ++ks) bq[ks] = *(const half8*)(qrow + 16 * ks);
            int Lst[16];
#pragma unroll
            for (int z = 0; z < 16; ++z) Lst[z] = (int)0x80000000;
#pragma unroll 1
            for (int nb = 0; nb < 4; ++nb) {
                f32x16 acc = {0.f, 0.f, 0.f, 0.f, 0.f, 0.f, 0.f, 0.f, 0.f, 0.f, 0.f, 0.f, 0.f, 0.f, 0.f, 0.f};
#pragma unroll
                for (int ks = 0; ks < 8; ++ks) {
                    const half8 ak = *(const LAS half8*)(kl + nb * 32 * 256 + (((2 * ks + hh) ^ (r32 & 15)) << 4));
                    acc = __builtin_amdgcn_mfma_f32_32x32x16_f16(ak, bq[ks], acc, 0, 0, 0);
                }
                int K[16];
#pragma unroll
                for (int r = 0; r < 16; ++r) { const int n = nb * 32 + (r & 3) + 8 * (r >> 2) + 4 * hh; K[r] = (mono_i(acc[r]) & ~127) | (127 - n); }
                bitonic_sort16_desc(K);
#pragma unroll
                for (int z = 0; z < 16; ++z) Lst[z] = max(Lst[z], K[15 - z]);
                bitonic_merge16_desc(Lst);
            }
            merge_pair16(Lst);
#pragma unroll
            for (int z = 0; z < 16; ++z) top[p][z] = Lst[z];
        }
        float va[16], vb[16];
#pragma unroll
        for (int z = 0; z < 16; ++z) { va[z] = unmono_f(top[0][z] & ~127); vb[z] = unmono_f(top[1][z] & ~127);
            tab[z] = (unsigned char)(127 - (top[0][z] & 127)); tab[16 + z] = (unsigned char)(127 - (top[1][z] & 127)); }
        int Cl[16];
        { const float a01 = hh ? va[1] : va[0];
#pragma unroll
          for (int j = 0; j < 16; ++j) { const int key = (mono_i(a01 + vb[j]) & ~255) | (255 - (hh * 16 + j)); Cl[j] = (hh && j >= 8) ? (int)0x80000000 : key; } }
#pragma unroll
        for (int i = 2; i < 16; i += 2) {
            const float ai = hh ? va[i + 1] : va[i];
#pragma unroll
            for (int j = 0; j < 16; ++j)
                if ((i + 1) * (j + 1) <= 16) {
                    int key = (mono_i(ai + vb[j]) & ~255) | (255 - ((i + hh) * 16 + j));
                    if ((i + 2) * (j + 1) > 16) key = hh ? (int)0x80000000 : key;
                    INS16(Cl, key);
                }
        }
        merge_pair16(Cl);
        float e[16], sum = 0.f; const float mx = unmono_f(Cl[0] & ~255);
#pragma unroll
        for (int z = 0; z < 16; ++z) { e[z] = __expf(unmono_f(Cl[z] & ~255) - mx); sum += e[z]; }
        const float inv = 1.0f / sum;
        LDS_WAIT();
        int* ei = eidx + (size_t)t * 128 + h * 16 + 8 * hh; float* eg = egate + (size_t)t * 128 + h * 16 + 8 * hh;
#pragma unroll
        for (int z = 0; z < 16; ++z) {
            if ((z >> 3) == hh) { const int code = 255 - (Cl[z] & 255); const int ia = tab[code >> 4], ib = tab[16 + (code & 15)];
                ei[z & 7] = ia * 128 + ib; eg[z & 7] = e[z] * inv; }
        }
        LDS_WAIT();
    }
  }
}

struct Slicing { int m, pi, nloc, rank; };
__device__ __forceinline__ Slicing get_slicing(const unsigned* bar, volatile LAS unsigned* misc) {
    Slicing S; const unsigned x = (unsigned)__builtin_amdgcn_s_getreg((3 << 11) | 20) & 0xFu;
    int m = 0, pi = 0, nloc = 1;
    for (unsigned j = 0; j < 16; ++j) { const unsigned c = __hip_atomic_load(&bar[256 + 64 * j], __ATOMIC_RELAXED, __HIP_MEMORY_SCOPE_AGENT); if (c > 0u) { if (j < x) ++pi; ++m; } if (j == x) nloc = (int)c; }
    S.m = m > 0 ? m : 1; S.pi = pi; S.nloc = nloc > 0 ? nloc : 1; S.rank = (int)misc[10];
    return S;
}
__device__ __forceinline__ float gelu_fast(float v) {
    const float av = fabsf(v), t = __builtin_amdgcn_rcpf(av * 0.2316418882f + 1.0f);
    float q = t * 0.5307027145f + (-0.7265760135f); q = q * t + 0.7107068705f; q = q * t + (-0.142248368f); q = q * t + 0.127414796f; q = q * t;
    const float m = v * (q * __builtin_amdgcn_exp2f((v * v) * (-0.72134752044f)));
    return v < 0.f ? m : v - m;
}
__device__ __forceinline__ void ph_h2quant(const Ctx& C, const f16* __restrict__ x1h, const float* __restrict__ ss2, unsigned* __restrict__ h2q, float* __restrict__ hsc) {
    const int lane = C.lane;
    for (int t = C.gw; t < T; t += C.ngw) {
        const half8 h0 = *(const half8*)(x1h + (size_t)t * DM + 16 * lane), h1 = *(const half8*)(x1h + (size_t)t * DM + 16 * lane + 8);
        float hm = 0.f;
#pragma unroll
        for (int i = 0; i < 8; ++i) hm = fmaxf(hm, fmaxf(fabsf((float)h0[i]), fabsf((float)h1[i])));
        hm = wave_max(hm);
        const float inv = hm > 0.f ? 127.0f / hm : 0.f;
        u32x4 w;
        w[0] = (unsigned)pack4_i8((float)h0[0] * inv, (float)h0[1] * inv, (float)h0[2] * inv, (float)h0[3] * inv);
        w[1] = (unsigned)pack4_i8((float)h0[4] * inv, (float)h0[5] * inv, (float)h0[6] * inv, (float)h0[7] * inv);
        w[2] = (unsigned)pack4_i8((float)h1[0] * inv, (float)h1[1] * inv, (float)h1[2] * inv, (float)h1[3] * inv);
        w[3] = (unsigned)pack4_i8((float)h1[4] * inv, (float)h1[5] * inv, (float)h1[6] * inv, (float)h1[7] * inv);
        *(u32x4*)(h2q + (size_t)t * 256 + 4 * lane) = w;
        if (lane == 0) hsc[t] = hm * (1.0f / 127.0f) * rs_from_ss(ss2, t);
    }
}
__device__ __forceinline__ __amdgpu_buffer_rsrc_t slice_rsrc(const unsigned char* base) {
    const unsigned long long b = (unsigned long long)base;
    const unsigned lo = __builtin_amdgcn_readfirstlane((unsigned)b), hi = __builtin_amdgcn_readfirstlane((unsigned)(b >> 32));
    return __builtin_amdgcn_make_buffer_rsrc((void*)(((unsigned long long)hi << 32) | lo), 0, NEXP * 128, 0x00020000);
}
template <int EMASK>
__device__ __forceinline__ void ph_upeer(const Ctx& C, LAS unsigned char* lds, const Slicing SL, const unsigned* __restrict__ h2q, const int* __restrict__ eidx,
                                         const unsigned char* __restrict__ uq, short* __restrict__ pdot) {
    const int lane = C.lane, grp = lane >> 3, c8 = lane & 7;
    const int wv = SL.rank * NWAVES + C.wave, nwv = SL.nloc * NWAVES;
    const int ntok = (T - wv + nwv - 1) / nwv;
    auto tok = [&](int i) { const int t = wv + i * nwv; return t < T ? t : T - 1; };
    volatile LAS int* row = (volatile LAS int*)(lds + C.wave * 1024);
  for (int s = SL.pi; s < 8; s += SL.m) {
    const __amdgpu_buffer_rsrc_t urs = slice_rsrc(uq + (size_t)s * (NEXP * 128));
    const unsigned* hqs = h2q + s * 32 + c8 * 4;
    int tA = tok(0), tB = tok(1);
    int e0 = eidx[(size_t)tA * 128 + lane], e1 = eidx[(size_t)tA * 128 + 64 + lane];
    u32x4 hq = *(const u32x4*)(hqs + (size_t)tA * 256);
    int ne0 = eidx[(size_t)tB * 128 + lane], ne1 = eidx[(size_t)tB * 128 + 64 + lane];
    u32x4 r[16];
#pragma unroll
    for (int i = 0; i < 16; ++i) { const int e = __shfl(i < 8 ? e0 : e1, 8 * (i & 7) + grp) & EMASK; r[i] = __builtin_amdgcn_raw_buffer_load_b128(urs, e * 128 + c8 * 16, 0, 0); }
#pragma unroll 1
    for (int it = 0; it < ntok; ++it) {
        const int t = tok(it), t1 = tok(it + 1), t2 = tok(it + 2);
        const int ze0 = eidx[(size_t)t2 * 128 + lane], ze1 = eidx[(size_t)t2 * 128 + 64 + lane];
        const u32x4 nhq = *(const u32x4*)(hqs + (size_t)t1 * 256);
#pragma unroll
        for (int q = 0; q < 4; ++q) {
            int evv[4];
#pragma unroll
            for (int j = 0; j < 4; ++j) evv[j] = __shfl(q < 2 ? ne0 : ne1, 32 * (q & 1) + 8 * j + grp) & EMASK;
            int pa[4], pb[4];
#pragma unroll
            for (int j = 0; j < 4; ++j) {
                pa[j] = __builtin_amdgcn_sdot4((int)r[4 * q + j][0], (int)hq[0], 0, false); pb[j] = __builtin_amdgcn_sdot4((int)r[4 * q + j][1], (int)hq[1], 0, false);
                pa[j] = __builtin_amdgcn_sdot4((int)r[4 * q + j][2], (int)hq[2], pa[j], false); pb[j] = __builtin_amdgcn_sdot4((int)r[4 * q + j][3], (int)hq[3], pb[j], false);
            }
#pragma unroll
            for (int j = 0; j < 4; ++j) { pa[j] += pb[j]; pa[j] += dppi<0xB1>(pa[j]); }
#pragma unroll
            for (int j = 0; j < 4; ++j) pa[j] += dppi<0x4E>(pa[j]);
#pragma unroll
            for (int j = 0; j < 4; ++j) pa[j] += dppi<0x141>(pa[j]);
            if (c8 == 0) {
#pragma unroll
                for (int j = 0; j < 4; ++j) row[8 * (4 * q + j) + grp] = pa[j];
            }
#pragma unroll
            for (int j = 0; j < 4; ++j) {
                asm volatile("" ::: "memory");
                r[4 * q + j] = __builtin_amdgcn_raw_buffer_load_b128(urs, evv[j] * 128 + c8 * 16, 0, 0);
                asm volatile("" ::: "memory");
            }
        }
        LDS_WAIT();
        const int p0 = row[lane], p1 = row[64 + lane];
        LDS_WAIT();
        { short* pp = pdot + ((size_t)s * T + t) * 128 + lane; const int c0 = min(max((p0 + 4) >> 3, -32768), 32767), c1 = min(max((p1 + 4) >> 3, -32768), 32767);
          asm volatile("global_store_short %0, %1, off\n\tglobal_store_short %0, %2, off offset:128" :: "v"(pp), "v"(c0), "v"(c1) : "memory"); }
        hq = nhq; ne0 = ze0; ne1 = ze1;
    }
  }
}
__device__ __forceinline__ void ph_ureduce(const Ctx& C, LAS unsigned char* lds, const short* __restrict__ pdot, const float* __restrict__ hsc, const int* __restrict__ eidx, const float* __restrict__ us,
                                           const float* __restrict__ vs, const float* __restrict__ egate, unsigned* __restrict__ wqp, float* __restrict__ wsc) {
    const int lane = C.lane;
    volatile LAS unsigned char* row = (volatile LAS unsigned char*)(lds + C.wave * 1024);
    for (int tb = C.gw * 2; tb < T; tb += C.ngw * 2) {
        int e0[2], e1[2], s0[2], s1[2]; float h[2], g0[2], g1[2];
#pragma unroll
        for (int u = 0; u < 2; ++u) {
            const int t = tb + u;
            e0[u] = eidx[(size_t)t * 128 + lane]; e1[u] = eidx[(size_t)t * 128 + 64 + lane];
            g0[u] = egate[(size_t)t * 128 + lane]; g1[u] = egate[(size_t)t * 128 + 64 + lane];
            h[u] = hsc[t]; s0[u] = 0; s1[u] = 0;
#pragma unroll
            for (int s = 0; s < 8; ++s) { const short* pp = pdot + ((size_t)s * T + t) * 128 + lane; s0[u] += (int)pp[0]; s1[u] += (int)pp[64]; }
        }
        float w0[2], w1[2];
#pragma unroll
        for (int u = 0; u < 2; ++u) {
            w0[u] = gelu_fast((float)s0[u] * (8.0f * h[u]) * us[e0[u]]) * g0[u] * vs[e0[u]];
            w1[u] = gelu_fast((float)s1[u] * (8.0f * h[u]) * us[e1[u]]) * g1[u] * vs[e1[u]];
        }
#pragma unroll
        for (int u = 0; u < 2; ++u) {
            const int t = tb + u;
            const float wm = wave_max(fmaxf(fabsf(w0[u]), fabsf(w1[u])));
            const float inv = wm > 0.f ? 127.0f / wm : 0.f;
            { const int k = lane; row[u * 128 + (k & 7) * 16 + (k >> 5) * 4 + ((k >> 3) & 3)] = (unsigned char)(int)rintf(w0[u] * inv); }
            { const int k = 64 + lane; row[u * 128 + (k & 7) * 16 + (k >> 5) * 4 + ((k >> 3) & 3)] = (unsigned char)(int)rintf(w1[u] * inv); }
            if (lane == 0) wsc[t] = wm * (1.0f / 127.0f);
        }
        LDS_WAIT();
        wqp[(size_t)tb * 32 + lane] = ((volatile LAS unsigned*)row)[lane];
        LDS_WAIT();
    }
}
template <int EMASK>
__device__ __forceinline__ void ph_vpeer(const Ctx& C, const Slicing SL, const int* __restrict__ eidx, const unsigned* __restrict__ wqp, const float* __restrict__ wsc, const unsigned char* __restrict__ vq,
                                         const float* xio, float* xout, float* __restrict__ ssf) {
    const int lane = C.lane, grp = lane >> 3, c8 = lane & 7;
    const bool hh = (lane & 32) != 0, b4 = (lane & 16) != 0, b3 = (lane & 8) != 0;
    const int wv = SL.rank * NWAVES + C.wave, nwv = SL.nloc * NWAVES;
    const int ntok = (T - wv + nwv - 1) / nwv;
    auto tok = [&](int i) { const int t = wv + i * nwv; return t < T ? t : T - 1; };
  for (int s = SL.pi; s < 8; s += SL.m) {
    const __amdgpu_buffer_rsrc_t vrs = slice_rsrc(vq + (size_t)s * (NEXP * 128));
    const int chl = 8 * (hh ? 1 : 0) + 4 * (b4 ? 1 : 0) + 2 * (b3 ? 1 : 0);
    const int coff = s * 128 + c8 * 16 + chl;
    int tA = tok(0), tB = tok(1);
    int e0 = eidx[(size_t)tA * 128 + lane], e1 = eidx[(size_t)tA * 128 + 64 + lane];
    u32x4 wq = *(const u32x4*)(wqp + (size_t)tA * 32 + grp * 4); float wscale = wsc[tA];
    int ne0 = eidx[(size_t)tB * 128 + lane], ne1 = eidx[(size_t)tB * 128 + 64 + lane];
    u32x4 r[16];
#pragma unroll
    for (int i = 0; i < 16; ++i) { const int e = __shfl(i < 8 ? e0 : e1, 8 * (i & 7) + grp) & EMASK; r[i] = __builtin_amdgcn_raw_buffer_load_b128(vrs, e * 128 + c8 * 16, 0, 0); }
#pragma unroll 1
    for (int it = 0; it < ntok; ++it) {
        const int t = tok(it), t1 = tok(it + 1), t2 = tok(it + 2);
        const int ze0 = eidx[(size_t)t2 * 128 + lane], ze1 = eidx[(size_t)t2 * 128 + 64 + lane];
        const u32x4 nwq = *(const u32x4*)(wqp + (size_t)t1 * 32 + grp * 4); const float nwscale = wsc[t1];
        const float2 xv = *(const float2*)(xio + (size_t)t * DM + coff);
        int o[16];
#pragma unroll
        for (int c = 0; c < 16; ++c) o[c] = 0;
#pragma unroll
        for (int q = 0; q < 4; ++q) {
            int evv[4];
#pragma unroll
            for (int j = 0; j < 4; ++j) evv[j] = __shfl(q < 2 ? ne0 : ne1, 32 * (q & 1) + 8 * j + grp) & EMASK;
#pragma unroll
            for (int d = 0; d < 4; ++d) {
                const unsigned a = r[4 * q][d], b = r[4 * q + 1][d], c = r[4 * q + 2][d], e = r[4 * q + 3][d];
                const unsigned t0 = __builtin_amdgcn_perm(b, a, 0x05010400u), t1p = __builtin_amdgcn_perm(b, a, 0x07030602u);
                const unsigned u0 = __builtin_amdgcn_perm(e, c, 0x05010400u), u1 = __builtin_amdgcn_perm(e, c, 0x07030602u);
                o[4 * d + 0] = __builtin_amdgcn_sdot4((int)__builtin_amdgcn_perm(u0, t0, 0x05040100u), (int)wq[q], o[4 * d + 0], false);
                o[4 * d + 1] = __builtin_amdgcn_sdot4((int)__builtin_amdgcn_perm(u0, t0, 0x07060302u), (int)wq[q], o[4 * d + 1], false);
                o[4 * d + 2] = __builtin_amdgcn_sdot4((int)__builtin_amdgcn_perm(u1, t1p, 0x05040100u), (int)wq[q], o[4 * d + 2], false);
                o[4 * d + 3] = __builtin_amdgcn_sdot4((int)__builtin_amdgcn_perm(u1, t1p, 0x07060302u), (int)wq[q], o[4 * d + 3], false);
            }
#pragma unroll
            for (int j = 0; j < 4; ++j) {
                asm volatile("" ::: "memory");
                r[4 * q + j] = __builtin_amdgcn_raw_buffer_load_b128(vrs, evv[j] * 128 + c8 * 16, 0, 0);
                asm volatile("" ::: "memory");
            }
        }
        int q8[8], q4[4], q2[2];
#pragma unroll
        for (int k = 0; k < 8; ++k) q8[k] = bfly32i(o[k], o[8 + k]);
#pragma unroll
        for (int k = 0; k < 4; ++k) q4[k] = bfly16i(q8[k], q8[4 + k]);
#pragma unroll
        for (int k = 0; k < 2; ++k) { const int mine = b3 ? q4[2 + k] : q4[k], oth = b3 ? q4[k] : q4[2 + k]; q2[k] = mine + dppi<0x128>(oth); }
        const float y0 = xv.x + (float)q2[0] * wscale, y1 = xv.y + (float)q2[1] * wscale;
        { float* yp = xout + (size_t)t * DM + coff; const float2 yv = make_float2(y0, y1); asm volatile("global_store_dwordx2 %0, %1, off" :: "v"(yp), "v"(yv) : "memory"); }
        const float ss = wave_sum(y0 * y0 + y1 * y1);
        if (lane == 0) { float* sp = ssf + (size_t)s * T + t; asm volatile("global_store_dword %0, %1, off" :: "v"(sp), "v"(ss) : "memory"); }
        wq = nwq; wscale = nwscale; ne0 = ze0; ne1 = ze1;
    }
  }
}
__device__ __forceinline__ void ph_final(const Ctx& C, const float* __restrict__ ssf, float* xio, const float* __restrict__ gf) {
    const int lane = C.lane;
    f32x4 gg[4];
#pragma unroll
    for (int j = 0; j < 4; ++j) gg[j] = *(const f32x4*)(gf + j * 256 + lane * 4);
    for (int tb = C.gw * 4; tb < T; tb += C.ngw * 4) {
        f32x4 v[4][4]; float r[4];
#pragma unroll
        for (int u = 0; u < 4; ++u) {
#pragma unroll
            for (int j = 0; j < 4; ++j) v[u][j] = *(const f32x4*)(xio + (size_t)(tb + u) * DM + j * 256 + lane * 4);
            float s = 0.f;
#pragma unroll
            for (int i = 0; i < 8; ++i) s += ssf[(size_t)i * T + tb + u];
            r[u] = rsqrtf(s * (1.0f / DM) + EPS);
        }
#pragma unroll
        for (int u = 0; u < 4; ++u)
#pragma unroll
            for (int j = 0; j < 4; ++j) *(f32x4*)(xio + (size_t)(tb + u) * DM + j * 256 + lane * 4) = v[u][j] * r[u] * gg[j];
    }
}

namespace pg8 {
#define PG8_LAS __attribute__((address_space(3)))
typedef _Float16 frag8 __attribute__((ext_vector_type(8)));
typedef float f32x4 __attribute__((ext_vector_type(4)));
constexpr int BM = 256, BK = 64, HALF = 128, HTB = HALF * BK * 2  , STAGE_BYTES = 8 * HTB, NXCD = 8, WGM = 8;

__host__ __device__ __forceinline__ int lds_byte(int r, int c) { const int st = (r >> 4) * 2 + (c >> 5), rr = r & 15, cc = c & 31, ob = rr * 64 + cc * 2; return st * 1024 + (ob ^ (((ob >> 9) & 1) << 5)); }
__host__ __device__ __forceinline__ void stage_rc(int b, int& R, int& C) { const int st = b / 1024, sb = b % 1024, swz = sb ^ (((sb >> 9) & 1) << 5); R = (st >> 1) * 16 + swz / 64; C = (st & 1) * 32 + (swz % 64) / 2; }
__host__ __device__ __forceinline__ int perm32(int rho) { const int n = rho >> 4, i = rho & 15; return 8 * (i >> 2) + 4 * n + (i & 3); }

struct Unit { int pm, pn; };
struct Gemm { const f16* A; const f16* Bt; int M, N, K; };

struct StaticOrder {
    int nM, nN, nwg, G, c;
    __host__ __device__ void init(int M, int N, int G_, int c_) { nM = M / BM; nN = N / BM; nwg = nM * nN; G = G_; c = c_; }
    __host__ __device__ bool next(int i, Unit& u) const {
        const long L = (long)i * G + c; if (L >= nwg) return false;
        int wgid = (int)L; { const int q = nwg / NXCD, r = nwg % NXCD, xcd = wgid % NXCD, off = wgid / NXCD; wgid = (xcd < r ? xcd * (q + 1) : r * (q + 1) + (xcd - r) * q) + off; }
        const int nig = WGM * nN, gid = wgid / nig, fm = gid * WGM, gsz = (nM - fm) < WGM ? (nM - fm) : WGM;
        u.pm = fm + ((wgid % nig) % gsz); u.pn = (wgid % nig) / gsz; return true;
    }
    __device__ __forceinline__ void a_ready(const Unit&) const {}
    __device__ __forceinline__ void done(const Unit&) const {}
};

__device__ __forceinline__ frag8 pack8(const f32x4 a, const f32x4 b) {
    frag8 h; h[0] = (f16)a[0]; h[1] = (f16)a[1]; h[2] = (f16)a[2]; h[3] = (f16)a[3]; h[4] = (f16)b[0]; h[5] = (f16)b[1]; h[6] = (f16)b[2]; h[7] = (f16)b[3]; return h;
}
__device__ __forceinline__ float sigmoidf_(float z) { return 1.0f / (1.0f + __expf(-z)); }

struct EpiP1 {
    typedef i32x4 acc_t; static constexpr bool PERM = true, AFTER_DRAIN = false, MIDK = false;
    const float* ss1; const float* rsx; const float* wcs; const float* bgate; f16* qkvu; f16* gates; f16* vT;
    __device__ __forceinline__ void operator()(const i32x4 (&acc)[2][2][4][2], const Unit& u, int wr, int wc, int fr, int fq) const {
        const int row0 = u.pm * BM + wr * 64 + fr, colt = u.pn * BM; const bool isg = colt >= NQKVU;
        f32x4 cs[2][2];
#pragma unroll
        for (int bj = 0; bj < 2; ++bj) { const int c0 = colt + bj * HALF + wc * 32 + 8 * fq; cs[bj][0] = *(const f32x4*)(wcs + c0); cs[bj][1] = *(const f32x4*)(wcs + c0 + 4); }
#pragma unroll
        for (int ai = 0; ai < 2; ++ai)
#pragma unroll
            for (int m = 0; m < 4; ++m) { const int row = row0 + ai * HALF + m * 16; const float r = rsqrtf(ss1[row] * (1.0f / DM) + EPS) * rsx[row];
#pragma unroll
                for (int bj = 0; bj < 2; ++bj) { const int c0 = colt + bj * HALF + wc * 32 + 8 * fq; f32x4 v0, v1;
#pragma unroll
                    for (int i = 0; i < 4; ++i) { v0[i] = (float)acc[ai][bj][m][0][i] * (r * cs[bj][0][i]); v1[i] = (float)acc[ai][bj][m][1][i] * (r * cs[bj][1][i]); }
                    if (isg) { const int cg = c0 - NQKVU; const f32x4 b0 = *(const f32x4*)(bgate + cg), b1 = *(const f32x4*)(bgate + cg + 4);
#pragma unroll
                        for (int i = 0; i < 4; ++i) { v0[i] = sigmoidf_(v0[i] + b0[i]); v1[i] = sigmoidf_(v1[i] + b1[i]); }
                        *(frag8*)(gates + (size_t)row * NGATE + cg) = pack8(v0, v1); }
                    else { const frag8 hv = pack8(v0, v1); *(frag8*)(qkvu + (size_t)row * NQKVU + c0) = hv;
                        if (colt == 512 && bj == 1) {
                            f16* vp = vT + ((size_t)((row >> 11) * 2 + (wc >> 1)) * 64 + (wc & 1) * 32 + 8 * fq) * SEQ + (row & (SEQ - 1));
#pragma unroll
                            for (int i = 0; i < 8; ++i) vp[(size_t)i * SEQ] = hv[i]; } } } }
    }
};
struct EpiMerged {
    typedef f32x4 acc_t; static constexpr bool PERM = true, AFTER_DRAIN = false, MIDK = true;
    const f16* gates; f16* merged;
    __device__ __forceinline__ void mid(f32x4 (&acc)[2][2][4][2], const Unit& u, int wr, int wc, int fr, int fq) const {
        const int row0 = u.pm * BM + wr * 64 + fr, colt = u.pn * BM;
        const f16* gb = gates + (size_t)row0 * NGATE + colt + wc * 32 + 8 * fq;
        asm volatile("" : "+v"(gb));
#pragma unroll
        for (int ai = 0; ai < 2; ++ai) {
            frag8 g0[4][2], g1[4][2];
#pragma unroll
            for (int m = 0; m < 4; ++m)
#pragma unroll
                for (int bj = 0; bj < 2; ++bj) { const f16* gp = gb + (size_t)(ai * HALF + m * 16) * NGATE + bj * HALF; g0[m][bj] = *(const frag8*)gp; g1[m][bj] = *(const frag8*)(gp + DM); }
#pragma unroll
            for (int m = 0; m < 4; ++m)
#pragma unroll
                for (int bj = 0; bj < 2; ++bj)
#pragma unroll
                    for (int i = 0; i < 4; ++i) {
                        acc[ai][bj][m][0][i] *= (float)g0[m][bj][i] * __builtin_amdgcn_rcpf(fmaxf((float)g1[m][bj][i], 1e-4f));
                        acc[ai][bj][m][1][i] *= (float)g0[m][bj][4 + i] * __builtin_amdgcn_rcpf(fmaxf((float)g1[m][bj][4 + i], 1e-4f)); }
            asm volatile("" ::: "memory");
        }
    }
    __device__ __forceinline__ void operator()(const f32x4 (&acc)[2][2][4][2], const Unit& u, int wr, int wc, int fr, int fq) const {
        const int row0 = u.pm * BM + wr * 64 + fr, colt = u.pn * BM;
#pragma unroll
        for (int ai = 0; ai < 2; ++ai)
#pragma unroll
            for (int m = 0; m < 4; ++m) { const int row = row0 + ai * HALF + m * 16;
#pragma unroll
                for (int bj = 0; bj < 2; ++bj) { const int c0 = colt + bj * HALF + wc * 32 + 8 * fq;
                    const frag8 g1 = *(const frag8*)(gates + (size_t)row * NGATE + DM + c0); f32x4 v0, v1;
#pragma unroll
                    for (int i = 0; i < 4; ++i) { v0[i] = acc[ai][bj][m][0][i] * fmaxf((float)g1[i], 1e-4f); v1[i] = acc[ai][bj][m][1][i] * fmaxf((float)g1[4 + i], 1e-4f); }
                    *(frag8*)(merged + (size_t)row * DM + c0) = pack8(v0, v1); } }
    }
};
struct EpiOut {
    typedef f32x4 acc_t; static constexpr bool PERM = false, AFTER_DRAIN = false, MIDK = false;
    const float* x; const float* g2; float* x1; f16* x1h; float* ss2p;
    __device__ __forceinline__ void operator()(const f32x4 (&acc)[2][2][4][2], const Unit& u, int wr, int wc, int fr, int fq) const {
        const int row0 = u.pm * BM + wr * 64 + fr, col0 = u.pn * BM + wc * 32 + 4 * fq;
        f32x4 gv[2][2];
#pragma unroll
        for (int bj = 0; bj < 2; ++bj)
#pragma unroll
            for (int n = 0; n < 2; ++n) gv[bj][n] = *(const f32x4*)(g2 + col0 + bj * HALF + n * 16);
#pragma unroll
        for (int ai = 0; ai < 2; ++ai)
#pragma unroll
            for (int m = 0; m < 4; ++m) { const int row = row0 + ai * HALF + m * 16; const size_t off = (size_t)row * DM + col0; float ssq = 0.f;
#pragma unroll
                for (int bj = 0; bj < 2; ++bj)
#pragma unroll
                    for (int n = 0; n < 2; ++n) { const f32x4 y = *(const f32x4*)(x + off + bj * HALF + n * 16) + acc[ai][bj][m][n];
                        *(f32x4*)(x1 + off + bj * HALF + n * 16) = y; ssq += (y[0] * y[0] + y[1] * y[1]) + (y[2] * y[2] + y[3] * y[3]);
                        const f32x4 yg = y * gv[bj][n]; half4 h; h[0] = (f16)yg[0]; h[1] = (f16)yg[1]; h[2] = (f16)yg[2]; h[3] = (f16)yg[3];
                        *(half4*)(x1h + off + bj * HALF + n * 16) = h; }
                ssq += __shfl_xor(ssq, 16); ssq += __shfl_xor(ssq, 32);
                if (fq == 0) ss2p[(size_t)(u.pn * 4 + wc) * T + row] = ssq; }
    }
};
struct EpiQ {
    typedef i32x4 acc_t; static constexpr bool PERM = true, AFTER_DRAIN = false, MIDK = false;
    const float* hsc; const float* wqs; f16* qp;
    __device__ __forceinline__ void operator()(const i32x4 (&acc)[2][2][4][2], const Unit& u, int wr, int wc, int fr, int fq) const {
        const int row0 = u.pm * BM + wr * 64 + fr, colt = u.pn * BM;
        f32x4 cs[2][2];
#pragma unroll
        for (int bj = 0; bj < 2; ++bj) { const int c0 = colt + bj * HALF + wc * 32 + 8 * fq; cs[bj][0] = *(const f32x4*)(wqs + c0); cs[bj][1] = *(const f32x4*)(wqs + c0 + 4); }
#pragma unroll
        for (int ai = 0; ai < 2; ++ai)
#pragma unroll
            for (int m = 0; m < 4; ++m) { const int row = row0 + ai * HALF + m * 16; const float r = hsc[row];
#pragma unroll
                for (int bj = 0; bj < 2; ++bj) { const int c0 = colt + bj * HALF + wc * 32 + 8 * fq; f32x4 v0, v1;
#pragma unroll
                    for (int i = 0; i < 4; ++i) { v0[i] = (float)acc[ai][bj][m][0][i] * (r * cs[bj][0][i]); v1[i] = (float)acc[ai][bj][m][1][i] * (r * cs[bj][1][i]); }
                    *(frag8*)(qp + (size_t)row * 2048 + c0) = pack8(v0, v1); } }
    }
};

__device__ __forceinline__ void mma16(const frag8 b, const frag8 a, f32x4& c) { c = __builtin_amdgcn_mfma_f32_16x16x32_f16(b, a, c, 0, 0, 0); }
__device__ __forceinline__ void mma16(const frag8 b, const frag8 a, i32x4& c) { c = __builtin_amdgcn_mfma_i32_16x16x64_i8(__builtin_bit_cast(i32x4, b), __builtin_bit_cast(i32x4, a), c, 0, 0, 0); }
template <class Epi, class Sched, bool ALIGN_EPI = false, bool SP2 = false>
__device__ __forceinline__ void gemm_phase(PG8_LAS unsigned char* lds, const Gemm g, const Sched& S, const Epi& E) {
    const int tid = threadIdx.x, wid = __builtin_amdgcn_readfirstlane(tid >> 6), lane = tid & 63, wr = wid >> 2, wc = wid & 3, fr = lane & 15, fq = lane >> 4;
    const int K = g.K, nt = K / BK;
    unsigned voffA[2], voffB[2];
#pragma unroll
    for (int i = 0; i < 2; ++i) { int R, C; stage_rc(tid * 16 + i * 8192, R, C); const int Rb = Epi::PERM ? ((R & ~31) + perm32(R & 31)) : R;
        voffA[i] = (unsigned)(R * K + C) * 2u; voffB[i] = (unsigned)(Rb * K + C) * 2u; }
    const size_t kstep = (size_t)(BK * 2);
    const size_t hstep = (size_t)HALF * K * 2;
    const size_t tstep = 2 * hstep;
    const unsigned ldsw = (unsigned)wid * 1024u;
    const int aoff = lds_byte(wr * 64 + fr, fq * 8), boff = lds_byte(wc * 32 + fr, fq * 8);
#define PG8_SA(b, h) (((b) * 2 + (h)) * HTB)
#define PG8_SB(b, h) ((4 + (b) * 2 + (h)) * HTB)
#define PG8_STAGE(bufoff, gbase, voff) do { _Pragma("unroll") for (int _i = 0; _i < 2; ++_i) \
        __builtin_amdgcn_global_load_lds((const unsigned*)((const char*)(gbase) + (voff)[_i]), (PG8_LAS unsigned*)(lds + (bufoff) + ldsw + _i * 8192), 16, 0, 0); } while (0)
#define PG8_LDA(dst, b, h) do { _Pragma("unroll") for (int m = 0; m < 4; ++m) _Pragma("unroll") for (int k = 0; k < 2; ++k) dst[m][k] = *(const PG8_LAS frag8*)(lds + PG8_SA(b, h) + aoff + m * 2048 + k * 1024); } while (0)
#define PG8_LDB(dst, b, h) do { _Pragma("unroll") for (int n = 0; n < 2; ++n) _Pragma("unroll") for (int k = 0; k < 2; ++k) dst[n][k] = *(const PG8_LAS frag8*)(lds + PG8_SB(b, h) + boff + n * 2048 + k * 1024); } while (0)
#define PG8_MMA(ai, bj, At, Bt) do { __builtin_amdgcn_s_setprio(1); _Pragma("unroll") for (int m = 0; m < 4; ++m) _Pragma("unroll") for (int n = 0; n < 2; ++n) _Pragma("unroll") for (int k = 0; k < 2; ++k) \
        mma16(Bt[n][k], At[m][k], acc[ai][bj][m][n]); __builtin_amdgcn_s_setprio(0); } while (0)
#define PG8_WAIT_V(n) asm volatile("s_waitcnt vmcnt(" #n ")" ::: "memory")
#define PG8_WAIT_L(n) asm volatile("s_waitcnt lgkmcnt(" #n ")" ::: "memory")
#define PG8_BAR __builtin_amdgcn_s_barrier()
#define PG8_SCHED __builtin_amdgcn_sched_barrier(0)
    Unit cur, nxt; int ui = 0;
    if (!S.next(0, cur)) return;
    typedef typename Epi::acc_t acc_t;
    acc_t acc[2][2][4][2];
#pragma unroll
    for (int a = 0; a < 2; ++a)
#pragma unroll
        for (int b = 0; b < 2; ++b)
#pragma unroll
            for (int m = 0; m < 4; ++m)
#pragma unroll
                for (int n = 0; n < 2; ++n) acc[a][b][m][n] = acc_t{};
    frag8 At[4][2], B0[2][2], B1[2][2];
    const char* cA = (const char*)g.A + (size_t)cur.pm * tstep; const char* cB = (const char*)g.Bt + (size_t)cur.pn * tstep;
    S.a_ready(cur);
    if constexpr (SP2) {
        PG8_STAGE(PG8_SB(0, 0), cB, voffB); PG8_STAGE(PG8_SB(0, 1), cB + hstep, voffB); PG8_STAGE(PG8_SA(0, 0), cA, voffA); PG8_STAGE(PG8_SA(0, 1), cA + hstep, voffA);
        if (wr == 1) PG8_BAR;
        PG8_WAIT_V(2); PG8_BAR;
        PG8_STAGE(PG8_SB(1, 0), cB + kstep, voffB); PG8_STAGE(PG8_SA(1, 0), cA + kstep, voffA); PG8_STAGE(PG8_SB(1, 1), cB + hstep + kstep, voffB);
        PG8_WAIT_V(6); PG8_BAR;
    } else {
        PG8_STAGE(PG8_SB(0, 0), cB, voffB); PG8_STAGE(PG8_SA(0, 0), cA, voffA); PG8_STAGE(PG8_SB(0, 1), cB + hstep, voffB); PG8_STAGE(PG8_SA(0, 1), cA + hstep, voffA);
        if (wr == 1) PG8_BAR;
        PG8_WAIT_V(4); PG8_BAR;
        PG8_STAGE(PG8_SB(1, 0), cB + kstep, voffB); PG8_STAGE(PG8_SA(1, 0), cA + kstep, voffA); PG8_STAGE(PG8_SB(1, 1), cB + hstep + kstep, voffB);
        PG8_WAIT_V(6); PG8_BAR;
    }
    for (;;) {
        const bool has_next = S.next(ui + 1, nxt);
        const char* nA = has_next ? (const char*)g.A + (size_t)nxt.pm * tstep : cA; const char* nB = has_next ? (const char*)g.Bt + (size_t)nxt.pn * tstep : cB;
        for (int t = 0; t < nt; t += 2) {
            const bool last = (t == nt - 2);
            if constexpr (Epi::MIDK) { if (t == (nt >> 1)) E.mid(acc, cur, wr, wc, fr, fq); }
            const char* a1 = cA + (size_t)(t + 1) * kstep;
            const char* a2 = last ? nA : cA + (size_t)(t + 2) * kstep; const char* b2 = last ? nB : cB + (size_t)(t + 2) * kstep;
            const char* a3 = a2 + kstep; const char* b3 = b2 + kstep;
            if (last && has_next) S.a_ready(nxt);
            if constexpr (SP2) {
            PG8_LDB(B0, 0, 0); PG8_LDB(B1, 0, 1); PG8_SCHED; PG8_LDA(At, 0, 0); PG8_STAGE(PG8_SA(1, 1), a1 + hstep, voffA);
            PG8_WAIT_V(8); PG8_WAIT_L(0); PG8_BAR; PG8_MMA(0, 0, At, B0); PG8_MMA(0, 1, At, B1); PG8_BAR; PG8_SCHED;
            PG8_LDA(At, 0, 1); PG8_STAGE(PG8_SB(0, 0), b2, voffB); PG8_STAGE(PG8_SB(0, 1), b2 + hstep, voffB); PG8_STAGE(PG8_SA(0, 0), a2, voffA);
            PG8_WAIT_V(8); PG8_WAIT_L(0); PG8_BAR; PG8_MMA(1, 0, At, B0); PG8_MMA(1, 1, At, B1); PG8_BAR; PG8_SCHED;
            PG8_LDB(B0, 1, 0); PG8_LDB(B1, 1, 1); PG8_SCHED; PG8_LDA(At, 1, 0); PG8_STAGE(PG8_SA(0, 1), a2 + hstep, voffA);
            PG8_WAIT_V(8); PG8_WAIT_L(0); PG8_BAR; PG8_MMA(0, 0, At, B0); PG8_MMA(0, 1, At, B1); PG8_BAR; PG8_SCHED;
            PG8_LDA(At, 1, 1); PG8_STAGE(PG8_SB(1, 0), b3, voffB); PG8_STAGE(PG8_SB(1, 1), b3 + hstep, voffB); PG8_STAGE(PG8_SA(1, 0), a3, voffA);
            PG8_WAIT_V(8); PG8_WAIT_L(0); PG8_BAR; PG8_MMA(1, 0, At, B0); PG8_MMA(1, 1, At, B1); PG8_BAR; PG8_SCHED;
            } else {
            PG8_LDB(B0, 0, 0); PG8_SCHED; PG8_LDA(At, 0, 0); PG8_STAGE(PG8_SA(1, 1), a1 + hstep, voffA);
            PG8_WAIT_L(8); PG8_BAR; PG8_WAIT_L(0); PG8_MMA(0, 0, At, B0); PG8_BAR; PG8_SCHED;
            PG8_LDB(B1, 0, 1); PG8_STAGE(PG8_SB(0, 0), b2, voffB);
            PG8_BAR; PG8_WAIT_L(0); PG8_MMA(0, 1, At, B1); PG8_BAR;
            PG8_LDA(At, 0, 1); PG8_STAGE(PG8_SA(0, 0), a2, voffA);
            PG8_BAR; PG8_WAIT_L(0); PG8_MMA(1, 0, At, B0); PG8_BAR; PG8_SCHED;
            PG8_STAGE(PG8_SB(0, 1), b2 + hstep, voffB);
            PG8_WAIT_V(6); PG8_BAR; PG8_MMA(1, 1, At, B1); PG8_BAR;
            PG8_LDB(B0, 1, 0); PG8_SCHED; PG8_LDA(At, 1, 0); PG8_STAGE(PG8_SA(0, 1), a2 + hstep, voffA);
            PG8_WAIT_L(8); PG8_BAR; PG8_WAIT_L(0); PG8_MMA(0, 0, At, B0); PG8_BAR; PG8_SCHED;
            PG8_LDB(B1, 1, 1); PG8_STAGE(PG8_SB(1, 0), b3, voffB);
            PG8_BAR; PG8_WAIT_L(0); PG8_MMA(0, 1, At, B1); PG8_BAR;
            PG8_LDA(At, 1, 1); PG8_STAGE(PG8_SA(1, 0), a3, voffA);
            PG8_BAR; PG8_WAIT_L(0); PG8_MMA(1, 0, At, B0); PG8_BAR; PG8_SCHED;
            PG8_STAGE(PG8_SB(1, 1), b3 + hstep, voffB);
            PG8_WAIT_V(6); PG8_BAR; PG8_MMA(1, 1, At, B1); PG8_BAR;
            }
        }
        if constexpr (ALIGN_EPI) { if (wr == 0) PG8_BAR; }
        if constexpr (!Epi::AFTER_DRAIN) { E(acc, cur, wr, wc, fr, fq); S.done(cur); }
        if (!has_next) break;
#pragma unroll
        for (int a = 0; a < 2; ++a)
#pragma unroll
            for (int b = 0; b < 2; ++b)
#pragma unroll
                for (int m = 0; m < 4; ++m)
#pragma unroll
                    for (int n = 0; n < 2; ++n) acc[a][b][m][n] = acc_t{};
        cur = nxt; cA = nA; cB = nB; ++ui;
        if constexpr (ALIGN_EPI) { if (wr == 1) PG8_BAR; }
    }
    PG8_WAIT_V(0);
    if constexpr (!ALIGN_EPI) { if (wr == 0) PG8_BAR; }
    PG8_BAR;
    if constexpr (Epi::AFTER_DRAIN) { E.fused(acc, cur, wr, wc, fr, fq, lds, wid, lane); S.done(cur); }
#undef PG8_SA
#undef PG8_SB
#undef PG8_STAGE
#undef PG8_LDA
#undef PG8_LDB
#undef PG8_MMA
#undef PG8_WAIT_V
#undef PG8_WAIT_L
#undef PG8_BAR
#undef PG8_SCHED
}
}

#define XB_TMO      128
#define XB_XCNT(j)  (256  + 64 * (j))
#define XB_XSUB(j)  (1280 + 64 * (j))
#define XB_XGEN(j)  (2304 + 64 * (j))
#define XB_TOP      3328
#define XB_TOPGEN   3392
#define XCD_BAR_WORDS 3456
#define XB_SPIN_CAP (1u << 18)

__device__ __forceinline__ unsigned xb_ld(unsigned* p)              { return __hip_atomic_load(p, __ATOMIC_RELAXED, __HIP_MEMORY_SCOPE_AGENT); }
__device__ __forceinline__ unsigned xb_add(unsigned* p, unsigned v) { return __hip_atomic_fetch_add(p, v, __ATOMIC_RELAXED, __HIP_MEMORY_SCOPE_AGENT); }
__device__ __forceinline__ unsigned xb_xcc_id() { return (unsigned)__builtin_amdgcn_s_getreg((3 << 11) | 20) & 0xFu; }
#define XB_SPIN(cond, bar) do { unsigned _sp = 0; while (cond) { __builtin_amdgcn_s_sleep(1); \
    if ((++_sp & 255u) == 0u) { if (xb_ld(&(bar)[XB_TMO])) break; if (_sp > XB_SPIN_CAP) { atomicAdd(&(bar)[XB_TMO], 1u); break; } } } } while (0)

struct XcdBarrier {
    unsigned* bar; unsigned x;
    volatile LAS unsigned* st;
};

__device__ __forceinline__ XcdBarrier xcd_barrier_post(unsigned* bar, volatile LAS unsigned* st) {
    XcdBarrier b; b.bar = bar; b.x = xb_xcc_id(); b.st = st;
    if (threadIdx.x == 0) st[2] = xb_add(&bar[XB_XCNT(b.x)], 1u);
    return b;
}
__device__ __forceinline__ void xcd_barrier_complete(unsigned* bar, unsigned x, unsigned& nloc, unsigned& nx) {
    const unsigned G = gridDim.x * gridDim.y * gridDim.z;
    unsigned sum, cnt, mine, sp = 0u;
    for (;;) {
        sum = 0u; cnt = 0u; mine = 0u;
#pragma unroll
        for (unsigned j = 0; j < 16; ++j) { const unsigned c = xb_ld(&bar[XB_XCNT(j)]); sum += c; cnt += (c > 0u) ? 1u : 0u; mine = (j == x) ? c : mine; }
        if (sum == G) break;
        __builtin_amdgcn_s_sleep(1);
        if ((++sp & 255u) == 0u) { if (xb_ld(&bar[XB_TMO])) break; if (sp > XB_SPIN_CAP) { atomicAdd(&bar[XB_TMO], 1u); break; } }
    }
    nloc = mine > 0u ? mine : 1u; nx = cnt > 0u ? cnt : 1u;
}

__device__ __forceinline__ void xcd_barrier(const XcdBarrier& b) {
    asm volatile("s_waitcnt vmcnt(0)" ::: "memory");
    __syncthreads();
    if (threadIdx.x == 0) {
        unsigned* bar = b.bar;
        __builtin_amdgcn_s_waitcnt(0);
        unsigned nloc = b.st[0], nx = b.st[1];
        if (nloc == 0u) { xcd_barrier_complete(bar, b.x, nloc, nx); b.st[0] = nloc; b.st[1] = nx; }
        const unsigned old = xb_add(&bar[XB_XSUB(b.x)], 1u);
        const unsigned gen = old / nloc;
        if (old + 1u == (gen + 1u) * nloc) {
            __builtin_amdgcn_fence(__ATOMIC_RELEASE, "agent");
            asm volatile("s_waitcnt vmcnt(0)" ::: "memory");
            const unsigned og = xb_add(&bar[XB_TOP], 1u);
            const unsigned tg = og / nx;
            if (og + 1u == (tg + 1u) * nx) xb_add(&bar[XB_TOPGEN], 1u);
            else XB_SPIN(xb_ld(&bar[XB_TOPGEN]) == tg, bar);
            __builtin_amdgcn_fence(__ATOMIC_ACQUIRE, "agent");
            xb_add(&bar[XB_XGEN(b.x)], 1u);
            asm volatile("s_waitcnt vmcnt(0)" ::: "memory");
        } else {
            XB_SPIN(xb_ld(&bar[XB_XGEN(b.x)]) == gen, bar);
            __builtin_amdgcn_fence(__ATOMIC_ACQUIRE, "agent");
            asm volatile("s_waitcnt vmcnt(0)" ::: "memory");
        }
    }
    __syncthreads();
}


struct Args { const float* in[16]; float* out; unsigned char* ws; int ph_lo, ph_hi; };
constexpr int N_PHASES = 11;

__global__ void __launch_bounds__(NTHREADS, 2) mk_fwd(Args a) {
    extern __shared__ __attribute__((aligned(16))) unsigned char lds[];
    LAS unsigned char* L = (LAS unsigned char*)lds;
    volatile LAS unsigned* MISC = (volatile LAS unsigned*)(L + MISC_OFF);
    unsigned char* ws = a.ws;
    Ctx C;
    C.tid = threadIdx.x; C.lane = C.tid & 63; C.wave = __builtin_amdgcn_readfirstlane(C.tid >> 6);
    C.G = gridDim.x; C.gw = blockIdx.x * NWAVES + C.wave; C.ngw = C.G * NWAVES; C.gt = blockIdx.x * NTHREADS + C.tid; C.ngt = C.G * NTHREADS;
    for (int u = C.tid; u < (LDS_BYTES - LDSCTL_OFF) / 4; u += NTHREADS) ((LAS unsigned*)(L + LDSCTL_OFF))[u] = 0u;
    __syncthreads();
    const int lo = a.ph_lo, hi = a.ph_hi, G = C.G;
    const bool multi = (hi - lo) > 1;
    XcdBarrier bar; bar.bar = (unsigned*)(ws + WS_CTL) + CW_BAR; bar.x = 0; bar.st = nullptr;
    if (multi) bar = xcd_barrier_post((unsigned*)(ws + WS_CTL) + CW_BAR, MISC + 8);
#define IN(k) (lo <= (k) && (k) < hi)
#define SEAM(k) do { if (IN(k) && IN((k) + 1)) xcd_barrier(bar); } while (0)

#define REPS(k) for (int rep_ = 0; rep_ < ((PROBE_DUP == (k)) ? 2 : 1); ++rep_)
#define REPBAR(k) do { if (PROBE_DUP == (k) && rep_ == 0) xcd_barrier(bar); } while (0)
    if (IN(0)) REPS(0) { ph_prep(C, L, a.in, ws); REPBAR(0); }
    SEAM(0);
    if (IN(1)) {
        quant_wrows(C, (const f16*)(ws + WS_WCAT), NCAT, (unsigned*)(ws + WS_WCATQ), (float*)(ws + WS_WCS));
        quant_wrows(C, (const f16*)(ws + WS_WQ), 2048, (unsigned*)(ws + WS_WQQ), (float*)(ws + WS_WQS));
        xcd_barrier(bar);
        pg8::Gemm g{(const f16*)(ws + WS_XH), (const f16*)(ws + WS_WCATQ), T, NCAT, DM / 2}; pg8::StaticOrder S; S.init(T, NCAT, G, (int)blockIdx.x);
        pg8::EpiP1 E{(const float*)(ws + WS_RS1), (const float*)(ws + WS_RSX), (const float*)(ws + WS_WCS), a.in[8], (f16*)(ws + WS_QKVU), (f16*)(ws + WS_GATES), (f16*)(ws + WS_VT)};
        pg8::gemm_phase<pg8::EpiP1, pg8::StaticOrder, true, true>(L, g, S, E);
    }
    SEAM(1);
    if (IN(2)) REPS(2) {
        ph_attn_pool(C, L, (const f16*)(ws + WS_QKVU), (const f16*)(ws + WS_VT), a.in[3], (const f16*)(ws + WS_POOLW), a.in[5], (f16*)(ws + WS_OCAT));
        REPBAR(2);
    }
    if (IN(2) && IN(4)) xcd_barrier(bar);
    if (IN(4)) REPS(4) {
        pg8::Gemm g{(const f16*)(ws + WS_OCAT), (const f16*)(ws + WS_WB), T, DM, DM}; pg8::StaticOrder S; S.init(T, DM, G, (int)blockIdx.x);
        pg8::EpiMerged E{(const f16*)(ws + WS_GATES), (f16*)(ws + WS_MERGED)};
        pg8::gemm_phase<pg8::EpiMerged, pg8::StaticOrder, true, true>(L, g, S, E);
        REPBAR(4);
    }
    SEAM(4);
    if (IN(5)) REPS(5) {
        pg8::Gemm g{(const f16*)(ws + WS_MERGED), (const f16*)(ws + WS_WOUT), T, DM, DM}; pg8::StaticOrder S; S.init(T, DM, G, (int)blockIdx.x);
        pg8::EpiOut E{a.in[0], a.in[10], a.out, (f16*)(ws + WS_X1H), (float*)(ws + WS_SS2)};
        pg8::gemm_phase<pg8::EpiOut, pg8::StaticOrder, true, true>(L, g, S, E);
        REPBAR(5);
    }
    SEAM(5);
    if (IN(6)) {
        ph_h2quant(C, (const f16*)(ws + WS_X1H), (const float*)(ws + WS_SS2), (unsigned*)(ws + WS_H2Q), (float*)(ws + WS_HSC));
        xcd_barrier(bar);
        pg8::Gemm g{(const f16*)(ws + WS_H2Q), (const f16*)(ws + WS_WQQ), T, 2048, DM / 2}; pg8::StaticOrder S; S.init(T, 2048, G, (int)blockIdx.x);
        pg8::EpiQ E{(const float*)(ws + WS_HSC), (const float*)(ws + WS_WQS), (f16*)(ws + WS_QP)};
        pg8::gemm_phase<pg8::EpiQ, pg8::StaticOrder, true, true>(L, g, S, E);
    }
    SEAM(6);
    if (IN(7)) REPS(7) {
        auto side = [&]() {
            quant_rows<false>(C, a.in[13], (unsigned*)(ws + WS_UQ), (float*)(ws + WS_US));
            quant_rows<false>(C, a.in[14], (unsigned*)(ws + WS_VQ), (float*)(ws + WS_VS));
        };
        ph_route(C, L, (const f16*)(ws + WS_QP), (const float*)(ws + WS_SS2), (const f16*)(ws + WS_SUBK), (int*)(ws + WS_EIDX), (float*)(ws + WS_EGATE), side);
        if (!(C.wave & 4)) side();
        REPBAR(7); }
    SEAM(7);
    if (IN(8)) REPS(8) {
        const Slicing SL = get_slicing((const unsigned*)(ws + WS_CTL) + CW_BAR, MISC);
        if (PROBE_DUP == 8 && rep_ == 0) ph_upeer<255>(C, L, SL, (const unsigned*)(ws + WS_H2Q), (const int*)(ws + WS_EIDX), (const unsigned char*)(ws + WS_UQ), (short*)(ws + WS_PDOT));
        else ph_upeer<16383>(C, L, SL, (const unsigned*)(ws + WS_H2Q), (const int*)(ws + WS_EIDX), (const unsigned char*)(ws + WS_UQ), (short*)(ws + WS_PDOT));
        REPBAR(8);
    }
    SEAM(8);
    if (IN(9)) {
        ph_ureduce(C, L, (const short*)(ws + WS_PDOT), (const float*)(ws + WS_HSC), (const int*)(ws + WS_EIDX), (const float*)(ws + WS_US), (const float*)(ws + WS_VS), (const float*)(ws + WS_EGATE),
                   (unsigned*)(ws + WS_WQP), (float*)(ws + WS_WSC));
        xcd_barrier(bar);
        const Slicing SL = get_slicing((const unsigned*)(ws + WS_CTL) + CW_BAR, MISC);
        if (PROBE_DUP == 9) {
            ph_vpeer<255>(C, SL, (const int*)(ws + WS_EIDX), (const unsigned*)(ws + WS_WQP), (const float*)(ws + WS_WSC), (const unsigned char*)(ws + WS_VQ), a.out, (float*)(ws + WS_QP), (float*)(ws + WS_MERGED));
            xcd_barrier(bar);
        }
        if (PROBE_DUP == 19) {
            ph_vpeer<16383>(C, SL, (const int*)(ws + WS_EIDX), (const unsigned*)(ws + WS_WQP), (const float*)(ws + WS_WSC), (const unsigned char*)(ws + WS_VQ), a.out, (float*)(ws + WS_QP), (float*)(ws + WS_MERGED));
            xcd_barrier(bar);
        }
        ph_vpeer<16383>(C, SL, (const int*)(ws + WS_EIDX), (const unsigned*)(ws + WS_WQP), (const float*)(ws + WS_WSC), (const unsigned char*)(ws + WS_VQ), a.out, a.out, (float*)(ws + WS_SSF));
    }
    SEAM(9);
    if (IN(10)) { ph_final(C, (const float*)(ws + WS_SSF), a.out, a.in[15]); }
#undef IN
#undef SEAM
}

#ifndef MK_N_LAUNCHES
#define MK_N_LAUNCHES 1
#endif
extern "C" void kernel_launch(void* const* d_in, const int* in_sizes, int n_in, void* d_out, int out_size, void* d_ws, size_t ws_size, hipStream_t stream) {
    static int grid = 0;
    if (grid == 0) {
        if (n_in != 16 || in_sizes[0] != T * DM || out_size != T * DM || ws_size < WS_END) {
            fprintf(stderr, "kernel_launch: unexpected shapes (n_in %d in0 %d out %d ws %zu)\n", n_in, n_in > 0 ? in_sizes[0] : -1, out_size, ws_size);
            grid = -1; return;
        }
        int dev = 0, cus = 0;
        if (hipGetDevice(&dev) != hipSuccess || hipDeviceGetAttribute(&cus, hipDeviceAttributeMultiprocessorCount, dev) != hipSuccess) { grid = -1; return; }
        if (hipFuncSetAttribute((const void*)mk_fwd, hipFuncAttributeMaxDynamicSharedMemorySize, LDS_BYTES) != hipSuccess) { fprintf(stderr, "kernel_launch: hipFuncSetAttribute failed\n"); grid = -1; return; }
        int per_cu = 0;
        if (hipOccupancyMaxActiveBlocksPerMultiprocessor(&per_cu, (const void*)mk_fwd, NTHREADS, LDS_BYTES) != hipSuccess || per_cu < 1)
            fprintf(stderr, "kernel_launch: occupancy query reports %d workgroups per CU\n", per_cu);
        (void)hipGetLastError();
        grid = cus;
    }
    if (grid < 0) return;
    (void)hipMemsetAsync((char*)d_ws + WS_CTL, 0, CTL_ZERO_BYTES, stream);
    Args a{};
    for (int i = 0; i < 16; ++i) a.in[i] = (const float*)d_in[i];
    a.out = (float*)d_out; a.ws = (unsigned char*)d_ws;
    if (MK_N_LAUNCHES == 1) {
        a.ph_lo = 0; a.ph_hi = N_PHASES;
        hipLaunchKernelGGL(mk_fwd, dim3(grid), dim3(NTHREADS), LDS_BYTES, stream, a);
    } else {
        for (int p = 0; p < N_PHASES; ++p) { a.ph_lo = p; a.ph_hi = p + 1; hipLaunchKernelGGL(mk_fwd, dim3(grid), dim3(NTHREADS), LDS_BYTES, stream, a); }
    }
}
```

```cpp
#include <hip/hip_runtime.h>
#include <cstdint>
#include <cstdio>

typedef _Float16 f16;
typedef _Float16 half8 __attribute__((ext_vector_type(8)));
typedef _Float16 half4 __attribute__((ext_vector_type(4)));
typedef _Float16 half2 __attribute__((ext_vector_type(2)));
typedef float f32x4 __attribute__((ext_vector_type(4)));
typedef float f32x16 __attribute__((ext_vector_type(16)));
typedef unsigned u32x4 __attribute__((ext_vector_type(4)));
typedef int i32x4 __attribute__((ext_vector_type(4)));
#define LAS __attribute__((address_space(3)))
#ifndef PROBE_DIAG
#define PROBE_DIAG (0)
#endif
#ifndef PROBE_DUP
#define PROBE_DUP (-1)
#endif
#define GAS __attribute__((address_space(1)))

constexpr int DM = 1024, BATCH = 16, SEQ = 2048, T = BATCH * SEQ;
constexpr int NQKVU = 1280, NGATE = 2048, NCAT = NQKVU + NGATE;
constexpr int COL_K = 512, COL_V = 640, COL_U = 768;
constexpr int NEXP = 16384, PEER_H = 8, TOPK = 16;
constexpr float EPS = 1e-6f;
constexpr int NWAVES = 8, NTHREADS = NWAVES * 64;

constexpr size_t MiB = 1u << 20;
constexpr size_t WS_CTL = 0, CTL_ZERO_BYTES = 64 * 1024;
constexpr size_t WS_WCAT = 1 * MiB;
constexpr size_t WS_WB = 8 * MiB;
constexpr size_t WS_WOUT = 10 * MiB;
constexpr size_t WS_WQ = 12 * MiB;
constexpr size_t WS_POOLW = 16 * MiB;
constexpr size_t WS_SUBK = 16 * MiB + 512 * 1024;
constexpr size_t WS_RS1 = 17 * MiB;
constexpr size_t WS_EIDX = 18 * MiB;
constexpr size_t WS_EGATE = 34 * MiB;
constexpr size_t WS_WCATQ = 50 * MiB;
constexpr size_t WS_WCS = 54 * MiB;
constexpr size_t WS_WQQ = 56 * MiB;
constexpr size_t WS_WQS = 59 * MiB;
constexpr size_t WS_RSX = 55 * MiB;
constexpr size_t WS_UTAB = 50 * MiB;
constexpr size_t WS_VTAB = 82 * MiB;
constexpr size_t WS_XH = 114 * MiB;
constexpr size_t WS_MERGED = WS_XH;
constexpr size_t WS_QKVU = 178 * MiB;
constexpr size_t WS_X1H = WS_QKVU;
constexpr size_t WS_PEER = WS_QKVU;
constexpr size_t WS_GATES = 258 * MiB;
constexpr size_t WS_QP = WS_GATES;
constexpr size_t WS_OCAT = 386 * MiB;
constexpr size_t WS_UQ = 450 * MiB;
constexpr size_t WS_VQ = 466 * MiB;
constexpr size_t WS_US = 17 * MiB + 256 * 1024, WS_VS = 17 * MiB + 512 * 1024;
constexpr size_t WS_PDOT = WS_GATES;
constexpr size_t WS_H2Q = 404 * MiB;
constexpr size_t WS_HSC = 403 * MiB;
constexpr size_t WS_SSF = 402 * MiB;
constexpr size_t WS_WQP = 386 * MiB;
constexpr size_t WS_WSC = 390 * MiB;
constexpr size_t WS_ACT = 386 * MiB;
constexpr size_t WS_SS2 = 482 * MiB;
constexpr size_t WS_VT = 484 * MiB;
constexpr size_t WS_END = 492 * MiB;
constexpr int CW_BAR = 4096;

constexpr int RING_OFF = 0, RING_BYTES = 131072;
constexpr int LDSCTL_OFF = RING_BYTES, MISC_OFF = LDSCTL_OFF + 320;
constexpr int LDS_BYTES = 147456;

#define LDS_WAIT() asm volatile("s_waitcnt lgkmcnt(0)" ::: "memory")
template <int CTRL> __device__ __forceinline__ float dppf(float x) { return __uint_as_float(__builtin_amdgcn_update_dpp(0u, __float_as_uint(x), CTRL, 0xf, 0xf, false)); }
template <int CTRL> __device__ __forceinline__ int dppi(int x) { return (int)__builtin_amdgcn_update_dpp(0u, (unsigned)x, CTRL, 0xf, 0xf, false); }
__device__ __forceinline__ float bfly32(float a, float b) { auto r = __builtin_amdgcn_permlane32_swap(__float_as_uint(a), __float_as_uint(b), false, false); return __uint_as_float(r[0]) + __uint_as_float(r[1]); }
__device__ __forceinline__ float bfly16(float a, float b) { auto r = __builtin_amdgcn_permlane16_swap(__float_as_uint(a), __float_as_uint(b), false, false); return __uint_as_float(r[0]) + __uint_as_float(r[1]); }
__device__ __forceinline__ int bfly32i(int a, int b) { auto r = __builtin_amdgcn_permlane32_swap((unsigned)a, (unsigned)b, false, false); return (int)(r[0] + r[1]); }
__device__ __forceinline__ int bfly16i(int a, int b) { auto r = __builtin_amdgcn_permlane16_swap((unsigned)a, (unsigned)b, false, false); return (int)(r[0] + r[1]); }
__device__ __forceinline__ float wave_sum(float x) {
    x += dppf<0x121>(x); x += dppf<0x122>(x); x += dppf<0x124>(x); x += dppf<0x128>(x);
    x = bfly16(x, x); return bfly32(x, x);
}
__device__ __forceinline__ int wave_sum_i(int x) {
    x += dppi<0x121>(x); x += dppi<0x122>(x); x += dppi<0x124>(x); x += dppi<0x128>(x);
    x = bfly16i(x, x); return bfly32i(x, x);
}
__device__ __forceinline__ float wave_max(float x) {
    x = fmaxf(x, dppf<0x121>(x)); x = fmaxf(x, dppf<0x122>(x)); x = fmaxf(x, dppf<0x124>(x)); x = fmaxf(x, dppf<0x128>(x));
    { auto r = __builtin_amdgcn_permlane16_swap(__float_as_uint(x), __float_as_uint(x), false, false); x = fmaxf(__uint_as_float(r[0]), __uint_as_float(r[1])); }
    { auto r = __builtin_amdgcn_permlane32_swap(__float_as_uint(x), __float_as_uint(x), false, false); x = fmaxf(__uint_as_float(r[0]), __uint_as_float(r[1])); }
    return x;
}
__device__ __forceinline__ float gelu_exact(float x) { return 0.5f * x * (1.0f + erff(x * 0.70710678118654752f)); }
__device__ __forceinline__ float rs_from_ss(const float* ss, int t) {
    float s = 0.f;
#pragma unroll
    for (int i = 0; i < 16; ++i) s += ss[(size_t)i * T + t];
    return rsqrtf(s * (1.0f / DM) + EPS);
}

struct Ctx {
    int tid, lane, wave;
    int G;
    int gw, ngw;
    int gt, ngt;
};

__device__ __forceinline__ int pack4_i8(float a, float b, float c, float d) {
    const int ia = (int)rintf(a), ib = (int)rintf(b), ic = (int)rintf(c), id = (int)rintf(d);
    return (ia & 0xff) | ((ib & 0xff) << 8) | ((ic & 0xff) << 16) | (id << 24);
}
template <bool OFFS>
__device__ __forceinline__ void quant_rows(const Ctx& C, const float* __restrict__ tab, unsigned* __restrict__ q, float* __restrict__ scale) {
    const int lane = C.lane;
    for (int r = C.gw; r < NEXP; r += C.ngw) {
        const float* row = tab + (size_t)r * DM;
        f32x4 v[4]; float m = 0.f;
#pragma unroll
        for (int j = 0; j < 4; ++j) { v[j] = *(const f32x4*)(row + j * 256 + lane * 4); m = fmaxf(m, fmaxf(fmaxf(fabsf(v[j][0]), fabsf(v[j][1])), fmaxf(fabsf(v[j][2]), fabsf(v[j][3])))); }
        m = wave_max(m);
        const float inv = m > 0.f ? 127.0f / m : 0.f;
#pragma unroll
        for (int j = 0; j < 4; ++j) {
            unsigned w = (unsigned)pack4_i8(v[j][0] * inv, v[j][1] * inv, v[j][2] * inv, v[j][3] * inv);
            if (OFFS) w ^= 0x80808080u;
            { const int dw = j * 64 + lane; q[(size_t)(dw >> 5) * (NEXP * 32) + (size_t)r * 32 + (dw & 31)] = w; }
        }
        if (lane == 0) scale[r] = m * (1.0f / 127.0f);
    }
}

__device__ __forceinline__ void p0_transpose_item(const float* W, int K, int N, f16* WT, int ldo, int koff, LAS float* scr, int item, int lane) {
    const int nblk = N / 32, kb = item / nblk, nb = item % nblk, k0 = 64 * kb, n0 = 32 * nb;
#pragma unroll 8
    for (int i = 0; i < 32; ++i) { const int kk = 2 * i + (lane >> 5); scr[kk * 33 + (lane & 31)] = W[(size_t)(k0 + kk) * N + n0 + (lane & 31)]; }
    LDS_WAIT(); asm volatile("" ::: "memory");
    const int c = lane & 7;
#pragma unroll
    for (int j = 0; j < 4; ++j) { const int n = (lane >> 3) + 8 * j; const LAS float* s = scr + (8 * c) * 33 + n;
        half8 o;
#pragma unroll
        for (int i = 0; i < 8; ++i) o[i] = (f16)s[i * 33];
        *(half8*)(WT + (size_t)(n0 + n) * ldo + koff + k0 + 8 * c) = o; }
    LDS_WAIT(); asm volatile("" ::: "memory");
}
__device__ __forceinline__ void cvt_stream(const Ctx& C, const float* in, f16* out, size_t n4) {
    for (size_t i = (size_t)C.gt; i < n4; i += (size_t)C.ngt) {
        const f32x4 v = ((const f32x4*)in)[i];
        half4 h; h[0] = (f16)v[0]; h[1] = (f16)v[1]; h[2] = (f16)v[2]; h[3] = (f16)v[3];
        ((half4*)out)[i] = h;
    }
}
__device__ __forceinline__ void rowprep(const Ctx& C, const float* x, const float* g, unsigned* xq, float* rsx, float* ss) {
    const int lane = C.lane;
    f32x4 gg[4];
#pragma unroll
    for (int j = 0; j < 4; ++j) gg[j] = *(const f32x4*)(g + j * 256 + lane * 4);
    for (int tb = C.gw * 4; tb < T; tb += C.ngw * 4) {
        f32x4 v[4][4];
#pragma unroll
        for (int u = 0; u < 4; ++u)
#pragma unroll
            for (int j = 0; j < 4; ++j) v[u][j] = *(const f32x4*)(x + (size_t)(tb + u) * DM + j * 256 + lane * 4);
#pragma unroll
        for (int u = 0; u < 4; ++u) {
            float s = 0.f, am = 0.f;
#pragma unroll
            for (int j = 0; j < 4; ++j) {
                const f32x4 w = v[u][j];
                s += w[0] * w[0] + w[1] * w[1] + w[2] * w[2] + w[3] * w[3];
                v[u][j] = w * gg[j];
                am = fmaxf(am, fmaxf(fmaxf(fabsf(v[u][j][0]), fabsf(v[u][j][1])), fmaxf(fabsf(v[u][j][2]), fabsf(v[u][j][3]))));
            }
            s = wave_sum(s); am = wave_max(am);
            const float inv = am > 0.f ? 127.0f / am : 0.f;
#pragma unroll
            for (int j = 0; j < 4; ++j) xq[(size_t)(tb + u) * 256 + j * 64 + lane] = (unsigned)pack4_i8(v[u][j][0] * inv, v[u][j][1] * inv, v[u][j][2] * inv, v[u][j][3] * inv);
            if (lane == 0) { ss[tb + u] = s; rsx[tb + u] = am * (1.0f / 127.0f); }
        }
    }
}
__device__ __forceinline__ void quant_wrows(const Ctx& C, const f16* __restrict__ w, int rows, unsigned* __restrict__ q, float* __restrict__ scale) {
    const int lane = C.lane;
    for (int r = C.gw; r < rows; r += C.ngw) {
        const half8 a = *(const half8*)(w + (size_t)r * DM + 16 * lane), b = *(const half8*)(w + (size_t)r * DM + 16 * lane + 8);
        float m = 0.f;
#pragma unroll
        for (int i = 0; i < 8; ++i) m = fmaxf(m, fmaxf(fabsf((float)a[i]), fabsf((float)b[i])));
        m = wave_max(m);
        const float inv = m > 0.f ? 127.0f / m : 0.f;
        u32x4 o;
        o[0] = (unsigned)pack4_i8((float)a[0] * inv, (float)a[1] * inv, (float)a[2] * inv, (float)a[3] * inv);
        o[1] = (unsigned)pack4_i8((float)a[4] * inv, (float)a[5] * inv, (float)a[6] * inv, (float)a[7] * inv);
        o[2] = (unsigned)pack4_i8((float)b[0] * inv, (float)b[1] * inv, (float)b[2] * inv, (float)b[3] * inv);
        o[3] = (unsigned)pack4_i8((float)b[4] * inv, (float)b[5] * inv, (float)b[6] * inv, (float)b[7] * inv);
        *(u32x4*)(q + (size_t)r * 256 + 4 * lane) = o;
        if (lane == 0) scale[r] = m * (1.0f / 127.0f);
    }
}
__device__ __forceinline__ void ph_prep(const Ctx& C, LAS unsigned char* lds, const float* const* in, unsigned char* ws) {
    LAS float* scr = (LAS float*)(lds + RING_OFF + C.wave * 16384);
    f16* wcat = (f16*)(ws + WS_WCAT); f16* wb = (f16*)(ws + WS_WB); f16* wout = (f16*)(ws + WS_WOUT); f16* wq = (f16*)(ws + WS_WQ); f16* poolw = (f16*)(ws + WS_POOLW);
    constexpr int I_IN = 16 * 40, I_G = 16 * 64, I_B = 8 * 32, I_O = 16 * 32, I_Q = 16 * 64, I_P = 2 * 4;
    constexpr int NITEMS = I_IN + I_G + 2 * I_B + I_O + I_Q + 4 * I_P;
    for (int it = C.gw; it < NITEMS; it += C.ngw) {
        int r = it;
        if (r < I_IN) { p0_transpose_item(in[2], 1024, 1280, wcat, 1024, 0, scr, r, C.lane); continue; } r -= I_IN;
        if (r < I_G) { p0_transpose_item(in[7], 1024, 2048, wcat + (size_t)NQKVU * 1024, 1024, 0, scr, r, C.lane); continue; } r -= I_G;
        if (r < I_B) { p0_transpose_item(in[6], 512, 1024, wb, 1024, 0, scr, r, C.lane); continue; } r -= I_B;
        if (r < I_B) { p0_transpose_item(in[6] + 512 * 1024, 512, 1024, wb, 1024, 512, scr, r, C.lane); continue; } r -= I_B;
        if (r < I_O) { p0_transpose_item(in[9], 1024, 1024, wout, 1024, 0, scr, r, C.lane); continue; } r -= I_O;
        if (r < I_Q) { p0_transpose_item(in[11], 1024, 2048, wq, 1024, 0, scr, r, C.lane); continue; } r -= I_Q;
        { const int g = r / I_P; p0_transpose_item(in[4] + g * 128 * 128, 128, 128, poolw + g * 128 * 128, 128, 0, scr, r % I_P, C.lane); }
    }
    cvt_stream(C, in[12], (f16*)(ws + WS_SUBK), (size_t)8 * 2 * 128 * 128 / 4);
    rowprep(C, in[0], in[1], (unsigned*)(ws + WS_XH), (float*)(ws + WS_RSX), (float*)(ws + WS_RS1));
}

__device__ __forceinline__ void ph_attn_naive(const Ctx& C, const f16* __restrict__ qkvu, const float* __restrict__ sink, f16* __restrict__ ocat) {
    for (int gid = C.gt; gid < T * 8; gid += C.ngt) {
        const int t = gid % T, h = gid / T;
        const int b = t / SEQ, ts = t % SEQ, kh = h >> 2;
        float q[64], o[64];
        const f16* qr = qkvu + (size_t)t * NQKVU + h * 64;
#pragma unroll
        for (int d = 0; d < 64; ++d) { q[d] = (float)qr[d]; o[d] = 0.f; }
        const float slope = exp2f(-(float)(h + 1));
        float m = -1e30f, l = 0.f;
        const int s0 = max(ts - 128, 0), s1 = min(ts + 128, SEQ - 1);
        for (int s = s0; s <= s1; ++s) {
            const f16* kr = qkvu + (size_t)(b * SEQ + s) * NQKVU + COL_K + kh * 64;
            const f16* vr = qkvu + (size_t)(b * SEQ + s) * NQKVU + COL_V + kh * 64;
            float dot = 0.f;
#pragma unroll
            for (int d = 0; d < 64; ++d) dot += q[d] * (float)kr[d];
            const float lg = dot * 0.125f - slope * fabsf((float)(ts - s));
            const float mn = fmaxf(m, lg), al = __expf(m - mn), p = __expf(lg - mn);
            l = l * al + p;
#pragma unroll
            for (int d = 0; d < 64; ++d) o[d] = o[d] * al + p * (float)vr[d];
            m = mn;
        }
        const float sk = sink[h];
        const float mn = fmaxf(m, sk), al = __expf(m - mn);
        l = l * al + __expf(sk - mn);
        const float inv = al / l;
        f16* orow = ocat + (size_t)t * DM + h * 64;
#pragma unroll
        for (int d = 0; d < 64; ++d) orow[d] = (f16)(o[d] * inv);
    }
}

template <int DIAG = 0>
__device__ __forceinline__ void attn_unit(const Ctx& C, int u, LAS unsigned char* lds, const f16* __restrict__ qkvu, const f16* __restrict__ vT, const float* __restrict__ sink, f16* __restrict__ ocat) {
    const int lane = C.lane, r32 = lane & 31, hh = lane >> 5;
    const int krow = (r32 & 19) | ((r32 & 4) << 1) | ((r32 & 8) >> 1);
    constexpr float L2E = 1.4426950408889634f;
    {
        const int qs = u & 63, h = (u >> 6) & 7, b = u >> 9, kh = h >> 2;
        const int tq = qs * 32 + r32;
        const float slope2 = exp2f(-(float)(h + 1)) * L2E, sink2 = sink[h] * L2E;
        const f16* qrow = qkvu + (size_t)(b * SEQ + tq) * NQKVU + h * 64 + 8 * hh;
        half8 bq[4];
#pragma unroll
        for (int ks = 0; ks < 4; ++ks) bq[ks] = *(const half8*)(qrow + 16 * ks);
        f32x16 o0, o1;
#pragma unroll
        for (int r = 0; r < 16; ++r) { o0[r] = 0.f; o1[r] = 0.f; }
        float m = -1e30f, l = 0.f;
        const int kb_lo = max(qs - 4, 0), kb_hi = min(qs + 4, 63);
        LAS unsigned char* kst = lds + 65536 + C.wave * 8192; LAS unsigned char* vst = kst + 4096;
        const int krw = lane >> 3, kch = lane & 7, vrw = lane >> 2, vch = lane & 3;
        const f16* kg = qkvu + (size_t)(b * SEQ + krw) * NQKVU + COL_K + kh * 64 + kch * 8;
        const f16* vg = vT + (size_t)((b * 2 + kh) * 64 + vrw) * SEQ + vch * 8;
        half8 gk[4], gv[4];
#pragma unroll
        for (int i = 0; i < 4; ++i) { gk[i] = *(const half8*)(kg + (size_t)(kb_lo * 32 + 8 * i) * NQKVU); gv[i] = *(const half8*)(vg + (size_t)(16 * i) * SEQ + kb_lo * 32); }
#pragma unroll 1
        for (int kb = kb_lo; kb <= kb_hi; ++kb) {
#pragma unroll
            for (int i = 0; i < 4; ++i) {
                const int kr = krw + 8 * i; *(LAS half8*)(kst + kr * 128 + ((kch ^ (kr & 7)) << 4)) = gk[i];
                const int vr = vrw + 16 * i; *(LAS half8*)(vst + vr * 64 + ((vch ^ ((vr >> 2) & 3)) << 4)) = gv[i];
            }
            LDS_WAIT();
            half8 kf[4], va[2][2];
#pragma unroll
            for (int ks = 0; ks < 4; ++ks) kf[ks] = *(const LAS half8*)(kst + krow * 128 + (((2 * ks + hh) ^ (krow & 7)) << 4));
#pragma unroll
            for (int db = 0; db < 2; ++db)
#pragma unroll
                for (int st = 0; st < 2; ++st) { const int d = db * 32 + r32; va[db][st] = *(const LAS half8*)(vst + d * 64 + (((2 * st + hh) ^ ((d >> 2) & 3)) << 4)); }
            LDS_WAIT();
            const int kn = (DIAG == 2) ? kb_lo : (kb < kb_hi ? kb + 1 : kb);
#pragma unroll
            for (int i = 0; i < 4; ++i) { gk[i] = *(const half8*)(kg + (size_t)(kn * 32 + 8 * i) * NQKVU); gv[i] = *(const half8*)(vg + (size_t)(16 * i) * SEQ + kn * 32); }
            f32x16 s;
#pragma unroll
            for (int r = 0; r < 16; ++r) s[r] = 0.f;
#pragma unroll
            for (int ks = 0; ks < 4; ++ks) s = __builtin_amdgcn_mfma_f32_32x32x16_f16(kf[ks], bq[ks], s, 0, 0, 0);
            float bmax = -1e30f; bool ok[16];
#pragma unroll
            for (int r = 0; r < 16; ++r) {
                const int tk = kb * 32 + 16 * (r >> 3) + 8 * hh + (r & 7);
                const int dist = abs(tq - tk);
                ok[r] = dist <= 128;
                s[r] = ok[r] ? s[r] * (0.125f * L2E) - slope2 * (float)dist : -1e30f;
                bmax = fmaxf(bmax, s[r]);
            }
            bmax = fmaxf(bmax, __shfl_xor(bmax, 32));
            const float mn = fmaxf(m, bmax), al = exp2f(m - mn);
            m = mn;
            float ps = 0.f; half8 pb[2];
#pragma unroll
            for (int r = 0; r < 16; ++r) { const float p = ok[r] ? (DIAG == 1 ? (s[r] - mn) : exp2f(s[r] - mn)) : 0.f; ps += p; pb[r >> 3][r & 7] = (f16)p; }
            l = l * al + ps;
#pragma unroll
            for (int r = 0; r < 16; ++r) { o0[r] *= al; o1[r] *= al; }
#pragma unroll
            for (int st = 0; st < 2; ++st) { o0 = __builtin_amdgcn_mfma_f32_32x32x16_f16(va[0][st], pb[st], o0, 0, 0, 0); o1 = __builtin_amdgcn_mfma_f32_32x32x16_f16(va[1][st], pb[st], o1, 0, 0, 0); }
        }
        l += __shfl_xor(l, 32);
        const float mf = fmaxf(m, sink2), al = exp2f(m - mf);
        const float sc = al / (l * al + exp2f(sink2 - mf));
        f16* orow = ocat + (size_t)(b * SEQ + tq) * DM + h * 64 + 4 * hh;
#pragma unroll
        for (int g = 0; g < 4; ++g) {
            half4 a, c;
#pragma unroll
            for (int i = 0; i < 4; ++i) { a[i] = (f16)(o0[4 * g + i] * sc); c[i] = (f16)(o1[4 * g + i] * sc); }
            *(half4*)(orow + 8 * g) = a; *(half4*)(orow + 32 + 8 * g) = c;
        }
    }
}

__device__ __forceinline__ void ph_pool_naive(const Ctx& C, const f16* __restrict__ qkvu, f16* __restrict__ mixed) {
    for (size_t gid = (size_t)C.gt; gid < (size_t)T * 512; gid += (size_t)C.ngt) {
        const int c = (int)(gid & 511), t = (int)(gid >> 9);
        const int b = t / SEQ, ts = t % SEQ, g = c >> 7, w = 2 << g;
        const int lo = max(ts - w / 2, 0), hi = min(ts + w / 2, SEQ);
        float s = 0.f;
        for (int i = lo; i < hi; ++i) s += (float)qkvu[(size_t)(b * SEQ + i) * NQKVU + COL_U + c];
        const float mean = s / (float)(hi - lo);
        mixed[(size_t)t * 512 + c] = (f16)(mean - (float)qkvu[(size_t)t * NQKVU + COL_U + c]);
    }
}
__device__ __forceinline__ void ph_poolmm_naive(const Ctx& C, const f16* __restrict__ mixed, const f16* __restrict__ poolw_t, const float* __restrict__ pscale, f16* __restrict__ ocat) {
    for (size_t gid = (size_t)C.gt; gid < (size_t)T * 512; gid += (size_t)C.ngt) {
        const int n = (int)(gid & 511), t = (int)(gid >> 9), g = n >> 7, d = n & 127;
        const f16* mr = mixed + (size_t)t * 512 + g * 128;
        const f16* wr = poolw_t + (size_t)(g * 128 + d) * 128;
        float acc = 0.f;
        for (int c = 0; c < 128; ++c) acc += (float)mr[c] * (float)wr[c];
        ocat[(size_t)t * DM + 512 + n] = (f16)(acc * pscale[n]);
    }
}

template <int HW>
__device__ __forceinline__ void pool_step1(const f16* __restrict__ qkvu, LAS unsigned char* tile, int t0, int g, int lane) {
    const int c2 = lane, b = t0 >> 11, sf = t0 & (SEQ - 1);
    const f16* ub = qkvu + (size_t)(b * SEQ) * NQKVU + COL_U + g * 128 + 2 * c2;
    constexpr int NR = 32 + 2 * HW - 1;
    half2 v[NR];
#pragma unroll
    for (int i = 0; i < NR; ++i) { const int s = sf - HW + i; half2 z; z[0] = (f16)0.f; z[1] = (f16)0.f; v[i] = z; if (s >= 0 && s < SEQ) v[i] = *(const half2*)(ub + (size_t)s * NQKVU); }
    float s0 = 0.f, s1 = 0.f;
#pragma unroll
    for (int i = 0; i < 2 * HW - 1; ++i) { s0 += (float)v[i][0]; s1 += (float)v[i][1]; }
#pragma unroll
    for (int j = 0; j < 32; ++j) {
        s0 += (float)v[j + 2 * HW - 1][0]; s1 += (float)v[j + 2 * HW - 1][1];
        const int s = sf + j, lo = max(s - HW, 0), hi = min(s + HW, SEQ);
        const float inv = 1.0f / (float)(hi - lo);
        half2 mx; mx[0] = (f16)(s0 * inv - (float)v[j + HW][0]); mx[1] = (f16)(s1 * inv - (float)v[j + HW][1]);
        *(LAS half2*)(tile + j * 256 + (((c2 >> 2) ^ (j & 15)) << 4) + ((c2 & 3) << 2)) = mx;
        s0 -= (float)v[j][0]; s1 -= (float)v[j][1];
    }
}
__device__ __forceinline__ void pool_unit(const Ctx& C, int u, LAS unsigned char* lds, const f16* __restrict__ qkvu, const f16* __restrict__ poolw_t, const float* __restrict__ pscale, f16* __restrict__ ocat) {
    const int lane = C.lane, r32 = lane & 31, hh = lane >> 5;
    LAS unsigned char* tile = lds + C.wave * 8192;
    const int g = u & 3, t0 = (u >> 2) * 32;
    switch (g) { case 0: pool_step1<1>(qkvu, tile, t0, g, lane); break; case 1: pool_step1<2>(qkvu, tile, t0, g, lane); break;
                 case 2: pool_step1<4>(qkvu, tile, t0, g, lane); break; default: pool_step1<8>(qkvu, tile, t0, g, lane); break; }
    LDS_WAIT();
    f32x16 acc[4];
#pragma unroll
    for (int db = 0; db < 4; ++db)
#pragma unroll
        for (int r = 0; r < 16; ++r) acc[db][r] = 0.f;
    const f16* wr = poolw_t + (size_t)(g * 128 + r32) * 128 + 8 * hh;
#pragma unroll
    for (int ks = 0; ks < 8; ++ks) {
        const half8 bm = *(const LAS half8*)(tile + r32 * 256 + (((2 * ks + hh) ^ (r32 & 15)) << 4));
#pragma unroll
        for (int db = 0; db < 4; ++db) { const half8 a = *(const half8*)(wr + (size_t)(db * 32) * 128 + 16 * ks); acc[db] = __builtin_amdgcn_mfma_f32_32x32x16_f16(a, bm, acc[db], 0, 0, 0); }
    }
    LDS_WAIT();
    f16* orow = ocat + (size_t)(t0 + r32) * DM + 512 + g * 128 + 4 * hh;
    const float* ps = pscale + g * 128 + 4 * hh;
#pragma unroll
    for (int db = 0; db < 4; ++db)
#pragma unroll
        for (int q = 0; q < 4; ++q) {
            const f32x4 pv = *(const f32x4*)(ps + db * 32 + 8 * q);
            half4 x0;
#pragma unroll
            for (int i = 0; i < 4; ++i) x0[i] = (f16)(acc[db][4 * q + i] * pv[i]);
            *(half4*)(orow + db * 32 + 8 * q) = x0;
        }
}
__device__ __forceinline__ void ph_attn_pool(const Ctx& C, LAS unsigned char* lds, const f16* __restrict__ qkvu, const f16* __restrict__ vT, const float* __restrict__ sink,
                                             const f16* __restrict__ poolw_t, const float* __restrict__ pscale, f16* __restrict__ ocat) {
    for (int m = C.gw; m < (T / 32) * 4; m += C.ngw) {
        if (C.wave & 4) pool_unit(C, m, lds, qkvu, poolw_t, pscale, ocat);
        attn_unit<0>(C, 2 * m, lds, qkvu, vT, sink, ocat);
        attn_unit<0>(C, 2 * m + 1, lds, qkvu, vT, sink, ocat);
        if (!(C.wave & 4)) pool_unit(C, m, lds, qkvu, poolw_t, pscale, ocat);
    }
}

#define INS(LV, LI, v_, i_) do { float cv_ = (v_); int ci_ = (i_); \
    _Pragma("unroll") for (int z_ = 0; z_ < 16; ++z_) { const bool gt_ = cv_ > LV[z_]; const float tv_ = gt_ ? LV[z_] : cv_; const int ti_ = gt_ ? LI[z_] : ci_; \
        LV[z_] = gt_ ? cv_ : LV[z_]; LI[z_] = gt_ ? ci_ : LI[z_]; cv_ = tv_; ci_ = ti_; } } while (0)
__device__ __forceinline__ void ph_route_naive(const Ctx& C, const f16* __restrict__ qp, const float* __restrict__ ss2, const f16* __restrict__ subk, int* __restrict__ eidx, float* __restrict__ egate) {
    for (int gid = C.gt; gid < T * 8; gid += C.ngt) {
        const int t = gid % T, h = gid / T;
        const float rs2 = rs_from_ss(ss2, t);
        float av[16], bv[16]; int ai[16], bi[16];
#pragma unroll
        for (int z = 0; z < 16; ++z) { av[z] = -3e38f; bv[z] = -3e38f; ai[z] = 0; bi[z] = 0; }
        for (int p = 0; p < 2; ++p) {
            const f16* qr = qp + (size_t)t * 2048 + h * 256 + p * 128;
            for (int n = 0; n < 128; ++n) {
                const f16* kr = subk + ((size_t)((h * 2 + p) * 128 + n)) * 128;
                float dot = 0.f;
                for (int c = 0; c < 128; ++c) dot += (float)qr[c] * (float)kr[c];
                dot *= rs2;
                if (p == 0) INS(av, ai, dot, n); else INS(bv, bi, dot, n);
            }
        }
        float cv[16]; int ci[16];
#pragma unroll
        for (int z = 0; z < 16; ++z) { cv[z] = -3e38f; ci[z] = 0; }
#pragma unroll
        for (int i = 0; i < 16; ++i)
#pragma unroll
            for (int j = 0; j < 16; ++j)
                if ((i + 1) * (j + 1) <= 16) INS(cv, ci, av[i] + bv[j], ai[i] * 128 + bi[j]);
        float sum = 0.f, e[16];
#pragma unroll
        for (int z = 0; z < 16; ++z) { e[z] = __expf(cv[z] - cv[0]); sum += e[z]; }
        const float inv = 1.0f / sum;
#pragma unroll
        for (int z = 0; z < 16; ++z) { eidx[(size_t)t * 128 + h * 16 + z] = ci[z]; egate[(size_t)t * 128 + h * 16 + z] = e[z] * inv; }
    }
}

__device__ __forceinline__ int mono_i(float f) { const int b = __float_as_int(f); return b ^ ((b >> 31) & 0x7fffffff); }
__device__ __forceinline__ float unmono_f(int m) { return __int_as_float(m ^ ((m >> 31) & 0x7fffffff)); }
#define INS16(Lst, x_) do { int xv_ = (x_); _Pragma("unroll") for (int z_ = 0; z_ < 16; ++z_) { const int hi_ = max(Lst[z_], xv_); xv_ = min(Lst[z_], xv_); Lst[z_] = hi_; } } while (0)
__device__ __forceinline__ void merge_pair16(int (&Lst)[16]) {
    int P[16];
#pragma unroll
    for (int z = 0; z < 16; ++z) P[z] = __shfl_xor(Lst[z], 32);
#pragma unroll
    for (int z = 0; z < 16; ++z) Lst[z] = max(Lst[z], P[15 - z]);
#pragma unroll
    for (int s = 8; s >= 1; s >>= 1)
#pragma unroll
        for (int i = 0; i < 16; ++i) if ((i & s) == 0) { const int hi = max(Lst[i], Lst[i + s]), lo = min(Lst[i], Lst[i + s]); Lst[i] = hi; Lst[i + s] = lo; }
}
__device__ __forceinline__ void bitonic_sort16_desc(int (&K)[16]) {
#pragma unroll
    for (int k = 2; k <= 16; k <<= 1)
#pragma unroll
        for (int j = k >> 1; j > 0; j >>= 1)
#pragma unroll
            for (int i = 0; i < 16; ++i) { const int l = i ^ j; if (l > i) { const int a = K[i], b = K[l], hi = max(a, b), lo = min(a, b); const bool desc = (i & k) == 0; K[i] = desc ? hi : lo; K[l] = desc ? lo : hi; } }
}
__device__ __forceinline__ void bitonic_merge16_desc(int (&K)[16]) {
#pragma unroll
    for (int s = 8; s >= 1; s >>= 1)
#pragma unroll
        for (int i = 0; i < 16; ++i) if ((i & s) == 0) { const int hi = max(K[i], K[i + s]), lo = min(K[i], K[i + s]); K[i] = hi; K[i + s] = lo; }
}
template <class Side>
__device__ __forceinline__ void ph_route(const Ctx& C, LAS unsigned char* lds, const f16* __restrict__ qp, const float* __restrict__ ss2, const f16* __restrict__ subk,
                                         int* __restrict__ eidx, float* __restrict__ egate, const Side& side_job) {
    const int lane = C.lane, r32 = lane & 31, hh = lane >> 5;
    LAS unsigned char* tab = lds + 65536 + C.wave * 4096 + lane * 36;
    const int GH = C.G < 8 ? C.G : 8;
  for (int h = blockIdx.x % GH; h < 8; h += GH) {
    const int rank_h = blockIdx.x / GH, nwg_h = (C.G - (blockIdx.x % GH) + GH - 1) / GH;
    __syncthreads();
    for (int i = C.tid; i < 2 * 128 * 16; i += NTHREADS) {
        const int row = i >> 4, ch = i & 15;
        *(LAS half8*)(lds + row * 256 + ((ch ^ (row & 15)) << 4)) = *(const half8*)(subk + (size_t)(h * 256 + row) * 128 + ch * 8);
    }
    __syncthreads();
    if (h == (int)(blockIdx.x % GH) && (C.wave & 4)) side_job();
    for (int tb = rank_h * NWAVES + C.wave; tb < T / 32; tb += nwg_h * NWAVES) {
        const int t0 = tb * 32, t = t0 + r32;
        int top[2][16];
#pragma unroll
        for (int p = 0; p < 2; ++p) {
            const f16* qrow = qp + (size_t)t * 2048 + h * 256 + p * 128 + 8 * hh;
            const LAS unsigned char* kl = lds + (p * 128 + r32) * 256;
            half8 bq[8];
#pragma unroll
            for (int ks = 0; ks < 8; ++ks) bq[ks] = *(const half8*)(qrow + 16 * ks);
            int Lst[16];
#pragma unroll
            for (int z = 0; z < 16; ++z) Lst[z] = (int)0x80000000;
#pragma unroll 1
            for (int nb = 0; nb < 4; ++nb) {
                f32x16 acc = {0.f, 0.f, 0.f, 0.f, 0.f, 0.f, 0.f, 0.f, 0.f, 0.f, 0.f, 0.f, 0.f, 0.f, 0.f, 0.f};
#pragma unroll
                for (int ks = 0; ks < 8; ++ks) {
                    const half8 ak = *(const LAS half8*)(kl + nb * 32 * 256 + (((2 * ks + hh) ^ (r32 & 15)) << 4));
                    acc = __builtin_amdgcn_mfma_f32_32x32x16_f16(ak, bq[ks], acc, 0, 0, 0);
                }
                int K[16];
#pragma unroll
                for (int r = 0; r < 16; ++r) { const int n = nb * 32 + (r & 3) + 8 * (r >> 2) + 4 * hh; K[r] = (mono_i(acc[r]) & ~127) | (127 - n); }
                bitonic_sort16_desc(K);
#pragma unroll
                for (int z = 0; z < 16; ++z) Lst[z] = max(Lst[z], K[15 - z]);
                bitonic_merge16_desc(Lst);
            }
            merge_pair16(Lst);
#pragma unroll
            for (int z = 0; z < 16; ++z) top[p][z] = Lst[z];
        }
        float va[16], vb[16];
#pragma unroll
        for (int z = 0; z < 16; ++z) { va[z] = unmono_f(top[0][z] & ~127); vb[z] = unmono_f(top[1][z] & ~127);
            tab[z] = (unsigned char)(127 - (top[0][z] & 127)); tab[16 + z] = (unsigned char)(127 - (top[1][z] & 127)); }
        int Cl[16];
        { const float a01 = hh ? va[1] : va[0];
#pragma unroll
          for (int j = 0; j < 16; ++j) { const int key = (mono_i(a01 + vb[j]) & ~255) | (255 - (hh * 16 + j)); Cl[j] = (hh && j >= 8) ? (int)0x80000000 : key; } }
#pragma unroll
        for (int i = 2; i < 16; i += 2) {
            const float ai = hh ? va[i + 1] : va[i];
#pragma unroll
            for (int j = 0; j < 16; ++j)
                if ((i + 1) * (j + 1) <= 16) {
                    int key = (mono_i(ai + vb[j]) & ~255) | (255 - ((i + hh) * 16 + j));
                    if ((i + 2) * (j + 1) > 16) key = hh ? (int)0x80000000 : key;
                    INS16(Cl, key);
                }
        }
        merge_pair16(Cl);
        float e[16], sum = 0.f; const float mx = unmono_f(Cl[0] & ~255);
#pragma unroll
        for (int z = 0; z < 16; ++z) { e[z] = __expf(unmono_f(Cl[z] & ~255) - mx); sum += e[z]; }
        const float inv = 1.0f / sum;
        LDS_WAIT();
        int* ei = eidx + (size_t)t * 128 + h * 16 + 8 * hh; float* eg = egate + (size_t)t * 128 + h * 16 + 8 * hh;
#pragma unroll
        for (int z = 0; z < 16; ++z) {
            if ((z >> 3) == hh) { const int code = 255 - (Cl[z] & 255); const int ia = tab[code >> 4], ib = tab[16 + (code & 15)];
                ei[z & 7] = ia * 128 + ib; eg[z & 7] = e[z] * inv; }
        }
        LDS_WAIT();
    }
  }
}

struct Slicing { int m, pi, nloc, rank; };
__device__ __forceinline__ Slicing get_slicing(const unsigned* bar, volatile LAS unsigned* misc) {
    Slicing S; const unsigned x = (unsigned)__builtin_amdgcn_s_getreg((3 << 11) | 20) & 0xFu;
    int m = 0, pi = 0, nloc = 1;
    for (unsigned j = 0; j < 16; ++j) { const unsigned c = __hip_atomic_load(&bar[256 + 64 * j], __ATOMIC_RELAXED, __HIP_MEMORY_SCOPE_AGENT); if (c > 0u) { if (j < x) ++pi; ++m; } if (j == x) nloc = (int)c; }
    S.m = m > 0 ? m : 1; S.pi = pi; S.nloc = nloc > 0 ? nloc : 1; S.rank = (int)misc[10];
    return S;
}
__device__ __forceinline__ float gelu_fast(float v) {
    const float av = fabsf(v), t = __builtin_amdgcn_rcpf(av * 0.2316418882f + 1.0f);
    float q = t * 0.5307027145f + (-0.7265760135f); q = q * t + 0.7107068705f; q = q * t + (-0.142248368f); q = q * t + 0.127414796f; q = q * t;
    const float m = v * (q * __builtin_amdgcn_exp2f((v * v) * (-0.72134752044f)));
    return v < 0.f ? m : v - m;
}
__device__ __forceinline__ void ph_h2quant(const Ctx& C, const f16* __restrict__ x1h, const float* __restrict__ ss2, unsigned* __restrict__ h2q, float* __restrict__ hsc) {
    const int lane = C.lane;
    for (int t = C.gw; t < T; t += C.ngw) {
        const half8 h0 = *(const half8*)(x1h + (size_t)t * DM + 16 * lane), h1 = *(const half8*)(x1h + (size_t)t * DM + 16 * lane + 8);
        float hm = 0.f;
#pragma unroll
        for (int i = 0; i < 8; ++i) hm = fmaxf(hm, fmaxf(fabsf((float)h0[i]), fabsf((float)h1[i])));
        hm = wave_max(hm);
        const float inv = hm > 0.f ? 127.0f / hm : 0.f;
        u32x4 w;
        w[0] = (unsigned)pack4_i8((float)h0[0] * inv, (float)h0[1] * inv, (float)h0[2] * inv, (float)h0[3] * inv);
        w[1] = (unsigned)pack4_i8((float)h0[4] * inv, (float)h0[5] * inv, (float)h0[6] * inv, (float)h0[7] * inv);
        w[2] = (unsigned)pack4_i8((float)h1[0] * inv, (float)h1[1] * inv, (float)h1[2] * inv, (float)h1[3] * inv);
        w[3] = (unsigned)pack4_i8((float)h1[4] * inv, (float)h1[5] * inv, (float)h1[6] * inv, (float)h1[7] * inv);
        *(u32x4*)(h2q + (size_t)t * 256 + 4 * lane) = w;
        if (lane == 0) hsc[t] = hm * (1.0f / 127.0f) * rs_from_ss(ss2, t);
    }
}
__device__ __forceinline__ __amdgpu_buffer_rsrc_t slice_rsrc(const unsigned char* base) {
    const unsigned long long b = (unsigned long long)base;
    const unsigned lo = __builtin_amdgcn_readfirstlane((unsigned)b), hi = __builtin_amdgcn_readfirstlane((unsigned)(b >> 32));
    return __builtin_amdgcn_make_buffer_rsrc((void*)(((unsigned long long)hi << 32) | lo), 0, NEXP * 128, 0x00020000);
}
template <int EMASK>
__device__ __forceinline__ void ph_upeer(const Ctx& C, LAS unsigned char* lds, const Slicing SL, const unsigned* __restrict__ h2q, const int* __restrict__ eidx,
                                         const unsigned char* __restrict__ uq, short* __restrict__ pdot) {
    const int lane = C.lane, grp = lane >> 3, c8 = lane & 7;
    const int wv = SL.rank * NWAVES + C.wave, nwv = SL.nloc * NWAVES;
    const int ntok = (T - wv + nwv - 1) / nwv;
    auto tok = [&](int i) { const int t = wv + i * nwv; return t < T ? t : T - 1; };
    volatile LAS int* row = (volatile LAS int*)(lds + C.wave * 1024);
  for (int s = SL.pi; s < 8; s += SL.m) {
    const __amdgpu_buffer_rsrc_t urs = slice_rsrc(uq + (size_t)s * (NEXP * 128));
    const unsigned* hqs = h2q + s * 32 + c8 * 4;
    int tA = tok(0), tB = tok(1);
    int e0 = eidx[(size_t)tA * 128 + lane], e1 = eidx[(size_t)tA * 128 + 64 + lane];
    u32x4 hq = *(const u32x4*)(hqs + (size_t)tA * 256);
    int ne0 = eidx[(size_t)tB * 128 + lane], ne1 = eidx[(size_t)tB * 128 + 64 + lane];
    u32x4 r[16];
#pragma unroll
    for (int i = 0; i < 16; ++i) { const int e = __shfl(i < 8 ? e0 : e1, 8 * (i & 7) + grp) & EMASK; r[i] = __builtin_amdgcn_raw_buffer_load_b128(urs, e * 128 + c8 * 16, 0, 0); }
#pragma unroll 1
    for (int it = 0; it < ntok; ++it) {
        const int t = tok(it), t1 = tok(it + 1), t2 = tok(it + 2);
        const int ze0 = eidx[(size_t)t2 * 128 + lane], ze1 = eidx[(size_t)t2 * 128 + 64 + lane];
        const u32x4 nhq = *(const u32x4*)(hqs + (size_t)t1 * 256);
#pragma unroll
        for (int q = 0; q < 4; ++q) {
            int evv[4];
#pragma unroll
            for (int j = 0; j < 4; ++j) evv[j] = __shfl(q < 2 ? ne0 : ne1, 32 * (q & 1) + 8 * j + grp) & EMASK;
            int pa[4], pb[4];
#pragma unroll
            for (int j = 0; j < 4; ++j) {
                pa[j] = __builtin_amdgcn_sdot4((int)r[4 * q + j][0], (int)hq[0], 0, false); pb[j] = __builtin_amdgcn_sdot4((int)r[4 * q + j][1], (int)hq[1], 0, false);
                pa[j] = __builtin_amdgcn_sdot4((int)r[4 * q + j][2], (int)hq[2], pa[j], false); pb[j] = __builtin_amdgcn_sdot4((int)r[4 * q + j][3], (int)hq[3], pb[j], false);
            }
#pragma unroll
            for (int j = 0; j < 4; ++j) { pa[j] += pb[j]; pa[j] += dppi<0xB1>(pa[j]); }
#pragma unroll
            for (int j = 0; j < 4; ++j) pa[j] += dppi<0x4E>(pa[j]);
#pragma unroll
            for (int j = 0; j < 4; ++j) pa[j] += dppi<0x141>(pa[j]);
            if (c8 == 0) {
#pragma unroll
                for (int j = 0; j < 4; ++j) row[8 * (4 * q + j) + grp] = pa[j];
            }
#pragma unroll
            for (int j = 0; j < 4; ++j) {
                asm volatile("" ::: "memory");
                r[4 * q + j] = __builtin_amdgcn_raw_buffer_load_b128(urs, evv[j] * 128 + c8 * 16, 0, 0);
                asm volatile("" ::: "memory");
            }
        }
        LDS_WAIT();
        const int p0 = row[lane], p1 = row[64 + lane];
        LDS_WAIT();
        { short* pp = pdot + ((size_t)s * T + t) * 128 + lane; const int c0 = min(max((p0 + 4) >> 3, -32768), 32767), c1 = min(max((p1 + 4) >> 3, -32768), 32767);
          asm volatile("global_store_short %0, %1, off\n\tglobal_store_short %0, %2, off offset:128" :: "v"(pp), "v"(c0), "v"(c1) : "memory"); }
        hq = nhq; ne0 = ze0; ne1 = ze1;
    }
  }
}
__device__ __forceinline__ void ph_ureduce(const Ctx& C, LAS unsigned char* lds, const short* __restrict__ pdot, const float* __restrict__ hsc, const int* __restrict__ eidx, const float* __restrict__ us,
                                           const float* __restrict__ vs, const float* __restrict__ egate, unsigned* __restrict__ wqp, float* __restrict__ wsc) {
    const int lane = C.lane;
    volatile LAS unsigned char* row = (volatile LAS unsigned char*)(lds + C.wave * 1024);
    for (int tb = C.gw * 2; tb < T; tb += C.ngw * 2) {
        int e0[2], e1[2], s0[2], s1[2]; float h[2], g0[2], g1[2];
#pragma unroll
        for (int u = 0; u < 2; ++u) {
            const int t = tb + u;
            e0[u] = eidx[(size_t)t * 128 + lane]; e1[u] = eidx[(size_t)t * 128 + 64 + lane];
            g0[u] = egate[(size_t)t * 128 + lane]; g1[u] = egate[(size_t)t * 128 + 64 + lane];
            h[u] = hsc[t]; s0[u] = 0; s1[u] = 0;
#pragma unroll
            for (int s = 0; s < 8; ++s) { const short* pp = pdot + ((size_t)s * T + t) * 128 + lane; s0[u] += (int)pp[0]; s1[u] += (int)pp[64]; }
        }
        float w0[2], w1[2];
#pragma unroll
        for (int u = 0; u < 2; ++u) {
            w0[u] = gelu_fast((float)s0[u] * (8.0f * h[u]) * us[e0[u]]) * g0[u] * vs[e0[u]];
            w1[u] = gelu_fast((float)s1[u] * (8.0f * h[u]) * us[e1[u]]) * g1[u] * vs[e1[u]];
        }
#pragma unroll
        for (int u = 0; u < 2; ++u) {
            const int t = tb + u;
            const float wm = wave_max(fmaxf(fabsf(w0[u]), fabsf(w1[u])));
            const float inv = wm > 0.f ? 127.0f / wm : 0.f;
            { const int k = lane; row[u * 128 + (k & 7) * 16 + (k >> 5) * 4 + ((k >> 3) & 3)] = (unsigned char)(int)rintf(w0[u] * inv); }
            { const int k = 64 + lane; row[u * 128 + (k & 7) * 16 + (k >> 5) * 4 + ((k >> 3) & 3)] = (unsigned char)(int)rintf(w1[u] * inv); }
            if (lane == 0) wsc[t] = wm * (1.0f / 127.0f);
        }
        LDS_WAIT();
        wqp[(size_t)tb * 32 + lane] = ((volatile LAS unsigned*)row)[lane];
        LDS_WAIT();
    }
}
template <int EMASK>
__device__ __forceinline__ void ph_vpeer(const Ctx& C, const Slicing SL, const int* __restrict__ eidx, const unsigned* __restrict__ wqp, const float* __restrict__ wsc, const unsigned char* __restrict__ vq,
                                         f16* __restrict__ peer) {
    const int lane = C.lane, grp = lane >> 3, c8 = lane & 7;
    const bool hh = (lane & 32) != 0, b4 = (lane & 16) != 0, b3 = (lane & 8) != 0;
    const int wv = SL.rank * NWAVES + C.wave, nwv = SL.nloc * NWAVES;
    const int ntok = (T - wv + nwv - 1) / nwv;
    auto tok = [&](int i) { const int t = wv + i * nwv; return t < T ? t : T - 1; };
  for (int s = SL.pi; s < 8; s += SL.m) {
    const __amdgpu_buffer_rsrc_t vrs = slice_rsrc(vq + (size_t)s * (NEXP * 128));
    const int chl = 8 * (hh ? 1 : 0) + 4 * (b4 ? 1 : 0) + 2 * (b3 ? 1 : 0);
    const int coff = s * 128 + c8 * 16 + chl;
    int tA = tok(0), tB = tok(1);
    int e0 = eidx[(size_t)tA * 128 + lane], e1 = eidx[(size_t)tA * 128 + 64 + lane];
    u32x4 wq = *(const u32x4*)(wqp + (size_t)tA * 32 + grp * 4); float wscale = wsc[tA];
    int ne0 = eidx[(size_t)tB * 128 + lane], ne1 = eidx[(size_t)tB * 128 + 64 + lane];
    u32x4 r[16];
#pragma unroll
    for (int i = 0; i < 16; ++i) { const int e = __shfl(i < 8 ? e0 : e1, 8 * (i & 7) + grp) & EMASK; r[i] = __builtin_amdgcn_raw_buffer_load_b128(vrs, e * 128 + c8 * 16, 0, 0); }
#pragma unroll 1
    for (int it = 0; it < ntok; ++it) {
        const int t = tok(it), t1 = tok(it + 1), t2 = tok(it + 2);
        const int ze0 = eidx[(size_t)t2 * 128 + lane], ze1 = eidx[(size_t)t2 * 128 + 64 + lane];
        const u32x4 nwq = *(const u32x4*)(wqp + (size_t)t1 * 32 + grp * 4); const float nwscale = wsc[t1];
        int o[16];
#pragma unroll
        for (int c = 0; c < 16; ++c) o[c] = 0;
#pragma unroll
        for (int q = 0; q < 4; ++q) {
            int evv[4];
#pragma unroll
            for (int j = 0; j < 4; ++j) evv[j] = __shfl(q < 2 ? ne0 : ne1, 32 * (q & 1) + 8 * j + grp) & EMASK;
#pragma unroll
            for (int d = 0; d < 4; ++d) {
                const unsigned a = r[4 * q][d], b = r[4 * q + 1][d], c = r[4 * q + 2][d], e = r[4 * q + 3][d];
                const unsigned t0 = __builtin_amdgcn_perm(b, a, 0x05010400u), t1p = __builtin_amdgcn_perm(b, a, 0x07030602u);
                const unsigned u0 = __builtin_amdgcn_perm(e, c, 0x05010400u), u1 = __builtin_amdgcn_perm(e, c, 0x07030602u);
                o[4 * d + 0] = __builtin_amdgcn_sdot4((int)__builtin_amdgcn_perm(u0, t0, 0x05040100u), (int)wq[q], o[4 * d + 0], false);
                o[4 * d + 1] = __builtin_amdgcn_sdot4((int)__builtin_amdgcn_perm(u0, t0, 0x07060302u), (int)wq[q], o[4 * d + 1], false);
                o[4 * d + 2] = __builtin_amdgcn_sdot4((int)__builtin_amdgcn_perm(u1, t1p, 0x05040100u), (int)wq[q], o[4 * d + 2], false);
                o[4 * d + 3] = __builtin_amdgcn_sdot4((int)__builtin_amdgcn_perm(u1, t1p, 0x07060302u), (int)wq[q], o[4 * d + 3], false);
            }
#pragma unroll
            for (int j = 0; j < 4; ++j) {
                asm volatile("" ::: "memory");
                r[4 * q + j] = __builtin_amdgcn_raw_buffer_load_b128(vrs, evv[j] * 128 + c8 * 16, 0, 0);
                asm volatile("" ::: "memory");
            }
        }
        int q8[8], q4[4], q2[2];
#pragma unroll
        for (int k = 0; k < 8; ++k) q8[k] = bfly32i(o[k], o[8 + k]);
#pragma unroll
        for (int k = 0; k < 4; ++k) q4[k] = bfly16i(q8[k], q8[4 + k]);
#pragma unroll
        for (int k = 0; k < 2; ++k) { const int mine = b3 ? q4[2 + k] : q4[k], oth = b3 ? q4[k] : q4[2 + k]; q2[k] = mine + dppi<0x128>(oth); }
        { half2 pv; pv[0] = (f16)((float)q2[0] * wscale); pv[1] = (f16)((float)q2[1] * wscale); f16* yp = peer + (size_t)t * DM + coff; asm volatile("global_store_dword %0, %1, off" :: "v"(yp), "v"(pv) : "memory"); }
        wq = nwq; wscale = nwscale; ne0 = ze0; ne1 = ze1;
    }
  }
}
__device__ __forceinline__ void ph_final(const Ctx& C, const f16* __restrict__ peer, float* xio, const float* __restrict__ gf) {
    const int lane = C.lane;
    f32x4 gg[4];
#pragma unroll
    for (int j = 0; j < 4; ++j) gg[j] = *(const f32x4*)(gf + j * 256 + lane * 4);
    for (int tb = C.gw * 4; tb < T; tb += C.ngw * 4) {
        f32x4 v[4][4]; half4 pe[4][4];
#pragma unroll
        for (int u = 0; u < 4; ++u)
#pragma unroll
            for (int j = 0; j < 4; ++j) { v[u][j] = *(const f32x4*)(xio + (size_t)(tb + u) * DM + j * 256 + lane * 4); pe[u][j] = *(const half4*)(peer + (size_t)(tb + u) * DM + j * 256 + lane * 4); }
#pragma unroll
        for (int u = 0; u < 4; ++u) {
            float s = 0.f;
#pragma unroll
            for (int j = 0; j < 4; ++j) {
#pragma unroll
                for (int i = 0; i < 4; ++i) { v[u][j][i] += (float)pe[u][j][i]; s += v[u][j][i] * v[u][j][i]; }
            }
            const float r = rsqrtf(wave_sum(s) * (1.0f / DM) + EPS);
#pragma unroll
            for (int j = 0; j < 4; ++j) *(f32x4*)(xio + (size_t)(tb + u) * DM + j * 256 + lane * 4) = v[u][j] * r * gg[j];
        }
    }
}

namespace pg8 {
#define PG8_LAS __attribute__((address_space(3)))
typedef _Float16 frag8 __attribute__((ext_vector_type(8)));
typedef float f32x4 __attribute__((ext_vector_type(4)));
constexpr int BM = 256, BK = 64, HALF = 128, HTB = HALF * BK * 2  , STAGE_BYTES = 8 * HTB, NXCD = 8, WGM = 8;

__host__ __device__ __forceinline__ int lds_byte(int r, int c) { const int st = (r >> 4) * 2 + (c >> 5), rr = r & 15, cc = c & 31, ob = rr * 64 + cc * 2; return st * 1024 + (ob ^ (((ob >> 9) & 1) << 5)); }
__host__ __device__ __forceinline__ void stage_rc(int b, int& R, int& C) { const int st = b / 1024, sb = b % 1024, swz = sb ^ (((sb >> 9) & 1) << 5); R = (st >> 1) * 16 + swz / 64; C = (st & 1) * 32 + (swz % 64) / 2; }
__host__ __device__ __forceinline__ int perm32(int rho) { const int n = rho >> 4, i = rho & 15; return 8 * (i >> 2) + 4 * n + (i & 3); }

struct Unit { int pm, pn; };
struct Gemm { const f16* A; const f16* Bt; int M, N, K; };

struct StaticOrder {
    int nM, nN, nwg, G, c;
    __host__ __device__ void init(int M, int N, int G_, int c_) { nM = M / BM; nN = N / BM; nwg = nM * nN; G = G_; c = c_; }
    __host__ __device__ bool next(int i, Unit& u) const {
        const long L = (long)i * G + c; if (L >= nwg) return false;
        int wgid = (int)L; { const int q = nwg / NXCD, r = nwg % NXCD, xcd = wgid % NXCD, off = wgid / NXCD; wgid = (xcd < r ? xcd * (q + 1) : r * (q + 1) + (xcd - r) * q) + off; }
        const int nig = WGM * nN, gid = wgid / nig, fm = gid * WGM, gsz = (nM - fm) < WGM ? (nM - fm) : WGM;
        u.pm = fm + ((wgid % nig) % gsz); u.pn = (wgid % nig) / gsz; return true;
    }
    __device__ __forceinline__ void a_ready(const Unit&) const {}
    __device__ __forceinline__ void done(const Unit&) const {}
};

__device__ __forceinline__ frag8 pack8(const f32x4 a, const f32x4 b) {
    frag8 h; h[0] = (f16)a[0]; h[1] = (f16)a[1]; h[2] = (f16)a[2]; h[3] = (f16)a[3]; h[4] = (f16)b[0]; h[5] = (f16)b[1]; h[6] = (f16)b[2]; h[7] = (f16)b[3]; return h;
}
__device__ __forceinline__ float sigmoidf_(float z) { return 1.0f / (1.0f + __expf(-z)); }

struct EpiP1 {
    typedef i32x4 acc_t; static constexpr bool PERM = true, AFTER_DRAIN = false, MIDK = false;
    const float* ss1; const float* rsx; const float* wcs; const float* bgate; f16* qkvu; f16* gates; f16* vT;
    __device__ __forceinline__ void operator()(const i32x4 (&acc)[2][2][4][2], const Unit& u, int wr, int wc, int fr, int fq) const {
        const int row0 = u.pm * BM + wr * 64 + fr, colt = u.pn * BM; const bool isg = colt >= NQKVU;
        f32x4 cs[2][2];
#pragma unroll
        for (int bj = 0; bj < 2; ++bj) { const int c0 = colt + bj * HALF + wc * 32 + 8 * fq; cs[bj][0] = *(const f32x4*)(wcs + c0); cs[bj][1] = *(const f32x4*)(wcs + c0 + 4); }
#pragma unroll
        for (int ai = 0; ai < 2; ++ai)
#pragma unroll
            for (int m = 0; m < 4; ++m) { const int row = row0 + ai * HALF + m * 16; const float r = rsqrtf(ss1[row] * (1.0f / DM) + EPS) * rsx[row];
#pragma unroll
                for (int bj = 0; bj < 2; ++bj) { const int c0 = colt + bj * HALF + wc * 32 + 8 * fq; f32x4 v0, v1;
#pragma unroll
                    for (int i = 0; i < 4; ++i) { v0[i] = (float)acc[ai][bj][m][0][i] * (r * cs[bj][0][i]); v1[i] = (float)acc[ai][bj][m][1][i] * (r * cs[bj][1][i]); }
                    if (isg) { const int cg = c0 - NQKVU; const f32x4 b0 = *(const f32x4*)(bgate + cg), b1 = *(const f32x4*)(bgate + cg + 4);
#pragma unroll
                        for (int i = 0; i < 4; ++i) { v0[i] = sigmoidf_(v0[i] + b0[i]); v1[i] = sigmoidf_(v1[i] + b1[i]); }
                        *(frag8*)(gates + (size_t)row * NGATE + cg) = pack8(v0, v1); }
                    else { const frag8 hv = pack8(v0, v1); *(frag8*)(qkvu + (size_t)row * NQKVU + c0) = hv;
                        if (colt == 512 && bj == 1) {
                            f16* vp = vT + ((size_t)((row >> 11) * 2 + (wc >> 1)) * 64 + (wc & 1) * 32 + 8 * fq) * SEQ + (row & (SEQ - 1));
#pragma unroll
                            for (int i = 0; i < 8; ++i) vp[(size_t)i * SEQ] = hv[i]; } } } }
    }
};
struct EpiMerged {
    typedef f32x4 acc_t; static constexpr bool PERM = true, AFTER_DRAIN = false, MIDK = true;
    const f16* gates; f16* merged;
    __device__ __forceinline__ void mid(f32x4 (&acc)[2][2][4][2], const Unit& u, int wr, int wc, int fr, int fq) const {
        const int row0 = u.pm * BM + wr * 64 + fr, colt = u.pn * BM;
        const f16* gb = gates + (size_t)row0 * NGATE + colt + wc * 32 + 8 * fq;
        asm volatile("" : "+v"(gb));
#pragma unroll
        for (int ai = 0; ai < 2; ++ai) {
            frag8 g0[4][2], g1[4][2];
#pragma unroll
            for (int m = 0; m < 4; ++m)
#pragma unroll
                for (int bj = 0; bj < 2; ++bj) { const f16* gp = gb + (size_t)(ai * HALF + m * 16) * NGATE + bj * HALF; g0[m][bj] = *(const frag8*)gp; g1[m][bj] = *(const frag8*)(gp + DM); }
#pragma unroll
            for (int m = 0; m < 4; ++m)
#pragma unroll
                for (int bj = 0; bj < 2; ++bj)
#pragma unroll
                    for (int i = 0; i < 4; ++i) {
                        acc[ai][bj][m][0][i] *= (float)g0[m][bj][i] * __builtin_amdgcn_rcpf(fmaxf((float)g1[m][bj][i], 1e-4f));
                        acc[ai][bj][m][1][i] *= (float)g0[m][bj][4 + i] * __builtin_amdgcn_rcpf(fmaxf((float)g1[m][bj][4 + i], 1e-4f)); }
            asm volatile("" ::: "memory");
        }
    }
    __device__ __forceinline__ void operator()(const f32x4 (&acc)[2][2][4][2], const Unit& u, int wr, int wc, int fr, int fq) const {
        const int row0 = u.pm * BM + wr * 64 + fr, colt = u.pn * BM;
#pragma unroll
        for (int ai = 0; ai < 2; ++ai)
#pragma unroll
            for (int m = 0; m < 4; ++m) { const int row = row0 + ai * HALF + m * 16;
#pragma unroll
                for (int bj = 0; bj < 2; ++bj) { const int c0 = colt + bj * HALF + wc * 32 + 8 * fq;
                    const frag8 g1 = *(const frag8*)(gates + (size_t)row * NGATE + DM + c0); f32x4 v0, v1;
#pragma unroll
                    for (int i = 0; i < 4; ++i) { v0[i] = acc[ai][bj][m][0][i] * fmaxf((float)g1[i], 1e-4f); v1[i] = acc[ai][bj][m][1][i] * fmaxf((float)g1[4 + i], 1e-4f); }
                    *(frag8*)(merged + (size_t)row * DM + c0) = pack8(v0, v1); } }
    }
};
struct EpiOut {
    typedef f32x4 acc_t; static constexpr bool PERM = false, AFTER_DRAIN = false, MIDK = false;
    const float* x; const float* g2; float* x1; f16* x1h; float* ss2p;
    __device__ __forceinline__ void operator()(const f32x4 (&acc)[2][2][4][2], const Unit& u, int wr, int wc, int fr, int fq) const {
        const int row0 = u.pm * BM + wr * 64 + fr, col0 = u.pn * BM + wc * 32 + 4 * fq;
        f32x4 gv[2][2];
#pragma unroll
        for (int bj = 0; bj < 2; ++bj)
#pragma unroll
            for (int n = 0; n < 2; ++n) gv[bj][n] = *(const f32x4*)(g2 + col0 + bj * HALF + n * 16);
#pragma unroll
        for (int ai = 0; ai < 2; ++ai)
#pragma unroll
            for (int m = 0; m < 4; ++m) { const int row = row0 + ai * HALF + m * 16; const size_t off = (size_t)row * DM + col0; float ssq = 0.f;
#pragma unroll
                for (int bj = 0; bj < 2; ++bj)
#pragma unroll
                    for (int n = 0; n < 2; ++n) { const f32x4 y = *(const f32x4*)(x + off + bj * HALF + n * 16) + acc[ai][bj][m][n];
                        *(f32x4*)(x1 + off + bj * HALF + n * 16) = y; ssq += (y[0] * y[0] + y[1] * y[1]) + (y[2] * y[2] + y[3] * y[3]);
                        const f32x4 yg = y * gv[bj][n]; half4 h; h[0] = (f16)yg[0]; h[1] = (f16)yg[1]; h[2] = (f16)yg[2]; h[3] = (f16)yg[3];
                        *(half4*)(x1h + off + bj * HALF + n * 16) = h; }
                ssq += __shfl_xor(ssq, 16); ssq += __shfl_xor(ssq, 32);
                if (fq == 0) ss2p[(size_t)(u.pn * 4 + wc) * T + row] = ssq; }
    }
};
struct EpiQ {
    typedef i32x4 acc_t; static constexpr bool PERM = true, AFTER_DRAIN = false, MIDK = false;
    const float* hsc; const float* wqs; f16* qp;
    __device__ __forceinline__ void operator()(const i32x4 (&acc)[2][2][4][2], const Unit& u, int wr, int wc, int fr, int fq) const {
        const int row0 = u.pm * BM + wr * 64 + fr, colt = u.pn * BM;
        f32x4 cs[2][2];
#pragma unroll
        for (int bj = 0; bj < 2; ++bj) { const int c0 = colt + bj * HALF + wc * 32 + 8 * fq; cs[bj][0] = *(const f32x4*)(wqs + c0); cs[bj][1] = *(const f32x4*)(wqs + c0 + 4); }
#pragma unroll
        for (int ai = 0; ai < 2; ++ai)
#pragma unroll
            for (int m = 0; m < 4; ++m) { const int row = row0 + ai * HALF + m * 16; const float r = hsc[row];
#pragma unroll
                for (int bj = 0; bj < 2; ++bj) { const int c0 = colt + bj * HALF + wc * 32 + 8 * fq; f32x4 v0, v1;
#pragma unroll
                    for (int i = 0; i < 4; ++i) { v0[i] = (float)acc[ai][bj][m][0][i] * (r * cs[bj][0][i]); v1[i] = (float)acc[ai][bj][m][1][i] * (r * cs[bj][1][i]); }
                    *(frag8*)(qp + (size_t)row * 2048 + c0) = pack8(v0, v1); } }
    }
};

__device__ __forceinline__ void mma16(const frag8 b, const frag8 a, f32x4& c) { c = __builtin_amdgcn_mfma_f32_16x16x32_f16(b, a, c, 0, 0, 0); }
__device__ __forceinline__ void mma16(const frag8 b, const frag8 a, i32x4& c) { c = __builtin_amdgcn_mfma_i32_16x16x64_i8(__builtin_bit_cast(i32x4, b), __builtin_bit_cast(i32x4, a), c, 0, 0, 0); }
template <class Epi, class Sched, bool ALIGN_EPI = false, bool SP2 = false>
__device__ __forceinline__ void gemm_phase(PG8_LAS unsigned char* lds, const Gemm g, const Sched& S, const Epi& E) {
    const int tid = threadIdx.x, wid = __builtin_amdgcn_readfirstlane(tid >> 6), lane = tid & 63, wr = wid >> 2, wc = wid & 3, fr = lane & 15, fq = lane >> 4;
    const int K = g.K, nt = K / BK;
    unsigned voffA[2], voffB[2];
#pragma unroll
    for (int i = 0; i < 2; ++i) { int R, C; stage_rc(tid * 16 + i * 8192, R, C); const int Rb = Epi::PERM ? ((R & ~31) + perm32(R & 31)) : R;
        voffA[i] = (unsigned)(R * K + C) * 2u; voffB[i] = (unsigned)(Rb * K + C) * 2u; }
    const size_t kstep = (size_t)(BK * 2);
    const size_t hstep = (size_t)HALF * K * 2;
    const size_t tstep = 2 * hstep;
    const unsigned ldsw = (unsigned)wid * 1024u;
    const int aoff = lds_byte(wr * 64 + fr, fq * 8), boff = lds_byte(wc * 32 + fr, fq * 8);
#define PG8_SA(b, h) (((b) * 2 + (h)) * HTB)
#define PG8_SB(b, h) ((4 + (b) * 2 + (h)) * HTB)
#define PG8_STAGE(bufoff, gbase, voff) do { _Pragma("unroll") for (int _i = 0; _i < 2; ++_i) \
        __builtin_amdgcn_global_load_lds((const unsigned*)((const char*)(gbase) + (voff)[_i]), (PG8_LAS unsigned*)(lds + (bufoff) + ldsw + _i * 8192), 16, 0, 0); } while (0)
#define PG8_LDA(dst, b, h) do { _Pragma("unroll") for (int m = 0; m < 4; ++m) _Pragma("unroll") for (int k = 0; k < 2; ++k) dst[m][k] = *(const PG8_LAS frag8*)(lds + PG8_SA(b, h) + aoff + m * 2048 + k * 1024); } while (0)
#define PG8_LDB(dst, b, h) do { _Pragma("unroll") for (int n = 0; n < 2; ++n) _Pragma("unroll") for (int k = 0; k < 2; ++k) dst[n][k] = *(const PG8_LAS frag8*)(lds + PG8_SB(b, h) + boff + n * 2048 + k * 1024); } while (0)
#define PG8_MMA(ai, bj, At, Bt) do { __builtin_amdgcn_s_setprio(1); _Pragma("unroll") for (int m = 0; m < 4; ++m) _Pragma("unroll") for (int n = 0; n < 2; ++n) _Pragma("unroll") for (int k = 0; k < 2; ++k) \
        mma16(Bt[n][k], At[m][k], acc[ai][bj][m][n]); __builtin_amdgcn_s_setprio(0); } while (0)
#define PG8_WAIT_V(n) asm volatile("s_waitcnt vmcnt(" #n ")" ::: "memory")
#define PG8_WAIT_L(n) asm volatile("s_waitcnt lgkmcnt(" #n ")" ::: "memory")
#define PG8_BAR __builtin_amdgcn_s_barrier()
#define PG8_SCHED __builtin_amdgcn_sched_barrier(0)
    Unit cur, nxt; int ui = 0;
    if (!S.next(0, cur)) return;
    typedef typename Epi::acc_t acc_t;
    acc_t acc[2][2][4][2];
#pragma unroll
    for (int a = 0; a < 2; ++a)
#pragma unroll
        for (int b = 0; b < 2; ++b)
#pragma unroll
            for (int m = 0; m < 4; ++m)
#pragma unroll
                for (int n = 0; n < 2; ++n) acc[a][b][m][n] = acc_t{};
    frag8 At[4][2], B0[2][2], B1[2][2];
    const char* cA = (const char*)g.A + (size_t)cur.pm * tstep; const char* cB = (const char*)g.Bt + (size_t)cur.pn * tstep;
    S.a_ready(cur);
    if constexpr (SP2) {
        PG8_STAGE(PG8_SB(0, 0), cB, voffB); PG8_STAGE(PG8_SB(0, 1), cB + hstep, voffB); PG8_STAGE(PG8_SA(0, 0), cA, voffA); PG8_STAGE(PG8_SA(0, 1), cA + hstep, voffA);
        if (wr == 1) PG8_BAR;
        PG8_WAIT_V(2); PG8_BAR;
        PG8_STAGE(PG8_SB(1, 0), cB + kstep, voffB); PG8_STAGE(PG8_SA(1, 0), cA + kstep, voffA); PG8_STAGE(PG8_SB(1, 1), cB + hstep + kstep, voffB);
        PG8_WAIT_V(6); PG8_BAR;
    } else {
        PG8_STAGE(PG8_SB(0, 0), cB, voffB); PG8_STAGE(PG8_SA(0, 0), cA, voffA); PG8_STAGE(PG8_SB(0, 1), cB + hstep, voffB); PG8_STAGE(PG8_SA(0, 1), cA + hstep, voffA);
        if (wr == 1) PG8_BAR;
        PG8_WAIT_V(4); PG8_BAR;
        PG8_STAGE(PG8_SB(1, 0), cB + kstep, voffB); PG8_STAGE(PG8_SA(1, 0), cA + kstep, voffA); PG8_STAGE(PG8_SB(1, 1), cB + hstep + kstep, voffB);
        PG8_WAIT_V(6); PG8_BAR;
    }
    for (;;) {
        const bool has_next = S.next(ui + 1, nxt);
        const char* nA = has_next ? (const char*)g.A + (size_t)nxt.pm * tstep : cA; const char* nB = has_next ? (const char*)g.Bt + (size_t)nxt.pn * tstep : cB;
        for (int t = 0; t < nt; t += 2) {
            const bool last = (t == nt - 2);
            if constexpr (Epi::MIDK) { if (t == (nt >> 1)) E.mid(acc, cur, wr, wc, fr, fq); }
            const char* a1 = cA + (size_t)(t + 1) * kstep;
            const char* a2 = last ? nA : cA + (size_t)(t + 2) * kstep; const char* b2 = last ? nB : cB + (size_t)(t + 2) * kstep;
            const char* a3 = a2 + kstep; const char* b3 = b2 + kstep;
            if (last && has_next) S.a_ready(nxt);
            if constexpr (SP2) {
            PG8_LDB(B0, 0, 0); PG8_LDB(B1, 0, 1); PG8_SCHED; PG8_LDA(At, 0, 0); PG8_STAGE(PG8_SA(1, 1), a1 + hstep, voffA);
            PG8_WAIT_V(8); PG8_WAIT_L(0); PG8_BAR; PG8_MMA(0, 0, At, B0); PG8_MMA(0, 1, At, B1); PG8_BAR; PG8_SCHED;
            PG8_LDA(At, 0, 1); PG8_STAGE(PG8_SB(0, 0), b2, voffB); PG8_STAGE(PG8_SB(0, 1), b2 + hstep, voffB); PG8_STAGE(PG8_SA(0, 0), a2, voffA);
            PG8_WAIT_V(8); PG8_WAIT_L(0); PG8_BAR; PG8_MMA(1, 0, At, B0); PG8_MMA(1, 1, At, B1); PG8_BAR; PG8_SCHED;
            PG8_LDB(B0, 1, 0); PG8_LDB(B1, 1, 1); PG8_SCHED; PG8_LDA(At, 1, 0); PG8_STAGE(PG8_SA(0, 1), a2 + hstep, voffA);
            PG8_WAIT_V(8); PG8_WAIT_L(0); PG8_BAR; PG8_MMA(0, 0, At, B0); PG8_MMA(0, 1, At, B1); PG8_BAR; PG8_SCHED;
            PG8_LDA(At, 1, 1); PG8_STAGE(PG8_SB(1, 0), b3, voffB); PG8_STAGE(PG8_SB(1, 1), b3 + hstep, voffB); PG8_STAGE(PG8_SA(1, 0), a3, voffA);
            PG8_WAIT_V(8); PG8_WAIT_L(0); PG8_BAR; PG8_MMA(1, 0, At, B0); PG8_MMA(1, 1, At, B1); PG8_BAR; PG8_SCHED;
            } else {
            PG8_LDB(B0, 0, 0); PG8_SCHED; PG8_LDA(At, 0, 0); PG8_STAGE(PG8_SA(1, 1), a1 + hstep, voffA);
            PG8_WAIT_L(8); PG8_BAR; PG8_WAIT_L(0); PG8_MMA(0, 0, At, B0); PG8_BAR; PG8_SCHED;
            PG8_LDB(B1, 0, 1); PG8_STAGE(PG8_SB(0, 0), b2, voffB);
            PG8_BAR; PG8_WAIT_L(0); PG8_MMA(0, 1, At, B1); PG8_BAR;
            PG8_LDA(At, 0, 1); PG8_STAGE(PG8_SA(0, 0), a2, voffA);
            PG8_BAR; PG8_WAIT_L(0); PG8_MMA(1, 0, At, B0); PG8_BAR; PG8_SCHED;
            PG8_STAGE(PG8_SB(0, 1), b2 + hstep, voffB);
            PG8_WAIT_V(6); PG8_BAR; PG8_MMA(1, 1, At, B1); PG8_BAR;
            PG8_LDB(B0, 1, 0); PG8_SCHED; PG8_LDA(At, 1, 0); PG8_STAGE(PG8_SA(0, 1), a2 + hstep, voffA);
            PG8_WAIT_L(8); PG8_BAR; PG8_WAIT_L(0); PG8_MMA(0, 0, At, B0); PG8_BAR; PG8_SCHED;
            PG8_LDB(B1, 1, 1); PG8_STAGE(PG8_SB(1, 0), b3, voffB);
            PG8_BAR; PG8_WAIT_L(0); PG8_MMA(0, 1, At, B1); PG8_BAR;
            PG8_LDA(At, 1, 1); PG8_STAGE(PG8_SA(1, 0), a3, voffA);
            PG8_BAR; PG8_WAIT_L(0); PG8_MMA(1, 0, At, B0); PG8_BAR; PG8_SCHED;
            PG8_STAGE(PG8_SB(1, 1), b3 + hstep, voffB);
            PG8_WAIT_V(6); PG8_BAR; PG8_MMA(1, 1, At, B1); PG8_BAR;
            }
        }
        if constexpr (ALIGN_EPI) { if (wr == 0) PG8_BAR; }
        if constexpr (!Epi::AFTER_DRAIN) { E(acc, cur, wr, wc, fr, fq); S.done(cur); }
        if (!has_next) break;
#pragma unroll
        for (int a = 0; a < 2; ++a)
#pragma unroll
            for (int b = 0; b < 2; ++b)
#pragma unroll
                for (int m = 0; m < 4; ++m)
#pragma unroll
                    for (int n = 0; n < 2; ++n) acc[a][b][m][n] = acc_t{};
        cur = nxt; cA = nA; cB = nB; ++ui;
        if constexpr (ALIGN_EPI) { if (wr == 1) PG8_BAR; }
    }
    PG8_WAIT_V(0);
    if constexpr (!ALIGN_EPI) { if (wr == 0) PG8_BAR; }
    PG8_BAR;
    if constexpr (Epi::AFTER_DRAIN) { E.fused(acc, cur, wr, wc, fr, fq, lds, wid, lane); S.done(cur); }
#undef PG8_SA
#undef PG8_SB
#undef PG8_STAGE
#undef PG8_LDA
#undef PG8_LDB
#undef PG8_MMA
#undef PG8_WAIT_V
#undef PG8_WAIT_L
#undef PG8_BAR
#undef PG8_SCHED
}
}

#define XB_TMO      128
#define XB_XCNT(j)  (256  + 64 * (j))
#define XB_XSUB(j)  (1280 + 64 * (j))
#define XB_XGEN(j)  (2304 + 64 * (j))
#define XB_TOP      3328
#define XB_TOPGEN   3392
#define XCD_BAR_WORDS 3456
#define XB_SPIN_CAP (1u << 18)

__device__ __forceinline__ unsigned xb_ld(unsigned* p)              { return __hip_atomic_load(p, __ATOMIC_RELAXED, __HIP_MEMORY_SCOPE_AGENT); }
__device__ __forceinline__ unsigned xb_add(unsigned* p, unsigned v) { return __hip_atomic_fetch_add(p, v, __ATOMIC_RELAXED, __HIP_MEMORY_SCOPE_AGENT); }
__device__ __forceinline__ unsigned xb_xcc_id() { return (unsigned)__builtin_amdgcn_s_getreg((3 << 11) | 20) & 0xFu; }
#define XB_SPIN(cond, bar) do { unsigned _sp = 0; while (cond) { __builtin_amdgcn_s_sleep(1); \
    if ((++_sp & 255u) == 0u) { if (xb_ld(&(bar)[XB_TMO])) break; if (_sp > XB_SPIN_CAP) { atomicAdd(&(bar)[XB_TMO], 1u); break; } } } } while (0)

struct XcdBarrier {
    unsigned* bar; unsigned x;
    volatile LAS unsigned* st;
};

__device__ __forceinline__ XcdBarrier xcd_barrier_post(unsigned* bar, volatile LAS unsigned* st) {
    XcdBarrier b; b.bar = bar; b.x = xb_xcc_id(); b.st = st;
    if (threadIdx.x == 0) st[2] = xb_add(&bar[XB_XCNT(b.x)], 1u);
    return b;
}
__device__ __forceinline__ void xcd_barrier_complete(unsigned* bar, unsigned x, unsigned& nloc, unsigned& nx) {
    const unsigned G = gridDim.x * gridDim.y * gridDim.z;
    unsigned sum, cnt, mine, sp = 0u;
    for (;;) {
        sum = 0u; cnt = 0u; mine = 0u;
#pragma unroll
        for (unsigned j = 0; j < 16; ++j) { const unsigned c = xb_ld(&bar[XB_XCNT(j)]); sum += c; cnt += (c > 0u) ? 1u : 0u; mine = (j == x) ? c : mine; }
        if (sum == G) break;
        __builtin_amdgcn_s_sleep(1);
        if ((++sp & 255u) == 0u) { if (xb_ld(&bar[XB_TMO])) break; if (sp > XB_SPIN_CAP) { atomicAdd(&bar[XB_TMO], 1u); break; } }
    }
    nloc = mine > 0u ? mine : 1u; nx = cnt > 0u ? cnt : 1u;
}

__device__ __forceinline__ void xcd_barrier(const XcdBarrier& b) {
    asm volatile("s_waitcnt vmcnt(0)" ::: "memory");
    __syncthreads();
    if (threadIdx.x == 0) {
        unsigned* bar = b.bar;
        __builtin_amdgcn_s_waitcnt(0);
        unsigned nloc = b.st[0], nx = b.st[1];
        if (nloc == 0u) { xcd_barrier_complete(bar, b.x, nloc, nx); b.st[0] = nloc; b.st[1] = nx; }
        const unsigned old = xb_add(&bar[XB_XSUB(b.x)], 1u);
        const unsigned gen = old / nloc;
        if (old + 1u == (gen + 1u) * nloc) {
            __builtin_amdgcn_fence(__ATOMIC_RELEASE, "agent");
            asm volatile("s_waitcnt vmcnt(0)" ::: "memory");
            const unsigned og = xb_add(&bar[XB_TOP], 1u);
            const unsigned tg = og / nx;
            if (og + 1u == (tg + 1u) * nx) xb_add(&bar[XB_TOPGEN], 1u);
            else XB_SPIN(xb_ld(&bar[XB_TOPGEN]) == tg, bar);
            __builtin_amdgcn_fence(__ATOMIC_ACQUIRE, "agent");
            xb_add(&bar[XB_XGEN(b.x)], 1u);
            asm volatile("s_waitcnt vmcnt(0)" ::: "memory");
        } else {
            XB_SPIN(xb_ld(&bar[XB_XGEN(b.x)]) == gen, bar);
            __builtin_amdgcn_fence(__ATOMIC_ACQUIRE, "agent");
            asm volatile("s_waitcnt vmcnt(0)" ::: "memory");
        }
    }
    __syncthreads();
}


struct Args { const float* in[16]; float* out; unsigned char* ws; int ph_lo, ph_hi; };
constexpr int N_PHASES = 11;

__global__ void __launch_bounds__(NTHREADS, 2) mk_fwd(Args a) {
    extern __shared__ __attribute__((aligned(16))) unsigned char lds[];
    LAS unsigned char* L = (LAS unsigned char*)lds;
    volatile LAS unsigned* MISC = (volatile LAS unsigned*)(L + MISC_OFF);
    unsigned char* ws = a.ws;
    Ctx C;
    C.tid = threadIdx.x; C.lane = C.tid & 63; C.wave = __builtin_amdgcn_readfirstlane(C.tid >> 6);
    C.G = gridDim.x; C.gw = blockIdx.x * NWAVES + C.wave; C.ngw = C.G * NWAVES; C.gt = blockIdx.x * NTHREADS + C.tid; C.ngt = C.G * NTHREADS;
    for (int u = C.tid; u < (LDS_BYTES - LDSCTL_OFF) / 4; u += NTHREADS) ((LAS unsigned*)(L + LDSCTL_OFF))[u] = 0u;
    __syncthreads();
    const int lo = a.ph_lo, hi = a.ph_hi, G = C.G;
    const bool multi = (hi - lo) > 1;
    XcdBarrier bar; bar.bar = (unsigned*)(ws + WS_CTL) + CW_BAR; bar.x = 0; bar.st = nullptr;
    if (multi) bar = xcd_barrier_post((unsigned*)(ws + WS_CTL) + CW_BAR, MISC + 8);
#define IN(k) (lo <= (k) && (k) < hi)
#define SEAM(k) do { if (IN(k) && IN((k) + 1)) xcd_barrier(bar); } while (0)

#define REPS(k) for (int rep_ = 0; rep_ < ((PROBE_DUP == (k)) ? 2 : 1); ++rep_)
#define REPBAR(k) do { if (PROBE_DUP == (k) && rep_ == 0) xcd_barrier(bar); } while (0)
    if (IN(0)) REPS(0) { ph_prep(C, L, a.in, ws); REPBAR(0); }
    SEAM(0);
    if (IN(1)) {
        quant_wrows(C, (const f16*)(ws + WS_WCAT), NCAT, (unsigned*)(ws + WS_WCATQ), (float*)(ws + WS_WCS));
        quant_wrows(C, (const f16*)(ws + WS_WQ), 2048, (unsigned*)(ws + WS_WQQ), (float*)(ws + WS_WQS));
        xcd_barrier(bar);
        pg8::Gemm g{(const f16*)(ws + WS_XH), (const f16*)(ws + WS_WCATQ), T, NCAT, DM / 2}; pg8::StaticOrder S; S.init(T, NCAT, G, (int)blockIdx.x);
        pg8::EpiP1 E{(const float*)(ws + WS_RS1), (const float*)(ws + WS_RSX), (const float*)(ws + WS_WCS), a.in[8], (f16*)(ws + WS_QKVU), (f16*)(ws + WS_GATES), (f16*)(ws + WS_VT)};
        pg8::gemm_phase<pg8::EpiP1, pg8::StaticOrder, true, true>(L, g, S, E);
    }
    SEAM(1);
    if (IN(2)) REPS(2) {
        ph_attn_pool(C, L, (const f16*)(ws + WS_QKVU), (const f16*)(ws + WS_VT), a.in[3], (const f16*)(ws + WS_POOLW), a.in[5], (f16*)(ws + WS_OCAT));
        REPBAR(2);
    }
    if (IN(2) && IN(4)) xcd_barrier(bar);
    if (IN(4)) REPS(4) {
        pg8::Gemm g{(const f16*)(ws + WS_OCAT), (const f16*)(ws + WS_WB), T, DM, DM}; pg8::StaticOrder S; S.init(T, DM, G, (int)blockIdx.x);
        pg8::EpiMerged E{(const f16*)(ws + WS_GATES), (f16*)(ws + WS_MERGED)};
        pg8::gemm_phase<pg8::EpiMerged, pg8::StaticOrder, true, true>(L, g, S, E);
        REPBAR(4);
    }
    SEAM(4);
    if (IN(5)) REPS(5) {
        pg8::Gemm g{(const f16*)(ws + WS_MERGED), (const f16*)(ws + WS_WOUT), T, DM, DM}; pg8::StaticOrder S; S.init(T, DM, G, (int)blockIdx.x);
        pg8::EpiOut E{a.in[0], a.in[10], a.out, (f16*)(ws + WS_X1H), (float*)(ws + WS_SS2)};
        pg8::gemm_phase<pg8::EpiOut, pg8::StaticOrder, true, true>(L, g, S, E);
        REPBAR(5);
    }
    SEAM(5);
    if (IN(6)) {
        ph_h2quant(C, (const f16*)(ws + WS_X1H), (const float*)(ws + WS_SS2), (unsigned*)(ws + WS_H2Q), (float*)(ws + WS_HSC));
        xcd_barrier(bar);
        pg8::Gemm g{(const f16*)(ws + WS_H2Q), (const f16*)(ws + WS_WQQ), T, 2048, DM / 2}; pg8::StaticOrder S; S.init(T, 2048, G, (int)blockIdx.x);
        pg8::EpiQ E{(const float*)(ws + WS_HSC), (const float*)(ws + WS_WQS), (f16*)(ws + WS_QP)};
        pg8::gemm_phase<pg8::EpiQ, pg8::StaticOrder, true, true>(L, g, S, E);
    }
    SEAM(6);
    if (IN(7)) REPS(7) {
        auto side = [&]() {
            quant_rows<false>(C, a.in[13], (unsigned*)(ws + WS_UQ), (float*)(ws + WS_US));
            quant_rows<false>(C, a.in[14], (unsigned*)(ws + WS_VQ), (float*)(ws + WS_VS));
        };
        ph_route(C, L, (const f16*)(ws + WS_QP), (const float*)(ws + WS_SS2), (const f16*)(ws + WS_SUBK), (int*)(ws + WS_EIDX), (float*)(ws + WS_EGATE), side);
        if (!(C.wave & 4)) side();
        REPBAR(7); }
    SEAM(7);
    if (IN(8)) REPS(8) {
        const Slicing SL = get_slicing((const unsigned*)(ws + WS_CTL) + CW_BAR, MISC);
        if (PROBE_DUP == 8 && rep_ == 0) ph_upeer<255>(C, L, SL, (const unsigned*)(ws + WS_H2Q), (const int*)(ws + WS_EIDX), (const unsigned char*)(ws + WS_UQ), (short*)(ws + WS_PDOT));
        else ph_upeer<16383>(C, L, SL, (const unsigned*)(ws + WS_H2Q), (const int*)(ws + WS_EIDX), (const unsigned char*)(ws + WS_UQ), (short*)(ws + WS_PDOT));
        REPBAR(8);
    }
    SEAM(8);
    if (IN(9)) {
        ph_ureduce(C, L, (const short*)(ws + WS_PDOT), (const float*)(ws + WS_HSC), (const int*)(ws + WS_EIDX), (const float*)(ws + WS_US), (const float*)(ws + WS_VS), (const float*)(ws + WS_EGATE),
                   (unsigned*)(ws + WS_WQP), (float*)(ws + WS_WSC));
        xcd_barrier(bar);
        const Slicing SL = get_slicing((const unsigned*)(ws + WS_CTL) + CW_BAR, MISC);
        ph_vpeer<16383>(C, SL, (const int*)(ws + WS_EIDX), (const unsigned*)(ws + WS_WQP), (const float*)(ws + WS_WSC), (const unsigned char*)(ws + WS_VQ), (f16*)(ws + WS_PEER));
    }
    SEAM(9);
    if (IN(10)) { ph_final(C, (const f16*)(ws + WS_PEER), a.out, a.in[15]); }
#undef IN
#undef SEAM
}

#ifndef MK_N_LAUNCHES
#define MK_N_LAUNCHES 1
#endif
extern "C" void kernel_launch(void* const* d_in, const int* in_sizes, int n_in, void* d_out, int out_size, void* d_ws, size_t ws_size, hipStream_t stream) {
    static int grid = 0;
    if (grid == 0) {
        if (n_in != 16 || in_sizes[0] != T * DM || out_size != T * DM || ws_size < WS_END) {
            fprintf(stderr, "kernel_launch: unexpected shapes (n_in %d in0 %d out %d ws %zu)\n", n_in, n_in > 0 ? in_sizes[0] : -1, out_size, ws_size);
            grid = -1; return;
        }
        int dev = 0, cus = 0;
        if (hipGetDevice(&dev) != hipSuccess || hipDeviceGetAttribute(&cus, hipDeviceAttributeMultiprocessorCount, dev) != hipSuccess) { grid = -1; return; }
        if (hipFuncSetAttribute((const void*)mk_fwd, hipFuncAttributeMaxDynamicSharedMemorySize, LDS_BYTES) != hipSuccess) { fprintf(stderr, "kernel_launch: hipFuncSetAttribute failed\n"); grid = -1; return; }
        int per_cu = 0;
        if (hipOccupancyMaxActiveBlocksPerMultiprocessor(&per_cu, (const void*)mk_fwd, NTHREADS, LDS_BYTES) != hipSuccess || per_cu < 1)
            fprintf(stderr, "kernel_launch: occupancy query reports %d workgroups per CU\n", per_cu);
        (void)hipGetLastError();
        grid = cus;
    }
    if (grid < 0) return;
    (void)hipMemsetAsync((char*)d_ws + WS_CTL, 0, CTL_ZERO_BYTES, stream);
    Args a{};
    for (int i = 0; i < 16; ++i) a.in[i] = (const float*)d_in[i];
    a.out = (float*)d_out; a.ws = (unsigned char*)d_ws;
    if (MK_N_LAUNCHES == 1) {
        a.ph_lo = 0; a.ph_hi = N_PHASES;
        hipLaunchKernelGGL(mk_fwd, dim3(grid), dim3(NTHREADS), LDS_BYTES, stream, a);
    } else {
        for (int p = 0; p < N_PHASES; ++p) { a.ph_lo = p; a.ph_hi = p + 1; hipLaunchKernelGGL(mk_fwd, dim3(grid), dim3(NTHREADS), LDS_BYTES, stream, a); }
    }
}
```

```cpp
#include <hip/hip_runtime.h>
#include <cstdint>
#include <cstdio>

typedef _Float16 f16;
typedef _Float16 half8 __attribute__((ext_vector_type(8)));
typedef _Float16 half4 __attribute__((ext_vector_type(4)));
typedef _Float16 half2 __attribute__((ext_vector_type(2)));
typedef float f32x4 __attribute__((ext_vector_type(4)));
typedef float f32x16 __attribute__((ext_vector_type(16)));
typedef unsigned u32x4 __attribute__((ext_vector_type(4)));
typedef int i32x4 __attribute__((ext_vector_type(4)));
#define LAS __attribute__((address_space(3)))
#ifndef PROBE_DIAG
#define PROBE_DIAG (0)
#endif
#ifndef PROBE_DUP
#define PROBE_DUP (-1)
#endif
#define GAS __attribute__((address_space(1)))

constexpr int DM = 1024, BATCH = 16, SEQ = 2048, T = BATCH * SEQ;
constexpr int NQKVU = 1280, NGATE = 2048, NCAT = NQKVU + NGATE;
constexpr int COL_K = 512, COL_V = 640, COL_U = 768;
constexpr int NEXP = 16384, PEER_H = 8, TOPK = 16;
constexpr float EPS = 1e-6f;
constexpr int NWAVES = 8, NTHREADS = NWAVES * 64;

constexpr size_t MiB = 1u << 20;
constexpr size_t WS_CTL = 0, CTL_ZERO_BYTES = 64 * 1024;
constexpr size_t WS_WCAT = 1 * MiB;
constexpr size_t WS_WB = 8 * MiB;
constexpr size_t WS_WOUT = 10 * MiB;
constexpr size_t WS_WQ = 12 * MiB;
constexpr size_t WS_POOLW = 16 * MiB;
constexpr size_t WS_SUBK = 16 * MiB + 512 * 1024;
constexpr size_t WS_RS1 = 17 * MiB;
constexpr size_t WS_EIDX = 18 * MiB;
constexpr size_t WS_EGATE = 34 * MiB;
constexpr size_t WS_WCATQ = 50 * MiB;
constexpr size_t WS_WCS = 54 * MiB;
constexpr size_t WS_WQQ = 56 * MiB;
constexpr size_t WS_WQS = 59 * MiB;
constexpr size_t WS_RSX = 55 * MiB;
constexpr size_t WS_UTAB = 50 * MiB;
constexpr size_t WS_VTAB = 82 * MiB;
constexpr size_t WS_XH = 114 * MiB;
constexpr size_t WS_MERGED = WS_XH;
constexpr size_t WS_QKVU = 178 * MiB;
constexpr size_t WS_X1H = WS_QKVU;
constexpr size_t WS_PEER = WS_QKVU;
constexpr size_t WS_GATES = 258 * MiB;
constexpr size_t WS_QP = WS_GATES;
constexpr size_t WS_OCAT = 386 * MiB;
constexpr size_t WS_UQ = 450 * MiB;
constexpr size_t WS_VQ = 466 * MiB;
constexpr size_t WS_US = 17 * MiB + 256 * 1024, WS_VS = 17 * MiB + 512 * 1024;
constexpr size_t WS_PDOT = WS_GATES;
constexpr size_t WS_H2Q = 404 * MiB;
constexpr size_t WS_HSC = 403 * MiB;
constexpr size_t WS_SSF = 402 * MiB;
constexpr size_t WS_WQP = 386 * MiB;
constexpr size_t WS_WSC = 390 * MiB;
constexpr size_t WS_ACT = 386 * MiB;
constexpr size_t WS_SS2 = 482 * MiB;
constexpr size_t WS_VT = 484 * MiB;
constexpr size_t WS_END = 492 * MiB;
constexpr int CW_BAR = 4096;

constexpr int RING_OFF = 0, RING_BYTES = 131072;
constexpr int LDSCTL_OFF = RING_BYTES, MISC_OFF = LDSCTL_OFF + 320;
constexpr int LDS_BYTES = 147456;

#define LDS_WAIT() asm volatile("s_waitcnt lgkmcnt(0)" ::: "memory")
template <int CTRL> __device__ __forceinline__ float dppf(float x) { return __uint_as_float(__builtin_amdgcn_update_dpp(0u, __float_as_uint(x), CTRL, 0xf, 0xf, false)); }
template <int CTRL> __device__ __forceinline__ int dppi(int x) { return (int)__builtin_amdgcn_update_dpp(0u, (unsigned)x, CTRL, 0xf, 0xf, false); }
__device__ __forceinline__ float bfly32(float a, float b) { auto r = __builtin_amdgcn_permlane32_swap(__float_as_uint(a), __float_as_uint(b), false, false); return __uint_as_float(r[0]) + __uint_as_float(r[1]); }
__device__ __forceinline__ float bfly16(float a, float b) { auto r = __builtin_amdgcn_permlane16_swap(__float_as_uint(a), __float_as_uint(b), false, false); return __uint_as_float(r[0]) + __uint_as_float(r[1]); }
__device__ __forceinline__ int bfly32i(int a, int b) { auto r = __builtin_amdgcn_permlane32_swap((unsigned)a, (unsigned)b, false, false); return (int)(r[0] + r[1]); }
__device__ __forceinline__ int bfly16i(int a, int b) { auto r = __builtin_amdgcn_permlane16_swap((unsigned)a, (unsigned)b, false, false); return (int)(r[0] + r[1]); }
__device__ __forceinline__ float wave_sum(float x) {
    x += dppf<0x121>(x); x += dppf<0x122>(x); x += dppf<0x124>(x); x += dppf<0x128>(x);
    x = bfly16(x, x); return bfly32(x, x);
}
__device__ __forceinline__ int wave_sum_i(int x) {
    x += dppi<0x121>(x); x += dppi<0x122>(x); x += dppi<0x124>(x); x += dppi<0x128>(x);
    x = bfly16i(x, x); return bfly32i(x, x);
}
__device__ __forceinline__ float wave_max(float x) {
    x = fmaxf(x, dppf<0x121>(x)); x = fmaxf(x, dppf<0x122>(x)); x = fmaxf(x, dppf<0x124>(x)); x = fmaxf(x, dppf<0x128>(x));
    { auto r = __builtin_amdgcn_permlane16_swap(__float_as_uint(x), __float_as_uint(x), false, false); x = fmaxf(__uint_as_float(r[0]), __uint_as_float(r[1])); }
    { auto r = __builtin_amdgcn_permlane32_swap(__float_as_uint(x), __float_as_uint(x), false, false); x = fmaxf(__uint_as_float(r[0]), __uint_as_float(r[1])); }
    return x;
}
__device__ __forceinline__ float gelu_exact(float x) { return 0.5f * x * (1.0f + erff(x * 0.70710678118654752f)); }
__device__ __forceinline__ float rs_from_ss(const float* ss, int t) {
    float s = 0.f;
#pragma unroll
    for (int i = 0; i < 16; ++i) s += ss[(size_t)i * T + t];
    return rsqrtf(s * (1.0f / DM) + EPS);
}

struct Ctx {
    int tid, lane, wave;
    int G;
    int gw, ngw;
    int gt, ngt;
};

__device__ __forceinline__ int pack4_i8(float a, float b, float c, float d) {
    const int ia = (int)rintf(a), ib = (int)rintf(b), ic = (int)rintf(c), id = (int)rintf(d);
    return (ia & 0xff) | ((ib & 0xff) << 8) | ((ic & 0xff) << 16) | (id << 24);
}
template <bool OFFS>
__device__ __forceinline__ void quant_rows(const Ctx& C, const float* __restrict__ tab, unsigned* __restrict__ q, float* __restrict__ scale) {
    const int lane = C.lane;
    for (int r = C.gw; r < NEXP; r += C.ngw) {
        const float* row = tab + (size_t)r * DM;
        f32x4 v[4]; float m = 0.f;
#pragma unroll
        for (int j = 0; j < 4; ++j) { v[j] = *(const f32x4*)(row + j * 256 + lane * 4); m = fmaxf(m, fmaxf(fmaxf(fabsf(v[j][0]), fabsf(v[j][1])), fmaxf(fabsf(v[j][2]), fabsf(v[j][3])))); }
        m = wave_max(m);
        const float inv = m > 0.f ? 127.0f / m : 0.f;
#pragma unroll
        for (int j = 0; j < 4; ++j) {
            unsigned w = (unsigned)pack4_i8(v[j][0] * inv, v[j][1] * inv, v[j][2] * inv, v[j][3] * inv);
            if (OFFS) w ^= 0x80808080u;
            { const int dw = j * 64 + lane; q[(size_t)(dw >> 5) * (NEXP * 32) + (size_t)r * 32 + (dw & 31)] = w; }
        }
        if (lane == 0) scale[r] = m * (1.0f / 127.0f);
    }
}

__device__ __forceinline__ void p0_transpose_item(const float* W, int K, int N, f16* WT, int ldo, int koff, LAS float* scr, int item, int lane) {
    const int nblk = N / 32, kb = item / nblk, nb = item % nblk, k0 = 64 * kb, n0 = 32 * nb;
#pragma unroll 8
    for (int i = 0; i < 32; ++i) { const int kk = 2 * i + (lane >> 5); scr[kk * 33 + (lane & 31)] = W[(size_t)(k0 + kk) * N + n0 + (lane & 31)]; }
    LDS_WAIT(); asm volatile("" ::: "memory");
    const int c = lane & 7;
#pragma unroll
    for (int j = 0; j < 4; ++j) { const int n = (lane >> 3) + 8 * j; const LAS float* s = scr + (8 * c) * 33 + n;
        half8 o;
#pragma unroll
        for (int i = 0; i < 8; ++i) o[i] = (f16)s[i * 33];
        *(half8*)(WT + (size_t)(n0 + n) * ldo + koff + k0 + 8 * c) = o; }
    LDS_WAIT(); asm volatile("" ::: "memory");
}
__device__ __forceinline__ void cvt_stream(const Ctx& C, const float* in, f16* out, size_t n4) {
    for (size_t i = (size_t)C.gt; i < n4; i += (size_t)C.ngt) {
        const f32x4 v = ((const f32x4*)in)[i];
        half4 h; h[0] = (f16)v[0]; h[1] = (f16)v[1]; h[2] = (f16)v[2]; h[3] = (f16)v[3];
        ((half4*)out)[i] = h;
    }
}
__device__ __forceinline__ void rowprep(const Ctx& C, const float* x, const float* g, unsigned* xq, float* rsx, float* ss) {
    const int lane = C.lane;
    f32x4 gg[4];
#pragma unroll
    for (int j = 0; j < 4; ++j) gg[j] = *(const f32x4*)(g + j * 256 + lane * 4);
    for (int tb = C.gw * 4; tb < T; tb += C.ngw * 4) {
        f32x4 v[4][4];
#pragma unroll
        for (int u = 0; u < 4; ++u)
#pragma unroll
            for (int j = 0; j < 4; ++j) v[u][j] = *(const f32x4*)(x + (size_t)(tb + u) * DM + j * 256 + lane * 4);
#pragma unroll
        for (int u = 0; u < 4; ++u) {
            float s = 0.f, am = 0.f;
#pragma unroll
            for (int j = 0; j < 4; ++j) {
                const f32x4 w = v[u][j];
                s += w[0] * w[0] + w[1] * w[1] + w[2] * w[2] + w[3] * w[3];
                v[u][j] = w * gg[j];
                am = fmaxf(am, fmaxf(fmaxf(fabsf(v[u][j][0]), fabsf(v[u][j][1])), fmaxf(fabsf(v[u][j][2]), fabsf(v[u][j][3]))));
            }
            s = wave_sum(s); am = wave_max(am);
            const float inv = am > 0.f ? 127.0f / am : 0.f;
#pragma unroll
            for (int j = 0; j < 4; ++j) xq[(size_t)(tb + u) * 256 + j * 64 + lane] = (unsigned)pack4_i8(v[u][j][0] * inv, v[u][j][1] * inv, v[u][j][2] * inv, v[u][j][3] * inv);
            if (lane == 0) { ss[tb + u] = s; rsx[tb + u] = am * (1.0f / 127.0f); }
        }
    }
}
__device__ __forceinline__ void quant_wrows(const Ctx& C, const f16* __restrict__ w, int rows, unsigned* __restrict__ q, float* __restrict__ scale) {
    const int lane = C.lane;
    for (int r = C.gw; r < rows; r += C.ngw) {
        const half8 a = *(const half8*)(w + (size_t)r * DM + 16 * lane), b = *(const half8*)(w + (size_t)r * DM + 16 * lane + 8);
        float m = 0.f;
#pragma unroll
        for (int i = 0; i < 8; ++i) m = fmaxf(m, fmaxf(fabsf((float)a[i]), fabsf((float)b[i])));
        m = wave_max(m);
        const float inv = m > 0.f ? 127.0f / m : 0.f;
        u32x4 o;
        o[0] = (unsigned)pack4_i8((float)a[0] * inv, (float)a[1] * inv, (float)a[2] * inv, (float)a[3] * inv);
        o[1] = (unsigned)pack4_i8((float)a[4] * inv, (float)a[5] * inv, (float)a[6] * inv, (float)a[7] * inv);
        o[2] = (unsigned)pack4_i8((float)b[0] * inv, (float)b[1] * inv, (float)b[2] * inv, (float)b[3] * inv);
        o[3] = (unsigned)pack4_i8((float)b[4] * inv, (float)b[5] * inv, (float)b[6] * inv, (float)b[7] * inv);
        *(u32x4*)(q + (size_t)r * 256 + 4 * lane) = o;
        if (lane == 0) scale[r] = m * (1.0f / 127.0f);
    }
}
__device__ __forceinline__ void ph_prep(const Ctx& C, LAS unsigned char* lds, const float* const* in, unsigned char* ws) {
    LAS float* scr = (LAS float*)(lds + RING_OFF + C.wave * 16384);
    f16* wcat = (f16*)(ws + WS_WCAT); f16* wb = (f16*)(ws + WS_WB); f16* wout = (f16*)(ws + WS_WOUT); f16* wq = (f16*)(ws + WS_WQ); f16* poolw = (f16*)(ws + WS_POOLW);
    constexpr int I_IN = 16 * 40, I_G = 16 * 64, I_B = 8 * 32, I_O = 16 * 32, I_Q = 16 * 64, I_P = 2 * 4;
    constexpr int NITEMS = I_IN + I_G + 2 * I_B + I_O + I_Q + 4 * I_P;
    for (int it = C.gw; it < NITEMS; it += C.ngw) {
        int r = it;
        if (r < I_IN) { p0_transpose_item(in[2], 1024, 1280, wcat, 1024, 0, scr, r, C.lane); continue; } r -= I_IN;
        if (r < I_G) { p0_transpose_item(in[7], 1024, 2048, wcat + (size_t)NQKVU * 1024, 1024, 0, scr, r, C.lane); continue; } r -= I_G;
        if (r < I_B) { p0_transpose_item(in[6], 512, 1024, wb, 1024, 0, scr, r, C.lane); continue; } r -= I_B;
        if (r < I_B) { p0_transpose_item(in[6] + 512 * 1024, 512, 1024, wb, 1024, 512, scr, r, C.lane); continue; } r -= I_B;
        if (r < I_O) { p0_transpose_item(in[9], 1024, 1024, wout, 1024, 0, scr, r, C.lane); continue; } r -= I_O;
        if (r < I_Q) { p0_transpose_item(in[11], 1024, 2048, wq, 1024, 0, scr, r, C.lane); continue; } r -= I_Q;
        { const int g = r / I_P; p0_transpose_item(in[4] + g * 128 * 128, 128, 128, poolw + g * 128 * 128, 128, 0, scr, r % I_P, C.lane); }
    }
    cvt_stream(C, in[12], (f16*)(ws + WS_SUBK), (size_t)8 * 2 * 128 * 128 / 4);
    rowprep(C, in[0], in[1], (unsigned*)(ws + WS_XH), (float*)(ws + WS_RSX), (float*)(ws + WS_RS1));
}

__device__ __forceinline__ void ph_attn_naive(const Ctx& C, const f16* __restrict__ qkvu, const float* __restrict__ sink, f16* __restrict__ ocat) {
    for (int gid = C.gt; gid < T * 8; gid += C.ngt) {
        const int t = gid % T, h = gid / T;
        const int b = t / SEQ, ts = t % SEQ, kh = h >> 2;
        float q[64], o[64];
        const f16* qr = qkvu + (size_t)t * NQKVU + h * 64;
#pragma unroll
        for (int d = 0; d < 64; ++d) { q[d] = (float)qr[d]; o[d] = 0.f; }
        const float slope = exp2f(-(float)(h + 1));
        float m = -1e30f, l = 0.f;
        const int s0 = max(ts - 128, 0), s1 = min(ts + 128, SEQ - 1);
        for (int s = s0; s <= s1; ++s) {
            const f16* kr = qkvu + (size_t)(b * SEQ + s) * NQKVU + COL_K + kh * 64;
            const f16* vr = qkvu + (size_t)(b * SEQ + s) * NQKVU + COL_V + kh * 64;
            float dot = 0.f;
#pragma unroll
            for (int d = 0; d < 64; ++d) dot += q[d] * (float)kr[d];
            const float lg = dot * 0.125f - slope * fabsf((float)(ts - s));
            const float mn = fmaxf(m, lg), al = __expf(m - mn), p = __expf(lg - mn);
            l = l * al + p;
#pragma unroll
            for (int d = 0; d < 64; ++d) o[d] = o[d] * al + p * (float)vr[d];
            m = mn;
        }
        const float sk = sink[h];
        const float mn = fmaxf(m, sk), al = __expf(m - mn);
        l = l * al + __expf(sk - mn);
        const float inv = al / l;
        f16* orow = ocat + (size_t)t * DM + h * 64;
#pragma unroll
        for (int d = 0; d < 64; ++d) orow[d] = (f16)(o[d] * inv);
    }
}

template <int DIAG = 0>
__device__ __forceinline__ void attn_unit(const Ctx& C, int u, LAS unsigned char* lds, const f16* __restrict__ qkvu, const f16* __restrict__ vT, const float* __restrict__ sink, f16* __restrict__ ocat) {
    const int lane = C.lane, r32 = lane & 31, hh = lane >> 5;
    const int krow = (r32 & 19) | ((r32 & 4) << 1) | ((r32 & 8) >> 1);
    constexpr float L2E = 1.4426950408889634f;
    {
        const int qs = u & 63, h = (u >> 6) & 7, b = u >> 9, kh = h >> 2;
        const int tq = qs * 32 + r32;
        const float slope2 = exp2f(-(float)(h + 1)) * L2E, sink2 = sink[h] * L2E;
        const f16* qrow = qkvu + (size_t)(b * SEQ + tq) * NQKVU + h * 64 + 8 * hh;
        half8 bq[4];
#pragma unroll
        for (int ks = 0; ks < 4; ++ks) bq[ks] = *(const half8*)(qrow + 16 * ks);
        f32x16 o0, o1;
#pragma unroll
        for (int r = 0; r < 16; ++r) { o0[r] = 0.f; o1[r] = 0.f; }
        float m = -1e30f, l = 0.f;
        const int kb_lo = max(qs - 4, 0), kb_hi = min(qs + 4, 63);
        LAS unsigned char* kst = lds + 65536 + C.wave * 8192; LAS unsigned char* vst = kst + 4096;
        const int krw = lane >> 3, kch = lane & 7, vrw = lane >> 2, vch = lane & 3;
        const f16* kg = qkvu + (size_t)(b * SEQ + krw) * NQKVU + COL_K + kh * 64 + kch * 8;
        const f16* vg = vT + (size_t)((b * 2 + kh) * 64 + vrw) * SEQ + vch * 8;
        half8 gk[4], gv[4];
#pragma unroll
        for (int i = 0; i < 4; ++i) { gk[i] = *(const half8*)(kg + (size_t)(kb_lo * 32 + 8 * i) * NQKVU); gv[i] = *(const half8*)(vg + (size_t)(16 * i) * SEQ + kb_lo * 32); }
#pragma unroll 1
        for (int kb = kb_lo; kb <= kb_hi; ++kb) {
#pragma unroll
            for (int i = 0; i < 4; ++i) {
                const int kr = krw + 8 * i; *(LAS half8*)(kst + kr * 128 + ((kch ^ (kr & 7)) << 4)) = gk[i];
                const int vr = vrw + 16 * i; *(LAS half8*)(vst + vr * 64 + ((vch ^ ((vr >> 2) & 3)) << 4)) = gv[i];
            }
            LDS_WAIT();
            half8 kf[4], va[2][2];
#pragma unroll
            for (int ks = 0; ks < 4; ++ks) kf[ks] = *(const LAS half8*)(kst + krow * 128 + (((2 * ks + hh) ^ (krow & 7)) << 4));
#pragma unroll
            for (int db = 0; db < 2; ++db)
#pragma unroll
                for (int st = 0; st < 2; ++st) { const int d = db * 32 + r32; va[db][st] = *(const LAS half8*)(vst + d * 64 + (((2 * st + hh) ^ ((d >> 2) & 3)) << 4)); }
            LDS_WAIT();
            const int kn = (DIAG == 2) ? kb_lo : (kb < kb_hi ? kb + 1 : kb);
#pragma unroll
            for (int i = 0; i < 4; ++i) { gk[i] = *(const half8*)(kg + (size_t)(kn * 32 + 8 * i) * NQKVU); gv[i] = *(const half8*)(vg + (size_t)(16 * i) * SEQ + kn * 32); }
            f32x16 s;
#pragma unroll
            for (int r = 0; r < 16; ++r) s[r] = 0.f;
#pragma unroll
            for (int ks = 0; ks < 4; ++ks) s = __builtin_amdgcn_mfma_f32_32x32x16_f16(kf[ks], bq[ks], s, 0, 0, 0);
            float bmax = -1e30f; bool ok[16];
#pragma unroll
            for (int r = 0; r < 16; ++r) {
                const int tk = kb * 32 + 16 * (r >> 3) + 8 * hh + (r & 7);
                const int dist = abs(tq - tk);
                ok[r] = dist <= 128;
                s[r] = ok[r] ? s[r] * (0.125f * L2E) - slope2 * (float)dist : -1e30f;
                bmax = fmaxf(bmax, s[r]);
            }
            bmax = fmaxf(bmax, __shfl_xor(bmax, 32));
            const float mn = fmaxf(m, bmax), al = exp2f(m - mn);
            m = mn;
            float ps = 0.f; half8 pb[2];
#pragma unroll
            for (int r = 0; r < 16; ++r) { const float p = ok[r] ? (DIAG == 1 ? (s[r] - mn) : exp2f(s[r] - mn)) : 0.f; ps += p; pb[r >> 3][r & 7] = (f16)p; }
            l = l * al + ps;
#pragma unroll
            for (int r = 0; r < 16; ++r) { o0[r] *= al; o1[r] *= al; }
#pragma unroll
            for (int st = 0; st < 2; ++st) { o0 = __builtin_amdgcn_mfma_f32_32x32x16_f16(va[0][st], pb[st], o0, 0, 0, 0); o1 = __builtin_amdgcn_mfma_f32_32x32x16_f16(va[1][st], pb[st], o1, 0, 0, 0); }
        }
        l += __shfl_xor(l, 32);
        const float mf = fmaxf(m, sink2), al = exp2f(m - mf);
        const float sc = al / (l * al + exp2f(sink2 - mf));
        f16* orow = ocat + (size_t)(b * SEQ + tq) * DM + h * 64 + 4 * hh;
#pragma unroll
        for (int g = 0; g < 4; ++g) {
            half4 a, c;
#pragma unroll
            for (int i = 0; i < 4; ++i) { a[i] = (f16)(o0[4 * g + i] * sc); c[i] = (f16)(o1[4 * g + i] * sc); }
            *(half4*)(orow + 8 * g) = a; *(half4*)(orow + 32 + 8 * g) = c;
        }
    }
}

__device__ __forceinline__ void ph_pool_naive(const Ctx& C, const f16* __restrict__ qkvu, f16* __restrict__ mixed) {
    for (size_t gid = (size_t)C.gt; gid < (size_t)T * 512; gid += (size_t)C.ngt) {
        const int c = (int)(gid & 511), t = (int)(gid >> 9);
        const int b = t / SEQ, ts = t % SEQ, g = c >> 7, w = 2 << g;
        const int lo = max(ts - w / 2, 0), hi = min(ts + w / 2, SEQ);
        float s = 0.f;
        for (int i = lo; i < hi; ++i) s += (float)qkvu[(size_t)(b * SEQ + i) * NQKVU + COL_U + c];
        const float mean = s / (float)(hi - lo);
        mixed[(size_t)t * 512 + c] = (f16)(mean - (float)qkvu[(size_t)t * NQKVU + COL_U + c]);
    }
}
__device__ __forceinline__ void ph_poolmm_naive(const Ctx& C, const f16* __restrict__ mixed, const f16* __restrict__ poolw_t, const float* __restrict__ pscale, f16* __restrict__ ocat) {
    for (size_t gid = (size_t)C.gt; gid < (size_t)T * 512; gid += (size_t)C.ngt) {
        const int n = (int)(gid & 511), t = (int)(gid >> 9), g = n >> 7, d = n & 127;
        const f16* mr = mixed + (size_t)t * 512 + g * 128;
        const f16* wr = poolw_t + (size_t)(g * 128 + d) * 128;
        float acc = 0.f;
        for (int c = 0; c < 128; ++c) acc += (float)mr[c] * (float)wr[c];
        ocat[(size_t)t * DM + 512 + n] = (f16)(acc * pscale[n]);
    }
}

template <int HW>
__device__ __forceinline__ void pool_step1(const f16* __restrict__ qkvu, LAS unsigned char* tile, int t0, int g, int lane) {
    const int c2 = lane, b = t0 >> 11, sf = t0 & (SEQ - 1);
    const f16* ub = qkvu + (size_t)(b * SEQ) * NQKVU + COL_U + g * 128 + 2 * c2;
    constexpr int NR = 32 + 2 * HW - 1;
    half2 v[NR];
#pragma unroll
    for (int i = 0; i < NR; ++i) { const int s = sf - HW + i; half2 z; z[0] = (f16)0.f; z[1] = (f16)0.f; v[i] = z; if (s >= 0 && s < SEQ) v[i] = *(const half2*)(ub + (size_t)s * NQKVU); }
    float s0 = 0.f, s1 = 0.f;
#pragma unroll
    for (int i = 0; i < 2 * HW - 1; ++i) { s0 += (float)v[i][0]; s1 += (float)v[i][1]; }
#pragma unroll
    for (int j = 0; j < 32; ++j) {
        s0 += (float)v[j + 2 * HW - 1][0]; s1 += (float)v[j + 2 * HW - 1][1];
        const int s = sf + j, lo = max(s - HW, 0), hi = min(s + HW, SEQ);
        const float inv = 1.0f / (float)(hi - lo);
        half2 mx; mx[0] = (f16)(s0 * inv - (float)v[j + HW][0]); mx[1] = (f16)(s1 * inv - (float)v[j + HW][1]);
        *(LAS half2*)(tile + j * 256 + (((c2 >> 2) ^ (j & 15)) << 4) + ((c2 & 3) << 2)) = mx;
        s0 -= (float)v[j][0]; s1 -= (float)v[j][1];
    }
}
__device__ __forceinline__ void pool_unit(const Ctx& C, int u, LAS unsigned char* lds, const f16* __restrict__ qkvu, const f16* __restrict__ poolw_t, const float* __restrict__ pscale, f16* __restrict__ ocat) {
    const int lane = C.lane, r32 = lane & 31, hh = lane >> 5;
    LAS unsigned char* tile = lds + C.wave * 8192;
    const int g = u & 3, t0 = (u >> 2) * 32;
    switch (g) { case 0: pool_step1<1>(qkvu, tile, t0, g, lane); break; case 1: pool_step1<2>(qkvu, tile, t0, g, lane); break;
                 case 2: pool_step1<4>(qkvu, tile, t0, g, lane); break; default: pool_step1<8>(qkvu, tile, t0, g, lane); break; }
    LDS_WAIT();
    f32x16 acc[4];
#pragma unroll
    for (int db = 0; db < 4; ++db)
#pragma unroll
        for (int r = 0; r < 16; ++r) acc[db][r] = 0.f;
    const f16* wr = poolw_t + (size_t)(g * 128 + r32) * 128 + 8 * hh;
#pragma unroll
    for (int ks = 0; ks < 8; ++ks) {
        const half8 bm = *(const LAS half8*)(tile + r32 * 256 + (((2 * ks + hh) ^ (r32 & 15)) << 4));
#pragma unroll
        for (int db = 0; db < 4; ++db) { const half8 a = *(const half8*)(wr + (size_t)(db * 32) * 128 + 16 * ks); acc[db] = __builtin_amdgcn_mfma_f32_32x32x16_f16(a, bm, acc[db], 0, 0, 0); }
    }
    LDS_WAIT();
    f16* orow = ocat + (size_t)(t0 + r32) * DM + 512 + g * 128 + 4 * hh;
    const float* ps = pscale + g * 128 + 4 * hh;
#pragma unroll
    for (int db = 0; db < 4; ++db)
#pragma unroll
        for (int q = 0; q < 4; ++q) {
            const f32x4 pv = *(const f32x4*)(ps + db * 32 + 8 * q);
            half4 x0;
#pragma unroll
            for (int i = 0; i < 4; ++i) x0[i] = (f16)(acc[db][4 * q + i] * pv[i]);
            *(half4*)(orow + db * 32 + 8 * q) = x0;
        }
}
__device__ __forceinline__ void ph_attn_pool(const Ctx& C, LAS unsigned char* lds, const f16* __restrict__ qkvu, const f16* __restrict__ vT, const float* __restrict__ sink,
                                             const f16* __restrict__ poolw_t, const float* __restrict__ pscale, f16* __restrict__ ocat) {
    const int vwg = (C.G % 8 == 0) ? (int)(blockIdx.x % 8) * (C.G / 8) + (int)(blockIdx.x / 8) : (int)blockIdx.x;
    for (int m = vwg * NWAVES + C.wave; m < (T / 32) * 4; m += C.ngw) {
        if (C.wave & 4) pool_unit(C, m, lds, qkvu, poolw_t, pscale, ocat);
        attn_unit<0>(C, 2 * m, lds, qkvu, vT, sink, ocat);
        attn_unit<0>(C, 2 * m + 1, lds, qkvu, vT, sink, ocat);
        if (!(C.wave & 4)) pool_unit(C, m, lds, qkvu, poolw_t, pscale, ocat);
    }
}

#define INS(LV, LI, v_, i_) do { float cv_ = (v_); int ci_ = (i_); \
    _Pragma("unroll") for (int z_ = 0; z_ < 16; ++z_) { const bool gt_ = cv_ > LV[z_]; const float tv_ = gt_ ? LV[z_] : cv_; const int ti_ = gt_ ? LI[z_] : ci_; \
        LV[z_] = gt_ ? cv_ : LV[z_]; LI[z_] = gt_ ? ci_ : LI[z_]; cv_ = tv_; ci_ = ti_; } } while (0)
__device__ __forceinline__ void ph_route_naive(const Ctx& C, const f16* __restrict__ qp, const float* __restrict__ ss2, const f16* __restrict__ subk, int* __restrict__ eidx, float* __restrict__ egate) {
    for (int gid = C.gt; gid < T * 8; gid += C.ngt) {
        const int t = gid % T, h = gid / T;
        const float rs2 = rs_from_ss(ss2, t);
        float av[16], bv[16]; int ai[16], bi[16];
#pragma unroll
        for (int z = 0; z < 16; ++z) { av[z] = -3e38f; bv[z] = -3e38f; ai[z] = 0; bi[z] = 0; }
        for (int p = 0; p < 2; ++p) {
            const f16* qr = qp + (size_t)t * 2048 + h * 256 + p * 128;
            for (int n = 0; n < 128; ++n) {
                const f16* kr = subk + ((size_t)((h * 2 + p) * 128 + n)) * 128;
                float dot = 0.f;
                for (int c = 0; c < 128; ++c) dot += (float)qr[c] * (float)kr[c];
                dot *= rs2;
                if (p == 0) INS(av, ai, dot, n); else INS(bv, bi, dot, n);
            }
        }
        float cv[16]; int ci[16];
#pragma unroll
        for (int z = 0; z < 16; ++z) { cv[z] = -3e38f; ci[z] = 0; }
#pragma unroll
        for (int i = 0; i < 16; ++i)
#pragma unroll
            for (int j = 0; j < 16; ++j)
                if ((i + 1) * (j + 1) <= 16) INS(cv, ci, av[i] + bv[j], ai[i] * 128 + bi[j]);
        float sum = 0.f, e[16];
#pragma unroll
        for (int z = 0; z < 16; ++z) { e[z] = __expf(cv[z] - cv[0]); sum += e[z]; }
        const float inv = 1.0f / sum;
#pragma unroll
        for (int z = 0; z < 16; ++z) { eidx[(size_t)t * 128 + h * 16 + z] = ci[z]; egate[(size_t)t * 128 + h * 16 + z] = e[z] * inv; }
    }
}

__device__ __forceinline__ int mono_i(float f) { const int b = __float_as_int(f); return b ^ ((b >> 31) & 0x7fffffff); }
__device__ __forceinline__ float unmono_f(int m) { return __int_as_float(m ^ ((m >> 31) & 0x7fffffff)); }
#define INS16(Lst, x_) do { int xv_ = (x_); _Pragma("unroll") for (int z_ = 0; z_ < 16; ++z_) { const int hi_ = max(Lst[z_], xv_); xv_ = min(Lst[z_], xv_); Lst[z_] = hi_; } } while (0)
__device__ __forceinline__ void merge_pair16(int (&Lst)[16]) {
    int P[16];
#pragma unroll
    for (int z = 0; z < 16; ++z) P[z] = __shfl_xor(Lst[z], 32);
#pragma unroll
    for (int z = 0; z < 16; ++z) Lst[z] = max(Lst[z], P[15 - z]);
#pragma unroll
    for (int s = 8; s >= 1; s >>= 1)
#pragma unroll
        for (int i = 0; i < 16; ++i) if ((i & s) == 0) { const int hi = max(Lst[i], Lst[i + s]), lo = min(Lst[i], Lst[i + s]); Lst[i] = hi; Lst[i + s] = lo; }
}
__device__ __forceinline__ void bitonic_sort16_desc(int (&K)[16]) {
#pragma unroll
    for (int k = 2; k <= 16; k <<= 1)
#pragma unroll
        for (int j = k >> 1; j > 0; j >>= 1)
#pragma unroll
            for (int i = 0; i < 16; ++i) { const int l = i ^ j; if (l > i) { const int a = K[i], b = K[l], hi = max(a, b), lo = min(a, b); const bool desc = (i & k) == 0; K[i] = desc ? hi : lo; K[l] = desc ? lo : hi; } }
}
__device__ __forceinline__ void bitonic_merge16_desc(int (&K)[16]) {
#pragma unroll
    for (int s = 8; s >= 1; s >>= 1)
#pragma unroll
        for (int i = 0; i < 16; ++i) if ((i & s) == 0) { const int hi = max(K[i], K[i + s]), lo = min(K[i], K[i + s]); K[i] = hi; K[i + s] = lo; }
}
template <class Side>
__device__ __forceinline__ void ph_route(const Ctx& C, LAS unsigned char* lds, const f16* __restrict__ qp, const float* __restrict__ ss2, const f16* __restrict__ subk,
                                         int* __restrict__ eidx, float* __restrict__ egate, const Side& side_job) {
    const int lane = C.lane, r32 = lane & 31, hh = lane >> 5;
    LAS unsigned char* tab = lds + 65536 + C.wave * 4096 + lane * 36;
    const int GH = C.G < 8 ? C.G : 8;
  for (int h = blockIdx.x % GH; h < 8; h += GH) {
    const int rank_h = blockIdx.x / GH, nwg_h = (C.G - (blockIdx.x % GH) + GH - 1) / GH;
    __syncthreads();
    for (int i = C.tid; i < 2 * 128 * 16; i += NTHREADS) {
        const int row = i >> 4, ch = i & 15;
        *(LAS half8*)(lds + row * 256 + ((ch ^ (row & 15)) << 4)) = *(const half8*)(subk + (size_t)(h * 256 + row) * 128 + ch * 8);
    }
    __syncthreads();
    if (h == (int)(blockIdx.x % GH) && (C.wave & 4)) side_job();
    for (int tb = rank_h * NWAVES + C.wave; tb < T / 32; tb += nwg_h * NWAVES) {
        const int t0 = tb * 32, t = t0 + r32;
        int top[2][16];
#pragma unroll
        for (int p = 0; p < 2; ++p) {
            const f16* qrow = qp + (size_t)t * 2048 + h * 256 + p * 128 + 8 * hh;
            const LAS unsigned char* kl = lds + (p * 128 + r32) * 256;
            half8 bq[8];
#pragma unroll
            for (int ks = 0; ks < 8; ++ks) bq[ks] = *(const half8*)(qrow + 16 * ks);
            int Lst[16];
#pragma unroll
            for (int z = 0; z < 16; ++z) Lst[z] = (int)0x80000000;
#pragma unroll 1
            for (int nb = 0; nb < 4; ++nb) {
                f32x16 acc = {0.f, 0.f, 0.f, 0.f, 0.f, 0.f, 0.f, 0.f, 0.f, 0.f, 0.f, 0.f, 0.f, 0.f, 0.f, 0.f};
#pragma unroll
                for (int ks = 0; ks < 8; ++ks) {
                    const half8 ak = *(const LAS half8*)(kl + nb * 32 * 256 + (((2 * ks + hh) ^ (r32 & 15)) << 4));
                    acc = __builtin_amdgcn_mfma_f32_32x32x16_f16(ak, bq[ks], acc, 0, 0, 0);
                }
                int K[16];
#pragma unroll
                for (int r = 0; r < 16; ++r) { const int n = nb * 32 + (r & 3) + 8 * (r >> 2) + 4 * hh; K[r] = (mono_i(acc[r]) & ~127) | (127 - n); }
                bitonic_sort16_desc(K);
#pragma unroll
                for (int z = 0; z < 16; ++z) Lst[z] = max(Lst[z], K[15 - z]);
                bitonic_merge16_desc(Lst);
            }
            merge_pair16(Lst);
#pragma unroll
            for (int z = 0; z < 16; ++z) top[p][z] = Lst[z];
        }
        float va[16], vb[16];
#pragma unroll
        for (int z = 0; z < 16; ++z) { va[z] = unmono_f(top[0][z] & ~127); vb[z] = unmono_f(top[1][z] & ~127);
            tab[z] = (unsigned char)(127 - (top[0][z] & 127)); tab[16 + z] = (unsigned char)(127 - (top[1][z] & 127)); }
        int Cl[16];
        { const float a01 = hh ? va[1] : va[0];
#pragma unroll
          for (int j = 0; j < 16; ++j) { const int key = (mono_i(a01 + vb[j]) & ~255) | (255 - (hh * 16 + j)); Cl[j] = (hh && j >= 8) ? (int)0x80000000 : key; } }
#pragma unroll
        for (int i = 2; i < 16; i += 2) {
            const float ai = hh ? va[i + 1] : va[i];
#pragma unroll
            for (int j = 0; j < 16; ++j)
                if ((i + 1) * (j + 1) <= 16) {
                    int key = (mono_i(ai + vb[j]) & ~255) | (255 - ((i + hh) * 16 + j));
                    if ((i + 2) * (j + 1) > 16) key = hh ? (int)0x80000000 : key;
                    INS16(Cl, key);
                }
        }
        merge_pair16(Cl);
        float e[16], sum = 0.f; const float mx = unmono_f(Cl[0] & ~255);
#pragma unroll
        for (int z = 0; z < 16; ++z) { e[z] = __expf(unmono_f(Cl[z] & ~255) - mx); sum += e[z]; }
        const float inv = 1.0f / sum;
        LDS_WAIT();
        int* ei = eidx + (size_t)t * 128 + h * 16 + 8 * hh; float* eg = egate + (size_t)t * 128 + h * 16 + 8 * hh;
#pragma unroll
        for (int z = 0; z < 16; ++z) {
            if ((z >> 3) == hh) { const int code = 255 - (Cl[z] & 255); const int ia = tab[code >> 4], ib = tab[16 + (code & 15)];
                ei[z & 7] = ia * 128 + ib; eg[z & 7] = e[z] * inv; }
        }
        LDS_WAIT();
    }
  }
}

struct Slicing { int m, pi, nloc, rank; };
__device__ __forceinline__ Slicing get_slicing(const unsigned* bar, volatile LAS unsigned* misc) {
    Slicing S; const unsigned x = (unsigned)__builtin_amdgcn_s_getreg((3 << 11) | 20) & 0xFu;
    int m = 0, pi = 0, nloc = 1;
    for (unsigned j = 0; j < 16; ++j) { const unsigned c = __hip_atomic_load(&bar[256 + 64 * j], __ATOMIC_RELAXED, __HIP_MEMORY_SCOPE_AGENT); if (c > 0u) { if (j < x) ++pi; ++m; } if (j == x) nloc = (int)c; }
    S.m = m > 0 ? m : 1; S.pi = pi; S.nloc = nloc > 0 ? nloc : 1; S.rank = (int)misc[10];
    return S;
}
__device__ __forceinline__ float gelu_fast(float v) {
    const float av = fabsf(v), t = __builtin_amdgcn_rcpf(av * 0.2316418882f + 1.0f);
    float q = t * 0.5307027145f + (-0.7265760135f); q = q * t + 0.7107068705f; q = q * t + (-0.142248368f); q = q * t + 0.127414796f; q = q * t;
    const float m = v * (q * __builtin_amdgcn_exp2f((v * v) * (-0.72134752044f)));
    return v < 0.f ? m : v - m;
}
__device__ __forceinline__ void ph_h2quant(const Ctx& C, const f16* __restrict__ x1h, const float* __restrict__ ss2, unsigned* __restrict__ h2q, float* __restrict__ hsc) {
    const int lane = C.lane;
    for (int t = C.gw; t < T; t += C.ngw) {
        const half8 h0 = *(const half8*)(x1h + (size_t)t * DM + 16 * lane), h1 = *(const half8*)(x1h + (size_t)t * DM + 16 * lane + 8);
        float hm = 0.f;
#pragma unroll
        for (int i = 0; i < 8; ++i) hm = fmaxf(hm, fmaxf(fabsf((float)h0[i]), fabsf((float)h1[i])));
        hm = wave_max(hm);
        const float inv = hm > 0.f ? 127.0f / hm : 0.f;
        u32x4 w;
        w[0] = (unsigned)pack4_i8((float)h0[0] * inv, (float)h0[1] * inv, (float)h0[2] * inv, (float)h0[3] * inv);
        w[1] = (unsigned)pack4_i8((float)h0[4] * inv, (float)h0[5] * inv, (float)h0[6] * inv, (float)h0[7] * inv);
        w[2] = (unsigned)pack4_i8((float)h1[0] * inv, (float)h1[1] * inv, (float)h1[2] * inv, (float)h1[3] * inv);
        w[3] = (unsigned)pack4_i8((float)h1[4] * inv, (float)h1[5] * inv, (float)h1[6] * inv, (float)h1[7] * inv);
        *(u32x4*)(h2q + (size_t)t * 256 + 4 * lane) = w;
        if (lane == 0) hsc[t] = hm * (1.0f / 127.0f) * rs_from_ss(ss2, t);
    }
}
__device__ __forceinline__ __amdgpu_buffer_rsrc_t slice_rsrc(const unsigned char* base) {
    const unsigned long long b = (unsigned long long)base;
    const unsigned lo = __builtin_amdgcn_readfirstlane((unsigned)b), hi = __builtin_amdgcn_readfirstlane((unsigned)(b >> 32));
    return __builtin_amdgcn_make_buffer_rsrc((void*)(((unsigned long long)hi << 32) | lo), 0, NEXP * 128, 0x00020000);
}
template <int EMASK>
__device__ __forceinline__ void ph_upeer(const Ctx& C, LAS unsigned char* lds, const Slicing SL, const unsigned* __restrict__ h2q, const int* __restrict__ eidx,
                                         const unsigned char* __restrict__ uq, short* __restrict__ pdot) {
    const int lane = C.lane, grp = lane >> 3, c8 = lane & 7;
    const int wv = SL.rank * NWAVES + C.wave, nwv = SL.nloc * NWAVES;
    const int ntok = (T - wv + nwv - 1) / nwv;
    auto tok = [&](int i) { const int t = wv + i * nwv; return t < T ? t : T - 1; };
    volatile LAS int* row = (volatile LAS int*)(lds + C.wave * 1024);
  for (int s = SL.pi; s < 8; s += SL.m) {
    const __amdgpu_buffer_rsrc_t urs = slice_rsrc(uq + (size_t)s * (NEXP * 128));
    const unsigned* hqs = h2q + s * 32 + c8 * 4;
    int tA = tok(0), tB = tok(1);
    int e0 = eidx[(size_t)tA * 128 + lane], e1 = eidx[(size_t)tA * 128 + 64 + lane];
    u32x4 hq = *(const u32x4*)(hqs + (size_t)tA * 256);
    int ne0 = eidx[(size_t)tB * 128 + lane], ne1 = eidx[(size_t)tB * 128 + 64 + lane];
    u32x4 r[16];
#pragma unroll
    for (int i = 0; i < 16; ++i) { const int e = __shfl(i < 8 ? e0 : e1, 8 * (i & 7) + grp) & EMASK; r[i] = __builtin_amdgcn_raw_buffer_load_b128(urs, e * 128 + c8 * 16, 0, 0); }
#pragma unroll 1
    for (int it = 0; it < ntok; ++it) {
        const int t = tok(it), t1 = tok(it + 1), t2 = tok(it + 2);
        const int ze0 = eidx[(size_t)t2 * 128 + lane], ze1 = eidx[(size_t)t2 * 128 + 64 + lane];
        const u32x4 nhq = *(const u32x4*)(hqs + (size_t)t1 * 256);
#pragma unroll
        for (int q = 0; q < 4; ++q) {
            int evv[4];
#pragma unroll
            for (int j = 0; j < 4; ++j) evv[j] = __shfl(q < 2 ? ne0 : ne1, 32 * (q & 1) + 8 * j + grp) & EMASK;
            int pa[4], pb[4];
#pragma unroll
            for (int j = 0; j < 4; ++j) {
                pa[j] = __builtin_amdgcn_sdot4((int)r[4 * q + j][0], (int)hq[0], 0, false); pb[j] = __builtin_amdgcn_sdot4((int)r[4 * q + j][1], (int)hq[1], 0, false);
                pa[j] = __builtin_amdgcn_sdot4((int)r[4 * q + j][2], (int)hq[2], pa[j], false); pb[j] = __builtin_amdgcn_sdot4((int)r[4 * q + j][3], (int)hq[3], pb[j], false);
            }
#pragma unroll
            for (int j = 0; j < 4; ++j) { pa[j] += pb[j]; pa[j] += dppi<0xB1>(pa[j]); }
#pragma unroll
            for (int j = 0; j < 4; ++j) pa[j] += dppi<0x4E>(pa[j]);
#pragma unroll
            for (int j = 0; j < 4; ++j) pa[j] += dppi<0x141>(pa[j]);
            if (c8 == 0) {
#pragma unroll
                for (int j = 0; j < 4; ++j) row[8 * (4 * q + j) + grp] = pa[j];
            }
#pragma unroll
            for (int j = 0; j < 4; ++j) {
                asm volatile("" ::: "memory");
                r[4 * q + j] = __builtin_amdgcn_raw_buffer_load_b128(urs, evv[j] * 128 + c8 * 16, 0, 0);
                asm volatile("" ::: "memory");
            }
        }
        LDS_WAIT();
        const int p0 = row[lane], p1 = row[64 + lane];
        LDS_WAIT();
        { short* pp = pdot + ((size_t)s * T + t) * 128 + lane; const int c0 = min(max((p0 + 4) >> 3, -32768), 32767), c1 = min(max((p1 + 4) >> 3, -32768), 32767);
          asm volatile("global_store_short %0, %1, off\n\tglobal_store_short %0, %2, off offset:128" :: "v"(pp), "v"(c0), "v"(c1) : "memory"); }
        hq = nhq; ne0 = ze0; ne1 = ze1;
    }
  }
}
__device__ __forceinline__ void ph_ureduce(const Ctx& C, LAS unsigned char* lds, const short* __restrict__ pdot, const float* __restrict__ hsc, const int* __restrict__ eidx, const float* __restrict__ us,
                                           const float* __restrict__ vs, const float* __restrict__ egate, unsigned* __restrict__ wqp, float* __restrict__ wsc) {
    const int lane = C.lane;
    volatile LAS unsigned char* row = (volatile LAS unsigned char*)(lds + C.wave * 1024);
    for (int tb = C.gw * 2; tb < T; tb += C.ngw * 2) {
        int e0[2], e1[2], s0[2], s1[2]; float h[2], g0[2], g1[2];
#pragma unroll
        for (int u = 0; u < 2; ++u) {
            const int t = tb + u;
            e0[u] = eidx[(size_t)t * 128 + lane]; e1[u] = eidx[(size_t)t * 128 + 64 + lane];
            g0[u] = egate[(size_t)t * 128 + lane]; g1[u] = egate[(size_t)t * 128 + 64 + lane];
            h[u] = hsc[t]; s0[u] = 0; s1[u] = 0;
#pragma unroll
            for (int s = 0; s < 8; ++s) { const short* pp = pdot + ((size_t)s * T + t) * 128 + lane; s0[u] += (int)pp[0]; s1[u] += (int)pp[64]; }
        }
        float w0[2], w1[2];
#pragma unroll
        for (int u = 0; u < 2; ++u) {
            w0[u] = gelu_fast((float)s0[u] * (8.0f * h[u]) * us[e0[u]]) * g0[u] * vs[e0[u]];
            w1[u] = gelu_fast((float)s1[u] * (8.0f * h[u]) * us[e1[u]]) * g1[u] * vs[e1[u]];
        }
#pragma unroll
        for (int u = 0; u < 2; ++u) {
            const int t = tb + u;
            const float wm = wave_max(fmaxf(fabsf(w0[u]), fabsf(w1[u])));
            const float inv = wm > 0.f ? 127.0f / wm : 0.f;
            { const int k = lane; row[u * 128 + (k & 7) * 16 + (k >> 5) * 4 + ((k >> 3) & 3)] = (unsigned char)(int)rintf(w0[u] * inv); }
            { const int k = 64 + lane; row[u * 128 + (k & 7) * 16 + (k >> 5) * 4 + ((k >> 3) & 3)] = (unsigned char)(int)rintf(w1[u] * inv); }
            if (lane == 0) wsc[t] = wm * (1.0f / 127.0f);
        }
        LDS_WAIT();
        wqp[(size_t)tb * 32 + lane] = ((volatile LAS unsigned*)row)[lane];
        LDS_WAIT();
    }
}
template <int EMASK>
__device__ __forceinline__ void ph_vpeer(const Ctx& C, const Slicing SL, const int* __restrict__ eidx, const unsigned* __restrict__ wqp, const float* __restrict__ wsc, const unsigned char* __restrict__ vq,
                                         f16* __restrict__ peer) {
    const int lane = C.lane, grp = lane >> 3, c8 = lane & 7;
    const bool hh = (lane & 32) != 0, b4 = (lane & 16) != 0, b3 = (lane & 8) != 0;
    const int wv = SL.rank * NWAVES + C.wave, nwv = SL.nloc * NWAVES;
    const int ntok = (T - wv + nwv - 1) / nwv;
    auto tok = [&](int i) { const int t = wv + i * nwv; return t < T ? t : T - 1; };
  for (int s = SL.pi; s < 8; s += SL.m) {
    const __amdgpu_buffer_rsrc_t vrs = slice_rsrc(vq + (size_t)s * (NEXP * 128));
    const int chl = 8 * (hh ? 1 : 0) + 4 * (b4 ? 1 : 0) + 2 * (b3 ? 1 : 0);
    const int coff = s * 128 + c8 * 16 + chl;
    int tA = tok(0), tB = tok(1);
    int e0 = eidx[(size_t)tA * 128 + lane], e1 = eidx[(size_t)tA * 128 + 64 + lane];
    u32x4 wq = *(const u32x4*)(wqp + (size_t)tA * 32 + grp * 4); float wscale = wsc[tA];
    int ne0 = eidx[(size_t)tB * 128 + lane], ne1 = eidx[(size_t)tB * 128 + 64 + lane];
    u32x4 r[16];
#pragma unroll
    for (int i = 0; i < 16; ++i) { const int e = __shfl(i < 8 ? e0 : e1, 8 * (i & 7) + grp) & EMASK; r[i] = __builtin_amdgcn_raw_buffer_load_b128(vrs, e * 128 + c8 * 16, 0, 0); }
#pragma unroll 1
    for (int it = 0; it < ntok; ++it) {
        const int t = tok(it), t1 = tok(it + 1), t2 = tok(it + 2);
        const int ze0 = eidx[(size_t)t2 * 128 + lane], ze1 = eidx[(size_t)t2 * 128 + 64 + lane];
        const u32x4 nwq = *(const u32x4*)(wqp + (size_t)t1 * 32 + grp * 4); const float nwscale = wsc[t1];
        int o[16];
#pragma unroll
        for (int c = 0; c < 16; ++c) o[c] = 0;
#pragma unroll
        for (int q = 0; q < 4; ++q) {
            int evv[4];
#pragma unroll
            for (int j = 0; j < 4; ++j) evv[j] = __shfl(q < 2 ? ne0 : ne1, 32 * (q & 1) + 8 * j + grp) & EMASK;
#pragma unroll
            for (int d = 0; d < 4; ++d) {
                const unsigned a = r[4 * q][d], b = r[4 * q + 1][d], c = r[4 * q + 2][d], e = r[4 * q + 3][d];
                const unsigned t0 = __builtin_amdgcn_perm(b, a, 0x05010400u), t1p = __builtin_amdgcn_perm(b, a, 0x07030602u);
                const unsigned u0 = __builtin_amdgcn_perm(e, c, 0x05010400u), u1 = __builtin_amdgcn_perm(e, c, 0x07030602u);
                o[4 * d + 0] = __builtin_amdgcn_sdot4((int)__builtin_amdgcn_perm(u0, t0, 0x05040100u), (int)wq[q], o[4 * d + 0], false);
                o[4 * d + 1] = __builtin_amdgcn_sdot4((int)__builtin_amdgcn_perm(u0, t0, 0x07060302u), (int)wq[q], o[4 * d + 1], false);
                o[4 * d + 2] = __builtin_amdgcn_sdot4((int)__builtin_amdgcn_perm(u1, t1p, 0x05040100u), (int)wq[q], o[4 * d + 2], false);
                o[4 * d + 3] = __builtin_amdgcn_sdot4((int)__builtin_amdgcn_perm(u1, t1p, 0x07060302u), (int)wq[q], o[4 * d + 3], false);
            }
#pragma unroll
            for (int j = 0; j < 4; ++j) {
                asm volatile("" ::: "memory");
                r[4 * q + j] = __builtin_amdgcn_raw_buffer_load_b128(vrs, evv[j] * 128 + c8 * 16, 0, 0);
                asm volatile("" ::: "memory");
            }
        }
        int q8[8], q4[4], q2[2];
#pragma unroll
        for (int k = 0; k < 8; ++k) q8[k] = bfly32i(o[k], o[8 + k]);
#pragma unroll
        for (int k = 0; k < 4; ++k) q4[k] = bfly16i(q8[k], q8[4 + k]);
#pragma unroll
        for (int k = 0; k < 2; ++k) { const int mine = b3 ? q4[2 + k] : q4[k], oth = b3 ? q4[k] : q4[2 + k]; q2[k] = mine + dppi<0x128>(oth); }
        { half2 pv; pv[0] = (f16)((float)q2[0] * wscale); pv[1] = (f16)((float)q2[1] * wscale); f16* yp = peer + (size_t)t * DM + coff; asm volatile("global_store_dword %0, %1, off" :: "v"(yp), "v"(pv) : "memory"); }
        wq = nwq; wscale = nwscale; ne0 = ze0; ne1 = ze1;
    }
  }
}
__device__ __forceinline__ void ph_final(const Ctx& C, const f16* __restrict__ peer, float* xio, const float* __restrict__ gf) {
    const int lane = C.lane;
    f32x4 gg[4];
#pragma unroll
    for (int j = 0; j < 4; ++j) gg[j] = *(const f32x4*)(gf + j * 256 + lane * 4);
    for (int tb = C.gw * 4; tb < T; tb += C.ngw * 4) {
        f32x4 v[4][4]; half4 pe[4][4];
#pragma unroll
        for (int u = 0; u < 4; ++u)
#pragma unroll
            for (int j = 0; j < 4; ++j) { v[u][j] = *(const f32x4*)(xio + (size_t)(tb + u) * DM + j * 256 + lane * 4); pe[u][j] = *(const half4*)(peer + (size_t)(tb + u) * DM + j * 256 + lane * 4); }
#pragma unroll
        for (int u = 0; u < 4; ++u) {
            float s = 0.f;
#pragma unroll
            for (int j = 0; j < 4; ++j) {
#pragma unroll
                for (int i = 0; i < 4; ++i) { v[u][j][i] += (float)pe[u][j][i]; s += v[u][j][i] * v[u][j][i]; }
            }
            const float r = rsqrtf(wave_sum(s) * (1.0f / DM) + EPS);
#pragma unroll
            for (int j = 0; j < 4; ++j) *(f32x4*)(xio + (size_t)(tb + u) * DM + j * 256 + lane * 4) = v[u][j] * r * gg[j];
        }
    }
}

namespace pg8 {
#define PG8_LAS __attribute__((address_space(3)))
typedef _Float16 frag8 __attribute__((ext_vector_type(8)));
typedef float f32x4 __attribute__((ext_vector_type(4)));
constexpr int BM = 256, BK = 64, HALF = 128, HTB = HALF * BK * 2  , STAGE_BYTES = 8 * HTB, NXCD = 8, WGM = 8;

__host__ __device__ __forceinline__ int lds_byte(int r, int c) { const int st = (r >> 4) * 2 + (c >> 5), rr = r & 15, cc = c & 31, ob = rr * 64 + cc * 2; return st * 1024 + (ob ^ (((ob >> 9) & 1) << 5)); }
__host__ __device__ __forceinline__ void stage_rc(int b, int& R, int& C) { const int st = b / 1024, sb = b % 1024, swz = sb ^ (((sb >> 9) & 1) << 5); R = (st >> 1) * 16 + swz / 64; C = (st & 1) * 32 + (swz % 64) / 2; }
__host__ __device__ __forceinline__ int perm32(int rho) { const int n = rho >> 4, i = rho & 15; return 8 * (i >> 2) + 4 * n + (i & 3); }

struct Unit { int pm, pn; };
struct Gemm { const f16* A; const f16* Bt; int M, N, K; };

struct StaticOrder {
    int nM, nN, nwg, G, c;
    __host__ __device__ void init(int M, int N, int G_, int c_) { nM = M / BM; nN = N / BM; nwg = nM * nN; G = G_; c = c_; }
    __host__ __device__ bool next(int i, Unit& u) const {
        const long L = (long)i * G + c; if (L >= nwg) return false;
        int wgid = (int)L; { const int q = nwg / NXCD, r = nwg % NXCD, xcd = wgid % NXCD, off = wgid / NXCD; wgid = (xcd < r ? xcd * (q + 1) : r * (q + 1) + (xcd - r) * q) + off; }
        const int nig = WGM * nN, gid = wgid / nig, fm = gid * WGM, gsz = (nM - fm) < WGM ? (nM - fm) : WGM;
        u.pm = fm + ((wgid % nig) % gsz); u.pn = (wgid % nig) / gsz; return true;
    }
    __device__ __forceinline__ void a_ready(const Unit&) const {}
    __device__ __forceinline__ void done(const Unit&) const {}
};

__device__ __forceinline__ frag8 pack8(const f32x4 a, const f32x4 b) {
    frag8 h; h[0] = (f16)a[0]; h[1] = (f16)a[1]; h[2] = (f16)a[2]; h[3] = (f16)a[3]; h[4] = (f16)b[0]; h[5] = (f16)b[1]; h[6] = (f16)b[2]; h[7] = (f16)b[3]; return h;
}
__device__ __forceinline__ float sigmoidf_(float z) { return 1.0f / (1.0f + __expf(-z)); }

struct EpiP1 {
    typedef i32x4 acc_t; static constexpr bool PERM = true, AFTER_DRAIN = false, MIDK = false;
    const float* ss1; const float* rsx; const float* wcs; const float* bgate; f16* qkvu; f16* gates; f16* vT;
    __device__ __forceinline__ void operator()(const i32x4 (&acc)[2][2][4][2], const Unit& u, int wr, int wc, int fr, int fq) const {
        const int row0 = u.pm * BM + wr * 64 + fr, colt = u.pn * BM; const bool isg = colt >= NQKVU;
        f32x4 cs[2][2];
#pragma unroll
        for (int bj = 0; bj < 2; ++bj) { const int c0 = colt + bj * HALF + wc * 32 + 8 * fq; cs[bj][0] = *(const f32x4*)(wcs + c0); cs[bj][1] = *(const f32x4*)(wcs + c0 + 4); }
#pragma unroll
        for (int ai = 0; ai < 2; ++ai)
#pragma unroll
            for (int m = 0; m < 4; ++m) { const int row = row0 + ai * HALF + m * 16; const float r = rsqrtf(ss1[row] * (1.0f / DM) + EPS) * rsx[row];
#pragma unroll
                for (int bj = 0; bj < 2; ++bj) { const int c0 = colt + bj * HALF + wc * 32 + 8 * fq; f32x4 v0, v1;
#pragma unroll
                    for (int i = 0; i < 4; ++i) { v0[i] = (float)acc[ai][bj][m][0][i] * (r * cs[bj][0][i]); v1[i] = (float)acc[ai][bj][m][1][i] * (r * cs[bj][1][i]); }
                    if (isg) { const int cg = c0 - NQKVU; const f32x4 b0 = *(const f32x4*)(bgate + cg), b1 = *(const f32x4*)(bgate + cg + 4);
#pragma unroll
                        for (int i = 0; i < 4; ++i) { v0[i] = sigmoidf_(v0[i] + b0[i]); v1[i] = sigmoidf_(v1[i] + b1[i]); }
                        *(frag8*)(gates + (size_t)row * NGATE + cg) = pack8(v0, v1); }
                    else { const frag8 hv = pack8(v0, v1); *(frag8*)(qkvu + (size_t)row * NQKVU + c0) = hv;
                        if (colt == 512 && bj == 1) {
                            f16* vp = vT + ((size_t)((row >> 11) * 2 + (wc >> 1)) * 64 + (wc & 1) * 32 + 8 * fq) * SEQ + (row & (SEQ - 1));
#pragma unroll
                            for (int i = 0; i < 8; ++i) vp[(size_t)i * SEQ] = hv[i]; } } } }
    }
};
struct EpiMerged {
    typedef f32x4 acc_t; static constexpr bool PERM = true, AFTER_DRAIN = false, MIDK = true;
    const f16* gates; f16* merged;
    __device__ __forceinline__ void mid(f32x4 (&acc)[2][2][4][2], const Unit& u, int wr, int wc, int fr, int fq) const {
        const int row0 = u.pm * BM + wr * 64 + fr, colt = u.pn * BM;
        const f16* gb = gates + (size_t)row0 * NGATE + colt + wc * 32 + 8 * fq;
        asm volatile("" : "+v"(gb));
#pragma unroll
        for (int ai = 0; ai < 2; ++ai) {
            frag8 g0[4][2], g1[4][2];
#pragma unroll
            for (int m = 0; m < 4; ++m)
#pragma unroll
                for (int bj = 0; bj < 2; ++bj) { const f16* gp = gb + (size_t)(ai * HALF + m * 16) * NGATE + bj * HALF; g0[m][bj] = *(const frag8*)gp; g1[m][bj] = *(const frag8*)(gp + DM); }
#pragma unroll
            for (int m = 0; m < 4; ++m)
#pragma unroll
                for (int bj = 0; bj < 2; ++bj)
#pragma unroll
                    for (int i = 0; i < 4; ++i) {
                        acc[ai][bj][m][0][i] *= (float)g0[m][bj][i] * __builtin_amdgcn_rcpf(fmaxf((float)g1[m][bj][i], 1e-4f));
                        acc[ai][bj][m][1][i] *= (float)g0[m][bj][4 + i] * __builtin_amdgcn_rcpf(fmaxf((float)g1[m][bj][4 + i], 1e-4f)); }
            asm volatile("" ::: "memory");
        }
    }
    __device__ __forceinline__ void operator()(const f32x4 (&acc)[2][2][4][2], const Unit& u, int wr, int wc, int fr, int fq) const {
        const int row0 = u.pm * BM + wr * 64 + fr, colt = u.pn * BM;
#pragma unroll
        for (int ai = 0; ai < 2; ++ai)
#pragma unroll
            for (int m = 0; m < 4; ++m) { const int row = row0 + ai * HALF + m * 16;
#pragma unroll
                for (int bj = 0; bj < 2; ++bj) { const int c0 = colt + bj * HALF + wc * 32 + 8 * fq;
                    const frag8 g1 = *(const frag8*)(gates + (size_t)row * NGATE + DM + c0); f32x4 v0, v1;
#pragma unroll
                    for (int i = 0; i < 4; ++i) { v0[i] = acc[ai][bj][m][0][i] * fmaxf((float)g1[i], 1e-4f); v1[i] = acc[ai][bj][m][1][i] * fmaxf((float)g1[4 + i], 1e-4f); }
                    *(frag8*)(merged + (size_t)row * DM + c0) = pack8(v0, v1); } }
    }
};
struct EpiOut {
    typedef f32x4 acc_t; static constexpr bool PERM = false, AFTER_DRAIN = false, MIDK = false;
    const float* x; const float* g2; float* x1; f16* x1h; float* ss2p;
    __device__ __forceinline__ void operator()(const f32x4 (&acc)[2][2][4][2], const Unit& u, int wr, int wc, int fr, int fq) const {
        const int row0 = u.pm * BM + wr * 64 + fr, col0 = u.pn * BM + wc * 32 + 4 * fq;
        f32x4 gv[2][2];
#pragma unroll
        for (int bj = 0; bj < 2; ++bj)
#pragma unroll
            for (int n = 0; n < 2; ++n) gv[bj][n] = *(const f32x4*)(g2 + col0 + bj * HALF + n * 16);
#pragma unroll
        for (int ai = 0; ai < 2; ++ai)
#pragma unroll
            for (int m = 0; m < 4; ++m) { const int row = row0 + ai * HALF + m * 16; const size_t off = (size_t)row * DM + col0; float ssq = 0.f;
#pragma unroll
                for (int bj = 0; bj < 2; ++bj)
#pragma unroll
                    for (int n = 0; n < 2; ++n) { const f32x4 y = *(const f32x4*)(x + off + bj * HALF + n * 16) + acc[ai][bj][m][n];
                        *(f32x4*)(x1 + off + bj * HALF + n * 16) = y; ssq += (y[0] * y[0] + y[1] * y[1]) + (y[2] * y[2] + y[3] * y[3]);
                        const f32x4 yg = y * gv[bj][n]; half4 h; h[0] = (f16)yg[0]; h[1] = (f16)yg[1]; h[2] = (f16)yg[2]; h[3] = (f16)yg[3];
                        *(half4*)(x1h + off + bj * HALF + n * 16) = h; }
                ssq += __shfl_xor(ssq, 16); ssq += __shfl_xor(ssq, 32);
                if (fq == 0) ss2p[(size_t)(u.pn * 4 + wc) * T + row] = ssq; }
    }
};
struct EpiQ {
    typedef i32x4 acc_t; static constexpr bool PERM = true, AFTER_DRAIN = false, MIDK = false;
    const float* hsc; const float* wqs; f16* qp;
    __device__ __forceinline__ void operator()(const i32x4 (&acc)[2][2][4][2], const Unit& u, int wr, int wc, int fr, int fq) const {
        const int row0 = u.pm * BM + wr * 64 + fr, colt = u.pn * BM;
        f32x4 cs[2][2];
#pragma unroll
        for (int bj = 0; bj < 2; ++bj) { const int c0 = colt + bj * HALF + wc * 32 + 8 * fq; cs[bj][0] = *(const f32x4*)(wqs + c0); cs[bj][1] = *(const f32x4*)(wqs + c0 + 4); }
#pragma unroll
        for (int ai = 0; ai < 2; ++ai)
#pragma unroll
            for (int m = 0; m < 4; ++m) { const int row = row0 + ai * HALF + m * 16; const float r = hsc[row];
#pragma unroll
                for (int bj = 0; bj < 2; ++bj) { const int c0 = colt + bj * HALF + wc * 32 + 8 * fq; f32x4 v0, v1;
#pragma unroll
                    for (int i = 0; i < 4; ++i) { v0[i] = (float)acc[ai][bj][m][0][i] * (r * cs[bj][0][i]); v1[i] = (float)acc[ai][bj][m][1][i] * (r * cs[bj][1][i]); }
                    *(frag8*)(qp + (size_t)row * 2048 + c0) = pack8(v0, v1); } }
    }
};

__device__ __forceinline__ void mma16(const frag8 b, const frag8 a, f32x4& c) { c = __builtin_amdgcn_mfma_f32_16x16x32_f16(b, a, c, 0, 0, 0); }
__device__ __forceinline__ void mma16(const frag8 b, const frag8 a, i32x4& c) { c = __builtin_amdgcn_mfma_i32_16x16x64_i8(__builtin_bit_cast(i32x4, b), __builtin_bit_cast(i32x4, a), c, 0, 0, 0); }
template <class Epi, class Sched, bool ALIGN_EPI = false, bool SP2 = false>
__device__ __forceinline__ void gemm_phase(PG8_LAS unsigned char* lds, const Gemm g, const Sched& S, const Epi& E) {
    const int tid = threadIdx.x, wid = __builtin_amdgcn_readfirstlane(tid >> 6), lane = tid & 63, wr = wid >> 2, wc = wid & 3, fr = lane & 15, fq = lane >> 4;
    const int K = g.K, nt = K / BK;
    unsigned voffA[2], voffB[2];
#pragma unroll
    for (int i = 0; i < 2; ++i) { int R, C; stage_rc(tid * 16 + i * 8192, R, C); const int Rb = Epi::PERM ? ((R & ~31) + perm32(R & 31)) : R;
        voffA[i] = (unsigned)(R * K + C) * 2u; voffB[i] = (unsigned)(Rb * K + C) * 2u; }
    const size_t kstep = (size_t)(BK * 2);
    const size_t hstep = (size_t)HALF * K * 2;
    const size_t tstep = 2 * hstep;
    const unsigned ldsw = (unsigned)wid * 1024u;
    const int aoff = lds_byte(wr * 64 + fr, fq * 8), boff = lds_byte(wc * 32 + fr, fq * 8);
#define PG8_SA(b, h) (((b) * 2 + (h)) * HTB)
#define PG8_SB(b, h) ((4 + (b) * 2 + (h)) * HTB)
#define PG8_STAGE(bufoff, gbase, voff) do { _Pragma("unroll") for (int _i = 0; _i < 2; ++_i) \
        __builtin_amdgcn_global_load_lds((const unsigned*)((const char*)(gbase) + (voff)[_i]), (PG8_LAS unsigned*)(lds + (bufoff) + ldsw + _i * 8192), 16, 0, 0); } while (0)
#define PG8_LDA(dst, b, h) do { _Pragma("unroll") for (int m = 0; m < 4; ++m) _Pragma("unroll") for (int k = 0; k < 2; ++k) dst[m][k] = *(const PG8_LAS frag8*)(lds + PG8_SA(b, h) + aoff + m * 2048 + k * 1024); } while (0)
#define PG8_LDB(dst, b, h) do { _Pragma("unroll") for (int n = 0; n < 2; ++n) _Pragma("unroll") for (int k = 0; k < 2; ++k) dst[n][k] = *(const PG8_LAS frag8*)(lds + PG8_SB(b, h) + boff + n * 2048 + k * 1024); } while (0)
#define PG8_MMA(ai, bj, At, Bt) do { __builtin_amdgcn_s_setprio(1); _Pragma("unroll") for (int m = 0; m < 4; ++m) _Pragma("unroll") for (int n = 0; n < 2; ++n) _Pragma("unroll") for (int k = 0; k < 2; ++k) \
        mma16(Bt[n][k], At[m][k], acc[ai][bj][m][n]); __builtin_amdgcn_s_setprio(0); } while (0)
#define PG8_WAIT_V(n) asm volatile("s_waitcnt vmcnt(" #n ")" ::: "memory")
#define PG8_WAIT_L(n) asm volatile("s_waitcnt lgkmcnt(" #n ")" ::: "memory")
#define PG8_BAR __builtin_amdgcn_s_barrier()
#define PG8_SCHED __builtin_amdgcn_sched_barrier(0)
    Unit cur, nxt; int ui = 0;
    if (!S.next(0, cur)) return;
    typedef typename Epi::acc_t acc_t;
    acc_t acc[2][2][4][2];
#pragma unroll
    for (int a = 0; a < 2; ++a)
#pragma unroll
        for (int b = 0; b < 2; ++b)
#pragma unroll
            for (int m = 0; m < 4; ++m)
#pragma unroll
                for (int n = 0; n < 2; ++n) acc[a][b][m][n] = acc_t{};
    frag8 At[4][2], B0[2][2], B1[2][2];
    const char* cA = (const char*)g.A + (size_t)cur.pm * tstep; const char* cB = (const char*)g.Bt + (size_t)cur.pn * tstep;
    S.a_ready(cur);
    if constexpr (SP2) {
        PG8_STAGE(PG8_SB(0, 0), cB, voffB); PG8_STAGE(PG8_SB(0, 1), cB + hstep, voffB); PG8_STAGE(PG8_SA(0, 0), cA, voffA); PG8_STAGE(PG8_SA(0, 1), cA + hstep, voffA);
        if (wr == 1) PG8_BAR;
        PG8_WAIT_V(2); PG8_BAR;
        PG8_STAGE(PG8_SB(1, 0), cB + kstep, voffB); PG8_STAGE(PG8_SA(1, 0), cA + kstep, voffA); PG8_STAGE(PG8_SB(1, 1), cB + hstep + kstep, voffB);
        PG8_WAIT_V(6); PG8_BAR;
    } else {
        PG8_STAGE(PG8_SB(0, 0), cB, voffB); PG8_STAGE(PG8_SA(0, 0), cA, voffA); PG8_STAGE(PG8_SB(0, 1), cB + hstep, voffB); PG8_STAGE(PG8_SA(0, 1), cA + hstep, voffA);
        if (wr == 1) PG8_BAR;
        PG8_WAIT_V(4); PG8_BAR;
        PG8_STAGE(PG8_SB(1, 0), cB + kstep, voffB); PG8_STAGE(PG8_SA(1, 0), cA + kstep, voffA); PG8_STAGE(PG8_SB(1, 1), cB + hstep + kstep, voffB);
        PG8_WAIT_V(6); PG8_BAR;
    }
    for (;;) {
        const bool has_next = S.next(ui + 1, nxt);
        const char* nA = has_next ? (const char*)g.A + (size_t)nxt.pm * tstep : cA; const char* nB = has_next ? (const char*)g.Bt + (size_t)nxt.pn * tstep : cB;
        for (int t = 0; t < nt; t += 2) {
            const bool last = (t == nt - 2);
            if constexpr (Epi::MIDK) { if (t == (nt >> 1)) E.mid(acc, cur, wr, wc, fr, fq); }
            const char* a1 = cA + (size_t)(t + 1) * kstep;
            const char* a2 = last ? nA : cA + (size_t)(t + 2) * kstep; const char* b2 = last ? nB : cB + (size_t)(t + 2) * kstep;
            const char* a3 = a2 + kstep; const char* b3 = b2 + kstep;
            if (last && has_next) S.a_ready(nxt);
            if constexpr (SP2) {
            PG8_LDB(B0, 0, 0); PG8_LDB(B1, 0, 1); PG8_SCHED; PG8_LDA(At, 0, 0); PG8_STAGE(PG8_SA(1, 1), a1 + hstep, voffA);
            PG8_WAIT_V(8); PG8_WAIT_L(0); PG8_BAR; PG8_MMA(0, 0, At, B0); PG8_MMA(0, 1, At, B1); PG8_BAR; PG8_SCHED;
            PG8_LDA(At, 0, 1); PG8_STAGE(PG8_SB(0, 0), b2, voffB); PG8_STAGE(PG8_SB(0, 1), b2 + hstep, voffB); PG8_STAGE(PG8_SA(0, 0), a2, voffA);
            PG8_WAIT_V(8); PG8_WAIT_L(0); PG8_BAR; PG8_MMA(1, 0, At, B0); PG8_MMA(1, 1, At, B1); PG8_BAR; PG8_SCHED;
            PG8_LDB(B0, 1, 0); PG8_LDB(B1, 1, 1); PG8_SCHED; PG8_LDA(At, 1, 0); PG8_STAGE(PG8_SA(0, 1), a2 + hstep, voffA);
            PG8_WAIT_V(8); PG8_WAIT_L(0); PG8_BAR; PG8_MMA(0, 0, At, B0); PG8_MMA(0, 1, At, B1); PG8_BAR; PG8_SCHED;
            PG8_LDA(At, 1, 1); PG8_STAGE(PG8_SB(1, 0), b3, voffB); PG8_STAGE(PG8_SB(1, 1), b3 + hstep, voffB); PG8_STAGE(PG8_SA(1, 0), a3, voffA);
            PG8_WAIT_V(8); PG8_WAIT_L(0); PG8_BAR; PG8_MMA(1, 0, At, B0); PG8_MMA(1, 1, At, B1); PG8_BAR; PG8_SCHED;
            } else {
            PG8_LDB(B0, 0, 0); PG8_SCHED; PG8_LDA(At, 0, 0); PG8_STAGE(PG8_SA(1, 1), a1 + hstep, voffA);
            PG8_WAIT_L(8); PG8_BAR; PG8_WAIT_L(0); PG8_MMA(0, 0, At, B0); PG8_BAR; PG8_SCHED;
            PG8_LDB(B1, 0, 1); PG8_STAGE(PG8_SB(0, 0), b2, voffB);
            PG8_BAR; PG8_WAIT_L(0); PG8_MMA(0, 1, At, B1); PG8_BAR;
            PG8_LDA(At, 0, 1); PG8_STAGE(PG8_SA(0, 0), a2, voffA);
            PG8_BAR; PG8_WAIT_L(0); PG8_MMA(1, 0, At, B0); PG8_BAR; PG8_SCHED;
            PG8_STAGE(PG8_SB(0, 1), b2 + hstep, voffB);
            PG8_WAIT_V(6); PG8_BAR; PG8_MMA(1, 1, At, B1); PG8_BAR;
            PG8_LDB(B0, 1, 0); PG8_SCHED; PG8_LDA(At, 1, 0); PG8_STAGE(PG8_SA(0, 1), a2 + hstep, voffA);
            PG8_WAIT_L(8); PG8_BAR; PG8_WAIT_L(0); PG8_MMA(0, 0, At, B0); PG8_BAR; PG8_SCHED;
            PG8_LDB(B1, 1, 1); PG8_STAGE(PG8_SB(1, 0), b3, voffB);
            PG8_BAR; PG8_WAIT_L(0); PG8_MMA(0, 1, At, B1); PG8_BAR;
            PG8_LDA(At, 1, 1); PG8_STAGE(PG8_SA(1, 0), a3, voffA);
            PG8_BAR; PG8_WAIT_L(0); PG8_MMA(1, 0, At, B0); PG8_BAR; PG8_SCHED;
            PG8_STAGE(PG8_SB(1, 1), b3 + hstep, voffB);
            PG8_WAIT_V(6); PG8_BAR; PG8_MMA(1, 1, At, B1); PG8_BAR;
            }
        }
        if constexpr (ALIGN_EPI) { if (wr == 0) PG8_BAR; }
        if constexpr (!Epi::AFTER_DRAIN) { E(acc, cur, wr, wc, fr, fq); S.done(cur); }
        if (!has_next) break;
#pragma unroll
        for (int a = 0; a < 2; ++a)
#pragma unroll
            for (int b = 0; b < 2; ++b)
#pragma unroll
                for (int m = 0; m < 4; ++m)
#pragma unroll
                    for (int n = 0; n < 2; ++n) acc[a][b][m][n] = acc_t{};
        cur = nxt; cA = nA; cB = nB; ++ui;
        if constexpr (ALIGN_EPI) { if (wr == 1) PG8_BAR; }
    }
    PG8_WAIT_V(0);
    if constexpr (!ALIGN_EPI) { if (wr == 0) PG8_BAR; }
    PG8_BAR;
    if constexpr (Epi::AFTER_DRAIN) { E.fused(acc, cur, wr, wc, fr, fq, lds, wid, lane); S.done(cur); }
#undef PG8_SA
#undef PG8_SB
#undef PG8_STAGE
#undef PG8_LDA
#undef PG8_LDB
#undef PG8_MMA
#undef PG8_WAIT_V
#undef PG8_WAIT_L
#undef PG8_BAR
#undef PG8_SCHED
}
}

#define XB_TMO      128
#define XB_XCNT(j)  (256  + 64 * (j))
#define XB_XSUB(j)  (1280 + 64 * (j))
#define XB_XGEN(j)  (2304 + 64 * (j))
#define XB_TOP      3328
#define XB_TOPGEN   3392
#define XCD_BAR_WORDS 3456
#define XB_SPIN_CAP (1u << 18)

__device__ __forceinline__ unsigned xb_ld(unsigned* p)              { return __hip_atomic_load(p, __ATOMIC_RELAXED, __HIP_MEMORY_SCOPE_AGENT); }
__device__ __forceinline__ unsigned xb_add(unsigned* p, unsigned v) { return __hip_atomic_fetch_add(p, v, __ATOMIC_RELAXED, __HIP_MEMORY_SCOPE_AGENT); }
__device__ __forceinline__ unsigned xb_xcc_id() { return (unsigned)__builtin_amdgcn_s_getreg((3 << 11) | 20) & 0xFu; }
#define XB_SPIN(cond, bar) do { unsigned _sp = 0; while (cond) { __builtin_amdgcn_s_sleep(1); \
    if ((++_sp & 255u) == 0u) { if (xb_ld(&(bar)[XB_TMO])) break; if (_sp > XB_SPIN_CAP) { atomicAdd(&(bar)[XB_TMO], 1u); break; } } } } while (0)

struct XcdBarrier {
    unsigned* bar; unsigned x;
    volatile LAS unsigned* st;
};

__device__ __forceinline__ XcdBarrier xcd_barrier_post(unsigned* bar, volatile LAS unsigned* st) {
    XcdBarrier b; b.bar = bar; b.x = xb_xcc_id(); b.st = st;
    if (threadIdx.x == 0) st[2] = xb_add(&bar[XB_XCNT(b.x)], 1u);
    return b;
}
__device__ __forceinline__ void xcd_barrier_complete(unsigned* bar, unsigned x, unsigned& nloc, unsigned& nx) {
    const unsigned G = gridDim.x * gridDim.y * gridDim.z;
    unsigned sum, cnt, mine, sp = 0u;
    for (;;) {
        sum = 0u; cnt = 0u; mine = 0u;
#pragma unroll
        for (unsigned j = 0; j < 16; ++j) { const unsigned c = xb_ld(&bar[XB_XCNT(j)]); sum += c; cnt += (c > 0u) ? 1u : 0u; mine = (j == x) ? c : mine; }
        if (sum == G) break;
        __builtin_amdgcn_s_sleep(1);
        if ((++sp & 255u) == 0u) { if (xb_ld(&bar[XB_TMO])) break; if (sp > XB_SPIN_CAP) { atomicAdd(&bar[XB_TMO], 1u); break; } }
    }
    nloc = mine > 0u ? mine : 1u; nx = cnt > 0u ? cnt : 1u;
}

__device__ __forceinline__ void xcd_barrier(const XcdBarrier& b) {
    asm volatile("s_waitcnt vmcnt(0)" ::: "memory");
    __syncthreads();
    if (threadIdx.x == 0) {
        unsigned* bar = b.bar;
        __builtin_amdgcn_s_waitcnt(0);
        unsigned nloc = b.st[0], nx = b.st[1];
        if (nloc == 0u) { xcd_barrier_complete(bar, b.x, nloc, nx); b.st[0] = nloc; b.st[1] = nx; }
        const unsigned old = xb_add(&bar[XB_XSUB(b.x)], 1u);
        const unsigned gen = old / nloc;
        if (old + 1u == (gen + 1u) * nloc) {
            __builtin_amdgcn_fence(__ATOMIC_RELEASE, "agent");
            asm volatile("s_waitcnt vmcnt(0)" ::: "memory");
            const unsigned og = xb_add(&bar[XB_TOP], 1u);
            const unsigned tg = og / nx;
            if (og + 1u == (tg + 1u) * nx) xb_add(&bar[XB_TOPGEN], 1u);
            else XB_SPIN(xb_ld(&bar[XB_TOPGEN]) == tg, bar);
            __builtin_amdgcn_fence(__ATOMIC_ACQUIRE, "agent");
            xb_add(&bar[XB_XGEN(b.x)], 1u);
            asm volatile("s_waitcnt vmcnt(0)" ::: "memory");
        } else {
            XB_SPIN(xb_ld(&bar[XB_XGEN(b.x)]) == gen, bar);
            __builtin_amdgcn_fence(__ATOMIC_ACQUIRE, "agent");
            asm volatile("s_waitcnt vmcnt(0)" ::: "memory");
        }
    }
    __syncthreads();
}


struct Args { const float* in[16]; float* out; unsigned char* ws; int ph_lo, ph_hi; };
constexpr int N_PHASES = 11;

__global__ void __launch_bounds__(NTHREADS, 2) mk_fwd(Args a) {
    extern __shared__ __attribute__((aligned(16))) unsigned char lds[];
    LAS unsigned char* L = (LAS unsigned char*)lds;
    volatile LAS unsigned* MISC = (volatile LAS unsigned*)(L + MISC_OFF);
    unsigned char* ws = a.ws;
    Ctx C;
    C.tid = threadIdx.x; C.lane = C.tid & 63; C.wave = __builtin_amdgcn_readfirstlane(C.tid >> 6);
    C.G = gridDim.x; C.gw = blockIdx.x * NWAVES + C.wave; C.ngw = C.G * NWAVES; C.gt = blockIdx.x * NTHREADS + C.tid; C.ngt = C.G * NTHREADS;
    for (int u = C.tid; u < (LDS_BYTES - LDSCTL_OFF) / 4; u += NTHREADS) ((LAS unsigned*)(L + LDSCTL_OFF))[u] = 0u;
    __syncthreads();
    const int lo = a.ph_lo, hi = a.ph_hi, G = C.G;
    const bool multi = (hi - lo) > 1;
    XcdBarrier bar; bar.bar = (unsigned*)(ws + WS_CTL) + CW_BAR; bar.x = 0; bar.st = nullptr;
    if (multi) bar = xcd_barrier_post((unsigned*)(ws + WS_CTL) + CW_BAR, MISC + 8);
#define IN(k) (lo <= (k) && (k) < hi)
#define SEAM(k) do { if (IN(k) && IN((k) + 1)) xcd_barrier(bar); } while (0)

#define REPS(k) for (int rep_ = 0; rep_ < ((PROBE_DUP == (k)) ? 2 : 1); ++rep_)
#define REPBAR(k) do { if (PROBE_DUP == (k) && rep_ == 0) xcd_barrier(bar); } while (0)
    if (IN(0)) REPS(0) { ph_prep(C, L, a.in, ws); REPBAR(0); }
    SEAM(0);
    if (IN(1)) {
        quant_wrows(C, (const f16*)(ws + WS_WCAT), NCAT, (unsigned*)(ws + WS_WCATQ), (float*)(ws + WS_WCS));
        quant_wrows(C, (const f16*)(ws + WS_WQ), 2048, (unsigned*)(ws + WS_WQQ), (float*)(ws + WS_WQS));
        xcd_barrier(bar);
        pg8::Gemm g{(const f16*)(ws + WS_XH), (const f16*)(ws + WS_WCATQ), T, NCAT, DM / 2}; pg8::StaticOrder S; S.init(T, NCAT, G, (int)blockIdx.x);
        pg8::EpiP1 E{(const float*)(ws + WS_RS1), (const float*)(ws + WS_RSX), (const float*)(ws + WS_WCS), a.in[8], (f16*)(ws + WS_QKVU), (f16*)(ws + WS_GATES), (f16*)(ws + WS_VT)};
        pg8::gemm_phase<pg8::EpiP1, pg8::StaticOrder, true, true>(L, g, S, E);
    }
    SEAM(1);
    if (IN(2)) REPS(2) {
        ph_attn_pool(C, L, (const f16*)(ws + WS_QKVU), (const f16*)(ws + WS_VT), a.in[3], (const f16*)(ws + WS_POOLW), a.in[5], (f16*)(ws + WS_OCAT));
        REPBAR(2);
    }
    if (IN(2) && IN(4)) xcd_barrier(bar);
    if (IN(4)) REPS(4) {
        pg8::Gemm g{(const f16*)(ws + WS_OCAT), (const f16*)(ws + WS_WB), T, DM, DM}; pg8::StaticOrder S; S.init(T, DM, G, (int)blockIdx.x);
        pg8::EpiMerged E{(const f16*)(ws + WS_GATES), (f16*)(ws + WS_MERGED)};
        pg8::gemm_phase<pg8::EpiMerged, pg8::StaticOrder, true, true>(L, g, S, E);
        REPBAR(4);
    }
    SEAM(4);
    if (IN(5)) REPS(5) {
        pg8::Gemm g{(const f16*)(ws + WS_MERGED), (const f16*)(ws + WS_WOUT), T, DM, DM}; pg8::StaticOrder S; S.init(T, DM, G, (int)blockIdx.x);
        pg8::EpiOut E{a.in[0], a.in[10], a.out, (f16*)(ws + WS_X1H), (float*)(ws + WS_SS2)};
        pg8::gemm_phase<pg8::EpiOut, pg8::StaticOrder, true, true>(L, g, S, E);
        REPBAR(5);
    }
    SEAM(5);
    if (IN(6)) {
        ph_h2quant(C, (const f16*)(ws + WS_X1H), (const float*)(ws + WS_SS2), (unsigned*)(ws + WS_H2Q), (float*)(ws + WS_HSC));
        xcd_barrier(bar);
        pg8::Gemm g{(const f16*)(ws + WS_H2Q), (const f16*)(ws + WS_WQQ), T, 2048, DM / 2}; pg8::StaticOrder S; S.init(T, 2048, G, (int)blockIdx.x);
        pg8::EpiQ E{(const float*)(ws + WS_HSC), (const float*)(ws + WS_WQS), (f16*)(ws + WS_QP)};
        pg8::gemm_phase<pg8::EpiQ, pg8::StaticOrder, true, true>(L, g, S, E);
    }
    SEAM(6);
    if (IN(7)) REPS(7) {
        auto side = [&]() {
            quant_rows<false>(C, a.in[13], (unsigned*)(ws + WS_UQ), (float*)(ws + WS_US));
            quant_rows<false>(C, a.in[14], (unsigned*)(ws + WS_VQ), (float*)(ws + WS_VS));
        };
        ph_route(C, L, (const f16*)(ws + WS_QP), (const float*)(ws + WS_SS2), (const f16*)(ws + WS_SUBK), (int*)(ws + WS_EIDX), (float*)(ws + WS_EGATE), side);
        if (!(C.wave & 4)) side();
        REPBAR(7); }
    SEAM(7);
    if (IN(8)) REPS(8) {
        const Slicing SL = get_slicing((const unsigned*)(ws + WS_CTL) + CW_BAR, MISC);
        if (PROBE_DUP == 8 && rep_ == 0) ph_upeer<255>(C, L, SL, (const unsigned*)(ws + WS_H2Q), (const int*)(ws + WS_EIDX), (const unsigned char*)(ws + WS_UQ), (short*)(ws + WS_PDOT));
        else ph_upeer<16383>(C, L, SL, (const unsigned*)(ws + WS_H2Q), (const int*)(ws + WS_EIDX), (const unsigned char*)(ws + WS_UQ), (short*)(ws + WS_PDOT));
        REPBAR(8);
    }
    SEAM(8);
    if (IN(9)) {
        ph_ureduce(C, L, (const short*)(ws + WS_PDOT), (const float*)(ws + WS_HSC), (const int*)(ws + WS_EIDX), (const float*)(ws + WS_US), (const float*)(ws + WS_VS), (const float*)(ws + WS_EGATE),
                   (unsigned*)(ws + WS_WQP), (float*)(ws + WS_WSC));
        xcd_barrier(bar);
        const Slicing SL = get_slicing((const unsigned*)(ws + WS_CTL) + CW_BAR, MISC);
        ph_vpeer<16383>(C, SL, (const int*)(ws + WS_EIDX), (const unsigned*)(ws + WS_WQP), (const float*)(ws + WS_WSC), (const unsigned char*)(ws + WS_VQ), (f16*)(ws + WS_PEER));
    }
    SEAM(9);
    if (IN(10)) { ph_final(C, (const f16*)(ws + WS_PEER), a.out, a.in[15]); }
#undef IN
#undef SEAM
}

#ifndef MK_N_LAUNCHES
#define MK_N_LAUNCHES 1
#endif
extern "C" void kernel_launch(void* const* d_in, const int* in_sizes, int n_in, void* d_out, int out_size, void* d_ws, size_t ws_size, hipStream_t stream) {
    static int grid = 0;
    if (grid == 0) {
        if (n_in != 16 || in_sizes[0] != T * DM || out_size != T * DM || ws_size < WS_END) {
            fprintf(stderr, "kernel_launch: unexpected shapes (n_in %d in0 %d out %d ws %zu)\n", n_in, n_in > 0 ? in_sizes[0] : -1, out_size, ws_size);
            grid = -1; return;
        }
        int dev = 0, cus = 0;
        if (hipGetDevice(&dev) != hipSuccess || hipDeviceGetAttribute(&cus, hipDeviceAttributeMultiprocessorCount, dev) != hipSuccess) { grid = -1; return; }
        if (hipFuncSetAttribute((const void*)mk_fwd, hipFuncAttributeMaxDynamicSharedMemorySize, LDS_BYTES) != hipSuccess) { fprintf(stderr, "kernel_launch: hipFuncSetAttribute failed\n"); grid = -1; return; }
        int per_cu = 0;
        if (hipOccupancyMaxActiveBlocksPerMultiprocessor(&per_cu, (const void*)mk_fwd, NTHREADS, LDS_BYTES) != hipSuccess || per_cu < 1)
            fprintf(stderr, "kernel_launch: occupancy query reports %d workgroups per CU\n", per_cu);
        (void)hipGetLastError();
        grid = cus;
    }
    if (grid < 0) return;
    (void)hipMemsetAsync((char*)d_ws + WS_CTL, 0, CTL_ZERO_BYTES, stream);
    Args a{};
    for (int i = 0; i < 16; ++i) a.in[i] = (const float*)d_in[i];
    a.out = (float*)d_out; a.ws = (unsigned char*)d_ws;
    if (MK_N_LAUNCHES == 1) {
        a.ph_lo = 0; a.ph_hi = N_PHASES;
        hipLaunchKernelGGL(mk_fwd, dim3(grid), dim3(NTHREADS), LDS_BYTES, stream, a);
    } else {
        for (int p = 0; p < N_PHASES; ++p) { a.ph_lo = p; a.ph_hi = p + 1; hipLaunchKernelGGL(mk_fwd, dim3(grid), dim3(NTHREADS), LDS_BYTES, stream, a); }
    }
}
```

```cpp
#include <hip/hip_runtime.h>
#include <cstdint>
#include <cstdio>

typedef _Float16 f16;
typedef _Float16 half8 __attribute__((ext_vector_type(8)));
typedef _Float16 half4 __attribute__((ext_vector_type(4)));
typedef _Float16 half2 __attribute__((ext_vector_type(2)));
typedef float f32x4 __attribute__((ext_vector_type(4)));
typedef float f32x16 __attribute__((ext_vector_type(16)));
typedef unsigned u32x4 __attribute__((ext_vector_type(4)));
typedef int i32x4 __attribute__((ext_vector_type(4)));
#define LAS __attribute__((address_space(3)))
#ifndef PROBE_DIAG
#define PROBE_DIAG (0)
#endif
#ifndef PROBE_DUP
#define PROBE_DUP (-1)
#endif
#define GAS __attribute__((address_space(1)))

constexpr int DM = 1024, BATCH = 16, SEQ = 2048, T = BATCH * SEQ;
constexpr int NQKVU = 1280, NGATE = 2048, NCAT = NQKVU + NGATE;
constexpr int COL_K = 512, COL_V = 640, COL_U = 768;
constexpr int NEXP = 16384, PEER_H = 8, TOPK = 16;
constexpr float EPS = 1e-6f;
constexpr int NWAVES = 8, NTHREADS = NWAVES * 64;

constexpr size_t MiB = 1u << 20;
constexpr size_t WS_CTL = 0, CTL_ZERO_BYTES = 64 * 1024;
constexpr size_t WS_WCAT = 1 * MiB;
constexpr size_t WS_WB = 8 * MiB;
constexpr size_t WS_WOUT = 10 * MiB;
constexpr size_t WS_WQ = 12 * MiB;
constexpr size_t WS_POOLW = 16 * MiB;
constexpr size_t WS_SUBK = 16 * MiB + 512 * 1024;
constexpr size_t WS_RS1 = 17 * MiB;
constexpr size_t WS_EIDX = 18 * MiB;
constexpr size_t WS_EGATE = 34 * MiB;
constexpr size_t WS_WCATQ = 50 * MiB;
constexpr size_t WS_WCS = 54 * MiB;
constexpr size_t WS_WQQ = 56 * MiB;
constexpr size_t WS_WQS = 59 * MiB;
constexpr size_t WS_RSX = 55 * MiB;
constexpr size_t WS_UTAB = 50 * MiB;
constexpr size_t WS_VTAB = 82 * MiB;
constexpr size_t WS_XH = 114 * MiB;
constexpr size_t WS_MERGED = WS_XH;
constexpr size_t WS_QKVU = 178 * MiB;
constexpr size_t WS_X1H = WS_QKVU;
constexpr size_t WS_PEER = WS_QKVU;
constexpr size_t WS_GATES = 258 * MiB;
constexpr size_t WS_QP = WS_GATES;
constexpr size_t WS_OCAT = 386 * MiB;
constexpr size_t WS_UQ = 450 * MiB;
constexpr size_t WS_VQ = 466 * MiB;
constexpr size_t WS_US = 17 * MiB + 256 * 1024, WS_VS = 17 * MiB + 512 * 1024;
constexpr size_t WS_PDOT = WS_GATES;
constexpr size_t WS_H2Q = 404 * MiB;
constexpr size_t WS_HSC = 403 * MiB;
constexpr size_t WS_SSF = 402 * MiB;
constexpr size_t WS_WQP = 386 * MiB;
constexpr size_t WS_WSC = 390 * MiB;
constexpr size_t WS_ACT = 386 * MiB;
constexpr size_t WS_SS2 = 482 * MiB;
constexpr size_t WS_VT = 484 * MiB;
constexpr size_t WS_END = 492 * MiB;
constexpr int CW_BAR = 4096;

constexpr int RING_OFF = 0, RING_BYTES = 131072;
constexpr int LDSCTL_OFF = RING_BYTES, MISC_OFF = LDSCTL_OFF + 320;
constexpr int LDS_BYTES = 147456;

#define LDS_WAIT() asm volatile("s_waitcnt lgkmcnt(0)" ::: "memory")
template <int CTRL> __device__ __forceinline__ float dppf(float x) { return __uint_as_float(__builtin_amdgcn_update_dpp(0u, __float_as_uint(x), CTRL, 0xf, 0xf, false)); }
template <int CTRL> __device__ __forceinline__ int dppi(int x) { return (int)__builtin_amdgcn_update_dpp(0u, (unsigned)x, CTRL, 0xf, 0xf, false); }
__device__ __forceinline__ float bfly32(float a, float b) { auto r = __builtin_amdgcn_permlane32_swap(__float_as_uint(a), __float_as_uint(b), false, false); return __uint_as_float(r[0]) + __uint_as_float(r[1]); }
__device__ __forceinline__ float bfly16(float a, float b) { auto r = __builtin_amdgcn_permlane16_swap(__float_as_uint(a), __float_as_uint(b), false, false); return __uint_as_float(r[0]) + __uint_as_float(r[1]); }
__device__ __forceinline__ int bfly32i(int a, int b) { auto r = __builtin_amdgcn_permlane32_swap((unsigned)a, (unsigned)b, false, false); return (int)(r[0] + r[1]); }
__device__ __forceinline__ int bfly16i(int a, int b) { auto r = __builtin_amdgcn_permlane16_swap((unsigned)a, (unsigned)b, false, false); return (int)(r[0] + r[1]); }
__device__ __forceinline__ float wave_sum(float x) {
    x += dppf<0x121>(x); x += dppf<0x122>(x); x += dppf<0x124>(x); x += dppf<0x128>(x);
    x = bfly16(x, x); return bfly32(x, x);
}
__device__ __forceinline__ int wave_sum_i(int x) {
    x += dppi<0x121>(x); x += dppi<0x122>(x); x += dppi<0x124>(x); x += dppi<0x128>(x);
    x = bfly16i(x, x); return bfly32i(x, x);
}
__device__ __forceinline__ float wave_max(float x) {
    x = fmaxf(x, dppf<0x121>(x)); x = fmaxf(x, dppf<0x122>(x)); x = fmaxf(x, dppf<0x124>(x)); x = fmaxf(x, dppf<0x128>(x));
    { auto r = __builtin_amdgcn_permlane16_swap(__float_as_uint(x), __float_as_uint(x), false, false); x = fmaxf(__uint_as_float(r[0]), __uint_as_float(r[1])); }
    { auto r = __builtin_amdgcn_permlane32_swap(__float_as_uint(x), __float_as_uint(x), false, false); x = fmaxf(__uint_as_float(r[0]), __uint_as_float(r[1])); }
    return x;
}
__device__ __forceinline__ float gelu_exact(float x) { return 0.5f * x * (1.0f + erff(x * 0.70710678118654752f)); }
__device__ __forceinline__ float rs_from_ss(const float* ss, int t) {
    float s = 0.f;
#pragma unroll
    for (int i = 0; i < 16; ++i) s += ss[(size_t)i * T + t];
    return rsqrtf(s * (1.0f / DM) + EPS);
}

struct Ctx {
    int tid, lane, wave;
    int G;
    int gw, ngw;
    int gt, ngt;
};

__device__ __forceinline__ int pack4_i8(float a, float b, float c, float d) {
    const int ia = (int)rintf(a), ib = (int)rintf(b), ic = (int)rintf(c), id = (int)rintf(d);
    return (ia & 0xff) | ((ib & 0xff) << 8) | ((ic & 0xff) << 16) | (id << 24);
}
template <bool OFFS>
__device__ __forceinline__ void quant_rows(const Ctx& C, const float* __restrict__ tab, unsigned* __restrict__ q, float* __restrict__ scale) {
    const int lane = C.lane;
    for (int r = C.gw; r < NEXP; r += C.ngw) {
        const float* row = tab + (size_t)r * DM;
        f32x4 v[4]; float m = 0.f;
#pragma unroll
        for (int j = 0; j < 4; ++j) { v[j] = *(const f32x4*)(row + j * 256 + lane * 4); m = fmaxf(m, fmaxf(fmaxf(fabsf(v[j][0]), fabsf(v[j][1])), fmaxf(fabsf(v[j][2]), fabsf(v[j][3])))); }
        m = wave_max(m);
        const float inv = m > 0.f ? 127.0f / m : 0.f;
#pragma unroll
        for (int j = 0; j < 4; ++j) {
            unsigned w = (unsigned)pack4_i8(v[j][0] * inv, v[j][1] * inv, v[j][2] * inv, v[j][3] * inv);
            if (OFFS) w ^= 0x80808080u;
            { const int dw = j * 64 + lane; q[(size_t)(dw >> 5) * (NEXP * 32) + (size_t)r * 32 + (dw & 31)] = w; }
        }
        if (lane == 0) scale[r] = m * (1.0f / 127.0f);
    }
}

__device__ __forceinline__ void p0_transpose_item(const float* W, int K, int N, f16* WT, int ldo, int koff, LAS float* scr, int item, int lane) {
    const int nblk = N / 32, kb = item / nblk, nb = item % nblk, k0 = 64 * kb, n0 = 32 * nb;
#pragma unroll 8
    for (int i = 0; i < 32; ++i) { const int kk = 2 * i + (lane >> 5); scr[kk * 33 + (lane & 31)] = W[(size_t)(k0 + kk) * N + n0 + (lane & 31)]; }
    LDS_WAIT(); asm volatile("" ::: "memory");
    const int c = lane & 7;
#pragma unroll
    for (int j = 0; j < 4; ++j) { const int n = (lane >> 3) + 8 * j; const LAS float* s = scr + (8 * c) * 33 + n;
        half8 o;
#pragma unroll
        for (int i = 0; i < 8; ++i) o[i] = (f16)s[i * 33];
        *(half8*)(WT + (size_t)(n0 + n) * ldo + koff + k0 + 8 * c) = o; }
    LDS_WAIT(); asm volatile("" ::: "memory");
}
__device__ __forceinline__ void cvt_stream(const Ctx& C, const float* in, f16* out, size_t n4) {
    for (size_t i = (size_t)C.gt; i < n4; i += (size_t)C.ngt) {
        const f32x4 v = ((const f32x4*)in)[i];
        half4 h; h[0] = (f16)v[0]; h[1] = (f16)v[1]; h[2] = (f16)v[2]; h[3] = (f16)v[3];
        ((half4*)out)[i] = h;
    }
}
__device__ __forceinline__ void rowprep(const Ctx& C, const float* x, const float* g, unsigned* xq, float* rsx, float* ss) {
    const int lane = C.lane;
    f32x4 gg[4];
#pragma unroll
    for (int j = 0; j < 4; ++j) gg[j] = *(const f32x4*)(g + j * 256 + lane * 4);
    for (int tb = C.gw * 4; tb < T; tb += C.ngw * 4) {
        f32x4 v[4][4];
#pragma unroll
        for (int u = 0; u < 4; ++u)
#pragma unroll
            for (int j = 0; j < 4; ++j) v[u][j] = *(const f32x4*)(x + (size_t)(tb + u) * DM + j * 256 + lane * 4);
#pragma unroll
        for (int u = 0; u < 4; ++u) {
            float s = 0.f, am = 0.f;
#pragma unroll
            for (int j = 0; j < 4; ++j) {
                const f32x4 w = v[u][j];
                s += w[0] * w[0] + w[1] * w[1] + w[2] * w[2] + w[3] * w[3];
                v[u][j] = w * gg[j];
                am = fmaxf(am, fmaxf(fmaxf(fabsf(v[u][j][0]), fabsf(v[u][j][1])), fmaxf(fabsf(v[u][j][2]), fabsf(v[u][j][3]))));
            }
            s = wave_sum(s); am = wave_max(am);
            const float inv = am > 0.f ? 127.0f / am : 0.f;
#pragma unroll
            for (int j = 0; j < 4; ++j) xq[(size_t)(tb + u) * 256 + j * 64 + lane] = (unsigned)pack4_i8(v[u][j][0] * inv, v[u][j][1] * inv, v[u][j][2] * inv, v[u][j][3] * inv);
            if (lane == 0) { ss[tb + u] = s; rsx[tb + u] = am * (1.0f / 127.0f); }
        }
    }
}
__device__ __forceinline__ void quant_wrows(const Ctx& C, const f16* __restrict__ w, int rows, unsigned* __restrict__ q, float* __restrict__ scale) {
    const int lane = C.lane;
    for (int r = C.gw; r < rows; r += C.ngw) {
        const half8 a = *(const half8*)(w + (size_t)r * DM + 16 * lane), b = *(const half8*)(w + (size_t)r * DM + 16 * lane + 8);
        float m = 0.f;
#pragma unroll
        for (int i = 0; i < 8; ++i) m = fmaxf(m, fmaxf(fabsf((float)a[i]), fabsf((float)b[i])));
        m = wave_max(m);
        const float inv = m > 0.f ? 127.0f / m : 0.f;
        u32x4 o;
        o[0] = (unsigned)pack4_i8((float)a[0] * inv, (float)a[1] * inv, (float)a[2] * inv, (float)a[3] * inv);
        o[1] = (unsigned)pack4_i8((float)a[4] * inv, (float)a[5] * inv, (float)a[6] * inv, (float)a[7] * inv);
        o[2] = (unsigned)pack4_i8((float)b[0] * inv, (float)b[1] * inv, (float)b[2] * inv, (float)b[3] * inv);
        o[3] = (unsigned)pack4_i8((float)b[4] * inv, (float)b[5] * inv, (float)b[6] * inv, (float)b[7] * inv);
        *(u32x4*)(q + (size_t)r * 256 + 4 * lane) = o;
        if (lane == 0) scale[r] = m * (1.0f / 127.0f);
    }
}
__device__ __forceinline__ void ph_prep(const Ctx& C, LAS unsigned char* lds, const float* const* in, unsigned char* ws) {
    LAS float* scr = (LAS float*)(lds + RING_OFF + C.wave * 16384);
    f16* wcat = (f16*)(ws + WS_WCAT); f16* wb = (f16*)(ws + WS_WB); f16* wout = (f16*)(ws + WS_WOUT); f16* wq = (f16*)(ws + WS_WQ); f16* poolw = (f16*)(ws + WS_POOLW);
    constexpr int I_IN = 16 * 40, I_G = 16 * 64, I_B = 8 * 32, I_O = 16 * 32, I_Q = 16 * 64, I_P = 2 * 4;
    constexpr int NITEMS = I_IN + I_G + 2 * I_B + I_O + I_Q + 4 * I_P;
    for (int it = C.gw; it < NITEMS; it += C.ngw) {
        int r = it;
        if (r < I_IN) { p0_transpose_item(in[2], 1024, 1280, wcat, 1024, 0, scr, r, C.lane); continue; } r -= I_IN;
        if (r < I_G) { p0_transpose_item(in[7], 1024, 2048, wcat + (size_t)NQKVU * 1024, 1024, 0, scr, r, C.lane); continue; } r -= I_G;
        if (r < I_B) { p0_transpose_item(in[6], 512, 1024, wb, 1024, 0, scr, r, C.lane); continue; } r -= I_B;
        if (r < I_B) { p0_transpose_item(in[6] + 512 * 1024, 512, 1024, wb, 1024, 512, scr, r, C.lane); continue; } r -= I_B;
        if (r < I_O) { p0_transpose_item(in[9], 1024, 1024, wout, 1024, 0, scr, r, C.lane); continue; } r -= I_O;
        if (r < I_Q) { p0_transpose_item(in[11], 1024, 2048, wq, 1024, 0, scr, r, C.lane); continue; } r -= I_Q;
        { const int g = r / I_P; p0_transpose_item(in[4] + g * 128 * 128, 128, 128, poolw + g * 128 * 128, 128, 0, scr, r % I_P, C.lane); }
    }
    cvt_stream(C, in[12], (f16*)(ws + WS_SUBK), (size_t)8 * 2 * 128 * 128 / 4);
    rowprep(C, in[0], in[1], (unsigned*)(ws + WS_XH), (float*)(ws + WS_RSX), (float*)(ws + WS_RS1));
}

__device__ __forceinline__ void ph_attn_naive(const Ctx& C, const f16* __restrict__ qkvu, const float* __restrict__ sink, f16* __restrict__ ocat) {
    for (int gid = C.gt; gid < T * 8; gid += C.ngt) {
        const int t = gid % T, h = gid / T;
        const int b = t / SEQ, ts = t % SEQ, kh = h >> 2;
        float q[64], o[64];
        const f16* qr = qkvu + (size_t)t * NQKVU + h * 64;
#pragma unroll
        for (int d = 0; d < 64; ++d) { q[d] = (float)qr[d]; o[d] = 0.f; }
        const float slope = exp2f(-(float)(h + 1));
        float m = -1e30f, l = 0.f;
        const int s0 = max(ts - 128, 0), s1 = min(ts + 128, SEQ - 1);
        for (int s = s0; s <= s1; ++s) {
            const f16* kr = qkvu + (size_t)(b * SEQ + s) * NQKVU + COL_K + kh * 64;
            const f16* vr = qkvu + (size_t)(b * SEQ + s) * NQKVU + COL_V + kh * 64;
            float dot = 0.f;
#pragma unroll
            for (int d = 0; d < 64; ++d) dot += q[d] * (float)kr[d];
            const float lg = dot * 0.125f - slope * fabsf((float)(ts - s));
            const float mn = fmaxf(m, lg), al = __expf(m - mn), p = __expf(lg - mn);
            l = l * al + p;
#pragma unroll
            for (int d = 0; d < 64; ++d) o[d] = o[d] * al + p * (float)vr[d];
            m = mn;
        }
        const float sk = sink[h];
        const float mn = fmaxf(m, sk), al = __expf(m - mn);
        l = l * al + __expf(sk - mn);
        const float inv = al / l;
        f16* orow = ocat + (size_t)t * DM + h * 64;
#pragma unroll
        for (int d = 0; d < 64; ++d) orow[d] = (f16)(o[d] * inv);
    }
}

template <int DIAG = 0>
__device__ __forceinline__ void attn_unit(const Ctx& C, int u, LAS unsigned char* lds, const f16* __restrict__ qkvu, const f16* __restrict__ vT, const float* __restrict__ sink, f16* __restrict__ ocat) {
    const int lane = C.lane, r32 = lane & 31, hh = lane >> 5;
    const int krow = (r32 & 19) | ((r32 & 4) << 1) | ((r32 & 8) >> 1);
    constexpr float L2E = 1.4426950408889634f;
    {
        const int qs = u & 63, h = (u >> 6) & 7, b = u >> 9, kh = h >> 2;
        const int tq = qs * 32 + r32;
        const float slope2 = exp2f(-(float)(h + 1)) * L2E, sink2 = sink[h] * L2E;
        const f16* qrow = qkvu + (size_t)(b * SEQ + tq) * NQKVU + h * 64 + 8 * hh;
        half8 bq[4];
#pragma unroll
        for (int ks = 0; ks < 4; ++ks) bq[ks] = *(const half8*)(qrow + 16 * ks);
        f32x16 o0, o1;
#pragma unroll
        for (int r = 0; r < 16; ++r) { o0[r] = 0.f; o1[r] = 0.f; }
        float m = -1e30f, l = 0.f;
        const int kb_lo = max(qs - 4, 0), kb_hi = min(qs + 4, 63);
        LAS unsigned char* kst = lds + 65536 + C.wave * 8192; LAS unsigned char* vst = kst + 4096;
        const int krw = lane >> 3, kch = lane & 7, vrw = lane >> 2, vch = lane & 3;
        const f16* kg = qkvu + (size_t)(b * SEQ + krw) * NQKVU + COL_K + kh * 64 + kch * 8;
        const f16* vg = vT + (size_t)((b * 2 + kh) * 64 + vrw) * SEQ + vch * 8;
        half8 gk[4], gv[4];
#pragma unroll
        for (int i = 0; i < 4; ++i) { gk[i] = *(const half8*)(kg + (size_t)(kb_lo * 32 + 8 * i) * NQKVU); gv[i] = *(const half8*)(vg + (size_t)(16 * i) * SEQ + kb_lo * 32); }
#pragma unroll 1
        for (int kb = kb_lo; kb <= kb_hi; ++kb) {
#pragma unroll
            for (int i = 0; i < 4; ++i) {
                const int kr = krw + 8 * i; *(LAS half8*)(kst + kr * 128 + ((kch ^ (kr & 7)) << 4)) = gk[i];
                const int vr = vrw + 16 * i; *(LAS half8*)(vst + vr * 64 + ((vch ^ ((vr >> 2) & 3)) << 4)) = gv[i];
            }
            LDS_WAIT();
            half8 kf[4], va[2][2];
#pragma unroll
            for (int ks = 0; ks < 4; ++ks) kf[ks] = *(const LAS half8*)(kst + krow * 128 + (((2 * ks + hh) ^ (krow & 7)) << 4));
#pragma unroll
            for (int db = 0; db < 2; ++db)
#pragma unroll
                for (int st = 0; st < 2; ++st) { const int d = db * 32 + r32; va[db][st] = *(const LAS half8*)(vst + d * 64 + (((2 * st + hh) ^ ((d >> 2) & 3)) << 4)); }
            LDS_WAIT();
            const int kn = (DIAG == 2) ? kb_lo : (kb < kb_hi ? kb + 1 : kb);
#pragma unroll
            for (int i = 0; i < 4; ++i) { gk[i] = *(const half8*)(kg + (size_t)(kn * 32 + 8 * i) * NQKVU); gv[i] = *(const half8*)(vg + (size_t)(16 * i) * SEQ + kn * 32); }
            f32x16 s;
#pragma unroll
            for (int r = 0; r < 16; ++r) s[r] = 0.f;
#pragma unroll
            for (int ks = 0; ks < 4; ++ks) s = __builtin_amdgcn_mfma_f32_32x32x16_f16(kf[ks], bq[ks], s, 0, 0, 0);
            float bmax = -1e30f; bool ok[16];
#pragma unroll
            for (int r = 0; r < 16; ++r) {
                const int tk = kb * 32 + 16 * (r >> 3) + 8 * hh + (r & 7);
                const int dist = abs(tq - tk);
                ok[r] = dist <= 128;
                s[r] = ok[r] ? s[r] * (0.125f * L2E) - slope2 * (float)dist : -1e30f;
                bmax = fmaxf(bmax, s[r]);
            }
            bmax = fmaxf(bmax, __shfl_xor(bmax, 32));
            const float mn = fmaxf(m, bmax), al = exp2f(m - mn);
            m = mn;
            float ps = 0.f; half8 pb[2];
#pragma unroll
            for (int r = 0; r < 16; ++r) { const float p = ok[r] ? (DIAG == 1 ? (s[r] - mn) : exp2f(s[r] - mn)) : 0.f; ps += p; pb[r >> 3][r & 7] = (f16)p; }
            l = l * al + ps;
#pragma unroll
            for (int r = 0; r < 16; ++r) { o0[r] *= al; o1[r] *= al; }
#pragma unroll
            for (int st = 0; st < 2; ++st) { o0 = __builtin_amdgcn_mfma_f32_32x32x16_f16(va[0][st], pb[st], o0, 0, 0, 0); o1 = __builtin_amdgcn_mfma_f32_32x32x16_f16(va[1][st], pb[st], o1, 0, 0, 0); }
        }
        l += __shfl_xor(l, 32);
        const float mf = fmaxf(m, sink2), al = exp2f(m - mf);
        const float sc = al / (l * al + exp2f(sink2 - mf));
        f16* orow = ocat + (size_t)(b * SEQ + tq) * DM + h * 64 + 4 * hh;
#pragma unroll
        for (int g = 0; g < 4; ++g) {
            half4 a, c;
#pragma unroll
            for (int i = 0; i < 4; ++i) { a[i] = (f16)(o0[4 * g + i] * sc); c[i] = (f16)(o1[4 * g + i] * sc); }
            *(half4*)(orow + 8 * g) = a; *(half4*)(orow + 32 + 8 * g) = c;
        }
    }
}

__device__ __forceinline__ void attn_unit2(const Ctx& C, int u, LAS unsigned char* lds, const f16* __restrict__ qkvu, const f16* __restrict__ vT, const float* __restrict__ sink, f16* __restrict__ ocat) {
    const int lane = C.lane, r32 = lane & 31, hh = lane >> 5;
    const int krow = (r32 & 19) | ((r32 & 4) << 1) | ((r32 & 8) >> 1);
    constexpr float L2E = 1.4426950408889634f;
    const int qp = u & 31, h = (u >> 5) & 7, b = u >> 8, kh = h >> 2;
    const float slope2 = exp2f(-(float)(h + 1)) * L2E, sink2 = sink[h] * L2E;
    LAS unsigned char* qst = lds + 65536 + C.wave * 8192 + lane * 16;
    f32x16 o0[2], o1[2]; float m[2], l[2]; int tq[2];
#pragma unroll
    for (int j = 0; j < 2; ++j) {
        tq[j] = (2 * qp + j) * 32 + r32;
        const f16* qrow = qkvu + (size_t)(b * SEQ + tq[j]) * NQKVU + h * 64 + 8 * hh;
#pragma unroll
        for (int ks = 0; ks < 4; ++ks) *(LAS half8*)(qst + (j * 4 + ks) * 1024) = *(const half8*)(qrow + 16 * ks);
#pragma unroll
        for (int r = 0; r < 16; ++r) { o0[j][r] = 0.f; o1[j][r] = 0.f; }
        m[j] = -1e30f; l[j] = 0.f;
    }
    const int kb_lo = max(2 * qp - 4, 0), kb_hi = min(2 * qp + 5, 63);
    LAS unsigned char* kst = lds + C.wave * 8192; LAS unsigned char* vst = kst + 4096;
    const int krw = lane >> 3, kch = lane & 7, vrw = lane >> 2, vch = lane & 3;
    const f16* kg = qkvu + (size_t)(b * SEQ + krw) * NQKVU + COL_K + kh * 64 + kch * 8;
    const f16* vg = vT + (size_t)((b * 2 + kh) * 64 + vrw) * SEQ + vch * 8;
    half8 gk[4], gv[4];
#pragma unroll
    for (int i = 0; i < 4; ++i) { gk[i] = *(const half8*)(kg + (size_t)(kb_lo * 32 + 8 * i) * NQKVU); gv[i] = *(const half8*)(vg + (size_t)(16 * i) * SEQ + kb_lo * 32); }
#pragma unroll 1
    for (int kb = kb_lo; kb <= kb_hi; ++kb) {
#pragma unroll
        for (int i = 0; i < 4; ++i) {
            const int kr = krw + 8 * i; *(LAS half8*)(kst + kr * 128 + ((kch ^ (kr & 7)) << 4)) = gk[i];
            const int vr = vrw + 16 * i; *(LAS half8*)(vst + vr * 64 + ((vch ^ ((vr >> 2) & 3)) << 4)) = gv[i];
        }
        LDS_WAIT();
        half8 kf[4], va[2][2];
#pragma unroll
        for (int ks = 0; ks < 4; ++ks) kf[ks] = *(const LAS half8*)(kst + krow * 128 + (((2 * ks + hh) ^ (krow & 7)) << 4));
#pragma unroll
        for (int db = 0; db < 2; ++db)
#pragma unroll
            for (int st = 0; st < 2; ++st) { const int d = db * 32 + r32; va[db][st] = *(const LAS half8*)(vst + d * 64 + (((2 * st + hh) ^ ((d >> 2) & 3)) << 4)); }
        LDS_WAIT();
        const int kn = kb < kb_hi ? kb + 1 : kb;
#pragma unroll
        for (int i = 0; i < 4; ++i) { gk[i] = *(const half8*)(kg + (size_t)(kn * 32 + 8 * i) * NQKVU); gv[i] = *(const half8*)(vg + (size_t)(16 * i) * SEQ + kn * 32); }
#pragma unroll
        for (int j = 0; j < 2; ++j) {
            if (abs(kb - (2 * qp + j)) > 4) continue;
            f32x16 s;
#pragma unroll
            for (int r = 0; r < 16; ++r) s[r] = 0.f;
#pragma unroll
            for (int ks = 0; ks < 4; ++ks) s = __builtin_amdgcn_mfma_f32_32x32x16_f16(kf[ks], *(const volatile LAS half8*)(qst + (j * 4 + ks) * 1024), s, 0, 0, 0);
            float bmax = -1e30f; bool ok[16];
#pragma unroll
            for (int r = 0; r < 16; ++r) {
                const int tk = kb * 32 + 16 * (r >> 3) + 8 * hh + (r & 7);
                const int dist = abs(tq[j] - tk);
                ok[r] = dist <= 128;
                s[r] = ok[r] ? s[r] * (0.125f * L2E) - slope2 * (float)dist : -1e30f;
                bmax = fmaxf(bmax, s[r]);
            }
            bmax = fmaxf(bmax, __shfl_xor(bmax, 32));
            const float mn = fmaxf(m[j], bmax), al = exp2f(m[j] - mn);
            m[j] = mn;
            float ps = 0.f; half8 pb[2];
#pragma unroll
            for (int r = 0; r < 16; ++r) { const float pv = ok[r] ? exp2f(s[r] - mn) : 0.f; ps += pv; pb[r >> 3][r & 7] = (f16)pv; }
            l[j] = l[j] * al + ps;
#pragma unroll
            for (int r = 0; r < 16; ++r) { o0[j][r] *= al; o1[j][r] *= al; }
#pragma unroll
            for (int st = 0; st < 2; ++st) { o0[j] = __builtin_amdgcn_mfma_f32_32x32x16_f16(va[0][st], pb[st], o0[j], 0, 0, 0); o1[j] = __builtin_amdgcn_mfma_f32_32x32x16_f16(va[1][st], pb[st], o1[j], 0, 0, 0); }
            __builtin_amdgcn_sched_barrier(0);
        }
    }
#pragma unroll
    for (int j = 0; j < 2; ++j) {
        const float lt = l[j] + __shfl_xor(l[j], 32);
        const float mf = fmaxf(m[j], sink2), al = exp2f(m[j] - mf);
        const float sc = al / (lt * al + exp2f(sink2 - mf));
        f16* orow = ocat + (size_t)(b * SEQ + tq[j]) * DM + h * 64 + 4 * hh;
#pragma unroll
        for (int g = 0; g < 4; ++g) {
            half4 a, c;
#pragma unroll
            for (int i = 0; i < 4; ++i) { a[i] = (f16)(o0[j][4 * g + i] * sc); c[i] = (f16)(o1[j][4 * g + i] * sc); }
            *(half4*)(orow + 8 * g) = a; *(half4*)(orow + 32 + 8 * g) = c;
        }
    }
}

__device__ __forceinline__ void ph_pool_naive(const Ctx& C, const f16* __restrict__ qkvu, f16* __restrict__ mixed) {
    for (size_t gid = (size_t)C.gt; gid < (size_t)T * 512; gid += (size_t)C.ngt) {
        const int c = (int)(gid & 511), t = (int)(gid >> 9);
        const int b = t / SEQ, ts = t % SEQ, g = c >> 7, w = 2 << g;
        const int lo = max(ts - w / 2, 0), hi = min(ts + w / 2, SEQ);
        float s = 0.f;
        for (int i = lo; i < hi; ++i) s += (float)qkvu[(size_t)(b * SEQ + i) * NQKVU + COL_U + c];
        const float mean = s / (float)(hi - lo);
        mixed[(size_t)t * 512 + c] = (f16)(mean - (float)qkvu[(size_t)t * NQKVU + COL_U + c]);
    }
}
__device__ __forceinline__ void ph_poolmm_naive(const Ctx& C, const f16* __restrict__ mixed, const f16* __restrict__ poolw_t, const float* __restrict__ pscale, f16* __restrict__ ocat) {
    for (size_t gid = (size_t)C.gt; gid < (size_t)T * 512; gid += (size_t)C.ngt) {
        const int n = (int)(gid & 511), t = (int)(gid >> 9), g = n >> 7, d = n & 127;
        const f16* mr = mixed + (size_t)t * 512 + g * 128;
        const f16* wr = poolw_t + (size_t)(g * 128 + d) * 128;
        float acc = 0.f;
        for (int c = 0; c < 128; ++c) acc += (float)mr[c] * (float)wr[c];
        ocat[(size_t)t * DM + 512 + n] = (f16)(acc * pscale[n]);
    }
}

template <int HW>
__device__ __forceinline__ void pool_step1(const f16* __restrict__ qkvu, LAS unsigned char* tile, int t0, int g, int lane) {
    const int c2 = lane, b = t0 >> 11, sf = t0 & (SEQ - 1);
    const f16* ub = qkvu + (size_t)(b * SEQ) * NQKVU + COL_U + g * 128 + 2 * c2;
    constexpr int NR = 32 + 2 * HW - 1;
    half2 v[NR];
#pragma unroll
    for (int i = 0; i < NR; ++i) { const int s = sf - HW + i; half2 z; z[0] = (f16)0.f; z[1] = (f16)0.f; v[i] = z; if (s >= 0 && s < SEQ) v[i] = *(const half2*)(ub + (size_t)s * NQKVU); }
    float s0 = 0.f, s1 = 0.f;
#pragma unroll
    for (int i = 0; i < 2 * HW - 1; ++i) { s0 += (float)v[i][0]; s1 += (float)v[i][1]; }
#pragma unroll
    for (int j = 0; j < 32; ++j) {
        s0 += (float)v[j + 2 * HW - 1][0]; s1 += (float)v[j + 2 * HW - 1][1];
        const int s = sf + j, lo = max(s - HW, 0), hi = min(s + HW, SEQ);
        const float inv = 1.0f / (float)(hi - lo);
        half2 mx; mx[0] = (f16)(s0 * inv - (float)v[j + HW][0]); mx[1] = (f16)(s1 * inv - (float)v[j + HW][1]);
        *(LAS half2*)(tile + j * 256 + (((c2 >> 2) ^ (j & 15)) << 4) + ((c2 & 3) << 2)) = mx;
        s0 -= (float)v[j][0]; s1 -= (float)v[j][1];
    }
}
__device__ __forceinline__ void pool_unit(const Ctx& C, int u, LAS unsigned char* lds, const f16* __restrict__ qkvu, const f16* __restrict__ poolw_t, const float* __restrict__ pscale, f16* __restrict__ ocat) {
    const int lane = C.lane, r32 = lane & 31, hh = lane >> 5;
    LAS unsigned char* tile = lds + C.wave * 8192;
    const int g = u & 3, t0 = (u >> 2) * 32;
    switch (g) { case 0: pool_step1<1>(qkvu, tile, t0, g, lane); break; case 1: pool_step1<2>(qkvu, tile, t0, g, lane); break;
                 case 2: pool_step1<4>(qkvu, tile, t0, g, lane); break; default: pool_step1<8>(qkvu, tile, t0, g, lane); break; }
    LDS_WAIT();
    f32x16 acc[4];
#pragma unroll
    for (int db = 0; db < 4; ++db)
#pragma unroll
        for (int r = 0; r < 16; ++r) acc[db][r] = 0.f;
    const f16* wr = poolw_t + (size_t)(g * 128 + r32) * 128 + 8 * hh;
#pragma unroll
    for (int ks = 0; ks < 8; ++ks) {
        const half8 bm = *(const LAS half8*)(tile + r32 * 256 + (((2 * ks + hh) ^ (r32 & 15)) << 4));
#pragma unroll
        for (int db = 0; db < 4; ++db) { const half8 a = *(const half8*)(wr + (size_t)(db * 32) * 128 + 16 * ks); acc[db] = __builtin_amdgcn_mfma_f32_32x32x16_f16(a, bm, acc[db], 0, 0, 0); }
    }
    LDS_WAIT();
    f16* orow = ocat + (size_t)(t0 + r32) * DM + 512 + g * 128 + 4 * hh;
    const float* ps = pscale + g * 128 + 4 * hh;
#pragma unroll
    for (int db = 0; db < 4; ++db)
#pragma unroll
        for (int q = 0; q < 4; ++q) {
            const f32x4 pv = *(const f32x4*)(ps + db * 32 + 8 * q);
            half4 x0;
#pragma unroll
            for (int i = 0; i < 4; ++i) x0[i] = (f16)(acc[db][4 * q + i] * pv[i]);
            *(half4*)(orow + db * 32 + 8 * q) = x0;
        }
}
__device__ __forceinline__ void ph_attn_pool(const Ctx& C, LAS unsigned char* lds, const f16* __restrict__ qkvu, const f16* __restrict__ vT, const float* __restrict__ sink,
                                             const f16* __restrict__ poolw_t, const float* __restrict__ pscale, f16* __restrict__ ocat) {
    const int vwg = (C.G % 8 == 0) ? (int)(blockIdx.x % 8) * (C.G / 8) + (int)(blockIdx.x / 8) : (int)blockIdx.x;
    const bool pool_first = (C.wave & 4) != 0;
    for (int i = 0, m = vwg * NWAVES + C.wave; m < (T / 32) * 4; ++i) {
        if (((i & 1) == 0) == pool_first) pool_unit(C, m, lds, qkvu, poolw_t, pscale, ocat);
        else attn_unit2(C, m, lds, qkvu, vT, sink, ocat);
        if (i & 1) m += C.ngw;
    }
}

#define INS(LV, LI, v_, i_) do { float cv_ = (v_); int ci_ = (i_); \
    _Pragma("unroll") for (int z_ = 0; z_ < 16; ++z_) { const bool gt_ = cv_ > LV[z_]; const float tv_ = gt_ ? LV[z_] : cv_; const int ti_ = gt_ ? LI[z_] : ci_; \
        LV[z_] = gt_ ? cv_ : LV[z_]; LI[z_] = gt_ ? ci_ : LI[z_]; cv_ = tv_; ci_ = ti_; } } while (0)
__device__ __forceinline__ void ph_route_naive(const Ctx& C, const f16* __restrict__ qp, const float* __restrict__ ss2, const f16* __restrict__ subk, int* __restrict__ eidx, float* __restrict__ egate) {
    for (int gid = C.gt; gid < T * 8; gid += C.ngt) {
        const int t = gid % T, h = gid / T;
        const float rs2 = rs_from_ss(ss2, t);
        float av[16], bv[16]; int ai[16], bi[16];
#pragma unroll
        for (int z = 0; z < 16; ++z) { av[z] = -3e38f; bv[z] = -3e38f; ai[z] = 0; bi[z] = 0; }
        for (int p = 0; p < 2; ++p) {
            const f16* qr = qp + (size_t)t * 2048 + h * 256 + p * 128;
            for (int n = 0; n < 128; ++n) {
                const f16* kr = subk + ((size_t)((h * 2 + p) * 128 + n)) * 128;
                float dot = 0.f;
                for (int c = 0; c < 128; ++c) dot += (float)qr[c] * (float)kr[c];
                dot *= rs2;
                if (p == 0) INS(av, ai, dot, n); else INS(bv, bi, dot, n);
            }
        }
        float cv[16]; int ci[16];
#pragma unroll
        for (int z = 0; z < 16; ++z) { cv[z] = -3e38f; ci[z] = 0; }
#pragma unroll
        for (int i = 0; i < 16; ++i)
#pragma unroll
            for (int j = 0; j < 16; ++j)
                if ((i + 1) * (j + 1) <= 16) INS(cv, ci, av[i] + bv[j], ai[i] * 128 + bi[j]);
        float sum = 0.f, e[16];
#pragma unroll
        for (int z = 0; z < 16; ++z) { e[z] = __expf(cv[z] - cv[0]); sum += e[z]; }
        const float inv = 1.0f / sum;
#pragma unroll
        for (int z = 0; z < 16; ++z) { eidx[(size_t)t * 128 + h * 16 + z] = ci[z]; egate[(size_t)t * 128 + h * 16 + z] = e[z] * inv; }
    }
}

__device__ __forceinline__ int mono_i(float f) { const int b = __float_as_int(f); return b ^ ((b >> 31) & 0x7fffffff); }
__device__ __forceinline__ float unmono_f(int m) { return __int_as_float(m ^ ((m >> 31) & 0x7fffffff)); }
#define INS16(Lst, x_) do { int xv_ = (x_); _Pragma("unroll") for (int z_ = 0; z_ < 16; ++z_) { const int hi_ = max(Lst[z_], xv_); xv_ = min(Lst[z_], xv_); Lst[z_] = hi_; } } while (0)
__device__ __forceinline__ void merge_pair16(int (&Lst)[16]) {
    int P[16];
#pragma unroll
    for (int z = 0; z < 16; ++z) P[z] = __shfl_xor(Lst[z], 32);
#pragma unroll
    for (int z = 0; z < 16; ++z) Lst[z] = max(Lst[z], P[15 - z]);
#pragma unroll
    for (int s = 8; s >= 1; s >>= 1)
#pragma unroll
        for (int i = 0; i < 16; ++i) if ((i & s) == 0) { const int hi = max(Lst[i], Lst[i + s]), lo = min(Lst[i], Lst[i + s]); Lst[i] = hi; Lst[i + s] = lo; }
}
__device__ __forceinline__ void bitonic_sort16_desc(int (&K)[16]) {
#pragma unroll
    for (int k = 2; k <= 16; k <<= 1)
#pragma unroll
        for (int j = k >> 1; j > 0; j >>= 1)
#pragma unroll
            for (int i = 0; i < 16; ++i) { const int l = i ^ j; if (l > i) { const int a = K[i], b = K[l], hi = max(a, b), lo = min(a, b); const bool desc = (i & k) == 0; K[i] = desc ? hi : lo; K[l] = desc ? lo : hi; } }
}
__device__ __forceinline__ void bitonic_merge16_desc(int (&K)[16]) {
#pragma unroll
    for (int s = 8; s >= 1; s >>= 1)
#pragma unroll
        for (int i = 0; i < 16; ++i) if ((i & s) == 0) { const int hi = max(K[i], K[i + s]), lo = min(K[i], K[i + s]); K[i] = hi; K[i + s] = lo; }
}
template <class Side>
__device__ __forceinline__ void ph_route(const Ctx& C, LAS unsigned char* lds, const f16* __restrict__ qp, const float* __restrict__ ss2, const f16* __restrict__ subk,
                                         int* __restrict__ eidx, float* __restrict__ egate, const Side& side_job) {
    const int lane = C.lane, r32 = lane & 31, hh = lane >> 5;
    LAS unsigned char* tab = lds + 65536 + C.wave * 4096 + lane * 36;
    const int GH = C.G < 8 ? C.G : 8;
  for (int h = blockIdx.x % GH; h < 8; h += GH) {
    const int rank_h = blockIdx.x / GH, nwg_h = (C.G - (blockIdx.x % GH) + GH - 1) / GH;
    __syncthreads();
    for (int i = C.tid; i < 2 * 128 * 16; i += NTHREADS) {
        const int row = i >> 4, ch = i & 15;
        *(LAS half8*)(lds + row * 256 + ((ch ^ (row & 15)) << 4)) = *(const half8*)(subk + (size_t)(h * 256 + row) * 128 + ch * 8);
    }
    __syncthreads();
    if (h == (int)(blockIdx.x % GH) && (C.wave & 4)) side_job();
    for (int tb = rank_h * NWAVES + C.wave; tb < T / 32; tb += nwg_h * NWAVES) {
        const int t0 = tb * 32, t = t0 + r32;
        int top[2][16];
#pragma unroll
        for (int p = 0; p < 2; ++p) {
            const f16* qrow = qp + (size_t)t * 2048 + h * 256 + p * 128 + 8 * hh;
            const LAS unsigned char* kl = lds + (p * 128 + r32) * 256;
            half8 bq[8];
#pragma unroll
            for (int ks = 0; ks < 8; ++ks) bq[ks] = *(const half8*)(qrow + 16 * ks);
            int Lst[16];
#pragma unroll
            for (int z = 0; z < 16; ++z) Lst[z] = (int)0x80000000;
#pragma unroll 1
            for (int nb = 0; nb < 4; ++nb) {
                f32x16 acc = {0.f, 0.f, 0.f, 0.f, 0.f, 0.f, 0.f, 0.f, 0.f, 0.f, 0.f, 0.f, 0.f, 0.f, 0.f, 0.f};
#pragma unroll
                for (int ks = 0; ks < 8; ++ks) {
                    const half8 ak = *(const LAS half8*)(kl + nb * 32 * 256 + (((2 * ks + hh) ^ (r32 & 15)) << 4));
                    acc = __builtin_amdgcn_mfma_f32_32x32x16_f16(ak, bq[ks], acc, 0, 0, 0);
                }
                int K[16];
#pragma unroll
                for (int r = 0; r < 16; ++r) { const int n = nb * 32 + (r & 3) + 8 * (r >> 2) + 4 * hh; K[r] = (mono_i(acc[r]) & ~127) | (127 - n); }
                bitonic_sort16_desc(K);
#pragma unroll
                for (int z = 0; z < 16; ++z) Lst[z] = max(Lst[z], K[15 - z]);
                bitonic_merge16_desc(Lst);
            }
            merge_pair16(Lst);
#pragma unroll
            for (int z = 0; z < 16; ++z) top[p][z] = Lst[z];
        }
        float va[16], vb[16];
#pragma unroll
        for (int z = 0; z < 16; ++z) { va[z] = unmono_f(top[0][z] & ~127); vb[z] = unmono_f(top[1][z] & ~127);
            tab[z] = (unsigned char)(127 - (top[0][z] & 127)); tab[16 + z] = (unsigned char)(127 - (top[1][z] & 127)); }
        int Cl[16];
        { const float a01 = hh ? va[1] : va[0];
#pragma unroll
          for (int j = 0; j < 16; ++j) { const int key = (mono_i(a01 + vb[j]) & ~255) | (255 - (hh * 16 + j)); Cl[j] = (hh && j >= 8) ? (int)0x80000000 : key; } }
#pragma unroll
        for (int i = 2; i < 16; i += 2) {
            const float ai = hh ? va[i + 1] : va[i];
#pragma unroll
            for (int j = 0; j < 16; ++j)
                if ((i + 1) * (j + 1) <= 16) {
                    int key = (mono_i(ai + vb[j]) & ~255) | (255 - ((i + hh) * 16 + j));
                    if ((i + 2) * (j + 1) > 16) key = hh ? (int)0x80000000 : key;
                    INS16(Cl, key);
                }
        }
        merge_pair16(Cl);
        float e[16], sum = 0.f; const float mx = unmono_f(Cl[0] & ~255);
#pragma unroll
        for (int z = 0; z < 16; ++z) { e[z] = __expf(unmono_f(Cl[z] & ~255) - mx); sum += e[z]; }
        const float inv = 1.0f / sum;
        LDS_WAIT();
        int* ei = eidx + (size_t)t * 128 + h * 16 + 8 * hh; float* eg = egate + (size_t)t * 128 + h * 16 + 8 * hh;
#pragma unroll
        for (int z = 0; z < 16; ++z) {
            if ((z >> 3) == hh) { const int code = 255 - (Cl[z] & 255); const int ia = tab[code >> 4], ib = tab[16 + (code & 15)];
                ei[z & 7] = ia * 128 + ib; eg[z & 7] = e[z] * inv; }
        }
        LDS_WAIT();
    }
  }
}

struct Slicing { int m, pi, nloc, rank; };
__device__ __forceinline__ Slicing get_slicing(const unsigned* bar, volatile LAS unsigned* misc) {
    Slicing S; const unsigned x = (unsigned)__builtin_amdgcn_s_getreg((3 << 11) | 20) & 0xFu;
    int m = 0, pi = 0, nloc = 1;
    for (unsigned j = 0; j < 16; ++j) { const unsigned c = __hip_atomic_load(&bar[256 + 64 * j], __ATOMIC_RELAXED, __HIP_MEMORY_SCOPE_AGENT); if (c > 0u) { if (j < x) ++pi; ++m; } if (j == x) nloc = (int)c; }
    S.m = m > 0 ? m : 1; S.pi = pi; S.nloc = nloc > 0 ? nloc : 1; S.rank = (int)misc[10];
    return S;
}
__device__ __forceinline__ float gelu_fast(float v) {
    const float av = fabsf(v), t = __builtin_amdgcn_rcpf(av * 0.2316418882f + 1.0f);
    float q = t * 0.5307027145f + (-0.7265760135f); q = q * t + 0.7107068705f; q = q * t + (-0.142248368f); q = q * t + 0.127414796f; q = q * t;
    const float m = v * (q * __builtin_amdgcn_exp2f((v * v) * (-0.72134752044f)));
    return v < 0.f ? m : v - m;
}
__device__ __forceinline__ void ph_h2quant(const Ctx& C, const f16* __restrict__ x1h, const float* __restrict__ ss2, unsigned* __restrict__ h2q, float* __restrict__ hsc) {
    const int lane = C.lane;
    for (int t = C.gw; t < T; t += C.ngw) {
        const half8 h0 = *(const half8*)(x1h + (size_t)t * DM + 16 * lane), h1 = *(const half8*)(x1h + (size_t)t * DM + 16 * lane + 8);
        float hm = 0.f;
#pragma unroll
        for (int i = 0; i < 8; ++i) hm = fmaxf(hm, fmaxf(fabsf((float)h0[i]), fabsf((float)h1[i])));
        hm = wave_max(hm);
        const float inv = hm > 0.f ? 127.0f / hm : 0.f;
        u32x4 w;
        w[0] = (unsigned)pack4_i8((float)h0[0] * inv, (float)h0[1] * inv, (float)h0[2] * inv, (float)h0[3] * inv);
        w[1] = (unsigned)pack4_i8((float)h0[4] * inv, (float)h0[5] * inv, (float)h0[6] * inv, (float)h0[7] * inv);
        w[2] = (unsigned)pack4_i8((float)h1[0] * inv, (float)h1[1] * inv, (float)h1[2] * inv, (float)h1[3] * inv);
        w[3] = (unsigned)pack4_i8((float)h1[4] * inv, (float)h1[5] * inv, (float)h1[6] * inv, (float)h1[7] * inv);
        *(u32x4*)(h2q + (size_t)t * 256 + 4 * lane) = w;
        if (lane == 0) hsc[t] = hm * (1.0f / 127.0f) * rs_from_ss(ss2, t);
    }
}
__device__ __forceinline__ __amdgpu_buffer_rsrc_t slice_rsrc(const unsigned char* base) {
    const unsigned long long b = (unsigned long long)base;
    const unsigned lo = __builtin_amdgcn_readfirstlane((unsigned)b), hi = __builtin_amdgcn_readfirstlane((unsigned)(b >> 32));
    return __builtin_amdgcn_make_buffer_rsrc((void*)(((unsigned long long)hi << 32) | lo), 0, NEXP * 128, 0x00020000);
}
template <int EMASK>
__device__ __forceinline__ void ph_upeer(const Ctx& C, LAS unsigned char* lds, const Slicing SL, const unsigned* __restrict__ h2q, const int* __restrict__ eidx,
                                         const unsigned char* __restrict__ uq, short* __restrict__ pdot) {
    const int lane = C.lane, grp = lane >> 3, c8 = lane & 7;
    const int wv = SL.rank * NWAVES + C.wave, nwv = SL.nloc * NWAVES;
    const int ntok = (T - wv + nwv - 1) / nwv;
    auto tok = [&](int i) { const int t = wv + i * nwv; return t < T ? t : T - 1; };
    volatile LAS int* row = (volatile LAS int*)(lds + C.wave * 1024);
  for (int s = SL.pi; s < 8; s += SL.m) {
    const __amdgpu_buffer_rsrc_t urs = slice_rsrc(uq + (size_t)s * (NEXP * 128));
    const unsigned* hqs = h2q + s * 32 + c8 * 4;
    int tA = tok(0), tB = tok(1);
    int e0 = eidx[(size_t)tA * 128 + lane], e1 = eidx[(size_t)tA * 128 + 64 + lane];
    u32x4 hq = *(const u32x4*)(hqs + (size_t)tA * 256);
    int ne0 = eidx[(size_t)tB * 128 + lane], ne1 = eidx[(size_t)tB * 128 + 64 + lane];
    u32x4 r[16];
#pragma unroll
    for (int i = 0; i < 16; ++i) { const int e = __shfl(i < 8 ? e0 : e1, 8 * (i & 7) + grp) & EMASK; r[i] = __builtin_amdgcn_raw_buffer_load_b128(urs, e * 128 + c8 * 16, 0, 0); }
#pragma unroll 1
    for (int it = 0; it < ntok; ++it) {
        const int t = tok(it), t1 = tok(it + 1), t2 = tok(it + 2);
        const int ze0 = eidx[(size_t)t2 * 128 + lane], ze1 = eidx[(size_t)t2 * 128 + 64 + lane];
        const u32x4 nhq = *(const u32x4*)(hqs + (size_t)t1 * 256);
#pragma unroll
        for (int q = 0; q < 4; ++q) {
            int evv[4];
#pragma unroll
            for (int j = 0; j < 4; ++j) evv[j] = __shfl(q < 2 ? ne0 : ne1, 32 * (q & 1) + 8 * j + grp) & EMASK;
            int pa[4], pb[4];
#pragma unroll
            for (int j = 0; j < 4; ++j) {
                pa[j] = __builtin_amdgcn_sdot4((int)r[4 * q + j][0], (int)hq[0], 0, false); pb[j] = __builtin_amdgcn_sdot4((int)r[4 * q + j][1], (int)hq[1], 0, false);
                pa[j] = __builtin_amdgcn_sdot4((int)r[4 * q + j][2], (int)hq[2], pa[j], false); pb[j] = __builtin_amdgcn_sdot4((int)r[4 * q + j][3], (int)hq[3], pb[j], false);
            }
#pragma unroll
            for (int j = 0; j < 4; ++j) { pa[j] += pb[j]; pa[j] += dppi<0xB1>(pa[j]); }
#pragma unroll
            for (int j = 0; j < 4; ++j) pa[j] += dppi<0x4E>(pa[j]);
#pragma unroll
            for (int j = 0; j < 4; ++j) pa[j] += dppi<0x141>(pa[j]);
            if (c8 == 0) {
#pragma unroll
                for (int j = 0; j < 4; ++j) row[8 * (4 * q + j) + grp] = pa[j];
            }
#pragma unroll
            for (int j = 0; j < 4; ++j) {
                asm volatile("" ::: "memory");
                r[4 * q + j] = __builtin_amdgcn_raw_buffer_load_b128(urs, evv[j] * 128 + c8 * 16, 0, 0);
                asm volatile("" ::: "memory");
            }
        }
        LDS_WAIT();
        const int p0 = row[lane], p1 = row[64 + lane];
        LDS_WAIT();
        { short* pp = pdot + ((size_t)s * T + t) * 128 + lane; const int c0 = min(max((p0 + 4) >> 3, -32768), 32767), c1 = min(max((p1 + 4) >> 3, -32768), 32767);
          asm volatile("global_store_short %0, %1, off\n\tglobal_store_short %0, %2, off offset:128" :: "v"(pp), "v"(c0), "v"(c1) : "memory"); }
        hq = nhq; ne0 = ze0; ne1 = ze1;
    }
  }
}
__device__ __forceinline__ void ph_ureduce(const Ctx& C, LAS unsigned char* lds, const short* __restrict__ pdot, const float* __restrict__ hsc, const int* __restrict__ eidx, const float* __restrict__ us,
                                           const float* __restrict__ vs, const float* __restrict__ egate, unsigned* __restrict__ wqp, float* __restrict__ wsc) {
    const int lane = C.lane;
    volatile LAS unsigned char* row = (volatile LAS unsigned char*)(lds + C.wave * 1024);
    for (int tb = C.gw * 2; tb < T; tb += C.ngw * 2) {
        int e0[2], e1[2], s0[2], s1[2]; float h[2], g0[2], g1[2];
#pragma unroll
        for (int u = 0; u < 2; ++u) {
            const int t = tb + u;
            e0[u] = eidx[(size_t)t * 128 + lane]; e1[u] = eidx[(size_t)t * 128 + 64 + lane];
            g0[u] = egate[(size_t)t * 128 + lane]; g1[u] = egate[(size_t)t * 128 + 64 + lane];
            h[u] = hsc[t]; s0[u] = 0; s1[u] = 0;
#pragma unroll
            for (int s = 0; s < 8; ++s) { const short* pp = pdot + ((size_t)s * T + t) * 128 + lane; s0[u] += (int)pp[0]; s1[u] += (int)pp[64]; }
        }
        float w0[2], w1[2];
#pragma unroll
        for (int u = 0; u < 2; ++u) {
            w0[u] = gelu_fast((float)s0[u] * (8.0f * h[u]) * us[e0[u]]) * g0[u] * vs[e0[u]];
            w1[u] = gelu_fast((float)s1[u] * (8.0f * h[u]) * us[e1[u]]) * g1[u] * vs[e1[u]];
        }
#pragma unroll
        for (int u = 0; u < 2; ++u) {
            const int t = tb + u;
            const float wm = wave_max(fmaxf(fabsf(w0[u]), fabsf(w1[u])));
            const float inv = wm > 0.f ? 127.0f / wm : 0.f;
            { const int k = lane; row[u * 128 + (k & 7) * 16 + (k >> 5) * 4 + ((k >> 3) & 3)] = (unsigned char)(int)rintf(w0[u] * inv); }
            { const int k = 64 + lane; row[u * 128 + (k & 7) * 16 + (k >> 5) * 4 + ((k >> 3) & 3)] = (unsigned char)(int)rintf(w1[u] * inv); }
            if (lane == 0) wsc[t] = wm * (1.0f / 127.0f);
        }
        LDS_WAIT();
        wqp[(size_t)tb * 32 + lane] = ((volatile LAS unsigned*)row)[lane];
        LDS_WAIT();
    }
}
template <int EMASK>
__device__ __forceinline__ void ph_vpeer(const Ctx& C, const Slicing SL, const int* __restrict__ eidx, const unsigned* __restrict__ wqp, const float* __restrict__ wsc, const unsigned char* __restrict__ vq,
                                         f16* __restrict__ peer) {
    const int lane = C.lane, grp = lane >> 3, c8 = lane & 7;
    const bool hh = (lane & 32) != 0, b4 = (lane & 16) != 0, b3 = (lane & 8) != 0;
    const int wv = SL.rank * NWAVES + C.wave, nwv = SL.nloc * NWAVES;
    const int ntok = (T - wv + nwv - 1) / nwv;
    auto tok = [&](int i) { const int t = wv + i * nwv; return t < T ? t : T - 1; };
  for (int s = SL.pi; s < 8; s += SL.m) {
    const __amdgpu_buffer_rsrc_t vrs = slice_rsrc(vq + (size_t)s * (NEXP * 128));
    const int chl = 8 * (hh ? 1 : 0) + 4 * (b4 ? 1 : 0) + 2 * (b3 ? 1 : 0);
    const int coff = s * 128 + c8 * 16 + chl;
    int tA = tok(0), tB = tok(1);
    int e0 = eidx[(size_t)tA * 128 + lane], e1 = eidx[(size_t)tA * 128 + 64 + lane];
    u32x4 wq = *(const u32x4*)(wqp + (size_t)tA * 32 + grp * 4); float wscale = wsc[tA];
    int ne0 = eidx[(size_t)tB * 128 + lane], ne1 = eidx[(size_t)tB * 128 + 64 + lane];
    u32x4 r[16];
#pragma unroll
    for (int i = 0; i < 16; ++i) { const int e = __shfl(i < 8 ? e0 : e1, 8 * (i & 7) + grp) & EMASK; r[i] = __builtin_amdgcn_raw_buffer_load_b128(vrs, e * 128 + c8 * 16, 0, 0); }
#pragma unroll 1
    for (int it = 0; it < ntok; ++it) {
        const int t = tok(it), t1 = tok(it + 1), t2 = tok(it + 2);
        const int ze0 = eidx[(size_t)t2 * 128 + lane], ze1 = eidx[(size_t)t2 * 128 + 64 + lane];
        const u32x4 nwq = *(const u32x4*)(wqp + (size_t)t1 * 32 + grp * 4); const float nwscale = wsc[t1];
        int o[16];
#pragma unroll
        for (int c = 0; c < 16; ++c) o[c] = 0;
#pragma unroll
        for (int q = 0; q < 4; ++q) {
            int evv[4];
#pragma unroll
            for (int j = 0; j < 4; ++j) evv[j] = __shfl(q < 2 ? ne0 : ne1, 32 * (q & 1) + 8 * j + grp) & EMASK;
#pragma unroll
            for (int d = 0; d < 4; ++d) {
                const unsigned a = r[4 * q][d], b = r[4 * q + 1][d], c = r[4 * q + 2][d], e = r[4 * q + 3][d];
                const unsigned t0 = __builtin_amdgcn_perm(b, a, 0x05010400u), t1p = __builtin_amdgcn_perm(b, a, 0x07030602u);
                const unsigned u0 = __builtin_amdgcn_perm(e, c, 0x05010400u), u1 = __builtin_amdgcn_perm(e, c, 0x07030602u);
                o[4 * d + 0] = __builtin_amdgcn_sdot4((int)__builtin_amdgcn_perm(u0, t0, 0x05040100u), (int)wq[q], o[4 * d + 0], false);
                o[4 * d + 1] = __builtin_amdgcn_sdot4((int)__builtin_amdgcn_perm(u0, t0, 0x07060302u), (int)wq[q], o[4 * d + 1], false);
                o[4 * d + 2] = __builtin_amdgcn_sdot4((int)__builtin_amdgcn_perm(u1, t1p, 0x05040100u), (int)wq[q], o[4 * d + 2], false);
                o[4 * d + 3] = __builtin_amdgcn_sdot4((int)__builtin_amdgcn_perm(u1, t1p, 0x07060302u), (int)wq[q], o[4 * d + 3], false);
            }
#pragma unroll
            for (int j = 0; j < 4; ++j) {
                asm volatile("" ::: "memory");
                r[4 * q + j] = __builtin_amdgcn_raw_buffer_load_b128(vrs, evv[j] * 128 + c8 * 16, 0, 0);
                asm volatile("" ::: "memory");
            }
        }
        int q8[8], q4[4], q2[2];
#pragma unroll
        for (int k = 0; k < 8; ++k) q8[k] = bfly32i(o[k], o[8 + k]);
#pragma unroll
        for (int k = 0; k < 4; ++k) q4[k] = bfly16i(q8[k], q8[4 + k]);
#pragma unroll
        for (int k = 0; k < 2; ++k) { const int mine = b3 ? q4[2 + k] : q4[k], oth = b3 ? q4[k] : q4[2 + k]; q2[k] = mine + dppi<0x128>(oth); }
        { half2 pv; pv[0] = (f16)((float)q2[0] * wscale); pv[1] = (f16)((float)q2[1] * wscale); f16* yp = peer + (size_t)t * DM + coff; asm volatile("global_store_dword %0, %1, off" :: "v"(yp), "v"(pv) : "memory"); }
        wq = nwq; wscale = nwscale; ne0 = ze0; ne1 = ze1;
    }
  }
}
__device__ __forceinline__ void ph_final(const Ctx& C, const f16* __restrict__ peer, float* xio, const float* __restrict__ gf) {
    const int lane = C.lane;
    f32x4 gg[4];
#pragma unroll
    for (int j = 0; j < 4; ++j) gg[j] = *(const f32x4*)(gf + j * 256 + lane * 4);
    for (int tb = C.gw * 4; tb < T; tb += C.ngw * 4) {
        f32x4 v[4][4]; half4 pe[4][4];
#pragma unroll
        for (int u = 0; u < 4; ++u)
#pragma unroll
            for (int j = 0; j < 4; ++j) { v[u][j] = *(const f32x4*)(xio + (size_t)(tb + u) * DM + j * 256 + lane * 4); pe[u][j] = *(const half4*)(peer + (size_t)(tb + u) * DM + j * 256 + lane * 4); }
#pragma unroll
        for (int u = 0; u < 4; ++u) {
            float s = 0.f;
#pragma unroll
            for (int j = 0; j < 4; ++j) {
#pragma unroll
                for (int i = 0; i < 4; ++i) { v[u][j][i] += (float)pe[u][j][i]; s += v[u][j][i] * v[u][j][i]; }
            }
            const float r = rsqrtf(wave_sum(s) * (1.0f / DM) + EPS);
#pragma unroll
            for (int j = 0; j < 4; ++j) *(f32x4*)(xio + (size_t)(tb + u) * DM + j * 256 + lane * 4) = v[u][j] * r * gg[j];
        }
    }
}

namespace pg8 {
#define PG8_LAS __attribute__((address_space(3)))
typedef _Float16 frag8 __attribute__((ext_vector_type(8)));
typedef float f32x4 __attribute__((ext_vector_type(4)));
constexpr int BM = 256, BK = 64, HALF = 128, HTB = HALF * BK * 2  , STAGE_BYTES = 8 * HTB, NXCD = 8, WGM = 8;

__host__ __device__ __forceinline__ int lds_byte(int r, int c) { const int st = (r >> 4) * 2 + (c >> 5), rr = r & 15, cc = c & 31, ob = rr * 64 + cc * 2; return st * 1024 + (ob ^ (((ob >> 9) & 1) << 5)); }
__host__ __device__ __forceinline__ void stage_rc(int b, int& R, int& C) { const int st = b / 1024, sb = b % 1024, swz = sb ^ (((sb >> 9) & 1) << 5); R = (st >> 1) * 16 + swz / 64; C = (st & 1) * 32 + (swz % 64) / 2; }
__host__ __device__ __forceinline__ int perm32(int rho) { const int n = rho >> 4, i = rho & 15; return 8 * (i >> 2) + 4 * n + (i & 3); }

struct Unit { int pm, pn; };
struct Gemm { const f16* A; const f16* Bt; int M, N, K; };

struct StaticOrder {
    int nM, nN, nwg, G, c;
    __host__ __device__ void init(int M, int N, int G_, int c_) { nM = M / BM; nN = N / BM; nwg = nM * nN; G = G_; c = c_; }
    __host__ __device__ bool next(int i, Unit& u) const {
        const long L = (long)i * G + c; if (L >= nwg) return false;
        int wgid = (int)L; { const int q = nwg / NXCD, r = nwg % NXCD, xcd = wgid % NXCD, off = wgid / NXCD; wgid = (xcd < r ? xcd * (q + 1) : r * (q + 1) + (xcd - r) * q) + off; }
        const int nig = WGM * nN, gid = wgid / nig, fm = gid * WGM, gsz = (nM - fm) < WGM ? (nM - fm) : WGM;
        u.pm = fm + ((wgid % nig) % gsz); u.pn = (wgid % nig) / gsz; return true;
    }
    __device__ __forceinline__ void a_ready(const Unit&) const {}
    __device__ __forceinline__ void done(const Unit&) const {}
};

__device__ __forceinline__ frag8 pack8(const f32x4 a, const f32x4 b) {
    frag8 h; h[0] = (f16)a[0]; h[1] = (f16)a[1]; h[2] = (f16)a[2]; h[3] = (f16)a[3]; h[4] = (f16)b[0]; h[5] = (f16)b[1]; h[6] = (f16)b[2]; h[7] = (f16)b[3]; return h;
}
__device__ __forceinline__ float sigmoidf_(float z) { return 1.0f / (1.0f + __expf(-z)); }

struct EpiP1 {
    typedef i32x4 acc_t; static constexpr bool PERM = true, AFTER_DRAIN = false, MIDK = false;
    const float* ss1; const float* rsx; const float* wcs; const float* bgate; f16* qkvu; f16* gates; f16* vT;
    __device__ __forceinline__ void operator()(const i32x4 (&acc)[2][2][4][2], const Unit& u, int wr, int wc, int fr, int fq) const {
        const int row0 = u.pm * BM + wr * 64 + fr, colt = u.pn * BM; const bool isg = colt >= NQKVU;
        f32x4 cs[2][2];
#pragma unroll
        for (int bj = 0; bj < 2; ++bj) { const int c0 = colt + bj * HALF + wc * 32 + 8 * fq; cs[bj][0] = *(const f32x4*)(wcs + c0); cs[bj][1] = *(const f32x4*)(wcs + c0 + 4); }
#pragma unroll
        for (int ai = 0; ai < 2; ++ai)
#pragma unroll
            for (int m = 0; m < 4; ++m) { const int row = row0 + ai * HALF + m * 16; const float r = rsqrtf(ss1[row] * (1.0f / DM) + EPS) * rsx[row];
#pragma unroll
                for (int bj = 0; bj < 2; ++bj) { const int c0 = colt + bj * HALF + wc * 32 + 8 * fq; f32x4 v0, v1;
#pragma unroll
                    for (int i = 0; i < 4; ++i) { v0[i] = (float)acc[ai][bj][m][0][i] * (r * cs[bj][0][i]); v1[i] = (float)acc[ai][bj][m][1][i] * (r * cs[bj][1][i]); }
                    if (isg) { const int cg = c0 - NQKVU; const f32x4 b0 = *(const f32x4*)(bgate + cg), b1 = *(const f32x4*)(bgate + cg + 4);
#pragma unroll
                        for (int i = 0; i < 4; ++i) { v0[i] = sigmoidf_(v0[i] + b0[i]); v1[i] = sigmoidf_(v1[i] + b1[i]); }
                        *(frag8*)(gates + (size_t)row * NGATE + cg) = pack8(v0, v1); }
                    else { const frag8 hv = pack8(v0, v1); *(frag8*)(qkvu + (size_t)row * NQKVU + c0) = hv;
                        if (colt == 512 && bj == 1) {
                            f16* vp = vT + ((size_t)((row >> 11) * 2 + (wc >> 1)) * 64 + (wc & 1) * 32 + 8 * fq) * SEQ + (row & (SEQ - 1));
#pragma unroll
                            for (int i = 0; i < 8; ++i) vp[(size_t)i * SEQ] = hv[i]; } } } }
    }
};
struct EpiMerged {
    typedef f32x4 acc_t; static constexpr bool PERM = true, AFTER_DRAIN = false, MIDK = true;
    const f16* gates; f16* merged;
    __device__ __forceinline__ void mid(f32x4 (&acc)[2][2][4][2], const Unit& u, int wr, int wc, int fr, int fq) const {
        const int row0 = u.pm * BM + wr * 64 + fr, colt = u.pn * BM;
        const f16* gb = gates + (size_t)row0 * NGATE + colt + wc * 32 + 8 * fq;
        asm volatile("" : "+v"(gb));
#pragma unroll
        for (int ai = 0; ai < 2; ++ai) {
            frag8 g0[4][2], g1[4][2];
#pragma unroll
            for (int m = 0; m < 4; ++m)
#pragma unroll
                for (int bj = 0; bj < 2; ++bj) { const f16* gp = gb + (size_t)(ai * HALF + m * 16) * NGATE + bj * HALF; g0[m][bj] = *(const frag8*)gp; g1[m][bj] = *(const frag8*)(gp + DM); }
#pragma unroll
            for (int m = 0; m < 4; ++m)
#pragma unroll
                for (int bj = 0; bj < 2; ++bj)
#pragma unroll
                    for (int i = 0; i < 4; ++i) {
                        acc[ai][bj][m][0][i] *= (float)g0[m][bj][i] * __builtin_amdgcn_rcpf(fmaxf((float)g1[m][bj][i], 1e-4f));
                        acc[ai][bj][m][1][i] *= (float)g0[m][bj][4 + i] * __builtin_amdgcn_rcpf(fmaxf((float)g1[m][bj][4 + i], 1e-4f)); }
            asm volatile("" ::: "memory");
        }
    }
    __device__ __forceinline__ void operator()(const f32x4 (&acc)[2][2][4][2], const Unit& u, int wr, int wc, int fr, int fq) const {
        const int row0 = u.pm * BM + wr * 64 + fr, colt = u.pn * BM;
#pragma unroll
        for (int ai = 0; ai < 2; ++ai)
#pragma unroll
            for (int m = 0; m < 4; ++m) { const int row = row0 + ai * HALF + m * 16;
#pragma unroll
                for (int bj = 0; bj < 2; ++bj) { const int c0 = colt + bj * HALF + wc * 32 + 8 * fq;
                    const frag8 g1 = *(const frag8*)(gates + (size_t)row * NGATE + DM + c0); f32x4 v0, v1;
#pragma unroll
                    for (int i = 0; i < 4; ++i) { v0[i] = acc[ai][bj][m][0][i] * fmaxf((float)g1[i], 1e-4f); v1[i] = acc[ai][bj][m][1][i] * fmaxf((float)g1[4 + i], 1e-4f); }
                    *(frag8*)(merged + (size_t)row * DM + c0) = pack8(v0, v1); } }
    }
};
struct EpiOut {
    typedef f32x4 acc_t; static constexpr bool PERM = false, AFTER_DRAIN = false, MIDK = false;
    const float* x; const float* g2; float* x1; f16* x1h; float* ss2p;
    __device__ __forceinline__ void operator()(const f32x4 (&acc)[2][2][4][2], const Unit& u, int wr, int wc, int fr, int fq) const {
        const int row0 = u.pm * BM + wr * 64 + fr, col0 = u.pn * BM + wc * 32 + 4 * fq;
        f32x4 gv[2][2];
#pragma unroll
        for (int bj = 0; bj < 2; ++bj)
#pragma unroll
            for (int n = 0; n < 2; ++n) gv[bj][n] = *(const f32x4*)(g2 + col0 + bj * HALF + n * 16);
#pragma unroll
        for (int ai = 0; ai < 2; ++ai)
#pragma unroll
            for (int m = 0; m < 4; ++m) { const int row = row0 + ai * HALF + m * 16; const size_t off = (size_t)row * DM + col0; float ssq = 0.f;
#pragma unroll
                for (int bj = 0; bj < 2; ++bj)
#pragma unroll
                    for (int n = 0; n < 2; ++n) { const f32x4 y = *(const f32x4*)(x + off + bj * HALF + n * 16) + acc[ai][bj][m][n];
                        *(f32x4*)(x1 + off + bj * HALF + n * 16) = y; ssq += (y[0] * y[0] + y[1] * y[1]) + (y[2] * y[2] + y[3] * y[3]);
                        const f32x4 yg = y * gv[bj][n]; half4 h; h[0] = (f16)yg[0]; h[1] = (f16)yg[1]; h[2] = (f16)yg[2]; h[3] = (f16)yg[3];
                        *(half4*)(x1h + off + bj * HALF + n * 16) = h; }
                ssq += __shfl_xor(ssq, 16); ssq += __shfl_xor(ssq, 32);
                if (fq == 0) ss2p[(size_t)(u.pn * 4 + wc) * T + row] = ssq; }
    }
};
struct EpiQ {
    typedef i32x4 acc_t; static constexpr bool PERM = true, AFTER_DRAIN = false, MIDK = false;
    const float* hsc; const float* wqs; f16* qp;
    __device__ __forceinline__ void operator()(const i32x4 (&acc)[2][2][4][2], const Unit& u, int wr, int wc, int fr, int fq) const {
        const int row0 = u.pm * BM + wr * 64 + fr, colt = u.pn * BM;
        f32x4 cs[2][2];
#pragma unroll
        for (int bj = 0; bj < 2; ++bj) { const int c0 = colt + bj * HALF + wc * 32 + 8 * fq; cs[bj][0] = *(const f32x4*)(wqs + c0); cs[bj][1] = *(const f32x4*)(wqs + c0 + 4); }
#pragma unroll
        for (int ai = 0; ai < 2; ++ai)
#pragma unroll
            for (int m = 0; m < 4; ++m) { const int row = row0 + ai * HALF + m * 16; const float r = hsc[row];
#pragma unroll
                for (int bj = 0; bj < 2; ++bj) { const int c0 = colt + bj * HALF + wc * 32 + 8 * fq; f32x4 v0, v1;
#pragma unroll
                    for (int i = 0; i < 4; ++i) { v0[i] = (float)acc[ai][bj][m][0][i] * (r * cs[bj][0][i]); v1[i] = (float)acc[ai][bj][m][1][i] * (r * cs[bj][1][i]); }
                    *(frag8*)(qp + (size_t)row * 2048 + c0) = pack8(v0, v1); } }
    }
};

__device__ __forceinline__ void mma16(const frag8 b, const frag8 a, f32x4& c) { c = __builtin_amdgcn_mfma_f32_16x16x32_f16(b, a, c, 0, 0, 0); }
__device__ __forceinline__ void mma16(const frag8 b, const frag8 a, i32x4& c) { c = __builtin_amdgcn_mfma_i32_16x16x64_i8(__builtin_bit_cast(i32x4, b), __builtin_bit_cast(i32x4, a), c, 0, 0, 0); }
template <class Epi, class Sched, bool ALIGN_EPI = false, bool SP2 = false>
__device__ __forceinline__ void gemm_phase(PG8_LAS unsigned char* lds, const Gemm g, const Sched& S, const Epi& E) {
    const int tid = threadIdx.x, wid = __builtin_amdgcn_readfirstlane(tid >> 6), lane = tid & 63, wr = wid >> 2, wc = wid & 3, fr = lane & 15, fq = lane >> 4;
    const int K = g.K, nt = K / BK;
    unsigned voffA[2], voffB[2];
#pragma unroll
    for (int i = 0; i < 2; ++i) { int R, C; stage_rc(tid * 16 + i * 8192, R, C); const int Rb = Epi::PERM ? ((R & ~31) + perm32(R & 31)) : R;
        voffA[i] = (unsigned)(R * K + C) * 2u; voffB[i] = (unsigned)(Rb * K + C) * 2u; }
    const size_t kstep = (size_t)(BK * 2);
    const size_t hstep = (size_t)HALF * K * 2;
    const size_t tstep = 2 * hstep;
    const unsigned ldsw = (unsigned)wid * 1024u;
    const int aoff = lds_byte(wr * 64 + fr, fq * 8), boff = lds_byte(wc * 32 + fr, fq * 8);
#define PG8_SA(b, h) (((b) * 2 + (h)) * HTB)
#define PG8_SB(b, h) ((4 + (b) * 2 + (h)) * HTB)
#define PG8_STAGE(bufoff, gbase, voff) do { _Pragma("unroll") for (int _i = 0; _i < 2; ++_i) \
        __builtin_amdgcn_global_load_lds((const unsigned*)((const char*)(gbase) + (voff)[_i]), (PG8_LAS unsigned*)(lds + (bufoff) + ldsw + _i * 8192), 16, 0, 0); } while (0)
#define PG8_LDA(dst, b, h) do { _Pragma("unroll") for (int m = 0; m < 4; ++m) _Pragma("unroll") for (int k = 0; k < 2; ++k) dst[m][k] = *(const PG8_LAS frag8*)(lds + PG8_SA(b, h) + aoff + m * 2048 + k * 1024); } while (0)
#define PG8_LDB(dst, b, h) do { _Pragma("unroll") for (int n = 0; n < 2; ++n) _Pragma("unroll") for (int k = 0; k < 2; ++k) dst[n][k] = *(const PG8_LAS frag8*)(lds + PG8_SB(b, h) + boff + n * 2048 + k * 1024); } while (0)
#define PG8_MMA(ai, bj, At, Bt) do { __builtin_amdgcn_s_setprio(1); _Pragma("unroll") for (int m = 0; m < 4; ++m) _Pragma("unroll") for (int n = 0; n < 2; ++n) _Pragma("unroll") for (int k = 0; k < 2; ++k) \
        mma16(Bt[n][k], At[m][k], acc[ai][bj][m][n]); __builtin_amdgcn_s_setprio(0); } while (0)
#define PG8_WAIT_V(n) asm volatile("s_waitcnt vmcnt(" #n ")" ::: "memory")
#define PG8_WAIT_L(n) asm volatile("s_waitcnt lgkmcnt(" #n ")" ::: "memory")
#define PG8_BAR __builtin_amdgcn_s_barrier()
#define PG8_SCHED __builtin_amdgcn_sched_barrier(0)
    Unit cur, nxt; int ui = 0;
    if (!S.next(0, cur)) return;
    typedef typename Epi::acc_t acc_t;
    acc_t acc[2][2][4][2];
#pragma unroll
    for (int a = 0; a < 2; ++a)
#pragma unroll
        for (int b = 0; b < 2; ++b)
#pragma unroll
            for (int m = 0; m < 4; ++m)
#pragma unroll
                for (int n = 0; n < 2; ++n) acc[a][b][m][n] = acc_t{};
    frag8 At[4][2], B0[2][2], B1[2][2];
    const char* cA = (const char*)g.A + (size_t)cur.pm * tstep; const char* cB = (const char*)g.Bt + (size_t)cur.pn * tstep;
    S.a_ready(cur);
    if constexpr (SP2) {
        PG8_STAGE(PG8_SB(0, 0), cB, voffB); PG8_STAGE(PG8_SB(0, 1), cB + hstep, voffB); PG8_STAGE(PG8_SA(0, 0), cA, voffA); PG8_STAGE(PG8_SA(0, 1), cA + hstep, voffA);
        if (wr == 1) PG8_BAR;
        PG8_WAIT_V(2); PG8_BAR;
        PG8_STAGE(PG8_SB(1, 0), cB + kstep, voffB); PG8_STAGE(PG8_SA(1, 0), cA + kstep, voffA); PG8_STAGE(PG8_SB(1, 1), cB + hstep + kstep, voffB);
        PG8_WAIT_V(6); PG8_BAR;
    } else {
        PG8_STAGE(PG8_SB(0, 0), cB, voffB); PG8_STAGE(PG8_SA(0, 0), cA, voffA); PG8_STAGE(PG8_SB(0, 1), cB + hstep, voffB); PG8_STAGE(PG8_SA(0, 1), cA + hstep, voffA);
        if (wr == 1) PG8_BAR;
        PG8_WAIT_V(4); PG8_BAR;
        PG8_STAGE(PG8_SB(1, 0), cB + kstep, voffB); PG8_STAGE(PG8_SA(1, 0), cA + kstep, voffA); PG8_STAGE(PG8_SB(1, 1), cB + hstep + kstep, voffB);
        PG8_WAIT_V(6); PG8_BAR;
    }
    for (;;) {
        const bool has_next = S.next(ui + 1, nxt);
        const char* nA = has_next ? (const char*)g.A + (size_t)nxt.pm * tstep : cA; const char* nB = has_next ? (const char*)g.Bt + (size_t)nxt.pn * tstep : cB;
        for (int t = 0; t < nt; t += 2) {
            const bool last = (t == nt - 2);
            if constexpr (Epi::MIDK) { if (t == (nt >> 1)) E.mid(acc, cur, wr, wc, fr, fq); }
            const char* a1 = cA + (size_t)(t + 1) * kstep;
            const char* a2 = last ? nA : cA + (size_t)(t + 2) * kstep; const char* b2 = last ? nB : cB + (size_t)(t + 2) * kstep;
            const char* a3 = a2 + kstep; const char* b3 = b2 + kstep;
            if (last && has_next) S.a_ready(nxt);
            if constexpr (SP2) {
            PG8_LDB(B0, 0, 0); PG8_LDB(B1, 0, 1); PG8_SCHED; PG8_LDA(At, 0, 0); PG8_STAGE(PG8_SA(1, 1), a1 + hstep, voffA);
            PG8_WAIT_V(8); PG8_WAIT_L(0); PG8_BAR; PG8_MMA(0, 0, At, B0); PG8_MMA(0, 1, At, B1); PG8_BAR; PG8_SCHED;
            PG8_LDA(At, 0, 1); PG8_STAGE(PG8_SB(0, 0), b2, voffB); PG8_STAGE(PG8_SB(0, 1), b2 + hstep, voffB); PG8_STAGE(PG8_SA(0, 0), a2, voffA);
            PG8_WAIT_V(8); PG8_WAIT_L(0); PG8_BAR; PG8_MMA(1, 0, At, B0); PG8_MMA(1, 1, At, B1); PG8_BAR; PG8_SCHED;
            PG8_LDB(B0, 1, 0); PG8_LDB(B1, 1, 1); PG8_SCHED; PG8_LDA(At, 1, 0); PG8_STAGE(PG8_SA(0, 1), a2 + hstep, voffA);
            PG8_WAIT_V(8); PG8_WAIT_L(0); PG8_BAR; PG8_MMA(0, 0, At, B0); PG8_MMA(0, 1, At, B1); PG8_BAR; PG8_SCHED;
            PG8_LDA(At, 1, 1); PG8_STAGE(PG8_SB(1, 0), b3, voffB); PG8_STAGE(PG8_SB(1, 1), b3 + hstep, voffB); PG8_STAGE(PG8_SA(1, 0), a3, voffA);
            PG8_WAIT_V(8); PG8_WAIT_L(0); PG8_BAR; PG8_MMA(1, 0, At, B0); PG8_MMA(1, 1, At, B1); PG8_BAR; PG8_SCHED;
            } else {
            PG8_LDB(B0, 0, 0); PG8_SCHED; PG8_LDA(At, 0, 0); PG8_STAGE(PG8_SA(1, 1), a1 + hstep, voffA);
            PG8_WAIT_L(8); PG8_BAR; PG8_WAIT_L(0); PG8_MMA(0, 0, At, B0); PG8_BAR; PG8_SCHED;
            PG8_LDB(B1, 0, 1); PG8_STAGE(PG8_SB(0, 0), b2, voffB);
            PG8_BAR; PG8_WAIT_L(0); PG8_MMA(0, 1, At, B1); PG8_BAR;
            PG8_LDA(At, 0, 1); PG8_STAGE(PG8_SA(0, 0), a2, voffA);
            PG8_BAR; PG8_WAIT_L(0); PG8_MMA(1, 0, At, B0); PG8_BAR; PG8_SCHED;
            PG8_STAGE(PG8_SB(0, 1), b2 + hstep, voffB);
            PG8_WAIT_V(6); PG8_BAR; PG8_MMA(1, 1, At, B1); PG8_BAR;
            PG8_LDB(B0, 1, 0); PG8_SCHED; PG8_LDA(At, 1, 0); PG8_STAGE(PG8_SA(0, 1), a2 + hstep, voffA);
            PG8_WAIT_L(8); PG8_BAR; PG8_WAIT_L(0); PG8_MMA(0, 0, At, B0); PG8_BAR; PG8_SCHED;
            PG8_LDB(B1, 1, 1); PG8_STAGE(PG8_SB(1, 0), b3, voffB);
            PG8_BAR; PG8_WAIT_L(0); PG8_MMA(0, 1, At, B1); PG8_BAR;
            PG8_LDA(At, 1, 1); PG8_STAGE(PG8_SA(1, 0), a3, voffA);
            PG8_BAR; PG8_WAIT_L(0); PG8_MMA(1, 0, At, B0); PG8_BAR; PG8_SCHED;
            PG8_STAGE(PG8_SB(1, 1), b3 + hstep, voffB);
            PG8_WAIT_V(6); PG8_BAR; PG8_MMA(1, 1, At, B1); PG8_BAR;
            }
        }
        if constexpr (ALIGN_EPI) { if (wr == 0) PG8_BAR; }
        if constexpr (!Epi::AFTER_DRAIN) { E(acc, cur, wr, wc, fr, fq); S.done(cur); }
        if (!has_next) break;
#pragma unroll
        for (int a = 0; a < 2; ++a)
#pragma unroll
            for (int b = 0; b < 2; ++b)
#pragma unroll
                for (int m = 0; m < 4; ++m)
#pragma unroll
                    for (int n = 0; n < 2; ++n) acc[a][b][m][n] = acc_t{};
        cur = nxt; cA = nA; cB = nB; ++ui;
        if constexpr (ALIGN_EPI) { if (wr == 1) PG8_BAR; }
    }
    PG8_WAIT_V(0);
    if constexpr (!ALIGN_EPI) { if (wr == 0) PG8_BAR; }
    PG8_BAR;
    if constexpr (Epi::AFTER_DRAIN) { E.fused(acc, cur, wr, wc, fr, fq, lds, wid, lane); S.done(cur); }
#undef PG8_SA
#undef PG8_SB
#undef PG8_STAGE
#undef PG8_LDA
#undef PG8_LDB
#undef PG8_MMA
#undef PG8_WAIT_V
#undef PG8_WAIT_L
#undef PG8_BAR
#undef PG8_SCHED
}
}

#define XB_TMO      128
#define XB_XCNT(j)  (256  + 64 * (j))
#define XB_XSUB(j)  (1280 + 64 * (j))
#define XB_XGEN(j)  (2304 + 64 * (j))
#define XB_TOP      3328
#define XB_TOPGEN   3392
#define XCD_BAR_WORDS 3456
#define XB_SPIN_CAP (1u << 18)

__device__ __forceinline__ unsigned xb_ld(unsigned* p)              { return __hip_atomic_load(p, __ATOMIC_RELAXED, __HIP_MEMORY_SCOPE_AGENT); }
__device__ __forceinline__ unsigned xb_add(unsigned* p, unsigned v) { return __hip_atomic_fetch_add(p, v, __ATOMIC_RELAXED, __HIP_MEMORY_SCOPE_AGENT); }
__device__ __forceinline__ unsigned xb_xcc_id() { return (unsigned)__builtin_amdgcn_s_getreg((3 << 11) | 20) & 0xFu; }
#define XB_SPIN(cond, bar) do { unsigned _sp = 0; while (cond) { __builtin_amdgcn_s_sleep(1); \
    if ((++_sp & 255u) == 0u) { if (xb_ld(&(bar)[XB_TMO])) break; if (_sp > XB_SPIN_CAP) { atomicAdd(&(bar)[XB_TMO], 1u); break; } } } } while (0)

struct XcdBarrier {
    unsigned* bar; unsigned x;
    volatile LAS unsigned* st;
};

__device__ __forceinline__ XcdBarrier xcd_barrier_post(unsigned* bar, volatile LAS unsigned* st) {
    XcdBarrier b; b.bar = bar; b.x = xb_xcc_id(); b.st = st;
    if (threadIdx.x == 0) st[2] = xb_add(&bar[XB_XCNT(b.x)], 1u);
    return b;
}
__device__ __forceinline__ void xcd_barrier_complete(unsigned* bar, unsigned x, unsigned& nloc, unsigned& nx) {
    const unsigned G = gridDim.x * gridDim.y * gridDim.z;
    unsigned sum, cnt, mine, sp = 0u;
    for (;;) {
        sum = 0u; cnt = 0u; mine = 0u;
#pragma unroll
        for (unsigned j = 0; j < 16; ++j) { const unsigned c = xb_ld(&bar[XB_XCNT(j)]); sum += c; cnt += (c > 0u) ? 1u : 0u; mine = (j == x) ? c : mine; }
        if (sum == G) break;
        __builtin_amdgcn_s_sleep(1);
        if ((++sp & 255u) == 0u) { if (xb_ld(&bar[XB_TMO])) break; if (sp > XB_SPIN_CAP) { atomicAdd(&bar[XB_TMO], 1u); break; } }
    }
    nloc = mine > 0u ? mine : 1u; nx = cnt > 0u ? cnt : 1u;
}

__device__ __forceinline__ void xcd_barrier(const XcdBarrier& b) {
    asm volatile("s_waitcnt vmcnt(0)" ::: "memory");
    __syncthreads();
    if (threadIdx.x == 0) {
        unsigned* bar = b.bar;
        __builtin_amdgcn_s_waitcnt(0);
        unsigned nloc = b.st[0], nx = b.st[1];
        if (nloc == 0u) { xcd_barrier_complete(bar, b.x, nloc, nx); b.st[0] = nloc; b.st[1] = nx; }
        const unsigned old = xb_add(&bar[XB_XSUB(b.x)], 1u);
        const unsigned gen = old / nloc;
        if (old + 1u == (gen + 1u) * nloc) {
            __builtin_amdgcn_fence(__ATOMIC_RELEASE, "agent");
            asm volatile("s_waitcnt vmcnt(0)" ::: "memory");
            const unsigned og = xb_add(&bar[XB_TOP], 1u);
            const unsigned tg = og / nx;
            if (og + 1u == (tg + 1u) * nx) xb_add(&bar[XB_TOPGEN], 1u);
            else XB_SPIN(xb_ld(&bar[XB_TOPGEN]) == tg, bar);
            __builtin_amdgcn_fence(__ATOMIC_ACQUIRE, "agent");
            xb_add(&bar[XB_XGEN(b.x)], 1u);
            asm volatile("s_waitcnt vmcnt(0)" ::: "memory");
        } else {
            XB_SPIN(xb_ld(&bar[XB_XGEN(b.x)]) == gen, bar);
            __builtin_amdgcn_fence(__ATOMIC_ACQUIRE, "agent");
            asm volatile("s_waitcnt vmcnt(0)" ::: "memory");
        }
    }
    __syncthreads();
}


struct Args { const float* in[16]; float* out; unsigned char* ws; int ph_lo, ph_hi; };
constexpr int N_PHASES = 11;

__global__ void __launch_bounds__(NTHREADS, 2) mk_fwd(Args a) {
    extern __shared__ __attribute__((aligned(16))) unsigned char lds[];
    LAS unsigned char* L = (LAS unsigned char*)lds;
    volatile LAS unsigned* MISC = (volatile LAS unsigned*)(L + MISC_OFF);
    unsigned char* ws = a.ws;
    Ctx C;
    C.tid = threadIdx.x; C.lane = C.tid & 63; C.wave = __builtin_amdgcn_readfirstlane(C.tid >> 6);
    C.G = gridDim.x; C.gw = blockIdx.x * NWAVES + C.wave; C.ngw = C.G * NWAVES; C.gt = blockIdx.x * NTHREADS + C.tid; C.ngt = C.G * NTHREADS;
    for (int u = C.tid; u < (LDS_BYTES - LDSCTL_OFF) / 4; u += NTHREADS) ((LAS unsigned*)(L + LDSCTL_OFF))[u] = 0u;
    __syncthreads();
    const int lo = a.ph_lo, hi = a.ph_hi, G = C.G;
    const bool multi = (hi - lo) > 1;
    XcdBarrier bar; bar.bar = (unsigned*)(ws + WS_CTL) + CW_BAR; bar.x = 0; bar.st = nullptr;
    if (multi) bar = xcd_barrier_post((unsigned*)(ws + WS_CTL) + CW_BAR, MISC + 8);
#define IN(k) (lo <= (k) && (k) < hi)
#define SEAM(k) do { if (IN(k) && IN((k) + 1)) xcd_barrier(bar); } while (0)

#define REPS(k) for (int rep_ = 0; rep_ < ((PROBE_DUP == (k)) ? 2 : 1); ++rep_)
#define REPBAR(k) do { if (PROBE_DUP == (k) && rep_ == 0) xcd_barrier(bar); } while (0)
    if (IN(0)) REPS(0) { ph_prep(C, L, a.in, ws); REPBAR(0); }
    SEAM(0);
    if (IN(1)) {
        quant_wrows(C, (const f16*)(ws + WS_WCAT), NCAT, (unsigned*)(ws + WS_WCATQ), (float*)(ws + WS_WCS));
        quant_wrows(C, (const f16*)(ws + WS_WQ), 2048, (unsigned*)(ws + WS_WQQ), (float*)(ws + WS_WQS));
        xcd_barrier(bar);
        pg8::Gemm g{(const f16*)(ws + WS_XH), (const f16*)(ws + WS_WCATQ), T, NCAT, DM / 2}; pg8::StaticOrder S; S.init(T, NCAT, G, (int)blockIdx.x);
        pg8::EpiP1 E{(const float*)(ws + WS_RS1), (const float*)(ws + WS_RSX), (const float*)(ws + WS_WCS), a.in[8], (f16*)(ws + WS_QKVU), (f16*)(ws + WS_GATES), (f16*)(ws + WS_VT)};
        pg8::gemm_phase<pg8::EpiP1, pg8::StaticOrder, true, true>(L, g, S, E);
    }
    SEAM(1);
    if (IN(2)) REPS(2) {
        ph_attn_pool(C, L, (const f16*)(ws + WS_QKVU), (const f16*)(ws + WS_VT), a.in[3], (const f16*)(ws + WS_POOLW), a.in[5], (f16*)(ws + WS_OCAT));
        REPBAR(2);
    }
    if (IN(2) && IN(4)) xcd_barrier(bar);
    if (IN(4)) REPS(4) {
        pg8::Gemm g{(const f16*)(ws + WS_OCAT), (const f16*)(ws + WS_WB), T, DM, DM}; pg8::StaticOrder S; S.init(T, DM, G, (int)blockIdx.x);
        pg8::EpiMerged E{(const f16*)(ws + WS_GATES), (f16*)(ws + WS_MERGED)};
        pg8::gemm_phase<pg8::EpiMerged, pg8::StaticOrder, true, true>(L, g, S, E);
        REPBAR(4);
    }
    SEAM(4);
    if (IN(5)) REPS(5) {
        pg8::Gemm g{(const f16*)(ws + WS_MERGED), (const f16*)(ws + WS_WOUT), T, DM, DM}; pg8::StaticOrder S; S.init(T, DM, G, (int)blockIdx.x);
        pg8::EpiOut E{a.in[0], a.in[10], a.out, (f16*)(ws + WS_X1H), (float*)(ws + WS_SS2)};
        pg8::gemm_phase<pg8::EpiOut, pg8::StaticOrder, true, true>(L, g, S, E);
        REPBAR(5);
    }
    SEAM(5);
    if (IN(6)) {
        ph_h2quant(C, (const f16*)(ws + WS_X1H), (const float*)(ws + WS_SS2), (unsigned*)(ws + WS_H2Q), (float*)(ws + WS_HSC));
        xcd_barrier(bar);
        pg8::Gemm g{(const f16*)(ws + WS_H2Q), (const f16*)(ws + WS_WQQ), T, 2048, DM / 2}; pg8::StaticOrder S; S.init(T, 2048, G, (int)blockIdx.x);
        pg8::EpiQ E{(const float*)(ws + WS_HSC), (const float*)(ws + WS_WQS), (f16*)(ws + WS_QP)};
        pg8::gemm_phase<pg8::EpiQ, pg8::StaticOrder, true, true>(L, g, S, E);
    }
    SEAM(6);
    if (IN(7)) REPS(7) {
        auto side = [&]() {
            quant_rows<false>(C, a.in[13], (unsigned*)(ws + WS_UQ), (float*)(ws + WS_US));
            quant_rows<false>(C, a.in[14], (unsigned*)(ws + WS_VQ), (float*)(ws + WS_VS));
        };
        ph_route(C, L, (const f16*)(ws + WS_QP), (const float*)(ws + WS_SS2), (const f16*)(ws + WS_SUBK), (int*)(ws + WS_EIDX), (float*)(ws + WS_EGATE), side);
        if (!(C.wave & 4)) side();
        REPBAR(7); }
    SEAM(7);
    if (IN(8)) REPS(8) {
        const Slicing SL = get_slicing((const unsigned*)(ws + WS_CTL) + CW_BAR, MISC);
        if (PROBE_DUP == 8 && rep_ == 0) ph_upeer<255>(C, L, SL, (const unsigned*)(ws + WS_H2Q), (const int*)(ws + WS_EIDX), (const unsigned char*)(ws + WS_UQ), (short*)(ws + WS_PDOT));
        else ph_upeer<16383>(C, L, SL, (const unsigned*)(ws + WS_H2Q), (const int*)(ws + WS_EIDX), (const unsigned char*)(ws + WS_UQ), (short*)(ws + WS_PDOT));
        REPBAR(8);
    }
    SEAM(8);
    if (IN(9)) {
        ph_ureduce(C, L, (const short*)(ws + WS_PDOT), (const float*)(ws + WS_HSC), (const int*)(ws + WS_EIDX), (const float*)(ws + WS_US), (const float*)(ws + WS_VS), (const float*)(ws + WS_EGATE),
                   (unsigned*)(ws + WS_WQP), (float*)(ws + WS_WSC));
        xcd_barrier(bar);
        const Slicing SL = get_slicing((const unsigned*)(ws + WS_CTL) + CW_BAR, MISC);
        ph_vpeer<16383>(C, SL, (const int*)(ws + WS_EIDX), (const unsigned*)(ws + WS_WQP), (const float*)(ws + WS_WSC), (const unsigned char*)(ws + WS_VQ), (f16*)(ws + WS_PEER));
    }
    SEAM(9);
    if (IN(10)) { ph_final(C, (const f16*)(ws + WS_PEER), a.out, a.in[15]); }
#undef IN
#undef SEAM
}

#ifndef MK_N_LAUNCHES
#define MK_N_LAUNCHES 1
#endif
extern "C" void kernel_launch(void* const* d_in, const int* in_sizes, int n_in, void* d_out, int out_size, void* d_ws, size_t ws_size, hipStream_t stream) {
    static int grid = 0;
    if (grid == 0) {
        if (n_in != 16 || in_sizes[0] != T * DM || out_size != T * DM || ws_size < WS_END) {
            fprintf(stderr, "kernel_launch: unexpected shapes (n_in %d in0 %d out %d ws %zu)\n", n_in, n_in > 0 ? in_sizes[0] : -1, out_size, ws_size);
            grid = -1; return;
        }
        int dev = 0, cus = 0;
        if (hipGetDevice(&dev) != hipSuccess || hipDeviceGetAttribute(&cus, hipDeviceAttributeMultiprocessorCount, dev) != hipSuccess) { grid = -1; return; }
        if (hipFuncSetAttribute((const void*)mk_fwd, hipFuncAttributeMaxDynamicSharedMemorySize, LDS_BYTES) != hipSuccess) { fprintf(stderr, "kernel_launch: hipFuncSetAttribute failed\n"); grid = -1; return; }
        int per_cu = 0;
        if (hipOccupancyMaxActiveBlocksPerMultiprocessor(&per_cu, (const void*)mk_fwd, NTHREADS, LDS_BYTES) != hipSuccess || per_cu < 1)
            fprintf(stderr, "kernel_launch: occupancy query reports %d workgroups per CU\n", per_cu);
        (void)hipGetLastError();
        grid = cus;
    }
    if (grid < 0) return;
    (void)hipMemsetAsync((char*)d_ws + WS_CTL, 0, CTL_ZERO_BYTES, stream);
    Args a{};
    for (int i = 0; i < 16; ++i) a.in[i] = (const float*)d_in[i];
    a.out = (float*)d_out; a.ws = (unsigned char*)d_ws;
    if (MK_N_LAUNCHES == 1) {
        a.ph_lo = 0; a.ph_hi = N_PHASES;
        hipLaunchKernelGGL(mk_fwd, dim3(grid), dim3(NTHREADS), LDS_BYTES, stream, a);
    } else {
        for (int p = 0; p < N_PHASES; ++p) { a.ph_lo = p; a.ph_hi = p + 1; hipLaunchKernelGGL(mk_fwd, dim3(grid), dim3(NTHREADS), LDS_BYTES, stream, a); }
    }
}
```

```cpp
#include <hip/hip_runtime.h>
#include <cstdint>
#include <cstdio>

typedef _Float16 f16;
typedef _Float16 half8 __attribute__((ext_vector_type(8)));
typedef _Float16 half4 __attribute__((ext_vector_type(4)));
typedef _Float16 half2 __attribute__((ext_vector_type(2)));
typedef float f32x4 __attribute__((ext_vector_type(4)));
typedef float f32x16 __attribute__((ext_vector_type(16)));
typedef unsigned u32x4 __attribute__((ext_vector_type(4)));
typedef int i32x4 __attribute__((ext_vector_type(4)));
#define LAS __attribute__((address_space(3)))
#ifndef PROBE_DIAG
#define PROBE_DIAG (0)
#endif
#ifndef PROBE_DUP
#define PROBE_DUP (-1)
#endif
#define GAS __attribute__((address_space(1)))

constexpr int DM = 1024, BATCH = 16, SEQ = 2048, T = BATCH * SEQ;
constexpr int NQKVU = 1280, NGATE = 2048, NCAT = NQKVU + NGATE;
constexpr int COL_K = 512, COL_V = 640, COL_U = 768;
constexpr int NEXP = 16384, PEER_H = 8, TOPK = 16;
constexpr float EPS = 1e-6f;
constexpr int NWAVES = 8, NTHREADS = NWAVES * 64;

constexpr size_t MiB = 1u << 20;
constexpr size_t WS_CTL = 0, CTL_ZERO_BYTES = 64 * 1024;
constexpr size_t WS_WCAT = 1 * MiB;
constexpr size_t WS_WB = 8 * MiB;
constexpr size_t WS_WOUT = 10 * MiB;
constexpr size_t WS_WQ = 12 * MiB;
constexpr size_t WS_POOLW = 16 * MiB;
constexpr size_t WS_SUBK = 16 * MiB + 512 * 1024;
constexpr size_t WS_RS1 = 17 * MiB;
constexpr size_t WS_EIDX = 18 * MiB;
constexpr size_t WS_EGATE = 34 * MiB;
constexpr size_t WS_WCATQ = 50 * MiB;
constexpr size_t WS_WCS = 54 * MiB;
constexpr size_t WS_WQQ = 56 * MiB;
constexpr size_t WS_WQS = 59 * MiB;
constexpr size_t WS_RSX = 55 * MiB;
constexpr size_t WS_UTAB = 50 * MiB;
constexpr size_t WS_VTAB = 82 * MiB;
constexpr size_t WS_XH = 114 * MiB;
constexpr size_t WS_MERGED = WS_XH;
constexpr size_t WS_QKVU = 178 * MiB;
constexpr size_t WS_X1H = WS_QKVU;
constexpr size_t WS_PEER = WS_QKVU;
constexpr size_t WS_GATES = 258 * MiB;
constexpr size_t WS_QP = WS_GATES;
constexpr size_t WS_OCAT = 386 * MiB;
constexpr size_t WS_UQ = 450 * MiB;
constexpr size_t WS_VQ = 466 * MiB;
constexpr size_t WS_US = 17 * MiB + 256 * 1024, WS_VS = 17 * MiB + 512 * 1024;
constexpr size_t WS_PDOT = WS_GATES;
constexpr size_t WS_H2Q = 404 * MiB;
constexpr size_t WS_HSC = 403 * MiB;
constexpr size_t WS_SSF = 402 * MiB;
constexpr size_t WS_WQP = 386 * MiB;
constexpr size_t WS_WSC = 390 * MiB;
constexpr size_t WS_ACT = 386 * MiB;
constexpr size_t WS_SS2 = 482 * MiB;
constexpr size_t WS_VT = 484 * MiB;
constexpr size_t WS_END = 492 * MiB;
constexpr int CW_BAR = 4096;

constexpr int RING_OFF = 0, RING_BYTES = 131072;
constexpr int LDSCTL_OFF = RING_BYTES, MISC_OFF = LDSCTL_OFF + 320;
constexpr int LDS_BYTES = 147456;

#define LDS_WAIT() asm volatile("s_waitcnt lgkmcnt(0)" ::: "memory")
template <int CTRL> __device__ __forceinline__ float dppf(float x) { return __uint_as_float(__builtin_amdgcn_update_dpp(0u, __float_as_uint(x), CTRL, 0xf, 0xf, false)); }
template <int CTRL> __device__ __forceinline__ int dppi(int x) { return (int)__builtin_amdgcn_update_dpp(0u, (unsigned)x, CTRL, 0xf, 0xf, false); }
__device__ __forceinline__ float bfly32(float a, float b) { auto r = __builtin_amdgcn_permlane32_swap(__float_as_uint(a), __float_as_uint(b), false, false); return __uint_as_float(r[0]) + __uint_as_float(r[1]); }
__device__ __forceinline__ float bfly16(float a, float b) { auto r = __builtin_amdgcn_permlane16_swap(__float_as_uint(a), __float_as_uint(b), false, false); return __uint_as_float(r[0]) + __uint_as_float(r[1]); }
__device__ __forceinline__ int bfly32i(int a, int b) { auto r = __builtin_amdgcn_permlane32_swap((unsigned)a, (unsigned)b, false, false); return (int)(r[0] + r[1]); }
__device__ __forceinline__ int bfly16i(int a, int b) { auto r = __builtin_amdgcn_permlane16_swap((unsigned)a, (unsigned)b, false, false); return (int)(r[0] + r[1]); }
__device__ __forceinline__ float wave_sum(float x) {
    x += dppf<0x121>(x); x += dppf<0x122>(x); x += dppf<0x124>(x); x += dppf<0x128>(x);
    x = bfly16(x, x); return bfly32(x, x);
}
__device__ __forceinline__ int wave_sum_i(int x) {
    x += dppi<0x121>(x); x += dppi<0x122>(x); x += dppi<0x124>(x); x += dppi<0x128>(x);
    x = bfly16i(x, x); return bfly32i(x, x);
}
__device__ __forceinline__ float wave_max(float x) {
    x = fmaxf(x, dppf<0x121>(x)); x = fmaxf(x, dppf<0x122>(x)); x = fmaxf(x, dppf<0x124>(x)); x = fmaxf(x, dppf<0x128>(x));
    { auto r = __builtin_amdgcn_permlane16_swap(__float_as_uint(x), __float_as_uint(x), false, false); x = fmaxf(__uint_as_float(r[0]), __uint_as_float(r[1])); }
    { auto r = __builtin_amdgcn_permlane32_swap(__float_as_uint(x), __float_as_uint(x), false, false); x = fmaxf(__uint_as_float(r[0]), __uint_as_float(r[1])); }
    return x;
}
__device__ __forceinline__ float gelu_exact(float x) { return 0.5f * x * (1.0f + erff(x * 0.70710678118654752f)); }
__device__ __forceinline__ float rs_from_ss(const float* ss, int t) {
    float s = 0.f;
#pragma unroll
    for (int i = 0; i < 16; ++i) s += ss[(size_t)i * T + t];
    return rsqrtf(s * (1.0f / DM) + EPS);
}

struct Ctx {
    int tid, lane, wave;
    int G;
    int gw, ngw;
    int gt, ngt;
};

__device__ __forceinline__ int pack4_i8(float a, float b, float c, float d) {
    const int ia = (int)rintf(a), ib = (int)rintf(b), ic = (int)rintf(c), id = (int)rintf(d);
    return (ia & 0xff) | ((ib & 0xff) << 8) | ((ic & 0xff) << 16) | (id << 24);
}
template <bool OFFS>
__device__ __forceinline__ void quant_rows(const Ctx& C, const float* __restrict__ tab, unsigned* __restrict__ q, float* __restrict__ scale) {
    const int lane = C.lane;
    for (int r = C.gw; r < NEXP; r += C.ngw) {
        const float* row = tab + (size_t)r * DM;
        f32x4 v[4]; float m = 0.f;
#pragma unroll
        for (int j = 0; j < 4; ++j) { v[j] = *(const f32x4*)(row + j * 256 + lane * 4); m = fmaxf(m, fmaxf(fmaxf(fabsf(v[j][0]), fabsf(v[j][1])), fmaxf(fabsf(v[j][2]), fabsf(v[j][3])))); }
        m = wave_max(m);
        const float inv = m > 0.f ? 127.0f / m : 0.f;
#pragma unroll
        for (int j = 0; j < 4; ++j) {
            unsigned w = (unsigned)pack4_i8(v[j][0] * inv, v[j][1] * inv, v[j][2] * inv, v[j][3] * inv);
            if (OFFS) w ^= 0x80808080u;
            { const int dw = j * 64 + lane; q[(size_t)(dw >> 5) * (NEXP * 32) + (size_t)r * 32 + (dw & 31)] = w; }
        }
        if (lane == 0) scale[r] = m * (1.0f / 127.0f);
    }
}

__device__ __forceinline__ void p0_transpose_item(const float* W, int K, int N, f16* WT, int ldo, int koff, LAS float* scr, int item, int lane) {
    const int nblk = N / 32, kb = item / nblk, nb = item % nblk, k0 = 64 * kb, n0 = 32 * nb;
#pragma unroll 8
    for (int i = 0; i < 32; ++i) { const int kk = 2 * i + (lane >> 5); scr[kk * 33 + (lane & 31)] = W[(size_t)(k0 + kk) * N + n0 + (lane & 31)]; }
    LDS_WAIT(); asm volatile("" ::: "memory");
    const int c = lane & 7;
#pragma unroll
    for (int j = 0; j < 4; ++j) { const int n = (lane >> 3) + 8 * j; const LAS float* s = scr + (8 * c) * 33 + n;
        half8 o;
#pragma unroll
        for (int i = 0; i < 8; ++i) o[i] = (f16)s[i * 33];
        *(half8*)(WT + (size_t)(n0 + n) * ldo + koff + k0 + 8 * c) = o; }
    LDS_WAIT(); asm volatile("" ::: "memory");
}
__device__ __forceinline__ void cvt_stream(const Ctx& C, const float* in, f16* out, size_t n4) {
    for (size_t i = (size_t)C.gt; i < n4; i += (size_t)C.ngt) {
        const f32x4 v = ((const f32x4*)in)[i];
        half4 h; h[0] = (f16)v[0]; h[1] = (f16)v[1]; h[2] = (f16)v[2]; h[3] = (f16)v[3];
        ((half4*)out)[i] = h;
    }
}
__device__ __forceinline__ void rowprep(const Ctx& C, const float* x, const float* g, unsigned* xq, float* rsx, float* ss) {
    const int lane = C.lane;
    f32x4 gg[4];
#pragma unroll
    for (int j = 0; j < 4; ++j) gg[j] = *(const f32x4*)(g + j * 256 + lane * 4);
    for (int tb = C.gw * 4; tb < T; tb += C.ngw * 4) {
        f32x4 v[4][4];
#pragma unroll
        for (int u = 0; u < 4; ++u)
#pragma unroll
            for (int j = 0; j < 4; ++j) v[u][j] = *(const f32x4*)(x + (size_t)(tb + u) * DM + j * 256 + lane * 4);
#pragma unroll
        for (int u = 0; u < 4; ++u) {
            float s = 0.f, am = 0.f;
#pragma unroll
            for (int j = 0; j < 4; ++j) {
                const f32x4 w = v[u][j];
                s += w[0] * w[0] + w[1] * w[1] + w[2] * w[2] + w[3] * w[3];
                v[u][j] = w * gg[j];
                am = fmaxf(am, fmaxf(fmaxf(fabsf(v[u][j][0]), fabsf(v[u][j][1])), fmaxf(fabsf(v[u][j][2]), fabsf(v[u][j][3]))));
            }
            s = wave_sum(s); am = wave_max(am);
            const float inv = am > 0.f ? 127.0f / am : 0.f;
#pragma unroll
            for (int j = 0; j < 4; ++j) xq[(size_t)(tb + u) * 256 + j * 64 + lane] = (unsigned)pack4_i8(v[u][j][0] * inv, v[u][j][1] * inv, v[u][j][2] * inv, v[u][j][3] * inv);
            if (lane == 0) { ss[tb + u] = s; rsx[tb + u] = am * (1.0f / 127.0f); }
        }
    }
}
__device__ __forceinline__ void quant_wrows(const Ctx& C, const f16* __restrict__ w, int rows, unsigned* __restrict__ q, float* __restrict__ scale) {
    const int lane = C.lane;
    for (int r = C.gw; r < rows; r += C.ngw) {
        const half8 a = *(const half8*)(w + (size_t)r * DM + 16 * lane), b = *(const half8*)(w + (size_t)r * DM + 16 * lane + 8);
        float m = 0.f;
#pragma unroll
        for (int i = 0; i < 8; ++i) m = fmaxf(m, fmaxf(fabsf((float)a[i]), fabsf((float)b[i])));
        m = wave_max(m);
        const float inv = m > 0.f ? 127.0f / m : 0.f;
        u32x4 o;
        o[0] = (unsigned)pack4_i8((float)a[0] * inv, (float)a[1] * inv, (float)a[2] * inv, (float)a[3] * inv);
        o[1] = (unsigned)pack4_i8((float)a[4] * inv, (float)a[5] * inv, (float)a[6] * inv, (float)a[7] * inv);
        o[2] = (unsigned)pack4_i8((float)b[0] * inv, (float)b[1] * inv, (float)b[2] * inv, (float)b[3] * inv);
        o[3] = (unsigned)pack4_i8((float)b[4] * inv, (float)b[5] * inv, (float)b[6] * inv, (float)b[7] * inv);
        *(u32x4*)(q + (size_t)r * 256 + 4 * lane) = o;
        if (lane == 0) scale[r] = m * (1.0f / 127.0f);
    }
}
__device__ __forceinline__ void ph_prep(const Ctx& C, LAS unsigned char* lds, const float* const* in, unsigned char* ws) {
    LAS float* scr = (LAS float*)(lds + RING_OFF + C.wave * 16384);
    f16* wcat = (f16*)(ws + WS_WCAT); f16* wb = (f16*)(ws + WS_WB); f16* wout = (f16*)(ws + WS_WOUT); f16* wq = (f16*)(ws + WS_WQ); f16* poolw = (f16*)(ws + WS_POOLW);
    constexpr int I_IN = 16 * 40, I_G = 16 * 64, I_B = 8 * 32, I_O = 16 * 32, I_Q = 16 * 64, I_P = 2 * 4;
    constexpr int NITEMS = I_IN + I_G + 2 * I_B + I_O + I_Q + 4 * I_P;
    for (int it = C.gw; it < NITEMS; it += C.ngw) {
        int r = it;
        if (r < I_IN) { p0_transpose_item(in[2], 1024, 1280, wcat, 1024, 0, scr, r, C.lane); continue; } r -= I_IN;
        if (r < I_G) { p0_transpose_item(in[7], 1024, 2048, wcat + (size_t)NQKVU * 1024, 1024, 0, scr, r, C.lane); continue; } r -= I_G;
        if (r < I_B) { p0_transpose_item(in[6], 512, 1024, wb, 1024, 0, scr, r, C.lane); continue; } r -= I_B;
        if (r < I_B) { p0_transpose_item(in[6] + 512 * 1024, 512, 1024, wb, 1024, 512, scr, r, C.lane); continue; } r -= I_B;
        if (r < I_O) { p0_transpose_item(in[9], 1024, 1024, wout, 1024, 0, scr, r, C.lane); continue; } r -= I_O;
        if (r < I_Q) { p0_transpose_item(in[11], 1024, 2048, wq, 1024, 0, scr, r, C.lane); continue; } r -= I_Q;
        { const int g = r / I_P; p0_transpose_item(in[4] + g * 128 * 128, 128, 128, poolw + g * 128 * 128, 128, 0, scr, r % I_P, C.lane); }
    }
    cvt_stream(C, in[12], (f16*)(ws + WS_SUBK), (size_t)8 * 2 * 128 * 128 / 4);
    rowprep(C, in[0], in[1], (unsigned*)(ws + WS_XH), (float*)(ws + WS_RSX), (float*)(ws + WS_RS1));
}

__device__ __forceinline__ void ph_attn_naive(const Ctx& C, const f16* __restrict__ qkvu, const float* __restrict__ sink, f16* __restrict__ ocat) {
    for (int gid = C.gt; gid < T * 8; gid += C.ngt) {
        const int t = gid % T, h = gid / T;
        const int b = t / SEQ, ts = t % SEQ, kh = h >> 2;
        float q[64], o[64];
        const f16* qr = qkvu + (size_t)t * NQKVU + h * 64;
#pragma unroll
        for (int d = 0; d < 64; ++d) { q[d] = (float)qr[d]; o[d] = 0.f; }
        const float slope = exp2f(-(float)(h + 1));
        float m = -1e30f, l = 0.f;
        const int s0 = max(ts - 128, 0), s1 = min(ts + 128, SEQ - 1);
        for (int s = s0; s <= s1; ++s) {
            const f16* kr = qkvu + (size_t)(b * SEQ + s) * NQKVU + COL_K + kh * 64;
            const f16* vr = qkvu + (size_t)(b * SEQ + s) * NQKVU + COL_V + kh * 64;
            float dot = 0.f;
#pragma unroll
            for (int d = 0; d < 64; ++d) dot += q[d] * (float)kr[d];
            const float lg = dot * 0.125f - slope * fabsf((float)(ts - s));
            const float mn = fmaxf(m, lg), al = __expf(m - mn), p = __expf(lg - mn);
            l = l * al + p;
#pragma unroll
            for (int d = 0; d < 64; ++d) o[d] = o[d] * al + p * (float)vr[d];
            m = mn;
        }
        const float sk = sink[h];
        const float mn = fmaxf(m, sk), al = __expf(m - mn);
        l = l * al + __expf(sk - mn);
        const float inv = al / l;
        f16* orow = ocat + (size_t)t * DM + h * 64;
#pragma unroll
        for (int d = 0; d < 64; ++d) orow[d] = (f16)(o[d] * inv);
    }
}

template <int DIAG = 0>
__device__ __forceinline__ void attn_unit(const Ctx& C, int u, LAS unsigned char* lds, const f16* __restrict__ qkvu, const f16* __restrict__ vT, const float* __restrict__ sink, f16* __restrict__ ocat) {
    const int lane = C.lane, r32 = lane & 31, hh = lane >> 5;
    const int krow = (r32 & 19) | ((r32 & 4) << 1) | ((r32 & 8) >> 1);
    constexpr float L2E = 1.4426950408889634f;
    {
        const int qs = u & 63, h = (u >> 6) & 7, b = u >> 9, kh = h >> 2;
        const int tq = qs * 32 + r32;
        const float slope2 = exp2f(-(float)(h + 1)) * L2E, sink2 = sink[h] * L2E;
        const f16* qrow = qkvu + (size_t)(b * SEQ + tq) * NQKVU + h * 64 + 8 * hh;
        half8 bq[4];
#pragma unroll
        for (int ks = 0; ks < 4; ++ks) bq[ks] = *(const half8*)(qrow + 16 * ks);
        f32x16 o0, o1;
#pragma unroll
        for (int r = 0; r < 16; ++r) { o0[r] = 0.f; o1[r] = 0.f; }
        float m = -1e30f, l = 0.f;
        const int kb_lo = max(qs - 4, 0), kb_hi = min(qs + 4, 63);
        LAS unsigned char* kst = lds + 65536 + C.wave * 8192; LAS unsigned char* vst = kst + 4096;
        const int krw = lane >> 3, kch = lane & 7, vrw = lane >> 2, vch = lane & 3;
        const f16* kg = qkvu + (size_t)(b * SEQ + krw) * NQKVU + COL_K + kh * 64 + kch * 8;
        const f16* vg = vT + (size_t)((b * 2 + kh) * 64 + vrw) * SEQ + vch * 8;
        half8 gk[4], gv[4];
#pragma unroll
        for (int i = 0; i < 4; ++i) { gk[i] = *(const half8*)(kg + (size_t)(kb_lo * 32 + 8 * i) * NQKVU); gv[i] = *(const half8*)(vg + (size_t)(16 * i) * SEQ + kb_lo * 32); }
#pragma unroll 1
        for (int kb = kb_lo; kb <= kb_hi; ++kb) {
#pragma unroll
            for (int i = 0; i < 4; ++i) {
                const int kr = krw + 8 * i; *(LAS half8*)(kst + kr * 128 + ((kch ^ (kr & 7)) << 4)) = gk[i];
                const int vr = vrw + 16 * i; *(LAS half8*)(vst + vr * 64 + ((vch ^ ((vr >> 2) & 3)) << 4)) = gv[i];
            }
            LDS_WAIT();
            half8 kf[4], va[2][2];
#pragma unroll
            for (int ks = 0; ks < 4; ++ks) kf[ks] = *(const LAS half8*)(kst + krow * 128 + (((2 * ks + hh) ^ (krow & 7)) << 4));
#pragma unroll
            for (int db = 0; db < 2; ++db)
#pragma unroll
                for (int st = 0; st < 2; ++st) { const int d = db * 32 + r32; va[db][st] = *(const LAS half8*)(vst + d * 64 + (((2 * st + hh) ^ ((d >> 2) & 3)) << 4)); }
            LDS_WAIT();
            const int kn = (DIAG == 2) ? kb_lo : (kb < kb_hi ? kb + 1 : kb);
#pragma unroll
            for (int i = 0; i < 4; ++i) { gk[i] = *(const half8*)(kg + (size_t)(kn * 32 + 8 * i) * NQKVU); gv[i] = *(const half8*)(vg + (size_t)(16 * i) * SEQ + kn * 32); }
            f32x16 s;
#pragma unroll
            for (int r = 0; r < 16; ++r) s[r] = 0.f;
#pragma unroll
            for (int ks = 0; ks < 4; ++ks) s = __builtin_amdgcn_mfma_f32_32x32x16_f16(kf[ks], bq[ks], s, 0, 0, 0);
            float bmax = -1e30f; bool ok[16];
#pragma unroll
            for (int r = 0; r < 16; ++r) {
                const int tk = kb * 32 + 16 * (r >> 3) + 8 * hh + (r & 7);
                const int dist = abs(tq - tk);
                ok[r] = dist <= 128;
                s[r] = ok[r] ? s[r] * (0.125f * L2E) - slope2 * (float)dist : -1e30f;
                bmax = fmaxf(bmax, s[r]);
            }
            bmax = fmaxf(bmax, __shfl_xor(bmax, 32));
            const float mn = fmaxf(m, bmax), al = exp2f(m - mn);
            m = mn;
            float ps = 0.f; half8 pb[2];
#pragma unroll
            for (int r = 0; r < 16; ++r) { const float p = ok[r] ? (DIAG == 1 ? (s[r] - mn) : exp2f(s[r] - mn)) : 0.f; ps += p; pb[r >> 3][r & 7] = (f16)p; }
            l = l * al + ps;
#pragma unroll
            for (int r = 0; r < 16; ++r) { o0[r] *= al; o1[r] *= al; }
#pragma unroll
            for (int st = 0; st < 2; ++st) { o0 = __builtin_amdgcn_mfma_f32_32x32x16_f16(va[0][st], pb[st], o0, 0, 0, 0); o1 = __builtin_amdgcn_mfma_f32_32x32x16_f16(va[1][st], pb[st], o1, 0, 0, 0); }
        }
        l += __shfl_xor(l, 32);
        const float mf = fmaxf(m, sink2), al = exp2f(m - mf);
        const float sc = al / (l * al + exp2f(sink2 - mf));
        f16* orow = ocat + (size_t)(b * SEQ + tq) * DM + h * 64 + 4 * hh;
#pragma unroll
        for (int g = 0; g < 4; ++g) {
            half4 a, c;
#pragma unroll
            for (int i = 0; i < 4; ++i) { a[i] = (f16)(o0[4 * g + i] * sc); c[i] = (f16)(o1[4 * g + i] * sc); }
            *(half4*)(orow + 8 * g) = a; *(half4*)(orow + 32 + 8 * g) = c;
        }
    }
}

__device__ __forceinline__ void attn_unit2(const Ctx& C, int u, LAS unsigned char* lds, const f16* __restrict__ qkvu, const f16* __restrict__ vT, const float* __restrict__ sink, f16* __restrict__ ocat) {
    const int lane = C.lane, r32 = lane & 31, hh = lane >> 5;
    const int krow = (r32 & 19) | ((r32 & 4) << 1) | ((r32 & 8) >> 1);
    constexpr float L2E = 1.4426950408889634f;
    const int qp = u & 31, h = (u >> 5) & 7, b = u >> 8, kh = h >> 2;
    const float slope2 = exp2f(-(float)(h + 1)) * L2E, sink2 = sink[h] * L2E;
    const float bbase = slope2 * (float)(r32 - 8 * hh);
    constexpr float THR = 6.0f;
    LAS unsigned char* qst = lds + 65536 + C.wave * 8192 + lane * 16;
    f32x16 o0[2], o1[2]; float m[2], l[2]; int tq[2];
#pragma unroll
    for (int j = 0; j < 2; ++j) {
        tq[j] = (2 * qp + j) * 32 + r32;
        const f16* qrow = qkvu + (size_t)(b * SEQ + tq[j]) * NQKVU + h * 64 + 8 * hh;
#pragma unroll
        for (int ks = 0; ks < 4; ++ks) *(LAS half8*)(qst + (j * 4 + ks) * 1024) = *(const half8*)(qrow + 16 * ks);
#pragma unroll
        for (int r = 0; r < 16; ++r) { o0[j][r] = 0.f; o1[j][r] = 0.f; }
        m[j] = -1e30f; l[j] = 0.f;
    }
    const int kb_lo = max(2 * qp - 4, 0), kb_hi = min(2 * qp + 5, 63);
    LAS unsigned char* kst = lds + C.wave * 8192;
    const int krw = lane >> 3, kch = lane & 7;
    const f16* kg = qkvu + (size_t)(b * SEQ + krw) * NQKVU + COL_K + kh * 64 + kch * 8;
    const f16* vbase = vT + (size_t)((b * 2 + kh) * 64 + r32) * SEQ + 8 * hh;
    half8 gk[4];
#pragma unroll
    for (int i = 0; i < 4; ++i) gk[i] = *(const half8*)(kg + (size_t)(kb_lo * 32 + 8 * i) * NQKVU);
#pragma unroll 1
    for (int kb = kb_lo; kb <= kb_hi; ++kb) {
        half8 kf[4], va[2][2];
#pragma unroll
        for (int db = 0; db < 2; ++db)
#pragma unroll
            for (int st = 0; st < 2; ++st) va[db][st] = *(const half8*)(vbase + (size_t)(db * 32) * SEQ + kb * 32 + 16 * st);
#pragma unroll
        for (int i = 0; i < 4; ++i) { const int kr = krw + 8 * i; *(LAS half8*)(kst + kr * 128 + ((kch ^ (kr & 7)) << 4)) = gk[i]; }
        LDS_WAIT();
#pragma unroll
        for (int ks = 0; ks < 4; ++ks) kf[ks] = *(const LAS half8*)(kst + krow * 128 + (((2 * ks + hh) ^ (krow & 7)) << 4));
        LDS_WAIT();
        const int kn = kb < kb_hi ? kb + 1 : kb;
#pragma unroll
        for (int i = 0; i < 4; ++i) gk[i] = *(const half8*)(kg + (size_t)(kn * 32 + 8 * i) * NQKVU);
#pragma unroll
        for (int j = 0; j < 2; ++j) {
            if (abs(kb - (2 * qp + j)) > 4) continue;
            const int D = (2 * qp + j) - kb;
            f32x16 s;
#pragma unroll
            for (int r = 0; r < 16; ++r) s[r] = 0.f;
#pragma unroll
            for (int ks = 0; ks < 4; ++ks) s = __builtin_amdgcn_mfma_f32_32x32x16_f16(kf[ks], *(const volatile LAS half8*)(qst + (j * 4 + ks) * 1024), s, 0, 0, 0);
            const float B = slope2 * 32.0f * (float)abs(D);
            float bm = -1e30f;
            if (D != 0) {
                const float ssl = D > 0 ? slope2 : -slope2, sb = D > 0 ? -bbase : bbase;
#pragma unroll
                for (int r = 0; r < 16; ++r) { const float bias = fmaf(ssl, (float)(16 * (r >> 3) + (r & 7)), sb); s[r] = fmaf(s[r], 0.125f * L2E, bias);
                    if (abs(D) == 4) s[r] = bias < -0.5f * slope2 ? -1e30f : s[r]; }
            } else {
#pragma unroll
                for (int r = 0; r < 16; ++r) s[r] = fmaf(s[r], 0.125f * L2E, -fabsf(fmaf(-slope2, (float)(16 * (r >> 3) + (r & 7)), bbase)));
            }
#pragma unroll
            for (int r = 0; r < 16; ++r) bm = fmaxf(bm, s[r]);
            bm = fmaxf(bm, __shfl_xor(bm, 32)) - B;
            {
                const float mn = (bm > m[j] + THR) ? bm : m[j], al = __builtin_amdgcn_exp2f(m[j] - mn);
                m[j] = mn; l[j] *= al;
#pragma unroll
                for (int r = 0; r < 16; ++r) { o0[j][r] *= al; o1[j][r] *= al; }
            }
            const float mb = m[j] + B;
            float ps = 0.f; half8 pb[2];
#pragma unroll
            for (int r = 0; r < 16; ++r) { const float pv = __builtin_amdgcn_exp2f(s[r] - mb); ps += pv; pb[r >> 3][r & 7] = (f16)pv; }
            l[j] += ps;
#pragma unroll
            for (int st = 0; st < 2; ++st) { o0[j] = __builtin_amdgcn_mfma_f32_32x32x16_f16(va[0][st], pb[st], o0[j], 0, 0, 0); o1[j] = __builtin_amdgcn_mfma_f32_32x32x16_f16(va[1][st], pb[st], o1[j], 0, 0, 0); }
            __builtin_amdgcn_sched_barrier(0);
        }
    }
#pragma unroll
    for (int j = 0; j < 2; ++j) {
        const float lt = l[j] + __shfl_xor(l[j], 32);
        const float mf = fmaxf(m[j], sink2), al = __builtin_amdgcn_exp2f(m[j] - mf);
        const float sc = al / (lt * al + __builtin_amdgcn_exp2f(sink2 - mf));
        LDS_WAIT();
#pragma unroll
        for (int g = 0; g < 4; ++g) {
            half4 a, c;
#pragma unroll
            for (int i = 0; i < 4; ++i) { a[i] = (f16)(o0[j][4 * g + i] * sc); c[i] = (f16)(o1[j][4 * g + i] * sc); }
            *(LAS half4*)(kst + r32 * 128 + ((g ^ (r32 & 7)) << 4) + 8 * hh) = a;
            *(LAS half4*)(kst + r32 * 128 + (((4 + g) ^ (r32 & 7)) << 4) + 8 * hh) = c;
        }
        LDS_WAIT();
#pragma unroll
        for (int i = 0; i < 4; ++i) {
            const int row = (lane >> 3) + 8 * i, ch = lane & 7;
            const half8 v = *(const LAS half8*)(kst + row * 128 + ((ch ^ (row & 7)) << 4));
            *(half8*)(ocat + (size_t)(b * SEQ + (2 * qp + j) * 32 + row) * DM + h * 64 + ch * 8) = v;
        }
    }
}

__device__ __forceinline__ void ph_pool_naive(const Ctx& C, const f16* __restrict__ qkvu, f16* __restrict__ mixed) {
    for (size_t gid = (size_t)C.gt; gid < (size_t)T * 512; gid += (size_t)C.ngt) {
        const int c = (int)(gid & 511), t = (int)(gid >> 9);
        const int b = t / SEQ, ts = t % SEQ, g = c >> 7, w = 2 << g;
        const int lo = max(ts - w / 2, 0), hi = min(ts + w / 2, SEQ);
        float s = 0.f;
        for (int i = lo; i < hi; ++i) s += (float)qkvu[(size_t)(b * SEQ + i) * NQKVU + COL_U + c];
        const float mean = s / (float)(hi - lo);
        mixed[(size_t)t * 512 + c] = (f16)(mean - (float)qkvu[(size_t)t * NQKVU + COL_U + c]);
    }
}
__device__ __forceinline__ void ph_poolmm_naive(const Ctx& C, const f16* __restrict__ mixed, const f16* __restrict__ poolw_t, const float* __restrict__ pscale, f16* __restrict__ ocat) {
    for (size_t gid = (size_t)C.gt; gid < (size_t)T * 512; gid += (size_t)C.ngt) {
        const int n = (int)(gid & 511), t = (int)(gid >> 9), g = n >> 7, d = n & 127;
        const f16* mr = mixed + (size_t)t * 512 + g * 128;
        const f16* wr = poolw_t + (size_t)(g * 128 + d) * 128;
        float acc = 0.f;
        for (int c = 0; c < 128; ++c) acc += (float)mr[c] * (float)wr[c];
        ocat[(size_t)t * DM + 512 + n] = (f16)(acc * pscale[n]);
    }
}

template <int HW>
__device__ __forceinline__ void pool_step1(const f16* __restrict__ qkvu, LAS unsigned char* tile, int t0, int g, int lane) {
    const int c2 = lane, b = t0 >> 11, sf = t0 & (SEQ - 1);
    const f16* ub = qkvu + (size_t)(b * SEQ) * NQKVU + COL_U + g * 128 + 2 * c2;
    constexpr int NR = 32 + 2 * HW - 1;
    half2 v[NR];
#pragma unroll
    for (int i = 0; i < NR; ++i) { const int s = sf - HW + i; half2 z; z[0] = (f16)0.f; z[1] = (f16)0.f; v[i] = z; if (s >= 0 && s < SEQ) v[i] = *(const half2*)(ub + (size_t)s * NQKVU); }
    float s0 = 0.f, s1 = 0.f;
#pragma unroll
    for (int i = 0; i < 2 * HW - 1; ++i) { s0 += (float)v[i][0]; s1 += (float)v[i][1]; }
#pragma unroll
    for (int j = 0; j < 32; ++j) {
        s0 += (float)v[j + 2 * HW - 1][0]; s1 += (float)v[j + 2 * HW - 1][1];
        const int s = sf + j, lo = max(s - HW, 0), hi = min(s + HW, SEQ);
        const float inv = 1.0f / (float)(hi - lo);
        half2 mx; mx[0] = (f16)(s0 * inv - (float)v[j + HW][0]); mx[1] = (f16)(s1 * inv - (float)v[j + HW][1]);
        *(LAS half2*)(tile + j * 256 + (((c2 >> 2) ^ (j & 15)) << 4) + ((c2 & 3) << 2)) = mx;
        s0 -= (float)v[j][0]; s1 -= (float)v[j][1];
    }
}
__device__ __forceinline__ void pool_unit(const Ctx& C, int u, LAS unsigned char* lds, const f16* __restrict__ qkvu, const f16* __restrict__ poolw_t, const float* __restrict__ pscale, f16* __restrict__ ocat) {
    const int lane = C.lane, r32 = lane & 31, hh = lane >> 5;
    LAS unsigned char* tile = lds + C.wave * 8192;
    const int g = u & 3, t0 = (u >> 2) * 32;
    switch (g) { case 0: pool_step1<1>(qkvu, tile, t0, g, lane); break; case 1: pool_step1<2>(qkvu, tile, t0, g, lane); break;
                 case 2: pool_step1<4>(qkvu, tile, t0, g, lane); break; default: pool_step1<8>(qkvu, tile, t0, g, lane); break; }
    LDS_WAIT();
    f32x16 acc[4];
#pragma unroll
    for (int db = 0; db < 4; ++db)
#pragma unroll
        for (int r = 0; r < 16; ++r) acc[db][r] = 0.f;
    const f16* wr = poolw_t + (size_t)(g * 128 + r32) * 128 + 8 * hh;
#pragma unroll
    for (int ks = 0; ks < 8; ++ks) {
        const half8 bm = *(const LAS half8*)(tile + r32 * 256 + (((2 * ks + hh) ^ (r32 & 15)) << 4));
#pragma unroll
        for (int db = 0; db < 4; ++db) { const half8 a = *(const half8*)(wr + (size_t)(db * 32) * 128 + 16 * ks); acc[db] = __builtin_amdgcn_mfma_f32_32x32x16_f16(a, bm, acc[db], 0, 0, 0); }
    }
    LDS_WAIT();
    f16* orow = ocat + (size_t)(t0 + r32) * DM + 512 + g * 128 + 4 * hh;
    const float* ps = pscale + g * 128 + 4 * hh;
#pragma unroll
    for (int db = 0; db < 4; ++db)
#pragma unroll
        for (int q = 0; q < 4; ++q) {
            const f32x4 pv = *(const f32x4*)(ps + db * 32 + 8 * q);
            half4 x0;
#pragma unroll
            for (int i = 0; i < 4; ++i) x0[i] = (f16)(acc[db][4 * q + i] * pv[i]);
            *(half4*)(orow + db * 32 + 8 * q) = x0;
        }
}
__device__ __forceinline__ void ph_attn_pool(const Ctx& C, LAS unsigned char* lds, const f16* __restrict__ qkvu, const f16* __restrict__ vT, const float* __restrict__ sink,
                                             const f16* __restrict__ poolw_t, const float* __restrict__ pscale, f16* __restrict__ ocat) {
    const int vwg = (C.G % 8 == 0) ? (int)(blockIdx.x % 8) * (C.G / 8) + (int)(blockIdx.x / 8) : (int)blockIdx.x;
    const bool pool_first = (C.wave & 4) != 0;
    for (int i = 0, m = vwg * NWAVES + C.wave; m < (T / 32) * 4; ++i) {
        if (((i & 1) == 0) == pool_first) pool_unit(C, m, lds, qkvu, poolw_t, pscale, ocat);
        else attn_unit2(C, m, lds, qkvu, vT, sink, ocat);
        if (i & 1) m += C.ngw;
    }
}

#define INS(LV, LI, v_, i_) do { float cv_ = (v_); int ci_ = (i_); \
    _Pragma("unroll") for (int z_ = 0; z_ < 16; ++z_) { const bool gt_ = cv_ > LV[z_]; const float tv_ = gt_ ? LV[z_] : cv_; const int ti_ = gt_ ? LI[z_] : ci_; \
        LV[z_] = gt_ ? cv_ : LV[z_]; LI[z_] = gt_ ? ci_ : LI[z_]; cv_ = tv_; ci_ = ti_; } } while (0)
__device__ __forceinline__ void ph_route_naive(const Ctx& C, const f16* __restrict__ qp, const float* __restrict__ ss2, const f16* __restrict__ subk, int* __restrict__ eidx, float* __restrict__ egate) {
    for (int gid = C.gt; gid < T * 8; gid += C.ngt) {
        const int t = gid % T, h = gid / T;
        const float rs2 = rs_from_ss(ss2, t);
        float av[16], bv[16]; int ai[16], bi[16];
#pragma unroll
        for (int z = 0; z < 16; ++z) { av[z] = -3e38f; bv[z] = -3e38f; ai[z] = 0; bi[z] = 0; }
        for (int p = 0; p < 2; ++p) {
            const f16* qr = qp + (size_t)t * 2048 + h * 256 + p * 128;
            for (int n = 0; n < 128; ++n) {
                const f16* kr = subk + ((size_t)((h * 2 + p) * 128 + n)) * 128;
                float dot = 0.f;
                for (int c = 0; c < 128; ++c) dot += (float)qr[c] * (float)kr[c];
                dot *= rs2;
                if (p == 0) INS(av, ai, dot, n); else INS(bv, bi, dot, n);
            }
        }
        float cv[16]; int ci[16];
#pragma unroll
        for (int z = 0; z < 16; ++z) { cv[z] = -3e38f; ci[z] = 0; }
#pragma unroll
        for (int i = 0; i < 16; ++i)
#pragma unroll
            for (int j = 0; j < 16; ++j)
                if ((i + 1) * (j + 1) <= 16) INS(cv, ci, av[i] + bv[j], ai[i] * 128 + bi[j]);
        float sum = 0.f, e[16];
#pragma unroll
        for (int z = 0; z < 16; ++z) { e[z] = __expf(cv[z] - cv[0]); sum += e[z]; }
        const float inv = 1.0f / sum;
#pragma unroll
        for (int z = 0; z < 16; ++z) { eidx[(size_t)t * 128 + h * 16 + z] = ci[z]; egate[(size_t)t * 128 + h * 16 + z] = e[z] * inv; }
    }
}

__device__ __forceinline__ int mono_i(float f) { const int b = __float_as_int(f); return b ^ ((b >> 31) & 0x7fffffff); }
__device__ __forceinline__ float unmono_f(int m) { return __int_as_float(m ^ ((m >> 31) & 0x7fffffff)); }
#define INS16(Lst, x_) do { int xv_ = (x_); _Pragma("unroll") for (int z_ = 0; z_ < 16; ++z_) { const int hi_ = max(Lst[z_], xv_); xv_ = min(Lst[z_], xv_); Lst[z_] = hi_; } } while (0)
__device__ __forceinline__ void merge_pair16(int (&Lst)[16]) {
    int P[16];
#pragma unroll
    for (int z = 0; z < 16; ++z) P[z] = __shfl_xor(Lst[z], 32);
#pragma unroll
    for (int z = 0; z < 16; ++z) Lst[z] = max(Lst[z], P[15 - z]);
#pragma unroll
    for (int s = 8; s >= 1; s >>= 1)
#pragma unroll
        for (int i = 0; i < 16; ++i) if ((i & s) == 0) { const int hi = max(Lst[i], Lst[i + s]), lo = min(Lst[i], Lst[i + s]); Lst[i] = hi; Lst[i + s] = lo; }
}
__device__ __forceinline__ void bitonic_sort16_desc(int (&K)[16]) {
#pragma unroll
    for (int k = 2; k <= 16; k <<= 1)
#pragma unroll
        for (int j = k >> 1; j > 0; j >>= 1)
#pragma unroll
            for (int i = 0; i < 16; ++i) { const int l = i ^ j; if (l > i) { const int a = K[i], b = K[l], hi = max(a, b), lo = min(a, b); const bool desc = (i & k) == 0; K[i] = desc ? hi : lo; K[l] = desc ? lo : hi; } }
}
__device__ __forceinline__ void bitonic_merge16_desc(int (&K)[16]) {
#pragma unroll
    for (int s = 8; s >= 1; s >>= 1)
#pragma unroll
        for (int i = 0; i < 16; ++i) if ((i & s) == 0) { const int hi = max(K[i], K[i + s]), lo = min(K[i], K[i + s]); K[i] = hi; K[i + s] = lo; }
}
template <class Side>
__device__ __forceinline__ void ph_route(const Ctx& C, LAS unsigned char* lds, const f16* __restrict__ qp, const float* __restrict__ ss2, const f16* __restrict__ subk,
                                         int* __restrict__ eidx, float* __restrict__ egate, const Side& side_job) {
    const int lane = C.lane, r32 = lane & 31, hh = lane >> 5;
    LAS unsigned char* tab = lds + 65536 + C.wave * 4096 + lane * 36;
    const int GH = C.G < 8 ? C.G : 8;
  for (int h = blockIdx.x % GH; h < 8; h += GH) {
    const int rank_h = blockIdx.x / GH, nwg_h = (C.G - (blockIdx.x % GH) + GH - 1) / GH;
    __syncthreads();
    for (int i = C.tid; i < 2 * 128 * 16; i += NTHREADS) {
        const int row = i >> 4, ch = i & 15;
        *(LAS half8*)(lds + row * 256 + ((ch ^ (row & 15)) << 4)) = *(const half8*)(subk + (size_t)(h * 256 + row) * 128 + ch * 8);
    }
    __syncthreads();
    if (h == (int)(blockIdx.x % GH) && (C.wave & 4)) side_job();
    for (int tb = rank_h * NWAVES + C.wave; tb < T / 32; tb += nwg_h * NWAVES) {
        const int t0 = tb * 32, t = t0 + r32;
        int top[2][16];
#pragma unroll
        for (int p = 0; p < 2; ++p) {
            const f16* qrow = qp + (size_t)t * 2048 + h * 256 + p * 128 + 8 * hh;
            const LAS unsigned char* kl = lds + (p * 128 + r32) * 256;
            half8 bq[8];
#pragma unroll
            for (int ks = 0; ks < 8; ++ks) bq[ks] = *(const half8*)(qrow + 16 * ks);
            int Lst[16];
#pragma unroll
            for (int z = 0; z < 16; ++z) Lst[z] = (int)0x80000000;
#pragma unroll 1
            for (int nb = 0; nb < 4; ++nb) {
                f32x16 acc = {0.f, 0.f, 0.f, 0.f, 0.f, 0.f, 0.f, 0.f, 0.f, 0.f, 0.f, 0.f, 0.f, 0.f, 0.f, 0.f};
#pragma unroll
                for (int ks = 0; ks < 8; ++ks) {
                    const half8 ak = *(const LAS half8*)(kl + nb * 32 * 256 + (((2 * ks + hh) ^ (r32 & 15)) << 4));
                    acc = __builtin_amdgcn_mfma_f32_32x32x16_f16(ak, bq[ks], acc, 0, 0, 0);
                }
                int K[16];
#pragma unroll
                for (int r = 0; r < 16; ++r) { const int n = nb * 32 + (r & 3) + 8 * (r >> 2) + 4 * hh; K[r] = (mono_i(acc[r]) & ~127) | (127 - n); }
                bitonic_sort16_desc(K);
#pragma unroll
                for (int z = 0; z < 16; ++z) Lst[z] = max(Lst[z], K[15 - z]);
                bitonic_merge16_desc(Lst);
            }
            merge_pair16(Lst);
#pragma unroll
            for (int z = 0; z < 16; ++z) top[p][z] = Lst[z];
        }
        float va[16], vb[16];
#pragma unroll
        for (int z = 0; z < 16; ++z) { va[z] = unmono_f(top[0][z] & ~127); vb[z] = unmono_f(top[1][z] & ~127);
            tab[z] = (unsigned char)(127 - (top[0][z] & 127)); tab[16 + z] = (unsigned char)(127 - (top[1][z] & 127)); }
        int Cl[16];
        { const float a01 = hh ? va[1] : va[0];
#pragma unroll
          for (int j = 0; j < 16; ++j) { const int key = (mono_i(a01 + vb[j]) & ~255) | (255 - (hh * 16 + j)); Cl[j] = (hh && j >= 8) ? (int)0x80000000 : key; } }
#pragma unroll
        for (int i = 2; i < 16; i += 2) {
            const float ai = hh ? va[i + 1] : va[i];
#pragma unroll
            for (int j = 0; j < 16; ++j)
                if ((i + 1) * (j + 1) <= 16) {
                    int key = (mono_i(ai + vb[j]) & ~255) | (255 - ((i + hh) * 16 + j));
                    if ((i + 2) * (j + 1) > 16) key = hh ? (int)0x80000000 : key;
                    INS16(Cl, key);
                }
        }
        merge_pair16(Cl);
        float e[16], sum = 0.f; const float mx = unmono_f(Cl[0] & ~255);
#pragma unroll
        for (int z = 0; z < 16; ++z) { e[z] = __expf(unmono_f(Cl[z] & ~255) - mx); sum += e[z]; }
        const float inv = 1.0f / sum;
        LDS_WAIT();
        int* ei = eidx + (size_t)t * 128 + h * 16 + 8 * hh; float* eg = egate + (size_t)t * 128 + h * 16 + 8 * hh;
#pragma unroll
        for (int z = 0; z < 16; ++z) {
            if ((z >> 3) == hh) { const int code = 255 - (Cl[z] & 255); const int ia = tab[code >> 4], ib = tab[16 + (code & 15)];
                ei[z & 7] = ia * 128 + ib; eg[z & 7] = e[z] * inv; }
        }
        LDS_WAIT();
    }
  }
}

struct Slicing { int m, pi, nloc, rank; };
__device__ __forceinline__ Slicing get_slicing(const unsigned* bar, volatile LAS unsigned* misc) {
    Slicing S; const unsigned x = (unsigned)__builtin_amdgcn_s_getreg((3 << 11) | 20) & 0xFu;
    int m = 0, pi = 0, nloc = 1;
    for (unsigned j = 0; j < 16; ++j) { const unsigned c = __hip_atomic_load(&bar[256 + 64 * j], __ATOMIC_RELAXED, __HIP_MEMORY_SCOPE_AGENT); if (c > 0u) { if (j < x) ++pi; ++m; } if (j == x) nloc = (int)c; }
    S.m = m > 0 ? m : 1; S.pi = pi; S.nloc = nloc > 0 ? nloc : 1; S.rank = (int)misc[10];
    return S;
}
__device__ __forceinline__ float gelu_fast(float v) {
    const float av = fabsf(v), t = __builtin_amdgcn_rcpf(av * 0.2316418882f + 1.0f);
    float q = t * 0.5307027145f + (-0.7265760135f); q = q * t + 0.7107068705f; q = q * t + (-0.142248368f); q = q * t + 0.127414796f; q = q * t;
    const float m = v * (q * __builtin_amdgcn_exp2f((v * v) * (-0.72134752044f)));
    return v < 0.f ? m : v - m;
}
__device__ __forceinline__ void ph_h2quant(const Ctx& C, const f16* __restrict__ x1h, const float* __restrict__ ss2, unsigned* __restrict__ h2q, float* __restrict__ hsc) {
    const int lane = C.lane;
    for (int t = C.gw; t < T; t += C.ngw) {
        const half8 h0 = *(const half8*)(x1h + (size_t)t * DM + 16 * lane), h1 = *(const half8*)(x1h + (size_t)t * DM + 16 * lane + 8);
        float hm = 0.f;
#pragma unroll
        for (int i = 0; i < 8; ++i) hm = fmaxf(hm, fmaxf(fabsf((float)h0[i]), fabsf((float)h1[i])));
        hm = wave_max(hm);
        const float inv = hm > 0.f ? 127.0f / hm : 0.f;
        u32x4 w;
        w[0] = (unsigned)pack4_i8((float)h0[0] * inv, (float)h0[1] * inv, (float)h0[2] * inv, (float)h0[3] * inv);
        w[1] = (unsigned)pack4_i8((float)h0[4] * inv, (float)h0[5] * inv, (float)h0[6] * inv, (float)h0[7] * inv);
        w[2] = (unsigned)pack4_i8((float)h1[0] * inv, (float)h1[1] * inv, (float)h1[2] * inv, (float)h1[3] * inv);
        w[3] = (unsigned)pack4_i8((float)h1[4] * inv, (float)h1[5] * inv, (float)h1[6] * inv, (float)h1[7] * inv);
        *(u32x4*)(h2q + (size_t)t * 256 + 4 * lane) = w;
        if (lane == 0) hsc[t] = hm * (1.0f / 127.0f) * rs_from_ss(ss2, t);
    }
}
__device__ __forceinline__ __amdgpu_buffer_rsrc_t slice_rsrc(const unsigned char* base) {
    const unsigned long long b = (unsigned long long)base;
    const unsigned lo = __builtin_amdgcn_readfirstlane((unsigned)b), hi = __builtin_amdgcn_readfirstlane((unsigned)(b >> 32));
    return __builtin_amdgcn_make_buffer_rsrc((void*)(((unsigned long long)hi << 32) | lo), 0, NEXP * 128, 0x00020000);
}
template <int EMASK>
__device__ __forceinline__ void ph_upeer(const Ctx& C, LAS unsigned char* lds, const Slicing SL, const unsigned* __restrict__ h2q, const int* __restrict__ eidx,
                                         const unsigned char* __restrict__ uq, short* __restrict__ pdot) {
    const int lane = C.lane, grp = lane >> 3, c8 = lane & 7;
    const int wv = SL.rank * NWAVES + C.wave, nwv = SL.nloc * NWAVES;
    const int ntok = (T - wv + nwv - 1) / nwv;
    auto tok = [&](int i) { const int t = wv + i * nwv; return t < T ? t : T - 1; };
    volatile LAS int* row = (volatile LAS int*)(lds + C.wave * 1024);
  for (int s = SL.pi; s < 8; s += SL.m) {
    const __amdgpu_buffer_rsrc_t urs = slice_rsrc(uq + (size_t)s * (NEXP * 128));
    const unsigned* hqs = h2q + s * 32 + c8 * 4;
    int tA = tok(0), tB = tok(1);
    int e0 = eidx[(size_t)tA * 128 + lane], e1 = eidx[(size_t)tA * 128 + 64 + lane];
    u32x4 hq = *(const u32x4*)(hqs + (size_t)tA * 256);
    int ne0 = eidx[(size_t)tB * 128 + lane], ne1 = eidx[(size_t)tB * 128 + 64 + lane];
    u32x4 r[16];
#pragma unroll
    for (int i = 0; i < 16; ++i) { const int e = __shfl(i < 8 ? e0 : e1, 8 * (i & 7) + grp) & EMASK; r[i] = __builtin_amdgcn_raw_buffer_load_b128(urs, e * 128 + c8 * 16, 0, 0); }
#pragma unroll 1
    for (int it = 0; it < ntok; ++it) {
        const int t = tok(it), t1 = tok(it + 1), t2 = tok(it + 2);
        const int ze0 = eidx[(size_t)t2 * 128 + lane], ze1 = eidx[(size_t)t2 * 128 + 64 + lane];
        const u32x4 nhq = *(const u32x4*)(hqs + (size_t)t1 * 256);
#pragma unroll
        for (int q = 0; q < 4; ++q) {
            int evv[4];
#pragma unroll
            for (int j = 0; j < 4; ++j) evv[j] = __shfl(q < 2 ? ne0 : ne1, 32 * (q & 1) + 8 * j + grp) & EMASK;
            int pa[4], pb[4];
#pragma unroll
            for (int j = 0; j < 4; ++j) {
                pa[j] = __builtin_amdgcn_sdot4((int)r[4 * q + j][0], (int)hq[0], 0, false); pb[j] = __builtin_amdgcn_sdot4((int)r[4 * q + j][1], (int)hq[1], 0, false);
                pa[j] = __builtin_amdgcn_sdot4((int)r[4 * q + j][2], (int)hq[2], pa[j], false); pb[j] = __builtin_amdgcn_sdot4((int)r[4 * q + j][3], (int)hq[3], pb[j], false);
            }
#pragma unroll
            for (int j = 0; j < 4; ++j) { pa[j] += pb[j]; pa[j] += dppi<0xB1>(pa[j]); }
#pragma unroll
            for (int j = 0; j < 4; ++j) pa[j] += dppi<0x4E>(pa[j]);
#pragma unroll
            for (int j = 0; j < 4; ++j) pa[j] += dppi<0x141>(pa[j]);
            if (c8 == 0) {
#pragma unroll
                for (int j = 0; j < 4; ++j) row[8 * (4 * q + j) + grp] = pa[j];
            }
#pragma unroll
            for (int j = 0; j < 4; ++j) {
                asm volatile("" ::: "memory");
                r[4 * q + j] = __builtin_amdgcn_raw_buffer_load_b128(urs, evv[j] * 128 + c8 * 16, 0, 0);
                asm volatile("" ::: "memory");
            }
        }
        LDS_WAIT();
        const int p0 = row[lane], p1 = row[64 + lane];
        LDS_WAIT();
        { short* pp = pdot + ((size_t)s * T + t) * 128 + lane; const int c0 = min(max((p0 + 4) >> 3, -32768), 32767), c1 = min(max((p1 + 4) >> 3, -32768), 32767);
          asm volatile("global_store_short %0, %1, off\n\tglobal_store_short %0, %2, off offset:128" :: "v"(pp), "v"(c0), "v"(c1) : "memory"); }
        hq = nhq; ne0 = ze0; ne1 = ze1;
    }
  }
}
__device__ __forceinline__ void ph_ureduce(const Ctx& C, LAS unsigned char* lds, const short* __restrict__ pdot, const float* __restrict__ hsc, const int* __restrict__ eidx, const float* __restrict__ us,
                                           const float* __restrict__ vs, const float* __restrict__ egate, unsigned* __restrict__ wqp, float* __restrict__ wsc) {
    const int lane = C.lane;
    volatile LAS unsigned char* row = (volatile LAS unsigned char*)(lds + C.wave * 1024);
    for (int tb = C.gw * 2; tb < T; tb += C.ngw * 2) {
        int e0[2], e1[2], s0[2], s1[2]; float h[2], g0[2], g1[2];
#pragma unroll
        for (int u = 0; u < 2; ++u) {
            const int t = tb + u;
            e0[u] = eidx[(size_t)t * 128 + lane]; e1[u] = eidx[(size_t)t * 128 + 64 + lane];
            g0[u] = egate[(size_t)t * 128 + lane]; g1[u] = egate[(size_t)t * 128 + 64 + lane];
            h[u] = hsc[t]; s0[u] = 0; s1[u] = 0;
#pragma unroll
            for (int s = 0; s < 8; ++s) { const short* pp = pdot + ((size_t)s * T + t) * 128 + lane; s0[u] += (int)pp[0]; s1[u] += (int)pp[64]; }
        }
        float w0[2], w1[2];
#pragma unroll
        for (int u = 0; u < 2; ++u) {
            w0[u] = gelu_fast((float)s0[u] * (8.0f * h[u]) * us[e0[u]]) * g0[u] * vs[e0[u]];
            w1[u] = gelu_fast((float)s1[u] * (8.0f * h[u]) * us[e1[u]]) * g1[u] * vs[e1[u]];
        }
#pragma unroll
        for (int u = 0; u < 2; ++u) {
            const int t = tb + u;
            const float wm = wave_max(fmaxf(fabsf(w0[u]), fabsf(w1[u])));
            const float inv = wm > 0.f ? 127.0f / wm : 0.f;
            { const int k = lane; row[u * 128 + (k & 7) * 16 + (k >> 5) * 4 + ((k >> 3) & 3)] = (unsigned char)(int)rintf(w0[u] * inv); }
            { const int k = 64 + lane; row[u * 128 + (k & 7) * 16 + (k >> 5) * 4 + ((k >> 3) & 3)] = (unsigned char)(int)rintf(w1[u] * inv); }
            if (lane == 0) wsc[t] = wm * (1.0f / 127.0f);
        }
        LDS_WAIT();
        wqp[(size_t)tb * 32 + lane] = ((volatile LAS unsigned*)row)[lane];
        LDS_WAIT();
    }
}
template <int EMASK>
__device__ __forceinline__ void ph_vpeer(const Ctx& C, const Slicing SL, const int* __restrict__ eidx, const unsigned* __restrict__ wqp, const float* __restrict__ wsc, const unsigned char* __restrict__ vq,
                                         f16* __restrict__ peer) {
    const int lane = C.lane, grp = lane >> 3, c8 = lane & 7;
    const bool hh = (lane & 32) != 0, b4 = (lane & 16) != 0, b3 = (lane & 8) != 0;
    const int wv = SL.rank * NWAVES + C.wave, nwv = SL.nloc * NWAVES;
    const int ntok = (T - wv + nwv - 1) / nwv;
    auto tok = [&](int i) { const int t = wv + i * nwv; return t < T ? t : T - 1; };
  for (int s = SL.pi; s < 8; s += SL.m) {
    const __amdgpu_buffer_rsrc_t vrs = slice_rsrc(vq + (size_t)s * (NEXP * 128));
    const int chl = 8 * (hh ? 1 : 0) + 4 * (b4 ? 1 : 0) + 2 * (b3 ? 1 : 0);
    const int coff = s * 128 + c8 * 16 + chl;
    int tA = tok(0), tB = tok(1);
    int e0 = eidx[(size_t)tA * 128 + lane], e1 = eidx[(size_t)tA * 128 + 64 + lane];
    u32x4 wq = *(const u32x4*)(wqp + (size_t)tA * 32 + grp * 4); float wscale = wsc[tA];
    int ne0 = eidx[(size_t)tB * 128 + lane], ne1 = eidx[(size_t)tB * 128 + 64 + lane];
    u32x4 r[16];
#pragma unroll
    for (int i = 0; i < 16; ++i) { const int e = __shfl(i < 8 ? e0 : e1, 8 * (i & 7) + grp) & EMASK; r[i] = __builtin_amdgcn_raw_buffer_load_b128(vrs, e * 128 + c8 * 16, 0, 0); }
#pragma unroll 1
    for (int it = 0; it < ntok; ++it) {
        const int t = tok(it), t1 = tok(it + 1), t2 = tok(it + 2);
        const int ze0 = eidx[(size_t)t2 * 128 + lane], ze1 = eidx[(size_t)t2 * 128 + 64 + lane];
        const u32x4 nwq = *(const u32x4*)(wqp + (size_t)t1 * 32 + grp * 4); const float nwscale = wsc[t1];
        int o[16];
#pragma unroll
        for (int c = 0; c < 16; ++c) o[c] = 0;
#pragma unroll
        for (int q = 0; q < 4; ++q) {
            int evv[4];
#pragma unroll
            for (int j = 0; j < 4; ++j) evv[j] = __shfl(q < 2 ? ne0 : ne1, 32 * (q & 1) + 8 * j + grp) & EMASK;
#pragma unroll
            for (int d = 0; d < 4; ++d) {
                const unsigned a = r[4 * q][d], b = r[4 * q + 1][d], c = r[4 * q + 2][d], e = r[4 * q + 3][d];
                const unsigned t0 = __builtin_amdgcn_perm(b, a, 0x05010400u), t1p = __builtin_amdgcn_perm(b, a, 0x07030602u);
                const unsigned u0 = __builtin_amdgcn_perm(e, c, 0x05010400u), u1 = __builtin_amdgcn_perm(e, c, 0x07030602u);
                o[4 * d + 0] = __builtin_amdgcn_sdot4((int)__builtin_amdgcn_perm(u0, t0, 0x05040100u), (int)wq[q], o[4 * d + 0], false);
                o[4 * d + 1] = __builtin_amdgcn_sdot4((int)__builtin_amdgcn_perm(u0, t0, 0x07060302u), (int)wq[q], o[4 * d + 1], false);
                o[4 * d + 2] = __builtin_amdgcn_sdot4((int)__builtin_amdgcn_perm(u1, t1p, 0x05040100u), (int)wq[q], o[4 * d + 2], false);
                o[4 * d + 3] = __builtin_amdgcn_sdot4((int)__builtin_amdgcn_perm(u1, t1p, 0x07060302u), (int)wq[q], o[4 * d + 3], false);
            }
#pragma unroll
            for (int j = 0; j < 4; ++j) {
                asm volatile("" ::: "memory");
                r[4 * q + j] = __builtin_amdgcn_raw_buffer_load_b128(vrs, evv[j] * 128 + c8 * 16, 0, 0);
                asm volatile("" ::: "memory");
            }
        }
        int q8[8], q4[4], q2[2];
#pragma unroll
        for (int k = 0; k < 8; ++k) q8[k] = bfly32i(o[k], o[8 + k]);
#pragma unroll
        for (int k = 0; k < 4; ++k) q4[k] = bfly16i(q8[k], q8[4 + k]);
#pragma unroll
        for (int k = 0; k < 2; ++k) { const int mine = b3 ? q4[2 + k] : q4[k], oth = b3 ? q4[k] : q4[2 + k]; q2[k] = mine + dppi<0x128>(oth); }
        { half2 pv; pv[0] = (f16)((float)q2[0] * wscale); pv[1] = (f16)((float)q2[1] * wscale); f16* yp = peer + (size_t)t * DM + coff; asm volatile("global_store_dword %0, %1, off" :: "v"(yp), "v"(pv) : "memory"); }
        wq = nwq; wscale = nwscale; ne0 = ze0; ne1 = ze1;
    }
  }
}
__device__ __forceinline__ void ph_final(const Ctx& C, const f16* __restrict__ peer, float* xio, const float* __restrict__ gf) {
    const int lane = C.lane;
    f32x4 gg[4];
#pragma unroll
    for (int j = 0; j < 4; ++j) gg[j] = *(const f32x4*)(gf + j * 256 + lane * 4);
    for (int tb = C.gw * 4; tb < T; tb += C.ngw * 4) {
        f32x4 v[4][4]; half4 pe[4][4];
#pragma unroll
        for (int u = 0; u < 4; ++u)
#pragma unroll
            for (int j = 0; j < 4; ++j) { v[u][j] = *(const f32x4*)(xio + (size_t)(tb + u) * DM + j * 256 + lane * 4); pe[u][j] = *(const half4*)(peer + (size_t)(tb + u) * DM + j * 256 + lane * 4); }
#pragma unroll
        for (int u = 0; u < 4; ++u) {
            float s = 0.f;
#pragma unroll
            for (int j = 0; j < 4; ++j) {
#pragma unroll
                for (int i = 0; i < 4; ++i) { v[u][j][i] += (float)pe[u][j][i]; s += v[u][j][i] * v[u][j][i]; }
            }
            const float r = rsqrtf(wave_sum(s) * (1.0f / DM) + EPS);
#pragma unroll
            for (int j = 0; j < 4; ++j) *(f32x4*)(xio + (size_t)(tb + u) * DM + j * 256 + lane * 4) = v[u][j] * r * gg[j];
        }
    }
}

namespace pg8 {
#define PG8_LAS __attribute__((address_space(3)))
typedef _Float16 frag8 __attribute__((ext_vector_type(8)));
typedef float f32x4 __attribute__((ext_vector_type(4)));
constexpr int BM = 256, BK = 64, HALF = 128, HTB = HALF * BK * 2  , STAGE_BYTES = 8 * HTB, NXCD = 8, WGM = 8;

__host__ __device__ __forceinline__ int lds_byte(int r, int c) { const int st = (r >> 4) * 2 + (c >> 5), rr = r & 15, cc = c & 31, ob = rr * 64 + cc * 2; return st * 1024 + (ob ^ (((ob >> 9) & 1) << 5)); }
__host__ __device__ __forceinline__ void stage_rc(int b, int& R, int& C) { const int st = b / 1024, sb = b % 1024, swz = sb ^ (((sb >> 9) & 1) << 5); R = (st >> 1) * 16 + swz / 64; C = (st & 1) * 32 + (swz % 64) / 2; }
__host__ __device__ __forceinline__ int perm32(int rho) { const int n = rho >> 4, i = rho & 15; return 8 * (i >> 2) + 4 * n + (i & 3); }

struct Unit { int pm, pn; };
struct Gemm { const f16* A; const f16* Bt; int M, N, K; };

struct StaticOrder {
    int nM, nN, nwg, G, c;
    __host__ __device__ void init(int M, int N, int G_, int c_) { nM = M / BM; nN = N / BM; nwg = nM * nN; G = G_; c = c_; }
    __host__ __device__ bool next(int i, Unit& u) const {
        const long L = (long)i * G + c; if (L >= nwg) return false;
        int wgid = (int)L; { const int q = nwg / NXCD, r = nwg % NXCD, xcd = wgid % NXCD, off = wgid / NXCD; wgid = (xcd < r ? xcd * (q + 1) : r * (q + 1) + (xcd - r) * q) + off; }
        const int nig = WGM * nN, gid = wgid / nig, fm = gid * WGM, gsz = (nM - fm) < WGM ? (nM - fm) : WGM;
        u.pm = fm + ((wgid % nig) % gsz); u.pn = (wgid % nig) / gsz; return true;
    }
    __device__ __forceinline__ void a_ready(const Unit&) const {}
    __device__ __forceinline__ void done(const Unit&) const {}
};

__device__ __forceinline__ frag8 pack8(const f32x4 a, const f32x4 b) {
    frag8 h; h[0] = (f16)a[0]; h[1] = (f16)a[1]; h[2] = (f16)a[2]; h[3] = (f16)a[3]; h[4] = (f16)b[0]; h[5] = (f16)b[1]; h[6] = (f16)b[2]; h[7] = (f16)b[3]; return h;
}
__device__ __forceinline__ float sigmoidf_(float z) { return 1.0f / (1.0f + __expf(-z)); }

struct EpiP1 {
    typedef i32x4 acc_t; static constexpr bool PERM = true, AFTER_DRAIN = false, MIDK = false;
    const float* ss1; const float* rsx; const float* wcs; const float* bgate; f16* qkvu; f16* gates; f16* vT;
    __device__ __forceinline__ void operator()(const i32x4 (&acc)[2][2][4][2], const Unit& u, int wr, int wc, int fr, int fq) const {
        const int row0 = u.pm * BM + wr * 64 + fr, colt = u.pn * BM; const bool isg = colt >= NQKVU;
        f32x4 cs[2][2];
#pragma unroll
        for (int bj = 0; bj < 2; ++bj) { const int c0 = colt + bj * HALF + wc * 32 + 8 * fq; cs[bj][0] = *(const f32x4*)(wcs + c0); cs[bj][1] = *(const f32x4*)(wcs + c0 + 4); }
#pragma unroll
        for (int ai = 0; ai < 2; ++ai)
#pragma unroll
            for (int m = 0; m < 4; ++m) { const int row = row0 + ai * HALF + m * 16; const float r = rsqrtf(ss1[row] * (1.0f / DM) + EPS) * rsx[row];
#pragma unroll
                for (int bj = 0; bj < 2; ++bj) { const int c0 = colt + bj * HALF + wc * 32 + 8 * fq; f32x4 v0, v1;
#pragma unroll
                    for (int i = 0; i < 4; ++i) { v0[i] = (float)acc[ai][bj][m][0][i] * (r * cs[bj][0][i]); v1[i] = (float)acc[ai][bj][m][1][i] * (r * cs[bj][1][i]); }
                    if (isg) { const int cg = c0 - NQKVU; const f32x4 b0 = *(const f32x4*)(bgate + cg), b1 = *(const f32x4*)(bgate + cg + 4);
#pragma unroll
                        for (int i = 0; i < 4; ++i) { v0[i] = sigmoidf_(v0[i] + b0[i]); v1[i] = sigmoidf_(v1[i] + b1[i]); }
                        *(frag8*)(gates + (size_t)row * NGATE + cg) = pack8(v0, v1); }
                    else { const frag8 hv = pack8(v0, v1); *(frag8*)(qkvu + (size_t)row * NQKVU + c0) = hv;
                        if (colt == 512 && bj == 1) {
                            f16* vp = vT + ((size_t)((row >> 11) * 2 + (wc >> 1)) * 64 + (wc & 1) * 32 + 8 * fq) * SEQ + (row & (SEQ - 1));
#pragma unroll
                            for (int i = 0; i < 8; ++i) vp[(size_t)i * SEQ] = hv[i]; } } } }
    }
};
struct EpiMerged {
    typedef f32x4 acc_t; static constexpr bool PERM = true, AFTER_DRAIN = false, MIDK = true;
    const f16* gates; f16* merged;
    __device__ __forceinline__ void mid(f32x4 (&acc)[2][2][4][2], const Unit& u, int wr, int wc, int fr, int fq) const {
        const int row0 = u.pm * BM + wr * 64 + fr, colt = u.pn * BM;
        const f16* gb = gates + (size_t)row0 * NGATE + colt + wc * 32 + 8 * fq;
        asm volatile("" : "+v"(gb));
#pragma unroll
        for (int ai = 0; ai < 2; ++ai) {
            frag8 g0[4][2], g1[4][2];
#pragma unroll
            for (int m = 0; m < 4; ++m)
#pragma unroll
                for (int bj = 0; bj < 2; ++bj) { const f16* gp = gb + (size_t)(ai * HALF + m * 16) * NGATE + bj * HALF; g0[m][bj] = *(const frag8*)gp; g1[m][bj] = *(const frag8*)(gp + DM); }
#pragma unroll
            for (int m = 0; m < 4; ++m)
#pragma unroll
                for (int bj = 0; bj < 2; ++bj)
#pragma unroll
                    for (int i = 0; i < 4; ++i) {
                        acc[ai][bj][m][0][i] *= (float)g0[m][bj][i] * __builtin_amdgcn_rcpf(fmaxf((float)g1[m][bj][i], 1e-4f));
                        acc[ai][bj][m][1][i] *= (float)g0[m][bj][4 + i] * __builtin_amdgcn_rcpf(fmaxf((float)g1[m][bj][4 + i], 1e-4f)); }
            asm volatile("" ::: "memory");
        }
    }
    __device__ __forceinline__ void operator()(const f32x4 (&acc)[2][2][4][2], const Unit& u, int wr, int wc, int fr, int fq) const {
        const int row0 = u.pm * BM + wr * 64 + fr, colt = u.pn * BM;
#pragma unroll
        for (int ai = 0; ai < 2; ++ai)
#pragma unroll
            for (int m = 0; m < 4; ++m) { const int row = row0 + ai * HALF + m * 16;
#pragma unroll
                for (int bj = 0; bj < 2; ++bj) { const int c0 = colt + bj * HALF + wc * 32 + 8 * fq;
                    const frag8 g1 = *(const frag8*)(gates + (size_t)row * NGATE + DM + c0); f32x4 v0, v1;
#pragma unroll
                    for (int i = 0; i < 4; ++i) { v0[i] = acc[ai][bj][m][0][i] * fmaxf((float)g1[i], 1e-4f); v1[i] = acc[ai][bj][m][1][i] * fmaxf((float)g1[4 + i], 1e-4f); }
                    *(frag8*)(merged + (size_t)row * DM + c0) = pack8(v0, v1); } }
    }
};
struct EpiOut {
    typedef f32x4 acc_t; static constexpr bool PERM = false, AFTER_DRAIN = false, MIDK = false;
    const float* x; const float* g2; float* x1; f16* x1h; float* ss2p;
    __device__ __forceinline__ void operator()(const f32x4 (&acc)[2][2][4][2], const Unit& u, int wr, int wc, int fr, int fq) const {
        const int row0 = u.pm * BM + wr * 64 + fr, col0 = u.pn * BM + wc * 32 + 4 * fq;
        f32x4 gv[2][2];
#pragma unroll
        for (int bj = 0; bj < 2; ++bj)
#pragma unroll
            for (int n = 0; n < 2; ++n) gv[bj][n] = *(const f32x4*)(g2 + col0 + bj * HALF + n * 16);
#pragma unroll
        for (int ai = 0; ai < 2; ++ai)
#pragma unroll
            for (int m = 0; m < 4; ++m) { const int row = row0 + ai * HALF + m * 16; const size_t off = (size_t)row * DM + col0; float ssq = 0.f;
#pragma unroll
                for (int bj = 0; bj < 2; ++bj)
#pragma unroll
                    for (int n = 0; n < 2; ++n) { const f32x4 y = *(const f32x4*)(x + off + bj * HALF + n * 16) + acc[ai][bj][m][n];
                        *(f32x4*)(x1 + off + bj * HALF + n * 16) = y; ssq += (y[0] * y[0] + y[1] * y[1]) + (y[2] * y[2] + y[3] * y[3]);
                        const f32x4 yg = y * gv[bj][n]; half4 h; h[0] = (f16)yg[0]; h[1] = (f16)yg[1]; h[2] = (f16)yg[2]; h[3] = (f16)yg[3];
                        *(half4*)(x1h + off + bj * HALF + n * 16) = h; }
                ssq += __shfl_xor(ssq, 16); ssq += __shfl_xor(ssq, 32);
                if (fq == 0) ss2p[(size_t)(u.pn * 4 + wc) * T + row] = ssq; }
    }
};
struct EpiQ {
    typedef i32x4 acc_t; static constexpr bool PERM = true, AFTER_DRAIN = false, MIDK = false;
    const float* hsc; const float* wqs; f16* qp;
    __device__ __forceinline__ void operator()(const i32x4 (&acc)[2][2][4][2], const Unit& u, int wr, int wc, int fr, int fq) const {
        const int row0 = u.pm * BM + wr * 64 + fr, colt = u.pn * BM;
        f32x4 cs[2][2];
#pragma unroll
        for (int bj = 0; bj < 2; ++bj) { const int c0 = colt + bj * HALF + wc * 32 + 8 * fq; cs[bj][0] = *(const f32x4*)(wqs + c0); cs[bj][1] = *(const f32x4*)(wqs + c0 + 4); }
#pragma unroll
        for (int ai = 0; ai < 2; ++ai)
#pragma unroll
            for (int m = 0; m < 4; ++m) { const int row = row0 + ai * HALF + m * 16; const float r = hsc[row];
#pragma unroll
                for (int bj = 0; bj < 2; ++bj) { const int c0 = colt + bj * HALF + wc * 32 + 8 * fq; f32x4 v0, v1;
#pragma unroll
                    for (int i = 0; i < 4; ++i) { v0[i] = (float)acc[ai][bj][m][0][i] * (r * cs[bj][0][i]); v1[i] = (float)acc[ai][bj][m][1][i] * (r * cs[bj][1][i]); }
                    *(frag8*)(qp + (size_t)row * 2048 + c0) = pack8(v0, v1); } }
    }
};

__device__ __forceinline__ void mma16(const frag8 b, const frag8 a, f32x4& c) { c = __builtin_amdgcn_mfma_f32_16x16x32_f16(b, a, c, 0, 0, 0); }
__device__ __forceinline__ void mma16(const frag8 b, const frag8 a, i32x4& c) { c = __builtin_amdgcn_mfma_i32_16x16x64_i8(__builtin_bit_cast(i32x4, b), __builtin_bit_cast(i32x4, a), c, 0, 0, 0); }
template <class Epi, class Sched, bool ALIGN_EPI = false, bool SP2 = false>
__device__ __forceinline__ void gemm_phase(PG8_LAS unsigned char* lds, const Gemm g, const Sched& S, const Epi& E) {
    const int tid = threadIdx.x, wid = __builtin_amdgcn_readfirstlane(tid >> 6), lane = tid & 63, wr = wid >> 2, wc = wid & 3, fr = lane & 15, fq = lane >> 4;
    const int K = g.K, nt = K / BK;
    unsigned voffA[2], voffB[2];
#pragma unroll
    for (int i = 0; i < 2; ++i) { int R, C; stage_rc(tid * 16 + i * 8192, R, C); const int Rb = Epi::PERM ? ((R & ~31) + perm32(R & 31)) : R;
        voffA[i] = (unsigned)(R * K + C) * 2u; voffB[i] = (unsigned)(Rb * K + C) * 2u; }
    const size_t kstep = (size_t)(BK * 2);
    const size_t hstep = (size_t)HALF * K * 2;
    const size_t tstep = 2 * hstep;
    const unsigned ldsw = (unsigned)wid * 1024u;
    const int aoff = lds_byte(wr * 64 + fr, fq * 8), boff = lds_byte(wc * 32 + fr, fq * 8);
#define PG8_SA(b, h) (((b) * 2 + (h)) * HTB)
#define PG8_SB(b, h) ((4 + (b) * 2 + (h)) * HTB)
#define PG8_STAGE(bufoff, gbase, voff) do { _Pragma("unroll") for (int _i = 0; _i < 2; ++_i) \
        __builtin_amdgcn_global_load_lds((const unsigned*)((const char*)(gbase) + (voff)[_i]), (PG8_LAS unsigned*)(lds + (bufoff) + ldsw + _i * 8192), 16, 0, 0); } while (0)
#define PG8_LDA(dst, b, h) do { _Pragma("unroll") for (int m = 0; m < 4; ++m) _Pragma("unroll") for (int k = 0; k < 2; ++k) dst[m][k] = *(const PG8_LAS frag8*)(lds + PG8_SA(b, h) + aoff + m * 2048 + k * 1024); } while (0)
#define PG8_LDB(dst, b, h) do { _Pragma("unroll") for (int n = 0; n < 2; ++n) _Pragma("unroll") for (int k = 0; k < 2; ++k) dst[n][k] = *(const PG8_LAS frag8*)(lds + PG8_SB(b, h) + boff + n * 2048 + k * 1024); } while (0)
#define PG8_MMA(ai, bj, At, Bt) do { __builtin_amdgcn_s_setprio(1); _Pragma("unroll") for (int m = 0; m < 4; ++m) _Pragma("unroll") for (int n = 0; n < 2; ++n) _Pragma("unroll") for (int k = 0; k < 2; ++k) \
        mma16(Bt[n][k], At[m][k], acc[ai][bj][m][n]); __builtin_amdgcn_s_setprio(0); } while (0)
#define PG8_WAIT_V(n) asm volatile("s_waitcnt vmcnt(" #n ")" ::: "memory")
#define PG8_WAIT_L(n) asm volatile("s_waitcnt lgkmcnt(" #n ")" ::: "memory")
#define PG8_BAR __builtin_amdgcn_s_barrier()
#define PG8_SCHED __builtin_amdgcn_sched_barrier(0)
    Unit cur, nxt; int ui = 0;
    if (!S.next(0, cur)) return;
    typedef typename Epi::acc_t acc_t;
    acc_t acc[2][2][4][2];
#pragma unroll
    for (int a = 0; a < 2; ++a)
#pragma unroll
        for (int b = 0; b < 2; ++b)
#pragma unroll
            for (int m = 0; m < 4; ++m)
#pragma unroll
                for (int n = 0; n < 2; ++n) acc[a][b][m][n] = acc_t{};
    frag8 At[4][2], B0[2][2], B1[2][2];
    const char* cA = (const char*)g.A + (size_t)cur.pm * tstep; const char* cB = (const char*)g.Bt + (size_t)cur.pn * tstep;
    S.a_ready(cur);
    if constexpr (SP2) {
        PG8_STAGE(PG8_SB(0, 0), cB, voffB); PG8_STAGE(PG8_SB(0, 1), cB + hstep, voffB); PG8_STAGE(PG8_SA(0, 0), cA, voffA); PG8_STAGE(PG8_SA(0, 1), cA + hstep, voffA);
        if (wr == 1) PG8_BAR;
        PG8_WAIT_V(2); PG8_BAR;
        PG8_STAGE(PG8_SB(1, 0), cB + kstep, voffB); PG8_STAGE(PG8_SA(1, 0), cA + kstep, voffA); PG8_STAGE(PG8_SB(1, 1), cB + hstep + kstep, voffB);
        PG8_WAIT_V(6); PG8_BAR;
    } else {
        PG8_STAGE(PG8_SB(0, 0), cB, voffB); PG8_STAGE(PG8_SA(0, 0), cA, voffA); PG8_STAGE(PG8_SB(0, 1), cB + hstep, voffB); PG8_STAGE(PG8_SA(0, 1), cA + hstep, voffA);
        if (wr == 1) PG8_BAR;
        PG8_WAIT_V(4); PG8_BAR;
        PG8_STAGE(PG8_SB(1, 0), cB + kstep, voffB); PG8_STAGE(PG8_SA(1, 0), cA + kstep, voffA); PG8_STAGE(PG8_SB(1, 1), cB + hstep + kstep, voffB);
        PG8_WAIT_V(6); PG8_BAR;
    }
    for (;;) {
        const bool has_next = S.next(ui + 1, nxt);
        const char* nA = has_next ? (const char*)g.A + (size_t)nxt.pm * tstep : cA; const char* nB = has_next ? (const char*)g.Bt + (size_t)nxt.pn * tstep : cB;
        for (int t = 0; t < nt; t += 2) {
            const bool last = (t == nt - 2);
            if constexpr (Epi::MIDK) { if (t == (nt >> 1)) E.mid(acc, cur, wr, wc, fr, fq); }
            const char* a1 = cA + (size_t)(t + 1) * kstep;
            const char* a2 = last ? nA : cA + (size_t)(t + 2) * kstep; const char* b2 = last ? nB : cB + (size_t)(t + 2) * kstep;
            const char* a3 = a2 + kstep; const char* b3 = b2 + kstep;
            if (last && has_next) S.a_ready(nxt);
            if constexpr (SP2) {
            PG8_LDB(B0, 0, 0); PG8_LDB(B1, 0, 1); PG8_SCHED; PG8_LDA(At, 0, 0); PG8_STAGE(PG8_SA(1, 1), a1 + hstep, voffA);
            PG8_WAIT_V(8); PG8_WAIT_L(0); PG8_BAR; PG8_MMA(0, 0, At, B0); PG8_MMA(0, 1, At, B1); PG8_BAR; PG8_SCHED;
            PG8_LDA(At, 0, 1); PG8_STAGE(PG8_SB(0, 0), b2, voffB); PG8_STAGE(PG8_SB(0, 1), b2 + hstep, voffB); PG8_STAGE(PG8_SA(0, 0), a2, voffA);
            PG8_WAIT_V(8); PG8_WAIT_L(0); PG8_BAR; PG8_MMA(1, 0, At, B0); PG8_MMA(1, 1, At, B1); PG8_BAR; PG8_SCHED;
            PG8_LDB(B0, 1, 0); PG8_LDB(B1, 1, 1); PG8_SCHED; PG8_LDA(At, 1, 0); PG8_STAGE(PG8_SA(0, 1), a2 + hstep, voffA);
            PG8_WAIT_V(8); PG8_WAIT_L(0); PG8_BAR; PG8_MMA(0, 0, At, B0); PG8_MMA(0, 1, At, B1); PG8_BAR; PG8_SCHED;
            PG8_LDA(At, 1, 1); PG8_STAGE(PG8_SB(1, 0), b3, voffB); PG8_STAGE(PG8_SB(1, 1), b3 + hstep, voffB); PG8_STAGE(PG8_SA(1, 0), a3, voffA);
            PG8_WAIT_V(8); PG8_WAIT_L(0); PG8_BAR; PG8_MMA(1, 0, At, B0); PG8_MMA(1, 1, At, B1); PG8_BAR; PG8_SCHED;
            } else {
            PG8_LDB(B0, 0, 0); PG8_SCHED; PG8_LDA(At, 0, 0); PG8_STAGE(PG8_SA(1, 1), a1 + hstep, voffA);
            PG8_WAIT_L(8); PG8_BAR; PG8_WAIT_L(0); PG8_MMA(0, 0, At, B0); PG8_BAR; PG8_SCHED;
            PG8_LDB(B1, 0, 1); PG8_STAGE(PG8_SB(0, 0), b2, voffB);
            PG8_BAR; PG8_WAIT_L(0); PG8_MMA(0, 1, At, B1); PG8_BAR;
            PG8_LDA(At, 0, 1); PG8_STAGE(PG8_SA(0, 0), a2, voffA);
            PG8_BAR; PG8_WAIT_L(0); PG8_MMA(1, 0, At, B0); PG8_BAR; PG8_SCHED;
            PG8_STAGE(PG8_SB(0, 1), b2 + hstep, voffB);
            PG8_WAIT_V(6); PG8_BAR; PG8_MMA(1, 1, At, B1); PG8_BAR;
            PG8_LDB(B0, 1, 0); PG8_SCHED; PG8_LDA(At, 1, 0); PG8_STAGE(PG8_SA(0, 1), a2 + hstep, voffA);
            PG8_WAIT_L(8); PG8_BAR; PG8_WAIT_L(0); PG8_MMA(0, 0, At, B0); PG8_BAR; PG8_SCHED;
            PG8_LDB(B1, 1, 1); PG8_STAGE(PG8_SB(1, 0), b3, voffB);
            PG8_BAR; PG8_WAIT_L(0); PG8_MMA(0, 1, At, B1); PG8_BAR;
            PG8_LDA(At, 1, 1); PG8_STAGE(PG8_SA(1, 0), a3, voffA);
            PG8_BAR; PG8_WAIT_L(0); PG8_MMA(1, 0, At, B0); PG8_BAR; PG8_SCHED;
            PG8_STAGE(PG8_SB(1, 1), b3 + hstep, voffB);
            PG8_WAIT_V(6); PG8_BAR; PG8_MMA(1, 1, At, B1); PG8_BAR;
            }
        }
        if constexpr (ALIGN_EPI) { if (wr == 0) PG8_BAR; }
        if constexpr (!Epi::AFTER_DRAIN) { E(acc, cur, wr, wc, fr, fq); S.done(cur); }
        if (!has_next) break;
#pragma unroll
        for (int a = 0; a < 2; ++a)
#pragma unroll
            for (int b = 0; b < 2; ++b)
#pragma unroll
                for (int m = 0; m < 4; ++m)
#pragma unroll
                    for (int n = 0; n < 2; ++n) acc[a][b][m][n] = acc_t{};
        cur = nxt; cA = nA; cB = nB; ++ui;
        if constexpr (ALIGN_EPI) { if (wr == 1) PG8_BAR; }
    }
    PG8_WAIT_V(0);
    if constexpr (!ALIGN_EPI) { if (wr == 0) PG8_BAR; }
    PG8_BAR;
    if constexpr (Epi::AFTER_DRAIN) { E.fused(acc, cur, wr, wc, fr, fq, lds, wid, lane); S.done(cur); }
#undef PG8_SA
#undef PG8_SB
#undef PG8_STAGE
#undef PG8_LDA
#undef PG8_LDB
#undef PG8_MMA
#undef PG8_WAIT_V
#undef PG8_WAIT_L
#undef PG8_BAR
#undef PG8_SCHED
}
}

#define XB_TMO      128
#define XB_XCNT(j)  (256  + 64 * (j))
#define XB_XSUB(j)  (1280 + 64 * (j))
#define XB_XGEN(j)  (2304 + 64 * (j))
#define XB_TOP      3328
#define XB_TOPGEN   3392
#define XCD_BAR_WORDS 3456
#define XB_SPIN_CAP (1u << 18)

__device__ __forceinline__ unsigned xb_ld(unsigned* p)              { return __hip_atomic_load(p, __ATOMIC_RELAXED, __HIP_MEMORY_SCOPE_AGENT); }
__device__ __forceinline__ unsigned xb_add(unsigned* p, unsigned v) { return __hip_atomic_fetch_add(p, v, __ATOMIC_RELAXED, __HIP_MEMORY_SCOPE_AGENT); }
__device__ __forceinline__ unsigned xb_xcc_id() { return (unsigned)__builtin_amdgcn_s_getreg((3 << 11) | 20) & 0xFu; }
#define XB_SPIN(cond, bar) do { unsigned _sp = 0; while (cond) { __builtin_amdgcn_s_sleep(1); \
    if ((++_sp & 255u) == 0u) { if (xb_ld(&(bar)[XB_TMO])) break; if (_sp > XB_SPIN_CAP) { atomicAdd(&(bar)[XB_TMO], 1u); break; } } } } while (0)

struct XcdBarrier {
    unsigned* bar; unsigned x;
    volatile LAS unsigned* st;
};

__device__ __forceinline__ XcdBarrier xcd_barrier_post(unsigned* bar, volatile LAS unsigned* st) {
    XcdBarrier b; b.bar = bar; b.x = xb_xcc_id(); b.st = st;
    if (threadIdx.x == 0) st[2] = xb_add(&bar[XB_XCNT(b.x)], 1u);
    return b;
}
__device__ __forceinline__ void xcd_barrier_complete(unsigned* bar, unsigned x, unsigned& nloc, unsigned& nx) {
    const unsigned G = gridDim.x * gridDim.y * gridDim.z;
    unsigned sum, cnt, mine, sp = 0u;
    for (;;) {
        sum = 0u; cnt = 0u; mine = 0u;
#pragma unroll
        for (unsigned j = 0; j < 16; ++j) { const unsigned c = xb_ld(&bar[XB_XCNT(j)]); sum += c; cnt += (c > 0u) ? 1u : 0u; mine = (j == x) ? c : mine; }
        if (sum == G) break;
        __builtin_amdgcn_s_sleep(1);
        if ((++sp & 255u) == 0u) { if (xb_ld(&bar[XB_TMO])) break; if (sp > XB_SPIN_CAP) { atomicAdd(&bar[XB_TMO], 1u); break; } }
    }
    nloc = mine > 0u ? mine : 1u; nx = cnt > 0u ? cnt : 1u;
}

__device__ __forceinline__ void xcd_barrier(const XcdBarrier& b) {
    asm volatile("s_waitcnt vmcnt(0)" ::: "memory");
    __syncthreads();
    if (threadIdx.x == 0) {
        unsigned* bar = b.bar;
        __builtin_amdgcn_s_waitcnt(0);
        unsigned nloc = b.st[0], nx = b.st[1];
        if (nloc == 0u) { xcd_barrier_complete(bar, b.x, nloc, nx); b.st[0] = nloc; b.st[1] = nx; }
        const unsigned old = xb_add(&bar[XB_XSUB(b.x)], 1u);
        const unsigned gen = old / nloc;
        if (old + 1u == (gen + 1u) * nloc) {
            __builtin_amdgcn_fence(__ATOMIC_RELEASE, "agent");
            asm volatile("s_waitcnt vmcnt(0)" ::: "memory");
            const unsigned og = xb_add(&bar[XB_TOP], 1u);
            const unsigned tg = og / nx;
            if (og + 1u == (tg + 1u) * nx) xb_add(&bar[XB_TOPGEN], 1u);
            else XB_SPIN(xb_ld(&bar[XB_TOPGEN]) == tg, bar);
            __builtin_amdgcn_fence(__ATOMIC_ACQUIRE, "agent");
            xb_add(&bar[XB_XGEN(b.x)], 1u);
            asm volatile("s_waitcnt vmcnt(0)" ::: "memory");
        } else {
            XB_SPIN(xb_ld(&bar[XB_XGEN(b.x)]) == gen, bar);
            __builtin_amdgcn_fence(__ATOMIC_ACQUIRE, "agent");
            asm volatile("s_waitcnt vmcnt(0)" ::: "memory");
        }
    }
    __syncthreads();
}


struct Args { const float* in[16]; float* out; unsigned char* ws; int ph_lo, ph_hi; };
constexpr int N_PHASES = 11;

__global__ void __launch_bounds__(NTHREADS, 2) mk_fwd(Args a) {
    extern __shared__ __attribute__((aligned(16))) unsigned char lds[];
    LAS unsigned char* L = (LAS unsigned char*)lds;
    volatile LAS unsigned* MISC = (volatile LAS unsigned*)(L + MISC_OFF);
    unsigned char* ws = a.ws;
    Ctx C;
    C.tid = threadIdx.x; C.lane = C.tid & 63; C.wave = __builtin_amdgcn_readfirstlane(C.tid >> 6);
    C.G = gridDim.x; C.gw = blockIdx.x * NWAVES + C.wave; C.ngw = C.G * NWAVES; C.gt = blockIdx.x * NTHREADS + C.tid; C.ngt = C.G * NTHREADS;
    for (int u = C.tid; u < (LDS_BYTES - LDSCTL_OFF) / 4; u += NTHREADS) ((LAS unsigned*)(L + LDSCTL_OFF))[u] = 0u;
    __syncthreads();
    const int lo = a.ph_lo, hi = a.ph_hi, G = C.G;
    const bool multi = (hi - lo) > 1;
    XcdBarrier bar; bar.bar = (unsigned*)(ws + WS_CTL) + CW_BAR; bar.x = 0; bar.st = nullptr;
    if (multi) bar = xcd_barrier_post((unsigned*)(ws + WS_CTL) + CW_BAR, MISC + 8);
#define IN(k) (lo <= (k) && (k) < hi)
#define SEAM(k) do { if (IN(k) && IN((k) + 1)) xcd_barrier(bar); } while (0)

#define REPS(k) for (int rep_ = 0; rep_ < ((PROBE_DUP == (k)) ? 2 : 1); ++rep_)
#define REPBAR(k) do { if (PROBE_DUP == (k) && rep_ == 0) xcd_barrier(bar); } while (0)
    if (IN(0)) REPS(0) { ph_prep(C, L, a.in, ws); REPBAR(0); }
    SEAM(0);
    if (IN(1)) {
        quant_wrows(C, (const f16*)(ws + WS_WCAT), NCAT, (unsigned*)(ws + WS_WCATQ), (float*)(ws + WS_WCS));
        quant_wrows(C, (const f16*)(ws + WS_WQ), 2048, (unsigned*)(ws + WS_WQQ), (float*)(ws + WS_WQS));
        xcd_barrier(bar);
        pg8::Gemm g{(const f16*)(ws + WS_XH), (const f16*)(ws + WS_WCATQ), T, NCAT, DM / 2}; pg8::StaticOrder S; S.init(T, NCAT, G, (int)blockIdx.x);
        pg8::EpiP1 E{(const float*)(ws + WS_RS1), (const float*)(ws + WS_RSX), (const float*)(ws + WS_WCS), a.in[8], (f16*)(ws + WS_QKVU), (f16*)(ws + WS_GATES), (f16*)(ws + WS_VT)};
        pg8::gemm_phase<pg8::EpiP1, pg8::StaticOrder, true, true>(L, g, S, E);
    }
    SEAM(1);
    if (IN(2)) REPS(2) {
        ph_attn_pool(C, L, (const f16*)(ws + WS_QKVU), (const f16*)(ws + WS_VT), a.in[3], (const f16*)(ws + WS_POOLW), a.in[5], (f16*)(ws + WS_OCAT));
        REPBAR(2);
    }
    if (IN(2) && IN(4)) xcd_barrier(bar);
    if (IN(4)) REPS(4) {
        pg8::Gemm g{(const f16*)(ws + WS_OCAT), (const f16*)(ws + WS_WB), T, DM, DM}; pg8::StaticOrder S; S.init(T, DM, G, (int)blockIdx.x);
        pg8::EpiMerged E{(const f16*)(ws + WS_GATES), (f16*)(ws + WS_MERGED)};
        pg8::gemm_phase<pg8::EpiMerged, pg8::StaticOrder, true, true>(L, g, S, E);
        REPBAR(4);
    }
    SEAM(4);
    if (IN(5)) REPS(5) {
        pg8::Gemm g{(const f16*)(ws + WS_MERGED), (const f16*)(ws + WS_WOUT), T, DM, DM}; pg8::StaticOrder S; S.init(T, DM, G, (int)blockIdx.x);
        pg8::EpiOut E{a.in[0], a.in[10], a.out, (f16*)(ws + WS_X1H), (float*)(ws + WS_SS2)};
        pg8::gemm_phase<pg8::EpiOut, pg8::StaticOrder, true, true>(L, g, S, E);
        REPBAR(5);
    }
    SEAM(5);
    if (IN(6)) {
        ph_h2quant(C, (const f16*)(ws + WS_X1H), (const float*)(ws + WS_SS2), (unsigned*)(ws + WS_H2Q), (float*)(ws + WS_HSC));
        xcd_barrier(bar);
        pg8::Gemm g{(const f16*)(ws + WS_H2Q), (const f16*)(ws + WS_WQQ), T, 2048, DM / 2}; pg8::StaticOrder S; S.init(T, 2048, G, (int)blockIdx.x);
        pg8::EpiQ E{(const float*)(ws + WS_HSC), (const float*)(ws + WS_WQS), (f16*)(ws + WS_QP)};
        pg8::gemm_phase<pg8::EpiQ, pg8::StaticOrder, true, true>(L, g, S, E);
    }
    SEAM(6);
    if (IN(7)) REPS(7) {
        auto side = [&]() {
            quant_rows<false>(C, a.in[13], (unsigned*)(ws + WS_UQ), (float*)(ws + WS_US));
            quant_rows<false>(C, a.in[14], (unsigned*)(ws + WS_VQ), (float*)(ws + WS_VS));
        };
        ph_route(C, L, (const f16*)(ws + WS_QP), (const float*)(ws + WS_SS2), (const f16*)(ws + WS_SUBK), (int*)(ws + WS_EIDX), (float*)(ws + WS_EGATE), side);
        if (!(C.wave & 4)) side();
        REPBAR(7); }
    SEAM(7);
    if (IN(8)) REPS(8) {
        const Slicing SL = get_slicing((const unsigned*)(ws + WS_CTL) + CW_BAR, MISC);
        if (PROBE_DUP == 8 && rep_ == 0) ph_upeer<255>(C, L, SL, (const unsigned*)(ws + WS_H2Q), (const int*)(ws + WS_EIDX), (const unsigned char*)(ws + WS_UQ), (short*)(ws + WS_PDOT));
        else ph_upeer<16383>(C, L, SL, (const unsigned*)(ws + WS_H2Q), (const int*)(ws + WS_EIDX), (const unsigned char*)(ws + WS_UQ), (short*)(ws + WS_PDOT));
        REPBAR(8);
    }
    SEAM(8);
    if (IN(9)) {
        ph_ureduce(C, L, (const short*)(ws + WS_PDOT), (const float*)(ws + WS_HSC), (const int*)(ws + WS_EIDX), (const float*)(ws + WS_US), (const float*)(ws + WS_VS), (const float*)(ws + WS_EGATE),
                   (unsigned*)(ws + WS_WQP), (float*)(ws + WS_WSC));
        xcd_barrier(bar);
        const Slicing SL = get_slicing((const unsigned*)(ws + WS_CTL) + CW_BAR, MISC);
        ph_vpeer<16383>(C, SL, (const int*)(ws + WS_EIDX), (const unsigned*)(ws + WS_WQP), (const float*)(ws + WS_WSC), (const unsigned char*)(ws + WS_VQ), (f16*)(ws + WS_PEER));
    }
    SEAM(9);
    if (IN(10)) { ph_final(C, (const f16*)(ws + WS_PEER), a.out, a.in[15]); }
#undef IN
#undef SEAM
}

#ifndef MK_N_LAUNCHES
#define MK_N_LAUNCHES 1
#endif
extern "C" void kernel_launch(void* const* d_in, const int* in_sizes, int n_in, void* d_out, int out_size, void* d_ws, size_t ws_size, hipStream_t stream) {
    static int grid = 0;
    if (grid == 0) {
        if (n_in != 16 || in_sizes[0] != T * DM || out_size != T * DM || ws_size < WS_END) {
            fprintf(stderr, "kernel_launch: unexpected shapes (n_in %d in0 %d out %d ws %zu)\n", n_in, n_in > 0 ? in_sizes[0] : -1, out_size, ws_size);
            grid = -1; return;
        }
        int dev = 0, cus = 0;
        if (hipGetDevice(&dev) != hipSuccess || hipDeviceGetAttribute(&cus, hipDeviceAttributeMultiprocessorCount, dev) != hipSuccess) { grid = -1; return; }
        if (hipFuncSetAttribute((const void*)mk_fwd, hipFuncAttributeMaxDynamicSharedMemorySize, LDS_BYTES) != hipSuccess) { fprintf(stderr, "kernel_launch: hipFuncSetAttribute failed\n"); grid = -1; return; }
        int per_cu = 0;
        if (hipOccupancyMaxActiveBlocksPerMultiprocessor(&per_cu, (const void*)mk_fwd, NTHREADS, LDS_BYTES) != hipSuccess || per_cu < 1)
            fprintf(stderr, "kernel_launch: occupancy query reports %d workgroups per CU\n", per_cu);
        (void)hipGetLastError();
        grid = cus;
    }
    if (grid < 0) return;
    (void)hipMemsetAsync((char*)d_ws + WS_CTL, 0, CTL_ZERO_BYTES, stream);
    Args a{};
    for (int i = 0; i < 16; ++i) a.in[i] = (const float*)d_in[i];
    a.out = (float*)d_out; a.ws = (unsigned char*)d_ws;
    if (MK_N_LAUNCHES == 1) {
        a.ph_lo = 0; a.ph_hi = N_PHASES;
        hipLaunchKernelGGL(mk_fwd, dim3(grid), dim3(NTHREADS), LDS_BYTES, stream, a);
    } else {
        for (int p = 0; p < N_PHASES; ++p) { a.ph_lo = p; a.ph_hi = p + 1; hipLaunchKernelGGL(mk_fwd, dim3(grid), dim3(NTHREADS), LDS_BYTES, stream, a); }
    }
}
```

```cpp
#include <hip/hip_runtime.h>
#include <cstdint>
#include <cstdio>

typedef _Float16 f16;
typedef _Float16 half8 __attribute__((ext_vector_type(8)));
typedef _Float16 half4 __attribute__((ext_vector_type(4)));
typedef _Float16 half2 __attribute__((ext_vector_type(2)));
typedef float f32x4 __attribute__((ext_vector_type(4)));
typedef float f32x16 __attribute__((ext_vector_type(16)));
typedef unsigned u32x4 __attribute__((ext_vector_type(4)));
typedef int i32x4 __attribute__((ext_vector_type(4)));
#define LAS __attribute__((address_space(3)))
#ifndef PROBE_DIAG
#define PROBE_DIAG (0)
#endif
#ifndef PROBE_DUP
#define PROBE_DUP (-1)
#endif
#define GAS __attribute__((address_space(1)))

constexpr int DM = 1024, BATCH = 16, SEQ = 2048, T = BATCH * SEQ;
constexpr int NQKVU = 1280, NGATE = 2048, NCAT = NQKVU + NGATE;
constexpr int COL_K = 512, COL_V = 640, COL_U = 768;
constexpr int NEXP = 16384, PEER_H = 8, TOPK = 16;
constexpr float EPS = 1e-6f;
constexpr int NWAVES = 8, NTHREADS = NWAVES * 64;

constexpr size_t MiB = 1u << 20;
constexpr size_t WS_CTL = 0, CTL_ZERO_BYTES = 64 * 1024;
constexpr size_t WS_WCAT = 1 * MiB;
constexpr size_t WS_WB = 8 * MiB;
constexpr size_t WS_WOUT = 10 * MiB;
constexpr size_t WS_WQ = 12 * MiB;
constexpr size_t WS_POOLW = 16 * MiB;
constexpr size_t WS_SUBK = 16 * MiB + 512 * 1024;
constexpr size_t WS_RS1 = 17 * MiB;
constexpr size_t WS_EIDX = 18 * MiB;
constexpr size_t WS_EGATE = 34 * MiB;
constexpr size_t WS_WCATQ = 50 * MiB;
constexpr size_t WS_WCS = 54 * MiB;
constexpr size_t WS_WQQ = 56 * MiB;
constexpr size_t WS_WQS = 59 * MiB;
constexpr size_t WS_RSX = 55 * MiB;
constexpr size_t WS_UTAB = 50 * MiB;
constexpr size_t WS_VTAB = 82 * MiB;
constexpr size_t WS_XH = 114 * MiB;
constexpr size_t WS_MERGED = WS_XH;
constexpr size_t WS_QKVU = 178 * MiB;
constexpr size_t WS_X1H = WS_QKVU;
constexpr size_t WS_PEER = WS_QKVU;
constexpr size_t WS_GATES = 258 * MiB;
constexpr size_t WS_QP = WS_GATES;
constexpr size_t WS_OCAT = 386 * MiB;
constexpr size_t WS_UQ = 450 * MiB;
constexpr size_t WS_VQ = 466 * MiB;
constexpr size_t WS_US = 17 * MiB + 256 * 1024, WS_VS = 17 * MiB + 512 * 1024;
constexpr size_t WS_PDOT = WS_GATES;
constexpr size_t WS_H2Q = 404 * MiB;
constexpr size_t WS_HSC = 403 * MiB;
constexpr size_t WS_SSF = 402 * MiB;
constexpr size_t WS_WQP = 386 * MiB;
constexpr size_t WS_WSC = 390 * MiB;
constexpr size_t WS_ACT = 386 * MiB;
constexpr size_t WS_SS2 = 482 * MiB;
constexpr size_t WS_VT = 484 * MiB;
constexpr size_t WS_END = 492 * MiB;
constexpr int CW_BAR = 4096;

constexpr int RING_OFF = 0, RING_BYTES = 131072;
constexpr int LDSCTL_OFF = RING_BYTES, MISC_OFF = LDSCTL_OFF + 320;
constexpr int LDS_BYTES = 147456;

#define LDS_WAIT() asm volatile("s_waitcnt lgkmcnt(0)" ::: "memory")
template <int CTRL> __device__ __forceinline__ float dppf(float x) { return __uint_as_float(__builtin_amdgcn_update_dpp(0u, __float_as_uint(x), CTRL, 0xf, 0xf, false)); }
template <int CTRL> __device__ __forceinline__ int dppi(int x) { return (int)__builtin_amdgcn_update_dpp(0u, (unsigned)x, CTRL, 0xf, 0xf, false); }
__device__ __forceinline__ float bfly32(float a, float b) { auto r = __builtin_amdgcn_permlane32_swap(__float_as_uint(a), __float_as_uint(b), false, false); return __uint_as_float(r[0]) + __uint_as_float(r[1]); }
__device__ __forceinline__ float bfly16(float a, float b) { auto r = __builtin_amdgcn_permlane16_swap(__float_as_uint(a), __float_as_uint(b), false, false); return __uint_as_float(r[0]) + __uint_as_float(r[1]); }
__device__ __forceinline__ int bfly32i(int a, int b) { auto r = __builtin_amdgcn_permlane32_swap((unsigned)a, (unsigned)b, false, false); return (int)(r[0] + r[1]); }
__device__ __forceinline__ int bfly16i(int a, int b) { auto r = __builtin_amdgcn_permlane16_swap((unsigned)a, (unsigned)b, false, false); return (int)(r[0] + r[1]); }
__device__ __forceinline__ float wave_sum(float x) {
    x += dppf<0x121>(x); x += dppf<0x122>(x); x += dppf<0x124>(x); x += dppf<0x128>(x);
    x = bfly16(x, x); return bfly32(x, x);
}
__device__ __forceinline__ int wave_sum_i(int x) {
    x += dppi<0x121>(x); x += dppi<0x122>(x); x += dppi<0x124>(x); x += dppi<0x128>(x);
    x = bfly16i(x, x); return bfly32i(x, x);
}
__device__ __forceinline__ float wave_max(float x) {
    x = fmaxf(x, dppf<0x121>(x)); x = fmaxf(x, dppf<0x122>(x)); x = fmaxf(x, dppf<0x124>(x)); x = fmaxf(x, dppf<0x128>(x));
    { auto r = __builtin_amdgcn_permlane16_swap(__float_as_uint(x), __float_as_uint(x), false, false); x = fmaxf(__uint_as_float(r[0]), __uint_as_float(r[1])); }
    { auto r = __builtin_amdgcn_permlane32_swap(__float_as_uint(x), __float_as_uint(x), false, false); x = fmaxf(__uint_as_float(r[0]), __uint_as_float(r[1])); }
    return x;
}
__device__ __forceinline__ float gelu_exact(float x) { return 0.5f * x * (1.0f + erff(x * 0.70710678118654752f)); }
__device__ __forceinline__ float rs_from_ss(const float* ss, int t) {
    float s = 0.f;
#pragma unroll
    for (int i = 0; i < 16; ++i) s += ss[(size_t)i * T + t];
    return rsqrtf(s * (1.0f / DM) + EPS);
}

struct Ctx {
    int tid, lane, wave;
    int G;
    int gw, ngw;
    int gt, ngt;
};

__device__ __forceinline__ int pack4_i8(float a, float b, float c, float d) {
    const int ia = (int)rintf(a), ib = (int)rintf(b), ic = (int)rintf(c), id = (int)rintf(d);
    return (ia & 0xff) | ((ib & 0xff) << 8) | ((ic & 0xff) << 16) | (id << 24);
}
template <bool OFFS>
__device__ __forceinline__ void quant_rows(const Ctx& C, const float* __restrict__ tab, unsigned* __restrict__ q, float* __restrict__ scale) {
    const int lane = C.lane;
    for (int r = C.gw; r < NEXP; r += C.ngw) {
        const float* row = tab + (size_t)r * DM;
        f32x4 v[4]; float m = 0.f;
#pragma unroll
        for (int j = 0; j < 4; ++j) { v[j] = *(const f32x4*)(row + j * 256 + lane * 4); m = fmaxf(m, fmaxf(fmaxf(fabsf(v[j][0]), fabsf(v[j][1])), fmaxf(fabsf(v[j][2]), fabsf(v[j][3])))); }
        m = wave_max(m);
        const float inv = m > 0.f ? 127.0f / m : 0.f;
#pragma unroll
        for (int j = 0; j < 4; ++j) {
            unsigned w = (unsigned)pack4_i8(v[j][0] * inv, v[j][1] * inv, v[j][2] * inv, v[j][3] * inv);
            if (OFFS) w ^= 0x80808080u;
            { const int dw = j * 64 + lane; q[(size_t)(dw >> 5) * (NEXP * 32) + (size_t)r * 32 + (dw & 31)] = w; }
        }
        if (lane == 0) scale[r] = m * (1.0f / 127.0f);
    }
}

__device__ __forceinline__ void p0_transpose_item(const float* W, int K, int N, f16* WT, int ldo, int koff, LAS float* scr, int item, int lane) {
    const int nblk = N / 32, kb = item / nblk, nb = item % nblk, k0 = 64 * kb, n0 = 32 * nb;
#pragma unroll 8
    for (int i = 0; i < 32; ++i) { const int kk = 2 * i + (lane >> 5); scr[kk * 33 + (lane & 31)] = W[(size_t)(k0 + kk) * N + n0 + (lane & 31)]; }
    LDS_WAIT(); asm volatile("" ::: "memory");
    const int c = lane & 7;
#pragma unroll
    for (int j = 0; j < 4; ++j) { const int n = (lane >> 3) + 8 * j; const LAS float* s = scr + (8 * c) * 33 + n;
        half8 o;
#pragma unroll
        for (int i = 0; i < 8; ++i) o[i] = (f16)s[i * 33];
        *(half8*)(WT + (size_t)(n0 + n) * ldo + koff + k0 + 8 * c) = o; }
    LDS_WAIT(); asm volatile("" ::: "memory");
}
__device__ __forceinline__ void cvt_stream(const Ctx& C, const float* in, f16* out, size_t n4) {
    for (size_t i = (size_t)C.gt; i < n4; i += (size_t)C.ngt) {
        const f32x4 v = ((const f32x4*)in)[i];
        half4 h; h[0] = (f16)v[0]; h[1] = (f16)v[1]; h[2] = (f16)v[2]; h[3] = (f16)v[3];
        ((half4*)out)[i] = h;
    }
}
__device__ __forceinline__ void rowprep(const Ctx& C, const float* x, const float* g, unsigned* xq, float* rsx, float* ss) {
    const int lane = C.lane;
    f32x4 gg[4];
#pragma unroll
    for (int j = 0; j < 4; ++j) gg[j] = *(const f32x4*)(g + j * 256 + lane * 4);
    for (int tb = C.gw * 4; tb < T; tb += C.ngw * 4) {
        f32x4 v[4][4];
#pragma unroll
        for (int u = 0; u < 4; ++u)
#pragma unroll
            for (int j = 0; j < 4; ++j) v[u][j] = *(const f32x4*)(x + (size_t)(tb + u) * DM + j * 256 + lane * 4);
#pragma unroll
        for (int u = 0; u < 4; ++u) {
            float s = 0.f, am = 0.f;
#pragma unroll
            for (int j = 0; j < 4; ++j) {
                const f32x4 w = v[u][j];
                s += w[0] * w[0] + w[1] * w[1] + w[2] * w[2] + w[3] * w[3];
                v[u][j] = w * gg[j];
                am = fmaxf(am, fmaxf(fmaxf(fabsf(v[u][j][0]), fabsf(v[u][j][1])), fmaxf(fabsf(v[u][j][2]), fabsf(v[u][j][3]))));
            }
            s = wave_sum(s); am = wave_max(am);
            const float inv = am > 0.f ? 127.0f / am : 0.f;
#pragma unroll
            for (int j = 0; j < 4; ++j) xq[(size_t)(tb + u) * 256 + j * 64 + lane] = (unsigned)pack4_i8(v[u][j][0] * inv, v[u][j][1] * inv, v[u][j][2] * inv, v[u][j][3] * inv);
            if (lane == 0) { ss[tb + u] = s; rsx[tb + u] = am * (1.0f / 127.0f); }
        }
    }
}
__device__ __forceinline__ void quant_wrows(const Ctx& C, const f16* __restrict__ w, int rows, unsigned* __restrict__ q, float* __restrict__ scale) {
    const int lane = C.lane;
    for (int r = C.gw; r < rows; r += C.ngw) {
        const half8 a = *(const half8*)(w + (size_t)r * DM + 16 * lane), b = *(const half8*)(w + (size_t)r * DM + 16 * lane + 8);
        float m = 0.f;
#pragma unroll
        for (int i = 0; i < 8; ++i) m = fmaxf(m, fmaxf(fabsf((float)a[i]), fabsf((float)b[i])));
        m = wave_max(m);
        const float inv = m > 0.f ? 127.0f / m : 0.f;
        u32x4 o;
        o[0] = (unsigned)pack4_i8((float)a[0] * inv, (float)a[1] * inv, (float)a[2] * inv, (float)a[3] * inv);
        o[1] = (unsigned)pack4_i8((float)a[4] * inv, (float)a[5] * inv, (float)a[6] * inv, (float)a[7] * inv);
        o[2] = (unsigned)pack4_i8((float)b[0] * inv, (float)b[1] * inv, (float)b[2] * inv, (float)b[3] * inv);
        o[3] = (unsigned)pack4_i8((float)b[4] * inv, (float)b[5] * inv, (float)b[6] * inv, (float)b[7] * inv);
        *(u32x4*)(q + (size_t)r * 256 + 4 * lane) = o;
        if (lane == 0) scale[r] = m * (1.0f / 127.0f);
    }
}
__device__ __forceinline__ void ph_prep(const Ctx& C, LAS unsigned char* lds, const float* const* in, unsigned char* ws) {
    LAS float* scr = (LAS float*)(lds + RING_OFF + C.wave * 16384);
    f16* wcat = (f16*)(ws + WS_WCAT); f16* wb = (f16*)(ws + WS_WB); f16* wout = (f16*)(ws + WS_WOUT); f16* wq = (f16*)(ws + WS_WQ); f16* poolw = (f16*)(ws + WS_POOLW);
    constexpr int I_IN = 16 * 40, I_G = 16 * 64, I_B = 8 * 32, I_O = 16 * 32, I_Q = 16 * 64, I_P = 2 * 4;
    constexpr int NITEMS = I_IN + I_G + 2 * I_B + I_O + I_Q + 4 * I_P;
    for (int it = C.gw; it < NITEMS; it += C.ngw) {
        int r = it;
        if (r < I_IN) { p0_transpose_item(in[2], 1024, 1280, wcat, 1024, 0, scr, r, C.lane); continue; } r -= I_IN;
        if (r < I_G) { p0_transpose_item(in[7], 1024, 2048, wcat + (size_t)NQKVU * 1024, 1024, 0, scr, r, C.lane); continue; } r -= I_G;
        if (r < I_B) { p0_transpose_item(in[6], 512, 1024, wb, 1024, 0, scr, r, C.lane); continue; } r -= I_B;
        if (r < I_B) { p0_transpose_item(in[6] + 512 * 1024, 512, 1024, wb, 1024, 512, scr, r, C.lane); continue; } r -= I_B;
        if (r < I_O) { p0_transpose_item(in[9], 1024, 1024, wout, 1024, 0, scr, r, C.lane); continue; } r -= I_O;
        if (r < I_Q) { p0_transpose_item(in[11], 1024, 2048, wq, 1024, 0, scr, r, C.lane); continue; } r -= I_Q;
        { const int g = r / I_P; p0_transpose_item(in[4] + g * 128 * 128, 128, 128, poolw + g * 128 * 128, 128, 0, scr, r % I_P, C.lane); }
    }
    cvt_stream(C, in[12], (f16*)(ws + WS_SUBK), (size_t)8 * 2 * 128 * 128 / 4);
    rowprep(C, in[0], in[1], (unsigned*)(ws + WS_XH), (float*)(ws + WS_RSX), (float*)(ws + WS_RS1));
}

__device__ __forceinline__ void ph_attn_naive(const Ctx& C, const f16* __restrict__ qkvu, const float* __restrict__ sink, f16* __restrict__ ocat) {
    for (int gid = C.gt; gid < T * 8; gid += C.ngt) {
        const int t = gid % T, h = gid / T;
        const int b = t / SEQ, ts = t % SEQ, kh = h >> 2;
        float q[64], o[64];
        const f16* qr = qkvu + (size_t)t * NQKVU + h * 64;
#pragma unroll
        for (int d = 0; d < 64; ++d) { q[d] = (float)qr[d]; o[d] = 0.f; }
        const float slope = exp2f(-(float)(h + 1));
        float m = -1e30f, l = 0.f;
        const int s0 = max(ts - 128, 0), s1 = min(ts + 128, SEQ - 1);
        for (int s = s0; s <= s1; ++s) {
            const f16* kr = qkvu + (size_t)(b * SEQ + s) * NQKVU + COL_K + kh * 64;
            const f16* vr = qkvu + (size_t)(b * SEQ + s) * NQKVU + COL_V + kh * 64;
            float dot = 0.f;
#pragma unroll
            for (int d = 0; d < 64; ++d) dot += q[d] * (float)kr[d];
            const float lg = dot * 0.125f - slope * fabsf((float)(ts - s));
            const float mn = fmaxf(m, lg), al = __expf(m - mn), p = __expf(lg - mn);
            l = l * al + p;
#pragma unroll
            for (int d = 0; d < 64; ++d) o[d] = o[d] * al + p * (float)vr[d];
            m = mn;
        }
        const float sk = sink[h];
        const float mn = fmaxf(m, sk), al = __expf(m - mn);
        l = l * al + __expf(sk - mn);
        const float inv = al / l;
        f16* orow = ocat + (size_t)t * DM + h * 64;
#pragma unroll
        for (int d = 0; d < 64; ++d) orow[d] = (f16)(o[d] * inv);
    }
}

template <int DIAG = 0>
__device__ __forceinline__ void attn_unit(const Ctx& C, int u, LAS unsigned char* lds, const f16* __restrict__ qkvu, const f16* __restrict__ vT, const float* __restrict__ sink, f16* __restrict__ ocat) {
    const int lane = C.lane, r32 = lane & 31, hh = lane >> 5;
    const int krow = (r32 & 19) | ((r32 & 4) << 1) | ((r32 & 8) >> 1);
    constexpr float L2E = 1.4426950408889634f;
    {
        const int qs = u & 63, h = (u >> 6) & 7, b = u >> 9, kh = h >> 2;
        const int tq = qs * 32 + r32;
        const float slope2 = exp2f(-(float)(h + 1)) * L2E, sink2 = sink[h] * L2E;
        const f16* qrow = qkvu + (size_t)(b * SEQ + tq) * NQKVU + h * 64 + 8 * hh;
        half8 bq[4];
#pragma unroll
        for (int ks = 0; ks < 4; ++ks) bq[ks] = *(const half8*)(qrow + 16 * ks);
        f32x16 o0, o1;
#pragma unroll
        for (int r = 0; r < 16; ++r) { o0[r] = 0.f; o1[r] = 0.f; }
        float m = -1e30f, l = 0.f;
        const int kb_lo = max(qs - 4, 0), kb_hi = min(qs + 4, 63);
        LAS unsigned char* kst = lds + 65536 + C.wave * 8192; LAS unsigned char* vst = kst + 4096;
        const int krw = lane >> 3, kch = lane & 7, vrw = lane >> 2, vch = lane & 3;
        const f16* kg = qkvu + (size_t)(b * SEQ + krw) * NQKVU + COL_K + kh * 64 + kch * 8;
        const f16* vg = vT + (size_t)((b * 2 + kh) * 64 + vrw) * SEQ + vch * 8;
        half8 gk[4], gv[4];
#pragma unroll
        for (int i = 0; i < 4; ++i) { gk[i] = *(const half8*)(kg + (size_t)(kb_lo * 32 + 8 * i) * NQKVU); gv[i] = *(const half8*)(vg + (size_t)(16 * i) * SEQ + kb_lo * 32); }
#pragma unroll 1
        for (int kb = kb_lo; kb <= kb_hi; ++kb) {
#pragma unroll
            for (int i = 0; i < 4; ++i) {
                const int kr = krw + 8 * i; *(LAS half8*)(kst + kr * 128 + ((kch ^ (kr & 7)) << 4)) = gk[i];
                const int vr = vrw + 16 * i; *(LAS half8*)(vst + vr * 64 + ((vch ^ ((vr >> 2) & 3)) << 4)) = gv[i];
            }
            LDS_WAIT();
            half8 kf[4], va[2][2];
#pragma unroll
            for (int ks = 0; ks < 4; ++ks) kf[ks] = *(const LAS half8*)(kst + krow * 128 + (((2 * ks + hh) ^ (krow & 7)) << 4));
#pragma unroll
            for (int db = 0; db < 2; ++db)
#pragma unroll
                for (int st = 0; st < 2; ++st) { const int d = db * 32 + r32; va[db][st] = *(const LAS half8*)(vst + d * 64 + (((2 * st + hh) ^ ((d >> 2) & 3)) << 4)); }
            LDS_WAIT();
            const int kn = (DIAG == 2) ? kb_lo : (kb < kb_hi ? kb + 1 : kb);
#pragma unroll
            for (int i = 0; i < 4; ++i) { gk[i] = *(const half8*)(kg + (size_t)(kn * 32 + 8 * i) * NQKVU); gv[i] = *(const half8*)(vg + (size_t)(16 * i) * SEQ + kn * 32); }
            f32x16 s;
#pragma unroll
            for (int r = 0; r < 16; ++r) s[r] = 0.f;
#pragma unroll
            for (int ks = 0; ks < 4; ++ks) s = __builtin_amdgcn_mfma_f32_32x32x16_f16(kf[ks], bq[ks], s, 0, 0, 0);
            float bmax = -1e30f; bool ok[16];
#pragma unroll
            for (int r = 0; r < 16; ++r) {
                const int tk = kb * 32 + 16 * (r >> 3) + 8 * hh + (r & 7);
                const int dist = abs(tq - tk);
                ok[r] = dist <= 128;
                s[r] = ok[r] ? s[r] * (0.125f * L2E) - slope2 * (float)dist : -1e30f;
                bmax = fmaxf(bmax, s[r]);
            }
            bmax = fmaxf(bmax, __shfl_xor(bmax, 32));
            const float mn = fmaxf(m, bmax), al = exp2f(m - mn);
            m = mn;
            float ps = 0.f; half8 pb[2];
#pragma unroll
            for (int r = 0; r < 16; ++r) { const float p = ok[r] ? (DIAG == 1 ? (s[r] - mn) : exp2f(s[r] - mn)) : 0.f; ps += p; pb[r >> 3][r & 7] = (f16)p; }
            l = l * al + ps;
#pragma unroll
            for (int r = 0; r < 16; ++r) { o0[r] *= al; o1[r] *= al; }
#pragma unroll
            for (int st = 0; st < 2; ++st) { o0 = __builtin_amdgcn_mfma_f32_32x32x16_f16(va[0][st], pb[st], o0, 0, 0, 0); o1 = __builtin_amdgcn_mfma_f32_32x32x16_f16(va[1][st], pb[st], o1, 0, 0, 0); }
        }
        l += __shfl_xor(l, 32);
        const float mf = fmaxf(m, sink2), al = exp2f(m - mf);
        const float sc = al / (l * al + exp2f(sink2 - mf));
        f16* orow = ocat + (size_t)(b * SEQ + tq) * DM + h * 64 + 4 * hh;
#pragma unroll
        for (int g = 0; g < 4; ++g) {
            half4 a, c;
#pragma unroll
            for (int i = 0; i < 4; ++i) { a[i] = (f16)(o0[4 * g + i] * sc); c[i] = (f16)(o1[4 * g + i] * sc); }
            *(half4*)(orow + 8 * g) = a; *(half4*)(orow + 32 + 8 * g) = c;
        }
    }
}

__device__ __forceinline__ void attn_unit2(const Ctx& C, int u, LAS unsigned char* lds, const f16* __restrict__ qkvu, const f16* __restrict__ vT, const float* __restrict__ sink, f16* __restrict__ ocat) {
    int lane = C.lane; asm volatile("" : "+v"(lane));
    const int r32 = lane & 31, hh = lane >> 5;
    const int krow = (r32 & 19) | ((r32 & 4) << 1) | ((r32 & 8) >> 1);
    constexpr float L2E = 1.4426950408889634f;
    const int qp = u & 31, h = (u >> 5) & 7, b = u >> 8, kh = h >> 2;
    const float slope2 = exp2f(-(float)(h + 1)) * L2E, sink2 = sink[h] * L2E;
    const float bbase = slope2 * (float)(r32 - 8 * hh);
    constexpr float THR = 6.0f;
    LAS unsigned char* qst = lds + 65536 + C.wave * 8192 + lane * 16;
    f32x16 o0[2], o1[2]; float m[2], l[2]; int tq[2];
#pragma unroll
    for (int j = 0; j < 2; ++j) {
        tq[j] = (2 * qp + j) * 32 + r32;
        const f16* qrow = qkvu + (size_t)(b * SEQ + tq[j]) * NQKVU + h * 64 + 8 * hh;
#pragma unroll
        for (int ks = 0; ks < 4; ++ks) *(LAS half8*)(qst + (j * 4 + ks) * 1024) = *(const half8*)(qrow + 16 * ks);
#pragma unroll
        for (int r = 0; r < 16; ++r) { o0[j][r] = 0.f; o1[j][r] = 0.f; }
        m[j] = -1e30f; l[j] = 0.f;
    }
    const int kb_lo = max(2 * qp - 4, 0), kb_hi = min(2 * qp + 5, 63);
    LAS unsigned char* kst = lds + C.wave * 8192;
    const int krw = lane >> 3, kch = lane & 7;
    const f16* kg = qkvu + (size_t)(b * SEQ + krw) * NQKVU + COL_K + kh * 64 + kch * 8;
    const f16* vbase = vT + (size_t)((b * 2 + kh) * 64 + r32) * SEQ + 8 * hh;
    half8 gk[4];
#pragma unroll
    for (int i = 0; i < 4; ++i) gk[i] = *(const half8*)(kg + (size_t)(kb_lo * 32 + 8 * i) * NQKVU);
#pragma unroll 1
    for (int kb = kb_lo; kb <= kb_hi; ++kb) {
        half8 kf[4], va[2][2];
#pragma unroll
        for (int db = 0; db < 2; ++db)
#pragma unroll
            for (int st = 0; st < 2; ++st) va[db][st] = *(const half8*)(vbase + (size_t)(db * 32) * SEQ + kb * 32 + 16 * st);
#pragma unroll
        for (int i = 0; i < 4; ++i) { const int kr = krw + 8 * i; *(LAS half8*)(kst + kr * 128 + ((kch ^ (kr & 7)) << 4)) = gk[i]; }
        LDS_WAIT();
#pragma unroll
        for (int ks = 0; ks < 4; ++ks) kf[ks] = *(const LAS half8*)(kst + krow * 128 + (((2 * ks + hh) ^ (krow & 7)) << 4));
        LDS_WAIT();
        const int kn = kb < kb_hi ? kb + 1 : kb;
#pragma unroll
        for (int i = 0; i < 4; ++i) gk[i] = *(const half8*)(kg + (size_t)(kn * 32 + 8 * i) * NQKVU);
#pragma unroll
        for (int j = 0; j < 2; ++j) {
            if (abs(kb - (2 * qp + j)) > 4) continue;
            const int D = (2 * qp + j) - kb;
            f32x16 s;
#pragma unroll
            for (int r = 0; r < 16; ++r) s[r] = 0.f;
#pragma unroll
            for (int ks = 0; ks < 4; ++ks) s = __builtin_amdgcn_mfma_f32_32x32x16_f16(kf[ks], *(const volatile LAS half8*)(qst + (j * 4 + ks) * 1024), s, 0, 0, 0);
            const float B = slope2 * 32.0f * (float)abs(D);
            float bm = -1e30f;
            if (D != 0) {
                const float ssl = D > 0 ? slope2 : -slope2, sb = D > 0 ? -bbase : bbase;
#pragma unroll
                for (int r = 0; r < 16; ++r) { const float bias = fmaf(ssl, (float)(16 * (r >> 3) + (r & 7)), sb); s[r] = fmaf(s[r], 0.125f * L2E, bias);
                    if (abs(D) == 4) s[r] = bias < -0.5f * slope2 ? -1e30f : s[r]; }
            } else {
#pragma unroll
                for (int r = 0; r < 16; ++r) s[r] = fmaf(s[r], 0.125f * L2E, -fabsf(fmaf(-slope2, (float)(16 * (r >> 3) + (r & 7)), bbase)));
            }
#pragma unroll
            for (int r = 0; r < 16; ++r) bm = fmaxf(bm, s[r]);
            bm = fmaxf(bm, __shfl_xor(bm, 32)) - B;
            {
                const float mn = (bm > m[j] + THR) ? bm : m[j], al = __builtin_amdgcn_exp2f(m[j] - mn);
                m[j] = mn; l[j] *= al;
#pragma unroll
                for (int r = 0; r < 16; ++r) { o0[j][r] *= al; o1[j][r] *= al; }
            }
            const float mb = m[j] + B;
            float ps = 0.f; half8 pb[2];
#pragma unroll
            for (int r = 0; r < 16; ++r) { const float pv = __builtin_amdgcn_exp2f(s[r] - mb); ps += pv; pb[r >> 3][r & 7] = (f16)pv; }
            l[j] += ps;
#pragma unroll
            for (int st = 0; st < 2; ++st) { o0[j] = __builtin_amdgcn_mfma_f32_32x32x16_f16(va[0][st], pb[st], o0[j], 0, 0, 0); o1[j] = __builtin_amdgcn_mfma_f32_32x32x16_f16(va[1][st], pb[st], o1[j], 0, 0, 0); }
            __builtin_amdgcn_sched_barrier(0);
        }
    }
#pragma unroll
    for (int j = 0; j < 2; ++j) {
        const float lt = l[j] + __shfl_xor(l[j], 32);
        const float mf = fmaxf(m[j], sink2), al = __builtin_amdgcn_exp2f(m[j] - mf);
        const float sc = al / (lt * al + __builtin_amdgcn_exp2f(sink2 - mf));
        LDS_WAIT();
#pragma unroll
        for (int g = 0; g < 4; ++g) {
            half4 a, c;
#pragma unroll
            for (int i = 0; i < 4; ++i) { a[i] = (f16)(o0[j][4 * g + i] * sc); c[i] = (f16)(o1[j][4 * g + i] * sc); }
            *(LAS half4*)(kst + r32 * 128 + ((g ^ (r32 & 7)) << 4) + 8 * hh) = a;
            *(LAS half4*)(kst + r32 * 128 + (((4 + g) ^ (r32 & 7)) << 4) + 8 * hh) = c;
        }
        LDS_WAIT();
#pragma unroll
        for (int i = 0; i < 4; ++i) {
            const int row = (lane >> 3) + 8 * i, ch = lane & 7;
            const half8 v = *(const LAS half8*)(kst + row * 128 + ((ch ^ (row & 7)) << 4));
            *(half8*)(ocat + (size_t)(b * SEQ + (2 * qp + j) * 32 + row) * DM + h * 64 + ch * 8) = v;
        }
    }
}

__device__ __forceinline__ void ph_pool_naive(const Ctx& C, const f16* __restrict__ qkvu, f16* __restrict__ mixed) {
    for (size_t gid = (size_t)C.gt; gid < (size_t)T * 512; gid += (size_t)C.ngt) {
        const int c = (int)(gid & 511), t = (int)(gid >> 9);
        const int b = t / SEQ, ts = t % SEQ, g = c >> 7, w = 2 << g;
        const int lo = max(ts - w / 2, 0), hi = min(ts + w / 2, SEQ);
        float s = 0.f;
        for (int i = lo; i < hi; ++i) s += (float)qkvu[(size_t)(b * SEQ + i) * NQKVU + COL_U + c];
        const float mean = s / (float)(hi - lo);
        mixed[(size_t)t * 512 + c] = (f16)(mean - (float)qkvu[(size_t)t * NQKVU + COL_U + c]);
    }
}
__device__ __forceinline__ void ph_poolmm_naive(const Ctx& C, const f16* __restrict__ mixed, const f16* __restrict__ poolw_t, const float* __restrict__ pscale, f16* __restrict__ ocat) {
    for (size_t gid = (size_t)C.gt; gid < (size_t)T * 512; gid += (size_t)C.ngt) {
        const int n = (int)(gid & 511), t = (int)(gid >> 9), g = n >> 7, d = n & 127;
        const f16* mr = mixed + (size_t)t * 512 + g * 128;
        const f16* wr = poolw_t + (size_t)(g * 128 + d) * 128;
        float acc = 0.f;
        for (int c = 0; c < 128; ++c) acc += (float)mr[c] * (float)wr[c];
        ocat[(size_t)t * DM + 512 + n] = (f16)(acc * pscale[n]);
    }
}

template <int HW>
__device__ __forceinline__ void pool_step1(const f16* __restrict__ qkvu, LAS unsigned char* tile, int t0, int g, int lane) {
    const int c2 = lane, b = t0 >> 11, sf = t0 & (SEQ - 1);
    const f16* ub = qkvu + (size_t)(b * SEQ) * NQKVU + COL_U + g * 128 + 2 * c2;
    constexpr int NR = 32 + 2 * HW - 1;
    half2 v[NR];
#pragma unroll
    for (int i = 0; i < NR; ++i) { const int s = sf - HW + i; half2 z; z[0] = (f16)0.f; z[1] = (f16)0.f; v[i] = z; if (s >= 0 && s < SEQ) v[i] = *(const half2*)(ub + (size_t)s * NQKVU); }
    float s0 = 0.f, s1 = 0.f;
#pragma unroll
    for (int i = 0; i < 2 * HW - 1; ++i) { s0 += (float)v[i][0]; s1 += (float)v[i][1]; }
#pragma unroll
    for (int j = 0; j < 32; ++j) {
        s0 += (float)v[j + 2 * HW - 1][0]; s1 += (float)v[j + 2 * HW - 1][1];
        const int s = sf + j, lo = max(s - HW, 0), hi = min(s + HW, SEQ);
        const float inv = 1.0f / (float)(hi - lo);
        half2 mx; mx[0] = (f16)(s0 * inv - (float)v[j + HW][0]); mx[1] = (f16)(s1 * inv - (float)v[j + HW][1]);
        *(LAS half2*)(tile + j * 256 + (((c2 >> 2) ^ (j & 15)) << 4) + ((c2 & 3) << 2)) = mx;
        s0 -= (float)v[j][0]; s1 -= (float)v[j][1];
    }
}
__device__ __forceinline__ void pool_unit(const Ctx& C, int u, LAS unsigned char* lds, const f16* __restrict__ qkvu, const f16* __restrict__ poolw_t, const float* __restrict__ pscale, f16* __restrict__ ocat) {
    int lane = C.lane; asm volatile("" : "+v"(lane));
    const int r32 = lane & 31, hh = lane >> 5;
    LAS unsigned char* tile = lds + C.wave * 8192;
    const int g = u & 3, t0 = (u >> 2) * 32;
    switch (g) { case 0: pool_step1<1>(qkvu, tile, t0, g, lane); break; case 1: pool_step1<2>(qkvu, tile, t0, g, lane); break;
                 case 2: pool_step1<4>(qkvu, tile, t0, g, lane); break; default: pool_step1<8>(qkvu, tile, t0, g, lane); break; }
    LDS_WAIT();
    f32x16 acc[4];
#pragma unroll
    for (int db = 0; db < 4; ++db)
#pragma unroll
        for (int r = 0; r < 16; ++r) acc[db][r] = 0.f;
    const f16* wr = poolw_t + (size_t)(g * 128 + r32) * 128 + 8 * hh;
#pragma unroll
    for (int ks = 0; ks < 8; ++ks) {
        const half8 bm = *(const LAS half8*)(tile + r32 * 256 + (((2 * ks + hh) ^ (r32 & 15)) << 4));
#pragma unroll
        for (int db = 0; db < 4; ++db) { const half8 a = *(const half8*)(wr + (size_t)(db * 32) * 128 + 16 * ks); acc[db] = __builtin_amdgcn_mfma_f32_32x32x16_f16(a, bm, acc[db], 0, 0, 0); }
    }
    LDS_WAIT();
    const float* ps = pscale + g * 128 + 4 * hh;
#pragma unroll
    for (int db = 0; db < 4; ++db)
#pragma unroll
        for (int q = 0; q < 4; ++q) {
            const f32x4 pv = *(const f32x4*)(ps + db * 32 + 8 * q);
            half4 x0;
#pragma unroll
            for (int i = 0; i < 4; ++i) x0[i] = (f16)(acc[db][4 * q + i] * pv[i]);
            *(LAS half4*)(tile + r32 * 256 + (((db * 4 + q) ^ (r32 & 15)) << 4) + 8 * hh) = x0;
        }
    LDS_WAIT();
#pragma unroll
    for (int i = 0; i < 8; ++i) {
        const int row = (lane >> 4) + 4 * i, ch = lane & 15;
        const half8 v = *(const LAS half8*)(tile + row * 256 + ((ch ^ (row & 15)) << 4));
        *(half8*)(ocat + (size_t)(t0 + row) * DM + 512 + g * 128 + ch * 8) = v;
    }
    LDS_WAIT();
}
__device__ __forceinline__ void ph_attn_pool(const Ctx& C, LAS unsigned char* lds, const f16* __restrict__ qkvu, const f16* __restrict__ vT, const float* __restrict__ sink,
                                             const f16* __restrict__ poolw_t, const float* __restrict__ pscale, f16* __restrict__ ocat) {
    const int vwg = (C.G % 8 == 0) ? (int)(blockIdx.x % 8) * (C.G / 8) + (int)(blockIdx.x / 8) : (int)blockIdx.x;
    const bool pool_first = (C.wave & 4) != 0;
    for (int i = 0, m = vwg * NWAVES + C.wave; m < (T / 32) * 4; ++i) {
        if (((i & 1) == 0) == pool_first) pool_unit(C, m, lds, qkvu, poolw_t, pscale, ocat);
        else attn_unit2(C, m, lds, qkvu, vT, sink, ocat);
        if (i & 1) m += C.ngw;
    }
}

#define INS(LV, LI, v_, i_) do { float cv_ = (v_); int ci_ = (i_); \
    _Pragma("unroll") for (int z_ = 0; z_ < 16; ++z_) { const bool gt_ = cv_ > LV[z_]; const float tv_ = gt_ ? LV[z_] : cv_; const int ti_ = gt_ ? LI[z_] : ci_; \
        LV[z_] = gt_ ? cv_ : LV[z_]; LI[z_] = gt_ ? ci_ : LI[z_]; cv_ = tv_; ci_ = ti_; } } while (0)
__device__ __forceinline__ void ph_route_naive(const Ctx& C, const f16* __restrict__ qp, const float* __restrict__ ss2, const f16* __restrict__ subk, int* __restrict__ eidx, float* __restrict__ egate) {
    for (int gid = C.gt; gid < T * 8; gid += C.ngt) {
        const int t = gid % T, h = gid / T;
        const float rs2 = rs_from_ss(ss2, t);
        float av[16], bv[16]; int ai[16], bi[16];
#pragma unroll
        for (int z = 0; z < 16; ++z) { av[z] = -3e38f; bv[z] = -3e38f; ai[z] = 0; bi[z] = 0; }
        for (int p = 0; p < 2; ++p) {
            const f16* qr = qp + (size_t)t * 2048 + h * 256 + p * 128;
            for (int n = 0; n < 128; ++n) {
                const f16* kr = subk + ((size_t)((h * 2 + p) * 128 + n)) * 128;
                float dot = 0.f;
                for (int c = 0; c < 128; ++c) dot += (float)qr[c] * (float)kr[c];
                dot *= rs2;
                if (p == 0) INS(av, ai, dot, n); else INS(bv, bi, dot, n);
            }
        }
        float cv[16]; int ci[16];
#pragma unroll
        for (int z = 0; z < 16; ++z) { cv[z] = -3e38f; ci[z] = 0; }
#pragma unroll
        for (int i = 0; i < 16; ++i)
#pragma unroll
            for (int j = 0; j < 16; ++j)
                if ((i + 1) * (j + 1) <= 16) INS(cv, ci, av[i] + bv[j], ai[i] * 128 + bi[j]);
        float sum = 0.f, e[16];
#pragma unroll
        for (int z = 0; z < 16; ++z) { e[z] = __expf(cv[z] - cv[0]); sum += e[z]; }
        const float inv = 1.0f / sum;
#pragma unroll
        for (int z = 0; z < 16; ++z) { eidx[(size_t)t * 128 + h * 16 + z] = ci[z]; egate[(size_t)t * 128 + h * 16 + z] = e[z] * inv; }
    }
}

__device__ __forceinline__ int mono_i(float f) { const int b = __float_as_int(f); return b ^ ((b >> 31) & 0x7fffffff); }
__device__ __forceinline__ float unmono_f(int m) { return __int_as_float(m ^ ((m >> 31) & 0x7fffffff)); }
#define INS16(Lst, x_) do { int xv_ = (x_); _Pragma("unroll") for (int z_ = 0; z_ < 16; ++z_) { const int hi_ = max(Lst[z_], xv_); xv_ = min(Lst[z_], xv_); Lst[z_] = hi_; } } while (0)
__device__ __forceinline__ void merge_pair16(int (&Lst)[16]) {
    int P[16];
#pragma unroll
    for (int z = 0; z < 16; ++z) P[z] = __shfl_xor(Lst[z], 32);
#pragma unroll
    for (int z = 0; z < 16; ++z) Lst[z] = max(Lst[z], P[15 - z]);
#pragma unroll
    for (int s = 8; s >= 1; s >>= 1)
#pragma unroll
        for (int i = 0; i < 16; ++i) if ((i & s) == 0) { const int hi = max(Lst[i], Lst[i + s]), lo = min(Lst[i], Lst[i + s]); Lst[i] = hi; Lst[i + s] = lo; }
}
__device__ __forceinline__ void bitonic_sort16_desc(int (&K)[16]) {
#pragma unroll
    for (int k = 2; k <= 16; k <<= 1)
#pragma unroll
        for (int j = k >> 1; j > 0; j >>= 1)
#pragma unroll
            for (int i = 0; i < 16; ++i) { const int l = i ^ j; if (l > i) { const int a = K[i], b = K[l], hi = max(a, b), lo = min(a, b); const bool desc = (i & k) == 0; K[i] = desc ? hi : lo; K[l] = desc ? lo : hi; } }
}
__device__ __forceinline__ void bitonic_merge16_desc(int (&K)[16]) {
#pragma unroll
    for (int s = 8; s >= 1; s >>= 1)
#pragma unroll
        for (int i = 0; i < 16; ++i) if ((i & s) == 0) { const int hi = max(K[i], K[i + s]), lo = min(K[i], K[i + s]); K[i] = hi; K[i + s] = lo; }
}
template <class Side>
__device__ __forceinline__ void ph_route(const Ctx& C, LAS unsigned char* lds, const f16* __restrict__ qp, const float* __restrict__ ss2, const f16* __restrict__ subk,
                                         int* __restrict__ eidx, float* __restrict__ egate, const Side& side_job) {
    const int lane = C.lane, r32 = lane & 31, hh = lane >> 5;
    LAS unsigned char* tab = lds + 65536 + C.wave * 4096 + lane * 36;
    const int GH = C.G < 8 ? C.G : 8;
  for (int h = blockIdx.x % GH; h < 8; h += GH) {
    const int rank_h = blockIdx.x / GH, nwg_h = (C.G - (blockIdx.x % GH) + GH - 1) / GH;
    __syncthreads();
    for (int i = C.tid; i < 2 * 128 * 16; i += NTHREADS) {
        const int row = i >> 4, ch = i & 15;
        *(LAS half8*)(lds + row * 256 + ((ch ^ (row & 15)) << 4)) = *(const half8*)(subk + (size_t)(h * 256 + row) * 128 + ch * 8);
    }
    __syncthreads();
    if (h == (int)(blockIdx.x % GH) && (C.wave & 4)) side_job();
    for (int tb = rank_h * NWAVES + C.wave; tb < T / 32; tb += nwg_h * NWAVES) {
        const int t0 = tb * 32, t = t0 + r32;
        int top[2][16];
#pragma unroll
        for (int p = 0; p < 2; ++p) {
            const f16* qrow = qp + (size_t)t * 2048 + h * 256 + p * 128 + 8 * hh;
            const LAS unsigned char* kl = lds + (p * 128 + r32) * 256;
            half8 bq[8];
#pragma unroll
            for (int ks = 0; ks < 8; ++ks) bq[ks] = *(const half8*)(qrow + 16 * ks);
            int Lst[16];
#pragma unroll
            for (int z = 0; z < 16; ++z) Lst[z] = (int)0x80000000;
#pragma unroll 1
            for (int nb = 0; nb < 4; ++nb) {
                f32x16 acc = {0.f, 0.f, 0.f, 0.f, 0.f, 0.f, 0.f, 0.f, 0.f, 0.f, 0.f, 0.f, 0.f, 0.f, 0.f, 0.f};
#pragma unroll
                for (int ks = 0; ks < 8; ++ks) {
                    const half8 ak = *(const LAS half8*)(kl + nb * 32 * 256 + (((2 * ks + hh) ^ (r32 & 15)) << 4));
                    acc = __builtin_amdgcn_mfma_f32_32x32x16_f16(ak, bq[ks], acc, 0, 0, 0);
                }
                int K[16];
#pragma unroll
                for (int r = 0; r < 16; ++r) { const int n = nb * 32 + (r & 3) + 8 * (r >> 2) + 4 * hh; K[r] = (mono_i(acc[r]) & ~127) | (127 - n); }
                bitonic_sort16_desc(K);
#pragma unroll
                for (int z = 0; z < 16; ++z) Lst[z] = max(Lst[z], K[15 - z]);
                bitonic_merge16_desc(Lst);
            }
            merge_pair16(Lst);
#pragma unroll
            for (int z = 0; z < 16; ++z) top[p][z] = Lst[z];
        }
        float va[16], vb[16];
#pragma unroll
        for (int z = 0; z < 16; ++z) { va[z] = unmono_f(top[0][z] & ~127); vb[z] = unmono_f(top[1][z] & ~127);
            tab[z] = (unsigned char)(127 - (top[0][z] & 127)); tab[16 + z] = (unsigned char)(127 - (top[1][z] & 127)); }
        int Cl[16];
        { const float a01 = hh ? va[1] : va[0];
#pragma unroll
          for (int j = 0; j < 16; ++j) { const int key = (mono_i(a01 + vb[j]) & ~255) | (255 - (hh * 16 + j)); Cl[j] = (hh && j >= 8) ? (int)0x80000000 : key; } }
#pragma unroll
        for (int i = 2; i < 16; i += 2) {
            const float ai = hh ? va[i + 1] : va[i];
#pragma unroll
            for (int j = 0; j < 16; ++j)
                if ((i + 1) * (j + 1) <= 16) {
                    int key = (mono_i(ai + vb[j]) & ~255) | (255 - ((i + hh) * 16 + j));
                    if ((i + 2) * (j + 1) > 16) key = hh ? (int)0x80000000 : key;
                    INS16(Cl, key);
                }
        }
        merge_pair16(Cl);
        float e[16], sum = 0.f; const float mx = unmono_f(Cl[0] & ~255);
#pragma unroll
        for (int z = 0; z < 16; ++z) { e[z] = __expf(unmono_f(Cl[z] & ~255) - mx); sum += e[z]; }
        const float inv = 1.0f / sum;
        LDS_WAIT();
        int* ei = eidx + (size_t)t * 128 + h * 16 + 8 * hh; float* eg = egate + (size_t)t * 128 + h * 16 + 8 * hh;
#pragma unroll
        for (int z = 0; z < 16; ++z) {
            if ((z >> 3) == hh) { const int code = 255 - (Cl[z] & 255); const int ia = tab[code >> 4], ib = tab[16 + (code & 15)];
                ei[z & 7] = ia * 128 + ib; eg[z & 7] = e[z] * inv; }
        }
        LDS_WAIT();
    }
  }
}

struct Slicing { int m, pi, nloc, rank; };
__device__ __forceinline__ Slicing get_slicing(const unsigned* bar, volatile LAS unsigned* misc) {
    Slicing S; const unsigned x = (unsigned)__builtin_amdgcn_s_getreg((3 << 11) | 20) & 0xFu;
    int m = 0, pi = 0, nloc = 1;
    for (unsigned j = 0; j < 16; ++j) { const unsigned c = __hip_atomic_load(&bar[256 + 64 * j], __ATOMIC_RELAXED, __HIP_MEMORY_SCOPE_AGENT); if (c > 0u) { if (j < x) ++pi; ++m; } if (j == x) nloc = (int)c; }
    S.m = m > 0 ? m : 1; S.pi = pi; S.nloc = nloc > 0 ? nloc : 1; S.rank = (int)misc[10];
    return S;
}
__device__ __forceinline__ float gelu_fast(float v) {
    const float av = fabsf(v), t = __builtin_amdgcn_rcpf(av * 0.2316418882f + 1.0f);
    float q = t * 0.5307027145f + (-0.7265760135f); q = q * t + 0.7107068705f; q = q * t + (-0.142248368f); q = q * t + 0.127414796f; q = q * t;
    const float m = v * (q * __builtin_amdgcn_exp2f((v * v) * (-0.72134752044f)));
    return v < 0.f ? m : v - m;
}
__device__ __forceinline__ void ph_h2quant(const Ctx& C, const f16* __restrict__ x1h, const float* __restrict__ ss2, unsigned* __restrict__ h2q, float* __restrict__ hsc) {
    const int lane = C.lane;
    for (int t = C.gw; t < T; t += C.ngw) {
        const half8 h0 = *(const half8*)(x1h + (size_t)t * DM + 16 * lane), h1 = *(const half8*)(x1h + (size_t)t * DM + 16 * lane + 8);
        float hm = 0.f;
#pragma unroll
        for (int i = 0; i < 8; ++i) hm = fmaxf(hm, fmaxf(fabsf((float)h0[i]), fabsf((float)h1[i])));
        hm = wave_max(hm);
        const float inv = hm > 0.f ? 127.0f / hm : 0.f;
        u32x4 w;
        w[0] = (unsigned)pack4_i8((float)h0[0] * inv, (float)h0[1] * inv, (float)h0[2] * inv, (float)h0[3] * inv);
        w[1] = (unsigned)pack4_i8((float)h0[4] * inv, (float)h0[5] * inv, (float)h0[6] * inv, (float)h0[7] * inv);
        w[2] = (unsigned)pack4_i8((float)h1[0] * inv, (float)h1[1] * inv, (float)h1[2] * inv, (float)h1[3] * inv);
        w[3] = (unsigned)pack4_i8((float)h1[4] * inv, (float)h1[5] * inv, (float)h1[6] * inv, (float)h1[7] * inv);
        *(u32x4*)(h2q + (size_t)t * 256 + 4 * lane) = w;
        if (lane == 0) hsc[t] = hm * (1.0f / 127.0f) * rs_from_ss(ss2, t);
    }
}
__device__ __forceinline__ __amdgpu_buffer_rsrc_t slice_rsrc(const unsigned char* base) {
    const unsigned long long b = (unsigned long long)base;
    const unsigned lo = __builtin_amdgcn_readfirstlane((unsigned)b), hi = __builtin_amdgcn_readfirstlane((unsigned)(b >> 32));
    return __builtin_amdgcn_make_buffer_rsrc((void*)(((unsigned long long)hi << 32) | lo), 0, NEXP * 128, 0x00020000);
}
template <int EMASK>
__device__ __forceinline__ void ph_upeer(const Ctx& C, LAS unsigned char* lds, const Slicing SL, const unsigned* __restrict__ h2q, const int* __restrict__ eidx,
                                         const unsigned char* __restrict__ uq, short* __restrict__ pdot) {
    const int lane = C.lane, grp = lane >> 3, c8 = lane & 7;
    const int wv = SL.rank * NWAVES + C.wave, nwv = SL.nloc * NWAVES;
    const int ntok = (T - wv + nwv - 1) / nwv;
    auto tok = [&](int i) { const int t = wv + i * nwv; return t < T ? t : T - 1; };
    volatile LAS int* row = (volatile LAS int*)(lds + C.wave * 1024);
  for (int s = SL.pi; s < 8; s += SL.m) {
    const __amdgpu_buffer_rsrc_t urs = slice_rsrc(uq + (size_t)s * (NEXP * 128));
    const unsigned* hqs = h2q + s * 32 + c8 * 4;
    int tA = tok(0), tB = tok(1);
    int e0 = eidx[(size_t)tA * 128 + lane], e1 = eidx[(size_t)tA * 128 + 64 + lane];
    u32x4 hq = *(const u32x4*)(hqs + (size_t)tA * 256);
    int ne0 = eidx[(size_t)tB * 128 + lane], ne1 = eidx[(size_t)tB * 128 + 64 + lane];
    u32x4 r[16];
#pragma unroll
    for (int i = 0; i < 16; ++i) { const int e = __shfl(i < 8 ? e0 : e1, 8 * (i & 7) + grp) & EMASK; r[i] = __builtin_amdgcn_raw_buffer_load_b128(urs, e * 128 + c8 * 16, 0, 0); }
#pragma unroll 1
    for (int it = 0; it < ntok; ++it) {
        const int t = tok(it), t1 = tok(it + 1), t2 = tok(it + 2);
        const int ze0 = eidx[(size_t)t2 * 128 + lane], ze1 = eidx[(size_t)t2 * 128 + 64 + lane];
        const u32x4 nhq = *(const u32x4*)(hqs + (size_t)t1 * 256);
#pragma unroll
        for (int q = 0; q < 4; ++q) {
            int evv[4];
#pragma unroll
            for (int j = 0; j < 4; ++j) evv[j] = __shfl(q < 2 ? ne0 : ne1, 32 * (q & 1) + 8 * j + grp) & EMASK;
            int pa[4], pb[4];
#pragma unroll
            for (int j = 0; j < 4; ++j) {
                pa[j] = __builtin_amdgcn_sdot4((int)r[4 * q + j][0], (int)hq[0], 0, false); pb[j] = __builtin_amdgcn_sdot4((int)r[4 * q + j][1], (int)hq[1], 0, false);
                pa[j] = __builtin_amdgcn_sdot4((int)r[4 * q + j][2], (int)hq[2], pa[j], false); pb[j] = __builtin_amdgcn_sdot4((int)r[4 * q + j][3], (int)hq[3], pb[j], false);
            }
#pragma unroll
            for (int j = 0; j < 4; ++j) { pa[j] += pb[j]; pa[j] += dppi<0xB1>(pa[j]); }
#pragma unroll
            for (int j = 0; j < 4; ++j) pa[j] += dppi<0x4E>(pa[j]);
#pragma unroll
            for (int j = 0; j < 4; ++j) pa[j] += dppi<0x141>(pa[j]);
            if (c8 == 0) {
#pragma unroll
                for (int j = 0; j < 4; ++j) row[8 * (4 * q + j) + grp] = pa[j];
            }
#pragma unroll
            for (int j = 0; j < 4; ++j) {
                asm volatile("" ::: "memory");
                r[4 * q + j] = __builtin_amdgcn_raw_buffer_load_b128(urs, evv[j] * 128 + c8 * 16, 0, 0);
                asm volatile("" ::: "memory");
            }
        }
        LDS_WAIT();
        const int p0 = row[lane], p1 = row[64 + lane];
        LDS_WAIT();
        { short* pp = pdot + ((size_t)s * T + t) * 128 + lane; const int c0 = min(max((p0 + 4) >> 3, -32768), 32767), c1 = min(max((p1 + 4) >> 3, -32768), 32767);
          asm volatile("global_store_short %0, %1, off\n\tglobal_store_short %0, %2, off offset:128" :: "v"(pp), "v"(c0), "v"(c1) : "memory"); }
        hq = nhq; ne0 = ze0; ne1 = ze1;
    }
  }
}
__device__ __forceinline__ void ph_ureduce(const Ctx& C, LAS unsigned char* lds, const short* __restrict__ pdot, const float* __restrict__ hsc, const int* __restrict__ eidx, const float* __restrict__ us,
                                           const float* __restrict__ vs, const float* __restrict__ egate, unsigned* __restrict__ wqp, float* __restrict__ wsc) {
    const int lane = C.lane;
    volatile LAS unsigned char* row = (volatile LAS unsigned char*)(lds + C.wave * 1024);
    for (int tb = C.gw * 2; tb < T; tb += C.ngw * 2) {
        int e0[2], e1[2], s0[2], s1[2]; float h[2], g0[2], g1[2];
#pragma unroll
        for (int u = 0; u < 2; ++u) {
            const int t = tb + u;
            e0[u] = eidx[(size_t)t * 128 + lane]; e1[u] = eidx[(size_t)t * 128 + 64 + lane];
            g0[u] = egate[(size_t)t * 128 + lane]; g1[u] = egate[(size_t)t * 128 + 64 + lane];
            h[u] = hsc[t]; s0[u] = 0; s1[u] = 0;
#pragma unroll
            for (int s = 0; s < 8; ++s) { const short* pp = pdot + ((size_t)s * T + t) * 128 + lane; s0[u] += (int)pp[0]; s1[u] += (int)pp[64]; }
        }
        float w0[2], w1[2];
#pragma unroll
        for (int u = 0; u < 2; ++u) {
            w0[u] = gelu_fast((float)s0[u] * (8.0f * h[u]) * us[e0[u]]) * g0[u] * vs[e0[u]];
            w1[u] = gelu_fast((float)s1[u] * (8.0f * h[u]) * us[e1[u]]) * g1[u] * vs[e1[u]];
        }
#pragma unroll
        for (int u = 0; u < 2; ++u) {
            const int t = tb + u;
            const float wm = wave_max(fmaxf(fabsf(w0[u]), fabsf(w1[u])));
            const float inv = wm > 0.f ? 127.0f / wm : 0.f;
            { const int k = lane; row[u * 128 + (k & 7) * 16 + (k >> 5) * 4 + ((k >> 3) & 3)] = (unsigned char)(int)rintf(w0[u] * inv); }
            { const int k = 64 + lane; row[u * 128 + (k & 7) * 16 + (k >> 5) * 4 + ((k >> 3) & 3)] = (unsigned char)(int)rintf(w1[u] * inv); }
            if (lane == 0) wsc[t] = wm * (1.0f / 127.0f);
        }
        LDS_WAIT();
        wqp[(size_t)tb * 32 + lane] = ((volatile LAS unsigned*)row)[lane];
        LDS_WAIT();
    }
}
template <int EMASK>
__device__ __forceinline__ void ph_vpeer(const Ctx& C, const Slicing SL, const int* __restrict__ eidx, const unsigned* __restrict__ wqp, const float* __restrict__ wsc, const unsigned char* __restrict__ vq,
                                         f16* __restrict__ peer) {
    const int lane = C.lane, grp = lane >> 3, c8 = lane & 7;
    const bool hh = (lane & 32) != 0, b4 = (lane & 16) != 0, b3 = (lane & 8) != 0;
    const int wv = SL.rank * NWAVES + C.wave, nwv = SL.nloc * NWAVES;
    const int ntok = (T - wv + nwv - 1) / nwv;
    auto tok = [&](int i) { const int t = wv + i * nwv; return t < T ? t : T - 1; };
  for (int s = SL.pi; s < 8; s += SL.m) {
    const __amdgpu_buffer_rsrc_t vrs = slice_rsrc(vq + (size_t)s * (NEXP * 128));
    const int chl = 8 * (hh ? 1 : 0) + 4 * (b4 ? 1 : 0) + 2 * (b3 ? 1 : 0);
    const int coff = s * 128 + c8 * 16 + chl;
    int tA = tok(0), tB = tok(1);
    int e0 = eidx[(size_t)tA * 128 + lane], e1 = eidx[(size_t)tA * 128 + 64 + lane];
    u32x4 wq = *(const u32x4*)(wqp + (size_t)tA * 32 + grp * 4); float wscale = wsc[tA];
    int ne0 = eidx[(size_t)tB * 128 + lane], ne1 = eidx[(size_t)tB * 128 + 64 + lane];
    u32x4 r[16];
#pragma unroll
    for (int i = 0; i < 16; ++i) { const int e = __shfl(i < 8 ? e0 : e1, 8 * (i & 7) + grp) & EMASK; r[i] = __builtin_amdgcn_raw_buffer_load_b128(vrs, e * 128 + c8 * 16, 0, 0); }
#pragma unroll 1
    for (int it = 0; it < ntok; ++it) {
        const int t = tok(it), t1 = tok(it + 1), t2 = tok(it + 2);
        const int ze0 = eidx[(size_t)t2 * 128 + lane], ze1 = eidx[(size_t)t2 * 128 + 64 + lane];
        const u32x4 nwq = *(const u32x4*)(wqp + (size_t)t1 * 32 + grp * 4); const float nwscale = wsc[t1];
        int o[16];
#pragma unroll
        for (int c = 0; c < 16; ++c) o[c] = 0;
#pragma unroll
        for (int q = 0; q < 4; ++q) {
            int evv[4];
#pragma unroll
            for (int j = 0; j < 4; ++j) evv[j] = __shfl(q < 2 ? ne0 : ne1, 32 * (q & 1) + 8 * j + grp) & EMASK;
#pragma unroll
            for (int d = 0; d < 4; ++d) {
                const unsigned a = r[4 * q][d], b = r[4 * q + 1][d], c = r[4 * q + 2][d], e = r[4 * q + 3][d];
                const unsigned t0 = __builtin_amdgcn_perm(b, a, 0x05010400u), t1p = __builtin_amdgcn_perm(b, a, 0x07030602u);
                const unsigned u0 = __builtin_amdgcn_perm(e, c, 0x05010400u), u1 = __builtin_amdgcn_perm(e, c, 0x07030602u);
                o[4 * d + 0] = __builtin_amdgcn_sdot4((int)__builtin_amdgcn_perm(u0, t0, 0x05040100u), (int)wq[q], o[4 * d + 0], false);
                o[4 * d + 1] = __builtin_amdgcn_sdot4((int)__builtin_amdgcn_perm(u0, t0, 0x07060302u), (int)wq[q], o[4 * d + 1], false);
                o[4 * d + 2] = __builtin_amdgcn_sdot4((int)__builtin_amdgcn_perm(u1, t1p, 0x05040100u), (int)wq[q], o[4 * d + 2], false);
                o[4 * d + 3] = __builtin_amdgcn_sdot4((int)__builtin_amdgcn_perm(u1, t1p, 0x07060302u), (int)wq[q], o[4 * d + 3], false);
            }
#pragma unroll
            for (int j = 0; j < 4; ++j) {
                asm volatile("" ::: "memory");
                r[4 * q + j] = __builtin_amdgcn_raw_buffer_load_b128(vrs, evv[j] * 128 + c8 * 16, 0, 0);
                asm volatile("" ::: "memory");
            }
        }
        int q8[8], q4[4], q2[2];
#pragma unroll
        for (int k = 0; k < 8; ++k) q8[k] = bfly32i(o[k], o[8 + k]);
#pragma unroll
        for (int k = 0; k < 4; ++k) q4[k] = bfly16i(q8[k], q8[4 + k]);
#pragma unroll
        for (int k = 0; k < 2; ++k) { const int mine = b3 ? q4[2 + k] : q4[k], oth = b3 ? q4[k] : q4[2 + k]; q2[k] = mine + dppi<0x128>(oth); }
        { half2 pv; pv[0] = (f16)((float)q2[0] * wscale); pv[1] = (f16)((float)q2[1] * wscale); f16* yp = peer + (size_t)t * DM + coff; asm volatile("global_store_dword %0, %1, off" :: "v"(yp), "v"(pv) : "memory"); }
        wq = nwq; wscale = nwscale; ne0 = ze0; ne1 = ze1;
    }
  }
}
__device__ __forceinline__ void ph_final(const Ctx& C, const f16* __restrict__ peer, float* xio, const float* __restrict__ gf) {
    const int lane = C.lane;
    f32x4 gg[4];
#pragma unroll
    for (int j = 0; j < 4; ++j) gg[j] = *(const f32x4*)(gf + j * 256 + lane * 4);
    for (int tb = C.gw * 4; tb < T; tb += C.ngw * 4) {
        f32x4 v[4][4]; half4 pe[4][4];
#pragma unroll
        for (int u = 0; u < 4; ++u)
#pragma unroll
            for (int j = 0; j < 4; ++j) { v[u][j] = *(const f32x4*)(xio + (size_t)(tb + u) * DM + j * 256 + lane * 4); pe[u][j] = *(const half4*)(peer + (size_t)(tb + u) * DM + j * 256 + lane * 4); }
#pragma unroll
        for (int u = 0; u < 4; ++u) {
            float s = 0.f;
#pragma unroll
            for (int j = 0; j < 4; ++j) {
#pragma unroll
                for (int i = 0; i < 4; ++i) { v[u][j][i] += (float)pe[u][j][i]; s += v[u][j][i] * v[u][j][i]; }
            }
            const float r = rsqrtf(wave_sum(s) * (1.0f / DM) + EPS);
#pragma unroll
            for (int j = 0; j < 4; ++j) *(f32x4*)(xio + (size_t)(tb + u) * DM + j * 256 + lane * 4) = v[u][j] * r * gg[j];
        }
    }
}

namespace pg8 {
#define PG8_LAS __attribute__((address_space(3)))
typedef _Float16 frag8 __attribute__((ext_vector_type(8)));
typedef float f32x4 __attribute__((ext_vector_type(4)));
constexpr int BM = 256, BK = 64, HALF = 128, HTB = HALF * BK * 2  , STAGE_BYTES = 8 * HTB, NXCD = 8, WGM = 8;

__host__ __device__ __forceinline__ int lds_byte(int r, int c) { const int st = (r >> 4) * 2 + (c >> 5), rr = r & 15, cc = c & 31, ob = rr * 64 + cc * 2; return st * 1024 + (ob ^ (((ob >> 9) & 1) << 5)); }
__host__ __device__ __forceinline__ void stage_rc(int b, int& R, int& C) { const int st = b / 1024, sb = b % 1024, swz = sb ^ (((sb >> 9) & 1) << 5); R = (st >> 1) * 16 + swz / 64; C = (st & 1) * 32 + (swz % 64) / 2; }
__host__ __device__ __forceinline__ int perm32(int rho) { const int n = rho >> 4, i = rho & 15; return 8 * (i >> 2) + 4 * n + (i & 3); }

struct Unit { int pm, pn; };
struct Gemm { const f16* A; const f16* Bt; int M, N, K; };

struct StaticOrder {
    int nM, nN, nwg, G, c;
    __host__ __device__ void init(int M, int N, int G_, int c_) { nM = M / BM; nN = N / BM; nwg = nM * nN; G = G_; c = c_; }
    __host__ __device__ bool next(int i, Unit& u) const {
        const long L = (long)i * G + c; if (L >= nwg) return false;
        int wgid = (int)L; { const int q = nwg / NXCD, r = nwg % NXCD, xcd = wgid % NXCD, off = wgid / NXCD; wgid = (xcd < r ? xcd * (q + 1) : r * (q + 1) + (xcd - r) * q) + off; }
        const int nig = WGM * nN, gid = wgid / nig, fm = gid * WGM, gsz = (nM - fm) < WGM ? (nM - fm) : WGM;
        u.pm = fm + ((wgid % nig) % gsz); u.pn = (wgid % nig) / gsz; return true;
    }
    __device__ __forceinline__ void a_ready(const Unit&) const {}
    __device__ __forceinline__ void done(const Unit&) const {}
};

__device__ __forceinline__ frag8 pack8(const f32x4 a, const f32x4 b) {
    frag8 h; h[0] = (f16)a[0]; h[1] = (f16)a[1]; h[2] = (f16)a[2]; h[3] = (f16)a[3]; h[4] = (f16)b[0]; h[5] = (f16)b[1]; h[6] = (f16)b[2]; h[7] = (f16)b[3]; return h;
}
__device__ __forceinline__ float sigmoidf_(float z) { return 1.0f / (1.0f + __expf(-z)); }

struct EpiP1 {
    typedef i32x4 acc_t; static constexpr bool PERM = true, AFTER_DRAIN = false, MIDK = false;
    const float* ss1; const float* rsx; const float* wcs; const float* bgate; f16* qkvu; f16* gates; f16* vT;
    __device__ __forceinline__ void operator()(const i32x4 (&acc)[2][2][4][2], const Unit& u, int wr, int wc, int fr, int fq) const {
        const int row0 = u.pm * BM + wr * 64 + fr, colt = u.pn * BM; const bool isg = colt >= NQKVU;
        f32x4 cs[2][2];
#pragma unroll
        for (int bj = 0; bj < 2; ++bj) { const int c0 = colt + bj * HALF + wc * 32 + 8 * fq; cs[bj][0] = *(const f32x4*)(wcs + c0); cs[bj][1] = *(const f32x4*)(wcs + c0 + 4); }
#pragma unroll
        for (int ai = 0; ai < 2; ++ai)
#pragma unroll
            for (int m = 0; m < 4; ++m) { const int row = row0 + ai * HALF + m * 16; const float r = rsqrtf(ss1[row] * (1.0f / DM) + EPS) * rsx[row];
#pragma unroll
                for (int bj = 0; bj < 2; ++bj) { const int c0 = colt + bj * HALF + wc * 32 + 8 * fq; f32x4 v0, v1;
#pragma unroll
                    for (int i = 0; i < 4; ++i) { v0[i] = (float)acc[ai][bj][m][0][i] * (r * cs[bj][0][i]); v1[i] = (float)acc[ai][bj][m][1][i] * (r * cs[bj][1][i]); }
                    if (isg) { const int cg = c0 - NQKVU; const f32x4 b0 = *(const f32x4*)(bgate + cg), b1 = *(const f32x4*)(bgate + cg + 4);
#pragma unroll
                        for (int i = 0; i < 4; ++i) { v0[i] = sigmoidf_(v0[i] + b0[i]); v1[i] = sigmoidf_(v1[i] + b1[i]); }
                        *(frag8*)(gates + (size_t)row * NGATE + cg) = pack8(v0, v1); }
                    else { const frag8 hv = pack8(v0, v1); *(frag8*)(qkvu + (size_t)row * NQKVU + c0) = hv;
                        if (colt == 512 && bj == 1) {
                            f16* vp = vT + ((size_t)((row >> 11) * 2 + (wc >> 1)) * 64 + (wc & 1) * 32 + 8 * fq) * SEQ + (row & (SEQ - 1));
#pragma unroll
                            for (int i = 0; i < 8; ++i) vp[(size_t)i * SEQ] = hv[i]; } } } }
    }
};
struct EpiMerged {
    typedef f32x4 acc_t; static constexpr bool PERM = true, AFTER_DRAIN = false, MIDK = true;
    const f16* gates; f16* merged;
    __device__ __forceinline__ void mid(f32x4 (&acc)[2][2][4][2], const Unit& u, int wr, int wc, int fr, int fq) const {
        const int row0 = u.pm * BM + wr * 64 + fr, colt = u.pn * BM;
        const f16* gb = gates + (size_t)row0 * NGATE + colt + wc * 32 + 8 * fq;
        asm volatile("" : "+v"(gb));
#pragma unroll
        for (int ai = 0; ai < 2; ++ai) {
            frag8 g0[4][2], g1[4][2];
#pragma unroll
            for (int m = 0; m < 4; ++m)
#pragma unroll
                for (int bj = 0; bj < 2; ++bj) { const f16* gp = gb + (size_t)(ai * HALF + m * 16) * NGATE + bj * HALF; g0[m][bj] = *(const frag8*)gp; g1[m][bj] = *(const frag8*)(gp + DM); }
#pragma unroll
            for (int m = 0; m < 4; ++m)
#pragma unroll
                for (int bj = 0; bj < 2; ++bj)
#pragma unroll
                    for (int i = 0; i < 4; ++i) {
                        acc[ai][bj][m][0][i] *= (float)g0[m][bj][i] * __builtin_amdgcn_rcpf(fmaxf((float)g1[m][bj][i], 1e-4f));
                        acc[ai][bj][m][1][i] *= (float)g0[m][bj][4 + i] * __builtin_amdgcn_rcpf(fmaxf((float)g1[m][bj][4 + i], 1e-4f)); }
            asm volatile("" ::: "memory");
        }
    }
    __device__ __forceinline__ void operator()(const f32x4 (&acc)[2][2][4][2], const Unit& u, int wr, int wc, int fr, int fq) const {
        const int row0 = u.pm * BM + wr * 64 + fr, colt = u.pn * BM;
#pragma unroll
        for (int ai = 0; ai < 2; ++ai)
#pragma unroll
            for (int m = 0; m < 4; ++m) { const int row = row0 + ai * HALF + m * 16;
#pragma unroll
                for (int bj = 0; bj < 2; ++bj) { const int c0 = colt + bj * HALF + wc * 32 + 8 * fq;
                    const frag8 g1 = *(const frag8*)(gates + (size_t)row * NGATE + DM + c0); f32x4 v0, v1;
#pragma unroll
                    for (int i = 0; i < 4; ++i) { v0[i] = acc[ai][bj][m][0][i] * fmaxf((float)g1[i], 1e-4f); v1[i] = acc[ai][bj][m][1][i] * fmaxf((float)g1[4 + i], 1e-4f); }
                    *(frag8*)(merged + (size_t)row * DM + c0) = pack8(v0, v1); } }
    }
};
struct EpiOut {
    typedef f32x4 acc_t; static constexpr bool PERM = false, AFTER_DRAIN = false, MIDK = false;
    const float* x; const float* g2; float* x1; f16* x1h; float* ss2p;
    __device__ __forceinline__ void operator()(const f32x4 (&acc)[2][2][4][2], const Unit& u, int wr, int wc, int fr, int fq) const {
        const int row0 = u.pm * BM + wr * 64 + fr, col0 = u.pn * BM + wc * 32 + 4 * fq;
        f32x4 gv[2][2];
#pragma unroll
        for (int bj = 0; bj < 2; ++bj)
#pragma unroll
            for (int n = 0; n < 2; ++n) gv[bj][n] = *(const f32x4*)(g2 + col0 + bj * HALF + n * 16);
#pragma unroll
        for (int ai = 0; ai < 2; ++ai)
#pragma unroll
            for (int m = 0; m < 4; ++m) { const int row = row0 + ai * HALF + m * 16; const size_t off = (size_t)row * DM + col0; float ssq = 0.f;
#pragma unroll
                for (int bj = 0; bj < 2; ++bj)
#pragma unroll
                    for (int n = 0; n < 2; ++n) { const f32x4 y = *(const f32x4*)(x + off + bj * HALF + n * 16) + acc[ai][bj][m][n];
                        *(f32x4*)(x1 + off + bj * HALF + n * 16) = y; ssq += (y[0] * y[0] + y[1] * y[1]) + (y[2] * y[2] + y[3] * y[3]);
                        const f32x4 yg = y * gv[bj][n]; half4 h; h[0] = (f16)yg[0]; h[1] = (f16)yg[1]; h[2] = (f16)yg[2]; h[3] = (f16)yg[3];
                        *(half4*)(x1h + off + bj * HALF + n * 16) = h; }
                ssq += __shfl_xor(ssq, 16); ssq += __shfl_xor(ssq, 32);
                if (fq == 0) ss2p[(size_t)(u.pn * 4 + wc) * T + row] = ssq; }
    }
};
struct EpiQ {
    typedef i32x4 acc_t; static constexpr bool PERM = true, AFTER_DRAIN = false, MIDK = false;
    const float* hsc; const float* wqs; f16* qp;
    __device__ __forceinline__ void operator()(const i32x4 (&acc)[2][2][4][2], const Unit& u, int wr, int wc, int fr, int fq) const {
        const int row0 = u.pm * BM + wr * 64 + fr, colt = u.pn * BM;
        f32x4 cs[2][2];
#pragma unroll
        for (int bj = 0; bj < 2; ++bj) { const int c0 = colt + bj * HALF + wc * 32 + 8 * fq; cs[bj][0] = *(const f32x4*)(wqs + c0); cs[bj][1] = *(const f32x4*)(wqs + c0 + 4); }
#pragma unroll
        for (int ai = 0; ai < 2; ++ai)
#pragma unroll
            for (int m = 0; m < 4; ++m) { const int row = row0 + ai * HALF + m * 16; const float r = hsc[row];
#pragma unroll
                for (int bj = 0; bj < 2; ++bj) { const int c0 = colt + bj * HALF + wc * 32 + 8 * fq; f32x4 v0, v1;
#pragma unroll
                    for (int i = 0; i < 4; ++i) { v0[i] = (float)acc[ai][bj][m][0][i] * (r * cs[bj][0][i]); v1[i] = (float)acc[ai][bj][m][1][i] * (r * cs[bj][1][i]); }
                    *(frag8*)(qp + (size_t)row * 2048 + c0) = pack8(v0, v1); } }
    }
};

__device__ __forceinline__ void mma16(const frag8 b, const frag8 a, f32x4& c) { c = __builtin_amdgcn_mfma_f32_16x16x32_f16(b, a, c, 0, 0, 0); }
__device__ __forceinline__ void mma16(const frag8 b, const frag8 a, i32x4& c) { c = __builtin_amdgcn_mfma_i32_16x16x64_i8(__builtin_bit_cast(i32x4, b), __builtin_bit_cast(i32x4, a), c, 0, 0, 0); }
template <class Epi, class Sched, bool ALIGN_EPI = false, bool SP2 = false>
__device__ __forceinline__ void gemm_phase(PG8_LAS unsigned char* lds, const Gemm g, const Sched& S, const Epi& E) {
    const int tid = threadIdx.x, wid = __builtin_amdgcn_readfirstlane(tid >> 6), lane = tid & 63, wr = wid >> 2, wc = wid & 3, fr = lane & 15, fq = lane >> 4;
    const int K = g.K, nt = K / BK;
    unsigned voffA[2], voffB[2];
#pragma unroll
    for (int i = 0; i < 2; ++i) { int R, C; stage_rc(tid * 16 + i * 8192, R, C); const int Rb = Epi::PERM ? ((R & ~31) + perm32(R & 31)) : R;
        voffA[i] = (unsigned)(R * K + C) * 2u; voffB[i] = (unsigned)(Rb * K + C) * 2u; }
    const size_t kstep = (size_t)(BK * 2);
    const size_t hstep = (size_t)HALF * K * 2;
    const size_t tstep = 2 * hstep;
    const unsigned ldsw = (unsigned)wid * 1024u;
    const int aoff = lds_byte(wr * 64 + fr, fq * 8), boff = lds_byte(wc * 32 + fr, fq * 8);
#define PG8_SA(b, h) (((b) * 2 + (h)) * HTB)
#define PG8_SB(b, h) ((4 + (b) * 2 + (h)) * HTB)
#define PG8_STAGE(bufoff, gbase, voff) do { _Pragma("unroll") for (int _i = 0; _i < 2; ++_i) \
        __builtin_amdgcn_global_load_lds((const unsigned*)((const char*)(gbase) + (voff)[_i]), (PG8_LAS unsigned*)(lds + (bufoff) + ldsw + _i * 8192), 16, 0, 0); } while (0)
#define PG8_LDA(dst, b, h) do { _Pragma("unroll") for (int m = 0; m < 4; ++m) _Pragma("unroll") for (int k = 0; k < 2; ++k) dst[m][k] = *(const PG8_LAS frag8*)(lds + PG8_SA(b, h) + aoff + m * 2048 + k * 1024); } while (0)
#define PG8_LDB(dst, b, h) do { _Pragma("unroll") for (int n = 0; n < 2; ++n) _Pragma("unroll") for (int k = 0; k < 2; ++k) dst[n][k] = *(const PG8_LAS frag8*)(lds + PG8_SB(b, h) + boff + n * 2048 + k * 1024); } while (0)
#define PG8_MMA(ai, bj, At, Bt) do { __builtin_amdgcn_s_setprio(1); _Pragma("unroll") for (int m = 0; m < 4; ++m) _Pragma("unroll") for (int n = 0; n < 2; ++n) _Pragma("unroll") for (int k = 0; k < 2; ++k) \
        mma16(Bt[n][k], At[m][k], acc[ai][bj][m][n]); __builtin_amdgcn_s_setprio(0); } while (0)
#define PG8_WAIT_V(n) asm volatile("s_waitcnt vmcnt(" #n ")" ::: "memory")
#define PG8_WAIT_L(n) asm volatile("s_waitcnt lgkmcnt(" #n ")" ::: "memory")
#define PG8_BAR __builtin_amdgcn_s_barrier()
#define PG8_SCHED __builtin_amdgcn_sched_barrier(0)
    Unit cur, nxt; int ui = 0;
    if (!S.next(0, cur)) return;
    typedef typename Epi::acc_t acc_t;
    acc_t acc[2][2][4][2];
#pragma unroll
    for (int a = 0; a < 2; ++a)
#pragma unroll
        for (int b = 0; b < 2; ++b)
#pragma unroll
            for (int m = 0; m < 4; ++m)
#pragma unroll
                for (int n = 0; n < 2; ++n) acc[a][b][m][n] = acc_t{};
    frag8 At[4][2], B0[2][2], B1[2][2];
    const char* cA = (const char*)g.A + (size_t)cur.pm * tstep; const char* cB = (const char*)g.Bt + (size_t)cur.pn * tstep;
    S.a_ready(cur);
    if constexpr (SP2) {
        PG8_STAGE(PG8_SB(0, 0), cB, voffB); PG8_STAGE(PG8_SB(0, 1), cB + hstep, voffB); PG8_STAGE(PG8_SA(0, 0), cA, voffA); PG8_STAGE(PG8_SA(0, 1), cA + hstep, voffA);
        if (wr == 1) PG8_BAR;
        PG8_WAIT_V(2); PG8_BAR;
        PG8_STAGE(PG8_SB(1, 0), cB + kstep, voffB); PG8_STAGE(PG8_SA(1, 0), cA + kstep, voffA); PG8_STAGE(PG8_SB(1, 1), cB + hstep + kstep, voffB);
        PG8_WAIT_V(6); PG8_BAR;
    } else {
        PG8_STAGE(PG8_SB(0, 0), cB, voffB); PG8_STAGE(PG8_SA(0, 0), cA, voffA); PG8_STAGE(PG8_SB(0, 1), cB + hstep, voffB); PG8_STAGE(PG8_SA(0, 1), cA + hstep, voffA);
        if (wr == 1) PG8_BAR;
        PG8_WAIT_V(4); PG8_BAR;
        PG8_STAGE(PG8_SB(1, 0), cB + kstep, voffB); PG8_STAGE(PG8_SA(1, 0), cA + kstep, voffA); PG8_STAGE(PG8_SB(1, 1), cB + hstep + kstep, voffB);
        PG8_WAIT_V(6); PG8_BAR;
    }
    for (;;) {
        const bool has_next = S.next(ui + 1, nxt);
        const char* nA = has_next ? (const char*)g.A + (size_t)nxt.pm * tstep : cA; const char* nB = has_next ? (const char*)g.Bt + (size_t)nxt.pn * tstep : cB;
        for (int t = 0; t < nt; t += 2) {
            const bool last = (t == nt - 2);
            if constexpr (Epi::MIDK) { if (t == (nt >> 1)) E.mid(acc, cur, wr, wc, fr, fq); }
            const char* a1 = cA + (size_t)(t + 1) * kstep;
            const char* a2 = last ? nA : cA + (size_t)(t + 2) * kstep; const char* b2 = last ? nB : cB + (size_t)(t + 2) * kstep;
            const char* a3 = a2 + kstep; const char* b3 = b2 + kstep;
            if (last && has_next) S.a_ready(nxt);
            if constexpr (SP2) {
            PG8_LDB(B0, 0, 0); PG8_LDB(B1, 0, 1); PG8_SCHED; PG8_LDA(At, 0, 0); PG8_STAGE(PG8_SA(1, 1), a1 + hstep, voffA);
            PG8_WAIT_V(8); PG8_WAIT_L(0); PG8_BAR; PG8_MMA(0, 0, At, B0); PG8_MMA(0, 1, At, B1); PG8_BAR; PG8_SCHED;
            PG8_LDA(At, 0, 1); PG8_STAGE(PG8_SB(0, 0), b2, voffB); PG8_STAGE(PG8_SB(0, 1), b2 + hstep, voffB); PG8_STAGE(PG8_SA(0, 0), a2, voffA);
            PG8_WAIT_V(8); PG8_WAIT_L(0); PG8_BAR; PG8_MMA(1, 0, At, B0); PG8_MMA(1, 1, At, B1); PG8_BAR; PG8_SCHED;
            PG8_LDB(B0, 1, 0); PG8_LDB(B1, 1, 1); PG8_SCHED; PG8_LDA(At, 1, 0); PG8_STAGE(PG8_SA(0, 1), a2 + hstep, voffA);
            PG8_WAIT_V(8); PG8_WAIT_L(0); PG8_BAR; PG8_MMA(0, 0, At, B0); PG8_MMA(0, 1, At, B1); PG8_BAR; PG8_SCHED;
            PG8_LDA(At, 1, 1); PG8_STAGE(PG8_SB(1, 0), b3, voffB); PG8_STAGE(PG8_SB(1, 1), b3 + hstep, voffB); PG8_STAGE(PG8_SA(1, 0), a3, voffA);
            PG8_WAIT_V(8); PG8_WAIT_L(0); PG8_BAR; PG8_MMA(1, 0, At, B0); PG8_MMA(1, 1, At, B1); PG8_BAR; PG8_SCHED;
            } else {
            PG8_LDB(B0, 0, 0); PG8_SCHED; PG8_LDA(At, 0, 0); PG8_STAGE(PG8_SA(1, 1), a1 + hstep, voffA);
            PG8_WAIT_L(8); PG8_BAR; PG8_WAIT_L(0); PG8_MMA(0, 0, At, B0); PG8_BAR; PG8_SCHED;
            PG8_LDB(B1, 0, 1); PG8_STAGE(PG8_SB(0, 0), b2, voffB);
            PG8_BAR; PG8_WAIT_L(0); PG8_MMA(0, 1, At, B1); PG8_BAR;
            PG8_LDA(At, 0, 1); PG8_STAGE(PG8_SA(0, 0), a2, voffA);
            PG8_BAR; PG8_WAIT_L(0); PG8_MMA(1, 0, At, B0); PG8_BAR; PG8_SCHED;
            PG8_STAGE(PG8_SB(0, 1), b2 + hstep, voffB);
            PG8_WAIT_V(6); PG8_BAR; PG8_MMA(1, 1, At, B1); PG8_BAR;
            PG8_LDB(B0, 1, 0); PG8_SCHED; PG8_LDA(At, 1, 0); PG8_STAGE(PG8_SA(0, 1), a2 + hstep, voffA);
            PG8_WAIT_L(8); PG8_BAR; PG8_WAIT_L(0); PG8_MMA(0, 0, At, B0); PG8_BAR; PG8_SCHED;
            PG8_LDB(B1, 1, 1); PG8_STAGE(PG8_SB(1, 0), b3, voffB);
            PG8_BAR; PG8_WAIT_L(0); PG8_MMA(0, 1, At, B1); PG8_BAR;
            PG8_LDA(At, 1, 1); PG8_STAGE(PG8_SA(1, 0), a3, voffA);
            PG8_BAR; PG8_WAIT_L(0); PG8_MMA(1, 0, At, B0); PG8_BAR; PG8_SCHED;
            PG8_STAGE(PG8_SB(1, 1), b3 + hstep, voffB);
            PG8_WAIT_V(6); PG8_BAR; PG8_MMA(1, 1, At, B1); PG8_BAR;
            }
        }
        if constexpr (ALIGN_EPI) { if (wr == 0) PG8_BAR; }
        if constexpr (!Epi::AFTER_DRAIN) { E(acc, cur, wr, wc, fr, fq); S.done(cur); }
        if (!has_next) break;
#pragma unroll
        for (int a = 0; a < 2; ++a)
#pragma unroll
            for (int b = 0; b < 2; ++b)
#pragma unroll
                for (int m = 0; m < 4; ++m)
#pragma unroll
                    for (int n = 0; n < 2; ++n) acc[a][b][m][n] = acc_t{};
        cur = nxt; cA = nA; cB = nB; ++ui;
        if constexpr (ALIGN_EPI) { if (wr == 1) PG8_BAR; }
    }
    PG8_WAIT_V(0);
    if constexpr (!ALIGN_EPI) { if (wr == 0) PG8_BAR; }
    PG8_BAR;
    if constexpr (Epi::AFTER_DRAIN) { E.fused(acc, cur, wr, wc, fr, fq, lds, wid, lane); S.done(cur); }
#undef PG8_SA
#undef PG8_SB
#undef PG8_STAGE
#undef PG8_LDA
#undef PG8_LDB
#undef PG8_MMA
#undef PG8_WAIT_V
#undef PG8_WAIT_L
#undef PG8_BAR
#undef PG8_SCHED
}
}

#define XB_TMO      128
#define XB_XCNT(j)  (256  + 64 * (j))
#define XB_XSUB(j)  (1280 + 64 * (j))
#define XB_XGEN(j)  (2304 + 64 * (j))
#define XB_TOP      3328
#define XB_TOPGEN   3392
#define XCD_BAR_WORDS 3456
#define XB_SPIN_CAP (1u << 18)

__device__ __forceinline__ unsigned xb_ld(unsigned* p)              { return __hip_atomic_load(p, __ATOMIC_RELAXED, __HIP_MEMORY_SCOPE_AGENT); }
__device__ __forceinline__ unsigned xb_add(unsigned* p, unsigned v) { return __hip_atomic_fetch_add(p, v, __ATOMIC_RELAXED, __HIP_MEMORY_SCOPE_AGENT); }
__device__ __forceinline__ unsigned xb_xcc_id() { return (unsigned)__builtin_amdgcn_s_getreg((3 << 11) | 20) & 0xFu; }
#define XB_SPIN(cond, bar) do { unsigned _sp = 0; while (cond) { __builtin_amdgcn_s_sleep(1); \
    if ((++_sp & 255u) == 0u) { if (xb_ld(&(bar)[XB_TMO])) break; if (_sp > XB_SPIN_CAP) { atomicAdd(&(bar)[XB_TMO], 1u); break; } } } } while (0)

struct XcdBarrier {
    unsigned* bar; unsigned x;
    volatile LAS unsigned* st;
};

__device__ __forceinline__ XcdBarrier xcd_barrier_post(unsigned* bar, volatile LAS unsigned* st) {
    XcdBarrier b; b.bar = bar; b.x = xb_xcc_id(); b.st = st;
    if (threadIdx.x == 0) st[2] = xb_add(&bar[XB_XCNT(b.x)], 1u);
    return b;
}
__device__ __forceinline__ void xcd_barrier_complete(unsigned* bar, unsigned x, unsigned& nloc, unsigned& nx) {
    const unsigned G = gridDim.x * gridDim.y * gridDim.z;
    unsigned sum, cnt, mine, sp = 0u;
    for (;;) {
        sum = 0u; cnt = 0u; mine = 0u;
#pragma unroll
        for (unsigned j = 0; j < 16; ++j) { const unsigned c = xb_ld(&bar[XB_XCNT(j)]); sum += c; cnt += (c > 0u) ? 1u : 0u; mine = (j == x) ? c : mine; }
        if (sum == G) break;
        __builtin_amdgcn_s_sleep(1);
        if ((++sp & 255u) == 0u) { if (xb_ld(&bar[XB_TMO])) break; if (sp > XB_SPIN_CAP) { atomicAdd(&bar[XB_TMO], 1u); break; } }
    }
    nloc = mine > 0u ? mine : 1u; nx = cnt > 0u ? cnt : 1u;
}

__device__ __forceinline__ void xcd_barrier(const XcdBarrier& b) {
    asm volatile("s_waitcnt vmcnt(0)" ::: "memory");
    __syncthreads();
    if (threadIdx.x == 0) {
        unsigned* bar = b.bar;
        __builtin_amdgcn_s_waitcnt(0);
        unsigned nloc = b.st[0], nx = b.st[1];
        if (nloc == 0u) { xcd_barrier_complete(bar, b.x, nloc, nx); b.st[0] = nloc; b.st[1] = nx; }
        const unsigned old = xb_add(&bar[XB_XSUB(b.x)], 1u);
        const unsigned gen = old / nloc;
        if (old + 1u == (gen + 1u) * nloc) {
            __builtin_amdgcn_fence(__ATOMIC_RELEASE, "agent");
            asm volatile("s_waitcnt vmcnt(0)" ::: "memory");
            const unsigned og = xb_add(&bar[XB_TOP], 1u);
            const unsigned tg = og / nx;
            if (og + 1u == (tg + 1u) * nx) xb_add(&bar[XB_TOPGEN], 1u);
            else XB_SPIN(xb_ld(&bar[XB_TOPGEN]) == tg, bar);
            __builtin_amdgcn_fence(__ATOMIC_ACQUIRE, "agent");
            xb_add(&bar[XB_XGEN(b.x)], 1u);
            asm volatile("s_waitcnt vmcnt(0)" ::: "memory");
        } else {
            XB_SPIN(xb_ld(&bar[XB_XGEN(b.x)]) == gen, bar);
            __builtin_amdgcn_fence(__ATOMIC_ACQUIRE, "agent");
            asm volatile("s_waitcnt vmcnt(0)" ::: "memory");
        }
    }
    __syncthreads();
}


struct Args { const float* in[16]; float* out; unsigned char* ws; int ph_lo, ph_hi; };
constexpr int N_PHASES = 11;

__global__ void __launch_bounds__(NTHREADS, 2) mk_fwd(Args a) {
    extern __shared__ __attribute__((aligned(16))) unsigned char lds[];
    LAS unsigned char* L = (LAS unsigned char*)lds;
    volatile LAS unsigned* MISC = (volatile LAS unsigned*)(L + MISC_OFF);
    unsigned char* ws = a.ws;
    Ctx C;
    C.tid = threadIdx.x; C.lane = C.tid & 63; C.wave = __builtin_amdgcn_readfirstlane(C.tid >> 6);
    C.G = gridDim.x; C.gw = blockIdx.x * NWAVES + C.wave; C.ngw = C.G * NWAVES; C.gt = blockIdx.x * NTHREADS + C.tid; C.ngt = C.G * NTHREADS;
    for (int u = C.tid; u < (LDS_BYTES - LDSCTL_OFF) / 4; u += NTHREADS) ((LAS unsigned*)(L + LDSCTL_OFF))[u] = 0u;
    __syncthreads();
    const int lo = a.ph_lo, hi = a.ph_hi, G = C.G;
    const bool multi = (hi - lo) > 1;
    XcdBarrier bar; bar.bar = (unsigned*)(ws + WS_CTL) + CW_BAR; bar.x = 0; bar.st = nullptr;
    if (multi) bar = xcd_barrier_post((unsigned*)(ws + WS_CTL) + CW_BAR, MISC + 8);
#define IN(k) (lo <= (k) && (k) < hi)
#define SEAM(k) do { if (IN(k) && IN((k) + 1)) xcd_barrier(bar); } while (0)

#define REPS(k) for (int rep_ = 0; rep_ < ((PROBE_DUP == (k)) ? 2 : 1); ++rep_)
#define REPBAR(k) do { if (PROBE_DUP == (k) && rep_ == 0) xcd_barrier(bar); } while (0)
    if (IN(0)) REPS(0) { ph_prep(C, L, a.in, ws); REPBAR(0); }
    SEAM(0);
    if (IN(1)) {
        quant_wrows(C, (const f16*)(ws + WS_WCAT), NCAT, (unsigned*)(ws + WS_WCATQ), (float*)(ws + WS_WCS));
        quant_wrows(C, (const f16*)(ws + WS_WQ), 2048, (unsigned*)(ws + WS_WQQ), (float*)(ws + WS_WQS));
        xcd_barrier(bar);
        pg8::Gemm g{(const f16*)(ws + WS_XH), (const f16*)(ws + WS_WCATQ), T, NCAT, DM / 2}; pg8::StaticOrder S; S.init(T, NCAT, G, (int)blockIdx.x);
        pg8::EpiP1 E{(const float*)(ws + WS_RS1), (const float*)(ws + WS_RSX), (const float*)(ws + WS_WCS), a.in[8], (f16*)(ws + WS_QKVU), (f16*)(ws + WS_GATES), (f16*)(ws + WS_VT)};
        pg8::gemm_phase<pg8::EpiP1, pg8::StaticOrder, true, true>(L, g, S, E);
    }
    SEAM(1);
    if (IN(2)) REPS(2) {
        ph_attn_pool(C, L, (const f16*)(ws + WS_QKVU), (const f16*)(ws + WS_VT), a.in[3], (const f16*)(ws + WS_POOLW), a.in[5], (f16*)(ws + WS_OCAT));
        REPBAR(2);
    }
    if (IN(2) && IN(4)) xcd_barrier(bar);
    if (IN(4)) REPS(4) {
        pg8::Gemm g{(const f16*)(ws + WS_OCAT), (const f16*)(ws + WS_WB), T, DM, DM}; pg8::StaticOrder S; S.init(T, DM, G, (int)blockIdx.x);
        pg8::EpiMerged E{(const f16*)(ws + WS_GATES), (f16*)(ws + WS_MERGED)};
        pg8::gemm_phase<pg8::EpiMerged, pg8::StaticOrder, true, true>(L, g, S, E);
        REPBAR(4);
    }
    SEAM(4);
    if (IN(5)) REPS(5) {
        pg8::Gemm g{(const f16*)(ws + WS_MERGED), (const f16*)(ws + WS_WOUT), T, DM, DM}; pg8::StaticOrder S; S.init(T, DM, G, (int)blockIdx.x);
        pg8::EpiOut E{a.in[0], a.in[10], a.out, (f16*)(ws + WS_X1H), (float*)(ws + WS_SS2)};
        pg8::gemm_phase<pg8::EpiOut, pg8::StaticOrder, true, true>(L, g, S, E);
        REPBAR(5);
    }
    SEAM(5);
    if (IN(6)) {
        ph_h2quant(C, (const f16*)(ws + WS_X1H), (const float*)(ws + WS_SS2), (unsigned*)(ws + WS_H2Q), (float*)(ws + WS_HSC));
        xcd_barrier(bar);
        pg8::Gemm g{(const f16*)(ws + WS_H2Q), (const f16*)(ws + WS_WQQ), T, 2048, DM / 2}; pg8::StaticOrder S; S.init(T, 2048, G, (int)blockIdx.x);
        pg8::EpiQ E{(const float*)(ws + WS_HSC), (const float*)(ws + WS_WQS), (f16*)(ws + WS_QP)};
        pg8::gemm_phase<pg8::EpiQ, pg8::StaticOrder, true, true>(L, g, S, E);
    }
    SEAM(6);
    if (IN(7)) REPS(7) {
        auto side = [&]() {
            quant_rows<false>(C, a.in[13], (unsigned*)(ws + WS_UQ), (float*)(ws + WS_US));
            quant_rows<false>(C, a.in[14], (unsigned*)(ws + WS_VQ), (float*)(ws + WS_VS));
        };
        ph_route(C, L, (const f16*)(ws + WS_QP), (const float*)(ws + WS_SS2), (const f16*)(ws + WS_SUBK), (int*)(ws + WS_EIDX), (float*)(ws + WS_EGATE), side);
        if (!(C.wave & 4)) side();
        REPBAR(7); }
    SEAM(7);
    if (IN(8)) REPS(8) {
        const Slicing SL = get_slicing((const unsigned*)(ws + WS_CTL) + CW_BAR, MISC);
        if (PROBE_DUP == 8 && rep_ == 0) ph_upeer<255>(C, L, SL, (const unsigned*)(ws + WS_H2Q), (const int*)(ws + WS_EIDX), (const unsigned char*)(ws + WS_UQ), (short*)(ws + WS_PDOT));
        else ph_upeer<16383>(C, L, SL, (const unsigned*)(ws + WS_H2Q), (const int*)(ws + WS_EIDX), (const unsigned char*)(ws + WS_UQ), (short*)(ws + WS_PDOT));
        REPBAR(8);
    }
    SEAM(8);
    if (IN(9)) {
        ph_ureduce(C, L, (const short*)(ws + WS_PDOT), (const float*)(ws + WS_HSC), (const int*)(ws + WS_EIDX), (const float*)(ws + WS_US), (const float*)(ws + WS_VS), (const float*)(ws + WS_EGATE),
                   (unsigned*)(ws + WS_WQP), (float*)(ws + WS_WSC));
        xcd_barrier(bar);
        const Slicing SL = get_slicing((const unsigned*)(ws + WS_CTL) + CW_BAR, MISC);
        ph_vpeer<16383>(C, SL, (const int*)(ws + WS_EIDX), (const unsigned*)(ws + WS_WQP), (const float*)(ws + WS_WSC), (const unsigned char*)(ws + WS_VQ), (f16*)(ws + WS_PEER));
    }
    SEAM(9);
    if (IN(10)) { ph_final(C, (const f16*)(ws + WS_PEER), a.out, a.in[15]); }
#undef IN
#undef SEAM
}

#ifndef MK_N_LAUNCHES
#define MK_N_LAUNCHES 1
#endif
extern "C" void kernel_launch(void* const* d_in, const int* in_sizes, int n_in, void* d_out, int out_size, void* d_ws, size_t ws_size, hipStream_t stream) {
    static int grid = 0;
    if (grid == 0) {
        if (n_in != 16 || in_sizes[0] != T * DM || out_size != T * DM || ws_size < WS_END) {
            fprintf(stderr, "kernel_launch: unexpected shapes (n_in %d in0 %d out %d ws %zu)\n", n_in, n_in > 0 ? in_sizes[0] : -1, out_size, ws_size);
            grid = -1; return;
        }
        int dev = 0, cus = 0;
        if (hipGetDevice(&dev) != hipSuccess || hipDeviceGetAttribute(&cus, hipDeviceAttributeMultiprocessorCount, dev) != hipSuccess) { grid = -1; return; }
        if (hipFuncSetAttribute((const void*)mk_fwd, hipFuncAttributeMaxDynamicSharedMemorySize, LDS_BYTES) != hipSuccess) { fprintf(stderr, "kernel_launch: hipFuncSetAttribute failed\n"); grid = -1; return; }
        int per_cu = 0;
        if (hipOccupancyMaxActiveBlocksPerMultiprocessor(&per_cu, (const void*)mk_fwd, NTHREADS, LDS_BYTES) != hipSuccess || per_cu < 1)
            fprintf(stderr, "kernel_launch: occupancy query reports %d workgroups per CU\n", per_cu);
        (void)hipGetLastError();
        grid = cus;
    }
    if (grid < 0) return;
    (void)hipMemsetAsync((char*)d_ws + WS_CTL, 0, CTL_ZERO_BYTES, stream);
    Args a{};
    for (int i = 0; i < 16; ++i) a.in[i] = (const float*)d_in[i];
    a.out = (float*)d_out; a.ws = (unsigned char*)d_ws;
    if (MK_N_LAUNCHES == 1) {
        a.ph_lo = 0; a.ph_hi = N_PHASES;
        hipLaunchKernelGGL(mk_fwd, dim3(grid), dim3(NTHREADS), LDS_BYTES, stream, a);
    } else {
        for (int p = 0; p < N_PHASES; ++p) { a.ph_lo = p; a.ph_hi = p + 1; hipLaunchKernelGGL(mk_fwd, dim3(grid), dim3(NTHREADS), LDS_BYTES, stream, a); }
    }
}
```

```cpp
#include <hip/hip_runtime.h>
#include <cstdint>
#include <cstdio>

typedef _Float16 f16;
typedef _Float16 half8 __attribute__((ext_vector_type(8)));
typedef _Float16 half4 __attribute__((ext_vector_type(4)));
typedef _Float16 half2 __attribute__((ext_vector_type(2)));
typedef float f32x4 __attribute__((ext_vector_type(4)));
typedef float f32x16 __attribute__((ext_vector_type(16)));
typedef unsigned u32x4 __attribute__((ext_vector_type(4)));
typedef int i32x4 __attribute__((ext_vector_type(4)));
#define LAS __attribute__((address_space(3)))
#ifndef PROBE_DIAG
#define PROBE_DIAG (0)
#endif
#ifndef PROBE_DUP
#define PROBE_DUP (-1)
#endif
#define GAS __attribute__((address_space(1)))

constexpr int DM = 1024, BATCH = 16, SEQ = 2048, T = BATCH * SEQ;
constexpr int NQKVU = 1280, NGATE = 2048, NCAT = NQKVU + NGATE;
constexpr int COL_K = 512, COL_V = 640, COL_U = 768;
constexpr int NEXP = 16384, PEER_H = 8, TOPK = 16;
constexpr float EPS = 1e-6f;
constexpr int NWAVES = 8, NTHREADS = NWAVES * 64;

constexpr size_t MiB = 1u << 20;
constexpr size_t WS_CTL = 0, CTL_ZERO_BYTES = 64 * 1024;
constexpr size_t WS_WCAT = 1 * MiB;
constexpr size_t WS_WB = 8 * MiB;
constexpr size_t WS_WOUT = 10 * MiB;
constexpr size_t WS_WQ = 12 * MiB;
constexpr size_t WS_POOLW = 16 * MiB;
constexpr size_t WS_SUBK = 16 * MiB + 512 * 1024;
constexpr size_t WS_RS1 = 17 * MiB;
constexpr size_t WS_EIDX = 18 * MiB;
constexpr size_t WS_EGATE = 34 * MiB;
constexpr size_t WS_WCATQ = 50 * MiB;
constexpr size_t WS_WCS = 54 * MiB;
constexpr size_t WS_WQQ = 56 * MiB;
constexpr size_t WS_WQS = 59 * MiB;
constexpr size_t WS_RSX = 55 * MiB;
constexpr size_t WS_UTAB = 50 * MiB;
constexpr size_t WS_VTAB = 82 * MiB;
constexpr size_t WS_XH = 114 * MiB;
constexpr size_t WS_MERGED = WS_XH;
constexpr size_t WS_QKVU = 178 * MiB;
constexpr size_t WS_X1H = WS_QKVU;
constexpr size_t WS_PEER = WS_MERGED;
constexpr size_t WS_GATES = 258 * MiB;
constexpr size_t WS_QP = WS_GATES;
constexpr size_t WS_OCAT = 386 * MiB;
constexpr size_t WS_UQ = 450 * MiB;
constexpr size_t WS_VQ = 466 * MiB;
constexpr size_t WS_US = 17 * MiB + 256 * 1024, WS_VS = 17 * MiB + 512 * 1024;
constexpr size_t WS_PDOT = WS_GATES;
constexpr size_t WS_H2Q = 404 * MiB;
constexpr size_t WS_HSC = 403 * MiB;
constexpr size_t WS_SSF = 402 * MiB;
constexpr size_t WS_WQP = 386 * MiB;
constexpr size_t WS_WSC = 390 * MiB;
constexpr size_t WS_ACT = 386 * MiB;
constexpr size_t WS_SS2 = 482 * MiB;
constexpr size_t WS_VT = 484 * MiB;
constexpr size_t WS_END = 492 * MiB;
constexpr int CW_BAR = 4096;

constexpr int RING_OFF = 0, RING_BYTES = 131072;
constexpr int LDSCTL_OFF = RING_BYTES, MISC_OFF = LDSCTL_OFF + 320;
constexpr int LDS_BYTES = 147456;

#define LDS_WAIT() asm volatile("s_waitcnt lgkmcnt(0)" ::: "memory")
template <int CTRL> __device__ __forceinline__ float dppf(float x) { return __uint_as_float(__builtin_amdgcn_update_dpp(0u, __float_as_uint(x), CTRL, 0xf, 0xf, false)); }
template <int CTRL> __device__ __forceinline__ int dppi(int x) { return (int)__builtin_amdgcn_update_dpp(0u, (unsigned)x, CTRL, 0xf, 0xf, false); }
__device__ __forceinline__ float bfly32(float a, float b) { auto r = __builtin_amdgcn_permlane32_swap(__float_as_uint(a), __float_as_uint(b), false, false); return __uint_as_float(r[0]) + __uint_as_float(r[1]); }
__device__ __forceinline__ float bfly16(float a, float b) { auto r = __builtin_amdgcn_permlane16_swap(__float_as_uint(a), __float_as_uint(b), false, false); return __uint_as_float(r[0]) + __uint_as_float(r[1]); }
__device__ __forceinline__ int bfly32i(int a, int b) { auto r = __builtin_amdgcn_permlane32_swap((unsigned)a, (unsigned)b, false, false); return (int)(r[0] + r[1]); }
__device__ __forceinline__ int bfly16i(int a, int b) { auto r = __builtin_amdgcn_permlane16_swap((unsigned)a, (unsigned)b, false, false); return (int)(r[0] + r[1]); }
__device__ __forceinline__ float wave_sum(float x) {
    x += dppf<0x121>(x); x += dppf<0x122>(x); x += dppf<0x124>(x); x += dppf<0x128>(x);
    x = bfly16(x, x); return bfly32(x, x);
}
__device__ __forceinline__ int wave_sum_i(int x) {
    x += dppi<0x121>(x); x += dppi<0x122>(x); x += dppi<0x124>(x); x += dppi<0x128>(x);
    x = bfly16i(x, x); return bfly32i(x, x);
}
__device__ __forceinline__ float wave_max(float x) {
    x = fmaxf(x, dppf<0x121>(x)); x = fmaxf(x, dppf<0x122>(x)); x = fmaxf(x, dppf<0x124>(x)); x = fmaxf(x, dppf<0x128>(x));
    { auto r = __builtin_amdgcn_permlane16_swap(__float_as_uint(x), __float_as_uint(x), false, false); x = fmaxf(__uint_as_float(r[0]), __uint_as_float(r[1])); }
    { auto r = __builtin_amdgcn_permlane32_swap(__float_as_uint(x), __float_as_uint(x), false, false); x = fmaxf(__uint_as_float(r[0]), __uint_as_float(r[1])); }
    return x;
}
__device__ __forceinline__ float gelu_exact(float x) { return 0.5f * x * (1.0f + erff(x * 0.70710678118654752f)); }
__device__ __forceinline__ float rs_from_ss(const float* ss, int t) {
    float s = 0.f;
#pragma unroll
    for (int i = 0; i < 16; ++i) s += ss[(size_t)i * T + t];
    return rsqrtf(s * (1.0f / DM) + EPS);
}

struct Ctx {
    int tid, lane, wave;
    int G;
    int gw, ngw;
    int gt, ngt;
};

__device__ __forceinline__ int pack4_i8(float a, float b, float c, float d) {
    const int ia = (int)rintf(a), ib = (int)rintf(b), ic = (int)rintf(c), id = (int)rintf(d);
    return (ia & 0xff) | ((ib & 0xff) << 8) | ((ic & 0xff) << 16) | (id << 24);
}
template <bool OFFS>
__device__ __forceinline__ void quant_rows(const Ctx& C, const float* __restrict__ tab, unsigned* __restrict__ q, float* __restrict__ scale) {
    const int lane = C.lane;
    for (int r = C.gw; r < NEXP; r += C.ngw) {
        const float* row = tab + (size_t)r * DM;
        f32x4 v[4]; float m = 0.f;
#pragma unroll
        for (int j = 0; j < 4; ++j) { v[j] = *(const f32x4*)(row + j * 256 + lane * 4); m = fmaxf(m, fmaxf(fmaxf(fabsf(v[j][0]), fabsf(v[j][1])), fmaxf(fabsf(v[j][2]), fabsf(v[j][3])))); }
        m = wave_max(m);
        const float inv = m > 0.f ? 127.0f / m : 0.f;
#pragma unroll
        for (int j = 0; j < 4; ++j) {
            unsigned w = (unsigned)pack4_i8(v[j][0] * inv, v[j][1] * inv, v[j][2] * inv, v[j][3] * inv);
            if (OFFS) w ^= 0x80808080u;
            { const int dw = j * 64 + lane; q[(size_t)(dw >> 5) * (NEXP * 32) + (size_t)r * 32 + (dw & 31)] = w; }
        }
        if (lane == 0) scale[r] = m * (1.0f / 127.0f);
    }
}

__device__ __forceinline__ void p0_transpose_item(const float* W, int K, int N, f16* WT, int ldo, int koff, LAS float* scr, int item, int lane) {
    const int nblk = N / 32, kb = item / nblk, nb = item % nblk, k0 = 64 * kb, n0 = 32 * nb;
#pragma unroll 8
    for (int i = 0; i < 32; ++i) { const int kk = 2 * i + (lane >> 5); scr[kk * 33 + (lane & 31)] = W[(size_t)(k0 + kk) * N + n0 + (lane & 31)]; }
    LDS_WAIT(); asm volatile("" ::: "memory");
    const int c = lane & 7;
#pragma unroll
    for (int j = 0; j < 4; ++j) { const int n = (lane >> 3) + 8 * j; const LAS float* s = scr + (8 * c) * 33 + n;
        half8 o;
#pragma unroll
        for (int i = 0; i < 8; ++i) o[i] = (f16)s[i * 33];
        *(half8*)(WT + (size_t)(n0 + n) * ldo + koff + k0 + 8 * c) = o; }
    LDS_WAIT(); asm volatile("" ::: "memory");
}
__device__ __forceinline__ void cvt_stream(const Ctx& C, const float* in, f16* out, size_t n4) {
    for (size_t i = (size_t)C.gt; i < n4; i += (size_t)C.ngt) {
        const f32x4 v = ((const f32x4*)in)[i];
        half4 h; h[0] = (f16)v[0]; h[1] = (f16)v[1]; h[2] = (f16)v[2]; h[3] = (f16)v[3];
        ((half4*)out)[i] = h;
    }
}
__device__ __forceinline__ void rowprep(const Ctx& C, const float* x, const float* g, unsigned* xq, float* rsx, float* ss) {
    const int lane = C.lane;
    f32x4 gg[4];
#pragma unroll
    for (int j = 0; j < 4; ++j) gg[j] = *(const f32x4*)(g + j * 256 + lane * 4);
    for (int tb = C.gw * 4; tb < T; tb += C.ngw * 4) {
        f32x4 v[4][4];
#pragma unroll
        for (int u = 0; u < 4; ++u)
#pragma unroll
            for (int j = 0; j < 4; ++j) v[u][j] = *(const f32x4*)(x + (size_t)(tb + u) * DM + j * 256 + lane * 4);
#pragma unroll
        for (int u = 0; u < 4; ++u) {
            float s = 0.f, am = 0.f;
#pragma unroll
            for (int j = 0; j < 4; ++j) {
                const f32x4 w = v[u][j];
                s += w[0] * w[0] + w[1] * w[1] + w[2] * w[2] + w[3] * w[3];
                v[u][j] = w * gg[j];
                am = fmaxf(am, fmaxf(fmaxf(fabsf(v[u][j][0]), fabsf(v[u][j][1])), fmaxf(fabsf(v[u][j][2]), fabsf(v[u][j][3]))));
            }
            s = wave_sum(s); am = wave_max(am);
            const float inv = am > 0.f ? 127.0f / am : 0.f;
#pragma unroll
            for (int j = 0; j < 4; ++j) xq[(size_t)(tb + u) * 256 + j * 64 + lane] = (unsigned)pack4_i8(v[u][j][0] * inv, v[u][j][1] * inv, v[u][j][2] * inv, v[u][j][3] * inv);
            if (lane == 0) { ss[tb + u] = s; rsx[tb + u] = am * (1.0f / 127.0f); }
        }
    }
}
__device__ __forceinline__ void quant_wrows(const Ctx& C, const f16* __restrict__ w, int rows, unsigned* __restrict__ q, float* __restrict__ scale) {
    const int lane = C.lane;
    for (int r = C.gw; r < rows; r += C.ngw) {
        const half8 a = *(const half8*)(w + (size_t)r * DM + 16 * lane), b = *(const half8*)(w + (size_t)r * DM + 16 * lane + 8);
        float m = 0.f;
#pragma unroll
        for (int i = 0; i < 8; ++i) m = fmaxf(m, fmaxf(fabsf((float)a[i]), fabsf((float)b[i])));
        m = wave_max(m);
        const float inv = m > 0.f ? 127.0f / m : 0.f;
        u32x4 o;
        o[0] = (unsigned)pack4_i8((float)a[0] * inv, (float)a[1] * inv, (float)a[2] * inv, (float)a[3] * inv);
        o[1] = (unsigned)pack4_i8((float)a[4] * inv, (float)a[5] * inv, (float)a[6] * inv, (float)a[7] * inv);
        o[2] = (unsigned)pack4_i8((float)b[0] * inv, (float)b[1] * inv, (float)b[2] * inv, (float)b[3] * inv);
        o[3] = (unsigned)pack4_i8((float)b[4] * inv, (float)b[5] * inv, (float)b[6] * inv, (float)b[7] * inv);
        *(u32x4*)(q + (size_t)r * 256 + 4 * lane) = o;
        if (lane == 0) scale[r] = m * (1.0f / 127.0f);
    }
}
__device__ __forceinline__ void ph_prep(const Ctx& C, LAS unsigned char* lds, const float* const* in, unsigned char* ws) {
    LAS float* scr = (LAS float*)(lds + RING_OFF + C.wave * 16384);
    f16* wcat = (f16*)(ws + WS_WCAT); f16* wb = (f16*)(ws + WS_WB); f16* wout = (f16*)(ws + WS_WOUT); f16* wq = (f16*)(ws + WS_WQ); f16* poolw = (f16*)(ws + WS_POOLW);
    constexpr int I_IN = 16 * 40, I_G = 16 * 64, I_B = 8 * 32, I_O = 16 * 32, I_Q = 16 * 64, I_P = 2 * 4;
    constexpr int NITEMS = I_IN + I_G + 2 * I_B + I_O + I_Q + 4 * I_P;
    for (int it = C.gw; it < NITEMS; it += C.ngw) {
        int r = it;
        if (r < I_IN) { p0_transpose_item(in[2], 1024, 1280, wcat, 1024, 0, scr, r, C.lane); continue; } r -= I_IN;
        if (r < I_G) { p0_transpose_item(in[7], 1024, 2048, wcat + (size_t)NQKVU * 1024, 1024, 0, scr, r, C.lane); continue; } r -= I_G;
        if (r < I_B) { p0_transpose_item(in[6], 512, 1024, wb, 1024, 0, scr, r, C.lane); continue; } r -= I_B;
        if (r < I_B) { p0_transpose_item(in[6] + 512 * 1024, 512, 1024, wb, 1024, 512, scr, r, C.lane); continue; } r -= I_B;
        if (r < I_O) { p0_transpose_item(in[9], 1024, 1024, wout, 1024, 0, scr, r, C.lane); continue; } r -= I_O;
        if (r < I_Q) { p0_transpose_item(in[11], 1024, 2048, wq, 1024, 0, scr, r, C.lane); continue; } r -= I_Q;
        { const int g = r / I_P; p0_transpose_item(in[4] + g * 128 * 128, 128, 128, poolw + g * 128 * 128, 128, 0, scr, r % I_P, C.lane); }
    }
    cvt_stream(C, in[12], (f16*)(ws + WS_SUBK), (size_t)8 * 2 * 128 * 128 / 4);
    rowprep(C, in[0], in[1], (unsigned*)(ws + WS_XH), (float*)(ws + WS_RSX), (float*)(ws + WS_RS1));
}

__device__ __forceinline__ void ph_attn_naive(const Ctx& C, const f16* __restrict__ qkvu, const float* __restrict__ sink, f16* __restrict__ ocat) {
    for (int gid = C.gt; gid < T * 8; gid += C.ngt) {
        const int t = gid % T, h = gid / T;
        const int b = t / SEQ, ts = t % SEQ, kh = h >> 2;
        float q[64], o[64];
        const f16* qr = qkvu + (size_t)t * NQKVU + h * 64;
#pragma unroll
        for (int d = 0; d < 64; ++d) { q[d] = (float)qr[d]; o[d] = 0.f; }
        const float slope = exp2f(-(float)(h + 1));
        float m = -1e30f, l = 0.f;
        const int s0 = max(ts - 128, 0), s1 = min(ts + 128, SEQ - 1);
        for (int s = s0; s <= s1; ++s) {
            const f16* kr = qkvu + (size_t)(b * SEQ + s) * NQKVU + COL_K + kh * 64;
            const f16* vr = qkvu + (size_t)(b * SEQ + s) * NQKVU + COL_V + kh * 64;
            float dot = 0.f;
#pragma unroll
            for (int d = 0; d < 64; ++d) dot += q[d] * (float)kr[d];
            const float lg = dot * 0.125f - slope * fabsf((float)(ts - s));
            const float mn = fmaxf(m, lg), al = __expf(m - mn), p = __expf(lg - mn);
            l = l * al + p;
#pragma unroll
            for (int d = 0; d < 64; ++d) o[d] = o[d] * al + p * (float)vr[d];
            m = mn;
        }
        const float sk = sink[h];
        const float mn = fmaxf(m, sk), al = __expf(m - mn);
        l = l * al + __expf(sk - mn);
        const float inv = al / l;
        f16* orow = ocat + (size_t)t * DM + h * 64;
#pragma unroll
        for (int d = 0; d < 64; ++d) orow[d] = (f16)(o[d] * inv);
    }
}

template <int DIAG = 0>
__device__ __forceinline__ void attn_unit(const Ctx& C, int u, LAS unsigned char* lds, const f16* __restrict__ qkvu, const f16* __restrict__ vT, const float* __restrict__ sink, f16* __restrict__ ocat) {
    const int lane = C.lane, r32 = lane & 31, hh = lane >> 5;
    const int krow = (r32 & 19) | ((r32 & 4) << 1) | ((r32 & 8) >> 1);
    constexpr float L2E = 1.4426950408889634f;
    {
        const int qs = u & 63, h = (u >> 6) & 7, b = u >> 9, kh = h >> 2;
        const int tq = qs * 32 + r32;
        const float slope2 = exp2f(-(float)(h + 1)) * L2E, sink2 = sink[h] * L2E;
        const f16* qrow = qkvu + (size_t)(b * SEQ + tq) * NQKVU + h * 64 + 8 * hh;
        half8 bq[4];
#pragma unroll
        for (int ks = 0; ks < 4; ++ks) bq[ks] = *(const half8*)(qrow + 16 * ks);
        f32x16 o0, o1;
#pragma unroll
        for (int r = 0; r < 16; ++r) { o0[r] = 0.f; o1[r] = 0.f; }
        float m = -1e30f, l = 0.f;
        const int kb_lo = max(qs - 4, 0), kb_hi = min(qs + 4, 63);
        LAS unsigned char* kst = lds + 65536 + C.wave * 8192; LAS unsigned char* vst = kst + 4096;
        const int krw = lane >> 3, kch = lane & 7, vrw = lane >> 2, vch = lane & 3;
        const f16* kg = qkvu + (size_t)(b * SEQ + krw) * NQKVU + COL_K + kh * 64 + kch * 8;
        const f16* vg = vT + (size_t)((b * 2 + kh) * 64 + vrw) * SEQ + vch * 8;
        half8 gk[4], gv[4];
#pragma unroll
        for (int i = 0; i < 4; ++i) { gk[i] = *(const half8*)(kg + (size_t)(kb_lo * 32 + 8 * i) * NQKVU); gv[i] = *(const half8*)(vg + (size_t)(16 * i) * SEQ + kb_lo * 32); }
#pragma unroll 1
        for (int kb = kb_lo; kb <= kb_hi; ++kb) {
#pragma unroll
            for (int i = 0; i < 4; ++i) {
                const int kr = krw + 8 * i; *(LAS half8*)(kst + kr * 128 + ((kch ^ (kr & 7)) << 4)) = gk[i];
                const int vr = vrw + 16 * i; *(LAS half8*)(vst + vr * 64 + ((vch ^ ((vr >> 2) & 3)) << 4)) = gv[i];
            }
            LDS_WAIT();
            half8 kf[4], va[2][2];
#pragma unroll
            for (int ks = 0; ks < 4; ++ks) kf[ks] = *(const LAS half8*)(kst + krow * 128 + (((2 * ks + hh) ^ (krow & 7)) << 4));
#pragma unroll
            for (int db = 0; db < 2; ++db)
#pragma unroll
                for (int st = 0; st < 2; ++st) { const int d = db * 32 + r32; va[db][st] = *(const LAS half8*)(vst + d * 64 + (((2 * st + hh) ^ ((d >> 2) & 3)) << 4)); }
            LDS_WAIT();
            const int kn = (DIAG == 2) ? kb_lo : (kb < kb_hi ? kb + 1 : kb);
#pragma unroll
            for (int i = 0; i < 4; ++i) { gk[i] = *(const half8*)(kg + (size_t)(kn * 32 + 8 * i) * NQKVU); gv[i] = *(const half8*)(vg + (size_t)(16 * i) * SEQ + kn * 32); }
            f32x16 s;
#pragma unroll
            for (int r = 0; r < 16; ++r) s[r] = 0.f;
#pragma unroll
            for (int ks = 0; ks < 4; ++ks) s = __builtin_amdgcn_mfma_f32_32x32x16_f16(kf[ks], bq[ks], s, 0, 0, 0);
            float bmax = -1e30f; bool ok[16];
#pragma unroll
            for (int r = 0; r < 16; ++r) {
                const int tk = kb * 32 + 16 * (r >> 3) + 8 * hh + (r & 7);
                const int dist = abs(tq - tk);
                ok[r] = dist <= 128;
                s[r] = ok[r] ? s[r] * (0.125f * L2E) - slope2 * (float)dist : -1e30f;
                bmax = fmaxf(bmax, s[r]);
            }
            bmax = fmaxf(bmax, __shfl_xor(bmax, 32));
            const float mn = fmaxf(m, bmax), al = exp2f(m - mn);
            m = mn;
            float ps = 0.f; half8 pb[2];
#pragma unroll
            for (int r = 0; r < 16; ++r) { const float p = ok[r] ? (DIAG == 1 ? (s[r] - mn) : exp2f(s[r] - mn)) : 0.f; ps += p; pb[r >> 3][r & 7] = (f16)p; }
            l = l * al + ps;
#pragma unroll
            for (int r = 0; r < 16; ++r) { o0[r] *= al; o1[r] *= al; }
#pragma unroll
            for (int st = 0; st < 2; ++st) { o0 = __builtin_amdgcn_mfma_f32_32x32x16_f16(va[0][st], pb[st], o0, 0, 0, 0); o1 = __builtin_amdgcn_mfma_f32_32x32x16_f16(va[1][st], pb[st], o1, 0, 0, 0); }
        }
        l += __shfl_xor(l, 32);
        const float mf = fmaxf(m, sink2), al = exp2f(m - mf);
        const float sc = al / (l * al + exp2f(sink2 - mf));
        f16* orow = ocat + (size_t)(b * SEQ + tq) * DM + h * 64 + 4 * hh;
#pragma unroll
        for (int g = 0; g < 4; ++g) {
            half4 a, c;
#pragma unroll
            for (int i = 0; i < 4; ++i) { a[i] = (f16)(o0[4 * g + i] * sc); c[i] = (f16)(o1[4 * g + i] * sc); }
            *(half4*)(orow + 8 * g) = a; *(half4*)(orow + 32 + 8 * g) = c;
        }
    }
}

__device__ __forceinline__ void attn_unit2(const Ctx& C, int u, LAS unsigned char* lds, const f16* __restrict__ qkvu, const f16* __restrict__ vT, const float* __restrict__ sink, f16* __restrict__ ocat) {
    const int lane = C.lane, r32 = lane & 31, hh = lane >> 5;
    const int krow = (r32 & 19) | ((r32 & 4) << 1) | ((r32 & 8) >> 1);
    constexpr float L2E = 1.4426950408889634f;
    const int qp = u & 31, h = (u >> 5) & 7, b = u >> 8, kh = h >> 2;
    const float slope2 = exp2f(-(float)(h + 1)) * L2E, sink2 = sink[h] * L2E;
    const float bbase = slope2 * (float)(r32 - 8 * hh);
    constexpr float THR = 6.0f;
    LAS unsigned char* qst = lds + 65536 + C.wave * 8192 + lane * 16;
    f32x16 o0[2], o1[2]; float m[2], l[2]; int tq[2];
#pragma unroll
    for (int j = 0; j < 2; ++j) {
        tq[j] = (2 * qp + j) * 32 + r32;
        const f16* qrow = qkvu + (size_t)(b * SEQ + tq[j]) * NQKVU + h * 64 + 8 * hh;
#pragma unroll
        for (int ks = 0; ks < 4; ++ks) *(LAS half8*)(qst + (j * 4 + ks) * 1024) = *(const half8*)(qrow + 16 * ks);
#pragma unroll
        for (int r = 0; r < 16; ++r) { o0[j][r] = 0.f; o1[j][r] = 0.f; }
        m[j] = -1e30f; l[j] = 0.f;
    }
    const int kb_lo = max(2 * qp - 4, 0), kb_hi = min(2 * qp + 5, 63);
    LAS unsigned char* kst = lds + C.wave * 8192;
    const int krw = lane >> 3, kch = lane & 7;
    const f16* kg = qkvu + (size_t)(b * SEQ + krw) * NQKVU + COL_K + kh * 64 + kch * 8;
    const f16* vbase = vT + (size_t)((b * 2 + kh) * 64 + r32) * SEQ + 8 * hh;
    half8 gk[4];
#pragma unroll
    for (int i = 0; i < 4; ++i) gk[i] = *(const half8*)(kg + (size_t)(kb_lo * 32 + 8 * i) * NQKVU);
#pragma unroll 1
    for (int kb = kb_lo; kb <= kb_hi; ++kb) {
        half8 kf[4], va[2][2];
#pragma unroll
        for (int db = 0; db < 2; ++db)
#pragma unroll
            for (int st = 0; st < 2; ++st) va[db][st] = *(const half8*)(vbase + (size_t)(db * 32) * SEQ + kb * 32 + 16 * st);
#pragma unroll
        for (int i = 0; i < 4; ++i) { const int kr = krw + 8 * i; *(LAS half8*)(kst + kr * 128 + ((kch ^ (kr & 7)) << 4)) = gk[i]; }
        LDS_WAIT();
#pragma unroll
        for (int ks = 0; ks < 4; ++ks) kf[ks] = *(const LAS half8*)(kst + krow * 128 + (((2 * ks + hh) ^ (krow & 7)) << 4));
        LDS_WAIT();
        const int kn = kb < kb_hi ? kb + 1 : kb;
#pragma unroll
        for (int i = 0; i < 4; ++i) gk[i] = *(const half8*)(kg + (size_t)(kn * 32 + 8 * i) * NQKVU);
#pragma unroll
        for (int j = 0; j < 2; ++j) {
            if (abs(kb - (2 * qp + j)) > 4) continue;
            const int D = (2 * qp + j) - kb;
            f32x16 s;
#pragma unroll
            for (int r = 0; r < 16; ++r) s[r] = 0.f;
#pragma unroll
            for (int ks = 0; ks < 4; ++ks) s = __builtin_amdgcn_mfma_f32_32x32x16_f16(kf[ks], *(const volatile LAS half8*)(qst + (j * 4 + ks) * 1024), s, 0, 0, 0);
            const float B = slope2 * 32.0f * (float)abs(D);
            float bm = -1e30f;
            if (D != 0) {
                const float ssl = D > 0 ? slope2 : -slope2, sb = D > 0 ? -bbase : bbase;
#pragma unroll
                for (int r = 0; r < 16; ++r) { const float bias = fmaf(ssl, (float)(16 * (r >> 3) + (r & 7)), sb); s[r] = fmaf(s[r], 0.125f * L2E, bias);
                    if (abs(D) == 4) s[r] = bias < -0.5f * slope2 ? -1e30f : s[r]; }
            } else {
#pragma unroll
                for (int r = 0; r < 16; ++r) s[r] = fmaf(s[r], 0.125f * L2E, -fabsf(fmaf(-slope2, (float)(16 * (r >> 3) + (r & 7)), bbase)));
            }
#pragma unroll
            for (int r = 0; r < 16; ++r) bm = fmaxf(bm, s[r]);
            bm = fmaxf(bm, __shfl_xor(bm, 32)) - B;
            {
                const float mn = (bm > m[j] + THR) ? bm : m[j], al = __builtin_amdgcn_exp2f(m[j] - mn);
                m[j] = mn; l[j] *= al;
#pragma unroll
                for (int r = 0; r < 16; ++r) { o0[j][r] *= al; o1[j][r] *= al; }
            }
            const float mb = m[j] + B;
            float ps = 0.f; half8 pb[2];
#pragma unroll
            for (int r = 0; r < 16; ++r) { const float pv = __builtin_amdgcn_exp2f(s[r] - mb); ps += pv; pb[r >> 3][r & 7] = (f16)pv; }
            l[j] += ps;
#pragma unroll
            for (int st = 0; st < 2; ++st) { o0[j] = __builtin_amdgcn_mfma_f32_32x32x16_f16(va[0][st], pb[st], o0[j], 0, 0, 0); o1[j] = __builtin_amdgcn_mfma_f32_32x32x16_f16(va[1][st], pb[st], o1[j], 0, 0, 0); }
            __builtin_amdgcn_sched_barrier(0);
        }
    }
#pragma unroll
    for (int j = 0; j < 2; ++j) {
        const float lt = l[j] + __shfl_xor(l[j], 32);
        const float mf = fmaxf(m[j], sink2), al = __builtin_amdgcn_exp2f(m[j] - mf);
        const float sc = al / (lt * al + __builtin_amdgcn_exp2f(sink2 - mf));
        LDS_WAIT();
#pragma unroll
        for (int g = 0; g < 4; ++g) {
            half4 a, c;
#pragma unroll
            for (int i = 0; i < 4; ++i) { a[i] = (f16)(o0[j][4 * g + i] * sc); c[i] = (f16)(o1[j][4 * g + i] * sc); }
            *(LAS half4*)(kst + r32 * 128 + ((g ^ (r32 & 7)) << 4) + 8 * hh) = a;
            *(LAS half4*)(kst + r32 * 128 + (((4 + g) ^ (r32 & 7)) << 4) + 8 * hh) = c;
        }
        LDS_WAIT();
#pragma unroll
        for (int i = 0; i < 4; ++i) {
            const int row = (lane >> 3) + 8 * i, ch = lane & 7;
            const half8 v = *(const LAS half8*)(kst + row * 128 + ((ch ^ (row & 7)) << 4));
            *(half8*)(ocat + (size_t)(b * SEQ + (2 * qp + j) * 32 + row) * DM + h * 64 + ch * 8) = v;
        }
    }
}

__device__ __forceinline__ void ph_pool_naive(const Ctx& C, const f16* __restrict__ qkvu, f16* __restrict__ mixed) {
    for (size_t gid = (size_t)C.gt; gid < (size_t)T * 512; gid += (size_t)C.ngt) {
        const int c = (int)(gid & 511), t = (int)(gid >> 9);
        const int b = t / SEQ, ts = t % SEQ, g = c >> 7, w = 2 << g;
        const int lo = max(ts - w / 2, 0), hi = min(ts + w / 2, SEQ);
        float s = 0.f;
        for (int i = lo; i < hi; ++i) s += (float)qkvu[(size_t)(b * SEQ + i) * NQKVU + COL_U + c];
        const float mean = s / (float)(hi - lo);
        mixed[(size_t)t * 512 + c] = (f16)(mean - (float)qkvu[(size_t)t * NQKVU + COL_U + c]);
    }
}
__device__ __forceinline__ void ph_poolmm_naive(const Ctx& C, const f16* __restrict__ mixed, const f16* __restrict__ poolw_t, const float* __restrict__ pscale, f16* __restrict__ ocat) {
    for (size_t gid = (size_t)C.gt; gid < (size_t)T * 512; gid += (size_t)C.ngt) {
        const int n = (int)(gid & 511), t = (int)(gid >> 9), g = n >> 7, d = n & 127;
        const f16* mr = mixed + (size_t)t * 512 + g * 128;
        const f16* wr = poolw_t + (size_t)(g * 128 + d) * 128;
        float acc = 0.f;
        for (int c = 0; c < 128; ++c) acc += (float)mr[c] * (float)wr[c];
        ocat[(size_t)t * DM + 512 + n] = (f16)(acc * pscale[n]);
    }
}

template <int HW>
__device__ __forceinline__ void pool_step1(const f16* __restrict__ qkvu, LAS unsigned char* tile, int t0, int g, int lane) {
    const int c2 = lane, b = t0 >> 11, sf = t0 & (SEQ - 1);
    const f16* ub = qkvu + (size_t)(b * SEQ) * NQKVU + COL_U + g * 128 + 2 * c2;
    constexpr int NR = 32 + 2 * HW - 1;
    half2 v[NR];
#pragma unroll
    for (int i = 0; i < NR; ++i) { const int s = sf - HW + i; half2 z; z[0] = (f16)0.f; z[1] = (f16)0.f; v[i] = z; if (s >= 0 && s < SEQ) v[i] = *(const half2*)(ub + (size_t)s * NQKVU); }
    float s0 = 0.f, s1 = 0.f;
#pragma unroll
    for (int i = 0; i < 2 * HW - 1; ++i) { s0 += (float)v[i][0]; s1 += (float)v[i][1]; }
#pragma unroll
    for (int j = 0; j < 32; ++j) {
        s0 += (float)v[j + 2 * HW - 1][0]; s1 += (float)v[j + 2 * HW - 1][1];
        const int s = sf + j, lo = max(s - HW, 0), hi = min(s + HW, SEQ);
        const float inv = 1.0f / (float)(hi - lo);
        half2 mx; mx[0] = (f16)(s0 * inv - (float)v[j + HW][0]); mx[1] = (f16)(s1 * inv - (float)v[j + HW][1]);
        *(LAS half2*)(tile + j * 256 + (((c2 >> 2) ^ (j & 15)) << 4) + ((c2 & 3) << 2)) = mx;
        s0 -= (float)v[j][0]; s1 -= (float)v[j][1];
    }
}
__device__ __forceinline__ void pool_unit(const Ctx& C, int u, LAS unsigned char* lds, const f16* __restrict__ qkvu, const f16* __restrict__ poolw_t, const float* __restrict__ pscale, f16* __restrict__ ocat) {
    const int lane = C.lane, r32 = lane & 31, hh = lane >> 5;
    LAS unsigned char* tile = lds + C.wave * 8192;
    const int g = u & 3, t0 = (u >> 2) * 32;
    switch (g) { case 0: pool_step1<1>(qkvu, tile, t0, g, lane); break; case 1: pool_step1<2>(qkvu, tile, t0, g, lane); break;
                 case 2: pool_step1<4>(qkvu, tile, t0, g, lane); break; default: pool_step1<8>(qkvu, tile, t0, g, lane); break; }
    LDS_WAIT();
    f32x16 acc[4];
#pragma unroll
    for (int db = 0; db < 4; ++db)
#pragma unroll
        for (int r = 0; r < 16; ++r) acc[db][r] = 0.f;
    const f16* wr = poolw_t + (size_t)(g * 128 + r32) * 128 + 8 * hh;
#pragma unroll
    for (int ks = 0; ks < 8; ++ks) {
        const half8 bm = *(const LAS half8*)(tile + r32 * 256 + (((2 * ks + hh) ^ (r32 & 15)) << 4));
#pragma unroll
        for (int db = 0; db < 4; ++db) { const half8 a = *(const half8*)(wr + (size_t)(db * 32) * 128 + 16 * ks); acc[db] = __builtin_amdgcn_mfma_f32_32x32x16_f16(a, bm, acc[db], 0, 0, 0); }
    }
    LDS_WAIT();
    f16* orow = ocat + (size_t)(t0 + r32) * DM + 512 + g * 128 + 4 * hh;
    const float* ps = pscale + g * 128 + 4 * hh;
#pragma unroll
    for (int db = 0; db < 4; ++db)
#pragma unroll
        for (int q = 0; q < 4; ++q) {
            const f32x4 pv = *(const f32x4*)(ps + db * 32 + 8 * q);
            half4 x0;
#pragma unroll
            for (int i = 0; i < 4; ++i) x0[i] = (f16)(acc[db][4 * q + i] * pv[i]);
            *(half4*)(orow + db * 32 + 8 * q) = x0;
        }
}
__device__ __forceinline__ void ph_attn_pool(const Ctx& C, LAS unsigned char* lds, const f16* __restrict__ qkvu, const f16* __restrict__ vT, const float* __restrict__ sink,
                                             const f16* __restrict__ poolw_t, const float* __restrict__ pscale, f16* __restrict__ ocat) {
    const int vwg = (C.G % 8 == 0) ? (int)(blockIdx.x % 8) * (C.G / 8) + (int)(blockIdx.x / 8) : (int)blockIdx.x;
    const bool pool_first = (C.wave & 4) != 0;
    for (int i = 0, m = vwg * NWAVES + C.wave; m < (T / 32) * 4; ++i) {
        if (((i & 1) == 0) == pool_first) pool_unit(C, m, lds, qkvu, poolw_t, pscale, ocat);
        else attn_unit2(C, m, lds, qkvu, vT, sink, ocat);
        if (i & 1) m += C.ngw;
    }
}

#define INS(LV, LI, v_, i_) do { float cv_ = (v_); int ci_ = (i_); \
    _Pragma("unroll") for (int z_ = 0; z_ < 16; ++z_) { const bool gt_ = cv_ > LV[z_]; const float tv_ = gt_ ? LV[z_] : cv_; const int ti_ = gt_ ? LI[z_] : ci_; \
        LV[z_] = gt_ ? cv_ : LV[z_]; LI[z_] = gt_ ? ci_ : LI[z_]; cv_ = tv_; ci_ = ti_; } } while (0)
__device__ __forceinline__ void ph_route_naive(const Ctx& C, const f16* __restrict__ qp, const float* __restrict__ ss2, const f16* __restrict__ subk, int* __restrict__ eidx, float* __restrict__ egate) {
    for (int gid = C.gt; gid < T * 8; gid += C.ngt) {
        const int t = gid % T, h = gid / T;
        const float rs2 = rs_from_ss(ss2, t);
        float av[16], bv[16]; int ai[16], bi[16];
#pragma unroll
        for (int z = 0; z < 16; ++z) { av[z] = -3e38f; bv[z] = -3e38f; ai[z] = 0; bi[z] = 0; }
        for (int p = 0; p < 2; ++p) {
            const f16* qr = qp + (size_t)t * 2048 + h * 256 + p * 128;
            for (int n = 0; n < 128; ++n) {
                const f16* kr = subk + ((size_t)((h * 2 + p) * 128 + n)) * 128;
                float dot = 0.f;
                for (int c = 0; c < 128; ++c) dot += (float)qr[c] * (float)kr[c];
                dot *= rs2;
                if (p == 0) INS(av, ai, dot, n); else INS(bv, bi, dot, n);
            }
        }
        float cv[16]; int ci[16];
#pragma unroll
        for (int z = 0; z < 16; ++z) { cv[z] = -3e38f; ci[z] = 0; }
#pragma unroll
        for (int i = 0; i < 16; ++i)
#pragma unroll
            for (int j = 0; j < 16; ++j)
                if ((i + 1) * (j + 1) <= 16) INS(cv, ci, av[i] + bv[j], ai[i] * 128 + bi[j]);
        float sum = 0.f, e[16];
#pragma unroll
        for (int z = 0; z < 16; ++z) { e[z] = __expf(cv[z] - cv[0]); sum += e[z]; }
        const float inv = 1.0f / sum;
#pragma unroll
        for (int z = 0; z < 16; ++z) { eidx[(size_t)t * 128 + h * 16 + z] = ci[z]; egate[(size_t)t * 128 + h * 16 + z] = e[z] * inv; }
    }
}

__device__ __forceinline__ int mono_i(float f) { const int b = __float_as_int(f); return b ^ ((b >> 31) & 0x7fffffff); }
__device__ __forceinline__ float unmono_f(int m) { return __int_as_float(m ^ ((m >> 31) & 0x7fffffff)); }
#define INS16(Lst, x_) do { int xv_ = (x_); _Pragma("unroll") for (int z_ = 0; z_ < 16; ++z_) { const int hi_ = max(Lst[z_], xv_); xv_ = min(Lst[z_], xv_); Lst[z_] = hi_; } } while (0)
__device__ __forceinline__ void merge_pair16(int (&Lst)[16]) {
    int P[16];
#pragma unroll
    for (int z = 0; z < 16; ++z) P[z] = __shfl_xor(Lst[z], 32);
#pragma unroll
    for (int z = 0; z < 16; ++z) Lst[z] = max(Lst[z], P[15 - z]);
#pragma unroll
    for (int s = 8; s >= 1; s >>= 1)
#pragma unroll
        for (int i = 0; i < 16; ++i) if ((i & s) == 0) { const int hi = max(Lst[i], Lst[i + s]), lo = min(Lst[i], Lst[i + s]); Lst[i] = hi; Lst[i + s] = lo; }
}
__device__ __forceinline__ void bitonic_sort16_desc(int (&K)[16]) {
#pragma unroll
    for (int k = 2; k <= 16; k <<= 1)
#pragma unroll
        for (int j = k >> 1; j > 0; j >>= 1)
#pragma unroll
            for (int i = 0; i < 16; ++i) { const int l = i ^ j; if (l > i) { const int a = K[i], b = K[l], hi = max(a, b), lo = min(a, b); const bool desc = (i & k) == 0; K[i] = desc ? hi : lo; K[l] = desc ? lo : hi; } }
}
__device__ __forceinline__ void bitonic_merge16_desc(int (&K)[16]) {
#pragma unroll
    for (int s = 8; s >= 1; s >>= 1)
#pragma unroll
        for (int i = 0; i < 16; ++i) if ((i & s) == 0) { const int hi = max(K[i], K[i + s]), lo = min(K[i], K[i + s]); K[i] = hi; K[i + s] = lo; }
}
template <class Side>
__device__ __forceinline__ void ph_route(const Ctx& C, LAS unsigned char* lds, const f16* __restrict__ qp, const float* __restrict__ ss2, const f16* __restrict__ subk,
                                         int* __restrict__ eidx, float* __restrict__ egate, const Side& side_job) {
    const int lane = C.lane, r32 = lane & 31, hh = lane >> 5;
    LAS unsigned char* tab = lds + 65536 + C.wave * 4096 + lane * 36;
    const int GH = C.G < 8 ? C.G : 8;
  for (int h = blockIdx.x % GH; h < 8; h += GH) {
    const int rank_h = blockIdx.x / GH, nwg_h = (C.G - (blockIdx.x % GH) + GH - 1) / GH;
    __syncthreads();
    for (int i = C.tid; i < 2 * 128 * 16; i += NTHREADS) {
        const int row = i >> 4, ch = i & 15;
        *(LAS half8*)(lds + row * 256 + ((ch ^ (row & 15)) << 4)) = *(const half8*)(subk + (size_t)(h * 256 + row) * 128 + ch * 8);
    }
    __syncthreads();
    if (h == (int)(blockIdx.x % GH) && (C.wave & 4)) side_job();
    for (int tb = rank_h * NWAVES + C.wave; tb < T / 32; tb += nwg_h * NWAVES) {
        const int t0 = tb * 32, t = t0 + r32;
        int top[2][16];
#pragma unroll
        for (int p = 0; p < 2; ++p) {
            const f16* qrow = qp + (size_t)t * 2048 + h * 256 + p * 128 + 8 * hh;
            const LAS unsigned char* kl = lds + (p * 128 + r32) * 256;
            half8 bq[8];
#pragma unroll
            for (int ks = 0; ks < 8; ++ks) bq[ks] = *(const half8*)(qrow + 16 * ks);
            int Lst[16];
#pragma unroll
            for (int z = 0; z < 16; ++z) Lst[z] = (int)0x80000000;
#pragma unroll 1
            for (int nb = 0; nb < 4; ++nb) {
                f32x16 acc = {0.f, 0.f, 0.f, 0.f, 0.f, 0.f, 0.f, 0.f, 0.f, 0.f, 0.f, 0.f, 0.f, 0.f, 0.f, 0.f};
#pragma unroll
                for (int ks = 0; ks < 8; ++ks) {
                    const half8 ak = *(const LAS half8*)(kl + nb * 32 * 256 + (((2 * ks + hh) ^ (r32 & 15)) << 4));
                    acc = __builtin_amdgcn_mfma_f32_32x32x16_f16(ak, bq[ks], acc, 0, 0, 0);
                }
                int K[16];
#pragma unroll
                for (int r = 0; r < 16; ++r) { const int n = nb * 32 + (r & 3) + 8 * (r >> 2) + 4 * hh; K[r] = (mono_i(acc[r]) & ~127) | (127 - n); }
                bitonic_sort16_desc(K);
#pragma unroll
                for (int z = 0; z < 16; ++z) Lst[z] = max(Lst[z], K[15 - z]);
                bitonic_merge16_desc(Lst);
            }
            merge_pair16(Lst);
#pragma unroll
            for (int z = 0; z < 16; ++z) top[p][z] = Lst[z];
        }
        float va[16], vb[16];
#pragma unroll
        for (int z = 0; z < 16; ++z) { va[z] = unmono_f(top[0][z] & ~127); vb[z] = unmono_f(top[1][z] & ~127);
            tab[z] = (unsigned char)(127 - (top[0][z] & 127)); tab[16 + z] = (unsigned char)(127 - (top[1][z] & 127)); }
        int Cl[16];
        { const float a01 = hh ? va[1] : va[0];
#pragma unroll
          for (int j = 0; j < 16; ++j) { const int key = (mono_i(a01 + vb[j]) & ~255) | (255 - (hh * 16 + j)); Cl[j] = (hh && j >= 8) ? (int)0x80000000 : key; } }
#pragma unroll
        for (int i = 2; i < 16; i += 2) {
            const float ai = hh ? va[i + 1] : va[i];
#pragma unroll
            for (int j = 0; j < 16; ++j)
                if ((i + 1) * (j + 1) <= 16) {
                    int key = (mono_i(ai + vb[j]) & ~255) | (255 - ((i + hh) * 16 + j));
                    if ((i + 2) * (j + 1) > 16) key = hh ? (int)0x80000000 : key;
                    INS16(Cl, key);
                }
        }
        merge_pair16(Cl);
        float e[16], sum = 0.f; const float mx = unmono_f(Cl[0] & ~255);
#pragma unroll
        for (int z = 0; z < 16; ++z) { e[z] = __expf(unmono_f(Cl[z] & ~255) - mx); sum += e[z]; }
        const float inv = 1.0f / sum;
        LDS_WAIT();
        int* ei = eidx + (size_t)t * 128 + h * 16 + 8 * hh; float* eg = egate + (size_t)t * 128 + h * 16 + 8 * hh;
#pragma unroll
        for (int z = 0; z < 16; ++z) {
            if ((z >> 3) == hh) { const int code = 255 - (Cl[z] & 255); const int ia = tab[code >> 4], ib = tab[16 + (code & 15)];
                ei[z & 7] = ia * 128 + ib; eg[z & 7] = e[z] * inv; }
        }
        LDS_WAIT();
    }
  }
}

struct Slicing { int m, pi, nloc, rank; };
__device__ __forceinline__ Slicing get_slicing(const unsigned* bar, volatile LAS unsigned* misc) {
    Slicing S; const unsigned x = (unsigned)__builtin_amdgcn_s_getreg((3 << 11) | 20) & 0xFu;
    int m = 0, pi = 0, nloc = 1;
    for (unsigned j = 0; j < 16; ++j) { const unsigned c = __hip_atomic_load(&bar[256 + 64 * j], __ATOMIC_RELAXED, __HIP_MEMORY_SCOPE_AGENT); if (c > 0u) { if (j < x) ++pi; ++m; } if (j == x) nloc = (int)c; }
    S.m = m > 0 ? m : 1; S.pi = pi; S.nloc = nloc > 0 ? nloc : 1; S.rank = (int)misc[10];
    return S;
}
__device__ __forceinline__ float gelu_fast(float v) {
    const float av = fabsf(v), t = __builtin_amdgcn_rcpf(av * 0.2316418882f + 1.0f);
    float q = t * 0.5307027145f + (-0.7265760135f); q = q * t + 0.7107068705f; q = q * t + (-0.142248368f); q = q * t + 0.127414796f; q = q * t;
    const float m = v * (q * __builtin_amdgcn_exp2f((v * v) * (-0.72134752044f)));
    return v < 0.f ? m : v - m;
}
__device__ __forceinline__ void ph_h2quant(const Ctx& C, const f16* __restrict__ x1h, const float* __restrict__ g2, const float* __restrict__ ss2, unsigned* __restrict__ h2q, float* __restrict__ hsc) {
    const int lane = C.lane;
    f32x4 gv[4];
#pragma unroll
    for (int j = 0; j < 4; ++j) gv[j] = *(const f32x4*)(g2 + 16 * lane + 4 * j);
    for (int t = C.gw; t < T; t += C.ngw) {
        const half8 h0 = *(const half8*)(x1h + (size_t)t * DM + 16 * lane), h1 = *(const half8*)(x1h + (size_t)t * DM + 16 * lane + 8);
        float f[16]; float hm = 0.f;
#pragma unroll
        for (int i = 0; i < 8; ++i) { f[i] = (float)h0[i] * gv[i >> 2][i & 3]; f[8 + i] = (float)h1[i] * gv[2 + (i >> 2)][i & 3]; hm = fmaxf(hm, fmaxf(fabsf(f[i]), fabsf(f[8 + i]))); }
        hm = wave_max(hm);
        const float inv = hm > 0.f ? 127.0f / hm : 0.f;
        u32x4 w;
#pragma unroll
        for (int j = 0; j < 4; ++j) w[j] = (unsigned)pack4_i8(f[4 * j] * inv, f[4 * j + 1] * inv, f[4 * j + 2] * inv, f[4 * j + 3] * inv);
        *(u32x4*)(h2q + (size_t)t * 256 + 4 * lane) = w;
        if (lane == 0) hsc[t] = hm * (1.0f / 127.0f) * rs_from_ss(ss2, t);
    }
}
__device__ __forceinline__ __amdgpu_buffer_rsrc_t slice_rsrc(const unsigned char* base) {
    const unsigned long long b = (unsigned long long)base;
    const unsigned lo = __builtin_amdgcn_readfirstlane((unsigned)b), hi = __builtin_amdgcn_readfirstlane((unsigned)(b >> 32));
    return __builtin_amdgcn_make_buffer_rsrc((void*)(((unsigned long long)hi << 32) | lo), 0, NEXP * 128, 0x00020000);
}
template <int EMASK>
__device__ __forceinline__ void ph_upeer(const Ctx& C, LAS unsigned char* lds, const Slicing SL, const unsigned* __restrict__ h2q, const int* __restrict__ eidx,
                                         const unsigned char* __restrict__ uq, short* __restrict__ pdot) {
    const int lane = C.lane, grp = lane >> 3, c8 = lane & 7;
    const int wv = SL.rank * NWAVES + C.wave, nwv = SL.nloc * NWAVES;
    const int ntok = (T - wv + nwv - 1) / nwv;
    auto tok = [&](int i) { const int t = wv + i * nwv; return t < T ? t : T - 1; };
    volatile LAS int* row = (volatile LAS int*)(lds + C.wave * 1024);
  for (int s = SL.pi; s < 8; s += SL.m) {
    const __amdgpu_buffer_rsrc_t urs = slice_rsrc(uq + (size_t)s * (NEXP * 128));
    const unsigned* hqs = h2q + s * 32 + c8 * 4;
    int tA = tok(0), tB = tok(1);
    int e0 = eidx[(size_t)tA * 128 + lane], e1 = eidx[(size_t)tA * 128 + 64 + lane];
    u32x4 hq = *(const u32x4*)(hqs + (size_t)tA * 256);
    int ne0 = eidx[(size_t)tB * 128 + lane], ne1 = eidx[(size_t)tB * 128 + 64 + lane];
    u32x4 r[16];
#pragma unroll
    for (int i = 0; i < 16; ++i) { const int e = __shfl(i < 8 ? e0 : e1, 8 * (i & 7) + grp) & EMASK; r[i] = __builtin_amdgcn_raw_buffer_load_b128(urs, e * 128 + c8 * 16, 0, 0); }
#pragma unroll 1
    for (int it = 0; it < ntok; ++it) {
        const int t = tok(it), t1 = tok(it + 1), t2 = tok(it + 2);
        const int ze0 = eidx[(size_t)t2 * 128 + lane], ze1 = eidx[(size_t)t2 * 128 + 64 + lane];
        const u32x4 nhq = *(const u32x4*)(hqs + (size_t)t1 * 256);
#pragma unroll
        for (int q = 0; q < 4; ++q) {
            int evv[4];
#pragma unroll
            for (int j = 0; j < 4; ++j) evv[j] = __shfl(q < 2 ? ne0 : ne1, 32 * (q & 1) + 8 * j + grp) & EMASK;
            int pa[4], pb[4];
#pragma unroll
            for (int j = 0; j < 4; ++j) {
                pa[j] = __builtin_amdgcn_sdot4((int)r[4 * q + j][0], (int)hq[0], 0, false); pb[j] = __builtin_amdgcn_sdot4((int)r[4 * q + j][1], (int)hq[1], 0, false);
                pa[j] = __builtin_amdgcn_sdot4((int)r[4 * q + j][2], (int)hq[2], pa[j], false); pb[j] = __builtin_amdgcn_sdot4((int)r[4 * q + j][3], (int)hq[3], pb[j], false);
            }
#pragma unroll
            for (int j = 0; j < 4; ++j) { pa[j] += pb[j]; pa[j] += dppi<0xB1>(pa[j]); }
#pragma unroll
            for (int j = 0; j < 4; ++j) pa[j] += dppi<0x4E>(pa[j]);
#pragma unroll
            for (int j = 0; j < 4; ++j) pa[j] += dppi<0x141>(pa[j]);
            if (c8 == 0) {
#pragma unroll
                for (int j = 0; j < 4; ++j) row[8 * (4 * q + j) + grp] = pa[j];
            }
#pragma unroll
            for (int j = 0; j < 4; ++j) {
                asm volatile("" ::: "memory");
                r[4 * q + j] = __builtin_amdgcn_raw_buffer_load_b128(urs, evv[j] * 128 + c8 * 16, 0, 0);
                asm volatile("" ::: "memory");
            }
        }
        LDS_WAIT();
        const int p0 = row[lane], p1 = row[64 + lane];
        LDS_WAIT();
        { short* pp = pdot + ((size_t)s * T + t) * 128 + lane; const int c0 = min(max((p0 + 4) >> 3, -32768), 32767), c1 = min(max((p1 + 4) >> 3, -32768), 32767);
          asm volatile("global_store_short %0, %1, off\n\tglobal_store_short %0, %2, off offset:128" :: "v"(pp), "v"(c0), "v"(c1) : "memory"); }
        hq = nhq; ne0 = ze0; ne1 = ze1;
    }
  }
}
__device__ __forceinline__ void ph_ureduce(const Ctx& C, LAS unsigned char* lds, const short* __restrict__ pdot, const float* __restrict__ hsc, const int* __restrict__ eidx, const float* __restrict__ us,
                                           const float* __restrict__ vs, const float* __restrict__ egate, unsigned* __restrict__ wqp, float* __restrict__ wsc) {
    const int lane = C.lane;
    volatile LAS unsigned char* row = (volatile LAS unsigned char*)(lds + C.wave * 1024);
    for (int tb = C.gw * 2; tb < T; tb += C.ngw * 2) {
        int e0[2], e1[2], s0[2], s1[2]; float h[2], g0[2], g1[2];
#pragma unroll
        for (int u = 0; u < 2; ++u) {
            const int t = tb + u;
            e0[u] = eidx[(size_t)t * 128 + lane]; e1[u] = eidx[(size_t)t * 128 + 64 + lane];
            g0[u] = egate[(size_t)t * 128 + lane]; g1[u] = egate[(size_t)t * 128 + 64 + lane];
            h[u] = hsc[t]; s0[u] = 0; s1[u] = 0;
#pragma unroll
            for (int s = 0; s < 8; ++s) { const short* pp = pdot + ((size_t)s * T + t) * 128 + lane; s0[u] += (int)pp[0]; s1[u] += (int)pp[64]; }
        }
        float w0[2], w1[2];
#pragma unroll
        for (int u = 0; u < 2; ++u) {
            w0[u] = gelu_fast((float)s0[u] * (8.0f * h[u]) * us[e0[u]]) * g0[u] * vs[e0[u]];
            w1[u] = gelu_fast((float)s1[u] * (8.0f * h[u]) * us[e1[u]]) * g1[u] * vs[e1[u]];
        }
#pragma unroll
        for (int u = 0; u < 2; ++u) {
            const int t = tb + u;
            const float wm = wave_max(fmaxf(fabsf(w0[u]), fabsf(w1[u])));
            const float inv = wm > 0.f ? 127.0f / wm : 0.f;
            { const int k = lane; row[u * 128 + (k & 7) * 16 + (k >> 5) * 4 + ((k >> 3) & 3)] = (unsigned char)(int)rintf(w0[u] * inv); }
            { const int k = 64 + lane; row[u * 128 + (k & 7) * 16 + (k >> 5) * 4 + ((k >> 3) & 3)] = (unsigned char)(int)rintf(w1[u] * inv); }
            if (lane == 0) wsc[t] = wm * (1.0f / 127.0f);
        }
        LDS_WAIT();
        wqp[(size_t)tb * 32 + lane] = ((volatile LAS unsigned*)row)[lane];
        LDS_WAIT();
    }
}
template <int EMASK>
__device__ __forceinline__ void ph_vpeer(const Ctx& C, const Slicing SL, const int* __restrict__ eidx, const unsigned* __restrict__ wqp, const float* __restrict__ wsc, const unsigned char* __restrict__ vq,
                                         f16* __restrict__ peer) {
    const int lane = C.lane, grp = lane >> 3, c8 = lane & 7;
    const bool hh = (lane & 32) != 0, b4 = (lane & 16) != 0, b3 = (lane & 8) != 0;
    const int wv = SL.rank * NWAVES + C.wave, nwv = SL.nloc * NWAVES;
    const int ntok = (T - wv + nwv - 1) / nwv;
    auto tok = [&](int i) { const int t = wv + i * nwv; return t < T ? t : T - 1; };
  for (int s = SL.pi; s < 8; s += SL.m) {
    const __amdgpu_buffer_rsrc_t vrs = slice_rsrc(vq + (size_t)s * (NEXP * 128));
    const int chl = 8 * (hh ? 1 : 0) + 4 * (b4 ? 1 : 0) + 2 * (b3 ? 1 : 0);
    const int coff = s * 128 + c8 * 16 + chl;
    int tA = tok(0), tB = tok(1);
    int e0 = eidx[(size_t)tA * 128 + lane], e1 = eidx[(size_t)tA * 128 + 64 + lane];
    u32x4 wq = *(const u32x4*)(wqp + (size_t)tA * 32 + grp * 4); float wscale = wsc[tA];
    int ne0 = eidx[(size_t)tB * 128 + lane], ne1 = eidx[(size_t)tB * 128 + 64 + lane];
    u32x4 r[16];
#pragma unroll
    for (int i = 0; i < 16; ++i) { const int e = __shfl(i < 8 ? e0 : e1, 8 * (i & 7) + grp) & EMASK; r[i] = __builtin_amdgcn_raw_buffer_load_b128(vrs, e * 128 + c8 * 16, 0, 0); }
#pragma unroll 1
    for (int it = 0; it < ntok; ++it) {
        const int t = tok(it), t1 = tok(it + 1), t2 = tok(it + 2);
        const int ze0 = eidx[(size_t)t2 * 128 + lane], ze1 = eidx[(size_t)t2 * 128 + 64 + lane];
        const u32x4 nwq = *(const u32x4*)(wqp + (size_t)t1 * 32 + grp * 4); const float nwscale = wsc[t1];
        int o[16];
#pragma unroll
        for (int c = 0; c < 16; ++c) o[c] = 0;
#pragma unroll
        for (int q = 0; q < 4; ++q) {
            int evv[4];
#pragma unroll
            for (int j = 0; j < 4; ++j) evv[j] = __shfl(q < 2 ? ne0 : ne1, 32 * (q & 1) + 8 * j + grp) & EMASK;
#pragma unroll
            for (int d = 0; d < 4; ++d) {
                const unsigned a = r[4 * q][d], b = r[4 * q + 1][d], c = r[4 * q + 2][d], e = r[4 * q + 3][d];
                const unsigned t0 = __builtin_amdgcn_perm(b, a, 0x05010400u), t1p = __builtin_amdgcn_perm(b, a, 0x07030602u);
                const unsigned u0 = __builtin_amdgcn_perm(e, c, 0x05010400u), u1 = __builtin_amdgcn_perm(e, c, 0x07030602u);
                o[4 * d + 0] = __builtin_amdgcn_sdot4((int)__builtin_amdgcn_perm(u0, t0, 0x05040100u), (int)wq[q], o[4 * d + 0], false);
                o[4 * d + 1] = __builtin_amdgcn_sdot4((int)__builtin_amdgcn_perm(u0, t0, 0x07060302u), (int)wq[q], o[4 * d + 1], false);
                o[4 * d + 2] = __builtin_amdgcn_sdot4((int)__builtin_amdgcn_perm(u1, t1p, 0x05040100u), (int)wq[q], o[4 * d + 2], false);
                o[4 * d + 3] = __builtin_amdgcn_sdot4((int)__builtin_amdgcn_perm(u1, t1p, 0x07060302u), (int)wq[q], o[4 * d + 3], false);
            }
#pragma unroll
            for (int j = 0; j < 4; ++j) {
                asm volatile("" ::: "memory");
                r[4 * q + j] = __builtin_amdgcn_raw_buffer_load_b128(vrs, evv[j] * 128 + c8 * 16, 0, 0);
                asm volatile("" ::: "memory");
            }
        }
        int q8[8], q4[4], q2[2];
#pragma unroll
        for (int k = 0; k < 8; ++k) q8[k] = bfly32i(o[k], o[8 + k]);
#pragma unroll
        for (int k = 0; k < 4; ++k) q4[k] = bfly16i(q8[k], q8[4 + k]);
#pragma unroll
        for (int k = 0; k < 2; ++k) { const int mine = b3 ? q4[2 + k] : q4[k], oth = b3 ? q4[k] : q4[2 + k]; q2[k] = mine + dppi<0x128>(oth); }
        { half2 pv; pv[0] = (f16)((float)q2[0] * wscale); pv[1] = (f16)((float)q2[1] * wscale); f16* yp = peer + (size_t)t * DM + coff; asm volatile("global_store_dword %0, %1, off" :: "v"(yp), "v"(pv) : "memory"); }
        wq = nwq; wscale = nwscale; ne0 = ze0; ne1 = ze1;
    }
  }
}
__device__ __forceinline__ void ph_final(const Ctx& C, const f16* __restrict__ peer, const f16* __restrict__ x1h, float* __restrict__ out, const float* __restrict__ gf) {
    const int lane = C.lane;
    f32x4 gg[4];
#pragma unroll
    for (int j = 0; j < 4; ++j) gg[j] = *(const f32x4*)(gf + j * 256 + lane * 4);
    for (int tb = C.gw * 4; tb < T; tb += C.ngw * 4) {
        half4 xv[4][4], pe[4][4];
#pragma unroll
        for (int u = 0; u < 4; ++u)
#pragma unroll
            for (int j = 0; j < 4; ++j) { xv[u][j] = *(const half4*)(x1h + (size_t)(tb + u) * DM + j * 256 + lane * 4); pe[u][j] = *(const half4*)(peer + (size_t)(tb + u) * DM + j * 256 + lane * 4); }
#pragma unroll
        for (int u = 0; u < 4; ++u) {
            f32x4 v[4]; float s = 0.f;
#pragma unroll
            for (int j = 0; j < 4; ++j) {
#pragma unroll
                for (int i = 0; i < 4; ++i) { v[j][i] = (float)xv[u][j][i] + (float)pe[u][j][i]; s += v[j][i] * v[j][i]; }
            }
            const float r = rsqrtf(wave_sum(s) * (1.0f / DM) + EPS);
#pragma unroll
            for (int j = 0; j < 4; ++j) *(f32x4*)(out + (size_t)(tb + u) * DM + j * 256 + lane * 4) = v[j] * r * gg[j];
        }
    }
}

namespace pg8 {
#define PG8_LAS __attribute__((address_space(3)))
typedef _Float16 frag8 __attribute__((ext_vector_type(8)));
typedef float f32x4 __attribute__((ext_vector_type(4)));
constexpr int BM = 256, BK = 64, HALF = 128, HTB = HALF * BK * 2  , STAGE_BYTES = 8 * HTB, NXCD = 8, WGM = 8;

__host__ __device__ __forceinline__ int lds_byte(int r, int c) { const int st = (r >> 4) * 2 + (c >> 5), rr = r & 15, cc = c & 31, ob = rr * 64 + cc * 2; return st * 1024 + (ob ^ (((ob >> 9) & 1) << 5)); }
__host__ __device__ __forceinline__ void stage_rc(int b, int& R, int& C) { const int st = b / 1024, sb = b % 1024, swz = sb ^ (((sb >> 9) & 1) << 5); R = (st >> 1) * 16 + swz / 64; C = (st & 1) * 32 + (swz % 64) / 2; }
__host__ __device__ __forceinline__ int perm32(int rho) { const int n = rho >> 4, i = rho & 15; return 8 * (i >> 2) + 4 * n + (i & 3); }

struct Unit { int pm, pn; };
struct Gemm { const f16* A; const f16* Bt; int M, N, K; };

struct StaticOrder {
    int nM, nN, nwg, G, c;
    __host__ __device__ void init(int M, int N, int G_, int c_) { nM = M / BM; nN = N / BM; nwg = nM * nN; G = G_; c = c_; }
    __host__ __device__ bool next(int i, Unit& u) const {
        const long L = (long)i * G + c; if (L >= nwg) return false;
        int wgid = (int)L; { const int q = nwg / NXCD, r = nwg % NXCD, xcd = wgid % NXCD, off = wgid / NXCD; wgid = (xcd < r ? xcd * (q + 1) : r * (q + 1) + (xcd - r) * q) + off; }
        const int nig = WGM * nN, gid = wgid / nig, fm = gid * WGM, gsz = (nM - fm) < WGM ? (nM - fm) : WGM;
        u.pm = fm + ((wgid % nig) % gsz); u.pn = (wgid % nig) / gsz; return true;
    }
    __device__ __forceinline__ void a_ready(const Unit&) const {}
    __device__ __forceinline__ void done(const Unit&) const {}
};

__device__ __forceinline__ frag8 pack8(const f32x4 a, const f32x4 b) {
    frag8 h; h[0] = (f16)a[0]; h[1] = (f16)a[1]; h[2] = (f16)a[2]; h[3] = (f16)a[3]; h[4] = (f16)b[0]; h[5] = (f16)b[1]; h[6] = (f16)b[2]; h[7] = (f16)b[3]; return h;
}
__device__ __forceinline__ float sigmoidf_(float z) { return 1.0f / (1.0f + __expf(-z)); }

struct EpiP1 {
    typedef i32x4 acc_t; static constexpr bool PERM = true, AFTER_DRAIN = false, MIDK = false;
    const float* ss1; const float* rsx; const float* wcs; const float* bgate; f16* qkvu; f16* gates; f16* vT;
    __device__ __forceinline__ void operator()(const i32x4 (&acc)[2][2][4][2], const Unit& u, int wr, int wc, int fr, int fq) const {
        const int row0 = u.pm * BM + wr * 64 + fr, colt = u.pn * BM; const bool isg = colt >= NQKVU;
        f32x4 cs[2][2];
#pragma unroll
        for (int bj = 0; bj < 2; ++bj) { const int c0 = colt + bj * HALF + wc * 32 + 8 * fq; cs[bj][0] = *(const f32x4*)(wcs + c0); cs[bj][1] = *(const f32x4*)(wcs + c0 + 4); }
#pragma unroll
        for (int ai = 0; ai < 2; ++ai)
#pragma unroll
            for (int m = 0; m < 4; ++m) { const int row = row0 + ai * HALF + m * 16; const float r = rsqrtf(ss1[row] * (1.0f / DM) + EPS) * rsx[row];
#pragma unroll
                for (int bj = 0; bj < 2; ++bj) { const int c0 = colt + bj * HALF + wc * 32 + 8 * fq; f32x4 v0, v1;
#pragma unroll
                    for (int i = 0; i < 4; ++i) { v0[i] = (float)acc[ai][bj][m][0][i] * (r * cs[bj][0][i]); v1[i] = (float)acc[ai][bj][m][1][i] * (r * cs[bj][1][i]); }
                    if (isg) { const int cg = c0 - NQKVU; const f32x4 b0 = *(const f32x4*)(bgate + cg), b1 = *(const f32x4*)(bgate + cg + 4);
#pragma unroll
                        for (int i = 0; i < 4; ++i) { v0[i] = sigmoidf_(v0[i] + b0[i]); v1[i] = sigmoidf_(v1[i] + b1[i]); }
                        *(frag8*)(gates + (size_t)row * NGATE + cg) = pack8(v0, v1); }
                    else { const frag8 hv = pack8(v0, v1); *(frag8*)(qkvu + (size_t)row * NQKVU + c0) = hv;
                        if (colt == 512 && bj == 1) {
                            f16* vp = vT + ((size_t)((row >> 11) * 2 + (wc >> 1)) * 64 + (wc & 1) * 32 + 8 * fq) * SEQ + (row & (SEQ - 1));
#pragma unroll
                            for (int i = 0; i < 8; ++i) vp[(size_t)i * SEQ] = hv[i]; } } } }
    }
};
struct EpiMerged {
    typedef f32x4 acc_t; static constexpr bool PERM = true, AFTER_DRAIN = false, MIDK = true;
    const f16* gates; f16* merged;
    __device__ __forceinline__ void mid(f32x4 (&acc)[2][2][4][2], const Unit& u, int wr, int wc, int fr, int fq) const {
        const int row0 = u.pm * BM + wr * 64 + fr, colt = u.pn * BM;
        const f16* gb = gates + (size_t)row0 * NGATE + colt + wc * 32 + 8 * fq;
        asm volatile("" : "+v"(gb));
#pragma unroll
        for (int ai = 0; ai < 2; ++ai) {
            frag8 g0[4][2], g1[4][2];
#pragma unroll
            for (int m = 0; m < 4; ++m)
#pragma unroll
                for (int bj = 0; bj < 2; ++bj) { const f16* gp = gb + (size_t)(ai * HALF + m * 16) * NGATE + bj * HALF; g0[m][bj] = *(const frag8*)gp; g1[m][bj] = *(const frag8*)(gp + DM); }
#pragma unroll
            for (int m = 0; m < 4; ++m)
#pragma unroll
                for (int bj = 0; bj < 2; ++bj)
#pragma unroll
                    for (int i = 0; i < 4; ++i) {
                        acc[ai][bj][m][0][i] *= (float)g0[m][bj][i] * __builtin_amdgcn_rcpf(fmaxf((float)g1[m][bj][i], 1e-4f));
                        acc[ai][bj][m][1][i] *= (float)g0[m][bj][4 + i] * __builtin_amdgcn_rcpf(fmaxf((float)g1[m][bj][4 + i], 1e-4f)); }
            asm volatile("" ::: "memory");
        }
    }
    __device__ __forceinline__ void operator()(const f32x4 (&acc)[2][2][4][2], const Unit& u, int wr, int wc, int fr, int fq) const {
        const int row0 = u.pm * BM + wr * 64 + fr, colt = u.pn * BM;
#pragma unroll
        for (int ai = 0; ai < 2; ++ai)
#pragma unroll
            for (int m = 0; m < 4; ++m) { const int row = row0 + ai * HALF + m * 16;
#pragma unroll
                for (int bj = 0; bj < 2; ++bj) { const int c0 = colt + bj * HALF + wc * 32 + 8 * fq;
                    const frag8 g1 = *(const frag8*)(gates + (size_t)row * NGATE + DM + c0); f32x4 v0, v1;
#pragma unroll
                    for (int i = 0; i < 4; ++i) { v0[i] = acc[ai][bj][m][0][i] * fmaxf((float)g1[i], 1e-4f); v1[i] = acc[ai][bj][m][1][i] * fmaxf((float)g1[4 + i], 1e-4f); }
                    *(frag8*)(merged + (size_t)row * DM + c0) = pack8(v0, v1); } }
    }
};
struct EpiOut {
    typedef f32x4 acc_t; static constexpr bool PERM = true, AFTER_DRAIN = false, MIDK = false;
    const float* x; f16* x1h; float* ss2p;
    __device__ __forceinline__ void operator()(const f32x4 (&acc)[2][2][4][2], const Unit& u, int wr, int wc, int fr, int fq) const {
        const int row0 = u.pm * BM + wr * 64 + fr, col0 = u.pn * BM + wc * 32 + 8 * fq;
#pragma unroll
        for (int ai = 0; ai < 2; ++ai)
#pragma unroll
            for (int m = 0; m < 4; ++m) { const int row = row0 + ai * HALF + m * 16; const size_t off = (size_t)row * DM + col0; float ssq = 0.f;
#pragma unroll
                for (int bj = 0; bj < 2; ++bj) {
                    const f32x4 y0 = *(const f32x4*)(x + off + bj * HALF) + acc[ai][bj][m][0], y1 = *(const f32x4*)(x + off + bj * HALF + 4) + acc[ai][bj][m][1];
                    ssq += ((y0[0] * y0[0] + y0[1] * y0[1]) + (y0[2] * y0[2] + y0[3] * y0[3])) + ((y1[0] * y1[0] + y1[1] * y1[1]) + (y1[2] * y1[2] + y1[3] * y1[3]));
                    *(frag8*)(x1h + off + bj * HALF) = pack8(y0, y1); }
                ssq += __shfl_xor(ssq, 16); ssq += __shfl_xor(ssq, 32);
                if (fq == 0) ss2p[(size_t)(u.pn * 4 + wc) * T + row] = ssq; }
    }
};
struct EpiQ {
    typedef i32x4 acc_t; static constexpr bool PERM = true, AFTER_DRAIN = false, MIDK = false;
    const float* hsc; const float* wqs; f16* qp;
    __device__ __forceinline__ void operator()(const i32x4 (&acc)[2][2][4][2], const Unit& u, int wr, int wc, int fr, int fq) const {
        const int row0 = u.pm * BM + wr * 64 + fr, colt = u.pn * BM;
        f32x4 cs[2][2];
#pragma unroll
        for (int bj = 0; bj < 2; ++bj) { const int c0 = colt + bj * HALF + wc * 32 + 8 * fq; cs[bj][0] = *(const f32x4*)(wqs + c0); cs[bj][1] = *(const f32x4*)(wqs + c0 + 4); }
#pragma unroll
        for (int ai = 0; ai < 2; ++ai)
#pragma unroll
            for (int m = 0; m < 4; ++m) { const int row = row0 + ai * HALF + m * 16; const float r = hsc[row];
#pragma unroll
                for (int bj = 0; bj < 2; ++bj) { const int c0 = colt + bj * HALF + wc * 32 + 8 * fq; f32x4 v0, v1;
#pragma unroll
                    for (int i = 0; i < 4; ++i) { v0[i] = (float)acc[ai][bj][m][0][i] * (r * cs[bj][0][i]); v1[i] = (float)acc[ai][bj][m][1][i] * (r * cs[bj][1][i]); }
                    *(frag8*)(qp + (size_t)row * 2048 + c0) = pack8(v0, v1); } }
    }
};

__device__ __forceinline__ void mma16(const frag8 b, const frag8 a, f32x4& c) { c = __builtin_amdgcn_mfma_f32_16x16x32_f16(b, a, c, 0, 0, 0); }
__device__ __forceinline__ void mma16(const frag8 b, const frag8 a, i32x4& c) { c = __builtin_amdgcn_mfma_i32_16x16x64_i8(__builtin_bit_cast(i32x4, b), __builtin_bit_cast(i32x4, a), c, 0, 0, 0); }
template <class Epi, class Sched, bool ALIGN_EPI = false, bool SP2 = false>
__device__ __forceinline__ void gemm_phase(PG8_LAS unsigned char* lds, const Gemm g, const Sched& S, const Epi& E) {
    const int tid = threadIdx.x, wid = __builtin_amdgcn_readfirstlane(tid >> 6), lane = tid & 63, wr = wid >> 2, wc = wid & 3, fr = lane & 15, fq = lane >> 4;
    const int K = g.K, nt = K / BK;
    unsigned voffA[2], voffB[2];
#pragma unroll
    for (int i = 0; i < 2; ++i) { int R, C; stage_rc(tid * 16 + i * 8192, R, C); const int Rb = Epi::PERM ? ((R & ~31) + perm32(R & 31)) : R;
        voffA[i] = (unsigned)(R * K + C) * 2u; voffB[i] = (unsigned)(Rb * K + C) * 2u; }
    const size_t kstep = (size_t)(BK * 2);
    const size_t hstep = (size_t)HALF * K * 2;
    const size_t tstep = 2 * hstep;
    const unsigned ldsw = (unsigned)wid * 1024u;
    const int aoff = lds_byte(wr * 64 + fr, fq * 8), boff = lds_byte(wc * 32 + fr, fq * 8);
#define PG8_SA(b, h) (((b) * 2 + (h)) * HTB)
#define PG8_SB(b, h) ((4 + (b) * 2 + (h)) * HTB)
#define PG8_STAGE(bufoff, gbase, voff) do { _Pragma("unroll") for (int _i = 0; _i < 2; ++_i) \
        __builtin_amdgcn_global_load_lds((const unsigned*)((const char*)(gbase) + (voff)[_i]), (PG8_LAS unsigned*)(lds + (bufoff) + ldsw + _i * 8192), 16, 0, 0); } while (0)
#define PG8_LDA(dst, b, h) do { _Pragma("unroll") for (int m = 0; m < 4; ++m) _Pragma("unroll") for (int k = 0; k < 2; ++k) dst[m][k] = *(const PG8_LAS frag8*)(lds + PG8_SA(b, h) + aoff + m * 2048 + k * 1024); } while (0)
#define PG8_LDB(dst, b, h) do { _Pragma("unroll") for (int n = 0; n < 2; ++n) _Pragma("unroll") for (int k = 0; k < 2; ++k) dst[n][k] = *(const PG8_LAS frag8*)(lds + PG8_SB(b, h) + boff + n * 2048 + k * 1024); } while (0)
#define PG8_MMA(ai, bj, At, Bt) do { __builtin_amdgcn_s_setprio(1); _Pragma("unroll") for (int m = 0; m < 4; ++m) _Pragma("unroll") for (int n = 0; n < 2; ++n) _Pragma("unroll") for (int k = 0; k < 2; ++k) \
        mma16(Bt[n][k], At[m][k], acc[ai][bj][m][n]); __builtin_amdgcn_s_setprio(0); } while (0)
#define PG8_WAIT_V(n) asm volatile("s_waitcnt vmcnt(" #n ")" ::: "memory")
#define PG8_WAIT_L(n) asm volatile("s_waitcnt lgkmcnt(" #n ")" ::: "memory")
#define PG8_BAR __builtin_amdgcn_s_barrier()
#define PG8_SCHED __builtin_amdgcn_sched_barrier(0)
    Unit cur, nxt; int ui = 0;
    if (!S.next(0, cur)) return;
    typedef typename Epi::acc_t acc_t;
    acc_t acc[2][2][4][2];
#pragma unroll
    for (int a = 0; a < 2; ++a)
#pragma unroll
        for (int b = 0; b < 2; ++b)
#pragma unroll
            for (int m = 0; m < 4; ++m)
#pragma unroll
                for (int n = 0; n < 2; ++n) acc[a][b][m][n] = acc_t{};
    frag8 At[4][2], B0[2][2], B1[2][2];
    const char* cA = (const char*)g.A + (size_t)cur.pm * tstep; const char* cB = (const char*)g.Bt + (size_t)cur.pn * tstep;
    S.a_ready(cur);
    if constexpr (SP2) {
        PG8_STAGE(PG8_SB(0, 0), cB, voffB); PG8_STAGE(PG8_SB(0, 1), cB + hstep, voffB); PG8_STAGE(PG8_SA(0, 0), cA, voffA); PG8_STAGE(PG8_SA(0, 1), cA + hstep, voffA);
        if (wr == 1) PG8_BAR;
        PG8_WAIT_V(2); PG8_BAR;
        PG8_STAGE(PG8_SB(1, 0), cB + kstep, voffB); PG8_STAGE(PG8_SA(1, 0), cA + kstep, voffA); PG8_STAGE(PG8_SB(1, 1), cB + hstep + kstep, voffB);
        PG8_WAIT_V(6); PG8_BAR;
    } else {
        PG8_STAGE(PG8_SB(0, 0), cB, voffB); PG8_STAGE(PG8_SA(0, 0), cA, voffA); PG8_STAGE(PG8_SB(0, 1), cB + hstep, voffB); PG8_STAGE(PG8_SA(0, 1), cA + hstep, voffA);
        if (wr == 1) PG8_BAR;
        PG8_WAIT_V(4); PG8_BAR;
        PG8_STAGE(PG8_SB(1, 0), cB + kstep, voffB); PG8_STAGE(PG8_SA(1, 0), cA + kstep, voffA); PG8_STAGE(PG8_SB(1, 1), cB + hstep + kstep, voffB);
        PG8_WAIT_V(6); PG8_BAR;
    }
    for (;;) {
        const bool has_next = S.next(ui + 1, nxt);
        const char* nA = has_next ? (const char*)g.A + (size_t)nxt.pm * tstep : cA; const char* nB = has_next ? (const char*)g.Bt + (size_t)nxt.pn * tstep : cB;
        for (int t = 0; t < nt; t += 2) {
            const bool last = (t == nt - 2);
            if constexpr (Epi::MIDK) { if (t == (nt >> 1)) E.mid(acc, cur, wr, wc, fr, fq); }
            const char* a1 = cA + (size_t)(t + 1) * kstep;
            const char* a2 = last ? nA : cA + (size_t)(t + 2) * kstep; const char* b2 = last ? nB : cB + (size_t)(t + 2) * kstep;
            const char* a3 = a2 + kstep; const char* b3 = b2 + kstep;
            if (last && has_next) S.a_ready(nxt);
            if constexpr (SP2) {
            PG8_LDB(B0, 0, 0); PG8_LDB(B1, 0, 1); PG8_SCHED; PG8_LDA(At, 0, 0); PG8_STAGE(PG8_SA(1, 1), a1 + hstep, voffA);
            PG8_WAIT_V(8); PG8_WAIT_L(0); PG8_BAR; PG8_MMA(0, 0, At, B0); PG8_MMA(0, 1, At, B1); PG8_BAR; PG8_SCHED;
            PG8_LDA(At, 0, 1); PG8_STAGE(PG8_SB(0, 0), b2, voffB); PG8_STAGE(PG8_SB(0, 1), b2 + hstep, voffB); PG8_STAGE(PG8_SA(0, 0), a2, voffA);
            PG8_WAIT_V(8); PG8_WAIT_L(0); PG8_BAR; PG8_MMA(1, 0, At, B0); PG8_MMA(1, 1, At, B1); PG8_BAR; PG8_SCHED;
            PG8_LDB(B0, 1, 0); PG8_LDB(B1, 1, 1); PG8_SCHED; PG8_LDA(At, 1, 0); PG8_STAGE(PG8_SA(0, 1), a2 + hstep, voffA);
            PG8_WAIT_V(8); PG8_WAIT_L(0); PG8_BAR; PG8_MMA(0, 0, At, B0); PG8_MMA(0, 1, At, B1); PG8_BAR; PG8_SCHED;
            PG8_LDA(At, 1, 1); PG8_STAGE(PG8_SB(1, 0), b3, voffB); PG8_STAGE(PG8_SB(1, 1), b3 + hstep, voffB); PG8_STAGE(PG8_SA(1, 0), a3, voffA);
            PG8_WAIT_V(8); PG8_WAIT_L(0); PG8_BAR; PG8_MMA(1, 0, At, B0); PG8_MMA(1, 1, At, B1); PG8_BAR; PG8_SCHED;
            } else {
            PG8_LDB(B0, 0, 0); PG8_SCHED; PG8_LDA(At, 0, 0); PG8_STAGE(PG8_SA(1, 1), a1 + hstep, voffA);
            PG8_WAIT_L(8); PG8_BAR; PG8_WAIT_L(0); PG8_MMA(0, 0, At, B0); PG8_BAR; PG8_SCHED;
            PG8_LDB(B1, 0, 1); PG8_STAGE(PG8_SB(0, 0), b2, voffB);
            PG8_BAR; PG8_WAIT_L(0); PG8_MMA(0, 1, At, B1); PG8_BAR;
            PG8_LDA(At, 0, 1); PG8_STAGE(PG8_SA(0, 0), a2, voffA);
            PG8_BAR; PG8_WAIT_L(0); PG8_MMA(1, 0, At, B0); PG8_BAR; PG8_SCHED;
            PG8_STAGE(PG8_SB(0, 1), b2 + hstep, voffB);
            PG8_WAIT_V(6); PG8_BAR; PG8_MMA(1, 1, At, B1); PG8_BAR;
            PG8_LDB(B0, 1, 0); PG8_SCHED; PG8_LDA(At, 1, 0); PG8_STAGE(PG8_SA(0, 1), a2 + hstep, voffA);
            PG8_WAIT_L(8); PG8_BAR; PG8_WAIT_L(0); PG8_MMA(0, 0, At, B0); PG8_BAR; PG8_SCHED;
            PG8_LDB(B1, 1, 1); PG8_STAGE(PG8_SB(1, 0), b3, voffB);
            PG8_BAR; PG8_WAIT_L(0); PG8_MMA(0, 1, At, B1); PG8_BAR;
            PG8_LDA(At, 1, 1); PG8_STAGE(PG8_SA(1, 0), a3, voffA);
            PG8_BAR; PG8_WAIT_L(0); PG8_MMA(1, 0, At, B0); PG8_BAR; PG8_SCHED;
            PG8_STAGE(PG8_SB(1, 1), b3 + hstep, voffB);
            PG8_WAIT_V(6); PG8_BAR; PG8_MMA(1, 1, At, B1); PG8_BAR;
            }
        }
        if constexpr (ALIGN_EPI) { if (wr == 0) PG8_BAR; }
        if constexpr (!Epi::AFTER_DRAIN) { E(acc, cur, wr, wc, fr, fq); S.done(cur); }
        if (!has_next) break;
#pragma unroll
        for (int a = 0; a < 2; ++a)
#pragma unroll
            for (int b = 0; b < 2; ++b)
#pragma unroll
                for (int m = 0; m < 4; ++m)
#pragma unroll
                    for (int n = 0; n < 2; ++n) acc[a][b][m][n] = acc_t{};
        cur = nxt; cA = nA; cB = nB; ++ui;
        if constexpr (ALIGN_EPI) { if (wr == 1) PG8_BAR; }
    }
    PG8_WAIT_V(0);
    if constexpr (!ALIGN_EPI) { if (wr == 0) PG8_BAR; }
    PG8_BAR;
    if constexpr (Epi::AFTER_DRAIN) { E.fused(acc, cur, wr, wc, fr, fq, lds, wid, lane); S.done(cur); }
#undef PG8_SA
#undef PG8_SB
#undef PG8_STAGE
#undef PG8_LDA
#undef PG8_LDB
#undef PG8_MMA
#undef PG8_WAIT_V
#undef PG8_WAIT_L
#undef PG8_BAR
#undef PG8_SCHED
}
}

#define XB_TMO      128
#define XB_XCNT(j)  (256  + 64 * (j))
#define XB_XSUB(j)  (1280 + 64 * (j))
#define XB_XGEN(j)  (2304 + 64 * (j))
#define XB_TOP      3328
#define XB_TOPGEN   3392
#define XCD_BAR_WORDS 3456
#define XB_SPIN_CAP (1u << 18)

__device__ __forceinline__ unsigned xb_ld(unsigned* p)              { return __hip_atomic_load(p, __ATOMIC_RELAXED, __HIP_MEMORY_SCOPE_AGENT); }
__device__ __forceinline__ unsigned xb_add(unsigned* p, unsigned v) { return __hip_atomic_fetch_add(p, v, __ATOMIC_RELAXED, __HIP_MEMORY_SCOPE_AGENT); }
__device__ __forceinline__ unsigned xb_xcc_id() { return (unsigned)__builtin_amdgcn_s_getreg((3 << 11) | 20) & 0xFu; }
#define XB_SPIN(cond, bar) do { unsigned _sp = 0; while (cond) { __builtin_amdgcn_s_sleep(1); \
    if ((++_sp & 255u) == 0u) { if (xb_ld(&(bar)[XB_TMO])) break; if (_sp > XB_SPIN_CAP) { atomicAdd(&(bar)[XB_TMO], 1u); break; } } } } while (0)

struct XcdBarrier {
    unsigned* bar; unsigned x;
    volatile LAS unsigned* st;
};

__device__ __forceinline__ XcdBarrier xcd_barrier_post(unsigned* bar, volatile LAS unsigned* st) {
    XcdBarrier b; b.bar = bar; b.x = xb_xcc_id(); b.st = st;
    if (threadIdx.x == 0) st[2] = xb_add(&bar[XB_XCNT(b.x)], 1u);
    return b;
}
__device__ __forceinline__ void xcd_barrier_complete(unsigned* bar, unsigned x, unsigned& nloc, unsigned& nx) {
    const unsigned G = gridDim.x * gridDim.y * gridDim.z;
    unsigned sum, cnt, mine, sp = 0u;
    for (;;) {
        sum = 0u; cnt = 0u; mine = 0u;
#pragma unroll
        for (unsigned j = 0; j < 16; ++j) { const unsigned c = xb_ld(&bar[XB_XCNT(j)]); sum += c; cnt += (c > 0u) ? 1u : 0u; mine = (j == x) ? c : mine; }
        if (sum == G) break;
        __builtin_amdgcn_s_sleep(1);
        if ((++sp & 255u) == 0u) { if (xb_ld(&bar[XB_TMO])) break; if (sp > XB_SPIN_CAP) { atomicAdd(&bar[XB_TMO], 1u); break; } }
    }
    nloc = mine > 0u ? mine : 1u; nx = cnt > 0u ? cnt : 1u;
}

__device__ __forceinline__ void xcd_barrier(const XcdBarrier& b) {
    asm volatile("s_waitcnt vmcnt(0)" ::: "memory");
    __syncthreads();
    if (threadIdx.x == 0) {
        unsigned* bar = b.bar;
        __builtin_amdgcn_s_waitcnt(0);
        unsigned nloc = b.st[0], nx = b.st[1];
        if (nloc == 0u) { xcd_barrier_complete(bar, b.x, nloc, nx); b.st[0] = nloc; b.st[1] = nx; }
        const unsigned old = xb_add(&bar[XB_XSUB(b.x)], 1u);
        const unsigned gen = old / nloc;
        if (old + 1u == (gen + 1u) * nloc) {
            __builtin_amdgcn_fence(__ATOMIC_RELEASE, "agent");
            asm volatile("s_waitcnt vmcnt(0)" ::: "memory");
            const unsigned og = xb_add(&bar[XB_TOP], 1u);
            const unsigned tg = og / nx;
            if (og + 1u == (tg + 1u) * nx) xb_add(&bar[XB_TOPGEN], 1u);
            else XB_SPIN(xb_ld(&bar[XB_TOPGEN]) == tg, bar);
            __builtin_amdgcn_fence(__ATOMIC_ACQUIRE, "agent");
            xb_add(&bar[XB_XGEN(b.x)], 1u);
            asm volatile("s_waitcnt vmcnt(0)" ::: "memory");
        } else {
            XB_SPIN(xb_ld(&bar[XB_XGEN(b.x)]) == gen, bar);
            __builtin_amdgcn_fence(__ATOMIC_ACQUIRE, "agent");
            asm volatile("s_waitcnt vmcnt(0)" ::: "memory");
        }
    }
    __syncthreads();
}


struct Args { const float* in[16]; float* out; unsigned char* ws; int ph_lo, ph_hi; };
constexpr int N_PHASES = 11;

__global__ void __launch_bounds__(NTHREADS, 2) mk_fwd(Args a) {
    extern __shared__ __attribute__((aligned(16))) unsigned char lds[];
    LAS unsigned char* L = (LAS unsigned char*)lds;
    volatile LAS unsigned* MISC = (volatile LAS unsigned*)(L + MISC_OFF);
    unsigned char* ws = a.ws;
    Ctx C;
    C.tid = threadIdx.x; C.lane = C.tid & 63; C.wave = __builtin_amdgcn_readfirstlane(C.tid >> 6);
    C.G = gridDim.x; C.gw = blockIdx.x * NWAVES + C.wave; C.ngw = C.G * NWAVES; C.gt = blockIdx.x * NTHREADS + C.tid; C.ngt = C.G * NTHREADS;
    for (int u = C.tid; u < (LDS_BYTES - LDSCTL_OFF) / 4; u += NTHREADS) ((LAS unsigned*)(L + LDSCTL_OFF))[u] = 0u;
    __syncthreads();
    const int lo = a.ph_lo, hi = a.ph_hi, G = C.G;
    const bool multi = (hi - lo) > 1;
    XcdBarrier bar; bar.bar = (unsigned*)(ws + WS_CTL) + CW_BAR; bar.x = 0; bar.st = nullptr;
    if (multi) bar = xcd_barrier_post((unsigned*)(ws + WS_CTL) + CW_BAR, MISC + 8);
#define IN(k) (lo <= (k) && (k) < hi)
#define SEAM(k) do { if (IN(k) && IN((k) + 1)) xcd_barrier(bar); } while (0)

#define REPS(k) for (int rep_ = 0; rep_ < ((PROBE_DUP == (k)) ? 2 : 1); ++rep_)
#define REPBAR(k) do { if (PROBE_DUP == (k) && rep_ == 0) xcd_barrier(bar); } while (0)
    if (IN(0)) REPS(0) { ph_prep(C, L, a.in, ws); REPBAR(0); }
    SEAM(0);
    if (IN(1)) {
        quant_wrows(C, (const f16*)(ws + WS_WCAT), NCAT, (unsigned*)(ws + WS_WCATQ), (float*)(ws + WS_WCS));
        quant_wrows(C, (const f16*)(ws + WS_WQ), 2048, (unsigned*)(ws + WS_WQQ), (float*)(ws + WS_WQS));
        xcd_barrier(bar);
        pg8::Gemm g{(const f16*)(ws + WS_XH), (const f16*)(ws + WS_WCATQ), T, NCAT, DM / 2}; pg8::StaticOrder S; S.init(T, NCAT, G, (int)blockIdx.x);
        pg8::EpiP1 E{(const float*)(ws + WS_RS1), (const float*)(ws + WS_RSX), (const float*)(ws + WS_WCS), a.in[8], (f16*)(ws + WS_QKVU), (f16*)(ws + WS_GATES), (f16*)(ws + WS_VT)};
        pg8::gemm_phase<pg8::EpiP1, pg8::StaticOrder, true, true>(L, g, S, E);
    }
    SEAM(1);
    if (IN(2)) REPS(2) {
        ph_attn_pool(C, L, (const f16*)(ws + WS_QKVU), (const f16*)(ws + WS_VT), a.in[3], (const f16*)(ws + WS_POOLW), a.in[5], (f16*)(ws + WS_OCAT));
        REPBAR(2);
    }
    if (IN(2) && IN(4)) xcd_barrier(bar);
    if (IN(4)) REPS(4) {
        pg8::Gemm g{(const f16*)(ws + WS_OCAT), (const f16*)(ws + WS_WB), T, DM, DM}; pg8::StaticOrder S; S.init(T, DM, G, (int)blockIdx.x);
        pg8::EpiMerged E{(const f16*)(ws + WS_GATES), (f16*)(ws + WS_MERGED)};
        pg8::gemm_phase<pg8::EpiMerged, pg8::StaticOrder, true, true>(L, g, S, E);
        REPBAR(4);
    }
    SEAM(4);
    if (IN(5)) REPS(5) {
        pg8::Gemm g{(const f16*)(ws + WS_MERGED), (const f16*)(ws + WS_WOUT), T, DM, DM}; pg8::StaticOrder S; S.init(T, DM, G, (int)blockIdx.x);
        pg8::EpiOut E{a.in[0], (f16*)(ws + WS_X1H), (float*)(ws + WS_SS2)};
        pg8::gemm_phase<pg8::EpiOut, pg8::StaticOrder, true, true>(L, g, S, E);
        REPBAR(5);
    }
    SEAM(5);
    if (IN(6)) {
        ph_h2quant(C, (const f16*)(ws + WS_X1H), a.in[10], (const float*)(ws + WS_SS2), (unsigned*)(ws + WS_H2Q), (float*)(ws + WS_HSC));
        xcd_barrier(bar);
        pg8::Gemm g{(const f16*)(ws + WS_H2Q), (const f16*)(ws + WS_WQQ), T, 2048, DM / 2}; pg8::StaticOrder S; S.init(T, 2048, G, (int)blockIdx.x);
        pg8::EpiQ E{(const float*)(ws + WS_HSC), (const float*)(ws + WS_WQS), (f16*)(ws + WS_QP)};
        pg8::gemm_phase<pg8::EpiQ, pg8::StaticOrder, true, true>(L, g, S, E);
    }
    SEAM(6);
    if (IN(7)) REPS(7) {
        auto side = [&]() {
            quant_rows<false>(C, a.in[13], (unsigned*)(ws + WS_UQ), (float*)(ws + WS_US));
            quant_rows<false>(C, a.in[14], (unsigned*)(ws + WS_VQ), (float*)(ws + WS_VS));
        };
        ph_route(C, L, (const f16*)(ws + WS_QP), (const float*)(ws + WS_SS2), (const f16*)(ws + WS_SUBK), (int*)(ws + WS_EIDX), (float*)(ws + WS_EGATE), side);
        if (!(C.wave & 4)) side();
        REPBAR(7); }
    SEAM(7);
    if (IN(8)) REPS(8) {
        const Slicing SL = get_slicing((const unsigned*)(ws + WS_CTL) + CW_BAR, MISC);
        if (PROBE_DUP == 8 && rep_ == 0) ph_upeer<255>(C, L, SL, (const unsigned*)(ws + WS_H2Q), (const int*)(ws + WS_EIDX), (const unsigned char*)(ws + WS_UQ), (short*)(ws + WS_PDOT));
        else ph_upeer<16383>(C, L, SL, (const unsigned*)(ws + WS_H2Q), (const int*)(ws + WS_EIDX), (const unsigned char*)(ws + WS_UQ), (short*)(ws + WS_PDOT));
        REPBAR(8);
    }
    SEAM(8);
    if (IN(9)) {
        ph_ureduce(C, L, (const short*)(ws + WS_PDOT), (const float*)(ws + WS_HSC), (const int*)(ws + WS_EIDX), (const float*)(ws + WS_US), (const float*)(ws + WS_VS), (const float*)(ws + WS_EGATE),
                   (unsigned*)(ws + WS_WQP), (float*)(ws + WS_WSC));
        xcd_barrier(bar);
        const Slicing SL = get_slicing((const unsigned*)(ws + WS_CTL) + CW_BAR, MISC);
        ph_vpeer<16383>(C, SL, (const int*)(ws + WS_EIDX), (const unsigned*)(ws + WS_WQP), (const float*)(ws + WS_WSC), (const unsigned char*)(ws + WS_VQ), (f16*)(ws + WS_PEER));
    }
    SEAM(9);
    if (IN(10)) { ph_final(C, (const f16*)(ws + WS_PEER), (const f16*)(ws + WS_X1H), a.out, a.in[15]); }
#undef IN
#undef SEAM
}

#ifndef MK_N_LAUNCHES
#define MK_N_LAUNCHES 1
#endif
extern "C" void kernel_launch(void* const* d_in, const int* in_sizes, int n_in, void* d_out, int out_size, void* d_ws, size_t ws_size, hipStream_t stream) {
    static int grid = 0;
    if (grid == 0) {
        if (n_in != 16 || in_sizes[0] != T * DM || out_size != T * DM || ws_size < WS_END) {
            fprintf(stderr, "kernel_launch: unexpected shapes (n_in %d in0 %d out %d ws %zu)\n", n_in, n_in > 0 ? in_sizes[0] : -1, out_size, ws_size);
            grid = -1; return;
        }
        int dev = 0, cus = 0;
        if (hipGetDevice(&dev) != hipSuccess || hipDeviceGetAttribute(&cus, hipDeviceAttributeMultiprocessorCount, dev) != hipSuccess) { grid = -1; return; }
        if (hipFuncSetAttribute((const void*)mk_fwd, hipFuncAttributeMaxDynamicSharedMemorySize, LDS_BYTES) != hipSuccess) { fprintf(stderr, "kernel_launch: hipFuncSetAttribute failed\n"); grid = -1; return; }
        int per_cu = 0;
        if (hipOccupancyMaxActiveBlocksPerMultiprocessor(&per_cu, (const void*)mk_fwd, NTHREADS, LDS_BYTES) != hipSuccess || per_cu < 1)
            fprintf(stderr, "kernel_launch: occupancy query reports %d workgroups per CU\n", per_cu);
        (void)hipGetLastError();
        grid = cus;
    }
    if (grid < 0) return;
    (void)hipMemsetAsync((char*)d_ws + WS_CTL, 0, CTL_ZERO_BYTES, stream);
    Args a{};
    for (int i = 0; i < 16; ++i) a.in[i] = (const float*)d_in[i];
    a.out = (float*)d_out; a.ws = (unsigned char*)d_ws;
    if (MK_N_LAUNCHES == 1) {
        a.ph_lo = 0; a.ph_hi = N_PHASES;
        hipLaunchKernelGGL(mk_fwd, dim3(grid), dim3(NTHREADS), LDS_BYTES, stream, a);
    } else {
        for (int p = 0; p < N_PHASES; ++p) { a.ph_lo = p; a.ph_hi = p + 1; hipLaunchKernelGGL(mk_fwd, dim3(grid), dim3(NTHREADS), LDS_BYTES, stream, a); }
    }
}
```

```cpp
#include <hip/hip_runtime.h>
#include <cstdint>
#include <cstdio>

typedef _Float16 f16;
typedef _Float16 half8 __attribute__((ext_vector_type(8)));
typedef _Float16 half4 __attribute__((ext_vector_type(4)));
typedef _Float16 half2 __attribute__((ext_vector_type(2)));
typedef float f32x4 __attribute__((ext_vector_type(4)));
typedef float f32x16 __attribute__((ext_vector_type(16)));
typedef unsigned u32x4 __attribute__((ext_vector_type(4)));
typedef int i32x4 __attribute__((ext_vector_type(4)));
#define LAS __attribute__((address_space(3)))
#ifndef PROBE_DIAG
#define PROBE_DIAG (0)
#endif
#ifndef PROBE_DUP
#define PROBE_DUP (-1)
#endif
#define GAS __attribute__((address_space(1)))

constexpr int DM = 1024, BATCH = 16, SEQ = 2048, T = BATCH * SEQ;
constexpr int NQKVU = 1280, NGATE = 2048, NCAT = NQKVU + NGATE;
constexpr int COL_K = 512, COL_V = 640, COL_U = 768;
constexpr int NEXP = 16384, PEER_H = 8, TOPK = 16;
constexpr float EPS = 1e-6f;
constexpr int NWAVES = 8, NTHREADS = NWAVES * 64;

constexpr size_t MiB = 1u << 20;
constexpr size_t WS_CTL = 0, CTL_ZERO_BYTES = 64 * 1024;
constexpr size_t WS_WCAT = 1 * MiB;
constexpr size_t WS_WB = 8 * MiB;
constexpr size_t WS_WOUT = 10 * MiB;
constexpr size_t WS_WQ = 12 * MiB;
constexpr size_t WS_POOLW = 16 * MiB;
constexpr size_t WS_SUBK = 16 * MiB + 512 * 1024;
constexpr size_t WS_RS1 = 17 * MiB;
constexpr size_t WS_EIDX = 18 * MiB;
constexpr size_t WS_EGATE = 34 * MiB;
constexpr size_t WS_WCATQ = 50 * MiB;
constexpr size_t WS_WCS = 54 * MiB;
constexpr size_t WS_WQQ = 56 * MiB;
constexpr size_t WS_WQS = 59 * MiB;
constexpr size_t WS_RSX = 55 * MiB;
constexpr size_t WS_UTAB = 50 * MiB;
constexpr size_t WS_VTAB = 82 * MiB;
constexpr size_t WS_XH = 114 * MiB;
constexpr size_t WS_MERGED = WS_XH;
constexpr size_t WS_QKVU = 178 * MiB;
constexpr size_t WS_X1H = WS_QKVU;
constexpr size_t WS_PEER = WS_MERGED;
constexpr size_t WS_GATES = 258 * MiB;
constexpr size_t WS_QP = WS_GATES;
constexpr size_t WS_OCAT = 386 * MiB;
constexpr size_t WS_UQ = 450 * MiB;
constexpr size_t WS_VQ = 466 * MiB;
constexpr size_t WS_US = 17 * MiB + 256 * 1024, WS_VS = 17 * MiB + 512 * 1024;
constexpr size_t WS_PDOT = WS_GATES;
constexpr size_t WS_H2Q = 404 * MiB;
constexpr size_t WS_HSC = 403 * MiB;
constexpr size_t WS_SSF = 402 * MiB;
constexpr size_t WS_WQP = 386 * MiB;
constexpr size_t WS_WSC = 390 * MiB;
constexpr size_t WS_ACT = 386 * MiB;
constexpr size_t WS_SS2 = 482 * MiB;
constexpr size_t WS_VT = 484 * MiB;
constexpr size_t WS_END = 492 * MiB;
constexpr int CW_BAR = 4096;

constexpr int RING_OFF = 0, RING_BYTES = 131072;
constexpr int LDSCTL_OFF = RING_BYTES, MISC_OFF = LDSCTL_OFF + 320;
constexpr int LDS_BYTES = 147456;

#define LDS_WAIT() asm volatile("s_waitcnt lgkmcnt(0)" ::: "memory")
template <int CTRL> __device__ __forceinline__ float dppf(float x) { return __uint_as_float(__builtin_amdgcn_update_dpp(0u, __float_as_uint(x), CTRL, 0xf, 0xf, false)); }
template <int CTRL> __device__ __forceinline__ int dppi(int x) { return (int)__builtin_amdgcn_update_dpp(0u, (unsigned)x, CTRL, 0xf, 0xf, false); }
__device__ __forceinline__ float bfly32(float a, float b) { auto r = __builtin_amdgcn_permlane32_swap(__float_as_uint(a), __float_as_uint(b), false, false); return __uint_as_float(r[0]) + __uint_as_float(r[1]); }
__device__ __forceinline__ float bfly16(float a, float b) { auto r = __builtin_amdgcn_permlane16_swap(__float_as_uint(a), __float_as_uint(b), false, false); return __uint_as_float(r[0]) + __uint_as_float(r[1]); }
__device__ __forceinline__ int bfly32i(int a, int b) { auto r = __builtin_amdgcn_permlane32_swap((unsigned)a, (unsigned)b, false, false); return (int)(r[0] + r[1]); }
__device__ __forceinline__ int bfly16i(int a, int b) { auto r = __builtin_amdgcn_permlane16_swap((unsigned)a, (unsigned)b, false, false); return (int)(r[0] + r[1]); }
__device__ __forceinline__ float wave_sum(float x) {
    x += dppf<0x121>(x); x += dppf<0x122>(x); x += dppf<0x124>(x); x += dppf<0x128>(x);
    x = bfly16(x, x); return bfly32(x, x);
}
__device__ __forceinline__ int wave_sum_i(int x) {
    x += dppi<0x121>(x); x += dppi<0x122>(x); x += dppi<0x124>(x); x += dppi<0x128>(x);
    x = bfly16i(x, x); return bfly32i(x, x);
}
__device__ __forceinline__ float wave_max(float x) {
    x = fmaxf(x, dppf<0x121>(x)); x = fmaxf(x, dppf<0x122>(x)); x = fmaxf(x, dppf<0x124>(x)); x = fmaxf(x, dppf<0x128>(x));
    { auto r = __builtin_amdgcn_permlane16_swap(__float_as_uint(x), __float_as_uint(x), false, false); x = fmaxf(__uint_as_float(r[0]), __uint_as_float(r[1])); }
    { auto r = __builtin_amdgcn_permlane32_swap(__float_as_uint(x), __float_as_uint(x), false, false); x = fmaxf(__uint_as_float(r[0]), __uint_as_float(r[1])); }
    return x;
}
__device__ __forceinline__ float gelu_exact(float x) { return 0.5f * x * (1.0f + erff(x * 0.70710678118654752f)); }
__device__ __forceinline__ float rs_from_ss(const float* ss, int t) {
    float s = 0.f;
#pragma unroll
    for (int i = 0; i < 16; ++i) s += ss[(size_t)i * T + t];
    return rsqrtf(s * (1.0f / DM) + EPS);
}

struct Ctx {
    int tid, lane, wave;
    int G;
    int gw, ngw;
    int gt, ngt;
};

__device__ __forceinline__ int pack4_i8(float a, float b, float c, float d) {
    const int ia = (int)rintf(a), ib = (int)rintf(b), ic = (int)rintf(c), id = (int)rintf(d);
    return (ia & 0xff) | ((ib & 0xff) << 8) | ((ic & 0xff) << 16) | (id << 24);
}
template <bool OFFS>
__device__ __forceinline__ void quant_rows(const Ctx& C, const float* __restrict__ tab, unsigned* __restrict__ q, float* __restrict__ scale) {
    const int lane = C.lane;
    for (int r = C.gw; r < NEXP; r += C.ngw) {
        const float* row = tab + (size_t)r * DM;
        f32x4 v[4]; float m = 0.f;
#pragma unroll
        for (int j = 0; j < 4; ++j) { v[j] = *(const f32x4*)(row + j * 256 + lane * 4); m = fmaxf(m, fmaxf(fmaxf(fabsf(v[j][0]), fabsf(v[j][1])), fmaxf(fabsf(v[j][2]), fabsf(v[j][3])))); }
        m = wave_max(m);
        const float inv = m > 0.f ? 127.0f / m : 0.f;
#pragma unroll
        for (int j = 0; j < 4; ++j) {
            unsigned w = (unsigned)pack4_i8(v[j][0] * inv, v[j][1] * inv, v[j][2] * inv, v[j][3] * inv);
            if (OFFS) w ^= 0x80808080u;
            { const int dw = j * 64 + lane; q[(size_t)(dw >> 5) * (NEXP * 32) + (size_t)r * 32 + (dw & 31)] = w; }
        }
        if (lane == 0) scale[r] = m * (1.0f / 127.0f);
    }
}

__device__ __forceinline__ void p0_transpose_item(const float* W, int K, int N, f16* WT, int ldo, int koff, LAS float* scr, int item, int lane) {
    const int nblk = N / 32, kb = item / nblk, nb = item % nblk, k0 = 64 * kb, n0 = 32 * nb;
#pragma unroll 8
    for (int i = 0; i < 32; ++i) { const int kk = 2 * i + (lane >> 5); scr[kk * 33 + (lane & 31)] = W[(size_t)(k0 + kk) * N + n0 + (lane & 31)]; }
    LDS_WAIT(); asm volatile("" ::: "memory");
    const int c = lane & 7;
#pragma unroll
    for (int j = 0; j < 4; ++j) { const int n = (lane >> 3) + 8 * j; const LAS float* s = scr + (8 * c) * 33 + n;
        half8 o;
#pragma unroll
        for (int i = 0; i < 8; ++i) o[i] = (f16)s[i * 33];
        *(half8*)(WT + (size_t)(n0 + n) * ldo + koff + k0 + 8 * c) = o; }
    LDS_WAIT(); asm volatile("" ::: "memory");
}
__device__ __forceinline__ void cvt_stream(const Ctx& C, const float* in, f16* out, size_t n4) {
    for (size_t i = (size_t)C.gt; i < n4; i += (size_t)C.ngt) {
        const f32x4 v = ((const f32x4*)in)[i];
        half4 h; h[0] = (f16)v[0]; h[1] = (f16)v[1]; h[2] = (f16)v[2]; h[3] = (f16)v[3];
        ((half4*)out)[i] = h;
    }
}
__device__ __forceinline__ void rowprep(const Ctx& C, const float* x, const float* g, unsigned* xq, float* rsx, float* ss) {
    const int lane = C.lane;
    f32x4 gg[4];
#pragma unroll
    for (int j = 0; j < 4; ++j) gg[j] = *(const f32x4*)(g + j * 256 + lane * 4);
    for (int tb = C.gw * 4; tb < T; tb += C.ngw * 4) {
        f32x4 v[4][4];
#pragma unroll
        for (int u = 0; u < 4; ++u)
#pragma unroll
            for (int j = 0; j < 4; ++j) v[u][j] = *(const f32x4*)(x + (size_t)(tb + u) * DM + j * 256 + lane * 4);
#pragma unroll
        for (int u = 0; u < 4; ++u) {
            float s = 0.f, am = 0.f;
#pragma unroll
            for (int j = 0; j < 4; ++j) {
                const f32x4 w = v[u][j];
                s += w[0] * w[0] + w[1] * w[1] + w[2] * w[2] + w[3] * w[3];
                v[u][j] = w * gg[j];
                am = fmaxf(am, fmaxf(fmaxf(fabsf(v[u][j][0]), fabsf(v[u][j][1])), fmaxf(fabsf(v[u][j][2]), fabsf(v[u][j][3]))));
            }
            s = wave_sum(s); am = wave_max(am);
            const float inv = am > 0.f ? 127.0f / am : 0.f;
#pragma unroll
            for (int j = 0; j < 4; ++j) xq[(size_t)(tb + u) * 256 + j * 64 + lane] = (unsigned)pack4_i8(v[u][j][0] * inv, v[u][j][1] * inv, v[u][j][2] * inv, v[u][j][3] * inv);
            if (lane == 0) { ss[tb + u] = s; rsx[tb + u] = am * (1.0f / 127.0f); }
        }
    }
}
__device__ __forceinline__ void quant_wrows(const Ctx& C, const f16* __restrict__ w, int rows, unsigned* __restrict__ q, float* __restrict__ scale) {
    const int lane = C.lane;
    for (int r = C.gw; r < rows; r += C.ngw) {
        const half8 a = *(const half8*)(w + (size_t)r * DM + 16 * lane), b = *(const half8*)(w + (size_t)r * DM + 16 * lane + 8);
        float m = 0.f;
#pragma unroll
        for (int i = 0; i < 8; ++i) m = fmaxf(m, fmaxf(fabsf((float)a[i]), fabsf((float)b[i])));
        m = wave_max(m);
        const float inv = m > 0.f ? 127.0f / m : 0.f;
        u32x4 o;
        o[0] = (unsigned)pack4_i8((float)a[0] * inv, (float)a[1] * inv, (float)a[2] * inv, (float)a[3] * inv);
        o[1] = (unsigned)pack4_i8((float)a[4] * inv, (float)a[5] * inv, (float)a[6] * inv, (float)a[7] * inv);
        o[2] = (unsigned)pack4_i8((float)b[0] * inv, (float)b[1] * inv, (float)b[2] * inv, (float)b[3] * inv);
        o[3] = (unsigned)pack4_i8((float)b[4] * inv, (float)b[5] * inv, (float)b[6] * inv, (float)b[7] * inv);
        *(u32x4*)(q + (size_t)r * 256 + 4 * lane) = o;
        if (lane == 0) scale[r] = m * (1.0f / 127.0f);
    }
}
__device__ __forceinline__ void ph_prep(const Ctx& C, LAS unsigned char* lds, const float* const* in, unsigned char* ws) {
    LAS float* scr = (LAS float*)(lds + RING_OFF + C.wave * 16384);
    f16* wcat = (f16*)(ws + WS_WCAT); f16* wb = (f16*)(ws + WS_WB); f16* wout = (f16*)(ws + WS_WOUT); f16* wq = (f16*)(ws + WS_WQ); f16* poolw = (f16*)(ws + WS_POOLW);
    constexpr int I_IN = 16 * 40, I_G = 16 * 64, I_B = 8 * 32, I_O = 16 * 32, I_Q = 16 * 64, I_P = 2 * 4;
    constexpr int NITEMS = I_IN + I_G + 2 * I_B + I_O + I_Q + 4 * I_P;
    for (int it = C.gw; it < NITEMS; it += C.ngw) {
        int r = it;
        if (r < I_IN) { p0_transpose_item(in[2], 1024, 1280, wcat, 1024, 0, scr, r, C.lane); continue; } r -= I_IN;
        if (r < I_G) { p0_transpose_item(in[7], 1024, 2048, wcat + (size_t)NQKVU * 1024, 1024, 0, scr, r, C.lane); continue; } r -= I_G;
        if (r < I_B) { p0_transpose_item(in[6], 512, 1024, wb, 1024, 0, scr, r, C.lane); continue; } r -= I_B;
        if (r < I_B) { p0_transpose_item(in[6] + 512 * 1024, 512, 1024, wb, 1024, 512, scr, r, C.lane); continue; } r -= I_B;
        if (r < I_O) { p0_transpose_item(in[9], 1024, 1024, wout, 1024, 0, scr, r, C.lane); continue; } r -= I_O;
        if (r < I_Q) { p0_transpose_item(in[11], 1024, 2048, wq, 1024, 0, scr, r, C.lane); continue; } r -= I_Q;
        { const int g = r / I_P; p0_transpose_item(in[4] + g * 128 * 128, 128, 128, poolw + g * 128 * 128, 128, 0, scr, r % I_P, C.lane); }
    }
    cvt_stream(C, in[12], (f16*)(ws + WS_SUBK), (size_t)8 * 2 * 128 * 128 / 4);
    rowprep(C, in[0], in[1], (unsigned*)(ws + WS_XH), (float*)(ws + WS_RSX), (float*)(ws + WS_RS1));
}

__device__ __forceinline__ void ph_attn_naive(const Ctx& C, const f16* __restrict__ qkvu, const float* __restrict__ sink, f16* __restrict__ ocat) {
    for (int gid = C.gt; gid < T * 8; gid += C.ngt) {
        const int t = gid % T, h = gid / T;
        const int b = t / SEQ, ts = t % SEQ, kh = h >> 2;
        float q[64], o[64];
        const f16* qr = qkvu + (size_t)t * NQKVU + h * 64;
#pragma unroll
        for (int d = 0; d < 64; ++d) { q[d] = (float)qr[d]; o[d] = 0.f; }
        const float slope = exp2f(-(float)(h + 1));
        float m = -1e30f, l = 0.f;
        const int s0 = max(ts - 128, 0), s1 = min(ts + 128, SEQ - 1);
        for (int s = s0; s <= s1; ++s) {
            const f16* kr = qkvu + (size_t)(b * SEQ + s) * NQKVU + COL_K + kh * 64;
            const f16* vr = qkvu + (size_t)(b * SEQ + s) * NQKVU + COL_V + kh * 64;
            float dot = 0.f;
#pragma unroll
            for (int d = 0; d < 64; ++d) dot += q[d] * (float)kr[d];
            const float lg = dot * 0.125f - slope * fabsf((float)(ts - s));
            const float mn = fmaxf(m, lg), al = __expf(m - mn), p = __expf(lg - mn);
            l = l * al + p;
#pragma unroll
            for (int d = 0; d < 64; ++d) o[d] = o[d] * al + p * (float)vr[d];
            m = mn;
        }
        const float sk = sink[h];
        const float mn = fmaxf(m, sk), al = __expf(m - mn);
        l = l * al + __expf(sk - mn);
        const float inv = al / l;
        f16* orow = ocat + (size_t)t * DM + h * 64;
#pragma unroll
        for (int d = 0; d < 64; ++d) orow[d] = (f16)(o[d] * inv);
    }
}

template <int DIAG = 0>
__device__ __forceinline__ void attn_unit(const Ctx& C, int u, LAS unsigned char* lds, const f16* __restrict__ qkvu, const f16* __restrict__ vT, const float* __restrict__ sink, f16* __restrict__ ocat) {
    const int lane = C.lane, r32 = lane & 31, hh = lane >> 5;
    const int krow = (r32 & 19) | ((r32 & 4) << 1) | ((r32 & 8) >> 1);
    constexpr float L2E = 1.4426950408889634f;
    {
        const int qs = u & 63, h = (u >> 6) & 7, b = u >> 9, kh = h >> 2;
        const int tq = qs * 32 + r32;
        const float slope2 = exp2f(-(float)(h + 1)) * L2E, sink2 = sink[h] * L2E;
        const f16* qrow = qkvu + (size_t)(b * SEQ + tq) * NQKVU + h * 64 + 8 * hh;
        half8 bq[4];
#pragma unroll
        for (int ks = 0; ks < 4; ++ks) bq[ks] = *(const half8*)(qrow + 16 * ks);
        f32x16 o0, o1;
#pragma unroll
        for (int r = 0; r < 16; ++r) { o0[r] = 0.f; o1[r] = 0.f; }
        float m = -1e30f, l = 0.f;
        const int kb_lo = max(qs - 4, 0), kb_hi = min(qs + 4, 63);
        LAS unsigned char* kst = lds + 65536 + C.wave * 8192; LAS unsigned char* vst = kst + 4096;
        const int krw = lane >> 3, kch = lane & 7, vrw = lane >> 2, vch = lane & 3;
        const f16* kg = qkvu + (size_t)(b * SEQ + krw) * NQKVU + COL_K + kh * 64 + kch * 8;
        const f16* vg = vT + (size_t)((b * 2 + kh) * 64 + vrw) * SEQ + vch * 8;
        half8 gk[4], gv[4];
#pragma unroll
        for (int i = 0; i < 4; ++i) { gk[i] = *(const half8*)(kg + (size_t)(kb_lo * 32 + 8 * i) * NQKVU); gv[i] = *(const half8*)(vg + (size_t)(16 * i) * SEQ + kb_lo * 32); }
#pragma unroll 1
        for (int kb = kb_lo; kb <= kb_hi; ++kb) {
#pragma unroll
            for (int i = 0; i < 4; ++i) {
                const int kr = krw + 8 * i; *(LAS half8*)(kst + kr * 128 + ((kch ^ (kr & 7)) << 4)) = gk[i];
                const int vr = vrw + 16 * i; *(LAS half8*)(vst + vr * 64 + ((vch ^ ((vr >> 2) & 3)) << 4)) = gv[i];
            }
            LDS_WAIT();
            half8 kf[4], va[2][2];
#pragma unroll
            for (int ks = 0; ks < 4; ++ks) kf[ks] = *(const LAS half8*)(kst + krow * 128 + (((2 * ks + hh) ^ (krow & 7)) << 4));
#pragma unroll
            for (int db = 0; db < 2; ++db)
#pragma unroll
                for (int st = 0; st < 2; ++st) { const int d = db * 32 + r32; va[db][st] = *(const LAS half8*)(vst + d * 64 + (((2 * st + hh) ^ ((d >> 2) & 3)) << 4)); }
            LDS_WAIT();
            const int kn = (DIAG == 2) ? kb_lo : (kb < kb_hi ? kb + 1 : kb);
#pragma unroll
            for (int i = 0; i < 4; ++i) { gk[i] = *(const half8*)(kg + (size_t)(kn * 32 + 8 * i) * NQKVU); gv[i] = *(const half8*)(vg + (size_t)(16 * i) * SEQ + kn * 32); }
            f32x16 s;
#pragma unroll
            for (int r = 0; r < 16; ++r) s[r] = 0.f;
#pragma unroll
            for (int ks = 0; ks < 4; ++ks) s = __builtin_amdgcn_mfma_f32_32x32x16_f16(kf[ks], bq[ks], s, 0, 0, 0);
            float bmax = -1e30f; bool ok[16];
#pragma unroll
            for (int r = 0; r < 16; ++r) {
                const int tk = kb * 32 + 16 * (r >> 3) + 8 * hh + (r & 7);
                const int dist = abs(tq - tk);
                ok[r] = dist <= 128;
                s[r] = ok[r] ? s[r] * (0.125f * L2E) - slope2 * (float)dist : -1e30f;
                bmax = fmaxf(bmax, s[r]);
            }
            bmax = fmaxf(bmax, __shfl_xor(bmax, 32));
            const float mn = fmaxf(m, bmax), al = exp2f(m - mn);
            m = mn;
            float ps = 0.f; half8 pb[2];
#pragma unroll
            for (int r = 0; r < 16; ++r) { const float p = ok[r] ? (DIAG == 1 ? (s[r] - mn) : exp2f(s[r] - mn)) : 0.f; ps += p; pb[r >> 3][r & 7] = (f16)p; }
            l = l * al + ps;
#pragma unroll
            for (int r = 0; r < 16; ++r) { o0[r] *= al; o1[r] *= al; }
#pragma unroll
            for (int st = 0; st < 2; ++st) { o0 = __builtin_amdgcn_mfma_f32_32x32x16_f16(va[0][st], pb[st], o0, 0, 0, 0); o1 = __builtin_amdgcn_mfma_f32_32x32x16_f16(va[1][st], pb[st], o1, 0, 0, 0); }
        }
        l += __shfl_xor(l, 32);
        const float mf = fmaxf(m, sink2), al = exp2f(m - mf);
        const float sc = al / (l * al + exp2f(sink2 - mf));
        f16* orow = ocat + (size_t)(b * SEQ + tq) * DM + h * 64 + 4 * hh;
#pragma unroll
        for (int g = 0; g < 4; ++g) {
            half4 a, c;
#pragma unroll
            for (int i = 0; i < 4; ++i) { a[i] = (f16)(o0[4 * g + i] * sc); c[i] = (f16)(o1[4 * g + i] * sc); }
            *(half4*)(orow + 8 * g) = a; *(half4*)(orow + 32 + 8 * g) = c;
        }
    }
}

__device__ __forceinline__ void attn_unit2(const Ctx& C, int u, LAS unsigned char* lds, const f16* __restrict__ qkvu, const f16* __restrict__ vT, const float* __restrict__ sink, f16* __restrict__ ocat) {
    const int lane = C.lane, r32 = lane & 31, hh = lane >> 5;
    const int krow = (r32 & 19) | ((r32 & 4) << 1) | ((r32 & 8) >> 1);
    constexpr float L2E = 1.4426950408889634f;
    const int qp = u & 31, h = (u >> 5) & 7, b = u >> 8, kh = h >> 2;
    const float slope2 = exp2f(-(float)(h + 1)) * L2E, sink2 = sink[h] * L2E;
    const float bbase = slope2 * (float)(r32 - 8 * hh);
    constexpr float THR = 6.0f;
    LAS unsigned char* qst = lds + 65536 + C.wave * 8192 + lane * 16;
    f32x16 o0[2], o1[2]; float m[2], l[2]; int tq[2];
#pragma unroll
    for (int j = 0; j < 2; ++j) {
        tq[j] = (2 * qp + j) * 32 + r32;
        const f16* qrow = qkvu + (size_t)(b * SEQ + tq[j]) * NQKVU + h * 64 + 8 * hh;
#pragma unroll
        for (int ks = 0; ks < 4; ++ks) *(LAS half8*)(qst + (j * 4 + ks) * 1024) = *(const half8*)(qrow + 16 * ks);
#pragma unroll
        for (int r = 0; r < 16; ++r) { o0[j][r] = 0.f; o1[j][r] = 0.f; }
        m[j] = -1e30f; l[j] = 0.f;
    }
    const int kb_lo = max(2 * qp - 4, 0), kb_hi = min(2 * qp + 5, 63);
    LAS unsigned char* kst = lds + C.wave * 8192;
    const int krw = lane >> 3, kch = lane & 7;
    const f16* kg = qkvu + (size_t)(b * SEQ + krw) * NQKVU + COL_K + kh * 64 + kch * 8;
    const f16* vbase = vT + (size_t)((b * 2 + kh) * 64 + r32) * SEQ + 8 * hh;
    half8 gk[4];
#pragma unroll
    for (int i = 0; i < 4; ++i) gk[i] = *(const half8*)(kg + (size_t)(kb_lo * 32 + 8 * i) * NQKVU);
#pragma unroll 1
    for (int kb = kb_lo; kb <= kb_hi; ++kb) {
        half8 kf[4], va[2][2];
#pragma unroll
        for (int db = 0; db < 2; ++db)
#pragma unroll
            for (int st = 0; st < 2; ++st) va[db][st] = *(const half8*)(vbase + (size_t)(db * 32) * SEQ + kb * 32 + 16 * st);
#pragma unroll
        for (int i = 0; i < 4; ++i) { const int kr = krw + 8 * i; *(LAS half8*)(kst + kr * 128 + ((kch ^ (kr & 7)) << 4)) = gk[i]; }
        LDS_WAIT();
#pragma unroll
        for (int ks = 0; ks < 4; ++ks) kf[ks] = *(const LAS half8*)(kst + krow * 128 + (((2 * ks + hh) ^ (krow & 7)) << 4));
        LDS_WAIT();
        const int kn = kb < kb_hi ? kb + 1 : kb;
#pragma unroll
        for (int i = 0; i < 4; ++i) gk[i] = *(const half8*)(kg + (size_t)(kn * 32 + 8 * i) * NQKVU);
#pragma unroll
        for (int j = 0; j < 2; ++j) {
            if (abs(kb - (2 * qp + j)) > 4) continue;
            const int D = (2 * qp + j) - kb;
            f32x16 s;
#pragma unroll
            for (int r = 0; r < 16; ++r) s[r] = 0.f;
#pragma unroll
            for (int ks = 0; ks < 4; ++ks) s = __builtin_amdgcn_mfma_f32_32x32x16_f16(kf[ks], *(const volatile LAS half8*)(qst + (j * 4 + ks) * 1024), s, 0, 0, 0);
            const float B = slope2 * 32.0f * (float)abs(D);
            float bm = -1e30f;
            if (D != 0) {
                const float ssl = D > 0 ? slope2 : -slope2, sb = D > 0 ? -bbase : bbase;
#pragma unroll
                for (int r = 0; r < 16; ++r) { const float bias = fmaf(ssl, (float)(16 * (r >> 3) + (r & 7)), sb); s[r] = fmaf(s[r], 0.125f * L2E, bias);
                    if (abs(D) == 4) s[r] = bias < -0.5f * slope2 ? -1e30f : s[r]; }
            } else {
#pragma unroll
                for (int r = 0; r < 16; ++r) s[r] = fmaf(s[r], 0.125f * L2E, -fabsf(fmaf(-slope2, (float)(16 * (r >> 3) + (r & 7)), bbase)));
            }
#pragma unroll
            for (int r = 0; r < 16; ++r) bm = fmaxf(bm, s[r]);
            bm = fmaxf(bm, __shfl_xor(bm, 32)) - B;
            {
                const float mn = (bm > m[j] + THR) ? bm : m[j], al = __builtin_amdgcn_exp2f(m[j] - mn);
                m[j] = mn; l[j] *= al;
#pragma unroll
                for (int r = 0; r < 16; ++r) { o0[j][r] *= al; o1[j][r] *= al; }
            }
            const float mb = m[j] + B;
            float ps = 0.f; half8 pb[2];
#pragma unroll
            for (int r = 0; r < 16; ++r) { const float pv = __builtin_amdgcn_exp2f(s[r] - mb); ps += pv; pb[r >> 3][r & 7] = (f16)pv; }
            l[j] += ps;
#pragma unroll
            for (int st = 0; st < 2; ++st) { o0[j] = __builtin_amdgcn_mfma_f32_32x32x16_f16(va[0][st], pb[st], o0[j], 0, 0, 0); o1[j] = __builtin_amdgcn_mfma_f32_32x32x16_f16(va[1][st], pb[st], o1[j], 0, 0, 0); }
            __builtin_amdgcn_sched_barrier(0);
        }
    }
#pragma unroll
    for (int j = 0; j < 2; ++j) {
        const float lt = l[j] + __shfl_xor(l[j], 32);
        const float mf = fmaxf(m[j], sink2), al = __builtin_amdgcn_exp2f(m[j] - mf);
        const float sc = al / (lt * al + __builtin_amdgcn_exp2f(sink2 - mf));
        LDS_WAIT();
#pragma unroll
        for (int g = 0; g < 4; ++g) {
            half4 a, c;
#pragma unroll
            for (int i = 0; i < 4; ++i) { a[i] = (f16)(o0[j][4 * g + i] * sc); c[i] = (f16)(o1[j][4 * g + i] * sc); }
            *(LAS half4*)(kst + r32 * 128 + ((g ^ (r32 & 7)) << 4) + 8 * hh) = a;
            *(LAS half4*)(kst + r32 * 128 + (((4 + g) ^ (r32 & 7)) << 4) + 8 * hh) = c;
        }
        LDS_WAIT();
#pragma unroll
        for (int i = 0; i < 4; ++i) {
            const int row = (lane >> 3) + 8 * i, ch = lane & 7;
            const half8 v = *(const LAS half8*)(kst + row * 128 + ((ch ^ (row & 7)) << 4));
            *(half8*)(ocat + (size_t)(b * SEQ + (2 * qp + j) * 32 + row) * DM + h * 64 + ch * 8) = v;
        }
    }
}

__device__ __forceinline__ void ph_pool_naive(const Ctx& C, const f16* __restrict__ qkvu, f16* __restrict__ mixed) {
    for (size_t gid = (size_t)C.gt; gid < (size_t)T * 512; gid += (size_t)C.ngt) {
        const int c = (int)(gid & 511), t = (int)(gid >> 9);
        const int b = t / SEQ, ts = t % SEQ, g = c >> 7, w = 2 << g;
        const int lo = max(ts - w / 2, 0), hi = min(ts + w / 2, SEQ);
        float s = 0.f;
        for (int i = lo; i < hi; ++i) s += (float)qkvu[(size_t)(b * SEQ + i) * NQKVU + COL_U + c];
        const float mean = s / (float)(hi - lo);
        mixed[(size_t)t * 512 + c] = (f16)(mean - (float)qkvu[(size_t)t * NQKVU + COL_U + c]);
    }
}
__device__ __forceinline__ void ph_poolmm_naive(const Ctx& C, const f16* __restrict__ mixed, const f16* __restrict__ poolw_t, const float* __restrict__ pscale, f16* __restrict__ ocat) {
    for (size_t gid = (size_t)C.gt; gid < (size_t)T * 512; gid += (size_t)C.ngt) {
        const int n = (int)(gid & 511), t = (int)(gid >> 9), g = n >> 7, d = n & 127;
        const f16* mr = mixed + (size_t)t * 512 + g * 128;
        const f16* wr = poolw_t + (size_t)(g * 128 + d) * 128;
        float acc = 0.f;
        for (int c = 0; c < 128; ++c) acc += (float)mr[c] * (float)wr[c];
        ocat[(size_t)t * DM + 512 + n] = (f16)(acc * pscale[n]);
    }
}

template <int HW>
__device__ __forceinline__ void pool_step1(const f16* __restrict__ qkvu, LAS unsigned char* tile, int t0, int g, int lane) {
    const int c2 = lane, b = t0 >> 11, sf = t0 & (SEQ - 1);
    const f16* ub = qkvu + (size_t)(b * SEQ) * NQKVU + COL_U + g * 128 + 2 * c2;
    constexpr int NR = 32 + 2 * HW - 1;
    half2 v[NR];
#pragma unroll
    for (int i = 0; i < NR; ++i) { const int s = sf - HW + i; half2 z; z[0] = (f16)0.f; z[1] = (f16)0.f; v[i] = z; if (s >= 0 && s < SEQ) v[i] = *(const half2*)(ub + (size_t)s * NQKVU); }
    float s0 = 0.f, s1 = 0.f;
#pragma unroll
    for (int i = 0; i < 2 * HW - 1; ++i) { s0 += (float)v[i][0]; s1 += (float)v[i][1]; }
#pragma unroll
    for (int j = 0; j < 32; ++j) {
        s0 += (float)v[j + 2 * HW - 1][0]; s1 += (float)v[j + 2 * HW - 1][1];
        const int s = sf + j, lo = max(s - HW, 0), hi = min(s + HW, SEQ);
        const float inv = 1.0f / (float)(hi - lo);
        half2 mx; mx[0] = (f16)(s0 * inv - (float)v[j + HW][0]); mx[1] = (f16)(s1 * inv - (float)v[j + HW][1]);
        *(LAS half2*)(tile + j * 256 + (((c2 >> 2) ^ (j & 15)) << 4) + ((c2 & 3) << 2)) = mx;
        s0 -= (float)v[j][0]; s1 -= (float)v[j][1];
    }
}
__device__ __forceinline__ void pool_unit(const Ctx& C, int u, LAS unsigned char* lds, const f16* __restrict__ qkvu, const f16* __restrict__ poolw_t, const float* __restrict__ pscale, f16* __restrict__ ocat) {
    const int lane = C.lane, r32 = lane & 31, hh = lane >> 5;
    LAS unsigned char* tile = lds + C.wave * 8192;
    const int g = u & 3, t0 = (u >> 2) * 32;
    switch (g) { case 0: pool_step1<1>(qkvu, tile, t0, g, lane); break; case 1: pool_step1<2>(qkvu, tile, t0, g, lane); break;
                 case 2: pool_step1<4>(qkvu, tile, t0, g, lane); break; default: pool_step1<8>(qkvu, tile, t0, g, lane); break; }
    LDS_WAIT();
    f32x16 acc[4];
#pragma unroll
    for (int db = 0; db < 4; ++db)
#pragma unroll
        for (int r = 0; r < 16; ++r) acc[db][r] = 0.f;
    const f16* wr = poolw_t + (size_t)(g * 128 + r32) * 128 + 8 * hh;
#pragma unroll
    for (int ks = 0; ks < 8; ++ks) {
        const half8 bm = *(const LAS half8*)(tile + r32 * 256 + (((2 * ks + hh) ^ (r32 & 15)) << 4));
#pragma unroll
        for (int db = 0; db < 4; ++db) { const half8 a = *(const half8*)(wr + (size_t)(db * 32) * 128 + 16 * ks); acc[db] = __builtin_amdgcn_mfma_f32_32x32x16_f16(a, bm, acc[db], 0, 0, 0); }
    }
    LDS_WAIT();
    f16* orow = ocat + (size_t)(t0 + r32) * DM + 512 + g * 128 + 4 * hh;
    const float* ps = pscale + g * 128 + 4 * hh;
#pragma unroll
    for (int db = 0; db < 4; ++db)
#pragma unroll
        for (int q = 0; q < 4; ++q) {
            const f32x4 pv = *(const f32x4*)(ps + db * 32 + 8 * q);
            half4 x0;
#pragma unroll
            for (int i = 0; i < 4; ++i) x0[i] = (f16)(acc[db][4 * q + i] * pv[i]);
            *(half4*)(orow + db * 32 + 8 * q) = x0;
        }
}
__device__ __forceinline__ void ph_attn_pool(const Ctx& C, LAS unsigned char* lds, const f16* __restrict__ qkvu, const f16* __restrict__ vT, const float* __restrict__ sink,
                                             const f16* __restrict__ poolw_t, const float* __restrict__ pscale, f16* __restrict__ ocat) {
    const int vwg = (C.G % 8 == 0) ? (int)(blockIdx.x % 8) * (C.G / 8) + (int)(blockIdx.x / 8) : (int)blockIdx.x;
    const bool pool_first = (C.wave & 4) != 0;
    for (int i = 0, m = vwg * NWAVES + C.wave; m < (T / 32) * 4; ++i) {
        if (((i & 1) == 0) == pool_first) pool_unit(C, m, lds, qkvu, poolw_t, pscale, ocat);
        else attn_unit2(C, m, lds, qkvu, vT, sink, ocat);
        if (i & 1) m += C.ngw;
    }
}

#define INS(LV, LI, v_, i_) do { float cv_ = (v_); int ci_ = (i_); \
    _Pragma("unroll") for (int z_ = 0; z_ < 16; ++z_) { const bool gt_ = cv_ > LV[z_]; const float tv_ = gt_ ? LV[z_] : cv_; const int ti_ = gt_ ? LI[z_] : ci_; \
        LV[z_] = gt_ ? cv_ : LV[z_]; LI[z_] = gt_ ? ci_ : LI[z_]; cv_ = tv_; ci_ = ti_; } } while (0)
__device__ __forceinline__ void ph_route_naive(const Ctx& C, const f16* __restrict__ qp, const float* __restrict__ ss2, const f16* __restrict__ subk, int* __restrict__ eidx, float* __restrict__ egate) {
    for (int gid = C.gt; gid < T * 8; gid += C.ngt) {
        const int t = gid % T, h = gid / T;
        const float rs2 = rs_from_ss(ss2, t);
        float av[16], bv[16]; int ai[16], bi[16];
#pragma unroll
        for (int z = 0; z < 16; ++z) { av[z] = -3e38f; bv[z] = -3e38f; ai[z] = 0; bi[z] = 0; }
        for (int p = 0; p < 2; ++p) {
            const f16* qr = qp + (size_t)t * 2048 + h * 256 + p * 128;
            for (int n = 0; n < 128; ++n) {
                const f16* kr = subk + ((size_t)((h * 2 + p) * 128 + n)) * 128;
                float dot = 0.f;
                for (int c = 0; c < 128; ++c) dot += (float)qr[c] * (float)kr[c];
                dot *= rs2;
                if (p == 0) INS(av, ai, dot, n); else INS(bv, bi, dot, n);
            }
        }
        float cv[16]; int ci[16];
#pragma unroll
        for (int z = 0; z < 16; ++z) { cv[z] = -3e38f; ci[z] = 0; }
#pragma unroll
        for (int i = 0; i < 16; ++i)
#pragma unroll
            for (int j = 0; j < 16; ++j)
                if ((i + 1) * (j + 1) <= 16) INS(cv, ci, av[i] + bv[j], ai[i] * 128 + bi[j]);
        float sum = 0.f, e[16];
#pragma unroll
        for (int z = 0; z < 16; ++z) { e[z] = __expf(cv[z] - cv[0]); sum += e[z]; }
        const float inv = 1.0f / sum;
#pragma unroll
        for (int z = 0; z < 16; ++z) { eidx[(size_t)t * 128 + h * 16 + z] = ci[z]; egate[(size_t)t * 128 + h * 16 + z] = e[z] * inv; }
    }
}

__device__ __forceinline__ int mono_i(float f) { const int b = __float_as_int(f); return b ^ ((b >> 31) & 0x7fffffff); }
__device__ __forceinline__ float unmono_f(int m) { return __int_as_float(m ^ ((m >> 31) & 0x7fffffff)); }
#define INS16(Lst, x_) do { int xv_ = (x_); _Pragma("unroll") for (int z_ = 0; z_ < 16; ++z_) { const int hi_ = max(Lst[z_], xv_); xv_ = min(Lst[z_], xv_); Lst[z_] = hi_; } } while (0)
__device__ __forceinline__ void merge_pair16(int (&Lst)[16]) {
    int P[16];
#pragma unroll
    for (int z = 0; z < 16; ++z) P[z] = __shfl_xor(Lst[z], 32);
#pragma unroll
    for (int z = 0; z < 16; ++z) Lst[z] = max(Lst[z], P[15 - z]);
#pragma unroll
    for (int s = 8; s >= 1; s >>= 1)
#pragma unroll
        for (int i = 0; i < 16; ++i) if ((i & s) == 0) { const int hi = max(Lst[i], Lst[i + s]), lo = min(Lst[i], Lst[i + s]); Lst[i] = hi; Lst[i + s] = lo; }
}
__device__ __forceinline__ void bitonic_sort16_desc(int (&K)[16]) {
#pragma unroll
    for (int k = 2; k <= 16; k <<= 1)
#pragma unroll
        for (int j = k >> 1; j > 0; j >>= 1)
#pragma unroll
            for (int i = 0; i < 16; ++i) { const int l = i ^ j; if (l > i) { const int a = K[i], b = K[l], hi = max(a, b), lo = min(a, b); const bool desc = (i & k) == 0; K[i] = desc ? hi : lo; K[l] = desc ? lo : hi; } }
}
__device__ __forceinline__ void bitonic_merge16_desc(int (&K)[16]) {
#pragma unroll
    for (int s = 8; s >= 1; s >>= 1)
#pragma unroll
        for (int i = 0; i < 16; ++i) if ((i & s) == 0) { const int hi = max(K[i], K[i + s]), lo = min(K[i], K[i + s]); K[i] = hi; K[i + s] = lo; }
}
template <class Side>
__device__ __forceinline__ void ph_route(const Ctx& C, LAS unsigned char* lds, const f16* __restrict__ qp, const float* __restrict__ ss2, const f16* __restrict__ subk,
                                         int* __restrict__ eidx, float* __restrict__ egate, const Side& side_job) {
    const int lane = C.lane, r32 = lane & 31, hh = lane >> 5;
    LAS unsigned char* tab = lds + 65536 + C.wave * 4096 + lane * 36;
    const int GH = C.G < 8 ? C.G : 8;
  for (int h = blockIdx.x % GH; h < 8; h += GH) {
    const int rank_h = blockIdx.x / GH, nwg_h = (C.G - (blockIdx.x % GH) + GH - 1) / GH;
    __syncthreads();
    for (int i = C.tid; i < 2 * 128 * 16; i += NTHREADS) {
        const int row = i >> 4, ch = i & 15;
        *(LAS half8*)(lds + row * 256 + ((ch ^ (row & 15)) << 4)) = *(const half8*)(subk + (size_t)(h * 256 + row) * 128 + ch * 8);
    }
    __syncthreads();
    if (h == (int)(blockIdx.x % GH) && (C.wave & 4)) side_job();
    for (int tb = rank_h * NWAVES + C.wave; tb < T / 32; tb += nwg_h * NWAVES) {
        const int t0 = tb * 32, t = t0 + r32;
        int top[2][16];
#pragma unroll
        for (int p = 0; p < 2; ++p) {
            const f16* qrow = qp + (size_t)t * 2048 + h * 256 + p * 128 + 8 * hh;
            const LAS unsigned char* kl = lds + (p * 128 + r32) * 256;
            half8 bq[8];
#pragma unroll
            for (int ks = 0; ks < 8; ++ks) bq[ks] = *(const half8*)(qrow + 16 * ks);
            int Lst[16];
#pragma unroll
            for (int z = 0; z < 16; ++z) Lst[z] = (int)0x80000000;
#pragma unroll 1
            for (int nb = 0; nb < 4; ++nb) {
                f32x16 acc = {0.f, 0.f, 0.f, 0.f, 0.f, 0.f, 0.f, 0.f, 0.f, 0.f, 0.f, 0.f, 0.f, 0.f, 0.f, 0.f};
#pragma unroll
                for (int ks = 0; ks < 8; ++ks) {
                    const half8 ak = *(const LAS half8*)(kl + nb * 32 * 256 + (((2 * ks + hh) ^ (r32 & 15)) << 4));
                    acc = __builtin_amdgcn_mfma_f32_32x32x16_f16(ak, bq[ks], acc, 0, 0, 0);
                }
                int K[16];
#pragma unroll
                for (int r = 0; r < 16; ++r) { const int n = nb * 32 + (r & 3) + 8 * (r >> 2) + 4 * hh; K[r] = (mono_i(acc[r]) & ~127) | (127 - n); }
                bitonic_sort16_desc(K);
#pragma unroll
                for (int z = 0; z < 16; ++z) Lst[z] = max(Lst[z], K[15 - z]);
                bitonic_merge16_desc(Lst);
            }
            merge_pair16(Lst);
#pragma unroll
            for (int z = 0; z < 16; ++z) top[p][z] = Lst[z];
        }
        float va[16], vb[16];
#pragma unroll
        for (int z = 0; z < 16; ++z) { va[z] = unmono_f(top[0][z] & ~127); vb[z] = unmono_f(top[1][z] & ~127);
            tab[z] = (unsigned char)(127 - (top[0][z] & 127)); tab[16 + z] = (unsigned char)(127 - (top[1][z] & 127)); }
        int Cl[16];
        { const float a01 = hh ? va[1] : va[0];
#pragma unroll
          for (int j = 0; j < 16; ++j) { const int key = (mono_i(a01 + vb[j]) & ~255) | (255 - (hh * 16 + j)); Cl[j] = (hh && j >= 8) ? (int)0x80000000 : key; } }
#pragma unroll
        for (int i = 2; i < 16; i += 2) {
            const float ai = hh ? va[i + 1] : va[i];
#pragma unroll
            for (int j = 0; j < 16; ++j)
                if ((i + 1) * (j + 1) <= 16) {
                    int key = (mono_i(ai + vb[j]) & ~255) | (255 - ((i + hh) * 16 + j));
                    if ((i + 2) * (j + 1) > 16) key = hh ? (int)0x80000000 : key;
                    INS16(Cl, key);
                }
        }
        merge_pair16(Cl);
        float e[16], sum = 0.f; const float mx = unmono_f(Cl[0] & ~255);
#pragma unroll
        for (int z = 0; z < 16; ++z) { e[z] = __expf(unmono_f(Cl[z] & ~255) - mx); sum += e[z]; }
        const float inv = 1.0f / sum;
        LDS_WAIT();
        int* ei = eidx + (size_t)t * 128 + h * 16 + 8 * hh; float* eg = egate + (size_t)t * 128 + h * 16 + 8 * hh;
#pragma unroll
        for (int z = 0; z < 16; ++z) {
            if ((z >> 3) == hh) { const int code = 255 - (Cl[z] & 255); const int ia = tab[code >> 4], ib = tab[16 + (code & 15)];
                ei[z & 7] = ia * 128 + ib; eg[z & 7] = e[z] * inv; }
        }
        LDS_WAIT();
    }
  }
}

struct Slicing { int m, pi, nloc, rank; };
__device__ __forceinline__ Slicing get_slicing(const unsigned* bar, volatile LAS unsigned* misc) {
    Slicing S; const unsigned x = (unsigned)__builtin_amdgcn_s_getreg((3 << 11) | 20) & 0xFu;
    int m = 0, pi = 0, nloc = 1;
    for (unsigned j = 0; j < 16; ++j) { const unsigned c = __hip_atomic_load(&bar[256 + 64 * j], __ATOMIC_RELAXED, __HIP_MEMORY_SCOPE_AGENT); if (c > 0u) { if (j < x) ++pi; ++m; } if (j == x) nloc = (int)c; }
    S.m = m > 0 ? m : 1; S.pi = pi; S.nloc = nloc > 0 ? nloc : 1; S.rank = (int)misc[10];
    return S;
}
__device__ __forceinline__ float gelu_fast(float v) {
    const float av = fabsf(v), t = __builtin_amdgcn_rcpf(av * 0.2316418882f + 1.0f);
    float q = t * 0.5307027145f + (-0.7265760135f); q = q * t + 0.7107068705f; q = q * t + (-0.142248368f); q = q * t + 0.127414796f; q = q * t;
    const float m = v * (q * __builtin_amdgcn_exp2f((v * v) * (-0.72134752044f)));
    return v < 0.f ? m : v - m;
}
__device__ __forceinline__ void ph_h2quant(const Ctx& C, const f16* __restrict__ x1h, const float* __restrict__ g2, const float* __restrict__ ss2, unsigned* __restrict__ h2q, float* __restrict__ hsc) {
    const int lane = C.lane;
    f32x4 gv[4];
#pragma unroll
    for (int j = 0; j < 4; ++j) gv[j] = *(const f32x4*)(g2 + 16 * lane + 4 * j);
    for (int t = C.gw; t < T; t += C.ngw) {
        const half8 h0 = *(const half8*)(x1h + (size_t)t * DM + 16 * lane), h1 = *(const half8*)(x1h + (size_t)t * DM + 16 * lane + 8);
        float f[16]; float hm = 0.f;
#pragma unroll
        for (int i = 0; i < 8; ++i) { f[i] = (float)h0[i] * gv[i >> 2][i & 3]; f[8 + i] = (float)h1[i] * gv[2 + (i >> 2)][i & 3]; hm = fmaxf(hm, fmaxf(fabsf(f[i]), fabsf(f[8 + i]))); }
        hm = wave_max(hm);
        const float inv = hm > 0.f ? 127.0f / hm : 0.f;
        u32x4 w;
#pragma unroll
        for (int j = 0; j < 4; ++j) w[j] = (unsigned)pack4_i8(f[4 * j] * inv, f[4 * j + 1] * inv, f[4 * j + 2] * inv, f[4 * j + 3] * inv);
        *(u32x4*)(h2q + (size_t)t * 256 + 4 * lane) = w;
        if (lane == 0) hsc[t] = hm * (1.0f / 127.0f) * rs_from_ss(ss2, t);
    }
}
__device__ __forceinline__ __amdgpu_buffer_rsrc_t slice_rsrc(const unsigned char* base) {
    const unsigned long long b = (unsigned long long)base;
    const unsigned lo = __builtin_amdgcn_readfirstlane((unsigned)b), hi = __builtin_amdgcn_readfirstlane((unsigned)(b >> 32));
    return __builtin_amdgcn_make_buffer_rsrc((void*)(((unsigned long long)hi << 32) | lo), 0, NEXP * 128, 0x00020000);
}
template <int EMASK>
__device__ __forceinline__ void ph_upeer(const Ctx& C, LAS unsigned char* lds, const Slicing SL, const unsigned* __restrict__ h2q, const int* __restrict__ eidx,
                                         const unsigned char* __restrict__ uq, short* __restrict__ pdot) {
    const int lane = C.lane, grp = lane >> 3, c8 = lane & 7;
    const int wv = SL.rank * NWAVES + C.wave, nwv = SL.nloc * NWAVES;
    const int ntok = (T - wv + nwv - 1) / nwv;
    auto tok = [&](int i) { const int t = wv + i * nwv; return t < T ? t : T - 1; };
    volatile LAS int* row = (volatile LAS int*)(lds + C.wave * 1024);
  for (int s = SL.pi; s < 8; s += SL.m) {
    const __amdgpu_buffer_rsrc_t urs = slice_rsrc(uq + (size_t)s * (NEXP * 128));
    const unsigned* hqs = h2q + s * 32 + c8 * 4;
    int tA = tok(0), tB = tok(1);
    int e0 = eidx[(size_t)tA * 128 + lane], e1 = eidx[(size_t)tA * 128 + 64 + lane];
    u32x4 hq = *(const u32x4*)(hqs + (size_t)tA * 256);
    int ne0 = eidx[(size_t)tB * 128 + lane], ne1 = eidx[(size_t)tB * 128 + 64 + lane];
    u32x4 r[16];
#pragma unroll
    for (int i = 0; i < 16; ++i) { const int e = __shfl(i < 8 ? e0 : e1, 8 * (i & 7) + grp) & EMASK; r[i] = __builtin_amdgcn_raw_buffer_load_b128(urs, e * 128 + c8 * 16, 0, 0); }
#pragma unroll 1
    for (int it = 0; it < ntok; ++it) {
        const int t = tok(it), t1 = tok(it + 1), t2 = tok(it + 2);
        const int ze0 = eidx[(size_t)t2 * 128 + lane], ze1 = eidx[(size_t)t2 * 128 + 64 + lane];
        const u32x4 nhq = *(const u32x4*)(hqs + (size_t)t1 * 256);
#pragma unroll
        for (int q = 0; q < 4; ++q) {
            int evv[4];
#pragma unroll
            for (int j = 0; j < 4; ++j) evv[j] = __shfl(q < 2 ? ne0 : ne1, 32 * (q & 1) + 8 * j + grp) & EMASK;
            int pa[4], pb[4];
#pragma unroll
            for (int j = 0; j < 4; ++j) {
                pa[j] = __builtin_amdgcn_sdot4((int)r[4 * q + j][0], (int)hq[0], 0, false); pb[j] = __builtin_amdgcn_sdot4((int)r[4 * q + j][1], (int)hq[1], 0, false);
                pa[j] = __builtin_amdgcn_sdot4((int)r[4 * q + j][2], (int)hq[2], pa[j], false); pb[j] = __builtin_amdgcn_sdot4((int)r[4 * q + j][3], (int)hq[3], pb[j], false);
            }
#pragma unroll
            for (int j = 0; j < 4; ++j) { pa[j] += pb[j]; pa[j] += dppi<0xB1>(pa[j]); }
#pragma unroll
            for (int j = 0; j < 4; ++j) pa[j] += dppi<0x4E>(pa[j]);
#pragma unroll
            for (int j = 0; j < 4; ++j) pa[j] += dppi<0x141>(pa[j]);
            if (c8 == 0) {
#pragma unroll
                for (int j = 0; j < 4; ++j) row[8 * (4 * q + j) + grp] = pa[j];
            }
#pragma unroll
            for (int j = 0; j < 4; ++j) {
                asm volatile("" ::: "memory");
                r[4 * q + j] = __builtin_amdgcn_raw_buffer_load_b128(urs, evv[j] * 128 + c8 * 16, 0, 0);
                asm volatile("" ::: "memory");
            }
        }
        LDS_WAIT();
        const int p0 = row[lane], p1 = row[64 + lane];
        LDS_WAIT();
        { short* pp = pdot + ((size_t)s * T + t) * 128 + lane; const int c0 = min(max((p0 + 4) >> 3, -32768), 32767), c1 = min(max((p1 + 4) >> 3, -32768), 32767);
          asm volatile("global_store_short %0, %1, off\n\tglobal_store_short %0, %2, off offset:128" :: "v"(pp), "v"(c0), "v"(c1) : "memory"); }
        hq = nhq; ne0 = ze0; ne1 = ze1;
    }
  }
}
__device__ __forceinline__ void ph_ureduce(const Ctx& C, LAS unsigned char* lds, const short* __restrict__ pdot, const float* __restrict__ hsc, const int* __restrict__ eidx, const float* __restrict__ us,
                                           const float* __restrict__ vs, const float* __restrict__ egate, unsigned* __restrict__ wqp, float* __restrict__ wsc) {
    const int lane = C.lane;
    volatile LAS unsigned char* row = (volatile LAS unsigned char*)(lds + C.wave * 1024);
    for (int tb = C.gw * 2; tb < T; tb += C.ngw * 2) {
        int e0[2], e1[2], s0[2], s1[2]; float h[2], g0[2], g1[2];
#pragma unroll
        for (int u = 0; u < 2; ++u) {
            const int t = tb + u;
            e0[u] = eidx[(size_t)t * 128 + lane]; e1[u] = eidx[(size_t)t * 128 + 64 + lane];
            g0[u] = egate[(size_t)t * 128 + lane]; g1[u] = egate[(size_t)t * 128 + 64 + lane];
            h[u] = hsc[t]; s0[u] = 0; s1[u] = 0;
#pragma unroll
            for (int s = 0; s < 8; ++s) { const short* pp = pdot + ((size_t)s * T + t) * 128 + lane; s0[u] += (int)pp[0]; s1[u] += (int)pp[64]; }
        }
        float w0[2], w1[2];
#pragma unroll
        for (int u = 0; u < 2; ++u) {
            w0[u] = gelu_fast((float)s0[u] * (8.0f * h[u]) * us[e0[u]]) * g0[u] * vs[e0[u]];
            w1[u] = gelu_fast((float)s1[u] * (8.0f * h[u]) * us[e1[u]]) * g1[u] * vs[e1[u]];
        }
#pragma unroll
        for (int u = 0; u < 2; ++u) {
            const int t = tb + u;
            const float wm = wave_max(fmaxf(fabsf(w0[u]), fabsf(w1[u])));
            const float inv = wm > 0.f ? 127.0f / wm : 0.f;
            { const int k = lane; row[u * 128 + (k & 7) * 16 + (k >> 5) * 4 + ((k >> 3) & 3)] = (unsigned char)(int)rintf(w0[u] * inv); }
            { const int k = 64 + lane; row[u * 128 + (k & 7) * 16 + (k >> 5) * 4 + ((k >> 3) & 3)] = (unsigned char)(int)rintf(w1[u] * inv); }
            if (lane == 0) wsc[t] = wm * (1.0f / 127.0f);
        }
        LDS_WAIT();
        wqp[(size_t)tb * 32 + lane] = ((volatile LAS unsigned*)row)[lane];
        LDS_WAIT();
    }
}
template <int EMASK>
__device__ __forceinline__ void ph_vpeer(const Ctx& C, const Slicing SL, const int* __restrict__ eidx, const unsigned* __restrict__ wqp, const float* __restrict__ wsc, const unsigned char* __restrict__ vq,
                                         f16* __restrict__ peer) {
    const int lane = C.lane, grp = lane >> 3, c8 = lane & 7;
    const bool hh = (lane & 32) != 0, b4 = (lane & 16) != 0, b3 = (lane & 8) != 0;
    const int wv = SL.rank * NWAVES + C.wave, nwv = SL.nloc * NWAVES;
    const int ntok = (T - wv + nwv - 1) / nwv;
    auto tok = [&](int i) { const int t = wv + i * nwv; return t < T ? t : T - 1; };
  for (int s = SL.pi; s < 8; s += SL.m) {
    const __amdgpu_buffer_rsrc_t vrs = slice_rsrc(vq + (size_t)s * (NEXP * 128));
    const int chl = 8 * (hh ? 1 : 0) + 4 * (b4 ? 1 : 0) + 2 * (b3 ? 1 : 0);
    const int coff = s * 128 + c8 * 16 + chl;
    int tA = tok(0), tB = tok(1);
    int e0 = eidx[(size_t)tA * 128 + lane], e1 = eidx[(size_t)tA * 128 + 64 + lane];
    u32x4 wq = *(const u32x4*)(wqp + (size_t)tA * 32 + grp * 4); float wscale = wsc[tA];
    int ne0 = eidx[(size_t)tB * 128 + lane], ne1 = eidx[(size_t)tB * 128 + 64 + lane];
    u32x4 r[16];
#pragma unroll
    for (int i = 0; i < 16; ++i) { const int e = __shfl(i < 8 ? e0 : e1, 8 * (i & 7) + grp) & EMASK; r[i] = __builtin_amdgcn_raw_buffer_load_b128(vrs, e * 128 + c8 * 16, 0, 0); }
#pragma unroll 1
    for (int it = 0; it < ntok; ++it) {
        const int t = tok(it), t1 = tok(it + 1), t2 = tok(it + 2);
        const int ze0 = eidx[(size_t)t2 * 128 + lane], ze1 = eidx[(size_t)t2 * 128 + 64 + lane];
        const u32x4 nwq = *(const u32x4*)(wqp + (size_t)t1 * 32 + grp * 4); const float nwscale = wsc[t1];
        int o[16];
#pragma unroll
        for (int c = 0; c < 16; ++c) o[c] = 0;
#pragma unroll
        for (int q = 0; q < 4; ++q) {
            int evv[4];
#pragma unroll
            for (int j = 0; j < 4; ++j) evv[j] = __shfl(q < 2 ? ne0 : ne1, 32 * (q & 1) + 8 * j + grp) & EMASK;
#pragma unroll
            for (int d = 0; d < 4; ++d) {
                const unsigned a = r[4 * q][d], b = r[4 * q + 1][d], c = r[4 * q + 2][d], e = r[4 * q + 3][d];
                const unsigned t0 = __builtin_amdgcn_perm(b, a, 0x05010400u), t1p = __builtin_amdgcn_perm(b, a, 0x07030602u);
                const unsigned u0 = __builtin_amdgcn_perm(e, c, 0x05010400u), u1 = __builtin_amdgcn_perm(e, c, 0x07030602u);
                o[4 * d + 0] = __builtin_amdgcn_sdot4((int)__builtin_amdgcn_perm(u0, t0, 0x05040100u), (int)wq[q], o[4 * d + 0], false);
                o[4 * d + 1] = __builtin_amdgcn_sdot4((int)__builtin_amdgcn_perm(u0, t0, 0x07060302u), (int)wq[q], o[4 * d + 1], false);
                o[4 * d + 2] = __builtin_amdgcn_sdot4((int)__builtin_amdgcn_perm(u1, t1p, 0x05040100u), (int)wq[q], o[4 * d + 2], false);
                o[4 * d + 3] = __builtin_amdgcn_sdot4((int)__builtin_amdgcn_perm(u1, t1p, 0x07060302u), (int)wq[q], o[4 * d + 3], false);
            }
#pragma unroll
            for (int j = 0; j < 4; ++j) {
                asm volatile("" ::: "memory");
                r[4 * q + j] = __builtin_amdgcn_raw_buffer_load_b128(vrs, evv[j] * 128 + c8 * 16, 0, 0);
                asm volatile("" ::: "memory");
            }
        }
        int q8[8], q4[4], q2[2];
#pragma unroll
        for (int k = 0; k < 8; ++k) q8[k] = bfly32i(o[k], o[8 + k]);
#pragma unroll
        for (int k = 0; k < 4; ++k) q4[k] = bfly16i(q8[k], q8[4 + k]);
#pragma unroll
        for (int k = 0; k < 2; ++k) { const int mine = b3 ? q4[2 + k] : q4[k], oth = b3 ? q4[k] : q4[2 + k]; q2[k] = mine + dppi<0x128>(oth); }
        { half2 pv; pv[0] = (f16)((float)q2[0] * wscale); pv[1] = (f16)((float)q2[1] * wscale); f16* yp = peer + (size_t)t * DM + coff; asm volatile("global_store_dword %0, %1, off" :: "v"(yp), "v"(pv) : "memory"); }
        wq = nwq; wscale = nwscale; ne0 = ze0; ne1 = ze1;
    }
  }
}
__device__ __forceinline__ void ph_final(const Ctx& C, const f16* __restrict__ peer, const f16* __restrict__ x1h, float* __restrict__ out, const float* __restrict__ gf) {
    const int lane = C.lane;
    f32x4 gg[4];
#pragma unroll
    for (int j = 0; j < 4; ++j) gg[j] = *(const f32x4*)(gf + j * 256 + lane * 4);
    for (int tb = C.gw * 4; tb < T; tb += C.ngw * 4) {
        half4 xv[4][4], pe[4][4];
#pragma unroll
        for (int u = 0; u < 4; ++u)
#pragma unroll
            for (int j = 0; j < 4; ++j) { xv[u][j] = *(const half4*)(x1h + (size_t)(tb + u) * DM + j * 256 + lane * 4); pe[u][j] = *(const half4*)(peer + (size_t)(tb + u) * DM + j * 256 + lane * 4); }
#pragma unroll
        for (int u = 0; u < 4; ++u) {
            f32x4 v[4]; float s = 0.f;
#pragma unroll
            for (int j = 0; j < 4; ++j) {
#pragma unroll
                for (int i = 0; i < 4; ++i) { v[j][i] = (float)xv[u][j][i] + (float)pe[u][j][i]; s += v[j][i] * v[j][i]; }
            }
            const float r = rsqrtf(wave_sum(s) * (1.0f / DM) + EPS);
#pragma unroll
            for (int j = 0; j < 4; ++j) *(f32x4*)(out + (size_t)(tb + u) * DM + j * 256 + lane * 4) = v[j] * r * gg[j];
        }
    }
}

namespace pg8 {
#define PG8_LAS __attribute__((address_space(3)))
typedef _Float16 frag8 __attribute__((ext_vector_type(8)));
typedef float f32x4 __attribute__((ext_vector_type(4)));
constexpr int BM = 256, BK = 64, HALF = 128, HTB = HALF * BK * 2  , STAGE_BYTES = 8 * HTB, NXCD = 8, WGM = 8;

__host__ __device__ __forceinline__ int lds_byte(int r, int c) { const int st = (r >> 4) * 2 + (c >> 5), rr = r & 15, cc = c & 31, ob = rr * 64 + cc * 2; return st * 1024 + (ob ^ (((ob >> 9) & 1) << 5)); }
__host__ __device__ __forceinline__ void stage_rc(int b, int& R, int& C) { const int st = b / 1024, sb = b % 1024, swz = sb ^ (((sb >> 9) & 1) << 5); R = (st >> 1) * 16 + swz / 64; C = (st & 1) * 32 + (swz % 64) / 2; }
__host__ __device__ __forceinline__ int perm32(int rho) { const int n = rho >> 4, i = rho & 15; return 8 * (i >> 2) + 4 * n + (i & 3); }

struct Unit { int pm, pn; };
struct Gemm { const f16* A; const f16* Bt; int M, N, K; };

struct StaticOrder {
    int nM, nN, nwg, G, c;
    __host__ __device__ void init(int M, int N, int G_, int c_) { nM = M / BM; nN = N / BM; nwg = nM * nN; G = G_; c = c_; }
    __host__ __device__ bool next(int i, Unit& u) const {
        const long L = (long)i * G + c; if (L >= nwg) return false;
        int wgid = (int)L; { const int q = nwg / NXCD, r = nwg % NXCD, xcd = wgid % NXCD, off = wgid / NXCD; wgid = (xcd < r ? xcd * (q + 1) : r * (q + 1) + (xcd - r) * q) + off; }
        const int nig = WGM * nN, gid = wgid / nig, fm = gid * WGM, gsz = (nM - fm) < WGM ? (nM - fm) : WGM;
        u.pm = fm + ((wgid % nig) % gsz); u.pn = (wgid % nig) / gsz; return true;
    }
    __device__ __forceinline__ void a_ready(const Unit&) const {}
    __device__ __forceinline__ void done(const Unit&) const {}
};

__device__ __forceinline__ frag8 pack8(const f32x4 a, const f32x4 b) {
    frag8 h; h[0] = (f16)a[0]; h[1] = (f16)a[1]; h[2] = (f16)a[2]; h[3] = (f16)a[3]; h[4] = (f16)b[0]; h[5] = (f16)b[1]; h[6] = (f16)b[2]; h[7] = (f16)b[3]; return h;
}
__device__ __forceinline__ float sigmoidf_(float z) { return 1.0f / (1.0f + __expf(-z)); }

constexpr size_t GATE_TILE = 65536, GATE_WAVE = 8192, GATE_CHUNK = 1024;
struct EpiP1 {
    typedef i32x4 acc_t; static constexpr bool PERM = true, AFTER_DRAIN = false, MIDK = false;
    const float* ss1; const float* rsx; const float* wcs; const float* bgate; f16* qkvu; unsigned char* gates; f16* vT;
    __device__ __forceinline__ static unsigned q4(const f32x4 v) {
        return (unsigned)(v[0] * 255.0f + 0.5f) | ((unsigned)(v[1] * 255.0f + 0.5f) << 8) | ((unsigned)(v[2] * 255.0f + 0.5f) << 16) | ((unsigned)(v[3] * 255.0f + 0.5f) << 24);
    }
    __device__ __forceinline__ void operator()(const i32x4 (&acc)[2][2][4][2], const Unit& u, int wr, int wc, int fr, int fq) const {
        const int row0 = u.pm * BM + wr * 64 + fr, colt = u.pn * BM; const bool isg = colt >= NQKVU;
        f32x4 cs[2][2];
#pragma unroll
        for (int bj = 0; bj < 2; ++bj) { const int c0 = colt + bj * HALF + wc * 32 + 8 * fq; cs[bj][0] = *(const f32x4*)(wcs + c0); cs[bj][1] = *(const f32x4*)(wcs + c0 + 4); }
        unsigned char* gl = gates + (size_t)((u.pm * 8 + (u.pn - 5)) * 8 + wr * 4 + wc) * GATE_WAVE + (fq * 16 + fr) * 16;
#pragma unroll
        for (int ai = 0; ai < 2; ++ai)
#pragma unroll
            for (int m = 0; m < 4; ++m) { const int row = row0 + ai * HALF + m * 16; const float r = rsqrtf(ss1[row] * (1.0f / DM) + EPS) * rsx[row];
                u32x4 gw;
#pragma unroll
                for (int bj = 0; bj < 2; ++bj) { const int c0 = colt + bj * HALF + wc * 32 + 8 * fq; f32x4 v0, v1;
#pragma unroll
                    for (int i = 0; i < 4; ++i) { v0[i] = (float)acc[ai][bj][m][0][i] * (r * cs[bj][0][i]); v1[i] = (float)acc[ai][bj][m][1][i] * (r * cs[bj][1][i]); }
                    if (isg) { const int cg = c0 - NQKVU; const f32x4 b0 = *(const f32x4*)(bgate + cg), b1 = *(const f32x4*)(bgate + cg + 4);
#pragma unroll
                        for (int i = 0; i < 4; ++i) { v0[i] = sigmoidf_(v0[i] + b0[i]); v1[i] = sigmoidf_(v1[i] + b1[i]); }
                        gw[2 * bj] = q4(v0); gw[2 * bj + 1] = q4(v1); }
                    else { const frag8 hv = pack8(v0, v1); *(frag8*)(qkvu + (size_t)row * NQKVU + c0) = hv;
                        if (colt == 512 && bj == 1) {
                            f16* vp = vT + ((size_t)((row >> 11) * 2 + (wc >> 1)) * 64 + (wc & 1) * 32 + 8 * fq) * SEQ + (row & (SEQ - 1));
#pragma unroll
                            for (int i = 0; i < 8; ++i) vp[(size_t)i * SEQ] = hv[i]; } } }
                if (isg) *(u32x4*)(gl + (ai * 4 + m) * GATE_CHUNK) = gw; }
    }
};
struct EpiMerged {
    typedef f32x4 acc_t; static constexpr bool PERM = true, AFTER_DRAIN = false, MIDK = true;
    const unsigned char* gates; f16* merged;
    __device__ __forceinline__ static float ub(unsigned w, int i) { return (float)((w >> (8 * i)) & 255u); }
    __device__ __forceinline__ void mid(f32x4 (&acc)[2][2][4][2], const Unit& u, int wr, int wc, int fr, int fq) const {
        const unsigned char* gb = gates + (size_t)((u.pm * 8 + u.pn) * 8 + wr * 4 + wc) * GATE_WAVE + (fq * 16 + fr) * 16;
        asm volatile("" : "+v"(gb));
#pragma unroll
        for (int ai = 0; ai < 2; ++ai) {
            u32x4 g0[4], g1[4];
#pragma unroll
            for (int m = 0; m < 4; ++m) { g0[m] = *(const u32x4*)(gb + (ai * 4 + m) * GATE_CHUNK); g1[m] = *(const u32x4*)(gb + 4 * GATE_TILE + (ai * 4 + m) * GATE_CHUNK); }
#pragma unroll
            for (int m = 0; m < 4; ++m)
#pragma unroll
                for (int bj = 0; bj < 2; ++bj)
#pragma unroll
                    for (int n = 0; n < 2; ++n)
#pragma unroll
                        for (int i = 0; i < 4; ++i) acc[ai][bj][m][n][i] *= ub(g0[m][2 * bj + n], i) * __builtin_amdgcn_rcpf(fmaxf(ub(g1[m][2 * bj + n], i), 0.0255f));
            asm volatile("" ::: "memory");
        }
    }
    __device__ __forceinline__ void operator()(const f32x4 (&acc)[2][2][4][2], const Unit& u, int wr, int wc, int fr, int fq) const {
        const int row0 = u.pm * BM + wr * 64 + fr, colt = u.pn * BM;
        const unsigned char* gb = gates + (size_t)((u.pm * 8 + 4 + u.pn) * 8 + wr * 4 + wc) * GATE_WAVE + (fq * 16 + fr) * 16;
#pragma unroll
        for (int ai = 0; ai < 2; ++ai)
#pragma unroll
            for (int m = 0; m < 4; ++m) { const int row = row0 + ai * HALF + m * 16;
                const u32x4 g1 = *(const u32x4*)(gb + (ai * 4 + m) * GATE_CHUNK);
#pragma unroll
                for (int bj = 0; bj < 2; ++bj) { const int c0 = colt + bj * HALF + wc * 32 + 8 * fq; f32x4 v0, v1;
#pragma unroll
                    for (int i = 0; i < 4; ++i) { v0[i] = acc[ai][bj][m][0][i] * (fmaxf(ub(g1[2 * bj], i), 0.0255f) * (1.0f / 255.0f)); v1[i] = acc[ai][bj][m][1][i] * (fmaxf(ub(g1[2 * bj + 1], i), 0.0255f) * (1.0f / 255.0f)); }
                    *(frag8*)(merged + (size_t)row * DM + c0) = pack8(v0, v1); } }
    }
};
struct EpiOut {
    typedef f32x4 acc_t; static constexpr bool PERM = true, AFTER_DRAIN = false, MIDK = false;
    const float* x; f16* x1h; float* ss2p;
    __device__ __forceinline__ void operator()(const f32x4 (&acc)[2][2][4][2], const Unit& u, int wr, int wc, int fr, int fq) const {
        const int row0 = u.pm * BM + wr * 64 + fr, col0 = u.pn * BM + wc * 32 + 8 * fq;
#pragma unroll
        for (int ai = 0; ai < 2; ++ai)
#pragma unroll
            for (int m = 0; m < 4; ++m) { const int row = row0 + ai * HALF + m * 16; const size_t off = (size_t)row * DM + col0; float ssq = 0.f;
#pragma unroll
                for (int bj = 0; bj < 2; ++bj) {
                    const f32x4 y0 = *(const f32x4*)(x + off + bj * HALF) + acc[ai][bj][m][0], y1 = *(const f32x4*)(x + off + bj * HALF + 4) + acc[ai][bj][m][1];
                    ssq += ((y0[0] * y0[0] + y0[1] * y0[1]) + (y0[2] * y0[2] + y0[3] * y0[3])) + ((y1[0] * y1[0] + y1[1] * y1[1]) + (y1[2] * y1[2] + y1[3] * y1[3]));
                    *(frag8*)(x1h + off + bj * HALF) = pack8(y0, y1); }
                ssq += __shfl_xor(ssq, 16); ssq += __shfl_xor(ssq, 32);
                if (fq == 0) ss2p[(size_t)(u.pn * 4 + wc) * T + row] = ssq; }
    }
};
struct EpiQ {
    typedef i32x4 acc_t; static constexpr bool PERM = true, AFTER_DRAIN = false, MIDK = false;
    const float* hsc; const float* wqs; f16* qp;
    __device__ __forceinline__ void operator()(const i32x4 (&acc)[2][2][4][2], const Unit& u, int wr, int wc, int fr, int fq) const {
        const int row0 = u.pm * BM + wr * 64 + fr, colt = u.pn * BM;
        f32x4 cs[2][2];
#pragma unroll
        for (int bj = 0; bj < 2; ++bj) { const int c0 = colt + bj * HALF + wc * 32 + 8 * fq; cs[bj][0] = *(const f32x4*)(wqs + c0); cs[bj][1] = *(const f32x4*)(wqs + c0 + 4); }
#pragma unroll
        for (int ai = 0; ai < 2; ++ai)
#pragma unroll
            for (int m = 0; m < 4; ++m) { const int row = row0 + ai * HALF + m * 16; const float r = hsc[row];
#pragma unroll
                for (int bj = 0; bj < 2; ++bj) { const int c0 = colt + bj * HALF + wc * 32 + 8 * fq; f32x4 v0, v1;
#pragma unroll
                    for (int i = 0; i < 4; ++i) { v0[i] = (float)acc[ai][bj][m][0][i] * (r * cs[bj][0][i]); v1[i] = (float)acc[ai][bj][m][1][i] * (r * cs[bj][1][i]); }
                    *(frag8*)(qp + (size_t)row * 2048 + c0) = pack8(v0, v1); } }
    }
};

__device__ __forceinline__ void mma16(const frag8 b, const frag8 a, f32x4& c) { c = __builtin_amdgcn_mfma_f32_16x16x32_f16(b, a, c, 0, 0, 0); }
__device__ __forceinline__ void mma16(const frag8 b, const frag8 a, i32x4& c) { c = __builtin_amdgcn_mfma_i32_16x16x64_i8(__builtin_bit_cast(i32x4, b), __builtin_bit_cast(i32x4, a), c, 0, 0, 0); }
template <class Epi, class Sched, bool ALIGN_EPI = false, bool SP2 = false>
__device__ __forceinline__ void gemm_phase(PG8_LAS unsigned char* lds, const Gemm g, const Sched& S, const Epi& E) {
    const int tid = threadIdx.x, wid = __builtin_amdgcn_readfirstlane(tid >> 6), lane = tid & 63, wr = wid >> 2, wc = wid & 3, fr = lane & 15, fq = lane >> 4;
    const int K = g.K, nt = K / BK;
    unsigned voffA[2], voffB[2];
#pragma unroll
    for (int i = 0; i < 2; ++i) { int R, C; stage_rc(tid * 16 + i * 8192, R, C); const int Rb = Epi::PERM ? ((R & ~31) + perm32(R & 31)) : R;
        voffA[i] = (unsigned)(R * K + C) * 2u; voffB[i] = (unsigned)(Rb * K + C) * 2u; }
    const size_t kstep = (size_t)(BK * 2);
    const size_t hstep = (size_t)HALF * K * 2;
    const size_t tstep = 2 * hstep;
    const unsigned ldsw = (unsigned)wid * 1024u;
    const int aoff = lds_byte(wr * 64 + fr, fq * 8), boff = lds_byte(wc * 32 + fr, fq * 8);
#define PG8_SA(b, h) (((b) * 2 + (h)) * HTB)
#define PG8_SB(b, h) ((4 + (b) * 2 + (h)) * HTB)
#define PG8_STAGE(bufoff, gbase, voff) do { _Pragma("unroll") for (int _i = 0; _i < 2; ++_i) \
        __builtin_amdgcn_global_load_lds((const unsigned*)((const char*)(gbase) + (voff)[_i]), (PG8_LAS unsigned*)(lds + (bufoff) + ldsw + _i * 8192), 16, 0, 0); } while (0)
#define PG8_LDA(dst, b, h) do { _Pragma("unroll") for (int m = 0; m < 4; ++m) _Pragma("unroll") for (int k = 0; k < 2; ++k) dst[m][k] = *(const PG8_LAS frag8*)(lds + PG8_SA(b, h) + aoff + m * 2048 + k * 1024); } while (0)
#define PG8_LDB(dst, b, h) do { _Pragma("unroll") for (int n = 0; n < 2; ++n) _Pragma("unroll") for (int k = 0; k < 2; ++k) dst[n][k] = *(const PG8_LAS frag8*)(lds + PG8_SB(b, h) + boff + n * 2048 + k * 1024); } while (0)
#define PG8_MMA(ai, bj, At, Bt) do { __builtin_amdgcn_s_setprio(1); _Pragma("unroll") for (int m = 0; m < 4; ++m) _Pragma("unroll") for (int n = 0; n < 2; ++n) _Pragma("unroll") for (int k = 0; k < 2; ++k) \
        mma16(Bt[n][k], At[m][k], acc[ai][bj][m][n]); __builtin_amdgcn_s_setprio(0); } while (0)
#define PG8_WAIT_V(n) asm volatile("s_waitcnt vmcnt(" #n ")" ::: "memory")
#define PG8_WAIT_L(n) asm volatile("s_waitcnt lgkmcnt(" #n ")" ::: "memory")
#define PG8_BAR __builtin_amdgcn_s_barrier()
#define PG8_SCHED __builtin_amdgcn_sched_barrier(0)
    Unit cur, nxt; int ui = 0;
    if (!S.next(0, cur)) return;
    typedef typename Epi::acc_t acc_t;
    acc_t acc[2][2][4][2];
#pragma unroll
    for (int a = 0; a < 2; ++a)
#pragma unroll
        for (int b = 0; b < 2; ++b)
#pragma unroll
            for (int m = 0; m < 4; ++m)
#pragma unroll
                for (int n = 0; n < 2; ++n) acc[a][b][m][n] = acc_t{};
    frag8 At[4][2], B0[2][2], B1[2][2];
    const char* cA = (const char*)g.A + (size_t)cur.pm * tstep; const char* cB = (const char*)g.Bt + (size_t)cur.pn * tstep;
    S.a_ready(cur);
    if constexpr (SP2) {
        PG8_STAGE(PG8_SB(0, 0), cB, voffB); PG8_STAGE(PG8_SB(0, 1), cB + hstep, voffB); PG8_STAGE(PG8_SA(0, 0), cA, voffA); PG8_STAGE(PG8_SA(0, 1), cA + hstep, voffA);
        if (wr == 1) PG8_BAR;
        PG8_WAIT_V(2); PG8_BAR;
        PG8_STAGE(PG8_SB(1, 0), cB + kstep, voffB); PG8_STAGE(PG8_SA(1, 0), cA + kstep, voffA); PG8_STAGE(PG8_SB(1, 1), cB + hstep + kstep, voffB);
        PG8_WAIT_V(6); PG8_BAR;
    } else {
        PG8_STAGE(PG8_SB(0, 0), cB, voffB); PG8_STAGE(PG8_SA(0, 0), cA, voffA); PG8_STAGE(PG8_SB(0, 1), cB + hstep, voffB); PG8_STAGE(PG8_SA(0, 1), cA + hstep, voffA);
        if (wr == 1) PG8_BAR;
        PG8_WAIT_V(4); PG8_BAR;
        PG8_STAGE(PG8_SB(1, 0), cB + kstep, voffB); PG8_STAGE(PG8_SA(1, 0), cA + kstep, voffA); PG8_STAGE(PG8_SB(1, 1), cB + hstep + kstep, voffB);
        PG8_WAIT_V(6); PG8_BAR;
    }
    for (;;) {
        const bool has_next = S.next(ui + 1, nxt);
        const char* nA = has_next ? (const char*)g.A + (size_t)nxt.pm * tstep : cA; const char* nB = has_next ? (const char*)g.Bt + (size_t)nxt.pn * tstep : cB;
        for (int t = 0; t < nt; t += 2) {
            const bool last = (t == nt - 2);
            if constexpr (Epi::MIDK) { if (t == (nt >> 1)) E.mid(acc, cur, wr, wc, fr, fq); }
            const char* a1 = cA + (size_t)(t + 1) * kstep;
            const char* a2 = last ? nA : cA + (size_t)(t + 2) * kstep; const char* b2 = last ? nB : cB + (size_t)(t + 2) * kstep;
            const char* a3 = a2 + kstep; const char* b3 = b2 + kstep;
            if (last && has_next) S.a_ready(nxt);
            if constexpr (SP2) {
            PG8_LDB(B0, 0, 0); PG8_LDB(B1, 0, 1); PG8_SCHED; PG8_LDA(At, 0, 0); PG8_STAGE(PG8_SA(1, 1), a1 + hstep, voffA);
            PG8_WAIT_V(8); PG8_WAIT_L(0); PG8_BAR; PG8_MMA(0, 0, At, B0); PG8_MMA(0, 1, At, B1); PG8_BAR; PG8_SCHED;
            PG8_LDA(At, 0, 1); PG8_STAGE(PG8_SB(0, 0), b2, voffB); PG8_STAGE(PG8_SB(0, 1), b2 + hstep, voffB); PG8_STAGE(PG8_SA(0, 0), a2, voffA);
            PG8_WAIT_V(8); PG8_WAIT_L(0); PG8_BAR; PG8_MMA(1, 0, At, B0); PG8_MMA(1, 1, At, B1); PG8_BAR; PG8_SCHED;
            PG8_LDB(B0, 1, 0); PG8_LDB(B1, 1, 1); PG8_SCHED; PG8_LDA(At, 1, 0); PG8_STAGE(PG8_SA(0, 1), a2 + hstep, voffA);
            PG8_WAIT_V(8); PG8_WAIT_L(0); PG8_BAR; PG8_MMA(0, 0, At, B0); PG8_MMA(0, 1, At, B1); PG8_BAR; PG8_SCHED;
            PG8_LDA(At, 1, 1); PG8_STAGE(PG8_SB(1, 0), b3, voffB); PG8_STAGE(PG8_SB(1, 1), b3 + hstep, voffB); PG8_STAGE(PG8_SA(1, 0), a3, voffA);
            PG8_WAIT_V(8); PG8_WAIT_L(0); PG8_BAR; PG8_MMA(1, 0, At, B0); PG8_MMA(1, 1, At, B1); PG8_BAR; PG8_SCHED;
            } else {
            PG8_LDB(B0, 0, 0); PG8_SCHED; PG8_LDA(At, 0, 0); PG8_STAGE(PG8_SA(1, 1), a1 + hstep, voffA);
            PG8_WAIT_L(8); PG8_BAR; PG8_WAIT_L(0); PG8_MMA(0, 0, At, B0); PG8_BAR; PG8_SCHED;
            PG8_LDB(B1, 0, 1); PG8_STAGE(PG8_SB(0, 0), b2, voffB);
            PG8_BAR; PG8_WAIT_L(0); PG8_MMA(0, 1, At, B1); PG8_BAR;
            PG8_LDA(At, 0, 1); PG8_STAGE(PG8_SA(0, 0), a2, voffA);
            PG8_BAR; PG8_WAIT_L(0); PG8_MMA(1, 0, At, B0); PG8_BAR; PG8_SCHED;
            PG8_STAGE(PG8_SB(0, 1), b2 + hstep, voffB);
            PG8_WAIT_V(6); PG8_BAR; PG8_MMA(1, 1, At, B1); PG8_BAR;
            PG8_LDB(B0, 1, 0); PG8_SCHED; PG8_LDA(At, 1, 0); PG8_STAGE(PG8_SA(0, 1), a2 + hstep, voffA);
            PG8_WAIT_L(8); PG8_BAR; PG8_WAIT_L(0); PG8_MMA(0, 0, At, B0); PG8_BAR; PG8_SCHED;
            PG8_LDB(B1, 1, 1); PG8_STAGE(PG8_SB(1, 0), b3, voffB);
            PG8_BAR; PG8_WAIT_L(0); PG8_MMA(0, 1, At, B1); PG8_BAR;
            PG8_LDA(At, 1, 1); PG8_STAGE(PG8_SA(1, 0), a3, voffA);
            PG8_BAR; PG8_WAIT_L(0); PG8_MMA(1, 0, At, B0); PG8_BAR; PG8_SCHED;
            PG8_STAGE(PG8_SB(1, 1), b3 + hstep, voffB);
            PG8_WAIT_V(6); PG8_BAR; PG8_MMA(1, 1, At, B1); PG8_BAR;
            }
        }
        if constexpr (ALIGN_EPI) { if (wr == 0) PG8_BAR; }
        if constexpr (!Epi::AFTER_DRAIN) { E(acc, cur, wr, wc, fr, fq); S.done(cur); }
        if (!has_next) break;
#pragma unroll
        for (int a = 0; a < 2; ++a)
#pragma unroll
            for (int b = 0; b < 2; ++b)
#pragma unroll
                for (int m = 0; m < 4; ++m)
#pragma unroll
                    for (int n = 0; n < 2; ++n) acc[a][b][m][n] = acc_t{};
        cur = nxt; cA = nA; cB = nB; ++ui;
        if constexpr (ALIGN_EPI) { if (wr == 1) PG8_BAR; }
    }
    PG8_WAIT_V(0);
    if constexpr (!ALIGN_EPI) { if (wr == 0) PG8_BAR; }
    PG8_BAR;
    if constexpr (Epi::AFTER_DRAIN) { E.fused(acc, cur, wr, wc, fr, fq, lds, wid, lane); S.done(cur); }
#undef PG8_SA
#undef PG8_SB
#undef PG8_STAGE
#undef PG8_LDA
#undef PG8_LDB
#undef PG8_MMA
#undef PG8_WAIT_V
#undef PG8_WAIT_L
#undef PG8_BAR
#undef PG8_SCHED
}
}

#define XB_TMO      128
#define XB_XCNT(j)  (256  + 64 * (j))
#define XB_XSUB(j)  (1280 + 64 * (j))
#define XB_XGEN(j)  (2304 + 64 * (j))
#define XB_TOP      3328
#define XB_TOPGEN   3392
#define XCD_BAR_WORDS 3456
#define XB_SPIN_CAP (1u << 18)

__device__ __forceinline__ unsigned xb_ld(unsigned* p)              { return __hip_atomic_load(p, __ATOMIC_RELAXED, __HIP_MEMORY_SCOPE_AGENT); }
__device__ __forceinline__ unsigned xb_add(unsigned* p, unsigned v) { return __hip_atomic_fetch_add(p, v, __ATOMIC_RELAXED, __HIP_MEMORY_SCOPE_AGENT); }
__device__ __forceinline__ unsigned xb_xcc_id() { return (unsigned)__builtin_amdgcn_s_getreg((3 << 11) | 20) & 0xFu; }
#define XB_SPIN(cond, bar) do { unsigned _sp = 0; while (cond) { __builtin_amdgcn_s_sleep(1); \
    if ((++_sp & 255u) == 0u) { if (xb_ld(&(bar)[XB_TMO])) break; if (_sp > XB_SPIN_CAP) { atomicAdd(&(bar)[XB_TMO], 1u); break; } } } } while (0)

struct XcdBarrier {
    unsigned* bar; unsigned x;
    volatile LAS unsigned* st;
};

__device__ __forceinline__ XcdBarrier xcd_barrier_post(unsigned* bar, volatile LAS unsigned* st) {
    XcdBarrier b; b.bar = bar; b.x = xb_xcc_id(); b.st = st;
    if (threadIdx.x == 0) st[2] = xb_add(&bar[XB_XCNT(b.x)], 1u);
    return b;
}
__device__ __forceinline__ void xcd_barrier_complete(unsigned* bar, unsigned x, unsigned& nloc, unsigned& nx) {
    const unsigned G = gridDim.x * gridDim.y * gridDim.z;
    unsigned sum, cnt, mine, sp = 0u;
    for (;;) {
        sum = 0u; cnt = 0u; mine = 0u;
#pragma unroll
        for (unsigned j = 0; j < 16; ++j) { const unsigned c = xb_ld(&bar[XB_XCNT(j)]); sum += c; cnt += (c > 0u) ? 1u : 0u; mine = (j == x) ? c : mine; }
        if (sum == G) break;
        __builtin_amdgcn_s_sleep(1);
        if ((++sp & 255u) == 0u) { if (xb_ld(&bar[XB_TMO])) break; if (sp > XB_SPIN_CAP) { atomicAdd(&bar[XB_TMO], 1u); break; } }
    }
    nloc = mine > 0u ? mine : 1u; nx = cnt > 0u ? cnt : 1u;
}

__device__ __forceinline__ void xcd_barrier(const XcdBarrier& b) {
    asm volatile("s_waitcnt vmcnt(0)" ::: "memory");
    __syncthreads();
    if (threadIdx.x == 0) {
        unsigned* bar = b.bar;
        __builtin_amdgcn_s_waitcnt(0);
        unsigned nloc = b.st[0], nx = b.st[1];
        if (nloc == 0u) { xcd_barrier_complete(bar, b.x, nloc, nx); b.st[0] = nloc; b.st[1] = nx; }
        const unsigned old = xb_add(&bar[XB_XSUB(b.x)], 1u);
        const unsigned gen = old / nloc;
        if (old + 1u == (gen + 1u) * nloc) {
            __builtin_amdgcn_fence(__ATOMIC_RELEASE, "agent");
            asm volatile("s_waitcnt vmcnt(0)" ::: "memory");
            const unsigned og = xb_add(&bar[XB_TOP], 1u);
            const unsigned tg = og / nx;
            if (og + 1u == (tg + 1u) * nx) xb_add(&bar[XB_TOPGEN], 1u);
            else XB_SPIN(xb_ld(&bar[XB_TOPGEN]) == tg, bar);
            __builtin_amdgcn_fence(__ATOMIC_ACQUIRE, "agent");
            xb_add(&bar[XB_XGEN(b.x)], 1u);
            asm volatile("s_waitcnt vmcnt(0)" ::: "memory");
        } else {
            XB_SPIN(xb_ld(&bar[XB_XGEN(b.x)]) == gen, bar);
            __builtin_amdgcn_fence(__ATOMIC_ACQUIRE, "agent");
            asm volatile("s_waitcnt vmcnt(0)" ::: "memory");
        }
    }
    __syncthreads();
}


struct Args { const float* in[16]; float* out; unsigned char* ws; int ph_lo, ph_hi; };
constexpr int N_PHASES = 11;

__global__ void __launch_bounds__(NTHREADS, 2) mk_fwd(Args a) {
    extern __shared__ __attribute__((aligned(16))) unsigned char lds[];
    LAS unsigned char* L = (LAS unsigned char*)lds;
    volatile LAS unsigned* MISC = (volatile LAS unsigned*)(L + MISC_OFF);
    unsigned char* ws = a.ws;
    Ctx C;
    C.tid = threadIdx.x; C.lane = C.tid & 63; C.wave = __builtin_amdgcn_readfirstlane(C.tid >> 6);
    C.G = gridDim.x; C.gw = blockIdx.x * NWAVES + C.wave; C.ngw = C.G * NWAVES; C.gt = blockIdx.x * NTHREADS + C.tid; C.ngt = C.G * NTHREADS;
    for (int u = C.tid; u < (LDS_BYTES - LDSCTL_OFF) / 4; u += NTHREADS) ((LAS unsigned*)(L + LDSCTL_OFF))[u] = 0u;
    __syncthreads();
    const int lo = a.ph_lo, hi = a.ph_hi, G = C.G;
    const bool multi = (hi - lo) > 1;
    XcdBarrier bar; bar.bar = (unsigned*)(ws + WS_CTL) + CW_BAR; bar.x = 0; bar.st = nullptr;
    if (multi) bar = xcd_barrier_post((unsigned*)(ws + WS_CTL) + CW_BAR, MISC + 8);
#define IN(k) (lo <= (k) && (k) < hi)
#define SEAM(k) do { if (IN(k) && IN((k) + 1)) xcd_barrier(bar); } while (0)

#define REPS(k) for (int rep_ = 0; rep_ < ((PROBE_DUP == (k)) ? 2 : 1); ++rep_)
#define REPBAR(k) do { if (PROBE_DUP == (k) && rep_ == 0) xcd_barrier(bar); } while (0)
    if (IN(0)) REPS(0) { ph_prep(C, L, a.in, ws); REPBAR(0); }
    SEAM(0);
    if (IN(1)) {
        quant_wrows(C, (const f16*)(ws + WS_WCAT), NCAT, (unsigned*)(ws + WS_WCATQ), (float*)(ws + WS_WCS));
        quant_wrows(C, (const f16*)(ws + WS_WQ), 2048, (unsigned*)(ws + WS_WQQ), (float*)(ws + WS_WQS));
        xcd_barrier(bar);
        pg8::Gemm g{(const f16*)(ws + WS_XH), (const f16*)(ws + WS_WCATQ), T, NCAT, DM / 2}; pg8::StaticOrder S; S.init(T, NCAT, G, (int)blockIdx.x);
        pg8::EpiP1 E{(const float*)(ws + WS_RS1), (const float*)(ws + WS_RSX), (const float*)(ws + WS_WCS), a.in[8], (f16*)(ws + WS_QKVU), ws + WS_GATES, (f16*)(ws + WS_VT)};
        pg8::gemm_phase<pg8::EpiP1, pg8::StaticOrder, true, true>(L, g, S, E);
    }
    SEAM(1);
    if (IN(2)) REPS(2) {
        ph_attn_pool(C, L, (const f16*)(ws + WS_QKVU), (const f16*)(ws + WS_VT), a.in[3], (const f16*)(ws + WS_POOLW), a.in[5], (f16*)(ws + WS_OCAT));
        REPBAR(2);
    }
    if (IN(2) && IN(4)) xcd_barrier(bar);
    if (IN(4)) REPS(4) {
        pg8::Gemm g{(const f16*)(ws + WS_OCAT), (const f16*)(ws + WS_WB), T, DM, DM}; pg8::StaticOrder S; S.init(T, DM, G, (int)blockIdx.x);
        pg8::EpiMerged E{ws + WS_GATES, (f16*)(ws + WS_MERGED)};
        pg8::gemm_phase<pg8::EpiMerged, pg8::StaticOrder, true, true>(L, g, S, E);
        REPBAR(4);
    }
    SEAM(4);
    if (IN(5)) REPS(5) {
        pg8::Gemm g{(const f16*)(ws + WS_MERGED), (const f16*)(ws + WS_WOUT), T, DM, DM}; pg8::StaticOrder S; S.init(T, DM, G, (int)blockIdx.x);
        pg8::EpiOut E{a.in[0], (f16*)(ws + WS_X1H), (float*)(ws + WS_SS2)};
        pg8::gemm_phase<pg8::EpiOut, pg8::StaticOrder, true, true>(L, g, S, E);
        REPBAR(5);
    }
    SEAM(5);
    if (IN(6)) {
        ph_h2quant(C, (const f16*)(ws + WS_X1H), a.in[10], (const float*)(ws + WS_SS2), (unsigned*)(ws + WS_H2Q), (float*)(ws + WS_HSC));
        xcd_barrier(bar);
        pg8::Gemm g{(const f16*)(ws + WS_H2Q), (const f16*)(ws + WS_WQQ), T, 2048, DM / 2}; pg8::StaticOrder S; S.init(T, 2048, G, (int)blockIdx.x);
        pg8::EpiQ E{(const float*)(ws + WS_HSC), (const float*)(ws + WS_WQS), (f16*)(ws + WS_QP)};
        pg8::gemm_phase<pg8::EpiQ, pg8::StaticOrder, true, true>(L, g, S, E);
    }
    SEAM(6);
    if (IN(7)) REPS(7) {
        auto side = [&]() {
            quant_rows<false>(C, a.in[13], (unsigned*)(ws + WS_UQ), (float*)(ws + WS_US));
            quant_rows<false>(C, a.in[14], (unsigned*)(ws + WS_VQ), (float*)(ws + WS_VS));
        };
        ph_route(C, L, (const f16*)(ws + WS_QP), (const float*)(ws + WS_SS2), (const f16*)(ws + WS_SUBK), (int*)(ws + WS_EIDX), (float*)(ws + WS_EGATE), side);
        if (!(C.wave & 4)) side();
        REPBAR(7); }
    SEAM(7);
    if (IN(8)) REPS(8) {
        const Slicing SL = get_slicing((const unsigned*)(ws + WS_CTL) + CW_BAR, MISC);
        if (PROBE_DUP == 8 && rep_ == 0) ph_upeer<255>(C, L, SL, (const unsigned*)(ws + WS_H2Q), (const int*)(ws + WS_EIDX), (const unsigned char*)(ws + WS_UQ), (short*)(ws + WS_PDOT));
        else ph_upeer<16383>(C, L, SL, (const unsigned*)(ws + WS_H2Q), (const int*)(ws + WS_EIDX), (const unsigned char*)(ws + WS_UQ), (short*)(ws + WS_PDOT));
        REPBAR(8);
    }
    SEAM(8);
    if (IN(9)) {
        ph_ureduce(C, L, (const short*)(ws + WS_PDOT), (const float*)(ws + WS_HSC), (const int*)(ws + WS_EIDX), (const float*)(ws + WS_US), (const float*)(ws + WS_VS), (const float*)(ws + WS_EGATE),
                   (unsigned*)(ws + WS_WQP), (float*)(ws + WS_WSC));
        xcd_barrier(bar);
        const Slicing SL = get_slicing((const unsigned*)(ws + WS_CTL) + CW_BAR, MISC);
        ph_vpeer<16383>(C, SL, (const int*)(ws + WS_EIDX), (const unsigned*)(ws + WS_WQP), (const float*)(ws + WS_WSC), (const unsigned char*)(ws + WS_VQ), (f16*)(ws + WS_PEER));
    }
    SEAM(9);
    if (IN(10)) { ph_final(C, (const f16*)(ws + WS_PEER), (const f16*)(ws + WS_X1H), a.out, a.in[15]); }
#undef IN
#undef SEAM
}

#ifndef MK_N_LAUNCHES
#define MK_N_LAUNCHES 1
#endif
extern "C" void kernel_launch(void* const* d_in, const int* in_sizes, int n_in, void* d_out, int out_size, void* d_ws, size_t ws_size, hipStream_t stream) {
    static int grid = 0;
    if (grid == 0) {
        if (n_in != 16 || in_sizes[0] != T * DM || out_size != T * DM || ws_size < WS_END) {
            fprintf(stderr, "kernel_launch: unexpected shapes (n_in %d in0 %d out %d ws %zu)\n", n_in, n_in > 0 ? in_sizes[0] : -1, out_size, ws_size);
            grid = -1; return;
        }
        int dev = 0, cus = 0;
        if (hipGetDevice(&dev) != hipSuccess || hipDeviceGetAttribute(&cus, hipDeviceAttributeMultiprocessorCount, dev) != hipSuccess) { grid = -1; return; }
        if (hipFuncSetAttribute((const void*)mk_fwd, hipFuncAttributeMaxDynamicSharedMemorySize, LDS_BYTES) != hipSuccess) { fprintf(stderr, "kernel_launch: hipFuncSetAttribute failed\n"); grid = -1; return; }
        int per_cu = 0;
        if (hipOccupancyMaxActiveBlocksPerMultiprocessor(&per_cu, (const void*)mk_fwd, NTHREADS, LDS_BYTES) != hipSuccess || per_cu < 1)
            fprintf(stderr, "kernel_launch: occupancy query reports %d workgroups per CU\n", per_cu);
        (void)hipGetLastError();
        grid = cus;
    }
    if (grid < 0) return;
    (void)hipMemsetAsync((char*)d_ws + WS_CTL, 0, CTL_ZERO_BYTES, stream);
    Args a{};
    for (int i = 0; i < 16; ++i) a.in[i] = (const float*)d_in[i];
    a.out = (float*)d_out; a.ws = (unsigned char*)d_ws;
    if (MK_N_LAUNCHES == 1) {
        a.ph_lo = 0; a.ph_hi = N_PHASES;
        hipLaunchKernelGGL(mk_fwd, dim3(grid), dim3(NTHREADS), LDS_BYTES, stream, a);
    } else {
        for (int p = 0; p < N_PHASES; ++p) { a.ph_lo = p; a.ph_hi = p + 1; hipLaunchKernelGGL(mk_fwd, dim3(grid), dim3(NTHREADS), LDS_BYTES, stream, a); }
    }
}
```

```cpp
#include <hip/hip_runtime.h>
#include <cstdint>
#include <cstdio>

typedef _Float16 f16;
typedef _Float16 half8 __attribute__((ext_vector_type(8)));
typedef _Float16 half4 __attribute__((ext_vector_type(4)));
typedef _Float16 half2 __attribute__((ext_vector_type(2)));
typedef float f32x4 __attribute__((ext_vector_type(4)));
typedef float f32x16 __attribute__((ext_vector_type(16)));
typedef unsigned u32x4 __attribute__((ext_vector_type(4)));
typedef int i32x4 __attribute__((ext_vector_type(4)));
#define LAS __attribute__((address_space(3)))
#ifndef PROBE_DIAG
#define PROBE_DIAG (0)
#endif
#ifndef PROBE_DUP
#define PROBE_DUP (-1)
#endif
#define GAS __attribute__((address_space(1)))

constexpr int DM = 1024, BATCH = 16, SEQ = 2048, T = BATCH * SEQ;
constexpr int NQKVU = 1280, NGATE = 2048, NCAT = NQKVU + NGATE;
constexpr int COL_K = 512, COL_V = 640, COL_U = 768;
constexpr int NEXP = 16384, PEER_H = 8, TOPK = 16;
constexpr float EPS = 1e-6f;
constexpr int NWAVES = 8, NTHREADS = NWAVES * 64;

constexpr size_t MiB = 1u << 20;
constexpr size_t WS_CTL = 0, CTL_ZERO_BYTES = 64 * 1024;
constexpr size_t WS_WCAT = 1 * MiB;
constexpr size_t WS_WB = 8 * MiB;
constexpr size_t WS_WOUT = 10 * MiB;
constexpr size_t WS_WQ = 12 * MiB;
constexpr size_t WS_POOLW = 16 * MiB;
constexpr size_t WS_SUBK = 16 * MiB + 512 * 1024;
constexpr size_t WS_RS1 = 17 * MiB;
constexpr size_t WS_EIDX = 18 * MiB;
constexpr size_t WS_EGATE = 34 * MiB;
constexpr size_t WS_WCATQ = 50 * MiB;
constexpr size_t WS_WCS = 54 * MiB;
constexpr size_t WS_WQQ = 56 * MiB;
constexpr size_t WS_WQS = 59 * MiB;
constexpr size_t WS_RSX = 55 * MiB;
constexpr size_t WS_UTAB = 50 * MiB;
constexpr size_t WS_VTAB = 82 * MiB;
constexpr size_t WS_XH = 114 * MiB;
constexpr size_t WS_MERGED = WS_XH;
constexpr size_t WS_QKVU = 178 * MiB;
constexpr size_t WS_X1H = WS_QKVU;
constexpr size_t WS_PEER = WS_MERGED;
constexpr size_t WS_GATES = 258 * MiB;
constexpr size_t WS_QP = WS_GATES;
constexpr size_t WS_OCAT = 386 * MiB;
constexpr size_t WS_UQ = 450 * MiB;
constexpr size_t WS_VQ = 466 * MiB;
constexpr size_t WS_US = 17 * MiB + 256 * 1024, WS_VS = 17 * MiB + 512 * 1024;
constexpr size_t WS_PDOT = WS_GATES;
constexpr size_t WS_H2Q = 404 * MiB;
constexpr size_t WS_HSC = 403 * MiB;
constexpr size_t WS_SSF = 402 * MiB;
constexpr size_t WS_WQP = 386 * MiB;
constexpr size_t WS_WSC = 390 * MiB;
constexpr size_t WS_ACT = 386 * MiB;
constexpr size_t WS_SS2 = 482 * MiB;
constexpr size_t WS_VT = 484 * MiB;
constexpr size_t WS_END = 492 * MiB;
constexpr int CW_BAR = 4096;

constexpr int RING_OFF = 0, RING_BYTES = 131072;
constexpr int LDSCTL_OFF = RING_BYTES, MISC_OFF = LDSCTL_OFF + 320;
constexpr int LDS_BYTES = 147456;

#define LDS_WAIT() asm volatile("s_waitcnt lgkmcnt(0)" ::: "memory")
template <int CTRL> __device__ __forceinline__ float dppf(float x) { return __uint_as_float(__builtin_amdgcn_update_dpp(0u, __float_as_uint(x), CTRL, 0xf, 0xf, false)); }
template <int CTRL> __device__ __forceinline__ int dppi(int x) { return (int)__builtin_amdgcn_update_dpp(0u, (unsigned)x, CTRL, 0xf, 0xf, false); }
__device__ __forceinline__ float bfly32(float a, float b) { auto r = __builtin_amdgcn_permlane32_swap(__float_as_uint(a), __float_as_uint(b), false, false); return __uint_as_float(r[0]) + __uint_as_float(r[1]); }
__device__ __forceinline__ float bfly16(float a, float b) { auto r = __builtin_amdgcn_permlane16_swap(__float_as_uint(a), __float_as_uint(b), false, false); return __uint_as_float(r[0]) + __uint_as_float(r[1]); }
__device__ __forceinline__ int bfly32i(int a, int b) { auto r = __builtin_amdgcn_permlane32_swap((unsigned)a, (unsigned)b, false, false); return (int)(r[0] + r[1]); }
__device__ __forceinline__ int bfly16i(int a, int b) { auto r = __builtin_amdgcn_permlane16_swap((unsigned)a, (unsigned)b, false, false); return (int)(r[0] + r[1]); }
__device__ __forceinline__ float wave_sum(float x) {
    x += dppf<0x121>(x); x += dppf<0x122>(x); x += dppf<0x124>(x); x += dppf<0x128>(x);
    x = bfly16(x, x); return bfly32(x, x);
}
__device__ __forceinline__ int wave_sum_i(int x) {
    x += dppi<0x121>(x); x += dppi<0x122>(x); x += dppi<0x124>(x); x += dppi<0x128>(x);
    x = bfly16i(x, x); return bfly32i(x, x);
}
__device__ __forceinline__ float wave_max(float x) {
    x = fmaxf(x, dppf<0x121>(x)); x = fmaxf(x, dppf<0x122>(x)); x = fmaxf(x, dppf<0x124>(x)); x = fmaxf(x, dppf<0x128>(x));
    { auto r = __builtin_amdgcn_permlane16_swap(__float_as_uint(x), __float_as_uint(x), false, false); x = fmaxf(__uint_as_float(r[0]), __uint_as_float(r[1])); }
    { auto r = __builtin_amdgcn_permlane32_swap(__float_as_uint(x), __float_as_uint(x), false, false); x = fmaxf(__uint_as_float(r[0]), __uint_as_float(r[1])); }
    return x;
}
__device__ __forceinline__ float gelu_exact(float x) { return 0.5f * x * (1.0f + erff(x * 0.70710678118654752f)); }
__device__ __forceinline__ float rs_from_ss(const float* ss, int t) {
    float s = 0.f;
#pragma unroll
    for (int i = 0; i < 16; ++i) s += ss[(size_t)i * T + t];
    return rsqrtf(s * (1.0f / DM) + EPS);
}

struct Ctx {
    int tid, lane, wave;
    int G;
    int gw, ngw;
    int gt, ngt;
};

__device__ __forceinline__ int pack4_i8(float a, float b, float c, float d) {
    const int ia = (int)rintf(a), ib = (int)rintf(b), ic = (int)rintf(c), id = (int)rintf(d);
    return (ia & 0xff) | ((ib & 0xff) << 8) | ((ic & 0xff) << 16) | (id << 24);
}
template <bool OFFS>
__device__ __forceinline__ void quant_rows(const Ctx& C, const float* __restrict__ tab, unsigned* __restrict__ q, float* __restrict__ scale) {
    const int lane = C.lane;
    for (int r = C.gw; r < NEXP; r += C.ngw) {
        const float* row = tab + (size_t)r * DM;
        f32x4 v[4]; float m = 0.f;
#pragma unroll
        for (int j = 0; j < 4; ++j) { v[j] = *(const f32x4*)(row + j * 256 + lane * 4); m = fmaxf(m, fmaxf(fmaxf(fabsf(v[j][0]), fabsf(v[j][1])), fmaxf(fabsf(v[j][2]), fabsf(v[j][3])))); }
        m = wave_max(m);
        const float inv = m > 0.f ? 127.0f / m : 0.f;
#pragma unroll
        for (int j = 0; j < 4; ++j) {
            unsigned w = (unsigned)pack4_i8(v[j][0] * inv, v[j][1] * inv, v[j][2] * inv, v[j][3] * inv);
            if (OFFS) w ^= 0x80808080u;
            { const int dw = j * 64 + lane; q[(size_t)(dw >> 5) * (NEXP * 32) + (size_t)r * 32 + (dw & 31)] = w; }
        }
        if (lane == 0) scale[r] = m * (1.0f / 127.0f);
    }
}

__device__ __forceinline__ void p0_transpose_item(const float* W, int K, int N, f16* WT, int ldo, int koff, LAS float* scr, int item, int lane) {
    const int nblk = N / 32, kb = item / nblk, nb = item % nblk, k0 = 64 * kb, n0 = 32 * nb;
#pragma unroll 8
    for (int i = 0; i < 32; ++i) { const int kk = 2 * i + (lane >> 5); scr[kk * 33 + (lane & 31)] = W[(size_t)(k0 + kk) * N + n0 + (lane & 31)]; }
    LDS_WAIT(); asm volatile("" ::: "memory");
    const int c = lane & 7;
#pragma unroll
    for (int j = 0; j < 4; ++j) { const int n = (lane >> 3) + 8 * j; const LAS float* s = scr + (8 * c) * 33 + n;
        half8 o;
#pragma unroll
        for (int i = 0; i < 8; ++i) o[i] = (f16)s[i * 33];
        *(half8*)(WT + (size_t)(n0 + n) * ldo + koff + k0 + 8 * c) = o; }
    LDS_WAIT(); asm volatile("" ::: "memory");
}
__device__ __forceinline__ void cvt_stream(const Ctx& C, const float* in, f16* out, size_t n4) {
    for (size_t i = (size_t)C.gt; i < n4; i += (size_t)C.ngt) {
        const f32x4 v = ((const f32x4*)in)[i];
        half4 h; h[0] = (f16)v[0]; h[1] = (f16)v[1]; h[2] = (f16)v[2]; h[3] = (f16)v[3];
        ((half4*)out)[i] = h;
    }
}
__device__ __forceinline__ void rowprep(const Ctx& C, const float* x, const float* g, unsigned* xq, float* rsx, float* ss) {
    const int lane = C.lane;
    f32x4 gg[4];
#pragma unroll
    for (int j = 0; j < 4; ++j) gg[j] = *(const f32x4*)(g + j * 256 + lane * 4);
    for (int tb = C.gw * 4; tb < T; tb += C.ngw * 4) {
        f32x4 v[4][4];
#pragma unroll
        for (int u = 0; u < 4; ++u)
#pragma unroll
            for (int j = 0; j < 4; ++j) v[u][j] = *(const f32x4*)(x + (size_t)(tb + u) * DM + j * 256 + lane * 4);
#pragma unroll
        for (int u = 0; u < 4; ++u) {
            float s = 0.f, am = 0.f;
#pragma unroll
            for (int j = 0; j < 4; ++j) {
                const f32x4 w = v[u][j];
                s += w[0] * w[0] + w[1] * w[1] + w[2] * w[2] + w[3] * w[3];
                v[u][j] = w * gg[j];
                am = fmaxf(am, fmaxf(fmaxf(fabsf(v[u][j][0]), fabsf(v[u][j][1])), fmaxf(fabsf(v[u][j][2]), fabsf(v[u][j][3]))));
            }
            s = wave_sum(s); am = wave_max(am);
            const float inv = am > 0.f ? 127.0f / am : 0.f;
#pragma unroll
            for (int j = 0; j < 4; ++j) xq[(size_t)(tb + u) * 256 + j * 64 + lane] = (unsigned)pack4_i8(v[u][j][0] * inv, v[u][j][1] * inv, v[u][j][2] * inv, v[u][j][3] * inv);
            if (lane == 0) { ss[tb + u] = s; rsx[tb + u] = am * (1.0f / 127.0f); }
        }
    }
}
__device__ __forceinline__ void quant_wrows(const Ctx& C, const f16* __restrict__ w, int rows, unsigned* __restrict__ q, float* __restrict__ scale) {
    const int lane = C.lane;
    for (int r = C.gw; r < rows; r += C.ngw) {
        const half8 a = *(const half8*)(w + (size_t)r * DM + 16 * lane), b = *(const half8*)(w + (size_t)r * DM + 16 * lane + 8);
        float m = 0.f;
#pragma unroll
        for (int i = 0; i < 8; ++i) m = fmaxf(m, fmaxf(fabsf((float)a[i]), fabsf((float)b[i])));
        m = wave_max(m);
        const float inv = m > 0.f ? 127.0f / m : 0.f;
        u32x4 o;
        o[0] = (unsigned)pack4_i8((float)a[0] * inv, (float)a[1] * inv, (float)a[2] * inv, (float)a[3] * inv);
        o[1] = (unsigned)pack4_i8((float)a[4] * inv, (float)a[5] * inv, (float)a[6] * inv, (float)a[7] * inv);
        o[2] = (unsigned)pack4_i8((float)b[0] * inv, (float)b[1] * inv, (float)b[2] * inv, (float)b[3] * inv);
        o[3] = (unsigned)pack4_i8((float)b[4] * inv, (float)b[5] * inv, (float)b[6] * inv, (float)b[7] * inv);
        *(u32x4*)(q + (size_t)r * 256 + 4 * lane) = o;
        if (lane == 0) scale[r] = m * (1.0f / 127.0f);
    }
}
__device__ __forceinline__ void ph_prep(const Ctx& C, LAS unsigned char* lds, const float* const* in, unsigned char* ws) {
    LAS float* scr = (LAS float*)(lds + RING_OFF + C.wave * 16384);
    f16* wcat = (f16*)(ws + WS_WCAT); f16* wb = (f16*)(ws + WS_WB); f16* wout = (f16*)(ws + WS_WOUT); f16* wq = (f16*)(ws + WS_WQ); f16* poolw = (f16*)(ws + WS_POOLW);
    constexpr int I_IN = 16 * 40, I_G = 16 * 64, I_B = 8 * 32, I_O = 16 * 32, I_Q = 16 * 64, I_P = 2 * 4;
    constexpr int NITEMS = I_IN + I_G + 2 * I_B + I_O + I_Q + 4 * I_P;
    for (int it = C.gw; it < NITEMS; it += C.ngw) {
        int r = it;
        if (r < I_IN) { p0_transpose_item(in[2], 1024, 1280, wcat, 1024, 0, scr, r, C.lane); continue; } r -= I_IN;
        if (r < I_G) { p0_transpose_item(in[7], 1024, 2048, wcat + (size_t)NQKVU * 1024, 1024, 0, scr, r, C.lane); continue; } r -= I_G;
        if (r < I_B) { p0_transpose_item(in[6], 512, 1024, wb, 1024, 0, scr, r, C.lane); continue; } r -= I_B;
        if (r < I_B) { p0_transpose_item(in[6] + 512 * 1024, 512, 1024, wb, 1024, 512, scr, r, C.lane); continue; } r -= I_B;
        if (r < I_O) { p0_transpose_item(in[9], 1024, 1024, wout, 1024, 0, scr, r, C.lane); continue; } r -= I_O;
        if (r < I_Q) { p0_transpose_item(in[11], 1024, 2048, wq, 1024, 0, scr, r, C.lane); continue; } r -= I_Q;
        { const int g = r / I_P; p0_transpose_item(in[4] + g * 128 * 128, 128, 128, poolw + g * 128 * 128, 128, 0, scr, r % I_P, C.lane); }
    }
    cvt_stream(C, in[12], (f16*)(ws + WS_SUBK), (size_t)8 * 2 * 128 * 128 / 4);
    rowprep(C, in[0], in[1], (unsigned*)(ws + WS_XH), (float*)(ws + WS_RSX), (float*)(ws + WS_RS1));
}

__device__ __forceinline__ void ph_attn_naive(const Ctx& C, const f16* __restrict__ qkvu, const float* __restrict__ sink, f16* __restrict__ ocat) {
    for (int gid = C.gt; gid < T * 8; gid += C.ngt) {
        const int t = gid % T, h = gid / T;
        const int b = t / SEQ, ts = t % SEQ, kh = h >> 2;
        float q[64], o[64];
        const f16* qr = qkvu + (size_t)t * NQKVU + h * 64;
#pragma unroll
        for (int d = 0; d < 64; ++d) { q[d] = (float)qr[d]; o[d] = 0.f; }
        const float slope = exp2f(-(float)(h + 1));
        float m = -1e30f, l = 0.f;
        const int s0 = max(ts - 128, 0), s1 = min(ts + 128, SEQ - 1);
        for (int s = s0; s <= s1; ++s) {
            const f16* kr = qkvu + (size_t)(b * SEQ + s) * NQKVU + COL_K + kh * 64;
            const f16* vr = qkvu + (size_t)(b * SEQ + s) * NQKVU + COL_V + kh * 64;
            float dot = 0.f;
#pragma unroll
            for (int d = 0; d < 64; ++d) dot += q[d] * (float)kr[d];
            const float lg = dot * 0.125f - slope * fabsf((float)(ts - s));
            const float mn = fmaxf(m, lg), al = __expf(m - mn), p = __expf(lg - mn);
            l = l * al + p;
#pragma unroll
            for (int d = 0; d < 64; ++d) o[d] = o[d] * al + p * (float)vr[d];
            m = mn;
        }
        const float sk = sink[h];
        const float mn = fmaxf(m, sk), al = __expf(m - mn);
        l = l * al + __expf(sk - mn);
        const float inv = al / l;
        f16* orow = ocat + (size_t)t * DM + h * 64;
#pragma unroll
        for (int d = 0; d < 64; ++d) orow[d] = (f16)(o[d] * inv);
    }
}

template <int DIAG = 0>
__device__ __forceinline__ void attn_unit(const Ctx& C, int u, LAS unsigned char* lds, const f16* __restrict__ qkvu, const f16* __restrict__ vT, const float* __restrict__ sink, f16* __restrict__ ocat) {
    const int lane = C.lane, r32 = lane & 31, hh = lane >> 5;
    const int krow = (r32 & 19) | ((r32 & 4) << 1) | ((r32 & 8) >> 1);
    constexpr float L2E = 1.4426950408889634f;
    {
        const int qs = u & 63, h = (u >> 6) & 7, b = u >> 9, kh = h >> 2;
        const int tq = qs * 32 + r32;
        const float slope2 = exp2f(-(float)(h + 1)) * L2E, sink2 = sink[h] * L2E;
        const f16* qrow = qkvu + (size_t)(b * SEQ + tq) * NQKVU + h * 64 + 8 * hh;
        half8 bq[4];
#pragma unroll
        for (int ks = 0; ks < 4; ++ks) bq[ks] = *(const half8*)(qrow + 16 * ks);
        f32x16 o0, o1;
#pragma unroll
        for (int r = 0; r < 16; ++r) { o0[r] = 0.f; o1[r] = 0.f; }
        float m = -1e30f, l = 0.f;
        const int kb_lo = max(qs - 4, 0), kb_hi = min(qs + 4, 63);
        LAS unsigned char* kst = lds + 65536 + C.wave * 8192; LAS unsigned char* vst = kst + 4096;
        const int krw = lane >> 3, kch = lane & 7, vrw = lane >> 2, vch = lane & 3;
        const f16* kg = qkvu + (size_t)(b * SEQ + krw) * NQKVU + COL_K + kh * 64 + kch * 8;
        const f16* vg = vT + (size_t)((b * 2 + kh) * 64 + vrw) * SEQ + vch * 8;
        half8 gk[4], gv[4];
#pragma unroll
        for (int i = 0; i < 4; ++i) { gk[i] = *(const half8*)(kg + (size_t)(kb_lo * 32 + 8 * i) * NQKVU); gv[i] = *(const half8*)(vg + (size_t)(16 * i) * SEQ + kb_lo * 32); }
#pragma unroll 1
        for (int kb = kb_lo; kb <= kb_hi; ++kb) {
#pragma unroll
            for (int i = 0; i < 4; ++i) {
                const int kr = krw + 8 * i; *(LAS half8*)(kst + kr * 128 + ((kch ^ (kr & 7)) << 4)) = gk[i];
                const int vr = vrw + 16 * i; *(LAS half8*)(vst + vr * 64 + ((vch ^ ((vr >> 2) & 3)) << 4)) = gv[i];
            }
            LDS_WAIT();
            half8 kf[4], va[2][2];
#pragma unroll
            for (int ks = 0; ks < 4; ++ks) kf[ks] = *(const LAS half8*)(kst + krow * 128 + (((2 * ks + hh) ^ (krow & 7)) << 4));
#pragma unroll
            for (int db = 0; db < 2; ++db)
#pragma unroll
                for (int st = 0; st < 2; ++st) { const int d = db * 32 + r32; va[db][st] = *(const LAS half8*)(vst + d * 64 + (((2 * st + hh) ^ ((d >> 2) & 3)) << 4)); }
            LDS_WAIT();
            const int kn = (DIAG == 2) ? kb_lo : (kb < kb_hi ? kb + 1 : kb);
#pragma unroll
            for (int i = 0; i < 4; ++i) { gk[i] = *(const half8*)(kg + (size_t)(kn * 32 + 8 * i) * NQKVU); gv[i] = *(const half8*)(vg + (size_t)(16 * i) * SEQ + kn * 32); }
            f32x16 s;
#pragma unroll
            for (int r = 0; r < 16; ++r) s[r] = 0.f;
#pragma unroll
            for (int ks = 0; ks < 4; ++ks) s = __builtin_amdgcn_mfma_f32_32x32x16_f16(kf[ks], bq[ks], s, 0, 0, 0);
            float bmax = -1e30f; bool ok[16];
#pragma unroll
            for (int r = 0; r < 16; ++r) {
                const int tk = kb * 32 + 16 * (r >> 3) + 8 * hh + (r & 7);
                const int dist = abs(tq - tk);
                ok[r] = dist <= 128;
                s[r] = ok[r] ? s[r] * (0.125f * L2E) - slope2 * (float)dist : -1e30f;
                bmax = fmaxf(bmax, s[r]);
            }
            bmax = fmaxf(bmax, __shfl_xor(bmax, 32));
            const float mn = fmaxf(m, bmax), al = exp2f(m - mn);
            m = mn;
            float ps = 0.f; half8 pb[2];
#pragma unroll
            for (int r = 0; r < 16; ++r) { const float p = ok[r] ? (DIAG == 1 ? (s[r] - mn) : exp2f(s[r] - mn)) : 0.f; ps += p; pb[r >> 3][r & 7] = (f16)p; }
            l = l * al + ps;
#pragma unroll
            for (int r = 0; r < 16; ++r) { o0[r] *= al; o1[r] *= al; }
#pragma unroll
            for (int st = 0; st < 2; ++st) { o0 = __builtin_amdgcn_mfma_f32_32x32x16_f16(va[0][st], pb[st], o0, 0, 0, 0); o1 = __builtin_amdgcn_mfma_f32_32x32x16_f16(va[1][st], pb[st], o1, 0, 0, 0); }
        }
        l += __shfl_xor(l, 32);
        const float mf = fmaxf(m, sink2), al = exp2f(m - mf);
        const float sc = al / (l * al + exp2f(sink2 - mf));
        f16* orow = ocat + (size_t)(b * SEQ + tq) * DM + h * 64 + 4 * hh;
#pragma unroll
        for (int g = 0; g < 4; ++g) {
            half4 a, c;
#pragma unroll
            for (int i = 0; i < 4; ++i) { a[i] = (f16)(o0[4 * g + i] * sc); c[i] = (f16)(o1[4 * g + i] * sc); }
            *(half4*)(orow + 8 * g) = a; *(half4*)(orow + 32 + 8 * g) = c;
        }
    }
}

__device__ __forceinline__ void attn_unit2(const Ctx& C, int u, LAS unsigned char* lds, const f16* __restrict__ qkvu, const f16* __restrict__ vT, const float* __restrict__ sink, f16* __restrict__ ocat) {
    const int lane = C.lane, r32 = lane & 31, hh = lane >> 5;
    const int krow = (r32 & 19) | ((r32 & 4) << 1) | ((r32 & 8) >> 1);
    constexpr float L2E = 1.4426950408889634f;
    const int qp = u & 31, h = (u >> 5) & 7, b = u >> 8, kh = h >> 2;
    const float slope2 = exp2f(-(float)(h + 1)) * L2E, sink2 = sink[h] * L2E;
    const float bbase = slope2 * (float)(r32 - 8 * hh);
    constexpr float THR = 6.0f;
    LAS unsigned char* qst = lds + 65536 + C.wave * 8192 + lane * 16;
    f32x16 o0[2], o1[2]; float m[2], l[2]; int tq[2];
#pragma unroll
    for (int j = 0; j < 2; ++j) {
        tq[j] = (2 * qp + j) * 32 + r32;
        const f16* qrow = qkvu + (size_t)(b * SEQ + tq[j]) * NQKVU + h * 64 + 8 * hh;
#pragma unroll
        for (int ks = 0; ks < 4; ++ks) *(LAS half8*)(qst + (j * 4 + ks) * 1024) = *(const half8*)(qrow + 16 * ks);
#pragma unroll
        for (int r = 0; r < 16; ++r) { o0[j][r] = 0.f; o1[j][r] = 0.f; }
        m[j] = -1e30f; l[j] = 0.f;
    }
    const int kb_lo = max(2 * qp - 4, 0), kb_hi = min(2 * qp + 5, 63);
    LAS unsigned char* kst = lds + C.wave * 8192;
    const int krw = lane >> 3, kch = lane & 7;
    const f16* kg = qkvu + (size_t)(b * SEQ + krw) * NQKVU + COL_K + kh * 64 + kch * 8;
    const f16* vbase = vT + (size_t)((b * 2 + kh) * 64 + r32) * SEQ + 8 * hh;
    half8 gk[4];
#pragma unroll
    for (int i = 0; i < 4; ++i) gk[i] = *(const half8*)(kg + (size_t)(kb_lo * 32 + 8 * i) * NQKVU);
#pragma unroll 1
    for (int kb = kb_lo; kb <= kb_hi; ++kb) {
        half8 kf[4], va[2][2];
#pragma unroll
        for (int db = 0; db < 2; ++db)
#pragma unroll
            for (int st = 0; st < 2; ++st) va[db][st] = *(const half8*)(vbase + (size_t)(db * 32) * SEQ + kb * 32 + 16 * st);
#pragma unroll
        for (int i = 0; i < 4; ++i) { const int kr = krw + 8 * i; *(LAS half8*)(kst + kr * 128 + ((kch ^ (kr & 7)) << 4)) = gk[i]; }
        LDS_WAIT();
#pragma unroll
        for (int ks = 0; ks < 4; ++ks) kf[ks] = *(const LAS half8*)(kst + krow * 128 + (((2 * ks + hh) ^ (krow & 7)) << 4));
        LDS_WAIT();
        const int kn = kb < kb_hi ? kb + 1 : kb;
#pragma unroll
        for (int i = 0; i < 4; ++i) gk[i] = *(const half8*)(kg + (size_t)(kn * 32 + 8 * i) * NQKVU);
#pragma unroll
        for (int j = 0; j < 2; ++j) {
            if (abs(kb - (2 * qp + j)) > 4) continue;
            const int D = (2 * qp + j) - kb;
            f32x16 s;
#pragma unroll
            for (int r = 0; r < 16; ++r) s[r] = 0.f;
#pragma unroll
            for (int ks = 0; ks < 4; ++ks) s = __builtin_amdgcn_mfma_f32_32x32x16_f16(kf[ks], *(const volatile LAS half8*)(qst + (j * 4 + ks) * 1024), s, 0, 0, 0);
            const float B = slope2 * 32.0f * (float)abs(D);
            float bm = -1e30f;
            if (D != 0) {
                const float ssl = D > 0 ? slope2 : -slope2, sb = D > 0 ? -bbase : bbase;
#pragma unroll
                for (int r = 0; r < 16; ++r) { const float bias = fmaf(ssl, (float)(16 * (r >> 3) + (r & 7)), sb); s[r] = fmaf(s[r], 0.125f * L2E, bias);
                    if (abs(D) == 4) s[r] = bias < -0.5f * slope2 ? -1e30f : s[r]; }
            } else {
#pragma unroll
                for (int r = 0; r < 16; ++r) s[r] = fmaf(s[r], 0.125f * L2E, -fabsf(fmaf(-slope2, (float)(16 * (r >> 3) + (r & 7)), bbase)));
            }
#pragma unroll
            for (int r = 0; r < 16; ++r) bm = fmaxf(bm, s[r]);
            bm = fmaxf(bm, __shfl_xor(bm, 32)) - B;
            {
                const float mn = (bm > m[j] + THR) ? bm : m[j], al = __builtin_amdgcn_exp2f(m[j] - mn);
                m[j] = mn; l[j] *= al;
#pragma unroll
                for (int r = 0; r < 16; ++r) { o0[j][r] *= al; o1[j][r] *= al; }
            }
            const float mb = m[j] + B;
            float ps = 0.f; half8 pb[2];
#pragma unroll
            for (int r = 0; r < 16; ++r) { const float pv = __builtin_amdgcn_exp2f(s[r] - mb); ps += pv; pb[r >> 3][r & 7] = (f16)pv; }
            l[j] += ps;
#pragma unroll
            for (int st = 0; st < 2; ++st) { o0[j] = __builtin_amdgcn_mfma_f32_32x32x16_f16(va[0][st], pb[st], o0[j], 0, 0, 0); o1[j] = __builtin_amdgcn_mfma_f32_32x32x16_f16(va[1][st], pb[st], o1[j], 0, 0, 0); }
            __builtin_amdgcn_sched_barrier(0);
        }
    }
#pragma unroll
    for (int j = 0; j < 2; ++j) {
        const float lt = l[j] + __shfl_xor(l[j], 32);
        const float mf = fmaxf(m[j], sink2), al = __builtin_amdgcn_exp2f(m[j] - mf);
        const float sc = al / (lt * al + __builtin_amdgcn_exp2f(sink2 - mf));
        LDS_WAIT();
#pragma unroll
        for (int g = 0; g < 4; ++g) {
            half4 a, c;
#pragma unroll
            for (int i = 0; i < 4; ++i) { a[i] = (f16)(o0[j][4 * g + i] * sc); c[i] = (f16)(o1[j][4 * g + i] * sc); }
            *(LAS half4*)(kst + r32 * 128 + ((g ^ (r32 & 7)) << 4) + 8 * hh) = a;
            *(LAS half4*)(kst + r32 * 128 + (((4 + g) ^ (r32 & 7)) << 4) + 8 * hh) = c;
        }
        LDS_WAIT();
#pragma unroll
        for (int i = 0; i < 4; ++i) {
            const int row = (lane >> 3) + 8 * i, ch = lane & 7;
            const half8 v = *(const LAS half8*)(kst + row * 128 + ((ch ^ (row & 7)) << 4));
            *(half8*)(ocat + (size_t)(b * SEQ + (2 * qp + j) * 32 + row) * DM + h * 64 + ch * 8) = v;
        }
    }
}

__device__ __forceinline__ void ph_pool_naive(const Ctx& C, const f16* __restrict__ qkvu, f16* __restrict__ mixed) {
    for (size_t gid = (size_t)C.gt; gid < (size_t)T * 512; gid += (size_t)C.ngt) {
        const int c = (int)(gid & 511), t = (int)(gid >> 9);
        const int b = t / SEQ, ts = t % SEQ, g = c >> 7, w = 2 << g;
        const int lo = max(ts - w / 2, 0), hi = min(ts + w / 2, SEQ);
        float s = 0.f;
        for (int i = lo; i < hi; ++i) s += (float)qkvu[(size_t)(b * SEQ + i) * NQKVU + COL_U + c];
        const float mean = s / (float)(hi - lo);
        mixed[(size_t)t * 512 + c] = (f16)(mean - (float)qkvu[(size_t)t * NQKVU + COL_U + c]);
    }
}
__device__ __forceinline__ void ph_poolmm_naive(const Ctx& C, const f16* __restrict__ mixed, const f16* __restrict__ poolw_t, const float* __restrict__ pscale, f16* __restrict__ ocat) {
    for (size_t gid = (size_t)C.gt; gid < (size_t)T * 512; gid += (size_t)C.ngt) {
        const int n = (int)(gid & 511), t = (int)(gid >> 9), g = n >> 7, d = n & 127;
        const f16* mr = mixed + (size_t)t * 512 + g * 128;
        const f16* wr = poolw_t + (size_t)(g * 128 + d) * 128;
        float acc = 0.f;
        for (int c = 0; c < 128; ++c) acc += (float)mr[c] * (float)wr[c];
        ocat[(size_t)t * DM + 512 + n] = (f16)(acc * pscale[n]);
    }
}

template <int HW>
__device__ __forceinline__ void pool_step1(const f16* __restrict__ qkvu, LAS unsigned char* tile, int t0, int g, int lane) {
    const int c2 = lane, b = t0 >> 11, sf = t0 & (SEQ - 1);
    const f16* ub = qkvu + (size_t)(b * SEQ) * NQKVU + COL_U + g * 128 + 2 * c2;
    constexpr int NR = 32 + 2 * HW - 1;
    half2 v[NR];
#pragma unroll
    for (int i = 0; i < NR; ++i) { const int s = sf - HW + i; half2 z; z[0] = (f16)0.f; z[1] = (f16)0.f; v[i] = z; if (s >= 0 && s < SEQ) v[i] = *(const half2*)(ub + (size_t)s * NQKVU); }
    float s0 = 0.f, s1 = 0.f;
#pragma unroll
    for (int i = 0; i < 2 * HW - 1; ++i) { s0 += (float)v[i][0]; s1 += (float)v[i][1]; }
#pragma unroll
    for (int j = 0; j < 32; ++j) {
        s0 += (float)v[j + 2 * HW - 1][0]; s1 += (float)v[j + 2 * HW - 1][1];
        const int s = sf + j, lo = max(s - HW, 0), hi = min(s + HW, SEQ);
        const float inv = 1.0f / (float)(hi - lo);
        half2 mx; mx[0] = (f16)(s0 * inv - (float)v[j + HW][0]); mx[1] = (f16)(s1 * inv - (float)v[j + HW][1]);
        *(LAS half2*)(tile + j * 256 + (((c2 >> 2) ^ (j & 15)) << 4) + ((c2 & 3) << 2)) = mx;
        s0 -= (float)v[j][0]; s1 -= (float)v[j][1];
    }
}
__device__ __forceinline__ void pool_unit(const Ctx& C, int u, LAS unsigned char* lds, const f16* __restrict__ qkvu, const f16* __restrict__ poolw_t, const float* __restrict__ pscale, f16* __restrict__ ocat) {
    const int lane = C.lane, r32 = lane & 31, hh = lane >> 5;
    LAS unsigned char* tile = lds + C.wave * 8192;
    const int g = u & 3, t0 = (u >> 2) * 32;
    switch (g) { case 0: pool_step1<1>(qkvu, tile, t0, g, lane); break; case 1: pool_step1<2>(qkvu, tile, t0, g, lane); break;
                 case 2: pool_step1<4>(qkvu, tile, t0, g, lane); break; default: pool_step1<8>(qkvu, tile, t0, g, lane); break; }
    LDS_WAIT();
    f32x16 acc[4];
#pragma unroll
    for (int db = 0; db < 4; ++db)
#pragma unroll
        for (int r = 0; r < 16; ++r) acc[db][r] = 0.f;
    const f16* wr = poolw_t + (size_t)(g * 128 + r32) * 128 + 8 * hh;
#pragma unroll
    for (int ks = 0; ks < 8; ++ks) {
        const half8 bm = *(const LAS half8*)(tile + r32 * 256 + (((2 * ks + hh) ^ (r32 & 15)) << 4));
#pragma unroll
        for (int db = 0; db < 4; ++db) { const half8 a = *(const half8*)(wr + (size_t)(db * 32) * 128 + 16 * ks); acc[db] = __builtin_amdgcn_mfma_f32_32x32x16_f16(a, bm, acc[db], 0, 0, 0); }
    }
    LDS_WAIT();
    f16* orow = ocat + (size_t)(t0 + r32) * DM + 512 + g * 128 + 4 * hh;
    const float* ps = pscale + g * 128 + 4 * hh;
#pragma unroll
    for (int db = 0; db < 4; ++db)
#pragma unroll
        for (int q = 0; q < 4; ++q) {
            const f32x4 pv = *(const f32x4*)(ps + db * 32 + 8 * q);
            half4 x0;
#pragma unroll
            for (int i = 0; i < 4; ++i) x0[i] = (f16)(acc[db][4 * q + i] * pv[i]);
            *(half4*)(orow + db * 32 + 8 * q) = x0;
        }
}
__device__ __forceinline__ void ph_attn_pool(const Ctx& C, LAS unsigned char* lds, const f16* __restrict__ qkvu, const f16* __restrict__ vT, const float* __restrict__ sink,
                                             const f16* __restrict__ poolw_t, const float* __restrict__ pscale, f16* __restrict__ ocat) {
    const int vwg = (C.G % 8 == 0) ? (int)(blockIdx.x % 8) * (C.G / 8) + (int)(blockIdx.x / 8) : (int)blockIdx.x;
    const bool pool_first = (C.wave & 4) != 0;
    for (int i = 0, m = vwg * NWAVES + C.wave; m < (T / 32) * 4; ++i) {
        if (((i & 1) == 0) == pool_first) pool_unit(C, m, lds, qkvu, poolw_t, pscale, ocat);
        else attn_unit2(C, m, lds, qkvu, vT, sink, ocat);
        if (i & 1) m += C.ngw;
    }
}

#define INS(LV, LI, v_, i_) do { float cv_ = (v_); int ci_ = (i_); \
    _Pragma("unroll") for (int z_ = 0; z_ < 16; ++z_) { const bool gt_ = cv_ > LV[z_]; const float tv_ = gt_ ? LV[z_] : cv_; const int ti_ = gt_ ? LI[z_] : ci_; \
        LV[z_] = gt_ ? cv_ : LV[z_]; LI[z_] = gt_ ? ci_ : LI[z_]; cv_ = tv_; ci_ = ti_; } } while (0)
__device__ __forceinline__ void ph_route_naive(const Ctx& C, const f16* __restrict__ qp, const float* __restrict__ ss2, const f16* __restrict__ subk, int* __restrict__ eidx, float* __restrict__ egate) {
    for (int gid = C.gt; gid < T * 8; gid += C.ngt) {
        const int t = gid % T, h = gid / T;
        const float rs2 = rs_from_ss(ss2, t);
        float av[16], bv[16]; int ai[16], bi[16];
#pragma unroll
        for (int z = 0; z < 16; ++z) { av[z] = -3e38f; bv[z] = -3e38f; ai[z] = 0; bi[z] = 0; }
        for (int p = 0; p < 2; ++p) {
            const f16* qr = qp + (size_t)t * 2048 + h * 256 + p * 128;
            for (int n = 0; n < 128; ++n) {
                const f16* kr = subk + ((size_t)((h * 2 + p) * 128 + n)) * 128;
                float dot = 0.f;
                for (int c = 0; c < 128; ++c) dot += (float)qr[c] * (float)kr[c];
                dot *= rs2;
                if (p == 0) INS(av, ai, dot, n); else INS(bv, bi, dot, n);
            }
        }
        float cv[16]; int ci[16];
#pragma unroll
        for (int z = 0; z < 16; ++z) { cv[z] = -3e38f; ci[z] = 0; }
#pragma unroll
        for (int i = 0; i < 16; ++i)
#pragma unroll
            for (int j = 0; j < 16; ++j)
                if ((i + 1) * (j + 1) <= 16) INS(cv, ci, av[i] + bv[j], ai[i] * 128 + bi[j]);
        float sum = 0.f, e[16];
#pragma unroll
        for (int z = 0; z < 16; ++z) { e[z] = __expf(cv[z] - cv[0]); sum += e[z]; }
        const float inv = 1.0f / sum;
#pragma unroll
        for (int z = 0; z < 16; ++z) { eidx[(size_t)t * 128 + h * 16 + z] = ci[z]; egate[(size_t)t * 128 + h * 16 + z] = e[z] * inv; }
    }
}

__device__ __forceinline__ int mono_i(float f) { const int b = __float_as_int(f); return b ^ ((b >> 31) & 0x7fffffff); }
__device__ __forceinline__ float unmono_f(int m) { return __int_as_float(m ^ ((m >> 31) & 0x7fffffff)); }
#define INS16(Lst, x_) do { int xv_ = (x_); _Pragma("unroll") for (int z_ = 0; z_ < 16; ++z_) { const int hi_ = max(Lst[z_], xv_); xv_ = min(Lst[z_], xv_); Lst[z_] = hi_; } } while (0)
__device__ __forceinline__ void merge_pair16(int (&Lst)[16]) {
    int P[16];
#pragma unroll
    for (int z = 0; z < 16; ++z) P[z] = __shfl_xor(Lst[z], 32);
#pragma unroll
    for (int z = 0; z < 16; ++z) Lst[z] = max(Lst[z], P[15 - z]);
#pragma unroll
    for (int s = 8; s >= 1; s >>= 1)
#pragma unroll
        for (int i = 0; i < 16; ++i) if ((i & s) == 0) { const int hi = max(Lst[i], Lst[i + s]), lo = min(Lst[i], Lst[i + s]); Lst[i] = hi; Lst[i + s] = lo; }
}
__device__ __forceinline__ void bitonic_sort16_desc(int (&K)[16]) {
#pragma unroll
    for (int k = 2; k <= 16; k <<= 1)
#pragma unroll
        for (int j = k >> 1; j > 0; j >>= 1)
#pragma unroll
            for (int i = 0; i < 16; ++i) { const int l = i ^ j; if (l > i) { const int a = K[i], b = K[l], hi = max(a, b), lo = min(a, b); const bool desc = (i & k) == 0; K[i] = desc ? hi : lo; K[l] = desc ? lo : hi; } }
}
__device__ __forceinline__ void bitonic_merge16_desc(int (&K)[16]) {
#pragma unroll
    for (int s = 8; s >= 1; s >>= 1)
#pragma unroll
        for (int i = 0; i < 16; ++i) if ((i & s) == 0) { const int hi = max(K[i], K[i + s]), lo = min(K[i], K[i + s]); K[i] = hi; K[i + s] = lo; }
}
template <class Side>
__device__ __forceinline__ void ph_route(const Ctx& C, LAS unsigned char* lds, const f16* __restrict__ qp, const float* __restrict__ ss2, const f16* __restrict__ subk,
                                         int* __restrict__ eidx, float* __restrict__ egate, const Side& side_job) {
    const int lane = C.lane, r32 = lane & 31, hh = lane >> 5;
    LAS unsigned char* tab = lds + 65536 + C.wave * 4096 + lane * 36;
    const int GH = C.G < 8 ? C.G : 8;
  for (int h = blockIdx.x % GH; h < 8; h += GH) {
    const int rank_h = blockIdx.x / GH, nwg_h = (C.G - (blockIdx.x % GH) + GH - 1) / GH;
    __syncthreads();
    for (int i = C.tid; i < 2 * 128 * 16; i += NTHREADS) {
        const int row = i >> 4, ch = i & 15;
        *(LAS half8*)(lds + row * 256 + ((ch ^ (row & 15)) << 4)) = *(const half8*)(subk + (size_t)(h * 256 + row) * 128 + ch * 8);
    }
    __syncthreads();
    if (h == (int)(blockIdx.x % GH) && (C.wave & 4)) side_job();
    for (int tb = rank_h * NWAVES + C.wave; tb < T / 32; tb += nwg_h * NWAVES) {
        const int t0 = tb * 32, t = t0 + r32;
        int top[2][16];
#pragma unroll
        for (int p = 0; p < 2; ++p) {
            const unsigned char* qbase = (const unsigned char*)qp + (size_t)(((t0 >> 8) * 8 + h) * 8 + ((t0 >> 6) & 1) * 4) * 16384
                                       + ((((t0 >> 7) & 1) * 4 + ((t0 >> 4) & 3) + (r32 >> 4)) * 2 + p) * 1024 + (hh * 16 + (r32 & 15)) * 16;
            const LAS unsigned char* kl = lds + (p * 128 + r32) * 256;
            half8 bq[8];
#pragma unroll
            for (int ks = 0; ks < 8; ++ks) bq[ks] = *(const half8*)(qbase + (ks >> 1) * 16384 + (ks & 1) * 512);
            int Lst[16];
#pragma unroll
            for (int z = 0; z < 16; ++z) Lst[z] = (int)0x80000000;
#pragma unroll 1
            for (int nb = 0; nb < 4; ++nb) {
                f32x16 acc = {0.f, 0.f, 0.f, 0.f, 0.f, 0.f, 0.f, 0.f, 0.f, 0.f, 0.f, 0.f, 0.f, 0.f, 0.f, 0.f};
#pragma unroll
                for (int ks = 0; ks < 8; ++ks) {
                    const half8 ak = *(const LAS half8*)(kl + nb * 32 * 256 + (((2 * ks + hh) ^ (r32 & 15)) << 4));
                    acc = __builtin_amdgcn_mfma_f32_32x32x16_f16(ak, bq[ks], acc, 0, 0, 0);
                }
                int K[16];
#pragma unroll
                for (int r = 0; r < 16; ++r) { const int n = nb * 32 + (r & 3) + 8 * (r >> 2) + 4 * hh; K[r] = (mono_i(acc[r]) & ~127) | (127 - n); }
                bitonic_sort16_desc(K);
#pragma unroll
                for (int z = 0; z < 16; ++z) Lst[z] = max(Lst[z], K[15 - z]);
                bitonic_merge16_desc(Lst);
            }
            merge_pair16(Lst);
#pragma unroll
            for (int z = 0; z < 16; ++z) top[p][z] = Lst[z];
        }
        float va[16], vb[16];
#pragma unroll
        for (int z = 0; z < 16; ++z) { va[z] = unmono_f(top[0][z] & ~127); vb[z] = unmono_f(top[1][z] & ~127);
            tab[z] = (unsigned char)(127 - (top[0][z] & 127)); tab[16 + z] = (unsigned char)(127 - (top[1][z] & 127)); }
        int Cl[16];
        { const float a01 = hh ? va[1] : va[0];
#pragma unroll
          for (int j = 0; j < 16; ++j) { const int key = (mono_i(a01 + vb[j]) & ~255) | (255 - (hh * 16 + j)); Cl[j] = (hh && j >= 8) ? (int)0x80000000 : key; } }
#pragma unroll
        for (int i = 2; i < 16; i += 2) {
            const float ai = hh ? va[i + 1] : va[i];
#pragma unroll
            for (int j = 0; j < 16; ++j)
                if ((i + 1) * (j + 1) <= 16) {
                    int key = (mono_i(ai + vb[j]) & ~255) | (255 - ((i + hh) * 16 + j));
                    if ((i + 2) * (j + 1) > 16) key = hh ? (int)0x80000000 : key;
                    INS16(Cl, key);
                }
        }
        merge_pair16(Cl);
        float e[16], sum = 0.f; const float mx = unmono_f(Cl[0] & ~255);
#pragma unroll
        for (int z = 0; z < 16; ++z) { e[z] = __expf(unmono_f(Cl[z] & ~255) - mx); sum += e[z]; }
        const float inv = 1.0f / sum;
        LDS_WAIT();
        int* ei = eidx + (size_t)t * 128 + h * 16 + 8 * hh; float* eg = egate + (size_t)t * 128 + h * 16 + 8 * hh;
#pragma unroll
        for (int z = 0; z < 16; ++z) {
            if ((z >> 3) == hh) { const int code = 255 - (Cl[z] & 255); const int ia = tab[code >> 4], ib = tab[16 + (code & 15)];
                ei[z & 7] = ia * 128 + ib; eg[z & 7] = e[z] * inv; }
        }
        LDS_WAIT();
    }
  }
}

struct Slicing { int m, pi, nloc, rank; };
__device__ __forceinline__ Slicing get_slicing(const unsigned* bar, volatile LAS unsigned* misc) {
    Slicing S; const unsigned x = (unsigned)__builtin_amdgcn_s_getreg((3 << 11) | 20) & 0xFu;
    int m = 0, pi = 0, nloc = 1;
    for (unsigned j = 0; j < 16; ++j) { const unsigned c = __hip_atomic_load(&bar[256 + 64 * j], __ATOMIC_RELAXED, __HIP_MEMORY_SCOPE_AGENT); if (c > 0u) { if (j < x) ++pi; ++m; } if (j == x) nloc = (int)c; }
    S.m = m > 0 ? m : 1; S.pi = pi; S.nloc = nloc > 0 ? nloc : 1; S.rank = (int)misc[10];
    return S;
}
__device__ __forceinline__ float gelu_fast(float v) {
    const float av = fabsf(v), t = __builtin_amdgcn_rcpf(av * 0.2316418882f + 1.0f);
    float q = t * 0.5307027145f + (-0.7265760135f); q = q * t + 0.7107068705f; q = q * t + (-0.142248368f); q = q * t + 0.127414796f; q = q * t;
    const float m = v * (q * __builtin_amdgcn_exp2f((v * v) * (-0.72134752044f)));
    return v < 0.f ? m : v - m;
}
__device__ __forceinline__ void ph_h2quant(const Ctx& C, const f16* __restrict__ x1h, const float* __restrict__ g2, const float* __restrict__ ss2, unsigned* __restrict__ h2q, float* __restrict__ hsc) {
    const int lane = C.lane;
    f32x4 gv[4];
#pragma unroll
    for (int j = 0; j < 4; ++j) gv[j] = *(const f32x4*)(g2 + 16 * lane + 4 * j);
    for (int tb = C.gw * 4; tb < T; tb += C.ngw * 4) {
        half8 h0[4], h1[4]; float rs[4];
#pragma unroll
        for (int u = 0; u < 4; ++u) { h0[u] = *(const half8*)(x1h + (size_t)(tb + u) * DM + 16 * lane); h1[u] = *(const half8*)(x1h + (size_t)(tb + u) * DM + 16 * lane + 8); rs[u] = rs_from_ss(ss2, tb + u); }
#pragma unroll
        for (int u = 0; u < 4; ++u) {
            float f[16]; float hm = 0.f;
#pragma unroll
            for (int i = 0; i < 8; ++i) { f[i] = (float)h0[u][i] * gv[i >> 2][i & 3]; f[8 + i] = (float)h1[u][i] * gv[2 + (i >> 2)][i & 3]; hm = fmaxf(hm, fmaxf(fabsf(f[i]), fabsf(f[8 + i]))); }
            hm = wave_max(hm);
            const float inv = hm > 0.f ? 127.0f / hm : 0.f;
            u32x4 w;
#pragma unroll
            for (int j = 0; j < 4; ++j) w[j] = (unsigned)pack4_i8(f[4 * j] * inv, f[4 * j + 1] * inv, f[4 * j + 2] * inv, f[4 * j + 3] * inv);
            *(u32x4*)(h2q + (size_t)(tb + u) * 256 + 4 * lane) = w;
            if (lane == 0) hsc[tb + u] = hm * (1.0f / 127.0f) * rs[u];
        }
    }
}
__device__ __forceinline__ __amdgpu_buffer_rsrc_t slice_rsrc(const unsigned char* base) {
    const unsigned long long b = (unsigned long long)base;
    const unsigned lo = __builtin_amdgcn_readfirstlane((unsigned)b), hi = __builtin_amdgcn_readfirstlane((unsigned)(b >> 32));
    return __builtin_amdgcn_make_buffer_rsrc((void*)(((unsigned long long)hi << 32) | lo), 0, NEXP * 128, 0x00020000);
}
template <int EMASK>
__device__ __forceinline__ void ph_upeer(const Ctx& C, LAS unsigned char* lds, const Slicing SL, const unsigned* __restrict__ h2q, const int* __restrict__ eidx,
                                         const unsigned char* __restrict__ uq, short* __restrict__ pdot) {
    const int lane = C.lane, grp = lane >> 3, c8 = lane & 7;
    const int wv = SL.rank * NWAVES + C.wave, nwv = SL.nloc * NWAVES;
    const int ntok = (T - wv + nwv - 1) / nwv;
    auto tok = [&](int i) { const int t = wv + i * nwv; return t < T ? t : T - 1; };
    volatile LAS int* row = (volatile LAS int*)(lds + C.wave * 1024);
  for (int s = SL.pi; s < 8; s += SL.m) {
    const __amdgpu_buffer_rsrc_t urs = slice_rsrc(uq + (size_t)s * (NEXP * 128));
    const unsigned* hqs = h2q + s * 32 + c8 * 4;
    int tA = tok(0), tB = tok(1);
    int e0 = eidx[(size_t)tA * 128 + lane], e1 = eidx[(size_t)tA * 128 + 64 + lane];
    u32x4 hq = *(const u32x4*)(hqs + (size_t)tA * 256);
    int ne0 = eidx[(size_t)tB * 128 + lane], ne1 = eidx[(size_t)tB * 128 + 64 + lane];
    u32x4 r[16];
#pragma unroll
    for (int i = 0; i < 16; ++i) { const int e = __shfl(i < 8 ? e0 : e1, 8 * (i & 7) + grp) & EMASK; r[i] = __builtin_amdgcn_raw_buffer_load_b128(urs, e * 128 + c8 * 16, 0, 0); }
#pragma unroll 1
    for (int it = 0; it < ntok; ++it) {
        const int t = tok(it), t1 = tok(it + 1), t2 = tok(it + 2);
        const int ze0 = eidx[(size_t)t2 * 128 + lane], ze1 = eidx[(size_t)t2 * 128 + 64 + lane];
        const u32x4 nhq = *(const u32x4*)(hqs + (size_t)t1 * 256);
#pragma unroll
        for (int q = 0; q < 4; ++q) {
            int evv[4];
#pragma unroll
            for (int j = 0; j < 4; ++j) evv[j] = __shfl(q < 2 ? ne0 : ne1, 32 * (q & 1) + 8 * j + grp) & EMASK;
            int pa[4], pb[4];
#pragma unroll
            for (int j = 0; j < 4; ++j) {
                pa[j] = __builtin_amdgcn_sdot4((int)r[4 * q + j][0], (int)hq[0], 0, false); pb[j] = __builtin_amdgcn_sdot4((int)r[4 * q + j][1], (int)hq[1], 0, false);
                pa[j] = __builtin_amdgcn_sdot4((int)r[4 * q + j][2], (int)hq[2], pa[j], false); pb[j] = __builtin_amdgcn_sdot4((int)r[4 * q + j][3], (int)hq[3], pb[j], false);
            }
#pragma unroll
            for (int j = 0; j < 4; ++j) { pa[j] += pb[j]; pa[j] += dppi<0xB1>(pa[j]); }
#pragma unroll
            for (int j = 0; j < 4; ++j) pa[j] += dppi<0x4E>(pa[j]);
#pragma unroll
            for (int j = 0; j < 4; ++j) pa[j] += dppi<0x141>(pa[j]);
            if (c8 == 0) {
#pragma unroll
                for (int j = 0; j < 4; ++j) row[8 * (4 * q + j) + grp] = pa[j];
            }
#pragma unroll
            for (int j = 0; j < 4; ++j) {
                asm volatile("" ::: "memory");
                r[4 * q + j] = __builtin_amdgcn_raw_buffer_load_b128(urs, evv[j] * 128 + c8 * 16, 0, 0);
                asm volatile("" ::: "memory");
            }
        }
        LDS_WAIT();
        const int p0 = row[lane], p1 = row[64 + lane];
        LDS_WAIT();
        { short* pp = pdot + ((size_t)s * T + t) * 128 + lane; const int c0 = min(max((p0 + 4) >> 3, -32768), 32767), c1 = min(max((p1 + 4) >> 3, -32768), 32767);
          asm volatile("global_store_short %0, %1, off\n\tglobal_store_short %0, %2, off offset:128" :: "v"(pp), "v"(c0), "v"(c1) : "memory"); }
        hq = nhq; ne0 = ze0; ne1 = ze1;
    }
  }
}
__device__ __forceinline__ void ph_ureduce(const Ctx& C, LAS unsigned char* lds, const short* __restrict__ pdot, const float* __restrict__ hsc, const int* __restrict__ eidx, const float* __restrict__ us,
                                           const float* __restrict__ vs, const float* __restrict__ egate, unsigned* __restrict__ wqp, float* __restrict__ wsc) {
    const int lane = C.lane;
    volatile LAS unsigned char* row = (volatile LAS unsigned char*)(lds + C.wave * 1024);
    for (int tb = C.gw * 2; tb < T; tb += C.ngw * 2) {
        int e0[2], e1[2], s0[2], s1[2]; float h[2], g0[2], g1[2];
#pragma unroll
        for (int u = 0; u < 2; ++u) {
            const int t = tb + u;
            e0[u] = eidx[(size_t)t * 128 + lane]; e1[u] = eidx[(size_t)t * 128 + 64 + lane];
            g0[u] = egate[(size_t)t * 128 + lane]; g1[u] = egate[(size_t)t * 128 + 64 + lane];
            h[u] = hsc[t]; s0[u] = 0; s1[u] = 0;
#pragma unroll
            for (int s = 0; s < 8; ++s) { const short* pp = pdot + ((size_t)s * T + t) * 128 + lane; s0[u] += (int)pp[0]; s1[u] += (int)pp[64]; }
        }
        float w0[2], w1[2];
#pragma unroll
        for (int u = 0; u < 2; ++u) {
            w0[u] = gelu_fast((float)s0[u] * (8.0f * h[u]) * us[e0[u]]) * g0[u] * vs[e0[u]];
            w1[u] = gelu_fast((float)s1[u] * (8.0f * h[u]) * us[e1[u]]) * g1[u] * vs[e1[u]];
        }
#pragma unroll
        for (int u = 0; u < 2; ++u) {
            const int t = tb + u;
            const float wm = wave_max(fmaxf(fabsf(w0[u]), fabsf(w1[u])));
            const float inv = wm > 0.f ? 127.0f / wm : 0.f;
            { const int k = lane; row[u * 128 + (k & 7) * 16 + (k >> 5) * 4 + ((k >> 3) & 3)] = (unsigned char)(int)rintf(w0[u] * inv); }
            { const int k = 64 + lane; row[u * 128 + (k & 7) * 16 + (k >> 5) * 4 + ((k >> 3) & 3)] = (unsigned char)(int)rintf(w1[u] * inv); }
            if (lane == 0) wsc[t] = wm * (1.0f / 127.0f);
        }
        LDS_WAIT();
        wqp[(size_t)tb * 32 + lane] = ((volatile LAS unsigned*)row)[lane];
        LDS_WAIT();
    }
}
template <int EMASK>
__device__ __forceinline__ void ph_vpeer(const Ctx& C, const Slicing SL, const int* __restrict__ eidx, const unsigned* __restrict__ wqp, const float* __restrict__ wsc, const unsigned char* __restrict__ vq,
                                         f16* __restrict__ peer) {
    const int lane = C.lane, grp = lane >> 3, c8 = lane & 7;
    const bool hh = (lane & 32) != 0, b4 = (lane & 16) != 0, b3 = (lane & 8) != 0;
    const int wv = SL.rank * NWAVES + C.wave, nwv = SL.nloc * NWAVES;
    const int ntok = (T - wv + nwv - 1) / nwv;
    auto tok = [&](int i) { const int t = wv + i * nwv; return t < T ? t : T - 1; };
  for (int s = SL.pi; s < 8; s += SL.m) {
    const __amdgpu_buffer_rsrc_t vrs = slice_rsrc(vq + (size_t)s * (NEXP * 128));
    const int chl = 8 * (hh ? 1 : 0) + 4 * (b4 ? 1 : 0) + 2 * (b3 ? 1 : 0);
    const int coff = s * 128 + c8 * 16 + chl;
    int tA = tok(0), tB = tok(1);
    int e0 = eidx[(size_t)tA * 128 + lane], e1 = eidx[(size_t)tA * 128 + 64 + lane];
    u32x4 wq = *(const u32x4*)(wqp + (size_t)tA * 32 + grp * 4); float wscale = wsc[tA];
    int ne0 = eidx[(size_t)tB * 128 + lane], ne1 = eidx[(size_t)tB * 128 + 64 + lane];
    u32x4 r[16];
#pragma unroll
    for (int i = 0; i < 16; ++i) { const int e = __shfl(i < 8 ? e0 : e1, 8 * (i & 7) + grp) & EMASK; r[i] = __builtin_amdgcn_raw_buffer_load_b128(vrs, e * 128 + c8 * 16, 0, 0); }
#pragma unroll 1
    for (int it = 0; it < ntok; ++it) {
        const int t = tok(it), t1 = tok(it + 1), t2 = tok(it + 2);
        const int ze0 = eidx[(size_t)t2 * 128 + lane], ze1 = eidx[(size_t)t2 * 128 + 64 + lane];
        const u32x4 nwq = *(const u32x4*)(wqp + (size_t)t1 * 32 + grp * 4); const float nwscale = wsc[t1];
        int o[16];
#pragma unroll
        for (int c = 0; c < 16; ++c) o[c] = 0;
#pragma unroll
        for (int q = 0; q < 4; ++q) {
            int evv[4];
#pragma unroll
            for (int j = 0; j < 4; ++j) evv[j] = __shfl(q < 2 ? ne0 : ne1, 32 * (q & 1) + 8 * j + grp) & EMASK;
#pragma unroll
            for (int d = 0; d < 4; ++d) {
                const unsigned a = r[4 * q][d], b = r[4 * q + 1][d], c = r[4 * q + 2][d], e = r[4 * q + 3][d];
                const unsigned t0 = __builtin_amdgcn_perm(b, a, 0x05010400u), t1p = __builtin_amdgcn_perm(b, a, 0x07030602u);
                const unsigned u0 = __builtin_amdgcn_perm(e, c, 0x05010400u), u1 = __builtin_amdgcn_perm(e, c, 0x07030602u);
                o[4 * d + 0] = __builtin_amdgcn_sdot4((int)__builtin_amdgcn_perm(u0, t0, 0x05040100u), (int)wq[q], o[4 * d + 0], false);
                o[4 * d + 1] = __builtin_amdgcn_sdot4((int)__builtin_amdgcn_perm(u0, t0, 0x07060302u), (int)wq[q], o[4 * d + 1], false);
                o[4 * d + 2] = __builtin_amdgcn_sdot4((int)__builtin_amdgcn_perm(u1, t1p, 0x05040100u), (int)wq[q], o[4 * d + 2], false);
                o[4 * d + 3] = __builtin_amdgcn_sdot4((int)__builtin_amdgcn_perm(u1, t1p, 0x07060302u), (int)wq[q], o[4 * d + 3], false);
            }
#pragma unroll
            for (int j = 0; j < 4; ++j) {
                asm volatile("" ::: "memory");
                r[4 * q + j] = __builtin_amdgcn_raw_buffer_load_b128(vrs, evv[j] * 128 + c8 * 16, 0, 0);
                asm volatile("" ::: "memory");
            }
        }
        int q8[8], q4[4], q2[2];
#pragma unroll
        for (int k = 0; k < 8; ++k) q8[k] = bfly32i(o[k], o[8 + k]);
#pragma unroll
        for (int k = 0; k < 4; ++k) q4[k] = bfly16i(q8[k], q8[4 + k]);
#pragma unroll
        for (int k = 0; k < 2; ++k) { const int mine = b3 ? q4[2 + k] : q4[k], oth = b3 ? q4[k] : q4[2 + k]; q2[k] = mine + dppi<0x128>(oth); }
        { half2 pv; pv[0] = (f16)((float)q2[0] * wscale); pv[1] = (f16)((float)q2[1] * wscale); f16* yp = peer + (size_t)t * DM + coff; asm volatile("global_store_dword %0, %1, off" :: "v"(yp), "v"(pv) : "memory"); }
        wq = nwq; wscale = nwscale; ne0 = ze0; ne1 = ze1;
    }
  }
}
__device__ __forceinline__ void ph_final(const Ctx& C, const f16* __restrict__ peer, const f16* __restrict__ x1h, float* __restrict__ out, const float* __restrict__ gf) {
    const int lane = C.lane;
    f32x4 gg[4];
#pragma unroll
    for (int j = 0; j < 4; ++j) gg[j] = *(const f32x4*)(gf + j * 256 + lane * 4);
    for (int tb = C.gw * 4; tb < T; tb += C.ngw * 4) {
        half4 xv[4][4], pe[4][4];
#pragma unroll
        for (int u = 0; u < 4; ++u)
#pragma unroll
            for (int j = 0; j < 4; ++j) { xv[u][j] = *(const half4*)(x1h + (size_t)(tb + u) * DM + j * 256 + lane * 4); pe[u][j] = *(const half4*)(peer + (size_t)(tb + u) * DM + j * 256 + lane * 4); }
#pragma unroll
        for (int u = 0; u < 4; ++u) {
            f32x4 v[4]; float s = 0.f;
#pragma unroll
            for (int j = 0; j < 4; ++j) {
#pragma unroll
                for (int i = 0; i < 4; ++i) { v[j][i] = (float)xv[u][j][i] + (float)pe[u][j][i]; s += v[j][i] * v[j][i]; }
            }
            const float r = rsqrtf(wave_sum(s) * (1.0f / DM) + EPS);
#pragma unroll
            for (int j = 0; j < 4; ++j) *(f32x4*)(out + (size_t)(tb + u) * DM + j * 256 + lane * 4) = v[j] * r * gg[j];
        }
    }
}

namespace pg8 {
#define PG8_LAS __attribute__((address_space(3)))
typedef _Float16 frag8 __attribute__((ext_vector_type(8)));
typedef float f32x4 __attribute__((ext_vector_type(4)));
constexpr int BM = 256, BK = 64, HALF = 128, HTB = HALF * BK * 2  , STAGE_BYTES = 8 * HTB, NXCD = 8, WGM = 8;

__host__ __device__ __forceinline__ int lds_byte(int r, int c) { const int st = (r >> 4) * 2 + (c >> 5), rr = r & 15, cc = c & 31, ob = rr * 64 + cc * 2; return st * 1024 + (ob ^ (((ob >> 9) & 1) << 5)); }
__host__ __device__ __forceinline__ void stage_rc(int b, int& R, int& C) { const int st = b / 1024, sb = b % 1024, swz = sb ^ (((sb >> 9) & 1) << 5); R = (st >> 1) * 16 + swz / 64; C = (st & 1) * 32 + (swz % 64) / 2; }
__host__ __device__ __forceinline__ int perm32(int rho) { const int n = rho >> 4, i = rho & 15; return 8 * (i >> 2) + 4 * n + (i & 3); }

struct Unit { int pm, pn; };
struct Gemm { const f16* A; const f16* Bt; int M, N, K; };

struct StaticOrder {
    int nM, nN, nwg, G, c;
    __host__ __device__ void init(int M, int N, int G_, int c_) { nM = M / BM; nN = N / BM; nwg = nM * nN; G = G_; c = c_; }
    __host__ __device__ bool next(int i, Unit& u) const {
        const long L = (long)i * G + c; if (L >= nwg) return false;
        int wgid = (int)L; { const int q = nwg / NXCD, r = nwg % NXCD, xcd = wgid % NXCD, off = wgid / NXCD; wgid = (xcd < r ? xcd * (q + 1) : r * (q + 1) + (xcd - r) * q) + off; }
        const int nig = WGM * nN, gid = wgid / nig, fm = gid * WGM, gsz = (nM - fm) < WGM ? (nM - fm) : WGM;
        u.pm = fm + ((wgid % nig) % gsz); u.pn = (wgid % nig) / gsz; return true;
    }
    __device__ __forceinline__ void a_ready(const Unit&) const {}
    __device__ __forceinline__ void done(const Unit&) const {}
};

__device__ __forceinline__ frag8 pack8(const f32x4 a, const f32x4 b) {
    frag8 h; h[0] = (f16)a[0]; h[1] = (f16)a[1]; h[2] = (f16)a[2]; h[3] = (f16)a[3]; h[4] = (f16)b[0]; h[5] = (f16)b[1]; h[6] = (f16)b[2]; h[7] = (f16)b[3]; return h;
}
__device__ __forceinline__ float sigmoidf_(float z) { return 1.0f / (1.0f + __expf(-z)); }

constexpr size_t GATE_TILE = 65536, GATE_WAVE = 8192, GATE_CHUNK = 1024;
struct EpiP1 {
    typedef i32x4 acc_t; static constexpr bool PERM = true, AFTER_DRAIN = false, MIDK = false;
    const float* ss1; const float* rsx; const float* wcs; const float* bgate; f16* qkvu; unsigned char* gates; f16* vT;
    __device__ __forceinline__ static unsigned q4(const f32x4 v) {
        return (unsigned)(v[0] * 255.0f + 0.5f) | ((unsigned)(v[1] * 255.0f + 0.5f) << 8) | ((unsigned)(v[2] * 255.0f + 0.5f) << 16) | ((unsigned)(v[3] * 255.0f + 0.5f) << 24);
    }
    __device__ __forceinline__ void operator()(const i32x4 (&acc)[2][2][4][2], const Unit& u, int wr, int wc, int fr, int fq) const {
        const int row0 = u.pm * BM + wr * 64 + fr, colt = u.pn * BM; const bool isg = colt >= NQKVU;
        f32x4 cs[2][2];
#pragma unroll
        for (int bj = 0; bj < 2; ++bj) { const int c0 = colt + bj * HALF + wc * 32 + 8 * fq; cs[bj][0] = *(const f32x4*)(wcs + c0); cs[bj][1] = *(const f32x4*)(wcs + c0 + 4); }
        unsigned char* gl = gates + (size_t)((u.pm * 8 + (u.pn - 5)) * 8 + wr * 4 + wc) * GATE_WAVE + (fq * 16 + fr) * 16;
#pragma unroll
        for (int ai = 0; ai < 2; ++ai)
#pragma unroll
            for (int m = 0; m < 4; ++m) { const int row = row0 + ai * HALF + m * 16; const float r = rsqrtf(ss1[row] * (1.0f / DM) + EPS) * rsx[row];
                u32x4 gw;
#pragma unroll
                for (int bj = 0; bj < 2; ++bj) { const int c0 = colt + bj * HALF + wc * 32 + 8 * fq; f32x4 v0, v1;
#pragma unroll
                    for (int i = 0; i < 4; ++i) { v0[i] = (float)acc[ai][bj][m][0][i] * (r * cs[bj][0][i]); v1[i] = (float)acc[ai][bj][m][1][i] * (r * cs[bj][1][i]); }
                    if (isg) { const int cg = c0 - NQKVU; const f32x4 b0 = *(const f32x4*)(bgate + cg), b1 = *(const f32x4*)(bgate + cg + 4);
#pragma unroll
                        for (int i = 0; i < 4; ++i) { v0[i] = sigmoidf_(v0[i] + b0[i]); v1[i] = sigmoidf_(v1[i] + b1[i]); }
                        gw[2 * bj] = q4(v0); gw[2 * bj + 1] = q4(v1); }
                    else { const frag8 hv = pack8(v0, v1); *(frag8*)(qkvu + (size_t)row * NQKVU + c0) = hv;
                        if (colt == 512 && bj == 1) {
                            f16* vp = vT + ((size_t)((row >> 11) * 2 + (wc >> 1)) * 64 + (wc & 1) * 32 + 8 * fq) * SEQ + (row & (SEQ - 1));
#pragma unroll
                            for (int i = 0; i < 8; ++i) vp[(size_t)i * SEQ] = hv[i]; } } }
                if (isg) *(u32x4*)(gl + (ai * 4 + m) * GATE_CHUNK) = gw; }
    }
};
struct EpiMerged {
    typedef f32x4 acc_t; static constexpr bool PERM = true, AFTER_DRAIN = false, MIDK = true;
    const unsigned char* gates; f16* merged;
    __device__ __forceinline__ static float ub(unsigned w, int i) { return (float)((w >> (8 * i)) & 255u); }
    __device__ __forceinline__ void mid(f32x4 (&acc)[2][2][4][2], const Unit& u, int wr, int wc, int fr, int fq) const {
        const unsigned char* gb = gates + (size_t)((u.pm * 8 + u.pn) * 8 + wr * 4 + wc) * GATE_WAVE + (fq * 16 + fr) * 16;
        asm volatile("" : "+v"(gb));
#pragma unroll
        for (int ai = 0; ai < 2; ++ai) {
            u32x4 g0[4], g1[4];
#pragma unroll
            for (int m = 0; m < 4; ++m) { g0[m] = *(const u32x4*)(gb + (ai * 4 + m) * GATE_CHUNK); g1[m] = *(const u32x4*)(gb + 4 * GATE_TILE + (ai * 4 + m) * GATE_CHUNK); }
#pragma unroll
            for (int m = 0; m < 4; ++m)
#pragma unroll
                for (int bj = 0; bj < 2; ++bj)
#pragma unroll
                    for (int n = 0; n < 2; ++n)
#pragma unroll
                        for (int i = 0; i < 4; ++i) acc[ai][bj][m][n][i] *= ub(g0[m][2 * bj + n], i) * __builtin_amdgcn_rcpf(fmaxf(ub(g1[m][2 * bj + n], i), 0.0255f));
            asm volatile("" ::: "memory");
        }
    }
    __device__ __forceinline__ void operator()(const f32x4 (&acc)[2][2][4][2], const Unit& u, int wr, int wc, int fr, int fq) const {
        const int row0 = u.pm * BM + wr * 64 + fr, colt = u.pn * BM;
        const unsigned char* gb = gates + (size_t)((u.pm * 8 + 4 + u.pn) * 8 + wr * 4 + wc) * GATE_WAVE + (fq * 16 + fr) * 16;
#pragma unroll
        for (int ai = 0; ai < 2; ++ai)
#pragma unroll
            for (int m = 0; m < 4; ++m) { const int row = row0 + ai * HALF + m * 16;
                const u32x4 g1 = *(const u32x4*)(gb + (ai * 4 + m) * GATE_CHUNK);
#pragma unroll
                for (int bj = 0; bj < 2; ++bj) { const int c0 = colt + bj * HALF + wc * 32 + 8 * fq; f32x4 v0, v1;
#pragma unroll
                    for (int i = 0; i < 4; ++i) { v0[i] = acc[ai][bj][m][0][i] * (fmaxf(ub(g1[2 * bj], i), 0.0255f) * (1.0f / 255.0f)); v1[i] = acc[ai][bj][m][1][i] * (fmaxf(ub(g1[2 * bj + 1], i), 0.0255f) * (1.0f / 255.0f)); }
                    *(frag8*)(merged + (size_t)row * DM + c0) = pack8(v0, v1); } }
    }
};
struct EpiOut {
    typedef f32x4 acc_t; static constexpr bool PERM = true, AFTER_DRAIN = false, MIDK = false;
    const float* x; f16* x1h; float* ss2p;
    __device__ __forceinline__ void operator()(const f32x4 (&acc)[2][2][4][2], const Unit& u, int wr, int wc, int fr, int fq) const {
        const int row0 = u.pm * BM + wr * 64 + fr, col0 = u.pn * BM + wc * 32 + 8 * fq;
#pragma unroll
        for (int ai = 0; ai < 2; ++ai)
#pragma unroll
            for (int m = 0; m < 4; ++m) { const int row = row0 + ai * HALF + m * 16; const size_t off = (size_t)row * DM + col0; float ssq = 0.f;
#pragma unroll
                for (int bj = 0; bj < 2; ++bj) {
                    const f32x4 y0 = *(const f32x4*)(x + off + bj * HALF) + acc[ai][bj][m][0], y1 = *(const f32x4*)(x + off + bj * HALF + 4) + acc[ai][bj][m][1];
                    ssq += ((y0[0] * y0[0] + y0[1] * y0[1]) + (y0[2] * y0[2] + y0[3] * y0[3])) + ((y1[0] * y1[0] + y1[1] * y1[1]) + (y1[2] * y1[2] + y1[3] * y1[3]));
                    *(frag8*)(x1h + off + bj * HALF) = pack8(y0, y1); }
                ssq += __shfl_xor(ssq, 16); ssq += __shfl_xor(ssq, 32);
                if (fq == 0) ss2p[(size_t)(u.pn * 4 + wc) * T + row] = ssq; }
    }
};
struct EpiQ {
    typedef i32x4 acc_t; static constexpr bool PERM = true, AFTER_DRAIN = false, MIDK = false;
    const float* hsc; const float* wqs; f16* qp;
    __device__ __forceinline__ void operator()(const i32x4 (&acc)[2][2][4][2], const Unit& u, int wr, int wc, int fr, int fq) const {
        const int row0 = u.pm * BM + wr * 64 + fr, colt = u.pn * BM;
        f32x4 cs[2][2];
#pragma unroll
        for (int bj = 0; bj < 2; ++bj) { const int c0 = colt + bj * HALF + wc * 32 + 8 * fq; cs[bj][0] = *(const f32x4*)(wqs + c0); cs[bj][1] = *(const f32x4*)(wqs + c0 + 4); }
        unsigned char* qb = (unsigned char*)qp + (size_t)((u.pm * 8 + u.pn) * 8 + wr * 4 + wc) * 16384 + (fq * 16 + fr) * 16;
#pragma unroll
        for (int ai = 0; ai < 2; ++ai)
#pragma unroll
            for (int m = 0; m < 4; ++m) { const int row = row0 + ai * HALF + m * 16; const float r = hsc[row];
#pragma unroll
                for (int bj = 0; bj < 2; ++bj) { f32x4 v0, v1;
#pragma unroll
                    for (int i = 0; i < 4; ++i) { v0[i] = (float)acc[ai][bj][m][0][i] * (r * cs[bj][0][i]); v1[i] = (float)acc[ai][bj][m][1][i] * (r * cs[bj][1][i]); }
                    *(frag8*)(qb + ((ai * 4 + m) * 2 + bj) * 1024) = pack8(v0, v1); } }
    }
};

__device__ __forceinline__ void mma16(const frag8 b, const frag8 a, f32x4& c) { c = __builtin_amdgcn_mfma_f32_16x16x32_f16(b, a, c, 0, 0, 0); }
__device__ __forceinline__ void mma16(const frag8 b, const frag8 a, i32x4& c) { c = __builtin_amdgcn_mfma_i32_16x16x64_i8(__builtin_bit_cast(i32x4, b), __builtin_bit_cast(i32x4, a), c, 0, 0, 0); }
template <class Epi, class Sched, bool ALIGN_EPI = false, bool SP2 = false>
__device__ __forceinline__ void gemm_phase(PG8_LAS unsigned char* lds, const Gemm g, const Sched& S, const Epi& E) {
    const int tid = threadIdx.x, wid = __builtin_amdgcn_readfirstlane(tid >> 6), lane = tid & 63, wr = wid >> 2, wc = wid & 3, fr = lane & 15, fq = lane >> 4;
    const int K = g.K, nt = K / BK;
    unsigned voffA[2], voffB[2];
#pragma unroll
    for (int i = 0; i < 2; ++i) { int R, C; stage_rc(tid * 16 + i * 8192, R, C); const int Rb = Epi::PERM ? ((R & ~31) + perm32(R & 31)) : R;
        voffA[i] = (unsigned)(R * K + C) * 2u; voffB[i] = (unsigned)(Rb * K + C) * 2u; }
    const size_t kstep = (size_t)(BK * 2);
    const size_t hstep = (size_t)HALF * K * 2;
    const size_t tstep = 2 * hstep;
    const unsigned ldsw = (unsigned)wid * 1024u;
    const int aoff = lds_byte(wr * 64 + fr, fq * 8), boff = lds_byte(wc * 32 + fr, fq * 8);
#define PG8_SA(b, h) (((b) * 2 + (h)) * HTB)
#define PG8_SB(b, h) ((4 + (b) * 2 + (h)) * HTB)
#define PG8_STAGE(bufoff, gbase, voff) do { _Pragma("unroll") for (int _i = 0; _i < 2; ++_i) \
        __builtin_amdgcn_global_load_lds((const unsigned*)((const char*)(gbase) + (voff)[_i]), (PG8_LAS unsigned*)(lds + (bufoff) + ldsw + _i * 8192), 16, 0, 0); } while (0)
#define PG8_LDA(dst, b, h) do { _Pragma("unroll") for (int m = 0; m < 4; ++m) _Pragma("unroll") for (int k = 0; k < 2; ++k) dst[m][k] = *(const PG8_LAS frag8*)(lds + PG8_SA(b, h) + aoff + m * 2048 + k * 1024); } while (0)
#define PG8_LDB(dst, b, h) do { _Pragma("unroll") for (int n = 0; n < 2; ++n) _Pragma("unroll") for (int k = 0; k < 2; ++k) dst[n][k] = *(const PG8_LAS frag8*)(lds + PG8_SB(b, h) + boff + n * 2048 + k * 1024); } while (0)
#define PG8_MMA(ai, bj, At, Bt) do { __builtin_amdgcn_s_setprio(1); _Pragma("unroll") for (int m = 0; m < 4; ++m) _Pragma("unroll") for (int n = 0; n < 2; ++n) _Pragma("unroll") for (int k = 0; k < 2; ++k) \
        mma16(Bt[n][k], At[m][k], acc[ai][bj][m][n]); __builtin_amdgcn_s_setprio(0); } while (0)
#define PG8_WAIT_V(n) asm volatile("s_waitcnt vmcnt(" #n ")" ::: "memory")
#define PG8_WAIT_L(n) asm volatile("s_waitcnt lgkmcnt(" #n ")" ::: "memory")
#define PG8_BAR __builtin_amdgcn_s_barrier()
#define PG8_SCHED __builtin_amdgcn_sched_barrier(0)
    Unit cur, nxt; int ui = 0;
    if (!S.next(0, cur)) return;
    typedef typename Epi::acc_t acc_t;
    acc_t acc[2][2][4][2];
#pragma unroll
    for (int a = 0; a < 2; ++a)
#pragma unroll
        for (int b = 0; b < 2; ++b)
#pragma unroll
            for (int m = 0; m < 4; ++m)
#pragma unroll
                for (int n = 0; n < 2; ++n) acc[a][b][m][n] = acc_t{};
    frag8 At[4][2], B0[2][2], B1[2][2];
    const char* cA = (const char*)g.A + (size_t)cur.pm * tstep; const char* cB = (const char*)g.Bt + (size_t)cur.pn * tstep;
    S.a_ready(cur);
    if constexpr (SP2) {
        PG8_STAGE(PG8_SB(0, 0), cB, voffB); PG8_STAGE(PG8_SB(0, 1), cB + hstep, voffB); PG8_STAGE(PG8_SA(0, 0), cA, voffA); PG8_STAGE(PG8_SA(0, 1), cA + hstep, voffA);
        if (wr == 1) PG8_BAR;
        PG8_WAIT_V(2); PG8_BAR;
        PG8_STAGE(PG8_SB(1, 0), cB + kstep, voffB); PG8_STAGE(PG8_SA(1, 0), cA + kstep, voffA); PG8_STAGE(PG8_SB(1, 1), cB + hstep + kstep, voffB);
        PG8_WAIT_V(6); PG8_BAR;
    } else {
        PG8_STAGE(PG8_SB(0, 0), cB, voffB); PG8_STAGE(PG8_SA(0, 0), cA, voffA); PG8_STAGE(PG8_SB(0, 1), cB + hstep, voffB); PG8_STAGE(PG8_SA(0, 1), cA + hstep, voffA);
        if (wr == 1) PG8_BAR;
        PG8_WAIT_V(4); PG8_BAR;
        PG8_STAGE(PG8_SB(1, 0), cB + kstep, voffB); PG8_STAGE(PG8_SA(1, 0), cA + kstep, voffA); PG8_STAGE(PG8_SB(1, 1), cB + hstep + kstep, voffB);
        PG8_WAIT_V(6); PG8_BAR;
    }
    for (;;) {
        const bool has_next = S.next(ui + 1, nxt);
        const char* nA = has_next ? (const char*)g.A + (size_t)nxt.pm * tstep : cA; const char* nB = has_next ? (const char*)g.Bt + (size_t)nxt.pn * tstep : cB;
        for (int t = 0; t < nt; t += 2) {
            const bool last = (t == nt - 2);
            if constexpr (Epi::MIDK) { if (t == (nt >> 1)) E.mid(acc, cur, wr, wc, fr, fq); }
            const char* a1 = cA + (size_t)(t + 1) * kstep;
            const char* a2 = last ? nA : cA + (size_t)(t + 2) * kstep; const char* b2 = last ? nB : cB + (size_t)(t + 2) * kstep;
            const char* a3 = a2 + kstep; const char* b3 = b2 + kstep;
            if (last && has_next) S.a_ready(nxt);
            if constexpr (SP2) {
            PG8_LDB(B0, 0, 0); PG8_LDB(B1, 0, 1); PG8_SCHED; PG8_LDA(At, 0, 0); PG8_STAGE(PG8_SA(1, 1), a1 + hstep, voffA);
            PG8_WAIT_V(8); PG8_WAIT_L(0); PG8_BAR; PG8_MMA(0, 0, At, B0); PG8_MMA(0, 1, At, B1); PG8_BAR; PG8_SCHED;
            PG8_LDA(At, 0, 1); PG8_STAGE(PG8_SB(0, 0), b2, voffB); PG8_STAGE(PG8_SB(0, 1), b2 + hstep, voffB); PG8_STAGE(PG8_SA(0, 0), a2, voffA);
            PG8_WAIT_V(8); PG8_WAIT_L(0); PG8_BAR; PG8_MMA(1, 0, At, B0); PG8_MMA(1, 1, At, B1); PG8_BAR; PG8_SCHED;
            PG8_LDB(B0, 1, 0); PG8_LDB(B1, 1, 1); PG8_SCHED; PG8_LDA(At, 1, 0); PG8_STAGE(PG8_SA(0, 1), a2 + hstep, voffA);
            PG8_WAIT_V(8); PG8_WAIT_L(0); PG8_BAR; PG8_MMA(0, 0, At, B0); PG8_MMA(0, 1, At, B1); PG8_BAR; PG8_SCHED;
            PG8_LDA(At, 1, 1); PG8_STAGE(PG8_SB(1, 0), b3, voffB); PG8_STAGE(PG8_SB(1, 1), b3 + hstep, voffB); PG8_STAGE(PG8_SA(1, 0), a3, voffA);
            PG8_WAIT_V(8); PG8_WAIT_L(0); PG8_BAR; PG8_MMA(1, 0, At, B0); PG8_MMA(1, 1, At, B1); PG8_BAR; PG8_SCHED;
            } else {
            PG8_LDB(B0, 0, 0); PG8_SCHED; PG8_LDA(At, 0, 0); PG8_STAGE(PG8_SA(1, 1), a1 + hstep, voffA);
            PG8_WAIT_L(8); PG8_BAR; PG8_WAIT_L(0); PG8_MMA(0, 0, At, B0); PG8_BAR; PG8_SCHED;
            PG8_LDB(B1, 0, 1); PG8_STAGE(PG8_SB(0, 0), b2, voffB);
            PG8_BAR; PG8_WAIT_L(0); PG8_MMA(0, 1, At, B1); PG8_BAR;
            PG8_LDA(At, 0, 1); PG8_STAGE(PG8_SA(0, 0), a2, voffA);
            PG8_BAR; PG8_WAIT_L(0); PG8_MMA(1, 0, At, B0); PG8_BAR; PG8_SCHED;
            PG8_STAGE(PG8_SB(0, 1), b2 + hstep, voffB);
            PG8_WAIT_V(6); PG8_BAR; PG8_MMA(1, 1, At, B1); PG8_BAR;
            PG8_LDB(B0, 1, 0); PG8_SCHED; PG8_LDA(At, 1, 0); PG8_STAGE(PG8_SA(0, 1), a2 + hstep, voffA);
            PG8_WAIT_L(8); PG8_BAR; PG8_WAIT_L(0); PG8_MMA(0, 0, At, B0); PG8_BAR; PG8_SCHED;
            PG8_LDB(B1, 1, 1); PG8_STAGE(PG8_SB(1, 0), b3, voffB);
            PG8_BAR; PG8_WAIT_L(0); PG8_MMA(0, 1, At, B1); PG8_BAR;
            PG8_LDA(At, 1, 1); PG8_STAGE(PG8_SA(1, 0), a3, voffA);
            PG8_BAR; PG8_WAIT_L(0); PG8_MMA(1, 0, At, B0); PG8_BAR; PG8_SCHED;
            PG8_STAGE(PG8_SB(1, 1), b3 + hstep, voffB);
            PG8_WAIT_V(6); PG8_BAR; PG8_MMA(1, 1, At, B1); PG8_BAR;
            }
        }
        if constexpr (ALIGN_EPI) { if (wr == 0) PG8_BAR; }
        if constexpr (!Epi::AFTER_DRAIN) { E(acc, cur, wr, wc, fr, fq); S.done(cur); }
        if (!has_next) break;
#pragma unroll
        for (int a = 0; a < 2; ++a)
#pragma unroll
            for (int b = 0; b < 2; ++b)
#pragma unroll
                for (int m = 0; m < 4; ++m)
#pragma unroll
                    for (int n = 0; n < 2; ++n) acc[a][b][m][n] = acc_t{};
        cur = nxt; cA = nA; cB = nB; ++ui;
        if constexpr (ALIGN_EPI) { if (wr == 1) PG8_BAR; }
    }
    PG8_WAIT_V(0);
    if constexpr (!ALIGN_EPI) { if (wr == 0) PG8_BAR; }
    PG8_BAR;
    if constexpr (Epi::AFTER_DRAIN) { E.fused(acc, cur, wr, wc, fr, fq, lds, wid, lane); S.done(cur); }
#undef PG8_SA
#undef PG8_SB
#undef PG8_STAGE
#undef PG8_LDA
#undef PG8_LDB
#undef PG8_MMA
#undef PG8_WAIT_V
#undef PG8_WAIT_L
#undef PG8_BAR
#undef PG8_SCHED
}
}

#define XB_TMO      128
#define XB_XCNT(j)  (256  + 64 * (j))
#define XB_XSUB(j)  (1280 + 64 * (j))
#define XB_XGEN(j)  (2304 + 64 * (j))
#define XB_TOP      3328
#define XB_TOPGEN   3392
#define XCD_BAR_WORDS 3456
#define XB_SPIN_CAP (1u << 18)

__device__ __forceinline__ unsigned xb_ld(unsigned* p)              { return __hip_atomic_load(p, __ATOMIC_RELAXED, __HIP_MEMORY_SCOPE_AGENT); }
__device__ __forceinline__ unsigned xb_add(unsigned* p, unsigned v) { return __hip_atomic_fetch_add(p, v, __ATOMIC_RELAXED, __HIP_MEMORY_SCOPE_AGENT); }
__device__ __forceinline__ unsigned xb_xcc_id() { return (unsigned)__builtin_amdgcn_s_getreg((3 << 11) | 20) & 0xFu; }
#define XB_SPIN(cond, bar) do { unsigned _sp = 0; while (cond) { __builtin_amdgcn_s_sleep(1); \
    if ((++_sp & 255u) == 0u) { if (xb_ld(&(bar)[XB_TMO])) break; if (_sp > XB_SPIN_CAP) { atomicAdd(&(bar)[XB_TMO], 1u); break; } } } } while (0)

struct XcdBarrier {
    unsigned* bar; unsigned x;
    volatile LAS unsigned* st;
};

__device__ __forceinline__ XcdBarrier xcd_barrier_post(unsigned* bar, volatile LAS unsigned* st) {
    XcdBarrier b; b.bar = bar; b.x = xb_xcc_id(); b.st = st;
    if (threadIdx.x == 0) st[2] = xb_add(&bar[XB_XCNT(b.x)], 1u);
    return b;
}
__device__ __forceinline__ void xcd_barrier_complete(unsigned* bar, unsigned x, unsigned& nloc, unsigned& nx) {
    const unsigned G = gridDim.x * gridDim.y * gridDim.z;
    unsigned sum, cnt, mine, sp = 0u;
    for (;;) {
        sum = 0u; cnt = 0u; mine = 0u;
#pragma unroll
        for (unsigned j = 0; j < 16; ++j) { const unsigned c = xb_ld(&bar[XB_XCNT(j)]); sum += c; cnt += (c > 0u) ? 1u : 0u; mine = (j == x) ? c : mine; }
        if (sum == G) break;
        __builtin_amdgcn_s_sleep(1);
        if ((++sp & 255u) == 0u) { if (xb_ld(&bar[XB_TMO])) break; if (sp > XB_SPIN_CAP) { atomicAdd(&bar[XB_TMO], 1u); break; } }
    }
    nloc = mine > 0u ? mine : 1u; nx = cnt > 0u ? cnt : 1u;
}

__device__ __forceinline__ void xcd_barrier(const XcdBarrier& b) {
    asm volatile("s_waitcnt vmcnt(0)" ::: "memory");
    __syncthreads();
    if (threadIdx.x == 0) {
        unsigned* bar = b.bar;
        __builtin_amdgcn_s_waitcnt(0);
        unsigned nloc = b.st[0], nx = b.st[1];
        if (nloc == 0u) { xcd_barrier_complete(bar, b.x, nloc, nx); b.st[0] = nloc; b.st[1] = nx; }
        const unsigned old = xb_add(&bar[XB_XSUB(b.x)], 1u);
        const unsigned gen = old / nloc;
        if (old + 1u == (gen + 1u) * nloc) {
            __builtin_amdgcn_fence(__ATOMIC_RELEASE, "agent");
            asm volatile("s_waitcnt vmcnt(0)" ::: "memory");
            const unsigned og = xb_add(&bar[XB_TOP], 1u);
            const unsigned tg = og / nx;
            if (og + 1u == (tg + 1u) * nx) xb_add(&bar[XB_TOPGEN], 1u);
            else XB_SPIN(xb_ld(&bar[XB_TOPGEN]) == tg, bar);
            __builtin_amdgcn_fence(__ATOMIC_ACQUIRE, "agent");
            xb_add(&bar[XB_XGEN(b.x)], 1u);
            asm volatile("s_waitcnt vmcnt(0)" ::: "memory");
        } else {
            XB_SPIN(xb_ld(&bar[XB_XGEN(b.x)]) == gen, bar);
            __builtin_amdgcn_fence(__ATOMIC_ACQUIRE, "agent");
            asm volatile("s_waitcnt vmcnt(0)" ::: "memory");
        }
    }
    __syncthreads();
}


struct Args { const float* in[16]; float* out; unsigned char* ws; int ph_lo, ph_hi; };
constexpr int N_PHASES = 11;

__global__ void __launch_bounds__(NTHREADS, 2) mk_fwd(Args a) {
    extern __shared__ __attribute__((aligned(16))) unsigned char lds[];
    LAS unsigned char* L = (LAS unsigned char*)lds;
    volatile LAS unsigned* MISC = (volatile LAS unsigned*)(L + MISC_OFF);
    unsigned char* ws = a.ws;
    Ctx C;
    C.tid = threadIdx.x; C.lane = C.tid & 63; C.wave = __builtin_amdgcn_readfirstlane(C.tid >> 6);
    C.G = gridDim.x; C.gw = blockIdx.x * NWAVES + C.wave; C.ngw = C.G * NWAVES; C.gt = blockIdx.x * NTHREADS + C.tid; C.ngt = C.G * NTHREADS;
    for (int u = C.tid; u < (LDS_BYTES - LDSCTL_OFF) / 4; u += NTHREADS) ((LAS unsigned*)(L + LDSCTL_OFF))[u] = 0u;
    __syncthreads();
    const int lo = a.ph_lo, hi = a.ph_hi, G = C.G;
    const bool multi = (hi - lo) > 1;
    XcdBarrier bar; bar.bar = (unsigned*)(ws + WS_CTL) + CW_BAR; bar.x = 0; bar.st = nullptr;
    if (multi) bar = xcd_barrier_post((unsigned*)(ws + WS_CTL) + CW_BAR, MISC + 8);
#define IN(k) (lo <= (k) && (k) < hi)
#define SEAM(k) do { if (IN(k) && IN((k) + 1)) xcd_barrier(bar); } while (0)

#define REPS(k) _Pragma("unroll") for (int rep_ = 0; rep_ < ((PROBE_DUP == (k)) ? 2 : 1); ++rep_)
#define REPBAR(k) do { if (PROBE_DUP == (k) && rep_ == 0) xcd_barrier(bar); } while (0)
    if (IN(0)) REPS(0) { ph_prep(C, L, a.in, ws); REPBAR(0); }
    SEAM(0);
    if (IN(1)) REPS(1) {
        quant_wrows(C, (const f16*)(ws + WS_WCAT), NCAT, (unsigned*)(ws + WS_WCATQ), (float*)(ws + WS_WCS));
        quant_wrows(C, (const f16*)(ws + WS_WQ), 2048, (unsigned*)(ws + WS_WQQ), (float*)(ws + WS_WQS));
        xcd_barrier(bar);
        pg8::Gemm g{(const f16*)(ws + WS_XH), (const f16*)(ws + WS_WCATQ), T, NCAT, DM / 2}; pg8::StaticOrder S; S.init(T, NCAT, G, (int)blockIdx.x);
        pg8::EpiP1 E{(const float*)(ws + WS_RS1), (const float*)(ws + WS_RSX), (const float*)(ws + WS_WCS), a.in[8], (f16*)(ws + WS_QKVU), ws + WS_GATES, (f16*)(ws + WS_VT)};
        pg8::gemm_phase<pg8::EpiP1, pg8::StaticOrder, true, true>(L, g, S, E);
        REPBAR(1);
    }
    SEAM(1);
    if (IN(2)) REPS(2) {
        ph_attn_pool(C, L, (const f16*)(ws + WS_QKVU), (const f16*)(ws + WS_VT), a.in[3], (const f16*)(ws + WS_POOLW), a.in[5], (f16*)(ws + WS_OCAT));
        REPBAR(2);
    }
    if (IN(2) && IN(4)) xcd_barrier(bar);
    if (IN(4)) REPS(4) {
        pg8::Gemm g{(const f16*)(ws + WS_OCAT), (const f16*)(ws + WS_WB), T, DM, DM}; pg8::StaticOrder S; S.init(T, DM, G, (int)blockIdx.x);
        pg8::EpiMerged E{ws + WS_GATES, (f16*)(ws + WS_MERGED)};
        pg8::gemm_phase<pg8::EpiMerged, pg8::StaticOrder, true, true>(L, g, S, E);
        REPBAR(4);
    }
    SEAM(4);
    if (IN(5)) REPS(5) {
        pg8::Gemm g{(const f16*)(ws + WS_MERGED), (const f16*)(ws + WS_WOUT), T, DM, DM}; pg8::StaticOrder S; S.init(T, DM, G, (int)blockIdx.x);
        pg8::EpiOut E{a.in[0], (f16*)(ws + WS_X1H), (float*)(ws + WS_SS2)};
        pg8::gemm_phase<pg8::EpiOut, pg8::StaticOrder, true, true>(L, g, S, E);
        REPBAR(5);
    }
    SEAM(5);
    if (IN(6)) REPS(6) {
        ph_h2quant(C, (const f16*)(ws + WS_X1H), a.in[10], (const float*)(ws + WS_SS2), (unsigned*)(ws + WS_H2Q), (float*)(ws + WS_HSC));
        xcd_barrier(bar);
        pg8::Gemm g{(const f16*)(ws + WS_H2Q), (const f16*)(ws + WS_WQQ), T, 2048, DM / 2}; pg8::StaticOrder S; S.init(T, 2048, G, (int)blockIdx.x);
        pg8::EpiQ E{(const float*)(ws + WS_HSC), (const float*)(ws + WS_WQS), (f16*)(ws + WS_QP)};
        pg8::gemm_phase<pg8::EpiQ, pg8::StaticOrder, true, true>(L, g, S, E);
        REPBAR(6);
    }
    SEAM(6);
    if (IN(7)) REPS(7) {
        auto side = [&]() {
            quant_rows<false>(C, a.in[13], (unsigned*)(ws + WS_UQ), (float*)(ws + WS_US));
            quant_rows<false>(C, a.in[14], (unsigned*)(ws + WS_VQ), (float*)(ws + WS_VS));
        };
        ph_route(C, L, (const f16*)(ws + WS_QP), (const float*)(ws + WS_SS2), (const f16*)(ws + WS_SUBK), (int*)(ws + WS_EIDX), (float*)(ws + WS_EGATE), side);
        if (!(C.wave & 4)) side();
        REPBAR(7); }
    SEAM(7);
    if (IN(8)) REPS(8) {
        const Slicing SL = get_slicing((const unsigned*)(ws + WS_CTL) + CW_BAR, MISC);
        if (PROBE_DUP == 8 && rep_ == 0) ph_upeer<255>(C, L, SL, (const unsigned*)(ws + WS_H2Q), (const int*)(ws + WS_EIDX), (const unsigned char*)(ws + WS_UQ), (short*)(ws + WS_PDOT));
        else ph_upeer<16383>(C, L, SL, (const unsigned*)(ws + WS_H2Q), (const int*)(ws + WS_EIDX), (const unsigned char*)(ws + WS_UQ), (short*)(ws + WS_PDOT));
        REPBAR(8);
    }
    SEAM(8);
    if (IN(9)) {
        REPS(9) {
        ph_ureduce(C, L, (const short*)(ws + WS_PDOT), (const float*)(ws + WS_HSC), (const int*)(ws + WS_EIDX), (const float*)(ws + WS_US), (const float*)(ws + WS_VS), (const float*)(ws + WS_EGATE),
                   (unsigned*)(ws + WS_WQP), (float*)(ws + WS_WSC));
        REPBAR(9); }
        xcd_barrier(bar);
        const Slicing SL = get_slicing((const unsigned*)(ws + WS_CTL) + CW_BAR, MISC);
        REPS(11) {
        ph_vpeer<16383>(C, SL, (const int*)(ws + WS_EIDX), (const unsigned*)(ws + WS_WQP), (const float*)(ws + WS_WSC), (const unsigned char*)(ws + WS_VQ), (f16*)(ws + WS_PEER));
        REPBAR(11); }
    }
    SEAM(9);
    if (IN(10)) REPS(10) { REPBAR(10); ph_final(C, (const f16*)(ws + WS_PEER), (const f16*)(ws + WS_X1H), a.out, a.in[15]); }
#undef IN
#undef SEAM
}

#ifndef MK_N_LAUNCHES
#define MK_N_LAUNCHES 1
#endif
extern "C" void kernel_launch(void* const* d_in, const int* in_sizes, int n_in, void* d_out, int out_size, void* d_ws, size_t ws_size, hipStream_t stream) {
    static int grid = 0;
    if (grid == 0) {
        if (n_in != 16 || in_sizes[0] != T * DM || out_size != T * DM || ws_size < WS_END) {
            fprintf(stderr, "kernel_launch: unexpected shapes (n_in %d in0 %d out %d ws %zu)\n", n_in, n_in > 0 ? in_sizes[0] : -1, out_size, ws_size);
            grid = -1; return;
        }
        int dev = 0, cus = 0;
        if (hipGetDevice(&dev) != hipSuccess || hipDeviceGetAttribute(&cus, hipDeviceAttributeMultiprocessorCount, dev) != hipSuccess) { grid = -1; return; }
        if (hipFuncSetAttribute((const void*)mk_fwd, hipFuncAttributeMaxDynamicSharedMemorySize, LDS_BYTES) != hipSuccess) { fprintf(stderr, "kernel_launch: hipFuncSetAttribute failed\n"); grid = -1; return; }
        int per_cu = 0;
        if (hipOccupancyMaxActiveBlocksPerMultiprocessor(&per_cu, (const void*)mk_fwd, NTHREADS, LDS_BYTES) != hipSuccess || per_cu < 1)
            fprintf(stderr, "kernel_launch: occupancy query reports %d workgroups per CU\n", per_cu);
        (void)hipGetLastError();
        grid = cus;
    }
    if (grid < 0) return;
    (void)hipMemsetAsync((char*)d_ws + WS_CTL, 0, CTL_ZERO_BYTES, stream);
    Args a{};
    for (int i = 0; i < 16; ++i) a.in[i] = (const float*)d_in[i];
    a.out = (float*)d_out; a.ws = (unsigned char*)d_ws;
    if (MK_N_LAUNCHES == 1) {
        a.ph_lo = 0; a.ph_hi = N_PHASES;
        hipLaunchKernelGGL(mk_fwd, dim3(grid), dim3(NTHREADS), LDS_BYTES, stream, a);
    } else {
        for (int p = 0; p < N_PHASES; ++p) { a.ph_lo = p; a.ph_hi = p + 1; hipLaunchKernelGGL(mk_fwd, dim3(grid), dim3(NTHREADS), LDS_BYTES, stream, a); }
    }
}
```

```cpp
#include <hip/hip_runtime.h>
#include <cstdint>
#include <cstdio>

typedef _Float16 f16;
typedef _Float16 half8 __attribute__((ext_vector_type(8)));
typedef _Float16 half4 __attribute__((ext_vector_type(4)));
typedef _Float16 half2 __attribute__((ext_vector_type(2)));
typedef float f32x4 __attribute__((ext_vector_type(4)));
typedef float f32x16 __attribute__((ext_vector_type(16)));
typedef unsigned u32x4 __attribute__((ext_vector_type(4)));
typedef int i32x4 __attribute__((ext_vector_type(4)));
#define LAS __attribute__((address_space(3)))
#ifndef PROBE_DIAG
#define PROBE_DIAG (0)
#endif
#ifndef PROBE_DUP
#define PROBE_DUP (-1)
#endif
#define GAS __attribute__((address_space(1)))

constexpr int DM = 1024, BATCH = 16, SEQ = 2048, T = BATCH * SEQ;
constexpr int NQKVU = 1280, NGATE = 2048, NCAT = NQKVU + NGATE;
constexpr int COL_K = 512, COL_V = 640, COL_U = 768;
constexpr int NEXP = 16384, PEER_H = 8, TOPK = 16;
constexpr float EPS = 1e-6f;
constexpr int NWAVES = 8, NTHREADS = NWAVES * 64;

constexpr size_t MiB = 1u << 20;
constexpr size_t WS_CTL = 0, CTL_ZERO_BYTES = 64 * 1024;
constexpr size_t WS_WCAT = 1 * MiB;
constexpr size_t WS_WB = 8 * MiB;
constexpr size_t WS_WOUT = 10 * MiB;
constexpr size_t WS_WQ = 12 * MiB;
constexpr size_t WS_POOLW = 16 * MiB;
constexpr size_t WS_SUBK = 16 * MiB + 512 * 1024;
constexpr size_t WS_RS1 = 17 * MiB;
constexpr size_t WS_EIDX = 18 * MiB;
constexpr size_t WS_EGATE = 34 * MiB;
constexpr size_t WS_WCATQ = 50 * MiB;
constexpr size_t WS_WCS = 54 * MiB;
constexpr size_t WS_WQQ = 56 * MiB;
constexpr size_t WS_WQS = 59 * MiB;
constexpr size_t WS_RSX = 55 * MiB;
constexpr size_t WS_UTAB = 50 * MiB;
constexpr size_t WS_VTAB = 82 * MiB;
constexpr size_t WS_XH = 114 * MiB;
constexpr size_t WS_MERGED = WS_XH;
constexpr size_t WS_QKVU = 178 * MiB;
constexpr size_t WS_X1H = WS_QKVU;
constexpr size_t WS_PEER = WS_MERGED;
constexpr size_t WS_GATES = 258 * MiB;
constexpr size_t WS_QP = WS_GATES;
constexpr size_t WS_OCAT = 386 * MiB;
constexpr size_t WS_UQ = 450 * MiB;
constexpr size_t WS_VQ = 466 * MiB;
constexpr size_t WS_US = 17 * MiB + 256 * 1024, WS_VS = 17 * MiB + 512 * 1024;
constexpr size_t WS_PDOT = WS_GATES;
constexpr size_t WS_H2Q = 404 * MiB;
constexpr size_t WS_HSC = 403 * MiB;
constexpr size_t WS_SSF = 402 * MiB;
constexpr size_t WS_WQP = 386 * MiB;
constexpr size_t WS_WSC = 390 * MiB;
constexpr size_t WS_ACT = 386 * MiB;
constexpr size_t WS_SS2 = 482 * MiB;
constexpr size_t WS_VT = 484 * MiB;
constexpr size_t WS_END = 492 * MiB;
constexpr int CW_BAR = 4096;

constexpr int RING_OFF = 0, RING_BYTES = 131072;
constexpr int LDSCTL_OFF = RING_BYTES, MISC_OFF = LDSCTL_OFF + 320;
constexpr int LDS_BYTES = 147456;

#define LDS_WAIT() asm volatile("s_waitcnt lgkmcnt(0)" ::: "memory")
template <int CTRL> __device__ __forceinline__ float dppf(float x) { return __uint_as_float(__builtin_amdgcn_update_dpp(0u, __float_as_uint(x), CTRL, 0xf, 0xf, false)); }
template <int CTRL> __device__ __forceinline__ int dppi(int x) { return (int)__builtin_amdgcn_update_dpp(0u, (unsigned)x, CTRL, 0xf, 0xf, false); }
__device__ __forceinline__ float bfly32(float a, float b) { auto r = __builtin_amdgcn_permlane32_swap(__float_as_uint(a), __float_as_uint(b), false, false); return __uint_as_float(r[0]) + __uint_as_float(r[1]); }
__device__ __forceinline__ float bfly16(float a, float b) { auto r = __builtin_amdgcn_permlane16_swap(__float_as_uint(a), __float_as_uint(b), false, false); return __uint_as_float(r[0]) + __uint_as_float(r[1]); }
__device__ __forceinline__ int bfly32i(int a, int b) { auto r = __builtin_amdgcn_permlane32_swap((unsigned)a, (unsigned)b, false, false); return (int)(r[0] + r[1]); }
__device__ __forceinline__ int bfly16i(int a, int b) { auto r = __builtin_amdgcn_permlane16_swap((unsigned)a, (unsigned)b, false, false); return (int)(r[0] + r[1]); }
__device__ __forceinline__ float wave_sum(float x) {
    x += dppf<0x121>(x); x += dppf<0x122>(x); x += dppf<0x124>(x); x += dppf<0x128>(x);
    x = bfly16(x, x); return bfly32(x, x);
}
__device__ __forceinline__ int wave_sum_i(int x) {
    x += dppi<0x121>(x); x += dppi<0x122>(x); x += dppi<0x124>(x); x += dppi<0x128>(x);
    x = bfly16i(x, x); return bfly32i(x, x);
}
__device__ __forceinline__ float wave_max(float x) {
    x = fmaxf(x, dppf<0x121>(x)); x = fmaxf(x, dppf<0x122>(x)); x = fmaxf(x, dppf<0x124>(x)); x = fmaxf(x, dppf<0x128>(x));
    { auto r = __builtin_amdgcn_permlane16_swap(__float_as_uint(x), __float_as_uint(x), false, false); x = fmaxf(__uint_as_float(r[0]), __uint_as_float(r[1])); }
    { auto r = __builtin_amdgcn_permlane32_swap(__float_as_uint(x), __float_as_uint(x), false, false); x = fmaxf(__uint_as_float(r[0]), __uint_as_float(r[1])); }
    return x;
}
__device__ __forceinline__ float gelu_exact(float x) { return 0.5f * x * (1.0f + erff(x * 0.70710678118654752f)); }
__device__ __forceinline__ float rs_from_ss(const float* ss, int t) {
    float s = 0.f;
#pragma unroll
    for (int i = 0; i < 16; ++i) s += ss[(size_t)i * T + t];
    return rsqrtf(s * (1.0f / DM) + EPS);
}

struct Ctx {
    int tid, lane, wave;
    int G;
    int gw, ngw;
    int gt, ngt;
};

__device__ __forceinline__ int pack4_i8(float a, float b, float c, float d) {
    const int ia = (int)rintf(a), ib = (int)rintf(b), ic = (int)rintf(c), id = (int)rintf(d);
    return (ia & 0xff) | ((ib & 0xff) << 8) | ((ic & 0xff) << 16) | (id << 24);
}
template <bool OFFS>
__device__ __forceinline__ void quant_rows(const Ctx& C, const float* __restrict__ tab, unsigned* __restrict__ q, float* __restrict__ scale) {
    const int lane = C.lane;
    for (int r = C.gw; r < NEXP; r += C.ngw) {
        const float* row = tab + (size_t)r * DM;
        f32x4 v[4]; float m = 0.f;
#pragma unroll
        for (int j = 0; j < 4; ++j) { v[j] = *(const f32x4*)(row + j * 256 + lane * 4); m = fmaxf(m, fmaxf(fmaxf(fabsf(v[j][0]), fabsf(v[j][1])), fmaxf(fabsf(v[j][2]), fabsf(v[j][3])))); }
        m = wave_max(m);
        const float inv = m > 0.f ? 127.0f / m : 0.f;
#pragma unroll
        for (int j = 0; j < 4; ++j) {
            unsigned w = (unsigned)pack4_i8(v[j][0] * inv, v[j][1] * inv, v[j][2] * inv, v[j][3] * inv);
            if (OFFS) w ^= 0x80808080u;
            { const int dw = j * 64 + lane; q[(size_t)(dw >> 5) * (NEXP * 32) + (size_t)r * 32 + (dw & 31)] = w; }
        }
        if (lane == 0) scale[r] = m * (1.0f / 127.0f);
    }
}

template <bool OFFS>
__device__ __forceinline__ void quant_rows_range(const int lane, const float* __restrict__ tab, unsigned* __restrict__ q, float* __restrict__ scale, int r0, int r1, int sw, int nsw) {
    for (int ra = r0 + sw; ra < r1; ra += 2 * nsw) {
        const int rb = ra + nsw; const bool hb = rb < r1; const int rbb = hb ? rb : ra;
        f32x4 v[2][4];
#pragma unroll
        for (int j = 0; j < 4; ++j) { v[0][j] = *(const f32x4*)(tab + (size_t)ra * DM + j * 256 + lane * 4); v[1][j] = *(const f32x4*)(tab + (size_t)rbb * DM + j * 256 + lane * 4); }
#pragma unroll
        for (int u = 0; u < 2; ++u) {
            const int r = u ? rbb : ra;
            float m = 0.f;
#pragma unroll
            for (int j = 0; j < 4; ++j) m = fmaxf(m, fmaxf(fmaxf(fabsf(v[u][j][0]), fabsf(v[u][j][1])), fmaxf(fabsf(v[u][j][2]), fabsf(v[u][j][3]))));
            m = wave_max(m);
            const float inv = m > 0.f ? 127.0f / m : 0.f;
            if (u == 0 || hb) {
#pragma unroll
                for (int j = 0; j < 4; ++j) {
                    unsigned w = (unsigned)pack4_i8(v[u][j][0] * inv, v[u][j][1] * inv, v[u][j][2] * inv, v[u][j][3] * inv);
                    if (OFFS) w ^= 0x80808080u;
                    { const int dw = j * 64 + lane; q[(size_t)(dw >> 5) * (NEXP * 32) + (size_t)r * 32 + (dw & 31)] = w; }
                }
                if (lane == 0) scale[r] = m * (1.0f / 127.0f);
            }
        }
    }
}
struct Stag { bool member; int rank, count; };
__device__ __forceinline__ Stag stag_group(int b, int G, int mode, int nwg) {
    Stag s;
    const int rem = nwg % G;
    if (mode == 1 && rem != 0) { s.member = b >= rem; s.rank = b - rem; s.count = G - rem; return s; }
    if (G < 16) { s.member = true; s.rank = b; s.count = G; return s; }
    s.member = ((b >> 3) & 1) != 0; s.rank = (b >> 4) * 8 + (b & 7); s.count = (G >> 4) * 8 + ((G & 15) > 8 ? (G & 15) - 8 : 0);
    return s;
}

__device__ __forceinline__ void p0_transpose_item(const float* W, int K, int N, f16* WT, int ldo, int koff, LAS float* scr, int item, int lane) {
    const int nblk = N / 32, kb = item / nblk, nb = item % nblk, k0 = 64 * kb, n0 = 32 * nb;
#pragma unroll 8
    for (int i = 0; i < 32; ++i) { const int kk = 2 * i + (lane >> 5); scr[kk * 33 + (lane & 31)] = W[(size_t)(k0 + kk) * N + n0 + (lane & 31)]; }
    LDS_WAIT(); asm volatile("" ::: "memory");
    const int c = lane & 7;
#pragma unroll
    for (int j = 0; j < 4; ++j) { const int n = (lane >> 3) + 8 * j; const LAS float* s = scr + (8 * c) * 33 + n;
        half8 o;
#pragma unroll
        for (int i = 0; i < 8; ++i) o[i] = (f16)s[i * 33];
        *(half8*)(WT + (size_t)(n0 + n) * ldo + koff + k0 + 8 * c) = o; }
    LDS_WAIT(); asm volatile("" ::: "memory");
}
__device__ __forceinline__ void cvt_stream(const Ctx& C, const float* in, f16* out, size_t n4) {
    for (size_t i = (size_t)C.gt; i < n4; i += (size_t)C.ngt) {
        const f32x4 v = ((const f32x4*)in)[i];
        half4 h; h[0] = (f16)v[0]; h[1] = (f16)v[1]; h[2] = (f16)v[2]; h[3] = (f16)v[3];
        ((half4*)out)[i] = h;
    }
}
__device__ __forceinline__ void rowprep(const Ctx& C, const float* x, const float* g, unsigned* xq, float* rsx, float* ss) {
    const int lane = C.lane;
    f32x4 gg[4];
#pragma unroll
    for (int j = 0; j < 4; ++j) gg[j] = *(const f32x4*)(g + j * 256 + lane * 4);
    for (int tb = C.gw * 4; tb < T; tb += C.ngw * 4) {
        f32x4 v[4][4];
#pragma unroll
        for (int u = 0; u < 4; ++u)
#pragma unroll
            for (int j = 0; j < 4; ++j) v[u][j] = *(const f32x4*)(x + (size_t)(tb + u) * DM + j * 256 + lane * 4);
#pragma unroll
        for (int u = 0; u < 4; ++u) {
            float s = 0.f, am = 0.f;
#pragma unroll
            for (int j = 0; j < 4; ++j) {
                const f32x4 w = v[u][j];
                s += w[0] * w[0] + w[1] * w[1] + w[2] * w[2] + w[3] * w[3];
                v[u][j] = w * gg[j];
                am = fmaxf(am, fmaxf(fmaxf(fabsf(v[u][j][0]), fabsf(v[u][j][1])), fmaxf(fabsf(v[u][j][2]), fabsf(v[u][j][3]))));
            }
            s = wave_sum(s); am = wave_max(am);
            const float inv = am > 0.f ? 127.0f / am : 0.f;
#pragma unroll
            for (int j = 0; j < 4; ++j) xq[(size_t)(tb + u) * 256 + j * 64 + lane] = (unsigned)pack4_i8(v[u][j][0] * inv, v[u][j][1] * inv, v[u][j][2] * inv, v[u][j][3] * inv);
            if (lane == 0) { ss[tb + u] = s; rsx[tb + u] = am * (1.0f / 127.0f); }
        }
    }
}
__device__ __forceinline__ void quant_wrows(const Ctx& C, const f16* __restrict__ w, int rows, unsigned* __restrict__ q, float* __restrict__ scale) {
    const int lane = C.lane;
    for (int r = C.gw; r < rows; r += C.ngw) {
        const half8 a = *(const half8*)(w + (size_t)r * DM + 16 * lane), b = *(const half8*)(w + (size_t)r * DM + 16 * lane + 8);
        float m = 0.f;
#pragma unroll
        for (int i = 0; i < 8; ++i) m = fmaxf(m, fmaxf(fabsf((float)a[i]), fabsf((float)b[i])));
        m = wave_max(m);
        const float inv = m > 0.f ? 127.0f / m : 0.f;
        u32x4 o;
        o[0] = (unsigned)pack4_i8((float)a[0] * inv, (float)a[1] * inv, (float)a[2] * inv, (float)a[3] * inv);
        o[1] = (unsigned)pack4_i8((float)a[4] * inv, (float)a[5] * inv, (float)a[6] * inv, (float)a[7] * inv);
        o[2] = (unsigned)pack4_i8((float)b[0] * inv, (float)b[1] * inv, (float)b[2] * inv, (float)b[3] * inv);
        o[3] = (unsigned)pack4_i8((float)b[4] * inv, (float)b[5] * inv, (float)b[6] * inv, (float)b[7] * inv);
        *(u32x4*)(q + (size_t)r * 256 + 4 * lane) = o;
        if (lane == 0) scale[r] = m * (1.0f / 127.0f);
    }
}
__device__ __forceinline__ void ph_prep(const Ctx& C, LAS unsigned char* lds, const float* const* in, unsigned char* ws) {
    LAS float* scr = (LAS float*)(lds + RING_OFF + C.wave * 16384);
    f16* wcat = (f16*)(ws + WS_WCAT); f16* wb = (f16*)(ws + WS_WB); f16* wout = (f16*)(ws + WS_WOUT); f16* wq = (f16*)(ws + WS_WQ); f16* poolw = (f16*)(ws + WS_POOLW);
    constexpr int I_IN = 16 * 40, I_G = 16 * 64, I_B = 8 * 32, I_O = 16 * 32, I_Q = 16 * 64, I_P = 2 * 4;
    constexpr int NITEMS = I_IN + I_G + 2 * I_B + I_O + I_Q + 4 * I_P;
    for (int it = C.gw; it < NITEMS; it += C.ngw) {
        int r = it;
        if (r < I_IN) { p0_transpose_item(in[2], 1024, 1280, wcat, 1024, 0, scr, r, C.lane); continue; } r -= I_IN;
        if (r < I_G) { p0_transpose_item(in[7], 1024, 2048, wcat + (size_t)NQKVU * 1024, 1024, 0, scr, r, C.lane); continue; } r -= I_G;
        if (r < I_B) { p0_transpose_item(in[6], 512, 1024, wb, 1024, 0, scr, r, C.lane); continue; } r -= I_B;
        if (r < I_B) { p0_transpose_item(in[6] + 512 * 1024, 512, 1024, wb, 1024, 512, scr, r, C.lane); continue; } r -= I_B;
        if (r < I_O) { p0_transpose_item(in[9], 1024, 1024, wout, 1024, 0, scr, r, C.lane); continue; } r -= I_O;
        if (r < I_Q) { p0_transpose_item(in[11], 1024, 2048, wq, 1024, 0, scr, r, C.lane); continue; } r -= I_Q;
        { const int g = r / I_P; p0_transpose_item(in[4] + g * 128 * 128, 128, 128, poolw + g * 128 * 128, 128, 0, scr, r % I_P, C.lane); }
    }
    cvt_stream(C, in[12], (f16*)(ws + WS_SUBK), (size_t)8 * 2 * 128 * 128 / 4);
    rowprep(C, in[0], in[1], (unsigned*)(ws + WS_XH), (float*)(ws + WS_RSX), (float*)(ws + WS_RS1));
}

__device__ __forceinline__ void ph_attn_naive(const Ctx& C, const f16* __restrict__ qkvu, const float* __restrict__ sink, f16* __restrict__ ocat) {
    for (int gid = C.gt; gid < T * 8; gid += C.ngt) {
        const int t = gid % T, h = gid / T;
        const int b = t / SEQ, ts = t % SEQ, kh = h >> 2;
        float q[64], o[64];
        const f16* qr = qkvu + (size_t)t * NQKVU + h * 64;
#pragma unroll
        for (int d = 0; d < 64; ++d) { q[d] = (float)qr[d]; o[d] = 0.f; }
        const float slope = exp2f(-(float)(h + 1));
        float m = -1e30f, l = 0.f;
        const int s0 = max(ts - 128, 0), s1 = min(ts + 128, SEQ - 1);
        for (int s = s0; s <= s1; ++s) {
            const f16* kr = qkvu + (size_t)(b * SEQ + s) * NQKVU + COL_K + kh * 64;
            const f16* vr = qkvu + (size_t)(b * SEQ + s) * NQKVU + COL_V + kh * 64;
            float dot = 0.f;
#pragma unroll
            for (int d = 0; d < 64; ++d) dot += q[d] * (float)kr[d];
            const float lg = dot * 0.125f - slope * fabsf((float)(ts - s));
            const float mn = fmaxf(m, lg), al = __expf(m - mn), p = __expf(lg - mn);
            l = l * al + p;
#pragma unroll
            for (int d = 0; d < 64; ++d) o[d] = o[d] * al + p * (float)vr[d];
            m = mn;
        }
        const float sk = sink[h];
        const float mn = fmaxf(m, sk), al = __expf(m - mn);
        l = l * al + __expf(sk - mn);
        const float inv = al / l;
        f16* orow = ocat + (size_t)t * DM + h * 64;
#pragma unroll
        for (int d = 0; d < 64; ++d) orow[d] = (f16)(o[d] * inv);
    }
}

template <int DIAG = 0>
__device__ __forceinline__ void attn_unit(const Ctx& C, int u, LAS unsigned char* lds, const f16* __restrict__ qkvu, const f16* __restrict__ vT, const float* __restrict__ sink, f16* __restrict__ ocat) {
    const int lane = C.lane, r32 = lane & 31, hh = lane >> 5;
    const int krow = (r32 & 19) | ((r32 & 4) << 1) | ((r32 & 8) >> 1);
    constexpr float L2E = 1.4426950408889634f;
    {
        const int qs = u & 63, h = (u >> 6) & 7, b = u >> 9, kh = h >> 2;
        const int tq = qs * 32 + r32;
        const float slope2 = exp2f(-(float)(h + 1)) * L2E, sink2 = sink[h] * L2E;
        const f16* qrow = qkvu + (size_t)(b * SEQ + tq) * NQKVU + h * 64 + 8 * hh;
        half8 bq[4];
#pragma unroll
        for (int ks = 0; ks < 4; ++ks) bq[ks] = *(const half8*)(qrow + 16 * ks);
        f32x16 o0, o1;
#pragma unroll
        for (int r = 0; r < 16; ++r) { o0[r] = 0.f; o1[r] = 0.f; }
        float m = -1e30f, l = 0.f;
        const int kb_lo = max(qs - 4, 0), kb_hi = min(qs + 4, 63);
        LAS unsigned char* kst = lds + 65536 + C.wave * 8192; LAS unsigned char* vst = kst + 4096;
        const int krw = lane >> 3, kch = lane & 7, vrw = lane >> 2, vch = lane & 3;
        const f16* kg = qkvu + (size_t)(b * SEQ + krw) * NQKVU + COL_K + kh * 64 + kch * 8;
        const f16* vg = vT + (size_t)((b * 2 + kh) * 64 + vrw) * SEQ + vch * 8;
        half8 gk[4], gv[4];
#pragma unroll
        for (int i = 0; i < 4; ++i) { gk[i] = *(const half8*)(kg + (size_t)(kb_lo * 32 + 8 * i) * NQKVU); gv[i] = *(const half8*)(vg + (size_t)(16 * i) * SEQ + kb_lo * 32); }
#pragma unroll 1
        for (int kb = kb_lo; kb <= kb_hi; ++kb) {
#pragma unroll
            for (int i = 0; i < 4; ++i) {
                const int kr = krw + 8 * i; *(LAS half8*)(kst + kr * 128 + ((kch ^ (kr & 7)) << 4)) = gk[i];
                const int vr = vrw + 16 * i; *(LAS half8*)(vst + vr * 64 + ((vch ^ ((vr >> 2) & 3)) << 4)) = gv[i];
            }
            LDS_WAIT();
            half8 kf[4], va[2][2];
#pragma unroll
            for (int ks = 0; ks < 4; ++ks) kf[ks] = *(const LAS half8*)(kst + krow * 128 + (((2 * ks + hh) ^ (krow & 7)) << 4));
#pragma unroll
            for (int db = 0; db < 2; ++db)
#pragma unroll
                for (int st = 0; st < 2; ++st) { const int d = db * 32 + r32; va[db][st] = *(const LAS half8*)(vst + d * 64 + (((2 * st + hh) ^ ((d >> 2) & 3)) << 4)); }
            LDS_WAIT();
            const int kn = (DIAG == 2) ? kb_lo : (kb < kb_hi ? kb + 1 : kb);
#pragma unroll
            for (int i = 0; i < 4; ++i) { gk[i] = *(const half8*)(kg + (size_t)(kn * 32 + 8 * i) * NQKVU); gv[i] = *(const half8*)(vg + (size_t)(16 * i) * SEQ + kn * 32); }
            f32x16 s;
#pragma unroll
            for (int r = 0; r < 16; ++r) s[r] = 0.f;
#pragma unroll
            for (int ks = 0; ks < 4; ++ks) s = __builtin_amdgcn_mfma_f32_32x32x16_f16(kf[ks], bq[ks], s, 0, 0, 0);
            float bmax = -1e30f; bool ok[16];
#pragma unroll
            for (int r = 0; r < 16; ++r) {
                const int tk = kb * 32 + 16 * (r >> 3) + 8 * hh + (r & 7);
                const int dist = abs(tq - tk);
                ok[r] = dist <= 128;
                s[r] = ok[r] ? s[r] * (0.125f * L2E) - slope2 * (float)dist : -1e30f;
                bmax = fmaxf(bmax, s[r]);
            }
            bmax = fmaxf(bmax, __shfl_xor(bmax, 32));
            const float mn = fmaxf(m, bmax), al = exp2f(m - mn);
            m = mn;
            float ps = 0.f; half8 pb[2];
#pragma unroll
            for (int r = 0; r < 16; ++r) { const float p = ok[r] ? (DIAG == 1 ? (s[r] - mn) : exp2f(s[r] - mn)) : 0.f; ps += p; pb[r >> 3][r & 7] = (f16)p; }
            l = l * al + ps;
#pragma unroll
            for (int r = 0; r < 16; ++r) { o0[r] *= al; o1[r] *= al; }
#pragma unroll
            for (int st = 0; st < 2; ++st) { o0 = __builtin_amdgcn_mfma_f32_32x32x16_f16(va[0][st], pb[st], o0, 0, 0, 0); o1 = __builtin_amdgcn_mfma_f32_32x32x16_f16(va[1][st], pb[st], o1, 0, 0, 0); }
        }
        l += __shfl_xor(l, 32);
        const float mf = fmaxf(m, sink2), al = exp2f(m - mf);
        const float sc = al / (l * al + exp2f(sink2 - mf));
        f16* orow = ocat + (size_t)(b * SEQ + tq) * DM + h * 64 + 4 * hh;
#pragma unroll
        for (int g = 0; g < 4; ++g) {
            half4 a, c;
#pragma unroll
            for (int i = 0; i < 4; ++i) { a[i] = (f16)(o0[4 * g + i] * sc); c[i] = (f16)(o1[4 * g + i] * sc); }
            *(half4*)(orow + 8 * g) = a; *(half4*)(orow + 32 + 8 * g) = c;
        }
    }
}

__device__ __forceinline__ void attn_unit2(const Ctx& C, int u, LAS unsigned char* lds, const f16* __restrict__ qkvu, const f16* __restrict__ vT, const float* __restrict__ sink, f16* __restrict__ ocat) {
    const int lane = C.lane, r32 = lane & 31, hh = lane >> 5;
    const int krow = (r32 & 19) | ((r32 & 4) << 1) | ((r32 & 8) >> 1);
    constexpr float L2E = 1.4426950408889634f;
    const int qp = u & 31, h = (u >> 5) & 7, b = u >> 8, kh = h >> 2;
    const float slope2 = exp2f(-(float)(h + 1)) * L2E, sink2 = sink[h] * L2E;
    const float bbase = slope2 * (float)(r32 - 8 * hh);
    constexpr float THR = 6.0f;
    LAS unsigned char* qst = lds + 65536 + C.wave * 8192 + lane * 16;
    f32x16 o0[2], o1[2]; float m[2], l[2]; int tq[2];
#pragma unroll
    for (int j = 0; j < 2; ++j) {
        tq[j] = (2 * qp + j) * 32 + r32;
        const f16* qrow = qkvu + (size_t)(b * SEQ + tq[j]) * NQKVU + h * 64 + 8 * hh;
#pragma unroll
        for (int ks = 0; ks < 4; ++ks) *(LAS half8*)(qst + (j * 4 + ks) * 1024) = *(const half8*)(qrow + 16 * ks);
#pragma unroll
        for (int r = 0; r < 16; ++r) { o0[j][r] = 0.f; o1[j][r] = 0.f; }
        m[j] = -1e30f; l[j] = 0.f;
    }
    const int kb_lo = max(2 * qp - 4, 0), kb_hi = min(2 * qp + 5, 63);
    LAS unsigned char* kst = lds + C.wave * 8192;
    const int krw = lane >> 3, kch = lane & 7;
    const f16* kg = qkvu + (size_t)(b * SEQ + krw) * NQKVU + COL_K + kh * 64 + kch * 8;
    const f16* vbase = vT + (size_t)((b * 2 + kh) * 64 + r32) * SEQ + 8 * hh;
    half8 gk[4];
#pragma unroll
    for (int i = 0; i < 4; ++i) gk[i] = *(const half8*)(kg + (size_t)(kb_lo * 32 + 8 * i) * NQKVU);
#pragma unroll 1
    for (int kb = kb_lo; kb <= kb_hi; ++kb) {
        half8 kf[4], va[2][2];
#pragma unroll
        for (int db = 0; db < 2; ++db)
#pragma unroll
            for (int st = 0; st < 2; ++st) va[db][st] = *(const half8*)(vbase + (size_t)(db * 32) * SEQ + kb * 32 + 16 * st);
#pragma unroll
        for (int i = 0; i < 4; ++i) { const int kr = krw + 8 * i; *(LAS half8*)(kst + kr * 128 + ((kch ^ (kr & 7)) << 4)) = gk[i]; }
        LDS_WAIT();
#pragma unroll
        for (int ks = 0; ks < 4; ++ks) kf[ks] = *(const LAS half8*)(kst + krow * 128 + (((2 * ks + hh) ^ (krow & 7)) << 4));
        LDS_WAIT();
        const int kn = kb < kb_hi ? kb + 1 : kb;
#pragma unroll
        for (int i = 0; i < 4; ++i) gk[i] = *(const half8*)(kg + (size_t)(kn * 32 + 8 * i) * NQKVU);
#pragma unroll
        for (int j = 0; j < 2; ++j) {
            if (abs(kb - (2 * qp + j)) > 4) continue;
            const int D = (2 * qp + j) - kb;
            f32x16 s;
#pragma unroll
            for (int r = 0; r < 16; ++r) s[r] = 0.f;
#pragma unroll
            for (int ks = 0; ks < 4; ++ks) s = __builtin_amdgcn_mfma_f32_32x32x16_f16(kf[ks], *(const volatile LAS half8*)(qst + (j * 4 + ks) * 1024), s, 0, 0, 0);
            const float B = slope2 * 32.0f * (float)abs(D);
            float bm = -1e30f;
            if (D != 0) {
                const float ssl = D > 0 ? slope2 : -slope2, sb = D > 0 ? -bbase : bbase;
#pragma unroll
                for (int r = 0; r < 16; ++r) { const float bias = fmaf(ssl, (float)(16 * (r >> 3) + (r & 7)), sb); s[r] = fmaf(s[r], 0.125f * L2E, bias);
                    if (abs(D) == 4) s[r] = bias < -0.5f * slope2 ? -1e30f : s[r]; }
            } else {
#pragma unroll
                for (int r = 0; r < 16; ++r) s[r] = fmaf(s[r], 0.125f * L2E, -fabsf(fmaf(-slope2, (float)(16 * (r >> 3) + (r & 7)), bbase)));
            }
#pragma unroll
            for (int r = 0; r < 16; ++r) bm = fmaxf(bm, s[r]);
            bm = fmaxf(bm, __shfl_xor(bm, 32)) - B;
            {
                const float mn = (bm > m[j] + THR) ? bm : m[j], al = __builtin_amdgcn_exp2f(m[j] - mn);
                m[j] = mn; l[j] *= al;
#pragma unroll
                for (int r = 0; r < 16; ++r) { o0[j][r] *= al; o1[j][r] *= al; }
            }
            const float mb = m[j] + B;
            float ps = 0.f; half8 pb[2];
#pragma unroll
            for (int r = 0; r < 16; ++r) { const float pv = __builtin_amdgcn_exp2f(s[r] - mb); ps += pv; pb[r >> 3][r & 7] = (f16)pv; }
            l[j] += ps;
#pragma unroll
            for (int st = 0; st < 2; ++st) { o0[j] = __builtin_amdgcn_mfma_f32_32x32x16_f16(va[0][st], pb[st], o0[j], 0, 0, 0); o1[j] = __builtin_amdgcn_mfma_f32_32x32x16_f16(va[1][st], pb[st], o1[j], 0, 0, 0); }
            __builtin_amdgcn_sched_barrier(0);
        }
    }
#pragma unroll
    for (int j = 0; j < 2; ++j) {
        const float lt = l[j] + __shfl_xor(l[j], 32);
        const float mf = fmaxf(m[j], sink2), al = __builtin_amdgcn_exp2f(m[j] - mf);
        const float sc = al / (lt * al + __builtin_amdgcn_exp2f(sink2 - mf));
        LDS_WAIT();
#pragma unroll
        for (int g = 0; g < 4; ++g) {
            half4 a, c;
#pragma unroll
            for (int i = 0; i < 4; ++i) { a[i] = (f16)(o0[j][4 * g + i] * sc); c[i] = (f16)(o1[j][4 * g + i] * sc); }
            *(LAS half4*)(kst + r32 * 128 + ((g ^ (r32 & 7)) << 4) + 8 * hh) = a;
            *(LAS half4*)(kst + r32 * 128 + (((4 + g) ^ (r32 & 7)) << 4) + 8 * hh) = c;
        }
        LDS_WAIT();
#pragma unroll
        for (int i = 0; i < 4; ++i) {
            const int row = (lane >> 3) + 8 * i, ch = lane & 7;
            const half8 v = *(const LAS half8*)(kst + row * 128 + ((ch ^ (row & 7)) << 4));
            *(half8*)(ocat + (size_t)(b * SEQ + (2 * qp + j) * 32 + row) * DM + h * 64 + ch * 8) = v;
        }
    }
}

__device__ __forceinline__ void ph_pool_naive(const Ctx& C, const f16* __restrict__ qkvu, f16* __restrict__ mixed) {
    for (size_t gid = (size_t)C.gt; gid < (size_t)T * 512; gid += (size_t)C.ngt) {
        const int c = (int)(gid & 511), t = (int)(gid >> 9);
        const int b = t / SEQ, ts = t % SEQ, g = c >> 7, w = 2 << g;
        const int lo = max(ts - w / 2, 0), hi = min(ts + w / 2, SEQ);
        float s = 0.f;
        for (int i = lo; i < hi; ++i) s += (float)qkvu[(size_t)(b * SEQ + i) * NQKVU + COL_U + c];
        const float mean = s / (float)(hi - lo);
        mixed[(size_t)t * 512 + c] = (f16)(mean - (float)qkvu[(size_t)t * NQKVU + COL_U + c]);
    }
}
__device__ __forceinline__ void ph_poolmm_naive(const Ctx& C, const f16* __restrict__ mixed, const f16* __restrict__ poolw_t, const float* __restrict__ pscale, f16* __restrict__ ocat) {
    for (size_t gid = (size_t)C.gt; gid < (size_t)T * 512; gid += (size_t)C.ngt) {
        const int n = (int)(gid & 511), t = (int)(gid >> 9), g = n >> 7, d = n & 127;
        const f16* mr = mixed + (size_t)t * 512 + g * 128;
        const f16* wr = poolw_t + (size_t)(g * 128 + d) * 128;
        float acc = 0.f;
        for (int c = 0; c < 128; ++c) acc += (float)mr[c] * (float)wr[c];
        ocat[(size_t)t * DM + 512 + n] = (f16)(acc * pscale[n]);
    }
}

template <int HW>
__device__ __forceinline__ void pool_step1(const f16* __restrict__ qkvu, LAS unsigned char* tile, int t0, int g, int lane) {
    const int c2 = lane, b = t0 >> 11, sf = t0 & (SEQ - 1);
    const f16* ub = qkvu + (size_t)(b * SEQ) * NQKVU + COL_U + g * 128 + 2 * c2;
    constexpr int NR = 32 + 2 * HW - 1;
    half2 v[NR];
#pragma unroll
    for (int i = 0; i < NR; ++i) { const int s = sf - HW + i; half2 z; z[0] = (f16)0.f; z[1] = (f16)0.f; v[i] = z; if (s >= 0 && s < SEQ) v[i] = *(const half2*)(ub + (size_t)s * NQKVU); }
    float s0 = 0.f, s1 = 0.f;
#pragma unroll
    for (int i = 0; i < 2 * HW - 1; ++i) { s0 += (float)v[i][0]; s1 += (float)v[i][1]; }
#pragma unroll
    for (int j = 0; j < 32; ++j) {
        s0 += (float)v[j + 2 * HW - 1][0]; s1 += (float)v[j + 2 * HW - 1][1];
        const int s = sf + j, lo = max(s - HW, 0), hi = min(s + HW, SEQ);
        const float inv = 1.0f / (float)(hi - lo);
        half2 mx; mx[0] = (f16)(s0 * inv - (float)v[j + HW][0]); mx[1] = (f16)(s1 * inv - (float)v[j + HW][1]);
        *(LAS half2*)(tile + j * 256 + (((c2 >> 2) ^ (j & 15)) << 4) + ((c2 & 3) << 2)) = mx;
        s0 -= (float)v[j][0]; s1 -= (float)v[j][1];
    }
}
__device__ __forceinline__ void pool_unit(const Ctx& C, int u, LAS unsigned char* lds, const f16* __restrict__ qkvu, const f16* __restrict__ poolw_t, const float* __restrict__ pscale, f16* __restrict__ ocat) {
    const int lane = C.lane, r32 = lane & 31, hh = lane >> 5;
    LAS unsigned char* tile = lds + C.wave * 8192;
    const int g = u & 3, t0 = (u >> 2) * 32;
    switch (g) { case 0: pool_step1<1>(qkvu, tile, t0, g, lane); break; case 1: pool_step1<2>(qkvu, tile, t0, g, lane); break;
                 case 2: pool_step1<4>(qkvu, tile, t0, g, lane); break; default: pool_step1<8>(qkvu, tile, t0, g, lane); break; }
    LDS_WAIT();
    f32x16 acc[4];
#pragma unroll
    for (int db = 0; db < 4; ++db)
#pragma unroll
        for (int r = 0; r < 16; ++r) acc[db][r] = 0.f;
    const f16* wr = poolw_t + (size_t)(g * 128 + r32) * 128 + 8 * hh;
#pragma unroll
    for (int ks = 0; ks < 8; ++ks) {
        const half8 bm = *(const LAS half8*)(tile + r32 * 256 + (((2 * ks + hh) ^ (r32 & 15)) << 4));
#pragma unroll
        for (int db = 0; db < 4; ++db) { const half8 a = *(const half8*)(wr + (size_t)(db * 32) * 128 + 16 * ks); acc[db] = __builtin_amdgcn_mfma_f32_32x32x16_f16(a, bm, acc[db], 0, 0, 0); }
    }
    LDS_WAIT();
    f16* orow = ocat + (size_t)(t0 + r32) * DM + 512 + g * 128 + 4 * hh;
    const float* ps = pscale + g * 128 + 4 * hh;
#pragma unroll
    for (int db = 0; db < 4; ++db)
#pragma unroll
        for (int q = 0; q < 4; ++q) {
            const f32x4 pv = *(const f32x4*)(ps + db * 32 + 8 * q);
            half4 x0;
#pragma unroll
            for (int i = 0; i < 4; ++i) x0[i] = (f16)(acc[db][4 * q + i] * pv[i]);
            *(half4*)(orow + db * 32 + 8 * q) = x0;
        }
}
__device__ __forceinline__ void ph_attn_pool(const Ctx& C, LAS unsigned char* lds, const f16* __restrict__ qkvu, const f16* __restrict__ vT, const float* __restrict__ sink,
                                             const f16* __restrict__ poolw_t, const float* __restrict__ pscale, f16* __restrict__ ocat) {
    const int vwg = (C.G % 8 == 0) ? (int)(blockIdx.x % 8) * (C.G / 8) + (int)(blockIdx.x / 8) : (int)blockIdx.x;
    const bool pool_first = (C.wave & 4) != 0;
    for (int i = 0, m = vwg * NWAVES + C.wave; m < (T / 32) * 4; ++i) {
        if (((i & 1) == 0) == pool_first) pool_unit(C, m, lds, qkvu, poolw_t, pscale, ocat);
        else attn_unit2(C, m, lds, qkvu, vT, sink, ocat);
        if (i & 1) m += C.ngw;
    }
}

#define INS(LV, LI, v_, i_) do { float cv_ = (v_); int ci_ = (i_); \
    _Pragma("unroll") for (int z_ = 0; z_ < 16; ++z_) { const bool gt_ = cv_ > LV[z_]; const float tv_ = gt_ ? LV[z_] : cv_; const int ti_ = gt_ ? LI[z_] : ci_; \
        LV[z_] = gt_ ? cv_ : LV[z_]; LI[z_] = gt_ ? ci_ : LI[z_]; cv_ = tv_; ci_ = ti_; } } while (0)
__device__ __forceinline__ void ph_route_naive(const Ctx& C, const f16* __restrict__ qp, const float* __restrict__ ss2, const f16* __restrict__ subk, int* __restrict__ eidx, float* __restrict__ egate) {
    for (int gid = C.gt; gid < T * 8; gid += C.ngt) {
        const int t = gid % T, h = gid / T;
        const float rs2 = rs_from_ss(ss2, t);
        float av[16], bv[16]; int ai[16], bi[16];
#pragma unroll
        for (int z = 0; z < 16; ++z) { av[z] = -3e38f; bv[z] = -3e38f; ai[z] = 0; bi[z] = 0; }
        for (int p = 0; p < 2; ++p) {
            const f16* qr = qp + (size_t)t * 2048 + h * 256 + p * 128;
            for (int n = 0; n < 128; ++n) {
                const f16* kr = subk + ((size_t)((h * 2 + p) * 128 + n)) * 128;
                float dot = 0.f;
                for (int c = 0; c < 128; ++c) dot += (float)qr[c] * (float)kr[c];
                dot *= rs2;
                if (p == 0) INS(av, ai, dot, n); else INS(bv, bi, dot, n);
            }
        }
        float cv[16]; int ci[16];
#pragma unroll
        for (int z = 0; z < 16; ++z) { cv[z] = -3e38f; ci[z] = 0; }
#pragma unroll
        for (int i = 0; i < 16; ++i)
#pragma unroll
            for (int j = 0; j < 16; ++j)
                if ((i + 1) * (j + 1) <= 16) INS(cv, ci, av[i] + bv[j], ai[i] * 128 + bi[j]);
        float sum = 0.f, e[16];
#pragma unroll
        for (int z = 0; z < 16; ++z) { e[z] = __expf(cv[z] - cv[0]); sum += e[z]; }
        const float inv = 1.0f / sum;
#pragma unroll
        for (int z = 0; z < 16; ++z) { eidx[(size_t)t * 128 + h * 16 + z] = ci[z]; egate[(size_t)t * 128 + h * 16 + z] = e[z] * inv; }
    }
}

__device__ __forceinline__ int mono_i(float f) { const int b = __float_as_int(f); return b ^ ((b >> 31) & 0x7fffffff); }
__device__ __forceinline__ float unmono_f(int m) { return __int_as_float(m ^ ((m >> 31) & 0x7fffffff)); }
#define INS16(Lst, x_) do { int xv_ = (x_); _Pragma("unroll") for (int z_ = 0; z_ < 16; ++z_) { const int hi_ = max(Lst[z_], xv_); xv_ = min(Lst[z_], xv_); Lst[z_] = hi_; } } while (0)
__device__ __forceinline__ void merge_pair16(int (&Lst)[16]) {
    int P[16];
#pragma unroll
    for (int z = 0; z < 16; ++z) P[z] = __shfl_xor(Lst[z], 32);
#pragma unroll
    for (int z = 0; z < 16; ++z) Lst[z] = max(Lst[z], P[15 - z]);
#pragma unroll
    for (int s = 8; s >= 1; s >>= 1)
#pragma unroll
        for (int i = 0; i < 16; ++i) if ((i & s) == 0) { const int hi = max(Lst[i], Lst[i + s]), lo = min(Lst[i], Lst[i + s]); Lst[i] = hi; Lst[i + s] = lo; }
}
__device__ __forceinline__ void bitonic_sort16_desc(int (&K)[16]) {
#pragma unroll
    for (int k = 2; k <= 16; k <<= 1)
#pragma unroll
        for (int j = k >> 1; j > 0; j >>= 1)
#pragma unroll
            for (int i = 0; i < 16; ++i) { const int l = i ^ j; if (l > i) { const int a = K[i], b = K[l], hi = max(a, b), lo = min(a, b); const bool desc = (i & k) == 0; K[i] = desc ? hi : lo; K[l] = desc ? lo : hi; } }
}
__device__ __forceinline__ void bitonic_merge16_desc(int (&K)[16]) {
#pragma unroll
    for (int s = 8; s >= 1; s >>= 1)
#pragma unroll
        for (int i = 0; i < 16; ++i) if ((i & s) == 0) { const int hi = max(K[i], K[i + s]), lo = min(K[i], K[i + s]); K[i] = hi; K[i + s] = lo; }
}
template <class Side>
__device__ __forceinline__ void ph_route(const Ctx& C, LAS unsigned char* lds, const f16* __restrict__ qp, const float* __restrict__ ss2, const f16* __restrict__ subk,
                                         int* __restrict__ eidx, float* __restrict__ egate, const Side& side_job) {
    const int lane = C.lane, r32 = lane & 31, hh = lane >> 5;
    LAS unsigned char* tab = lds + 65536 + C.wave * 4096 + lane * 36;
    const int GH = C.G < 8 ? C.G : 8;
  for (int h = blockIdx.x % GH; h < 8; h += GH) {
    const int rank_h = blockIdx.x / GH, nwg_h = (C.G - (blockIdx.x % GH) + GH - 1) / GH;
    __syncthreads();
    for (int i = C.tid; i < 2 * 128 * 16; i += NTHREADS) {
        const int row = i >> 4, ch = i & 15;
        *(LAS half8*)(lds + row * 256 + ((ch ^ (row & 15)) << 4)) = *(const half8*)(subk + (size_t)(h * 256 + row) * 128 + ch * 8);
    }
    __syncthreads();
    if (h == (int)(blockIdx.x % GH) && (C.wave & 4)) side_job();
    for (int tb = rank_h * NWAVES + C.wave; tb < T / 32; tb += nwg_h * NWAVES) {
        const int t0 = tb * 32, t = t0 + r32;
        int top[2][16];
#pragma unroll
        for (int p = 0; p < 2; ++p) {
            const unsigned char* qbase = (const unsigned char*)qp + (size_t)(((t0 >> 8) * 8 + h) * 8 + ((t0 >> 6) & 1) * 4) * 16384
                                       + ((((t0 >> 7) & 1) * 4 + ((t0 >> 4) & 3) + (r32 >> 4)) * 2 + p) * 1024 + (hh * 16 + (r32 & 15)) * 16;
            const LAS unsigned char* kl = lds + (p * 128 + r32) * 256;
            half8 bq[8];
#pragma unroll
            for (int ks = 0; ks < 8; ++ks) bq[ks] = *(const half8*)(qbase + (ks >> 1) * 16384 + (ks & 1) * 512);
            int Lst[16];
#pragma unroll
            for (int z = 0; z < 16; ++z) Lst[z] = (int)0x80000000;
#pragma unroll 1
            for (int nb = 0; nb < 4; ++nb) {
                f32x16 acc = {0.f, 0.f, 0.f, 0.f, 0.f, 0.f, 0.f, 0.f, 0.f, 0.f, 0.f, 0.f, 0.f, 0.f, 0.f, 0.f};
#pragma unroll
                for (int ks = 0; ks < 8; ++ks) {
                    const half8 ak = *(const LAS half8*)(kl + nb * 32 * 256 + (((2 * ks + hh) ^ (r32 & 15)) << 4));
                    acc = __builtin_amdgcn_mfma_f32_32x32x16_f16(ak, bq[ks], acc, 0, 0, 0);
                }
                int K[16];
#pragma unroll
                for (int r = 0; r < 16; ++r) { const int n = nb * 32 + (r & 3) + 8 * (r >> 2) + 4 * hh; K[r] = (mono_i(acc[r]) & ~127) | (127 - n); }
                bitonic_sort16_desc(K);
#pragma unroll
                for (int z = 0; z < 16; ++z) Lst[z] = max(Lst[z], K[15 - z]);
                bitonic_merge16_desc(Lst);
            }
            merge_pair16(Lst);
#pragma unroll
            for (int z = 0; z < 16; ++z) top[p][z] = Lst[z];
        }
        float va[16], vb[16];
#pragma unroll
        for (int z = 0; z < 16; ++z) { va[z] = unmono_f(top[0][z] & ~127); vb[z] = unmono_f(top[1][z] & ~127);
            tab[z] = (unsigned char)(127 - (top[0][z] & 127)); tab[16 + z] = (unsigned char)(127 - (top[1][z] & 127)); }
        int Cl[16];
        { const float a01 = hh ? va[1] : va[0];
#pragma unroll
          for (int j = 0; j < 16; ++j) { const int key = (mono_i(a01 + vb[j]) & ~255) | (255 - (hh * 16 + j)); Cl[j] = (hh && j >= 8) ? (int)0x80000000 : key; } }
#pragma unroll
        for (int i = 2; i < 16; i += 2) {
            const float ai = hh ? va[i + 1] : va[i];
#pragma unroll
            for (int j = 0; j < 16; ++j)
                if ((i + 1) * (j + 1) <= 16) {
                    int key = (mono_i(ai + vb[j]) & ~255) | (255 - ((i + hh) * 16 + j));
                    if ((i + 2) * (j + 1) > 16) key = hh ? (int)0x80000000 : key;
                    INS16(Cl, key);
                }
        }
        merge_pair16(Cl);
        float e[16], sum = 0.f; const float mx = unmono_f(Cl[0] & ~255);
#pragma unroll
        for (int z = 0; z < 16; ++z) { e[z] = __expf(unmono_f(Cl[z] & ~255) - mx); sum += e[z]; }
        const float inv = 1.0f / sum;
        LDS_WAIT();
        int* ei = eidx + (size_t)t * 128 + h * 16 + 8 * hh; float* eg = egate + (size_t)t * 128 + h * 16 + 8 * hh;
#pragma unroll
        for (int z = 0; z < 16; ++z) {
            if ((z >> 3) == hh) { const int code = 255 - (Cl[z] & 255); const int ia = tab[code >> 4], ib = tab[16 + (code & 15)];
                ei[z & 7] = ia * 128 + ib; eg[z & 7] = e[z] * inv; }
        }
        LDS_WAIT();
    }
  }
}

struct Slicing { int m, pi, nloc, rank; };
__device__ __forceinline__ Slicing get_slicing(const unsigned* bar, volatile LAS unsigned* misc) {
    Slicing S; const unsigned x = (unsigned)__builtin_amdgcn_s_getreg((3 << 11) | 20) & 0xFu;
    int m = 0, pi = 0, nloc = 1;
    for (unsigned j = 0; j < 16; ++j) { const unsigned c = __hip_atomic_load(&bar[256 + 64 * j], __ATOMIC_RELAXED, __HIP_MEMORY_SCOPE_AGENT); if (c > 0u) { if (j < x) ++pi; ++m; } if (j == x) nloc = (int)c; }
    S.m = m > 0 ? m : 1; S.pi = pi; S.nloc = nloc > 0 ? nloc : 1; S.rank = (int)misc[10];
    return S;
}
__device__ __forceinline__ float gelu_fast(float v) {
    const float av = fabsf(v), t = __builtin_amdgcn_rcpf(av * 0.2316418882f + 1.0f);
    float q = t * 0.5307027145f + (-0.7265760135f); q = q * t + 0.7107068705f; q = q * t + (-0.142248368f); q = q * t + 0.127414796f; q = q * t;
    const float m = v * (q * __builtin_amdgcn_exp2f((v * v) * (-0.72134752044f)));
    return v < 0.f ? m : v - m;
}
__device__ __forceinline__ void ph_h2quant(const Ctx& C, const f16* __restrict__ x1h, const float* __restrict__ g2, const float* __restrict__ ss2, unsigned* __restrict__ h2q, float* __restrict__ hsc) {
    const int lane = C.lane;
    f32x4 gv[4];
#pragma unroll
    for (int j = 0; j < 4; ++j) gv[j] = *(const f32x4*)(g2 + 16 * lane + 4 * j);
    for (int tb = C.gw * 4; tb < T; tb += C.ngw * 4) {
        half8 h0[4], h1[4]; float rs[4];
#pragma unroll
        for (int u = 0; u < 4; ++u) { h0[u] = *(const half8*)(x1h + (size_t)(tb + u) * DM + 16 * lane); h1[u] = *(const half8*)(x1h + (size_t)(tb + u) * DM + 16 * lane + 8); rs[u] = rs_from_ss(ss2, tb + u); }
#pragma unroll
        for (int u = 0; u < 4; ++u) {
            float f[16]; float hm = 0.f;
#pragma unroll
            for (int i = 0; i < 8; ++i) { f[i] = (float)h0[u][i] * gv[i >> 2][i & 3]; f[8 + i] = (float)h1[u][i] * gv[2 + (i >> 2)][i & 3]; hm = fmaxf(hm, fmaxf(fabsf(f[i]), fabsf(f[8 + i]))); }
            hm = wave_max(hm);
            const float inv = hm > 0.f ? 127.0f / hm : 0.f;
            u32x4 w;
#pragma unroll
            for (int j = 0; j < 4; ++j) w[j] = (unsigned)pack4_i8(f[4 * j] * inv, f[4 * j + 1] * inv, f[4 * j + 2] * inv, f[4 * j + 3] * inv);
            *(u32x4*)(h2q + (size_t)(tb + u) * 256 + 4 * lane) = w;
            if (lane == 0) hsc[tb + u] = hm * (1.0f / 127.0f) * rs[u];
        }
    }
}
__device__ __forceinline__ __amdgpu_buffer_rsrc_t slice_rsrc(const unsigned char* base) {
    const unsigned long long b = (unsigned long long)base;
    const unsigned lo = __builtin_amdgcn_readfirstlane((unsigned)b), hi = __builtin_amdgcn_readfirstlane((unsigned)(b >> 32));
    return __builtin_amdgcn_make_buffer_rsrc((void*)(((unsigned long long)hi << 32) | lo), 0, NEXP * 128, 0x00020000);
}
template <int EMASK>
__device__ __forceinline__ void ph_upeer(const Ctx& C, LAS unsigned char* lds, const Slicing SL, const unsigned* __restrict__ h2q, const int* __restrict__ eidx,
                                         const unsigned char* __restrict__ uq, short* __restrict__ pdot) {
    const int lane = C.lane, grp = lane >> 3, c8 = lane & 7;
    const int wv = SL.rank * NWAVES + C.wave, nwv = SL.nloc * NWAVES;
    const int ntok = (T - wv + nwv - 1) / nwv;
    auto tok = [&](int i) { const int t = wv + i * nwv; return t < T ? t : T - 1; };
    volatile LAS int* row = (volatile LAS int*)(lds + C.wave * 1024);
  for (int s = SL.pi; s < 8; s += SL.m) {
    const __amdgpu_buffer_rsrc_t urs = slice_rsrc(uq + (size_t)s * (NEXP * 128));
    const unsigned* hqs = h2q + s * 32 + c8 * 4;
    int tA = tok(0), tB = tok(1);
    int e0 = eidx[(size_t)tA * 128 + lane], e1 = eidx[(size_t)tA * 128 + 64 + lane];
    u32x4 hq = *(const u32x4*)(hqs + (size_t)tA * 256);
    int ne0 = eidx[(size_t)tB * 128 + lane], ne1 = eidx[(size_t)tB * 128 + 64 + lane];
    u32x4 r[16];
#pragma unroll
    for (int i = 0; i < 16; ++i) { const int e = __shfl(i < 8 ? e0 : e1, 8 * (i & 7) + grp) & EMASK; r[i] = __builtin_amdgcn_raw_buffer_load_b128(urs, e * 128 + c8 * 16, 0, 0); }
#pragma unroll 1
    for (int it = 0; it < ntok; ++it) {
        const int t = tok(it), t1 = tok(it + 1), t2 = tok(it + 2);
        const int ze0 = eidx[(size_t)t2 * 128 + lane], ze1 = eidx[(size_t)t2 * 128 + 64 + lane];
        const u32x4 nhq = *(const u32x4*)(hqs + (size_t)t1 * 256);
#pragma unroll
        for (int q = 0; q < 4; ++q) {
            int evv[4];
#pragma unroll
            for (int j = 0; j < 4; ++j) evv[j] = __shfl(q < 2 ? ne0 : ne1, 32 * (q & 1) + 8 * j + grp) & EMASK;
            int pa[4], pb[4];
#pragma unroll
            for (int j = 0; j < 4; ++j) {
                pa[j] = __builtin_amdgcn_sdot4((int)r[4 * q + j][0], (int)hq[0], 0, false); pb[j] = __builtin_amdgcn_sdot4((int)r[4 * q + j][1], (int)hq[1], 0, false);
                pa[j] = __builtin_amdgcn_sdot4((int)r[4 * q + j][2], (int)hq[2], pa[j], false); pb[j] = __builtin_amdgcn_sdot4((int)r[4 * q + j][3], (int)hq[3], pb[j], false);
            }
#pragma unroll
            for (int j = 0; j < 4; ++j) { pa[j] += pb[j]; pa[j] += dppi<0xB1>(pa[j]); }
#pragma unroll
            for (int j = 0; j < 4; ++j) pa[j] += dppi<0x4E>(pa[j]);
#pragma unroll
            for (int j = 0; j < 4; ++j) pa[j] += dppi<0x141>(pa[j]);
            if (c8 == 0) {
#pragma unroll
                for (int j = 0; j < 4; ++j) row[8 * (4 * q + j) + grp] = pa[j];
            }
#pragma unroll
            for (int j = 0; j < 4; ++j) {
                asm volatile("" ::: "memory");
                r[4 * q + j] = __builtin_amdgcn_raw_buffer_load_b128(urs, evv[j] * 128 + c8 * 16, 0, 0);
                asm volatile("" ::: "memory");
            }
        }
        LDS_WAIT();
        const int p0 = row[lane], p1 = row[64 + lane];
        LDS_WAIT();
        { short* pp = pdot + ((size_t)s * T + t) * 128 + lane; const int c0 = min(max((p0 + 4) >> 3, -32768), 32767), c1 = min(max((p1 + 4) >> 3, -32768), 32767);
          asm volatile("global_store_short %0, %1, off\n\tglobal_store_short %0, %2, off offset:128" :: "v"(pp), "v"(c0), "v"(c1) : "memory"); }
        hq = nhq; ne0 = ze0; ne1 = ze1;
    }
  }
}
__device__ __forceinline__ void ph_ureduce(const Ctx& C, LAS unsigned char* lds, const short* __restrict__ pdot, const float* __restrict__ hsc, const int* __restrict__ eidx, const float* __restrict__ us,
                                           const float* __restrict__ vs, const float* __restrict__ egate, unsigned* __restrict__ wqp, float* __restrict__ wsc) {
    const int lane = C.lane;
    volatile LAS unsigned char* row = (volatile LAS unsigned char*)(lds + C.wave * 1024);
    for (int tb = C.gw * 2; tb < T; tb += C.ngw * 2) {
        int e0[2], e1[2], s0[2], s1[2]; float h[2], g0[2], g1[2];
#pragma unroll
        for (int u = 0; u < 2; ++u) {
            const int t = tb + u;
            e0[u] = eidx[(size_t)t * 128 + lane]; e1[u] = eidx[(size_t)t * 128 + 64 + lane];
            g0[u] = egate[(size_t)t * 128 + lane]; g1[u] = egate[(size_t)t * 128 + 64 + lane];
            h[u] = hsc[t]; s0[u] = 0; s1[u] = 0;
#pragma unroll
            for (int s = 0; s < 8; ++s) { const short* pp = pdot + ((size_t)s * T + t) * 128 + lane; s0[u] += (int)pp[0]; s1[u] += (int)pp[64]; }
        }
        float w0[2], w1[2];
#pragma unroll
        for (int u = 0; u < 2; ++u) {
            w0[u] = gelu_fast((float)s0[u] * (8.0f * h[u]) * us[e0[u]]) * g0[u] * vs[e0[u]];
            w1[u] = gelu_fast((float)s1[u] * (8.0f * h[u]) * us[e1[u]]) * g1[u] * vs[e1[u]];
        }
#pragma unroll
        for (int u = 0; u < 2; ++u) {
            const int t = tb + u;
            const float wm = wave_max(fmaxf(fabsf(w0[u]), fabsf(w1[u])));
            const float inv = wm > 0.f ? 127.0f / wm : 0.f;
            { const int k = lane; row[u * 128 + (k & 7) * 16 + (k >> 5) * 4 + ((k >> 3) & 3)] = (unsigned char)(int)rintf(w0[u] * inv); }
            { const int k = 64 + lane; row[u * 128 + (k & 7) * 16 + (k >> 5) * 4 + ((k >> 3) & 3)] = (unsigned char)(int)rintf(w1[u] * inv); }
            if (lane == 0) wsc[t] = wm * (1.0f / 127.0f);
        }
        LDS_WAIT();
        wqp[(size_t)tb * 32 + lane] = ((volatile LAS unsigned*)row)[lane];
        LDS_WAIT();
    }
}
template <int EMASK>
__device__ __forceinline__ void ph_vpeer(const Ctx& C, const Slicing SL, const int* __restrict__ eidx, const unsigned* __restrict__ wqp, const float* __restrict__ wsc, const unsigned char* __restrict__ vq,
                                         f16* __restrict__ peer) {
    const int lane = C.lane, grp = lane >> 3, c8 = lane & 7;
    const bool hh = (lane & 32) != 0, b4 = (lane & 16) != 0, b3 = (lane & 8) != 0;
    const int wv = SL.rank * NWAVES + C.wave, nwv = SL.nloc * NWAVES;
    const int ntok = (T - wv + nwv - 1) / nwv;
    auto tok = [&](int i) { const int t = wv + i * nwv; return t < T ? t : T - 1; };
  for (int s = SL.pi; s < 8; s += SL.m) {
    const __amdgpu_buffer_rsrc_t vrs = slice_rsrc(vq + (size_t)s * (NEXP * 128));
    const int chl = 8 * (hh ? 1 : 0) + 4 * (b4 ? 1 : 0) + 2 * (b3 ? 1 : 0);
    const int coff = s * 128 + c8 * 16 + chl;
    int tA = tok(0), tB = tok(1);
    int e0 = eidx[(size_t)tA * 128 + lane], e1 = eidx[(size_t)tA * 128 + 64 + lane];
    u32x4 wq = *(const u32x4*)(wqp + (size_t)tA * 32 + grp * 4); float wscale = wsc[tA];
    int ne0 = eidx[(size_t)tB * 128 + lane], ne1 = eidx[(size_t)tB * 128 + 64 + lane];
    u32x4 r[16];
#pragma unroll
    for (int i = 0; i < 16; ++i) { const int e = __shfl(i < 8 ? e0 : e1, 8 * (i & 7) + grp) & EMASK; r[i] = __builtin_amdgcn_raw_buffer_load_b128(vrs, e * 128 + c8 * 16, 0, 0); }
#pragma unroll 1
    for (int it = 0; it < ntok; ++it) {
        const int t = tok(it), t1 = tok(it + 1), t2 = tok(it + 2);
        const int ze0 = eidx[(size_t)t2 * 128 + lane], ze1 = eidx[(size_t)t2 * 128 + 64 + lane];
        const u32x4 nwq = *(const u32x4*)(wqp + (size_t)t1 * 32 + grp * 4); const float nwscale = wsc[t1];
        int o[16];
#pragma unroll
        for (int c = 0; c < 16; ++c) o[c] = 0;
#pragma unroll
        for (int q = 0; q < 4; ++q) {
            int evv[4];
#pragma unroll
            for (int j = 0; j < 4; ++j) evv[j] = __shfl(q < 2 ? ne0 : ne1, 32 * (q & 1) + 8 * j + grp) & EMASK;
#pragma unroll
            for (int d = 0; d < 4; ++d) {
                const unsigned a = r[4 * q][d], b = r[4 * q + 1][d], c = r[4 * q + 2][d], e = r[4 * q + 3][d];
                const unsigned t0 = __builtin_amdgcn_perm(b, a, 0x05010400u), t1p = __builtin_amdgcn_perm(b, a, 0x07030602u);
                const unsigned u0 = __builtin_amdgcn_perm(e, c, 0x05010400u), u1 = __builtin_amdgcn_perm(e, c, 0x07030602u);
                o[4 * d + 0] = __builtin_amdgcn_sdot4((int)__builtin_amdgcn_perm(u0, t0, 0x05040100u), (int)wq[q], o[4 * d + 0], false);
                o[4 * d + 1] = __builtin_amdgcn_sdot4((int)__builtin_amdgcn_perm(u0, t0, 0x07060302u), (int)wq[q], o[4 * d + 1], false);
                o[4 * d + 2] = __builtin_amdgcn_sdot4((int)__builtin_amdgcn_perm(u1, t1p, 0x05040100u), (int)wq[q], o[4 * d + 2], false);
                o[4 * d + 3] = __builtin_amdgcn_sdot4((int)__builtin_amdgcn_perm(u1, t1p, 0x07060302u), (int)wq[q], o[4 * d + 3], false);
            }
#pragma unroll
            for (int j = 0; j < 4; ++j) {
                asm volatile("" ::: "memory");
                r[4 * q + j] = __builtin_amdgcn_raw_buffer_load_b128(vrs, evv[j] * 128 + c8 * 16, 0, 0);
                asm volatile("" ::: "memory");
            }
        }
        int q8[8], q4[4], q2[2];
#pragma unroll
        for (int k = 0; k < 8; ++k) q8[k] = bfly32i(o[k], o[8 + k]);
#pragma unroll
        for (int k = 0; k < 4; ++k) q4[k] = bfly16i(q8[k], q8[4 + k]);
#pragma unroll
        for (int k = 0; k < 2; ++k) { const int mine = b3 ? q4[2 + k] : q4[k], oth = b3 ? q4[k] : q4[2 + k]; q2[k] = mine + dppi<0x128>(oth); }
        { half2 pv; pv[0] = (f16)((float)q2[0] * wscale); pv[1] = (f16)((float)q2[1] * wscale); f16* yp = peer + (size_t)t * DM + coff; asm volatile("global_store_dword %0, %1, off" :: "v"(yp), "v"(pv) : "memory"); }
        wq = nwq; wscale = nwscale; ne0 = ze0; ne1 = ze1;
    }
  }
}
__device__ __forceinline__ void ph_final(const Ctx& C, const f16* __restrict__ peer, const f16* __restrict__ x1h, float* __restrict__ out, const float* __restrict__ gf) {
    const int lane = C.lane;
    f32x4 gg[4];
#pragma unroll
    for (int j = 0; j < 4; ++j) gg[j] = *(const f32x4*)(gf + j * 256 + lane * 4);
    for (int tb = C.gw * 4; tb < T; tb += C.ngw * 4) {
        half4 xv[4][4], pe[4][4];
#pragma unroll
        for (int u = 0; u < 4; ++u)
#pragma unroll
            for (int j = 0; j < 4; ++j) { xv[u][j] = *(const half4*)(x1h + (size_t)(tb + u) * DM + j * 256 + lane * 4); pe[u][j] = *(const half4*)(peer + (size_t)(tb + u) * DM + j * 256 + lane * 4); }
#pragma unroll
        for (int u = 0; u < 4; ++u) {
            f32x4 v[4]; float s = 0.f;
#pragma unroll
            for (int j = 0; j < 4; ++j) {
#pragma unroll
                for (int i = 0; i < 4; ++i) { v[j][i] = (float)xv[u][j][i] + (float)pe[u][j][i]; s += v[j][i] * v[j][i]; }
            }
            const float r = rsqrtf(wave_sum(s) * (1.0f / DM) + EPS);
#pragma unroll
            for (int j = 0; j < 4; ++j) *(f32x4*)(out + (size_t)(tb + u) * DM + j * 256 + lane * 4) = v[j] * r * gg[j];
        }
    }
}

namespace pg8 {
#define PG8_LAS __attribute__((address_space(3)))
typedef _Float16 frag8 __attribute__((ext_vector_type(8)));
typedef float f32x4 __attribute__((ext_vector_type(4)));
constexpr int BM = 256, BK = 64, HALF = 128, HTB = HALF * BK * 2  , STAGE_BYTES = 8 * HTB, NXCD = 8, WGM = 8;

__host__ __device__ __forceinline__ int lds_byte(int r, int c) { const int st = (r >> 4) * 2 + (c >> 5), rr = r & 15, cc = c & 31, ob = rr * 64 + cc * 2; return st * 1024 + (ob ^ (((ob >> 9) & 1) << 5)); }
__host__ __device__ __forceinline__ void stage_rc(int b, int& R, int& C) { const int st = b / 1024, sb = b % 1024, swz = sb ^ (((sb >> 9) & 1) << 5); R = (st >> 1) * 16 + swz / 64; C = (st & 1) * 32 + (swz % 64) / 2; }
__host__ __device__ __forceinline__ int perm32(int rho) { const int n = rho >> 4, i = rho & 15; return 8 * (i >> 2) + 4 * n + (i & 3); }

struct Unit { int pm, pn; };
struct Gemm { const f16* A; const f16* Bt; int M, N, K; };

struct StaticOrder {
    int nM, nN, nwg, G, c;
    __host__ __device__ void init(int M, int N, int G_, int c_) { nM = M / BM; nN = N / BM; nwg = nM * nN; G = G_; c = c_; }
    __host__ __device__ bool next(int i, Unit& u) const {
        const long L = (long)i * G + c; if (L >= nwg) return false;
        int wgid = (int)L; { const int q = nwg / NXCD, r = nwg % NXCD, xcd = wgid % NXCD, off = wgid / NXCD; wgid = (xcd < r ? xcd * (q + 1) : r * (q + 1) + (xcd - r) * q) + off; }
        const int nig = WGM * nN, gid = wgid / nig, fm = gid * WGM, gsz = (nM - fm) < WGM ? (nM - fm) : WGM;
        u.pm = fm + ((wgid % nig) % gsz); u.pn = (wgid % nig) / gsz; return true;
    }
    __device__ __forceinline__ void a_ready(const Unit&) const {}
    __device__ __forceinline__ void done(const Unit&) const {}
};

__device__ __forceinline__ frag8 pack8(const f32x4 a, const f32x4 b) {
    frag8 h; h[0] = (f16)a[0]; h[1] = (f16)a[1]; h[2] = (f16)a[2]; h[3] = (f16)a[3]; h[4] = (f16)b[0]; h[5] = (f16)b[1]; h[6] = (f16)b[2]; h[7] = (f16)b[3]; return h;
}
__device__ __forceinline__ float sigmoidf_(float z) { return 1.0f / (1.0f + __expf(-z)); }

constexpr size_t GATE_TILE = 65536, GATE_WAVE = 8192, GATE_CHUNK = 1024;
struct EpiP1 {
    typedef i32x4 acc_t; static constexpr bool PERM = true, AFTER_DRAIN = false, MIDK = false;
    const float* ss1; const float* rsx; const float* wcs; const float* bgate; f16* qkvu; unsigned char* gates; f16* vT;
    __device__ __forceinline__ static unsigned q4(const f32x4 v) {
        return (unsigned)(v[0] * 255.0f + 0.5f) | ((unsigned)(v[1] * 255.0f + 0.5f) << 8) | ((unsigned)(v[2] * 255.0f + 0.5f) << 16) | ((unsigned)(v[3] * 255.0f + 0.5f) << 24);
    }
    __device__ __forceinline__ void operator()(const i32x4 (&acc)[2][2][4][2], const Unit& u, int wr, int wc, int fr, int fq) const {
        const int row0 = u.pm * BM + wr * 64 + fr, colt = u.pn * BM; const bool isg = colt >= NQKVU;
        f32x4 cs[2][2];
#pragma unroll
        for (int bj = 0; bj < 2; ++bj) { const int c0 = colt + bj * HALF + wc * 32 + 8 * fq; cs[bj][0] = *(const f32x4*)(wcs + c0); cs[bj][1] = *(const f32x4*)(wcs + c0 + 4); }
        unsigned char* gl = gates + (size_t)((u.pm * 8 + (u.pn - 5)) * 8 + wr * 4 + wc) * GATE_WAVE + (fq * 16 + fr) * 16;
#pragma unroll
        for (int ai = 0; ai < 2; ++ai)
#pragma unroll
            for (int m = 0; m < 4; ++m) { const int row = row0 + ai * HALF + m * 16; const float r = rsqrtf(ss1[row] * (1.0f / DM) + EPS) * rsx[row];
                u32x4 gw;
#pragma unroll
                for (int bj = 0; bj < 2; ++bj) { const int c0 = colt + bj * HALF + wc * 32 + 8 * fq; f32x4 v0, v1;
#pragma unroll
                    for (int i = 0; i < 4; ++i) { v0[i] = (float)acc[ai][bj][m][0][i] * (r * cs[bj][0][i]); v1[i] = (float)acc[ai][bj][m][1][i] * (r * cs[bj][1][i]); }
                    if (isg) { const int cg = c0 - NQKVU; const f32x4 b0 = *(const f32x4*)(bgate + cg), b1 = *(const f32x4*)(bgate + cg + 4);
#pragma unroll
                        for (int i = 0; i < 4; ++i) { v0[i] = sigmoidf_(v0[i] + b0[i]); v1[i] = sigmoidf_(v1[i] + b1[i]); }
                        gw[2 * bj] = q4(v0); gw[2 * bj + 1] = q4(v1); }
                    else { const frag8 hv = pack8(v0, v1); *(frag8*)(qkvu + (size_t)row * NQKVU + c0) = hv;
                        if (colt == 512 && bj == 1) {
                            f16* vp = vT + ((size_t)((row >> 11) * 2 + (wc >> 1)) * 64 + (wc & 1) * 32 + 8 * fq) * SEQ + (row & (SEQ - 1));
#pragma unroll
                            for (int i = 0; i < 8; ++i) vp[(size_t)i * SEQ] = hv[i]; } } }
                if (isg) *(u32x4*)(gl + (ai * 4 + m) * GATE_CHUNK) = gw; }
    }
};
struct EpiMerged {
    typedef f32x4 acc_t; static constexpr bool PERM = true, AFTER_DRAIN = false, MIDK = true;
    const unsigned char* gates; f16* merged;
    __device__ __forceinline__ static float ub(unsigned w, int i) { return (float)((w >> (8 * i)) & 255u); }
    __device__ __forceinline__ void mid(f32x4 (&acc)[2][2][4][2], const Unit& u, int wr, int wc, int fr, int fq) const {
        const unsigned char* gb = gates + (size_t)((u.pm * 8 + u.pn) * 8 + wr * 4 + wc) * GATE_WAVE + (fq * 16 + fr) * 16;
        asm volatile("" : "+v"(gb));
#pragma unroll
        for (int ai = 0; ai < 2; ++ai) {
            u32x4 g0[4], g1[4];
#pragma unroll
            for (int m = 0; m < 4; ++m) { g0[m] = *(const u32x4*)(gb + (ai * 4 + m) * GATE_CHUNK); g1[m] = *(const u32x4*)(gb + 4 * GATE_TILE + (ai * 4 + m) * GATE_CHUNK); }
#pragma unroll
            for (int m = 0; m < 4; ++m)
#pragma unroll
                for (int bj = 0; bj < 2; ++bj)
#pragma unroll
                    for (int n = 0; n < 2; ++n)
#pragma unroll
                        for (int i = 0; i < 4; ++i) acc[ai][bj][m][n][i] *= ub(g0[m][2 * bj + n], i) * __builtin_amdgcn_rcpf(fmaxf(ub(g1[m][2 * bj + n], i), 0.0255f));
            asm volatile("" ::: "memory");
        }
    }
    __device__ __forceinline__ void operator()(const f32x4 (&acc)[2][2][4][2], const Unit& u, int wr, int wc, int fr, int fq) const {
        const int row0 = u.pm * BM + wr * 64 + fr, colt = u.pn * BM;
        const unsigned char* gb = gates + (size_t)((u.pm * 8 + 4 + u.pn) * 8 + wr * 4 + wc) * GATE_WAVE + (fq * 16 + fr) * 16;
#pragma unroll
        for (int ai = 0; ai < 2; ++ai)
#pragma unroll
            for (int m = 0; m < 4; ++m) { const int row = row0 + ai * HALF + m * 16;
                const u32x4 g1 = *(const u32x4*)(gb + (ai * 4 + m) * GATE_CHUNK);
#pragma unroll
                for (int bj = 0; bj < 2; ++bj) { const int c0 = colt + bj * HALF + wc * 32 + 8 * fq; f32x4 v0, v1;
#pragma unroll
                    for (int i = 0; i < 4; ++i) { v0[i] = acc[ai][bj][m][0][i] * (fmaxf(ub(g1[2 * bj], i), 0.0255f) * (1.0f / 255.0f)); v1[i] = acc[ai][bj][m][1][i] * (fmaxf(ub(g1[2 * bj + 1], i), 0.0255f) * (1.0f / 255.0f)); }
                    *(frag8*)(merged + (size_t)row * DM + c0) = pack8(v0, v1); } }
    }
};
struct EpiOut {
    typedef f32x4 acc_t; static constexpr bool PERM = true, AFTER_DRAIN = false, MIDK = false;
    const float* x; f16* x1h; float* ss2p;
    __device__ __forceinline__ void operator()(const f32x4 (&acc)[2][2][4][2], const Unit& u, int wr, int wc, int fr, int fq) const {
        const int row0 = u.pm * BM + wr * 64 + fr, col0 = u.pn * BM + wc * 32 + 8 * fq;
#pragma unroll
        for (int ai = 0; ai < 2; ++ai)
#pragma unroll
            for (int m = 0; m < 4; ++m) { const int row = row0 + ai * HALF + m * 16; const size_t off = (size_t)row * DM + col0; float ssq = 0.f;
#pragma unroll
                for (int bj = 0; bj < 2; ++bj) {
                    const f32x4 y0 = *(const f32x4*)(x + off + bj * HALF) + acc[ai][bj][m][0], y1 = *(const f32x4*)(x + off + bj * HALF + 4) + acc[ai][bj][m][1];
                    ssq += ((y0[0] * y0[0] + y0[1] * y0[1]) + (y0[2] * y0[2] + y0[3] * y0[3])) + ((y1[0] * y1[0] + y1[1] * y1[1]) + (y1[2] * y1[2] + y1[3] * y1[3]));
                    *(frag8*)(x1h + off + bj * HALF) = pack8(y0, y1); }
                ssq += __shfl_xor(ssq, 16); ssq += __shfl_xor(ssq, 32);
                if (fq == 0) ss2p[(size_t)(u.pn * 4 + wc) * T + row] = ssq; }
    }
};
struct EpiQ {
    typedef i32x4 acc_t; static constexpr bool PERM = true, AFTER_DRAIN = false, MIDK = false;
    const float* hsc; const float* wqs; f16* qp;
    __device__ __forceinline__ void operator()(const i32x4 (&acc)[2][2][4][2], const Unit& u, int wr, int wc, int fr, int fq) const {
        const int row0 = u.pm * BM + wr * 64 + fr, colt = u.pn * BM;
        f32x4 cs[2][2];
#pragma unroll
        for (int bj = 0; bj < 2; ++bj) { const int c0 = colt + bj * HALF + wc * 32 + 8 * fq; cs[bj][0] = *(const f32x4*)(wqs + c0); cs[bj][1] = *(const f32x4*)(wqs + c0 + 4); }
        unsigned char* qb = (unsigned char*)qp + (size_t)((u.pm * 8 + u.pn) * 8 + wr * 4 + wc) * 16384 + (fq * 16 + fr) * 16;
#pragma unroll
        for (int ai = 0; ai < 2; ++ai)
#pragma unroll
            for (int m = 0; m < 4; ++m) { const int row = row0 + ai * HALF + m * 16; const float r = hsc[row];
#pragma unroll
                for (int bj = 0; bj < 2; ++bj) { f32x4 v0, v1;
#pragma unroll
                    for (int i = 0; i < 4; ++i) { v0[i] = (float)acc[ai][bj][m][0][i] * (r * cs[bj][0][i]); v1[i] = (float)acc[ai][bj][m][1][i] * (r * cs[bj][1][i]); }
                    *(frag8*)(qb + ((ai * 4 + m) * 2 + bj) * 1024) = pack8(v0, v1); } }
    }
};

__device__ __forceinline__ void mma16(const frag8 b, const frag8 a, f32x4& c) { c = __builtin_amdgcn_mfma_f32_16x16x32_f16(b, a, c, 0, 0, 0); }
__device__ __forceinline__ void mma16(const frag8 b, const frag8 a, i32x4& c) { c = __builtin_amdgcn_mfma_i32_16x16x64_i8(__builtin_bit_cast(i32x4, b), __builtin_bit_cast(i32x4, a), c, 0, 0, 0); }
template <class Epi, class Sched, bool ALIGN_EPI = false, bool SP2 = false>
__device__ __forceinline__ void gemm_phase(PG8_LAS unsigned char* lds, const Gemm g, const Sched& S, const Epi& E) {
    const int tid = threadIdx.x, wid = __builtin_amdgcn_readfirstlane(tid >> 6), lane = tid & 63, wr = wid >> 2, wc = wid & 3, fr = lane & 15, fq = lane >> 4;
    const int K = g.K, nt = K / BK;
    unsigned voffA[2], voffB[2];
#pragma unroll
    for (int i = 0; i < 2; ++i) { int R, C; stage_rc(tid * 16 + i * 8192, R, C); const int Rb = Epi::PERM ? ((R & ~31) + perm32(R & 31)) : R;
        voffA[i] = (unsigned)(R * K + C) * 2u; voffB[i] = (unsigned)(Rb * K + C) * 2u; }
    const size_t kstep = (size_t)(BK * 2);
    const size_t hstep = (size_t)HALF * K * 2;
    const size_t tstep = 2 * hstep;
    const unsigned ldsw = (unsigned)wid * 1024u;
    const int aoff = lds_byte(wr * 64 + fr, fq * 8), boff = lds_byte(wc * 32 + fr, fq * 8);
#define PG8_SA(b, h) (((b) * 2 + (h)) * HTB)
#define PG8_SB(b, h) ((4 + (b) * 2 + (h)) * HTB)
#define PG8_STAGE(bufoff, gbase, voff) do { _Pragma("unroll") for (int _i = 0; _i < 2; ++_i) \
        __builtin_amdgcn_global_load_lds((const unsigned*)((const char*)(gbase) + (voff)[_i]), (PG8_LAS unsigned*)(lds + (bufoff) + ldsw + _i * 8192), 16, 0, 0); } while (0)
#define PG8_LDA(dst, b, h) do { _Pragma("unroll") for (int m = 0; m < 4; ++m) _Pragma("unroll") for (int k = 0; k < 2; ++k) dst[m][k] = *(const PG8_LAS frag8*)(lds + PG8_SA(b, h) + aoff + m * 2048 + k * 1024); } while (0)
#define PG8_LDB(dst, b, h) do { _Pragma("unroll") for (int n = 0; n < 2; ++n) _Pragma("unroll") for (int k = 0; k < 2; ++k) dst[n][k] = *(const PG8_LAS frag8*)(lds + PG8_SB(b, h) + boff + n * 2048 + k * 1024); } while (0)
#define PG8_MMA(ai, bj, At, Bt) do { __builtin_amdgcn_s_setprio(1); _Pragma("unroll") for (int m = 0; m < 4; ++m) _Pragma("unroll") for (int n = 0; n < 2; ++n) _Pragma("unroll") for (int k = 0; k < 2; ++k) \
        mma16(Bt[n][k], At[m][k], acc[ai][bj][m][n]); __builtin_amdgcn_s_setprio(0); } while (0)
#define PG8_WAIT_V(n) asm volatile("s_waitcnt vmcnt(" #n ")" ::: "memory")
#define PG8_WAIT_L(n) asm volatile("s_waitcnt lgkmcnt(" #n ")" ::: "memory")
#define PG8_BAR __builtin_amdgcn_s_barrier()
#define PG8_SCHED __builtin_amdgcn_sched_barrier(0)
    Unit cur, nxt; int ui = 0;
    if (!S.next(0, cur)) return;
    typedef typename Epi::acc_t acc_t;
    acc_t acc[2][2][4][2];
#pragma unroll
    for (int a = 0; a < 2; ++a)
#pragma unroll
        for (int b = 0; b < 2; ++b)
#pragma unroll
            for (int m = 0; m < 4; ++m)
#pragma unroll
                for (int n = 0; n < 2; ++n) acc[a][b][m][n] = acc_t{};
    frag8 At[4][2], B0[2][2], B1[2][2];
    const char* cA = (const char*)g.A + (size_t)cur.pm * tstep; const char* cB = (const char*)g.Bt + (size_t)cur.pn * tstep;
    S.a_ready(cur);
    if constexpr (SP2) {
        PG8_STAGE(PG8_SB(0, 0), cB, voffB); PG8_STAGE(PG8_SB(0, 1), cB + hstep, voffB); PG8_STAGE(PG8_SA(0, 0), cA, voffA); PG8_STAGE(PG8_SA(0, 1), cA + hstep, voffA);
        if (wr == 1) PG8_BAR;
        PG8_WAIT_V(2); PG8_BAR;
        PG8_STAGE(PG8_SB(1, 0), cB + kstep, voffB); PG8_STAGE(PG8_SA(1, 0), cA + kstep, voffA); PG8_STAGE(PG8_SB(1, 1), cB + hstep + kstep, voffB);
        PG8_WAIT_V(6); PG8_BAR;
    } else {
        PG8_STAGE(PG8_SB(0, 0), cB, voffB); PG8_STAGE(PG8_SA(0, 0), cA, voffA); PG8_STAGE(PG8_SB(0, 1), cB + hstep, voffB); PG8_STAGE(PG8_SA(0, 1), cA + hstep, voffA);
        if (wr == 1) PG8_BAR;
        PG8_WAIT_V(4); PG8_BAR;
        PG8_STAGE(PG8_SB(1, 0), cB + kstep, voffB); PG8_STAGE(PG8_SA(1, 0), cA + kstep, voffA); PG8_STAGE(PG8_SB(1, 1), cB + hstep + kstep, voffB);
        PG8_WAIT_V(6); PG8_BAR;
    }
    for (;;) {
        const bool has_next = S.next(ui + 1, nxt);
        const char* nA = has_next ? (const char*)g.A + (size_t)nxt.pm * tstep : cA; const char* nB = has_next ? (const char*)g.Bt + (size_t)nxt.pn * tstep : cB;
        for (int t = 0; t < nt; t += 2) {
            const bool last = (t == nt - 2);
            if constexpr (Epi::MIDK) { if (t == (nt >> 1)) E.mid(acc, cur, wr, wc, fr, fq); }
            const char* a1 = cA + (size_t)(t + 1) * kstep;
            const char* a2 = last ? nA : cA + (size_t)(t + 2) * kstep; const char* b2 = last ? nB : cB + (size_t)(t + 2) * kstep;
            const char* a3 = a2 + kstep; const char* b3 = b2 + kstep;
            if (last && has_next) S.a_ready(nxt);
            if constexpr (SP2) {
            PG8_LDB(B0, 0, 0); PG8_LDB(B1, 0, 1); PG8_SCHED; PG8_LDA(At, 0, 0); PG8_STAGE(PG8_SA(1, 1), a1 + hstep, voffA);
            PG8_WAIT_V(8); PG8_WAIT_L(0); PG8_BAR; PG8_MMA(0, 0, At, B0); PG8_MMA(0, 1, At, B1); PG8_BAR; PG8_SCHED;
            PG8_LDA(At, 0, 1); PG8_STAGE(PG8_SB(0, 0), b2, voffB); PG8_STAGE(PG8_SB(0, 1), b2 + hstep, voffB); PG8_STAGE(PG8_SA(0, 0), a2, voffA);
            PG8_WAIT_V(8); PG8_WAIT_L(0); PG8_BAR; PG8_MMA(1, 0, At, B0); PG8_MMA(1, 1, At, B1); PG8_BAR; PG8_SCHED;
            PG8_LDB(B0, 1, 0); PG8_LDB(B1, 1, 1); PG8_SCHED; PG8_LDA(At, 1, 0); PG8_STAGE(PG8_SA(0, 1), a2 + hstep, voffA);
            PG8_WAIT_V(8); PG8_WAIT_L(0); PG8_BAR; PG8_MMA(0, 0, At, B0); PG8_MMA(0, 1, At, B1); PG8_BAR; PG8_SCHED;
            PG8_LDA(At, 1, 1); PG8_STAGE(PG8_SB(1, 0), b3, voffB); PG8_STAGE(PG8_SB(1, 1), b3 + hstep, voffB); PG8_STAGE(PG8_SA(1, 0), a3, voffA);
            PG8_WAIT_V(8); PG8_WAIT_L(0); PG8_BAR; PG8_MMA(1, 0, At, B0); PG8_MMA(1, 1, At, B1); PG8_BAR; PG8_SCHED;
            } else {
            PG8_LDB(B0, 0, 0); PG8_SCHED; PG8_LDA(At, 0, 0); PG8_STAGE(PG8_SA(1, 1), a1 + hstep, voffA);
            PG8_WAIT_L(8); PG8_BAR; PG8_WAIT_L(0); PG8_MMA(0, 0, At, B0); PG8_BAR; PG8_SCHED;
            PG8_LDB(B1, 0, 1); PG8_STAGE(PG8_SB(0, 0), b2, voffB);
            PG8_BAR; PG8_WAIT_L(0); PG8_MMA(0, 1, At, B1); PG8_BAR;
            PG8_LDA(At, 0, 1); PG8_STAGE(PG8_SA(0, 0), a2, voffA);
            PG8_BAR; PG8_WAIT_L(0); PG8_MMA(1, 0, At, B0); PG8_BAR; PG8_SCHED;
            PG8_STAGE(PG8_SB(0, 1), b2 + hstep, voffB);
            PG8_WAIT_V(6); PG8_BAR; PG8_MMA(1, 1, At, B1); PG8_BAR;
            PG8_LDB(B0, 1, 0); PG8_SCHED; PG8_LDA(At, 1, 0); PG8_STAGE(PG8_SA(0, 1), a2 + hstep, voffA);
            PG8_WAIT_L(8); PG8_BAR; PG8_WAIT_L(0); PG8_MMA(0, 0, At, B0); PG8_BAR; PG8_SCHED;
            PG8_LDB(B1, 1, 1); PG8_STAGE(PG8_SB(1, 0), b3, voffB);
            PG8_BAR; PG8_WAIT_L(0); PG8_MMA(0, 1, At, B1); PG8_BAR;
            PG8_LDA(At, 1, 1); PG8_STAGE(PG8_SA(1, 0), a3, voffA);
            PG8_BAR; PG8_WAIT_L(0); PG8_MMA(1, 0, At, B0); PG8_BAR; PG8_SCHED;
            PG8_STAGE(PG8_SB(1, 1), b3 + hstep, voffB);
            PG8_WAIT_V(6); PG8_BAR; PG8_MMA(1, 1, At, B1); PG8_BAR;
            }
        }
        if constexpr (ALIGN_EPI) { if (wr == 0) PG8_BAR; }
        if constexpr (!Epi::AFTER_DRAIN) { E(acc, cur, wr, wc, fr, fq); S.done(cur); }
        if (!has_next) break;
#pragma unroll
        for (int a = 0; a < 2; ++a)
#pragma unroll
            for (int b = 0; b < 2; ++b)
#pragma unroll
                for (int m = 0; m < 4; ++m)
#pragma unroll
                    for (int n = 0; n < 2; ++n) acc[a][b][m][n] = acc_t{};
        cur = nxt; cA = nA; cB = nB; ++ui;
        if constexpr (ALIGN_EPI) { if (wr == 1) PG8_BAR; }
    }
    PG8_WAIT_V(0);
    if constexpr (!ALIGN_EPI) { if (wr == 0) PG8_BAR; }
    PG8_BAR;
    if constexpr (Epi::AFTER_DRAIN) { E.fused(acc, cur, wr, wc, fr, fq, lds, wid, lane); S.done(cur); }
#undef PG8_SA
#undef PG8_SB
#undef PG8_STAGE
#undef PG8_LDA
#undef PG8_LDB
#undef PG8_MMA
#undef PG8_WAIT_V
#undef PG8_WAIT_L
#undef PG8_BAR
#undef PG8_SCHED
}
}

#define XB_TMO      128
#define XB_XCNT(j)  (256  + 64 * (j))
#define XB_XSUB(j)  (1280 + 64 * (j))
#define XB_XGEN(j)  (2304 + 64 * (j))
#define XB_TOP      3328
#define XB_TOPGEN   3392
#define XCD_BAR_WORDS 3456
#define XB_SPIN_CAP (1u << 18)

__device__ __forceinline__ unsigned xb_ld(unsigned* p)              { return __hip_atomic_load(p, __ATOMIC_RELAXED, __HIP_MEMORY_SCOPE_AGENT); }
__device__ __forceinline__ unsigned xb_add(unsigned* p, unsigned v) { return __hip_atomic_fetch_add(p, v, __ATOMIC_RELAXED, __HIP_MEMORY_SCOPE_AGENT); }
__device__ __forceinline__ unsigned xb_xcc_id() { return (unsigned)__builtin_amdgcn_s_getreg((3 << 11) | 20) & 0xFu; }
#define XB_SPIN(cond, bar) do { unsigned _sp = 0; while (cond) { __builtin_amdgcn_s_sleep(1); \
    if ((++_sp & 255u) == 0u) { if (xb_ld(&(bar)[XB_TMO])) break; if (_sp > XB_SPIN_CAP) { atomicAdd(&(bar)[XB_TMO], 1u); break; } } } } while (0)

struct XcdBarrier {
    unsigned* bar; unsigned x;
    volatile LAS unsigned* st;
};

__device__ __forceinline__ XcdBarrier xcd_barrier_post(unsigned* bar, volatile LAS unsigned* st) {
    XcdBarrier b; b.bar = bar; b.x = xb_xcc_id(); b.st = st;
    if (threadIdx.x == 0) st[2] = xb_add(&bar[XB_XCNT(b.x)], 1u);
    return b;
}
__device__ __forceinline__ void xcd_barrier_complete(unsigned* bar, unsigned x, unsigned& nloc, unsigned& nx) {
    const unsigned G = gridDim.x * gridDim.y * gridDim.z;
    unsigned sum, cnt, mine, sp = 0u;
    for (;;) {
        sum = 0u; cnt = 0u; mine = 0u;
#pragma unroll
        for (unsigned j = 0; j < 16; ++j) { const unsigned c = xb_ld(&bar[XB_XCNT(j)]); sum += c; cnt += (c > 0u) ? 1u : 0u; mine = (j == x) ? c : mine; }
        if (sum == G) break;
        __builtin_amdgcn_s_sleep(1);
        if ((++sp & 255u) == 0u) { if (xb_ld(&bar[XB_TMO])) break; if (sp > XB_SPIN_CAP) { atomicAdd(&bar[XB_TMO], 1u); break; } }
    }
    nloc = mine > 0u ? mine : 1u; nx = cnt > 0u ? cnt : 1u;
}

__device__ __forceinline__ void xcd_barrier(const XcdBarrier& b) {
    asm volatile("s_waitcnt vmcnt(0)" ::: "memory");
    __syncthreads();
    if (threadIdx.x == 0) {
        unsigned* bar = b.bar;
        __builtin_amdgcn_s_waitcnt(0);
        unsigned nloc = b.st[0], nx = b.st[1];
        if (nloc == 0u) { xcd_barrier_complete(bar, b.x, nloc, nx); b.st[0] = nloc; b.st[1] = nx; }
        const unsigned old = xb_add(&bar[XB_XSUB(b.x)], 1u);
        const unsigned gen = old / nloc;
        if (old + 1u == (gen + 1u) * nloc) {
            __builtin_amdgcn_fence(__ATOMIC_RELEASE, "agent");
            asm volatile("s_waitcnt vmcnt(0)" ::: "memory");
            const unsigned og = xb_add(&bar[XB_TOP], 1u);
            const unsigned tg = og / nx;
            if (og + 1u == (tg + 1u) * nx) xb_add(&bar[XB_TOPGEN], 1u);
            else XB_SPIN(xb_ld(&bar[XB_TOPGEN]) == tg, bar);
            __builtin_amdgcn_fence(__ATOMIC_ACQUIRE, "agent");
            xb_add(&bar[XB_XGEN(b.x)], 1u);
            asm volatile("s_waitcnt vmcnt(0)" ::: "memory");
        } else {
            XB_SPIN(xb_ld(&bar[XB_XGEN(b.x)]) == gen, bar);
            __builtin_amdgcn_fence(__ATOMIC_ACQUIRE, "agent");
            asm volatile("s_waitcnt vmcnt(0)" ::: "memory");
        }
    }
    __syncthreads();
}


struct Args { const float* in[16]; float* out; unsigned char* ws; int ph_lo, ph_hi; };
constexpr int N_PHASES = 11;

__global__ void __launch_bounds__(NTHREADS, 2) mk_fwd(Args a) {
    extern __shared__ __attribute__((aligned(16))) unsigned char lds[];
    LAS unsigned char* L = (LAS unsigned char*)lds;
    volatile LAS unsigned* MISC = (volatile LAS unsigned*)(L + MISC_OFF);
    unsigned char* ws = a.ws;
    Ctx C;
    C.tid = threadIdx.x; C.lane = C.tid & 63; C.wave = __builtin_amdgcn_readfirstlane(C.tid >> 6);
    C.G = gridDim.x; C.gw = blockIdx.x * NWAVES + C.wave; C.ngw = C.G * NWAVES; C.gt = blockIdx.x * NTHREADS + C.tid; C.ngt = C.G * NTHREADS;
    for (int u = C.tid; u < (LDS_BYTES - LDSCTL_OFF) / 4; u += NTHREADS) ((LAS unsigned*)(L + LDSCTL_OFF))[u] = 0u;
    __syncthreads();
    const int lo = a.ph_lo, hi = a.ph_hi, G = C.G;
    const bool multi = (hi - lo) > 1;
    XcdBarrier bar; bar.bar = (unsigned*)(ws + WS_CTL) + CW_BAR; bar.x = 0; bar.st = nullptr;
    if (multi) bar = xcd_barrier_post((unsigned*)(ws + WS_CTL) + CW_BAR, MISC + 8);
#define IN(k) (lo <= (k) && (k) < hi)
#define SEAM(k) do { if (IN(k) && IN((k) + 1)) xcd_barrier(bar); } while (0)

#define FILLER(c, mode, nwg) do { const Stag sg_ = stag_group((int)blockIdx.x, G, (mode), (nwg)); if (sg_.member) { \
        if ((c) < 2) quant_rows_range<false>(C.lane, a.in[13], (unsigned*)(ws + WS_UQ), (float*)(ws + WS_US), 8192 * ((c) & 1), 8192 * ((c) & 1) + 8192, sg_.rank * NWAVES + C.wave, sg_.count * NWAVES); \
        else quant_rows_range<false>(C.lane, a.in[14], (unsigned*)(ws + WS_VQ), (float*)(ws + WS_VS), 8192 * ((c) & 1), 8192 * ((c) & 1) + 8192, sg_.rank * NWAVES + C.wave, sg_.count * NWAVES); } } while (0)
#define REPS(k) _Pragma("unroll") for (int rep_ = 0; rep_ < ((PROBE_DUP == (k)) ? 2 : 1); ++rep_)
#define REPBAR(k) do { if (PROBE_DUP == (k) && rep_ == 0) xcd_barrier(bar); } while (0)
    if (IN(0)) REPS(0) { ph_prep(C, L, a.in, ws); REPBAR(0); }
    SEAM(0);
    if (IN(1)) REPS(1) {
        for (int r2_ = 0; r2_ < (PROBE_DUP == 14 ? 2 : 1); ++r2_) {
        quant_wrows(C, (const f16*)(ws + WS_WCAT), NCAT, (unsigned*)(ws + WS_WCATQ), (float*)(ws + WS_WCS));
        quant_wrows(C, (const f16*)(ws + WS_WQ), 2048, (unsigned*)(ws + WS_WQQ), (float*)(ws + WS_WQS));
        xcd_barrier(bar); }
        pg8::Gemm g{(const f16*)(ws + WS_XH), (const f16*)(ws + WS_WCATQ), T, NCAT, DM / 2}; pg8::StaticOrder S; S.init(T, NCAT, G, (int)blockIdx.x);
        pg8::EpiP1 E{(const float*)(ws + WS_RS1), (const float*)(ws + WS_RSX), (const float*)(ws + WS_WCS), a.in[8], (f16*)(ws + WS_QKVU), ws + WS_GATES, (f16*)(ws + WS_VT)};
        if (rep_ == 0) FILLER(0, 1, (T / 256) * (NCAT / 256));
        pg8::gemm_phase<pg8::EpiP1, pg8::StaticOrder, true, true>(L, g, S, E);
        REPBAR(1);
    }
    SEAM(1);
    if (IN(2)) REPS(2) {
        ph_attn_pool(C, L, (const f16*)(ws + WS_QKVU), (const f16*)(ws + WS_VT), a.in[3], (const f16*)(ws + WS_POOLW), a.in[5], (f16*)(ws + WS_OCAT));
        REPBAR(2);
    }
    if (IN(2) && IN(4)) xcd_barrier(bar);
    if (IN(4)) REPS(4) {
        pg8::Gemm g{(const f16*)(ws + WS_OCAT), (const f16*)(ws + WS_WB), T, DM, DM}; pg8::StaticOrder S; S.init(T, DM, G, (int)blockIdx.x);
        pg8::EpiMerged E{ws + WS_GATES, (f16*)(ws + WS_MERGED)};
        if (rep_ == 0) FILLER(1, 0, 0);
        pg8::gemm_phase<pg8::EpiMerged, pg8::StaticOrder, true, true>(L, g, S, E);
        REPBAR(4);
    }
    SEAM(4);
    if (IN(5)) REPS(5) {
        pg8::Gemm g{(const f16*)(ws + WS_MERGED), (const f16*)(ws + WS_WOUT), T, DM, DM}; pg8::StaticOrder S; S.init(T, DM, G, (int)blockIdx.x);
        pg8::EpiOut E{a.in[0], (f16*)(ws + WS_X1H), (float*)(ws + WS_SS2)};
        if (rep_ == 0) FILLER(2, 0, 0);
        pg8::gemm_phase<pg8::EpiOut, pg8::StaticOrder, true, true>(L, g, S, E);
        REPBAR(5);
    }
    SEAM(5);
    if (IN(6)) REPS(6) {
        for (int r2_ = 0; r2_ < (PROBE_DUP == 12 ? 2 : 1); ++r2_) {
        ph_h2quant(C, (const f16*)(ws + WS_X1H), a.in[10], (const float*)(ws + WS_SS2), (unsigned*)(ws + WS_H2Q), (float*)(ws + WS_HSC));
        xcd_barrier(bar); }
        pg8::Gemm g{(const f16*)(ws + WS_H2Q), (const f16*)(ws + WS_WQQ), T, 2048, DM / 2}; pg8::StaticOrder S; S.init(T, 2048, G, (int)blockIdx.x);
        pg8::EpiQ E{(const float*)(ws + WS_HSC), (const float*)(ws + WS_WQS), (f16*)(ws + WS_QP)};
        if (rep_ == 0) FILLER(3, 0, 0);
        pg8::gemm_phase<pg8::EpiQ, pg8::StaticOrder, true, true>(L, g, S, E);
        REPBAR(6);
    }
    SEAM(6);
    if (IN(7)) REPS(7) {
        auto side = [&]() {};
        ph_route(C, L, (const f16*)(ws + WS_QP), (const float*)(ws + WS_SS2), (const f16*)(ws + WS_SUBK), (int*)(ws + WS_EIDX), (float*)(ws + WS_EGATE), side);
        REPBAR(7); }
    SEAM(7);
    if (IN(8)) REPS(8) {
        const Slicing SL = get_slicing((const unsigned*)(ws + WS_CTL) + CW_BAR, MISC);
        if (PROBE_DUP == 8 && rep_ == 0) ph_upeer<255>(C, L, SL, (const unsigned*)(ws + WS_H2Q), (const int*)(ws + WS_EIDX), (const unsigned char*)(ws + WS_UQ), (short*)(ws + WS_PDOT));
        else ph_upeer<16383>(C, L, SL, (const unsigned*)(ws + WS_H2Q), (const int*)(ws + WS_EIDX), (const unsigned char*)(ws + WS_UQ), (short*)(ws + WS_PDOT));
        REPBAR(8);
    }
    SEAM(8);
    if (IN(9)) {
        REPS(9) {
        ph_ureduce(C, L, (const short*)(ws + WS_PDOT), (const float*)(ws + WS_HSC), (const int*)(ws + WS_EIDX), (const float*)(ws + WS_US), (const float*)(ws + WS_VS), (const float*)(ws + WS_EGATE),
                   (unsigned*)(ws + WS_WQP), (float*)(ws + WS_WSC));
        REPBAR(9); }
        xcd_barrier(bar);
        const Slicing SL = get_slicing((const unsigned*)(ws + WS_CTL) + CW_BAR, MISC);
        REPS(11) {
        ph_vpeer<16383>(C, SL, (const int*)(ws + WS_EIDX), (const unsigned*)(ws + WS_WQP), (const float*)(ws + WS_WSC), (const unsigned char*)(ws + WS_VQ), (f16*)(ws + WS_PEER));
        REPBAR(11); }
    }
    SEAM(9);
    if (IN(10)) REPS(10) { REPBAR(10); ph_final(C, (const f16*)(ws + WS_PEER), (const f16*)(ws + WS_X1H), a.out, a.in[15]); }
#undef IN
#undef SEAM
}

#ifndef MK_N_LAUNCHES
#define MK_N_LAUNCHES 1
#endif
extern "C" void kernel_launch(void* const* d_in, const int* in_sizes, int n_in, void* d_out, int out_size, void* d_ws, size_t ws_size, hipStream_t stream) {
    static int grid = 0;
    if (grid == 0) {
        if (n_in != 16 || in_sizes[0] != T * DM || out_size != T * DM || ws_size < WS_END) {
            fprintf(stderr, "kernel_launch: unexpected shapes (n_in %d in0 %d out %d ws %zu)\n", n_in, n_in > 0 ? in_sizes[0] : -1, out_size, ws_size);
            grid = -1; return;
        }
        int dev = 0, cus = 0;
        if (hipGetDevice(&dev) != hipSuccess || hipDeviceGetAttribute(&cus, hipDeviceAttributeMultiprocessorCount, dev) != hipSuccess) { grid = -1; return; }
        if (hipFuncSetAttribute((const void*)mk_fwd, hipFuncAttributeMaxDynamicSharedMemorySize, LDS_BYTES) != hipSuccess) { fprintf(stderr, "kernel_launch: hipFuncSetAttribute failed\n"); grid = -1; return; }
        int per_cu = 0;
        if (hipOccupancyMaxActiveBlocksPerMultiprocessor(&per_cu, (const void*)mk_fwd, NTHREADS, LDS_BYTES) != hipSuccess || per_cu < 1)
            fprintf(stderr, "kernel_launch: occupancy query reports %d workgroups per CU\n", per_cu);
        (void)hipGetLastError();
        grid = cus;
    }
    if (grid < 0) return;
    (void)hipMemsetAsync((char*)d_ws + WS_CTL, 0, CTL_ZERO_BYTES, stream);
    Args a{};
    for (int i = 0; i < 16; ++i) a.in[i] = (const float*)d_in[i];
    a.out = (float*)d_out; a.ws = (unsigned char*)d_ws;
    if (MK_N_LAUNCHES == 1) {
        a.ph_lo = 0; a.ph_hi = N_PHASES;
        hipLaunchKernelGGL(mk_fwd, dim3(grid), dim3(NTHREADS), LDS_BYTES, stream, a);
    } else {
        for (int p = 0; p < N_PHASES; ++p) { a.ph_lo = p; a.ph_hi = p + 1; hipLaunchKernelGGL(mk_fwd, dim3(grid), dim3(NTHREADS), LDS_BYTES, stream, a); }
    }
}
```

```cpp
#include <hip/hip_runtime.h>
#include <cstdint>
#include <cstdio>

typedef _Float16 f16;
typedef _Float16 half8 __attribute__((ext_vector_type(8)));
typedef _Float16 half4 __attribute__((ext_vector_type(4)));
typedef _Float16 half2 __attribute__((ext_vector_type(2)));
typedef float f32x4 __attribute__((ext_vector_type(4)));
typedef float f32x16 __attribute__((ext_vector_type(16)));
typedef unsigned u32x4 __attribute__((ext_vector_type(4)));
typedef int i32x4 __attribute__((ext_vector_type(4)));
#define LAS __attribute__((address_space(3)))
#ifndef PROBE_DIAG
#define PROBE_DIAG (0)
#endif
#ifndef PROBE_DUP
#define PROBE_DUP (-1)
#endif
#define GAS __attribute__((address_space(1)))

constexpr int DM = 1024, BATCH = 16, SEQ = 2048, T = BATCH * SEQ;
constexpr int NQKVU = 1280, NGATE = 2048, NCAT = NQKVU + NGATE;
constexpr int COL_K = 512, COL_V = 640, COL_U = 768;
constexpr int NEXP = 16384, PEER_H = 8, TOPK = 16;
constexpr float EPS = 1e-6f;
constexpr int NWAVES = 8, NTHREADS = NWAVES * 64;

constexpr size_t MiB = 1u << 20;
constexpr size_t WS_CTL = 0, CTL_ZERO_BYTES = 64 * 1024;
constexpr size_t WS_WCAT = 1 * MiB;
constexpr size_t WS_WB = 8 * MiB;
constexpr size_t WS_WOUT = 10 * MiB;
constexpr size_t WS_WQ = 12 * MiB;
constexpr size_t WS_POOLW = 16 * MiB;
constexpr size_t WS_SUBK = 16 * MiB + 512 * 1024;
constexpr size_t WS_RS1 = 17 * MiB;
constexpr size_t WS_EIDX = 18 * MiB;
constexpr size_t WS_EGATE = 34 * MiB;
constexpr size_t WS_WCATQ = 50 * MiB;
constexpr size_t WS_WCS = 54 * MiB;
constexpr size_t WS_WQQ = 56 * MiB;
constexpr size_t WS_WQS = 59 * MiB;
constexpr size_t WS_RSX = 55 * MiB;
constexpr size_t WS_UTAB = 50 * MiB;
constexpr size_t WS_VTAB = 82 * MiB;
constexpr size_t WS_XH = 114 * MiB;
constexpr size_t WS_MERGED = WS_XH;
constexpr size_t WS_QKVU = 178 * MiB;
constexpr size_t WS_X1H = WS_QKVU;
constexpr size_t WS_PEER = WS_MERGED;
constexpr size_t WS_GATES = 258 * MiB;
constexpr size_t WS_QP = WS_GATES;
constexpr size_t WS_OCAT = 386 * MiB;
constexpr size_t WS_UQ = 450 * MiB;
constexpr size_t WS_VQ = 466 * MiB;
constexpr size_t WS_US = 17 * MiB + 256 * 1024, WS_VS = 17 * MiB + 512 * 1024;
constexpr size_t WS_PDOT = WS_GATES;
constexpr size_t WS_H2Q = 404 * MiB;
constexpr size_t WS_HSC = 403 * MiB;
constexpr size_t WS_SSF = 402 * MiB;
constexpr size_t WS_WQP = 386 * MiB;
constexpr size_t WS_WSC = 390 * MiB;
constexpr size_t WS_ACT = 386 * MiB;
constexpr size_t WS_SS2 = 482 * MiB;
constexpr size_t WS_VT = 484 * MiB;
constexpr size_t WS_END = 492 * MiB;
constexpr int CW_BAR = 4096;

constexpr int RING_OFF = 0, RING_BYTES = 131072;
constexpr int LDSCTL_OFF = RING_BYTES, MISC_OFF = LDSCTL_OFF + 320;
constexpr int LDS_BYTES = 147456;

#define LDS_WAIT() asm volatile("s_waitcnt lgkmcnt(0)" ::: "memory")
template <int CTRL> __device__ __forceinline__ float dppf(float x) { return __uint_as_float(__builtin_amdgcn_update_dpp(0u, __float_as_uint(x), CTRL, 0xf, 0xf, false)); }
template <int CTRL> __device__ __forceinline__ int dppi(int x) { return (int)__builtin_amdgcn_update_dpp(0u, (unsigned)x, CTRL, 0xf, 0xf, false); }
__device__ __forceinline__ float bfly32(float a, float b) { auto r = __builtin_amdgcn_permlane32_swap(__float_as_uint(a), __float_as_uint(b), false, false); return __uint_as_float(r[0]) + __uint_as_float(r[1]); }
__device__ __forceinline__ float bfly16(float a, float b) { auto r = __builtin_amdgcn_permlane16_swap(__float_as_uint(a), __float_as_uint(b), false, false); return __uint_as_float(r[0]) + __uint_as_float(r[1]); }
__device__ __forceinline__ int bfly32i(int a, int b) { auto r = __builtin_amdgcn_permlane32_swap((unsigned)a, (unsigned)b, false, false); return (int)(r[0] + r[1]); }
__device__ __forceinline__ int bfly16i(int a, int b) { auto r = __builtin_amdgcn_permlane16_swap((unsigned)a, (unsigned)b, false, false); return (int)(r[0] + r[1]); }
__device__ __forceinline__ float wave_sum(float x) {
    x += dppf<0x121>(x); x += dppf<0x122>(x); x += dppf<0x124>(x); x += dppf<0x128>(x);
    x = bfly16(x, x); return bfly32(x, x);
}
__device__ __forceinline__ int wave_sum_i(int x) {
    x += dppi<0x121>(x); x += dppi<0x122>(x); x += dppi<0x124>(x); x += dppi<0x128>(x);
    x = bfly16i(x, x); return bfly32i(x, x);
}
__device__ __forceinline__ float wave_max(float x) {
    x = fmaxf(x, dppf<0x121>(x)); x = fmaxf(x, dppf<0x122>(x)); x = fmaxf(x, dppf<0x124>(x)); x = fmaxf(x, dppf<0x128>(x));
    { auto r = __builtin_amdgcn_permlane16_swap(__float_as_uint(x), __float_as_uint(x), false, false); x = fmaxf(__uint_as_float(r[0]), __uint_as_float(r[1])); }
    { auto r = __builtin_amdgcn_permlane32_swap(__float_as_uint(x), __float_as_uint(x), false, false); x = fmaxf(__uint_as_float(r[0]), __uint_as_float(r[1])); }
    return x;
}
__device__ __forceinline__ float gelu_exact(float x) { return 0.5f * x * (1.0f + erff(x * 0.70710678118654752f)); }
__device__ __forceinline__ float rs_from_ss(const float* ss, int t) {
    float s = 0.f;
#pragma unroll
    for (int i = 0; i < 16; ++i) s += ss[(size_t)i * T + t];
    return rsqrtf(s * (1.0f / DM) + EPS);
}

struct Ctx {
    int tid, lane, wave;
    int G;
    int gw, ngw;
    int gt, ngt;
};

__device__ __forceinline__ int pack4_i8(float a, float b, float c, float d) {
    const int ia = (int)rintf(a), ib = (int)rintf(b), ic = (int)rintf(c), id = (int)rintf(d);
    return (ia & 0xff) | ((ib & 0xff) << 8) | ((ic & 0xff) << 16) | (id << 24);
}
template <bool OFFS>
__device__ __forceinline__ void quant_rows(const Ctx& C, const float* __restrict__ tab, unsigned* __restrict__ q, float* __restrict__ scale) {
    const int lane = C.lane;
    for (int r = C.gw; r < NEXP; r += C.ngw) {
        const float* row = tab + (size_t)r * DM;
        f32x4 v[4]; float m = 0.f;
#pragma unroll
        for (int j = 0; j < 4; ++j) { v[j] = *(const f32x4*)(row + j * 256 + lane * 4); m = fmaxf(m, fmaxf(fmaxf(fabsf(v[j][0]), fabsf(v[j][1])), fmaxf(fabsf(v[j][2]), fabsf(v[j][3])))); }
        m = wave_max(m);
        const float inv = m > 0.f ? 127.0f / m : 0.f;
#pragma unroll
        for (int j = 0; j < 4; ++j) {
            unsigned w = (unsigned)pack4_i8(v[j][0] * inv, v[j][1] * inv, v[j][2] * inv, v[j][3] * inv);
            if (OFFS) w ^= 0x80808080u;
            { const int dw = j * 64 + lane; q[(size_t)(dw >> 5) * (NEXP * 32) + (size_t)r * 32 + (dw & 31)] = w; }
        }
        if (lane == 0) scale[r] = m * (1.0f / 127.0f);
    }
}

template <bool OFFS>
__device__ __forceinline__ void quant_rows_range(const int lane, const float* __restrict__ tab, unsigned* __restrict__ q, float* __restrict__ scale, int r0, int r1, int sw, int nsw) {
    for (int ra = r0 + sw; ra < r1; ra += 2 * nsw) {
        const int rb = ra + nsw; const bool hb = rb < r1; const int rbb = hb ? rb : ra;
        f32x4 v[2][4];
#pragma unroll
        for (int j = 0; j < 4; ++j) { v[0][j] = *(const f32x4*)(tab + (size_t)ra * DM + j * 256 + lane * 4); v[1][j] = *(const f32x4*)(tab + (size_t)rbb * DM + j * 256 + lane * 4); }
#pragma unroll
        for (int u = 0; u < 2; ++u) {
            const int r = u ? rbb : ra;
            float m = 0.f;
#pragma unroll
            for (int j = 0; j < 4; ++j) m = fmaxf(m, fmaxf(fmaxf(fabsf(v[u][j][0]), fabsf(v[u][j][1])), fmaxf(fabsf(v[u][j][2]), fabsf(v[u][j][3]))));
            m = wave_max(m);
            const float inv = m > 0.f ? 127.0f / m : 0.f;
            if (u == 0 || hb) {
#pragma unroll
                for (int j = 0; j < 4; ++j) {
                    unsigned w = (unsigned)pack4_i8(v[u][j][0] * inv, v[u][j][1] * inv, v[u][j][2] * inv, v[u][j][3] * inv);
                    if (OFFS) w ^= 0x80808080u;
                    { const int dw = j * 64 + lane; q[(size_t)(dw >> 5) * (NEXP * 32) + (size_t)r * 32 + (dw & 31)] = w; }
                }
                if (lane == 0) scale[r] = m * (1.0f / 127.0f);
            }
        }
    }
}
struct Stag { bool member; int rank, count; };
__device__ __forceinline__ Stag stag_group(int b, int G, int mode, int nwg) {
    Stag s;
#ifdef STAG_ALL
    s.member = true; s.rank = b; s.count = G; return s;
#endif
    const int rem = nwg % G;
    if (mode == 1 && rem != 0) { s.member = b >= rem; s.rank = b - rem; s.count = G - rem; return s; }
    if (G < 16) { s.member = true; s.rank = b; s.count = G; return s; }
    s.member = ((b >> 3) & 1) != 0; s.rank = (b >> 4) * 8 + (b & 7); s.count = (G >> 4) * 8 + ((G & 15) > 8 ? (G & 15) - 8 : 0);
    return s;
}

__device__ __forceinline__ void p0_transpose_item(const float* W, int K, int N, f16* WT, int ldo, int koff, LAS float* scr, int item, int lane) {
    const int nblk = N / 32, kb = item / nblk, nb = item % nblk, k0 = 64 * kb, n0 = 32 * nb;
#pragma unroll 8
    for (int i = 0; i < 32; ++i) { const int kk = 2 * i + (lane >> 5); scr[kk * 33 + (lane & 31)] = W[(size_t)(k0 + kk) * N + n0 + (lane & 31)]; }
    LDS_WAIT(); asm volatile("" ::: "memory");
    const int c = lane & 7;
#pragma unroll
    for (int j = 0; j < 4; ++j) { const int n = (lane >> 3) + 8 * j; const LAS float* s = scr + (8 * c) * 33 + n;
        half8 o;
#pragma unroll
        for (int i = 0; i < 8; ++i) o[i] = (f16)s[i * 33];
        *(half8*)(WT + (size_t)(n0 + n) * ldo + koff + k0 + 8 * c) = o; }
    LDS_WAIT(); asm volatile("" ::: "memory");
}
__device__ __forceinline__ void cvt_stream(const Ctx& C, const float* in, f16* out, size_t n4) {
    for (size_t i = (size_t)C.gt; i < n4; i += (size_t)C.ngt) {
        const f32x4 v = ((const f32x4*)in)[i];
        half4 h; h[0] = (f16)v[0]; h[1] = (f16)v[1]; h[2] = (f16)v[2]; h[3] = (f16)v[3];
        ((half4*)out)[i] = h;
    }
}
__device__ __forceinline__ void rowprep(const Ctx& C, const float* x, const float* g, unsigned* xq, float* rsx, float* ss) {
    const int lane = C.lane;
    f32x4 gg[4];
#pragma unroll
    for (int j = 0; j < 4; ++j) gg[j] = *(const f32x4*)(g + j * 256 + lane * 4);
    for (int tb = C.gw * 4; tb < T; tb += C.ngw * 4) {
        f32x4 v[4][4];
#pragma unroll
        for (int u = 0; u < 4; ++u)
#pragma unroll
            for (int j = 0; j < 4; ++j) v[u][j] = *(const f32x4*)(x + (size_t)(tb + u) * DM + j * 256 + lane * 4);
#pragma unroll
        for (int u = 0; u < 4; ++u) {
            float s = 0.f, am = 0.f;
#pragma unroll
            for (int j = 0; j < 4; ++j) {
                const f32x4 w = v[u][j];
                s += w[0] * w[0] + w[1] * w[1] + w[2] * w[2] + w[3] * w[3];
                v[u][j] = w * gg[j];
                am = fmaxf(am, fmaxf(fmaxf(fabsf(v[u][j][0]), fabsf(v[u][j][1])), fmaxf(fabsf(v[u][j][2]), fabsf(v[u][j][3]))));
            }
            s = wave_sum(s); am = wave_max(am);
            const float inv = am > 0.f ? 127.0f / am : 0.f;
#pragma unroll
            for (int j = 0; j < 4; ++j) xq[(size_t)(tb + u) * 256 + j * 64 + lane] = (unsigned)pack4_i8(v[u][j][0] * inv, v[u][j][1] * inv, v[u][j][2] * inv, v[u][j][3] * inv);
            if (lane == 0) { ss[tb + u] = s; rsx[tb + u] = am * (1.0f / 127.0f); }
        }
    }
}
__device__ __forceinline__ void quant_wrows(const Ctx& C, const f16* __restrict__ w, int rows, unsigned* __restrict__ q, float* __restrict__ scale) {
    const int lane = C.lane;
    for (int r = C.gw; r < rows; r += C.ngw) {
        const half8 a = *(const half8*)(w + (size_t)r * DM + 16 * lane), b = *(const half8*)(w + (size_t)r * DM + 16 * lane + 8);
        float m = 0.f;
#pragma unroll
        for (int i = 0; i < 8; ++i) m = fmaxf(m, fmaxf(fabsf((float)a[i]), fabsf((float)b[i])));
        m = wave_max(m);
        const float inv = m > 0.f ? 127.0f / m : 0.f;
        u32x4 o;
        o[0] = (unsigned)pack4_i8((float)a[0] * inv, (float)a[1] * inv, (float)a[2] * inv, (float)a[3] * inv);
        o[1] = (unsigned)pack4_i8((float)a[4] * inv, (float)a[5] * inv, (float)a[6] * inv, (float)a[7] * inv);
        o[2] = (unsigned)pack4_i8((float)b[0] * inv, (float)b[1] * inv, (float)b[2] * inv, (float)b[3] * inv);
        o[3] = (unsigned)pack4_i8((float)b[4] * inv, (float)b[5] * inv, (float)b[6] * inv, (float)b[7] * inv);
        *(u32x4*)(q + (size_t)r * 256 + 4 * lane) = o;
        if (lane == 0) scale[r] = m * (1.0f / 127.0f);
    }
}
__device__ __forceinline__ void ph_prep(const Ctx& C, LAS unsigned char* lds, const float* const* in, unsigned char* ws) {
    LAS float* scr = (LAS float*)(lds + RING_OFF + C.wave * 16384);
    f16* wcat = (f16*)(ws + WS_WCAT); f16* wb = (f16*)(ws + WS_WB); f16* wout = (f16*)(ws + WS_WOUT); f16* wq = (f16*)(ws + WS_WQ); f16* poolw = (f16*)(ws + WS_POOLW);
    constexpr int I_IN = 16 * 40, I_G = 16 * 64, I_B = 8 * 32, I_O = 16 * 32, I_Q = 16 * 64, I_P = 2 * 4;
    constexpr int NITEMS = I_IN + I_G + 2 * I_B + I_O + I_Q + 4 * I_P;
    for (int it = C.gw; it < NITEMS; it += C.ngw) {
        int r = it;
        if (r < I_IN) { p0_transpose_item(in[2], 1024, 1280, wcat, 1024, 0, scr, r, C.lane); continue; } r -= I_IN;
        if (r < I_G) { p0_transpose_item(in[7], 1024, 2048, wcat + (size_t)NQKVU * 1024, 1024, 0, scr, r, C.lane); continue; } r -= I_G;
        if (r < I_B) { p0_transpose_item(in[6], 512, 1024, wb, 1024, 0, scr, r, C.lane); continue; } r -= I_B;
        if (r < I_B) { p0_transpose_item(in[6] + 512 * 1024, 512, 1024, wb, 1024, 512, scr, r, C.lane); continue; } r -= I_B;
        if (r < I_O) { p0_transpose_item(in[9], 1024, 1024, wout, 1024, 0, scr, r, C.lane); continue; } r -= I_O;
        if (r < I_Q) { p0_transpose_item(in[11], 1024, 2048, wq, 1024, 0, scr, r, C.lane); continue; } r -= I_Q;
        { const int g = r / I_P; p0_transpose_item(in[4] + g * 128 * 128, 128, 128, poolw + g * 128 * 128, 128, 0, scr, r % I_P, C.lane); }
    }
    cvt_stream(C, in[12], (f16*)(ws + WS_SUBK), (size_t)8 * 2 * 128 * 128 / 4);
    rowprep(C, in[0], in[1], (unsigned*)(ws + WS_XH), (float*)(ws + WS_RSX), (float*)(ws + WS_RS1));
}

__device__ __forceinline__ void ph_attn_naive(const Ctx& C, const f16* __restrict__ qkvu, const float* __restrict__ sink, f16* __restrict__ ocat) {
    for (int gid = C.gt; gid < T * 8; gid += C.ngt) {
        const int t = gid % T, h = gid / T;
        const int b = t / SEQ, ts = t % SEQ, kh = h >> 2;
        float q[64], o[64];
        const f16* qr = qkvu + (size_t)t * NQKVU + h * 64;
#pragma unroll
        for (int d = 0; d < 64; ++d) { q[d] = (float)qr[d]; o[d] = 0.f; }
        const float slope = exp2f(-(float)(h + 1));
        float m = -1e30f, l = 0.f;
        const int s0 = max(ts - 128, 0), s1 = min(ts + 128, SEQ - 1);
        for (int s = s0; s <= s1; ++s) {
            const f16* kr = qkvu + (size_t)(b * SEQ + s) * NQKVU + COL_K + kh * 64;
            const f16* vr = qkvu + (size_t)(b * SEQ + s) * NQKVU + COL_V + kh * 64;
            float dot = 0.f;
#pragma unroll
            for (int d = 0; d < 64; ++d) dot += q[d] * (float)kr[d];
            const float lg = dot * 0.125f - slope * fabsf((float)(ts - s));
            const float mn = fmaxf(m, lg), al = __expf(m - mn), p = __expf(lg - mn);
            l = l * al + p;
#pragma unroll
            for (int d = 0; d < 64; ++d) o[d] = o[d] * al + p * (float)vr[d];
            m = mn;
        }
        const float sk = sink[h];
        const float mn = fmaxf(m, sk), al = __expf(m - mn);
        l = l * al + __expf(sk - mn);
        const float inv = al / l;
        f16* orow = ocat + (size_t)t * DM + h * 64;
#pragma unroll
        for (int d = 0; d < 64; ++d) orow[d] = (f16)(o[d] * inv);
    }
}

template <int DIAG = 0>
__device__ __forceinline__ void attn_unit(const Ctx& C, int u, LAS unsigned char* lds, const f16* __restrict__ qkvu, const f16* __restrict__ vT, const float* __restrict__ sink, f16* __restrict__ ocat) {
    const int lane = C.lane, r32 = lane & 31, hh = lane >> 5;
    const int krow = (r32 & 19) | ((r32 & 4) << 1) | ((r32 & 8) >> 1);
    constexpr float L2E = 1.4426950408889634f;
    {
        const int qs = u & 63, h = (u >> 6) & 7, b = u >> 9, kh = h >> 2;
        const int tq = qs * 32 + r32;
        const float slope2 = exp2f(-(float)(h + 1)) * L2E, sink2 = sink[h] * L2E;
        const f16* qrow = qkvu + (size_t)(b * SEQ + tq) * NQKVU + h * 64 + 8 * hh;
        half8 bq[4];
#pragma unroll
        for (int ks = 0; ks < 4; ++ks) bq[ks] = *(const half8*)(qrow + 16 * ks);
        f32x16 o0, o1;
#pragma unroll
        for (int r = 0; r < 16; ++r) { o0[r] = 0.f; o1[r] = 0.f; }
        float m = -1e30f, l = 0.f;
        const int kb_lo = max(qs - 4, 0), kb_hi = min(qs + 4, 63);
        LAS unsigned char* kst = lds + 65536 + C.wave * 8192; LAS unsigned char* vst = kst + 4096;
        const int krw = lane >> 3, kch = lane & 7, vrw = lane >> 2, vch = lane & 3;
        const f16* kg = qkvu + (size_t)(b * SEQ + krw) * NQKVU + COL_K + kh * 64 + kch * 8;
        const f16* vg = vT + (size_t)((b * 2 + kh) * 64 + vrw) * SEQ + vch * 8;
        half8 gk[4], gv[4];
#pragma unroll
        for (int i = 0; i < 4; ++i) { gk[i] = *(const half8*)(kg + (size_t)(kb_lo * 32 + 8 * i) * NQKVU); gv[i] = *(const half8*)(vg + (size_t)(16 * i) * SEQ + kb_lo * 32); }
#pragma unroll 1
        for (int kb = kb_lo; kb <= kb_hi; ++kb) {
#pragma unroll
            for (int i = 0; i < 4; ++i) {
                const int kr = krw + 8 * i; *(LAS half8*)(kst + kr * 128 + ((kch ^ (kr & 7)) << 4)) = gk[i];
                const int vr = vrw + 16 * i; *(LAS half8*)(vst + vr * 64 + ((vch ^ ((vr >> 2) & 3)) << 4)) = gv[i];
            }
            LDS_WAIT();
            half8 kf[4], va[2][2];
#pragma unroll
            for (int ks = 0; ks < 4; ++ks) kf[ks] = *(const LAS half8*)(kst + krow * 128 + (((2 * ks + hh) ^ (krow & 7)) << 4));
#pragma unroll
            for (int db = 0; db < 2; ++db)
#pragma unroll
                for (int st = 0; st < 2; ++st) { const int d = db * 32 + r32; va[db][st] = *(const LAS half8*)(vst + d * 64 + (((2 * st + hh) ^ ((d >> 2) & 3)) << 4)); }
            LDS_WAIT();
            const int kn = (DIAG == 2) ? kb_lo : (kb < kb_hi ? kb + 1 : kb);
#pragma unroll
            for (int i = 0; i < 4; ++i) { gk[i] = *(const half8*)(kg + (size_t)(kn * 32 + 8 * i) * NQKVU); gv[i] = *(const half8*)(vg + (size_t)(16 * i) * SEQ + kn * 32); }
            f32x16 s;
#pragma unroll
            for (int r = 0; r < 16; ++r) s[r] = 0.f;
#pragma unroll
            for (int ks = 0; ks < 4; ++ks) s = __builtin_amdgcn_mfma_f32_32x32x16_f16(kf[ks], bq[ks], s, 0, 0, 0);
            float bmax = -1e30f; bool ok[16];
#pragma unroll
            for (int r = 0; r < 16; ++r) {
                const int tk = kb * 32 + 16 * (r >> 3) + 8 * hh + (r & 7);
                const int dist = abs(tq - tk);
                ok[r] = dist <= 128;
                s[r] = ok[r] ? s[r] * (0.125f * L2E) - slope2 * (float)dist : -1e30f;
                bmax = fmaxf(bmax, s[r]);
            }
            bmax = fmaxf(bmax, __shfl_xor(bmax, 32));
            const float mn = fmaxf(m, bmax), al = exp2f(m - mn);
            m = mn;
            float ps = 0.f; half8 pb[2];
#pragma unroll
            for (int r = 0; r < 16; ++r) { const float p = ok[r] ? (DIAG == 1 ? (s[r] - mn) : exp2f(s[r] - mn)) : 0.f; ps += p; pb[r >> 3][r & 7] = (f16)p; }
            l = l * al + ps;
#pragma unroll
            for (int r = 0; r < 16; ++r) { o0[r] *= al; o1[r] *= al; }
#pragma unroll
            for (int st = 0; st < 2; ++st) { o0 = __builtin_amdgcn_mfma_f32_32x32x16_f16(va[0][st], pb[st], o0, 0, 0, 0); o1 = __builtin_amdgcn_mfma_f32_32x32x16_f16(va[1][st], pb[st], o1, 0, 0, 0); }
        }
        l += __shfl_xor(l, 32);
        const float mf = fmaxf(m, sink2), al = exp2f(m - mf);
        const float sc = al / (l * al + exp2f(sink2 - mf));
        f16* orow = ocat + (size_t)(b * SEQ + tq) * DM + h * 64 + 4 * hh;
#pragma unroll
        for (int g = 0; g < 4; ++g) {
            half4 a, c;
#pragma unroll
            for (int i = 0; i < 4; ++i) { a[i] = (f16)(o0[4 * g + i] * sc); c[i] = (f16)(o1[4 * g + i] * sc); }
            *(half4*)(orow + 8 * g) = a; *(half4*)(orow + 32 + 8 * g) = c;
        }
    }
}

__device__ __forceinline__ void attn_unit2(const Ctx& C, int u, LAS unsigned char* lds, const f16* __restrict__ qkvu, const f16* __restrict__ vT, const float* __restrict__ sink, f16* __restrict__ ocat) {
    const int lane = C.lane, r32 = lane & 31, hh = lane >> 5;
    const int krow = (r32 & 19) | ((r32 & 4) << 1) | ((r32 & 8) >> 1);
    constexpr float L2E = 1.4426950408889634f;
    const int qp = u & 31, h = (u >> 5) & 7, b = u >> 8, kh = h >> 2;
    const float slope2 = exp2f(-(float)(h + 1)) * L2E, sink2 = sink[h] * L2E;
    const float bbase = slope2 * (float)(r32 - 8 * hh);
    constexpr float THR = 6.0f;
    LAS unsigned char* qst = lds + 65536 + C.wave * 8192 + lane * 16;
    f32x16 o0[2], o1[2]; float m[2], l[2]; int tq[2];
#pragma unroll
    for (int j = 0; j < 2; ++j) {
        tq[j] = (2 * qp + j) * 32 + r32;
        const f16* qrow = qkvu + (size_t)(b * SEQ + tq[j]) * NQKVU + h * 64 + 8 * hh;
#pragma unroll
        for (int ks = 0; ks < 4; ++ks) *(LAS half8*)(qst + (j * 4 + ks) * 1024) = *(const half8*)(qrow + 16 * ks);
#pragma unroll
        for (int r = 0; r < 16; ++r) { o0[j][r] = 0.f; o1[j][r] = 0.f; }
        m[j] = -1e30f; l[j] = 0.f;
    }
    const int kb_lo = max(2 * qp - 4, 0), kb_hi = min(2 * qp + 5, 63);
    LAS unsigned char* kst = lds + C.wave * 8192;
    const int krw = lane >> 3, kch = lane & 7;
    const f16* kg = qkvu + (size_t)(b * SEQ + krw) * NQKVU + COL_K + kh * 64 + kch * 8;
    const f16* vbase = vT + (size_t)((b * 2 + kh) * 64 + r32) * SEQ + 8 * hh;
    half8 gk[4];
#pragma unroll
    for (int i = 0; i < 4; ++i) gk[i] = *(const half8*)(kg + (size_t)(kb_lo * 32 + 8 * i) * NQKVU);
#pragma unroll 1
    for (int kb = kb_lo; kb <= kb_hi; ++kb) {
        half8 kf[4], va[2][2];
#pragma unroll
        for (int db = 0; db < 2; ++db)
#pragma unroll
            for (int st = 0; st < 2; ++st) va[db][st] = *(const half8*)(vbase + (size_t)(db * 32) * SEQ + kb * 32 + 16 * st);
#pragma unroll
        for (int i = 0; i < 4; ++i) { const int kr = krw + 8 * i; *(LAS half8*)(kst + kr * 128 + ((kch ^ (kr & 7)) << 4)) = gk[i]; }
        LDS_WAIT();
#pragma unroll
        for (int ks = 0; ks < 4; ++ks) kf[ks] = *(const LAS half8*)(kst + krow * 128 + (((2 * ks + hh) ^ (krow & 7)) << 4));
        LDS_WAIT();
        const int kn = kb < kb_hi ? kb + 1 : kb;
#pragma unroll
        for (int i = 0; i < 4; ++i) gk[i] = *(const half8*)(kg + (size_t)(kn * 32 + 8 * i) * NQKVU);
#pragma unroll
        for (int j = 0; j < 2; ++j) {
            if (abs(kb - (2 * qp + j)) > 4) continue;
            const int D = (2 * qp + j) - kb;
            f32x16 s;
#pragma unroll
            for (int r = 0; r < 16; ++r) s[r] = 0.f;
#pragma unroll
            for (int ks = 0; ks < 4; ++ks) s = __builtin_amdgcn_mfma_f32_32x32x16_f16(kf[ks], *(const volatile LAS half8*)(qst + (j * 4 + ks) * 1024), s, 0, 0, 0);
            const float B = slope2 * 32.0f * (float)abs(D);
            float bm = -1e30f;
            if (D != 0) {
                const float ssl = D > 0 ? slope2 : -slope2, sb = D > 0 ? -bbase : bbase;
#pragma unroll
                for (int r = 0; r < 16; ++r) { const float bias = fmaf(ssl, (float)(16 * (r >> 3) + (r & 7)), sb); s[r] = fmaf(s[r], 0.125f * L2E, bias);
                    if (abs(D) == 4) s[r] = bias < -0.5f * slope2 ? -1e30f : s[r]; }
            } else {
#pragma unroll
                for (int r = 0; r < 16; ++r) s[r] = fmaf(s[r], 0.125f * L2E, -fabsf(fmaf(-slope2, (float)(16 * (r >> 3) + (r & 7)), bbase)));
            }
#pragma unroll
            for (int r = 0; r < 16; ++r) bm = fmaxf(bm, s[r]);
            bm = fmaxf(bm, __shfl_xor(bm, 32)) - B;
            {
                const float mn = (bm > m[j] + THR) ? bm : m[j], al = __builtin_amdgcn_exp2f(m[j] - mn);
                m[j] = mn; l[j] *= al;
#pragma unroll
                for (int r = 0; r < 16; ++r) { o0[j][r] *= al; o1[j][r] *= al; }
            }
            const float mb = m[j] + B;
            float ps = 0.f; half8 pb[2];
#pragma unroll
            for (int r = 0; r < 16; ++r) { const float pv = __builtin_amdgcn_exp2f(s[r] - mb); ps += pv; pb[r >> 3][r & 7] = (f16)pv; }
            l[j] += ps;
#pragma unroll
            for (int st = 0; st < 2; ++st) { o0[j] = __builtin_amdgcn_mfma_f32_32x32x16_f16(va[0][st], pb[st], o0[j], 0, 0, 0); o1[j] = __builtin_amdgcn_mfma_f32_32x32x16_f16(va[1][st], pb[st], o1[j], 0, 0, 0); }
            __builtin_amdgcn_sched_barrier(0);
        }
    }
#pragma unroll
    for (int j = 0; j < 2; ++j) {
        const float lt = l[j] + __shfl_xor(l[j], 32);
        const float mf = fmaxf(m[j], sink2), al = __builtin_amdgcn_exp2f(m[j] - mf);
        const float sc = al / (lt * al + __builtin_amdgcn_exp2f(sink2 - mf));
        LDS_WAIT();
#pragma unroll
        for (int g = 0; g < 4; ++g) {
            half4 a, c;
#pragma unroll
            for (int i = 0; i < 4; ++i) { a[i] = (f16)(o0[j][4 * g + i] * sc); c[i] = (f16)(o1[j][4 * g + i] * sc); }
            *(LAS half4*)(kst + r32 * 128 + ((g ^ (r32 & 7)) << 4) + 8 * hh) = a;
            *(LAS half4*)(kst + r32 * 128 + (((4 + g) ^ (r32 & 7)) << 4) + 8 * hh) = c;
        }
        LDS_WAIT();
#pragma unroll
        for (int i = 0; i < 4; ++i) {
            const int row = (lane >> 3) + 8 * i, ch = lane & 7;
            const half8 v = *(const LAS half8*)(kst + row * 128 + ((ch ^ (row & 7)) << 4));
            *(half8*)(ocat + (size_t)(b * SEQ + (2 * qp + j) * 32 + row) * DM + h * 64 + ch * 8) = v;
        }
    }
}

__device__ __forceinline__ void ph_pool_naive(const Ctx& C, const f16* __restrict__ qkvu, f16* __restrict__ mixed) {
    for (size_t gid = (size_t)C.gt; gid < (size_t)T * 512; gid += (size_t)C.ngt) {
        const int c = (int)(gid & 511), t = (int)(gid >> 9);
        const int b = t / SEQ, ts = t % SEQ, g = c >> 7, w = 2 << g;
        const int lo = max(ts - w / 2, 0), hi = min(ts + w / 2, SEQ);
        float s = 0.f;
        for (int i = lo; i < hi; ++i) s += (float)qkvu[(size_t)(b * SEQ + i) * NQKVU + COL_U + c];
        const float mean = s / (float)(hi - lo);
        mixed[(size_t)t * 512 + c] = (f16)(mean - (float)qkvu[(size_t)t * NQKVU + COL_U + c]);
    }
}
__device__ __forceinline__ void ph_poolmm_naive(const Ctx& C, const f16* __restrict__ mixed, const f16* __restrict__ poolw_t, const float* __restrict__ pscale, f16* __restrict__ ocat) {
    for (size_t gid = (size_t)C.gt; gid < (size_t)T * 512; gid += (size_t)C.ngt) {
        const int n = (int)(gid & 511), t = (int)(gid >> 9), g = n >> 7, d = n & 127;
        const f16* mr = mixed + (size_t)t * 512 + g * 128;
        const f16* wr = poolw_t + (size_t)(g * 128 + d) * 128;
        float acc = 0.f;
        for (int c = 0; c < 128; ++c) acc += (float)mr[c] * (float)wr[c];
        ocat[(size_t)t * DM + 512 + n] = (f16)(acc * pscale[n]);
    }
}

template <int HW>
__device__ __forceinline__ void pool_step1(const f16* __restrict__ qkvu, LAS unsigned char* tile, int t0, int g, int lane) {
    const int c2 = lane, b = t0 >> 11, sf = t0 & (SEQ - 1);
    const f16* ub = qkvu + (size_t)(b * SEQ) * NQKVU + COL_U + g * 128 + 2 * c2;
    constexpr int NR = 32 + 2 * HW - 1;
    half2 v[NR];
#pragma unroll
    for (int i = 0; i < NR; ++i) { const int s = sf - HW + i; half2 z; z[0] = (f16)0.f; z[1] = (f16)0.f; v[i] = z; if (s >= 0 && s < SEQ) v[i] = *(const half2*)(ub + (size_t)s * NQKVU); }
    float s0 = 0.f, s1 = 0.f;
#pragma unroll
    for (int i = 0; i < 2 * HW - 1; ++i) { s0 += (float)v[i][0]; s1 += (float)v[i][1]; }
#pragma unroll
    for (int j = 0; j < 32; ++j) {
        s0 += (float)v[j + 2 * HW - 1][0]; s1 += (float)v[j + 2 * HW - 1][1];
        const int s = sf + j, lo = max(s - HW, 0), hi = min(s + HW, SEQ);
        const float inv = 1.0f / (float)(hi - lo);
        half2 mx; mx[0] = (f16)(s0 * inv - (float)v[j + HW][0]); mx[1] = (f16)(s1 * inv - (float)v[j + HW][1]);
        *(LAS half2*)(tile + j * 256 + (((c2 >> 2) ^ (j & 15)) << 4) + ((c2 & 3) << 2)) = mx;
        s0 -= (float)v[j][0]; s1 -= (float)v[j][1];
    }
}
__device__ __forceinline__ void pool_unit(const Ctx& C, int u, LAS unsigned char* lds, const f16* __restrict__ qkvu, const f16* __restrict__ poolw_t, const float* __restrict__ pscale, f16* __restrict__ ocat) {
    const int lane = C.lane, r32 = lane & 31, hh = lane >> 5;
    LAS unsigned char* tile = lds + C.wave * 8192;
    const int g = u & 3, t0 = (u >> 2) * 32;
    switch (g) { case 0: pool_step1<1>(qkvu, tile, t0, g, lane); break; case 1: pool_step1<2>(qkvu, tile, t0, g, lane); break;
                 case 2: pool_step1<4>(qkvu, tile, t0, g, lane); break; default: pool_step1<8>(qkvu, tile, t0, g, lane); break; }
    LDS_WAIT();
    f32x16 acc[4];
#pragma unroll
    for (int db = 0; db < 4; ++db)
#pragma unroll
        for (int r = 0; r < 16; ++r) acc[db][r] = 0.f;
    const f16* wr = poolw_t + (size_t)(g * 128 + r32) * 128 + 8 * hh;
#pragma unroll
    for (int ks = 0; ks < 8; ++ks) {
        const half8 bm = *(const LAS half8*)(tile + r32 * 256 + (((2 * ks + hh) ^ (r32 & 15)) << 4));
#pragma unroll
        for (int db = 0; db < 4; ++db) { const half8 a = *(const half8*)(wr + (size_t)(db * 32) * 128 + 16 * ks); acc[db] = __builtin_amdgcn_mfma_f32_32x32x16_f16(a, bm, acc[db], 0, 0, 0); }
    }
    LDS_WAIT();
    f16* orow = ocat + (size_t)(t0 + r32) * DM + 512 + g * 128 + 4 * hh;
    const float* ps = pscale + g * 128 + 4 * hh;
#pragma unroll
    for (int db = 0; db < 4; ++db)
#pragma unroll
        for (int q = 0; q < 4; ++q) {
            const f32x4 pv = *(const f32x4*)(ps + db * 32 + 8 * q);
            half4 x0;
#pragma unroll
            for (int i = 0; i < 4; ++i) x0[i] = (f16)(acc[db][4 * q + i] * pv[i]);
            *(half4*)(orow + db * 32 + 8 * q) = x0;
        }
}
__device__ __forceinline__ void ph_attn_pool(const Ctx& C, LAS unsigned char* lds, const f16* __restrict__ qkvu, const f16* __restrict__ vT, const float* __restrict__ sink,
                                             const f16* __restrict__ poolw_t, const float* __restrict__ pscale, f16* __restrict__ ocat) {
    const int vwg = (C.G % 8 == 0) ? (int)(blockIdx.x % 8) * (C.G / 8) + (int)(blockIdx.x / 8) : (int)blockIdx.x;
    const bool pool_first = (C.wave & 4) != 0;
    for (int i = 0, m = vwg * NWAVES + C.wave; m < (T / 32) * 4; ++i) {
        if (((i & 1) == 0) == pool_first) pool_unit(C, m, lds, qkvu, poolw_t, pscale, ocat);
        else attn_unit2(C, m, lds, qkvu, vT, sink, ocat);
        if (i & 1) m += C.ngw;
    }
}

#define INS(LV, LI, v_, i_) do { float cv_ = (v_); int ci_ = (i_); \
    _Pragma("unroll") for (int z_ = 0; z_ < 16; ++z_) { const bool gt_ = cv_ > LV[z_]; const float tv_ = gt_ ? LV[z_] : cv_; const int ti_ = gt_ ? LI[z_] : ci_; \
        LV[z_] = gt_ ? cv_ : LV[z_]; LI[z_] = gt_ ? ci_ : LI[z_]; cv_ = tv_; ci_ = ti_; } } while (0)
__device__ __forceinline__ void ph_route_naive(const Ctx& C, const f16* __restrict__ qp, const float* __restrict__ ss2, const f16* __restrict__ subk, int* __restrict__ eidx, float* __restrict__ egate) {
    for (int gid = C.gt; gid < T * 8; gid += C.ngt) {
        const int t = gid % T, h = gid / T;
        const float rs2 = rs_from_ss(ss2, t);
        float av[16], bv[16]; int ai[16], bi[16];
#pragma unroll
        for (int z = 0; z < 16; ++z) { av[z] = -3e38f; bv[z] = -3e38f; ai[z] = 0; bi[z] = 0; }
        for (int p = 0; p < 2; ++p) {
            const f16* qr = qp + (size_t)t * 2048 + h * 256 + p * 128;
            for (int n = 0; n < 128; ++n) {
                const f16* kr = subk + ((size_t)((h * 2 + p) * 128 + n)) * 128;
                float dot = 0.f;
                for (int c = 0; c < 128; ++c) dot += (float)qr[c] * (float)kr[c];
                dot *= rs2;
                if (p == 0) INS(av, ai, dot, n); else INS(bv, bi, dot, n);
            }
        }
        float cv[16]; int ci[16];
#pragma unroll
        for (int z = 0; z < 16; ++z) { cv[z] = -3e38f; ci[z] = 0; }
#pragma unroll
        for (int i = 0; i < 16; ++i)
#pragma unroll
            for (int j = 0; j < 16; ++j)
                if ((i + 1) * (j + 1) <= 16) INS(cv, ci, av[i] + bv[j], ai[i] * 128 + bi[j]);
        float sum = 0.f, e[16];
#pragma unroll
        for (int z = 0; z < 16; ++z) { e[z] = __expf(cv[z] - cv[0]); sum += e[z]; }
        const float inv = 1.0f / sum;
#pragma unroll
        for (int z = 0; z < 16; ++z) { eidx[(size_t)t * 128 + h * 16 + z] = ci[z]; egate[(size_t)t * 128 + h * 16 + z] = e[z] * inv; }
    }
}

__device__ __forceinline__ int mono_i(float f) { const int b = __float_as_int(f); return b ^ ((b >> 31) & 0x7fffffff); }
__device__ __forceinline__ float unmono_f(int m) { return __int_as_float(m ^ ((m >> 31) & 0x7fffffff)); }
#define INS16(Lst, x_) do { int xv_ = (x_); _Pragma("unroll") for (int z_ = 0; z_ < 16; ++z_) { const int hi_ = max(Lst[z_], xv_); xv_ = min(Lst[z_], xv_); Lst[z_] = hi_; } } while (0)
__device__ __forceinline__ void merge_pair16(int (&Lst)[16]) {
    int P[16];
#pragma unroll
    for (int z = 0; z < 16; ++z) P[z] = __shfl_xor(Lst[z], 32);
#pragma unroll
    for (int z = 0; z < 16; ++z) Lst[z] = max(Lst[z], P[15 - z]);
#pragma unroll
    for (int s = 8; s >= 1; s >>= 1)
#pragma unroll
        for (int i = 0; i < 16; ++i) if ((i & s) == 0) { const int hi = max(Lst[i], Lst[i + s]), lo = min(Lst[i], Lst[i + s]); Lst[i] = hi; Lst[i + s] = lo; }
}
__device__ __forceinline__ void bitonic_sort16_desc(int (&K)[16]) {
#pragma unroll
    for (int k = 2; k <= 16; k <<= 1)
#pragma unroll
        for (int j = k >> 1; j > 0; j >>= 1)
#pragma unroll
            for (int i = 0; i < 16; ++i) { const int l = i ^ j; if (l > i) { const int a = K[i], b = K[l], hi = max(a, b), lo = min(a, b); const bool desc = (i & k) == 0; K[i] = desc ? hi : lo; K[l] = desc ? lo : hi; } }
}
__device__ __forceinline__ void bitonic_merge16_desc(int (&K)[16]) {
#pragma unroll
    for (int s = 8; s >= 1; s >>= 1)
#pragma unroll
        for (int i = 0; i < 16; ++i) if ((i & s) == 0) { const int hi = max(K[i], K[i + s]), lo = min(K[i], K[i + s]); K[i] = hi; K[i + s] = lo; }
}
template <class Side>
__device__ __forceinline__ void ph_route(const Ctx& C, LAS unsigned char* lds, const f16* __restrict__ qp, const float* __restrict__ ss2, const f16* __restrict__ subk,
                                         int* __restrict__ eidx, float* __restrict__ egate, const Side& side_job) {
    const int lane = C.lane, r32 = lane & 31, hh = lane >> 5;
    LAS unsigned char* tab = lds + 65536 + C.wave * 4096 + lane * 36;
    const int GH = C.G < 8 ? C.G : 8;
  for (int h = blockIdx.x % GH; h < 8; h += GH) {
    const int rank_h = blockIdx.x / GH, nwg_h = (C.G - (blockIdx.x % GH) + GH - 1) / GH;
    __syncthreads();
    for (int i = C.tid; i < 2 * 128 * 16; i += NTHREADS) {
        const int row = i >> 4, ch = i & 15;
        *(LAS half8*)(lds + row * 256 + ((ch ^ (row & 15)) << 4)) = *(const half8*)(subk + (size_t)(h * 256 + row) * 128 + ch * 8);
    }
    __syncthreads();
    if (h == (int)(blockIdx.x % GH) && (C.wave & 4)) side_job();
    for (int tb = rank_h * NWAVES + C.wave; tb < T / 32; tb += nwg_h * NWAVES) {
        const int t0 = tb * 32, t = t0 + r32;
        int top[2][16];
#pragma unroll
        for (int p = 0; p < 2; ++p) {
            const unsigned char* qbase = (const unsigned char*)qp + (size_t)(((t0 >> 8) * 8 + h) * 8 + ((t0 >> 6) & 1) * 4) * 16384
                                       + ((((t0 >> 7) & 1) * 4 + ((t0 >> 4) & 3) + (r32 >> 4)) * 2 + p) * 1024 + (hh * 16 + (r32 & 15)) * 16;
            const LAS unsigned char* kl = lds + (p * 128 + r32) * 256;
            half8 bq[8];
#pragma unroll
            for (int ks = 0; ks < 8; ++ks) bq[ks] = *(const half8*)(qbase + (ks >> 1) * 16384 + (ks & 1) * 512);
            int Lst[16];
#pragma unroll
            for (int z = 0; z < 16; ++z) Lst[z] = (int)0x80000000;
#pragma unroll 1
            for (int nb = 0; nb < 4; ++nb) {
                f32x16 acc = {0.f, 0.f, 0.f, 0.f, 0.f, 0.f, 0.f, 0.f, 0.f, 0.f, 0.f, 0.f, 0.f, 0.f, 0.f, 0.f};
#pragma unroll
                for (int ks = 0; ks < 8; ++ks) {
                    const half8 ak = *(const LAS half8*)(kl + nb * 32 * 256 + (((2 * ks + hh) ^ (r32 & 15)) << 4));
                    acc = __builtin_amdgcn_mfma_f32_32x32x16_f16(ak, bq[ks], acc, 0, 0, 0);
                }
                int K[16];
#pragma unroll
                for (int r = 0; r < 16; ++r) { const int n = nb * 32 + (r & 3) + 8 * (r >> 2) + 4 * hh; K[r] = (mono_i(acc[r]) & ~127) | (127 - n); }
                bitonic_sort16_desc(K);
#pragma unroll
                for (int z = 0; z < 16; ++z) Lst[z] = max(Lst[z], K[15 - z]);
                bitonic_merge16_desc(Lst);
            }
            merge_pair16(Lst);
#pragma unroll
            for (int z = 0; z < 16; ++z) top[p][z] = Lst[z];
        }
        float va[16], vb[16];
#pragma unroll
        for (int z = 0; z < 16; ++z) { va[z] = unmono_f(top[0][z] & ~127); vb[z] = unmono_f(top[1][z] & ~127);
            tab[z] = (unsigned char)(127 - (top[0][z] & 127)); tab[16 + z] = (unsigned char)(127 - (top[1][z] & 127)); }
        int Cl[16];
        { const float a01 = hh ? va[1] : va[0];
#pragma unroll
          for (int j = 0; j < 16; ++j) { const int key = (mono_i(a01 + vb[j]) & ~255) | (255 - (hh * 16 + j)); Cl[j] = (hh && j >= 8) ? (int)0x80000000 : key; } }
#pragma unroll
        for (int i = 2; i < 16; i += 2) {
            const float ai = hh ? va[i + 1] : va[i];
#pragma unroll
            for (int j = 0; j < 16; ++j)
                if ((i + 1) * (j + 1) <= 16) {
                    int key = (mono_i(ai + vb[j]) & ~255) | (255 - ((i + hh) * 16 + j));
                    if ((i + 2) * (j + 1) > 16) key = hh ? (int)0x80000000 : key;
                    INS16(Cl, key);
                }
        }
        merge_pair16(Cl);
        float e[16], sum = 0.f; const float mx = unmono_f(Cl[0] & ~255);
#pragma unroll
        for (int z = 0; z < 16; ++z) { e[z] = __expf(unmono_f(Cl[z] & ~255) - mx); sum += e[z]; }
        const float inv = 1.0f / sum;
        LDS_WAIT();
        int* ei = eidx + (size_t)t * 128 + h * 16 + 8 * hh; float* eg = egate + (size_t)t * 128 + h * 16 + 8 * hh;
#pragma unroll
        for (int z = 0; z < 16; ++z) {
            if ((z >> 3) == hh) { const int code = 255 - (Cl[z] & 255); const int ia = tab[code >> 4], ib = tab[16 + (code & 15)];
                ei[z & 7] = ia * 128 + ib; eg[z & 7] = e[z] * inv; }
        }
        LDS_WAIT();
    }
  }
}

struct Slicing { int m, pi, nloc, rank; };
__device__ __forceinline__ Slicing get_slicing(const unsigned* bar, volatile LAS unsigned* misc) {
    Slicing S; const unsigned x = (unsigned)__builtin_amdgcn_s_getreg((3 << 11) | 20) & 0xFu;
    int m = 0, pi = 0, nloc = 1;
    for (unsigned j = 0; j < 16; ++j) { const unsigned c = __hip_atomic_load(&bar[256 + 64 * j], __ATOMIC_RELAXED, __HIP_MEMORY_SCOPE_AGENT); if (c > 0u) { if (j < x) ++pi; ++m; } if (j == x) nloc = (int)c; }
    S.m = m > 0 ? m : 1; S.pi = pi; S.nloc = nloc > 0 ? nloc : 1; S.rank = (int)misc[10];
    return S;
}
__device__ __forceinline__ float gelu_fast(float v) {
    const float av = fabsf(v), t = __builtin_amdgcn_rcpf(av * 0.2316418882f + 1.0f);
    float q = t * 0.5307027145f + (-0.7265760135f); q = q * t + 0.7107068705f; q = q * t + (-0.142248368f); q = q * t + 0.127414796f; q = q * t;
    const float m = v * (q * __builtin_amdgcn_exp2f((v * v) * (-0.72134752044f)));
    return v < 0.f ? m : v - m;
}
__device__ __forceinline__ void ph_h2quant(const Ctx& C, const f16* __restrict__ x1h, const float* __restrict__ g2, const float* __restrict__ ss2, unsigned* __restrict__ h2q, float* __restrict__ hsc) {
    const int lane = C.lane;
    f32x4 gv[4];
#pragma unroll
    for (int j = 0; j < 4; ++j) gv[j] = *(const f32x4*)(g2 + 16 * lane + 4 * j);
    for (int tb = C.gw * 4; tb < T; tb += C.ngw * 4) {
        half8 h0[4], h1[4]; float rs[4];
#pragma unroll
        for (int u = 0; u < 4; ++u) { h0[u] = *(const half8*)(x1h + (size_t)(tb + u) * DM + 16 * lane); h1[u] = *(const half8*)(x1h + (size_t)(tb + u) * DM + 16 * lane + 8); rs[u] = rs_from_ss(ss2, tb + u); }
#pragma unroll
        for (int u = 0; u < 4; ++u) {
            float f[16]; float hm = 0.f;
#pragma unroll
            for (int i = 0; i < 8; ++i) { f[i] = (float)h0[u][i] * gv[i >> 2][i & 3]; f[8 + i] = (float)h1[u][i] * gv[2 + (i >> 2)][i & 3]; hm = fmaxf(hm, fmaxf(fabsf(f[i]), fabsf(f[8 + i]))); }
            hm = wave_max(hm);
            const float inv = hm > 0.f ? 127.0f / hm : 0.f;
            u32x4 w;
#pragma unroll
            for (int j = 0; j < 4; ++j) w[j] = (unsigned)pack4_i8(f[4 * j] * inv, f[4 * j + 1] * inv, f[4 * j + 2] * inv, f[4 * j + 3] * inv);
            *(u32x4*)(h2q + (size_t)(tb + u) * 256 + 4 * lane) = w;
            if (lane == 0) hsc[tb + u] = hm * (1.0f / 127.0f) * rs[u];
        }
    }
}
__device__ __forceinline__ __amdgpu_buffer_rsrc_t slice_rsrc(const unsigned char* base) {
    const unsigned long long b = (unsigned long long)base;
    const unsigned lo = __builtin_amdgcn_readfirstlane((unsigned)b), hi = __builtin_amdgcn_readfirstlane((unsigned)(b >> 32));
    return __builtin_amdgcn_make_buffer_rsrc((void*)(((unsigned long long)hi << 32) | lo), 0, NEXP * 128, 0x00020000);
}
template <int EMASK>
__device__ __forceinline__ void ph_upeer(const Ctx& C, LAS unsigned char* lds, const Slicing SL, const unsigned* __restrict__ h2q, const int* __restrict__ eidx,
                                         const unsigned char* __restrict__ uq, short* __restrict__ pdot) {
    const int lane = C.lane, grp = lane >> 3, c8 = lane & 7;
    const int wv = SL.rank * NWAVES + C.wave, nwv = SL.nloc * NWAVES;
    const int ntok = (T - wv + nwv - 1) / nwv;
    auto tok = [&](int i) { const int t = wv + i * nwv; return t < T ? t : T - 1; };
    volatile LAS int* row = (volatile LAS int*)(lds + C.wave * 1024);
  for (int s = SL.pi; s < 8; s += SL.m) {
    const __amdgpu_buffer_rsrc_t urs = slice_rsrc(uq + (size_t)s * (NEXP * 128));
    const unsigned* hqs = h2q + s * 32 + c8 * 4;
    int tA = tok(0), tB = tok(1);
    int e0 = eidx[(size_t)tA * 128 + lane], e1 = eidx[(size_t)tA * 128 + 64 + lane];
    u32x4 hq = *(const u32x4*)(hqs + (size_t)tA * 256);
    int ne0 = eidx[(size_t)tB * 128 + lane], ne1 = eidx[(size_t)tB * 128 + 64 + lane];
    u32x4 r[16];
#pragma unroll
    for (int i = 0; i < 16; ++i) { const int e = __shfl(i < 8 ? e0 : e1, 8 * (i & 7) + grp) & EMASK; r[i] = __builtin_amdgcn_raw_buffer_load_b128(urs, e * 128 + c8 * 16, 0, 0); }
#pragma unroll 1
    for (int it = 0; it < ntok; ++it) {
        const int t = tok(it), t1 = tok(it + 1), t2 = tok(it + 2);
        const int ze0 = eidx[(size_t)t2 * 128 + lane], ze1 = eidx[(size_t)t2 * 128 + 64 + lane];
        const u32x4 nhq = *(const u32x4*)(hqs + (size_t)t1 * 256);
#pragma unroll
        for (int q = 0; q < 4; ++q) {
            int evv[4];
#pragma unroll
            for (int j = 0; j < 4; ++j) evv[j] = __shfl(q < 2 ? ne0 : ne1, 32 * (q & 1) + 8 * j + grp) & EMASK;
            int pa[4], pb[4];
#pragma unroll
            for (int j = 0; j < 4; ++j) {
                pa[j] = __builtin_amdgcn_sdot4((int)r[4 * q + j][0], (int)hq[0], 0, false); pb[j] = __builtin_amdgcn_sdot4((int)r[4 * q + j][1], (int)hq[1], 0, false);
                pa[j] = __builtin_amdgcn_sdot4((int)r[4 * q + j][2], (int)hq[2], pa[j], false); pb[j] = __builtin_amdgcn_sdot4((int)r[4 * q + j][3], (int)hq[3], pb[j], false);
            }
#pragma unroll
            for (int j = 0; j < 4; ++j) { pa[j] += pb[j]; pa[j] += dppi<0xB1>(pa[j]); }
#pragma unroll
            for (int j = 0; j < 4; ++j) pa[j] += dppi<0x4E>(pa[j]);
#pragma unroll
            for (int j = 0; j < 4; ++j) pa[j] += dppi<0x141>(pa[j]);
            if (c8 == 0) {
#pragma unroll
                for (int j = 0; j < 4; ++j) row[8 * (4 * q + j) + grp] = pa[j];
            }
#pragma unroll
            for (int j = 0; j < 4; ++j) {
                asm volatile("" ::: "memory");
                r[4 * q + j] = __builtin_amdgcn_raw_buffer_load_b128(urs, evv[j] * 128 + c8 * 16, 0, 0);
                asm volatile("" ::: "memory");
            }
        }
        LDS_WAIT();
        const int p0 = row[lane], p1 = row[64 + lane];
        LDS_WAIT();
        { short* pp = pdot + ((size_t)s * T + t) * 128 + lane; const int c0 = min(max((p0 + 4) >> 3, -32768), 32767), c1 = min(max((p1 + 4) >> 3, -32768), 32767);
          asm volatile("global_store_short %0, %1, off\n\tglobal_store_short %0, %2, off offset:128" :: "v"(pp), "v"(c0), "v"(c1) : "memory"); }
        hq = nhq; ne0 = ze0; ne1 = ze1;
    }
  }
}
__device__ __forceinline__ void ph_ureduce(const Ctx& C, LAS unsigned char* lds, const short* __restrict__ pdot, const float* __restrict__ hsc, const int* __restrict__ eidx, const float* __restrict__ us,
                                           const float* __restrict__ vs, const float* __restrict__ egate, unsigned* __restrict__ wqp, float* __restrict__ wsc) {
    const int lane = C.lane;
    volatile LAS unsigned char* row = (volatile LAS unsigned char*)(lds + C.wave * 1024);
    for (int tb = C.gw * 2; tb < T; tb += C.ngw * 2) {
        int e0[2], e1[2], s0[2], s1[2]; float h[2], g0[2], g1[2];
#pragma unroll
        for (int u = 0; u < 2; ++u) {
            const int t = tb + u;
            e0[u] = eidx[(size_t)t * 128 + lane]; e1[u] = eidx[(size_t)t * 128 + 64 + lane];
            g0[u] = egate[(size_t)t * 128 + lane]; g1[u] = egate[(size_t)t * 128 + 64 + lane];
            h[u] = hsc[t]; s0[u] = 0; s1[u] = 0;
#pragma unroll
            for (int s = 0; s < 8; ++s) { const short* pp = pdot + ((size_t)s * T + t) * 128 + lane; s0[u] += (int)pp[0]; s1[u] += (int)pp[64]; }
        }
        float w0[2], w1[2];
#pragma unroll
        for (int u = 0; u < 2; ++u) {
            w0[u] = gelu_fast((float)s0[u] * (8.0f * h[u]) * us[e0[u]]) * g0[u] * vs[e0[u]];
            w1[u] = gelu_fast((float)s1[u] * (8.0f * h[u]) * us[e1[u]]) * g1[u] * vs[e1[u]];
        }
#pragma unroll
        for (int u = 0; u < 2; ++u) {
            const int t = tb + u;
            const float wm = wave_max(fmaxf(fabsf(w0[u]), fabsf(w1[u])));
            const float inv = wm > 0.f ? 127.0f / wm : 0.f;
            { const int k = lane; row[u * 128 + (k & 7) * 16 + (k >> 5) * 4 + ((k >> 3) & 3)] = (unsigned char)(int)rintf(w0[u] * inv); }
            { const int k = 64 + lane; row[u * 128 + (k & 7) * 16 + (k >> 5) * 4 + ((k >> 3) & 3)] = (unsigned char)(int)rintf(w1[u] * inv); }
            if (lane == 0) wsc[t] = wm * (1.0f / 127.0f);
        }
        LDS_WAIT();
        wqp[(size_t)tb * 32 + lane] = ((volatile LAS unsigned*)row)[lane];
        LDS_WAIT();
    }
}
template <int EMASK>
__device__ __forceinline__ void ph_vpeer(const Ctx& C, const Slicing SL, const int* __restrict__ eidx, const unsigned* __restrict__ wqp, const float* __restrict__ wsc, const unsigned char* __restrict__ vq,
                                         f16* __restrict__ peer) {
    const int lane = C.lane, grp = lane >> 3, c8 = lane & 7;
    const bool hh = (lane & 32) != 0, b4 = (lane & 16) != 0, b3 = (lane & 8) != 0;
    const int wv = SL.rank * NWAVES + C.wave, nwv = SL.nloc * NWAVES;
    const int ntok = (T - wv + nwv - 1) / nwv;
    auto tok = [&](int i) { const int t = wv + i * nwv; return t < T ? t : T - 1; };
  for (int s = SL.pi; s < 8; s += SL.m) {
    const __amdgpu_buffer_rsrc_t vrs = slice_rsrc(vq + (size_t)s * (NEXP * 128));
    const int chl = 8 * (hh ? 1 : 0) + 4 * (b4 ? 1 : 0) + 2 * (b3 ? 1 : 0);
    const int coff = s * 128 + c8 * 16 + chl;
    int tA = tok(0), tB = tok(1);
    int e0 = eidx[(size_t)tA * 128 + lane], e1 = eidx[(size_t)tA * 128 + 64 + lane];
    u32x4 wq = *(const u32x4*)(wqp + (size_t)tA * 32 + grp * 4); float wscale = wsc[tA];
    int ne0 = eidx[(size_t)tB * 128 + lane], ne1 = eidx[(size_t)tB * 128 + 64 + lane];
    u32x4 r[16];
#pragma unroll
    for (int i = 0; i < 16; ++i) { const int e = __shfl(i < 8 ? e0 : e1, 8 * (i & 7) + grp) & EMASK; r[i] = __builtin_amdgcn_raw_buffer_load_b128(vrs, e * 128 + c8 * 16, 0, 0); }
#pragma unroll 1
    for (int it = 0; it < ntok; ++it) {
        const int t = tok(it), t1 = tok(it + 1), t2 = tok(it + 2);
        const int ze0 = eidx[(size_t)t2 * 128 + lane], ze1 = eidx[(size_t)t2 * 128 + 64 + lane];
        const u32x4 nwq = *(const u32x4*)(wqp + (size_t)t1 * 32 + grp * 4); const float nwscale = wsc[t1];
        int o[16];
#pragma unroll
        for (int c = 0; c < 16; ++c) o[c] = 0;
#pragma unroll
        for (int q = 0; q < 4; ++q) {
            int evv[4];
#pragma unroll
            for (int j = 0; j < 4; ++j) evv[j] = __shfl(q < 2 ? ne0 : ne1, 32 * (q & 1) + 8 * j + grp) & EMASK;
#pragma unroll
            for (int d = 0; d < 4; ++d) {
                const unsigned a = r[4 * q][d], b = r[4 * q + 1][d], c = r[4 * q + 2][d], e = r[4 * q + 3][d];
                const unsigned t0 = __builtin_amdgcn_perm(b, a, 0x05010400u), t1p = __builtin_amdgcn_perm(b, a, 0x07030602u);
                const unsigned u0 = __builtin_amdgcn_perm(e, c, 0x05010400u), u1 = __builtin_amdgcn_perm(e, c, 0x07030602u);
                o[4 * d + 0] = __builtin_amdgcn_sdot4((int)__builtin_amdgcn_perm(u0, t0, 0x05040100u), (int)wq[q], o[4 * d + 0], false);
                o[4 * d + 1] = __builtin_amdgcn_sdot4((int)__builtin_amdgcn_perm(u0, t0, 0x07060302u), (int)wq[q], o[4 * d + 1], false);
                o[4 * d + 2] = __builtin_amdgcn_sdot4((int)__builtin_amdgcn_perm(u1, t1p, 0x05040100u), (int)wq[q], o[4 * d + 2], false);
                o[4 * d + 3] = __builtin_amdgcn_sdot4((int)__builtin_amdgcn_perm(u1, t1p, 0x07060302u), (int)wq[q], o[4 * d + 3], false);
            }
#pragma unroll
            for (int j = 0; j < 4; ++j) {
                asm volatile("" ::: "memory");
                r[4 * q + j] = __builtin_amdgcn_raw_buffer_load_b128(vrs, evv[j] * 128 + c8 * 16, 0, 0);
                asm volatile("" ::: "memory");
            }
        }
        int q8[8], q4[4], q2[2];
#pragma unroll
        for (int k = 0; k < 8; ++k) q8[k] = bfly32i(o[k], o[8 + k]);
#pragma unroll
        for (int k = 0; k < 4; ++k) q4[k] = bfly16i(q8[k], q8[4 + k]);
#pragma unroll
        for (int k = 0; k < 2; ++k) { const int mine = b3 ? q4[2 + k] : q4[k], oth = b3 ? q4[k] : q4[2 + k]; q2[k] = mine + dppi<0x128>(oth); }
        { half2 pv; pv[0] = (f16)((float)q2[0] * wscale); pv[1] = (f16)((float)q2[1] * wscale); f16* yp = peer + (size_t)t * DM + coff; asm volatile("global_store_dword %0, %1, off" :: "v"(yp), "v"(pv) : "memory"); }
        wq = nwq; wscale = nwscale; ne0 = ze0; ne1 = ze1;
    }
  }
}
__device__ __forceinline__ void ph_final(const Ctx& C, const f16* __restrict__ peer, const f16* __restrict__ x1h, float* __restrict__ out, const float* __restrict__ gf) {
    const int lane = C.lane;
    f32x4 gg[4];
#pragma unroll
    for (int j = 0; j < 4; ++j) gg[j] = *(const f32x4*)(gf + j * 256 + lane * 4);
    for (int tb = C.gw * 4; tb < T; tb += C.ngw * 4) {
        half4 xv[4][4], pe[4][4];
#pragma unroll
        for (int u = 0; u < 4; ++u)
#pragma unroll
            for (int j = 0; j < 4; ++j) { xv[u][j] = *(const half4*)(x1h + (size_t)(tb + u) * DM + j * 256 + lane * 4); pe[u][j] = *(const half4*)(peer + (size_t)(tb + u) * DM + j * 256 + lane * 4); }
#pragma unroll
        for (int u = 0; u < 4; ++u) {
            f32x4 v[4]; float s = 0.f;
#pragma unroll
            for (int j = 0; j < 4; ++j) {
#pragma unroll
                for (int i = 0; i < 4; ++i) { v[j][i] = (float)xv[u][j][i] + (float)pe[u][j][i]; s += v[j][i] * v[j][i]; }
            }
            const float r = rsqrtf(wave_sum(s) * (1.0f / DM) + EPS);
#pragma unroll
            for (int j = 0; j < 4; ++j) *(f32x4*)(out + (size_t)(tb + u) * DM + j * 256 + lane * 4) = v[j] * r * gg[j];
        }
    }
}

namespace pg8 {
#define PG8_LAS __attribute__((address_space(3)))
typedef _Float16 frag8 __attribute__((ext_vector_type(8)));
typedef float f32x4 __attribute__((ext_vector_type(4)));
constexpr int BM = 256, BK = 64, HALF = 128, HTB = HALF * BK * 2  , STAGE_BYTES = 8 * HTB, NXCD = 8, WGM = 8;

__host__ __device__ __forceinline__ int lds_byte(int r, int c) { const int st = (r >> 4) * 2 + (c >> 5), rr = r & 15, cc = c & 31, ob = rr * 64 + cc * 2; return st * 1024 + (ob ^ (((ob >> 9) & 1) << 5)); }
__host__ __device__ __forceinline__ void stage_rc(int b, int& R, int& C) { const int st = b / 1024, sb = b % 1024, swz = sb ^ (((sb >> 9) & 1) << 5); R = (st >> 1) * 16 + swz / 64; C = (st & 1) * 32 + (swz % 64) / 2; }
__host__ __device__ __forceinline__ int perm32(int rho) { const int n = rho >> 4, i = rho & 15; return 8 * (i >> 2) + 4 * n + (i & 3); }

struct Unit { int pm, pn; };
struct Gemm { const f16* A; const f16* Bt; int M, N, K; };

struct StaticOrder {
    int nM, nN, nwg, G, c;
    __host__ __device__ void init(int M, int N, int G_, int c_) { nM = M / BM; nN = N / BM; nwg = nM * nN; G = G_; c = c_; }
    __host__ __device__ bool next(int i, Unit& u) const {
        const long L = (long)i * G + c; if (L >= nwg) return false;
        int wgid = (int)L; { const int q = nwg / NXCD, r = nwg % NXCD, xcd = wgid % NXCD, off = wgid / NXCD; wgid = (xcd < r ? xcd * (q + 1) : r * (q + 1) + (xcd - r) * q) + off; }
        const int nig = WGM * nN, gid = wgid / nig, fm = gid * WGM, gsz = (nM - fm) < WGM ? (nM - fm) : WGM;
        u.pm = fm + ((wgid % nig) % gsz); u.pn = (wgid % nig) / gsz; return true;
    }
    __device__ __forceinline__ void a_ready(const Unit&) const {}
    __device__ __forceinline__ void done(const Unit&) const {}
};

__device__ __forceinline__ frag8 pack8(const f32x4 a, const f32x4 b) {
    frag8 h; h[0] = (f16)a[0]; h[1] = (f16)a[1]; h[2] = (f16)a[2]; h[3] = (f16)a[3]; h[4] = (f16)b[0]; h[5] = (f16)b[1]; h[6] = (f16)b[2]; h[7] = (f16)b[3]; return h;
}
__device__ __forceinline__ float sigmoidf_(float z) { return 1.0f / (1.0f + __expf(-z)); }

constexpr size_t GATE_TILE = 65536, GATE_WAVE = 8192, GATE_CHUNK = 1024;
struct EpiP1 {
    typedef i32x4 acc_t; static constexpr bool PERM = true, AFTER_DRAIN = false, MIDK = false;
    const float* ss1; const float* rsx; const float* wcs; const float* bgate; f16* qkvu; unsigned char* gates; f16* vT;
    __device__ __forceinline__ static unsigned q4(const f32x4 v) {
        return (unsigned)(v[0] * 255.0f + 0.5f) | ((unsigned)(v[1] * 255.0f + 0.5f) << 8) | ((unsigned)(v[2] * 255.0f + 0.5f) << 16) | ((unsigned)(v[3] * 255.0f + 0.5f) << 24);
    }
    __device__ __forceinline__ void operator()(const i32x4 (&acc)[2][2][4][2], const Unit& u, int wr, int wc, int fr, int fq) const {
        const int row0 = u.pm * BM + wr * 64 + fr, colt = u.pn * BM; const bool isg = colt >= NQKVU;
        f32x4 cs[2][2];
#pragma unroll
        for (int bj = 0; bj < 2; ++bj) { const int c0 = colt + bj * HALF + wc * 32 + 8 * fq; cs[bj][0] = *(const f32x4*)(wcs + c0); cs[bj][1] = *(const f32x4*)(wcs + c0 + 4); }
        float sa[8], sb[8];
#pragma unroll
        for (int q = 0; q < 8; ++q) { const int row = row0 + (q >> 2) * HALF + (q & 3) * 16; sa[q] = ss1[row]; sb[q] = rsx[row]; }
        if (isg) {
            f32x4 bg[2][2];
#pragma unroll
            for (int bj = 0; bj < 2; ++bj) { const int cg = colt - NQKVU + bj * HALF + wc * 32 + 8 * fq; bg[bj][0] = *(const f32x4*)(bgate + cg); bg[bj][1] = *(const f32x4*)(bgate + cg + 4); }

#ifndef NO_PIN_P1G
            asm volatile("" : "+v"(sa[0]), "+v"(sa[1]), "+v"(sa[2]), "+v"(sa[3]), "+v"(sa[4]), "+v"(sa[5]), "+v"(sa[6]), "+v"(sa[7]), "+v"(sb[0]), "+v"(sb[1]), "+v"(sb[2]), "+v"(sb[3]), "+v"(sb[4]), "+v"(sb[5]),
                         "+v"(sb[6]), "+v"(sb[7]), "+v"(cs[0][0]), "+v"(cs[0][1]), "+v"(cs[1][0]), "+v"(cs[1][1]), "+v"(bg[0][0]), "+v"(bg[0][1]), "+v"(bg[1][0]), "+v"(bg[1][1]) :: "memory");
#endif

            unsigned char* gl = gates + (size_t)((u.pm * 8 + (u.pn - 5)) * 8 + wr * 4 + wc) * GATE_WAVE + (fq * 16 + fr) * 16;
#pragma unroll
            for (int ai = 0; ai < 2; ++ai)
#pragma unroll
                for (int m = 0; m < 4; ++m) { const float r = rsqrtf(sa[ai * 4 + m] * (1.0f / DM) + EPS) * sb[ai * 4 + m];
                    u32x4 gw;
#pragma unroll
                    for (int bj = 0; bj < 2; ++bj) { f32x4 v0, v1;
#pragma unroll
                        for (int i = 0; i < 4; ++i) { v0[i] = sigmoidf_((float)acc[ai][bj][m][0][i] * (r * cs[bj][0][i]) + bg[bj][0][i]); v1[i] = sigmoidf_((float)acc[ai][bj][m][1][i] * (r * cs[bj][1][i]) + bg[bj][1][i]); }
                        gw[2 * bj] = q4(v0); gw[2 * bj + 1] = q4(v1); }
                    *(u32x4*)(gl + (ai * 4 + m) * GATE_CHUNK) = gw; }
        } else {

#ifndef NO_PIN_P1Q
            asm volatile("" : "+v"(sa[0]), "+v"(sa[1]), "+v"(sa[2]), "+v"(sa[3]), "+v"(sa[4]), "+v"(sa[5]), "+v"(sa[6]), "+v"(sa[7]), "+v"(sb[0]), "+v"(sb[1]), "+v"(sb[2]), "+v"(sb[3]), "+v"(sb[4]), "+v"(sb[5]),
                         "+v"(sb[6]), "+v"(sb[7]), "+v"(cs[0][0]), "+v"(cs[0][1]), "+v"(cs[1][0]), "+v"(cs[1][1]) :: "memory");
#endif

#pragma unroll
            for (int ai = 0; ai < 2; ++ai)
#pragma unroll
                for (int m = 0; m < 4; ++m) { const int row = row0 + ai * HALF + m * 16; const float r = rsqrtf(sa[ai * 4 + m] * (1.0f / DM) + EPS) * sb[ai * 4 + m];
#pragma unroll
                    for (int bj = 0; bj < 2; ++bj) { const int c0 = colt + bj * HALF + wc * 32 + 8 * fq; f32x4 v0, v1;
#pragma unroll
                        for (int i = 0; i < 4; ++i) { v0[i] = (float)acc[ai][bj][m][0][i] * (r * cs[bj][0][i]); v1[i] = (float)acc[ai][bj][m][1][i] * (r * cs[bj][1][i]); }
                        const frag8 hv = pack8(v0, v1); *(frag8*)(qkvu + (size_t)row * NQKVU + c0) = hv;
                        if (colt == 512 && bj == 1) {
                            f16* vp = vT + ((size_t)((row >> 11) * 2 + (wc >> 1)) * 64 + (wc & 1) * 32 + 8 * fq) * SEQ + (row & (SEQ - 1));
#pragma unroll
                            for (int i = 0; i < 8; ++i) vp[(size_t)i * SEQ] = hv[i]; } } }
        }
    }
};
struct EpiMerged {
    typedef f32x4 acc_t; static constexpr bool PERM = true, AFTER_DRAIN = false, MIDK = true;
    const unsigned char* gates; f16* merged;
    __device__ __forceinline__ static float ub(unsigned w, int i) { return (float)((w >> (8 * i)) & 255u); }
    __device__ __forceinline__ void mid(f32x4 (&acc)[2][2][4][2], const Unit& u, int wr, int wc, int fr, int fq) const {
        const unsigned char* gb = gates + (size_t)((u.pm * 8 + u.pn) * 8 + wr * 4 + wc) * GATE_WAVE + (fq * 16 + fr) * 16;
        asm volatile("" : "+v"(gb));
#pragma unroll
        for (int ai = 0; ai < 2; ++ai) {
            u32x4 g0[4], g1[4];
#pragma unroll
            for (int m = 0; m < 4; ++m) { g0[m] = *(const u32x4*)(gb + (ai * 4 + m) * GATE_CHUNK); g1[m] = *(const u32x4*)(gb + 4 * GATE_TILE + (ai * 4 + m) * GATE_CHUNK); }
#pragma unroll
            for (int m = 0; m < 4; ++m)
#pragma unroll
                for (int bj = 0; bj < 2; ++bj)
#pragma unroll
                    for (int n = 0; n < 2; ++n)
#pragma unroll
                        for (int i = 0; i < 4; ++i) acc[ai][bj][m][n][i] *= ub(g0[m][2 * bj + n], i) * __builtin_amdgcn_rcpf(fmaxf(ub(g1[m][2 * bj + n], i), 0.0255f));
            asm volatile("" ::: "memory");
        }
    }
    __device__ __forceinline__ void operator()(const f32x4 (&acc)[2][2][4][2], const Unit& u, int wr, int wc, int fr, int fq) const {
        const int row0 = u.pm * BM + wr * 64 + fr, colt = u.pn * BM;
        const unsigned char* gb = gates + (size_t)((u.pm * 8 + 4 + u.pn) * 8 + wr * 4 + wc) * GATE_WAVE + (fq * 16 + fr) * 16;
        u32x4 g1a[8];
#pragma unroll
        for (int q = 0; q < 8; ++q) g1a[q] = *(const u32x4*)(gb + q * GATE_CHUNK);

#ifndef NO_PIN_MERGED
            asm volatile("" : "+v"(g1a[0]), "+v"(g1a[1]), "+v"(g1a[2]), "+v"(g1a[3]), "+v"(g1a[4]), "+v"(g1a[5]), "+v"(g1a[6]), "+v"(g1a[7]) :: "memory");
#endif

#pragma unroll
        for (int ai = 0; ai < 2; ++ai)
#pragma unroll
            for (int m = 0; m < 4; ++m) { const int row = row0 + ai * HALF + m * 16;
                const u32x4 g1 = g1a[ai * 4 + m];
#pragma unroll
                for (int bj = 0; bj < 2; ++bj) { const int c0 = colt + bj * HALF + wc * 32 + 8 * fq; f32x4 v0, v1;
#pragma unroll
                    for (int i = 0; i < 4; ++i) { v0[i] = acc[ai][bj][m][0][i] * (fmaxf(ub(g1[2 * bj], i), 0.0255f) * (1.0f / 255.0f)); v1[i] = acc[ai][bj][m][1][i] * (fmaxf(ub(g1[2 * bj + 1], i), 0.0255f) * (1.0f / 255.0f)); }
                    *(frag8*)(merged + (size_t)row * DM + c0) = pack8(v0, v1); } }
    }
};
struct EpiOut {
    typedef f32x4 acc_t; static constexpr bool PERM = true, AFTER_DRAIN = false, MIDK = false;
    const float* x; f16* x1h; float* ss2p;
    __device__ __forceinline__ void operator()(const f32x4 (&acc)[2][2][4][2], const Unit& u, int wr, int wc, int fr, int fq) const {
        const int row0 = u.pm * BM + wr * 64 + fr, col0 = u.pn * BM + wc * 32 + 8 * fq;
#pragma unroll
        for (int ai = 0; ai < 2; ++ai) {
            frag8 ov[4][2]; float ssq[4];
#pragma unroll
            for (int hb = 0; hb < 2; ++hb) { const int mb = hb * 2;
                f32x4 xv[2][2][2];
#pragma unroll
                for (int m = 0; m < 2; ++m)
#pragma unroll
                    for (int bj = 0; bj < 2; ++bj) { const float* xp = x + (size_t)(row0 + ai * HALF + (mb + m) * 16) * DM + col0 + bj * HALF; xv[m][bj][0] = *(const f32x4*)xp; xv[m][bj][1] = *(const f32x4*)(xp + 4); }
#ifndef NO_PIN_OUT
                asm volatile("" : "+v"(xv[0][0][0]), "+v"(xv[0][0][1]), "+v"(xv[0][1][0]), "+v"(xv[0][1][1]), "+v"(xv[1][0][0]), "+v"(xv[1][0][1]), "+v"(xv[1][1][0]), "+v"(xv[1][1][1]) :: "memory");
#endif
#pragma unroll
                for (int m = 0; m < 2; ++m) { float sq = 0.f;
#pragma unroll
                    for (int bj = 0; bj < 2; ++bj) { const f32x4 y0 = xv[m][bj][0] + acc[ai][bj][mb + m][0], y1 = xv[m][bj][1] + acc[ai][bj][mb + m][1];
                        sq += ((y0[0] * y0[0] + y0[1] * y0[1]) + (y0[2] * y0[2] + y0[3] * y0[3])) + ((y1[0] * y1[0] + y1[1] * y1[1]) + (y1[2] * y1[2] + y1[3] * y1[3]));
                        ov[mb + m][bj] = pack8(y0, y1); }
                    ssq[mb + m] = sq; }
            }
#pragma unroll
            for (int m = 0; m < 4; ++m) { const int row = row0 + ai * HALF + m * 16; const size_t off = (size_t)row * DM + col0;
#pragma unroll
                for (int bj = 0; bj < 2; ++bj) *(frag8*)(x1h + off + bj * HALF) = ov[m][bj];
                float sq = ssq[m]; sq += __shfl_xor(sq, 16); sq += __shfl_xor(sq, 32);
                if (fq == 0) ss2p[(size_t)(u.pn * 4 + wc) * T + row] = sq; }
            asm volatile("" ::: "memory");
        }
    }
};
template <bool DRY> struct EpiQT {
    typedef i32x4 acc_t; static constexpr bool PERM = true, AFTER_DRAIN = false, MIDK = false;
    const float* hsc; const float* wqs; f16* qp;
    __device__ __forceinline__ void operator()(const i32x4 (&acc)[2][2][4][2], const Unit& u, int wr, int wc, int fr, int fq) const {
        if (DRY) {
#pragma unroll
            for (int ai = 0; ai < 2; ++ai)
#pragma unroll
                for (int bj = 0; bj < 2; ++bj)
#pragma unroll
                    for (int m = 0; m < 4; ++m) { asm volatile("" :: "v"(acc[ai][bj][m][0]), "v"(acc[ai][bj][m][1])); }
            return; }
        const int row0 = u.pm * BM + wr * 64 + fr, colt = u.pn * BM;
        f32x4 cs[2][2];
#pragma unroll
        for (int bj = 0; bj < 2; ++bj) { const int c0 = colt + bj * HALF + wc * 32 + 8 * fq; cs[bj][0] = *(const f32x4*)(wqs + c0); cs[bj][1] = *(const f32x4*)(wqs + c0 + 4); }
        unsigned char* qb = (unsigned char*)qp + (size_t)((u.pm * 8 + u.pn) * 8 + wr * 4 + wc) * 16384 + (fq * 16 + fr) * 16;
        float hr[8];
#pragma unroll
        for (int q = 0; q < 8; ++q) hr[q] = hsc[row0 + (q >> 2) * HALF + (q & 3) * 16];

#ifndef NO_PIN_Q
            asm volatile("" : "+v"(hr[0]), "+v"(hr[1]), "+v"(hr[2]), "+v"(hr[3]), "+v"(hr[4]), "+v"(hr[5]), "+v"(hr[6]), "+v"(hr[7]), "+v"(cs[0][0]), "+v"(cs[0][1]), "+v"(cs[1][0]), "+v"(cs[1][1]) :: "memory");
#endif

#pragma unroll
        for (int ai = 0; ai < 2; ++ai)
#pragma unroll
            for (int m = 0; m < 4; ++m) { const float r = hr[ai * 4 + m];
#pragma unroll
                for (int bj = 0; bj < 2; ++bj) { f32x4 v0, v1;
#pragma unroll
                    for (int i = 0; i < 4; ++i) { v0[i] = (float)acc[ai][bj][m][0][i] * (r * cs[bj][0][i]); v1[i] = (float)acc[ai][bj][m][1][i] * (r * cs[bj][1][i]); }
                    *(frag8*)(qb + ((ai * 4 + m) * 2 + bj) * 1024) = pack8(v0, v1); } }
    }
};

typedef EpiQT<false> EpiQ;
__device__ __forceinline__ void mma16(const frag8 b, const frag8 a, f32x4& c) { c = __builtin_amdgcn_mfma_f32_16x16x32_f16(b, a, c, 0, 0, 0); }
__device__ __forceinline__ void mma16(const frag8 b, const frag8 a, i32x4& c) { c = __builtin_amdgcn_mfma_i32_16x16x64_i8(__builtin_bit_cast(i32x4, b), __builtin_bit_cast(i32x4, a), c, 0, 0, 0); }
template <class Epi, class Sched, bool ALIGN_EPI = false, bool SP2 = false>
__device__ __forceinline__ void gemm_phase(PG8_LAS unsigned char* lds, const Gemm g, const Sched& S, const Epi& E) {
    const int tid = threadIdx.x, wid = __builtin_amdgcn_readfirstlane(tid >> 6), lane = tid & 63, wr = wid >> 2, wc = wid & 3, fr = lane & 15, fq = lane >> 4;
    const int K = g.K, nt = K / BK;
    unsigned voffA[2], voffB[2];
#pragma unroll
    for (int i = 0; i < 2; ++i) { int R, C; stage_rc(tid * 16 + i * 8192, R, C); const int Rb = Epi::PERM ? ((R & ~31) + perm32(R & 31)) : R;
        voffA[i] = (unsigned)(R * K + C) * 2u; voffB[i] = (unsigned)(Rb * K + C) * 2u; }
    const size_t kstep = (size_t)(BK * 2);
    const size_t hstep = (size_t)HALF * K * 2;
    const size_t tstep = 2 * hstep;
    const unsigned ldsw = (unsigned)wid * 1024u;
    const int aoff = lds_byte(wr * 64 + fr, fq * 8), boff = lds_byte(wc * 32 + fr, fq * 8);
#define PG8_SA(b, h) (((b) * 2 + (h)) * HTB)
#define PG8_SB(b, h) ((4 + (b) * 2 + (h)) * HTB)
#define PG8_STAGE(bufoff, gbase, voff) do { _Pragma("unroll") for (int _i = 0; _i < 2; ++_i) \
        __builtin_amdgcn_global_load_lds((const unsigned*)((const char*)(gbase) + (voff)[_i]), (PG8_LAS unsigned*)(lds + (bufoff) + ldsw + _i * 8192), 16, 0, 0); } while (0)
#define PG8_LDA(dst, b, h) do { _Pragma("unroll") for (int m = 0; m < 4; ++m) _Pragma("unroll") for (int k = 0; k < 2; ++k) dst[m][k] = *(const PG8_LAS frag8*)(lds + PG8_SA(b, h) + aoff + m * 2048 + k * 1024); } while (0)
#define PG8_LDB(dst, b, h) do { _Pragma("unroll") for (int n = 0; n < 2; ++n) _Pragma("unroll") for (int k = 0; k < 2; ++k) dst[n][k] = *(const PG8_LAS frag8*)(lds + PG8_SB(b, h) + boff + n * 2048 + k * 1024); } while (0)
#define PG8_MMA(ai, bj, At, Bt) do { __builtin_amdgcn_s_setprio(1); _Pragma("unroll") for (int m = 0; m < 4; ++m) _Pragma("unroll") for (int n = 0; n < 2; ++n) _Pragma("unroll") for (int k = 0; k < 2; ++k) \
        mma16(Bt[n][k], At[m][k], acc[ai][bj][m][n]); __builtin_amdgcn_s_setprio(0); } while (0)
#define PG8_WAIT_V(n) asm volatile("s_waitcnt vmcnt(" #n ")" ::: "memory")
#define PG8_WAIT_L(n) asm volatile("s_waitcnt lgkmcnt(" #n ")" ::: "memory")
#define PG8_BAR __builtin_amdgcn_s_barrier()
#define PG8_SCHED __builtin_amdgcn_sched_barrier(0)
    Unit cur, nxt; int ui = 0;
    if (!S.next(0, cur)) return;
    typedef typename Epi::acc_t acc_t;
    acc_t acc[2][2][4][2];
#pragma unroll
    for (int a = 0; a < 2; ++a)
#pragma unroll
        for (int b = 0; b < 2; ++b)
#pragma unroll
            for (int m = 0; m < 4; ++m)
#pragma unroll
                for (int n = 0; n < 2; ++n) acc[a][b][m][n] = acc_t{};
    frag8 At[4][2], B0[2][2], B1[2][2];
    const char* cA = (const char*)g.A + (size_t)cur.pm * tstep; const char* cB = (const char*)g.Bt + (size_t)cur.pn * tstep;
    S.a_ready(cur);
    if constexpr (SP2) {
        PG8_STAGE(PG8_SB(0, 0), cB, voffB); PG8_STAGE(PG8_SB(0, 1), cB + hstep, voffB); PG8_STAGE(PG8_SA(0, 0), cA, voffA); PG8_STAGE(PG8_SA(0, 1), cA + hstep, voffA);
        if (wr == 1) PG8_BAR;
        PG8_WAIT_V(2); PG8_BAR;
        PG8_STAGE(PG8_SB(1, 0), cB + kstep, voffB); PG8_STAGE(PG8_SA(1, 0), cA + kstep, voffA); PG8_STAGE(PG8_SB(1, 1), cB + hstep + kstep, voffB);
        PG8_WAIT_V(6); PG8_BAR;
    } else {
        PG8_STAGE(PG8_SB(0, 0), cB, voffB); PG8_STAGE(PG8_SA(0, 0), cA, voffA); PG8_STAGE(PG8_SB(0, 1), cB + hstep, voffB); PG8_STAGE(PG8_SA(0, 1), cA + hstep, voffA);
        if (wr == 1) PG8_BAR;
        PG8_WAIT_V(4); PG8_BAR;
        PG8_STAGE(PG8_SB(1, 0), cB + kstep, voffB); PG8_STAGE(PG8_SA(1, 0), cA + kstep, voffA); PG8_STAGE(PG8_SB(1, 1), cB + hstep + kstep, voffB);
        PG8_WAIT_V(6); PG8_BAR;
    }
    for (;;) {
        const bool has_next = S.next(ui + 1, nxt);
        const char* nA = has_next ? (const char*)g.A + (size_t)nxt.pm * tstep : cA; const char* nB = has_next ? (const char*)g.Bt + (size_t)nxt.pn * tstep : cB;
        for (int t = 0; t < nt; t += 2) {
            const bool last = (t == nt - 2);
            if constexpr (Epi::MIDK) { if (t == (nt >> 1)) E.mid(acc, cur, wr, wc, fr, fq); }
            const char* a1 = cA + (size_t)(t + 1) * kstep;
            const char* a2 = last ? nA : cA + (size_t)(t + 2) * kstep; const char* b2 = last ? nB : cB + (size_t)(t + 2) * kstep;
            const char* a3 = a2 + kstep; const char* b3 = b2 + kstep;
            if (last && has_next) S.a_ready(nxt);
            if constexpr (SP2) {
            PG8_LDB(B0, 0, 0); PG8_LDB(B1, 0, 1); PG8_SCHED; PG8_LDA(At, 0, 0); PG8_STAGE(PG8_SA(1, 1), a1 + hstep, voffA);
            PG8_WAIT_V(8); PG8_WAIT_L(0); PG8_BAR; PG8_MMA(0, 0, At, B0); PG8_MMA(0, 1, At, B1); PG8_BAR; PG8_SCHED;
            PG8_LDA(At, 0, 1); PG8_STAGE(PG8_SB(0, 0), b2, voffB); PG8_STAGE(PG8_SB(0, 1), b2 + hstep, voffB); PG8_STAGE(PG8_SA(0, 0), a2, voffA);
            PG8_WAIT_V(8); PG8_WAIT_L(0); PG8_BAR; PG8_MMA(1, 0, At, B0); PG8_MMA(1, 1, At, B1); PG8_BAR; PG8_SCHED;
            PG8_LDB(B0, 1, 0); PG8_LDB(B1, 1, 1); PG8_SCHED; PG8_LDA(At, 1, 0); PG8_STAGE(PG8_SA(0, 1), a2 + hstep, voffA);
            PG8_WAIT_V(8); PG8_WAIT_L(0); PG8_BAR; PG8_MMA(0, 0, At, B0); PG8_MMA(0, 1, At, B1); PG8_BAR; PG8_SCHED;
            PG8_LDA(At, 1, 1); PG8_STAGE(PG8_SB(1, 0), b3, voffB); PG8_STAGE(PG8_SB(1, 1), b3 + hstep, voffB); PG8_STAGE(PG8_SA(1, 0), a3, voffA);
            PG8_WAIT_V(8); PG8_WAIT_L(0); PG8_BAR; PG8_MMA(1, 0, At, B0); PG8_MMA(1, 1, At, B1); PG8_BAR; PG8_SCHED;
            } else {
            PG8_LDB(B0, 0, 0); PG8_SCHED; PG8_LDA(At, 0, 0); PG8_STAGE(PG8_SA(1, 1), a1 + hstep, voffA);
            PG8_WAIT_L(8); PG8_BAR; PG8_WAIT_L(0); PG8_MMA(0, 0, At, B0); PG8_BAR; PG8_SCHED;
            PG8_LDB(B1, 0, 1); PG8_STAGE(PG8_SB(0, 0), b2, voffB);
            PG8_BAR; PG8_WAIT_L(0); PG8_MMA(0, 1, At, B1); PG8_BAR;
            PG8_LDA(At, 0, 1); PG8_STAGE(PG8_SA(0, 0), a2, voffA);
            PG8_BAR; PG8_WAIT_L(0); PG8_MMA(1, 0, At, B0); PG8_BAR; PG8_SCHED;
            PG8_STAGE(PG8_SB(0, 1), b2 + hstep, voffB);
            PG8_WAIT_V(6); PG8_BAR; PG8_MMA(1, 1, At, B1); PG8_BAR;
            PG8_LDB(B0, 1, 0); PG8_SCHED; PG8_LDA(At, 1, 0); PG8_STAGE(PG8_SA(0, 1), a2 + hstep, voffA);
            PG8_WAIT_L(8); PG8_BAR; PG8_WAIT_L(0); PG8_MMA(0, 0, At, B0); PG8_BAR; PG8_SCHED;
            PG8_LDB(B1, 1, 1); PG8_STAGE(PG8_SB(1, 0), b3, voffB);
            PG8_BAR; PG8_WAIT_L(0); PG8_MMA(0, 1, At, B1); PG8_BAR;
            PG8_LDA(At, 1, 1); PG8_STAGE(PG8_SA(1, 0), a3, voffA);
            PG8_BAR; PG8_WAIT_L(0); PG8_MMA(1, 0, At, B0); PG8_BAR; PG8_SCHED;
            PG8_STAGE(PG8_SB(1, 1), b3 + hstep, voffB);
            PG8_WAIT_V(6); PG8_BAR; PG8_MMA(1, 1, At, B1); PG8_BAR;
            }
        }
        if constexpr (ALIGN_EPI) { if (wr == 0) PG8_BAR; }
        if constexpr (!Epi::AFTER_DRAIN) { E(acc, cur, wr, wc, fr, fq); S.done(cur); }
        if (!has_next) break;
#pragma unroll
        for (int a = 0; a < 2; ++a)
#pragma unroll
            for (int b = 0; b < 2; ++b)
#pragma unroll
                for (int m = 0; m < 4; ++m)
#pragma unroll
                    for (int n = 0; n < 2; ++n) acc[a][b][m][n] = acc_t{};
        cur = nxt; cA = nA; cB = nB; ++ui;
        if constexpr (ALIGN_EPI) { if (wr == 1) PG8_BAR; }
    }
    PG8_WAIT_V(0);
    if constexpr (!ALIGN_EPI) { if (wr == 0) PG8_BAR; }
    PG8_BAR;
    if constexpr (Epi::AFTER_DRAIN) { E.fused(acc, cur, wr, wc, fr, fq, lds, wid, lane); S.done(cur); }
#undef PG8_SA
#undef PG8_SB
#undef PG8_STAGE
#undef PG8_LDA
#undef PG8_LDB
#undef PG8_MMA
#undef PG8_WAIT_V
#undef PG8_WAIT_L
#undef PG8_BAR
#undef PG8_SCHED
}
}

#define XB_TMO      128
#define XB_XCNT(j)  (256  + 64 * (j))
#define XB_XSUB(j)  (1280 + 64 * (j))
#define XB_XGEN(j)  (2304 + 64 * (j))
#define XB_TOP      3328
#define XB_TOPGEN   3392
#define XCD_BAR_WORDS 3456
#define XB_SPIN_CAP (1u << 18)

__device__ __forceinline__ unsigned xb_ld(unsigned* p)              { return __hip_atomic_load(p, __ATOMIC_RELAXED, __HIP_MEMORY_SCOPE_AGENT); }
__device__ __forceinline__ unsigned xb_add(unsigned* p, unsigned v) { return __hip_atomic_fetch_add(p, v, __ATOMIC_RELAXED, __HIP_MEMORY_SCOPE_AGENT); }
__device__ __forceinline__ unsigned xb_xcc_id() { return (unsigned)__builtin_amdgcn_s_getreg((3 << 11) | 20) & 0xFu; }
#define XB_SPIN(cond, bar) do { unsigned _sp = 0; while (cond) { __builtin_amdgcn_s_sleep(1); \
    if ((++_sp & 255u) == 0u) { if (xb_ld(&(bar)[XB_TMO])) break; if (_sp > XB_SPIN_CAP) { atomicAdd(&(bar)[XB_TMO], 1u); break; } } } } while (0)

struct XcdBarrier {
    unsigned* bar; unsigned x;
    volatile LAS unsigned* st;
};

__device__ __forceinline__ XcdBarrier xcd_barrier_post(unsigned* bar, volatile LAS unsigned* st) {
    XcdBarrier b; b.bar = bar; b.x = xb_xcc_id(); b.st = st;
    if (threadIdx.x == 0) st[2] = xb_add(&bar[XB_XCNT(b.x)], 1u);
    return b;
}
__device__ __forceinline__ void xcd_barrier_complete(unsigned* bar, unsigned x, unsigned& nloc, unsigned& nx) {
    const unsigned G = gridDim.x * gridDim.y * gridDim.z;
    unsigned sum, cnt, mine, sp = 0u;
    for (;;) {
        sum = 0u; cnt = 0u; mine = 0u;
#pragma unroll
        for (unsigned j = 0; j < 16; ++j) { const unsigned c = xb_ld(&bar[XB_XCNT(j)]); sum += c; cnt += (c > 0u) ? 1u : 0u; mine = (j == x) ? c : mine; }
        if (sum == G) break;
        __builtin_amdgcn_s_sleep(1);
        if ((++sp & 255u) == 0u) { if (xb_ld(&bar[XB_TMO])) break; if (sp > XB_SPIN_CAP) { atomicAdd(&bar[XB_TMO], 1u); break; } }
    }
    nloc = mine > 0u ? mine : 1u; nx = cnt > 0u ? cnt : 1u;
}

__device__ __forceinline__ void xcd_barrier(const XcdBarrier& b) {
    asm volatile("s_waitcnt vmcnt(0)" ::: "memory");
    __syncthreads();
    if (threadIdx.x == 0) {
        unsigned* bar = b.bar;
        __builtin_amdgcn_s_waitcnt(0);
        unsigned nloc = b.st[0], nx = b.st[1];
        if (nloc == 0u) { xcd_barrier_complete(bar, b.x, nloc, nx); b.st[0] = nloc; b.st[1] = nx; }
        const unsigned old = xb_add(&bar[XB_XSUB(b.x)], 1u);
        const unsigned gen = old / nloc;
        if (old + 1u == (gen + 1u) * nloc) {
            __builtin_amdgcn_fence(__ATOMIC_RELEASE, "agent");
            asm volatile("s_waitcnt vmcnt(0)" ::: "memory");
            const unsigned og = xb_add(&bar[XB_TOP], 1u);
            const unsigned tg = og / nx;
            if (og + 1u == (tg + 1u) * nx) xb_add(&bar[XB_TOPGEN], 1u);
            else XB_SPIN(xb_ld(&bar[XB_TOPGEN]) == tg, bar);
            __builtin_amdgcn_fence(__ATOMIC_ACQUIRE, "agent");
            xb_add(&bar[XB_XGEN(b.x)], 1u);
            asm volatile("s_waitcnt vmcnt(0)" ::: "memory");
        } else {
            XB_SPIN(xb_ld(&bar[XB_XGEN(b.x)]) == gen, bar);
            __builtin_amdgcn_fence(__ATOMIC_ACQUIRE, "agent");
            asm volatile("s_waitcnt vmcnt(0)" ::: "memory");
        }
    }
    __syncthreads();
}


struct Args { const float* in[16]; float* out; unsigned char* ws; int ph_lo, ph_hi; };
constexpr int N_PHASES = 11;

__global__ void __launch_bounds__(NTHREADS, 2) mk_fwd(Args a) {
    extern __shared__ __attribute__((aligned(16))) unsigned char lds[];
    LAS unsigned char* L = (LAS unsigned char*)lds;
    volatile LAS unsigned* MISC = (volatile LAS unsigned*)(L + MISC_OFF);
    unsigned char* ws = a.ws;
    Ctx C;
    C.tid = threadIdx.x; C.lane = C.tid & 63; C.wave = __builtin_amdgcn_readfirstlane(C.tid >> 6);
    C.G = gridDim.x; C.gw = blockIdx.x * NWAVES + C.wave; C.ngw = C.G * NWAVES; C.gt = blockIdx.x * NTHREADS + C.tid; C.ngt = C.G * NTHREADS;
    for (int u = C.tid; u < (LDS_BYTES - LDSCTL_OFF) / 4; u += NTHREADS) ((LAS unsigned*)(L + LDSCTL_OFF))[u] = 0u;
    __syncthreads();
    const int lo = a.ph_lo, hi = a.ph_hi, G = C.G;
    const bool multi = (hi - lo) > 1;
    XcdBarrier bar; bar.bar = (unsigned*)(ws + WS_CTL) + CW_BAR; bar.x = 0; bar.st = nullptr;
    if (multi) bar = xcd_barrier_post((unsigned*)(ws + WS_CTL) + CW_BAR, MISC + 8);
#define IN(k) (lo <= (k) && (k) < hi)
#define SEAM(k) do { if (IN(k) && IN((k) + 1)) xcd_barrier(bar); } while (0)

#define FILLER(c, mode, nwg) do { const Stag sg_ = stag_group((int)blockIdx.x, G, (mode), (nwg)); if (sg_.member) { \
        if ((c) < 2) quant_rows_range<false>(C.lane, a.in[13], (unsigned*)(ws + WS_UQ), (float*)(ws + WS_US), 8192 * ((c) & 1), 8192 * ((c) & 1) + 8192, sg_.rank * NWAVES + C.wave, sg_.count * NWAVES); \
        else quant_rows_range<false>(C.lane, a.in[14], (unsigned*)(ws + WS_VQ), (float*)(ws + WS_VS), 8192 * ((c) & 1), 8192 * ((c) & 1) + 8192, sg_.rank * NWAVES + C.wave, sg_.count * NWAVES); } } while (0)
#define REPS(k) _Pragma("unroll") for (int rep_ = 0; rep_ < ((PROBE_DUP == (k)) ? 2 : 1); ++rep_)
#define REPBAR(k) do { if (PROBE_DUP == (k) && rep_ == 0) xcd_barrier(bar); } while (0)
    if (IN(0)) REPS(0) { ph_prep(C, L, a.in, ws); REPBAR(0); }
    SEAM(0);
    if (IN(1)) REPS(1) {
        for (int r2_ = 0; r2_ < (PROBE_DUP == 14 ? 2 : 1); ++r2_) {
        quant_wrows(C, (const f16*)(ws + WS_WCAT), NCAT, (unsigned*)(ws + WS_WCATQ), (float*)(ws + WS_WCS));
        quant_wrows(C, (const f16*)(ws + WS_WQ), 2048, (unsigned*)(ws + WS_WQQ), (float*)(ws + WS_WQS));
        xcd_barrier(bar); }
        pg8::Gemm g{(const f16*)(ws + WS_XH), (const f16*)(ws + WS_WCATQ), T, NCAT, DM / 2}; pg8::StaticOrder S; S.init(T, NCAT, G, (int)blockIdx.x);
        pg8::EpiP1 E{(const float*)(ws + WS_RS1), (const float*)(ws + WS_RSX), (const float*)(ws + WS_WCS), a.in[8], (f16*)(ws + WS_QKVU), ws + WS_GATES, (f16*)(ws + WS_VT)};
        if (rep_ == 0) FILLER(0, 1, (T / 256) * (NCAT / 256));
        pg8::gemm_phase<pg8::EpiP1, pg8::StaticOrder, true, true>(L, g, S, E);
        REPBAR(1);
    }
    SEAM(1);
    if (IN(2)) REPS(2) {
        ph_attn_pool(C, L, (const f16*)(ws + WS_QKVU), (const f16*)(ws + WS_VT), a.in[3], (const f16*)(ws + WS_POOLW), a.in[5], (f16*)(ws + WS_OCAT));
        REPBAR(2);
    }
    if (IN(2) && IN(4)) xcd_barrier(bar);
    if (IN(4)) REPS(4) {
        pg8::Gemm g{(const f16*)(ws + WS_OCAT), (const f16*)(ws + WS_WB), T, DM, DM}; pg8::StaticOrder S; S.init(T, DM, G, (int)blockIdx.x);
        pg8::EpiMerged E{ws + WS_GATES, (f16*)(ws + WS_MERGED)};
        if (rep_ == 0) FILLER(1, 0, 0);
        pg8::gemm_phase<pg8::EpiMerged, pg8::StaticOrder, true, true>(L, g, S, E);
        REPBAR(4);
    }
    SEAM(4);
    if (IN(5)) REPS(5) {
        pg8::Gemm g{(const f16*)(ws + WS_MERGED), (const f16*)(ws + WS_WOUT), T, DM, DM}; pg8::StaticOrder S; S.init(T, DM, G, (int)blockIdx.x);
        pg8::EpiOut E{a.in[0], (f16*)(ws + WS_X1H), (float*)(ws + WS_SS2)};
        if (rep_ == 0) FILLER(2, 0, 0);
        pg8::gemm_phase<pg8::EpiOut, pg8::StaticOrder, true, true>(L, g, S, E);
        REPBAR(5);
    }
    SEAM(5);
    if (IN(6)) REPS(6) {
        for (int r2_ = 0; r2_ < (PROBE_DUP == 12 ? 2 : 1); ++r2_) {
        ph_h2quant(C, (const f16*)(ws + WS_X1H), a.in[10], (const float*)(ws + WS_SS2), (unsigned*)(ws + WS_H2Q), (float*)(ws + WS_HSC));
        xcd_barrier(bar); }
        pg8::Gemm g{(const f16*)(ws + WS_H2Q), (const f16*)(ws + WS_WQQ), T, 2048, DM / 2}; pg8::StaticOrder S; S.init(T, 2048, G, (int)blockIdx.x);
        pg8::EpiQ E{(const float*)(ws + WS_HSC), (const float*)(ws + WS_WQS), (f16*)(ws + WS_QP)};
        if (rep_ == 0) FILLER(3, 0, 0);
        pg8::gemm_phase<pg8::EpiQ, pg8::StaticOrder, true, true>(L, g, S, E);
#if PROBE_DUP == 13
        xcd_barrier(bar); pg8::gemm_phase<pg8::EpiQ, pg8::StaticOrder, true, true>(L, g, S, E);
#elif PROBE_DUP == 16
        xcd_barrier(bar); { pg8::EpiQT<true> E2{E.hsc, E.wqs, E.qp}; pg8::gemm_phase<pg8::EpiQT<true>, pg8::StaticOrder, true, true>(L, g, S, E2); }
#endif
        REPBAR(6);
    }
    SEAM(6);
    if (IN(7)) REPS(7) {
        auto side = [&]() {};
        ph_route(C, L, (const f16*)(ws + WS_QP), (const float*)(ws + WS_SS2), (const f16*)(ws + WS_SUBK), (int*)(ws + WS_EIDX), (float*)(ws + WS_EGATE), side);
        REPBAR(7); }
    SEAM(7);
    if (IN(8)) REPS(8) {
        const Slicing SL = get_slicing((const unsigned*)(ws + WS_CTL) + CW_BAR, MISC);
        if (PROBE_DUP == 8 && rep_ == 0) ph_upeer<255>(C, L, SL, (const unsigned*)(ws + WS_H2Q), (const int*)(ws + WS_EIDX), (const unsigned char*)(ws + WS_UQ), (short*)(ws + WS_PDOT));
        else ph_upeer<16383>(C, L, SL, (const unsigned*)(ws + WS_H2Q), (const int*)(ws + WS_EIDX), (const unsigned char*)(ws + WS_UQ), (short*)(ws + WS_PDOT));
        REPBAR(8);
    }
    SEAM(8);
    if (IN(9)) {
        REPS(9) {
        ph_ureduce(C, L, (const short*)(ws + WS_PDOT), (const float*)(ws + WS_HSC), (const int*)(ws + WS_EIDX), (const float*)(ws + WS_US), (const float*)(ws + WS_VS), (const float*)(ws + WS_EGATE),
                   (unsigned*)(ws + WS_WQP), (float*)(ws + WS_WSC));
        REPBAR(9); }
        xcd_barrier(bar);
        const Slicing SL = get_slicing((const unsigned*)(ws + WS_CTL) + CW_BAR, MISC);
        REPS(11) {
        ph_vpeer<16383>(C, SL, (const int*)(ws + WS_EIDX), (const unsigned*)(ws + WS_WQP), (const float*)(ws + WS_WSC), (const unsigned char*)(ws + WS_VQ), (f16*)(ws + WS_PEER));
        REPBAR(11); }
    }
    SEAM(9);
    if (IN(10)) REPS(10) { REPBAR(10); ph_final(C, (const f16*)(ws + WS_PEER), (const f16*)(ws + WS_X1H), a.out, a.in[15]); }
#undef IN
#undef SEAM
}

#ifndef MK_N_LAUNCHES
#define MK_N_LAUNCHES 1
#endif
extern "C" void kernel_launch(void* const* d_in, const int* in_sizes, int n_in, void* d_out, int out_size, void* d_ws, size_t ws_size, hipStream_t stream) {
    static int grid = 0;
    if (grid == 0) {
        if (n_in != 16 || in_sizes[0] != T * DM || out_size != T * DM || ws_size < WS_END) {
            fprintf(stderr, "kernel_launch: unexpected shapes (n_in %d in0 %d out %d ws %zu)\n", n_in, n_in > 0 ? in_sizes[0] : -1, out_size, ws_size);
            grid = -1; return;
        }
        int dev = 0, cus = 0;
        if (hipGetDevice(&dev) != hipSuccess || hipDeviceGetAttribute(&cus, hipDeviceAttributeMultiprocessorCount, dev) != hipSuccess) { grid = -1; return; }
        if (hipFuncSetAttribute((const void*)mk_fwd, hipFuncAttributeMaxDynamicSharedMemorySize, LDS_BYTES) != hipSuccess) { fprintf(stderr, "kernel_launch: hipFuncSetAttribute failed\n"); grid = -1; return; }
        int per_cu = 0;
        if (hipOccupancyMaxActiveBlocksPerMultiprocessor(&per_cu, (const void*)mk_fwd, NTHREADS, LDS_BYTES) != hipSuccess || per_cu < 1)
            fprintf(stderr, "kernel_launch: occupancy query reports %d workgroups per CU\n", per_cu);
        (void)hipGetLastError();
        grid = cus;
    }
    if (grid < 0) return;
    (void)hipMemsetAsync((char*)d_ws + WS_CTL, 0, CTL_ZERO_BYTES, stream);
    Args a{};
    for (int i = 0; i < 16; ++i) a.in[i] = (const float*)d_in[i];
    a.out = (float*)d_out; a.ws = (unsigned char*)d_ws;
    if (MK_N_LAUNCHES == 1) {
        a.ph_lo = 0; a.ph_hi = N_PHASES;
        hipLaunchKernelGGL(mk_fwd, dim3(grid), dim3(NTHREADS), LDS_BYTES, stream, a);
    } else {
        for (int p = 0; p < N_PHASES; ++p) { a.ph_lo = p; a.ph_hi = p + 1; hipLaunchKernelGGL(mk_fwd, dim3(grid), dim3(NTHREADS), LDS_BYTES, stream, a); }
    }
}
```
